# Optimizing an MI355X kernel written in HIP

```python
import math
import jax
import jax.numpy as jnp
from jax import lax
import numpy as np

D_MODEL = 1024
BATCH = 1
SEQ = 16384
DEPTH = 2

GRID_W = 64
CTX_LEN = 256
RMS_EPS = 1e-6

SSD_HEADS = 6
SSD_HEAD_DIM = 64
SSD_WIDTH = SSD_HEADS * SSD_HEAD_DIM
SSD_GROUPS = 2
SSD_STATE = 128
SSD_CONV = 5
SSD_CHUNK = 128
SSD_XBC = SSD_WIDTH + 2 * SSD_GROUPS * SSD_STATE

NA_HEADS = 6
NA_HEAD_DIM = 64
NA_WIDTH = NA_HEADS * NA_HEAD_DIM
NA_ROWS = 8
NA_COLS = 16

HY_WIDTH = 256
HY_SHORT = 3
HY_EMB = 33
HY_BANDS = (HY_EMB - 1) // 2
HY_HIDDEN = 64
HY_FAST_DECAY = 0.3
HY_SLOW_DECAY = 1.5
HY_DECAY_TARGET = 1e-2

D_MIX = SSD_WIDTH + NA_WIDTH + HY_WIDTH

OFF_Z = 0
OFF_XBC = OFF_Z + SSD_WIDTH
OFF_DT = OFF_XBC + SSD_XBC
OFF_Q = OFF_DT + 2 * SSD_HEADS
OFF_K = OFF_Q + NA_WIDTH
OFF_V = OFF_K + NA_WIDTH
OFF_HY = OFF_V + NA_WIDTH
IN_COLS = OFF_HY + 3 * HY_WIDTH

N_EXPERTS = 32
TOP_K = 4
D_EXPERT = 1024
SWIGLU_LIMIT = 7.0
SWIGLU_ALPHA = 1.702
MOE_BLOCK = 128

kernel_name = "hybrid_ssd_natten_hyena_moe_dit"

F32 = jnp.float32


def rms_norm(x, g):
    xf = x.astype(F32)
    y = xf * lax.rsqrt(jnp.mean(xf * xf, axis=-1, keepdims=True) + RMS_EPS)
    return (y * g.astype(F32)).astype(x.dtype)


def dw_conv(u, w, b):
    k = w.shape[0]
    out = lax.conv_general_dilated(
        u, w[:, None, :].astype(u.dtype), window_strides=(1,), padding=[(k // 2, k // 2)],
        dimension_numbers=("NWC", "WIO", "NWC"), feature_group_count=u.shape[-1])
    return out + b.astype(u.dtype)


def ssd_scan(xs, dt, a, bm, cm, init, with_output):
    b, l, h, p = xs.shape
    g, n = bm.shape[2], bm.shape[3]
    q = SSD_CHUNK
    nc = l // q
    rep = h // g
    bh = jnp.repeat(bm.astype(F32), rep, axis=2).reshape(b, nc, q, h, n)
    xdt = (xs.astype(F32) * dt[..., None]).reshape(b, nc, q, h, p)
    a_cs = jnp.cumsum((dt * a).reshape(b, nc, q, h), axis=2)
    a_last = a_cs[:, :, -1]
    states = jnp.einsum("bcjhn,bcjh,bcjhp->bchpn", bh, jnp.exp(a_last[:, :, None] - a_cs), xdt)

    def carry_chunk(s, inp):
        st, dec = inp
        return s * dec[..., None, None] + st, s

    final, s_start = lax.scan(carry_chunk, init,
                              (jnp.moveaxis(states, 1, 0), jnp.moveaxis(jnp.exp(a_last), 1, 0)))
    if not with_output:
        return None, final
    ch = jnp.repeat(cm.astype(F32), rep, axis=2).reshape(b, nc, q, h, n)
    tri = jnp.tril(jnp.ones((q, q), dtype=bool))[:, :, None]
    seg = a_cs[:, :, :, None, :] - a_cs[:, :, None, :, :]
    decay = jnp.exp(jnp.where(tri, seg, -jnp.inf))
    scores = jnp.einsum("bcihn,bcjhn->bcijh", ch, bh) * decay
    y = (jnp.einsum("bcijh,bcjhp->bcihp", scores, xdt)
         + jnp.einsum("bcihn,bchpn,bcih->bcihp", ch, jnp.moveaxis(s_start, 0, 1), jnp.exp(a_cs)))
    return y.reshape(b, l, h, p), final


def ssd_prepare(p, conv_w, conv_b):
    b, l, _ = p.shape
    z = p[..., OFF_Z:OFF_XBC]
    xbc = jax.nn.silu(dw_conv(p[..., OFF_XBC:OFF_DT], conv_w, conv_b))
    gn = SSD_GROUPS * SSD_STATE
    xs = xbc[..., :SSD_WIDTH].reshape(b, l, SSD_HEADS, SSD_HEAD_DIM)
    bm = xbc[..., SSD_WIDTH:SSD_WIDTH + gn].reshape(b, l, SSD_GROUPS, SSD_STATE)
    cm = xbc[..., SSD_WIDTH + gn:].reshape(b, l, SSD_GROUPS, SSD_STATE)
    dt_raw = p[..., OFF_DT:OFF_Q].astype(F32).reshape(b, l, 2, SSD_HEADS)
    return z, xs, bm, cm, dt_raw


def ssd_direction(xs, bm, cm, dt_raw, a_log, dt_bias, direction, init, with_output):
    dt = jax.nn.softplus(dt_raw[:, :, direction] + dt_bias[direction].astype(F32))
    a = -jnp.exp(a_log[direction].astype(F32))
    if direction == 1:
        xs, bm, cm, dt = xs[:, ::-1], bm[:, ::-1], cm[:, ::-1], dt[:, ::-1]
    y, final = ssd_scan(xs, dt, a, bm, cm, init, with_output)
    if direction == 1 and y is not None:
        y = y[:, ::-1]
    return y, final


def ssd_output(y_sum, xs, z, d_skip, norm_g):
    b, l = xs.shape[:2]
    gsz = SSD_WIDTH // SSD_GROUPS
    y = (y_sum + d_skip.astype(F32)[:, None] * xs.astype(F32)).reshape(b, l, SSD_GROUPS, gsz)
    gated = y * jax.nn.silu(z.astype(F32)).reshape(b, l, SSD_GROUPS, gsz)
    gated = gated * lax.rsqrt(jnp.mean(gated * gated, axis=-1, keepdims=True) + RMS_EPS)
    return (gated.reshape(b, l, SSD_WIDTH) * norm_g.astype(F32)).astype(z.dtype)


def ssd_mixer(p_lat, p_ctx, conv_w, conv_b, a_log, dt_bias, d_skip, norm_g, ctx_out):
    z_c, x_c, b_c, c_c, dt_c = ssd_prepare(p_ctx, conv_w, conv_b)
    z_l, x_l, b_l, c_l, dt_l = ssd_prepare(p_lat, conv_w, conv_b)
    init = jnp.zeros((p_ctx.shape[0], SSD_HEADS, SSD_HEAD_DIM, SSD_STATE), F32)
    y_lat, y_ctx = [], []
    for direction in (0, 1):
        yc, s_ctx = ssd_direction(x_c, b_c, c_c, dt_c, a_log, dt_bias, direction, init, ctx_out)
        yl, _ = ssd_direction(x_l, b_l, c_l, dt_l, a_log, dt_bias, direction, s_ctx, True)
        y_lat.append(yl)
        y_ctx.append(yc)
    out_lat = ssd_output(y_lat[0] + y_lat[1], x_l, z_l, d_skip, norm_g)
    out_ctx = ssd_output(y_ctx[0] + y_ctx[1], x_c, z_c, d_skip, norm_g) if ctx_out else None
    return out_lat, out_ctx


def na_mixer(p_lat, p_ctx, rpb, ctx_out):
    b, l, _ = p_lat.shape
    rows = l // GRID_W
    kh = min(NA_ROWS, rows)
    scale = NA_HEAD_DIM ** -0.5

    def heads(p, off):
        return p[..., off:off + NA_WIDTH].reshape(p.shape[0], p.shape[1], NA_HEADS, NA_HEAD_DIM)

    q_grid = heads(p_lat, OFF_Q).reshape(b, rows, GRID_W, NA_HEADS, NA_HEAD_DIM)
    k_grid = heads(p_lat, OFF_K).reshape(b, rows, GRID_W, NA_HEADS, NA_HEAD_DIM)
    v_grid = heads(p_lat, OFF_V).reshape(b, rows, GRID_W, NA_HEADS, NA_HEAD_DIM)
    k_ctx, v_ctx = heads(p_ctx, OFF_K), heads(p_ctx, OFF_V)

    col = jnp.arange(GRID_W)
    col_start = jnp.clip(col - NA_COLS // 2, 0, GRID_W - NA_COLS)
    col_ok = (col[None, :] >= col_start[:, None]) & (col[None, :] < col_start[:, None] + NA_COLS)
    dc = jnp.clip(col[None, :] - col[:, None] + NA_COLS - 1, 0, 2 * NA_COLS - 2)
    bias_tab = rpb.astype(F32)

    def query_row(args):
        q_row, r = args
        r0 = jnp.clip(r - kh // 2, 0, rows - kh)
        k_blk = lax.dynamic_slice_in_dim(k_grid, r0, kh, axis=1)
        v_blk = lax.dynamic_slice_in_dim(v_grid, r0, kh, axis=1)
        dr = r0 + jnp.arange(kh) - r + NA_ROWS - 1
        bias = bias_tab[dr[None, :, None], dc[:, None, :]]
        s_loc = jnp.einsum("bqhd,bkwhd->bqkwh", q_row, k_blk, preferred_element_type=F32) * scale + bias
        s_loc = jnp.where(col_ok[None, :, None, :, None], s_loc, -jnp.inf)
        s_loc = s_loc.reshape(b, GRID_W, kh * GRID_W, NA_HEADS)
        s_ctx = jnp.einsum("bqhd,bchd->bqch", q_row, k_ctx, preferred_element_type=F32) * scale
        prob = jax.nn.softmax(jnp.concatenate([s_loc, s_ctx], axis=2), axis=2).astype(v_grid.dtype)
        p_loc = prob[:, :, :kh * GRID_W].reshape(b, GRID_W, kh, GRID_W, NA_HEADS)
        return (jnp.einsum("bqkwh,bkwhd->bqhd", p_loc, v_blk)
                + jnp.einsum("bqch,bchd->bqhd", prob[:, :, kh * GRID_W:], v_ctx))

    o = lax.map(query_row, (jnp.moveaxis(q_grid, 1, 0), jnp.arange(rows)))
    y_lat = jnp.moveaxis(o, 0, 1).reshape(b, l, NA_WIDTH)
    if not ctx_out:
        return y_lat, None
    q_ctx = heads(p_ctx, OFF_Q)
    s = jnp.einsum("bqhd,bkhd->bhqk", q_ctx, k_ctx, preferred_element_type=F32) * scale
    o_ctx = jnp.einsum("bhqk,bkhd->bqhd", jax.nn.softmax(s, axis=-1).astype(v_ctx.dtype), v_ctx)
    return y_lat, o_ctx.reshape(b, p_ctx.shape[1], NA_WIDTH)


def hyena_filters(length, w1, b1, w2, b2, w3, freq):
    t = jnp.linspace(0.0, 1.0, length, dtype=F32)[:, None]
    w = 2.0 * math.pi * jnp.arange(length, dtype=F32)[:, None] / length
    f = jnp.linspace(1e-4, HY_BANDS - 1, HY_BANDS, dtype=F32)[None, :]
    z = jnp.concatenate([t, jnp.cos(f * w), -jnp.sin(f * w)], axis=1)
    freq = freq.astype(F32)
    h = jnp.sin(freq[0] * (z @ w1.astype(F32) + b1.astype(F32)))
    h = jnp.sin(freq[1] * (h @ w2.astype(F32) + b2.astype(F32)))
    h = (h @ w3.astype(F32)).reshape(length, 2, HY_WIDTH)
    max_decay = math.log(HY_DECAY_TARGET) / HY_FAST_DECAY
    min_decay = math.log(HY_DECAY_TARGET) / HY_SLOW_DECAY
    deltas = jnp.abs(jnp.linspace(min_decay, max_decay, HY_WIDTH, dtype=F32))
    h = h * jnp.exp(-t[:, :, None] * deltas)
    h = h / jnp.sum(jnp.abs(h), axis=(0, 1), keepdims=True)
    return h[:, 0], h[:, 1]


def long_conv(u, h_fwd, h_bwd, d_bias):
    b, l, ch = u.shape
    k = jnp.concatenate([h_fwd, jnp.zeros((1, ch), F32), h_bwd[:0:-1]], axis=0)
    uf = u.astype(F32)
    y = jnp.fft.irfft(jnp.fft.rfft(uf, n=2 * l, axis=1) * jnp.fft.rfft(k, axis=0)[None], n=2 * l, axis=1)[:, :l]
    return (y + uf * d_bias.astype(F32)).astype(u.dtype)


def hyena_mixer(p, conv_w, conv_b, f_w1, f_b1, f_w2, f_b2, f_w3, freq, d_bias):
    uc = dw_conv(p[..., OFF_HY:IN_COLS], conv_w, conv_b)
    x0, x1, v = jnp.split(uc, 3, axis=-1)
    h_fwd, h_bwd = hyena_filters(p.shape[1], f_w1, f_b1, f_w2, f_b2, f_w3, freq)
    return x0 * long_conv(v * x1, h_fwd, h_bwd, d_bias)


def moe_ffn(h, w_router, b_router, w_gate_up, b_gate_up, w_down, b_down):
    t, d = h.shape
    logits = (h @ w_router + b_router).astype(F32)
    top_logit, top_idx = lax.top_k(logits, TOP_K)
    gate_w = jax.nn.softmax(top_logit, axis=-1)
    n = t * TOP_K
    flat_e = top_idx.reshape(n)
    order = jnp.argsort(flat_e)
    sorted_e = flat_e[order]
    counts = jnp.bincount(flat_e, length=N_EXPERTS)
    padded = (counts + MOE_BLOCK - 1) // MOE_BLOCK * MOE_BLOCK
    pad_end = jnp.cumsum(padded)
    pad_start = pad_end - padded
    start = jnp.cumsum(counts) - counts
    dest = pad_start[sorted_e] + jnp.arange(n) - start[sorted_e]
    n_blocks = (n + N_EXPERTS * (MOE_BLOCK - 1) + MOE_BLOCK - 1) // MOE_BLOCK
    n_rows = n_blocks * MOE_BLOCK
    row_tok = jnp.full((n_rows,), t, jnp.int32).at[dest].set((order // TOP_K).astype(jnp.int32))
    row_w = jnp.zeros((n_rows,), F32).at[dest].set(gate_w.reshape(n)[order])
    block_e = jnp.minimum(jnp.searchsorted(pad_end, jnp.arange(n_blocks) * MOE_BLOCK, side="right"),
                          N_EXPERTS - 1)
    h_pad = jnp.concatenate([h, jnp.zeros((1, d), h.dtype)], axis=0)
    xb = h_pad[row_tok].reshape(n_blocks, MOE_BLOCK, d)

    def expert_block(args):
        xblk, e = args
        gu = xblk @ w_gate_up[e] + b_gate_up[e]
        gate, up = jnp.split(gu, 2, axis=-1)
        gate = jnp.minimum(gate, SWIGLU_LIMIT)
        up = jnp.clip(up, -SWIGLU_LIMIT, SWIGLU_LIMIT)
        act = gate * jax.nn.sigmoid(SWIGLU_ALPHA * gate) * (up + 1.0)
        return act @ w_down[e] + b_down[e]

    yb = lax.map(expert_block, (xb, block_e)).reshape(n_rows, d)
    y = jax.ops.segment_sum(yb * row_w[:, None].astype(yb.dtype), row_tok, num_segments=t + 1)
    return y[:t]


def trunk_layer(x, ctx, c, c_ctx, lp, last):
    b, l, d = x.shape
    mod = jax.nn.silu(c) @ lp["w_mod"] + lp["b_mod"]
    mod_c = jax.nn.silu(c_ctx) @ lp["w_mod"] + lp["b_mod"]
    sh1, sc1, g1, sh2, sc2, g2 = jnp.split(mod[:, None, :], 6, axis=-1)
    sh1c, sc1c, g1c, sh2c, sc2c, g2c = jnp.split(mod_c, 6)
    gains = lp["norm_g"]

    h = rms_norm(x, gains[0]) * (1.0 + sc1) + sh1
    hc = rms_norm(ctx, gains[0]) * (1.0 + sc1c) + sh1c
    p = h @ lp["w_in"]
    pc = hc @ lp["w_in"]
    ctx_out = not last
    y_ssd, y_ssd_c = ssd_mixer(p, pc, lp["ssd_conv_w"], lp["ssd_conv_b"], lp["ssd_a_log"],
                               lp["ssd_dt_bias"], lp["ssd_d"], lp["ssd_norm_g"], ctx_out)
    y_na, y_na_c = na_mixer(p, pc, lp["na_rpb"], ctx_out)
    hy_args = (lp["hy_conv_w"], lp["hy_conv_b"], lp["hy_f_w1"], lp["hy_f_b1"], lp["hy_f_w2"],
               lp["hy_f_b2"], lp["hy_f_w3"], lp["hy_freq"], lp["hy_d"])
    y_hy = hyena_mixer(p, *hy_args)
    mix = jnp.concatenate([y_ssd, y_na, y_hy], axis=-1) @ lp["w_out"]
    x = x + g1 * rms_norm(mix, gains[1])
    h2 = rms_norm(x, gains[2]) * (1.0 + sc2) + sh2
    moe_args = (lp["w_router"], lp["b_router"], lp["w_gate_up"], lp["b_gate_up"], lp["w_down"], lp["b_down"])

    if last:
        f = moe_ffn(h2.reshape(b * l, d), *moe_args).reshape(b, l, d)
        return x + g2 * rms_norm(f, gains[3]), None

    y_hy_c = hyena_mixer(pc, *hy_args)
    mix_c = jnp.concatenate([y_ssd_c, y_na_c, y_hy_c], axis=-1) @ lp["w_out"]
    ctx = ctx + g1c * rms_norm(mix_c, gains[1])
    h2c = rms_norm(ctx, gains[2]) * (1.0 + sc2c) + sh2c
    lc = ctx.shape[1]
    f = moe_ffn(jnp.concatenate([h2.reshape(b * l, d), h2c.reshape(b * lc, d)], axis=0), *moe_args)
    x = x + g2 * rms_norm(f[:b * l].reshape(b, l, d), gains[3])
    ctx = ctx + g2c * rms_norm(f[b * l:].reshape(b, lc, d), gains[3])
    return x, ctx


def setup_inputs(seed: int = 0) -> dict:
    key = jax.random.key(seed)
    ks = jax.random.split(key, 32)

    def nrm(i, shape, scale):
        return jax.random.normal(ks[i], shape, F32) * scale

    x = nrm(0, (BATCH, SEQ, D_MODEL), 1.0)
    c = nrm(1, (BATCH, D_MODEL), 1.0)
    ctx = nrm(2, (BATCH, CTX_LEN, D_MODEL), 1.0)
    c_ctx = nrm(3, (D_MODEL,), 1.0)
    w_mod = nrm(4, (DEPTH, D_MODEL, 6 * D_MODEL), 0.5 * D_MODEL ** -0.5)
    b_mod = nrm(5, (DEPTH, 6 * D_MODEL), 0.02)
    norm_g = 1.0 + nrm(6, (DEPTH, 4, D_MODEL), 0.05)
    w_in = nrm(7, (DEPTH, D_MODEL, IN_COLS), D_MODEL ** -0.5)
    ssd_conv_w = nrm(8, (DEPTH, SSD_CONV, SSD_XBC), SSD_CONV ** -0.5)
    ssd_conv_b = nrm(9, (DEPTH, SSD_XBC), 0.01)
    ssd_a_log = jnp.log(jax.random.uniform(ks[10], (DEPTH, 2, SSD_HEADS), F32, 1.0, 16.0))
    dt0 = jnp.exp(jax.random.uniform(ks[11], (DEPTH, 2, SSD_HEADS), F32, math.log(1e-3), math.log(1e-1)))
    ssd_dt_bias = dt0 + jnp.log(-jnp.expm1(-dt0))
    ssd_d = 1.0 + nrm(12, (DEPTH, SSD_HEADS), 0.1)
    ssd_norm_g = 1.0 + nrm(13, (DEPTH, SSD_WIDTH), 0.05)
    na_rpb = nrm(14, (DEPTH, 2 * NA_ROWS - 1, 2 * NA_COLS - 1, NA_HEADS), 0.1)
    hy_conv_w = nrm(15, (DEPTH, HY_SHORT, 3 * HY_WIDTH), HY_SHORT ** -0.5)
    hy_conv_b = nrm(16, (DEPTH, 3 * HY_WIDTH), 0.01)
    hy_f_w1 = nrm(17, (DEPTH, HY_EMB, HY_HIDDEN), HY_EMB ** -0.5)
    hy_f_b1 = nrm(18, (DEPTH, HY_HIDDEN), 0.1)
    hy_f_w2 = nrm(19, (DEPTH, HY_HIDDEN, HY_HIDDEN), HY_HIDDEN ** -0.5)
    hy_f_b2 = nrm(20, (DEPTH, HY_HIDDEN), 0.1)
    hy_f_w3 = nrm(21, (DEPTH, HY_HIDDEN, 2 * HY_WIDTH), HY_HIDDEN ** -0.5)
    hy_freq = 1.0 + nrm(22, (DEPTH, 2, HY_HIDDEN), 0.1)
    hy_d = nrm(23, (DEPTH, HY_WIDTH), 0.5)
    w_out = nrm(24, (DEPTH, D_MIX, D_MODEL), D_MIX ** -0.5)
    w_router = nrm(25, (DEPTH, D_MODEL, N_EXPERTS), D_MODEL ** -0.5)
    b_router = nrm(26, (DEPTH, N_EXPERTS), 0.01)
    w_gate_up = nrm(27, (DEPTH, N_EXPERTS, D_MODEL, 2 * D_EXPERT), D_MODEL ** -0.5)
    b_gate_up = nrm(28, (DEPTH, N_EXPERTS, 2 * D_EXPERT), 0.01)
    w_down = nrm(29, (DEPTH, N_EXPERTS, D_EXPERT, D_MODEL), D_EXPERT ** -0.5)
    b_down = nrm(30, (DEPTH, N_EXPERTS, D_MODEL), 0.01)
    return {"x": x, "c": c, "ctx": ctx, "c_ctx": c_ctx, "w_mod": w_mod, "b_mod": b_mod,
            "norm_g": norm_g, "w_in": w_in, "ssd_conv_w": ssd_conv_w, "ssd_conv_b": ssd_conv_b,
            "ssd_a_log": ssd_a_log, "ssd_dt_bias": ssd_dt_bias, "ssd_d": ssd_d, "ssd_norm_g": ssd_norm_g,
            "na_rpb": na_rpb, "hy_conv_w": hy_conv_w, "hy_conv_b": hy_conv_b, "hy_f_w1": hy_f_w1,
            "hy_f_b1": hy_f_b1, "hy_f_w2": hy_f_w2, "hy_f_b2": hy_f_b2, "hy_f_w3": hy_f_w3,
            "hy_freq": hy_freq, "hy_d": hy_d, "w_out": w_out, "w_router": w_router, "b_router": b_router,
            "w_gate_up": w_gate_up, "b_gate_up": b_gate_up, "w_down": w_down, "b_down": b_down}


def reference(x, c, ctx, c_ctx, w_mod, b_mod, norm_g, w_in, ssd_conv_w, ssd_conv_b, ssd_a_log,
              ssd_dt_bias, ssd_d, ssd_norm_g, na_rpb, hy_conv_w, hy_conv_b, hy_f_w1, hy_f_b1,
              hy_f_w2, hy_f_b2, hy_f_w3, hy_freq, hy_d, w_out, w_router, b_router, w_gate_up,
              b_gate_up, w_down, b_down):
    for i in range(DEPTH):
        lp = {"w_mod": w_mod[i], "b_mod": b_mod[i], "norm_g": norm_g[i], "w_in": w_in[i],
              "ssd_conv_w": ssd_conv_w[i], "ssd_conv_b": ssd_conv_b[i], "ssd_a_log": ssd_a_log[i],
              "ssd_dt_bias": ssd_dt_bias[i], "ssd_d": ssd_d[i], "ssd_norm_g": ssd_norm_g[i],
              "na_rpb": na_rpb[i], "hy_conv_w": hy_conv_w[i], "hy_conv_b": hy_conv_b[i],
              "hy_f_w1": hy_f_w1[i], "hy_f_b1": hy_f_b1[i], "hy_f_w2": hy_f_w2[i], "hy_f_b2": hy_f_b2[i],
              "hy_f_w3": hy_f_w3[i], "hy_freq": hy_freq[i], "hy_d": hy_d[i], "w_out": w_out[i],
              "w_router": w_router[i], "b_router": b_router[i], "w_gate_up": w_gate_up[i],
              "b_gate_up": b_gate_up[i], "w_down": w_down[i], "b_down": b_down[i]}
        x, ctx = trunk_layer(x, ctx, c, c_ctx, lp, i == DEPTH - 1)
    return x
```

```cpp
#include <hip/hip_runtime.h>
#include <cstdio>
#include <cstdint>

#define LAS __attribute__((address_space(3)))
typedef unsigned short bf16_t;
typedef short bf16x8 __attribute__((ext_vector_type(8)));
typedef float f32x4 __attribute__((ext_vector_type(4)));
typedef unsigned u32x4 __attribute__((ext_vector_type(4)));
typedef unsigned u32x2 __attribute__((ext_vector_type(2)));

#ifndef N_LAUNCH_MODE
#define N_LAUNCH_MODE 0
#endif

constexpr int D = 1024, L = 16384, LC = 256, T = L + LC, NCH = T / 128;
constexpr int PC = 3328;
constexpr int CZ = 0, CXBC = 384, CQ = 1280, CK = 1664, CV = 2048, CHY = 2432, CDT = 3200;
constexpr int NE = 32;
constexpr int MAXT = 292;
constexpr int MAXROWS = MAXT * 256;
constexpr int NTHREADS = 512;
constexpr int LDS_BYTES = 160 * 1024;
constexpr float RMS_EPS = 1e-6f;

enum { I_X = 0, I_C, I_CTX, I_CCTX, I_WMOD, I_BMOD, I_NORMG, I_WIN, I_SCW, I_SCB, I_ALOG, I_DTB, I_SSDD, I_SSDNG, I_RPB, I_HCW, I_HCB,
       I_FW1, I_FB1, I_FW2, I_FB2, I_FW3, I_FREQ, I_HYD, I_WOUT, I_WR, I_BR, I_WGU, I_BGU, I_WDN, I_BDN, N_IN };

constexpr size_t al256(size_t x) { return (x + 255) & ~(size_t)255; }
constexpr size_t WS_CTL   = 0;
constexpr size_t CTL_BYTES = 64 * 1024;
constexpr size_t WS_WINT  = WS_CTL + CTL_BYTES;
constexpr size_t WS_WOUTT = WS_WINT + al256((size_t)2 * PC * D * 2);
constexpr size_t WS_WGUT  = WS_WOUTT + al256((size_t)2 * D * D * 2);
constexpr size_t WS_WDT   = WS_WGUT + al256((size_t)2 * NE * 2048 * D * 2);
constexpr size_t WS_MODP  = WS_WDT + al256((size_t)2 * NE * D * D * 2);
constexpr size_t WS_KCOMB = WS_MODP + al256((size_t)2 * 2 * 16 * 6144 * 4);
constexpr size_t WS_KCOMBC= WS_KCOMB + al256((size_t)2 * 2 * L * 256 * 4);
constexpr size_t WS_FPART = WS_KCOMBC + al256((size_t)2 * LC * 256 * 4);
constexpr size_t WS_FPARTC= WS_FPART + al256((size_t)2 * 1024 * 512 * 4);
constexpr size_t WS_FSUM  = WS_FPARTC + al256((size_t)16 * 512 * 4);
constexpr size_t WS_HB    = WS_FSUM + al256((size_t)3 * 256 * 4);
constexpr size_t WS_P     = WS_HB + al256((size_t)T * D * 2);
constexpr size_t WS_XBC   = WS_P + al256((size_t)T * PC * 2);
constexpr size_t WS_DTV   = WS_XBC + al256((size_t)T * 896 * 2);
constexpr size_t WS_ACS   = WS_DTV + al256((size_t)T * 12 * 4);
constexpr size_t WS_ALAST = WS_ACS + al256((size_t)T * 12 * 4);
constexpr size_t WS_STATES= WS_ALAST + al256((size_t)NCH * 12 * 4);
constexpr size_t WS_SSTART= WS_STATES + al256((size_t)2 * NCH * 6 * 128 * 64 * 4);
constexpr size_t WS_U     = WS_SSTART + al256((size_t)2 * NCH * 6 * 128 * 64 * 4);
constexpr size_t WS_MIX   = WS_U + al256((size_t)T * 256 * 4);
constexpr size_t WS_MIXO  = WS_MIX + al256((size_t)T * D * 2);
constexpr size_t WS_XCUR  = WS_MIXO + al256((size_t)T * D * 4);
constexpr size_t WS_H2    = WS_XCUR + al256((size_t)T * D * 4);
constexpr size_t WS_RE    = WS_H2 + al256((size_t)T * D * 2);
constexpr size_t WS_RP    = WS_RE + al256((size_t)T * 4 * 4);
constexpr size_t WS_RW    = WS_RP + al256((size_t)T * 4 * 4);
constexpr size_t WS_SLOT  = WS_RW + al256((size_t)T * 4 * 4);
constexpr size_t WS_XG    = WS_SLOT + al256((size_t)T * 4 * 4);
constexpr size_t WS_HMID  = WS_XG + al256((size_t)MAXROWS * D * 2);
constexpr size_t WS_Y     = WS_HMID + al256((size_t)MAXROWS * D * 2);
constexpr size_t WS_END   = WS_Y + al256((size_t)MAXROWS * D * 2);

constexpr int CW_BAR = 0;
constexpr int CW_CNT = 4096;
constexpr int CW_NT = 4200;
constexpr int CW_TILE = 4224;

__device__ __forceinline__ float bf2f(unsigned short b) { return __uint_as_float(((unsigned)b) << 16); }
__device__ __forceinline__ unsigned short f2bf(float f) { unsigned u = __float_as_uint(f); u += 0x7FFFu + ((u >> 16) & 1u); return (unsigned short)(u >> 16); }
__device__ __forceinline__ unsigned pk_bf16(float lo, float hi) { return (unsigned)f2bf(lo) | ((unsigned)f2bf(hi) << 16); }
__device__ __forceinline__ float bflo(unsigned w) { return __uint_as_float(w << 16); }
__device__ __forceinline__ float bfhi(unsigned w) { return __uint_as_float(w & 0xFFFF0000u); }
__device__ __forceinline__ float silu_f(float x) { return x / (1.0f + __expf(-x)); }
__device__ __forceinline__ float softplus_f(float x) { return x > 20.f ? x : log1pf(__expf(x)); }
__device__ __forceinline__ float wave_sum(float v) {
#pragma unroll
    for (int o = 32; o >= 1; o >>= 1) v += __shfl_xor(v, o);
    return v;
}
__device__ __forceinline__ void lds_fence() { asm volatile("s_waitcnt lgkmcnt(0)" ::: "memory"); }

#define XB_TMO      128
#define XB_XCNT(j)  (256  + 64 * (j))
#define XB_XSUB(j)  (1280 + 64 * (j))
#define XB_XGEN(j)  (2304 + 64 * (j))
#define XB_TOP      3328
#define XB_TOPGEN   3392
#define XCD_BAR_WORDS 3456
#define XB_SPIN_CAP (1u << 18)
__device__ __forceinline__ unsigned xb_ld(unsigned* p)              { return __hip_atomic_load(p, __ATOMIC_RELAXED, __HIP_MEMORY_SCOPE_AGENT); }
__device__ __forceinline__ unsigned xb_add(unsigned* p, unsigned v) { return __hip_atomic_fetch_add(p, v, __ATOMIC_RELAXED, __HIP_MEMORY_SCOPE_AGENT); }
__device__ __forceinline__ unsigned xb_xcc_id() { return (unsigned)__builtin_amdgcn_s_getreg((3 << 11) | 20) & 0xFu; }
#define XB_SPIN(cond, bar) do { unsigned _sp = 0; while (cond) { __builtin_amdgcn_s_sleep(1); \
    if ((++_sp & 255u) == 0u) { if (xb_ld(&(bar)[XB_TMO])) break; if (_sp > XB_SPIN_CAP) { atomicAdd(&(bar)[XB_TMO], 1u); break; } } } } while (0)
struct XcdBarrier { unsigned* bar; unsigned x; volatile LAS unsigned* st; };
__device__ __forceinline__ XcdBarrier xcd_barrier_post(unsigned* bar, volatile LAS unsigned* st) {
    XcdBarrier b; b.bar = bar; b.x = xb_xcc_id(); b.st = st;
    if (threadIdx.x == 0) (void)xb_add(&bar[XB_XCNT(b.x)], 1u);
    return b;
}
__device__ __forceinline__ void xcd_barrier_complete(unsigned* bar, unsigned x, unsigned& nloc, unsigned& nx) {
    const unsigned G = gridDim.x * gridDim.y * gridDim.z;
    unsigned sum, cnt, mine, sp = 0u;
    for (;;) {
        sum = 0u; cnt = 0u; mine = 0u;
#pragma unroll
        for (unsigned j = 0; j < 16; ++j) { const unsigned c = xb_ld(&bar[XB_XCNT(j)]); sum += c; cnt += (c > 0u) ? 1u : 0u; mine = (j == x) ? c : mine; }
        if (sum == G) break;
        __builtin_amdgcn_s_sleep(1);
        if ((++sp & 255u) == 0u) { if (xb_ld(&bar[XB_TMO])) break; if (sp > XB_SPIN_CAP) { atomicAdd(&bar[XB_TMO], 1u); break; } }
    }
    nloc = mine > 0u ? mine : 1u; nx = cnt > 0u ? cnt : 1u;
}
__device__ __forceinline__ void xcd_barrier(const XcdBarrier& b) {
    asm volatile("s_waitcnt vmcnt(0)" ::: "memory");
    __syncthreads();
    if (threadIdx.x == 0) {
        unsigned* bar = b.bar;
        __builtin_amdgcn_s_waitcnt(0);
        unsigned nloc = b.st[0], nx = b.st[1];
        if (nloc == 0u) { xcd_barrier_complete(bar, b.x, nloc, nx); b.st[0] = nloc; b.st[1] = nx; }
        const unsigned old = xb_add(&bar[XB_XSUB(b.x)], 1u);
        const unsigned gen = old / nloc;
        if (old + 1u == (gen + 1u) * nloc) {
            __builtin_amdgcn_fence(__ATOMIC_RELEASE, "agent");
            asm volatile("s_waitcnt vmcnt(0)" ::: "memory");
            const unsigned og = xb_add(&bar[XB_TOP], 1u);
            const unsigned tg = og / nx;
            if (og + 1u == (tg + 1u) * nx) xb_add(&bar[XB_TOPGEN], 1u);
            else XB_SPIN(xb_ld(&bar[XB_TOPGEN]) == tg, bar);
            __builtin_amdgcn_fence(__ATOMIC_ACQUIRE, "agent");
            xb_add(&bar[XB_XGEN(b.x)], 1u);
            asm volatile("s_waitcnt vmcnt(0)" ::: "memory");
        } else {
            XB_SPIN(xb_ld(&bar[XB_XGEN(b.x)]) == gen, bar);
            __builtin_amdgcn_fence(__ATOMIC_ACQUIRE, "agent");
            asm volatile("s_waitcnt vmcnt(0)" ::: "memory");
        }
    }
    __syncthreads();
}

namespace pg8 {
constexpr int BM = 256, BK = 64, HALF = 128, HTB = HALF * BK * 2, STAGE_BYTES = 8 * HTB;
__host__ __device__ __forceinline__ int lds_byte(int r, int c) { const int st = (r >> 4) * 2 + (c >> 5), rr = r & 15, cc = c & 31, ob = rr * 64 + cc * 2; return st * 1024 + (ob ^ (((ob >> 9) & 1) << 5)); }
__host__ __device__ __forceinline__ void stage_rc(int b, int& R, int& C) { const int st = b / 1024, sb = b % 1024, swz = sb ^ (((sb >> 9) & 1) << 5); R = (st >> 1) * 16 + swz / 64; C = (st & 1) * 32 + (swz % 64) / 2; }
__host__ __device__ __forceinline__ int perm32(int rho) { const int n = rho >> 4, i = rho & 15; return 8 * (i >> 2) + 4 * n + (i & 3); }

struct Unit { int pa, pb, pn, e; };
struct Gemm { const bf16_t* A; const bf16_t* Bt; int K; };

template <class Epi, class Sched, bool ALIGN_EPI = true>
__device__ __forceinline__ void gemm_phase(LAS unsigned char* lds, const Gemm g, const Sched& S, const Epi& E, const int tid) {
    const int wid = __builtin_amdgcn_readfirstlane(tid >> 6), lane = tid & 63, wr = wid >> 2, wc = wid & 3, fr = lane & 15, fq = lane >> 4;
    const int K = g.K, nt = K / BK;
    unsigned voffA[2], voffB[2];
#pragma unroll
    for (int i = 0; i < 2; ++i) { int R, C; stage_rc(tid * 16 + i * 8192, R, C); const int Rb = Epi::PERM ? ((R & ~31) + perm32(R & 31)) : R;
        voffA[i] = (unsigned)(R * K + C) * 2u; voffB[i] = (unsigned)(Rb * K + C) * 2u; }
    const size_t kstep = (size_t)(BK * 2);
    const size_t hstep = (size_t)HALF * K * 2;
    const size_t tstep = 2 * hstep;
    const unsigned ldsw = (unsigned)wid * 1024u;
    const int aoff = lds_byte(wr * 64 + fr, fq * 8), boff = lds_byte(wc * 32 + fr, fq * 8);
#define PG8_SA(b, h) (((b) * 2 + (h)) * HTB)
#define PG8_SB(b, h) ((4 + (b) * 2 + (h)) * HTB)
#define PG8_STAGE(bufoff, gbase, voff) do { _Pragma("unroll") for (int _i = 0; _i < 2; ++_i) \
        __builtin_amdgcn_global_load_lds((const unsigned*)((const char*)(gbase) + (voff)[_i]), (LAS unsigned*)(lds + (bufoff) + ldsw + _i * 8192), 16, 0, 0); } while (0)
#define PG8_LDA(dst, b, h) do { _Pragma("unroll") for (int m = 0; m < 4; ++m) _Pragma("unroll") for (int k = 0; k < 2; ++k) dst[m][k] = *(const LAS bf16x8*)(lds + PG8_SA(b, h) + aoff + m * 2048 + k * 1024); } while (0)
#define PG8_LDB(dst, b, h) do { _Pragma("unroll") for (int n = 0; n < 2; ++n) _Pragma("unroll") for (int k = 0; k < 2; ++k) dst[n][k] = *(const LAS bf16x8*)(lds + PG8_SB(b, h) + boff + n * 2048 + k * 1024); } while (0)
#define PG8_MMA(ai, bj, At, Bt) do { __builtin_amdgcn_s_setprio(1); _Pragma("unroll") for (int m = 0; m < 4; ++m) _Pragma("unroll") for (int n = 0; n < 2; ++n) _Pragma("unroll") for (int k = 0; k < 2; ++k) \
        acc[ai][bj][m][n] = __builtin_amdgcn_mfma_f32_16x16x32_bf16(Bt[n][k], At[m][k], acc[ai][bj][m][n], 0, 0, 0); __builtin_amdgcn_s_setprio(0); } while (0)
#define PG8_WAIT_V(n) asm volatile("s_waitcnt vmcnt(" #n ")" ::: "memory")
#define PG8_WAIT_L(n) asm volatile("s_waitcnt lgkmcnt(" #n ")" ::: "memory")
#define PG8_BAR __builtin_amdgcn_s_barrier()
#define PG8_SCHED __builtin_amdgcn_sched_barrier(0)
    Unit cur, nxt; int ui = 0;
    if (!S.next(0, cur)) return;
    f32x4 acc[2][2][4][2];
#pragma unroll
    for (int a = 0; a < 2; ++a)
#pragma unroll
        for (int b = 0; b < 2; ++b)
#pragma unroll
            for (int m = 0; m < 4; ++m)
#pragma unroll
                for (int n = 0; n < 2; ++n) acc[a][b][m][n] = (f32x4){0.f, 0.f, 0.f, 0.f};
    bf16x8 At[4][2], B0[2][2], B1[2][2];
    const char* cA = (const char*)g.A + (size_t)cur.pa * tstep; const char* cB = (const char*)g.Bt + (size_t)cur.pb * tstep;
    PG8_STAGE(PG8_SB(0, 0), cB, voffB); PG8_STAGE(PG8_SB(0, 1), cB + hstep, voffB); PG8_STAGE(PG8_SA(0, 0), cA, voffA); PG8_STAGE(PG8_SA(0, 1), cA + hstep, voffA);
    if (wr == 1) PG8_BAR;
    PG8_WAIT_V(2); PG8_BAR;
    PG8_STAGE(PG8_SB(1, 0), cB + kstep, voffB); PG8_STAGE(PG8_SA(1, 0), cA + kstep, voffA); PG8_STAGE(PG8_SB(1, 1), cB + hstep + kstep, voffB);
    PG8_WAIT_V(6); PG8_BAR;
    for (;;) {
        const bool has_next = S.next(ui + 1, nxt);
        const char* nA = has_next ? (const char*)g.A + (size_t)nxt.pa * tstep : cA; const char* nB = has_next ? (const char*)g.Bt + (size_t)nxt.pb * tstep : cB;
        for (int t = 0; t < nt; t += 2) {
            const bool last = (t == nt - 2);
            const char* a1 = cA + (size_t)(t + 1) * kstep;
            const char* a2 = last ? nA : cA + (size_t)(t + 2) * kstep; const char* b2 = last ? nB : cB + (size_t)(t + 2) * kstep;
            const char* a3 = a2 + kstep; const char* b3 = b2 + kstep;
            PG8_LDB(B0, 0, 0); PG8_LDB(B1, 0, 1); PG8_SCHED; PG8_LDA(At, 0, 0); PG8_STAGE(PG8_SA(1, 1), a1 + hstep, voffA);
            PG8_WAIT_V(8); PG8_WAIT_L(0); PG8_BAR; PG8_MMA(0, 0, At, B0); PG8_MMA(0, 1, At, B1); PG8_BAR; PG8_SCHED;
            PG8_LDA(At, 0, 1); PG8_STAGE(PG8_SB(0, 0), b2, voffB); PG8_STAGE(PG8_SB(0, 1), b2 + hstep, voffB); PG8_STAGE(PG8_SA(0, 0), a2, voffA);
            PG8_WAIT_V(8); PG8_WAIT_L(0); PG8_BAR; PG8_MMA(1, 0, At, B0); PG8_MMA(1, 1, At, B1); PG8_BAR; PG8_SCHED;
            PG8_LDB(B0, 1, 0); PG8_LDB(B1, 1, 1); PG8_SCHED; PG8_LDA(At, 1, 0); PG8_STAGE(PG8_SA(0, 1), a2 + hstep, voffA);
            PG8_WAIT_V(8); PG8_WAIT_L(0); PG8_BAR; PG8_MMA(0, 0, At, B0); PG8_MMA(0, 1, At, B1); PG8_BAR; PG8_SCHED;
            PG8_LDA(At, 1, 1); PG8_STAGE(PG8_SB(1, 0), b3, voffB); PG8_STAGE(PG8_SB(1, 1), b3 + hstep, voffB); PG8_STAGE(PG8_SA(1, 0), a3, voffA);
            PG8_WAIT_V(8); PG8_WAIT_L(0); PG8_BAR; PG8_MMA(1, 0, At, B0); PG8_MMA(1, 1, At, B1); PG8_BAR; PG8_SCHED;
        }
        if constexpr (ALIGN_EPI) { if (wr == 0) PG8_BAR; }
        E(acc, cur, wr, wc, fr, fq);
        if (!has_next) break;
#pragma unroll
        for (int a = 0; a < 2; ++a)
#pragma unroll
            for (int b = 0; b < 2; ++b)
#pragma unroll
                for (int m = 0; m < 4; ++m)
#pragma unroll
                    for (int n = 0; n < 2; ++n) acc[a][b][m][n] = (f32x4){0.f, 0.f, 0.f, 0.f};
        cur = nxt; cA = nA; cB = nB; ++ui;
        if constexpr (ALIGN_EPI) { if (wr == 1) PG8_BAR; }
    }
    PG8_WAIT_V(0);
    if constexpr (!ALIGN_EPI) { if (wr == 0) PG8_BAR; }
    PG8_BAR;
#undef PG8_SA
#undef PG8_SB
#undef PG8_STAGE
#undef PG8_LDA
#undef PG8_LDB
#undef PG8_MMA
#undef PG8_WAIT_V
#undef PG8_WAIT_L
#undef PG8_BAR
#undef PG8_SCHED
}

struct EpiF32 {
    static constexpr bool PERM = false;
    float* C; int ldc;
    __device__ __forceinline__ void operator()(const f32x4 (&acc)[2][2][4][2], const Unit& u, int wr, int wc, int fr, int fq) const {
        const int row0 = u.pa * BM + wr * 64 + fr, col0 = u.pn * BM + wc * 32 + 4 * fq;
#pragma unroll
        for (int ai = 0; ai < 2; ++ai)
#pragma unroll
            for (int m = 0; m < 4; ++m) { float* rowp = C + (size_t)(row0 + ai * HALF + m * 16) * ldc + col0;
#pragma unroll
                for (int bj = 0; bj < 2; ++bj)
#pragma unroll
                    for (int n = 0; n < 2; ++n) *(f32x4*)(rowp + bj * HALF + n * 16) = acc[ai][bj][m][n]; }
    }
};
struct EpiBf16 {
    static constexpr bool PERM = true;
    bf16_t* O; int ldc; const float* bias; int bias_stride;
    __device__ __forceinline__ void operator()(const f32x4 (&acc)[2][2][4][2], const Unit& u, int wr, int wc, int fr, int fq) const {
        const int row0 = u.pa * BM + wr * 64 + fr; const int col0 = u.pn * BM + wc * 32 + 8 * fq;
        f32x4 bv[2][2];
#pragma unroll
        for (int bj = 0; bj < 2; ++bj)
#pragma unroll
            for (int n = 0; n < 2; ++n) bv[bj][n] = bias ? *(const f32x4*)(bias + (size_t)u.e * bias_stride + col0 + bj * HALF + 4 * n) : (f32x4){0.f, 0.f, 0.f, 0.f};
#pragma unroll
        for (int ai = 0; ai < 2; ++ai)
#pragma unroll
            for (int m = 0; m < 4; ++m) { bf16_t* rowp = O + (size_t)(row0 + ai * HALF + m * 16) * ldc + col0;
#pragma unroll
                for (int bj = 0; bj < 2; ++bj) { const f32x4 v0 = acc[ai][bj][m][0] + bv[bj][0], v1 = acc[ai][bj][m][1] + bv[bj][1];
                    u32x4 w; w.x = pk_bf16(v0[0], v0[1]); w.y = pk_bf16(v0[2], v0[3]); w.z = pk_bf16(v1[0], v1[1]); w.w = pk_bf16(v1[2], v1[3]);
                    *(u32x4*)(rowp + bj * HALF) = w; } }
    }
};
struct EpiAct {
    static constexpr bool PERM = true;
    bf16_t* O; const float* bias;
    __device__ __forceinline__ void operator()(const f32x4 (&acc)[2][2][4][2], const Unit& u, int wr, int wc, int fr, int fq) const {
        const int row0 = u.pa * BM + wr * 64 + fr; const int cc0 = wc * 32 + 8 * fq; const int ocol = u.pn * 128 + cc0;
        const float* bg = bias + (size_t)u.e * 2048 + ocol; const float* bu = bg + 1024;
        f32x4 bgv[2], buv[2];
#pragma unroll
        for (int n = 0; n < 2; ++n) { bgv[n] = *(const f32x4*)(bg + 4 * n); buv[n] = *(const f32x4*)(bu + 4 * n); }
#pragma unroll
        for (int ai = 0; ai < 2; ++ai)
#pragma unroll
            for (int m = 0; m < 4; ++m) { bf16_t* rowp = O + (size_t)(row0 + ai * HALF + m * 16) * D + ocol;
                float r[8];
#pragma unroll
                for (int n = 0; n < 2; ++n)
#pragma unroll
                    for (int j = 0; j < 4; ++j) { float gt = acc[ai][0][m][n][j] + bgv[n][j], up = acc[ai][1][m][n][j] + buv[n][j];
                        gt = fminf(gt, 7.0f); up = fminf(fmaxf(up, -7.0f), 7.0f);
                        r[n * 4 + j] = gt / (1.0f + __expf(-1.702f * gt)) * (up + 1.0f); }
                u32x4 w; w.x = pk_bf16(r[0], r[1]); w.y = pk_bf16(r[2], r[3]); w.z = pk_bf16(r[4], r[5]); w.w = pk_bf16(r[6], r[7]);
                *(u32x4*)rowp = w; }
    }
};
struct SchedGrid {
    int nN, total, G, c;
    __device__ __forceinline__ bool next(int i, Unit& u) const { const int Lx = i * G + c; if (Lx >= total) return false; u.pa = Lx / nN; u.pn = Lx - u.pa * nN; u.pb = u.pn; u.e = 0; return true; }
};
struct SchedMoe {
    int nN, total, G, c; const int* tile_e;
    __device__ __forceinline__ bool next(int i, Unit& u) const { const int Lx = i * G + c; if (Lx >= total) return false; u.pa = Lx / nN; u.pn = Lx - u.pa * nN; u.e = __builtin_amdgcn_readfirstlane((int)tile_e[u.pa]); u.pb = u.e * nN + u.pn; return true; }
};
}

struct Args { const float* in[N_IN]; float* out; unsigned char* ws; int ph_lo, ph_hi; };

typedef const float* __attribute__((address_space(4))) const* kargp_t;
struct InProxy { kargp_t kp; __device__ __forceinline__ const float* operator[](int i) const { return kp[i]; } };
struct Frame {
    InProxy in; float* out; unsigned char* ws;
    LAS unsigned char* lds;
    int tid, lane, wave, G, bid;
    template <class Tp> __device__ __forceinline__ Tp* w(size_t off) const { return (Tp*)(ws + off); }
};

__device__ __forceinline__ Frame launder(const Frame& F) {
    Frame R = F;
    int t = F.tid; asm volatile("" : "+v"(t)); R.tid = t; R.lane = t & 63; R.wave = __builtin_amdgcn_readfirstlane(t >> 6);
    unsigned long long w = (unsigned long long)F.ws; asm volatile("" : "+s"(w)); R.ws = (unsigned char*)w;
    unsigned long long o = (unsigned long long)F.out; asm volatile("" : "+s"(o)); R.out = (float*)o;
    unsigned long long k = (unsigned long long)F.in.kp; asm volatile("" : "+s"(k)); R.in.kp = (kargp_t)k;
    int g = F.G, b = F.bid; asm volatile("" : "+s"(g), "+s"(b)); R.G = g; R.bid = b;
    return R;
}

__device__ __forceinline__ float mod_val(const Frame& F, int l, int which, int j) {
    const float* mp = F.w<float>(WS_MODP) + (size_t)((l * 2 + which) * 16) * 6144 + j;
    float s = F.in[I_BMOD][l * 6144 + j];
#pragma unroll
    for (int k = 0; k < 16; ++k) s += mp[(size_t)k * 6144];
    return s;
}

__device__ __forceinline__ void convert_tile(const float* __restrict__ src, int ld, int k0, int n0, int mode, bf16_t* __restrict__ dst, LAS unsigned* lw, int lane) {
    const int i4 = lane & 15, kpl = lane >> 4;
    const int n = n0 + 4 * i4;
    int sc; bool valid = true;
    if (mode == 0) sc = n;
    else if (mode == 1) { if (n < 1280) sc = n; else if (n < 3200) sc = n + 12; else if (n < 3212) sc = n - 3200 + 1280; else { sc = 0; valid = false; } }
    else { const int pn = n >> 8, rr = n & 255; sc = rr < 128 ? pn * 128 + rr : 1024 + pn * 128 + (rr - 128); }
#pragma unroll
    for (int it = 0; it < 8; ++it) {
        const int kp = kpl + 4 * it;
        f32x4 a = (f32x4){0.f, 0.f, 0.f, 0.f}, b = a;
        if (valid) { a = *(const f32x4*)(src + (size_t)(k0 + 2 * kp) * ld + sc); b = *(const f32x4*)(src + (size_t)(k0 + 2 * kp + 1) * ld + sc); }
#pragma unroll
        for (int i = 0; i < 4; ++i) lw[kp * 65 + 4 * i4 + i] = pk_bf16(a[i], b[i]);
    }
    lds_fence();
    const int g = lane & 7, nl = lane >> 3;
#pragma unroll
    for (int it = 0; it < 8; ++it) {
        const int nn = nl + 8 * it;
        u32x4 v; v.x = lw[(4 * g + 0) * 65 + nn]; v.y = lw[(4 * g + 1) * 65 + nn]; v.z = lw[(4 * g + 2) * 65 + nn]; v.w = lw[(4 * g + 3) * 65 + nn];
        *(u32x4*)(dst + (size_t)(n0 + nn) * 1024 + k0 + 8 * g) = v;
    }
    lds_fence();
}

__device__ __forceinline__ void ph_convert(const Frame& F) {
    LAS unsigned* lw = (LAS unsigned*)(F.lds) + F.wave * (32 * 65 + 16);
    const int nwaves = F.G * 8, w0 = F.bid * 8 + F.wave;
    for (int t = w0; t < 51328; t += nwaves) {
        const float* src; bf16_t* dst; int ld, mode, k0, n0;
        if (t < 1664) { const int l = t / 832, r = t % 832; n0 = (r / 16) * 64; k0 = (r % 16) * 64; src = F.in[I_WIN] + (size_t)l * 1024 * 3212; ld = 3212; mode = 1; dst = F.w<bf16_t>(WS_WINT) + (size_t)l * PC * D; }
        else if (t < 2176) { const int q = t - 1664, l = q / 256, r = q % 256; n0 = (r / 16) * 64; k0 = (r % 16) * 64; src = F.in[I_WOUT] + (size_t)l * D * D; ld = 1024; mode = 0; dst = F.w<bf16_t>(WS_WOUTT) + (size_t)l * D * D; }
        else if (t < 34944) { const int q = t - 2176, le = q / 512, r = q % 512; n0 = (r / 16) * 64; k0 = (r % 16) * 64; src = F.in[I_WGU] + (size_t)le * 1024 * 2048; ld = 2048; mode = 2; dst = F.w<bf16_t>(WS_WGUT) + (size_t)le * 2048 * D; }
        else { const int q = t - 34944, le = q / 256, r = q % 256; n0 = (r / 16) * 64; k0 = (r % 16) * 64; src = F.in[I_WDN] + (size_t)le * D * D; ld = 1024; mode = 0; dst = F.w<bf16_t>(WS_WDT) + (size_t)le * D * D; }
        convert_tile(src, ld, k0, n0, mode, dst, lw, F.lane);
    }
}

__device__ __forceinline__ void ph_modpart(const Frame& F) {
    for (int it = F.bid; it < 384; it += F.G) {
        const int l = it / 192, r = it % 192, cc = r / 16, kc = r % 16;
        const int j = cc * 512 + F.tid;
        const float* wm = F.in[I_WMOD] + (size_t)l * D * 6144 + j;
        float a0 = 0.f, a1 = 0.f;
        for (int k = kc * 64; k < kc * 64 + 64; ++k) {
            const float wv = wm[(size_t)k * 6144];
            a0 += silu_f(F.in[I_C][k]) * wv; a1 += silu_f(F.in[I_CCTX][k]) * wv;
        }
        float* mp = F.w<float>(WS_MODP);
        mp[(size_t)((l * 2 + 0) * 16 + kc) * 6144 + j] = a0;
        mp[(size_t)((l * 2 + 1) * 16 + kc) * 6144 + j] = a1;
    }
}

__device__ __forceinline__ void ph_filter(const Frame& F) {
    LAS float* zs = (LAS float*)F.lds;
    LAS float* h1 = zs + 16 * 33;
    LAS float* h2 = h1 + 16 * 64;
    const float min_decay = -4.605170185988091f / 1.5f, max_decay = -4.605170185988091f / 0.3f;
    for (int it = F.bid; it < 2048 + 16; it += F.G) {
        const bool isctx = it >= 2048;
        const int l = isctx ? 0 : it / 1024, grp = isctx ? it - 2048 : it % 1024;
        const int Lx = isctx ? LC : L;
        const int t0 = grp * 16;
        __syncthreads();
        for (int q = F.tid; q < 16 * 33; q += NTHREADS) {
            const int pos = q / 33, i = q % 33; const int t = t0 + pos;
            const float tn = (float)t / (float)(Lx - 1);
            const float wv = 6.283185307179586f * (float)t / (float)Lx;
            float v;
            if (i == 0) v = tn;
            else { const int b = (i - 1) & 15; const float f = 1e-4f + (float)b * ((15.0f - 1e-4f) / 15.0f); v = (i <= 16) ? cosf(f * wv) : -sinf(f * wv); }
            zs[q] = v;
        }
        __syncthreads();
        for (int q = F.tid; q < 16 * 64; q += NTHREADS) {
            const int pos = q >> 6, o = q & 63;
            float s = F.in[I_FB1][l * 64 + o];
            for (int i = 0; i < 33; ++i) s += zs[pos * 33 + i] * F.in[I_FW1][(size_t)l * 33 * 64 + i * 64 + o];
            h1[q] = sinf(F.in[I_FREQ][l * 128 + o] * s);
        }
        __syncthreads();
        for (int q = F.tid; q < 16 * 64; q += NTHREADS) {
            const int pos = q >> 6, o = q & 63;
            float s = F.in[I_FB2][l * 64 + o];
            for (int i = 0; i < 64; ++i) s += h1[pos * 64 + i] * F.in[I_FW2][(size_t)l * 64 * 64 + i * 64 + o];
            h2[q] = sinf(F.in[I_FREQ][l * 128 + 64 + o] * s);
        }
        __syncthreads();
        {
            const int o = F.tid, c = o & 255, dir = o >> 8;
            float acc[16];
#pragma unroll
            for (int p = 0; p < 16; ++p) acc[p] = 0.f;
            const float* w3 = F.in[I_FW3] + (size_t)l * 64 * 512 + o;
            for (int k = 0; k < 64; ++k) { const float wv = w3[k * 512];
#pragma unroll
                for (int p = 0; p < 16; ++p) acc[p] += h2[p * 64 + k] * wv; }
            const float delta = fabsf(min_decay + (float)c * ((max_decay - min_decay) / 255.0f));
            float* kc = isctx ? F.w<float>(WS_KCOMBC) : F.w<float>(WS_KCOMB) + (size_t)l * 2 * L * 256;
            float asum = 0.f;
#pragma unroll
            for (int p = 0; p < 16; ++p) {
                const int t = t0 + p; const float tn = (float)t / (float)(Lx - 1);
                const float v = acc[p] * __expf(-tn * delta);
                asum += fabsf(v);
                if (dir == 0) kc[(size_t)(Lx - 1 + t) * 256 + c] = v;
                else if (t >= 1) kc[(size_t)(Lx - 1 - t) * 256 + c] = v;
            }
            if (isctx) F.w<float>(WS_FPARTC)[grp * 512 + o] = asum;
            else F.w<float>(WS_FPART)[((size_t)l * 1024 + grp) * 512 + o] = asum;
        }
    }
}

__device__ __forceinline__ void ph_fsum(const Frame& F) {
    const int nwaves = F.G * 8;
    for (int o = F.bid * 8 + F.wave; o < 768; o += nwaves) {
        const int which = o >> 8, c = o & 255;
        float s = 0.f;
        if (which < 2) { const float* fp = F.w<float>(WS_FPART) + (size_t)which * 1024 * 512;
            for (int i = F.lane; i < 1024; i += 64) s += fp[(size_t)i * 512 + c] + fp[(size_t)i * 512 + 256 + c]; }
        else { const float* fp = F.w<float>(WS_FPARTC); if (F.lane < 16) s = fp[F.lane * 512 + c] + fp[F.lane * 512 + 256 + c]; }
        s = wave_sum(s);
        if (F.lane == 0) F.w<float>(WS_FSUM)[o] = 1.0f / s;
    }
}

__device__ __forceinline__ void load_row(const float* p, int lane, f32x4 (&v)[4]) {
#pragma unroll
    for (int i = 0; i < 4; ++i) v[i] = *(const f32x4*)(p + 4 * lane + 256 * i);
}
__device__ __forceinline__ float row_rstd(const f32x4 (&v)[4]) {
    float s = 0.f;
#pragma unroll
    for (int i = 0; i < 4; ++i) s += v[i][0] * v[i][0] + v[i][1] * v[i][1] + v[i][2] * v[i][2] + v[i][3] * v[i][3];
    s = wave_sum(s);
    return rsqrtf(s * (1.0f / 1024.0f) + RMS_EPS);
}
__device__ __forceinline__ void stage_norm_vecs(const Frame& F, int l, int gain_idx, int sh_seg, int sc_seg, LAS float* dst  ) {
    for (int q = F.tid; q < 2048; q += NTHREADS) {
        const int which = q >> 10, j = q & 1023;
        const float g = F.in[I_NORMG][(l * 4 + gain_idx) * 1024 + j];
        dst[(which * 2 + 0) * 1024 + j] = g * (1.0f + mod_val(F, l, which, sc_seg * 1024 + j));
        dst[(which * 2 + 1) * 1024 + j] = mod_val(F, l, which, sh_seg * 1024 + j);
    }
}
__device__ __forceinline__ void norm_store_bf16(const f32x4 (&v)[4], float rstd, const LAS float* va, const LAS float* vb, bf16_t* orow, int lane) {
#pragma unroll
    for (int i = 0; i < 4; ++i) {
        const int c = 4 * lane + 256 * i;
        const f32x4 a = *(const LAS f32x4*)(va + c), b = *(const LAS f32x4*)(vb + c);
        u32x2 w; w.x = pk_bf16(v[i][0] * rstd * a[0] + b[0], v[i][1] * rstd * a[1] + b[1]); w.y = pk_bf16(v[i][2] * rstd * a[2] + b[2], v[i][3] * rstd * a[3] + b[3]);
        *(u32x2*)(orow + c) = w;
    }
}
__device__ __forceinline__ const float* xrow_ptr(const Frame& F, int l, int row) {
    if (l == 0) return row < L ? F.in[I_X] + (size_t)row * D : F.in[I_CTX] + (size_t)(row - L) * D;
    return F.w<float>(WS_XCUR) + (size_t)row * D;
}
__device__ __forceinline__ void ph_norm1(const Frame& F, int l) {
    LAS float* vec = (LAS float*)F.lds;
    __syncthreads();
    stage_norm_vecs(F, l, 0, 0, 1, vec);
    __syncthreads();
    const int nwaves = F.G * 8;
    for (int row = F.bid * 8 + F.wave; row < T; row += nwaves) {
        const int which = row >= L;
        f32x4 v[4]; load_row(xrow_ptr(F, l, row), F.lane, v);
        const float rstd = row_rstd(v);
        norm_store_bf16(v, rstd, vec + (which * 2) * 1024, vec + (which * 2 + 1) * 1024, F.w<bf16_t>(WS_HB) + (size_t)row * D, F.lane);
    }
}

__device__ __forceinline__ void ph_ssd_prep(const Frame& F, int l) {
    LAS float* Bs  = (LAS float*)F.lds;
    LAS float* xw  = Bs + 128 * 128;
    LAS float* dts = xw + 2 * 128 * 64;
    LAS float* acs = dts + 256;
    LAS float* wj  = acs + 256;
    const bf16_t* P = F.w<bf16_t>(WS_P);
    const float* cw = F.in[I_SCW] + (size_t)l * 5 * 896; const float* cb = F.in[I_SCB] + (size_t)l * 896;
    for (int it = F.bid; it < NCH * 6; it += F.G) {
        const int ch = it / 6, h = it % 6, g = h / 3;
        const int row0 = ch * 128;
        const int seq_lo = ch < 128 ? 0 : L, seq_hi = ch < 128 ? L : T;
        __syncthreads();
        if (F.tid < 256) {
            const int dir = F.tid >> 7, j = F.tid & 127;
            const float raw = bf2f(P[(size_t)(row0 + j) * PC + CDT + dir * 6 + h]) + F.in[I_DTB][(l * 2 + dir) * 6 + h];
            const float dt = softplus_f(raw);
            dts[F.tid] = dt;
            F.w<float>(WS_DTV)[(size_t)(row0 + j) * 12 + dir * 6 + h] = dt;
        }
        __syncthreads();
        if (F.tid == 0 || F.tid == 64) {
            const int dir = F.tid >> 6; const float a = -__expf(F.in[I_ALOG][(l * 2 + dir) * 6 + h]);
            float s = 0.f;
            if (dir == 0) { for (int j = 0; j < 128; ++j) { s += dts[j] * a; acs[j] = s; } }
            else { for (int j = 127; j >= 0; --j) { s += dts[128 + j] * a; acs[128 + j] = s; } }
            F.w<float>(WS_ALAST)[ch * 12 + dir * 6 + h] = s;
        }
        __syncthreads();
        if (F.tid < 256) {
            const int dir = F.tid >> 7, j = F.tid & 127;
            const float alast = dir == 0 ? acs[127] : acs[128];
            F.w<float>(WS_ACS)[(size_t)(row0 + j) * 12 + dir * 6 + h] = acs[F.tid];
            wj[F.tid] = __expf(alast - acs[F.tid]) * dts[F.tid];
        }
        __syncthreads();
        const int nchan = (h % 3 == 0) ? 320 : 192;
        for (int q = F.tid; q < 128 * nchan; q += NTHREADS) {
            const int j = q / nchan, cq = q % nchan;
            const int chn = cq < 64 ? h * 64 + cq : (cq < 192 ? 384 + g * 128 + (cq - 64) : 640 + g * 128 + (cq - 192));
            float s = cb[chn];
#pragma unroll
            for (int k = 0; k < 5; ++k) { const int r = row0 + j + k - 2; if (r >= seq_lo && r < seq_hi) s += cw[k * 896 + chn] * bf2f(P[(size_t)r * PC + CXBC + chn]); }
            s = silu_f(s);
            if (cq < 64 || h % 3 == 0) F.w<bf16_t>(WS_XBC)[(size_t)(row0 + j) * 896 + chn] = f2bf(s);
            if (cq < 64) { xw[j * 64 + cq] = s * wj[j]; xw[(128 + j) * 64 + cq] = s * wj[128 + j]; }
            else if (cq < 192) Bs[j * 128 + (cq - 64)] = s;
        }
        __syncthreads();
        {
            const int n = F.tid & 127, pq = F.tid >> 7;
            float a0[16], a1[16];
#pragma unroll
            for (int p = 0; p < 16; ++p) { a0[p] = 0.f; a1[p] = 0.f; }
            for (int j = 0; j < 128; ++j) {
                const float b = Bs[j * 128 + n];
#pragma unroll
                for (int p4 = 0; p4 < 4; ++p4) {
                    const f32x4 x0 = *(const LAS f32x4*)(xw + j * 64 + pq * 16 + p4 * 4), x1 = *(const LAS f32x4*)(xw + (128 + j) * 64 + pq * 16 + p4 * 4);
#pragma unroll
                    for (int e = 0; e < 4; ++e) { a0[p4 * 4 + e] += b * x0[e]; a1[p4 * 4 + e] += b * x1[e]; }
                }
            }
            float* s0 = F.w<float>(WS_STATES) + ((size_t)(0 * NCH + ch) * 6 + h) * 8192 + n * 64 + pq * 16;
            float* s1 = F.w<float>(WS_STATES) + ((size_t)(1 * NCH + ch) * 6 + h) * 8192 + n * 64 + pq * 16;
#pragma unroll
            for (int p4 = 0; p4 < 4; ++p4) { *(f32x4*)(s0 + p4 * 4) = (f32x4){a0[p4 * 4], a0[p4 * 4 + 1], a0[p4 * 4 + 2], a0[p4 * 4 + 3]};
                                             *(f32x4*)(s1 + p4 * 4) = (f32x4){a1[p4 * 4], a1[p4 * 4 + 1], a1[p4 * 4 + 2], a1[p4 * 4 + 3]}; }
        }
    }
}

__device__ __forceinline__ void ph_ssd_scan(const Frame& F) {
    for (int blk = F.bid; blk < 192; blk += F.G) {
        const int id = blk * 512 + F.tid;
        const int dir = id / 49152, rem = id % 49152, h = rem / 8192, e = rem % 8192;
        const float* al = F.w<float>(WS_ALAST) + dir * 6 + h;
        float s = 0.f;
        for (int step = 0; step < NCH; ++step) {
            int ch;
            if (dir == 0) ch = step < 2 ? 128 + step : step - 2;
            else ch = step < 2 ? 129 - step : 129 - step;
            const size_t off = ((size_t)(dir * NCH + ch) * 6 + h) * 8192 + e;
            F.w<float>(WS_SSTART)[off] = s;
            s = s * __expf(al[ch * 12]) + F.w<float>(WS_STATES)[off];
        }
    }
}

__device__ __forceinline__ void ph_ssd_out(const Frame& F, int l) {
    LAS unsigned* Cs = (LAS unsigned*)F.lds;
    LAS unsigned* Bs = Cs + 128 * 65;
    LAS float* G  = (LAS float*)(Bs + 128 * 65);
    LAS float* af = G + 128 * 129;
    LAS float* ab = af + 384;
    LAS float* red = ab + 384;
    LAS float* xdt = (LAS float*)Bs;
    const bf16_t* XBC = F.w<bf16_t>(WS_XBC);
    const bf16_t* P = F.w<bf16_t>(WS_P);
    const int nch = (l == 0) ? NCH : 128;
    for (int it = F.bid; it < nch * 2; it += F.G) {
        const int ch = it >> 1, g = it & 1, row0 = ch * 128;
        __syncthreads();
        for (int q = F.tid; q < 128 * 64; q += NTHREADS) {
            const int j = q >> 6, n2 = q & 63;
            Bs[j * 65 + n2] = *(const unsigned*)(XBC + (size_t)(row0 + j) * 896 + 384 + g * 128 + 2 * n2);
            Cs[j * 65 + n2] = *(const unsigned*)(XBC + (size_t)(row0 + j) * 896 + 640 + g * 128 + 2 * n2);
        }
        for (int q = F.tid; q < 768; q += NTHREADS) {
            const int dir = q / 384, r = q % 384, hh = r >> 7, j = r & 127;
            (dir ? ab : af)[hh * 128 + j] = F.w<float>(WS_ACS)[(size_t)(row0 + j) * 12 + dir * 6 + g * 3 + hh];
        }
        __syncthreads();
        const int i = F.tid & 127, pq = __builtin_amdgcn_readfirstlane(F.tid >> 7);
        {
            float gacc[32];
#pragma unroll
            for (int jj = 0; jj < 32; ++jj) gacc[jj] = 0.f;
            for (int n2 = 0; n2 < 64; ++n2) {
                const unsigned cw_ = Cs[i * 65 + n2]; const float c0 = bflo(cw_), c1 = bfhi(cw_);
#pragma unroll
                for (int jj = 0; jj < 32; ++jj) { const unsigned bw = Bs[(pq * 32 + jj) * 65 + n2]; gacc[jj] += c0 * bflo(bw) + c1 * bfhi(bw); }
            }
#pragma unroll
            for (int jj = 0; jj < 32; ++jj) G[i * 129 + pq * 32 + jj] = gacc[jj];
        }
        __syncthreads();
        float yacc[3][16];
#pragma unroll
        for (int hh = 0; hh < 3; ++hh) {
            const int h = g * 3 + hh;
            LAS unsigned* xd = (LAS unsigned*)Bs;
            for (int q = F.tid; q < 128 * 32; q += NTHREADS) {
                const int j = q >> 5, p2 = q & 31;
                const unsigned xv = *(const unsigned*)(XBC + (size_t)(row0 + j) * 896 + h * 64 + 2 * p2);
                const float d0 = F.w<float>(WS_DTV)[(size_t)(row0 + j) * 12 + h], d1 = F.w<float>(WS_DTV)[(size_t)(row0 + j) * 12 + 6 + h];
                xd[j * 32 + p2] = pk_bf16(bflo(xv) * d0, bfhi(xv) * d0);
                xd[(128 + j) * 32 + p2] = pk_bf16(bflo(xv) * d1, bfhi(xv) * d1);
            }
            __syncthreads();
            float acc[16];
#pragma unroll
            for (int p = 0; p < 16; ++p) acc[p] = 0.f;
            const float afi = af[hh * 128 + i], abi = ab[hh * 128 + i];
            for (int j = 0; j < 128; ++j) {
                const float gij = G[i * 129 + j];
                const float wf = (j <= i) ? gij * __expf(afi - af[hh * 128 + j]) : 0.f;
                const float wb = (j >= i) ? gij * __expf(abi - ab[hh * 128 + j]) : 0.f;
#pragma unroll
                for (int p2 = 0; p2 < 8; ++p2) {
                    const unsigned xf = xd[j * 32 + pq * 8 + p2], xb = xd[(128 + j) * 32 + pq * 8 + p2];
                    acc[2 * p2] += wf * bflo(xf) + wb * bflo(xb); acc[2 * p2 + 1] += wf * bfhi(xf) + wb * bfhi(xb);
                }
            }
#pragma unroll
            for (int dir = 0; dir < 2; ++dir) {
                const float* S = F.w<float>(WS_SSTART) + ((size_t)(dir * NCH + ch) * 6 + h) * 8192 + pq * 16;
                float tacc[16];
#pragma unroll
                for (int p = 0; p < 16; ++p) tacc[p] = 0.f;
                for (int n2 = 0; n2 < 64; ++n2) {
                    const unsigned cw_ = Cs[i * 65 + n2]; const float c0 = bflo(cw_), c1 = bfhi(cw_);
#pragma unroll
                    for (int p4 = 0; p4 < 4; ++p4) {
                        const f32x4 s0 = *(const f32x4*)(S + (size_t)(2 * n2) * 64 + p4 * 4), s1 = *(const f32x4*)(S + (size_t)(2 * n2 + 1) * 64 + p4 * 4);
#pragma unroll
                        for (int e = 0; e < 4; ++e) tacc[p4 * 4 + e] += c0 * s0[e] + c1 * s1[e];
                    }
                }
                const float ei = __expf(dir == 0 ? afi : abi);
#pragma unroll
                for (int p = 0; p < 16; ++p) acc[p] += ei * tacc[p];
            }
#pragma unroll
            for (int p = 0; p < 16; ++p) yacc[hh][p] = acc[p];
            __syncthreads();
        }
        float ss = 0.f;
#pragma unroll
        for (int hh = 0; hh < 3; ++hh) {
            const int h = g * 3 + hh; const float dsk = F.in[I_SSDD][l * 6 + h];
#pragma unroll
            for (int p = 0; p < 16; ++p) {
                const int chn = h * 64 + pq * 16 + p;
                const float xs = bf2f(XBC[(size_t)(row0 + i) * 896 + chn]);
                const float z = bf2f(P[(size_t)(row0 + i) * PC + CZ + chn]);
                const float v = (yacc[hh][p] + dsk * xs) * silu_f(z);
                yacc[hh][p] = v; ss += v * v;
            }
        }
        red[pq * 128 + i] = ss;
        __syncthreads();
        const float tot = red[i] + red[128 + i] + red[256 + i] + red[384 + i];
        const float rstd = rsqrtf(tot * (1.0f / 192.0f) + RMS_EPS);
#pragma unroll
        for (int hh = 0; hh < 3; ++hh) {
            const int h = g * 3 + hh;
            bf16_t* o = F.w<bf16_t>(WS_MIX) + (size_t)(row0 + i) * D + h * 64 + pq * 16;
            const float* ng = F.in[I_SSDNG] + l * 384 + h * 64 + pq * 16;
            u32x4 w0, w1;
            w0.x = pk_bf16(yacc[hh][0] * rstd * ng[0], yacc[hh][1] * rstd * ng[1]); w0.y = pk_bf16(yacc[hh][2] * rstd * ng[2], yacc[hh][3] * rstd * ng[3]);
            w0.z = pk_bf16(yacc[hh][4] * rstd * ng[4], yacc[hh][5] * rstd * ng[5]); w0.w = pk_bf16(yacc[hh][6] * rstd * ng[6], yacc[hh][7] * rstd * ng[7]);
            w1.x = pk_bf16(yacc[hh][8] * rstd * ng[8], yacc[hh][9] * rstd * ng[9]); w1.y = pk_bf16(yacc[hh][10] * rstd * ng[10], yacc[hh][11] * rstd * ng[11]);
            w1.z = pk_bf16(yacc[hh][12] * rstd * ng[12], yacc[hh][13] * rstd * ng[13]); w1.w = pk_bf16(yacc[hh][14] * rstd * ng[14], yacc[hh][15] * rstd * ng[15]);
            *(u32x4*)o = w0; *(u32x4*)(o + 8) = w1;
        }
    }
    (void)xdt;
}

__device__ __forceinline__ void ph_na(const Frame& F, int l) {
    LAS unsigned* Kb = (LAS unsigned*)F.lds;
    LAS unsigned* Vl = Kb + 256 * 33;
    LAS unsigned* Vc = Vl + 256 * 32;
    LAS float* Pr = (LAS float*)(Vc + 256 * 32);
    LAS float* Qs = Pr + 16 * 512;
    const bf16_t* P = F.w<bf16_t>(WS_P);
    const float* rpb = F.in[I_RPB] + (size_t)l * 15 * 31 * 6;
    const int nlat = 256 * 6 * 4, nitems = nlat + (l == 0 ? 96 : 0);
    const float scale = 0.125f;
    for (int it = F.bid; it < nitems; it += F.G) {
        const bool isctx = it >= nlat;
        int r = 0, h, cg, r0 = 0, kc0 = 0, qrow0;
        if (!isctx) { r = it / 24; const int rem = it % 24; h = rem >> 2; cg = rem & 3; r0 = min(max(r - 4, 0), 248); kc0 = min(max(16 * cg - 8, 0), 32); qrow0 = r * 64 + cg * 16; }
        else { const int q = it - nlat; h = q >> 4; cg = q & 15; qrow0 = L + cg * 16; }
        __syncthreads();
        for (int q = F.tid; q < 16 * 32; q += NTHREADS) { const int qi = q >> 5, d2 = q & 31; const unsigned w = *(const unsigned*)(P + (size_t)(qrow0 + qi) * PC + CQ + h * 64 + 2 * d2); Qs[qi * 64 + 2 * d2] = bflo(w); Qs[qi * 64 + 2 * d2 + 1] = bfhi(w); }
        for (int q = F.tid; q < 256 * 32; q += NTHREADS) {
            const int key = q >> 5, d2 = q & 31;
            if (!isctx) { const int krow = (r0 + (key >> 5)) * 64 + kc0 + (key & 31);
                Kb[key * 33 + d2] = *(const unsigned*)(P + (size_t)krow * PC + CK + h * 64 + 2 * d2);
                Vl[key * 32 + d2] = *(const unsigned*)(P + (size_t)krow * PC + CV + h * 64 + 2 * d2); }
            Vc[key * 32 + d2] = *(const unsigned*)(P + (size_t)(L + key) * PC + CV + h * 64 + 2 * d2);
        }
        __syncthreads();
        const int qi = F.tid >> 5, sub = F.tid & 31;
        float sl[8], sc[8];
        const int qcol = cg * 16 + qi;
        const int cstart = min(max(qcol - 8, 0), 48);
        if (!isctx) {
#pragma unroll
            for (int k = 0; k < 8; ++k) {
                const int key = sub + 32 * k;
                float s = 0.f;
                for (int d2 = 0; d2 < 32; ++d2) { const unsigned w = Kb[key * 33 + d2]; s += Qs[qi * 64 + 2 * d2] * bflo(w) + Qs[qi * 64 + 2 * d2 + 1] * bfhi(w); }
                const int kcol = kc0 + sub;
                const bool ok = (kcol >= cstart) && (kcol < cstart + 16);
                const int dr = r0 + k - r + 7, dc = min(max(kcol - qcol + 15, 0), 30);
                sl[k] = ok ? s * scale + rpb[(dr * 31 + dc) * 6 + h] : -INFINITY;
            }
        } else {
#pragma unroll
            for (int k = 0; k < 8; ++k) sl[k] = -INFINITY;
        }
        __syncthreads();
        for (int q = F.tid; q < 256 * 32; q += NTHREADS) { const int key = q >> 5, d2 = q & 31; Kb[key * 33 + d2] = *(const unsigned*)(P + (size_t)(L + key) * PC + CK + h * 64 + 2 * d2); }
        __syncthreads();
#pragma unroll
        for (int k = 0; k < 8; ++k) {
            const int key = sub + 32 * k;
            float s = 0.f;
            for (int d2 = 0; d2 < 32; ++d2) { const unsigned w = Kb[key * 33 + d2]; s += Qs[qi * 64 + 2 * d2] * bflo(w) + Qs[qi * 64 + 2 * d2 + 1] * bfhi(w); }
            sc[k] = s * scale;
        }
        float mx = -INFINITY;
#pragma unroll
        for (int k = 0; k < 8; ++k) mx = fmaxf(mx, fmaxf(sl[k], sc[k]));
#pragma unroll
        for (int o = 16; o >= 1; o >>= 1) mx = fmaxf(mx, __shfl_xor(mx, o));
        float sum = 0.f;
#pragma unroll
        for (int k = 0; k < 8; ++k) { sl[k] = __expf(sl[k] - mx); sc[k] = __expf(sc[k] - mx); sum += sl[k] + sc[k]; }
#pragma unroll
        for (int o = 16; o >= 1; o >>= 1) sum += __shfl_xor(sum, o);
        const float inv = 1.0f / sum;
#pragma unroll
        for (int k = 0; k < 8; ++k) { Pr[qi * 512 + sub + 32 * k] = sl[k] * inv; Pr[qi * 512 + 256 + sub + 32 * k] = sc[k] * inv; }
        __syncthreads();
        float o0 = 0.f, o1 = 0.f;
        if (!isctx) for (int key = 0; key < 256; ++key) { const float p = Pr[qi * 512 + key]; const unsigned w = Vl[key * 32 + sub]; o0 += p * bflo(w); o1 += p * bfhi(w); }
        for (int key = 0; key < 256; ++key) { const float p = Pr[qi * 512 + 256 + key]; const unsigned w = Vc[key * 32 + sub]; o0 += p * bflo(w); o1 += p * bfhi(w); }
        *(unsigned*)(F.w<bf16_t>(WS_MIX) + (size_t)(qrow0 + qi) * D + 384 + h * 64 + 2 * sub) = pk_bf16(o0, o1);
    }
}

__device__ __forceinline__ float hy_conv3(const bf16_t* P, const float* cw, const float* cb, int row, int seq_lo, int seq_hi, int col) {
    float s = cb[col];
#pragma unroll
    for (int k = 0; k < 3; ++k) { const int r = row + k - 1; if (r >= seq_lo && r < seq_hi) s += cw[k * 768 + col] * bf2f(P[(size_t)r * PC + CHY + col]); }
    return s;
}
__device__ __forceinline__ void ph_hy_prep(const Frame& F, int l) {
    const bf16_t* P = F.w<bf16_t>(WS_P);
    const float* cw = F.in[I_HCW] + (size_t)l * 3 * 768; const float* cb = F.in[I_HCB] + (size_t)l * 768;
    const int nrows = (l == 0) ? T : L;
    for (int rp = F.bid; rp < nrows / 2; rp += F.G) {
        const int row = rp * 2 + (F.tid >> 8), c = F.tid & 255;
        const int seq_lo = row < L ? 0 : L, seq_hi = row < L ? L : T;
        const float x1 = hy_conv3(P, cw, cb, row, seq_lo, seq_hi, 256 + c), v = hy_conv3(P, cw, cb, row, seq_lo, seq_hi, 512 + c);
        F.w<float>(WS_U)[(size_t)row * 256 + c] = v * x1;
    }
}
__device__ __forceinline__ void ph_hy_conv(const Frame& F, int l) {
    const bf16_t* P = F.w<bf16_t>(WS_P);
    const float* cw = F.in[I_HCW] + (size_t)l * 3 * 768; const float* cb = F.in[I_HCB] + (size_t)l * 768;
    const int nitems = 512 + (l == 0 ? 8 : 0);
    for (int it = F.bid; it < nitems; it += F.G) {
        const bool isctx = it >= 512;
        const int Lx = isctx ? LC : L, rbase = isctx ? L : 0;
        const int tb = (isctx ? it - 512 : it) * 2 + (F.tid >> 8), c = F.tid & 255, t0 = tb * 16;
        const float* U = F.w<float>(WS_U) + (size_t)rbase * 256 + c;
        const float* KC = (isctx ? F.w<float>(WS_KCOMBC) : F.w<float>(WS_KCOMB) + (size_t)l * 2 * L * 256) + c;
        float acc[16], wreg[16];
#pragma unroll
        for (int j = 0; j < 16; ++j) { acc[j] = 0.f; wreg[j] = KC[(size_t)(t0 + j + Lx - 1) * 256]; }
        for (int s0 = 0; s0 < Lx; s0 += 16) {
            float ub[16], nb[16];
#pragma unroll
            for (int r = 0; r < 16; ++r) { ub[r] = U[(size_t)(s0 + r) * 256]; const int x = t0 - (s0 + r + 1) + Lx - 1; nb[r] = x >= 0 ? KC[(size_t)x * 256] : 0.f; }
#pragma unroll
            for (int r = 0; r < 16; ++r) {
#pragma unroll
                for (int j = 0; j < 16; ++j) acc[j] += ub[r] * wreg[(j - r) & 15];
                wreg[(15 - r) & 15] = nb[r];
            }
        }
        const float inv = F.w<float>(WS_FSUM)[(isctx ? 2 : l) * 256 + c];
        const float db = F.in[I_HYD][l * 256 + c];
#pragma unroll
        for (int j = 0; j < 16; ++j) {
            const int row = rbase + t0 + j;
            const int seq_lo = isctx ? L : 0, seq_hi = isctx ? T : L;
            const float x0 = hy_conv3(P, cw, cb, row, seq_lo, seq_hi, c);
            const float u = F.w<float>(WS_U)[(size_t)row * 256 + c];
            F.w<bf16_t>(WS_MIX)[(size_t)row * D + 768 + c] = f2bf(x0 * (acc[j] * inv + u * db));
        }
    }
}

__device__ __forceinline__ void ph_post1(const Frame& F, int l) {
    LAS float* wr = (LAS float*)F.lds;
    LAS float* vec = wr + 32 * 1024;
    __syncthreads();
    for (int q = F.tid; q < 32 * 1024; q += NTHREADS) { const int k = q >> 5, e = q & 31; wr[e * 1024 + k] = F.in[I_WR][(size_t)l * 1024 * 32 + q]; }
    for (int q = F.tid; q < 2048; q += NTHREADS) {
        const int which = q >> 10, j = q & 1023;
        vec[(which * 3 + 0) * 1024 + j] = F.in[I_NORMG][(l * 4 + 1) * 1024 + j] * mod_val(F, l, which, 2 * 1024 + j);
        vec[(which * 3 + 1) * 1024 + j] = F.in[I_NORMG][(l * 4 + 2) * 1024 + j] * (1.0f + mod_val(F, l, which, 4 * 1024 + j));
        vec[(which * 3 + 2) * 1024 + j] = mod_val(F, l, which, 3 * 1024 + j);
    }
    __syncthreads();
    const int nrows = (l == 0) ? T : L;
    const int nwaves = F.G * 8;
    unsigned* cnt = F.w<unsigned>(WS_CTL) + CW_CNT + l * 32;
    for (int row = F.bid * 8 + F.wave; row < nrows; row += nwaves) {
        const int which = row >= L;
        const LAS float* v0 = vec + (which * 3) * 1024;
        f32x4 m[4], x[4];
        load_row(F.w<float>(WS_MIXO) + (size_t)row * D, F.lane, m);
        load_row(xrow_ptr(F, l, row), F.lane, x);
        const float rs1 = row_rstd(m);
#pragma unroll
        for (int i = 0; i < 4; ++i) { const f32x4 a = *(const LAS f32x4*)(v0 + 4 * F.lane + 256 * i); x[i] = x[i] + m[i] * rs1 * a; }
        float* xo = F.w<float>(WS_XCUR) + (size_t)row * D;
#pragma unroll
        for (int i = 0; i < 4; ++i) *(f32x4*)(xo + 4 * F.lane + 256 * i) = x[i];
        const float rs2 = row_rstd(x);
        f32x4 hv[4];
#pragma unroll
        for (int i = 0; i < 4; ++i) { const f32x4 a = *(const LAS f32x4*)(v0 + 1024 + 4 * F.lane + 256 * i), b = *(const LAS f32x4*)(v0 + 2048 + 4 * F.lane + 256 * i); hv[i] = x[i] * rs2 * a + b; }
        bf16_t* ho = F.w<bf16_t>(WS_H2) + (size_t)row * D;
#pragma unroll
        for (int i = 0; i < 4; ++i) { u32x2 w; w.x = pk_bf16(hv[i][0], hv[i][1]); w.y = pk_bf16(hv[i][2], hv[i][3]); *(u32x2*)(ho + 4 * F.lane + 256 * i) = w; }
        float mylogit = 0.f;
        for (int e = 0; e < 32; ++e) {
            float s = 0.f;
#pragma unroll
            for (int i = 0; i < 4; ++i) { const f32x4 w = *(const LAS f32x4*)(wr + e * 1024 + 4 * F.lane + 256 * i); s += hv[i][0] * w[0] + hv[i][1] * w[1] + hv[i][2] * w[2] + hv[i][3] * w[3]; }
            s = wave_sum(s);
            if (F.lane == e) mylogit = s + F.in[I_BR][l * 32 + e];
        }
        float cand = F.lane < 32 ? mylogit : -INFINITY;
        float tv[4]; int ti[4];
#pragma unroll
        for (int k = 0; k < 4; ++k) {
            float bv = cand; int bi = F.lane;
#pragma unroll
            for (int o = 32; o >= 1; o >>= 1) { const float ov = __shfl_xor(bv, o); const int oi = __shfl_xor(bi, o); if (ov > bv || (ov == bv && oi < bi)) { bv = ov; bi = oi; } }
            tv[k] = bv; ti[k] = bi;
            if (F.lane == bi) cand = -INFINITY;
        }
        const float e1 = __expf(tv[1] - tv[0]), e2 = __expf(tv[2] - tv[0]), e3 = __expf(tv[3] - tv[0]);
        const float inv = 1.0f / (1.0f + e1 + e2 + e3);
        if (F.lane < 4) {
            const int k = F.lane;
            const int e = k == 0 ? ti[0] : (k == 1 ? ti[1] : (k == 2 ? ti[2] : ti[3]));
            const float wgt = (k == 0 ? 1.0f : (k == 1 ? e1 : (k == 2 ? e2 : e3))) * inv;
            const unsigned pos = atomicAdd(cnt + e, 1u);
            F.w<int>(WS_RE)[row * 4 + k] = e; F.w<int>(WS_RP)[row * 4 + k] = (int)pos; F.w<float>(WS_RW)[row * 4 + k] = wgt;
        }
    }
}

__device__ __forceinline__ int expert_pad_start(const Frame& F, int l, int& ntiles) {
    const unsigned* cnt = F.w<unsigned>(WS_CTL) + CW_CNT + l * 32;
    int c = F.lane < 32 ? (int)__hip_atomic_load(cnt + F.lane, __ATOMIC_RELAXED, __HIP_MEMORY_SCOPE_AGENT) : 0;
    int padded = (c + 255) & ~255;
    int incl = padded;
#pragma unroll
    for (int o = 1; o < 32; o <<= 1) { const int v = __shfl_up(incl, o); if ((F.lane & 31) >= o) incl += v; }
    ntiles = __shfl(incl, 31) >> 8;
    return incl - padded;
}

__device__ __forceinline__ void ph_gather(const Frame& F, int l) {
    int ntiles; const int ps = expert_pad_start(F, l, ntiles);
    if (F.bid == 0 && F.wave == 0) {
        int* tab = F.w<int>(WS_CTL) + CW_TILE + l * 320;
        const int nxt = __shfl_down(ps, 1);
        const int endt = (F.lane == 31) ? ntiles : (nxt >> 8);
        if (F.lane < 32) for (int t = ps >> 8; t < endt; ++t) tab[t] = F.lane;
        if (F.lane == 0) F.w<int>(WS_CTL)[CW_NT + l] = ntiles;
    }
    const int nrows = (l == 0) ? T : L;
    const int nwaves = F.G * 8;
    for (int a = F.bid * 8 + F.wave; a < nrows * 4; a += nwaves) {
        const int row = a >> 2;
        const int e = F.w<int>(WS_RE)[a], pos = F.w<int>(WS_RP)[a];
        const int dst = __shfl(ps, e) + pos;
        if (F.lane == 0) F.w<int>(WS_SLOT)[a] = dst;
        const u32x4* s = (const u32x4*)(F.w<bf16_t>(WS_H2) + (size_t)row * D);
        u32x4* d = (u32x4*)(F.w<bf16_t>(WS_XG) + (size_t)dst * D);
        d[F.lane] = s[F.lane]; d[F.lane + 64] = s[F.lane + 64];
    }
}

__device__ __forceinline__ void ph_final(const Frame& F, int l) {
    LAS float* vec = (LAS float*)F.lds;
    __syncthreads();
    for (int q = F.tid; q < 2048; q += NTHREADS) { const int which = q >> 10, j = q & 1023; vec[q] = F.in[I_NORMG][(l * 4 + 3) * 1024 + j] * mod_val(F, l, which, 5 * 1024 + j); }
    if (l == 0) stage_norm_vecs(F, 1, 0, 0, 1, vec + 2048);
    __syncthreads();
    const int nrows = (l == 0) ? T : L;
    const int nwaves = F.G * 8;
    const bf16_t* Y = F.w<bf16_t>(WS_Y);
    for (int row = F.bid * 8 + F.wave; row < nrows; row += nwaves) {
        const int which = row >= L;
        f32x4 f[4];
#pragma unroll
        for (int i = 0; i < 4; ++i) f[i] = (f32x4){0.f, 0.f, 0.f, 0.f};
#pragma unroll
        for (int k = 0; k < 4; ++k) {
            const int slot = F.w<int>(WS_SLOT)[row * 4 + k]; const float wgt = F.w<float>(WS_RW)[row * 4 + k];
            const bf16_t* yr = Y + (size_t)slot * D;
#pragma unroll
            for (int i = 0; i < 4; ++i) { const u32x2 w = *(const u32x2*)(yr + 4 * F.lane + 256 * i); f[i][0] += wgt * bflo(w.x); f[i][1] += wgt * bfhi(w.x); f[i][2] += wgt * bflo(w.y); f[i][3] += wgt * bfhi(w.y); }
        }
        const float rs = row_rstd(f);
        f32x4 x[4]; load_row(F.w<float>(WS_XCUR) + (size_t)row * D, F.lane, x);
#pragma unroll
        for (int i = 0; i < 4; ++i) { const f32x4 a = *(const LAS f32x4*)(vec + which * 1024 + 4 * F.lane + 256 * i); x[i] = x[i] + f[i] * rs * a; }
        float* xo = (l == 1) ? F.out + (size_t)row * D : F.w<float>(WS_XCUR) + (size_t)row * D;
#pragma unroll
        for (int i = 0; i < 4; ++i) *(f32x4*)(xo + 4 * F.lane + 256 * i) = x[i];
        if (l == 0) {
            const float rstd = row_rstd(x);
            norm_store_bf16(x, rstd, vec + 2048 + (which * 2) * 1024, vec + 2048 + (which * 2 + 1) * 1024, F.w<bf16_t>(WS_HB) + (size_t)row * D, F.lane);
        }
    }
}

constexpr int PH_PER_LAYER = 10, N_PHASES = 2 + 2 * PH_PER_LAYER;
#ifndef PH_MASK
#define PH_MASK 0xFFFFFFFFu
#endif
#define EN(b) (((PH_MASK) >> (b)) & 1u)

__global__ void __launch_bounds__(NTHREADS, 2) mega(Args args) {
    extern __shared__ __attribute__((aligned(16))) unsigned char shm[];
    Frame F0;
    F0.in.kp = (kargp_t)__builtin_amdgcn_kernarg_segment_ptr();
    F0.out = args.out; F0.ws = args.ws; F0.lds = (LAS unsigned char*)shm;
    F0.tid = threadIdx.x; F0.lane = F0.tid & 63; F0.wave = __builtin_amdgcn_readfirstlane(F0.tid >> 6); F0.G = gridDim.x; F0.bid = blockIdx.x;
    volatile LAS unsigned* bst = (volatile LAS unsigned*)(shm + LDS_BYTES - 16);
    XcdBarrier bar; bar.bar = F0.w<unsigned>(WS_CTL) + CW_BAR; bar.x = 0; bar.st = bst;
#if N_LAUNCH_MODE == 1
    if (F0.tid == 0) { bst[0] = 0u; bst[1] = 0u; }
    __syncthreads();
    bar = xcd_barrier_post(F0.w<unsigned>(WS_CTL) + CW_BAR, bst);
#define GRID_BAR() xcd_barrier(bar)
#else
#define GRID_BAR() do {} while (0)
#endif
    const int lo = args.ph_lo, hi = args.ph_hi;
#define IN(k) (lo <= (k) && (k) < hi)
#define SEAM(k) do { if (IN(k) && IN((k) + 1)) GRID_BAR(); } while (0)

    if (IN(0)) { const Frame F = launder(F0); if (EN(0)) ph_convert(F); if (EN(1)) ph_modpart(F); if (EN(2)) ph_filter(F); }
    SEAM(0);
    if (IN(1)) { const Frame F = launder(F0); if (EN(3)) ph_norm1(F, 0); if (EN(4)) ph_fsum(F); }
    SEAM(1);
    for (int l = 0; l < 2; ++l) {
        const int pb = 2 + l * PH_PER_LAYER;
        if (EN(5) && IN(pb + 0)) { const Frame F = launder(F0);
            pg8::Gemm g{F.w<bf16_t>(WS_HB), F.w<bf16_t>(WS_WINT) + (size_t)l * PC * D, D};
            pg8::SchedGrid S{PC / 256, (T / 256) * (PC / 256), F.G, F.bid};
            pg8::EpiBf16 E{F.w<bf16_t>(WS_P), PC, nullptr, 0};
            pg8::gemm_phase<pg8::EpiBf16, pg8::SchedGrid>(F.lds, g, S, E, F.tid);
        }
        SEAM(pb + 0);
        if (IN(pb + 1)) { const Frame F = launder(F0); if (EN(6)) ph_ssd_prep(F, l); if (EN(7)) ph_hy_prep(F, l); if (EN(8)) ph_na(F, l); }
        SEAM(pb + 1);
        if (IN(pb + 2)) { const Frame F = launder(F0); if (EN(9)) ph_ssd_scan(F); if (EN(10)) ph_hy_conv(F, l); }
        SEAM(pb + 2);
        if (EN(11) && IN(pb + 3)) { const Frame F = launder(F0); ph_ssd_out(F, l); }
        SEAM(pb + 3);
        if (EN(12) && IN(pb + 4)) { const Frame F = launder(F0);
            pg8::Gemm g{F.w<bf16_t>(WS_MIX), F.w<bf16_t>(WS_WOUTT) + (size_t)l * D * D, D};
            const int nM = (l == 0) ? T / 256 : L / 256;
            pg8::SchedGrid S{4, nM * 4, F.G, F.bid};
            pg8::EpiF32 E{F.w<float>(WS_MIXO), D};
            pg8::gemm_phase<pg8::EpiF32, pg8::SchedGrid>(F.lds, g, S, E, F.tid);
        }
        SEAM(pb + 4);
        if (EN(13) && IN(pb + 5)) { const Frame F = launder(F0); ph_post1(F, l); }
        SEAM(pb + 5);
        if (EN(14) && IN(pb + 6)) { const Frame F = launder(F0); ph_gather(F, l); }
        SEAM(pb + 6);
        if (EN(15) && IN(pb + 7)) { const Frame F = launder(F0);
            const int* tab = F.w<int>(WS_CTL) + CW_TILE + l * 320;
            const int ntiles = __builtin_amdgcn_readfirstlane(F.w<int>(WS_CTL)[CW_NT + l]);
            pg8::Gemm g{F.w<bf16_t>(WS_XG), F.w<bf16_t>(WS_WGUT) + (size_t)l * NE * 2048 * D, D};
            pg8::SchedMoe S{8, ntiles * 8, F.G, F.bid, tab};
            pg8::EpiAct E{F.w<bf16_t>(WS_HMID), F.in[I_BGU] + (size_t)l * NE * 2048};
            pg8::gemm_phase<pg8::EpiAct, pg8::SchedMoe>(F.lds, g, S, E, F.tid);
        }
        SEAM(pb + 7);
        if (EN(16) && IN(pb + 8)) { const Frame F = launder(F0);
            const int* tab = F.w<int>(WS_CTL) + CW_TILE + l * 320;
            const int ntiles = __builtin_amdgcn_readfirstlane(F.w<int>(WS_CTL)[CW_NT + l]);
            pg8::Gemm g{F.w<bf16_t>(WS_HMID), F.w<bf16_t>(WS_WDT) + (size_t)l * NE * D * D, D};
            pg8::SchedMoe S{4, ntiles * 4, F.G, F.bid, tab};
            pg8::EpiBf16 E{F.w<bf16_t>(WS_Y), D, F.in[I_BDN] + (size_t)l * NE * D, D};
            pg8::gemm_phase<pg8::EpiBf16, pg8::SchedMoe>(F.lds, g, S, E, F.tid);
        }
        SEAM(pb + 8);
        if (EN(17) && IN(pb + 9)) { const Frame F = launder(F0); ph_final(F, l); }
        if (l == 0) SEAM(pb + 9);
    }
#undef IN
#undef SEAM
}

extern "C" void kernel_launch(void* const* d_in, const int* in_sizes, int n_in, void* d_out, int out_size, void* d_ws, size_t ws_size, hipStream_t stream) {
    static int grid = 0;
    if (grid == 0) {
        if (n_in != N_IN || out_size != L * D || ws_size < WS_END) { fprintf(stderr, "kernel_launch: unexpected shapes: n_in %d out %d ws %zu (need %zu)\n", n_in, out_size, ws_size, (size_t)WS_END); grid = -1; return; }
        int dev = 0, cus = 0, per_cu = 0;
        if (hipGetDevice(&dev) != hipSuccess || hipDeviceGetAttribute(&cus, hipDeviceAttributeMultiprocessorCount, dev) != hipSuccess) { grid = -1; return; }
        if (hipFuncSetAttribute((const void*)mega, hipFuncAttributeMaxDynamicSharedMemorySize, LDS_BYTES) != hipSuccess) { fprintf(stderr, "kernel_launch: hipFuncSetAttribute failed\n"); grid = -1; return; }
        if (hipOccupancyMaxActiveBlocksPerMultiprocessor(&per_cu, (const void*)mega, NTHREADS, LDS_BYTES) != hipSuccess || per_cu < 1) { fprintf(stderr, "kernel_launch: occupancy query says %d\n", per_cu); }
        (void)hipGetLastError();
        grid = cus;
    }
    if (grid < 0) return;
    (void)hipMemsetAsync((char*)d_ws + WS_CTL, 0, CTL_BYTES, stream);
    Args a{};
    for (int i = 0; i < N_IN; ++i) a.in[i] = (const float*)d_in[i];
    a.out = (float*)d_out; a.ws = (unsigned char*)d_ws;
#if N_LAUNCH_MODE == 1
    a.ph_lo = 0; a.ph_hi = N_PHASES;
    hipLaunchKernelGGL(mega, dim3(grid), dim3(NTHREADS), LDS_BYTES, stream, a);
#else
    for (int p = 0; p < N_PHASES; ++p) { a.ph_lo = p; a.ph_hi = p + 1; hipLaunchKernelGGL(mega, dim3(grid), dim3(NTHREADS), LDS_BYTES, stream, a); }
#endif
}
```

```cpp
#include <hip/hip_runtime.h>
#include <cstdio>
#include <cstdint>

#define LAS __attribute__((address_space(3)))
typedef unsigned short bf16_t;
typedef short bf16x8 __attribute__((ext_vector_type(8)));
typedef float f32x4 __attribute__((ext_vector_type(4)));
typedef unsigned u32x4 __attribute__((ext_vector_type(4)));
typedef unsigned u32x2 __attribute__((ext_vector_type(2)));

#ifndef N_LAUNCH_MODE
#define N_LAUNCH_MODE 1
#endif

constexpr int D = 1024, L = 16384, LC = 256, T = L + LC, NCH = T / 128;
constexpr int PC = 3328;
constexpr int CZ = 0, CXBC = 384, CQ = 1280, CK = 1664, CV = 2048, CHY = 2432, CDT = 3200;
constexpr int NE = 32;
constexpr int MAXT = 292;
constexpr int MAXROWS = MAXT * 256;
constexpr int NTHREADS = 512;
constexpr int LDS_BYTES = 160 * 1024;
constexpr float RMS_EPS = 1e-6f;

enum { I_X = 0, I_C, I_CTX, I_CCTX, I_WMOD, I_BMOD, I_NORMG, I_WIN, I_SCW, I_SCB, I_ALOG, I_DTB, I_SSDD, I_SSDNG, I_RPB, I_HCW, I_HCB,
       I_FW1, I_FB1, I_FW2, I_FB2, I_FW3, I_FREQ, I_HYD, I_WOUT, I_WR, I_BR, I_WGU, I_BGU, I_WDN, I_BDN, N_IN };

constexpr size_t al256(size_t x) { return (x + 255) & ~(size_t)255; }
constexpr size_t WS_CTL   = 0;
constexpr size_t CTL_BYTES = 64 * 1024;
constexpr size_t WS_WINT  = WS_CTL + CTL_BYTES;
constexpr size_t WS_WOUTT = WS_WINT + al256((size_t)2 * PC * D * 2);
constexpr size_t WS_WGUT  = WS_WOUTT + al256((size_t)2 * D * D * 2);
constexpr size_t WS_WDT   = WS_WGUT + al256((size_t)2 * NE * 2048 * D * 2);
constexpr size_t WS_MODP  = WS_WDT + al256((size_t)2 * NE * D * D * 2);
constexpr size_t WS_KCOMB = WS_MODP + al256((size_t)2 * 2 * 16 * 6144 * 4);
constexpr size_t WS_KCOMBC= WS_KCOMB + al256((size_t)2 * 2 * L * 256 * 4);
constexpr size_t WS_FPART = WS_KCOMBC + al256((size_t)2 * LC * 256 * 4);
constexpr size_t WS_FPARTC= WS_FPART + al256((size_t)2 * 1024 * 512 * 4);
constexpr size_t WS_FSUM  = WS_FPARTC + al256((size_t)16 * 512 * 4);
constexpr size_t WS_HB    = WS_FSUM + al256((size_t)3 * 256 * 4);
constexpr size_t WS_P     = WS_HB + al256((size_t)T * D * 2);
constexpr size_t WS_XBC   = WS_P + al256((size_t)T * PC * 2);
constexpr size_t WS_DTV   = WS_XBC + al256((size_t)T * 896 * 2);
constexpr size_t WS_ACS   = WS_DTV + al256((size_t)T * 12 * 4);
constexpr size_t WS_ALAST = WS_ACS + al256((size_t)T * 12 * 4);
constexpr size_t WS_STATES= WS_ALAST + al256((size_t)NCH * 12 * 4);
constexpr size_t WS_SSTART= WS_STATES + al256((size_t)2 * NCH * 6 * 128 * 64 * 4);
constexpr size_t WS_U     = WS_SSTART + al256((size_t)2 * NCH * 6 * 128 * 64 * 4);
constexpr size_t WS_MIX   = WS_U + al256((size_t)T * 256 * 4);
constexpr size_t WS_MIXO  = WS_MIX + al256((size_t)T * D * 2);
constexpr size_t WS_XCUR  = WS_MIXO + al256((size_t)T * D * 4);
constexpr size_t WS_H2    = WS_XCUR + al256((size_t)T * D * 4);
constexpr size_t WS_RE    = WS_H2 + al256((size_t)T * D * 2);
constexpr size_t WS_RP    = WS_RE + al256((size_t)T * 4 * 4);
constexpr size_t WS_RW    = WS_RP + al256((size_t)T * 4 * 4);
constexpr size_t WS_SLOT  = WS_RW + al256((size_t)T * 4 * 4);
constexpr size_t WS_XG    = WS_SLOT + al256((size_t)T * 4 * 4);
constexpr size_t WS_HMID  = WS_XG + al256((size_t)MAXROWS * D * 2);
constexpr size_t WS_Y     = WS_HMID + al256((size_t)MAXROWS * D * 2);
constexpr size_t WS_END   = WS_Y + al256((size_t)MAXROWS * D * 2);

constexpr int CW_BAR = 0;
constexpr int CW_CNT = 4096;
constexpr int CW_NT = 4200;
constexpr int CW_TILE = 4224;

__device__ __forceinline__ float bf2f(unsigned short b) { return __uint_as_float(((unsigned)b) << 16); }
__device__ __forceinline__ unsigned short f2bf(float f) { unsigned u = __float_as_uint(f); u += 0x7FFFu + ((u >> 16) & 1u); return (unsigned short)(u >> 16); }
__device__ __forceinline__ unsigned pk_bf16(float lo, float hi) { return (unsigned)f2bf(lo) | ((unsigned)f2bf(hi) << 16); }
__device__ __forceinline__ float bflo(unsigned w) { return __uint_as_float(w << 16); }
__device__ __forceinline__ float bfhi(unsigned w) { return __uint_as_float(w & 0xFFFF0000u); }
__device__ __forceinline__ float silu_f(float x) { return x / (1.0f + __expf(-x)); }
__device__ __forceinline__ float softplus_f(float x) { return x > 20.f ? x : log1pf(__expf(x)); }
__device__ __forceinline__ float wave_sum(float v) {
#pragma unroll
    for (int o = 32; o >= 1; o >>= 1) v += __shfl_xor(v, o);
    return v;
}
__device__ __forceinline__ void lds_fence() { asm volatile("s_waitcnt lgkmcnt(0)" ::: "memory"); }

#define XB_TMO      128
#define XB_XCNT(j)  (256  + 64 * (j))
#define XB_XSUB(j)  (1280 + 64 * (j))
#define XB_XGEN(j)  (2304 + 64 * (j))
#define XB_TOP      3328
#define XB_TOPGEN   3392
#define XCD_BAR_WORDS 3456
#define XB_SPIN_CAP (1u << 18)
__device__ __forceinline__ unsigned xb_ld(unsigned* p)              { return __hip_atomic_load(p, __ATOMIC_RELAXED, __HIP_MEMORY_SCOPE_AGENT); }
__device__ __forceinline__ unsigned xb_add(unsigned* p, unsigned v) { return __hip_atomic_fetch_add(p, v, __ATOMIC_RELAXED, __HIP_MEMORY_SCOPE_AGENT); }
__device__ __forceinline__ unsigned xb_xcc_id() { return (unsigned)__builtin_amdgcn_s_getreg((3 << 11) | 20) & 0xFu; }
#define XB_SPIN(cond, bar) do { unsigned _sp = 0; while (cond) { __builtin_amdgcn_s_sleep(1); \
    if ((++_sp & 255u) == 0u) { if (xb_ld(&(bar)[XB_TMO])) break; if (_sp > XB_SPIN_CAP) { atomicAdd(&(bar)[XB_TMO], 1u); break; } } } } while (0)
struct XcdBarrier { unsigned* bar; unsigned x; volatile LAS unsigned* st; };
__device__ __forceinline__ XcdBarrier xcd_barrier_post(unsigned* bar, volatile LAS unsigned* st) {
    XcdBarrier b; b.bar = bar; b.x = xb_xcc_id(); b.st = st;
    if (threadIdx.x == 0) (void)xb_add(&bar[XB_XCNT(b.x)], 1u);
    return b;
}
__device__ __forceinline__ void xcd_barrier_complete(unsigned* bar, unsigned x, unsigned& nloc, unsigned& nx) {
    const unsigned G = gridDim.x * gridDim.y * gridDim.z;
    unsigned sum, cnt, mine, sp = 0u;
    for (;;) {
        sum = 0u; cnt = 0u; mine = 0u;
#pragma unroll
        for (unsigned j = 0; j < 16; ++j) { const unsigned c = xb_ld(&bar[XB_XCNT(j)]); sum += c; cnt += (c > 0u) ? 1u : 0u; mine = (j == x) ? c : mine; }
        if (sum == G) break;
        __builtin_amdgcn_s_sleep(1);
        if ((++sp & 255u) == 0u) { if (xb_ld(&bar[XB_TMO])) break; if (sp > XB_SPIN_CAP) { atomicAdd(&bar[XB_TMO], 1u); break; } }
    }
    nloc = mine > 0u ? mine : 1u; nx = cnt > 0u ? cnt : 1u;
}
__device__ __forceinline__ void xcd_barrier(const XcdBarrier& b) {
    asm volatile("s_waitcnt vmcnt(0)" ::: "memory");
    __syncthreads();
    if (threadIdx.x == 0) {
        unsigned* bar = b.bar;
        __builtin_amdgcn_s_waitcnt(0);
        unsigned nloc = b.st[0], nx = b.st[1];
        if (nloc == 0u) { xcd_barrier_complete(bar, b.x, nloc, nx); b.st[0] = nloc; b.st[1] = nx; }
        const unsigned old = xb_add(&bar[XB_XSUB(b.x)], 1u);
        const unsigned gen = old / nloc;
        if (old + 1u == (gen + 1u) * nloc) {
            __builtin_amdgcn_fence(__ATOMIC_RELEASE, "agent");
            asm volatile("s_waitcnt vmcnt(0)" ::: "memory");
            const unsigned og = xb_add(&bar[XB_TOP], 1u);
            const unsigned tg = og / nx;
            if (og + 1u == (tg + 1u) * nx) xb_add(&bar[XB_TOPGEN], 1u);
            else XB_SPIN(xb_ld(&bar[XB_TOPGEN]) == tg, bar);
            __builtin_amdgcn_fence(__ATOMIC_ACQUIRE, "agent");
            xb_add(&bar[XB_XGEN(b.x)], 1u);
            asm volatile("s_waitcnt vmcnt(0)" ::: "memory");
        } else {
            XB_SPIN(xb_ld(&bar[XB_XGEN(b.x)]) == gen, bar);
            __builtin_amdgcn_fence(__ATOMIC_ACQUIRE, "agent");
            asm volatile("s_waitcnt vmcnt(0)" ::: "memory");
        }
    }
    __syncthreads();
}

namespace pg8 {
constexpr int BM = 256, BK = 64, HALF = 128, HTB = HALF * BK * 2, STAGE_BYTES = 8 * HTB;
__host__ __device__ __forceinline__ int lds_byte(int r, int c) { const int st = (r >> 4) * 2 + (c >> 5), rr = r & 15, cc = c & 31, ob = rr * 64 + cc * 2; return st * 1024 + (ob ^ (((ob >> 9) & 1) << 5)); }
__host__ __device__ __forceinline__ void stage_rc(int b, int& R, int& C) { const int st = b / 1024, sb = b % 1024, swz = sb ^ (((sb >> 9) & 1) << 5); R = (st >> 1) * 16 + swz / 64; C = (st & 1) * 32 + (swz % 64) / 2; }
__host__ __device__ __forceinline__ int perm32(int rho) { const int n = rho >> 4, i = rho & 15; return 8 * (i >> 2) + 4 * n + (i & 3); }

struct Unit { int pa, pb, pn, e; };
struct Gemm { const bf16_t* A; const bf16_t* Bt; int K; };

template <class Epi, class Sched, bool ALIGN_EPI = true>
__device__ __forceinline__ void gemm_phase(LAS unsigned char* lds, const Gemm g, const Sched& S, const Epi& E, const int tid) {
    const int wid = __builtin_amdgcn_readfirstlane(tid >> 6), lane = tid & 63, wr = wid >> 2, wc = wid & 3, fr = lane & 15, fq = lane >> 4;
    const int K = g.K, nt = K / BK;
    unsigned voffA[2], voffB[2];
#pragma unroll
    for (int i = 0; i < 2; ++i) { int R, C; stage_rc(tid * 16 + i * 8192, R, C); const int Rb = Epi::PERM ? ((R & ~31) + perm32(R & 31)) : R;
        voffA[i] = (unsigned)(R * K + C) * 2u; voffB[i] = (unsigned)(Rb * K + C) * 2u; }
    const size_t kstep = (size_t)(BK * 2);
    const size_t hstep = (size_t)HALF * K * 2;
    const size_t tstep = 2 * hstep;
    const unsigned ldsw = (unsigned)wid * 1024u;
    const int aoff = lds_byte(wr * 64 + fr, fq * 8), boff = lds_byte(wc * 32 + fr, fq * 8);
#define PG8_SA(b, h) (((b) * 2 + (h)) * HTB)
#define PG8_SB(b, h) ((4 + (b) * 2 + (h)) * HTB)
#define PG8_STAGE(bufoff, gbase, voff) do { _Pragma("unroll") for (int _i = 0; _i < 2; ++_i) \
        __builtin_amdgcn_global_load_lds((const unsigned*)((const char*)(gbase) + (voff)[_i]), (LAS unsigned*)(lds + (bufoff) + ldsw + _i * 8192), 16, 0, 0); } while (0)
#define PG8_LDA(dst, b, h) do { _Pragma("unroll") for (int m = 0; m < 4; ++m) _Pragma("unroll") for (int k = 0; k < 2; ++k) dst[m][k] = *(const LAS bf16x8*)(lds + PG8_SA(b, h) + aoff + m * 2048 + k * 1024); } while (0)
#define PG8_LDB(dst, b, h) do { _Pragma("unroll") for (int n = 0; n < 2; ++n) _Pragma("unroll") for (int k = 0; k < 2; ++k) dst[n][k] = *(const LAS bf16x8*)(lds + PG8_SB(b, h) + boff + n * 2048 + k * 1024); } while (0)
#define PG8_MMA(ai, bj, At, Bt) do { __builtin_amdgcn_s_setprio(1); _Pragma("unroll") for (int m = 0; m < 4; ++m) _Pragma("unroll") for (int n = 0; n < 2; ++n) _Pragma("unroll") for (int k = 0; k < 2; ++k) \
        acc[ai][bj][m][n] = __builtin_amdgcn_mfma_f32_16x16x32_bf16(Bt[n][k], At[m][k], acc[ai][bj][m][n], 0, 0, 0); __builtin_amdgcn_s_setprio(0); } while (0)
#define PG8_WAIT_V(n) asm volatile("s_waitcnt vmcnt(" #n ")" ::: "memory")
#define PG8_WAIT_L(n) asm volatile("s_waitcnt lgkmcnt(" #n ")" ::: "memory")
#define PG8_BAR __builtin_amdgcn_s_barrier()
#define PG8_SCHED __builtin_amdgcn_sched_barrier(0)
    Unit cur, nxt; int ui = 0;
    if (!S.next(0, cur)) return;
    f32x4 acc[2][2][4][2];
#pragma unroll
    for (int a = 0; a < 2; ++a)
#pragma unroll
        for (int b = 0; b < 2; ++b)
#pragma unroll
            for (int m = 0; m < 4; ++m)
#pragma unroll
                for (int n = 0; n < 2; ++n) acc[a][b][m][n] = (f32x4){0.f, 0.f, 0.f, 0.f};
    bf16x8 At[4][2], B0[2][2], B1[2][2];
    const char* cA = (const char*)g.A + (size_t)cur.pa * tstep; const char* cB = (const char*)g.Bt + (size_t)cur.pb * tstep;
    PG8_STAGE(PG8_SB(0, 0), cB, voffB); PG8_STAGE(PG8_SB(0, 1), cB + hstep, voffB); PG8_STAGE(PG8_SA(0, 0), cA, voffA); PG8_STAGE(PG8_SA(0, 1), cA + hstep, voffA);
    if (wr == 1) PG8_BAR;
    PG8_WAIT_V(2); PG8_BAR;
    PG8_STAGE(PG8_SB(1, 0), cB + kstep, voffB); PG8_STAGE(PG8_SA(1, 0), cA + kstep, voffA); PG8_STAGE(PG8_SB(1, 1), cB + hstep + kstep, voffB);
    PG8_WAIT_V(6); PG8_BAR;
    for (;;) {
        const bool has_next = S.next(ui + 1, nxt);
        const char* nA = has_next ? (const char*)g.A + (size_t)nxt.pa * tstep : cA; const char* nB = has_next ? (const char*)g.Bt + (size_t)nxt.pb * tstep : cB;
        for (int t = 0; t < nt; t += 2) {
            const bool last = (t == nt - 2);
            const char* a1 = cA + (size_t)(t + 1) * kstep;
            const char* a2 = last ? nA : cA + (size_t)(t + 2) * kstep; const char* b2 = last ? nB : cB + (size_t)(t + 2) * kstep;
            const char* a3 = a2 + kstep; const char* b3 = b2 + kstep;
            PG8_LDB(B0, 0, 0); PG8_LDB(B1, 0, 1); PG8_SCHED; PG8_LDA(At, 0, 0); PG8_STAGE(PG8_SA(1, 1), a1 + hstep, voffA);
            PG8_WAIT_V(8); PG8_WAIT_L(0); PG8_BAR; PG8_MMA(0, 0, At, B0); PG8_MMA(0, 1, At, B1); PG8_BAR; PG8_SCHED;
            PG8_LDA(At, 0, 1); PG8_STAGE(PG8_SB(0, 0), b2, voffB); PG8_STAGE(PG8_SB(0, 1), b2 + hstep, voffB); PG8_STAGE(PG8_SA(0, 0), a2, voffA);
            PG8_WAIT_V(8); PG8_WAIT_L(0); PG8_BAR; PG8_MMA(1, 0, At, B0); PG8_MMA(1, 1, At, B1); PG8_BAR; PG8_SCHED;
            PG8_LDB(B0, 1, 0); PG8_LDB(B1, 1, 1); PG8_SCHED; PG8_LDA(At, 1, 0); PG8_STAGE(PG8_SA(0, 1), a2 + hstep, voffA);
            PG8_WAIT_V(8); PG8_WAIT_L(0); PG8_BAR; PG8_MMA(0, 0, At, B0); PG8_MMA(0, 1, At, B1); PG8_BAR; PG8_SCHED;
            PG8_LDA(At, 1, 1); PG8_STAGE(PG8_SB(1, 0), b3, voffB); PG8_STAGE(PG8_SB(1, 1), b3 + hstep, voffB); PG8_STAGE(PG8_SA(1, 0), a3, voffA);
            PG8_WAIT_V(8); PG8_WAIT_L(0); PG8_BAR; PG8_MMA(1, 0, At, B0); PG8_MMA(1, 1, At, B1); PG8_BAR; PG8_SCHED;
        }
        if constexpr (ALIGN_EPI) { if (wr == 0) PG8_BAR; }
        E(acc, cur, wr, wc, fr, fq);
        if (!has_next) break;
#pragma unroll
        for (int a = 0; a < 2; ++a)
#pragma unroll
            for (int b = 0; b < 2; ++b)
#pragma unroll
                for (int m = 0; m < 4; ++m)
#pragma unroll
                    for (int n = 0; n < 2; ++n) acc[a][b][m][n] = (f32x4){0.f, 0.f, 0.f, 0.f};
        cur = nxt; cA = nA; cB = nB; ++ui;
        if constexpr (ALIGN_EPI) { if (wr == 1) PG8_BAR; }
    }
    PG8_WAIT_V(0);
    if constexpr (!ALIGN_EPI) { if (wr == 0) PG8_BAR; }
    PG8_BAR;
#undef PG8_SA
#undef PG8_SB
#undef PG8_STAGE
#undef PG8_LDA
#undef PG8_LDB
#undef PG8_MMA
#undef PG8_WAIT_V
#undef PG8_WAIT_L
#undef PG8_BAR
#undef PG8_SCHED
}

struct EpiF32 {
    static constexpr bool PERM = false;
    float* C; int ldc;
    __device__ __forceinline__ void operator()(const f32x4 (&acc)[2][2][4][2], const Unit& u, int wr, int wc, int fr, int fq) const {
        const int row0 = u.pa * BM + wr * 64 + fr, col0 = u.pn * BM + wc * 32 + 4 * fq;
#pragma unroll
        for (int ai = 0; ai < 2; ++ai)
#pragma unroll
            for (int m = 0; m < 4; ++m) { float* rowp = C + (size_t)(row0 + ai * HALF + m * 16) * ldc + col0;
#pragma unroll
                for (int bj = 0; bj < 2; ++bj)
#pragma unroll
                    for (int n = 0; n < 2; ++n) *(f32x4*)(rowp + bj * HALF + n * 16) = acc[ai][bj][m][n]; }
    }
};
struct EpiBf16 {
    static constexpr bool PERM = true;
    bf16_t* O; int ldc; const float* bias; int bias_stride;
    __device__ __forceinline__ void operator()(const f32x4 (&acc)[2][2][4][2], const Unit& u, int wr, int wc, int fr, int fq) const {
        const int row0 = u.pa * BM + wr * 64 + fr; const int col0 = u.pn * BM + wc * 32 + 8 * fq;
        f32x4 bv[2][2];
#pragma unroll
        for (int bj = 0; bj < 2; ++bj)
#pragma unroll
            for (int n = 0; n < 2; ++n) bv[bj][n] = bias ? *(const f32x4*)(bias + (size_t)u.e * bias_stride + col0 + bj * HALF + 4 * n) : (f32x4){0.f, 0.f, 0.f, 0.f};
#pragma unroll
        for (int ai = 0; ai < 2; ++ai)
#pragma unroll
            for (int m = 0; m < 4; ++m) { bf16_t* rowp = O + (size_t)(row0 + ai * HALF + m * 16) * ldc + col0;
#pragma unroll
                for (int bj = 0; bj < 2; ++bj) { const f32x4 v0 = acc[ai][bj][m][0] + bv[bj][0], v1 = acc[ai][bj][m][1] + bv[bj][1];
                    u32x4 w; w.x = pk_bf16(v0[0], v0[1]); w.y = pk_bf16(v0[2], v0[3]); w.z = pk_bf16(v1[0], v1[1]); w.w = pk_bf16(v1[2], v1[3]);
                    *(u32x4*)(rowp + bj * HALF) = w; } }
    }
};
struct EpiAct {
    static constexpr bool PERM = true;
    bf16_t* O; const float* bias;
    __device__ __forceinline__ void operator()(const f32x4 (&acc)[2][2][4][2], const Unit& u, int wr, int wc, int fr, int fq) const {
        const int row0 = u.pa * BM + wr * 64 + fr; const int cc0 = wc * 32 + 8 * fq; const int ocol = u.pn * 128 + cc0;
        const float* bg = bias + (size_t)u.e * 2048 + ocol; const float* bu = bg + 1024;
        f32x4 bgv[2], buv[2];
#pragma unroll
        for (int n = 0; n < 2; ++n) { bgv[n] = *(const f32x4*)(bg + 4 * n); buv[n] = *(const f32x4*)(bu + 4 * n); }
#pragma unroll
        for (int ai = 0; ai < 2; ++ai)
#pragma unroll
            for (int m = 0; m < 4; ++m) { bf16_t* rowp = O + (size_t)(row0 + ai * HALF + m * 16) * D + ocol;
                float r[8];
#pragma unroll
                for (int n = 0; n < 2; ++n)
#pragma unroll
                    for (int j = 0; j < 4; ++j) { float gt = acc[ai][0][m][n][j] + bgv[n][j], up = acc[ai][1][m][n][j] + buv[n][j];
                        gt = fminf(gt, 7.0f); up = fminf(fmaxf(up, -7.0f), 7.0f);
                        r[n * 4 + j] = gt / (1.0f + __expf(-1.702f * gt)) * (up + 1.0f); }
                u32x4 w; w.x = pk_bf16(r[0], r[1]); w.y = pk_bf16(r[2], r[3]); w.z = pk_bf16(r[4], r[5]); w.w = pk_bf16(r[6], r[7]);
                *(u32x4*)rowp = w; }
    }
};
struct SchedGrid {
    int nN, total, G, c;
    __device__ __forceinline__ bool next(int i, Unit& u) const { const int Lx = i * G + c; if (Lx >= total) return false; u.pa = Lx / nN; u.pn = Lx - u.pa * nN; u.pb = u.pn; u.e = 0; return true; }
};
struct SchedMoe {
    int nN, total, G, c; const int* tile_e;
    __device__ __forceinline__ bool next(int i, Unit& u) const { const int Lx = i * G + c; if (Lx >= total) return false; u.pa = Lx / nN; u.pn = Lx - u.pa * nN; u.e = __builtin_amdgcn_readfirstlane((int)tile_e[u.pa]); u.pb = u.e * nN + u.pn; return true; }
};
}

struct Args { const float* in[N_IN]; float* out; unsigned char* ws; int ph_lo, ph_hi; };

typedef const float* __attribute__((address_space(4))) const* kargp_t;
struct InProxy { kargp_t kp; __device__ __forceinline__ const float* operator[](int i) const { return kp[i]; } };
struct Frame {
    InProxy in; float* out; unsigned char* ws;
    LAS unsigned char* lds;
    int tid, lane, wave, G, bid;
    template <class Tp> __device__ __forceinline__ Tp* w(size_t off) const { return (Tp*)(ws + off); }
};

__device__ __forceinline__ Frame launder(const Frame& F) {
    Frame R = F;
    int t = F.tid; asm volatile("" : "+v"(t)); R.tid = t; R.lane = t & 63; R.wave = __builtin_amdgcn_readfirstlane(t >> 6);
    unsigned long long w = (unsigned long long)F.ws; asm volatile("" : "+s"(w)); R.ws = (unsigned char*)w;
    unsigned long long o = (unsigned long long)F.out; asm volatile("" : "+s"(o)); R.out = (float*)o;
    unsigned long long k = (unsigned long long)F.in.kp; asm volatile("" : "+s"(k)); R.in.kp = (kargp_t)k;
    int g = F.G, b = F.bid; asm volatile("" : "+s"(g), "+s"(b)); R.G = g; R.bid = b;
    return R;
}

__device__ __forceinline__ float mod_val(const Frame& F, int l, int which, int j) {
    const float* mp = F.w<float>(WS_MODP) + (size_t)((l * 2 + which) * 16) * 6144 + j;
    float s = F.in[I_BMOD][l * 6144 + j];
#pragma unroll
    for (int k = 0; k < 16; ++k) s += mp[(size_t)k * 6144];
    return s;
}

__device__ __forceinline__ void convert_tile(const float* __restrict__ src, int ld, int k0, int n0, int mode, bf16_t* __restrict__ dst, LAS unsigned* lw, int lane) {
    const int i4 = lane & 15, kpl = lane >> 4;
    const int n = n0 + 4 * i4;
    int sc; bool valid = true;
    if (mode == 0) sc = n;
    else if (mode == 1) { if (n < 1280) sc = n; else if (n < 3200) sc = n + 12; else if (n < 3212) sc = n - 3200 + 1280; else { sc = 0; valid = false; } }
    else { const int pn = n >> 8, rr = n & 255; sc = rr < 128 ? pn * 128 + rr : 1024 + pn * 128 + (rr - 128); }
#pragma unroll
    for (int it = 0; it < 8; ++it) {
        const int kp = kpl + 4 * it;
        f32x4 a = (f32x4){0.f, 0.f, 0.f, 0.f}, b = a;
        if (valid) { a = *(const f32x4*)(src + (size_t)(k0 + 2 * kp) * ld + sc); b = *(const f32x4*)(src + (size_t)(k0 + 2 * kp + 1) * ld + sc); }
#pragma unroll
        for (int i = 0; i < 4; ++i) lw[kp * 65 + 4 * i4 + i] = pk_bf16(a[i], b[i]);
    }
    lds_fence();
    const int g = lane & 7, nl = lane >> 3;
#pragma unroll
    for (int it = 0; it < 8; ++it) {
        const int nn = nl + 8 * it;
        u32x4 v; v.x = lw[(4 * g + 0) * 65 + nn]; v.y = lw[(4 * g + 1) * 65 + nn]; v.z = lw[(4 * g + 2) * 65 + nn]; v.w = lw[(4 * g + 3) * 65 + nn];
        *(u32x4*)(dst + (size_t)(n0 + nn) * 1024 + k0 + 8 * g) = v;
    }
    lds_fence();
}

__device__ __forceinline__ void ph_convert(const Frame& F) {
    LAS unsigned* lw = (LAS unsigned*)(F.lds) + F.wave * (32 * 65 + 16);
    const int nwaves = F.G * 8, w0 = F.bid * 8 + F.wave;
    for (int t = w0; t < 51328; t += nwaves) {
        const float* src; bf16_t* dst; int ld, mode, k0, n0;
        if (t < 1664) { const int l = t / 832, r = t % 832; n0 = (r / 16) * 64; k0 = (r % 16) * 64; src = F.in[I_WIN] + (size_t)l * 1024 * 3212; ld = 3212; mode = 1; dst = F.w<bf16_t>(WS_WINT) + (size_t)l * PC * D; }
        else if (t < 2176) { const int q = t - 1664, l = q / 256, r = q % 256; n0 = (r / 16) * 64; k0 = (r % 16) * 64; src = F.in[I_WOUT] + (size_t)l * D * D; ld = 1024; mode = 0; dst = F.w<bf16_t>(WS_WOUTT) + (size_t)l * D * D; }
        else if (t < 34944) { const int q = t - 2176, le = q / 512, r = q % 512; n0 = (r / 16) * 64; k0 = (r % 16) * 64; src = F.in[I_WGU] + (size_t)le * 1024 * 2048; ld = 2048; mode = 2; dst = F.w<bf16_t>(WS_WGUT) + (size_t)le * 2048 * D; }
        else { const int q = t - 34944, le = q / 256, r = q % 256; n0 = (r / 16) * 64; k0 = (r % 16) * 64; src = F.in[I_WDN] + (size_t)le * D * D; ld = 1024; mode = 0; dst = F.w<bf16_t>(WS_WDT) + (size_t)le * D * D; }
        convert_tile(src, ld, k0, n0, mode, dst, lw, F.lane);
    }
}

__device__ __forceinline__ void ph_modpart(const Frame& F) {
    for (int it = F.bid; it < 384; it += F.G) {
        const int l = it / 192, r = it % 192, cc = r / 16, kc = r % 16;
        const int j = cc * 512 + F.tid;
        const float* wm = F.in[I_WMOD] + (size_t)l * D * 6144 + j;
        float a0 = 0.f, a1 = 0.f;
        for (int k = kc * 64; k < kc * 64 + 64; ++k) {
            const float wv = wm[(size_t)k * 6144];
            a0 += silu_f(F.in[I_C][k]) * wv; a1 += silu_f(F.in[I_CCTX][k]) * wv;
        }
        float* mp = F.w<float>(WS_MODP);
        mp[(size_t)((l * 2 + 0) * 16 + kc) * 6144 + j] = a0;
        mp[(size_t)((l * 2 + 1) * 16 + kc) * 6144 + j] = a1;
    }
}

__device__ __forceinline__ void ph_filter(const Frame& F) {
    LAS float* zs = (LAS float*)F.lds;
    LAS float* h1 = zs + 16 * 33;
    LAS float* h2 = h1 + 16 * 64;
    const float min_decay = -4.605170185988091f / 1.5f, max_decay = -4.605170185988091f / 0.3f;
    for (int it = F.bid; it < 2048 + 16; it += F.G) {
        const bool isctx = it >= 2048;
        const int l = isctx ? 0 : it / 1024, grp = isctx ? it - 2048 : it % 1024;
        const int Lx = isctx ? LC : L;
        const int t0 = grp * 16;
        __syncthreads();
        for (int q = F.tid; q < 16 * 33; q += NTHREADS) {
            const int pos = q / 33, i = q % 33; const int t = t0 + pos;
            const float tn = (float)t / (float)(Lx - 1);
            const float wv = 6.283185307179586f * (float)t / (float)Lx;
            float v;
            if (i == 0) v = tn;
            else { const int b = (i - 1) & 15; const float f = 1e-4f + (float)b * ((15.0f - 1e-4f) / 15.0f); v = (i <= 16) ? cosf(f * wv) : -sinf(f * wv); }
            zs[q] = v;
        }
        __syncthreads();
        for (int q = F.tid; q < 16 * 64; q += NTHREADS) {
            const int pos = q >> 6, o = q & 63;
            float s = F.in[I_FB1][l * 64 + o];
            for (int i = 0; i < 33; ++i) s += zs[pos * 33 + i] * F.in[I_FW1][(size_t)l * 33 * 64 + i * 64 + o];
            h1[q] = sinf(F.in[I_FREQ][l * 128 + o] * s);
        }
        __syncthreads();
        for (int q = F.tid; q < 16 * 64; q += NTHREADS) {
            const int pos = q >> 6, o = q & 63;
            float s = F.in[I_FB2][l * 64 + o];
            for (int i = 0; i < 64; ++i) s += h1[pos * 64 + i] * F.in[I_FW2][(size_t)l * 64 * 64 + i * 64 + o];
            h2[q] = sinf(F.in[I_FREQ][l * 128 + 64 + o] * s);
        }
        __syncthreads();
        {
            const int o = F.tid, c = o & 255, dir = o >> 8;
            float acc[16];
#pragma unroll
            for (int p = 0; p < 16; ++p) acc[p] = 0.f;
            const float* w3 = F.in[I_FW3] + (size_t)l * 64 * 512 + o;
            for (int k = 0; k < 64; ++k) { const float wv = w3[k * 512];
#pragma unroll
                for (int p = 0; p < 16; ++p) acc[p] += h2[p * 64 + k] * wv; }
            const float delta = fabsf(min_decay + (float)c * ((max_decay - min_decay) / 255.0f));
            float* kc = isctx ? F.w<float>(WS_KCOMBC) : F.w<float>(WS_KCOMB) + (size_t)l * 2 * L * 256;
            float asum = 0.f;
#pragma unroll
            for (int p = 0; p < 16; ++p) {
                const int t = t0 + p; const float tn = (float)t / (float)(Lx - 1);
                const float v = acc[p] * __expf(-tn * delta);
                asum += fabsf(v);
                if (dir == 0) kc[(size_t)(Lx - 1 + t) * 256 + c] = v;
                else if (t >= 1) kc[(size_t)(Lx - 1 - t) * 256 + c] = v;
            }
            if (isctx) F.w<float>(WS_FPARTC)[grp * 512 + o] = asum;
            else F.w<float>(WS_FPART)[((size_t)l * 1024 + grp) * 512 + o] = asum;
        }
    }
}

__device__ __forceinline__ void ph_fsum(const Frame& F) {
    const int nwaves = F.G * 8;
    for (int o = F.bid * 8 + F.wave; o < 768; o += nwaves) {
        const int which = o >> 8, c = o & 255;
        float s = 0.f;
        if (which < 2) { const float* fp = F.w<float>(WS_FPART) + (size_t)which * 1024 * 512;
            for (int i = F.lane; i < 1024; i += 64) s += fp[(size_t)i * 512 + c] + fp[(size_t)i * 512 + 256 + c]; }
        else { const float* fp = F.w<float>(WS_FPARTC); if (F.lane < 16) s = fp[F.lane * 512 + c] + fp[F.lane * 512 + 256 + c]; }
        s = wave_sum(s);
        if (F.lane == 0) F.w<float>(WS_FSUM)[o] = 1.0f / s;
    }
}

__device__ __forceinline__ void load_row(const float* p, int lane, f32x4 (&v)[4]) {
#pragma unroll
    for (int i = 0; i < 4; ++i) v[i] = *(const f32x4*)(p + 4 * lane + 256 * i);
}
__device__ __forceinline__ float row_rstd(const f32x4 (&v)[4]) {
    float s = 0.f;
#pragma unroll
    for (int i = 0; i < 4; ++i) s += v[i][0] * v[i][0] + v[i][1] * v[i][1] + v[i][2] * v[i][2] + v[i][3] * v[i][3];
    s = wave_sum(s);
    return rsqrtf(s * (1.0f / 1024.0f) + RMS_EPS);
}
__device__ __forceinline__ void stage_norm_vecs(const Frame& F, int l, int gain_idx, int sh_seg, int sc_seg, LAS float* dst  ) {
    for (int q = F.tid; q < 2048; q += NTHREADS) {
        const int which = q >> 10, j = q & 1023;
        const float g = F.in[I_NORMG][(l * 4 + gain_idx) * 1024 + j];
        dst[(which * 2 + 0) * 1024 + j] = g * (1.0f + mod_val(F, l, which, sc_seg * 1024 + j));
        dst[(which * 2 + 1) * 1024 + j] = mod_val(F, l, which, sh_seg * 1024 + j);
    }
}
__device__ __forceinline__ void norm_store_bf16(const f32x4 (&v)[4], float rstd, const LAS float* va, const LAS float* vb, bf16_t* orow, int lane) {
#pragma unroll
    for (int i = 0; i < 4; ++i) {
        const int c = 4 * lane + 256 * i;
        const f32x4 a = *(const LAS f32x4*)(va + c), b = *(const LAS f32x4*)(vb + c);
        u32x2 w; w.x = pk_bf16(v[i][0] * rstd * a[0] + b[0], v[i][1] * rstd * a[1] + b[1]); w.y = pk_bf16(v[i][2] * rstd * a[2] + b[2], v[i][3] * rstd * a[3] + b[3]);
        *(u32x2*)(orow + c) = w;
    }
}
__device__ __forceinline__ const float* xrow_ptr(const Frame& F, int l, int row) {
    if (l == 0) return row < L ? F.in[I_X] + (size_t)row * D : F.in[I_CTX] + (size_t)(row - L) * D;
    return F.w<float>(WS_XCUR) + (size_t)row * D;
}
__device__ __forceinline__ void ph_norm1(const Frame& F, int l) {
    LAS float* vec = (LAS float*)F.lds;
    __syncthreads();
    stage_norm_vecs(F, l, 0, 0, 1, vec);
    __syncthreads();
    const int nwaves = F.G * 8;
    for (int row = F.bid * 8 + F.wave; row < T; row += nwaves) {
        const int which = row >= L;
        f32x4 v[4]; load_row(xrow_ptr(F, l, row), F.lane, v);
        const float rstd = row_rstd(v);
        norm_store_bf16(v, rstd, vec + (which * 2) * 1024, vec + (which * 2 + 1) * 1024, F.w<bf16_t>(WS_HB) + (size_t)row * D, F.lane);
    }
}

__device__ __forceinline__ void ph_ssd_prep(const Frame& F, int l) {
    LAS float* Bs  = (LAS float*)F.lds;
    LAS float* xw  = Bs + 128 * 128;
    LAS float* dts = xw + 2 * 128 * 64;
    LAS float* acs = dts + 256;
    LAS float* wj  = acs + 256;
    const bf16_t* P = F.w<bf16_t>(WS_P);
    const float* cw = F.in[I_SCW] + (size_t)l * 5 * 896; const float* cb = F.in[I_SCB] + (size_t)l * 896;
    for (int it = F.bid; it < NCH * 6; it += F.G) {
        const int ch = it / 6, h = it % 6, g = h / 3;
        const int row0 = ch * 128;
        const int seq_lo = ch < 128 ? 0 : L, seq_hi = ch < 128 ? L : T;
        __syncthreads();
        if (F.tid < 256) {
            const int dir = F.tid >> 7, j = F.tid & 127;
            const float raw = bf2f(P[(size_t)(row0 + j) * PC + CDT + dir * 6 + h]) + F.in[I_DTB][(l * 2 + dir) * 6 + h];
            const float dt = softplus_f(raw);
            dts[F.tid] = dt;
            F.w<float>(WS_DTV)[(size_t)(row0 + j) * 12 + dir * 6 + h] = dt;
        }
        __syncthreads();
        if (F.tid == 0 || F.tid == 64) {
            const int dir = F.tid >> 6; const float a = -__expf(F.in[I_ALOG][(l * 2 + dir) * 6 + h]);
            float s = 0.f;
            if (dir == 0) { for (int j = 0; j < 128; ++j) { s += dts[j] * a; acs[j] = s; } }
            else { for (int j = 127; j >= 0; --j) { s += dts[128 + j] * a; acs[128 + j] = s; } }
            F.w<float>(WS_ALAST)[ch * 12 + dir * 6 + h] = s;
        }
        __syncthreads();
        if (F.tid < 256) {
            const int dir = F.tid >> 7, j = F.tid & 127;
            const float alast = dir == 0 ? acs[127] : acs[128];
            F.w<float>(WS_ACS)[(size_t)(row0 + j) * 12 + dir * 6 + h] = acs[F.tid];
            wj[F.tid] = __expf(alast - acs[F.tid]) * dts[F.tid];
        }
        __syncthreads();
        const int nchan = (h % 3 == 0) ? 320 : 192;
        for (int q = F.tid; q < 128 * nchan; q += NTHREADS) {
            const int j = q / nchan, cq = q % nchan;
            const int chn = cq < 64 ? h * 64 + cq : (cq < 192 ? 384 + g * 128 + (cq - 64) : 640 + g * 128 + (cq - 192));
            float s = cb[chn];
#pragma unroll
            for (int k = 0; k < 5; ++k) { const int r = row0 + j + k - 2; if (r >= seq_lo && r < seq_hi) s += cw[k * 896 + chn] * bf2f(P[(size_t)r * PC + CXBC + chn]); }
            s = silu_f(s);
            if (cq < 64 || h % 3 == 0) F.w<bf16_t>(WS_XBC)[(size_t)(row0 + j) * 896 + chn] = f2bf(s);
            if (cq < 64) { xw[j * 64 + cq] = s * wj[j]; xw[(128 + j) * 64 + cq] = s * wj[128 + j]; }
            else if (cq < 192) Bs[j * 128 + (cq - 64)] = s;
        }
        __syncthreads();
        {
            const int n = F.tid & 127, pq = F.tid >> 7;
            float a0[16], a1[16];
#pragma unroll
            for (int p = 0; p < 16; ++p) { a0[p] = 0.f; a1[p] = 0.f; }
            for (int j = 0; j < 128; ++j) {
                const float b = Bs[j * 128 + n];
#pragma unroll
                for (int p4 = 0; p4 < 4; ++p4) {
                    const f32x4 x0 = *(const LAS f32x4*)(xw + j * 64 + pq * 16 + p4 * 4), x1 = *(const LAS f32x4*)(xw + (128 + j) * 64 + pq * 16 + p4 * 4);
#pragma unroll
                    for (int e = 0; e < 4; ++e) { a0[p4 * 4 + e] += b * x0[e]; a1[p4 * 4 + e] += b * x1[e]; }
                }
            }
            float* s0 = F.w<float>(WS_STATES) + ((size_t)(0 * NCH + ch) * 6 + h) * 8192 + n * 64 + pq * 16;
            float* s1 = F.w<float>(WS_STATES) + ((size_t)(1 * NCH + ch) * 6 + h) * 8192 + n * 64 + pq * 16;
#pragma unroll
            for (int p4 = 0; p4 < 4; ++p4) { *(f32x4*)(s0 + p4 * 4) = (f32x4){a0[p4 * 4], a0[p4 * 4 + 1], a0[p4 * 4 + 2], a0[p4 * 4 + 3]};
                                             *(f32x4*)(s1 + p4 * 4) = (f32x4){a1[p4 * 4], a1[p4 * 4 + 1], a1[p4 * 4 + 2], a1[p4 * 4 + 3]}; }
        }
    }
}

__device__ __forceinline__ void ph_ssd_scan(const Frame& F) {
    for (int blk = F.bid; blk < 192; blk += F.G) {
        const int id = blk * 512 + F.tid;
        const int dir = id / 49152, rem = id % 49152, h = rem / 8192, e = rem % 8192;
        const float* al = F.w<float>(WS_ALAST) + dir * 6 + h;
        float s = 0.f;
        for (int step = 0; step < NCH; ++step) {
            int ch;
            if (dir == 0) ch = step < 2 ? 128 + step : step - 2;
            else ch = step < 2 ? 129 - step : 129 - step;
            const size_t off = ((size_t)(dir * NCH + ch) * 6 + h) * 8192 + e;
            F.w<float>(WS_SSTART)[off] = s;
            s = s * __expf(al[ch * 12]) + F.w<float>(WS_STATES)[off];
        }
    }
}

__device__ __forceinline__ void ph_ssd_out(const Frame& F, int l) {
    LAS unsigned* Cs = (LAS unsigned*)F.lds;
    LAS unsigned* Bs = Cs + 128 * 65;
    LAS float* G  = (LAS float*)(Bs + 128 * 65);
    LAS float* af = G + 128 * 129;
    LAS float* ab = af + 384;
    LAS float* red = ab + 384;
    LAS float* xdt = (LAS float*)Bs;
    const bf16_t* XBC = F.w<bf16_t>(WS_XBC);
    const bf16_t* P = F.w<bf16_t>(WS_P);
    const int nch = (l == 0) ? NCH : 128;
    for (int it = F.bid; it < nch * 2; it += F.G) {
        const int ch = it >> 1, g = it & 1, row0 = ch * 128;
        __syncthreads();
        for (int q = F.tid; q < 128 * 64; q += NTHREADS) {
            const int j = q >> 6, n2 = q & 63;
            Bs[j * 65 + n2] = *(const unsigned*)(XBC + (size_t)(row0 + j) * 896 + 384 + g * 128 + 2 * n2);
            Cs[j * 65 + n2] = *(const unsigned*)(XBC + (size_t)(row0 + j) * 896 + 640 + g * 128 + 2 * n2);
        }
        for (int q = F.tid; q < 768; q += NTHREADS) {
            const int dir = q / 384, r = q % 384, hh = r >> 7, j = r & 127;
            (dir ? ab : af)[hh * 128 + j] = F.w<float>(WS_ACS)[(size_t)(row0 + j) * 12 + dir * 6 + g * 3 + hh];
        }
        __syncthreads();
        const int i = F.tid & 127, pq = __builtin_amdgcn_readfirstlane(F.tid >> 7);
        {
            float gacc[32];
#pragma unroll
            for (int jj = 0; jj < 32; ++jj) gacc[jj] = 0.f;
            for (int n2 = 0; n2 < 64; ++n2) {
                const unsigned cw_ = Cs[i * 65 + n2]; const float c0 = bflo(cw_), c1 = bfhi(cw_);
#pragma unroll
                for (int jj = 0; jj < 32; ++jj) { const unsigned bw = Bs[(pq * 32 + jj) * 65 + n2]; gacc[jj] += c0 * bflo(bw) + c1 * bfhi(bw); }
            }
#pragma unroll
            for (int jj = 0; jj < 32; ++jj) G[i * 129 + pq * 32 + jj] = gacc[jj];
        }
        __syncthreads();
        float yacc[3][16];
#pragma unroll
        for (int hh = 0; hh < 3; ++hh) {
            const int h = g * 3 + hh;
            LAS unsigned* xd = (LAS unsigned*)Bs;
            for (int q = F.tid; q < 128 * 32; q += NTHREADS) {
                const int j = q >> 5, p2 = q & 31;
                const unsigned xv = *(const unsigned*)(XBC + (size_t)(row0 + j) * 896 + h * 64 + 2 * p2);
                const float d0 = F.w<float>(WS_DTV)[(size_t)(row0 + j) * 12 + h], d1 = F.w<float>(WS_DTV)[(size_t)(row0 + j) * 12 + 6 + h];
                xd[j * 32 + p2] = pk_bf16(bflo(xv) * d0, bfhi(xv) * d0);
                xd[(128 + j) * 32 + p2] = pk_bf16(bflo(xv) * d1, bfhi(xv) * d1);
            }
            __syncthreads();
            float acc[16];
#pragma unroll
            for (int p = 0; p < 16; ++p) acc[p] = 0.f;
            const float afi = af[hh * 128 + i], abi = ab[hh * 128 + i];
            for (int j = 0; j < 128; ++j) {
                const float gij = G[i * 129 + j];
                const float wf = (j <= i) ? gij * __expf(afi - af[hh * 128 + j]) : 0.f;
                const float wb = (j >= i) ? gij * __expf(abi - ab[hh * 128 + j]) : 0.f;
#pragma unroll
                for (int p2 = 0; p2 < 8; ++p2) {
                    const unsigned xf = xd[j * 32 + pq * 8 + p2], xb = xd[(128 + j) * 32 + pq * 8 + p2];
                    acc[2 * p2] += wf * bflo(xf) + wb * bflo(xb); acc[2 * p2 + 1] += wf * bfhi(xf) + wb * bfhi(xb);
                }
            }
#pragma unroll
            for (int dir = 0; dir < 2; ++dir) {
                const float* S = F.w<float>(WS_SSTART) + ((size_t)(dir * NCH + ch) * 6 + h) * 8192 + pq * 16;
                float tacc[16];
#pragma unroll
                for (int p = 0; p < 16; ++p) tacc[p] = 0.f;
                for (int n2 = 0; n2 < 64; ++n2) {
                    const unsigned cw_ = Cs[i * 65 + n2]; const float c0 = bflo(cw_), c1 = bfhi(cw_);
#pragma unroll
                    for (int p4 = 0; p4 < 4; ++p4) {
                        const f32x4 s0 = *(const f32x4*)(S + (size_t)(2 * n2) * 64 + p4 * 4), s1 = *(const f32x4*)(S + (size_t)(2 * n2 + 1) * 64 + p4 * 4);
#pragma unroll
                        for (int e = 0; e < 4; ++e) tacc[p4 * 4 + e] += c0 * s0[e] + c1 * s1[e];
                    }
                }
                const float ei = __expf(dir == 0 ? afi : abi);
#pragma unroll
                for (int p = 0; p < 16; ++p) acc[p] += ei * tacc[p];
            }
#pragma unroll
            for (int p = 0; p < 16; ++p) yacc[hh][p] = acc[p];
            __syncthreads();
        }
        float ss = 0.f;
#pragma unroll
        for (int hh = 0; hh < 3; ++hh) {
            const int h = g * 3 + hh; const float dsk = F.in[I_SSDD][l * 6 + h];
#pragma unroll
            for (int p = 0; p < 16; ++p) {
                const int chn = h * 64 + pq * 16 + p;
                const float xs = bf2f(XBC[(size_t)(row0 + i) * 896 + chn]);
                const float z = bf2f(P[(size_t)(row0 + i) * PC + CZ + chn]);
                const float v = (yacc[hh][p] + dsk * xs) * silu_f(z);
                yacc[hh][p] = v; ss += v * v;
            }
        }
        red[pq * 128 + i] = ss;
        __syncthreads();
        const float tot = red[i] + red[128 + i] + red[256 + i] + red[384 + i];
        const float rstd = rsqrtf(tot * (1.0f / 192.0f) + RMS_EPS);
#pragma unroll
        for (int hh = 0; hh < 3; ++hh) {
            const int h = g * 3 + hh;
            bf16_t* o = F.w<bf16_t>(WS_MIX) + (size_t)(row0 + i) * D + h * 64 + pq * 16;
            const float* ng = F.in[I_SSDNG] + l * 384 + h * 64 + pq * 16;
            u32x4 w0, w1;
            w0.x = pk_bf16(yacc[hh][0] * rstd * ng[0], yacc[hh][1] * rstd * ng[1]); w0.y = pk_bf16(yacc[hh][2] * rstd * ng[2], yacc[hh][3] * rstd * ng[3]);
            w0.z = pk_bf16(yacc[hh][4] * rstd * ng[4], yacc[hh][5] * rstd * ng[5]); w0.w = pk_bf16(yacc[hh][6] * rstd * ng[6], yacc[hh][7] * rstd * ng[7]);
            w1.x = pk_bf16(yacc[hh][8] * rstd * ng[8], yacc[hh][9] * rstd * ng[9]); w1.y = pk_bf16(yacc[hh][10] * rstd * ng[10], yacc[hh][11] * rstd * ng[11]);
            w1.z = pk_bf16(yacc[hh][12] * rstd * ng[12], yacc[hh][13] * rstd * ng[13]); w1.w = pk_bf16(yacc[hh][14] * rstd * ng[14], yacc[hh][15] * rstd * ng[15]);
            *(u32x4*)o = w0; *(u32x4*)(o + 8) = w1;
        }
    }
    (void)xdt;
}

__device__ __forceinline__ void ph_na(const Frame& F, int l) {
    LAS unsigned* Kb = (LAS unsigned*)F.lds;
    LAS unsigned* Vl = Kb + 256 * 33;
    LAS unsigned* Vc = Vl + 256 * 32;
    LAS float* Pr = (LAS float*)(Vc + 256 * 32);
    LAS float* Qs = Pr + 16 * 512;
    const bf16_t* P = F.w<bf16_t>(WS_P);
    const float* rpb = F.in[I_RPB] + (size_t)l * 15 * 31 * 6;
    const int nlat = 256 * 6 * 4, nitems = nlat + (l == 0 ? 96 : 0);
    const float scale = 0.125f;
    for (int it = F.bid; it < nitems; it += F.G) {
        const bool isctx = it >= nlat;
        int r = 0, h, cg, r0 = 0, kc0 = 0, qrow0;
        if (!isctx) { r = it / 24; const int rem = it % 24; h = rem >> 2; cg = rem & 3; r0 = min(max(r - 4, 0), 248); kc0 = min(max(16 * cg - 8, 0), 32); qrow0 = r * 64 + cg * 16; }
        else { const int q = it - nlat; h = q >> 4; cg = q & 15; qrow0 = L + cg * 16; }
        __syncthreads();
        for (int q = F.tid; q < 16 * 32; q += NTHREADS) { const int qi = q >> 5, d2 = q & 31; const unsigned w = *(const unsigned*)(P + (size_t)(qrow0 + qi) * PC + CQ + h * 64 + 2 * d2); Qs[qi * 64 + 2 * d2] = bflo(w); Qs[qi * 64 + 2 * d2 + 1] = bfhi(w); }
        for (int q = F.tid; q < 256 * 32; q += NTHREADS) {
            const int key = q >> 5, d2 = q & 31;
            if (!isctx) { const int krow = (r0 + (key >> 5)) * 64 + kc0 + (key & 31);
                Kb[key * 33 + d2] = *(const unsigned*)(P + (size_t)krow * PC + CK + h * 64 + 2 * d2);
                Vl[key * 32 + d2] = *(const unsigned*)(P + (size_t)krow * PC + CV + h * 64 + 2 * d2); }
            Vc[key * 32 + d2] = *(const unsigned*)(P + (size_t)(L + key) * PC + CV + h * 64 + 2 * d2);
        }
        __syncthreads();
        const int qi = F.tid >> 5, sub = F.tid & 31;
        float sl[8], sc[8];
        const int qcol = cg * 16 + qi;
        const int cstart = min(max(qcol - 8, 0), 48);
        if (!isctx) {
#pragma unroll
            for (int k = 0; k < 8; ++k) {
                const int key = sub + 32 * k;
                float s = 0.f;
                for (int d2 = 0; d2 < 32; ++d2) { const unsigned w = Kb[key * 33 + d2]; s += Qs[qi * 64 + 2 * d2] * bflo(w) + Qs[qi * 64 + 2 * d2 + 1] * bfhi(w); }
                const int kcol = kc0 + sub;
                const bool ok = (kcol >= cstart) && (kcol < cstart + 16);
                const int dr = r0 + k - r + 7, dc = min(max(kcol - qcol + 15, 0), 30);
                sl[k] = ok ? s * scale + rpb[(dr * 31 + dc) * 6 + h] : -INFINITY;
            }
        } else {
#pragma unroll
            for (int k = 0; k < 8; ++k) sl[k] = -INFINITY;
        }
        __syncthreads();
        for (int q = F.tid; q < 256 * 32; q += NTHREADS) { const int key = q >> 5, d2 = q & 31; Kb[key * 33 + d2] = *(const unsigned*)(P + (size_t)(L + key) * PC + CK + h * 64 + 2 * d2); }
        __syncthreads();
#pragma unroll
        for (int k = 0; k < 8; ++k) {
            const int key = sub + 32 * k;
            float s = 0.f;
            for (int d2 = 0; d2 < 32; ++d2) { const unsigned w = Kb[key * 33 + d2]; s += Qs[qi * 64 + 2 * d2] * bflo(w) + Qs[qi * 64 + 2 * d2 + 1] * bfhi(w); }
            sc[k] = s * scale;
        }
        float mx = -INFINITY;
#pragma unroll
        for (int k = 0; k < 8; ++k) mx = fmaxf(mx, fmaxf(sl[k], sc[k]));
#pragma unroll
        for (int o = 16; o >= 1; o >>= 1) mx = fmaxf(mx, __shfl_xor(mx, o));
        float sum = 0.f;
#pragma unroll
        for (int k = 0; k < 8; ++k) { sl[k] = __expf(sl[k] - mx); sc[k] = __expf(sc[k] - mx); sum += sl[k] + sc[k]; }
#pragma unroll
        for (int o = 16; o >= 1; o >>= 1) sum += __shfl_xor(sum, o);
        const float inv = 1.0f / sum;
#pragma unroll
        for (int k = 0; k < 8; ++k) { Pr[qi * 512 + sub + 32 * k] = sl[k] * inv; Pr[qi * 512 + 256 + sub + 32 * k] = sc[k] * inv; }
        __syncthreads();
        float o0 = 0.f, o1 = 0.f;
        if (!isctx) for (int key = 0; key < 256; ++key) { const float p = Pr[qi * 512 + key]; const unsigned w = Vl[key * 32 + sub]; o0 += p * bflo(w); o1 += p * bfhi(w); }
        for (int key = 0; key < 256; ++key) { const float p = Pr[qi * 512 + 256 + key]; const unsigned w = Vc[key * 32 + sub]; o0 += p * bflo(w); o1 += p * bfhi(w); }
        *(unsigned*)(F.w<bf16_t>(WS_MIX) + (size_t)(qrow0 + qi) * D + 384 + h * 64 + 2 * sub) = pk_bf16(o0, o1);
    }
}

__device__ __forceinline__ float hy_conv3(const bf16_t* P, const float* cw, const float* cb, int row, int seq_lo, int seq_hi, int col) {
    float s = cb[col];
#pragma unroll
    for (int k = 0; k < 3; ++k) { const int r = row + k - 1; if (r >= seq_lo && r < seq_hi) s += cw[k * 768 + col] * bf2f(P[(size_t)r * PC + CHY + col]); }
    return s;
}
__device__ __forceinline__ void ph_hy_prep(const Frame& F, int l) {
    const bf16_t* P = F.w<bf16_t>(WS_P);
    const float* cw = F.in[I_HCW] + (size_t)l * 3 * 768; const float* cb = F.in[I_HCB] + (size_t)l * 768;
    const int nrows = (l == 0) ? T : L;
    for (int rp = F.bid; rp < nrows / 2; rp += F.G) {
        const int row = rp * 2 + (F.tid >> 8), c = F.tid & 255;
        const int seq_lo = row < L ? 0 : L, seq_hi = row < L ? L : T;
        const float x1 = hy_conv3(P, cw, cb, row, seq_lo, seq_hi, 256 + c), v = hy_conv3(P, cw, cb, row, seq_lo, seq_hi, 512 + c);
        F.w<float>(WS_U)[(size_t)row * 256 + c] = v * x1;
    }
}
__device__ __forceinline__ void ph_hy_conv(const Frame& F, int l) {
    const bf16_t* P = F.w<bf16_t>(WS_P);
    const float* cw = F.in[I_HCW] + (size_t)l * 3 * 768; const float* cb = F.in[I_HCB] + (size_t)l * 768;
    const int nitems = 512 + (l == 0 ? 8 : 0);
    for (int it = F.bid; it < nitems; it += F.G) {
        const bool isctx = it >= 512;
        const int Lx = isctx ? LC : L, rbase = isctx ? L : 0;
        const int tb = (isctx ? it - 512 : it) * 2 + (F.tid >> 8), c = F.tid & 255, t0 = tb * 16;
        const float* U = F.w<float>(WS_U) + (size_t)rbase * 256 + c;
        const float* KC = (isctx ? F.w<float>(WS_KCOMBC) : F.w<float>(WS_KCOMB) + (size_t)l * 2 * L * 256) + c;
        float acc[16], wreg[16];
#pragma unroll
        for (int j = 0; j < 16; ++j) { acc[j] = 0.f; wreg[j] = KC[(size_t)(t0 + j + Lx - 1) * 256]; }
        for (int s0 = 0; s0 < Lx; s0 += 16) {
            float ub[16], nb[16];
#pragma unroll
            for (int r = 0; r < 16; ++r) { ub[r] = U[(size_t)(s0 + r) * 256]; const int x = t0 - (s0 + r + 1) + Lx - 1; nb[r] = x >= 0 ? KC[(size_t)x * 256] : 0.f; }
#pragma unroll
            for (int r = 0; r < 16; ++r) {
#pragma unroll
                for (int j = 0; j < 16; ++j) acc[j] += ub[r] * wreg[(j - r) & 15];
                wreg[(15 - r) & 15] = nb[r];
            }
        }
        const float inv = F.w<float>(WS_FSUM)[(isctx ? 2 : l) * 256 + c];
        const float db = F.in[I_HYD][l * 256 + c];
#pragma unroll
        for (int j = 0; j < 16; ++j) {
            const int row = rbase + t0 + j;
            const int seq_lo = isctx ? L : 0, seq_hi = isctx ? T : L;
            const float x0 = hy_conv3(P, cw, cb, row, seq_lo, seq_hi, c);
            const float u = F.w<float>(WS_U)[(size_t)row * 256 + c];
            F.w<bf16_t>(WS_MIX)[(size_t)row * D + 768 + c] = f2bf(x0 * (acc[j] * inv + u * db));
        }
    }
}

__device__ __forceinline__ void ph_post1(const Frame& F, int l) {
    LAS float* wr = (LAS float*)F.lds;
    LAS float* vec = wr + 32 * 1024;
    __syncthreads();
    for (int q = F.tid; q < 32 * 1024; q += NTHREADS) { const int k = q >> 5, e = q & 31; wr[e * 1024 + k] = F.in[I_WR][(size_t)l * 1024 * 32 + q]; }
    for (int q = F.tid; q < 2048; q += NTHREADS) {
        const int which = q >> 10, j = q & 1023;
        vec[(which * 3 + 0) * 1024 + j] = F.in[I_NORMG][(l * 4 + 1) * 1024 + j] * mod_val(F, l, which, 2 * 1024 + j);
        vec[(which * 3 + 1) * 1024 + j] = F.in[I_NORMG][(l * 4 + 2) * 1024 + j] * (1.0f + mod_val(F, l, which, 4 * 1024 + j));
        vec[(which * 3 + 2) * 1024 + j] = mod_val(F, l, which, 3 * 1024 + j);
    }
    __syncthreads();
    const int nrows = (l == 0) ? T : L;
    const int nwaves = F.G * 8;
    unsigned* cnt = F.w<unsigned>(WS_CTL) + CW_CNT + l * 32;
    for (int row = F.bid * 8 + F.wave; row < nrows; row += nwaves) {
        const int which = row >= L;
        const LAS float* v0 = vec + (which * 3) * 1024;
        f32x4 m[4], x[4];
        load_row(F.w<float>(WS_MIXO) + (size_t)row * D, F.lane, m);
        load_row(xrow_ptr(F, l, row), F.lane, x);
        const float rs1 = row_rstd(m);
#pragma unroll
        for (int i = 0; i < 4; ++i) { const f32x4 a = *(const LAS f32x4*)(v0 + 4 * F.lane + 256 * i); x[i] = x[i] + m[i] * rs1 * a; }
        float* xo = F.w<float>(WS_XCUR) + (size_t)row * D;
#pragma unroll
        for (int i = 0; i < 4; ++i) *(f32x4*)(xo + 4 * F.lane + 256 * i) = x[i];
        const float rs2 = row_rstd(x);
        f32x4 hv[4];
#pragma unroll
        for (int i = 0; i < 4; ++i) { const f32x4 a = *(const LAS f32x4*)(v0 + 1024 + 4 * F.lane + 256 * i), b = *(const LAS f32x4*)(v0 + 2048 + 4 * F.lane + 256 * i); hv[i] = x[i] * rs2 * a + b; }
        bf16_t* ho = F.w<bf16_t>(WS_H2) + (size_t)row * D;
#pragma unroll
        for (int i = 0; i < 4; ++i) { u32x2 w; w.x = pk_bf16(hv[i][0], hv[i][1]); w.y = pk_bf16(hv[i][2], hv[i][3]); *(u32x2*)(ho + 4 * F.lane + 256 * i) = w; }
        float mylogit = 0.f;
        for (int e = 0; e < 32; ++e) {
            float s = 0.f;
#pragma unroll
            for (int i = 0; i < 4; ++i) { const f32x4 w = *(const LAS f32x4*)(wr + e * 1024 + 4 * F.lane + 256 * i); s += hv[i][0] * w[0] + hv[i][1] * w[1] + hv[i][2] * w[2] + hv[i][3] * w[3]; }
            s = wave_sum(s);
            if (F.lane == e) mylogit = s + F.in[I_BR][l * 32 + e];
        }
        float cand = F.lane < 32 ? mylogit : -INFINITY;
        float tv[4]; int ti[4];
#pragma unroll
        for (int k = 0; k < 4; ++k) {
            float bv = cand; int bi = F.lane;
#pragma unroll
            for (int o = 32; o >= 1; o >>= 1) { const float ov = __shfl_xor(bv, o); const int oi = __shfl_xor(bi, o); if (ov > bv || (ov == bv && oi < bi)) { bv = ov; bi = oi; } }
            tv[k] = bv; ti[k] = bi;
            if (F.lane == bi) cand = -INFINITY;
        }
        const float e1 = __expf(tv[1] - tv[0]), e2 = __expf(tv[2] - tv[0]), e3 = __expf(tv[3] - tv[0]);
        const float inv = 1.0f / (1.0f + e1 + e2 + e3);
        if (F.lane < 4) {
            const int k = F.lane;
            const int e = k == 0 ? ti[0] : (k == 1 ? ti[1] : (k == 2 ? ti[2] : ti[3]));
            const float wgt = (k == 0 ? 1.0f : (k == 1 ? e1 : (k == 2 ? e2 : e3))) * inv;
            const unsigned pos = atomicAdd(cnt + e, 1u);
            F.w<int>(WS_RE)[row * 4 + k] = e; F.w<int>(WS_RP)[row * 4 + k] = (int)pos; F.w<float>(WS_RW)[row * 4 + k] = wgt;
        }
    }
}

__device__ __forceinline__ int expert_pad_start(const Frame& F, int l, int& ntiles) {
    const unsigned* cnt = F.w<unsigned>(WS_CTL) + CW_CNT + l * 32;
    int c = F.lane < 32 ? (int)__hip_atomic_load(cnt + F.lane, __ATOMIC_RELAXED, __HIP_MEMORY_SCOPE_AGENT) : 0;
    int padded = (c + 255) & ~255;
    int incl = padded;
#pragma unroll
    for (int o = 1; o < 32; o <<= 1) { const int v = __shfl_up(incl, o); if ((F.lane & 31) >= o) incl += v; }
    ntiles = __shfl(incl, 31) >> 8;
    return incl - padded;
}

__device__ __forceinline__ void ph_gather(const Frame& F, int l) {
    int ntiles; const int ps = expert_pad_start(F, l, ntiles);
    if (F.bid == 0 && F.wave == 0) {
        int* tab = F.w<int>(WS_CTL) + CW_TILE + l * 320;
        const int nxt = __shfl_down(ps, 1);
        const int endt = (F.lane == 31) ? ntiles : (nxt >> 8);
        if (F.lane < 32) for (int t = ps >> 8; t < endt; ++t) tab[t] = F.lane;
        if (F.lane == 0) F.w<int>(WS_CTL)[CW_NT + l] = ntiles;
    }
    const int nrows = (l == 0) ? T : L;
    const int nwaves = F.G * 8;
    for (int a = F.bid * 8 + F.wave; a < nrows * 4; a += nwaves) {
        const int row = a >> 2;
        const int e = F.w<int>(WS_RE)[a], pos = F.w<int>(WS_RP)[a];
        const int dst = __shfl(ps, e) + pos;
        if (F.lane == 0) F.w<int>(WS_SLOT)[a] = dst;
        const u32x4* s = (const u32x4*)(F.w<bf16_t>(WS_H2) + (size_t)row * D);
        u32x4* d = (u32x4*)(F.w<bf16_t>(WS_XG) + (size_t)dst * D);
        d[F.lane] = s[F.lane]; d[F.lane + 64] = s[F.lane + 64];
    }
}

__device__ __forceinline__ void ph_final(const Frame& F, int l) {
    LAS float* vec = (LAS float*)F.lds;
    __syncthreads();
    for (int q = F.tid; q < 2048; q += NTHREADS) { const int which = q >> 10, j = q & 1023; vec[q] = F.in[I_NORMG][(l * 4 + 3) * 1024 + j] * mod_val(F, l, which, 5 * 1024 + j); }
    if (l == 0) stage_norm_vecs(F, 1, 0, 0, 1, vec + 2048);
    __syncthreads();
    const int nrows = (l == 0) ? T : L;
    const int nwaves = F.G * 8;
    const bf16_t* Y = F.w<bf16_t>(WS_Y);
    for (int row = F.bid * 8 + F.wave; row < nrows; row += nwaves) {
        const int which = row >= L;
        f32x4 f[4];
#pragma unroll
        for (int i = 0; i < 4; ++i) f[i] = (f32x4){0.f, 0.f, 0.f, 0.f};
#pragma unroll
        for (int k = 0; k < 4; ++k) {
            const int slot = F.w<int>(WS_SLOT)[row * 4 + k]; const float wgt = F.w<float>(WS_RW)[row * 4 + k];
            const bf16_t* yr = Y + (size_t)slot * D;
#pragma unroll
            for (int i = 0; i < 4; ++i) { const u32x2 w = *(const u32x2*)(yr + 4 * F.lane + 256 * i); f[i][0] += wgt * bflo(w.x); f[i][1] += wgt * bfhi(w.x); f[i][2] += wgt * bflo(w.y); f[i][3] += wgt * bfhi(w.y); }
        }
        const float rs = row_rstd(f);
        f32x4 x[4]; load_row(F.w<float>(WS_XCUR) + (size_t)row * D, F.lane, x);
#pragma unroll
        for (int i = 0; i < 4; ++i) { const f32x4 a = *(const LAS f32x4*)(vec + which * 1024 + 4 * F.lane + 256 * i); x[i] = x[i] + f[i] * rs * a; }
        float* xo = (l == 1) ? F.out + (size_t)row * D : F.w<float>(WS_XCUR) + (size_t)row * D;
#pragma unroll
        for (int i = 0; i < 4; ++i) *(f32x4*)(xo + 4 * F.lane + 256 * i) = x[i];
        if (l == 0) {
            const float rstd = row_rstd(x);
            norm_store_bf16(x, rstd, vec + 2048 + (which * 2) * 1024, vec + 2048 + (which * 2 + 1) * 1024, F.w<bf16_t>(WS_HB) + (size_t)row * D, F.lane);
        }
    }
}

constexpr int PH_PER_LAYER = 10, N_PHASES = 2 + 2 * PH_PER_LAYER;
#ifndef PH_MASK
#define PH_MASK 0xFFFFFFFFu
#endif
#define EN(b) (((PH_MASK) >> (b)) & 1u)

__global__ void __launch_bounds__(NTHREADS, 2) mega(Args args) {
    extern __shared__ __attribute__((aligned(16))) unsigned char shm[];
    Frame F0;
    F0.in.kp = (kargp_t)__builtin_amdgcn_kernarg_segment_ptr();
    F0.out = args.out; F0.ws = args.ws; F0.lds = (LAS unsigned char*)shm;
    F0.tid = threadIdx.x; F0.lane = F0.tid & 63; F0.wave = __builtin_amdgcn_readfirstlane(F0.tid >> 6); F0.G = gridDim.x; F0.bid = blockIdx.x;
    volatile LAS unsigned* bst = (volatile LAS unsigned*)(shm + LDS_BYTES - 16);
    XcdBarrier bar; bar.bar = F0.w<unsigned>(WS_CTL) + CW_BAR; bar.x = 0; bar.st = bst;
#if N_LAUNCH_MODE == 1
    if (F0.tid == 0) { bst[0] = 0u; bst[1] = 0u; }
    __syncthreads();
    bar = xcd_barrier_post(F0.w<unsigned>(WS_CTL) + CW_BAR, bst);
#define GRID_BAR() xcd_barrier(bar)
#else
#define GRID_BAR() do {} while (0)
#endif
    const int lo = args.ph_lo, hi = args.ph_hi;
#define IN(k) (lo <= (k) && (k) < hi)
#define SEAM(k) do { if (IN(k) && IN((k) + 1)) GRID_BAR(); } while (0)

    if (IN(0)) { const Frame F = launder(F0); if (EN(0)) ph_convert(F); if (EN(1)) ph_modpart(F); if (EN(2)) ph_filter(F); }
    SEAM(0);
    if (IN(1)) { const Frame F = launder(F0); if (EN(3)) ph_norm1(F, 0); if (EN(4)) ph_fsum(F); }
    SEAM(1);
    for (int l = 0; l < 2; ++l) {
        const int pb = 2 + l * PH_PER_LAYER;
        if (EN(5) && IN(pb + 0)) { const Frame F = launder(F0);
            pg8::Gemm g{F.w<bf16_t>(WS_HB), F.w<bf16_t>(WS_WINT) + (size_t)l * PC * D, D};
            pg8::SchedGrid S{PC / 256, (T / 256) * (PC / 256), F.G, F.bid};
            pg8::EpiBf16 E{F.w<bf16_t>(WS_P), PC, nullptr, 0};
            pg8::gemm_phase<pg8::EpiBf16, pg8::SchedGrid>(F.lds, g, S, E, F.tid);
        }
        SEAM(pb + 0);
        if (IN(pb + 1)) { const Frame F = launder(F0); if (EN(6)) ph_ssd_prep(F, l); if (EN(7)) ph_hy_prep(F, l); if (EN(8)) ph_na(F, l); }
        SEAM(pb + 1);
        if (IN(pb + 2)) { const Frame F = launder(F0); if (EN(9)) ph_ssd_scan(F); if (EN(10)) ph_hy_conv(F, l); }
        SEAM(pb + 2);
        if (EN(11) && IN(pb + 3)) { const Frame F = launder(F0); ph_ssd_out(F, l); }
        SEAM(pb + 3);
        if (EN(12) && IN(pb + 4)) { const Frame F = launder(F0);
            pg8::Gemm g{F.w<bf16_t>(WS_MIX), F.w<bf16_t>(WS_WOUTT) + (size_t)l * D * D, D};
            const int nM = (l == 0) ? T / 256 : L / 256;
            pg8::SchedGrid S{4, nM * 4, F.G, F.bid};
            pg8::EpiF32 E{F.w<float>(WS_MIXO), D};
            pg8::gemm_phase<pg8::EpiF32, pg8::SchedGrid>(F.lds, g, S, E, F.tid);
        }
        SEAM(pb + 4);
        if (EN(13) && IN(pb + 5)) { const Frame F = launder(F0); ph_post1(F, l); }
        SEAM(pb + 5);
        if (EN(14) && IN(pb + 6)) { const Frame F = launder(F0); ph_gather(F, l); }
        SEAM(pb + 6);
        if (EN(15) && IN(pb + 7)) { const Frame F = launder(F0);
            const int* tab = F.w<int>(WS_CTL) + CW_TILE + l * 320;
            const int ntiles = __builtin_amdgcn_readfirstlane(F.w<int>(WS_CTL)[CW_NT + l]);
            pg8::Gemm g{F.w<bf16_t>(WS_XG), F.w<bf16_t>(WS_WGUT) + (size_t)l * NE * 2048 * D, D};
            pg8::SchedMoe S{8, ntiles * 8, F.G, F.bid, tab};
            pg8::EpiAct E{F.w<bf16_t>(WS_HMID), F.in[I_BGU] + (size_t)l * NE * 2048};
            pg8::gemm_phase<pg8::EpiAct, pg8::SchedMoe>(F.lds, g, S, E, F.tid);
        }
        SEAM(pb + 7);
        if (EN(16) && IN(pb + 8)) { const Frame F = launder(F0);
            const int* tab = F.w<int>(WS_CTL) + CW_TILE + l * 320;
            const int ntiles = __builtin_amdgcn_readfirstlane(F.w<int>(WS_CTL)[CW_NT + l]);
            pg8::Gemm g{F.w<bf16_t>(WS_HMID), F.w<bf16_t>(WS_WDT) + (size_t)l * NE * D * D, D};
            pg8::SchedMoe S{4, ntiles * 4, F.G, F.bid, tab};
            pg8::EpiBf16 E{F.w<bf16_t>(WS_Y), D, F.in[I_BDN] + (size_t)l * NE * D, D};
            pg8::gemm_phase<pg8::EpiBf16, pg8::SchedMoe>(F.lds, g, S, E, F.tid);
        }
        SEAM(pb + 8);
        if (EN(17) && IN(pb + 9)) { const Frame F = launder(F0); ph_final(F, l); }
        if (l == 0) SEAM(pb + 9);
    }
#undef IN
#undef SEAM
}

extern "C" void kernel_launch(void* const* d_in, const int* in_sizes, int n_in, void* d_out, int out_size, void* d_ws, size_t ws_size, hipStream_t stream) {
    static int grid = 0;
    if (grid == 0) {
        if (n_in != N_IN || out_size != L * D || ws_size < WS_END) { fprintf(stderr, "kernel_launch: unexpected shapes: n_in %d out %d ws %zu (need %zu)\n", n_in, out_size, ws_size, (size_t)WS_END); grid = -1; return; }
        int dev = 0, cus = 0, per_cu = 0;
        if (hipGetDevice(&dev) != hipSuccess || hipDeviceGetAttribute(&cus, hipDeviceAttributeMultiprocessorCount, dev) != hipSuccess) { grid = -1; return; }
        if (hipFuncSetAttribute((const void*)mega, hipFuncAttributeMaxDynamicSharedMemorySize, LDS_BYTES) != hipSuccess) { fprintf(stderr, "kernel_launch: hipFuncSetAttribute failed\n"); grid = -1; return; }
        if (hipOccupancyMaxActiveBlocksPerMultiprocessor(&per_cu, (const void*)mega, NTHREADS, LDS_BYTES) != hipSuccess || per_cu < 1) { fprintf(stderr, "kernel_launch: occupancy query says %d\n", per_cu); }
        (void)hipGetLastError();
        grid = cus;
    }
    if (grid < 0) return;
    (void)hipMemsetAsync((char*)d_ws + WS_CTL, 0, CTL_BYTES, stream);
    Args a{};
    for (int i = 0; i < N_IN; ++i) a.in[i] = (const float*)d_in[i];
    a.out = (float*)d_out; a.ws = (unsigned char*)d_ws;
#if N_LAUNCH_MODE == 1
    a.ph_lo = 0; a.ph_hi = N_PHASES;
    hipLaunchKernelGGL(mega, dim3(grid), dim3(NTHREADS), LDS_BYTES, stream, a);
#else
    for (int p = 0; p < N_PHASES; ++p) { a.ph_lo = p; a.ph_hi = p + 1; hipLaunchKernelGGL(mega, dim3(grid), dim3(NTHREADS), LDS_BYTES, stream, a); }
#endif
}
```

```cpp
#include <hip/hip_runtime.h>
#include <cstdio>
#include <cstdint>

#define LAS __attribute__((address_space(3)))
typedef unsigned short bf16_t;
typedef short bf16x8 __attribute__((ext_vector_type(8)));
typedef float f32x4 __attribute__((ext_vector_type(4)));
typedef unsigned u32x4 __attribute__((ext_vector_type(4)));
typedef unsigned u32x2 __attribute__((ext_vector_type(2)));

#ifndef N_LAUNCH_MODE
#define N_LAUNCH_MODE 1
#endif

constexpr int D = 1024, L = 16384, LC = 256, T = L + LC, NCH = T / 128;
constexpr int PC = 3328;
constexpr int CZ = 0, CXBC = 384, CQ = 1280, CK = 1664, CV = 2048, CHY = 2432, CDT = 3200;
constexpr int NE = 32;
constexpr int MAXT = 292;
constexpr int MAXROWS = MAXT * 256;
constexpr int NTHREADS = 512;
constexpr int LDS_BYTES = 160 * 1024;
constexpr float RMS_EPS = 1e-6f;

enum { I_X = 0, I_C, I_CTX, I_CCTX, I_WMOD, I_BMOD, I_NORMG, I_WIN, I_SCW, I_SCB, I_ALOG, I_DTB, I_SSDD, I_SSDNG, I_RPB, I_HCW, I_HCB,
       I_FW1, I_FB1, I_FW2, I_FB2, I_FW3, I_FREQ, I_HYD, I_WOUT, I_WR, I_BR, I_WGU, I_BGU, I_WDN, I_BDN, N_IN };

constexpr size_t al256(size_t x) { return (x + 255) & ~(size_t)255; }
constexpr size_t WS_CTL   = 0;
constexpr size_t CTL_BYTES = 64 * 1024;
constexpr size_t WS_WINT  = WS_CTL + CTL_BYTES;
constexpr size_t WS_WOUTT = WS_WINT + al256((size_t)2 * PC * D * 2);
constexpr size_t WS_WGUT  = WS_WOUTT + al256((size_t)2 * D * D * 2);
constexpr size_t WS_WDT   = WS_WGUT + al256((size_t)2 * NE * 2048 * D * 2);
constexpr size_t WS_MODP  = WS_WDT + al256((size_t)2 * NE * D * D * 2);
constexpr int KRL = 2 * L + 512;
constexpr size_t WS_KR    = WS_MODP + al256((size_t)2 * 2 * 16 * 6144 * 4);
constexpr size_t WS_KCOMBC= WS_KR + al256((size_t)2 * 256 * KRL * 2);
constexpr size_t WS_FPART = WS_KCOMBC + al256((size_t)2 * LC * 256 * 4);
constexpr size_t WS_FPARTC= WS_FPART + al256((size_t)2 * 256 * 512 * 4);
constexpr size_t WS_FSUM  = WS_FPARTC + al256((size_t)16 * 512 * 4);
constexpr size_t WS_HB    = WS_FSUM + al256((size_t)3 * 256 * 4);
constexpr size_t WS_P     = WS_HB + al256((size_t)T * D * 2);
constexpr size_t WS_XBC   = WS_P + al256((size_t)T * PC * 2);
constexpr size_t WS_DTV   = WS_XBC + al256((size_t)T * 896 * 2);
constexpr size_t WS_ACS   = WS_DTV + al256((size_t)T * 12 * 4);
constexpr size_t WS_ALAST = WS_ACS + al256((size_t)T * 12 * 4);
constexpr size_t WS_STATES= WS_ALAST + al256((size_t)NCH * 12 * 4);
constexpr size_t WS_SSTART= WS_STATES + al256((size_t)2 * NCH * 6 * 128 * 64 * 4);
constexpr size_t WS_U     = WS_SSTART + al256((size_t)2 * NCH * 6 * 128 * 64 * 4);
constexpr size_t WS_UT    = WS_U + al256((size_t)T * 256 * 4);
constexpr size_t WS_X0T   = WS_UT + al256((size_t)256 * L * 2);
constexpr size_t WS_YT    = WS_X0T + al256((size_t)256 * L * 2);
constexpr size_t WS_MIX   = WS_YT + al256((size_t)256 * L * 2);
constexpr size_t WS_MIXO  = WS_MIX + al256((size_t)T * D * 2);
constexpr size_t WS_XCUR  = WS_MIXO + al256((size_t)T * D * 4);
constexpr size_t WS_H2    = WS_XCUR + al256((size_t)T * D * 4);
constexpr size_t WS_RE    = WS_H2 + al256((size_t)T * D * 2);
constexpr size_t WS_RP    = WS_RE + al256((size_t)T * 4 * 4);
constexpr size_t WS_RW    = WS_RP + al256((size_t)T * 4 * 4);
constexpr size_t WS_SLOT  = WS_RW + al256((size_t)T * 4 * 4);
constexpr size_t WS_XG    = WS_SLOT + al256((size_t)T * 4 * 4);
constexpr size_t WS_HMID  = WS_XG + al256((size_t)MAXROWS * D * 2);
constexpr size_t WS_Y     = WS_HMID + al256((size_t)MAXROWS * D * 2);
constexpr size_t WS_END   = WS_Y + al256((size_t)MAXROWS * D * 2);

constexpr int CW_BAR = 0;
constexpr int CW_CNT = 4096;
constexpr int CW_NT = 4200;
constexpr int CW_TILE = 4224;

__device__ __forceinline__ float bf2f(unsigned short b) { return __uint_as_float(((unsigned)b) << 16); }
__device__ __forceinline__ unsigned short f2bf(float f) { unsigned u = __float_as_uint(f); u += 0x7FFFu + ((u >> 16) & 1u); return (unsigned short)(u >> 16); }
__device__ __forceinline__ unsigned pk_bf16(float lo, float hi) { return (unsigned)f2bf(lo) | ((unsigned)f2bf(hi) << 16); }
__device__ __forceinline__ float bflo(unsigned w) { return __uint_as_float(w << 16); }
__device__ __forceinline__ float bfhi(unsigned w) { return __uint_as_float(w & 0xFFFF0000u); }
__device__ __forceinline__ float silu_f(float x) { return x / (1.0f + __expf(-x)); }
__device__ __forceinline__ float softplus_f(float x) { return x > 20.f ? x : log1pf(__expf(x)); }
__device__ __forceinline__ float wave_sum(float v) {
#pragma unroll
    for (int o = 32; o >= 1; o >>= 1) v += __shfl_xor(v, o);
    return v;
}
__device__ __forceinline__ void lds_fence() { asm volatile("s_waitcnt lgkmcnt(0)" ::: "memory"); }

#define XB_TMO      128
#define XB_XCNT(j)  (256  + 64 * (j))
#define XB_XSUB(j)  (1280 + 64 * (j))
#define XB_XGEN(j)  (2304 + 64 * (j))
#define XB_TOP      3328
#define XB_TOPGEN   3392
#define XCD_BAR_WORDS 3456
#define XB_SPIN_CAP (1u << 18)
__device__ __forceinline__ unsigned xb_ld(unsigned* p)              { return __hip_atomic_load(p, __ATOMIC_RELAXED, __HIP_MEMORY_SCOPE_AGENT); }
__device__ __forceinline__ unsigned xb_add(unsigned* p, unsigned v) { return __hip_atomic_fetch_add(p, v, __ATOMIC_RELAXED, __HIP_MEMORY_SCOPE_AGENT); }
__device__ __forceinline__ unsigned xb_xcc_id() { return (unsigned)__builtin_amdgcn_s_getreg((3 << 11) | 20) & 0xFu; }
#define XB_SPIN(cond, bar) do { unsigned _sp = 0; while (cond) { __builtin_amdgcn_s_sleep(1); \
    if ((++_sp & 255u) == 0u) { if (xb_ld(&(bar)[XB_TMO])) break; if (_sp > XB_SPIN_CAP) { atomicAdd(&(bar)[XB_TMO], 1u); break; } } } } while (0)
struct XcdBarrier { unsigned* bar; unsigned x; volatile LAS unsigned* st; };
__device__ __forceinline__ XcdBarrier xcd_barrier_post(unsigned* bar, volatile LAS unsigned* st) {
    XcdBarrier b; b.bar = bar; b.x = xb_xcc_id(); b.st = st;
    if (threadIdx.x == 0) (void)xb_add(&bar[XB_XCNT(b.x)], 1u);
    return b;
}
__device__ __forceinline__ void xcd_barrier_complete(unsigned* bar, unsigned x, unsigned& nloc, unsigned& nx) {
    const unsigned G = gridDim.x * gridDim.y * gridDim.z;
    unsigned sum, cnt, mine, sp = 0u;
    for (;;) {
        sum = 0u; cnt = 0u; mine = 0u;
#pragma unroll
        for (unsigned j = 0; j < 16; ++j) { const unsigned c = xb_ld(&bar[XB_XCNT(j)]); sum += c; cnt += (c > 0u) ? 1u : 0u; mine = (j == x) ? c : mine; }
        if (sum == G) break;
        __builtin_amdgcn_s_sleep(1);
        if ((++sp & 255u) == 0u) { if (xb_ld(&bar[XB_TMO])) break; if (sp > XB_SPIN_CAP) { atomicAdd(&bar[XB_TMO], 1u); break; } }
    }
    nloc = mine > 0u ? mine : 1u; nx = cnt > 0u ? cnt : 1u;
}
__device__ __forceinline__ void xcd_barrier(const XcdBarrier& b) {
    asm volatile("s_waitcnt vmcnt(0)" ::: "memory");
    __syncthreads();
    if (threadIdx.x == 0) {
        unsigned* bar = b.bar;
        __builtin_amdgcn_s_waitcnt(0);
        unsigned nloc = b.st[0], nx = b.st[1];
        if (nloc == 0u) { xcd_barrier_complete(bar, b.x, nloc, nx); b.st[0] = nloc; b.st[1] = nx; }
        const unsigned old = xb_add(&bar[XB_XSUB(b.x)], 1u);
        const unsigned gen = old / nloc;
        if (old + 1u == (gen + 1u) * nloc) {
            __builtin_amdgcn_fence(__ATOMIC_RELEASE, "agent");
            asm volatile("s_waitcnt vmcnt(0)" ::: "memory");
            const unsigned og = xb_add(&bar[XB_TOP], 1u);
            const unsigned tg = og / nx;
            if (og + 1u == (tg + 1u) * nx) xb_add(&bar[XB_TOPGEN], 1u);
            else XB_SPIN(xb_ld(&bar[XB_TOPGEN]) == tg, bar);
            __builtin_amdgcn_fence(__ATOMIC_ACQUIRE, "agent");
            xb_add(&bar[XB_XGEN(b.x)], 1u);
            asm volatile("s_waitcnt vmcnt(0)" ::: "memory");
        } else {
            XB_SPIN(xb_ld(&bar[XB_XGEN(b.x)]) == gen, bar);
            __builtin_amdgcn_fence(__ATOMIC_ACQUIRE, "agent");
            asm volatile("s_waitcnt vmcnt(0)" ::: "memory");
        }
    }
    __syncthreads();
}

#ifndef GEMM_REP
#define GEMM_REP 1
#endif
namespace pg8 {
constexpr int BM = 256, BK = 64, HALF = 128, HTB = HALF * BK * 2, STAGE_BYTES = 8 * HTB;
__host__ __device__ __forceinline__ int lds_byte(int r, int c) { const int st = (r >> 4) * 2 + (c >> 5), rr = r & 15, cc = c & 31, ob = rr * 64 + cc * 2; return st * 1024 + (ob ^ (((ob >> 9) & 1) << 5)); }
__host__ __device__ __forceinline__ void stage_rc(int b, int& R, int& C) { const int st = b / 1024, sb = b % 1024, swz = sb ^ (((sb >> 9) & 1) << 5); R = (st >> 1) * 16 + swz / 64; C = (st & 1) * 32 + (swz % 64) / 2; }
__host__ __device__ __forceinline__ int perm32(int rho) { const int n = rho >> 4, i = rho & 15; return 8 * (i >> 2) + 4 * n + (i & 3); }

struct Unit { int pa, pb, pn, e; };
struct Gemm { const bf16_t* A; const bf16_t* Bt; int K; };

template <class Epi, class Sched, bool ALIGN_EPI = true>
__device__ __forceinline__ void gemm_phase(LAS unsigned char* lds, const Gemm g, const Sched& S, const Epi& E, const int tid) {
    const int wid = __builtin_amdgcn_readfirstlane(tid >> 6), lane = tid & 63, wr = wid >> 2, wc = wid & 3, fr = lane & 15, fq = lane >> 4;
    const int K = g.K, nt = K / BK;
    unsigned voffA[2], voffB[2];
#pragma unroll
    for (int i = 0; i < 2; ++i) { int R, C; stage_rc(tid * 16 + i * 8192, R, C); const int Rb = Epi::PERM ? ((R & ~31) + perm32(R & 31)) : R;
        voffA[i] = (unsigned)(R * K + C) * 2u; voffB[i] = (unsigned)(Rb * K + C) * 2u; }
    const size_t kstep = (size_t)(BK * 2);
    const size_t hstep = (size_t)HALF * K * 2;
    const size_t tstep = 2 * hstep;
    const unsigned ldsw = (unsigned)wid * 1024u;
    const int aoff = lds_byte(wr * 64 + fr, fq * 8), boff = lds_byte(wc * 32 + fr, fq * 8);
#define PG8_SA(b, h) (((b) * 2 + (h)) * HTB)
#define PG8_SB(b, h) ((4 + (b) * 2 + (h)) * HTB)
#define PG8_STAGE(bufoff, gbase, voff) do { _Pragma("unroll") for (int _i = 0; _i < 2; ++_i) \
        __builtin_amdgcn_global_load_lds((const unsigned*)((const char*)(gbase) + (voff)[_i]), (LAS unsigned*)(lds + (bufoff) + ldsw + _i * 8192), 16, 0, 0); } while (0)
#define PG8_LDA(dst, b, h) do { _Pragma("unroll") for (int m = 0; m < 4; ++m) _Pragma("unroll") for (int k = 0; k < 2; ++k) dst[m][k] = *(const LAS bf16x8*)(lds + PG8_SA(b, h) + aoff + m * 2048 + k * 1024); } while (0)
#define PG8_LDB(dst, b, h) do { _Pragma("unroll") for (int n = 0; n < 2; ++n) _Pragma("unroll") for (int k = 0; k < 2; ++k) dst[n][k] = *(const LAS bf16x8*)(lds + PG8_SB(b, h) + boff + n * 2048 + k * 1024); } while (0)
#define PG8_MMA(ai, bj, At, Bt) do { __builtin_amdgcn_s_setprio(1); _Pragma("unroll") for (int m = 0; m < 4; ++m) _Pragma("unroll") for (int n = 0; n < 2; ++n) _Pragma("unroll") for (int k = 0; k < 2; ++k) \
        acc[ai][bj][m][n] = __builtin_amdgcn_mfma_f32_16x16x32_bf16(Bt[n][k], At[m][k], acc[ai][bj][m][n], 0, 0, 0); __builtin_amdgcn_s_setprio(0); } while (0)
#define PG8_WAIT_V(n) asm volatile("s_waitcnt vmcnt(" #n ")" ::: "memory")
#define PG8_WAIT_L(n) asm volatile("s_waitcnt lgkmcnt(" #n ")" ::: "memory")
#define PG8_BAR __builtin_amdgcn_s_barrier()
#define PG8_SCHED __builtin_amdgcn_sched_barrier(0)
    Unit cur, nxt; int ui = 0;
    if (!S.next(0, cur)) return;
    f32x4 acc[2][2][4][2];
#pragma unroll
    for (int a = 0; a < 2; ++a)
#pragma unroll
        for (int b = 0; b < 2; ++b)
#pragma unroll
            for (int m = 0; m < 4; ++m)
#pragma unroll
                for (int n = 0; n < 2; ++n) acc[a][b][m][n] = (f32x4){0.f, 0.f, 0.f, 0.f};
    bf16x8 At[4][2], B0[2][2], B1[2][2];
    const char* cA = (const char*)g.A + (size_t)cur.pa * tstep; const char* cB = (const char*)g.Bt + (size_t)cur.pb * tstep;
    PG8_STAGE(PG8_SB(0, 0), cB, voffB); PG8_STAGE(PG8_SB(0, 1), cB + hstep, voffB); PG8_STAGE(PG8_SA(0, 0), cA, voffA); PG8_STAGE(PG8_SA(0, 1), cA + hstep, voffA);
    if (wr == 1) PG8_BAR;
    PG8_WAIT_V(2); PG8_BAR;
    PG8_STAGE(PG8_SB(1, 0), cB + kstep, voffB); PG8_STAGE(PG8_SA(1, 0), cA + kstep, voffA); PG8_STAGE(PG8_SB(1, 1), cB + hstep + kstep, voffB);
    PG8_WAIT_V(6); PG8_BAR;
    for (;;) {
        const bool has_next = S.next(ui + 1, nxt);
        const char* nA = has_next ? (const char*)g.A + (size_t)nxt.pa * tstep : cA; const char* nB = has_next ? (const char*)g.Bt + (size_t)nxt.pb * tstep : cB;
        for (int t = 0; t < nt; t += 2) {
            const bool last = (t == nt - 2);
            const char* a1 = cA + (size_t)(t + 1) * kstep;
            const char* a2 = last ? nA : cA + (size_t)(t + 2) * kstep; const char* b2 = last ? nB : cB + (size_t)(t + 2) * kstep;
            const char* a3 = a2 + kstep; const char* b3 = b2 + kstep;
            PG8_LDB(B0, 0, 0); PG8_LDB(B1, 0, 1); PG8_SCHED; PG8_LDA(At, 0, 0); PG8_STAGE(PG8_SA(1, 1), a1 + hstep, voffA);
            PG8_WAIT_V(8); PG8_WAIT_L(0); PG8_BAR; PG8_MMA(0, 0, At, B0); PG8_MMA(0, 1, At, B1); PG8_BAR; PG8_SCHED;
            PG8_LDA(At, 0, 1); PG8_STAGE(PG8_SB(0, 0), b2, voffB); PG8_STAGE(PG8_SB(0, 1), b2 + hstep, voffB); PG8_STAGE(PG8_SA(0, 0), a2, voffA);
            PG8_WAIT_V(8); PG8_WAIT_L(0); PG8_BAR; PG8_MMA(1, 0, At, B0); PG8_MMA(1, 1, At, B1); PG8_BAR; PG8_SCHED;
            PG8_LDB(B0, 1, 0); PG8_LDB(B1, 1, 1); PG8_SCHED; PG8_LDA(At, 1, 0); PG8_STAGE(PG8_SA(0, 1), a2 + hstep, voffA);
            PG8_WAIT_V(8); PG8_WAIT_L(0); PG8_BAR; PG8_MMA(0, 0, At, B0); PG8_MMA(0, 1, At, B1); PG8_BAR; PG8_SCHED;
            PG8_LDA(At, 1, 1); PG8_STAGE(PG8_SB(1, 0), b3, voffB); PG8_STAGE(PG8_SB(1, 1), b3 + hstep, voffB); PG8_STAGE(PG8_SA(1, 0), a3, voffA);
            PG8_WAIT_V(8); PG8_WAIT_L(0); PG8_BAR; PG8_MMA(1, 0, At, B0); PG8_MMA(1, 1, At, B1); PG8_BAR; PG8_SCHED;
        }
        if constexpr (ALIGN_EPI) { if (wr == 0) PG8_BAR; }
        E(acc, cur, wr, wc, fr, fq);
        if (!has_next) break;
#pragma unroll
        for (int a = 0; a < 2; ++a)
#pragma unroll
            for (int b = 0; b < 2; ++b)
#pragma unroll
                for (int m = 0; m < 4; ++m)
#pragma unroll
                    for (int n = 0; n < 2; ++n) acc[a][b][m][n] = (f32x4){0.f, 0.f, 0.f, 0.f};
        cur = nxt; cA = nA; cB = nB; ++ui;
        if constexpr (ALIGN_EPI) { if (wr == 1) PG8_BAR; }
    }
    PG8_WAIT_V(0);
    if constexpr (!ALIGN_EPI) { if (wr == 0) PG8_BAR; }
    PG8_BAR;
#undef PG8_SA
#undef PG8_SB
#undef PG8_STAGE
#undef PG8_LDA
#undef PG8_LDB
#undef PG8_MMA
#undef PG8_WAIT_V
#undef PG8_WAIT_L
#undef PG8_BAR
#undef PG8_SCHED
}

struct EpiF32 {
    static constexpr bool PERM = false;
    float* C; int ldc;
    __device__ __forceinline__ void operator()(const f32x4 (&acc)[2][2][4][2], const Unit& u, int wr, int wc, int fr, int fq) const {
        const int row0 = u.pa * BM + wr * 64 + fr, col0 = u.pn * BM + wc * 32 + 4 * fq;
#pragma unroll
        for (int ai = 0; ai < 2; ++ai)
#pragma unroll
            for (int m = 0; m < 4; ++m) { float* rowp = C + (size_t)(row0 + ai * HALF + m * 16) * ldc + col0;
#pragma unroll
                for (int bj = 0; bj < 2; ++bj)
#pragma unroll
                    for (int n = 0; n < 2; ++n) *(f32x4*)(rowp + bj * HALF + n * 16) = acc[ai][bj][m][n]; }
    }
};
struct EpiBf16 {
    static constexpr bool PERM = true;
    bf16_t* O; int ldc; const float* bias; int bias_stride;
    __device__ __forceinline__ void operator()(const f32x4 (&acc)[2][2][4][2], const Unit& u, int wr, int wc, int fr, int fq) const {
        const int row0 = u.pa * BM + wr * 64 + fr; const int col0 = u.pn * BM + wc * 32 + 8 * fq;
        f32x4 bv[2][2];
#pragma unroll
        for (int bj = 0; bj < 2; ++bj)
#pragma unroll
            for (int n = 0; n < 2; ++n) bv[bj][n] = bias ? *(const f32x4*)(bias + (size_t)u.e * bias_stride + col0 + bj * HALF + 4 * n) : (f32x4){0.f, 0.f, 0.f, 0.f};
#pragma unroll
        for (int ai = 0; ai < 2; ++ai)
#pragma unroll
            for (int m = 0; m < 4; ++m) { bf16_t* rowp = O + (size_t)(row0 + ai * HALF + m * 16) * ldc + col0;
#pragma unroll
                for (int bj = 0; bj < 2; ++bj) { const f32x4 v0 = acc[ai][bj][m][0] + bv[bj][0], v1 = acc[ai][bj][m][1] + bv[bj][1];
                    u32x4 w; w.x = pk_bf16(v0[0], v0[1]); w.y = pk_bf16(v0[2], v0[3]); w.z = pk_bf16(v1[0], v1[1]); w.w = pk_bf16(v1[2], v1[3]);
                    *(u32x4*)(rowp + bj * HALF) = w; } }
    }
};
struct EpiAct {
    static constexpr bool PERM = true;
    bf16_t* O; const float* bias;
    __device__ __forceinline__ void operator()(const f32x4 (&acc)[2][2][4][2], const Unit& u, int wr, int wc, int fr, int fq) const {
        const int row0 = u.pa * BM + wr * 64 + fr; const int cc0 = wc * 32 + 8 * fq; const int ocol = u.pn * 128 + cc0;
        const float* bg = bias + (size_t)u.e * 2048 + ocol; const float* bu = bg + 1024;
        f32x4 bgv[2], buv[2];
#pragma unroll
        for (int n = 0; n < 2; ++n) { bgv[n] = *(const f32x4*)(bg + 4 * n); buv[n] = *(const f32x4*)(bu + 4 * n); }
#pragma unroll
        for (int ai = 0; ai < 2; ++ai)
#pragma unroll
            for (int m = 0; m < 4; ++m) { bf16_t* rowp = O + (size_t)(row0 + ai * HALF + m * 16) * D + ocol;
                float r[8];
#pragma unroll
                for (int n = 0; n < 2; ++n)
#pragma unroll
                    for (int j = 0; j < 4; ++j) { float gt = acc[ai][0][m][n][j] + bgv[n][j], up = acc[ai][1][m][n][j] + buv[n][j];
                        gt = fminf(gt, 7.0f); up = fminf(fmaxf(up, -7.0f), 7.0f);
                        r[n * 4 + j] = gt / (1.0f + __expf(-1.702f * gt)) * (up + 1.0f); }
                u32x4 w; w.x = pk_bf16(r[0], r[1]); w.y = pk_bf16(r[2], r[3]); w.z = pk_bf16(r[4], r[5]); w.w = pk_bf16(r[6], r[7]);
                *(u32x4*)rowp = w; }
    }
};
struct SchedGrid {
    int nN, total, G, c;
    __device__ __forceinline__ bool next(int i, Unit& u) const { int Lx = i * G + c; if (Lx >= GEMM_REP * total) return false; if (GEMM_REP > 1) Lx %= total; u.pa = Lx / nN; u.pn = Lx - u.pa * nN; u.pb = u.pn; u.e = 0; return true; }
};
struct SchedMoe {
    int nN, total, G, c; const int* tile_e;
    __device__ __forceinline__ bool next(int i, Unit& u) const { int Lx = i * G + c; if (Lx >= GEMM_REP * total) return false; if (GEMM_REP > 1) Lx %= total; u.pa = Lx / nN; u.pn = Lx - u.pa * nN; u.e = __builtin_amdgcn_readfirstlane((int)tile_e[u.pa]); u.pb = u.e * nN + u.pn; return true; }
};
}

struct Args { const float* in[N_IN]; float* out; unsigned char* ws; int ph_lo, ph_hi; };

typedef const float* __attribute__((address_space(4))) const* kargp_t;
struct InProxy { kargp_t kp; __device__ __forceinline__ const float* operator[](int i) const { return kp[i]; } };
struct Frame {
    InProxy in; float* out; unsigned char* ws;
    LAS unsigned char* lds;
    int tid, lane, wave, G, bid;
    template <class Tp> __device__ __forceinline__ Tp* w(size_t off) const { return (Tp*)(ws + off); }
};

__device__ __forceinline__ Frame launder(const Frame& F) {
    Frame R = F;
    int t = F.tid; asm volatile("" : "+v"(t)); R.tid = t; R.lane = t & 63; R.wave = __builtin_amdgcn_readfirstlane(t >> 6);
    unsigned long long w = (unsigned long long)F.ws; asm volatile("" : "+s"(w)); R.ws = (unsigned char*)w;
    unsigned long long o = (unsigned long long)F.out; asm volatile("" : "+s"(o)); R.out = (float*)o;
    unsigned long long k = (unsigned long long)F.in.kp; asm volatile("" : "+s"(k)); R.in.kp = (kargp_t)k;
    int g = F.G, b = F.bid; asm volatile("" : "+s"(g), "+s"(b)); R.G = g; R.bid = b;
    return R;
}

__device__ __forceinline__ float mod_val(const Frame& F, int l, int which, int j) {
    const float* mp = F.w<float>(WS_MODP) + (size_t)((l * 2 + which) * 16) * 6144 + j;
    float s = F.in[I_BMOD][l * 6144 + j];
#pragma unroll
    for (int k = 0; k < 16; ++k) s += mp[(size_t)k * 6144];
    return s;
}

__device__ __forceinline__ void convert_tile(const float* __restrict__ src, int ld, int k0, int n0, int mode, bf16_t* __restrict__ dst, LAS unsigned* lw, int lane) {
    const int i4 = lane & 15, kpl = lane >> 4;
    const int n = n0 + 4 * i4;
    int sc; bool valid = true;
    if (mode == 0) sc = n;
    else if (mode == 1) { if (n < 1280) sc = n; else if (n < 3200) sc = n + 12; else if (n < 3212) sc = n - 3200 + 1280; else { sc = 0; valid = false; } }
    else { const int pn = n >> 8, rr = n & 255; sc = rr < 128 ? pn * 128 + rr : 1024 + pn * 128 + (rr - 128); }
#pragma unroll
    for (int it = 0; it < 8; ++it) {
        const int kp = kpl + 4 * it;
        f32x4 a = (f32x4){0.f, 0.f, 0.f, 0.f}, b = a;
        if (valid) { a = *(const f32x4*)(src + (size_t)(k0 + 2 * kp) * ld + sc); b = *(const f32x4*)(src + (size_t)(k0 + 2 * kp + 1) * ld + sc); }
#pragma unroll
        for (int i = 0; i < 4; ++i) lw[kp * 65 + 4 * i4 + i] = pk_bf16(a[i], b[i]);
    }
    lds_fence();
    const int g = lane & 7, nl = lane >> 3;
#pragma unroll
    for (int it = 0; it < 8; ++it) {
        const int nn = nl + 8 * it;
        u32x4 v; v.x = lw[(4 * g + 0) * 65 + nn]; v.y = lw[(4 * g + 1) * 65 + nn]; v.z = lw[(4 * g + 2) * 65 + nn]; v.w = lw[(4 * g + 3) * 65 + nn];
        *(u32x4*)(dst + (size_t)(n0 + nn) * 1024 + k0 + 8 * g) = v;
    }
    lds_fence();
}

__device__ __forceinline__ void ph_convert(const Frame& F) {
    LAS unsigned* lw = (LAS unsigned*)(F.lds) + F.wave * (32 * 65 + 16);
    const int nwaves = F.G * 8, w0 = F.bid * 8 + F.wave;
    for (int t = w0; t < 51328; t += nwaves) {
        const float* src; bf16_t* dst; int ld, mode, k0, n0;
        if (t < 1664) { const int l = t / 832, r = t % 832; n0 = (r / 16) * 64; k0 = (r % 16) * 64; src = F.in[I_WIN] + (size_t)l * 1024 * 3212; ld = 3212; mode = 1; dst = F.w<bf16_t>(WS_WINT) + (size_t)l * PC * D; }
        else if (t < 2176) { const int q = t - 1664, l = q / 256, r = q % 256; n0 = (r / 16) * 64; k0 = (r % 16) * 64; src = F.in[I_WOUT] + (size_t)l * D * D; ld = 1024; mode = 0; dst = F.w<bf16_t>(WS_WOUTT) + (size_t)l * D * D; }
        else if (t < 34944) { const int q = t - 2176, le = q / 512, r = q % 512; n0 = (r / 16) * 64; k0 = (r % 16) * 64; src = F.in[I_WGU] + (size_t)le * 1024 * 2048; ld = 2048; mode = 2; dst = F.w<bf16_t>(WS_WGUT) + (size_t)le * 2048 * D; }
        else { const int q = t - 34944, le = q / 256, r = q % 256; n0 = (r / 16) * 64; k0 = (r % 16) * 64; src = F.in[I_WDN] + (size_t)le * D * D; ld = 1024; mode = 0; dst = F.w<bf16_t>(WS_WDT) + (size_t)le * D * D; }
        convert_tile(src, ld, k0, n0, mode, dst, lw, F.lane);
    }
}

__device__ __forceinline__ void ph_modpart(const Frame& F) {
    for (int it = F.bid; it < 384; it += F.G) {
        const int l = it / 192, r = it % 192, cc = r / 16, kc = r % 16;
        const int j = cc * 512 + F.tid;
        const float* wm = F.in[I_WMOD] + (size_t)l * D * 6144 + j;
        float a0 = 0.f, a1 = 0.f;
        for (int k = kc * 64; k < kc * 64 + 64; ++k) {
            const float wv = wm[(size_t)k * 6144];
            a0 += silu_f(F.in[I_C][k]) * wv; a1 += silu_f(F.in[I_CCTX][k]) * wv;
        }
        float* mp = F.w<float>(WS_MODP);
        mp[(size_t)((l * 2 + 0) * 16 + kc) * 6144 + j] = a0;
        mp[(size_t)((l * 2 + 1) * 16 + kc) * 6144 + j] = a1;
    }
}

__device__ __forceinline__ void ph_filter(const Frame& F) {
    LAS float* zs = (LAS float*)F.lds;
    LAS float* h1 = zs + 64 * 33;
    LAS float* h2 = h1 + 64 * 64;
    LAS bf16_t* ob = (LAS bf16_t*)(h2 + 64 * 64);
    const float min_decay = -4.605170185988091f / 1.5f, max_decay = -4.605170185988091f / 0.3f;
    for (int it = F.bid; it < 512 + 16; it += F.G) {
        const bool isctx = it >= 512;
        const int l = isctx ? 0 : it / 256, grp = isctx ? it - 512 : it % 256;
        const int Lx = isctx ? LC : L, npos = isctx ? 16 : 64;
        const int t0 = grp * npos;
        __syncthreads();
        for (int q = F.tid; q < npos * 33; q += NTHREADS) {
            const int pos = q / 33, i = q % 33; const int t = t0 + pos;
            const float tn = (float)t / (float)(Lx - 1);
            const float wv = 6.283185307179586f * (float)t / (float)Lx;
            float v;
            if (i == 0) v = tn;
            else { const int b = (i - 1) & 15; const float f = 1e-4f + (float)b * ((15.0f - 1e-4f) / 15.0f); v = (i <= 16) ? cosf(f * wv) : -sinf(f * wv); }
            zs[q] = v;
        }
        __syncthreads();
        for (int q = F.tid; q < npos * 64; q += NTHREADS) {
            const int pos = q >> 6, o = q & 63;
            float s = F.in[I_FB1][l * 64 + o];
            for (int i = 0; i < 33; ++i) s += zs[pos * 33 + i] * F.in[I_FW1][(size_t)l * 33 * 64 + i * 64 + o];
            h1[q] = sinf(F.in[I_FREQ][l * 128 + o] * s);
        }
        __syncthreads();
        for (int q = F.tid; q < npos * 64; q += NTHREADS) {
            const int pos = q >> 6, o = q & 63;
            float s = F.in[I_FB2][l * 64 + o];
            for (int i = 0; i < 64; ++i) s += h1[pos * 64 + i] * F.in[I_FW2][(size_t)l * 64 * 64 + i * 64 + o];
            h2[q] = sinf(F.in[I_FREQ][l * 128 + 64 + o] * s);
        }
        __syncthreads();
        {
            const int o = F.tid, c = o & 255, dir = o >> 8;
            const float* w3 = F.in[I_FW3] + (size_t)l * 64 * 512 + o;
            const float delta = fabsf(min_decay + (float)c * ((max_decay - min_decay) / 255.0f));
            float asum = 0.f;
            for (int sg = 0; sg < npos / 16; ++sg) {
                float acc[16];
#pragma unroll
                for (int p = 0; p < 16; ++p) acc[p] = 0.f;
                for (int k = 0; k < 64; ++k) { const float wv = w3[k * 512];
#pragma unroll
                    for (int p = 0; p < 16; ++p) acc[p] += h2[(sg * 16 + p) * 64 + k] * wv; }
#pragma unroll
                for (int p = 0; p < 16; ++p) {
                    const int t = t0 + sg * 16 + p; const float tn = (float)t / (float)(Lx - 1);
                    const float v = acc[p] * __expf(-tn * delta);
                    asum += fabsf(v);
                    if (isctx) { float* kc = F.w<float>(WS_KCOMBC);
                        if (dir == 0) kc[(size_t)(Lx - 1 + t) * 256 + c] = v; else if (t >= 1) kc[(size_t)(Lx - 1 - t) * 256 + c] = v; }
                    else ob[o * 66 + sg * 16 + p] = f2bf(v);
                }
            }
            if (isctx) F.w<float>(WS_FPARTC)[grp * 512 + o] = asum;
            else F.w<float>(WS_FPART)[((size_t)l * 256 + grp) * 512 + o] = asum;
        }
        if (!isctx) {
            __syncthreads();
            bf16_t* KR = F.w<bf16_t>(WS_KR) + (size_t)l * 256 * KRL;
            for (int q = F.tid; q < 512 * 64; q += NTHREADS) {
                const int o = q >> 6, p = q & 63, c = o & 255, dir = o >> 8;
                if (dir == 0) KR[(size_t)c * KRL + (L - t0 - 63 + p)] = ob[o * 66 + 63 - p];
                else if (t0 + p >= 1) KR[(size_t)c * KRL + (L + t0 + p)] = ob[o * 66 + p];
            }
            if (grp == 0) for (int q = F.tid; q < 256 * 513; q += NTHREADS) { const int c = q / 513, r = q % 513; KR[(size_t)c * KRL + (r == 512 ? 0 : 2 * L + r)] = 0; }
        }
    }
}

__device__ __forceinline__ void ph_fsum(const Frame& F) {
    const int nwaves = F.G * 8;
    for (int o = F.bid * 8 + F.wave; o < 768; o += nwaves) {
        const int which = o >> 8, c = o & 255;
        float s = 0.f;
        if (which < 2) { const float* fp = F.w<float>(WS_FPART) + (size_t)which * 256 * 512;
            for (int i = F.lane; i < 256; i += 64) s += fp[(size_t)i * 512 + c] + fp[(size_t)i * 512 + 256 + c]; }
        else { const float* fp = F.w<float>(WS_FPARTC); if (F.lane < 16) s = fp[F.lane * 512 + c] + fp[F.lane * 512 + 256 + c]; }
        s = wave_sum(s);
        if (F.lane == 0) F.w<float>(WS_FSUM)[o] = 1.0f / s;
    }
}

__device__ __forceinline__ void load_row(const float* p, int lane, f32x4 (&v)[4]) {
#pragma unroll
    for (int i = 0; i < 4; ++i) v[i] = *(const f32x4*)(p + 4 * lane + 256 * i);
}
__device__ __forceinline__ float row_rstd(const f32x4 (&v)[4]) {
    float s = 0.f;
#pragma unroll
    for (int i = 0; i < 4; ++i) s += v[i][0] * v[i][0] + v[i][1] * v[i][1] + v[i][2] * v[i][2] + v[i][3] * v[i][3];
    s = wave_sum(s);
    return rsqrtf(s * (1.0f / 1024.0f) + RMS_EPS);
}
__device__ __forceinline__ void stage_norm_vecs(const Frame& F, int l, int gain_idx, int sh_seg, int sc_seg, LAS float* dst  ) {
    for (int q = F.tid; q < 2048; q += NTHREADS) {
        const int which = q >> 10, j = q & 1023;
        const float g = F.in[I_NORMG][(l * 4 + gain_idx) * 1024 + j];
        dst[(which * 2 + 0) * 1024 + j] = g * (1.0f + mod_val(F, l, which, sc_seg * 1024 + j));
        dst[(which * 2 + 1) * 1024 + j] = mod_val(F, l, which, sh_seg * 1024 + j);
    }
}
__device__ __forceinline__ void norm_store_bf16(const f32x4 (&v)[4], float rstd, const LAS float* va, const LAS float* vb, bf16_t* orow, int lane) {
#pragma unroll
    for (int i = 0; i < 4; ++i) {
        const int c = 4 * lane + 256 * i;
        const f32x4 a = *(const LAS f32x4*)(va + c), b = *(const LAS f32x4*)(vb + c);
        u32x2 w; w.x = pk_bf16(v[i][0] * rstd * a[0] + b[0], v[i][1] * rstd * a[1] + b[1]); w.y = pk_bf16(v[i][2] * rstd * a[2] + b[2], v[i][3] * rstd * a[3] + b[3]);
        *(u32x2*)(orow + c) = w;
    }
}
__device__ __forceinline__ const float* xrow_ptr(const Frame& F, int l, int row) {
    if (l == 0) return row < L ? F.in[I_X] + (size_t)row * D : F.in[I_CTX] + (size_t)(row - L) * D;
    return F.w<float>(WS_XCUR) + (size_t)row * D;
}
__device__ __forceinline__ void ph_norm1(const Frame& F, int l) {
    LAS float* vec = (LAS float*)F.lds;
    __syncthreads();
    stage_norm_vecs(F, l, 0, 0, 1, vec);
    __syncthreads();
    const int nwaves = F.G * 8;
    for (int row = F.bid * 8 + F.wave; row < T; row += nwaves) {
        const int which = row >= L;
        f32x4 v[4]; load_row(xrow_ptr(F, l, row), F.lane, v);
        const float rstd = row_rstd(v);
        norm_store_bf16(v, rstd, vec + (which * 2) * 1024, vec + (which * 2 + 1) * 1024, F.w<bf16_t>(WS_HB) + (size_t)row * D, F.lane);
    }
}

typedef float f32x16 __attribute__((ext_vector_type(16)));
constexpr int SROW = 272;
__device__ __forceinline__ bf16x8 lds_frag(const LAS unsigned char* base, int row, int k) { return *(const LAS bf16x8*)(base + row * SROW + k * 2); }
__device__ __forceinline__ void ph_ssd_prep(const Frame& F, int l) {
    LAS unsigned char* BT = F.lds;
    LAS unsigned char* XW = F.lds + 34816;
    LAS float* dts = (LAS float*)(F.lds + 139264);
    LAS float* wj  = dts + 768;
    const bf16_t* P = F.w<bf16_t>(WS_P);
    const int lane = F.lane, wave = F.wave;
    for (int it = F.bid; it < NCH * 2; it += F.G) {
        const int ch = it >> 1, g = it & 1;
        const int row0 = ch * 128;
        const int seq_lo = ch < 128 ? 0 : L, seq_hi = ch < 128 ? L : T;
        int r = lane & 31, hf = lane >> 5; asm volatile("" : "+v"(r), "+v"(hf));
        __syncthreads();
        if (wave < 6) {
            const int hh = wave >> 1, dir = wave & 1, h = g * 3 + hh;
            const float a = -__expf(F.in[I_ALOG][(l * 2 + dir) * 6 + h]), bias = F.in[I_DTB][(l * 2 + dir) * 6 + h];
            const int j0 = 2 * lane;
            const float d0 = softplus_f(bf2f(P[(size_t)(row0 + j0) * PC + CDT + dir * 6 + h]) + bias);
            const float d1 = softplus_f(bf2f(P[(size_t)(row0 + j0 + 1) * PC + CDT + dir * 6 + h]) + bias);
            const float pair = (d0 + d1) * a;
            float incl = pair;
#pragma unroll
            for (int o = 1; o < 64; o <<= 1) {
                const float v = dir == 0 ? __shfl_up(incl, o) : __shfl_down(incl, o);
                const bool okl = dir == 0 ? (lane >= o) : (lane + o < 64);
                if (okl) incl += v;
            }
            const float total = __shfl(incl, dir == 0 ? 63 : 0);
            float acs0, acs1;
            if (dir == 0) { acs1 = incl; acs0 = incl - d1 * a; }
            else { acs0 = incl; acs1 = incl - d0 * a; }
            float* dtv = F.w<float>(WS_DTV) + (size_t)(row0 + j0) * 12 + dir * 6 + h; dtv[0] = d0; dtv[12] = d1;
            float* acv = F.w<float>(WS_ACS) + (size_t)(row0 + j0) * 12 + dir * 6 + h; acv[0] = acs0; acv[12] = acs1;
            if (lane == 0) F.w<float>(WS_ALAST)[ch * 12 + dir * 6 + h] = total;
            dts[wave * 128 + j0] = d0; dts[wave * 128 + j0 + 1] = d1;
            wj[wave * 128 + j0] = __expf(total - acs0) * d0; wj[wave * 128 + j0 + 1] = __expf(total - acs1) * d1;
        }
        __syncthreads();
        if (F.tid < 448) {
            const int pr = F.tid % 224, half = F.tid / 224;
            const int chn = pr < 96 ? g * 192 + 2 * pr : (pr < 160 ? 384 + g * 128 + 2 * (pr - 96) : 640 + g * 128 + 2 * (pr - 160));
            const float* cw = F.in[I_SCW] + (size_t)l * 5 * 896 + chn; const float* cb = F.in[I_SCB] + (size_t)l * 896 + chn;
            float w0[5], w1[5];
#pragma unroll
            for (int k = 0; k < 5; ++k) { w0[k] = cw[k * 896]; w1[k] = cw[k * 896 + 1]; }
            const float b0 = cb[0], b1 = cb[1];
            const int jb = half * 64;
            const bf16_t* src = P + CXBC + chn;
            unsigned win[5];
#pragma unroll
            for (int k = 0; k < 4; ++k) { const int rr = row0 + jb + k - 2; win[k + 1] = (rr >= seq_lo && rr < seq_hi) ? *(const unsigned*)(src + (size_t)rr * PC) : 0u; }
            const int hh = pr / 32;
            const int pch = 2 * (pr & 31);
            for (int jj = 0; jj < 64; jj += 2) {
                float s0[2], s1[2];
#pragma unroll
                for (int u = 0; u < 2; ++u) {
                    const int j = jb + jj + u;
#pragma unroll
                    for (int k = 0; k < 4; ++k) win[k] = win[k + 1];
                    { const int rr = row0 + j + 2; win[4] = (rr >= seq_lo && rr < seq_hi) ? *(const unsigned*)(src + (size_t)rr * PC) : 0u; }
                    float a0 = b0, a1 = b1;
#pragma unroll
                    for (int k = 0; k < 5; ++k) { a0 += w0[k] * bflo(win[k]); a1 += w1[k] * bfhi(win[k]); }
                    s0[u] = silu_f(a0); s1[u] = silu_f(a1);
                    *(unsigned*)(F.w<bf16_t>(WS_XBC) + (size_t)(row0 + j) * 896 + chn) = pk_bf16(s0[u], s1[u]);
                }
                const int j = jb + jj;
                if (pr < 96) {
#pragma unroll
                    for (int dir = 0; dir < 2; ++dir) {
                        const float wa = wj[(hh * 2 + dir) * 128 + j], wb = wj[(hh * 2 + dir) * 128 + j + 1];
                        LAS unsigned char* d = XW + ((hh * 2 + dir) * 64 + pch) * SROW + j * 2;
                        *(LAS unsigned*)d = pk_bf16(s0[0] * wa, s0[1] * wb);
                        *(LAS unsigned*)(d + SROW) = pk_bf16(s1[0] * wa, s1[1] * wb);
                    }
                } else if (pr < 160) {
                    LAS unsigned char* d = BT + (2 * (pr - 96)) * SROW + j * 2;
                    *(LAS unsigned*)d = pk_bf16(s0[0], s0[1]);
                    *(LAS unsigned*)(d + SROW) = pk_bf16(s1[0], s1[1]);
                }
            }
        }
        __syncthreads();
        {
            const int nt = wave & 3, pt = wave >> 2;
#pragma unroll 1
            for (int hh = 0; hh < 3; ++hh) {
                const int h = g * 3 + hh;
                f32x16 a0, a1;
#pragma unroll
                for (int i = 0; i < 16; ++i) { a0[i] = 0.f; a1[i] = 0.f; }
                const LAS unsigned char* X0 = XW + (hh * 2) * 64 * SROW;
#pragma unroll
                for (int ks = 0; ks < 8; ++ks) {
                    const bf16x8 a = lds_frag(BT, 32 * nt + r, 16 * ks + 8 * hf);
                    const bf16x8 b0 = lds_frag(X0, 32 * pt + r, 16 * ks + 8 * hf), b1 = lds_frag(X0, 64 + 32 * pt + r, 16 * ks + 8 * hf);
                    a0 = __builtin_amdgcn_mfma_f32_32x32x16_bf16(a, b0, a0, 0, 0, 0);
                    a1 = __builtin_amdgcn_mfma_f32_32x32x16_bf16(a, b1, a1, 0, 0, 0);
                }
                float* s0 = F.w<float>(WS_STATES) + ((size_t)(0 * NCH + ch) * 6 + h) * 8192 + (32 * pt + r) * 128 + 32 * nt + 4 * hf;
                float* s1 = F.w<float>(WS_STATES) + ((size_t)(1 * NCH + ch) * 6 + h) * 8192 + (32 * pt + r) * 128 + 32 * nt + 4 * hf;
#pragma unroll
                for (int gq = 0; gq < 4; ++gq) { *(f32x4*)(s0 + 8 * gq) = (f32x4){a0[4 * gq], a0[4 * gq + 1], a0[4 * gq + 2], a0[4 * gq + 3]};
                                                 *(f32x4*)(s1 + 8 * gq) = (f32x4){a1[4 * gq], a1[4 * gq + 1], a1[4 * gq + 2], a1[4 * gq + 3]}; }
            }
        }
    }
}

__device__ __forceinline__ void ph_ssd_scan(const Frame& F) {
    for (int blk = F.bid; blk < 192; blk += F.G) {
        const int id = blk * 512 + F.tid;
        const int dir = id / 49152, rem = id % 49152, h = rem / 8192, e = rem % 8192;
        const float* al = F.w<float>(WS_ALAST) + dir * 6 + h;
        const float* st = F.w<float>(WS_STATES) + ((size_t)(dir * NCH) * 6 + h) * 8192 + e;
        bf16_t* ss = F.w<bf16_t>(WS_SSTART) + ((size_t)(dir * NCH) * 6 + h) * 8192 + e;
        float sacc = 0.f;
        for (int s0 = 0; s0 < NCH; s0 += 13) {
            float sv[13], dv[13]; int cv[13];
#pragma unroll
            for (int u = 0; u < 13; ++u) {
                const int step = s0 + u;
                cv[u] = dir == 0 ? (step < 2 ? 128 + step : step - 2) : 129 - step;
                sv[u] = st[(size_t)cv[u] * 6 * 8192]; dv[u] = al[cv[u] * 12];
            }
#pragma unroll
            for (int u = 0; u < 13; ++u) { ss[(size_t)cv[u] * 6 * 8192] = f2bf(sacc); sacc = sacc * __expf(dv[u]) + sv[u]; }
        }
    }
}

__device__ __forceinline__ void ph_ssd_out(const Frame& F, int l) {
    LAS unsigned char* Cs = F.lds;
    LAS unsigned char* Bs = F.lds + 34816;
    LAS unsigned char* XT = F.lds + 69632;
    LAS float* Yl = (LAS float*)F.lds;
    LAS float* af = (LAS float*)(F.lds + 98816);
    LAS float* ab = af + 384, *dtf = ab + 384, *dtb = dtf + 384;
    LAS float* red = dtb + 384;
    const bf16_t* XBC = F.w<bf16_t>(WS_XBC);
    const bf16_t* P = F.w<bf16_t>(WS_P);
    const int nch = (l == 0) ? NCH : 128;
    const int lane = F.lane, wave = F.wave, r_in = lane & 31, hf_in = lane >> 5;
    const int it_ = wave & 3, jp = wave >> 2;
    for (int it = F.bid; it < nch * 2; it += F.G) {
        const int ch = it >> 1, g = it & 1, row0 = ch * 128;
        int r = r_in, hf = hf_in; asm volatile("" : "+v"(r), "+v"(hf));
        __syncthreads();
        for (int q = F.tid; q < 128 * 16; q += NTHREADS) {
            const int row = q >> 4, piece = q & 15;
            const bf16_t* src = XBC + (size_t)(row0 + row) * 896 + g * 128 + piece * 8;
            *(LAS u32x4*)(Bs + row * SROW + piece * 16) = *(const u32x4*)(src + 384);
            *(LAS u32x4*)(Cs + row * SROW + piece * 16) = *(const u32x4*)(src + 640);
        }
        for (int q = F.tid; q < 768; q += NTHREADS) {
            const int dir = q / 384, rr = q % 384, hh = rr >> 7, j = rr & 127;
            (dir ? ab : af)[hh * 128 + j] = F.w<float>(WS_ACS)[(size_t)(row0 + j) * 12 + dir * 6 + g * 3 + hh];
            (dir ? dtb : dtf)[hh * 128 + j] = F.w<float>(WS_DTV)[(size_t)(row0 + j) * 12 + dir * 6 + g * 3 + hh];
        }
        __syncthreads();
        f32x16 G0, G1;
#pragma unroll
        for (int i = 0; i < 16; ++i) { G0[i] = 0.f; G1[i] = 0.f; }
#pragma unroll
        for (int ks = 0; ks < 8; ++ks) {
            const bf16x8 a = lds_frag(Cs, 32 * it_ + r, 16 * ks + 8 * hf);
            const bf16x8 b0 = lds_frag(Bs, 64 * jp + r, 16 * ks + 8 * hf), b1 = lds_frag(Bs, 64 * jp + 32 + r, 16 * ks + 8 * hf);
            G0 = __builtin_amdgcn_mfma_f32_32x32x16_bf16(a, b0, G0, 0, 0, 0);
            G1 = __builtin_amdgcn_mfma_f32_32x32x16_bf16(a, b1, G1, 0, 0, 0);
        }
        f32x16 yacc[3];
#pragma unroll
        for (int hh = 0; hh < 3; ++hh) {
            const int h = g * 3 + hh;
            asm volatile("" : "+v"(r), "+v"(hf));
            __syncthreads();
#pragma unroll
            for (int tl = 0; tl < 2; ++tl) {
                const int j = 64 * jp + 32 * tl + r;
                const float afj = af[hh * 128 + j], abj = ab[hh * 128 + j], dfj = dtf[hh * 128 + j], dbj = dtb[hh * 128 + j];
#pragma unroll
                for (int rg = 0; rg < 16; ++rg) {
                    const int i = 32 * it_ + (rg & 3) + 8 * (rg >> 2) + 4 * hf;
                    const float mf = fminf(fmaxf((float)(i - j + 1), 0.f), 1.f), mb = fminf(fmaxf((float)(j - i + 1), 0.f), 1.f);
                    const float wf = __expf(fminf(af[hh * 128 + i] - afj, 0.f)) * dfj * mf;
                    const float wb = __expf(fminf(ab[hh * 128 + i] - abj, 0.f)) * dbj * mb;
                    const float gv = tl == 0 ? G0[rg] : G1[rg];
                    *(LAS bf16_t*)(Bs + i * SROW + j * 2) = f2bf(gv * (wf + wb));
                }
            }
            for (int q = F.tid; q < 128 * 8; q += NTHREADS) {
                const int j = q >> 3, pg = q & 7;
                const u32x4 v = *(const u32x4*)(XBC + (size_t)(row0 + j) * 896 + h * 64 + pg * 8);
                LAS unsigned char* d = XT + (pg * 8) * SROW + j * 2;
                *(LAS bf16_t*)(d + 0 * SROW) = (bf16_t)(v.x & 0xFFFF); *(LAS bf16_t*)(d + 1 * SROW) = (bf16_t)(v.x >> 16);
                *(LAS bf16_t*)(d + 2 * SROW) = (bf16_t)(v.y & 0xFFFF); *(LAS bf16_t*)(d + 3 * SROW) = (bf16_t)(v.y >> 16);
                *(LAS bf16_t*)(d + 4 * SROW) = (bf16_t)(v.z & 0xFFFF); *(LAS bf16_t*)(d + 5 * SROW) = (bf16_t)(v.z >> 16);
                *(LAS bf16_t*)(d + 6 * SROW) = (bf16_t)(v.w & 0xFFFF); *(LAS bf16_t*)(d + 7 * SROW) = (bf16_t)(v.w >> 16);
            }
            {
                f32x16 yF, yB;
#pragma unroll
                for (int i = 0; i < 16; ++i) { yF[i] = 0.f; yB[i] = 0.f; }
                const bf16_t* Sf = F.w<bf16_t>(WS_SSTART) + ((size_t)(0 * NCH + ch) * 6 + h) * 8192 + (32 * jp + r) * 128 + 8 * hf;
                const bf16_t* Sb = F.w<bf16_t>(WS_SSTART) + ((size_t)(1 * NCH + ch) * 6 + h) * 8192 + (32 * jp + r) * 128 + 8 * hf;
#pragma unroll 2
                for (int ks = 0; ks < 8; ++ks) {
                    const bf16x8 ac = lds_frag(Cs, 32 * it_ + r, 16 * ks + 8 * hf);
                    const bf16x8 bf_ = *(const bf16x8*)(Sf + 16 * ks), bb_ = *(const bf16x8*)(Sb + 16 * ks);
                    yF = __builtin_amdgcn_mfma_f32_32x32x16_bf16(ac, bf_, yF, 0, 0, 0);
                    yB = __builtin_amdgcn_mfma_f32_32x32x16_bf16(ac, bb_, yB, 0, 0, 0);
                }
#pragma unroll
                for (int rg = 0; rg < 16; ++rg) {
                    const int i = 32 * it_ + (rg & 3) + 8 * (rg >> 2) + 4 * hf;
                    yacc[hh][rg] = __expf(af[hh * 128 + i]) * yF[rg] + __expf(ab[hh * 128 + i]) * yB[rg];
                }
            }
            __syncthreads();
#pragma unroll 2
            for (int ks = 0; ks < 8; ++ks) {
                const bf16x8 aw = lds_frag(Bs, 32 * it_ + r, 16 * ks + 8 * hf), bx = lds_frag(XT, 32 * jp + r, 16 * ks + 8 * hf);
                yacc[hh] = __builtin_amdgcn_mfma_f32_32x32x16_bf16(aw, bx, yacc[hh], 0, 0, 0);
            }
        }
        __syncthreads();
#pragma unroll
        for (int hh = 0; hh < 3; ++hh)
#pragma unroll
            for (int rg = 0; rg < 16; ++rg) { const int i = 32 * it_ + (rg & 3) + 8 * (rg >> 2) + 4 * hf; Yl[i * 193 + hh * 64 + 32 * jp + r] = yacc[hh][rg]; }
        __syncthreads();
        const int i = F.tid & 127, pq = F.tid >> 7;
        float ssq = 0.f;
#pragma unroll 1
        for (int hh = 0; hh < 3; ++hh) {
            const int h = g * 3 + hh; const float dsk = F.in[I_SSDD][l * 6 + h];
            const int chn = h * 64 + pq * 16;
            const u32x4 xa = *(const u32x4*)(XBC + (size_t)(row0 + i) * 896 + chn), xb = *(const u32x4*)(XBC + (size_t)(row0 + i) * 896 + chn + 8);
            const u32x4 za = *(const u32x4*)(P + (size_t)(row0 + i) * PC + CZ + chn), zb = *(const u32x4*)(P + (size_t)(row0 + i) * PC + CZ + chn + 8);
            const unsigned xw_[8] = {xa.x, xa.y, xa.z, xa.w, xb.x, xb.y, xb.z, xb.w}, zw_[8] = {za.x, za.y, za.z, za.w, zb.x, zb.y, zb.z, zb.w};
            LAS float* yr = Yl + i * 193 + hh * 64 + pq * 16;
#pragma unroll
            for (int p2 = 0; p2 < 8; ++p2) {
                const float v0 = (yr[2 * p2] + dsk * bflo(xw_[p2])) * silu_f(bflo(zw_[p2]));
                const float v1 = (yr[2 * p2 + 1] + dsk * bfhi(xw_[p2])) * silu_f(bfhi(zw_[p2]));
                yr[2 * p2] = v0; yr[2 * p2 + 1] = v1; ssq += v0 * v0 + v1 * v1;
            }
        }
        red[pq * 128 + i] = ssq;
        __syncthreads();
        const float tot = red[i] + red[128 + i] + red[256 + i] + red[384 + i];
        const float rstd = rsqrtf(tot * (1.0f / 192.0f) + RMS_EPS);
#pragma unroll 1
        for (int hh = 0; hh < 3; ++hh) {
            const int h = g * 3 + hh;
            bf16_t* o = F.w<bf16_t>(WS_MIX) + (size_t)(row0 + i) * D + h * 64 + pq * 16;
            const float* ng = F.in[I_SSDNG] + l * 384 + h * 64 + pq * 16;
            const LAS float* yr = Yl + i * 193 + hh * 64 + pq * 16;
            unsigned wv[8];
#pragma unroll
            for (int p2 = 0; p2 < 8; ++p2) wv[p2] = pk_bf16(yr[2 * p2] * rstd * ng[2 * p2], yr[2 * p2 + 1] * rstd * ng[2 * p2 + 1]);
            *(u32x4*)o = (u32x4){wv[0], wv[1], wv[2], wv[3]}; *(u32x4*)(o + 8) = (u32x4){wv[4], wv[5], wv[6], wv[7]};
        }
    }
}

__device__ __forceinline__ int na_kv_off(int key, int piece) { return key * 128 + ((piece ^ (key & 7)) << 4); }
__device__ __forceinline__ void na_stage_kv(const Frame& F, const bf16_t* P, LAS unsigned char* Kd, LAS unsigned char* Vd, int h, bool local, int r0, int kc0) {
    for (int q = F.tid; q < 256 * 8; q += NTHREADS) {
        const int key = q >> 3, piece = q & 7;
        const int krow = local ? (r0 + (key >> 5)) * 64 + kc0 + (key & 31) : L + key;
        const bf16_t* src = P + (size_t)krow * PC + h * 64 + piece * 8;
        *(LAS u32x4*)(Kd + na_kv_off(key, piece)) = *(const u32x4*)(src + CK);
        *(LAS u32x4*)(Vd + na_kv_off(key, piece)) = *(const u32x4*)(src + CV);
    }
}
__device__ __forceinline__ void bar_lds() { asm volatile("s_waitcnt lgkmcnt(0)" ::: "memory"); __builtin_amdgcn_s_barrier(); asm volatile("" ::: "memory"); }
struct NaItem { int h, r, cg, r0, kc0, qrow0; bool isctx; };
__device__ __forceinline__ NaItem na_item(int bid, int i_lo, int i_hi, int k) {
    NaItem t; t.isctx = (i_lo + k >= i_hi); t.r = 0; t.r0 = 0; t.kc0 = 0;
    if (!t.isctx) { const int it = i_lo + k; t.h = it >> 10; t.r = (it >> 2) & 255; t.cg = it & 3; t.r0 = min(max(t.r - 4, 0), 248); t.kc0 = min(max(16 * t.cg - 8, 0), 32); t.qrow0 = t.r * 64 + t.cg * 16; }
    else { t.h = bid >> 4; t.cg = bid & 15; t.qrow0 = L + t.cg * 16; }
    return t;
}
__device__ __forceinline__ void ph_na(const Frame& F, int l) {
    LAS unsigned char* Kc = F.lds;
    LAS unsigned char* Vc = F.lds + 32768;
    LAS unsigned char* Kl = F.lds + 65536;
    LAS unsigned char* Vl = F.lds + 98304;
    LAS unsigned char* Qs = F.lds + 131072;
    LAS unsigned char* Pl = F.lds + 133120;
    LAS float* red = (LAS float*)(F.lds + 149760);
    const bf16_t* P = F.w<bf16_t>(WS_P);
    const float* rpb = F.in[I_RPB] + (size_t)l * 15 * 31 * 6;
    const int nlat = 6 * 256 * 4, per = (nlat + F.G - 1) / F.G;
    const int nctx = (l == 0) ? 96 : 0;
    const int lane = F.lane, wave = F.wave, c16 = lane & 15, kq = lane >> 4;
    const float scale = 0.125f;
    int cur_h = -1;
    const int i_lo = F.bid * per, i_hi = min(nlat, i_lo + per);
    const int n_mine = max(0, i_hi - i_lo) + ((F.bid < nctx) ? 1 : 0);
    u32x4 kreg[4], vreg[4], qreg;
    const int pkey = F.tid >> 3, ppiece = F.tid & 7;
#define NA_PREFETCH(T) do { if (!(T).isctx) { _Pragma("unroll") for (int u = 0; u < 4; ++u) { const int key = pkey + 64 * u; \
            const bf16_t* src = P + (size_t)(((T).r0 + (key >> 5)) * 64 + (T).kc0 + (key & 31)) * PC + (T).h * 64 + ppiece * 8; \
            kreg[u] = *(const u32x4*)(src + CK); vreg[u] = *(const u32x4*)(src + CV); } } \
        if (F.tid < 128) qreg = *(const u32x4*)(P + (size_t)((T).qrow0 + pkey) * PC + CQ + (T).h * 64 + ppiece * 8); } while (0)
    if (n_mine > 0) { const NaItem t0 = na_item(F.bid, i_lo, i_hi, 0); NA_PREFETCH(t0); }
    for (int k = 0; k < n_mine; ++k) {
        const NaItem t = na_item(F.bid, i_lo, i_hi, k);
        const bool isctx = t.isctx; const int h = t.h, r = t.r, cg = t.cg, r0 = t.r0, kc0 = t.kc0, qrow0 = t.qrow0;
        bar_lds();
        if (h != cur_h) { na_stage_kv(F, P, Kc, Vc, h, false, 0, 0); cur_h = h; }
        if (!isctx) {
#pragma unroll
            for (int u = 0; u < 4; ++u) { const int key = pkey + 64 * u; *(LAS u32x4*)(Kl + na_kv_off(key, ppiece)) = kreg[u]; *(LAS u32x4*)(Vl + na_kv_off(key, ppiece)) = vreg[u]; }
        }
        if (F.tid < 128) *(LAS u32x4*)(Qs + na_kv_off(pkey, ppiece)) = qreg;
        if (k + 1 < n_mine) { const NaItem tn = na_item(F.bid, i_lo, i_hi, k + 1); NA_PREFETCH(tn); }
        bar_lds();
        const bool loc = wave < 4;
        const LAS unsigned char* Kb = loc ? Kl : Kc;
        const int kbase = (wave & 3) * 64;
        f32x4 sacc[4];
#pragma unroll
        for (int nt = 0; nt < 4; ++nt) sacc[nt] = (f32x4){0.f, 0.f, 0.f, 0.f};
        if (!(loc && isctx)) {
#pragma unroll
            for (int ks = 0; ks < 2; ++ks) {
                const bf16x8 a = *(const LAS bf16x8*)(Qs + na_kv_off(c16, 4 * ks + kq));
#pragma unroll
                for (int nt = 0; nt < 4; ++nt) {
                    const bf16x8 b = *(const LAS bf16x8*)(Kb + na_kv_off(kbase + 16 * nt + c16, 4 * ks + kq));
                    sacc[nt] = __builtin_amdgcn_mfma_f32_16x16x32_bf16(a, b, sacc[nt], 0, 0, 0);
                }
            }
        }
        float mx[4];
#pragma unroll
        for (int rg = 0; rg < 4; ++rg) mx[rg] = -INFINITY;
#pragma unroll
        for (int nt = 0; nt < 4; ++nt) {
            const int kk = kbase + 16 * nt + c16;
#pragma unroll
            for (int rg = 0; rg < 4; ++rg) {
                float sv = sacc[nt][rg] * scale;
                if (loc) {
                    const int qi = 4 * kq + rg, qcol = cg * 16 + qi, cstart = min(max(qcol - 8, 0), 48);
                    const int krow = kk >> 5, kcol = kc0 + (kk & 31);
                    const bool ok = !isctx && (kcol >= cstart) && (kcol < cstart + 16);
                    const int dr = r0 + krow - r + 7, dc = min(max(kcol - qcol + 15, 0), 30);
                    sv = ok ? sv + rpb[(dr * 31 + dc) * 6 + h] : -INFINITY;
                }
                sacc[nt][rg] = sv; mx[rg] = fmaxf(mx[rg], sv);
            }
        }
#pragma unroll
        for (int rg = 0; rg < 4; ++rg) {
#pragma unroll
            for (int o = 8; o >= 1; o >>= 1) mx[rg] = fmaxf(mx[rg], __shfl_xor(mx[rg], o));
            if (c16 == 0) red[wave * 16 + 4 * kq + rg] = mx[rg];
        }
        bar_lds();
        float ps[4];
#pragma unroll
        for (int rg = 0; rg < 4; ++rg) {
            float gm = red[4 * kq + rg];
#pragma unroll
            for (int w = 1; w < 8; ++w) gm = fmaxf(gm, red[w * 16 + 4 * kq + rg]);
            mx[rg] = gm; ps[rg] = 0.f;
        }
#pragma unroll
        for (int nt = 0; nt < 4; ++nt) {
            const int kg = wave * 64 + 16 * nt + c16;
#pragma unroll
            for (int rg = 0; rg < 4; ++rg) {
                const float pv = __expf(sacc[nt][rg] - mx[rg]);
                ps[rg] += pv;
                *(LAS bf16_t*)(Pl + (4 * kq + rg) * 1040 + kg * 2) = f2bf(pv);
            }
        }
#pragma unroll
        for (int rg = 0; rg < 4; ++rg) {
#pragma unroll
            for (int o = 8; o >= 1; o >>= 1) ps[rg] += __shfl_xor(ps[rg], o);
            if (c16 == 0) red[128 + wave * 16 + 4 * kq + rg] = ps[rg];
        }
        bar_lds();
        if (wave < 4) {
            f32x4 o = (f32x4){0.f, 0.f, 0.f, 0.f};
            const int d = 16 * wave + c16;
#pragma unroll 4
            for (int ks = isctx ? 8 : 0; ks < 16; ++ks) {
                const bf16x8 a = *(const LAS bf16x8*)(Pl + c16 * 1040 + (32 * ks + 8 * kq) * 2);
                const LAS unsigned char* Vb = ks < 8 ? Vl : Vc;
                const int key0 = 32 * (ks & 7) + 8 * kq;
                bf16x8 b;
#pragma unroll
                for (int e = 0; e < 8; ++e) b[e] = *(const LAS short*)(Vb + na_kv_off(key0 + e, d >> 3) + (d & 7) * 2);
                o = __builtin_amdgcn_mfma_f32_16x16x32_bf16(a, b, o, 0, 0, 0);
            }
#pragma unroll
            for (int rg = 0; rg < 4; ++rg) {
                const int qi = 4 * kq + rg;
                float sum = 0.f;
#pragma unroll
                for (int w = 0; w < 8; ++w) sum += red[128 + w * 16 + qi];
                F.w<bf16_t>(WS_MIX)[(size_t)(qrow0 + qi) * D + 384 + h * 64 + d] = f2bf(o[rg] / sum);
            }
        }
    }
#undef NA_PREFETCH
}

__device__ __forceinline__ float hy_conv3(const bf16_t* P, const float* cw, const float* cb, int row, int seq_lo, int seq_hi, int col) {
    float s = cb[col];
#pragma unroll
    for (int k = 0; k < 3; ++k) { const int r = row + k - 1; if (r >= seq_lo && r < seq_hi) s += cw[k * 768 + col] * bf2f(P[(size_t)r * PC + CHY + col]); }
    return s;
}
__device__ __forceinline__ void ph_hy_prep(const Frame& F, int l) {
    const bf16_t* P = F.w<bf16_t>(WS_P);
    const float* cw = F.in[I_HCW] + (size_t)l * 3 * 768; const float* cb = F.in[I_HCB] + (size_t)l * 768;
    LAS unsigned* ut = (LAS unsigned*)F.lds;
    LAS unsigned* xt = ut + 256 * 33;
    for (int it = F.bid; it < L / 64; it += F.G) {
        const int t0 = it * 64;
        __syncthreads();
        {
            const int c = F.tid & 255, rh = F.tid >> 8;
            for (int rp = 0; rp < 16; ++rp) {
                const int row = t0 + rh * 32 + rp * 2;
                const float x1a = hy_conv3(P, cw, cb, row, 0, L, 256 + c), va = hy_conv3(P, cw, cb, row, 0, L, 512 + c), x0a = hy_conv3(P, cw, cb, row, 0, L, c);
                const float x1b = hy_conv3(P, cw, cb, row + 1, 0, L, 256 + c), vb = hy_conv3(P, cw, cb, row + 1, 0, L, 512 + c), x0b = hy_conv3(P, cw, cb, row + 1, 0, L, c);
                ut[c * 33 + rh * 16 + rp] = pk_bf16(va * x1a, vb * x1b);
                xt[c * 33 + rh * 16 + rp] = pk_bf16(x0a, x0b);
            }
        }
        __syncthreads();
        for (int q = F.tid; q < 256 * 8; q += NTHREADS) {
            const int c = q >> 3, g = q & 7;
            u32x4 a, b;
            a.x = ut[c * 33 + 4 * g]; a.y = ut[c * 33 + 4 * g + 1]; a.z = ut[c * 33 + 4 * g + 2]; a.w = ut[c * 33 + 4 * g + 3];
            b.x = xt[c * 33 + 4 * g]; b.y = xt[c * 33 + 4 * g + 1]; b.z = xt[c * 33 + 4 * g + 2]; b.w = xt[c * 33 + 4 * g + 3];
            *(u32x4*)(F.w<bf16_t>(WS_UT) + (size_t)c * L + t0 + 8 * g) = a;
            *(u32x4*)(F.w<bf16_t>(WS_X0T) + (size_t)c * L + t0 + 8 * g) = b;
        }
    }
    if (l == 0) {
        for (int rp = F.bid; rp < LC / 2; rp += F.G) {
            const int row = L + rp * 2 + (F.tid >> 8), c = F.tid & 255;
            const float x1 = hy_conv3(P, cw, cb, row, L, T, 256 + c), v = hy_conv3(P, cw, cb, row, L, T, 512 + c);
            F.w<float>(WS_U)[(size_t)row * 256 + c] = v * x1;
        }
    }
}
__device__ __forceinline__ void ph_hy_conv_ctx(const Frame& F, int l) {
    const bf16_t* P = F.w<bf16_t>(WS_P);
    const float* cw = F.in[I_HCW] + (size_t)l * 3 * 768; const float* cb = F.in[I_HCB] + (size_t)l * 768;
    for (int it = F.bid; it < 8; it += F.G) {
        const int Lx = LC, rbase = L;
        const int tb = it * 2 + (F.tid >> 8), c = F.tid & 255, t0 = tb * 16;
        const float* U = F.w<float>(WS_U) + (size_t)rbase * 256 + c;
        const float* KC = F.w<float>(WS_KCOMBC) + c;
        float acc[16], wreg[16];
#pragma unroll
        for (int j = 0; j < 16; ++j) { acc[j] = 0.f; wreg[j] = KC[(size_t)(t0 + j + Lx - 1) * 256]; }
        for (int s0 = 0; s0 < Lx; s0 += 16) {
            float ub[16], nb[16];
#pragma unroll
            for (int r = 0; r < 16; ++r) { ub[r] = U[(size_t)(s0 + r) * 256]; const int x = t0 - (s0 + r + 1) + Lx - 1; nb[r] = x >= 0 ? KC[(size_t)x * 256] : 0.f; }
#pragma unroll
            for (int r = 0; r < 16; ++r) {
#pragma unroll
                for (int j = 0; j < 16; ++j) acc[j] += ub[r] * wreg[(j - r) & 15];
                wreg[(15 - r) & 15] = nb[r];
            }
        }
        const float inv = F.w<float>(WS_FSUM)[2 * 256 + c];
        const float db = F.in[I_HYD][l * 256 + c];
#pragma unroll
        for (int j = 0; j < 16; ++j) {
            const int row = rbase + t0 + j;
            const float x0 = hy_conv3(P, cw, cb, row, L, T, c);
            const float u = F.w<float>(WS_U)[(size_t)row * 256 + c];
            F.w<bf16_t>(WS_MIX)[(size_t)row * D + 768 + c] = f2bf(x0 * (acc[j] * inv + u * db));
        }
    }
}

constexpr int HC_UBYTES = 190 * 272;
constexpr int HC_CPOFF = 51712, HC_NG = 162, HC_CPBYTES = 8 * HC_NG * 16;
__device__ __forceinline__ void hc_make_copies(LAS unsigned char* dst, const u32x4 g0, const u32x4 g1, int g) {
    const unsigned w[8] = {g0.x, g0.y, g0.z, g0.w, g1.x, g1.y, g1.z, g1.w};
#pragma unroll
    for (int sh = 0; sh < 8; ++sh) {
        u32x4 o;
        if ((sh & 1) == 0) { o.x = w[sh / 2]; o.y = w[sh / 2 + 1]; o.z = w[sh / 2 + 2]; o.w = w[sh / 2 + 3]; }
        else { const int b = sh / 2; o.x = __builtin_amdgcn_alignbit(w[b + 1], w[b], 16); o.y = __builtin_amdgcn_alignbit(w[b + 2], w[b + 1], 16);
               o.z = __builtin_amdgcn_alignbit(w[b + 3], w[b + 2], 16); o.w = __builtin_amdgcn_alignbit(w[b + 4], w[b + 3], 16); }
        *(LAS u32x4*)(dst + (sh * HC_NG + g) * 16) = o;
    }
}
__device__ __forceinline__ void ph_hy_conv(const Frame& F, int l) {
    LAS unsigned char* Ul = F.lds;
    LAS unsigned char* Cp = F.lds + HC_CPOFF;
    const int lane = F.lane, wave = F.wave;
    const int nt = wave < 4 ? wave : 7 - wave, par = wave >> 2;
    const int r = lane & 31, h = lane >> 5, sig = r & 7, rho = r >> 3;
    const int sh = (8 - sig) & 7, gofs = h - rho - (sig ? 1 : 0);
    const int a_lane = (sh * HC_NG + gofs) * 16;
    const int b_lane = r * 272 + h * 16;
    for (int c = F.bid; c < 256; c += F.G) {
        const bf16_t* KRc = F.w<bf16_t>(WS_KR) + ((size_t)l * 256 + c) * KRL;
        const bf16_t* UTc = F.w<bf16_t>(WS_UT) + (size_t)c * L;
        __syncthreads();
        for (int q = F.tid; q < 190 * 16; q += NTHREADS) {
            const int blk = q >> 4, piece = q & 15;
            u32x4 v = (u32x4){0u, 0u, 0u, 0u};
            if (blk >= 31 && blk < 159) v = *(const u32x4*)(UTc + (size_t)(blk - 31) * 128 + piece * 8);
            *(LAS u32x4*)(Ul + blk * 272 + piece * 16) = v;
        }
        u32x4 g0 = (u32x4){0u, 0u, 0u, 0u}, g1 = g0;
        if (F.tid < 163) { const bf16_t* src = KRc + 31744 + 8 * F.tid; g0 = *(const u32x4*)src; g1 = *(const u32x4*)(src + 8); }
        if (F.tid < HC_NG) hc_make_copies(Cp, g0, g1, F.tid);
        __syncthreads();
        f32x16 acc[4];
#pragma unroll
        for (int m = 0; m < 4; ++m)
#pragma unroll
            for (int i = 0; i < 16; ++i) acc[m][i] = 0.f;
        for (int ci = 0; ci < 32; ++ci) {
            const int Dc = -128 + 8 * ci;
            if (ci + 1 < 32 && F.tid < 163) { const bf16_t* src = KRc + (31744 - 1024 * (ci + 1)) + 8 * F.tid; g0 = *(const u32x4*)src; g1 = *(const u32x4*)(src + 8); }
            const LAS unsigned char* cp = Cp + (ci & 1) * HC_CPBYTES + a_lane;
#pragma unroll 1
            for (int d2 = 0; d2 < 4; ++d2) {
                const int dd = 2 * d2 + par, Dv = Dc + dd;
                if (!((Dv >= 32 * nt - 127) && (Dv <= 32 * nt + 31) && (Dv > -128))) continue;
                const LAS unsigned char* ap = cp + (16 * (8 - dd)) * 16;
                const LAS unsigned char* bp = Ul + b_lane + (32 * nt - Dv + 31) * 272;
                bf16x8 af[14], bfr[8];
#pragma unroll
                for (int e = 0; e < 14; ++e) af[e] = *(const LAS bf16x8*)(ap - 2 * (e - 7) * 16);
#pragma unroll
                for (int ks = 0; ks < 8; ++ks) bfr[ks] = *(const LAS bf16x8*)(bp + ks * 32);
#pragma unroll
                for (int ks = 0; ks < 8; ++ks)
#pragma unroll
                    for (int m = 0; m < 4; ++m) acc[m] = __builtin_amdgcn_mfma_f32_32x32x16_bf16(af[2 * m - ks + 7], bfr[ks], acc[m], 0, 0, 0);
            }
            if (ci + 1 < 32 && F.tid < HC_NG) hc_make_copies(Cp + ((ci + 1) & 1) * HC_CPBYTES, g0, g1, F.tid);
            __syncthreads();
        }
        LAS float* Rd = (LAS float*)F.lds;
        if (wave >= 4) {
#pragma unroll
            for (int m = 0; m < 4; ++m)
#pragma unroll
                for (int i = 0; i < 16; ++i) Rd[(nt * 64 + m * 16 + i) * 64 + lane] = acc[m][i];
        }
        __syncthreads();
        if (wave < 4) {
#pragma unroll
            for (int m = 0; m < 4; ++m)
#pragma unroll
                for (int i = 0; i < 16; ++i) acc[m][i] += Rd[(nt * 64 + m * 16 + i) * 64 + lane];
            const float inv = F.w<float>(WS_FSUM)[l * 256 + c];
            const float db = F.in[I_HYD][l * 256 + c];
            const bf16_t* X0c = F.w<bf16_t>(WS_X0T) + (size_t)c * L;
            bf16_t* YTc = F.w<bf16_t>(WS_YT) + (size_t)c * L;
            const int I = 32 * nt + r;
#pragma unroll
            for (int m = 0; m < 4; ++m) {
#pragma unroll
                for (int g = 0; g < 4; ++g) {
                    const int t = 128 * I + 32 * m + 8 * g + 4 * h;
                    const u32x2 xv = *(const u32x2*)(X0c + t), uv = *(const u32x2*)(UTc + t);
                    float y[4];
#pragma unroll
                    for (int e = 0; e < 4; ++e) y[e] = acc[m][4 * g + e] * inv;
                    y[0] = bflo(xv.x) * (y[0] + bflo(uv.x) * db); y[1] = bfhi(xv.x) * (y[1] + bfhi(uv.x) * db);
                    y[2] = bflo(xv.y) * (y[2] + bflo(uv.y) * db); y[3] = bfhi(xv.y) * (y[3] + bfhi(uv.y) * db);
                    u32x2 o; o.x = pk_bf16(y[0], y[1]); o.y = pk_bf16(y[2], y[3]);
                    *(u32x2*)(YTc + t) = o;
                }
            }
        }
    }
}
__device__ __forceinline__ void ph_hy_tr(const Frame& F) {
    LAS unsigned* yt = (LAS unsigned*)F.lds;
    for (int it = F.bid; it < L / 64; it += F.G) {
        const int t0 = it * 64;
        __syncthreads();
        for (int q = F.tid; q < 256 * 8; q += NTHREADS) {
            const int c = q >> 3, g = q & 7;
            const u32x4 a = *(const u32x4*)(F.w<bf16_t>(WS_YT) + (size_t)c * L + t0 + 8 * g);
            yt[c * 33 + 4 * g] = a.x; yt[c * 33 + 4 * g + 1] = a.y; yt[c * 33 + 4 * g + 2] = a.z; yt[c * 33 + 4 * g + 3] = a.w;
        }
        __syncthreads();
        for (int q = F.tid; q < 64 * 32; q += NTHREADS) {
            const int row = q >> 5, cg = q & 31;
            const LAS unsigned short* ys = (const LAS unsigned short*)yt;
            unsigned short v[8];
#pragma unroll
            for (int e = 0; e < 8; ++e) v[e] = ys[((cg * 8 + e) * 33) * 2 + row];
            u32x4 o; o.x = v[0] | ((unsigned)v[1] << 16); o.y = v[2] | ((unsigned)v[3] << 16); o.z = v[4] | ((unsigned)v[5] << 16); o.w = v[6] | ((unsigned)v[7] << 16);
            *(u32x4*)(F.w<bf16_t>(WS_MIX) + (size_t)(t0 + row) * D + 768 + cg * 8) = o;
        }
    }
}

__device__ __forceinline__ void ph_post1(const Frame& F, int l) {
    LAS float* wr = (LAS float*)F.lds;
    LAS float* vec = wr + 32 * 1024;
    __syncthreads();
    for (int q = F.tid; q < 32 * 1024; q += NTHREADS) { const int k = q >> 5, e = q & 31; wr[e * 1024 + k] = F.in[I_WR][(size_t)l * 1024 * 32 + q]; }
    for (int q = F.tid; q < 2048; q += NTHREADS) {
        const int which = q >> 10, j = q & 1023;
        vec[(which * 3 + 0) * 1024 + j] = F.in[I_NORMG][(l * 4 + 1) * 1024 + j] * mod_val(F, l, which, 2 * 1024 + j);
        vec[(which * 3 + 1) * 1024 + j] = F.in[I_NORMG][(l * 4 + 2) * 1024 + j] * (1.0f + mod_val(F, l, which, 4 * 1024 + j));
        vec[(which * 3 + 2) * 1024 + j] = mod_val(F, l, which, 3 * 1024 + j);
    }
    __syncthreads();
    const int nrows = (l == 0) ? T : L;
    const int nwaves = F.G * 8;
    unsigned* cnt = F.w<unsigned>(WS_CTL) + CW_CNT + l * 32;
    for (int row = F.bid * 8 + F.wave; row < nrows; row += nwaves) {
        const int which = row >= L;
        const LAS float* v0 = vec + (which * 3) * 1024;
        f32x4 m[4], x[4];
        load_row(F.w<float>(WS_MIXO) + (size_t)row * D, F.lane, m);
        load_row(xrow_ptr(F, l, row), F.lane, x);
        const float rs1 = row_rstd(m);
#pragma unroll
        for (int i = 0; i < 4; ++i) { const f32x4 a = *(const LAS f32x4*)(v0 + 4 * F.lane + 256 * i); x[i] = x[i] + m[i] * rs1 * a; }
        float* xo = F.w<float>(WS_XCUR) + (size_t)row * D;
#pragma unroll
        for (int i = 0; i < 4; ++i) *(f32x4*)(xo + 4 * F.lane + 256 * i) = x[i];
        const float rs2 = row_rstd(x);
        f32x4 hv[4];
#pragma unroll
        for (int i = 0; i < 4; ++i) { const f32x4 a = *(const LAS f32x4*)(v0 + 1024 + 4 * F.lane + 256 * i), b = *(const LAS f32x4*)(v0 + 2048 + 4 * F.lane + 256 * i); hv[i] = x[i] * rs2 * a + b; }
        bf16_t* ho = F.w<bf16_t>(WS_H2) + (size_t)row * D;
#pragma unroll
        for (int i = 0; i < 4; ++i) { u32x2 w; w.x = pk_bf16(hv[i][0], hv[i][1]); w.y = pk_bf16(hv[i][2], hv[i][3]); *(u32x2*)(ho + 4 * F.lane + 256 * i) = w; }
        float mylogit = 0.f;
        for (int e = 0; e < 32; ++e) {
            float s = 0.f;
#pragma unroll
            for (int i = 0; i < 4; ++i) { const f32x4 w = *(const LAS f32x4*)(wr + e * 1024 + 4 * F.lane + 256 * i); s += hv[i][0] * w[0] + hv[i][1] * w[1] + hv[i][2] * w[2] + hv[i][3] * w[3]; }
            s = wave_sum(s);
            if (F.lane == e) mylogit = s + F.in[I_BR][l * 32 + e];
        }
        float cand = F.lane < 32 ? mylogit : -INFINITY;
        float tv[4]; int ti[4];
#pragma unroll
        for (int k = 0; k < 4; ++k) {
            float bv = cand; int bi = F.lane;
#pragma unroll
            for (int o = 32; o >= 1; o >>= 1) { const float ov = __shfl_xor(bv, o); const int oi = __shfl_xor(bi, o); if (ov > bv || (ov == bv && oi < bi)) { bv = ov; bi = oi; } }
            tv[k] = bv; ti[k] = bi;
            if (F.lane == bi) cand = -INFINITY;
        }
        const float e1 = __expf(tv[1] - tv[0]), e2 = __expf(tv[2] - tv[0]), e3 = __expf(tv[3] - tv[0]);
        const float inv = 1.0f / (1.0f + e1 + e2 + e3);
        if (F.lane < 4) {
            const int k = F.lane;
            const int e = k == 0 ? ti[0] : (k == 1 ? ti[1] : (k == 2 ? ti[2] : ti[3]));
            const float wgt = (k == 0 ? 1.0f : (k == 1 ? e1 : (k == 2 ? e2 : e3))) * inv;
            const unsigned pos = atomicAdd(cnt + e, 1u);
            F.w<int>(WS_RE)[row * 4 + k] = e; F.w<int>(WS_RP)[row * 4 + k] = (int)pos; F.w<float>(WS_RW)[row * 4 + k] = wgt;
        }
    }
}

__device__ __forceinline__ int expert_pad_start(const Frame& F, int l, int& ntiles) {
    const unsigned* cnt = F.w<unsigned>(WS_CTL) + CW_CNT + l * 32;
    int c = F.lane < 32 ? (int)__hip_atomic_load(cnt + F.lane, __ATOMIC_RELAXED, __HIP_MEMORY_SCOPE_AGENT) : 0;
    int padded = (c + 255) & ~255;
    int incl = padded;
#pragma unroll
    for (int o = 1; o < 32; o <<= 1) { const int v = __shfl_up(incl, o); if ((F.lane & 31) >= o) incl += v; }
    ntiles = __shfl(incl, 31) >> 8;
    return incl - padded;
}

__device__ __forceinline__ void ph_gather(const Frame& F, int l) {
    int ntiles; const int ps = expert_pad_start(F, l, ntiles);
    if (F.bid == 0 && F.wave == 0) {
        int* tab = F.w<int>(WS_CTL) + CW_TILE + l * 320;
        const int nxt = __shfl_down(ps, 1);
        const int endt = (F.lane == 31) ? ntiles : (nxt >> 8);
        if (F.lane < 32) for (int t = ps >> 8; t < endt; ++t) tab[t] = F.lane;
        if (F.lane == 0) F.w<int>(WS_CTL)[CW_NT + l] = ntiles;
    }
    const int nrows = (l == 0) ? T : L;
    const int nwaves = F.G * 8;
    for (int a = F.bid * 8 + F.wave; a < nrows * 4; a += nwaves) {
        const int row = a >> 2;
        const int e = F.w<int>(WS_RE)[a], pos = F.w<int>(WS_RP)[a];
        const int dst = __shfl(ps, e) + pos;
        if (F.lane == 0) F.w<int>(WS_SLOT)[a] = dst;
        const u32x4* s = (const u32x4*)(F.w<bf16_t>(WS_H2) + (size_t)row * D);
        u32x4* d = (u32x4*)(F.w<bf16_t>(WS_XG) + (size_t)dst * D);
        d[F.lane] = s[F.lane]; d[F.lane + 64] = s[F.lane + 64];
    }
}

__device__ __forceinline__ void ph_final(const Frame& F, int l) {
    LAS float* vec = (LAS float*)F.lds;
    __syncthreads();
    for (int q = F.tid; q < 2048; q += NTHREADS) { const int which = q >> 10, j = q & 1023; vec[q] = F.in[I_NORMG][(l * 4 + 3) * 1024 + j] * mod_val(F, l, which, 5 * 1024 + j); }
    if (l == 0) stage_norm_vecs(F, 1, 0, 0, 1, vec + 2048);
    __syncthreads();
    const int nrows = (l == 0) ? T : L;
    const int nwaves = F.G * 8;
    const bf16_t* Y = F.w<bf16_t>(WS_Y);
    for (int row = F.bid * 8 + F.wave; row < nrows; row += nwaves) {
        const int which = row >= L;
        f32x4 f[4];
#pragma unroll
        for (int i = 0; i < 4; ++i) f[i] = (f32x4){0.f, 0.f, 0.f, 0.f};
#pragma unroll
        for (int k = 0; k < 4; ++k) {
            const int slot = F.w<int>(WS_SLOT)[row * 4 + k]; const float wgt = F.w<float>(WS_RW)[row * 4 + k];
            const bf16_t* yr = Y + (size_t)slot * D;
#pragma unroll
            for (int i = 0; i < 4; ++i) { const u32x2 w = *(const u32x2*)(yr + 4 * F.lane + 256 * i); f[i][0] += wgt * bflo(w.x); f[i][1] += wgt * bfhi(w.x); f[i][2] += wgt * bflo(w.y); f[i][3] += wgt * bfhi(w.y); }
        }
        const float rs = row_rstd(f);
        f32x4 x[4]; load_row(F.w<float>(WS_XCUR) + (size_t)row * D, F.lane, x);
#pragma unroll
        for (int i = 0; i < 4; ++i) { const f32x4 a = *(const LAS f32x4*)(vec + which * 1024 + 4 * F.lane + 256 * i); x[i] = x[i] + f[i] * rs * a; }
        float* xo = (l == 1) ? F.out + (size_t)row * D : F.w<float>(WS_XCUR) + (size_t)row * D;
#pragma unroll
        for (int i = 0; i < 4; ++i) *(f32x4*)(xo + 4 * F.lane + 256 * i) = x[i];
        if (l == 0) {
            const float rstd = row_rstd(x);
            norm_store_bf16(x, rstd, vec + 2048 + (which * 2) * 1024, vec + 2048 + (which * 2 + 1) * 1024, F.w<bf16_t>(WS_HB) + (size_t)row * D, F.lane);
        }
    }
}

constexpr int PH_PER_LAYER = 10, N_PHASES = 2 + 2 * PH_PER_LAYER;
#ifndef PH_MASK
#define PH_MASK 0xFFFFFFFFu
#endif
#define EN(b) (((PH_MASK) >> (b)) & 1u)
#ifndef DUP_MASK
#define DUP_MASK 0u
#endif
#define REP(b) for (int _rep = 0; _rep < 1 + (int)(((DUP_MASK) >> (b)) & 1u); ++_rep)

__global__ void __launch_bounds__(NTHREADS, 2) mega(Args args) {
    extern __shared__ __attribute__((aligned(16))) unsigned char shm[];
    Frame F0;
    F0.in.kp = (kargp_t)__builtin_amdgcn_kernarg_segment_ptr();
    F0.out = args.out; F0.ws = args.ws; F0.lds = (LAS unsigned char*)shm;
    F0.tid = threadIdx.x; F0.lane = F0.tid & 63; F0.wave = __builtin_amdgcn_readfirstlane(F0.tid >> 6); F0.G = gridDim.x; F0.bid = blockIdx.x;
    volatile LAS unsigned* bst = (volatile LAS unsigned*)(shm + LDS_BYTES - 16);
    XcdBarrier bar; bar.bar = F0.w<unsigned>(WS_CTL) + CW_BAR; bar.x = 0; bar.st = bst;
#if N_LAUNCH_MODE == 1
    if (F0.tid == 0) { bst[0] = 0u; bst[1] = 0u; }
    __syncthreads();
    bar = xcd_barrier_post(F0.w<unsigned>(WS_CTL) + CW_BAR, bst);
#define GRID_BAR() xcd_barrier(bar)
#else
#define GRID_BAR() do {} while (0)
#endif
    const int lo = args.ph_lo, hi = args.ph_hi;
#define IN(k) (lo <= (k) && (k) < hi)
#define SEAM(k) do { if (IN(k) && IN((k) + 1)) GRID_BAR(); } while (0)

    if (IN(0)) { const Frame F = launder(F0); REP(0) ph_convert(F); REP(1) ph_modpart(F); REP(2) ph_filter(F); }
    SEAM(0);
    if (IN(1)) { const Frame F = launder(F0); REP(3) ph_norm1(F, 0); REP(4) ph_fsum(F); }
    SEAM(1);
    for (int l = 0; l < 2; ++l) {
        const int pb = 2 + l * PH_PER_LAYER;
        if (EN(5) && IN(pb + 0)) { const Frame F = launder(F0);
            pg8::Gemm g{F.w<bf16_t>(WS_HB), F.w<bf16_t>(WS_WINT) + (size_t)l * PC * D, D};
            pg8::SchedGrid S{PC / 256, (T / 256) * (PC / 256), F.G, F.bid};
            pg8::EpiBf16 E{F.w<bf16_t>(WS_P), PC, nullptr, 0};
            REP(5) pg8::gemm_phase<pg8::EpiBf16, pg8::SchedGrid>(F.lds, g, S, E, F.tid);
        }
        SEAM(pb + 0);
        if (IN(pb + 1)) { const Frame F = launder(F0); REP(6) ph_ssd_prep(F, l); REP(7) ph_hy_prep(F, l); REP(8) ph_na(F, l); }
        SEAM(pb + 1);
        if (IN(pb + 2)) { const Frame F = launder(F0); REP(9) ph_ssd_scan(F); REP(10) { ph_hy_conv(F, l); if (l == 0) ph_hy_conv_ctx(F, l); } }
        SEAM(pb + 2);
        if (EN(11) && IN(pb + 3)) { const Frame F = launder(F0); REP(11) ph_ssd_out(F, l); REP(18) ph_hy_tr(F); }
        SEAM(pb + 3);
        if (EN(12) && IN(pb + 4)) { const Frame F = launder(F0);
            pg8::Gemm g{F.w<bf16_t>(WS_MIX), F.w<bf16_t>(WS_WOUTT) + (size_t)l * D * D, D};
            const int nM = (l == 0) ? T / 256 : L / 256;
            pg8::SchedGrid S{4, nM * 4, F.G, F.bid};
            pg8::EpiF32 E{F.w<float>(WS_MIXO), D};
            REP(12) pg8::gemm_phase<pg8::EpiF32, pg8::SchedGrid>(F.lds, g, S, E, F.tid);
        }
        SEAM(pb + 4);
        if (EN(13) && IN(pb + 5)) { const Frame F = launder(F0); ph_post1(F, l); }
        SEAM(pb + 5);
        if (EN(14) && IN(pb + 6)) { const Frame F = launder(F0); REP(14) ph_gather(F, l); }
        SEAM(pb + 6);
        if (EN(15) && IN(pb + 7)) { const Frame F = launder(F0);
            const int* tab = F.w<int>(WS_CTL) + CW_TILE + l * 320;
            const int ntiles = __builtin_amdgcn_readfirstlane(F.w<int>(WS_CTL)[CW_NT + l]);
            pg8::Gemm g{F.w<bf16_t>(WS_XG), F.w<bf16_t>(WS_WGUT) + (size_t)l * NE * 2048 * D, D};
            pg8::SchedMoe S{8, ntiles * 8, F.G, F.bid, tab};
            pg8::EpiAct E{F.w<bf16_t>(WS_HMID), F.in[I_BGU] + (size_t)l * NE * 2048};
            REP(15) pg8::gemm_phase<pg8::EpiAct, pg8::SchedMoe>(F.lds, g, S, E, F.tid);
        }
        SEAM(pb + 7);
        if (EN(16) && IN(pb + 8)) { const Frame F = launder(F0);
            const int* tab = F.w<int>(WS_CTL) + CW_TILE + l * 320;
            const int ntiles = __builtin_amdgcn_readfirstlane(F.w<int>(WS_CTL)[CW_NT + l]);
            pg8::Gemm g{F.w<bf16_t>(WS_HMID), F.w<bf16_t>(WS_WDT) + (size_t)l * NE * D * D, D};
            pg8::SchedMoe S{4, ntiles * 4, F.G, F.bid, tab};
            pg8::EpiBf16 E{F.w<bf16_t>(WS_Y), D, F.in[I_BDN] + (size_t)l * NE * D, D};
            REP(16) pg8::gemm_phase<pg8::EpiBf16, pg8::SchedMoe>(F.lds, g, S, E, F.tid);
        }
        SEAM(pb + 8);
        if (EN(17) && IN(pb + 9)) { const Frame F = launder(F0); ph_final(F, l); }
        if (l == 0) SEAM(pb + 9);
    }
#undef IN
#undef SEAM
}

extern "C" void kernel_launch(void* const* d_in, const int* in_sizes, int n_in, void* d_out, int out_size, void* d_ws, size_t ws_size, hipStream_t stream) {
    static int grid = 0;
    if (grid == 0) {
        if (n_in != N_IN || out_size != L * D || ws_size < WS_END) { fprintf(stderr, "kernel_launch: unexpected shapes: n_in %d out %d ws %zu (need %zu)\n", n_in, out_size, ws_size, (size_t)WS_END); grid = -1; return; }
        int dev = 0, cus = 0, per_cu = 0;
        if (hipGetDevice(&dev) != hipSuccess || hipDeviceGetAttribute(&cus, hipDeviceAttributeMultiprocessorCount, dev) != hipSuccess) { grid = -1; return; }
        if (hipFuncSetAttribute((const void*)mega, hipFuncAttributeMaxDynamicSharedMemorySize, LDS_BYTES) != hipSuccess) { fprintf(stderr, "kernel_launch: hipFuncSetAttribute failed\n"); grid = -1; return; }
        if (hipOccupancyMaxActiveBlocksPerMultiprocessor(&per_cu, (const void*)mega, NTHREADS, LDS_BYTES) != hipSuccess || per_cu < 1) { fprintf(stderr, "kernel_launch: occupancy query says %d\n", per_cu); }
        (void)hipGetLastError();
        grid = cus;
    }
    if (grid < 0) return;
    (void)hipMemsetAsync((char*)d_ws + WS_CTL, 0, CTL_BYTES, stream);
    Args a{};
    for (int i = 0; i < N_IN; ++i) a.in[i] = (const float*)d_in[i];
    a.out = (float*)d_out; a.ws = (unsigned char*)d_ws;
#if N_LAUNCH_MODE == 1
    a.ph_lo = 0; a.ph_hi = N_PHASES;
    hipLaunchKernelGGL(mega, dim3(grid), dim3(NTHREADS), LDS_BYTES, stream, a);
#else
    for (int p = 0; p < N_PHASES; ++p) { a.ph_lo = p; a.ph_hi = p + 1; hipLaunchKernelGGL(mega, dim3(grid), dim3(NTHREADS), LDS_BYTES, stream, a); }
#endif
}
```

```cpp
#include <hip/hip_runtime.h>
#include <cstdio>
#include <cstdint>

#define LAS __attribute__((address_space(3)))
typedef unsigned short bf16_t;
typedef short bf16x8 __attribute__((ext_vector_type(8)));
typedef float f32x4 __attribute__((ext_vector_type(4)));
typedef float f32x16 __attribute__((ext_vector_type(16)));
typedef unsigned u32x4 __attribute__((ext_vector_type(4)));
typedef unsigned u32x2 __attribute__((ext_vector_type(2)));
typedef int v4i __attribute__((ext_vector_type(4)));
typedef int v8i __attribute__((ext_vector_type(8)));

#ifndef N_LAUNCH_MODE
#define N_LAUNCH_MODE 1
#endif

constexpr int D = 1024, L = 16384, LC = 256, T = L + LC, NCH = T / 128;
constexpr int PC = 3328;
constexpr int CZ = 0, CXBC = 384, CQ = 1280, CK = 1664, CV = 2048, CHY = 2432, CDT = 3200;
constexpr int NE = 32;
constexpr int MAXT = 292;
constexpr int MAXROWS = MAXT * 256;
constexpr int NTHREADS = 512;
constexpr int LDS_BYTES = 160 * 1024;
constexpr float RMS_EPS = 1e-6f;

enum { I_X = 0, I_C, I_CTX, I_CCTX, I_WMOD, I_BMOD, I_NORMG, I_WIN, I_SCW, I_SCB, I_ALOG, I_DTB, I_SSDD, I_SSDNG, I_RPB, I_HCW, I_HCB,
       I_FW1, I_FB1, I_FW2, I_FB2, I_FW3, I_FREQ, I_HYD, I_WOUT, I_WR, I_BR, I_WGU, I_BGU, I_WDN, I_BDN, N_IN };

constexpr size_t al256(size_t x) { return (x + 255) & ~(size_t)255; }
constexpr size_t WS_CTL   = 0;
constexpr size_t CTL_BYTES = 64 * 1024;
constexpr size_t WS_WINT  = WS_CTL + CTL_BYTES;
constexpr size_t WS_WOUTT = WS_WINT + al256((size_t)2 * PC * D * 2);
constexpr size_t WS_WGUT  = WS_WOUTT + al256((size_t)2 * D * D * 2);
constexpr size_t WS_WDT   = WS_WGUT + al256((size_t)2 * NE * 2048 * D * 2);
constexpr size_t WS_MODP  = WS_WDT + al256((size_t)2 * NE * D * D * 2);
constexpr int KRL = 2 * L + 512;
constexpr size_t WS_KR    = WS_MODP + al256((size_t)2 * 2 * 32 * 6144 * 4);
constexpr size_t WS_KCOMBC= WS_KR + al256((size_t)2 * 256 * KRL * 2);
constexpr size_t WS_FPART = WS_KCOMBC + al256((size_t)2 * LC * 256 * 4);
constexpr size_t WS_FPARTC= WS_FPART + al256((size_t)2 * 256 * 512 * 4);
constexpr size_t WS_FSUM  = WS_FPARTC + al256((size_t)16 * 512 * 4);
constexpr size_t WS_HB    = WS_FSUM + al256((size_t)3 * 256 * 4);
constexpr size_t WS_P     = WS_HB + al256((size_t)T * D * 2);
constexpr size_t WS_XBC   = WS_P + al256((size_t)T * PC * 2);
constexpr size_t WS_DTV   = WS_XBC + al256((size_t)T * 896 * 2);
constexpr size_t WS_ACS   = WS_DTV + al256((size_t)T * 12 * 4);
constexpr size_t WS_ALAST = WS_ACS + al256((size_t)T * 12 * 4);
constexpr size_t WS_STATES= WS_ALAST + al256((size_t)NCH * 12 * 4);
constexpr size_t WS_SSTART= WS_STATES + al256((size_t)2 * NCH * 6 * 128 * 64 * 4);
constexpr size_t WS_U     = WS_SSTART + al256((size_t)2 * NCH * 6 * 128 * 64 * 4);
constexpr size_t WS_UT    = WS_U + al256((size_t)T * 256 * 4);
constexpr size_t WS_X0T   = WS_UT + al256((size_t)256 * L * 2);
constexpr size_t WS_YT    = WS_X0T + al256((size_t)256 * L * 2);
constexpr size_t WS_MIX   = WS_YT + al256((size_t)256 * L * 2);
constexpr size_t WS_MIXO  = WS_MIX + al256((size_t)T * D * 2);
constexpr size_t WS_XCUR  = WS_MIXO + al256((size_t)T * D * 4);
constexpr size_t WS_H2    = WS_XCUR + al256((size_t)T * D * 4);
constexpr size_t WS_RE    = WS_H2 + al256((size_t)(T + 1) * D * 2);
constexpr size_t WS_RP    = WS_RE + al256((size_t)T * 4 * 4);
constexpr size_t WS_RW    = WS_RP + al256((size_t)T * 4 * 4);
constexpr size_t WS_SLOT  = WS_RW + al256((size_t)T * 4 * 4);
constexpr size_t WS_XG    = WS_SLOT + al256((size_t)T * 4 * 4);
constexpr size_t WS_HMID  = WS_XG + 256;
constexpr size_t WS_Y     = WS_HMID + al256((size_t)2 * MAXROWS * D * 2);
constexpr size_t WS_VECS  = WS_Y + al256((size_t)2 * MAXROWS * D * 2);
constexpr size_t WS_ROWTOK= WS_VECS + al256((size_t)2 * 2 * 6 * 1024 * 4);
constexpr size_t WS_END   = WS_ROWTOK + al256((size_t)2 * MAXROWS * 4);

constexpr int CW_BAR = 0;
constexpr int CW_CNT = 8192;
constexpr int CW_NT = 4200;
constexpr int CW_TILE = 4224;

__device__ __forceinline__ float bf2f(unsigned short b) { return __uint_as_float(((unsigned)b) << 16); }
__device__ __forceinline__ unsigned short f2bf(float f) { unsigned u = __float_as_uint(f); u += 0x7FFFu + ((u >> 16) & 1u); return (unsigned short)(u >> 16); }
__device__ __forceinline__ unsigned pk_bf16(float lo, float hi) { return (unsigned)f2bf(lo) | ((unsigned)f2bf(hi) << 16); }
__device__ __forceinline__ float sat8(float x) { return fminf(fmaxf(x, -448.0f), 448.0f); }
__device__ __forceinline__ unsigned pk_fp8x4(float a, float b, float c, float d) { unsigned w = 0; w = __builtin_amdgcn_cvt_pk_fp8_f32(sat8(a), sat8(b), w, false); w = __builtin_amdgcn_cvt_pk_fp8_f32(sat8(c), sat8(d), w, true); return w; }
constexpr float W8_SCALE = 32.0f;
constexpr int W8_SCALE_E8M0 = 0x7A7A7A7A, ONE_E8M0 = 0x7F7F7F7F;
__device__ __forceinline__ float bflo(unsigned w) { return __uint_as_float(w << 16); }
__device__ __forceinline__ float bfhi(unsigned w) { return __uint_as_float(w & 0xFFFF0000u); }
__device__ __forceinline__ float silu_f(float x) { return x / (1.0f + __expf(-x)); }
__device__ __forceinline__ float softplus_f(float x) { return x > 20.f ? x : log1pf(__expf(x)); }
__device__ __forceinline__ float wave_sum(float v) {
#pragma unroll
    for (int o = 32; o >= 1; o >>= 1) v += __shfl_xor(v, o);
    return v;
}
__device__ __forceinline__ void lds_fence() { asm volatile("s_waitcnt lgkmcnt(0)" ::: "memory"); }

#define XB_TMO      128
#define XB_XCNT(j)  (256  + 64 * (j))
#define XB_XSUB(j)  (1280 + 64 * (j))
#define XB_XGEN(j)  (2304 + 64 * (j))
#define XB_TOP      3328
#define XB_TOPGEN   3392
#define XCD_BAR_WORDS 3456
#define XB_SPIN_CAP (1u << 18)
__device__ __forceinline__ unsigned xb_ld(unsigned* p)              { return __hip_atomic_load(p, __ATOMIC_RELAXED, __HIP_MEMORY_SCOPE_AGENT); }
__device__ __forceinline__ unsigned xb_add(unsigned* p, unsigned v) { return __hip_atomic_fetch_add(p, v, __ATOMIC_RELAXED, __HIP_MEMORY_SCOPE_AGENT); }
__device__ __forceinline__ unsigned xb_xcc_id() { return (unsigned)__builtin_amdgcn_s_getreg((3 << 11) | 20) & 0xFu; }
#define XB_SPIN(cond, bar) do { unsigned _sp = 0; while (cond) { __builtin_amdgcn_s_sleep(1); \
    if ((++_sp & 255u) == 0u) { if (xb_ld(&(bar)[XB_TMO])) break; if (_sp > XB_SPIN_CAP) { atomicAdd(&(bar)[XB_TMO], 1u); break; } } } } while (0)
struct XcdBarrier { unsigned* bar; unsigned x; volatile LAS unsigned* st; };
__device__ __forceinline__ XcdBarrier xcd_barrier_post(unsigned* bar, volatile LAS unsigned* st) {
    XcdBarrier b; b.bar = bar; b.x = xb_xcc_id(); b.st = st;
    if (threadIdx.x == 0) (void)xb_add(&bar[XB_XCNT(b.x)], 1u);
    return b;
}
__device__ __forceinline__ void xcd_barrier_complete(unsigned* bar, unsigned x, unsigned& nloc, unsigned& nx) {
    const unsigned G = gridDim.x * gridDim.y * gridDim.z;
    unsigned sum, cnt, mine, sp = 0u;
    for (;;) {
        sum = 0u; cnt = 0u; mine = 0u;
#pragma unroll
        for (unsigned j = 0; j < 16; ++j) { const unsigned c = xb_ld(&bar[XB_XCNT(j)]); sum += c; cnt += (c > 0u) ? 1u : 0u; mine = (j == x) ? c : mine; }
        if (sum == G) break;
        __builtin_amdgcn_s_sleep(1);
        if ((++sp & 255u) == 0u) { if (xb_ld(&bar[XB_TMO])) break; if (sp > XB_SPIN_CAP) { atomicAdd(&bar[XB_TMO], 1u); break; } }
    }
    nloc = mine > 0u ? mine : 1u; nx = cnt > 0u ? cnt : 1u;
}
__device__ __forceinline__ void xcd_barrier(const XcdBarrier& b) {
    asm volatile("s_waitcnt vmcnt(0)" ::: "memory");
    __syncthreads();
    if (threadIdx.x == 0) {
        unsigned* bar = b.bar;
        __builtin_amdgcn_s_waitcnt(0);
        unsigned nloc = b.st[0], nx = b.st[1];
        if (nloc == 0u) { xcd_barrier_complete(bar, b.x, nloc, nx); b.st[0] = nloc; b.st[1] = nx; }
        const unsigned old = xb_add(&bar[XB_XSUB(b.x)], 1u);
        const unsigned gen = old / nloc;
        if (old + 1u == (gen + 1u) * nloc) {
            __builtin_amdgcn_fence(__ATOMIC_RELEASE, "agent");
            asm volatile("s_waitcnt vmcnt(0)" ::: "memory");
            const unsigned og = xb_add(&bar[XB_TOP], 1u);
            const unsigned tg = og / nx;
            if (og + 1u == (tg + 1u) * nx) xb_add(&bar[XB_TOPGEN], 1u);
            else XB_SPIN(xb_ld(&bar[XB_TOPGEN]) == tg, bar);
            __builtin_amdgcn_fence(__ATOMIC_ACQUIRE, "agent");
            xb_add(&bar[XB_XGEN(b.x)], 1u);
            asm volatile("s_waitcnt vmcnt(0)" ::: "memory");
        } else {
            XB_SPIN(xb_ld(&bar[XB_XGEN(b.x)]) == gen, bar);
            __builtin_amdgcn_fence(__ATOMIC_ACQUIRE, "agent");
            asm volatile("s_waitcnt vmcnt(0)" ::: "memory");
        }
    }
    __syncthreads();
}

#ifndef GEMM_REP
#define GEMM_REP 1
#endif
namespace pg8 {
constexpr int BM = 256, BK = 64, HALF = 128, HTB = HALF * BK * 2, STAGE_BYTES = 8 * HTB;
__host__ __device__ __forceinline__ int lds_byte(int r, int c) { const int st = (r >> 4) * 2 + (c >> 5), rr = r & 15, cc = c & 31, ob = rr * 64 + cc * 2; return st * 1024 + (ob ^ (((ob >> 9) & 1) << 5)); }
__host__ __device__ __forceinline__ void stage_rc(int b, int& R, int& C) { const int st = b / 1024, sb = b % 1024, swz = sb ^ (((sb >> 9) & 1) << 5); R = (st >> 1) * 16 + swz / 64; C = (st & 1) * 32 + (swz % 64) / 2; }
__host__ __device__ __forceinline__ int perm32(int rho) { const int n = rho >> 4, i = rho & 15; return 8 * (i >> 2) + 4 * n + (i & 3); }

struct Unit { int pa, pb, pn, e; };
struct Gemm { const bf16_t* A; const bf16_t* Bt; int K; };

template <class Epi, class Sched, bool ALIGN_EPI = true, bool GATHER = false, bool FP8 = false>
__device__ __forceinline__ void gemm_phase(LAS unsigned char* lds, const Gemm g, const Sched& S, const Epi& E, const int tid, const LAS int* rowtab = nullptr) {
    const int wid = __builtin_amdgcn_readfirstlane(tid >> 6), lane = tid & 63, wr = wid >> 2, wc = wid & 3, fr = lane & 15, fq = lane >> 4;
    const int K = g.K, nt = K / BK;
    unsigned voffA[2], voffB[2];
    int gR[2], gC[2];
#pragma unroll
    for (int i = 0; i < 2; ++i) { int R, C; stage_rc(tid * 16 + i * 8192, R, C); const int Rb = Epi::PERM ? ((R & ~31) + perm32(R & 31)) : R;
        voffA[i] = (unsigned)(R * K + C) * 2u; voffB[i] = (unsigned)(Rb * K + C) * 2u; gR[i] = R; gC[i] = C * 2; }
    unsigned vC0[2], vC1[2], vN0[2], vN1[2];
#define PG8_GOFFS(dst0, dst1, ui_) do { _Pragma("unroll") for (int _i = 0; _i < 2; ++_i) { \
        dst0[_i] = (unsigned)rowtab[(ui_) * 256 + gR[_i]] * (unsigned)(K * 2) + (unsigned)gC[_i]; dst1[_i] = (unsigned)rowtab[(ui_) * 256 + 128 + gR[_i]] * (unsigned)(K * 2) + (unsigned)gC[_i]; } } while (0)
    const size_t kstep = (size_t)(BK * 2);
    const size_t hstep = (size_t)HALF * K * 2;
    const size_t tstep = 2 * hstep;
    const unsigned ldsw = (unsigned)wid * 1024u;
    const int aoff = lds_byte(wr * 64 + fr, fq * 8), boff = lds_byte(wc * 32 + fr, fq * 8);
#define PG8_SA(b, h) (((b) * 2 + (h)) * HTB)
#define PG8_SB(b, h) ((4 + (b) * 2 + (h)) * HTB)
#define PG8_STAGE(bufoff, gbase, voff) do { _Pragma("unroll") for (int _i = 0; _i < 2; ++_i) \
        __builtin_amdgcn_global_load_lds((const unsigned*)((const char*)(gbase) + (voff)[_i]), (LAS unsigned*)(lds + (bufoff) + ldsw + _i * 8192), 16, 0, 0); } while (0)
#define PG8_LDA(dst, b, h) do { _Pragma("unroll") for (int m = 0; m < 4; ++m) { const v4i _x = *(const LAS v4i*)(lds + PG8_SA(b, h) + aoff + m * 2048), _y = *(const LAS v4i*)(lds + PG8_SA(b, h) + aoff + m * 2048 + 1024); \
        dst[m] = __builtin_shufflevector(_x, _y, 0, 1, 2, 3, 4, 5, 6, 7); } } while (0)
#define PG8_LDB(dst, b, h) do { _Pragma("unroll") for (int n = 0; n < 2; ++n) { const v4i _x = *(const LAS v4i*)(lds + PG8_SB(b, h) + boff + n * 2048), _y = *(const LAS v4i*)(lds + PG8_SB(b, h) + boff + n * 2048 + 1024); \
        dst[n] = __builtin_shufflevector(_x, _y, 0, 1, 2, 3, 4, 5, 6, 7); } } while (0)
#define PG8_HALF0(x) __builtin_bit_cast(bf16x8, __builtin_shufflevector((x), (x), 0, 1, 2, 3))
#define PG8_HALF1(x) __builtin_bit_cast(bf16x8, __builtin_shufflevector((x), (x), 4, 5, 6, 7))
#define PG8_MMA(ai, bj, At, Bt) do { __builtin_amdgcn_s_setprio(1); if constexpr (FP8) { _Pragma("unroll") for (int m = 0; m < 4; ++m) _Pragma("unroll") for (int n = 0; n < 2; ++n) \
        asm volatile("v_mfma_scale_f32_16x16x128_f8f6f4 %0, %1, %2, %0, %3, %4 op_sel_hi:[0,0,0]" : "+v"(acc[ai][bj][m][n]) : "v"(Bt[n]), "v"(At[m]), "v"(sclW), "v"(sclX)); } \
        else { _Pragma("unroll") for (int m = 0; m < 4; ++m) _Pragma("unroll") for (int n = 0; n < 2; ++n) { \
        acc[ai][bj][m][n] = __builtin_amdgcn_mfma_f32_16x16x32_bf16(PG8_HALF0(Bt[n]), PG8_HALF0(At[m]), acc[ai][bj][m][n], 0, 0, 0); \
        acc[ai][bj][m][n] = __builtin_amdgcn_mfma_f32_16x16x32_bf16(PG8_HALF1(Bt[n]), PG8_HALF1(At[m]), acc[ai][bj][m][n], 0, 0, 0); } } __builtin_amdgcn_s_setprio(0); } while (0)
#define PG8_WAIT_V(n) asm volatile("s_waitcnt vmcnt(" #n ")" ::: "memory")
#define PG8_WAIT_L(n) asm volatile("s_waitcnt lgkmcnt(" #n ")" ::: "memory")
#define PG8_BAR __builtin_amdgcn_s_barrier()
#define PG8_SCHED __builtin_amdgcn_sched_barrier(0)
    Unit cur, nxt; int ui = 0;
    if (!S.next(0, cur)) return;
    f32x4 acc[2][2][4][2];
    E.init(acc, cur, wc, fq);
    const int sclW = W8_SCALE_E8M0, sclX = ONE_E8M0;
    v8i At[4], B0[2], B1[2];
    const char* cA = GATHER ? (const char*)g.A : (const char*)g.A + (size_t)cur.pa * tstep; const char* cB = (const char*)g.Bt + (size_t)cur.pb * tstep;
    const size_t hstepA = GATHER ? 0 : hstep;
    if constexpr (GATHER) { PG8_GOFFS(vC0, vC1, 0); } else {
#pragma unroll
        for (int i = 0; i < 2; ++i) { vC0[i] = voffA[i]; vC1[i] = voffA[i]; vN0[i] = voffA[i]; vN1[i] = voffA[i]; } }
    PG8_STAGE(PG8_SB(0, 0), cB, voffB); PG8_STAGE(PG8_SB(0, 1), cB + hstep, voffB); PG8_STAGE(PG8_SA(0, 0), cA, vC0); PG8_STAGE(PG8_SA(0, 1), cA + hstepA, vC1);
    if (wr == 1) PG8_BAR;
    PG8_WAIT_V(2); PG8_BAR;
    PG8_STAGE(PG8_SB(1, 0), cB + kstep, voffB); PG8_STAGE(PG8_SA(1, 0), cA + kstep, vC0); PG8_STAGE(PG8_SB(1, 1), cB + hstep + kstep, voffB);
    PG8_WAIT_V(6); PG8_BAR;
    for (;;) {
        const bool has_next = S.next(ui + 1, nxt);
        const char* nA = GATHER ? (const char*)g.A : (has_next ? (const char*)g.A + (size_t)nxt.pa * tstep : cA); const char* nB = has_next ? (const char*)g.Bt + (size_t)nxt.pb * tstep : cB;
        if constexpr (GATHER) { if (has_next) { PG8_GOFFS(vN0, vN1, ui + 1); } else {
#pragma unroll
            for (int i = 0; i < 2; ++i) { vN0[i] = vC0[i]; vN1[i] = vC1[i]; } } }
#pragma unroll 1
        for (int t = 0; t < nt; t += 2) {
            const bool last = (t == nt - 2);
            unsigned vX0[2], vX1[2];
#pragma unroll
            for (int i = 0; i < 2; ++i) { vX0[i] = (GATHER && last) ? vN0[i] : vC0[i]; vX1[i] = (GATHER && last) ? vN1[i] : vC1[i]; }
            const char* a1 = cA + (size_t)(t + 1) * kstep;
            const char* a2 = last ? nA : cA + (size_t)(t + 2) * kstep; const char* b2 = last ? nB : cB + (size_t)(t + 2) * kstep;
            const char* a3 = a2 + kstep; const char* b3 = b2 + kstep;
            PG8_LDB(B0, 0, 0); PG8_LDB(B1, 0, 1); PG8_SCHED; PG8_LDA(At, 0, 0); PG8_STAGE(PG8_SA(1, 1), a1 + hstepA, vC1);
            PG8_WAIT_V(8); PG8_WAIT_L(0); PG8_BAR; PG8_MMA(0, 0, At, B0); PG8_MMA(0, 1, At, B1); PG8_BAR; PG8_SCHED;
            PG8_LDA(At, 0, 1); PG8_STAGE(PG8_SB(0, 0), b2, voffB); PG8_STAGE(PG8_SB(0, 1), b2 + hstep, voffB); PG8_STAGE(PG8_SA(0, 0), a2, vX0);
            PG8_WAIT_V(8); PG8_WAIT_L(0); PG8_BAR; PG8_MMA(1, 0, At, B0); PG8_MMA(1, 1, At, B1); PG8_BAR; PG8_SCHED;
            PG8_LDB(B0, 1, 0); PG8_LDB(B1, 1, 1); PG8_SCHED; PG8_LDA(At, 1, 0); PG8_STAGE(PG8_SA(0, 1), a2 + hstepA, vX1);
            PG8_WAIT_V(8); PG8_WAIT_L(0); PG8_BAR; PG8_MMA(0, 0, At, B0); PG8_MMA(0, 1, At, B1); PG8_BAR; PG8_SCHED;
            PG8_LDA(At, 1, 1); PG8_STAGE(PG8_SB(1, 0), b3, voffB); PG8_STAGE(PG8_SB(1, 1), b3 + hstep, voffB); PG8_STAGE(PG8_SA(1, 0), a3, vX0);
            PG8_WAIT_V(8); PG8_WAIT_L(0); PG8_BAR; PG8_MMA(1, 0, At, B0); PG8_MMA(1, 1, At, B1); PG8_BAR; PG8_SCHED;
        }
        if constexpr (ALIGN_EPI) { if (wr == 0) PG8_BAR; }
        E(acc, cur, wr, wc, fr, fq);
        if (!has_next) break;
        E.init(acc, nxt, wc, fq);
        cur = nxt; cA = nA; cB = nB; ++ui;
        if constexpr (GATHER) {
#pragma unroll
            for (int i = 0; i < 2; ++i) { vC0[i] = vN0[i]; vC1[i] = vN1[i]; } }
        if constexpr (ALIGN_EPI) { if (wr == 1) PG8_BAR; }
    }
    PG8_WAIT_V(0);
    if constexpr (!ALIGN_EPI) { if (wr == 0) PG8_BAR; }
    PG8_BAR;
#undef PG8_GOFFS
#undef PG8_HALF0
#undef PG8_HALF1
#undef PG8_SA
#undef PG8_SB
#undef PG8_STAGE
#undef PG8_LDA
#undef PG8_LDB
#undef PG8_MMA
#undef PG8_WAIT_V
#undef PG8_WAIT_L
#undef PG8_BAR
#undef PG8_SCHED
}

struct EpiF32 {
    static constexpr bool PERM = false;
    float* C; int ldc;
    __device__ __forceinline__ void operator()(const f32x4 (&acc)[2][2][4][2], const Unit& u, int wr, int wc, int fr, int fq) const {
        const int row0 = u.pa * BM + wr * 64 + fr, col0 = u.pn * BM + wc * 32 + 4 * fq;
#pragma unroll
        for (int ai = 0; ai < 2; ++ai)
#pragma unroll
            for (int m = 0; m < 4; ++m) { float* rowp = C + (size_t)(row0 + ai * HALF + m * 16) * ldc + col0;
#pragma unroll
                for (int bj = 0; bj < 2; ++bj)
#pragma unroll
                    for (int n = 0; n < 2; ++n) *(f32x4*)(rowp + bj * HALF + n * 16) = acc[ai][bj][m][n]; }
    }
};
struct EpiBf16 {
    static constexpr bool PERM = true;
    bf16_t* O; int ldc; const float* bias; int bias_stride;
    __device__ __forceinline__ void init(f32x4 (&acc)[2][2][4][2], const Unit& u, int wc, int fq) const {
        const int col0 = u.pn * BM + wc * 32 + 8 * fq;
#pragma unroll
        for (int bj = 0; bj < 2; ++bj)
#pragma unroll
            for (int n = 0; n < 2; ++n) { const f32x4 bv = bias ? *(const f32x4*)(bias + (size_t)u.e * bias_stride + col0 + bj * HALF + 4 * n) : (f32x4){0.f, 0.f, 0.f, 0.f};
#pragma unroll
                for (int ai = 0; ai < 2; ++ai)
#pragma unroll
                    for (int m = 0; m < 4; ++m) acc[ai][bj][m][n] = bv; }
    }
    __device__ __forceinline__ void operator()(const f32x4 (&acc)[2][2][4][2], const Unit& u, int wr, int wc, int fr, int fq) const {
        const int row0 = u.pa * BM + wr * 64 + fr; const int col0 = u.pn * BM + wc * 32 + 8 * fq;
#pragma unroll
        for (int ai = 0; ai < 2; ++ai)
#pragma unroll
            for (int m = 0; m < 4; ++m) { bf16_t* rowp = O + (size_t)(row0 + ai * HALF + m * 16) * ldc + col0;
#pragma unroll
                for (int bj = 0; bj < 2; ++bj) { const f32x4 v0 = acc[ai][bj][m][0], v1 = acc[ai][bj][m][1];
                    u32x4 w; w.x = pk_bf16(v0[0], v0[1]); w.y = pk_bf16(v0[2], v0[3]); w.z = pk_bf16(v1[0], v1[1]); w.w = pk_bf16(v1[2], v1[3]);
                    *(u32x4*)(rowp + bj * HALF) = w; } }
    }
};
struct EpiAct {
    static constexpr bool PERM = true;
    unsigned char* O; const float* bias;
    __device__ __forceinline__ void init(f32x4 (&acc)[2][2][4][2], const Unit& u, int wc, int fq) const {
        const float* bg = bias + (size_t)u.e * 2048 + u.pn * 128 + wc * 32 + 8 * fq;
#pragma unroll
        for (int bj = 0; bj < 2; ++bj)
#pragma unroll
            for (int n = 0; n < 2; ++n) { const f32x4 bv = *(const f32x4*)(bg + bj * 1024 + 4 * n);
#pragma unroll
                for (int ai = 0; ai < 2; ++ai)
#pragma unroll
                    for (int m = 0; m < 4; ++m) acc[ai][bj][m][n] = bv; }
    }
    __device__ __forceinline__ void operator()(const f32x4 (&acc)[2][2][4][2], const Unit& u, int wr, int wc, int fr, int fq) const {
        const int row0 = u.pa * BM + wr * 64 + fr; const int cc0 = wc * 32 + 8 * fq; const int ocol = u.pn * 128 + cc0;
#pragma unroll
        for (int ai = 0; ai < 2; ++ai)
#pragma unroll
            for (int m = 0; m < 4; ++m) { unsigned char* rowp = O + (size_t)(row0 + ai * HALF + m * 16) * D + ocol;
                float r[8];
#pragma unroll
                for (int n = 0; n < 2; ++n)
#pragma unroll
                    for (int j = 0; j < 4; ++j) { float gt = acc[ai][0][m][n][j], up = acc[ai][1][m][n][j];
                        gt = fminf(gt, 7.0f); up = fminf(fmaxf(up, -7.0f), 7.0f);
                        r[n * 4 + j] = gt / (1.0f + __expf(-1.702f * gt)) * (up + 1.0f); }
                u32x2 w; w.x = pk_fp8x4(r[0], r[1], r[2], r[3]); w.y = pk_fp8x4(r[4], r[5], r[6], r[7]);
                *(u32x2*)rowp = w; }
    }
};
struct SchedGrid {
    int nN, total, G, c;
    __device__ __forceinline__ bool next(int i, Unit& u) const { int Lx = i * G + c; if (Lx >= GEMM_REP * total) return false; if (GEMM_REP > 1) Lx %= total; u.pa = Lx / nN; u.pn = Lx - u.pa * nN; u.pb = u.pn; u.e = 0; return true; }
};
struct SchedMoe {
    int nN, total, G, c; const int* tile_e;
    __device__ __forceinline__ bool next(int i, Unit& u) const { int Lx = i * G + c; if (Lx >= GEMM_REP * total) return false; if (GEMM_REP > 1) Lx %= total; u.pa = Lx / nN; u.pn = Lx - u.pa * nN; u.e = __builtin_amdgcn_readfirstlane((int)tile_e[u.pa]); u.pb = u.e * nN + u.pn; return true; }
};
}

struct Args { const float* in[N_IN]; float* out; unsigned char* ws; int ph_lo, ph_hi; };

typedef const float* __attribute__((address_space(4))) const* kargp_t;
struct InProxy { kargp_t kp; __device__ __forceinline__ const float* operator[](int i) const { return kp[i]; } };
struct Frame {
    InProxy in; float* out; unsigned char* ws;
    LAS unsigned char* lds;
    int tid, lane, wave, G, bid, vid;
    template <class Tp> __device__ __forceinline__ Tp* w(size_t off) const { return (Tp*)(ws + off); }
};

__device__ __forceinline__ Frame launder(const Frame& F) {
    Frame R = F;
    int t = F.tid; asm volatile("" : "+v"(t)); R.tid = t; R.lane = t & 63; R.wave = __builtin_amdgcn_readfirstlane(t >> 6);
    unsigned long long w = (unsigned long long)F.ws; asm volatile("" : "+s"(w)); R.ws = (unsigned char*)w;
    unsigned long long o = (unsigned long long)F.out; asm volatile("" : "+s"(o)); R.out = (float*)o;
    unsigned long long k = (unsigned long long)F.in.kp; asm volatile("" : "+s"(k)); R.in.kp = (kargp_t)k;
    int g = F.G, b = F.bid; asm volatile("" : "+s"(g), "+s"(b)); R.G = g; R.bid = b; R.vid = (g % 8 == 0) ? (b % 8) * (g / 8) + b / 8 : b;
    return R;
}

__device__ __forceinline__ float mod_val(const Frame& F, int l, int which, int j) {
    const float* mp = F.w<float>(WS_MODP) + (size_t)((l * 2 + which) * 32) * 6144 + j;
    float s = F.in[I_BMOD][l * 6144 + j];
#pragma unroll
    for (int k = 0; k < 32; ++k) s += mp[(size_t)k * 6144];
    return s;
}

struct CvtTile { const float* src; bf16_t* dst; int ld, mode, k0, n0; bool f8; };
__device__ __forceinline__ CvtTile cvt_decode(const Frame& F, int t) {
    CvtTile c;
    if (t < 1664) { const int l = t / 832, r = t % 832; c.n0 = (r / 16) * 64; c.k0 = (r % 16) * 64; c.src = F.in[I_WIN] + (size_t)l * 1024 * 3212; c.ld = 3212; c.mode = 1; c.f8 = false; c.dst = F.w<bf16_t>(WS_WINT) + (size_t)l * PC * D; }
    else if (t < 2176) { const int q = t - 1664, l = q / 256, r = q % 256; c.n0 = (r / 16) * 64; c.k0 = (r % 16) * 64; c.src = F.in[I_WOUT] + (size_t)l * D * D; c.ld = 1024; c.mode = 0; c.f8 = false; c.dst = F.w<bf16_t>(WS_WOUTT) + (size_t)l * D * D; }
    else if (t < 34944) { const int q = t - 2176, le = q / 512, r = q % 512; c.n0 = (r / 16) * 64; c.k0 = (r % 16) * 64; c.src = F.in[I_WGU] + (size_t)le * 1024 * 2048; c.ld = 2048; c.mode = 2; c.f8 = true; c.dst = (bf16_t*)(F.w<unsigned char>(WS_WGUT) + (size_t)le * 2048 * D); }
    else { const int q = t - 34944, le = q / 256, r = q % 256; c.n0 = (r / 16) * 64; c.k0 = (r % 16) * 64; c.src = F.in[I_WDN] + (size_t)le * D * D; c.ld = 1024; c.mode = 0; c.f8 = true; c.dst = (bf16_t*)(F.w<unsigned char>(WS_WDT) + (size_t)le * D * D); }
    return c;
}
__device__ __forceinline__ void cvt_load(const CvtTile& c, int lane, f32x4 (&a)[8], f32x4 (&b)[8]) {
    const int i4 = lane & 15, kpl = lane >> 4;
    const int n = c.n0 + 4 * i4;
    int sc; bool valid = true;
    if (c.mode == 0) sc = n;
    else if (c.mode == 1) { if (n < 1280) sc = n; else if (n < 3200) sc = n + 12; else if (n < 3212) sc = n - 3200 + 1280; else { sc = 0; valid = false; } }
    else { const int pn = n >> 8, rr = n & 255; sc = rr < 128 ? pn * 128 + rr : 1024 + pn * 128 + (rr - 128); }
#pragma unroll
    for (int it = 0; it < 8; ++it) {
        const int r0 = c.f8 ? 4 * (kpl + 4 * (it >> 1)) + 2 * (it & 1) : 2 * (kpl + 4 * it);
        a[it] = (f32x4){0.f, 0.f, 0.f, 0.f}; b[it] = a[it];
        if (valid) { a[it] = __builtin_nontemporal_load((const f32x4*)(c.src + (size_t)(c.k0 + r0) * c.ld + sc)); b[it] = __builtin_nontemporal_load((const f32x4*)(c.src + (size_t)(c.k0 + r0 + 1) * c.ld + sc)); }
    }
}
__device__ __forceinline__ void cvt_store(const CvtTile& c, int lane, const f32x4 (&a)[8], const f32x4 (&b)[8], LAS unsigned* lw) {
    const int i4 = lane & 15, kpl = lane >> 4;
    if (c.f8) {
#pragma unroll
        for (int j = 0; j < 4; ++j) {
            const int kq = kpl + 4 * j;
#pragma unroll
            for (int i = 0; i < 4; ++i) lw[kq * 65 + 4 * i4 + i] = pk_fp8x4(W8_SCALE * a[2 * j][i], W8_SCALE * b[2 * j][i], W8_SCALE * a[2 * j + 1][i], W8_SCALE * b[2 * j + 1][i]);
        }
        lds_fence();
        const int g = lane & 3, nl = lane >> 2;
        unsigned char* d8 = (unsigned char*)c.dst;
#pragma unroll
        for (int it = 0; it < 4; ++it) {
            const int nn = nl + 16 * it;
            u32x4 v; v.x = lw[(4 * g + 0) * 65 + nn]; v.y = lw[(4 * g + 1) * 65 + nn]; v.z = lw[(4 * g + 2) * 65 + nn]; v.w = lw[(4 * g + 3) * 65 + nn];
            *(u32x4*)(d8 + (size_t)(c.n0 + nn) * 1024 + c.k0 + 16 * g) = v;
        }
        lds_fence();
        return;
    }
#pragma unroll
    for (int it = 0; it < 8; ++it) {
        const int kp = kpl + 4 * it;
#pragma unroll
        for (int i = 0; i < 4; ++i) lw[kp * 65 + 4 * i4 + i] = pk_bf16(a[it][i], b[it][i]);
    }
    lds_fence();
    const int g = lane & 7, nl = lane >> 3;
#pragma unroll
    for (int it = 0; it < 8; ++it) {
        const int nn = nl + 8 * it;
        u32x4 v; v.x = lw[(4 * g + 0) * 65 + nn]; v.y = lw[(4 * g + 1) * 65 + nn]; v.z = lw[(4 * g + 2) * 65 + nn]; v.w = lw[(4 * g + 3) * 65 + nn];
        *(u32x4*)(c.dst + (size_t)(c.n0 + nn) * 1024 + c.k0 + 8 * g) = v;
    }
    lds_fence();
}

__device__ __forceinline__ void ph_convert(const Frame& F) {
    LAS unsigned* lw = (LAS unsigned*)(F.lds) + F.wave * (32 * 65 + 16);
    const int nwaves = F.G * 8, w0 = F.bid * 8 + F.wave;
    f32x4 a0[8], b0[8], a1[8], b1[8];
    int t = w0;
    if (t >= 51328) return;
    CvtTile c0 = cvt_decode(F, t);
    cvt_load(c0, F.lane, a0, b0);
    for (;;) {
        const int t1 = t + nwaves;
        CvtTile c1 = c0;
        if (t1 < 51328) { c1 = cvt_decode(F, t1); cvt_load(c1, F.lane, a1, b1); }
        cvt_store(c0, F.lane, a0, b0, lw);
        if (t1 >= 51328) break;
        const int t2 = t1 + nwaves;
        if (t2 < 51328) { c0 = cvt_decode(F, t2); cvt_load(c0, F.lane, a0, b0); }
        cvt_store(c1, F.lane, a1, b1, lw);
        if (t2 >= 51328) break;
        t = t2;
    }
}

__device__ __forceinline__ void ph_modpart(const Frame& F) {
    for (int it = F.bid; it < 768; it += F.G) {
        const int l = it / 384, r = it % 384, cc = r / 32, kc = r % 32;
        const int j = cc * 512 + F.tid;
        const float* wm = F.in[I_WMOD] + (size_t)l * D * 6144 + (size_t)(kc * 32) * 6144 + j;
        float wv[32];
#pragma unroll
        for (int k = 0; k < 32; ++k) wv[k] = wm[(size_t)k * 6144];
        float a0 = 0.f, a1 = 0.f;
#pragma unroll
        for (int k = 0; k < 32; ++k) { a0 += silu_f(F.in[I_C][kc * 32 + k]) * wv[k]; a1 += silu_f(F.in[I_CCTX][kc * 32 + k]) * wv[k]; }
        float* mp = F.w<float>(WS_MODP);
        mp[(size_t)((l * 2 + 0) * 32 + kc) * 6144 + j] = a0;
        mp[(size_t)((l * 2 + 1) * 32 + kc) * 6144 + j] = a1;
    }
}

__device__ __forceinline__ void ph_filter(const Frame& F) {
    LAS float* zs = (LAS float*)F.lds;
    LAS float* h1 = zs + 64 * 33;
    LAS unsigned char* H2b = F.lds + 24832;
    LAS bf16_t* ob = (LAS bf16_t*)(F.lds + 34048);
    const float min_decay = -4.605170185988091f / 1.5f, max_decay = -4.605170185988091f / 0.3f;
    const int wave = F.wave;
    for (int it = F.bid; it < 512 + 16; it += F.G) {
        int tid = F.tid; asm volatile("" : "+v"(tid));
        const int lane = tid & 63;
        const bool isctx = it >= 512;
        const int l = isctx ? 0 : it / 256, grp = isctx ? it - 512 : it % 256;
        const int Lx = isctx ? LC : L, npos = isctx ? 16 : 64;
        const int t0 = grp * npos;
        __syncthreads();
#pragma unroll 1
        for (int q = tid; q < npos * 33; q += NTHREADS) {
            const int pos = q / 33, i = q % 33; const int t = t0 + pos;
            const float tn = (float)t / (float)(Lx - 1);
            const float wv = 6.283185307179586f * (float)t / (float)Lx;
            float v;
            if (i == 0) v = tn;
            else { const int b = (i - 1) & 15; const float f = 1e-4f + (float)b * ((15.0f - 1e-4f) / 15.0f); v = (i <= 16) ? cosf(f * wv) : -sinf(f * wv); }
            zs[q] = v;
        }
        __syncthreads();
        {
            asm volatile("" : "+v"(tid));
            const int o = tid & 63, pg = tid >> 6;
            if (pg * 8 < npos) {
                float acc[8];
                const float bb = F.in[I_FB1][l * 64 + o];
#pragma unroll
                for (int p = 0; p < 8; ++p) acc[p] = bb;
#pragma unroll 3
                for (int i = 0; i < 33; ++i) { const float w = F.in[I_FW1][(size_t)l * 33 * 64 + i * 64 + o];
#pragma unroll
                    for (int p = 0; p < 8; ++p) acc[p] += zs[(pg * 8 + p) * 33 + i] * w; }
                const float fq = F.in[I_FREQ][l * 128 + o];
#pragma unroll
                for (int p = 0; p < 8; ++p) h1[(pg * 8 + p) * 64 + o] = sinf(fq * acc[p]);
            }
        }
        __syncthreads();
        {
            asm volatile("" : "+v"(tid));
            const int o = tid & 63, pg = tid >> 6;
            if (pg * 8 < npos) {
                float acc[8];
                const float bb = F.in[I_FB2][l * 64 + o];
#pragma unroll
                for (int p = 0; p < 8; ++p) acc[p] = bb;
#pragma unroll 4
                for (int i = 0; i < 64; ++i) { const float w = F.in[I_FW2][(size_t)l * 64 * 64 + i * 64 + o];
#pragma unroll
                    for (int p = 0; p < 8; ++p) acc[p] += h1[(pg * 8 + p) * 64 + i] * w; }
                const float fq = F.in[I_FREQ][l * 128 + 64 + o];
#pragma unroll
                for (int p = 0; p < 8; ++p) *(LAS bf16_t*)(H2b + (pg * 8 + p) * 144 + o * 2) = f2bf(sinf(fq * acc[p]));
            }
        }
        __syncthreads();
        {
            int r = lane & 31, hf = lane >> 5;
#pragma unroll
            for (int n = 0; n < 2; ++n) {
                asm volatile("" : "+v"(r), "+v"(hf));
                const int o = 32 * (2 * wave + n) + r, c = o & 255, dir = o >> 8;
                const float* w3 = F.in[I_FW3] + (size_t)l * 64 * 512 + o;
                f32x16 acc[2];
#pragma unroll
                for (int m = 0; m < 2; ++m)
#pragma unroll
                    for (int i = 0; i < 16; ++i) acc[m][i] = 0.f;
#pragma unroll
                for (int ks = 0; ks < 4; ++ks) {
                    float wv[8];
#pragma unroll
                    for (int e = 0; e < 8; ++e) wv[e] = w3[(size_t)(16 * ks + 8 * hf + e) * 512];
                    bf16x8 b;
#pragma unroll
                    for (int e = 0; e < 8; ++e) b[e] = (short)f2bf(wv[e]);
#pragma unroll
                    for (int m = 0; m < 2; ++m) {
                        const bf16x8 a = *(const LAS bf16x8*)(H2b + (32 * m + r) * 144 + (16 * ks + 8 * hf) * 2);
                        acc[m] = __builtin_amdgcn_mfma_f32_32x32x16_bf16(a, b, acc[m], 0, 0, 0);
                    }
                }
                const float delta = fabsf(min_decay + (float)c * ((max_decay - min_decay) / 255.0f));
                const float dstep = delta / (float)(Lx - 1);
                float asum = 0.f;
                if (!isctx) {
#pragma unroll
                    for (int m = 0; m < 2; ++m)
#pragma unroll
                        for (int rg = 0; rg < 16; ++rg) {
                            const int pos = 32 * m + (rg & 3) + 8 * (rg >> 2) + 4 * hf;
                            const float v = acc[m][rg] * __expf(-(float)(t0 + pos) * dstep);
                            asum += fabsf(v);
                            ob[o * 66 + pos] = f2bf(v);
                        }
                } else {
                    float* kc = F.w<float>(WS_KCOMBC);
#pragma unroll
                    for (int rg = 0; rg < 8; ++rg) {
                        const int pos = (rg & 3) + 8 * (rg >> 2) + 4 * hf, t = t0 + pos;
                        const float v = acc[0][rg] * __expf(-(float)t * dstep);
                        asum += fabsf(v);
                        const int x = dir == 0 ? Lx - 1 + t : Lx - 1 - t;
                        if (dir == 0 || t >= 1) kc[(size_t)x * 256 + c] = v;
                    }
                }
                asum += __shfl_xor(asum, 32);
                if (hf == 0) { if (isctx) F.w<float>(WS_FPARTC)[grp * 512 + o] = asum; else F.w<float>(WS_FPART)[((size_t)l * 256 + grp) * 512 + o] = asum; }
            }
        }
        if (!isctx) {
            __syncthreads();
            bf16_t* KR = F.w<bf16_t>(WS_KR) + (size_t)l * 256 * KRL;
            asm volatile("" : "+v"(tid));
            for (int q = tid; q < 512 * 64; q += NTHREADS) {
                const int o = q >> 6, p = q & 63, c = o & 255, dir = o >> 8;
                if (dir == 0) KR[(size_t)c * KRL + (L - t0 - 63 + p)] = ob[o * 66 + 63 - p];
                else if (t0 + p >= 1) KR[(size_t)c * KRL + (L + t0 + p)] = ob[o * 66 + p];
            }
            if (grp == 0) for (int q = tid; q < 256 * 513; q += NTHREADS) { const int c = q / 513, r = q % 513; KR[(size_t)c * KRL + (r == 512 ? 0 : 2 * L + r)] = 0; }
        }
    }
}

__device__ __forceinline__ void ph_fsum(const Frame& F) {
    const int nwaves = F.G * 8;
    for (int o = F.bid * 8 + F.wave; o < 768; o += nwaves) {
        const int which = o >> 8, c = o & 255;
        float s = 0.f;
        if (which < 2) { const float* fp = F.w<float>(WS_FPART) + (size_t)which * 256 * 512;
            for (int i = F.lane; i < 256; i += 64) s += fp[(size_t)i * 512 + c] + fp[(size_t)i * 512 + 256 + c]; }
        else { const float* fp = F.w<float>(WS_FPARTC); if (F.lane < 16) s = fp[F.lane * 512 + c] + fp[F.lane * 512 + 256 + c]; }
        s = wave_sum(s);
        if (F.lane == 0) F.w<float>(WS_FSUM)[o] = 1.0f / s;
    }
}

__device__ __forceinline__ void ph_vecs(const Frame& F) {
    for (int q = F.bid * NTHREADS + F.tid; q < 2 * 2 * 6 * 1024; q += F.G * NTHREADS) {
        const int j = q & 1023, k = (q >> 10) % 6, which = ((q >> 10) / 6) & 1, l = (q >> 10) / 12;
        const float* ng = F.in[I_NORMG] + (size_t)l * 4 * 1024;
        float v;
        if (k == 0) v = ng[j] * (1.0f + mod_val(F, l, which, 1 * 1024 + j));
        else if (k == 1) v = mod_val(F, l, which, j);
        else if (k == 2) v = ng[1024 + j] * mod_val(F, l, which, 2 * 1024 + j);
        else if (k == 3) v = ng[2048 + j] * (1.0f + mod_val(F, l, which, 4 * 1024 + j));
        else if (k == 4) v = mod_val(F, l, which, 3 * 1024 + j);
        else v = ng[3072 + j] * mod_val(F, l, which, 5 * 1024 + j);
        F.w<float>(WS_VECS)[q] = v;
    }
}
__device__ __forceinline__ const float* vecs_ptr(const Frame& F, int l, int which, int k) { return F.w<float>(WS_VECS) + (size_t)((l * 2 + which) * 6 + k) * 1024; }

__device__ __forceinline__ void load_row(const float* p, int lane, f32x4 (&v)[4]) {
#pragma unroll
    for (int i = 0; i < 4; ++i) v[i] = *(const f32x4*)(p + 4 * lane + 256 * i);
}
__device__ __forceinline__ float row_rstd(const f32x4 (&v)[4]) {
    float s = 0.f;
#pragma unroll
    for (int i = 0; i < 4; ++i) s += v[i][0] * v[i][0] + v[i][1] * v[i][1] + v[i][2] * v[i][2] + v[i][3] * v[i][3];
    s = wave_sum(s);
    return rsqrtf(s * (1.0f / 1024.0f) + RMS_EPS);
}
__device__ __forceinline__ void stage_norm_vecs(const Frame& F, int l, int gain_idx, int sh_seg, int sc_seg, LAS float* dst  ) {
    for (int q = F.tid; q < 2048; q += NTHREADS) {
        const int which = q >> 10, j = q & 1023;
        const float g = F.in[I_NORMG][(l * 4 + gain_idx) * 1024 + j];
        dst[(which * 2 + 0) * 1024 + j] = g * (1.0f + mod_val(F, l, which, sc_seg * 1024 + j));
        dst[(which * 2 + 1) * 1024 + j] = mod_val(F, l, which, sh_seg * 1024 + j);
    }
}
__device__ __forceinline__ void norm_store_bf16(const f32x4 (&v)[4], float rstd, const LAS float* va, const LAS float* vb, bf16_t* orow, int lane) {
#pragma unroll
    for (int i = 0; i < 4; ++i) {
        const int c = 4 * lane + 256 * i;
        const f32x4 a = *(const LAS f32x4*)(va + c), b = *(const LAS f32x4*)(vb + c);
        u32x2 w; w.x = pk_bf16(v[i][0] * rstd * a[0] + b[0], v[i][1] * rstd * a[1] + b[1]); w.y = pk_bf16(v[i][2] * rstd * a[2] + b[2], v[i][3] * rstd * a[3] + b[3]);
        *(u32x2*)(orow + c) = w;
    }
}
__device__ __forceinline__ const float* xrow_ptr(const Frame& F, int l, int row) {
    if (l == 0) return row < L ? F.in[I_X] + (size_t)row * D : F.in[I_CTX] + (size_t)(row - L) * D;
    return F.w<float>(WS_XCUR) + (size_t)row * D;
}
__device__ __forceinline__ void ph_norm1(const Frame& F, int l) {
    LAS float* vec = (LAS float*)F.lds;
    __syncthreads();
    stage_norm_vecs(F, l, 0, 0, 1, vec);
    __syncthreads();
    const int nwaves = F.G * 8;
    for (int row = F.bid * 8 + F.wave; row < T; row += nwaves) {
        const int which = row >= L;
        f32x4 v[4]; load_row(xrow_ptr(F, l, row), F.lane, v);
        const float rstd = row_rstd(v);
        norm_store_bf16(v, rstd, vec + (which * 2) * 1024, vec + (which * 2 + 1) * 1024, F.w<bf16_t>(WS_HB) + (size_t)row * D, F.lane);
    }
}

constexpr int SROW = 272;
__device__ __forceinline__ bf16x8 lds_frag(const LAS unsigned char* base, int row, int k) { return *(const LAS bf16x8*)(base + row * SROW + k * 2); }
__device__ __forceinline__ void ph_ssd_prep(const Frame& F, int l) {
    LAS unsigned char* BT = F.lds;
    LAS unsigned char* XW = F.lds + 34816;
    LAS float* dts = (LAS float*)(F.lds + 139264);
    LAS float* wj  = dts + 768;
    const bf16_t* P = F.w<bf16_t>(WS_P);
    const int lane = F.lane, wave = F.wave;
    for (int it = F.bid; it < NCH * 2; it += F.G) {
        const int ch = it >> 1, g = it & 1;
        const int row0 = ch * 128;
        const int seq_lo = ch < 128 ? 0 : L, seq_hi = ch < 128 ? L : T;
        int r = lane & 31, hf = lane >> 5; asm volatile("" : "+v"(r), "+v"(hf));
        __syncthreads();
        if (wave < 6) {
            const int hh = wave >> 1, dir = wave & 1, h = g * 3 + hh;
            const float a = -__expf(F.in[I_ALOG][(l * 2 + dir) * 6 + h]), bias = F.in[I_DTB][(l * 2 + dir) * 6 + h];
            const int j0 = 2 * lane;
            const float d0 = softplus_f(bf2f(P[(size_t)(row0 + j0) * PC + CDT + dir * 6 + h]) + bias);
            const float d1 = softplus_f(bf2f(P[(size_t)(row0 + j0 + 1) * PC + CDT + dir * 6 + h]) + bias);
            const float pair = (d0 + d1) * a;
            float incl = pair;
#pragma unroll
            for (int o = 1; o < 64; o <<= 1) {
                const float v = dir == 0 ? __shfl_up(incl, o) : __shfl_down(incl, o);
                const bool okl = dir == 0 ? (lane >= o) : (lane + o < 64);
                if (okl) incl += v;
            }
            const float total = __shfl(incl, dir == 0 ? 63 : 0);
            float acs0, acs1;
            if (dir == 0) { acs1 = incl; acs0 = incl - d1 * a; }
            else { acs0 = incl; acs1 = incl - d0 * a; }
            float* dtv = F.w<float>(WS_DTV) + (size_t)(row0 + j0) * 12 + dir * 6 + h; dtv[0] = d0; dtv[12] = d1;
            float* acv = F.w<float>(WS_ACS) + (size_t)(row0 + j0) * 12 + dir * 6 + h; acv[0] = acs0; acv[12] = acs1;
            if (lane == 0) F.w<float>(WS_ALAST)[ch * 12 + dir * 6 + h] = total;
            dts[wave * 128 + j0] = d0; dts[wave * 128 + j0 + 1] = d1;
            wj[wave * 128 + j0] = __expf(total - acs0) * d0; wj[wave * 128 + j0 + 1] = __expf(total - acs1) * d1;
        }
        __syncthreads();
        if (F.tid < 448) {
            const int pr = F.tid % 224, half = F.tid / 224;
            const int chn = pr < 96 ? g * 192 + 2 * pr : (pr < 160 ? 384 + g * 128 + 2 * (pr - 96) : 640 + g * 128 + 2 * (pr - 160));
            const float* cw = F.in[I_SCW] + (size_t)l * 5 * 896 + chn; const float* cb = F.in[I_SCB] + (size_t)l * 896 + chn;
            float w0[5], w1[5];
#pragma unroll
            for (int k = 0; k < 5; ++k) { w0[k] = cw[k * 896]; w1[k] = cw[k * 896 + 1]; }
            const float b0 = cb[0], b1 = cb[1];
            const int jb = half * 64;
            const bf16_t* src = P + CXBC + chn;
            unsigned win[5];
#pragma unroll
            for (int k = 0; k < 4; ++k) { const int rr = row0 + jb + k - 2; win[k + 1] = (rr >= seq_lo && rr < seq_hi) ? *(const unsigned*)(src + (size_t)rr * PC) : 0u; }
            const int hh = pr / 32;
            const int pch = 2 * (pr & 31);
            for (int jj = 0; jj < 64; jj += 2) {
                float s0[2], s1[2];
#pragma unroll
                for (int u = 0; u < 2; ++u) {
                    const int j = jb + jj + u;
#pragma unroll
                    for (int k = 0; k < 4; ++k) win[k] = win[k + 1];
                    { const int rr = row0 + j + 2; win[4] = (rr >= seq_lo && rr < seq_hi) ? *(const unsigned*)(src + (size_t)rr * PC) : 0u; }
                    float a0 = b0, a1 = b1;
#pragma unroll
                    for (int k = 0; k < 5; ++k) { a0 += w0[k] * bflo(win[k]); a1 += w1[k] * bfhi(win[k]); }
                    s0[u] = silu_f(a0); s1[u] = silu_f(a1);
                    *(unsigned*)(F.w<bf16_t>(WS_XBC) + (size_t)(row0 + j) * 896 + chn) = pk_bf16(s0[u], s1[u]);
                }
                const int j = jb + jj;
                if (pr < 96) {
#pragma unroll
                    for (int dir = 0; dir < 2; ++dir) {
                        const float wa = wj[(hh * 2 + dir) * 128 + j], wb = wj[(hh * 2 + dir) * 128 + j + 1];
                        LAS unsigned char* d = XW + ((hh * 2 + dir) * 64 + pch) * SROW + j * 2;
                        *(LAS unsigned*)d = pk_bf16(s0[0] * wa, s0[1] * wb);
                        *(LAS unsigned*)(d + SROW) = pk_bf16(s1[0] * wa, s1[1] * wb);
                    }
                } else if (pr < 160) {
                    LAS unsigned char* d = BT + (2 * (pr - 96)) * SROW + j * 2;
                    *(LAS unsigned*)d = pk_bf16(s0[0], s0[1]);
                    *(LAS unsigned*)(d + SROW) = pk_bf16(s1[0], s1[1]);
                }
            }
        }
        __syncthreads();
        {
            const int nt = wave & 3, pt = wave >> 2;
#pragma unroll 1
            for (int hh = 0; hh < 3; ++hh) {
                const int h = g * 3 + hh;
                f32x16 a0, a1;
#pragma unroll
                for (int i = 0; i < 16; ++i) { a0[i] = 0.f; a1[i] = 0.f; }
                const LAS unsigned char* X0 = XW + (hh * 2) * 64 * SROW;
#pragma unroll
                for (int ks = 0; ks < 8; ++ks) {
                    const bf16x8 a = lds_frag(BT, 32 * nt + r, 16 * ks + 8 * hf);
                    const bf16x8 b0 = lds_frag(X0, 32 * pt + r, 16 * ks + 8 * hf), b1 = lds_frag(X0, 64 + 32 * pt + r, 16 * ks + 8 * hf);
                    a0 = __builtin_amdgcn_mfma_f32_32x32x16_bf16(a, b0, a0, 0, 0, 0);
                    a1 = __builtin_amdgcn_mfma_f32_32x32x16_bf16(a, b1, a1, 0, 0, 0);
                }
                float* s0 = F.w<float>(WS_STATES) + ((size_t)(0 * NCH + ch) * 6 + h) * 8192 + (32 * pt + r) * 128 + 32 * nt + 4 * hf;
                float* s1 = F.w<float>(WS_STATES) + ((size_t)(1 * NCH + ch) * 6 + h) * 8192 + (32 * pt + r) * 128 + 32 * nt + 4 * hf;
#pragma unroll
                for (int gq = 0; gq < 4; ++gq) { *(f32x4*)(s0 + 8 * gq) = (f32x4){a0[4 * gq], a0[4 * gq + 1], a0[4 * gq + 2], a0[4 * gq + 3]};
                                                 *(f32x4*)(s1 + 8 * gq) = (f32x4){a1[4 * gq], a1[4 * gq + 1], a1[4 * gq + 2], a1[4 * gq + 3]}; }
            }
        }
    }
}

__device__ __forceinline__ void ph_ssd_scan(const Frame& F) {
    const int per = (98304 + F.G - 1) / F.G;
    for (int q = F.tid; q < per; q += NTHREADS) {
        const int id = F.bid * per + q;
        if (id >= 98304) break;
        const int dir = id / 49152, rem = id % 49152, h = rem / 8192, e = rem % 8192;
        const float* al = F.w<float>(WS_ALAST) + dir * 6 + h;
        const float* st = F.w<float>(WS_STATES) + ((size_t)(dir * NCH) * 6 + h) * 8192 + e;
        bf16_t* ss = F.w<bf16_t>(WS_SSTART) + ((size_t)(dir * NCH) * 6 + h) * 8192 + e;
        float sacc = 0.f;
        for (int s0 = 0; s0 < NCH; s0 += 26) {
            float sv[26], dv[26]; int cv[26];
#pragma unroll
            for (int u = 0; u < 26; ++u) {
                const int step = s0 + u;
                cv[u] = dir == 0 ? (step < 2 ? 128 + step : step - 2) : 129 - step;
                sv[u] = st[(size_t)cv[u] * 6 * 8192]; dv[u] = al[cv[u] * 12];
            }
#pragma unroll
            for (int u = 0; u < 26; ++u) { ss[(size_t)cv[u] * 6 * 8192] = f2bf(sacc); sacc = sacc * __expf(dv[u]) + sv[u]; }
        }
    }
}

__device__ __forceinline__ void ph_ssd_out(const Frame& F, int l) {
    LAS unsigned char* Cs = F.lds;
    LAS unsigned char* Bs = F.lds + 34816;
    LAS unsigned char* XT = F.lds + 69632;
    LAS float* Yl = (LAS float*)F.lds;
    LAS float* af = (LAS float*)(F.lds + 98816);
    LAS float* ab = af + 384, *dtf = ab + 384, *dtb = dtf + 384;
    LAS float* red = dtb + 384;
    const bf16_t* XBC = F.w<bf16_t>(WS_XBC);
    const bf16_t* P = F.w<bf16_t>(WS_P);
    const int nch = (l == 0) ? NCH : 128;
    const int lane = F.lane, wave = F.wave, r_in = lane & 31, hf_in = lane >> 5;
    const int it_ = wave & 3, jp = wave >> 2;
    for (int it = F.bid; it < nch * 2; it += F.G) {
        const int ch = it >> 1, g = it & 1, row0 = ch * 128;
        int r = r_in, hf = hf_in; asm volatile("" : "+v"(r), "+v"(hf));
        __syncthreads();
        for (int q = F.tid; q < 128 * 16; q += NTHREADS) {
            const int row = q >> 4, piece = q & 15;
            const bf16_t* src = XBC + (size_t)(row0 + row) * 896 + g * 128 + piece * 8;
            *(LAS u32x4*)(Bs + row * SROW + piece * 16) = *(const u32x4*)(src + 384);
            *(LAS u32x4*)(Cs + row * SROW + piece * 16) = *(const u32x4*)(src + 640);
        }
        for (int q = F.tid; q < 768; q += NTHREADS) {
            const int dir = q / 384, rr = q % 384, hh = rr >> 7, j = rr & 127;
            (dir ? ab : af)[hh * 128 + j] = F.w<float>(WS_ACS)[(size_t)(row0 + j) * 12 + dir * 6 + g * 3 + hh];
            (dir ? dtb : dtf)[hh * 128 + j] = F.w<float>(WS_DTV)[(size_t)(row0 + j) * 12 + dir * 6 + g * 3 + hh];
        }
        __syncthreads();
        f32x16 G0, G1;
#pragma unroll
        for (int i = 0; i < 16; ++i) { G0[i] = 0.f; G1[i] = 0.f; }
#pragma unroll
        for (int ks = 0; ks < 8; ++ks) {
            const bf16x8 a = lds_frag(Cs, 32 * it_ + r, 16 * ks + 8 * hf);
            const bf16x8 b0 = lds_frag(Bs, 64 * jp + r, 16 * ks + 8 * hf), b1 = lds_frag(Bs, 64 * jp + 32 + r, 16 * ks + 8 * hf);
            G0 = __builtin_amdgcn_mfma_f32_32x32x16_bf16(a, b0, G0, 0, 0, 0);
            G1 = __builtin_amdgcn_mfma_f32_32x32x16_bf16(a, b1, G1, 0, 0, 0);
        }
        f32x16 yacc[3];
#pragma unroll
        for (int hh = 0; hh < 3; ++hh) {
            const int h = g * 3 + hh;
            asm volatile("" : "+v"(r), "+v"(hf));
            __syncthreads();
#pragma unroll
            for (int tl = 0; tl < 2; ++tl) {
                const int j = 64 * jp + 32 * tl + r;
                const float afj = af[hh * 128 + j], abj = ab[hh * 128 + j], dfj = dtf[hh * 128 + j], dbj = dtb[hh * 128 + j];
#pragma unroll
                for (int rg = 0; rg < 16; ++rg) {
                    const int i = 32 * it_ + (rg & 3) + 8 * (rg >> 2) + 4 * hf;
                    const float mf = fminf(fmaxf((float)(i - j + 1), 0.f), 1.f), mb = fminf(fmaxf((float)(j - i + 1), 0.f), 1.f);
                    const float wf = __expf(fminf(af[hh * 128 + i] - afj, 0.f)) * dfj * mf;
                    const float wb = __expf(fminf(ab[hh * 128 + i] - abj, 0.f)) * dbj * mb;
                    const float gv = tl == 0 ? G0[rg] : G1[rg];
                    *(LAS bf16_t*)(Bs + i * SROW + j * 2) = f2bf(gv * (wf + wb));
                }
            }
            for (int q = F.tid; q < 128 * 8; q += NTHREADS) {
                const int j = q >> 3, pg = q & 7;
                const u32x4 v = *(const u32x4*)(XBC + (size_t)(row0 + j) * 896 + h * 64 + pg * 8);
                LAS unsigned char* d = XT + (pg * 8) * SROW + j * 2;
                *(LAS bf16_t*)(d + 0 * SROW) = (bf16_t)(v.x & 0xFFFF); *(LAS bf16_t*)(d + 1 * SROW) = (bf16_t)(v.x >> 16);
                *(LAS bf16_t*)(d + 2 * SROW) = (bf16_t)(v.y & 0xFFFF); *(LAS bf16_t*)(d + 3 * SROW) = (bf16_t)(v.y >> 16);
                *(LAS bf16_t*)(d + 4 * SROW) = (bf16_t)(v.z & 0xFFFF); *(LAS bf16_t*)(d + 5 * SROW) = (bf16_t)(v.z >> 16);
                *(LAS bf16_t*)(d + 6 * SROW) = (bf16_t)(v.w & 0xFFFF); *(LAS bf16_t*)(d + 7 * SROW) = (bf16_t)(v.w >> 16);
            }
            {
                f32x16 yF, yB;
#pragma unroll
                for (int i = 0; i < 16; ++i) { yF[i] = 0.f; yB[i] = 0.f; }
                const bf16_t* Sf = F.w<bf16_t>(WS_SSTART) + ((size_t)(0 * NCH + ch) * 6 + h) * 8192 + (32 * jp + r) * 128 + 8 * hf;
                const bf16_t* Sb = F.w<bf16_t>(WS_SSTART) + ((size_t)(1 * NCH + ch) * 6 + h) * 8192 + (32 * jp + r) * 128 + 8 * hf;
#pragma unroll 2
                for (int ks = 0; ks < 8; ++ks) {
                    const bf16x8 ac = lds_frag(Cs, 32 * it_ + r, 16 * ks + 8 * hf);
                    const bf16x8 bf_ = *(const bf16x8*)(Sf + 16 * ks), bb_ = *(const bf16x8*)(Sb + 16 * ks);
                    yF = __builtin_amdgcn_mfma_f32_32x32x16_bf16(ac, bf_, yF, 0, 0, 0);
                    yB = __builtin_amdgcn_mfma_f32_32x32x16_bf16(ac, bb_, yB, 0, 0, 0);
                }
#pragma unroll
                for (int rg = 0; rg < 16; ++rg) {
                    const int i = 32 * it_ + (rg & 3) + 8 * (rg >> 2) + 4 * hf;
                    yacc[hh][rg] = __expf(af[hh * 128 + i]) * yF[rg] + __expf(ab[hh * 128 + i]) * yB[rg];
                }
            }
            __syncthreads();
#pragma unroll 2
            for (int ks = 0; ks < 8; ++ks) {
                const bf16x8 aw = lds_frag(Bs, 32 * it_ + r, 16 * ks + 8 * hf), bx = lds_frag(XT, 32 * jp + r, 16 * ks + 8 * hf);
                yacc[hh] = __builtin_amdgcn_mfma_f32_32x32x16_bf16(aw, bx, yacc[hh], 0, 0, 0);
            }
        }
        __syncthreads();
#pragma unroll
        for (int hh = 0; hh < 3; ++hh)
#pragma unroll
            for (int rg = 0; rg < 16; ++rg) { const int i = 32 * it_ + (rg & 3) + 8 * (rg >> 2) + 4 * hf; Yl[i * 193 + hh * 64 + 32 * jp + r] = yacc[hh][rg]; }
        __syncthreads();
        const int i = F.tid & 127, pq = F.tid >> 7;
        float ssq = 0.f;
#pragma unroll 1
        for (int hh = 0; hh < 3; ++hh) {
            const int h = g * 3 + hh; const float dsk = F.in[I_SSDD][l * 6 + h];
            const int chn = h * 64 + pq * 16;
            const u32x4 xa = *(const u32x4*)(XBC + (size_t)(row0 + i) * 896 + chn), xb = *(const u32x4*)(XBC + (size_t)(row0 + i) * 896 + chn + 8);
            const u32x4 za = *(const u32x4*)(P + (size_t)(row0 + i) * PC + CZ + chn), zb = *(const u32x4*)(P + (size_t)(row0 + i) * PC + CZ + chn + 8);
            const unsigned xw_[8] = {xa.x, xa.y, xa.z, xa.w, xb.x, xb.y, xb.z, xb.w}, zw_[8] = {za.x, za.y, za.z, za.w, zb.x, zb.y, zb.z, zb.w};
            LAS float* yr = Yl + i * 193 + hh * 64 + pq * 16;
#pragma unroll
            for (int p2 = 0; p2 < 8; ++p2) {
                const float v0 = (yr[2 * p2] + dsk * bflo(xw_[p2])) * silu_f(bflo(zw_[p2]));
                const float v1 = (yr[2 * p2 + 1] + dsk * bfhi(xw_[p2])) * silu_f(bfhi(zw_[p2]));
                yr[2 * p2] = v0; yr[2 * p2 + 1] = v1; ssq += v0 * v0 + v1 * v1;
            }
        }
        red[pq * 128 + i] = ssq;
        __syncthreads();
        const float tot = red[i] + red[128 + i] + red[256 + i] + red[384 + i];
        const float rstd = rsqrtf(tot * (1.0f / 192.0f) + RMS_EPS);
#pragma unroll 1
        for (int hh = 0; hh < 3; ++hh) {
            const int h = g * 3 + hh;
            bf16_t* o = F.w<bf16_t>(WS_MIX) + (size_t)(row0 + i) * D + h * 64 + pq * 16;
            const float* ng = F.in[I_SSDNG] + l * 384 + h * 64 + pq * 16;
            const LAS float* yr = Yl + i * 193 + hh * 64 + pq * 16;
            unsigned wv[8];
#pragma unroll
            for (int p2 = 0; p2 < 8; ++p2) wv[p2] = pk_bf16(yr[2 * p2] * rstd * ng[2 * p2], yr[2 * p2 + 1] * rstd * ng[2 * p2 + 1]);
            *(u32x4*)o = (u32x4){wv[0], wv[1], wv[2], wv[3]}; *(u32x4*)(o + 8) = (u32x4){wv[4], wv[5], wv[6], wv[7]};
        }
    }
}

__device__ __forceinline__ int na_kv_off(int key, int piece) { return key * 128 + ((piece ^ (key & 7)) << 4); }
__device__ __forceinline__ void na_stage_kv(const Frame& F, const bf16_t* P, LAS unsigned char* Kd, LAS unsigned char* Vd, int h, bool local, int r0, int kc0) {
    for (int q = F.tid; q < 256 * 8; q += NTHREADS) {
        const int key = q >> 3, piece = q & 7;
        const int krow = local ? (r0 + (key >> 5)) * 64 + kc0 + (key & 31) : L + key;
        const bf16_t* src = P + (size_t)krow * PC + h * 64 + piece * 8;
        *(LAS u32x4*)(Kd + na_kv_off(key, piece)) = *(const u32x4*)(src + CK);
        *(LAS u32x4*)(Vd + na_kv_off(key, piece)) = *(const u32x4*)(src + CV);
    }
}
__device__ __forceinline__ void bar_lds() { asm volatile("s_waitcnt lgkmcnt(0)" ::: "memory"); __builtin_amdgcn_s_barrier(); asm volatile("" ::: "memory"); }
struct NaItem { int h, r, cg, r0, kc0, qrow0; bool isctx; };
__device__ __forceinline__ NaItem na_item(int cid, int i_lo, int i_hi, int k) {
    NaItem t; t.isctx = (i_lo + k >= i_hi); t.r = 0; t.r0 = 0; t.kc0 = 0;
    if (!t.isctx) { const int it = i_lo + k; t.h = it >> 10; t.r = (it >> 2) & 255; t.cg = it & 3; t.r0 = min(max(t.r - 4, 0), 248); t.kc0 = min(max(16 * t.cg - 8, 0), 32); t.qrow0 = t.r * 64 + t.cg * 16; }
    else { t.h = cid >> 4; t.cg = cid & 15; t.qrow0 = L + t.cg * 16; }
    return t;
}
__device__ __forceinline__ void ph_na(const Frame& F, int l, int part) {
    LAS unsigned char* Kc = F.lds;
    LAS unsigned char* Vc = F.lds + 32768;
    LAS unsigned char* Kl = F.lds + 65536;
    LAS unsigned char* Vl = F.lds + 98304;
    LAS unsigned char* Qs = F.lds + 131072;
    LAS unsigned char* Pw = F.lds + 133120;
    LAS float* ml = (LAS float*)(F.lds + 151552);
    LAS float* bt = ml + 256;
    const bf16_t* P = F.w<bf16_t>(WS_P);
    const float* rpb = F.in[I_RPB] + (size_t)l * 15 * 31 * 6;
    const int nlat = 6 * 256 * 4;
    const int nB = (l == 0) ? 2520 : 0, nA = nlat - nB;
    const int lane = F.lane, wave = F.wave, c16 = lane & 15, kq = lane >> 4;
    const float scale = 0.125f;
    int cur_h = -1;
    const float ws = part == 0 ? (l == 0 ? 0.45f : 0.67f) : 0.0f;
    const int nP = part == 0 ? nA : nB, base = part == 0 ? 0 : nA;
    const float Wtot = 4.0f * ws + (float)(F.G - 4);
    const float W0 = F.bid < 4 ? F.bid * ws : 4.0f * ws + (float)(F.bid - 4), W1 = F.bid < 3 ? (F.bid + 1) * ws : 4.0f * ws + (float)(F.bid - 3);
    const int i_lo = base + (int)((float)nP * W0 / Wtot + 0.5f), i_hi = (F.bid == F.G - 1) ? base + nP : base + (int)((float)nP * W1 / Wtot + 0.5f);
    const int cid = (l == 0 && part == 0 && F.bid >= 100 && F.bid < 196) ? F.bid - 100 : -1;
    const int n_mine = max(0, i_hi - i_lo) + (cid >= 0 ? 1 : 0);
    u32x4 kreg[4], vreg[4], qreg; float breg = 0.f;
    const int pkey = F.tid >> 3, ppiece = F.tid & 7;
#define NA_PREFETCH(T) do { if (!(T).isctx) { _Pragma("unroll") for (int u = 0; u < 4; ++u) { const int key = pkey + 64 * u; \
            const bf16_t* src = P + (size_t)(((T).r0 + (key >> 5)) * 64 + (T).kc0 + (key & 31)) * PC + (T).h * 64 + ppiece * 8; \
            kreg[u] = *(const u32x4*)(src + CK); vreg[u] = *(const u32x4*)(src + CV); } \
            if (F.tid < 256 && (F.tid & 31) < 31) breg = rpb[(((T).r0 + (F.tid >> 5) - (T).r + 7) * 31 + (F.tid & 31)) * 6 + (T).h]; } \
        if (F.tid < 128) qreg = *(const u32x4*)(P + (size_t)((T).qrow0 + pkey) * PC + CQ + (T).h * 64 + ppiece * 8); } while (0)
    if (n_mine > 0) { const NaItem t0 = na_item(cid, i_lo, i_hi, 0); NA_PREFETCH(t0); }
    for (int k = 0; k < n_mine; ++k) {
        const NaItem t = na_item(cid, i_lo, i_hi, k);
        const bool isctx = t.isctx; const int h = t.h, cg = t.cg, kc0 = t.kc0, qrow0 = t.qrow0;
        bar_lds();
        if (h != cur_h) { na_stage_kv(F, P, Kc, Vc, h, false, 0, 0); cur_h = h; }
        if (!isctx) {
#pragma unroll
            for (int u = 0; u < 4; ++u) { const int key = pkey + 64 * u; *(LAS u32x4*)(Kl + na_kv_off(key, ppiece)) = kreg[u]; *(LAS u32x4*)(Vl + na_kv_off(key, ppiece)) = vreg[u]; }
            if (F.tid < 256) bt[F.tid] = breg;
        }
        if (F.tid < 128) *(LAS u32x4*)(Qs + na_kv_off(pkey, ppiece)) = qreg;
        if (k + 1 < n_mine) { const NaItem tn = na_item(cid, i_lo, i_hi, k + 1); NA_PREFETCH(tn); }
        bar_lds();
        const bool loc = wave < 4;
        const LAS unsigned char* Kb = loc ? Kl : Kc;
        const LAS unsigned char* Vb = loc ? Vl : Vc;
        const int kbase = (wave & 3) * 64;
        LAS unsigned char* pw = Pw + wave * 2304;
        float mw[4], lw[4];
        if (!(loc && isctx)) {
            f32x4 sacc[4];
#pragma unroll
            for (int nt = 0; nt < 4; ++nt) sacc[nt] = (f32x4){0.f, 0.f, 0.f, 0.f};
#pragma unroll
            for (int ks = 0; ks < 2; ++ks) {
                const bf16x8 a = *(const LAS bf16x8*)(Qs + na_kv_off(c16, 4 * ks + kq));
#pragma unroll
                for (int nt = 0; nt < 4; ++nt) {
                    const bf16x8 b = *(const LAS bf16x8*)(Kb + na_kv_off(kbase + 16 * nt + c16, 4 * ks + kq));
                    sacc[nt] = __builtin_amdgcn_mfma_f32_16x16x32_bf16(a, b, sacc[nt], 0, 0, 0);
                }
            }
#pragma unroll
            for (int rg = 0; rg < 4; ++rg) mw[rg] = -INFINITY;
#pragma unroll
            for (int nt = 0; nt < 4; ++nt) {
                const int kk = kbase + 16 * nt + c16;
#pragma unroll
                for (int rg = 0; rg < 4; ++rg) {
                    float sv = sacc[nt][rg] * scale;
                    if (loc) {
                        const int qi = 4 * kq + rg, qcol = cg * 16 + qi, cstart = min(max(qcol - 8, 0), 48);
                        const int krow = kk >> 5, kcol = kc0 + (kk & 31);
                        const bool ok = (kcol >= cstart) && (kcol < cstart + 16);
                        const int dc = min(max(kcol - qcol + 15, 0), 30);
                        sv = ok ? sv + bt[krow * 32 + dc] : -INFINITY;
                    }
                    sacc[nt][rg] = sv; mw[rg] = fmaxf(mw[rg], sv);
                }
            }
#pragma unroll
            for (int rg = 0; rg < 4; ++rg) {
#pragma unroll
                for (int o = 8; o >= 1; o >>= 1) mw[rg] = fmaxf(mw[rg], __shfl_xor(mw[rg], o));
                lw[rg] = 0.f;
            }
#pragma unroll
            for (int nt = 0; nt < 4; ++nt) {
#pragma unroll
                for (int rg = 0; rg < 4; ++rg) {
                    const float msafe = mw[rg] == -INFINITY ? 0.f : mw[rg];
                    const float pv = __expf(sacc[nt][rg] - msafe);
                    lw[rg] += pv;
                    *(LAS bf16_t*)(pw + (4 * kq + rg) * 144 + (16 * nt + c16) * 2) = f2bf(pv);
                }
            }
#pragma unroll
            for (int rg = 0; rg < 4; ++rg) {
#pragma unroll
                for (int o = 8; o >= 1; o >>= 1) lw[rg] += __shfl_xor(lw[rg], o);
            }
            lds_fence();
            f32x4 oacc[4];
#pragma unroll
            for (int dt = 0; dt < 4; ++dt) oacc[dt] = (f32x4){0.f, 0.f, 0.f, 0.f};
#pragma unroll
            for (int ks = 0; ks < 2; ++ks) {
                const bf16x8 a = *(const LAS bf16x8*)(pw + c16 * 144 + (32 * ks + 8 * kq) * 2);
                const int key0 = kbase + 32 * ks + 8 * kq;
#pragma unroll
                for (int dt = 0; dt < 4; ++dt) {
                    const int d = 16 * dt + c16;
                    bf16x8 b;
#pragma unroll
                    for (int e = 0; e < 8; ++e) b[e] = *(const LAS short*)(Vb + na_kv_off(key0 + e, d >> 3) + (d & 7) * 2);
                    oacc[dt] = __builtin_amdgcn_mfma_f32_16x16x32_bf16(a, b, oacc[dt], 0, 0, 0);
                }
            }
            lds_fence();
#pragma unroll
            for (int dt = 0; dt < 4; ++dt)
#pragma unroll
                for (int rg = 0; rg < 4; ++rg) *(LAS bf16_t*)(pw + (4 * kq + rg) * 144 + (16 * dt + c16) * 2) = f2bf(oacc[dt][rg]);
        } else {
#pragma unroll
            for (int rg = 0; rg < 4; ++rg) { mw[rg] = -INFINITY; lw[rg] = 0.f; }
            for (int q = lane; q < 16 * 36; q += 64) ((LAS unsigned*)pw)[q] = 0u;
        }
        if (c16 == 0) {
#pragma unroll
            for (int rg = 0; rg < 4; ++rg) { ml[(wave * 16 + 4 * kq + rg) * 2] = mw[rg]; ml[(wave * 16 + 4 * kq + rg) * 2 + 1] = lw[rg]; }
        }
        bar_lds();
        {
            const int qi = F.tid >> 5, dp = F.tid & 31;
            float M = -INFINITY;
#pragma unroll
            for (int w = 0; w < 8; ++w) M = fmaxf(M, ml[(w * 16 + qi) * 2]);
            float num0 = 0.f, num1 = 0.f, den = 0.f;
#pragma unroll
            for (int w = 0; w < 8; ++w) {
                const float sc = __expf(ml[(w * 16 + qi) * 2] - M);
                const unsigned ov = *(const LAS unsigned*)(Pw + w * 2304 + qi * 144 + dp * 4);
                num0 += sc * bflo(ov); num1 += sc * bfhi(ov); den += sc * ml[(w * 16 + qi) * 2 + 1];
            }
            const float inv = 1.0f / den;
            *(unsigned*)(F.w<bf16_t>(WS_MIX) + (size_t)(qrow0 + qi) * D + 384 + h * 64 + 2 * dp) = pk_bf16(num0 * inv, num1 * inv);
        }
    }
#undef NA_PREFETCH
}

__device__ __forceinline__ float hy_conv3(const bf16_t* P, const float* cw, const float* cb, int row, int seq_lo, int seq_hi, int col) {
    float s = cb[col];
#pragma unroll
    for (int k = 0; k < 3; ++k) { const int r = row + k - 1; if (r >= seq_lo && r < seq_hi) s += cw[k * 768 + col] * bf2f(P[(size_t)r * PC + CHY + col]); }
    return s;
}
__device__ __forceinline__ void ph_hy_prep(const Frame& F, int l) {
    const bf16_t* P = F.w<bf16_t>(WS_P);
    const float* cw = F.in[I_HCW] + (size_t)l * 3 * 768; const float* cb = F.in[I_HCB] + (size_t)l * 768;
    LAS unsigned* ut = (LAS unsigned*)F.lds;
    LAS unsigned* xt = ut + 256 * 33;
    const int cp = F.tid & 127, rq = F.tid >> 7;
    float w0[3][3], w1[3][3], b0[3], b1[3];
#pragma unroll
    for (int sg = 0; sg < 3; ++sg) { b0[sg] = cb[sg * 256 + 2 * cp]; b1[sg] = cb[sg * 256 + 2 * cp + 1];
#pragma unroll
        for (int k = 0; k < 3; ++k) { w0[sg][k] = cw[k * 768 + sg * 256 + 2 * cp]; w1[sg][k] = cw[k * 768 + sg * 256 + 2 * cp + 1]; } }
    for (int it = F.bid; it < L / 64; it += F.G) {
        const int t0 = it * 64, rb = t0 + rq * 16;
        __syncthreads();
        {
            unsigned win[3][3];
#pragma unroll
            for (int sg = 0; sg < 3; ++sg) {
                win[sg][1] = (rb - 1 >= 0) ? *(const unsigned*)(P + (size_t)(rb - 1) * PC + CHY + sg * 256 + 2 * cp) : 0u;
                win[sg][2] = *(const unsigned*)(P + (size_t)rb * PC + CHY + sg * 256 + 2 * cp);
            }
            for (int jp = 0; jp < 8; ++jp) {
                float u0[2], u1[2], xa[2], xb[2];
#pragma unroll
                for (int q = 0; q < 2; ++q) {
                    const int row = rb + 2 * jp + q;
                    float a0[3], a1[3];
#pragma unroll
                    for (int sg = 0; sg < 3; ++sg) {
                        win[sg][0] = win[sg][1]; win[sg][1] = win[sg][2];
                        win[sg][2] = (row + 1 < L) ? *(const unsigned*)(P + (size_t)(row + 1) * PC + CHY + sg * 256 + 2 * cp) : 0u;
                        a0[sg] = b0[sg] + w0[sg][0] * bflo(win[sg][0]) + w0[sg][1] * bflo(win[sg][1]) + w0[sg][2] * bflo(win[sg][2]);
                        a1[sg] = b1[sg] + w1[sg][0] * bfhi(win[sg][0]) + w1[sg][1] * bfhi(win[sg][1]) + w1[sg][2] * bfhi(win[sg][2]);
                    }
                    xa[q] = a0[0]; xb[q] = a1[0]; u0[q] = a0[2] * a0[1]; u1[q] = a1[2] * a1[1];
                }
                const int rp = rq * 8 + jp;
                ut[(2 * cp) * 33 + rp] = pk_bf16(u0[0], u0[1]); ut[(2 * cp + 1) * 33 + rp] = pk_bf16(u1[0], u1[1]);
                xt[(2 * cp) * 33 + rp] = pk_bf16(xa[0], xa[1]); xt[(2 * cp + 1) * 33 + rp] = pk_bf16(xb[0], xb[1]);
            }
        }
        __syncthreads();
        for (int q = F.tid; q < 256 * 8; q += NTHREADS) {
            const int c = q >> 3, g = q & 7;
            u32x4 a, b;
            a.x = ut[c * 33 + 4 * g]; a.y = ut[c * 33 + 4 * g + 1]; a.z = ut[c * 33 + 4 * g + 2]; a.w = ut[c * 33 + 4 * g + 3];
            b.x = xt[c * 33 + 4 * g]; b.y = xt[c * 33 + 4 * g + 1]; b.z = xt[c * 33 + 4 * g + 2]; b.w = xt[c * 33 + 4 * g + 3];
            *(u32x4*)(F.w<bf16_t>(WS_UT) + (size_t)c * L + t0 + 8 * g) = a;
            *(u32x4*)(F.w<bf16_t>(WS_X0T) + (size_t)c * L + t0 + 8 * g) = b;
        }
    }
    if (l == 0) {
        for (int rp = F.bid; rp < LC / 2; rp += F.G) {
            const int row = L + rp * 2 + (F.tid >> 8), c = F.tid & 255;
            const float x1 = hy_conv3(P, cw, cb, row, L, T, 256 + c), v = hy_conv3(P, cw, cb, row, L, T, 512 + c);
            F.w<float>(WS_U)[(size_t)row * 256 + c] = v * x1;
        }
    }
}
__device__ __forceinline__ void ph_hy_conv_ctx(const Frame& F, int l) {
    const bf16_t* P = F.w<bf16_t>(WS_P);
    const float* cw = F.in[I_HCW] + (size_t)l * 3 * 768; const float* cb = F.in[I_HCB] + (size_t)l * 768;
    for (int it = F.bid; it < 8; it += F.G) {
        const int Lx = LC, rbase = L;
        const int tb = it * 2 + (F.tid >> 8), c = F.tid & 255, t0 = tb * 16;
        const float* U = F.w<float>(WS_U) + (size_t)rbase * 256 + c;
        const float* KC = F.w<float>(WS_KCOMBC) + c;
        float acc[16], wreg[16];
#pragma unroll
        for (int j = 0; j < 16; ++j) { acc[j] = 0.f; wreg[j] = KC[(size_t)(t0 + j + Lx - 1) * 256]; }
        for (int s0 = 0; s0 < Lx; s0 += 16) {
            float ub[16], nb[16];
#pragma unroll
            for (int r = 0; r < 16; ++r) { ub[r] = U[(size_t)(s0 + r) * 256]; const int x = t0 - (s0 + r + 1) + Lx - 1; nb[r] = x >= 0 ? KC[(size_t)x * 256] : 0.f; }
#pragma unroll
            for (int r = 0; r < 16; ++r) {
#pragma unroll
                for (int j = 0; j < 16; ++j) acc[j] += ub[r] * wreg[(j - r) & 15];
                wreg[(15 - r) & 15] = nb[r];
            }
        }
        const float inv = F.w<float>(WS_FSUM)[2 * 256 + c];
        const float db = F.in[I_HYD][l * 256 + c];
#pragma unroll
        for (int j = 0; j < 16; ++j) {
            const int row = rbase + t0 + j;
            const float x0 = hy_conv3(P, cw, cb, row, L, T, c);
            const float u = F.w<float>(WS_U)[(size_t)row * 256 + c];
            F.w<bf16_t>(WS_MIX)[(size_t)row * D + 768 + c] = f2bf(x0 * (acc[j] * inv + u * db));
        }
    }
}

constexpr int HC_UBYTES = 190 * 272;
constexpr int HC_CPOFF = 51712, HC_NG = 162, HC_CPBYTES = 8 * HC_NG * 16;
__device__ __forceinline__ void hc_make_copies(LAS unsigned char* dst, const u32x4 g0, const u32x4 g1, int g) {
    const unsigned w[8] = {g0.x, g0.y, g0.z, g0.w, g1.x, g1.y, g1.z, g1.w};
#pragma unroll
    for (int sh = 0; sh < 8; ++sh) {
        u32x4 o;
        if ((sh & 1) == 0) { o.x = w[sh / 2]; o.y = w[sh / 2 + 1]; o.z = w[sh / 2 + 2]; o.w = w[sh / 2 + 3]; }
        else { const int b = sh / 2; o.x = __builtin_amdgcn_alignbit(w[b + 1], w[b], 16); o.y = __builtin_amdgcn_alignbit(w[b + 2], w[b + 1], 16);
               o.z = __builtin_amdgcn_alignbit(w[b + 3], w[b + 2], 16); o.w = __builtin_amdgcn_alignbit(w[b + 4], w[b + 3], 16); }
        *(LAS u32x4*)(dst + (sh * HC_NG + g) * 16) = o;
    }
}
__device__ __forceinline__ void ph_hy_conv(const Frame& F, int l) {
    LAS unsigned char* Ul = F.lds;
    LAS unsigned char* Cp = F.lds + HC_CPOFF;
    const int lane = F.lane, wave = F.wave;
    const int nt = wave < 4 ? wave : 7 - wave, par = wave >> 2;
    const int r = lane & 31, h = lane >> 5, sig = r & 7, rho = r >> 3;
    const int sh = (8 - sig) & 7, gofs = h - rho - (sig ? 1 : 0);
    const int a_lane = (sh * HC_NG + gofs) * 16;
    const int b_lane = r * 272 + h * 16;
    for (int c = F.bid; c < 256; c += F.G) {
        const bf16_t* KRc = F.w<bf16_t>(WS_KR) + ((size_t)l * 256 + c) * KRL;
        const bf16_t* UTc = F.w<bf16_t>(WS_UT) + (size_t)c * L;
        __syncthreads();
        for (int q = F.tid; q < 190 * 16; q += NTHREADS) {
            const int blk = q >> 4, piece = q & 15;
            u32x4 v = (u32x4){0u, 0u, 0u, 0u};
            if (blk >= 31 && blk < 159) v = *(const u32x4*)(UTc + (size_t)(blk - 31) * 128 + piece * 8);
            *(LAS u32x4*)(Ul + blk * 272 + piece * 16) = v;
        }
        u32x4 g0 = (u32x4){0u, 0u, 0u, 0u}, g1 = g0;
        if (F.tid < 163) { const bf16_t* src = KRc + 31744 + 8 * F.tid; g0 = *(const u32x4*)src; g1 = *(const u32x4*)(src + 8); }
        if (F.tid < HC_NG) hc_make_copies(Cp, g0, g1, F.tid);
        __syncthreads();
        f32x16 acc[4];
#pragma unroll
        for (int m = 0; m < 4; ++m)
#pragma unroll
            for (int i = 0; i < 16; ++i) acc[m][i] = 0.f;
        for (int ci = 0; ci < 32; ++ci) {
            const int Dc = -128 + 8 * ci;
            if (ci + 1 < 32 && F.tid < 163) { const bf16_t* src = KRc + (31744 - 1024 * (ci + 1)) + 8 * F.tid; g0 = *(const u32x4*)src; g1 = *(const u32x4*)(src + 8); }
            const LAS unsigned char* cp = Cp + (ci & 1) * HC_CPBYTES + a_lane;
#pragma unroll 1
            for (int d2 = 0; d2 < 4; ++d2) {
                const int dd = 2 * d2 + par, Dv = Dc + dd;
                if (!((Dv >= 32 * nt - 127) && (Dv <= 32 * nt + 31) && (Dv > -128))) continue;
                const LAS unsigned char* ap = cp + (16 * (8 - dd)) * 16;
                const LAS unsigned char* bp = Ul + b_lane + (32 * nt - Dv + 31) * 272;
                bf16x8 af[14], bfr[8];
#pragma unroll
                for (int e = 0; e < 14; ++e) af[e] = *(const LAS bf16x8*)(ap - 2 * (e - 7) * 16);
#pragma unroll
                for (int ks = 0; ks < 8; ++ks) bfr[ks] = *(const LAS bf16x8*)(bp + ks * 32);
#pragma unroll
                for (int ks = 0; ks < 8; ++ks)
#pragma unroll
                    for (int m = 0; m < 4; ++m) acc[m] = __builtin_amdgcn_mfma_f32_32x32x16_bf16(af[2 * m - ks + 7], bfr[ks], acc[m], 0, 0, 0);
            }
            if (ci + 1 < 32 && F.tid < HC_NG) hc_make_copies(Cp + ((ci + 1) & 1) * HC_CPBYTES, g0, g1, F.tid);
            __syncthreads();
        }
        LAS float* Rd = (LAS float*)F.lds;
        if (wave >= 4) {
#pragma unroll
            for (int m = 0; m < 4; ++m)
#pragma unroll
                for (int i = 0; i < 16; ++i) Rd[(nt * 64 + m * 16 + i) * 64 + lane] = acc[m][i];
        }
        __syncthreads();
        if (wave < 4) {
#pragma unroll
            for (int m = 0; m < 4; ++m)
#pragma unroll
                for (int i = 0; i < 16; ++i) acc[m][i] += Rd[(nt * 64 + m * 16 + i) * 64 + lane];
            const float inv = F.w<float>(WS_FSUM)[l * 256 + c];
            const float db = F.in[I_HYD][l * 256 + c];
            const bf16_t* X0c = F.w<bf16_t>(WS_X0T) + (size_t)c * L;
            bf16_t* YTc = F.w<bf16_t>(WS_YT) + (size_t)c * L;
            const int I = 32 * nt + r;
#pragma unroll
            for (int m = 0; m < 4; ++m) {
#pragma unroll
                for (int g = 0; g < 4; ++g) {
                    const int t = 128 * I + 32 * m + 8 * g + 4 * h;
                    const u32x2 xv = *(const u32x2*)(X0c + t), uv = *(const u32x2*)(UTc + t);
                    float y[4];
#pragma unroll
                    for (int e = 0; e < 4; ++e) y[e] = acc[m][4 * g + e] * inv;
                    y[0] = bflo(xv.x) * (y[0] + bflo(uv.x) * db); y[1] = bfhi(xv.x) * (y[1] + bfhi(uv.x) * db);
                    y[2] = bflo(xv.y) * (y[2] + bflo(uv.y) * db); y[3] = bfhi(xv.y) * (y[3] + bfhi(uv.y) * db);
                    u32x2 o; o.x = pk_bf16(y[0], y[1]); o.y = pk_bf16(y[2], y[3]);
                    *(u32x2*)(YTc + t) = o;
                }
            }
        }
    }
}
__device__ __forceinline__ void ph_hy_tr(const Frame& F) {
    LAS unsigned* yt = (LAS unsigned*)F.lds;
    for (int it = F.bid; it < L / 64; it += F.G) {
        const int t0 = it * 64;
        __syncthreads();
        for (int q = F.tid; q < 256 * 8; q += NTHREADS) {
            const int c = q >> 3, g = q & 7;
            const u32x4 a = *(const u32x4*)(F.w<bf16_t>(WS_YT) + (size_t)c * L + t0 + 8 * g);
            yt[c * 33 + 4 * g] = a.x; yt[c * 33 + 4 * g + 1] = a.y; yt[c * 33 + 4 * g + 2] = a.z; yt[c * 33 + 4 * g + 3] = a.w;
        }
        __syncthreads();
        for (int q = F.tid; q < 64 * 32; q += NTHREADS) {
            const int row = q >> 5, cg = q & 31;
            const LAS unsigned short* ys = (const LAS unsigned short*)yt;
            unsigned short v[8];
#pragma unroll
            for (int e = 0; e < 8; ++e) v[e] = ys[((cg * 8 + e) * 33) * 2 + row];
            u32x4 o; o.x = v[0] | ((unsigned)v[1] << 16); o.y = v[2] | ((unsigned)v[3] << 16); o.z = v[4] | ((unsigned)v[5] << 16); o.w = v[6] | ((unsigned)v[7] << 16);
            *(u32x4*)(F.w<bf16_t>(WS_MIX) + (size_t)(t0 + row) * D + 768 + cg * 8) = o;
        }
    }
}

constexpr int WRP = 1028;
__device__ __forceinline__ void ph_post1(const Frame& F, int l) {
    LAS float* wr = (LAS float*)F.lds;
    LAS unsigned* lcnt = (LAS unsigned*)(F.lds + 32 * WRP * 4);
    __syncthreads();
    if (F.tid < 64) lcnt[F.tid] = 0u;
    for (int q = F.tid; q < 32 * 1024; q += NTHREADS) { const int k = q >> 5, e = q & 31; wr[e * WRP + k] = F.in[I_WR][(size_t)l * 1024 * 32 + q]; }
    __syncthreads();
    const int nrows = (l == 0) ? T : L;
    const int nwaves = F.G * 8, lane = F.lane;
    unsigned* cnt = F.w<unsigned>(WS_CTL) + CW_CNT + l * 1024;
    if (F.bid == 0) { for (int q = F.tid; q < D / 4; q += NTHREADS) ((unsigned*)(F.w<unsigned char>(WS_H2) + (size_t)T * D))[q] = 0u; }
    const float brl = F.in[I_BR][l * 32 + ((lane >> 1) & 31)];
    const int mye = (lane >> 1) & 31;
    for (int row0 = F.bid * 8 + F.wave; row0 < nrows; row0 += 2 * nwaves) {
        int rw[2]; bool vld[2];
        rw[0] = row0; vld[0] = true; vld[1] = (row0 + nwaves < nrows); rw[1] = vld[1] ? row0 + nwaves : row0;
        f32x4 m[2][4], x[2][4], hv[2][4];
#pragma unroll
        for (int u = 0; u < 2; ++u) { const bf16_t* mr = F.w<bf16_t>(WS_MIXO) + (size_t)rw[u] * D;
#pragma unroll
            for (int i = 0; i < 4; ++i) { const u32x2 w = *(const u32x2*)(mr + 4 * lane + 256 * i); m[u][i] = (f32x4){bflo(w.x), bfhi(w.x), bflo(w.y), bfhi(w.y)}; }
            load_row(xrow_ptr(F, l, rw[u]), lane, x[u]); }
#pragma unroll
        for (int u = 0; u < 2; ++u) {
            const int which = rw[u] >= L;
            const float* v0 = vecs_ptr(F, l, which, 2);
            const float rs1 = row_rstd(m[u]);
#pragma unroll
            for (int i = 0; i < 4; ++i) { const f32x4 a = *(const f32x4*)(v0 + 4 * lane + 256 * i); x[u][i] = x[u][i] + m[u][i] * rs1 * a; }
        }
#pragma unroll
        for (int u = 0; u < 2; ++u) {
            if (vld[u]) { float* xo = F.w<float>(WS_XCUR) + (size_t)rw[u] * D;
#pragma unroll
                for (int i = 0; i < 4; ++i) *(f32x4*)(xo + 4 * lane + 256 * i) = x[u][i]; }
        }
#pragma unroll
        for (int u = 0; u < 2; ++u) {
            const int which = rw[u] >= L;
            const float* v1 = vecs_ptr(F, l, which, 3), *v2 = vecs_ptr(F, l, which, 4);
            const float rs2 = row_rstd(x[u]);
#pragma unroll
            for (int i = 0; i < 4; ++i) { const f32x4 a = *(const f32x4*)(v1 + 4 * lane + 256 * i), b = *(const f32x4*)(v2 + 4 * lane + 256 * i); hv[u][i] = x[u][i] * rs2 * a + b; }
            if (vld[u]) { unsigned char* ho = F.w<unsigned char>(WS_H2) + (size_t)rw[u] * D;
#pragma unroll
                for (int i = 0; i < 4; ++i) *(unsigned*)(ho + 4 * lane + 256 * i) = pk_fp8x4(hv[u][i][0], hv[u][i][1], hv[u][i][2], hv[u][i][3]); }
        }
        float part[2][32];
#pragma unroll
        for (int e = 0; e < 32; ++e) {
            float s0 = 0.f, s1 = 0.f;
#pragma unroll
            for (int i = 0; i < 4; ++i) { const f32x4 w = *(const LAS f32x4*)(wr + e * WRP + 4 * lane + 256 * i);
                s0 += hv[0][i][0] * w[0] + hv[0][i][1] * w[1] + hv[0][i][2] * w[2] + hv[0][i][3] * w[3];
                s1 += hv[1][i][0] * w[0] + hv[1][i][1] * w[1] + hv[1][i][2] * w[2] + hv[1][i][3] * w[3]; }
            part[0][e] = s0; part[1][e] = s1;
        }
#pragma unroll
        for (int st = 0; st < 5; ++st) {
            const int o = 32 >> st, n = 32 >> st;
            const bool upper = (lane & o) != 0;
#pragma unroll
            for (int i = 0; i < n / 2; ++i) {
#pragma unroll
                for (int u = 0; u < 2; ++u) {
                    const float send = upper ? part[u][i] : part[u][i + n / 2];
                    const float recv = __shfl_xor(send, o);
                    const float keep = upper ? part[u][i + n / 2] : part[u][i];
                    part[u][i] = keep + recv;
                }
            }
        }
#pragma unroll
        for (int u = 0; u < 2; ++u) {
            float lg = part[u][0] + __shfl_xor(part[u][0], 1);
            lg += brl;
            int rank = 0;
#pragma unroll
            for (int e = 0; e < 32; ++e) { const float ov = __int_as_float(__builtin_amdgcn_readlane(__float_as_int(lg), 2 * e)); rank += (ov > lg || (ov == lg && e < mye)) ? 1 : 0; }
            int te[4]; float tv[4];
#pragma unroll
            for (int k = 0; k < 4; ++k) {
                const unsigned long long msk = __ballot(rank == k && (lane & 1) == 0);
                const int idx = msk ? __builtin_amdgcn_readfirstlane((int)__builtin_ctzll(msk)) : 2 * k;
                te[k] = idx >> 1; tv[k] = __int_as_float(__builtin_amdgcn_readlane(__float_as_int(lg), idx));
            }
            const float e1 = __expf(tv[1] - tv[0]), e2 = __expf(tv[2] - tv[0]), e3 = __expf(tv[3] - tv[0]);
            const float inv = 1.0f / (1.0f + e1 + e2 + e3);
            if (lane < 4 && vld[u]) {
                const int k = lane, row = rw[u];
                const int e = k == 0 ? te[0] : (k == 1 ? te[1] : (k == 2 ? te[2] : te[3]));
                const float wgt = (k == 0 ? 1.0f : (k == 1 ? e1 : (k == 2 ? e2 : e3))) * inv;
                const unsigned pos = __hip_atomic_fetch_add(lcnt + e, 1u, __ATOMIC_RELAXED, __HIP_MEMORY_SCOPE_WORKGROUP);
                F.w<int>(WS_RE)[row * 4 + k] = e; F.w<int>(WS_RP)[row * 4 + k] = (int)pos; F.w<float>(WS_RW)[row * 4 + k] = wgt;
            }
        }
    }
    __syncthreads();
    if (F.tid < 32) lcnt[32 + F.tid] = atomicAdd(cnt + F.tid * 32, lcnt[F.tid]);
    __syncthreads();
    for (int row = F.bid * 8 + F.wave; row < nrows; row += nwaves) {
        if (lane < 4) { const int a = row * 4 + lane; F.w<int>(WS_RP)[a] += (int)lcnt[32 + F.w<int>(WS_RE)[a]]; }
    }
}

__device__ __forceinline__ int expert_pad_start(const Frame& F, int l, int& ntiles) {
    const unsigned* cnt = F.w<unsigned>(WS_CTL) + CW_CNT + l * 1024;
    int c = F.lane < 32 ? (int)__hip_atomic_load(cnt + F.lane * 32, __ATOMIC_RELAXED, __HIP_MEMORY_SCOPE_AGENT) : 0;
    int padded = (c + 255) & ~255;
    int incl = padded;
#pragma unroll
    for (int o = 1; o < 32; o <<= 1) { const int v = __shfl_up(incl, o); if ((F.lane & 31) >= o) incl += v; }
    ntiles = __shfl(incl, 31) >> 8;
    return incl - padded;
}

__device__ __forceinline__ void ph_gather(const Frame& F, int l) {
    int ntiles; const int ps = expert_pad_start(F, l, ntiles);
    if (F.bid == 0 && F.wave == 0) {
        int* tab = F.w<int>(WS_CTL) + CW_TILE + l * 320;
        const int nxt = __shfl_down(ps, 1);
        const int endt = (F.lane == 31) ? ntiles : (nxt >> 8);
        if (F.lane < 32) for (int t = ps >> 8; t < endt; ++t) tab[t] = F.lane;
        if (F.lane == 0) F.w<int>(WS_CTL)[CW_NT + l] = ntiles;
    }
    const int nrows = (l == 0) ? T : L;
    for (int a0 = (F.bid * 8 + F.wave) * 64; a0 < nrows * 4; a0 += F.G * 8 * 64) {
        const int a = a0 + F.lane;
        if (a < nrows * 4) {
            const int e = F.w<int>(WS_RE)[a], pos = F.w<int>(WS_RP)[a];
            const int dst = __shfl(ps, e) + pos;
            F.w<int>(WS_SLOT)[a] = dst;
            F.w<int>(WS_ROWTOK)[(size_t)l * MAXROWS + dst] = a >> 2;
        }
    }
}

__device__ __forceinline__ void ph_final(const Frame& F, int l) {
    const int nrows = (l == 0) ? T : L;
    const int nwaves = F.G * 8, lane = F.lane;
    const bf16_t* Y = F.w<bf16_t>(WS_Y) + (size_t)l * MAXROWS * D;
    for (int row = F.bid * 8 + F.wave; row < nrows; row += nwaves) {
        const int which = row >= L;
        const float* ve = vecs_ptr(F, l, which, 5);
        f32x4 f[4];
#pragma unroll
        for (int i = 0; i < 4; ++i) f[i] = (f32x4){0.f, 0.f, 0.f, 0.f};
        int slot[4]; float wgt[4];
#pragma unroll
        for (int k = 0; k < 4; ++k) { slot[k] = F.w<int>(WS_SLOT)[row * 4 + k]; wgt[k] = F.w<float>(WS_RW)[row * 4 + k]; }
#pragma unroll
        for (int k = 0; k < 4; ++k) {
            const bf16_t* yr = Y + (size_t)slot[k] * D;
#pragma unroll
            for (int i = 0; i < 4; ++i) { const u32x2 w = *(const u32x2*)(yr + 4 * lane + 256 * i); f[i][0] += wgt[k] * bflo(w.x); f[i][1] += wgt[k] * bfhi(w.x); f[i][2] += wgt[k] * bflo(w.y); f[i][3] += wgt[k] * bfhi(w.y); }
        }
        const float rs = row_rstd(f);
        f32x4 x[4]; load_row(F.w<float>(WS_XCUR) + (size_t)row * D, lane, x);
#pragma unroll
        for (int i = 0; i < 4; ++i) { const f32x4 a = *(const f32x4*)(ve + 4 * lane + 256 * i); x[i] = x[i] + f[i] * rs * a; }
        float* xo = (l == 1) ? F.out + (size_t)row * D : F.w<float>(WS_XCUR) + (size_t)row * D;
#pragma unroll
        for (int i = 0; i < 4; ++i) *(f32x4*)(xo + 4 * lane + 256 * i) = x[i];
        if (l == 0) {
            const float rstd = row_rstd(x);
            const float* va = vecs_ptr(F, 1, which, 0), *vb = vecs_ptr(F, 1, which, 1);
            bf16_t* orow = F.w<bf16_t>(WS_HB) + (size_t)row * D;
#pragma unroll
            for (int i = 0; i < 4; ++i) {
                const int c = 4 * lane + 256 * i;
                const f32x4 a = *(const f32x4*)(va + c), b = *(const f32x4*)(vb + c);
                u32x2 w; w.x = pk_bf16(x[i][0] * rstd * a[0] + b[0], x[i][1] * rstd * a[1] + b[1]); w.y = pk_bf16(x[i][2] * rstd * a[2] + b[2], x[i][3] * rstd * a[3] + b[3]);
                *(u32x2*)(orow + c) = w;
            }
        }
    }
}

constexpr int PH_PER_LAYER = 10, N_PHASES = 2 + 2 * PH_PER_LAYER;
#ifndef PH_MASK
#define PH_MASK 0xFFFFFFFFu
#endif
#define EN(b) (((PH_MASK) >> (b)) & 1u)
#ifndef DUP_MASK
#define DUP_MASK 0u
#endif
#define REP(b) for (int _rep = 0; _rep < 1 + (int)(((DUP_MASK) >> (b)) & 1u); ++_rep)

__global__ void __launch_bounds__(NTHREADS, 2) mega(Args args) {
    extern __shared__ __attribute__((aligned(16))) unsigned char shm[];
    Frame F0;
    F0.in.kp = (kargp_t)__builtin_amdgcn_kernarg_segment_ptr();
    F0.out = args.out; F0.ws = args.ws; F0.lds = (LAS unsigned char*)shm;
    F0.tid = threadIdx.x; F0.lane = F0.tid & 63; F0.wave = __builtin_amdgcn_readfirstlane(F0.tid >> 6); F0.G = gridDim.x; F0.bid = blockIdx.x;
    volatile LAS unsigned* bst = (volatile LAS unsigned*)(shm + LDS_BYTES - 16);
    XcdBarrier bar; bar.bar = F0.w<unsigned>(WS_CTL) + CW_BAR; bar.x = 0; bar.st = bst;
#if N_LAUNCH_MODE == 1
    if (F0.tid == 0) { bst[0] = 0u; bst[1] = 0u; }
    __syncthreads();
    bar = xcd_barrier_post(F0.w<unsigned>(WS_CTL) + CW_BAR, bst);
#define GRID_BAR() xcd_barrier(bar)
#else
#define GRID_BAR() do {} while (0)
#endif
    const int lo = args.ph_lo, hi = args.ph_hi;
#define IN(k) (lo <= (k) && (k) < hi)
#define SEAM(k) do { if (IN(k) && IN((k) + 1)) GRID_BAR(); } while (0)

    if (IN(0)) { const Frame F = launder(F0); REP(0) ph_convert(F); REP(1) ph_modpart(F); REP(2) ph_filter(F); }
    SEAM(0);
    if (IN(1)) { const Frame F = launder(F0); REP(3) ph_norm1(F, 0); REP(4) ph_fsum(F); ph_vecs(F); }
    SEAM(1);
    for (int l = 0; l < 2; ++l) {
        const int pb = 2 + l * PH_PER_LAYER;
        if (EN(5) && IN(pb + 0)) { const Frame F = launder(F0);
            pg8::Gemm g{F.w<bf16_t>(WS_HB), F.w<bf16_t>(WS_WINT) + (size_t)l * PC * D, D};
            pg8::SchedGrid S{PC / 256, (T / 256) * (PC / 256), F.G, F.vid};
            pg8::EpiBf16 E{F.w<bf16_t>(WS_P), PC, nullptr, 0};
            REP(5) pg8::gemm_phase<pg8::EpiBf16, pg8::SchedGrid>(F.lds, g, S, E, F.tid);
        }
        SEAM(pb + 0);
        if (IN(pb + 1)) { const Frame F = launder(F0); REP(6) ph_ssd_prep(F, l); REP(7) ph_hy_prep(F, l); REP(8) ph_na(F, l, 0); }
        SEAM(pb + 1);
        if (IN(pb + 2)) { const Frame F = launder(F0); REP(9) ph_ssd_scan(F); REP(10) { ph_hy_conv(F, l); if (l == 0) ph_hy_conv_ctx(F, l); } }
        SEAM(pb + 2);
        if (EN(11) && IN(pb + 3)) { const Frame F = launder(F0); REP(11) ph_ssd_out(F, l); REP(18) ph_hy_tr(F); if (l == 0) ph_na(F, l, 1); }
        SEAM(pb + 3);
        if (EN(12) && IN(pb + 4)) { const Frame F = launder(F0);
            pg8::Gemm g{F.w<bf16_t>(WS_MIX), F.w<bf16_t>(WS_WOUTT) + (size_t)l * D * D, D};
            const int nM = (l == 0) ? T / 256 : L / 256;
            pg8::SchedGrid S{4, nM * 4, F.G, F.vid};
            pg8::EpiBf16 E{F.w<bf16_t>(WS_MIXO), D, nullptr, 0};
            REP(12) pg8::gemm_phase<pg8::EpiBf16, pg8::SchedGrid>(F.lds, g, S, E, F.tid);
        }
        SEAM(pb + 4);
        if (EN(13) && IN(pb + 5)) { const Frame F = launder(F0); ph_post1(F, l); }
        SEAM(pb + 5);
        if (EN(14) && IN(pb + 6)) { const Frame F = launder(F0); REP(14) ph_gather(F, l); }
        SEAM(pb + 6);
        if (EN(15) && IN(pb + 7)) { const Frame F = launder(F0);
            const int* tab = F.w<int>(WS_CTL) + CW_TILE + l * 320;
            const int ntiles = __builtin_amdgcn_readfirstlane(F.w<int>(WS_CTL)[CW_NT + l]);
            pg8::Gemm g{F.w<bf16_t>(WS_H2), (const bf16_t*)(F.w<unsigned char>(WS_WGUT) + (size_t)l * NE * 2048 * D), D / 2};
            pg8::SchedMoe S{8, ntiles * 8, F.G, F.vid, tab};
            pg8::EpiAct E{F.w<unsigned char>(WS_HMID) + (size_t)l * MAXROWS * D, F.in[I_BGU] + (size_t)l * NE * 2048};
            LAS int* rowtab = (LAS int*)(F.lds + pg8::STAGE_BYTES);
            __syncthreads();
            {
                int nt_; const int ps = expert_pad_start(F, l, nt_);
                const unsigned* cnt = F.w<unsigned>(WS_CTL) + CW_CNT + l * 1024;
                for (int ui = 0; ui * F.G + F.vid < ntiles * 8 && ui < 12; ++ui) {
                    const int pa = (ui * F.G + F.vid) / 8;
                    const int e = tab[pa];
                    const int pstart = __shfl(ps, e), ce = (int)__hip_atomic_load(cnt + e * 32, __ATOMIC_RELAXED, __HIP_MEMORY_SCOPE_AGENT);
                    if (F.tid < 256) { const int prow = pa * 256 + F.tid; rowtab[ui * 256 + F.tid] = (prow - pstart < ce) ? F.w<int>(WS_ROWTOK)[(size_t)l * MAXROWS + prow] : T; }
                }
            }
            __syncthreads();
            REP(15) pg8::gemm_phase<pg8::EpiAct, pg8::SchedMoe, true, true, true>(F.lds, g, S, E, F.tid, rowtab);
        }
        SEAM(pb + 7);
        if (EN(16) && IN(pb + 8)) { const Frame F = launder(F0);
            const int* tab = F.w<int>(WS_CTL) + CW_TILE + l * 320;
            const int ntiles = __builtin_amdgcn_readfirstlane(F.w<int>(WS_CTL)[CW_NT + l]);
            pg8::Gemm g{(const bf16_t*)(F.w<unsigned char>(WS_HMID) + (size_t)l * MAXROWS * D), (const bf16_t*)(F.w<unsigned char>(WS_WDT) + (size_t)l * NE * D * D), D / 2};
            pg8::SchedMoe S{4, ntiles * 4, F.G, F.vid, tab};
            pg8::EpiBf16 E{F.w<bf16_t>(WS_Y) + (size_t)l * MAXROWS * D, D, F.in[I_BDN] + (size_t)l * NE * D, D};
            REP(16) pg8::gemm_phase<pg8::EpiBf16, pg8::SchedMoe, true, false, true>(F.lds, g, S, E, F.tid);
        }
        SEAM(pb + 8);
        if (EN(17) && IN(pb + 9)) { const Frame F = launder(F0); ph_final(F, l); }
        if (l == 0) SEAM(pb + 9);
    }
#undef IN
#undef SEAM
}

extern "C" void kernel_launch(void* const* d_in, const int* in_sizes, int n_in, void* d_out, int out_size, void* d_ws, size_t ws_size, hipStream_t stream) {
    static int grid = 0;
    if (grid == 0) {
        if (n_in != N_IN || out_size != L * D || ws_size < WS_END) { fprintf(stderr, "kernel_launch: unexpected shapes: n_in %d out %d ws %zu (need %zu)\n", n_in, out_size, ws_size, (size_t)WS_END); grid = -1; return; }
        int dev = 0, cus = 0, per_cu = 0;
        if (hipGetDevice(&dev) != hipSuccess || hipDeviceGetAttribute(&cus, hipDeviceAttributeMultiprocessorCount, dev) != hipSuccess) { grid = -1; return; }
        if (hipFuncSetAttribute((const void*)mega, hipFuncAttributeMaxDynamicSharedMemorySize, LDS_BYTES) != hipSuccess) { fprintf(stderr, "kernel_launch: hipFuncSetAttribute failed\n"); grid = -1; return; }
        if (hipOccupancyMaxActiveBlocksPerMultiprocessor(&per_cu, (const void*)mega, NTHREADS, LDS_BYTES) != hipSuccess || per_cu < 1) { fprintf(stderr, "kernel_launch: occupancy query says %d\n", per_cu); }
        (void)hipGetLastError();
        grid = cus;
    }
    if (grid < 0) return;
    (void)hipMemsetAsync((char*)d_ws + WS_CTL, 0, CTL_BYTES, stream);
    Args a{};
    for (int i = 0; i < N_IN; ++i) a.in[i] = (const float*)d_in[i];
    a.out = (float*)d_out; a.ws = (unsigned char*)d_ws;
#if N_LAUNCH_MODE == 1
    a.ph_lo = 0; a.ph_hi = N_PHASES;
    hipLaunchKernelGGL(mega, dim3(grid), dim3(NTHREADS), LDS_BYTES, stream, a);
#else
    for (int p = 0; p < N_PHASES; ++p) { a.ph_lo = p; a.ph_hi = p + 1; hipLaunchKernelGGL(mega, dim3(grid), dim3(NTHREADS), LDS_BYTES, stream, a); }
#endif
}
```

```cpp
#include <hip/hip_runtime.h>
#include <cstdio>
#include <cstdint>

#define LAS __attribute__((address_space(3)))
typedef unsigned short bf16_t;
typedef short bf16x8 __attribute__((ext_vector_type(8)));
typedef float f32x4 __attribute__((ext_vector_type(4)));
typedef float f32x16 __attribute__((ext_vector_type(16)));
typedef unsigned u32x4 __attribute__((ext_vector_type(4)));
typedef unsigned u32x2 __attribute__((ext_vector_type(2)));
typedef int v4i __attribute__((ext_vector_type(4)));
typedef int v8i __attribute__((ext_vector_type(8)));

#ifndef N_LAUNCH_MODE
#define N_LAUNCH_MODE 1
#endif

constexpr int D = 1024, L = 16384, LC = 256, T = L + LC, NCH = T / 128;
constexpr int PC = 3328;
constexpr int CZ = 0, CXBC = 384, CQ = 1280, CK = 1664, CV = 2048, CHY = 2432, CDT = 3200;
constexpr int NE = 32;
constexpr int MAXT = 292;
constexpr int MAXROWS = MAXT * 256;
constexpr int NTHREADS = 512;
constexpr int LDS_BYTES = 160 * 1024;
constexpr float RMS_EPS = 1e-6f;

enum { I_X = 0, I_C, I_CTX, I_CCTX, I_WMOD, I_BMOD, I_NORMG, I_WIN, I_SCW, I_SCB, I_ALOG, I_DTB, I_SSDD, I_SSDNG, I_RPB, I_HCW, I_HCB,
       I_FW1, I_FB1, I_FW2, I_FB2, I_FW3, I_FREQ, I_HYD, I_WOUT, I_WR, I_BR, I_WGU, I_BGU, I_WDN, I_BDN, N_IN };

constexpr size_t al256(size_t x) { return (x + 255) & ~(size_t)255; }
constexpr size_t WS_CTL   = 0;
constexpr size_t CTL_BYTES = 64 * 1024;
constexpr size_t WS_WINT  = WS_CTL + CTL_BYTES;
constexpr size_t WS_WOUTT = WS_WINT + al256((size_t)2 * PC * D * 2);
constexpr size_t WS_WGUT  = WS_WOUTT + al256((size_t)2 * D * D * 2);
constexpr size_t WS_WDT   = WS_WGUT + al256((size_t)2 * NE * 2048 * D * 2);
constexpr size_t WS_MODP  = WS_WDT + al256((size_t)2 * NE * D * D * 2);
constexpr int KRL = 2 * L + 512;
constexpr size_t WS_KR    = WS_MODP + al256((size_t)2 * 2 * 32 * 6144 * 4);
constexpr size_t WS_KCOMBC= WS_KR + al256((size_t)2 * 256 * KRL * 2);
constexpr size_t WS_FPART = WS_KCOMBC + al256((size_t)2 * LC * 256 * 4);
constexpr size_t WS_FPARTC= WS_FPART + al256((size_t)2 * 256 * 512 * 4);
constexpr size_t WS_FSUM  = WS_FPARTC + al256((size_t)16 * 512 * 4);
constexpr size_t WS_HB    = WS_FSUM + al256((size_t)3 * 256 * 4);
constexpr size_t WS_P     = WS_HB + al256((size_t)T * D * 2);
constexpr size_t WS_XBC   = WS_P + al256((size_t)T * PC * 2);
constexpr size_t WS_DTV   = WS_XBC + al256((size_t)T * 896 * 2);
constexpr size_t WS_ACS   = WS_DTV + al256((size_t)T * 12 * 4);
constexpr size_t WS_ALAST = WS_ACS + al256((size_t)T * 12 * 4);
constexpr size_t WS_STATES= WS_ALAST + al256((size_t)NCH * 12 * 4);
constexpr size_t WS_SSTART= WS_STATES + al256((size_t)2 * NCH * 6 * 128 * 64 * 4);
constexpr size_t WS_U     = WS_SSTART + al256((size_t)2 * NCH * 6 * 128 * 64 * 4);
constexpr size_t WS_UT    = WS_U + al256((size_t)T * 256 * 4);
constexpr size_t WS_UT8   = WS_UT + al256((size_t)256 * L * 2);
constexpr size_t WS_X0T   = WS_UT8 + al256((size_t)256 * L);
constexpr size_t WS_YT    = WS_X0T + al256((size_t)256 * L * 2);
constexpr size_t WS_MIX   = WS_YT + al256((size_t)256 * L * 2);
constexpr size_t WS_MIXO  = WS_MIX + al256((size_t)T * D * 2);
constexpr size_t WS_XCUR  = WS_MIXO + al256((size_t)T * D * 4);
constexpr size_t WS_H2    = WS_XCUR + al256((size_t)T * D * 4);
constexpr size_t WS_RE    = WS_H2 + al256((size_t)(T + 1) * D * 2);
constexpr size_t WS_RP    = WS_RE + al256((size_t)T * 4 * 4);
constexpr size_t WS_RW    = WS_RP + al256((size_t)T * 4 * 4);
constexpr size_t WS_SLOT  = WS_RW + al256((size_t)T * 4 * 4);
constexpr size_t WS_XG    = WS_SLOT + al256((size_t)T * 4 * 4);
constexpr size_t WS_HMID  = WS_XG + 256;
constexpr size_t WS_Y     = WS_HMID + al256((size_t)2 * MAXROWS * D * 2);
constexpr size_t WS_VECS  = WS_Y + al256((size_t)2 * MAXROWS * D * 2);
constexpr size_t WS_ROWTOK= WS_VECS + al256((size_t)2 * 2 * 6 * 1024 * 4);
constexpr size_t WS_END   = WS_ROWTOK + al256((size_t)2 * MAXROWS * 4);

constexpr int CW_BAR = 0;
constexpr int CW_CNT = 8192;
constexpr int CW_NT = 4200;
constexpr int CW_TILE = 4224;

__device__ __forceinline__ float bf2f(unsigned short b) { return __uint_as_float(((unsigned)b) << 16); }
__device__ __forceinline__ unsigned short f2bf(float f) { unsigned u = __float_as_uint(f); u += 0x7FFFu + ((u >> 16) & 1u); return (unsigned short)(u >> 16); }
__device__ __forceinline__ unsigned pk_bf16(float lo, float hi) { return (unsigned)f2bf(lo) | ((unsigned)f2bf(hi) << 16); }
__device__ __forceinline__ float sat8(float x) { return fminf(fmaxf(x, -448.0f), 448.0f); }
__device__ __forceinline__ unsigned pk_fp8x4(float a, float b, float c, float d) { unsigned w = 0; w = __builtin_amdgcn_cvt_pk_fp8_f32(sat8(a), sat8(b), w, false); w = __builtin_amdgcn_cvt_pk_fp8_f32(sat8(c), sat8(d), w, true); return w; }
constexpr float KR_SCALE = 64.0f;
constexpr float W8_SCALE = 32.0f;
constexpr int W8_SCALE_E8M0 = 0x7A7A7A7A, ONE_E8M0 = 0x7F7F7F7F;
__device__ __forceinline__ float bflo(unsigned w) { return __uint_as_float(w << 16); }
__device__ __forceinline__ float bfhi(unsigned w) { return __uint_as_float(w & 0xFFFF0000u); }
__device__ __forceinline__ float silu_f(float x) { return x / (1.0f + __expf(-x)); }
__device__ __forceinline__ float softplus_f(float x) { return x > 20.f ? x : log1pf(__expf(x)); }
__device__ __forceinline__ float wave_sum(float v) {
#pragma unroll
    for (int o = 32; o >= 1; o >>= 1) v += __shfl_xor(v, o);
    return v;
}
__device__ __forceinline__ void lds_fence() { asm volatile("s_waitcnt lgkmcnt(0)" ::: "memory"); }

#define XB_TMO      128
#define XB_XCNT(j)  (256  + 64 * (j))
#define XB_XSUB(j)  (1280 + 64 * (j))
#define XB_XGEN(j)  (2304 + 64 * (j))
#define XB_TOP      3328
#define XB_TOPGEN   3392
#define XCD_BAR_WORDS 3456
#define XB_SPIN_CAP (1u << 18)
__device__ __forceinline__ unsigned xb_ld(unsigned* p)              { return __hip_atomic_load(p, __ATOMIC_RELAXED, __HIP_MEMORY_SCOPE_AGENT); }
__device__ __forceinline__ unsigned xb_add(unsigned* p, unsigned v) { return __hip_atomic_fetch_add(p, v, __ATOMIC_RELAXED, __HIP_MEMORY_SCOPE_AGENT); }
__device__ __forceinline__ unsigned xb_xcc_id() { return (unsigned)__builtin_amdgcn_s_getreg((3 << 11) | 20) & 0xFu; }
#define XB_SPIN(cond, bar) do { unsigned _sp = 0; while (cond) { __builtin_amdgcn_s_sleep(1); \
    if ((++_sp & 255u) == 0u) { if (xb_ld(&(bar)[XB_TMO])) break; if (_sp > XB_SPIN_CAP) { atomicAdd(&(bar)[XB_TMO], 1u); break; } } } } while (0)
struct XcdBarrier { unsigned* bar; unsigned x; volatile LAS unsigned* st; };
__device__ __forceinline__ XcdBarrier xcd_barrier_post(unsigned* bar, volatile LAS unsigned* st) {
    XcdBarrier b; b.bar = bar; b.x = xb_xcc_id(); b.st = st;
    if (threadIdx.x == 0) (void)xb_add(&bar[XB_XCNT(b.x)], 1u);
    return b;
}
__device__ __forceinline__ void xcd_barrier_complete(unsigned* bar, unsigned x, unsigned& nloc, unsigned& nx) {
    const unsigned G = gridDim.x * gridDim.y * gridDim.z;
    unsigned sum, cnt, mine, sp = 0u;
    for (;;) {
        sum = 0u; cnt = 0u; mine = 0u;
#pragma unroll
        for (unsigned j = 0; j < 16; ++j) { const unsigned c = xb_ld(&bar[XB_XCNT(j)]); sum += c; cnt += (c > 0u) ? 1u : 0u; mine = (j == x) ? c : mine; }
        if (sum == G) break;
        __builtin_amdgcn_s_sleep(1);
        if ((++sp & 255u) == 0u) { if (xb_ld(&bar[XB_TMO])) break; if (sp > XB_SPIN_CAP) { atomicAdd(&bar[XB_TMO], 1u); break; } }
    }
    nloc = mine > 0u ? mine : 1u; nx = cnt > 0u ? cnt : 1u;
}
__device__ __forceinline__ void xcd_barrier(const XcdBarrier& b) {
    asm volatile("s_waitcnt vmcnt(0)" ::: "memory");
    __syncthreads();
    if (threadIdx.x == 0) {
        unsigned* bar = b.bar;
        __builtin_amdgcn_s_waitcnt(0);
        unsigned nloc = b.st[0], nx = b.st[1];
        if (nloc == 0u) { xcd_barrier_complete(bar, b.x, nloc, nx); b.st[0] = nloc; b.st[1] = nx; }
        const unsigned old = xb_add(&bar[XB_XSUB(b.x)], 1u);
        const unsigned gen = old / nloc;
        if (old + 1u == (gen + 1u) * nloc) {
            __builtin_amdgcn_fence(__ATOMIC_RELEASE, "agent");
            asm volatile("s_waitcnt vmcnt(0)" ::: "memory");
            const unsigned og = xb_add(&bar[XB_TOP], 1u);
            const unsigned tg = og / nx;
            if (og + 1u == (tg + 1u) * nx) xb_add(&bar[XB_TOPGEN], 1u);
            else XB_SPIN(xb_ld(&bar[XB_TOPGEN]) == tg, bar);
            __builtin_amdgcn_fence(__ATOMIC_ACQUIRE, "agent");
            xb_add(&bar[XB_XGEN(b.x)], 1u);
            asm volatile("s_waitcnt vmcnt(0)" ::: "memory");
        } else {
            XB_SPIN(xb_ld(&bar[XB_XGEN(b.x)]) == gen, bar);
            __builtin_amdgcn_fence(__ATOMIC_ACQUIRE, "agent");
            asm volatile("s_waitcnt vmcnt(0)" ::: "memory");
        }
    }
    __syncthreads();
}

#ifndef GEMM_REP
#define GEMM_REP 1
#endif
namespace pg8 {
constexpr int BM = 256, BK = 64, HALF = 128, HTB = HALF * BK * 2, STAGE_BYTES = 8 * HTB;
__host__ __device__ __forceinline__ int lds_byte(int r, int c) { const int st = (r >> 4) * 2 + (c >> 5), rr = r & 15, cc = c & 31, ob = rr * 64 + cc * 2; return st * 1024 + (ob ^ (((ob >> 9) & 1) << 5)); }
__host__ __device__ __forceinline__ void stage_rc(int b, int& R, int& C) { const int st = b / 1024, sb = b % 1024, swz = sb ^ (((sb >> 9) & 1) << 5); R = (st >> 1) * 16 + swz / 64; C = (st & 1) * 32 + (swz % 64) / 2; }
__host__ __device__ __forceinline__ int perm32(int rho) { const int n = rho >> 4, i = rho & 15; return 8 * (i >> 2) + 4 * n + (i & 3); }

struct Unit { int pa, pb, pn, e; };
struct Gemm { const bf16_t* A; const bf16_t* Bt; int K; };

template <class Epi, class Sched, bool ALIGN_EPI = true, bool GATHER = false, bool FP8 = false>
__device__ __forceinline__ void gemm_phase(LAS unsigned char* lds, const Gemm g, const Sched& S, const Epi& E, const int tid, const LAS int* rowtab = nullptr) {
    const int wid = __builtin_amdgcn_readfirstlane(tid >> 6), lane = tid & 63, wr = wid >> 2, wc = wid & 3, fr = lane & 15, fq = lane >> 4;
    const int K = g.K, nt = K / BK;
    unsigned voffA[2], voffB[2];
    int gR[2], gC[2];
#pragma unroll
    for (int i = 0; i < 2; ++i) { int R, C; stage_rc(tid * 16 + i * 8192, R, C); const int Rb = Epi::PERM ? ((R & ~31) + perm32(R & 31)) : R;
        voffA[i] = (unsigned)(R * K + C) * 2u; voffB[i] = (unsigned)(Rb * K + C) * 2u; gR[i] = R; gC[i] = C * 2; }
    unsigned vC0[2], vC1[2], vN0[2], vN1[2];
#define PG8_GOFFS(dst0, dst1, ui_) do { _Pragma("unroll") for (int _i = 0; _i < 2; ++_i) { \
        dst0[_i] = (unsigned)rowtab[(ui_) * 256 + gR[_i]] * (unsigned)(K * 2) + (unsigned)gC[_i]; dst1[_i] = (unsigned)rowtab[(ui_) * 256 + 128 + gR[_i]] * (unsigned)(K * 2) + (unsigned)gC[_i]; } } while (0)
    const size_t kstep = (size_t)(BK * 2);
    const size_t hstep = (size_t)HALF * K * 2;
    const size_t tstep = 2 * hstep;
    const unsigned ldsw = (unsigned)wid * 1024u;
    const int aoff = lds_byte(wr * 64 + fr, fq * 8), boff = lds_byte(wc * 32 + fr, fq * 8);
#define PG8_SA(b, h) (((b) * 2 + (h)) * HTB)
#define PG8_SB(b, h) ((4 + (b) * 2 + (h)) * HTB)
#define PG8_STAGE(bufoff, gbase, voff) do { _Pragma("unroll") for (int _i = 0; _i < 2; ++_i) \
        __builtin_amdgcn_global_load_lds((const unsigned*)((const char*)(gbase) + (voff)[_i]), (LAS unsigned*)(lds + (bufoff) + ldsw + _i * 8192), 16, 0, 0); } while (0)
#define PG8_LDA(dst, b, h) do { _Pragma("unroll") for (int m = 0; m < 4; ++m) { const v4i _x = *(const LAS v4i*)(lds + PG8_SA(b, h) + aoff + m * 2048), _y = *(const LAS v4i*)(lds + PG8_SA(b, h) + aoff + m * 2048 + 1024); \
        dst[m] = __builtin_shufflevector(_x, _y, 0, 1, 2, 3, 4, 5, 6, 7); } } while (0)
#define PG8_LDB(dst, b, h) do { _Pragma("unroll") for (int n = 0; n < 2; ++n) { const v4i _x = *(const LAS v4i*)(lds + PG8_SB(b, h) + boff + n * 2048), _y = *(const LAS v4i*)(lds + PG8_SB(b, h) + boff + n * 2048 + 1024); \
        dst[n] = __builtin_shufflevector(_x, _y, 0, 1, 2, 3, 4, 5, 6, 7); } } while (0)
#define PG8_HALF0(x) __builtin_bit_cast(bf16x8, __builtin_shufflevector((x), (x), 0, 1, 2, 3))
#define PG8_HALF1(x) __builtin_bit_cast(bf16x8, __builtin_shufflevector((x), (x), 4, 5, 6, 7))
#define PG8_MMA(ai, bj, At, Bt) do { __builtin_amdgcn_s_setprio(1); if constexpr (FP8) { _Pragma("unroll") for (int m = 0; m < 4; ++m) _Pragma("unroll") for (int n = 0; n < 2; ++n) \
        asm volatile("v_mfma_scale_f32_16x16x128_f8f6f4 %0, %1, %2, %0, %3, %4 op_sel_hi:[0,0,0]" : "+v"(acc[ai][bj][m][n]) : "v"(Bt[n]), "v"(At[m]), "v"(sclW), "v"(sclX)); } \
        else { _Pragma("unroll") for (int m = 0; m < 4; ++m) _Pragma("unroll") for (int n = 0; n < 2; ++n) { \
        acc[ai][bj][m][n] = __builtin_amdgcn_mfma_f32_16x16x32_bf16(PG8_HALF0(Bt[n]), PG8_HALF0(At[m]), acc[ai][bj][m][n], 0, 0, 0); \
        acc[ai][bj][m][n] = __builtin_amdgcn_mfma_f32_16x16x32_bf16(PG8_HALF1(Bt[n]), PG8_HALF1(At[m]), acc[ai][bj][m][n], 0, 0, 0); } } __builtin_amdgcn_s_setprio(0); } while (0)
#define PG8_WAIT_V(n) asm volatile("s_waitcnt vmcnt(" #n ")" ::: "memory")
#define PG8_WAIT_L(n) asm volatile("s_waitcnt lgkmcnt(" #n ")" ::: "memory")
#define PG8_BAR __builtin_amdgcn_s_barrier()
#define PG8_SCHED __builtin_amdgcn_sched_barrier(0)
    Unit cur, nxt; int ui = 0;
    if (!S.next(0, cur)) return;
    f32x4 acc[2][2][4][2];
    E.init(acc, cur, wc, fq);
    const int sclW = W8_SCALE_E8M0, sclX = ONE_E8M0;
    v8i At[4], B0[2], B1[2];
    const char* cA = GATHER ? (const char*)g.A : (const char*)g.A + (size_t)cur.pa * tstep; const char* cB = (const char*)g.Bt + (size_t)cur.pb * tstep;
    const size_t hstepA = GATHER ? 0 : hstep;
    if constexpr (GATHER) { PG8_GOFFS(vC0, vC1, 0); } else {
#pragma unroll
        for (int i = 0; i < 2; ++i) { vC0[i] = voffA[i]; vC1[i] = voffA[i]; vN0[i] = voffA[i]; vN1[i] = voffA[i]; } }
    PG8_STAGE(PG8_SB(0, 0), cB, voffB); PG8_STAGE(PG8_SB(0, 1), cB + hstep, voffB); PG8_STAGE(PG8_SA(0, 0), cA, vC0); PG8_STAGE(PG8_SA(0, 1), cA + hstepA, vC1);
    if (wr == 1) PG8_BAR;
    PG8_WAIT_V(2); PG8_BAR;
    PG8_STAGE(PG8_SB(1, 0), cB + kstep, voffB); PG8_STAGE(PG8_SA(1, 0), cA + kstep, vC0); PG8_STAGE(PG8_SB(1, 1), cB + hstep + kstep, voffB);
    PG8_WAIT_V(6); PG8_BAR;
    for (;;) {
        const bool has_next = S.next(ui + 1, nxt);
        const char* nA = GATHER ? (const char*)g.A : (has_next ? (const char*)g.A + (size_t)nxt.pa * tstep : cA); const char* nB = has_next ? (const char*)g.Bt + (size_t)nxt.pb * tstep : cB;
        if constexpr (GATHER) { if (has_next) { PG8_GOFFS(vN0, vN1, ui + 1); } else {
#pragma unroll
            for (int i = 0; i < 2; ++i) { vN0[i] = vC0[i]; vN1[i] = vC1[i]; } } }
#pragma unroll 1
        for (int t = 0; t < nt; t += 2) {
            const bool last = (t == nt - 2);
            unsigned vX0[2], vX1[2];
#pragma unroll
            for (int i = 0; i < 2; ++i) { vX0[i] = (GATHER && last) ? vN0[i] : vC0[i]; vX1[i] = (GATHER && last) ? vN1[i] : vC1[i]; }
            const char* a1 = cA + (size_t)(t + 1) * kstep;
            const char* a2 = last ? nA : cA + (size_t)(t + 2) * kstep; const char* b2 = last ? nB : cB + (size_t)(t + 2) * kstep;
            const char* a3 = a2 + kstep; const char* b3 = b2 + kstep;
            PG8_LDB(B0, 0, 0); PG8_LDB(B1, 0, 1); PG8_SCHED; PG8_LDA(At, 0, 0); PG8_STAGE(PG8_SA(1, 1), a1 + hstepA, vC1);
            PG8_WAIT_V(8); PG8_WAIT_L(0); PG8_BAR; PG8_MMA(0, 0, At, B0); PG8_MMA(0, 1, At, B1); PG8_BAR; PG8_SCHED;
            PG8_LDA(At, 0, 1); PG8_STAGE(PG8_SB(0, 0), b2, voffB); PG8_STAGE(PG8_SB(0, 1), b2 + hstep, voffB); PG8_STAGE(PG8_SA(0, 0), a2, vX0);
            PG8_WAIT_V(8); PG8_WAIT_L(0); PG8_BAR; PG8_MMA(1, 0, At, B0); PG8_MMA(1, 1, At, B1); PG8_BAR; PG8_SCHED;
            PG8_LDB(B0, 1, 0); PG8_LDB(B1, 1, 1); PG8_SCHED; PG8_LDA(At, 1, 0); PG8_STAGE(PG8_SA(0, 1), a2 + hstepA, vX1);
            PG8_WAIT_V(8); PG8_WAIT_L(0); PG8_BAR; PG8_MMA(0, 0, At, B0); PG8_MMA(0, 1, At, B1); PG8_BAR; PG8_SCHED;
            PG8_LDA(At, 1, 1); PG8_STAGE(PG8_SB(1, 0), b3, voffB); PG8_STAGE(PG8_SB(1, 1), b3 + hstep, voffB); PG8_STAGE(PG8_SA(1, 0), a3, vX0);
            PG8_WAIT_V(8); PG8_WAIT_L(0); PG8_BAR; PG8_MMA(1, 0, At, B0); PG8_MMA(1, 1, At, B1); PG8_BAR; PG8_SCHED;
        }
        if constexpr (ALIGN_EPI) { if (wr == 0) PG8_BAR; }
        E(acc, cur, wr, wc, fr, fq);
        if (!has_next) break;
        E.init(acc, nxt, wc, fq);
        cur = nxt; cA = nA; cB = nB; ++ui;
        if constexpr (GATHER) {
#pragma unroll
            for (int i = 0; i < 2; ++i) { vC0[i] = vN0[i]; vC1[i] = vN1[i]; } }
        if constexpr (ALIGN_EPI) { if (wr == 1) PG8_BAR; }
    }
    PG8_WAIT_V(0);
    if constexpr (!ALIGN_EPI) { if (wr == 0) PG8_BAR; }
    PG8_BAR;
#undef PG8_GOFFS
#undef PG8_HALF0
#undef PG8_HALF1
#undef PG8_SA
#undef PG8_SB
#undef PG8_STAGE
#undef PG8_LDA
#undef PG8_LDB
#undef PG8_MMA
#undef PG8_WAIT_V
#undef PG8_WAIT_L
#undef PG8_BAR
#undef PG8_SCHED
}

struct EpiF32 {
    static constexpr bool PERM = false;
    float* C; int ldc;
    __device__ __forceinline__ void operator()(const f32x4 (&acc)[2][2][4][2], const Unit& u, int wr, int wc, int fr, int fq) const {
        const int row0 = u.pa * BM + wr * 64 + fr, col0 = u.pn * BM + wc * 32 + 4 * fq;
#pragma unroll
        for (int ai = 0; ai < 2; ++ai)
#pragma unroll
            for (int m = 0; m < 4; ++m) { float* rowp = C + (size_t)(row0 + ai * HALF + m * 16) * ldc + col0;
#pragma unroll
                for (int bj = 0; bj < 2; ++bj)
#pragma unroll
                    for (int n = 0; n < 2; ++n) *(f32x4*)(rowp + bj * HALF + n * 16) = acc[ai][bj][m][n]; }
    }
};
struct EpiBf16 {
    static constexpr bool PERM = true;
    bf16_t* O; int ldc; const float* bias; int bias_stride;
    __device__ __forceinline__ void init(f32x4 (&acc)[2][2][4][2], const Unit& u, int wc, int fq) const {
        const int col0 = u.pn * BM + wc * 32 + 8 * fq;
#pragma unroll
        for (int bj = 0; bj < 2; ++bj)
#pragma unroll
            for (int n = 0; n < 2; ++n) { const f32x4 bv = bias ? *(const f32x4*)(bias + (size_t)u.e * bias_stride + col0 + bj * HALF + 4 * n) : (f32x4){0.f, 0.f, 0.f, 0.f};
#pragma unroll
                for (int ai = 0; ai < 2; ++ai)
#pragma unroll
                    for (int m = 0; m < 4; ++m) acc[ai][bj][m][n] = bv; }
    }
    __device__ __forceinline__ void operator()(const f32x4 (&acc)[2][2][4][2], const Unit& u, int wr, int wc, int fr, int fq) const {
        const int row0 = u.pa * BM + wr * 64 + fr; const int col0 = u.pn * BM + wc * 32 + 8 * fq;
#pragma unroll
        for (int ai = 0; ai < 2; ++ai)
#pragma unroll
            for (int m = 0; m < 4; ++m) { bf16_t* rowp = O + (size_t)(row0 + ai * HALF + m * 16) * ldc + col0;
#pragma unroll
                for (int bj = 0; bj < 2; ++bj) { const f32x4 v0 = acc[ai][bj][m][0], v1 = acc[ai][bj][m][1];
                    u32x4 w; w.x = pk_bf16(v0[0], v0[1]); w.y = pk_bf16(v0[2], v0[3]); w.z = pk_bf16(v1[0], v1[1]); w.w = pk_bf16(v1[2], v1[3]);
                    *(u32x4*)(rowp + bj * HALF) = w; } }
    }
};
struct EpiAct {
    static constexpr bool PERM = true;
    unsigned char* O; const float* bias;
    __device__ __forceinline__ void init(f32x4 (&acc)[2][2][4][2], const Unit& u, int wc, int fq) const {
        const float* bg = bias + (size_t)u.e * 2048 + u.pn * 128 + wc * 32 + 8 * fq;
#pragma unroll
        for (int bj = 0; bj < 2; ++bj)
#pragma unroll
            for (int n = 0; n < 2; ++n) { const f32x4 bv = *(const f32x4*)(bg + bj * 1024 + 4 * n);
#pragma unroll
                for (int ai = 0; ai < 2; ++ai)
#pragma unroll
                    for (int m = 0; m < 4; ++m) acc[ai][bj][m][n] = bv; }
    }
    __device__ __forceinline__ void operator()(const f32x4 (&acc)[2][2][4][2], const Unit& u, int wr, int wc, int fr, int fq) const {
        const int row0 = u.pa * BM + wr * 64 + fr; const int cc0 = wc * 32 + 8 * fq; const int ocol = u.pn * 128 + cc0;
#pragma unroll
        for (int ai = 0; ai < 2; ++ai)
#pragma unroll
            for (int m = 0; m < 4; ++m) { unsigned char* rowp = O + (size_t)(row0 + ai * HALF + m * 16) * D + ocol;
                float r[8];
#pragma unroll
                for (int n = 0; n < 2; ++n)
#pragma unroll
                    for (int j = 0; j < 4; ++j) { float gt = acc[ai][0][m][n][j], up = acc[ai][1][m][n][j];
                        gt = fminf(gt, 7.0f); up = fminf(fmaxf(up, -7.0f), 7.0f);
                        r[n * 4 + j] = gt / (1.0f + __expf(-1.702f * gt)) * (up + 1.0f); }
                u32x2 w; w.x = pk_fp8x4(r[0], r[1], r[2], r[3]); w.y = pk_fp8x4(r[4], r[5], r[6], r[7]);
                *(u32x2*)rowp = w; }
    }
};
struct SchedGrid {
    int nN, total, G, c;
    __device__ __forceinline__ bool next(int i, Unit& u) const { int Lx = i * G + c; if (Lx >= GEMM_REP * total) return false; if (GEMM_REP > 1) Lx %= total; u.pa = Lx / nN; u.pn = Lx - u.pa * nN; u.pb = u.pn; u.e = 0; return true; }
};
struct SchedMoe {
    int nN, total, G, c; const int* tile_e;
    __device__ __forceinline__ bool next(int i, Unit& u) const { int Lx = i * G + c; if (Lx >= GEMM_REP * total) return false; if (GEMM_REP > 1) Lx %= total; u.pa = Lx / nN; u.pn = Lx - u.pa * nN; u.e = __builtin_amdgcn_readfirstlane((int)tile_e[u.pa]); u.pb = u.e * nN + u.pn; return true; }
};
}

struct Args { const float* in[N_IN]; float* out; unsigned char* ws; int ph_lo, ph_hi; };

typedef const float* __attribute__((address_space(4))) const* kargp_t;
struct InProxy { kargp_t kp; __device__ __forceinline__ const float* operator[](int i) const { return kp[i]; } };
struct Frame {
    InProxy in; float* out; unsigned char* ws;
    LAS unsigned char* lds;
    int tid, lane, wave, G, bid, vid;
    template <class Tp> __device__ __forceinline__ Tp* w(size_t off) const { return (Tp*)(ws + off); }
};

__device__ __forceinline__ Frame launder(const Frame& F) {
    Frame R = F;
    int t = F.tid; asm volatile("" : "+v"(t)); R.tid = t; R.lane = t & 63; R.wave = __builtin_amdgcn_readfirstlane(t >> 6);
    unsigned long long w = (unsigned long long)F.ws; asm volatile("" : "+s"(w)); R.ws = (unsigned char*)w;
    unsigned long long o = (unsigned long long)F.out; asm volatile("" : "+s"(o)); R.out = (float*)o;
    unsigned long long k = (unsigned long long)F.in.kp; asm volatile("" : "+s"(k)); R.in.kp = (kargp_t)k;
    int g = F.G, b = F.bid; asm volatile("" : "+s"(g), "+s"(b)); R.G = g; R.bid = b; R.vid = (g % 8 == 0) ? (b % 8) * (g / 8) + b / 8 : b;
    return R;
}

__device__ __forceinline__ float mod_val(const Frame& F, int l, int which, int j) {
    const float* mp = F.w<float>(WS_MODP) + (size_t)((l * 2 + which) * 32) * 6144 + j;
    float s = F.in[I_BMOD][l * 6144 + j];
#pragma unroll
    for (int k = 0; k < 32; ++k) s += mp[(size_t)k * 6144];
    return s;
}

struct CvtTile { const float* src; bf16_t* dst; int ld, mode, k0, n0; bool f8; };
__device__ __forceinline__ CvtTile cvt_decode(const Frame& F, int t) {
    CvtTile c;
    if (t < 1664) { const int l = t / 832, r = t % 832; c.n0 = (r / 16) * 64; c.k0 = (r % 16) * 64; c.src = F.in[I_WIN] + (size_t)l * 1024 * 3212; c.ld = 3212; c.mode = 1; c.f8 = false; c.dst = F.w<bf16_t>(WS_WINT) + (size_t)l * PC * D; }
    else if (t < 2176) { const int q = t - 1664, l = q / 256, r = q % 256; c.n0 = (r / 16) * 64; c.k0 = (r % 16) * 64; c.src = F.in[I_WOUT] + (size_t)l * D * D; c.ld = 1024; c.mode = 0; c.f8 = false; c.dst = F.w<bf16_t>(WS_WOUTT) + (size_t)l * D * D; }
    else if (t < 34944) { const int q = t - 2176, le = q / 512, r = q % 512; c.n0 = (r / 16) * 64; c.k0 = (r % 16) * 64; c.src = F.in[I_WGU] + (size_t)le * 1024 * 2048; c.ld = 2048; c.mode = 2; c.f8 = true; c.dst = (bf16_t*)(F.w<unsigned char>(WS_WGUT) + (size_t)le * 2048 * D); }
    else { const int q = t - 34944, le = q / 256, r = q % 256; c.n0 = (r / 16) * 64; c.k0 = (r % 16) * 64; c.src = F.in[I_WDN] + (size_t)le * D * D; c.ld = 1024; c.mode = 0; c.f8 = true; c.dst = (bf16_t*)(F.w<unsigned char>(WS_WDT) + (size_t)le * D * D); }
    return c;
}
__device__ __forceinline__ void cvt_load(const CvtTile& c, int lane, f32x4 (&a)[8], f32x4 (&b)[8]) {
    const int i4 = lane & 15, kpl = lane >> 4;
    const int n = c.n0 + 4 * i4;
    int sc; bool valid = true;
    if (c.mode == 0) sc = n;
    else if (c.mode == 1) { if (n < 1280) sc = n; else if (n < 3200) sc = n + 12; else if (n < 3212) sc = n - 3200 + 1280; else { sc = 0; valid = false; } }
    else { const int pn = n >> 8, rr = n & 255; sc = rr < 128 ? pn * 128 + rr : 1024 + pn * 128 + (rr - 128); }
#pragma unroll
    for (int it = 0; it < 8; ++it) {
        const int r0 = c.f8 ? 4 * (kpl + 4 * (it >> 1)) + 2 * (it & 1) : 2 * (kpl + 4 * it);
        a[it] = (f32x4){0.f, 0.f, 0.f, 0.f}; b[it] = a[it];
        if (valid) { a[it] = __builtin_nontemporal_load((const f32x4*)(c.src + (size_t)(c.k0 + r0) * c.ld + sc)); b[it] = __builtin_nontemporal_load((const f32x4*)(c.src + (size_t)(c.k0 + r0 + 1) * c.ld + sc)); }
    }
}
__device__ __forceinline__ void cvt_store(const CvtTile& c, int lane, const f32x4 (&a)[8], const f32x4 (&b)[8], LAS unsigned* lw) {
    const int i4 = lane & 15, kpl = lane >> 4;
    if (c.f8) {
#pragma unroll
        for (int j = 0; j < 4; ++j) {
            const int kq = kpl + 4 * j;
#pragma unroll
            for (int i = 0; i < 4; ++i) lw[kq * 65 + 4 * i4 + i] = pk_fp8x4(W8_SCALE * a[2 * j][i], W8_SCALE * b[2 * j][i], W8_SCALE * a[2 * j + 1][i], W8_SCALE * b[2 * j + 1][i]);
        }
        lds_fence();
        const int g = lane & 3, nl = lane >> 2;
        unsigned char* d8 = (unsigned char*)c.dst;
#pragma unroll
        for (int it = 0; it < 4; ++it) {
            const int nn = nl + 16 * it;
            u32x4 v; v.x = lw[(4 * g + 0) * 65 + nn]; v.y = lw[(4 * g + 1) * 65 + nn]; v.z = lw[(4 * g + 2) * 65 + nn]; v.w = lw[(4 * g + 3) * 65 + nn];
            *(u32x4*)(d8 + (size_t)(c.n0 + nn) * 1024 + c.k0 + 16 * g) = v;
        }
        lds_fence();
        return;
    }
#pragma unroll
    for (int it = 0; it < 8; ++it) {
        const int kp = kpl + 4 * it;
#pragma unroll
        for (int i = 0; i < 4; ++i) lw[kp * 65 + 4 * i4 + i] = pk_bf16(a[it][i], b[it][i]);
    }
    lds_fence();
    const int g = lane & 7, nl = lane >> 3;
#pragma unroll
    for (int it = 0; it < 8; ++it) {
        const int nn = nl + 8 * it;
        u32x4 v; v.x = lw[(4 * g + 0) * 65 + nn]; v.y = lw[(4 * g + 1) * 65 + nn]; v.z = lw[(4 * g + 2) * 65 + nn]; v.w = lw[(4 * g + 3) * 65 + nn];
        *(u32x4*)(c.dst + (size_t)(c.n0 + nn) * 1024 + c.k0 + 8 * g) = v;
    }
    lds_fence();
}

__device__ __forceinline__ void ph_convert(const Frame& F) {
    LAS unsigned* lw = (LAS unsigned*)(F.lds) + F.wave * (32 * 65 + 16);
    const int nwaves = F.G * 8, w0 = F.bid * 8 + F.wave;
    f32x4 a0[8], b0[8], a1[8], b1[8];
    int t = w0;
    if (t >= 51328) return;
    CvtTile c0 = cvt_decode(F, t);
    cvt_load(c0, F.lane, a0, b0);
    for (;;) {
        const int t1 = t + nwaves;
        CvtTile c1 = c0;
        if (t1 < 51328) { c1 = cvt_decode(F, t1); cvt_load(c1, F.lane, a1, b1); }
        cvt_store(c0, F.lane, a0, b0, lw);
        if (t1 >= 51328) break;
        const int t2 = t1 + nwaves;
        if (t2 < 51328) { c0 = cvt_decode(F, t2); cvt_load(c0, F.lane, a0, b0); }
        cvt_store(c1, F.lane, a1, b1, lw);
        if (t2 >= 51328) break;
        t = t2;
    }
}

__device__ __forceinline__ void ph_modpart(const Frame& F) {
    for (int it = F.bid; it < 768; it += F.G) {
        const int l = it / 384, r = it % 384, cc = r / 32, kc = r % 32;
        const int j = cc * 512 + F.tid;
        const float* wm = F.in[I_WMOD] + (size_t)l * D * 6144 + (size_t)(kc * 32) * 6144 + j;
        float wv[32];
#pragma unroll
        for (int k = 0; k < 32; ++k) wv[k] = wm[(size_t)k * 6144];
        float a0 = 0.f, a1 = 0.f;
#pragma unroll
        for (int k = 0; k < 32; ++k) { a0 += silu_f(F.in[I_C][kc * 32 + k]) * wv[k]; a1 += silu_f(F.in[I_CCTX][kc * 32 + k]) * wv[k]; }
        float* mp = F.w<float>(WS_MODP);
        mp[(size_t)((l * 2 + 0) * 32 + kc) * 6144 + j] = a0;
        mp[(size_t)((l * 2 + 1) * 32 + kc) * 6144 + j] = a1;
    }
}

__device__ __forceinline__ void ph_filter(const Frame& F) {
    LAS float* zs = (LAS float*)F.lds;
    LAS float* h1 = zs + 64 * 33;
    LAS unsigned char* H2b = F.lds + 24832;
    LAS unsigned char* ob = F.lds + 34048;
    const float min_decay = -4.605170185988091f / 1.5f, max_decay = -4.605170185988091f / 0.3f;
    const int wave = F.wave;
    for (int it = F.bid; it < 512 + 16; it += F.G) {
        int tid = F.tid; asm volatile("" : "+v"(tid));
        const int lane = tid & 63;
        const bool isctx = it >= 512;
        const int l = isctx ? 0 : it / 256, grp = isctx ? it - 512 : it % 256;
        const int Lx = isctx ? LC : L, npos = isctx ? 16 : 64;
        const int t0 = grp * npos;
        __syncthreads();
#pragma unroll 1
        for (int q = tid; q < npos * 33; q += NTHREADS) {
            const int pos = q / 33, i = q % 33; const int t = t0 + pos;
            const float tn = (float)t / (float)(Lx - 1);
            const float wv = 6.283185307179586f * (float)t / (float)Lx;
            float v;
            if (i == 0) v = tn;
            else { const int b = (i - 1) & 15; const float f = 1e-4f + (float)b * ((15.0f - 1e-4f) / 15.0f); v = (i <= 16) ? cosf(f * wv) : -sinf(f * wv); }
            zs[q] = v;
        }
        __syncthreads();
        {
            asm volatile("" : "+v"(tid));
            const int o = tid & 63, pg = tid >> 6;
            if (pg * 8 < npos) {
                float acc[8];
                const float bb = F.in[I_FB1][l * 64 + o];
#pragma unroll
                for (int p = 0; p < 8; ++p) acc[p] = bb;
#pragma unroll 3
                for (int i = 0; i < 33; ++i) { const float w = F.in[I_FW1][(size_t)l * 33 * 64 + i * 64 + o];
#pragma unroll
                    for (int p = 0; p < 8; ++p) acc[p] += zs[(pg * 8 + p) * 33 + i] * w; }
                const float fq = F.in[I_FREQ][l * 128 + o];
#pragma unroll
                for (int p = 0; p < 8; ++p) h1[(pg * 8 + p) * 64 + o] = sinf(fq * acc[p]);
            }
        }
        __syncthreads();
        {
            asm volatile("" : "+v"(tid));
            const int o = tid & 63, pg = tid >> 6;
            if (pg * 8 < npos) {
                float acc[8];
                const float bb = F.in[I_FB2][l * 64 + o];
#pragma unroll
                for (int p = 0; p < 8; ++p) acc[p] = bb;
#pragma unroll 4
                for (int i = 0; i < 64; ++i) { const float w = F.in[I_FW2][(size_t)l * 64 * 64 + i * 64 + o];
#pragma unroll
                    for (int p = 0; p < 8; ++p) acc[p] += h1[(pg * 8 + p) * 64 + i] * w; }
                const float fq = F.in[I_FREQ][l * 128 + 64 + o];
#pragma unroll
                for (int p = 0; p < 8; ++p) *(LAS bf16_t*)(H2b + (pg * 8 + p) * 144 + o * 2) = f2bf(sinf(fq * acc[p]));
            }
        }
        __syncthreads();
        {
            int r = lane & 31, hf = lane >> 5;
#pragma unroll
            for (int n = 0; n < 2; ++n) {
                asm volatile("" : "+v"(r), "+v"(hf));
                const int o = 32 * (2 * wave + n) + r, c = o & 255, dir = o >> 8;
                const float* w3 = F.in[I_FW3] + (size_t)l * 64 * 512 + o;
                f32x16 acc[2];
#pragma unroll
                for (int m = 0; m < 2; ++m)
#pragma unroll
                    for (int i = 0; i < 16; ++i) acc[m][i] = 0.f;
#pragma unroll
                for (int ks = 0; ks < 4; ++ks) {
                    float wv[8];
#pragma unroll
                    for (int e = 0; e < 8; ++e) wv[e] = w3[(size_t)(16 * ks + 8 * hf + e) * 512];
                    bf16x8 b;
#pragma unroll
                    for (int e = 0; e < 8; ++e) b[e] = (short)f2bf(wv[e]);
#pragma unroll
                    for (int m = 0; m < 2; ++m) {
                        const bf16x8 a = *(const LAS bf16x8*)(H2b + (32 * m + r) * 144 + (16 * ks + 8 * hf) * 2);
                        acc[m] = __builtin_amdgcn_mfma_f32_32x32x16_bf16(a, b, acc[m], 0, 0, 0);
                    }
                }
                const float delta = fabsf(min_decay + (float)c * ((max_decay - min_decay) / 255.0f));
                const float dstep = delta / (float)(Lx - 1);
                float asum = 0.f;
                if (!isctx) {
#pragma unroll
                    for (int m = 0; m < 2; ++m)
#pragma unroll
                        for (int rg = 0; rg < 16; ++rg) {
                            const int pos = 32 * m + (rg & 3) + 8 * (rg >> 2) + 4 * hf;
                            const float v = acc[m][rg] * __expf(-(float)(t0 + pos) * dstep);
                            asum += fabsf(v);
                            ob[o * 68 + pos] = (unsigned char)(pk_fp8x4(KR_SCALE * v, 0.f, 0.f, 0.f) & 0xFFu);
                        }
                } else {
                    float* kc = F.w<float>(WS_KCOMBC);
#pragma unroll
                    for (int rg = 0; rg < 8; ++rg) {
                        const int pos = (rg & 3) + 8 * (rg >> 2) + 4 * hf, t = t0 + pos;
                        const float v = acc[0][rg] * __expf(-(float)t * dstep);
                        asum += fabsf(v);
                        const int x = dir == 0 ? Lx - 1 + t : Lx - 1 - t;
                        if (dir == 0 || t >= 1) kc[(size_t)x * 256 + c] = v;
                    }
                }
                asum += __shfl_xor(asum, 32);
                if (hf == 0) { if (isctx) F.w<float>(WS_FPARTC)[grp * 512 + o] = asum; else F.w<float>(WS_FPART)[((size_t)l * 256 + grp) * 512 + o] = asum; }
            }
        }
        if (!isctx) {
            __syncthreads();
            unsigned char* KR = F.w<unsigned char>(WS_KR) + (size_t)l * 256 * KRL;
            asm volatile("" : "+v"(tid));
            for (int q = tid; q < 512 * 64; q += NTHREADS) {
                const int o = q >> 6, p = q & 63, c = o & 255, dir = o >> 8;
                if (dir == 0) KR[(size_t)c * KRL + (L - t0 - 63 + p)] = ob[o * 68 + 63 - p];
                else if (t0 + p >= 1) KR[(size_t)c * KRL + (L + t0 + p)] = ob[o * 68 + p];
            }
            if (grp == 0) for (int q = tid; q < 256 * 513; q += NTHREADS) { const int c = q / 513, r = q % 513; KR[(size_t)c * KRL + (r == 512 ? 0 : 2 * L + r)] = 0; }
        }
    }
}

__device__ __forceinline__ void ph_fsum(const Frame& F) {
    const int nwaves = F.G * 8;
    for (int o = F.bid * 8 + F.wave; o < 768; o += nwaves) {
        const int which = o >> 8, c = o & 255;
        float s = 0.f;
        if (which < 2) { const float* fp = F.w<float>(WS_FPART) + (size_t)which * 256 * 512;
            for (int i = F.lane; i < 256; i += 64) s += fp[(size_t)i * 512 + c] + fp[(size_t)i * 512 + 256 + c]; }
        else { const float* fp = F.w<float>(WS_FPARTC); if (F.lane < 16) s = fp[F.lane * 512 + c] + fp[F.lane * 512 + 256 + c]; }
        s = wave_sum(s);
        if (F.lane == 0) F.w<float>(WS_FSUM)[o] = 1.0f / s;
    }
}

__device__ __forceinline__ void ph_vecs(const Frame& F) {
    for (int q = F.bid * NTHREADS + F.tid; q < 2 * 2 * 6 * 1024; q += F.G * NTHREADS) {
        const int j = q & 1023, k = (q >> 10) % 6, which = ((q >> 10) / 6) & 1, l = (q >> 10) / 12;
        const float* ng = F.in[I_NORMG] + (size_t)l * 4 * 1024;
        float v;
        if (k == 0) v = ng[j] * (1.0f + mod_val(F, l, which, 1 * 1024 + j));
        else if (k == 1) v = mod_val(F, l, which, j);
        else if (k == 2) v = ng[1024 + j] * mod_val(F, l, which, 2 * 1024 + j);
        else if (k == 3) v = ng[2048 + j] * (1.0f + mod_val(F, l, which, 4 * 1024 + j));
        else if (k == 4) v = mod_val(F, l, which, 3 * 1024 + j);
        else v = ng[3072 + j] * mod_val(F, l, which, 5 * 1024 + j);
        F.w<float>(WS_VECS)[q] = v;
    }
}
__device__ __forceinline__ const float* vecs_ptr(const Frame& F, int l, int which, int k) { return F.w<float>(WS_VECS) + (size_t)((l * 2 + which) * 6 + k) * 1024; }

__device__ __forceinline__ void load_row(const float* p, int lane, f32x4 (&v)[4]) {
#pragma unroll
    for (int i = 0; i < 4; ++i) v[i] = *(const f32x4*)(p + 4 * lane + 256 * i);
}
__device__ __forceinline__ float row_rstd(const f32x4 (&v)[4]) {
    float s = 0.f;
#pragma unroll
    for (int i = 0; i < 4; ++i) s += v[i][0] * v[i][0] + v[i][1] * v[i][1] + v[i][2] * v[i][2] + v[i][3] * v[i][3];
    s = wave_sum(s);
    return rsqrtf(s * (1.0f / 1024.0f) + RMS_EPS);
}
__device__ __forceinline__ void stage_norm_vecs(const Frame& F, int l, int gain_idx, int sh_seg, int sc_seg, LAS float* dst  ) {
    for (int q = F.tid; q < 2048; q += NTHREADS) {
        const int which = q >> 10, j = q & 1023;
        const float g = F.in[I_NORMG][(l * 4 + gain_idx) * 1024 + j];
        dst[(which * 2 + 0) * 1024 + j] = g * (1.0f + mod_val(F, l, which, sc_seg * 1024 + j));
        dst[(which * 2 + 1) * 1024 + j] = mod_val(F, l, which, sh_seg * 1024 + j);
    }
}
__device__ __forceinline__ void norm_store_bf16(const f32x4 (&v)[4], float rstd, const LAS float* va, const LAS float* vb, bf16_t* orow, int lane) {
#pragma unroll
    for (int i = 0; i < 4; ++i) {
        const int c = 4 * lane + 256 * i;
        const f32x4 a = *(const LAS f32x4*)(va + c), b = *(const LAS f32x4*)(vb + c);
        u32x2 w; w.x = pk_bf16(v[i][0] * rstd * a[0] + b[0], v[i][1] * rstd * a[1] + b[1]); w.y = pk_bf16(v[i][2] * rstd * a[2] + b[2], v[i][3] * rstd * a[3] + b[3]);
        *(u32x2*)(orow + c) = w;
    }
}
__device__ __forceinline__ const float* xrow_ptr(const Frame& F, int l, int row) {
    if (l == 0) return row < L ? F.in[I_X] + (size_t)row * D : F.in[I_CTX] + (size_t)(row - L) * D;
    return F.w<float>(WS_XCUR) + (size_t)row * D;
}
__device__ __forceinline__ void ph_norm1(const Frame& F, int l) {
    LAS float* vec = (LAS float*)F.lds;
    __syncthreads();
    stage_norm_vecs(F, l, 0, 0, 1, vec);
    __syncthreads();
    const int nwaves = F.G * 8;
    for (int row = F.bid * 8 + F.wave; row < T; row += nwaves) {
        const int which = row >= L;
        f32x4 v[4]; load_row(xrow_ptr(F, l, row), F.lane, v);
        const float rstd = row_rstd(v);
        norm_store_bf16(v, rstd, vec + (which * 2) * 1024, vec + (which * 2 + 1) * 1024, F.w<bf16_t>(WS_HB) + (size_t)row * D, F.lane);
    }
}

constexpr int SROW = 272;
__device__ __forceinline__ bf16x8 lds_frag(const LAS unsigned char* base, int row, int k) { return *(const LAS bf16x8*)(base + row * SROW + k * 2); }
__device__ __forceinline__ void ph_ssd_prep(const Frame& F, int l) {
    LAS unsigned char* BT = F.lds;
    LAS unsigned char* XW = F.lds + 34816;
    LAS float* dts = (LAS float*)(F.lds + 139264);
    LAS float* wj  = dts + 768;
    const bf16_t* P = F.w<bf16_t>(WS_P);
    const int lane = F.lane, wave = F.wave;
    for (int it = F.bid; it < NCH * 2; it += F.G) {
        const int ch = it >> 1, g = it & 1;
        const int row0 = ch * 128;
        const int seq_lo = ch < 128 ? 0 : L, seq_hi = ch < 128 ? L : T;
        int r = lane & 31, hf = lane >> 5; asm volatile("" : "+v"(r), "+v"(hf));
        __syncthreads();
        if (wave < 6) {
            const int hh = wave >> 1, dir = wave & 1, h = g * 3 + hh;
            const float a = -__expf(F.in[I_ALOG][(l * 2 + dir) * 6 + h]), bias = F.in[I_DTB][(l * 2 + dir) * 6 + h];
            const int j0 = 2 * lane;
            const float d0 = softplus_f(bf2f(P[(size_t)(row0 + j0) * PC + CDT + dir * 6 + h]) + bias);
            const float d1 = softplus_f(bf2f(P[(size_t)(row0 + j0 + 1) * PC + CDT + dir * 6 + h]) + bias);
            const float pair = (d0 + d1) * a;
            float incl = pair;
#pragma unroll
            for (int o = 1; o < 64; o <<= 1) {
                const float v = dir == 0 ? __shfl_up(incl, o) : __shfl_down(incl, o);
                const bool okl = dir == 0 ? (lane >= o) : (lane + o < 64);
                if (okl) incl += v;
            }
            const float total = __shfl(incl, dir == 0 ? 63 : 0);
            float acs0, acs1;
            if (dir == 0) { acs1 = incl; acs0 = incl - d1 * a; }
            else { acs0 = incl; acs1 = incl - d0 * a; }
            float* dtv = F.w<float>(WS_DTV) + (size_t)(row0 + j0) * 12 + dir * 6 + h; dtv[0] = d0; dtv[12] = d1;
            float* acv = F.w<float>(WS_ACS) + (size_t)(row0 + j0) * 12 + dir * 6 + h; acv[0] = acs0; acv[12] = acs1;
            if (lane == 0) F.w<float>(WS_ALAST)[ch * 12 + dir * 6 + h] = total;
            dts[wave * 128 + j0] = d0; dts[wave * 128 + j0 + 1] = d1;
            wj[wave * 128 + j0] = __expf(total - acs0) * d0; wj[wave * 128 + j0 + 1] = __expf(total - acs1) * d1;
        }
        __syncthreads();
        if (F.tid < 448) {
            const int pr = F.tid % 224, half = F.tid / 224;
            const int chn = pr < 96 ? g * 192 + 2 * pr : (pr < 160 ? 384 + g * 128 + 2 * (pr - 96) : 640 + g * 128 + 2 * (pr - 160));
            const float* cw = F.in[I_SCW] + (size_t)l * 5 * 896 + chn; const float* cb = F.in[I_SCB] + (size_t)l * 896 + chn;
            float w0[5], w1[5];
#pragma unroll
            for (int k = 0; k < 5; ++k) { w0[k] = cw[k * 896]; w1[k] = cw[k * 896 + 1]; }
            const float b0 = cb[0], b1 = cb[1];
            const int jb = half * 64;
            const bf16_t* src = P + CXBC + chn;
            unsigned win[12];
#pragma unroll
            for (int k = 0; k < 4; ++k) { const int rr = row0 + jb + k - 2; win[k] = (rr >= seq_lo && rr < seq_hi) ? *(const unsigned*)(src + (size_t)rr * PC) : 0u; }
            const int hh = pr / 32;
            const int pch = 2 * (pr & 31);
            for (int jg = 0; jg < 64; jg += 8) {
#pragma unroll
                for (int k = 0; k < 8; ++k) { const int rr = row0 + jb + jg + k + 2; win[4 + k] = (rr >= seq_lo && rr < seq_hi) ? *(const unsigned*)(src + (size_t)rr * PC) : 0u; }
                float s0[8], s1[8];
#pragma unroll
                for (int u = 0; u < 8; ++u) {
                    float a0 = b0, a1 = b1;
#pragma unroll
                    for (int k = 0; k < 5; ++k) { a0 += w0[k] * bflo(win[u + k]); a1 += w1[k] * bfhi(win[u + k]); }
                    s0[u] = silu_f(a0); s1[u] = silu_f(a1);
                    *(unsigned*)(F.w<bf16_t>(WS_XBC) + (size_t)(row0 + jb + jg + u) * 896 + chn) = pk_bf16(s0[u], s1[u]);
                }
#pragma unroll
                for (int k = 0; k < 4; ++k) win[k] = win[8 + k];
#pragma unroll
                for (int u = 0; u < 8; u += 2) {
                    const int j = jb + jg + u;
                    if (pr < 96) {
#pragma unroll
                        for (int dir = 0; dir < 2; ++dir) {
                            const float wa = wj[(hh * 2 + dir) * 128 + j], wb = wj[(hh * 2 + dir) * 128 + j + 1];
                            LAS unsigned char* d = XW + ((hh * 2 + dir) * 64 + pch) * SROW + j * 2;
                            *(LAS unsigned*)d = pk_bf16(s0[u] * wa, s0[u + 1] * wb);
                            *(LAS unsigned*)(d + SROW) = pk_bf16(s1[u] * wa, s1[u + 1] * wb);
                        }
                    } else if (pr < 160) {
                        LAS unsigned char* d = BT + (2 * (pr - 96)) * SROW + j * 2;
                        *(LAS unsigned*)d = pk_bf16(s0[u], s0[u + 1]);
                        *(LAS unsigned*)(d + SROW) = pk_bf16(s1[u], s1[u + 1]);
                    }
                }
            }
        }
        __syncthreads();
        {
            const int nt = wave & 3, pt = wave >> 2;
#pragma unroll 1
            for (int hh = 0; hh < 3; ++hh) {
                const int h = g * 3 + hh;
                f32x16 a0, a1;
#pragma unroll
                for (int i = 0; i < 16; ++i) { a0[i] = 0.f; a1[i] = 0.f; }
                const LAS unsigned char* X0 = XW + (hh * 2) * 64 * SROW;
#pragma unroll
                for (int ks = 0; ks < 8; ++ks) {
                    const bf16x8 a = lds_frag(BT, 32 * nt + r, 16 * ks + 8 * hf);
                    const bf16x8 b0 = lds_frag(X0, 32 * pt + r, 16 * ks + 8 * hf), b1 = lds_frag(X0, 64 + 32 * pt + r, 16 * ks + 8 * hf);
                    a0 = __builtin_amdgcn_mfma_f32_32x32x16_bf16(a, b0, a0, 0, 0, 0);
                    a1 = __builtin_amdgcn_mfma_f32_32x32x16_bf16(a, b1, a1, 0, 0, 0);
                }
                float* s0 = F.w<float>(WS_STATES) + ((size_t)(0 * NCH + ch) * 6 + h) * 8192 + (32 * pt + r) * 128 + 32 * nt + 4 * hf;
                float* s1 = F.w<float>(WS_STATES) + ((size_t)(1 * NCH + ch) * 6 + h) * 8192 + (32 * pt + r) * 128 + 32 * nt + 4 * hf;
#pragma unroll
                for (int gq = 0; gq < 4; ++gq) { *(f32x4*)(s0 + 8 * gq) = (f32x4){a0[4 * gq], a0[4 * gq + 1], a0[4 * gq + 2], a0[4 * gq + 3]};
                                                 *(f32x4*)(s1 + 8 * gq) = (f32x4){a1[4 * gq], a1[4 * gq + 1], a1[4 * gq + 2], a1[4 * gq + 3]}; }
            }
        }
    }
}

__device__ __forceinline__ void ph_ssd_scan(const Frame& F) {
    const int per = (98304 + F.G - 1) / F.G;
    for (int q = F.tid; q < per; q += NTHREADS) {
        const int id = F.bid * per + q;
        if (id >= 98304) break;
        const int dir = id / 49152, rem = id % 49152, h = rem / 8192, e = rem % 8192;
        const float* al = F.w<float>(WS_ALAST) + dir * 6 + h;
        const float* st = F.w<float>(WS_STATES) + ((size_t)(dir * NCH) * 6 + h) * 8192 + e;
        bf16_t* ss = F.w<bf16_t>(WS_SSTART) + ((size_t)(dir * NCH) * 6 + h) * 8192 + e;
        float sacc = 0.f;
        for (int s0 = 0; s0 < NCH; s0 += 26) {
            float sv[26], dv[26]; int cv[26];
#pragma unroll
            for (int u = 0; u < 26; ++u) {
                const int step = s0 + u;
                cv[u] = dir == 0 ? (step < 2 ? 128 + step : step - 2) : 129 - step;
                sv[u] = st[(size_t)cv[u] * 6 * 8192]; dv[u] = al[cv[u] * 12];
            }
#pragma unroll
            for (int u = 0; u < 26; ++u) { ss[(size_t)cv[u] * 6 * 8192] = f2bf(sacc); sacc = sacc * __expf(dv[u]) + sv[u]; }
        }
    }
}

__device__ __forceinline__ void ph_ssd_out(const Frame& F, int l) {
    LAS unsigned char* Cs = F.lds;
    LAS unsigned char* Bs = F.lds + 34816;
    LAS unsigned char* XT = F.lds + 69632;
    LAS float* Yl = (LAS float*)F.lds;
    LAS float* af = (LAS float*)(F.lds + 98816);
    LAS float* ab = af + 384, *dtf = ab + 384, *dtb = dtf + 384;
    LAS float* red = dtb + 384;
    const bf16_t* XBC = F.w<bf16_t>(WS_XBC);
    const bf16_t* P = F.w<bf16_t>(WS_P);
    const int nch = (l == 0) ? NCH : 128;
    const int lane = F.lane, wave = F.wave, r_in = lane & 31, hf_in = lane >> 5;
    const int it_ = wave & 3, jp = wave >> 2;
    for (int it = F.bid; it < nch * 2; it += F.G) {
        const int ch = it >> 1, g = it & 1, row0 = ch * 128;
        int r = r_in, hf = hf_in; asm volatile("" : "+v"(r), "+v"(hf));
        __syncthreads();
        for (int q = F.tid; q < 128 * 16; q += NTHREADS) {
            const int row = q >> 4, piece = q & 15;
            const bf16_t* src = XBC + (size_t)(row0 + row) * 896 + g * 128 + piece * 8;
            *(LAS u32x4*)(Bs + row * SROW + piece * 16) = *(const u32x4*)(src + 384);
            *(LAS u32x4*)(Cs + row * SROW + piece * 16) = *(const u32x4*)(src + 640);
        }
        for (int q = F.tid; q < 768; q += NTHREADS) {
            const int dir = q / 384, rr = q % 384, hh = rr >> 7, j = rr & 127;
            (dir ? ab : af)[hh * 128 + j] = F.w<float>(WS_ACS)[(size_t)(row0 + j) * 12 + dir * 6 + g * 3 + hh];
            (dir ? dtb : dtf)[hh * 128 + j] = F.w<float>(WS_DTV)[(size_t)(row0 + j) * 12 + dir * 6 + g * 3 + hh];
        }
        __syncthreads();
        f32x16 G0, G1;
#pragma unroll
        for (int i = 0; i < 16; ++i) { G0[i] = 0.f; G1[i] = 0.f; }
#pragma unroll
        for (int ks = 0; ks < 8; ++ks) {
            const bf16x8 a = lds_frag(Cs, 32 * it_ + r, 16 * ks + 8 * hf);
            const bf16x8 b0 = lds_frag(Bs, 64 * jp + r, 16 * ks + 8 * hf), b1 = lds_frag(Bs, 64 * jp + 32 + r, 16 * ks + 8 * hf);
            G0 = __builtin_amdgcn_mfma_f32_32x32x16_bf16(a, b0, G0, 0, 0, 0);
            G1 = __builtin_amdgcn_mfma_f32_32x32x16_bf16(a, b1, G1, 0, 0, 0);
        }
        f32x16 yacc[3];
#pragma unroll
        for (int hh = 0; hh < 3; ++hh) {
            const int h = g * 3 + hh;
            asm volatile("" : "+v"(r), "+v"(hf));
            __syncthreads();
#pragma unroll
            for (int tl = 0; tl < 2; ++tl) {
                const int j = 64 * jp + 32 * tl + r;
                const float afj = af[hh * 128 + j], abj = ab[hh * 128 + j], dfj = dtf[hh * 128 + j], dbj = dtb[hh * 128 + j];
#pragma unroll
                for (int rg = 0; rg < 16; ++rg) {
                    const int i = 32 * it_ + (rg & 3) + 8 * (rg >> 2) + 4 * hf;
                    const float mf = fminf(fmaxf((float)(i - j + 1), 0.f), 1.f), mb = fminf(fmaxf((float)(j - i + 1), 0.f), 1.f);
                    const float wf = __expf(fminf(af[hh * 128 + i] - afj, 0.f)) * dfj * mf;
                    const float wb = __expf(fminf(ab[hh * 128 + i] - abj, 0.f)) * dbj * mb;
                    const float gv = tl == 0 ? G0[rg] : G1[rg];
                    *(LAS bf16_t*)(Bs + i * SROW + j * 2) = f2bf(gv * (wf + wb));
                }
            }
            for (int q = F.tid; q < 128 * 8; q += NTHREADS) {
                const int j = q >> 3, pg = q & 7;
                const u32x4 v = *(const u32x4*)(XBC + (size_t)(row0 + j) * 896 + h * 64 + pg * 8);
                LAS unsigned char* d = XT + (pg * 8) * SROW + j * 2;
                *(LAS bf16_t*)(d + 0 * SROW) = (bf16_t)(v.x & 0xFFFF); *(LAS bf16_t*)(d + 1 * SROW) = (bf16_t)(v.x >> 16);
                *(LAS bf16_t*)(d + 2 * SROW) = (bf16_t)(v.y & 0xFFFF); *(LAS bf16_t*)(d + 3 * SROW) = (bf16_t)(v.y >> 16);
                *(LAS bf16_t*)(d + 4 * SROW) = (bf16_t)(v.z & 0xFFFF); *(LAS bf16_t*)(d + 5 * SROW) = (bf16_t)(v.z >> 16);
                *(LAS bf16_t*)(d + 6 * SROW) = (bf16_t)(v.w & 0xFFFF); *(LAS bf16_t*)(d + 7 * SROW) = (bf16_t)(v.w >> 16);
            }
            {
                f32x16 yF, yB;
#pragma unroll
                for (int i = 0; i < 16; ++i) { yF[i] = 0.f; yB[i] = 0.f; }
                const bf16_t* Sf = F.w<bf16_t>(WS_SSTART) + ((size_t)(0 * NCH + ch) * 6 + h) * 8192 + (32 * jp + r) * 128 + 8 * hf;
                const bf16_t* Sb = F.w<bf16_t>(WS_SSTART) + ((size_t)(1 * NCH + ch) * 6 + h) * 8192 + (32 * jp + r) * 128 + 8 * hf;
#pragma unroll 2
                for (int ks = 0; ks < 8; ++ks) {
                    const bf16x8 ac = lds_frag(Cs, 32 * it_ + r, 16 * ks + 8 * hf);
                    const bf16x8 bf_ = *(const bf16x8*)(Sf + 16 * ks), bb_ = *(const bf16x8*)(Sb + 16 * ks);
                    yF = __builtin_amdgcn_mfma_f32_32x32x16_bf16(ac, bf_, yF, 0, 0, 0);
                    yB = __builtin_amdgcn_mfma_f32_32x32x16_bf16(ac, bb_, yB, 0, 0, 0);
                }
#pragma unroll
                for (int rg = 0; rg < 16; ++rg) {
                    const int i = 32 * it_ + (rg & 3) + 8 * (rg >> 2) + 4 * hf;
                    yacc[hh][rg] = __expf(af[hh * 128 + i]) * yF[rg] + __expf(ab[hh * 128 + i]) * yB[rg];
                }
            }
            __syncthreads();
#pragma unroll 2
            for (int ks = 0; ks < 8; ++ks) {
                const bf16x8 aw = lds_frag(Bs, 32 * it_ + r, 16 * ks + 8 * hf), bx = lds_frag(XT, 32 * jp + r, 16 * ks + 8 * hf);
                yacc[hh] = __builtin_amdgcn_mfma_f32_32x32x16_bf16(aw, bx, yacc[hh], 0, 0, 0);
            }
        }
        __syncthreads();
#pragma unroll
        for (int hh = 0; hh < 3; ++hh)
#pragma unroll
            for (int rg = 0; rg < 16; ++rg) { const int i = 32 * it_ + (rg & 3) + 8 * (rg >> 2) + 4 * hf; Yl[i * 193 + hh * 64 + 32 * jp + r] = yacc[hh][rg]; }
        __syncthreads();
        const int i = F.tid & 127, pq = F.tid >> 7;
        float ssq = 0.f;
#pragma unroll 1
        for (int hh = 0; hh < 3; ++hh) {
            const int h = g * 3 + hh; const float dsk = F.in[I_SSDD][l * 6 + h];
            const int chn = h * 64 + pq * 16;
            const u32x4 xa = *(const u32x4*)(XBC + (size_t)(row0 + i) * 896 + chn), xb = *(const u32x4*)(XBC + (size_t)(row0 + i) * 896 + chn + 8);
            const u32x4 za = *(const u32x4*)(P + (size_t)(row0 + i) * PC + CZ + chn), zb = *(const u32x4*)(P + (size_t)(row0 + i) * PC + CZ + chn + 8);
            const unsigned xw_[8] = {xa.x, xa.y, xa.z, xa.w, xb.x, xb.y, xb.z, xb.w}, zw_[8] = {za.x, za.y, za.z, za.w, zb.x, zb.y, zb.z, zb.w};
            LAS float* yr = Yl + i * 193 + hh * 64 + pq * 16;
#pragma unroll
            for (int p2 = 0; p2 < 8; ++p2) {
                const float v0 = (yr[2 * p2] + dsk * bflo(xw_[p2])) * silu_f(bflo(zw_[p2]));
                const float v1 = (yr[2 * p2 + 1] + dsk * bfhi(xw_[p2])) * silu_f(bfhi(zw_[p2]));
                yr[2 * p2] = v0; yr[2 * p2 + 1] = v1; ssq += v0 * v0 + v1 * v1;
            }
        }
        red[pq * 128 + i] = ssq;
        __syncthreads();
        const float tot = red[i] + red[128 + i] + red[256 + i] + red[384 + i];
        const float rstd = rsqrtf(tot * (1.0f / 192.0f) + RMS_EPS);
#pragma unroll 1
        for (int hh = 0; hh < 3; ++hh) {
            const int h = g * 3 + hh;
            bf16_t* o = F.w<bf16_t>(WS_MIX) + (size_t)(row0 + i) * D + h * 64 + pq * 16;
            const float* ng = F.in[I_SSDNG] + l * 384 + h * 64 + pq * 16;
            const LAS float* yr = Yl + i * 193 + hh * 64 + pq * 16;
            unsigned wv[8];
#pragma unroll
            for (int p2 = 0; p2 < 8; ++p2) wv[p2] = pk_bf16(yr[2 * p2] * rstd * ng[2 * p2], yr[2 * p2 + 1] * rstd * ng[2 * p2 + 1]);
            *(u32x4*)o = (u32x4){wv[0], wv[1], wv[2], wv[3]}; *(u32x4*)(o + 8) = (u32x4){wv[4], wv[5], wv[6], wv[7]};
        }
    }
}

__device__ __forceinline__ int na_kv_off(int key, int piece) { return key * 128 + ((piece ^ (key & 7)) << 4); }
__device__ __forceinline__ void na_stage_kv(const Frame& F, const bf16_t* P, LAS unsigned char* Kd, LAS unsigned char* Vd, int h, bool local, int r0, int kc0) {
    for (int q = F.tid; q < 256 * 8; q += NTHREADS) {
        const int key = q >> 3, piece = q & 7;
        const int krow = local ? (r0 + (key >> 5)) * 64 + kc0 + (key & 31) : L + key;
        const bf16_t* src = P + (size_t)krow * PC + h * 64 + piece * 8;
        *(LAS u32x4*)(Kd + na_kv_off(key, piece)) = *(const u32x4*)(src + CK);
        *(LAS u32x4*)(Vd + na_kv_off(key, piece)) = *(const u32x4*)(src + CV);
    }
}
__device__ __forceinline__ void bar_lds() { asm volatile("s_waitcnt lgkmcnt(0)" ::: "memory"); __builtin_amdgcn_s_barrier(); asm volatile("" ::: "memory"); }
struct NaItem { int h, r, cg, r0, kc0, qrow0; bool isctx; };
__device__ __forceinline__ NaItem na_item(int cid, int i_lo, int i_hi, int k) {
    NaItem t; t.isctx = (i_lo + k >= i_hi); t.r = 0; t.r0 = 0; t.kc0 = 0;
    if (!t.isctx) { const int it = i_lo + k; t.h = it >> 10; t.r = (it >> 2) & 255; t.cg = it & 3; t.r0 = min(max(t.r - 4, 0), 248); t.kc0 = min(max(16 * t.cg - 8, 0), 32); t.qrow0 = t.r * 64 + t.cg * 16; }
    else { t.h = cid >> 4; t.cg = cid & 15; t.qrow0 = L + t.cg * 16; }
    return t;
}
__device__ __forceinline__ void ph_na(const Frame& F, int l, int part) {
    LAS unsigned char* Kc = F.lds;
    LAS unsigned char* Vc = F.lds + 32768;
    LAS unsigned char* Kl = F.lds + 65536;
    LAS unsigned char* Vl = F.lds + 98304;
    LAS unsigned char* Qs = F.lds + 131072;
    LAS unsigned char* Pw = F.lds + 133120;
    LAS float* ml = (LAS float*)(F.lds + 151552);
    LAS float* bt = ml + 256;
    const bf16_t* P = F.w<bf16_t>(WS_P);
    const float* rpb = F.in[I_RPB] + (size_t)l * 15 * 31 * 6;
    const int nlat = 6 * 256 * 4;
    const int nB = (l == 0) ? 2520 : 0, nA = nlat - nB;
    const int lane = F.lane, wave = F.wave, c16 = lane & 15, kq = lane >> 4;
    const float scale = 0.125f;
    int cur_h = -1;
    const float ws = part == 0 ? (l == 0 ? 0.45f : 0.67f) : 0.0f;
    const int nP = part == 0 ? nA : nB, base = part == 0 ? 0 : nA;
    const float Wtot = 4.0f * ws + (float)(F.G - 4);
    const float W0 = F.bid < 4 ? F.bid * ws : 4.0f * ws + (float)(F.bid - 4), W1 = F.bid < 3 ? (F.bid + 1) * ws : 4.0f * ws + (float)(F.bid - 3);
    const int i_lo = base + (int)((float)nP * W0 / Wtot + 0.5f), i_hi = (F.bid == F.G - 1) ? base + nP : base + (int)((float)nP * W1 / Wtot + 0.5f);
    const int cid = (l == 0 && part == 0 && F.bid >= 100 && F.bid < 196) ? F.bid - 100 : -1;
    const int n_mine = max(0, i_hi - i_lo) + (cid >= 0 ? 1 : 0);
    u32x4 kreg[4], vreg[4], qreg; float breg = 0.f;
    const int pkey = F.tid >> 3, ppiece = F.tid & 7;
#define NA_PREFETCH(T) do { if (!(T).isctx) { _Pragma("unroll") for (int u = 0; u < 4; ++u) { const int key = pkey + 64 * u; \
            const bf16_t* src = P + (size_t)(((T).r0 + (key >> 5)) * 64 + (T).kc0 + (key & 31)) * PC + (T).h * 64 + ppiece * 8; \
            kreg[u] = *(const u32x4*)(src + CK); vreg[u] = *(const u32x4*)(src + CV); } \
            if (F.tid < 256 && (F.tid & 31) < 31) breg = rpb[(((T).r0 + (F.tid >> 5) - (T).r + 7) * 31 + (F.tid & 31)) * 6 + (T).h]; } \
        if (F.tid < 128) qreg = *(const u32x4*)(P + (size_t)((T).qrow0 + pkey) * PC + CQ + (T).h * 64 + ppiece * 8); } while (0)
    if (n_mine > 0) { const NaItem t0 = na_item(cid, i_lo, i_hi, 0); NA_PREFETCH(t0); }
    for (int k = 0; k < n_mine; ++k) {
        const NaItem t = na_item(cid, i_lo, i_hi, k);
        const bool isctx = t.isctx; const int h = t.h, cg = t.cg, kc0 = t.kc0, qrow0 = t.qrow0;
        bar_lds();
        if (h != cur_h) { na_stage_kv(F, P, Kc, Vc, h, false, 0, 0); cur_h = h; }
        if (!isctx) {
#pragma unroll
            for (int u = 0; u < 4; ++u) { const int key = pkey + 64 * u; *(LAS u32x4*)(Kl + na_kv_off(key, ppiece)) = kreg[u]; *(LAS u32x4*)(Vl + na_kv_off(key, ppiece)) = vreg[u]; }
            if (F.tid < 256) bt[F.tid] = breg;
        }
        if (F.tid < 128) *(LAS u32x4*)(Qs + na_kv_off(pkey, ppiece)) = qreg;
        if (k + 1 < n_mine) { const NaItem tn = na_item(cid, i_lo, i_hi, k + 1); NA_PREFETCH(tn); }
        bar_lds();
        const bool loc = wave < 4;
        const LAS unsigned char* Kb = loc ? Kl : Kc;
        const LAS unsigned char* Vb = loc ? Vl : Vc;
        const int kbase = (wave & 3) * 64;
        LAS unsigned char* pw = Pw + wave * 2304;
        float mw[4], lw[4];
        if (!(loc && isctx)) {
            f32x4 sacc[4];
#pragma unroll
            for (int nt = 0; nt < 4; ++nt) sacc[nt] = (f32x4){0.f, 0.f, 0.f, 0.f};
#pragma unroll
            for (int ks = 0; ks < 2; ++ks) {
                const bf16x8 a = *(const LAS bf16x8*)(Qs + na_kv_off(c16, 4 * ks + kq));
#pragma unroll
                for (int nt = 0; nt < 4; ++nt) {
                    const bf16x8 b = *(const LAS bf16x8*)(Kb + na_kv_off(kbase + 16 * nt + c16, 4 * ks + kq));
                    sacc[nt] = __builtin_amdgcn_mfma_f32_16x16x32_bf16(a, b, sacc[nt], 0, 0, 0);
                }
            }
#pragma unroll
            for (int rg = 0; rg < 4; ++rg) mw[rg] = -INFINITY;
#pragma unroll
            for (int nt = 0; nt < 4; ++nt) {
                const int kk = kbase + 16 * nt + c16;
#pragma unroll
                for (int rg = 0; rg < 4; ++rg) {
                    float sv = sacc[nt][rg] * scale;
                    if (loc) {
                        const int qi = 4 * kq + rg, qcol = cg * 16 + qi, cstart = min(max(qcol - 8, 0), 48);
                        const int krow = kk >> 5, kcol = kc0 + (kk & 31);
                        const bool ok = (kcol >= cstart) && (kcol < cstart + 16);
                        const int dc = min(max(kcol - qcol + 15, 0), 30);
                        sv = ok ? sv + bt[krow * 32 + dc] : -INFINITY;
                    }
                    sacc[nt][rg] = sv; mw[rg] = fmaxf(mw[rg], sv);
                }
            }
#pragma unroll
            for (int rg = 0; rg < 4; ++rg) {
#pragma unroll
                for (int o = 8; o >= 1; o >>= 1) mw[rg] = fmaxf(mw[rg], __shfl_xor(mw[rg], o));
                lw[rg] = 0.f;
            }
#pragma unroll
            for (int nt = 0; nt < 4; ++nt) {
#pragma unroll
                for (int rg = 0; rg < 4; ++rg) {
                    const float msafe = mw[rg] == -INFINITY ? 0.f : mw[rg];
                    const float pv = __expf(sacc[nt][rg] - msafe);
                    lw[rg] += pv;
                    *(LAS bf16_t*)(pw + (4 * kq + rg) * 144 + (16 * nt + c16) * 2) = f2bf(pv);
                }
            }
#pragma unroll
            for (int rg = 0; rg < 4; ++rg) {
#pragma unroll
                for (int o = 8; o >= 1; o >>= 1) lw[rg] += __shfl_xor(lw[rg], o);
            }
            lds_fence();
            f32x4 oacc[4];
#pragma unroll
            for (int dt = 0; dt < 4; ++dt) oacc[dt] = (f32x4){0.f, 0.f, 0.f, 0.f};
#pragma unroll
            for (int ks = 0; ks < 2; ++ks) {
                const bf16x8 a = *(const LAS bf16x8*)(pw + c16 * 144 + (32 * ks + 8 * kq) * 2);
                const int key0 = kbase + 32 * ks + 8 * kq;
#pragma unroll
                for (int dt = 0; dt < 4; ++dt) {
                    const int d = 16 * dt + c16;
                    bf16x8 b;
#pragma unroll
                    for (int e = 0; e < 8; ++e) b[e] = *(const LAS short*)(Vb + na_kv_off(key0 + e, d >> 3) + (d & 7) * 2);
                    oacc[dt] = __builtin_amdgcn_mfma_f32_16x16x32_bf16(a, b, oacc[dt], 0, 0, 0);
                }
            }
            lds_fence();
#pragma unroll
            for (int dt = 0; dt < 4; ++dt)
#pragma unroll
                for (int rg = 0; rg < 4; ++rg) *(LAS bf16_t*)(pw + (4 * kq + rg) * 144 + (16 * dt + c16) * 2) = f2bf(oacc[dt][rg]);
        } else {
#pragma unroll
            for (int rg = 0; rg < 4; ++rg) { mw[rg] = -INFINITY; lw[rg] = 0.f; }
            for (int q = lane; q < 16 * 36; q += 64) ((LAS unsigned*)pw)[q] = 0u;
        }
        if (c16 == 0) {
#pragma unroll
            for (int rg = 0; rg < 4; ++rg) { ml[(wave * 16 + 4 * kq + rg) * 2] = mw[rg]; ml[(wave * 16 + 4 * kq + rg) * 2 + 1] = lw[rg]; }
        }
        bar_lds();
        {
            const int qi = F.tid >> 5, dp = F.tid & 31;
            float M = -INFINITY;
#pragma unroll
            for (int w = 0; w < 8; ++w) M = fmaxf(M, ml[(w * 16 + qi) * 2]);
            float num0 = 0.f, num1 = 0.f, den = 0.f;
#pragma unroll
            for (int w = 0; w < 8; ++w) {
                const float sc = __expf(ml[(w * 16 + qi) * 2] - M);
                const unsigned ov = *(const LAS unsigned*)(Pw + w * 2304 + qi * 144 + dp * 4);
                num0 += sc * bflo(ov); num1 += sc * bfhi(ov); den += sc * ml[(w * 16 + qi) * 2 + 1];
            }
            const float inv = 1.0f / den;
            *(unsigned*)(F.w<bf16_t>(WS_MIX) + (size_t)(qrow0 + qi) * D + 384 + h * 64 + 2 * dp) = pk_bf16(num0 * inv, num1 * inv);
        }
    }
#undef NA_PREFETCH
}

__device__ __forceinline__ float hy_conv3(const bf16_t* P, const float* cw, const float* cb, int row, int seq_lo, int seq_hi, int col) {
    float s = cb[col];
#pragma unroll
    for (int k = 0; k < 3; ++k) { const int r = row + k - 1; if (r >= seq_lo && r < seq_hi) s += cw[k * 768 + col] * bf2f(P[(size_t)r * PC + CHY + col]); }
    return s;
}
__device__ __forceinline__ void ph_hy_prep(const Frame& F, int l) {
    const bf16_t* P = F.w<bf16_t>(WS_P);
    const float* cw = F.in[I_HCW] + (size_t)l * 3 * 768; const float* cb = F.in[I_HCB] + (size_t)l * 768;
    LAS unsigned* ut = (LAS unsigned*)F.lds;
    LAS unsigned* xt = ut + 256 * 33;
    const int cp = F.tid & 127, rq = F.tid >> 7;
    float w0[3][3], w1[3][3], b0[3], b1[3];
#pragma unroll
    for (int sg = 0; sg < 3; ++sg) { b0[sg] = cb[sg * 256 + 2 * cp]; b1[sg] = cb[sg * 256 + 2 * cp + 1];
#pragma unroll
        for (int k = 0; k < 3; ++k) { w0[sg][k] = cw[k * 768 + sg * 256 + 2 * cp]; w1[sg][k] = cw[k * 768 + sg * 256 + 2 * cp + 1]; } }
    for (int it = F.bid; it < L / 64; it += F.G) {
        const int t0 = it * 64, rb = t0 + rq * 16;
        __syncthreads();
        {
            unsigned win[3][18];
#pragma unroll
            for (int sg = 0; sg < 3; ++sg)
#pragma unroll
                for (int k = 0; k < 18; ++k) { const int rr = rb - 1 + k; win[sg][k] = (rr >= 0 && rr < L) ? *(const unsigned*)(P + (size_t)rr * PC + CHY + sg * 256 + 2 * cp) : 0u; }
#pragma unroll
            for (int jp = 0; jp < 8; ++jp) {
                float u0[2], u1[2], xa[2], xb[2];
#pragma unroll
                for (int q = 0; q < 2; ++q) {
                    const int k = 2 * jp + q;
                    float a0[3], a1[3];
#pragma unroll
                    for (int sg = 0; sg < 3; ++sg) {
                        a0[sg] = b0[sg] + w0[sg][0] * bflo(win[sg][k]) + w0[sg][1] * bflo(win[sg][k + 1]) + w0[sg][2] * bflo(win[sg][k + 2]);
                        a1[sg] = b1[sg] + w1[sg][0] * bfhi(win[sg][k]) + w1[sg][1] * bfhi(win[sg][k + 1]) + w1[sg][2] * bfhi(win[sg][k + 2]);
                    }
                    xa[q] = a0[0]; xb[q] = a1[0]; u0[q] = a0[2] * a0[1]; u1[q] = a1[2] * a1[1];
                }
                const int rp = rq * 8 + jp;
                ut[(2 * cp) * 33 + rp] = pk_bf16(u0[0], u0[1]); ut[(2 * cp + 1) * 33 + rp] = pk_bf16(u1[0], u1[1]);
                xt[(2 * cp) * 33 + rp] = pk_bf16(xa[0], xa[1]); xt[(2 * cp + 1) * 33 + rp] = pk_bf16(xb[0], xb[1]);
            }
        }
        __syncthreads();
        for (int q = F.tid; q < 256 * 8; q += NTHREADS) {
            const int c = q >> 3, g = q & 7;
            u32x4 a, b;
            a.x = ut[c * 33 + 4 * g]; a.y = ut[c * 33 + 4 * g + 1]; a.z = ut[c * 33 + 4 * g + 2]; a.w = ut[c * 33 + 4 * g + 3];
            b.x = xt[c * 33 + 4 * g]; b.y = xt[c * 33 + 4 * g + 1]; b.z = xt[c * 33 + 4 * g + 2]; b.w = xt[c * 33 + 4 * g + 3];
            *(u32x4*)(F.w<bf16_t>(WS_UT) + (size_t)c * L + t0 + 8 * g) = a;
            *(u32x4*)(F.w<bf16_t>(WS_X0T) + (size_t)c * L + t0 + 8 * g) = b;
            u32x2 a8; a8.x = pk_fp8x4(bflo(a.x), bfhi(a.x), bflo(a.y), bfhi(a.y)); a8.y = pk_fp8x4(bflo(a.z), bfhi(a.z), bflo(a.w), bfhi(a.w));
            *(u32x2*)(F.w<unsigned char>(WS_UT8) + (size_t)c * L + t0 + 8 * g) = a8;
        }
    }
    if (l == 0) {
        for (int rp = F.bid; rp < LC / 2; rp += F.G) {
            const int row = L + rp * 2 + (F.tid >> 8), c = F.tid & 255;
            const float x1 = hy_conv3(P, cw, cb, row, L, T, 256 + c), v = hy_conv3(P, cw, cb, row, L, T, 512 + c);
            F.w<float>(WS_U)[(size_t)row * 256 + c] = v * x1;
        }
    }
}
__device__ __forceinline__ void ph_hy_conv_ctx(const Frame& F, int l) {
    const bf16_t* P = F.w<bf16_t>(WS_P);
    const float* cw = F.in[I_HCW] + (size_t)l * 3 * 768; const float* cb = F.in[I_HCB] + (size_t)l * 768;
    for (int it = F.bid; it < 8; it += F.G) {
        const int Lx = LC, rbase = L;
        const int tb = it * 2 + (F.tid >> 8), c = F.tid & 255, t0 = tb * 16;
        const float* U = F.w<float>(WS_U) + (size_t)rbase * 256 + c;
        const float* KC = F.w<float>(WS_KCOMBC) + c;
        float acc[16], wreg[16];
#pragma unroll
        for (int j = 0; j < 16; ++j) { acc[j] = 0.f; wreg[j] = KC[(size_t)(t0 + j + Lx - 1) * 256]; }
        for (int s0 = 0; s0 < Lx; s0 += 16) {
            float ub[16], nb[16];
#pragma unroll
            for (int r = 0; r < 16; ++r) { ub[r] = U[(size_t)(s0 + r) * 256]; const int x = t0 - (s0 + r + 1) + Lx - 1; nb[r] = x >= 0 ? KC[(size_t)x * 256] : 0.f; }
#pragma unroll
            for (int r = 0; r < 16; ++r) {
#pragma unroll
                for (int j = 0; j < 16; ++j) acc[j] += ub[r] * wreg[(j - r) & 15];
                wreg[(15 - r) & 15] = nb[r];
            }
        }
        const float inv = F.w<float>(WS_FSUM)[2 * 256 + c];
        const float db = F.in[I_HYD][l * 256 + c];
#pragma unroll
        for (int j = 0; j < 16; ++j) {
            const int row = rbase + t0 + j;
            const float x0 = hy_conv3(P, cw, cb, row, L, T, c);
            const float u = F.w<float>(WS_U)[(size_t)row * 256 + c];
            F.w<bf16_t>(WS_MIX)[(size_t)row * D + 768 + c] = f2bf(x0 * (acc[j] * inv + u * db));
        }
    }
}

constexpr int HC_UP = 144, HC_UBYTES = 190 * HC_UP;
constexpr int HC_CPOFF = 27392, HC_NG = 83, HC_CPBYTES = 16 * HC_NG * 16;
__device__ __forceinline__ void hc_make_copies(LAS unsigned char* dst, const u32x4 g0, const u32x4 g1, int g) {
    const unsigned w[8] = {g0.x, g0.y, g0.z, g0.w, g1.x, g1.y, g1.z, g1.w};
#pragma unroll
    for (int sh = 0; sh < 16; ++sh) {
        const int b = sh >> 2, r = sh & 3;
        u32x4 o;
        if (r == 0) { o.x = w[b]; o.y = w[b + 1]; o.z = w[b + 2]; o.w = w[b + 3]; }
        else { o.x = __builtin_amdgcn_alignbyte(w[b + 1], w[b], r); o.y = __builtin_amdgcn_alignbyte(w[b + 2], w[b + 1], r);
               o.z = __builtin_amdgcn_alignbyte(w[b + 3], w[b + 2], r); o.w = __builtin_amdgcn_alignbyte(w[b + 4], w[b + 3], r); }
        *(LAS u32x4*)(dst + (sh * HC_NG + g) * 16) = o;
    }
}
__device__ __forceinline__ void ph_hy_conv(const Frame& F, int l) {
    LAS unsigned char* Ul = F.lds;
    LAS unsigned char* Cp = F.lds + HC_CPOFF;
    const int lane = F.lane, wave = F.wave;
    const int nt = wave < 4 ? wave : 7 - wave, par = wave >> 2;
    const int r = lane & 31, h = lane >> 5, sig = r & 15, rho = r >> 4;
    const int sh = (16 - sig) & 15, gofs = 2 * h - rho - (sig ? 1 : 0);
    const int a_lane = (sh * HC_NG + gofs) * 16;
    const int b_lane = r * HC_UP + h * 32;
    const int sclK = 0x79797979, sclU = ONE_E8M0;
    for (int c = F.bid; c < 256; c += F.G) {
        const unsigned char* KRc = F.w<unsigned char>(WS_KR) + ((size_t)l * 256 + c) * KRL;
        const unsigned char* U8c = F.w<unsigned char>(WS_UT8) + (size_t)c * L;
        const bf16_t* UTc = F.w<bf16_t>(WS_UT) + (size_t)c * L;
        __syncthreads();
        for (int q = F.tid; q < 190 * 8; q += NTHREADS) {
            const int blk = q >> 3, piece = q & 7;
            u32x4 v = (u32x4){0u, 0u, 0u, 0u};
            if (blk >= 31 && blk < 159) v = *(const u32x4*)(U8c + (size_t)(blk - 31) * 128 + piece * 16);
            *(LAS u32x4*)(Ul + blk * HC_UP + piece * 16) = v;
        }
        u32x4 g0 = (u32x4){0u, 0u, 0u, 0u}, g1 = g0;
        if (F.tid < HC_NG) { const unsigned char* src = KRc + 31744 + 16 * F.tid; g0 = *(const u32x4*)src; g1 = *(const u32x4*)(src + 16); }
        if (F.tid < HC_NG) hc_make_copies(Cp, g0, g1, F.tid);
        __syncthreads();
        f32x16 acc[4];
#pragma unroll
        for (int m = 0; m < 4; ++m)
#pragma unroll
            for (int i = 0; i < 16; ++i) acc[m][i] = 0.f;
        for (int ci = 0; ci < 32; ++ci) {
            const int Dc = -128 + 8 * ci;
            if (ci + 1 < 32 && F.tid < HC_NG) { const unsigned char* src = KRc + (31744 - 1024 * (ci + 1)) + 16 * F.tid; g0 = *(const u32x4*)src; g1 = *(const u32x4*)(src + 16); }
            const LAS unsigned char* cp = Cp + (ci & 1) * HC_CPBYTES + a_lane;
#pragma unroll 1
            for (int d2 = 0; d2 < 4; ++d2) {
                const int dd = 2 * d2 + par, Dv = Dc + dd;
                if (!((Dv >= 32 * nt - 127) && (Dv <= 32 * nt + 31) && (Dv > -128))) continue;
                const LAS unsigned char* ap = cp + (8 * (8 - dd)) * 16;
                const LAS unsigned char* bp = Ul + b_lane + (32 * nt - Dv + 31) * HC_UP;
                v8i af[6], bfr[2];
#pragma unroll
                for (int e = 0; e < 6; ++e) { const v4i x = *(const LAS v4i*)(ap - 2 * (e - 2) * 16), y = *(const LAS v4i*)(ap - 2 * (e - 2) * 16 + 16); af[e] = __builtin_shufflevector(x, y, 0, 1, 2, 3, 4, 5, 6, 7); }
#pragma unroll
                for (int ks = 0; ks < 2; ++ks) { const v4i x = *(const LAS v4i*)(bp + ks * 64), y = *(const LAS v4i*)(bp + ks * 64 + 16); bfr[ks] = __builtin_shufflevector(x, y, 0, 1, 2, 3, 4, 5, 6, 7); }
#pragma unroll
                for (int ks = 0; ks < 2; ++ks)
#pragma unroll
                    for (int m = 0; m < 4; ++m)
                        asm volatile("v_mfma_scale_f32_32x32x64_f8f6f4 %0, %1, %2, %0, %3, %4 op_sel_hi:[0,0,0]" : "+v"(acc[m]) : "v"(af[m - 2 * ks + 2]), "v"(bfr[ks]), "v"(sclK), "v"(sclU));
            }
            if (ci + 1 < 32 && F.tid < HC_NG) hc_make_copies(Cp + ((ci + 1) & 1) * HC_CPBYTES, g0, g1, F.tid);
            __syncthreads();
        }
        LAS float* Rd = (LAS float*)F.lds;
        if (wave >= 4) {
#pragma unroll
            for (int m = 0; m < 4; ++m)
#pragma unroll
                for (int i = 0; i < 16; ++i) Rd[(nt * 64 + m * 16 + i) * 64 + lane] = acc[m][i];
        }
        __syncthreads();
        if (wave < 4) {
#pragma unroll
            for (int m = 0; m < 4; ++m)
#pragma unroll
                for (int i = 0; i < 16; ++i) acc[m][i] += Rd[(nt * 64 + m * 16 + i) * 64 + lane];
            const float inv = F.w<float>(WS_FSUM)[l * 256 + c];
            const float db = F.in[I_HYD][l * 256 + c];
            const bf16_t* X0c = F.w<bf16_t>(WS_X0T) + (size_t)c * L;
            bf16_t* YTc = F.w<bf16_t>(WS_YT) + (size_t)c * L;
            const int I = 32 * nt + r;
#pragma unroll
            for (int m = 0; m < 4; ++m) {
#pragma unroll
                for (int g = 0; g < 4; ++g) {
                    const int t = 128 * I + 32 * m + 8 * g + 4 * h;
                    const u32x2 xv = *(const u32x2*)(X0c + t), uv = *(const u32x2*)(UTc + t);
                    float y[4];
#pragma unroll
                    for (int e = 0; e < 4; ++e) y[e] = acc[m][4 * g + e] * inv;
                    y[0] = bflo(xv.x) * (y[0] + bflo(uv.x) * db); y[1] = bfhi(xv.x) * (y[1] + bfhi(uv.x) * db);
                    y[2] = bflo(xv.y) * (y[2] + bflo(uv.y) * db); y[3] = bfhi(xv.y) * (y[3] + bfhi(uv.y) * db);
                    u32x2 o; o.x = pk_bf16(y[0], y[1]); o.y = pk_bf16(y[2], y[3]);
                    *(u32x2*)(YTc + t) = o;
                }
            }
        }
    }
}
__device__ __forceinline__ void ph_hy_tr(const Frame& F) {
    LAS unsigned* yt = (LAS unsigned*)F.lds;
    for (int it = F.bid; it < L / 64; it += F.G) {
        const int t0 = it * 64;
        __syncthreads();
        for (int q = F.tid; q < 256 * 8; q += NTHREADS) {
            const int c = q >> 3, g = q & 7;
            const u32x4 a = *(const u32x4*)(F.w<bf16_t>(WS_YT) + (size_t)c * L + t0 + 8 * g);
            yt[c * 33 + 4 * g] = a.x; yt[c * 33 + 4 * g + 1] = a.y; yt[c * 33 + 4 * g + 2] = a.z; yt[c * 33 + 4 * g + 3] = a.w;
        }
        __syncthreads();
        for (int q = F.tid; q < 64 * 32; q += NTHREADS) {
            const int row = q >> 5, cg = q & 31;
            const LAS unsigned short* ys = (const LAS unsigned short*)yt;
            unsigned short v[8];
#pragma unroll
            for (int e = 0; e < 8; ++e) v[e] = ys[((cg * 8 + e) * 33) * 2 + row];
            u32x4 o; o.x = v[0] | ((unsigned)v[1] << 16); o.y = v[2] | ((unsigned)v[3] << 16); o.z = v[4] | ((unsigned)v[5] << 16); o.w = v[6] | ((unsigned)v[7] << 16);
            *(u32x4*)(F.w<bf16_t>(WS_MIX) + (size_t)(t0 + row) * D + 768 + cg * 8) = o;
        }
    }
}

constexpr int WRP = 1028;
__device__ __forceinline__ void ph_post1(const Frame& F, int l) {
    LAS float* wr = (LAS float*)F.lds;
    LAS unsigned* lcnt = (LAS unsigned*)(F.lds + 32 * WRP * 4);
    __syncthreads();
    if (F.tid < 64) lcnt[F.tid] = 0u;
    {
        const f32x4* src = (const f32x4*)(F.in[I_WR] + (size_t)l * 1024 * 32);
        f32x4 v[16];
#pragma unroll
        for (int u = 0; u < 16; ++u) v[u] = src[F.tid + u * NTHREADS];
#pragma unroll
        for (int u = 0; u < 16; ++u) { const int q4 = F.tid + u * NTHREADS, k = q4 >> 3, e0 = (q4 & 7) * 4;
#pragma unroll
            for (int i = 0; i < 4; ++i) wr[(e0 + i) * WRP + k] = v[u][i]; }
    }
    __syncthreads();
    const int nrows = (l == 0) ? T : L;
    const int nwaves = F.G * 8, lane = F.lane;
    unsigned* cnt = F.w<unsigned>(WS_CTL) + CW_CNT + l * 1024;
    if (F.bid == 0) { for (int q = F.tid; q < D / 4; q += NTHREADS) ((unsigned*)(F.w<unsigned char>(WS_H2) + (size_t)T * D))[q] = 0u; }
    const float brl = F.in[I_BR][l * 32 + ((lane >> 1) & 31)];
    const int mye = (lane >> 1) & 31;
    for (int row0 = F.bid * 8 + F.wave; row0 < nrows; row0 += 2 * nwaves) {
        int rw[2]; bool vld[2];
        rw[0] = row0; vld[0] = true; vld[1] = (row0 + nwaves < nrows); rw[1] = vld[1] ? row0 + nwaves : row0;
        f32x4 m[2][4], x[2][4], hv[2][4];
#pragma unroll
        for (int u = 0; u < 2; ++u) { const bf16_t* mr = F.w<bf16_t>(WS_MIXO) + (size_t)rw[u] * D;
#pragma unroll
            for (int i = 0; i < 4; ++i) { const u32x2 w = *(const u32x2*)(mr + 4 * lane + 256 * i); m[u][i] = (f32x4){bflo(w.x), bfhi(w.x), bflo(w.y), bfhi(w.y)}; }
            load_row(xrow_ptr(F, l, rw[u]), lane, x[u]); }
#pragma unroll
        for (int u = 0; u < 2; ++u) {
            const int which = rw[u] >= L;
            const float* v0 = vecs_ptr(F, l, which, 2);
            const float rs1 = row_rstd(m[u]);
#pragma unroll
            for (int i = 0; i < 4; ++i) { const f32x4 a = *(const f32x4*)(v0 + 4 * lane + 256 * i); x[u][i] = x[u][i] + m[u][i] * rs1 * a; }
        }
#pragma unroll
        for (int u = 0; u < 2; ++u) {
            if (vld[u]) { float* xo = F.w<float>(WS_XCUR) + (size_t)rw[u] * D;
#pragma unroll
                for (int i = 0; i < 4; ++i) *(f32x4*)(xo + 4 * lane + 256 * i) = x[u][i]; }
        }
#pragma unroll
        for (int u = 0; u < 2; ++u) {
            const int which = rw[u] >= L;
            const float* v1 = vecs_ptr(F, l, which, 3), *v2 = vecs_ptr(F, l, which, 4);
            const float rs2 = row_rstd(x[u]);
#pragma unroll
            for (int i = 0; i < 4; ++i) { const f32x4 a = *(const f32x4*)(v1 + 4 * lane + 256 * i), b = *(const f32x4*)(v2 + 4 * lane + 256 * i); hv[u][i] = x[u][i] * rs2 * a + b; }
            if (vld[u]) { unsigned char* ho = F.w<unsigned char>(WS_H2) + (size_t)rw[u] * D;
#pragma unroll
                for (int i = 0; i < 4; ++i) *(unsigned*)(ho + 4 * lane + 256 * i) = pk_fp8x4(hv[u][i][0], hv[u][i][1], hv[u][i][2], hv[u][i][3]); }
        }
        float part[2][32];
#pragma unroll
        for (int e = 0; e < 32; ++e) {
            float s0 = 0.f, s1 = 0.f;
#pragma unroll
            for (int i = 0; i < 4; ++i) { const f32x4 w = *(const LAS f32x4*)(wr + e * WRP + 4 * lane + 256 * i);
                s0 += hv[0][i][0] * w[0] + hv[0][i][1] * w[1] + hv[0][i][2] * w[2] + hv[0][i][3] * w[3];
                s1 += hv[1][i][0] * w[0] + hv[1][i][1] * w[1] + hv[1][i][2] * w[2] + hv[1][i][3] * w[3]; }
            part[0][e] = s0; part[1][e] = s1;
        }
#pragma unroll
        for (int st = 0; st < 5; ++st) {
            const int o = 32 >> st, n = 32 >> st;
            const bool upper = (lane & o) != 0;
#pragma unroll
            for (int i = 0; i < n / 2; ++i) {
#pragma unroll
                for (int u = 0; u < 2; ++u) {
                    const float send = upper ? part[u][i] : part[u][i + n / 2];
                    const float recv = __shfl_xor(send, o);
                    const float keep = upper ? part[u][i + n / 2] : part[u][i];
                    part[u][i] = keep + recv;
                }
            }
        }
#pragma unroll
        for (int u = 0; u < 2; ++u) {
            float lg = part[u][0] + __shfl_xor(part[u][0], 1);
            lg += brl;
            int rank = 0;
#pragma unroll
            for (int e = 0; e < 32; ++e) { const float ov = __int_as_float(__builtin_amdgcn_readlane(__float_as_int(lg), 2 * e)); rank += (ov > lg || (ov == lg && e < mye)) ? 1 : 0; }
            int te[4]; float tv[4];
#pragma unroll
            for (int k = 0; k < 4; ++k) {
                const unsigned long long msk = __ballot(rank == k && (lane & 1) == 0);
                const int idx = msk ? __builtin_amdgcn_readfirstlane((int)__builtin_ctzll(msk)) : 2 * k;
                te[k] = idx >> 1; tv[k] = __int_as_float(__builtin_amdgcn_readlane(__float_as_int(lg), idx));
            }
            const float e1 = __expf(tv[1] - tv[0]), e2 = __expf(tv[2] - tv[0]), e3 = __expf(tv[3] - tv[0]);
            const float inv = 1.0f / (1.0f + e1 + e2 + e3);
            if (lane < 4 && vld[u]) {
                const int k = lane, row = rw[u];
                const int e = k == 0 ? te[0] : (k == 1 ? te[1] : (k == 2 ? te[2] : te[3]));
                const float wgt = (k == 0 ? 1.0f : (k == 1 ? e1 : (k == 2 ? e2 : e3))) * inv;
                const unsigned pos = __hip_atomic_fetch_add(lcnt + e, 1u, __ATOMIC_RELAXED, __HIP_MEMORY_SCOPE_WORKGROUP);
                F.w<int>(WS_RE)[row * 4 + k] = e; F.w<int>(WS_RP)[row * 4 + k] = (int)pos; F.w<float>(WS_RW)[row * 4 + k] = wgt;
            }
        }
    }
    __syncthreads();
    if (F.tid < 32) lcnt[32 + F.tid] = atomicAdd(cnt + F.tid * 32, lcnt[F.tid]);
    __syncthreads();
    for (int row = F.bid * 8 + F.wave; row < nrows; row += nwaves) {
        if (lane < 4) { const int a = row * 4 + lane; F.w<int>(WS_RP)[a] += (int)lcnt[32 + F.w<int>(WS_RE)[a]]; }
    }
}

__device__ __forceinline__ int expert_pad_start(const Frame& F, int l, int& ntiles) {
    const unsigned* cnt = F.w<unsigned>(WS_CTL) + CW_CNT + l * 1024;
    int c = F.lane < 32 ? (int)__hip_atomic_load(cnt + F.lane * 32, __ATOMIC_RELAXED, __HIP_MEMORY_SCOPE_AGENT) : 0;
    int padded = (c + 255) & ~255;
    int incl = padded;
#pragma unroll
    for (int o = 1; o < 32; o <<= 1) { const int v = __shfl_up(incl, o); if ((F.lane & 31) >= o) incl += v; }
    ntiles = __shfl(incl, 31) >> 8;
    return incl - padded;
}

__device__ __forceinline__ void ph_gather(const Frame& F, int l) {
    int ntiles; const int ps = expert_pad_start(F, l, ntiles);
    if (F.bid == 0 && F.wave == 0) {
        int* tab = F.w<int>(WS_CTL) + CW_TILE + l * 320;
        const int nxt = __shfl_down(ps, 1);
        const int endt = (F.lane == 31) ? ntiles : (nxt >> 8);
        if (F.lane < 32) for (int t = ps >> 8; t < endt; ++t) tab[t] = F.lane;
        if (F.lane == 0) F.w<int>(WS_CTL)[CW_NT + l] = ntiles;
    }
    const int nrows = (l == 0) ? T : L;
    for (int a0 = (F.bid * 8 + F.wave) * 64; a0 < nrows * 4; a0 += F.G * 8 * 64) {
        const int a = a0 + F.lane;
        if (a < nrows * 4) {
            const int e = F.w<int>(WS_RE)[a], pos = F.w<int>(WS_RP)[a];
            const int dst = __shfl(ps, e) + pos;
            F.w<int>(WS_SLOT)[a] = dst;
            F.w<int>(WS_ROWTOK)[(size_t)l * MAXROWS + dst] = a >> 2;
        }
    }
}

__device__ __forceinline__ void ph_final(const Frame& F, int l) {
    const int nrows = (l == 0) ? T : L;
    const int nwaves = F.G * 8, lane = F.lane;
    const bf16_t* Y = F.w<bf16_t>(WS_Y) + (size_t)l * MAXROWS * D;
    for (int row = F.bid * 8 + F.wave; row < nrows; row += nwaves) {
        const int which = row >= L;
        const float* ve = vecs_ptr(F, l, which, 5);
        f32x4 f[4];
#pragma unroll
        for (int i = 0; i < 4; ++i) f[i] = (f32x4){0.f, 0.f, 0.f, 0.f};
        int slot[4]; float wgt[4];
#pragma unroll
        for (int k = 0; k < 4; ++k) { slot[k] = F.w<int>(WS_SLOT)[row * 4 + k]; wgt[k] = F.w<float>(WS_RW)[row * 4 + k]; }
#pragma unroll
        for (int k = 0; k < 4; ++k) {
            const bf16_t* yr = Y + (size_t)slot[k] * D;
#pragma unroll
            for (int i = 0; i < 4; ++i) { const u32x2 w = *(const u32x2*)(yr + 4 * lane + 256 * i); f[i][0] += wgt[k] * bflo(w.x); f[i][1] += wgt[k] * bfhi(w.x); f[i][2] += wgt[k] * bflo(w.y); f[i][3] += wgt[k] * bfhi(w.y); }
        }
        const float rs = row_rstd(f);
        f32x4 x[4]; load_row(F.w<float>(WS_XCUR) + (size_t)row * D, lane, x);
#pragma unroll
        for (int i = 0; i < 4; ++i) { const f32x4 a = *(const f32x4*)(ve + 4 * lane + 256 * i); x[i] = x[i] + f[i] * rs * a; }
        float* xo = (l == 1) ? F.out + (size_t)row * D : F.w<float>(WS_XCUR) + (size_t)row * D;
#pragma unroll
        for (int i = 0; i < 4; ++i) *(f32x4*)(xo + 4 * lane + 256 * i) = x[i];
        if (l == 0) {
            const float rstd = row_rstd(x);
            const float* va = vecs_ptr(F, 1, which, 0), *vb = vecs_ptr(F, 1, which, 1);
            bf16_t* orow = F.w<bf16_t>(WS_HB) + (size_t)row * D;
#pragma unroll
            for (int i = 0; i < 4; ++i) {
                const int c = 4 * lane + 256 * i;
                const f32x4 a = *(const f32x4*)(va + c), b = *(const f32x4*)(vb + c);
                u32x2 w; w.x = pk_bf16(x[i][0] * rstd * a[0] + b[0], x[i][1] * rstd * a[1] + b[1]); w.y = pk_bf16(x[i][2] * rstd * a[2] + b[2], x[i][3] * rstd * a[3] + b[3]);
                *(u32x2*)(orow + c) = w;
            }
        }
    }
}

constexpr int PH_PER_LAYER = 10, N_PHASES = 2 + 2 * PH_PER_LAYER;
#ifndef PH_MASK
#define PH_MASK 0xFFFFFFFFu
#endif
#define EN(b) (((PH_MASK) >> (b)) & 1u)
#ifndef DUP_MASK
#define DUP_MASK 0u
#endif
#define REP(b) for (int _rep = 0; _rep < 1 + (int)(((DUP_MASK) >> (b)) & 1u); ++_rep)

__global__ void __launch_bounds__(NTHREADS, 2) mega(Args args) {
    extern __shared__ __attribute__((aligned(16))) unsigned char shm[];
    Frame F0;
    F0.in.kp = (kargp_t)__builtin_amdgcn_kernarg_segment_ptr();
    F0.out = args.out; F0.ws = args.ws; F0.lds = (LAS unsigned char*)shm;
    F0.tid = threadIdx.x; F0.lane = F0.tid & 63; F0.wave = __builtin_amdgcn_readfirstlane(F0.tid >> 6); F0.G = gridDim.x; F0.bid = blockIdx.x;
    volatile LAS unsigned* bst = (volatile LAS unsigned*)(shm + LDS_BYTES - 16);
    XcdBarrier bar; bar.bar = F0.w<unsigned>(WS_CTL) + CW_BAR; bar.x = 0; bar.st = bst;
#if N_LAUNCH_MODE == 1
    if (F0.tid == 0) { bst[0] = 0u; bst[1] = 0u; }
    __syncthreads();
    bar = xcd_barrier_post(F0.w<unsigned>(WS_CTL) + CW_BAR, bst);
#define GRID_BAR() xcd_barrier(bar)
#else
#define GRID_BAR() do {} while (0)
#endif
    const int lo = args.ph_lo, hi = args.ph_hi;
#define IN(k) (lo <= (k) && (k) < hi)
#define SEAM(k) do { if (IN(k) && IN((k) + 1)) GRID_BAR(); } while (0)

    if (IN(0)) { const Frame F = launder(F0); REP(0) ph_convert(F); REP(1) ph_modpart(F); REP(2) ph_filter(F); }
    SEAM(0);
    if (IN(1)) { const Frame F = launder(F0); REP(3) ph_norm1(F, 0); REP(4) ph_fsum(F); ph_vecs(F); }
    SEAM(1);
    for (int l = 0; l < 2; ++l) {
        const int pb = 2 + l * PH_PER_LAYER;
        if (EN(5) && IN(pb + 0)) { const Frame F = launder(F0);
            pg8::Gemm g{F.w<bf16_t>(WS_HB), F.w<bf16_t>(WS_WINT) + (size_t)l * PC * D, D};
            pg8::SchedGrid S{PC / 256, (T / 256) * (PC / 256), F.G, F.vid};
            pg8::EpiBf16 E{F.w<bf16_t>(WS_P), PC, nullptr, 0};
            REP(5) pg8::gemm_phase<pg8::EpiBf16, pg8::SchedGrid>(F.lds, g, S, E, F.tid);
        }
        SEAM(pb + 0);
        if (IN(pb + 1)) { const Frame F = launder(F0); REP(6) ph_ssd_prep(F, l); REP(7) ph_hy_prep(F, l); REP(8) ph_na(F, l, 0); }
        SEAM(pb + 1);
        if (IN(pb + 2)) { const Frame F = launder(F0); REP(9) ph_ssd_scan(F); REP(10) { ph_hy_conv(F, l); if (l == 0) ph_hy_conv_ctx(F, l); } }
        SEAM(pb + 2);
        if (EN(11) && IN(pb + 3)) { const Frame F = launder(F0); REP(11) ph_ssd_out(F, l); REP(18) ph_hy_tr(F); if (l == 0) ph_na(F, l, 1); }
        SEAM(pb + 3);
        if (EN(12) && IN(pb + 4)) { const Frame F = launder(F0);
            pg8::Gemm g{F.w<bf16_t>(WS_MIX), F.w<bf16_t>(WS_WOUTT) + (size_t)l * D * D, D};
            const int nM = (l == 0) ? T / 256 : L / 256;
            pg8::SchedGrid S{4, nM * 4, F.G, F.vid};
            pg8::EpiBf16 E{F.w<bf16_t>(WS_MIXO), D, nullptr, 0};
            REP(12) pg8::gemm_phase<pg8::EpiBf16, pg8::SchedGrid>(F.lds, g, S, E, F.tid);
        }
        SEAM(pb + 4);
        if (EN(13) && IN(pb + 5)) { const Frame F = launder(F0); ph_post1(F, l); }
        SEAM(pb + 5);
        if (EN(14) && IN(pb + 6)) { const Frame F = launder(F0); REP(14) ph_gather(F, l); }
        SEAM(pb + 6);
        if (EN(15) && IN(pb + 7)) { const Frame F = launder(F0);
            const int* tab = F.w<int>(WS_CTL) + CW_TILE + l * 320;
            const int ntiles = __builtin_amdgcn_readfirstlane(F.w<int>(WS_CTL)[CW_NT + l]);
            pg8::Gemm g{F.w<bf16_t>(WS_H2), (const bf16_t*)(F.w<unsigned char>(WS_WGUT) + (size_t)l * NE * 2048 * D), D / 2};
            pg8::SchedMoe S{8, ntiles * 8, F.G, F.vid, tab};
            pg8::EpiAct E{F.w<unsigned char>(WS_HMID) + (size_t)l * MAXROWS * D, F.in[I_BGU] + (size_t)l * NE * 2048};
            LAS int* rowtab = (LAS int*)(F.lds + pg8::STAGE_BYTES);
            __syncthreads();
            {
                int nt_; const int ps = expert_pad_start(F, l, nt_);
                const unsigned* cnt = F.w<unsigned>(WS_CTL) + CW_CNT + l * 1024;
                for (int ui = 0; ui * F.G + F.vid < ntiles * 8 && ui < 12; ++ui) {
                    const int pa = (ui * F.G + F.vid) / 8;
                    const int e = tab[pa];
                    const int pstart = __shfl(ps, e), ce = (int)__hip_atomic_load(cnt + e * 32, __ATOMIC_RELAXED, __HIP_MEMORY_SCOPE_AGENT);
                    if (F.tid < 256) { const int prow = pa * 256 + F.tid; rowtab[ui * 256 + F.tid] = (prow - pstart < ce) ? F.w<int>(WS_ROWTOK)[(size_t)l * MAXROWS + prow] : T; }
                }
            }
            __syncthreads();
            REP(15) pg8::gemm_phase<pg8::EpiAct, pg8::SchedMoe, true, true, true>(F.lds, g, S, E, F.tid, rowtab);
        }
        SEAM(pb + 7);
        if (EN(16) && IN(pb + 8)) { const Frame F = launder(F0);
            const int* tab = F.w<int>(WS_CTL) + CW_TILE + l * 320;
            const int ntiles = __builtin_amdgcn_readfirstlane(F.w<int>(WS_CTL)[CW_NT + l]);
            pg8::Gemm g{(const bf16_t*)(F.w<unsigned char>(WS_HMID) + (size_t)l * MAXROWS * D), (const bf16_t*)(F.w<unsigned char>(WS_WDT) + (size_t)l * NE * D * D), D / 2};
            pg8::SchedMoe S{4, ntiles * 4, F.G, F.vid, tab};
            pg8::EpiBf16 E{F.w<bf16_t>(WS_Y) + (size_t)l * MAXROWS * D, D, F.in[I_BDN] + (size_t)l * NE * D, D};
            REP(16) pg8::gemm_phase<pg8::EpiBf16, pg8::SchedMoe, true, false, true>(F.lds, g, S, E, F.tid);
        }
        SEAM(pb + 8);
        if (EN(17) && IN(pb + 9)) { const Frame F = launder(F0); ph_final(F, l); }
        if (l == 0) SEAM(pb + 9);
    }
#undef IN
#undef SEAM
}

extern "C" void kernel_launch(void* const* d_in, const int* in_sizes, int n_in, void* d_out, int out_size, void* d_ws, size_t ws_size, hipStream_t stream) {
    static int grid = 0;
    if (grid == 0) {
        if (n_in != N_IN || out_size != L * D || ws_size < WS_END) { fprintf(stderr, "kernel_launch: unexpected shapes: n_in %d out %d ws %zu (need %zu)\n", n_in, out_size, ws_size, (size_t)WS_END); grid = -1; return; }
        int dev = 0, cus = 0, per_cu = 0;
        if (hipGetDevice(&dev) != hipSuccess || hipDeviceGetAttribute(&cus, hipDeviceAttributeMultiprocessorCount, dev) != hipSuccess) { grid = -1; return; }
        if (hipFuncSetAttribute((const void*)mega, hipFuncAttributeMaxDynamicSharedMemorySize, LDS_BYTES) != hipSuccess) { fprintf(stderr, "kernel_launch: hipFuncSetAttribute failed\n"); grid = -1; return; }
        if (hipOccupancyMaxActiveBlocksPerMultiprocessor(&per_cu, (const void*)mega, NTHREADS, LDS_BYTES) != hipSuccess || per_cu < 1) { fprintf(stderr, "kernel_launch: occupancy query says %d\n", per_cu); }
        (void)hipGetLastError();
        grid = cus;
    }
    if (grid < 0) return;
    (void)hipMemsetAsync((char*)d_ws + WS_CTL, 0, CTL_BYTES, stream);
    Args a{};
    for (int i = 0; i < N_IN; ++i) a.in[i] = (const float*)d_in[i];
    a.out = (float*)d_out; a.ws = (unsigned char*)d_ws;
#if N_LAUNCH_MODE == 1
    a.ph_lo = 0; a.ph_hi = N_PHASES;
    hipLaunchKernelGGL(mega, dim3(grid), dim3(NTHREADS), LDS_BYTES, stream, a);
#else
    for (int p = 0; p < N_PHASES; ++p) { a.ph_lo = p; a.ph_hi = p + 1; hipLaunchKernelGGL(mega, dim3(grid), dim3(NTHREADS), LDS_BYTES, stream, a); }
#endif
}
```

```cpp
#include <hip/hip_runtime.h>
#include <cstdio>
#include <cstdint>

#define LAS __attribute__((address_space(3)))
typedef unsigned short bf16_t;
typedef short bf16x8 __attribute__((ext_vector_type(8)));
typedef float f32x4 __attribute__((ext_vector_type(4)));
typedef float f32x16 __attribute__((ext_vector_type(16)));
typedef unsigned u32x4 __attribute__((ext_vector_type(4)));
typedef unsigned u32x2 __attribute__((ext_vector_type(2)));
typedef int v4i __attribute__((ext_vector_type(4)));
typedef int v8i __attribute__((ext_vector_type(8)));

#ifndef N_LAUNCH_MODE
#define N_LAUNCH_MODE 1
#endif

constexpr int D = 1024, L = 16384, LC = 256, T = L + LC, NCH = T / 128;
constexpr int PC = 3328;
constexpr int CZ = 0, CXBC = 384, CQ = 1280, CK = 1664, CV = 2048, CHY = 2432, CDT = 3200;
constexpr int NE = 32;
constexpr int MAXT = 292;
constexpr int MAXROWS = MAXT * 256;
constexpr int NTHREADS = 512;
constexpr int LDS_BYTES = 160 * 1024;
constexpr float RMS_EPS = 1e-6f;

enum { I_X = 0, I_C, I_CTX, I_CCTX, I_WMOD, I_BMOD, I_NORMG, I_WIN, I_SCW, I_SCB, I_ALOG, I_DTB, I_SSDD, I_SSDNG, I_RPB, I_HCW, I_HCB,
       I_FW1, I_FB1, I_FW2, I_FB2, I_FW3, I_FREQ, I_HYD, I_WOUT, I_WR, I_BR, I_WGU, I_BGU, I_WDN, I_BDN, N_IN };

constexpr size_t al256(size_t x) { return (x + 255) & ~(size_t)255; }
constexpr size_t WS_CTL   = 0;
constexpr size_t CTL_BYTES = 64 * 1024;
constexpr size_t WS_WINT  = WS_CTL + CTL_BYTES;
constexpr size_t WS_WOUTT = WS_WINT + al256((size_t)2 * PC * D * 2);
constexpr size_t WS_WGUT  = WS_WOUTT + al256((size_t)2 * D * D * 2);
constexpr size_t WS_WDT   = WS_WGUT + al256((size_t)2 * NE * 2048 * D * 2);
constexpr size_t WS_MODP  = WS_WDT + al256((size_t)2 * NE * D * D * 2);
constexpr int KRL = 2 * L + 512;
constexpr size_t WS_KR    = WS_MODP + al256((size_t)2 * 2 * 32 * 6144 * 4);
constexpr size_t WS_KCOMBC= WS_KR + al256((size_t)2 * 256 * KRL * 2);
constexpr size_t WS_FPART = WS_KCOMBC + al256((size_t)2 * LC * 256 * 4);
constexpr size_t WS_FPARTC= WS_FPART + al256((size_t)2 * 256 * 512 * 4);
constexpr size_t WS_FSUM  = WS_FPARTC + al256((size_t)16 * 512 * 4);
constexpr size_t WS_HB    = WS_FSUM + al256((size_t)3 * 256 * 4);
constexpr size_t WS_P     = WS_HB + al256((size_t)T * D * 2);
constexpr size_t WS_XBC   = WS_P + al256((size_t)T * PC * 2);
constexpr size_t WS_DTV   = WS_XBC + al256((size_t)T * 896 * 2);
constexpr size_t WS_ACS   = WS_DTV + al256((size_t)T * 12 * 4);
constexpr size_t WS_ALAST = WS_ACS + al256((size_t)T * 12 * 4);
constexpr size_t WS_STATES= WS_ALAST + al256((size_t)NCH * 12 * 4);
constexpr size_t WS_SSTART= WS_STATES + al256((size_t)2 * NCH * 6 * 128 * 64 * 4);
constexpr size_t WS_U     = WS_SSTART + al256((size_t)2 * NCH * 6 * 128 * 64 * 4);
constexpr size_t WS_UT    = WS_U + al256((size_t)T * 256 * 4);
constexpr size_t WS_UT8   = WS_UT + al256((size_t)256 * L * 2);
constexpr size_t WS_X0T   = WS_UT8 + al256((size_t)256 * L);
constexpr size_t WS_YT    = WS_X0T + al256((size_t)256 * L * 2);
constexpr size_t WS_MIX   = WS_YT + al256((size_t)256 * L * 2);
constexpr size_t WS_MIXO  = WS_MIX + al256((size_t)T * D * 2);
constexpr size_t WS_XCUR  = WS_MIXO + al256((size_t)T * D * 4);
constexpr size_t WS_H2    = WS_XCUR + al256((size_t)T * D * 4);
constexpr size_t WS_RE    = WS_H2 + al256((size_t)(T + 1) * D * 2);
constexpr size_t WS_RP    = WS_RE + al256((size_t)T * 4 * 4);
constexpr size_t WS_RW    = WS_RP + al256((size_t)T * 4 * 4);
constexpr size_t WS_SLOT  = WS_RW + al256((size_t)T * 4 * 4);
constexpr size_t WS_XG    = WS_SLOT + al256((size_t)T * 4 * 4);
constexpr size_t WS_HMID  = WS_XG + 256;
constexpr size_t WS_Y     = WS_HMID + al256((size_t)2 * MAXROWS * D * 2);
constexpr size_t WS_VECS  = WS_Y + al256((size_t)2 * MAXROWS * D * 2);
constexpr size_t WS_ROWTOK= WS_VECS + al256((size_t)2 * 2 * 6 * 1024 * 4);
constexpr size_t WS_END   = WS_ROWTOK + al256((size_t)2 * MAXROWS * 4);

constexpr int CW_BAR = 0;
constexpr int CW_CNT = 8192;
constexpr int CW_CVQ = 4160;
constexpr int CW_NT = 4200;
constexpr int CW_TILE = 4224;

__device__ __forceinline__ float bf2f(unsigned short b) { return __uint_as_float(((unsigned)b) << 16); }
__device__ __forceinline__ unsigned short f2bf(float f) { unsigned u = __float_as_uint(f); u += 0x7FFFu + ((u >> 16) & 1u); return (unsigned short)(u >> 16); }
__device__ __forceinline__ unsigned pk_bf16(float lo, float hi) { return (unsigned)f2bf(lo) | ((unsigned)f2bf(hi) << 16); }
__device__ __forceinline__ float sat8(float x) { return fminf(fmaxf(x, -448.0f), 448.0f); }
__device__ __forceinline__ unsigned pk_fp8x4(float a, float b, float c, float d) { unsigned w = 0; w = __builtin_amdgcn_cvt_pk_fp8_f32(sat8(a), sat8(b), w, false); w = __builtin_amdgcn_cvt_pk_fp8_f32(sat8(c), sat8(d), w, true); return w; }
constexpr float KR_SCALE = 64.0f;
constexpr float W8_SCALE = 32.0f;
constexpr int W8_SCALE_E8M0 = 0x7A7A7A7A, ONE_E8M0 = 0x7F7F7F7F;
__device__ __forceinline__ float bflo(unsigned w) { return __uint_as_float(w << 16); }
__device__ __forceinline__ float bfhi(unsigned w) { return __uint_as_float(w & 0xFFFF0000u); }
__device__ __forceinline__ float silu_f(float x) { return x / (1.0f + __expf(-x)); }
__device__ __forceinline__ float softplus_f(float x) { return x > 20.f ? x : log1pf(__expf(x)); }
__device__ __forceinline__ float wave_sum(float v) {
#pragma unroll
    for (int o = 32; o >= 1; o >>= 1) v += __shfl_xor(v, o);
    return v;
}
__device__ __forceinline__ void lds_fence() { asm volatile("s_waitcnt lgkmcnt(0)" ::: "memory"); }

#define XB_TMO      128
#define XB_XCNT(j)  (256  + 64 * (j))
#define XB_XSUB(j)  (1280 + 64 * (j))
#define XB_XGEN(j)  (2304 + 64 * (j))
#define XB_TOP      3328
#define XB_TOPGEN   3392
#define XCD_BAR_WORDS 3456
#define XB_SPIN_CAP (1u << 18)
__device__ __forceinline__ unsigned xb_ld(unsigned* p)              { return __hip_atomic_load(p, __ATOMIC_RELAXED, __HIP_MEMORY_SCOPE_AGENT); }
__device__ __forceinline__ unsigned xb_add(unsigned* p, unsigned v) { return __hip_atomic_fetch_add(p, v, __ATOMIC_RELAXED, __HIP_MEMORY_SCOPE_AGENT); }
__device__ __forceinline__ unsigned xb_xcc_id() { return (unsigned)__builtin_amdgcn_s_getreg((3 << 11) | 20) & 0xFu; }
#define XB_SPIN(cond, bar) do { unsigned _sp = 0; while (cond) { __builtin_amdgcn_s_sleep(1); \
    if ((++_sp & 255u) == 0u) { if (xb_ld(&(bar)[XB_TMO])) break; if (_sp > XB_SPIN_CAP) { atomicAdd(&(bar)[XB_TMO], 1u); break; } } } } while (0)
struct XcdBarrier { unsigned* bar; unsigned x; volatile LAS unsigned* st; };
__device__ __forceinline__ XcdBarrier xcd_barrier_post(unsigned* bar, volatile LAS unsigned* st) {
    XcdBarrier b; b.bar = bar; b.x = xb_xcc_id(); b.st = st;
    if (threadIdx.x == 0) (void)xb_add(&bar[XB_XCNT(b.x)], 1u);
    return b;
}
__device__ __forceinline__ void xcd_barrier_complete(unsigned* bar, unsigned x, unsigned& nloc, unsigned& nx) {
    const unsigned G = gridDim.x * gridDim.y * gridDim.z;
    unsigned sum, cnt, mine, sp = 0u;
    for (;;) {
        sum = 0u; cnt = 0u; mine = 0u;
#pragma unroll
        for (unsigned j = 0; j < 16; ++j) { const unsigned c = xb_ld(&bar[XB_XCNT(j)]); sum += c; cnt += (c > 0u) ? 1u : 0u; mine = (j == x) ? c : mine; }
        if (sum == G) break;
        __builtin_amdgcn_s_sleep(1);
        if ((++sp & 255u) == 0u) { if (xb_ld(&bar[XB_TMO])) break; if (sp > XB_SPIN_CAP) { atomicAdd(&bar[XB_TMO], 1u); break; } }
    }
    nloc = mine > 0u ? mine : 1u; nx = cnt > 0u ? cnt : 1u;
}
__device__ __forceinline__ void xcd_barrier(const XcdBarrier& b) {
    asm volatile("s_waitcnt vmcnt(0)" ::: "memory");
    __syncthreads();
    if (threadIdx.x == 0) {
        unsigned* bar = b.bar;
        __builtin_amdgcn_s_waitcnt(0);
        unsigned nloc = b.st[0], nx = b.st[1];
        if (nloc == 0u) { xcd_barrier_complete(bar, b.x, nloc, nx); b.st[0] = nloc; b.st[1] = nx; }
        const unsigned old = xb_add(&bar[XB_XSUB(b.x)], 1u);
        const unsigned gen = old / nloc;
        if (old + 1u == (gen + 1u) * nloc) {
            __builtin_amdgcn_fence(__ATOMIC_RELEASE, "agent");
            asm volatile("s_waitcnt vmcnt(0)" ::: "memory");
            const unsigned og = xb_add(&bar[XB_TOP], 1u);
            const unsigned tg = og / nx;
            if (og + 1u == (tg + 1u) * nx) xb_add(&bar[XB_TOPGEN], 1u);
            else XB_SPIN(xb_ld(&bar[XB_TOPGEN]) == tg, bar);
            __builtin_amdgcn_fence(__ATOMIC_ACQUIRE, "agent");
            xb_add(&bar[XB_XGEN(b.x)], 1u);
            asm volatile("s_waitcnt vmcnt(0)" ::: "memory");
        } else {
            XB_SPIN(xb_ld(&bar[XB_XGEN(b.x)]) == gen, bar);
            __builtin_amdgcn_fence(__ATOMIC_ACQUIRE, "agent");
            asm volatile("s_waitcnt vmcnt(0)" ::: "memory");
        }
    }
    __syncthreads();
}

#ifndef GEMM_REP
#define GEMM_REP 1
#endif
namespace pg8 {
constexpr int BM = 256, BK = 64, HALF = 128, HTB = HALF * BK * 2, STAGE_BYTES = 8 * HTB;
__host__ __device__ __forceinline__ int lds_byte(int r, int c) { const int st = (r >> 4) * 2 + (c >> 5), rr = r & 15, cc = c & 31, ob = rr * 64 + cc * 2; return st * 1024 + (ob ^ (((ob >> 9) & 1) << 5)); }
__host__ __device__ __forceinline__ void stage_rc(int b, int& R, int& C) { const int st = b / 1024, sb = b % 1024, swz = sb ^ (((sb >> 9) & 1) << 5); R = (st >> 1) * 16 + swz / 64; C = (st & 1) * 32 + (swz % 64) / 2; }
__host__ __device__ __forceinline__ int perm32(int rho) { const int n = rho >> 4, i = rho & 15; return 8 * (i >> 2) + 4 * n + (i & 3); }

struct Unit { int pa, pb, pn, e; };
struct Gemm { const bf16_t* A; const bf16_t* Bt; int K; };

template <class Epi, class Sched, bool ALIGN_EPI = true, bool GATHER = false, bool FP8 = false>
__device__ __forceinline__ void gemm_phase(LAS unsigned char* lds, const Gemm g, const Sched& S, const Epi& E, const int tid, const LAS int* rowtab = nullptr) {
    const int wid = __builtin_amdgcn_readfirstlane(tid >> 6), lane = tid & 63, wr = wid >> 2, wc = wid & 3, fr = lane & 15, fq = lane >> 4;
    const int K = g.K, nt = K / BK;
    unsigned voffA[2], voffB[2];
    int gR[2], gC[2];
#pragma unroll
    for (int i = 0; i < 2; ++i) { int R, C; stage_rc(tid * 16 + i * 8192, R, C); const int Rb = Epi::PERM ? ((R & ~31) + perm32(R & 31)) : R;
        voffA[i] = (unsigned)(R * K + C) * 2u; voffB[i] = (unsigned)(Rb * K + C) * 2u; gR[i] = R; gC[i] = C * 2; }
    unsigned vC0[2], vC1[2], vN0[2], vN1[2];
#define PG8_GOFFS(dst0, dst1, ui_) do { _Pragma("unroll") for (int _i = 0; _i < 2; ++_i) { \
        dst0[_i] = (unsigned)rowtab[(ui_) * 256 + gR[_i]] * (unsigned)(K * 2) + (unsigned)gC[_i]; dst1[_i] = (unsigned)rowtab[(ui_) * 256 + 128 + gR[_i]] * (unsigned)(K * 2) + (unsigned)gC[_i]; } } while (0)
    const size_t kstep = (size_t)(BK * 2);
    const size_t hstep = (size_t)HALF * K * 2;
    const size_t tstep = 2 * hstep;
    const unsigned ldsw = (unsigned)wid * 1024u;
    const int aoff = lds_byte(wr * 64 + fr, fq * 8), boff = lds_byte(wc * 32 + fr, fq * 8);
#define PG8_SA(b, h) (((b) * 2 + (h)) * HTB)
#define PG8_SB(b, h) ((4 + (b) * 2 + (h)) * HTB)
#define PG8_STAGE(bufoff, gbase, voff) do { _Pragma("unroll") for (int _i = 0; _i < 2; ++_i) \
        __builtin_amdgcn_global_load_lds((const unsigned*)((const char*)(gbase) + (voff)[_i]), (LAS unsigned*)(lds + (bufoff) + ldsw + _i * 8192), 16, 0, 0); } while (0)
#define PG8_LDA(dst, b, h) do { _Pragma("unroll") for (int m = 0; m < 4; ++m) { const v4i _x = *(const LAS v4i*)(lds + PG8_SA(b, h) + aoff + m * 2048), _y = *(const LAS v4i*)(lds + PG8_SA(b, h) + aoff + m * 2048 + 1024); \
        dst[m] = __builtin_shufflevector(_x, _y, 0, 1, 2, 3, 4, 5, 6, 7); } } while (0)
#define PG8_LDB(dst, b, h) do { _Pragma("unroll") for (int n = 0; n < 2; ++n) { const v4i _x = *(const LAS v4i*)(lds + PG8_SB(b, h) + boff + n * 2048), _y = *(const LAS v4i*)(lds + PG8_SB(b, h) + boff + n * 2048 + 1024); \
        dst[n] = __builtin_shufflevector(_x, _y, 0, 1, 2, 3, 4, 5, 6, 7); } } while (0)
#define PG8_HALF0(x) __builtin_bit_cast(bf16x8, __builtin_shufflevector((x), (x), 0, 1, 2, 3))
#define PG8_HALF1(x) __builtin_bit_cast(bf16x8, __builtin_shufflevector((x), (x), 4, 5, 6, 7))
#define PG8_MMA(ai, bj, At, Bt) do { __builtin_amdgcn_s_setprio(1); if constexpr (FP8) { _Pragma("unroll") for (int m = 0; m < 4; ++m) _Pragma("unroll") for (int n = 0; n < 2; ++n) \
        asm volatile("v_mfma_scale_f32_16x16x128_f8f6f4 %0, %1, %2, %0, %3, %4 op_sel_hi:[0,0,0]" : "+v"(acc[ai][bj][m][n]) : "v"(Bt[n]), "v"(At[m]), "v"(sclW), "v"(sclX)); } \
        else { _Pragma("unroll") for (int m = 0; m < 4; ++m) _Pragma("unroll") for (int n = 0; n < 2; ++n) { \
        acc[ai][bj][m][n] = __builtin_amdgcn_mfma_f32_16x16x32_bf16(PG8_HALF0(Bt[n]), PG8_HALF0(At[m]), acc[ai][bj][m][n], 0, 0, 0); \
        acc[ai][bj][m][n] = __builtin_amdgcn_mfma_f32_16x16x32_bf16(PG8_HALF1(Bt[n]), PG8_HALF1(At[m]), acc[ai][bj][m][n], 0, 0, 0); } } __builtin_amdgcn_s_setprio(0); } while (0)
#define PG8_WAIT_V(n) asm volatile("s_waitcnt vmcnt(" #n ")" ::: "memory")
#define PG8_WAIT_L(n) asm volatile("s_waitcnt lgkmcnt(" #n ")" ::: "memory")
#define PG8_BAR __builtin_amdgcn_s_barrier()
#define PG8_SCHED __builtin_amdgcn_sched_barrier(0)
    Unit cur, nxt; int ui = 0;
    if (!S.next(0, cur)) return;
    f32x4 acc[2][2][4][2];
    E.init(acc, cur, wc, fq);
    const int sclW = W8_SCALE_E8M0, sclX = ONE_E8M0;
    v8i At[4], B0[2], B1[2];
    const char* cA = GATHER ? (const char*)g.A : (const char*)g.A + (size_t)cur.pa * tstep; const char* cB = (const char*)g.Bt + (size_t)cur.pb * tstep;
    const size_t hstepA = GATHER ? 0 : hstep;
    if constexpr (GATHER) { PG8_GOFFS(vC0, vC1, 0); } else {
#pragma unroll
        for (int i = 0; i < 2; ++i) { vC0[i] = voffA[i]; vC1[i] = voffA[i]; vN0[i] = voffA[i]; vN1[i] = voffA[i]; } }
    PG8_STAGE(PG8_SB(0, 0), cB, voffB); PG8_STAGE(PG8_SB(0, 1), cB + hstep, voffB); PG8_STAGE(PG8_SA(0, 0), cA, vC0); PG8_STAGE(PG8_SA(0, 1), cA + hstepA, vC1);
    if (wr == 1) PG8_BAR;
    PG8_WAIT_V(2); PG8_BAR;
    PG8_STAGE(PG8_SB(1, 0), cB + kstep, voffB); PG8_STAGE(PG8_SA(1, 0), cA + kstep, vC0); PG8_STAGE(PG8_SB(1, 1), cB + hstep + kstep, voffB);
    PG8_WAIT_V(6); PG8_BAR;
    for (;;) {
        const bool has_next = S.next(ui + 1, nxt);
        const char* nA = GATHER ? (const char*)g.A : (has_next ? (const char*)g.A + (size_t)nxt.pa * tstep : cA); const char* nB = has_next ? (const char*)g.Bt + (size_t)nxt.pb * tstep : cB;
        if constexpr (GATHER) { if (has_next) { PG8_GOFFS(vN0, vN1, ui + 1); } else {
#pragma unroll
            for (int i = 0; i < 2; ++i) { vN0[i] = vC0[i]; vN1[i] = vC1[i]; } } }
#pragma unroll 1
        for (int t = 0; t < nt; t += 2) {
            const bool last = (t == nt - 2);
            unsigned vX0[2], vX1[2];
#pragma unroll
            for (int i = 0; i < 2; ++i) { vX0[i] = (GATHER && last) ? vN0[i] : vC0[i]; vX1[i] = (GATHER && last) ? vN1[i] : vC1[i]; }
            const char* a1 = cA + (size_t)(t + 1) * kstep;
            const char* a2 = last ? nA : cA + (size_t)(t + 2) * kstep; const char* b2 = last ? nB : cB + (size_t)(t + 2) * kstep;
            const char* a3 = a2 + kstep; const char* b3 = b2 + kstep;
            PG8_LDB(B0, 0, 0); PG8_LDB(B1, 0, 1); PG8_SCHED; PG8_LDA(At, 0, 0); PG8_STAGE(PG8_SA(1, 1), a1 + hstepA, vC1);
            PG8_WAIT_V(8); PG8_WAIT_L(0); PG8_BAR; PG8_MMA(0, 0, At, B0); PG8_MMA(0, 1, At, B1); PG8_BAR; PG8_SCHED;
            PG8_LDA(At, 0, 1); PG8_STAGE(PG8_SB(0, 0), b2, voffB); PG8_STAGE(PG8_SB(0, 1), b2 + hstep, voffB); PG8_STAGE(PG8_SA(0, 0), a2, vX0);
            PG8_WAIT_V(8); PG8_WAIT_L(0); PG8_BAR; PG8_MMA(1, 0, At, B0); PG8_MMA(1, 1, At, B1); PG8_BAR; PG8_SCHED;
            PG8_LDB(B0, 1, 0); PG8_LDB(B1, 1, 1); PG8_SCHED; PG8_LDA(At, 1, 0); PG8_STAGE(PG8_SA(0, 1), a2 + hstepA, vX1);
            PG8_WAIT_V(8); PG8_WAIT_L(0); PG8_BAR; PG8_MMA(0, 0, At, B0); PG8_MMA(0, 1, At, B1); PG8_BAR; PG8_SCHED;
            PG8_LDA(At, 1, 1); PG8_STAGE(PG8_SB(1, 0), b3, voffB); PG8_STAGE(PG8_SB(1, 1), b3 + hstep, voffB); PG8_STAGE(PG8_SA(1, 0), a3, vX0);
            PG8_WAIT_V(8); PG8_WAIT_L(0); PG8_BAR; PG8_MMA(1, 0, At, B0); PG8_MMA(1, 1, At, B1); PG8_BAR; PG8_SCHED;
        }
        if constexpr (ALIGN_EPI) { if (wr == 0) PG8_BAR; }
        E(acc, cur, wr, wc, fr, fq);
        if (!has_next) break;
        E.init(acc, nxt, wc, fq);
        cur = nxt; cA = nA; cB = nB; ++ui;
        if constexpr (GATHER) {
#pragma unroll
            for (int i = 0; i < 2; ++i) { vC0[i] = vN0[i]; vC1[i] = vN1[i]; } }
        if constexpr (ALIGN_EPI) { if (wr == 1) PG8_BAR; }
    }
    PG8_WAIT_V(0);
    if constexpr (!ALIGN_EPI) { if (wr == 0) PG8_BAR; }
    PG8_BAR;
#undef PG8_GOFFS
#undef PG8_HALF0
#undef PG8_HALF1
#undef PG8_SA
#undef PG8_SB
#undef PG8_STAGE
#undef PG8_LDA
#undef PG8_LDB
#undef PG8_MMA
#undef PG8_WAIT_V
#undef PG8_WAIT_L
#undef PG8_BAR
#undef PG8_SCHED
}

struct EpiF32 {
    static constexpr bool PERM = false;
    float* C; int ldc;
    __device__ __forceinline__ void operator()(const f32x4 (&acc)[2][2][4][2], const Unit& u, int wr, int wc, int fr, int fq) const {
        const int row0 = u.pa * BM + wr * 64 + fr, col0 = u.pn * BM + wc * 32 + 4 * fq;
#pragma unroll
        for (int ai = 0; ai < 2; ++ai)
#pragma unroll
            for (int m = 0; m < 4; ++m) { float* rowp = C + (size_t)(row0 + ai * HALF + m * 16) * ldc + col0;
#pragma unroll
                for (int bj = 0; bj < 2; ++bj)
#pragma unroll
                    for (int n = 0; n < 2; ++n) *(f32x4*)(rowp + bj * HALF + n * 16) = acc[ai][bj][m][n]; }
    }
};
struct EpiBf16 {
    static constexpr bool PERM = true;
    bf16_t* O; int ldc; const float* bias; int bias_stride;
    __device__ __forceinline__ void init(f32x4 (&acc)[2][2][4][2], const Unit& u, int wc, int fq) const {
        const int col0 = u.pn * BM + wc * 32 + 8 * fq;
#pragma unroll
        for (int bj = 0; bj < 2; ++bj)
#pragma unroll
            for (int n = 0; n < 2; ++n) { const f32x4 bv = bias ? *(const f32x4*)(bias + (size_t)u.e * bias_stride + col0 + bj * HALF + 4 * n) : (f32x4){0.f, 0.f, 0.f, 0.f};
#pragma unroll
                for (int ai = 0; ai < 2; ++ai)
#pragma unroll
                    for (int m = 0; m < 4; ++m) acc[ai][bj][m][n] = bv; }
    }
    __device__ __forceinline__ void operator()(const f32x4 (&acc)[2][2][4][2], const Unit& u, int wr, int wc, int fr, int fq) const {
        const int row0 = u.pa * BM + wr * 64 + fr; const int col0 = u.pn * BM + wc * 32 + 8 * fq;
#pragma unroll
        for (int ai = 0; ai < 2; ++ai)
#pragma unroll
            for (int m = 0; m < 4; ++m) { bf16_t* rowp = O + (size_t)(row0 + ai * HALF + m * 16) * ldc + col0;
#pragma unroll
                for (int bj = 0; bj < 2; ++bj) { const f32x4 v0 = acc[ai][bj][m][0], v1 = acc[ai][bj][m][1];
                    u32x4 w; w.x = pk_bf16(v0[0], v0[1]); w.y = pk_bf16(v0[2], v0[3]); w.z = pk_bf16(v1[0], v1[1]); w.w = pk_bf16(v1[2], v1[3]);
                    *(u32x4*)(rowp + bj * HALF) = w; } }
    }
};
struct EpiAct {
    static constexpr bool PERM = true;
    unsigned char* O; const float* bias;
    __device__ __forceinline__ void init(f32x4 (&acc)[2][2][4][2], const Unit& u, int wc, int fq) const {
        const float* bg = bias + (size_t)u.e * 2048 + u.pn * 128 + wc * 32 + 8 * fq;
#pragma unroll
        for (int bj = 0; bj < 2; ++bj)
#pragma unroll
            for (int n = 0; n < 2; ++n) { const f32x4 bv = *(const f32x4*)(bg + bj * 1024 + 4 * n);
#pragma unroll
                for (int ai = 0; ai < 2; ++ai)
#pragma unroll
                    for (int m = 0; m < 4; ++m) acc[ai][bj][m][n] = bv; }
    }
    __device__ __forceinline__ void operator()(const f32x4 (&acc)[2][2][4][2], const Unit& u, int wr, int wc, int fr, int fq) const {
        const int row0 = u.pa * BM + wr * 64 + fr; const int cc0 = wc * 32 + 8 * fq; const int ocol = u.pn * 128 + cc0;
#pragma unroll
        for (int ai = 0; ai < 2; ++ai)
#pragma unroll
            for (int m = 0; m < 4; ++m) { unsigned char* rowp = O + (size_t)(row0 + ai * HALF + m * 16) * D + ocol;
                float r[8];
#pragma unroll
                for (int n = 0; n < 2; ++n)
#pragma unroll
                    for (int j = 0; j < 4; ++j) { float gt = acc[ai][0][m][n][j], up = acc[ai][1][m][n][j];
                        gt = fminf(gt, 7.0f); up = fminf(fmaxf(up, -7.0f), 7.0f);
                        r[n * 4 + j] = gt / (1.0f + __expf(-1.702f * gt)) * (up + 1.0f); }
                u32x2 w; w.x = pk_fp8x4(r[0], r[1], r[2], r[3]); w.y = pk_fp8x4(r[4], r[5], r[6], r[7]);
                *(u32x2*)rowp = w; }
    }
};
struct SchedGrid {
    int nN, total, G, c;
    __device__ __forceinline__ bool next(int i, Unit& u) const { int Lx = i * G + c; if (Lx >= GEMM_REP * total) return false; if (GEMM_REP > 1) Lx %= total; u.pa = Lx / nN; u.pn = Lx - u.pa * nN; u.pb = u.pn; u.e = 0; return true; }
};
struct SchedMoe {
    int nN, total, G, c; const int* tile_e;
    __device__ __forceinline__ bool next(int i, Unit& u) const { int Lx = i * G + c; if (Lx >= GEMM_REP * total) return false; if (GEMM_REP > 1) Lx %= total; u.pa = Lx / nN; u.pn = Lx - u.pa * nN; u.e = __builtin_amdgcn_readfirstlane((int)tile_e[u.pa]); u.pb = u.e * nN + u.pn; return true; }
};
}

struct Args { const float* in[N_IN]; float* out; unsigned char* ws; int ph_lo, ph_hi; };

typedef const float* __attribute__((address_space(4))) const* kargp_t;
struct InProxy { kargp_t kp; __device__ __forceinline__ const float* operator[](int i) const { return kp[i]; } };
struct Frame {
    InProxy in; float* out; unsigned char* ws;
    LAS unsigned char* lds;
    int tid, lane, wave, G, bid, vid;
    template <class Tp> __device__ __forceinline__ Tp* w(size_t off) const { return (Tp*)(ws + off); }
};

__device__ __forceinline__ Frame launder(const Frame& F) {
    Frame R = F;
    int t = F.tid; asm volatile("" : "+v"(t)); R.tid = t; R.lane = t & 63; R.wave = __builtin_amdgcn_readfirstlane(t >> 6);
    unsigned long long w = (unsigned long long)F.ws; asm volatile("" : "+s"(w)); R.ws = (unsigned char*)w;
    unsigned long long o = (unsigned long long)F.out; asm volatile("" : "+s"(o)); R.out = (float*)o;
    unsigned long long k = (unsigned long long)F.in.kp; asm volatile("" : "+s"(k)); R.in.kp = (kargp_t)k;
    int g = F.G, b = F.bid; asm volatile("" : "+s"(g), "+s"(b)); R.G = g; R.bid = b; R.vid = (g % 8 == 0) ? (b % 8) * (g / 8) + b / 8 : b;
    return R;
}

__device__ __forceinline__ float mod_val(const Frame& F, int l, int which, int j) {
    const float* mp = F.w<float>(WS_MODP) + (size_t)((l * 2 + which) * 32) * 6144 + j;
    float s = F.in[I_BMOD][l * 6144 + j];
#pragma unroll
    for (int k = 0; k < 32; ++k) s += mp[(size_t)k * 6144];
    return s;
}

struct CvtTile { const float* src; bf16_t* dst; int ld, mode, k0, n0; bool f8; };
__device__ __forceinline__ CvtTile cvt_decode(const Frame& F, int t) {
    CvtTile c;
    if (t < 1664) { const int l = t / 832, r = t % 832; c.n0 = (r / 16) * 64; c.k0 = (r % 16) * 64; c.src = F.in[I_WIN] + (size_t)l * 1024 * 3212; c.ld = 3212; c.mode = 1; c.f8 = false; c.dst = F.w<bf16_t>(WS_WINT) + (size_t)l * PC * D; }
    else if (t < 2176) { const int q = t - 1664, l = q / 256, r = q % 256; c.n0 = (r / 16) * 64; c.k0 = (r % 16) * 64; c.src = F.in[I_WOUT] + (size_t)l * D * D; c.ld = 1024; c.mode = 0; c.f8 = false; c.dst = F.w<bf16_t>(WS_WOUTT) + (size_t)l * D * D; }
    else if (t < 34944) { const int q = t - 2176, le = q / 512, r = q % 512; c.n0 = (r / 16) * 64; c.k0 = (r % 16) * 64; c.src = F.in[I_WGU] + (size_t)le * 1024 * 2048; c.ld = 2048; c.mode = 2; c.f8 = true; c.dst = (bf16_t*)(F.w<unsigned char>(WS_WGUT) + (size_t)le * 2048 * D); }
    else { const int q = t - 34944, le = q / 256, r = q % 256; c.n0 = (r / 16) * 64; c.k0 = (r % 16) * 64; c.src = F.in[I_WDN] + (size_t)le * D * D; c.ld = 1024; c.mode = 0; c.f8 = true; c.dst = (bf16_t*)(F.w<unsigned char>(WS_WDT) + (size_t)le * D * D); }
    return c;
}
__device__ __forceinline__ void cvt_load(const CvtTile& c, int lane, f32x4 (&a)[8], f32x4 (&b)[8]) {
    const int i4 = lane & 15, kpl = lane >> 4;
    const int n = c.n0 + 4 * i4;
    int sc; bool valid = true;
    if (c.mode == 0) sc = n;
    else if (c.mode == 1) { if (n < 1280) sc = n; else if (n < 3200) sc = n + 12; else if (n < 3212) sc = n - 3200 + 1280; else { sc = 0; valid = false; } }
    else { const int pn = n >> 8, rr = n & 255; sc = rr < 128 ? pn * 128 + rr : 1024 + pn * 128 + (rr - 128); }
#pragma unroll
    for (int it = 0; it < 8; ++it) {
        const int r0 = c.f8 ? 4 * (kpl + 4 * (it >> 1)) + 2 * (it & 1) : 2 * (kpl + 4 * it);
        a[it] = (f32x4){0.f, 0.f, 0.f, 0.f}; b[it] = a[it];
        if (valid) { a[it] = __builtin_nontemporal_load((const f32x4*)(c.src + (size_t)(c.k0 + r0) * c.ld + sc)); b[it] = __builtin_nontemporal_load((const f32x4*)(c.src + (size_t)(c.k0 + r0 + 1) * c.ld + sc)); }
    }
}
__device__ __forceinline__ void cvt_store(const CvtTile& c, int lane, const f32x4 (&a)[8], const f32x4 (&b)[8], LAS unsigned* lw) {
    const int i4 = lane & 15, kpl = lane >> 4;
    if (c.f8) {
#pragma unroll
        for (int j = 0; j < 4; ++j) {
            const int kq = kpl + 4 * j;
#pragma unroll
            for (int i = 0; i < 4; ++i) lw[kq * 65 + 4 * i4 + i] = pk_fp8x4(W8_SCALE * a[2 * j][i], W8_SCALE * b[2 * j][i], W8_SCALE * a[2 * j + 1][i], W8_SCALE * b[2 * j + 1][i]);
        }
        lds_fence();
        const int g = lane & 3, nl = lane >> 2;
        unsigned char* d8 = (unsigned char*)c.dst;
#pragma unroll
        for (int it = 0; it < 4; ++it) {
            const int nn = nl + 16 * it;
            u32x4 v; v.x = lw[(4 * g + 0) * 65 + nn]; v.y = lw[(4 * g + 1) * 65 + nn]; v.z = lw[(4 * g + 2) * 65 + nn]; v.w = lw[(4 * g + 3) * 65 + nn];
            *(u32x4*)(d8 + (size_t)(c.n0 + nn) * 1024 + c.k0 + 16 * g) = v;
        }
        lds_fence();
        return;
    }
#pragma unroll
    for (int it = 0; it < 8; ++it) {
        const int kp = kpl + 4 * it;
#pragma unroll
        for (int i = 0; i < 4; ++i) lw[kp * 65 + 4 * i4 + i] = pk_bf16(a[it][i], b[it][i]);
    }
    lds_fence();
    const int g = lane & 7, nl = lane >> 3;
#pragma unroll
    for (int it = 0; it < 8; ++it) {
        const int nn = nl + 8 * it;
        u32x4 v; v.x = lw[(4 * g + 0) * 65 + nn]; v.y = lw[(4 * g + 1) * 65 + nn]; v.z = lw[(4 * g + 2) * 65 + nn]; v.w = lw[(4 * g + 3) * 65 + nn];
        *(u32x4*)(c.dst + (size_t)(c.n0 + nn) * 1024 + c.k0 + 8 * g) = v;
    }
    lds_fence();
}

constexpr int CVT_N0 = 1664 + 512 + 16384 + 8192, CVT_NQ = 16384 + 8192;
__device__ __forceinline__ int cvt_tile0(int u) { return u < 18560 ? u : u - 18560 + 34944; }
__device__ __forceinline__ int cvt_tileq(int v) { return v < 16384 ? 18560 + v : 43136 + (v - 16384); }
__device__ __forceinline__ void ph_convert(const Frame& F) {
    LAS unsigned* lw = (LAS unsigned*)(F.lds) + F.wave * (32 * 65 + 16);
    const int nwaves = F.G * 8, w0 = F.bid * 8 + F.wave;
    f32x4 a0[8], b0[8], a1[8], b1[8];
    int t = w0;
    if (t >= CVT_N0) return;
    CvtTile c0 = cvt_decode(F, cvt_tile0(t));
    cvt_load(c0, F.lane, a0, b0);
    for (;;) {
        const int t1 = t + nwaves;
        CvtTile c1 = c0;
        if (t1 < CVT_N0) { c1 = cvt_decode(F, cvt_tile0(t1)); cvt_load(c1, F.lane, a1, b1); }
        cvt_store(c0, F.lane, a0, b0, lw);
        if (t1 >= CVT_N0) break;
        const int t2 = t1 + nwaves;
        if (t2 < CVT_N0) { c0 = cvt_decode(F, cvt_tile0(t2)); cvt_load(c0, F.lane, a0, b0); }
        cvt_store(c1, F.lane, a1, b1, lw);
        if (t2 >= CVT_N0) break;
        t = t2;
    }
}
__device__ __forceinline__ void cvt_drain(const Frame& F, int v0, int wrank, int nw, int quota) {
    __syncthreads();
    LAS unsigned* lw = (LAS unsigned*)(F.lds) + F.wave * (32 * 65 + 16);
    f32x4 a0[8], b0[8];
    if (quota >= 0) {
        for (int i = 0; i < quota; ++i) {
            const int v = v0 + wrank * quota + i;
            if (v >= CVT_NQ) break;
            const CvtTile c = cvt_decode(F, cvt_tileq(v));
            cvt_load(c, F.lane, a0, b0);
            cvt_store(c, F.lane, a0, b0, lw);
        }
    } else {
        for (int v = v0 + wrank; v < CVT_NQ; v += nw) {
            const CvtTile c = cvt_decode(F, cvt_tileq(v));
            cvt_load(c, F.lane, a0, b0);
            cvt_store(c, F.lane, a0, b0, lw);
        }
    }
    __syncthreads();
}

__device__ __forceinline__ void ph_modpart(const Frame& F) {
    for (int it = F.bid; it < 768; it += F.G) {
        const int l = it / 384, r = it % 384, cc = r / 32, kc = r % 32;
        const int j = cc * 512 + F.tid;
        const float* wm = F.in[I_WMOD] + (size_t)l * D * 6144 + (size_t)(kc * 32) * 6144 + j;
        float wv[32];
#pragma unroll
        for (int k = 0; k < 32; ++k) wv[k] = wm[(size_t)k * 6144];
        float a0 = 0.f, a1 = 0.f;
#pragma unroll
        for (int k = 0; k < 32; ++k) { a0 += silu_f(F.in[I_C][kc * 32 + k]) * wv[k]; a1 += silu_f(F.in[I_CCTX][kc * 32 + k]) * wv[k]; }
        float* mp = F.w<float>(WS_MODP);
        mp[(size_t)((l * 2 + 0) * 32 + kc) * 6144 + j] = a0;
        mp[(size_t)((l * 2 + 1) * 32 + kc) * 6144 + j] = a1;
    }
}

__device__ __forceinline__ void ph_filter(const Frame& F) {
    LAS float* zs = (LAS float*)F.lds;
    LAS float* h1 = zs + 64 * 33;
    LAS unsigned char* H2b = F.lds + 24832;
    LAS unsigned char* ob = F.lds + 34048;
    const float min_decay = -4.605170185988091f / 1.5f, max_decay = -4.605170185988091f / 0.3f;
    const int wave = F.wave;
    for (int it = F.bid; it < 512 + 16; it += F.G) {
        int tid = F.tid; asm volatile("" : "+v"(tid));
        const int lane = tid & 63;
        const bool isctx = it >= 512;
        const int l = isctx ? 0 : it / 256, grp = isctx ? it - 512 : it % 256;
        const int Lx = isctx ? LC : L, npos = isctx ? 16 : 64;
        const int t0 = grp * npos;
        __syncthreads();
#pragma unroll 1
        for (int q = tid; q < npos * 33; q += NTHREADS) {
            const int pos = q / 33, i = q % 33; const int t = t0 + pos;
            const float tn = (float)t / (float)(Lx - 1);
            const float wv = 6.283185307179586f * (float)t / (float)Lx;
            float v;
            if (i == 0) v = tn;
            else { const int b = (i - 1) & 15; const float f = 1e-4f + (float)b * ((15.0f - 1e-4f) / 15.0f); v = (i <= 16) ? cosf(f * wv) : -sinf(f * wv); }
            zs[q] = v;
        }
        __syncthreads();
        {
            asm volatile("" : "+v"(tid));
            const int o = tid & 63, pg = tid >> 6;
            if (pg * 8 < npos) {
                float acc[8];
                const float bb = F.in[I_FB1][l * 64 + o];
#pragma unroll
                for (int p = 0; p < 8; ++p) acc[p] = bb;
#pragma unroll 3
                for (int i = 0; i < 33; ++i) { const float w = F.in[I_FW1][(size_t)l * 33 * 64 + i * 64 + o];
#pragma unroll
                    for (int p = 0; p < 8; ++p) acc[p] += zs[(pg * 8 + p) * 33 + i] * w; }
                const float fq = F.in[I_FREQ][l * 128 + o];
#pragma unroll
                for (int p = 0; p < 8; ++p) h1[(pg * 8 + p) * 64 + o] = sinf(fq * acc[p]);
            }
        }
        __syncthreads();
        {
            asm volatile("" : "+v"(tid));
            const int o = tid & 63, pg = tid >> 6;
            if (pg * 8 < npos) {
                float acc[8];
                const float bb = F.in[I_FB2][l * 64 + o];
#pragma unroll
                for (int p = 0; p < 8; ++p) acc[p] = bb;
#pragma unroll 4
                for (int i = 0; i < 64; ++i) { const float w = F.in[I_FW2][(size_t)l * 64 * 64 + i * 64 + o];
#pragma unroll
                    for (int p = 0; p < 8; ++p) acc[p] += h1[(pg * 8 + p) * 64 + i] * w; }
                const float fq = F.in[I_FREQ][l * 128 + 64 + o];
#pragma unroll
                for (int p = 0; p < 8; ++p) *(LAS bf16_t*)(H2b + (pg * 8 + p) * 144 + o * 2) = f2bf(sinf(fq * acc[p]));
            }
        }
        __syncthreads();
        {
            int r = lane & 31, hf = lane >> 5;
#pragma unroll
            for (int n = 0; n < 2; ++n) {
                asm volatile("" : "+v"(r), "+v"(hf));
                const int o = 32 * (2 * wave + n) + r, c = o & 255, dir = o >> 8;
                const float* w3 = F.in[I_FW3] + (size_t)l * 64 * 512 + o;
                f32x16 acc[2];
#pragma unroll
                for (int m = 0; m < 2; ++m)
#pragma unroll
                    for (int i = 0; i < 16; ++i) acc[m][i] = 0.f;
#pragma unroll
                for (int ks = 0; ks < 4; ++ks) {
                    float wv[8];
#pragma unroll
                    for (int e = 0; e < 8; ++e) wv[e] = w3[(size_t)(16 * ks + 8 * hf + e) * 512];
                    bf16x8 b;
#pragma unroll
                    for (int e = 0; e < 8; ++e) b[e] = (short)f2bf(wv[e]);
#pragma unroll
                    for (int m = 0; m < 2; ++m) {
                        const bf16x8 a = *(const LAS bf16x8*)(H2b + (32 * m + r) * 144 + (16 * ks + 8 * hf) * 2);
                        acc[m] = __builtin_amdgcn_mfma_f32_32x32x16_bf16(a, b, acc[m], 0, 0, 0);
                    }
                }
                const float delta = fabsf(min_decay + (float)c * ((max_decay - min_decay) / 255.0f));
                const float dstep = delta / (float)(Lx - 1);
                float asum = 0.f;
                if (!isctx) {
#pragma unroll
                    for (int m = 0; m < 2; ++m)
#pragma unroll
                        for (int rg = 0; rg < 16; ++rg) {
                            const int pos = 32 * m + (rg & 3) + 8 * (rg >> 2) + 4 * hf;
                            const float v = acc[m][rg] * __expf(-(float)(t0 + pos) * dstep);
                            asum += fabsf(v);
                            ob[o * 68 + pos] = (unsigned char)(pk_fp8x4(KR_SCALE * v, 0.f, 0.f, 0.f) & 0xFFu);
                        }
                } else {
                    float* kc = F.w<float>(WS_KCOMBC);
#pragma unroll
                    for (int rg = 0; rg < 8; ++rg) {
                        const int pos = (rg & 3) + 8 * (rg >> 2) + 4 * hf, t = t0 + pos;
                        const float v = acc[0][rg] * __expf(-(float)t * dstep);
                        asum += fabsf(v);
                        const int x = dir == 0 ? Lx - 1 + t : Lx - 1 - t;
                        if (dir == 0 || t >= 1) kc[(size_t)x * 256 + c] = v;
                    }
                }
                asum += __shfl_xor(asum, 32);
                if (hf == 0) { if (isctx) F.w<float>(WS_FPARTC)[grp * 512 + o] = asum; else F.w<float>(WS_FPART)[((size_t)l * 256 + grp) * 512 + o] = asum; }
            }
        }
        if (!isctx) {
            __syncthreads();
            unsigned char* KR = F.w<unsigned char>(WS_KR) + (size_t)l * 256 * KRL;
            asm volatile("" : "+v"(tid));
            for (int q = tid; q < 512 * 64; q += NTHREADS) {
                const int o = q >> 6, p = q & 63, c = o & 255, dir = o >> 8;
                if (dir == 0) KR[(size_t)c * KRL + (L - t0 - 63 + p)] = ob[o * 68 + 63 - p];
                else if (t0 + p >= 1) KR[(size_t)c * KRL + (L + t0 + p)] = ob[o * 68 + p];
            }
            if (grp == 0) for (int q = tid; q < 256 * 513; q += NTHREADS) { const int c = q / 513, r = q % 513; KR[(size_t)c * KRL + (r == 512 ? 0 : 2 * L + r)] = 0; }
        }
    }
}

__device__ __forceinline__ void ph_fsum(const Frame& F) {
    const int nwaves = F.G * 8;
    for (int o = F.bid * 8 + F.wave; o < 768; o += nwaves) {
        const int which = o >> 8, c = o & 255;
        float s = 0.f;
        if (which < 2) { const float* fp = F.w<float>(WS_FPART) + (size_t)which * 256 * 512;
            for (int i = F.lane; i < 256; i += 64) s += fp[(size_t)i * 512 + c] + fp[(size_t)i * 512 + 256 + c]; }
        else { const float* fp = F.w<float>(WS_FPARTC); if (F.lane < 16) s = fp[F.lane * 512 + c] + fp[F.lane * 512 + 256 + c]; }
        s = wave_sum(s);
        if (F.lane == 0) F.w<float>(WS_FSUM)[o] = 1.0f / s;
    }
}

__device__ __forceinline__ void ph_vecs(const Frame& F) {
    for (int q = F.bid * NTHREADS + F.tid; q < 2 * 2 * 6 * 1024; q += F.G * NTHREADS) {
        const int j = q & 1023, k = (q >> 10) % 6, which = ((q >> 10) / 6) & 1, l = (q >> 10) / 12;
        const float* ng = F.in[I_NORMG] + (size_t)l * 4 * 1024;
        float v;
        if (k == 0) v = ng[j] * (1.0f + mod_val(F, l, which, 1 * 1024 + j));
        else if (k == 1) v = mod_val(F, l, which, j);
        else if (k == 2) v = ng[1024 + j] * mod_val(F, l, which, 2 * 1024 + j);
        else if (k == 3) v = ng[2048 + j] * (1.0f + mod_val(F, l, which, 4 * 1024 + j));
        else if (k == 4) v = mod_val(F, l, which, 3 * 1024 + j);
        else v = ng[3072 + j] * mod_val(F, l, which, 5 * 1024 + j);
        F.w<float>(WS_VECS)[q] = v;
    }
}
__device__ __forceinline__ const float* vecs_ptr(const Frame& F, int l, int which, int k) { return F.w<float>(WS_VECS) + (size_t)((l * 2 + which) * 6 + k) * 1024; }

__device__ __forceinline__ void load_row(const float* p, int lane, f32x4 (&v)[4]) {
#pragma unroll
    for (int i = 0; i < 4; ++i) v[i] = *(const f32x4*)(p + 4 * lane + 256 * i);
}
__device__ __forceinline__ float row_rstd(const f32x4 (&v)[4]) {
    float s = 0.f;
#pragma unroll
    for (int i = 0; i < 4; ++i) s += v[i][0] * v[i][0] + v[i][1] * v[i][1] + v[i][2] * v[i][2] + v[i][3] * v[i][3];
    s = wave_sum(s);
    return rsqrtf(s * (1.0f / 1024.0f) + RMS_EPS);
}
__device__ __forceinline__ void stage_norm_vecs(const Frame& F, int l, int gain_idx, int sh_seg, int sc_seg, LAS float* dst  ) {
    for (int q = F.tid; q < 2048; q += NTHREADS) {
        const int which = q >> 10, j = q & 1023;
        const float g = F.in[I_NORMG][(l * 4 + gain_idx) * 1024 + j];
        dst[(which * 2 + 0) * 1024 + j] = g * (1.0f + mod_val(F, l, which, sc_seg * 1024 + j));
        dst[(which * 2 + 1) * 1024 + j] = mod_val(F, l, which, sh_seg * 1024 + j);
    }
}
__device__ __forceinline__ void norm_store_bf16(const f32x4 (&v)[4], float rstd, const LAS float* va, const LAS float* vb, bf16_t* orow, int lane) {
#pragma unroll
    for (int i = 0; i < 4; ++i) {
        const int c = 4 * lane + 256 * i;
        const f32x4 a = *(const LAS f32x4*)(va + c), b = *(const LAS f32x4*)(vb + c);
        u32x2 w; w.x = pk_bf16(v[i][0] * rstd * a[0] + b[0], v[i][1] * rstd * a[1] + b[1]); w.y = pk_bf16(v[i][2] * rstd * a[2] + b[2], v[i][3] * rstd * a[3] + b[3]);
        *(u32x2*)(orow + c) = w;
    }
}
__device__ __forceinline__ const float* xrow_ptr(const Frame& F, int l, int row) {
    if (l == 0) return row < L ? F.in[I_X] + (size_t)row * D : F.in[I_CTX] + (size_t)(row - L) * D;
    return F.w<float>(WS_XCUR) + (size_t)row * D;
}
__device__ __forceinline__ void ph_norm1(const Frame& F, int l) {
    LAS float* vec = (LAS float*)F.lds;
    __syncthreads();
    stage_norm_vecs(F, l, 0, 0, 1, vec);
    __syncthreads();
    const int nwaves = F.G * 8;
    for (int row = F.bid * 8 + F.wave; row < T; row += nwaves) {
        const int which = row >= L;
        f32x4 v[4]; load_row(xrow_ptr(F, l, row), F.lane, v);
        const float rstd = row_rstd(v);
        norm_store_bf16(v, rstd, vec + (which * 2) * 1024, vec + (which * 2 + 1) * 1024, F.w<bf16_t>(WS_HB) + (size_t)row * D, F.lane);
    }
}

constexpr int SROW = 272;
__device__ __forceinline__ bf16x8 lds_frag(const LAS unsigned char* base, int row, int k) { return *(const LAS bf16x8*)(base + row * SROW + k * 2); }
__device__ __forceinline__ void ph_ssd_prep(const Frame& F, int l) {
    LAS unsigned char* BT = F.lds;
    LAS unsigned char* XW = F.lds + 34816;
    LAS float* dts = (LAS float*)(F.lds + 139264);
    LAS float* wj  = dts + 768;
    const bf16_t* P = F.w<bf16_t>(WS_P);
    const int lane = F.lane, wave = F.wave;
    for (int it = F.bid; it < NCH * 2; it += F.G) {
        const int ch = it >> 1, g = it & 1;
        const int row0 = ch * 128;
        const int seq_lo = ch < 128 ? 0 : L, seq_hi = ch < 128 ? L : T;
        int r = lane & 31, hf = lane >> 5; asm volatile("" : "+v"(r), "+v"(hf));
        __syncthreads();
        if (wave < 6) {
            const int hh = wave >> 1, dir = wave & 1, h = g * 3 + hh;
            const float a = -__expf(F.in[I_ALOG][(l * 2 + dir) * 6 + h]), bias = F.in[I_DTB][(l * 2 + dir) * 6 + h];
            const int j0 = 2 * lane;
            const float d0 = softplus_f(bf2f(P[(size_t)(row0 + j0) * PC + CDT + dir * 6 + h]) + bias);
            const float d1 = softplus_f(bf2f(P[(size_t)(row0 + j0 + 1) * PC + CDT + dir * 6 + h]) + bias);
            const float pair = (d0 + d1) * a;
            float incl = pair;
#pragma unroll
            for (int o = 1; o < 64; o <<= 1) {
                const float v = dir == 0 ? __shfl_up(incl, o) : __shfl_down(incl, o);
                const bool okl = dir == 0 ? (lane >= o) : (lane + o < 64);
                if (okl) incl += v;
            }
            const float total = __shfl(incl, dir == 0 ? 63 : 0);
            float acs0, acs1;
            if (dir == 0) { acs1 = incl; acs0 = incl - d1 * a; }
            else { acs0 = incl; acs1 = incl - d0 * a; }
            float* dtv = F.w<float>(WS_DTV) + (size_t)(row0 + j0) * 12 + dir * 6 + h; dtv[0] = d0; dtv[12] = d1;
            float* acv = F.w<float>(WS_ACS) + (size_t)(row0 + j0) * 12 + dir * 6 + h; acv[0] = acs0; acv[12] = acs1;
            if (lane == 0) F.w<float>(WS_ALAST)[ch * 12 + dir * 6 + h] = total;
            dts[wave * 128 + j0] = d0; dts[wave * 128 + j0 + 1] = d1;
            wj[wave * 128 + j0] = __expf(total - acs0) * d0; wj[wave * 128 + j0 + 1] = __expf(total - acs1) * d1;
        }
        __syncthreads();
        if (F.tid < 448) {
            const int pr = F.tid % 224, half = F.tid / 224;
            const int chn = pr < 96 ? g * 192 + 2 * pr : (pr < 160 ? 384 + g * 128 + 2 * (pr - 96) : 640 + g * 128 + 2 * (pr - 160));
            const float* cw = F.in[I_SCW] + (size_t)l * 5 * 896 + chn; const float* cb = F.in[I_SCB] + (size_t)l * 896 + chn;
            float w0[5], w1[5];
#pragma unroll
            for (int k = 0; k < 5; ++k) { w0[k] = cw[k * 896]; w1[k] = cw[k * 896 + 1]; }
            const float b0 = cb[0], b1 = cb[1];
            const int jb = half * 64;
            const bf16_t* src = P + CXBC + chn;
            unsigned win[12];
#pragma unroll
            for (int k = 0; k < 4; ++k) { const int rr = row0 + jb + k - 2; win[k] = (rr >= seq_lo && rr < seq_hi) ? *(const unsigned*)(src + (size_t)rr * PC) : 0u; }
            const int hh = pr / 32;
            const int pch = 2 * (pr & 31);
            for (int jg = 0; jg < 64; jg += 8) {
#pragma unroll
                for (int k = 0; k < 8; ++k) { const int rr = row0 + jb + jg + k + 2; win[4 + k] = (rr >= seq_lo && rr < seq_hi) ? *(const unsigned*)(src + (size_t)rr * PC) : 0u; }
                float s0[8], s1[8];
#pragma unroll
                for (int u = 0; u < 8; ++u) {
                    float a0 = b0, a1 = b1;
#pragma unroll
                    for (int k = 0; k < 5; ++k) { a0 += w0[k] * bflo(win[u + k]); a1 += w1[k] * bfhi(win[u + k]); }
                    s0[u] = silu_f(a0); s1[u] = silu_f(a1);
                    *(unsigned*)(F.w<bf16_t>(WS_XBC) + (size_t)(row0 + jb + jg + u) * 896 + chn) = pk_bf16(s0[u], s1[u]);
                }
#pragma unroll
                for (int k = 0; k < 4; ++k) win[k] = win[8 + k];
#pragma unroll
                for (int u = 0; u < 8; u += 2) {
                    const int j = jb + jg + u;
                    if (pr < 96) {
#pragma unroll
                        for (int dir = 0; dir < 2; ++dir) {
                            const float wa = wj[(hh * 2 + dir) * 128 + j], wb = wj[(hh * 2 + dir) * 128 + j + 1];
                            LAS unsigned char* d = XW + ((hh * 2 + dir) * 64 + pch) * SROW + j * 2;
                            *(LAS unsigned*)d = pk_bf16(s0[u] * wa, s0[u + 1] * wb);
                            *(LAS unsigned*)(d + SROW) = pk_bf16(s1[u] * wa, s1[u + 1] * wb);
                        }
                    } else if (pr < 160) {
                        LAS unsigned char* d = BT + (2 * (pr - 96)) * SROW + j * 2;
                        *(LAS unsigned*)d = pk_bf16(s0[u], s0[u + 1]);
                        *(LAS unsigned*)(d + SROW) = pk_bf16(s1[u], s1[u + 1]);
                    }
                }
            }
        }
        __syncthreads();
        {
            const int nt = wave & 3, pt = wave >> 2;
#pragma unroll 1
            for (int hh = 0; hh < 3; ++hh) {
                const int h = g * 3 + hh;
                f32x16 a0, a1;
#pragma unroll
                for (int i = 0; i < 16; ++i) { a0[i] = 0.f; a1[i] = 0.f; }
                const LAS unsigned char* X0 = XW + (hh * 2) * 64 * SROW;
#pragma unroll
                for (int ks = 0; ks < 8; ++ks) {
                    const bf16x8 a = lds_frag(BT, 32 * nt + r, 16 * ks + 8 * hf);
                    const bf16x8 b0 = lds_frag(X0, 32 * pt + r, 16 * ks + 8 * hf), b1 = lds_frag(X0, 64 + 32 * pt + r, 16 * ks + 8 * hf);
                    a0 = __builtin_amdgcn_mfma_f32_32x32x16_bf16(a, b0, a0, 0, 0, 0);
                    a1 = __builtin_amdgcn_mfma_f32_32x32x16_bf16(a, b1, a1, 0, 0, 0);
                }
                float* s0 = F.w<float>(WS_STATES) + ((size_t)(0 * NCH + ch) * 6 + h) * 8192 + (32 * pt + r) * 128 + 32 * nt + 4 * hf;
                float* s1 = F.w<float>(WS_STATES) + ((size_t)(1 * NCH + ch) * 6 + h) * 8192 + (32 * pt + r) * 128 + 32 * nt + 4 * hf;
#pragma unroll
                for (int gq = 0; gq < 4; ++gq) { *(f32x4*)(s0 + 8 * gq) = (f32x4){a0[4 * gq], a0[4 * gq + 1], a0[4 * gq + 2], a0[4 * gq + 3]};
                                                 *(f32x4*)(s1 + 8 * gq) = (f32x4){a1[4 * gq], a1[4 * gq + 1], a1[4 * gq + 2], a1[4 * gq + 3]}; }
            }
        }
    }
}

__device__ __forceinline__ void ph_ssd_scan(const Frame& F) {
    const int per = (98304 + F.G - 1) / F.G;
    for (int q = F.tid; q < per; q += NTHREADS) {
        const int id = F.bid * per + q;
        if (id >= 98304) break;
        const int dir = id / 49152, rem = id % 49152, h = rem / 8192, e = rem % 8192;
        const float* al = F.w<float>(WS_ALAST) + dir * 6 + h;
        const float* st = F.w<float>(WS_STATES) + ((size_t)(dir * NCH) * 6 + h) * 8192 + e;
        bf16_t* ss = F.w<bf16_t>(WS_SSTART) + ((size_t)(dir * NCH) * 6 + h) * 8192 + e;
        float sacc = 0.f;
        for (int s0 = 0; s0 < NCH; s0 += 26) {
            float sv[26], dv[26]; int cv[26];
#pragma unroll
            for (int u = 0; u < 26; ++u) {
                const int step = s0 + u;
                cv[u] = dir == 0 ? (step < 2 ? 128 + step : step - 2) : 129 - step;
                sv[u] = st[(size_t)cv[u] * 6 * 8192]; dv[u] = al[cv[u] * 12];
            }
#pragma unroll
            for (int u = 0; u < 26; ++u) { ss[(size_t)cv[u] * 6 * 8192] = f2bf(sacc); sacc = sacc * __expf(dv[u]) + sv[u]; }
        }
    }
}

__device__ __forceinline__ void ph_ssd_out(const Frame& F, int l) {
    LAS unsigned char* Cs = F.lds;
    LAS unsigned char* Bs = F.lds + 34816;
    LAS unsigned char* XT = F.lds + 69632;
    LAS float* Yl = (LAS float*)F.lds;
    LAS float* af = (LAS float*)(F.lds + 98816);
    LAS float* ab = af + 384, *dtf = ab + 384, *dtb = dtf + 384;
    LAS float* red = dtb + 384;
    const bf16_t* XBC = F.w<bf16_t>(WS_XBC);
    const bf16_t* P = F.w<bf16_t>(WS_P);
    const int nch = (l == 0) ? NCH : 128;
    const int lane = F.lane, wave = F.wave, r_in = lane & 31, hf_in = lane >> 5;
    const int it_ = wave & 3, jp = wave >> 2;
    for (int it = F.bid; it < nch * 2; it += F.G) {
        const int ch = it >> 1, g = it & 1, row0 = ch * 128;
        int r = r_in, hf = hf_in; asm volatile("" : "+v"(r), "+v"(hf));
        __syncthreads();
        for (int q = F.tid; q < 128 * 16; q += NTHREADS) {
            const int row = q >> 4, piece = q & 15;
            const bf16_t* src = XBC + (size_t)(row0 + row) * 896 + g * 128 + piece * 8;
            *(LAS u32x4*)(Bs + row * SROW + piece * 16) = *(const u32x4*)(src + 384);
            *(LAS u32x4*)(Cs + row * SROW + piece * 16) = *(const u32x4*)(src + 640);
        }
        for (int q = F.tid; q < 768; q += NTHREADS) {
            const int dir = q / 384, rr = q % 384, hh = rr >> 7, j = rr & 127;
            (dir ? ab : af)[hh * 128 + j] = F.w<float>(WS_ACS)[(size_t)(row0 + j) * 12 + dir * 6 + g * 3 + hh];
            (dir ? dtb : dtf)[hh * 128 + j] = F.w<float>(WS_DTV)[(size_t)(row0 + j) * 12 + dir * 6 + g * 3 + hh];
        }
        __syncthreads();
        f32x16 G0, G1;
#pragma unroll
        for (int i = 0; i < 16; ++i) { G0[i] = 0.f; G1[i] = 0.f; }
#pragma unroll
        for (int ks = 0; ks < 8; ++ks) {
            const bf16x8 a = lds_frag(Cs, 32 * it_ + r, 16 * ks + 8 * hf);
            const bf16x8 b0 = lds_frag(Bs, 64 * jp + r, 16 * ks + 8 * hf), b1 = lds_frag(Bs, 64 * jp + 32 + r, 16 * ks + 8 * hf);
            G0 = __builtin_amdgcn_mfma_f32_32x32x16_bf16(a, b0, G0, 0, 0, 0);
            G1 = __builtin_amdgcn_mfma_f32_32x32x16_bf16(a, b1, G1, 0, 0, 0);
        }
        f32x16 yacc[3];
#pragma unroll
        for (int hh = 0; hh < 3; ++hh) {
            const int h = g * 3 + hh;
            asm volatile("" : "+v"(r), "+v"(hf));
            __syncthreads();
#pragma unroll
            for (int tl = 0; tl < 2; ++tl) {
                const int j = 64 * jp + 32 * tl + r;
                const float afj = af[hh * 128 + j], abj = ab[hh * 128 + j], dfj = dtf[hh * 128 + j], dbj = dtb[hh * 128 + j];
#pragma unroll
                for (int rg = 0; rg < 16; ++rg) {
                    const int i = 32 * it_ + (rg & 3) + 8 * (rg >> 2) + 4 * hf;
                    const float mf = fminf(fmaxf((float)(i - j + 1), 0.f), 1.f), mb = fminf(fmaxf((float)(j - i + 1), 0.f), 1.f);
                    const float wf = __expf(fminf(af[hh * 128 + i] - afj, 0.f)) * dfj * mf;
                    const float wb = __expf(fminf(ab[hh * 128 + i] - abj, 0.f)) * dbj * mb;
                    const float gv = tl == 0 ? G0[rg] : G1[rg];
                    *(LAS bf16_t*)(Bs + i * SROW + j * 2) = f2bf(gv * (wf + wb));
                }
            }
            for (int q = F.tid; q < 128 * 8; q += NTHREADS) {
                const int j = q >> 3, pg = q & 7;
                const u32x4 v = *(const u32x4*)(XBC + (size_t)(row0 + j) * 896 + h * 64 + pg * 8);
                LAS unsigned char* d = XT + (pg * 8) * SROW + j * 2;
                *(LAS bf16_t*)(d + 0 * SROW) = (bf16_t)(v.x & 0xFFFF); *(LAS bf16_t*)(d + 1 * SROW) = (bf16_t)(v.x >> 16);
                *(LAS bf16_t*)(d + 2 * SROW) = (bf16_t)(v.y & 0xFFFF); *(LAS bf16_t*)(d + 3 * SROW) = (bf16_t)(v.y >> 16);
                *(LAS bf16_t*)(d + 4 * SROW) = (bf16_t)(v.z & 0xFFFF); *(LAS bf16_t*)(d + 5 * SROW) = (bf16_t)(v.z >> 16);
                *(LAS bf16_t*)(d + 6 * SROW) = (bf16_t)(v.w & 0xFFFF); *(LAS bf16_t*)(d + 7 * SROW) = (bf16_t)(v.w >> 16);
            }
            {
                f32x16 yF, yB;
#pragma unroll
                for (int i = 0; i < 16; ++i) { yF[i] = 0.f; yB[i] = 0.f; }
                const bf16_t* Sf = F.w<bf16_t>(WS_SSTART) + ((size_t)(0 * NCH + ch) * 6 + h) * 8192 + (32 * jp + r) * 128 + 8 * hf;
                const bf16_t* Sb = F.w<bf16_t>(WS_SSTART) + ((size_t)(1 * NCH + ch) * 6 + h) * 8192 + (32 * jp + r) * 128 + 8 * hf;
#pragma unroll 2
                for (int ks = 0; ks < 8; ++ks) {
                    const bf16x8 ac = lds_frag(Cs, 32 * it_ + r, 16 * ks + 8 * hf);
                    const bf16x8 bf_ = *(const bf16x8*)(Sf + 16 * ks), bb_ = *(const bf16x8*)(Sb + 16 * ks);
                    yF = __builtin_amdgcn_mfma_f32_32x32x16_bf16(ac, bf_, yF, 0, 0, 0);
                    yB = __builtin_amdgcn_mfma_f32_32x32x16_bf16(ac, bb_, yB, 0, 0, 0);
                }
#pragma unroll
                for (int rg = 0; rg < 16; ++rg) {
                    const int i = 32 * it_ + (rg & 3) + 8 * (rg >> 2) + 4 * hf;
                    yacc[hh][rg] = __expf(af[hh * 128 + i]) * yF[rg] + __expf(ab[hh * 128 + i]) * yB[rg];
                }
            }
            __syncthreads();
#pragma unroll 2
            for (int ks = 0; ks < 8; ++ks) {
                const bf16x8 aw = lds_frag(Bs, 32 * it_ + r, 16 * ks + 8 * hf), bx = lds_frag(XT, 32 * jp + r, 16 * ks + 8 * hf);
                yacc[hh] = __builtin_amdgcn_mfma_f32_32x32x16_bf16(aw, bx, yacc[hh], 0, 0, 0);
            }
        }
        __syncthreads();
#pragma unroll
        for (int hh = 0; hh < 3; ++hh)
#pragma unroll
            for (int rg = 0; rg < 16; ++rg) { const int i = 32 * it_ + (rg & 3) + 8 * (rg >> 2) + 4 * hf; Yl[i * 193 + hh * 64 + 32 * jp + r] = yacc[hh][rg]; }
        __syncthreads();
        const int i = F.tid & 127, pq = F.tid >> 7;
        float ssq = 0.f;
#pragma unroll 1
        for (int hh = 0; hh < 3; ++hh) {
            const int h = g * 3 + hh; const float dsk = F.in[I_SSDD][l * 6 + h];
            const int chn = h * 64 + pq * 16;
            const u32x4 xa = *(const u32x4*)(XBC + (size_t)(row0 + i) * 896 + chn), xb = *(const u32x4*)(XBC + (size_t)(row0 + i) * 896 + chn + 8);
            const u32x4 za = *(const u32x4*)(P + (size_t)(row0 + i) * PC + CZ + chn), zb = *(const u32x4*)(P + (size_t)(row0 + i) * PC + CZ + chn + 8);
            const unsigned xw_[8] = {xa.x, xa.y, xa.z, xa.w, xb.x, xb.y, xb.z, xb.w}, zw_[8] = {za.x, za.y, za.z, za.w, zb.x, zb.y, zb.z, zb.w};
            LAS float* yr = Yl + i * 193 + hh * 64 + pq * 16;
#pragma unroll
            for (int p2 = 0; p2 < 8; ++p2) {
                const float v0 = (yr[2 * p2] + dsk * bflo(xw_[p2])) * silu_f(bflo(zw_[p2]));
                const float v1 = (yr[2 * p2 + 1] + dsk * bfhi(xw_[p2])) * silu_f(bfhi(zw_[p2]));
                yr[2 * p2] = v0; yr[2 * p2 + 1] = v1; ssq += v0 * v0 + v1 * v1;
            }
        }
        red[pq * 128 + i] = ssq;
        __syncthreads();
        const float tot = red[i] + red[128 + i] + red[256 + i] + red[384 + i];
        const float rstd = rsqrtf(tot * (1.0f / 192.0f) + RMS_EPS);
#pragma unroll 1
        for (int hh = 0; hh < 3; ++hh) {
            const int h = g * 3 + hh;
            bf16_t* o = F.w<bf16_t>(WS_MIX) + (size_t)(row0 + i) * D + h * 64 + pq * 16;
            const float* ng = F.in[I_SSDNG] + l * 384 + h * 64 + pq * 16;
            const LAS float* yr = Yl + i * 193 + hh * 64 + pq * 16;
            unsigned wv[8];
#pragma unroll
            for (int p2 = 0; p2 < 8; ++p2) wv[p2] = pk_bf16(yr[2 * p2] * rstd * ng[2 * p2], yr[2 * p2 + 1] * rstd * ng[2 * p2 + 1]);
            *(u32x4*)o = (u32x4){wv[0], wv[1], wv[2], wv[3]}; *(u32x4*)(o + 8) = (u32x4){wv[4], wv[5], wv[6], wv[7]};
        }
    }
}

__device__ __forceinline__ int na_kv_off(int key, int piece) { return key * 128 + ((piece ^ (key & 7)) << 4); }
__device__ __forceinline__ void na_stage_kv(const Frame& F, const bf16_t* P, LAS unsigned char* Kd, LAS unsigned char* Vd, int h, bool local, int r0, int kc0) {
    for (int q = F.tid; q < 256 * 8; q += NTHREADS) {
        const int key = q >> 3, piece = q & 7;
        const int krow = local ? (r0 + (key >> 5)) * 64 + kc0 + (key & 31) : L + key;
        const bf16_t* src = P + (size_t)krow * PC + h * 64 + piece * 8;
        *(LAS u32x4*)(Kd + na_kv_off(key, piece)) = *(const u32x4*)(src + CK);
        *(LAS u32x4*)(Vd + na_kv_off(key, piece)) = *(const u32x4*)(src + CV);
    }
}
__device__ __forceinline__ void bar_lds() { asm volatile("s_waitcnt lgkmcnt(0)" ::: "memory"); __builtin_amdgcn_s_barrier(); asm volatile("" ::: "memory"); }
struct NaItem { int h, r, cg, r0, kc0, qrow0; bool isctx; };
__device__ __forceinline__ NaItem na_item(int cid, int i_lo, int i_hi, int k) {
    NaItem t; t.isctx = (i_lo + k >= i_hi); t.r = 0; t.r0 = 0; t.kc0 = 0;
    if (!t.isctx) { const int it = i_lo + k; t.h = it >> 10; t.r = (it >> 2) & 255; t.cg = it & 3; t.r0 = min(max(t.r - 4, 0), 248); t.kc0 = min(max(16 * t.cg - 8, 0), 32); t.qrow0 = t.r * 64 + t.cg * 16; }
    else { t.h = cid >> 4; t.cg = cid & 15; t.qrow0 = L + t.cg * 16; }
    return t;
}
__device__ __forceinline__ void ph_na(const Frame& F, int l, int part) {
    LAS unsigned char* Kc = F.lds;
    LAS unsigned char* Vc = F.lds + 32768;
    LAS unsigned char* Kl = F.lds + 65536;
    LAS unsigned char* Vl = F.lds + 98304;
    LAS unsigned char* Qs = F.lds + 131072;
    LAS unsigned char* Pw = F.lds + 133120;
    LAS float* ml = (LAS float*)(F.lds + 151552);
    LAS float* bt = ml + 256;
    const bf16_t* P = F.w<bf16_t>(WS_P);
    const float* rpb = F.in[I_RPB] + (size_t)l * 15 * 31 * 6;
    const int nlat = 6 * 256 * 4;
    const int nB = (l == 0) ? 2520 : 0, nA = nlat - nB;
    const int lane = F.lane, wave = F.wave, c16 = lane & 15, kq = lane >> 4;
    const float scale = 0.125f;
    int cur_h = -1;
    const float ws = part == 0 ? (l == 0 ? 0.45f : 0.67f) : 0.0f;
    const int nP = part == 0 ? nA : nB, base = part == 0 ? 0 : nA;
    const float Wtot = 4.0f * ws + (float)(F.G - 4);
    const float W0 = F.bid < 4 ? F.bid * ws : 4.0f * ws + (float)(F.bid - 4), W1 = F.bid < 3 ? (F.bid + 1) * ws : 4.0f * ws + (float)(F.bid - 3);
    const int i_lo = base + (int)((float)nP * W0 / Wtot + 0.5f), i_hi = (F.bid == F.G - 1) ? base + nP : base + (int)((float)nP * W1 / Wtot + 0.5f);
    const int cid = (l == 0 && part == 0 && F.bid >= 100 && F.bid < 196) ? F.bid - 100 : -1;
    const int n_mine = max(0, i_hi - i_lo) + (cid >= 0 ? 1 : 0);
    u32x4 kreg[4], vreg[4], qreg; float breg = 0.f;
    const int pkey = F.tid >> 3, ppiece = F.tid & 7;
#define NA_PREFETCH(T) do { if (!(T).isctx) { _Pragma("unroll") for (int u = 0; u < 4; ++u) { const int key = pkey + 64 * u; \
            const bf16_t* src = P + (size_t)(((T).r0 + (key >> 5)) * 64 + (T).kc0 + (key & 31)) * PC + (T).h * 64 + ppiece * 8; \
            kreg[u] = *(const u32x4*)(src + CK); vreg[u] = *(const u32x4*)(src + CV); } \
            if (F.tid < 256 && (F.tid & 31) < 31) breg = rpb[(((T).r0 + (F.tid >> 5) - (T).r + 7) * 31 + (F.tid & 31)) * 6 + (T).h]; } \
        if (F.tid < 128) qreg = *(const u32x4*)(P + (size_t)((T).qrow0 + pkey) * PC + CQ + (T).h * 64 + ppiece * 8); } while (0)
    if (n_mine > 0) { const NaItem t0 = na_item(cid, i_lo, i_hi, 0); NA_PREFETCH(t0); }
    for (int k = 0; k < n_mine; ++k) {
        const NaItem t = na_item(cid, i_lo, i_hi, k);
        const bool isctx = t.isctx; const int h = t.h, cg = t.cg, kc0 = t.kc0, qrow0 = t.qrow0;
        bar_lds();
        if (h != cur_h) { na_stage_kv(F, P, Kc, Vc, h, false, 0, 0); cur_h = h; }
        if (!isctx) {
#pragma unroll
            for (int u = 0; u < 4; ++u) { const int key = pkey + 64 * u; *(LAS u32x4*)(Kl + na_kv_off(key, ppiece)) = kreg[u]; *(LAS u32x4*)(Vl + na_kv_off(key, ppiece)) = vreg[u]; }
            if (F.tid < 256) bt[F.tid] = breg;
        }
        if (F.tid < 128) *(LAS u32x4*)(Qs + na_kv_off(pkey, ppiece)) = qreg;
        if (k + 1 < n_mine) { const NaItem tn = na_item(cid, i_lo, i_hi, k + 1); NA_PREFETCH(tn); }
        bar_lds();
        const bool loc = wave < 4;
        const LAS unsigned char* Kb = loc ? Kl : Kc;
        const LAS unsigned char* Vb = loc ? Vl : Vc;
        const int kbase = (wave & 3) * 64;
        LAS unsigned char* pw = Pw + wave * 2304;
        float mw[4], lw[4];
        if (!(loc && isctx)) {
            f32x4 sacc[4];
#pragma unroll
            for (int nt = 0; nt < 4; ++nt) sacc[nt] = (f32x4){0.f, 0.f, 0.f, 0.f};
#pragma unroll
            for (int ks = 0; ks < 2; ++ks) {
                const bf16x8 a = *(const LAS bf16x8*)(Qs + na_kv_off(c16, 4 * ks + kq));
#pragma unroll
                for (int nt = 0; nt < 4; ++nt) {
                    const bf16x8 b = *(const LAS bf16x8*)(Kb + na_kv_off(kbase + 16 * nt + c16, 4 * ks + kq));
                    sacc[nt] = __builtin_amdgcn_mfma_f32_16x16x32_bf16(a, b, sacc[nt], 0, 0, 0);
                }
            }
#pragma unroll
            for (int rg = 0; rg < 4; ++rg) mw[rg] = -INFINITY;
#pragma unroll
            for (int nt = 0; nt < 4; ++nt) {
                const int kk = kbase + 16 * nt + c16;
#pragma unroll
                for (int rg = 0; rg < 4; ++rg) {
                    float sv = sacc[nt][rg] * scale;
                    if (loc) {
                        const int qi = 4 * kq + rg, qcol = cg * 16 + qi, cstart = min(max(qcol - 8, 0), 48);
                        const int krow = kk >> 5, kcol = kc0 + (kk & 31);
                        const bool ok = (kcol >= cstart) && (kcol < cstart + 16);
                        const int dc = min(max(kcol - qcol + 15, 0), 30);
                        sv = ok ? sv + bt[krow * 32 + dc] : -INFINITY;
                    }
                    sacc[nt][rg] = sv; mw[rg] = fmaxf(mw[rg], sv);
                }
            }
#pragma unroll
            for (int rg = 0; rg < 4; ++rg) {
#pragma unroll
                for (int o = 8; o >= 1; o >>= 1) mw[rg] = fmaxf(mw[rg], __shfl_xor(mw[rg], o));
                lw[rg] = 0.f;
            }
#pragma unroll
            for (int nt = 0; nt < 4; ++nt) {
#pragma unroll
                for (int rg = 0; rg < 4; ++rg) {
                    const float msafe = mw[rg] == -INFINITY ? 0.f : mw[rg];
                    const float pv = __expf(sacc[nt][rg] - msafe);
                    lw[rg] += pv;
                    *(LAS bf16_t*)(pw + (4 * kq + rg) * 144 + (16 * nt + c16) * 2) = f2bf(pv);
                }
            }
#pragma unroll
            for (int rg = 0; rg < 4; ++rg) {
#pragma unroll
                for (int o = 8; o >= 1; o >>= 1) lw[rg] += __shfl_xor(lw[rg], o);
            }
            lds_fence();
            f32x4 oacc[4];
#pragma unroll
            for (int dt = 0; dt < 4; ++dt) oacc[dt] = (f32x4){0.f, 0.f, 0.f, 0.f};
#pragma unroll
            for (int ks = 0; ks < 2; ++ks) {
                const bf16x8 a = *(const LAS bf16x8*)(pw + c16 * 144 + (32 * ks + 8 * kq) * 2);
                const int key0 = kbase + 32 * ks + 8 * kq;
#pragma unroll
                for (int dt = 0; dt < 4; ++dt) {
                    const int d = 16 * dt + c16;
                    bf16x8 b;
#pragma unroll
                    for (int e = 0; e < 8; ++e) b[e] = *(const LAS short*)(Vb + na_kv_off(key0 + e, d >> 3) + (d & 7) * 2);
                    oacc[dt] = __builtin_amdgcn_mfma_f32_16x16x32_bf16(a, b, oacc[dt], 0, 0, 0);
                }
            }
            lds_fence();
#pragma unroll
            for (int dt = 0; dt < 4; ++dt)
#pragma unroll
                for (int rg = 0; rg < 4; ++rg) *(LAS bf16_t*)(pw + (4 * kq + rg) * 144 + (16 * dt + c16) * 2) = f2bf(oacc[dt][rg]);
        } else {
#pragma unroll
            for (int rg = 0; rg < 4; ++rg) { mw[rg] = -INFINITY; lw[rg] = 0.f; }
            for (int q = lane; q < 16 * 36; q += 64) ((LAS unsigned*)pw)[q] = 0u;
        }
        if (c16 == 0) {
#pragma unroll
            for (int rg = 0; rg < 4; ++rg) { ml[(wave * 16 + 4 * kq + rg) * 2] = mw[rg]; ml[(wave * 16 + 4 * kq + rg) * 2 + 1] = lw[rg]; }
        }
        bar_lds();
        {
            const int qi = F.tid >> 5, dp = F.tid & 31;
            float M = -INFINITY;
#pragma unroll
            for (int w = 0; w < 8; ++w) M = fmaxf(M, ml[(w * 16 + qi) * 2]);
            float num0 = 0.f, num1 = 0.f, den = 0.f;
#pragma unroll
            for (int w = 0; w < 8; ++w) {
                const float sc = __expf(ml[(w * 16 + qi) * 2] - M);
                const unsigned ov = *(const LAS unsigned*)(Pw + w * 2304 + qi * 144 + dp * 4);
                num0 += sc * bflo(ov); num1 += sc * bfhi(ov); den += sc * ml[(w * 16 + qi) * 2 + 1];
            }
            const float inv = 1.0f / den;
            *(unsigned*)(F.w<bf16_t>(WS_MIX) + (size_t)(qrow0 + qi) * D + 384 + h * 64 + 2 * dp) = pk_bf16(num0 * inv, num1 * inv);
        }
    }
#undef NA_PREFETCH
}

__device__ __forceinline__ float hy_conv3(const bf16_t* P, const float* cw, const float* cb, int row, int seq_lo, int seq_hi, int col) {
    float s = cb[col];
#pragma unroll
    for (int k = 0; k < 3; ++k) { const int r = row + k - 1; if (r >= seq_lo && r < seq_hi) s += cw[k * 768 + col] * bf2f(P[(size_t)r * PC + CHY + col]); }
    return s;
}
__device__ __forceinline__ void ph_hy_prep(const Frame& F, int l) {
    const bf16_t* P = F.w<bf16_t>(WS_P);
    const float* cw = F.in[I_HCW] + (size_t)l * 3 * 768; const float* cb = F.in[I_HCB] + (size_t)l * 768;
    LAS unsigned* ut = (LAS unsigned*)F.lds;
    LAS unsigned* xt = ut + 256 * 33;
    const int cp = F.tid & 127, rq = F.tid >> 7;
    float w0[3][3], w1[3][3], b0[3], b1[3];
#pragma unroll
    for (int sg = 0; sg < 3; ++sg) { b0[sg] = cb[sg * 256 + 2 * cp]; b1[sg] = cb[sg * 256 + 2 * cp + 1];
#pragma unroll
        for (int k = 0; k < 3; ++k) { w0[sg][k] = cw[k * 768 + sg * 256 + 2 * cp]; w1[sg][k] = cw[k * 768 + sg * 256 + 2 * cp + 1]; } }
    for (int it = F.bid; it < L / 64; it += F.G) {
        const int t0 = it * 64, rb = t0 + rq * 16;
        __syncthreads();
        {
            unsigned win[3][18];
#pragma unroll
            for (int sg = 0; sg < 3; ++sg)
#pragma unroll
                for (int k = 0; k < 18; ++k) { const int rr = rb - 1 + k; win[sg][k] = (rr >= 0 && rr < L) ? *(const unsigned*)(P + (size_t)rr * PC + CHY + sg * 256 + 2 * cp) : 0u; }
#pragma unroll
            for (int jp = 0; jp < 8; ++jp) {
                float u0[2], u1[2], xa[2], xb[2];
#pragma unroll
                for (int q = 0; q < 2; ++q) {
                    const int k = 2 * jp + q;
                    float a0[3], a1[3];
#pragma unroll
                    for (int sg = 0; sg < 3; ++sg) {
                        a0[sg] = b0[sg] + w0[sg][0] * bflo(win[sg][k]) + w0[sg][1] * bflo(win[sg][k + 1]) + w0[sg][2] * bflo(win[sg][k + 2]);
                        a1[sg] = b1[sg] + w1[sg][0] * bfhi(win[sg][k]) + w1[sg][1] * bfhi(win[sg][k + 1]) + w1[sg][2] * bfhi(win[sg][k + 2]);
                    }
                    xa[q] = a0[0]; xb[q] = a1[0]; u0[q] = a0[2] * a0[1]; u1[q] = a1[2] * a1[1];
                }
                const int rp = rq * 8 + jp;
                ut[(2 * cp) * 33 + rp] = pk_bf16(u0[0], u0[1]); ut[(2 * cp + 1) * 33 + rp] = pk_bf16(u1[0], u1[1]);
                xt[(2 * cp) * 33 + rp] = pk_bf16(xa[0], xa[1]); xt[(2 * cp + 1) * 33 + rp] = pk_bf16(xb[0], xb[1]);
            }
        }
        __syncthreads();
        for (int q = F.tid; q < 256 * 8; q += NTHREADS) {
            const int c = q >> 3, g = q & 7;
            u32x4 a, b;
            a.x = ut[c * 33 + 4 * g]; a.y = ut[c * 33 + 4 * g + 1]; a.z = ut[c * 33 + 4 * g + 2]; a.w = ut[c * 33 + 4 * g + 3];
            b.x = xt[c * 33 + 4 * g]; b.y = xt[c * 33 + 4 * g + 1]; b.z = xt[c * 33 + 4 * g + 2]; b.w = xt[c * 33 + 4 * g + 3];
            *(u32x4*)(F.w<bf16_t>(WS_UT) + (size_t)c * L + t0 + 8 * g) = a;
            *(u32x4*)(F.w<bf16_t>(WS_X0T) + (size_t)c * L + t0 + 8 * g) = b;
            u32x2 a8; a8.x = pk_fp8x4(bflo(a.x), bfhi(a.x), bflo(a.y), bfhi(a.y)); a8.y = pk_fp8x4(bflo(a.z), bfhi(a.z), bflo(a.w), bfhi(a.w));
            *(u32x2*)(F.w<unsigned char>(WS_UT8) + (size_t)c * L + t0 + 8 * g) = a8;
        }
    }
    if (l == 0) {
        for (int rp = F.bid; rp < LC / 2; rp += F.G) {
            const int row = L + rp * 2 + (F.tid >> 8), c = F.tid & 255;
            const float x1 = hy_conv3(P, cw, cb, row, L, T, 256 + c), v = hy_conv3(P, cw, cb, row, L, T, 512 + c);
            F.w<float>(WS_U)[(size_t)row * 256 + c] = v * x1;
        }
    }
}
__device__ __forceinline__ void ph_hy_conv_ctx(const Frame& F, int l) {
    const bf16_t* P = F.w<bf16_t>(WS_P);
    const float* cw = F.in[I_HCW] + (size_t)l * 3 * 768; const float* cb = F.in[I_HCB] + (size_t)l * 768;
    for (int it = F.bid; it < 8; it += F.G) {
        const int Lx = LC, rbase = L;
        const int tb = it * 2 + (F.tid >> 8), c = F.tid & 255, t0 = tb * 16;
        const float* U = F.w<float>(WS_U) + (size_t)rbase * 256 + c;
        const float* KC = F.w<float>(WS_KCOMBC) + c;
        float acc[16], wreg[16];
#pragma unroll
        for (int j = 0; j < 16; ++j) { acc[j] = 0.f; wreg[j] = KC[(size_t)(t0 + j + Lx - 1) * 256]; }
        for (int s0 = 0; s0 < Lx; s0 += 16) {
            float ub[16], nb[16];
#pragma unroll
            for (int r = 0; r < 16; ++r) { ub[r] = U[(size_t)(s0 + r) * 256]; const int x = t0 - (s0 + r + 1) + Lx - 1; nb[r] = x >= 0 ? KC[(size_t)x * 256] : 0.f; }
#pragma unroll
            for (int r = 0; r < 16; ++r) {
#pragma unroll
                for (int j = 0; j < 16; ++j) acc[j] += ub[r] * wreg[(j - r) & 15];
                wreg[(15 - r) & 15] = nb[r];
            }
        }
        const float inv = F.w<float>(WS_FSUM)[2 * 256 + c];
        const float db = F.in[I_HYD][l * 256 + c];
#pragma unroll
        for (int j = 0; j < 16; ++j) {
            const int row = rbase + t0 + j;
            const float x0 = hy_conv3(P, cw, cb, row, L, T, c);
            const float u = F.w<float>(WS_U)[(size_t)row * 256 + c];
            F.w<bf16_t>(WS_MIX)[(size_t)row * D + 768 + c] = f2bf(x0 * (acc[j] * inv + u * db));
        }
    }
}

constexpr int HC_UP = 144, HC_UBYTES = 190 * HC_UP;
constexpr int HC_CPOFF = 27392, HC_NG = 83, HC_CPBYTES = 16 * HC_NG * 16;
__device__ __forceinline__ void hc_make_copies(LAS unsigned char* dst, const u32x4 g0, const u32x4 g1, int g) {
    const unsigned w[8] = {g0.x, g0.y, g0.z, g0.w, g1.x, g1.y, g1.z, g1.w};
#pragma unroll
    for (int sh = 0; sh < 16; ++sh) {
        const int b = sh >> 2, r = sh & 3;
        u32x4 o;
        if (r == 0) { o.x = w[b]; o.y = w[b + 1]; o.z = w[b + 2]; o.w = w[b + 3]; }
        else { o.x = __builtin_amdgcn_alignbyte(w[b + 1], w[b], r); o.y = __builtin_amdgcn_alignbyte(w[b + 2], w[b + 1], r);
               o.z = __builtin_amdgcn_alignbyte(w[b + 3], w[b + 2], r); o.w = __builtin_amdgcn_alignbyte(w[b + 4], w[b + 3], r); }
        *(LAS u32x4*)(dst + (sh * HC_NG + g) * 16) = o;
    }
}
__device__ __forceinline__ void ph_hy_conv(const Frame& F, int l) {
    LAS unsigned char* Ul = F.lds;
    LAS unsigned char* Cp = F.lds + HC_CPOFF;
    const int lane = F.lane, wave = F.wave;
    const int nt = wave < 4 ? wave : 7 - wave, par = wave >> 2;
    const int r = lane & 31, h = lane >> 5, sig = r & 15, rho = r >> 4;
    const int sh = (16 - sig) & 15, gofs = 2 * h - rho - (sig ? 1 : 0);
    const int a_lane = (sh * HC_NG + gofs) * 16;
    const int b_lane = r * HC_UP + h * 32;
    const int sclK = 0x79797979, sclU = ONE_E8M0;
    for (int c = F.bid; c < 256; c += F.G) {
        const unsigned char* KRc = F.w<unsigned char>(WS_KR) + ((size_t)l * 256 + c) * KRL;
        const unsigned char* U8c = F.w<unsigned char>(WS_UT8) + (size_t)c * L;
        const bf16_t* UTc = F.w<bf16_t>(WS_UT) + (size_t)c * L;
        __syncthreads();
        for (int q = F.tid; q < 190 * 8; q += NTHREADS) {
            const int blk = q >> 3, piece = q & 7;
            u32x4 v = (u32x4){0u, 0u, 0u, 0u};
            if (blk >= 31 && blk < 159) v = *(const u32x4*)(U8c + (size_t)(blk - 31) * 128 + piece * 16);
            *(LAS u32x4*)(Ul + blk * HC_UP + piece * 16) = v;
        }
        u32x4 g0 = (u32x4){0u, 0u, 0u, 0u}, g1 = g0;
        if (F.tid < HC_NG) { const unsigned char* src = KRc + 31744 + 16 * F.tid; g0 = *(const u32x4*)src; g1 = *(const u32x4*)(src + 16); }
        if (F.tid < HC_NG) hc_make_copies(Cp, g0, g1, F.tid);
        __syncthreads();
        f32x16 acc[4];
#pragma unroll
        for (int m = 0; m < 4; ++m)
#pragma unroll
            for (int i = 0; i < 16; ++i) acc[m][i] = 0.f;
        for (int ci = 0; ci < 32; ++ci) {
            const int Dc = -128 + 8 * ci;
            if (ci + 1 < 32 && F.tid < HC_NG) { const unsigned char* src = KRc + (31744 - 1024 * (ci + 1)) + 16 * F.tid; g0 = *(const u32x4*)src; g1 = *(const u32x4*)(src + 16); }
            const LAS unsigned char* cp = Cp + (ci & 1) * HC_CPBYTES + a_lane;
#pragma unroll 1
            for (int d2 = 0; d2 < 4; ++d2) {
                const int dd = 2 * d2 + par, Dv = Dc + dd;
                if (!((Dv >= 32 * nt - 127) && (Dv <= 32 * nt + 31) && (Dv > -128))) continue;
                const LAS unsigned char* ap = cp + (8 * (8 - dd)) * 16;
                const LAS unsigned char* bp = Ul + b_lane + (32 * nt - Dv + 31) * HC_UP;
                v8i af[6], bfr[2];
#pragma unroll
                for (int e = 0; e < 6; ++e) { const v4i x = *(const LAS v4i*)(ap - 2 * (e - 2) * 16), y = *(const LAS v4i*)(ap - 2 * (e - 2) * 16 + 16); af[e] = __builtin_shufflevector(x, y, 0, 1, 2, 3, 4, 5, 6, 7); }
#pragma unroll
                for (int ks = 0; ks < 2; ++ks) { const v4i x = *(const LAS v4i*)(bp + ks * 64), y = *(const LAS v4i*)(bp + ks * 64 + 16); bfr[ks] = __builtin_shufflevector(x, y, 0, 1, 2, 3, 4, 5, 6, 7); }
#pragma unroll
                for (int ks = 0; ks < 2; ++ks)
#pragma unroll
                    for (int m = 0; m < 4; ++m)
                        asm volatile("v_mfma_scale_f32_32x32x64_f8f6f4 %0, %1, %2, %0, %3, %4 op_sel_hi:[0,0,0]" : "+v"(acc[m]) : "v"(af[m - 2 * ks + 2]), "v"(bfr[ks]), "v"(sclK), "v"(sclU));
            }
            if (ci + 1 < 32 && F.tid < HC_NG) hc_make_copies(Cp + ((ci + 1) & 1) * HC_CPBYTES, g0, g1, F.tid);
            __syncthreads();
        }
        LAS float* Rd = (LAS float*)F.lds;
        if (wave >= 4) {
#pragma unroll
            for (int m = 0; m < 4; ++m)
#pragma unroll
                for (int i = 0; i < 16; ++i) Rd[(nt * 64 + m * 16 + i) * 64 + lane] = acc[m][i];
        }
        __syncthreads();
        if (wave < 4) {
#pragma unroll
            for (int m = 0; m < 4; ++m)
#pragma unroll
                for (int i = 0; i < 16; ++i) acc[m][i] += Rd[(nt * 64 + m * 16 + i) * 64 + lane];
            const float inv = F.w<float>(WS_FSUM)[l * 256 + c];
            const float db = F.in[I_HYD][l * 256 + c];
            const bf16_t* X0c = F.w<bf16_t>(WS_X0T) + (size_t)c * L;
            bf16_t* YTc = F.w<bf16_t>(WS_YT) + (size_t)c * L;
            const int I = 32 * nt + r;
#pragma unroll
            for (int m = 0; m < 4; ++m) {
#pragma unroll
                for (int g = 0; g < 4; ++g) {
                    const int t = 128 * I + 32 * m + 8 * g + 4 * h;
                    const u32x2 xv = *(const u32x2*)(X0c + t), uv = *(const u32x2*)(UTc + t);
                    float y[4];
#pragma unroll
                    for (int e = 0; e < 4; ++e) y[e] = acc[m][4 * g + e] * inv;
                    y[0] = bflo(xv.x) * (y[0] + bflo(uv.x) * db); y[1] = bfhi(xv.x) * (y[1] + bfhi(uv.x) * db);
                    y[2] = bflo(xv.y) * (y[2] + bflo(uv.y) * db); y[3] = bfhi(xv.y) * (y[3] + bfhi(uv.y) * db);
                    u32x2 o; o.x = pk_bf16(y[0], y[1]); o.y = pk_bf16(y[2], y[3]);
                    *(u32x2*)(YTc + t) = o;
                }
            }
        }
    }
}
__device__ __forceinline__ void ph_hy_tr(const Frame& F) {
    LAS unsigned* yt = (LAS unsigned*)F.lds;
    for (int it = F.bid; it < L / 64; it += F.G) {
        const int t0 = it * 64;
        __syncthreads();
        for (int q = F.tid; q < 256 * 8; q += NTHREADS) {
            const int c = q >> 3, g = q & 7;
            const u32x4 a = *(const u32x4*)(F.w<bf16_t>(WS_YT) + (size_t)c * L + t0 + 8 * g);
            yt[c * 33 + 4 * g] = a.x; yt[c * 33 + 4 * g + 1] = a.y; yt[c * 33 + 4 * g + 2] = a.z; yt[c * 33 + 4 * g + 3] = a.w;
        }
        __syncthreads();
        for (int q = F.tid; q < 64 * 32; q += NTHREADS) {
            const int row = q >> 5, cg = q & 31;
            const LAS unsigned short* ys = (const LAS unsigned short*)yt;
            unsigned short v[8];
#pragma unroll
            for (int e = 0; e < 8; ++e) v[e] = ys[((cg * 8 + e) * 33) * 2 + row];
            u32x4 o; o.x = v[0] | ((unsigned)v[1] << 16); o.y = v[2] | ((unsigned)v[3] << 16); o.z = v[4] | ((unsigned)v[5] << 16); o.w = v[6] | ((unsigned)v[7] << 16);
            *(u32x4*)(F.w<bf16_t>(WS_MIX) + (size_t)(t0 + row) * D + 768 + cg * 8) = o;
        }
    }
}

constexpr int WRP = 1028;
__device__ __forceinline__ void ph_post1(const Frame& F, int l) {
    LAS float* wr = (LAS float*)F.lds;
    LAS unsigned* lcnt = (LAS unsigned*)(F.lds + 32 * WRP * 4);
    __syncthreads();
    if (F.tid < 64) lcnt[F.tid] = 0u;
    {
        const f32x4* src = (const f32x4*)(F.in[I_WR] + (size_t)l * 1024 * 32);
        f32x4 v[16];
#pragma unroll
        for (int u = 0; u < 16; ++u) v[u] = src[F.tid + u * NTHREADS];
#pragma unroll
        for (int u = 0; u < 16; ++u) { const int q4 = F.tid + u * NTHREADS, k = q4 >> 3, e0 = (q4 & 7) * 4;
#pragma unroll
            for (int i = 0; i < 4; ++i) wr[(e0 + i) * WRP + k] = v[u][i]; }
    }
    __syncthreads();
    const int nrows = (l == 0) ? T : L;
    const int nwaves = F.G * 8, lane = F.lane;
    unsigned* cnt = F.w<unsigned>(WS_CTL) + CW_CNT + l * 1024;
    if (F.bid == 0) { for (int q = F.tid; q < D / 4; q += NTHREADS) ((unsigned*)(F.w<unsigned char>(WS_H2) + (size_t)T * D))[q] = 0u; }
    const float brl = F.in[I_BR][l * 32 + ((lane >> 1) & 31)];
    const int mye = (lane >> 1) & 31;
    for (int row0 = F.bid * 8 + F.wave; row0 < nrows; row0 += 2 * nwaves) {
        int rw[2]; bool vld[2];
        rw[0] = row0; vld[0] = true; vld[1] = (row0 + nwaves < nrows); rw[1] = vld[1] ? row0 + nwaves : row0;
        f32x4 m[2][4], x[2][4], hv[2][4];
#pragma unroll
        for (int u = 0; u < 2; ++u) { const bf16_t* mr = F.w<bf16_t>(WS_MIXO) + (size_t)rw[u] * D;
#pragma unroll
            for (int i = 0; i < 4; ++i) { const u32x2 w = *(const u32x2*)(mr + 4 * lane + 256 * i); m[u][i] = (f32x4){bflo(w.x), bfhi(w.x), bflo(w.y), bfhi(w.y)}; }
            load_row(xrow_ptr(F, l, rw[u]), lane, x[u]); }
#pragma unroll
        for (int u = 0; u < 2; ++u) {
            const int which = rw[u] >= L;
            const float* v0 = vecs_ptr(F, l, which, 2);
            const float rs1 = row_rstd(m[u]);
#pragma unroll
            for (int i = 0; i < 4; ++i) { const f32x4 a = *(const f32x4*)(v0 + 4 * lane + 256 * i); x[u][i] = x[u][i] + m[u][i] * rs1 * a; }
        }
#pragma unroll
        for (int u = 0; u < 2; ++u) {
            if (vld[u]) { float* xo = F.w<float>(WS_XCUR) + (size_t)rw[u] * D;
#pragma unroll
                for (int i = 0; i < 4; ++i) *(f32x4*)(xo + 4 * lane + 256 * i) = x[u][i]; }
        }
#pragma unroll
        for (int u = 0; u < 2; ++u) {
            const int which = rw[u] >= L;
            const float* v1 = vecs_ptr(F, l, which, 3), *v2 = vecs_ptr(F, l, which, 4);
            const float rs2 = row_rstd(x[u]);
#pragma unroll
            for (int i = 0; i < 4; ++i) { const f32x4 a = *(const f32x4*)(v1 + 4 * lane + 256 * i), b = *(const f32x4*)(v2 + 4 * lane + 256 * i); hv[u][i] = x[u][i] * rs2 * a + b; }
            if (vld[u]) { unsigned char* ho = F.w<unsigned char>(WS_H2) + (size_t)rw[u] * D;
#pragma unroll
                for (int i = 0; i < 4; ++i) *(unsigned*)(ho + 4 * lane + 256 * i) = pk_fp8x4(hv[u][i][0], hv[u][i][1], hv[u][i][2], hv[u][i][3]); }
        }
        float part[2][32];
#pragma unroll
        for (int e = 0; e < 32; ++e) {
            float s0 = 0.f, s1 = 0.f;
#pragma unroll
            for (int i = 0; i < 4; ++i) { const f32x4 w = *(const LAS f32x4*)(wr + e * WRP + 4 * lane + 256 * i);
                s0 += hv[0][i][0] * w[0] + hv[0][i][1] * w[1] + hv[0][i][2] * w[2] + hv[0][i][3] * w[3];
                s1 += hv[1][i][0] * w[0] + hv[1][i][1] * w[1] + hv[1][i][2] * w[2] + hv[1][i][3] * w[3]; }
            part[0][e] = s0; part[1][e] = s1;
        }
#pragma unroll
        for (int st = 0; st < 5; ++st) {
            const int o = 32 >> st, n = 32 >> st;
            const bool upper = (lane & o) != 0;
#pragma unroll
            for (int i = 0; i < n / 2; ++i) {
#pragma unroll
                for (int u = 0; u < 2; ++u) {
                    const float send = upper ? part[u][i] : part[u][i + n / 2];
                    const float recv = __shfl_xor(send, o);
                    const float keep = upper ? part[u][i + n / 2] : part[u][i];
                    part[u][i] = keep + recv;
                }
            }
        }
#pragma unroll
        for (int u = 0; u < 2; ++u) {
            float lg = part[u][0] + __shfl_xor(part[u][0], 1);
            lg += brl;
            int rank = 0;
#pragma unroll
            for (int e = 0; e < 32; ++e) { const float ov = __int_as_float(__builtin_amdgcn_readlane(__float_as_int(lg), 2 * e)); rank += (ov > lg || (ov == lg && e < mye)) ? 1 : 0; }
            int te[4]; float tv[4];
#pragma unroll
            for (int k = 0; k < 4; ++k) {
                const unsigned long long msk = __ballot(rank == k && (lane & 1) == 0);
                const int idx = msk ? __builtin_amdgcn_readfirstlane((int)__builtin_ctzll(msk)) : 2 * k;
                te[k] = idx >> 1; tv[k] = __int_as_float(__builtin_amdgcn_readlane(__float_as_int(lg), idx));
            }
            const float e1 = __expf(tv[1] - tv[0]), e2 = __expf(tv[2] - tv[0]), e3 = __expf(tv[3] - tv[0]);
            const float inv = 1.0f / (1.0f + e1 + e2 + e3);
            if (lane < 4 && vld[u]) {
                const int k = lane, row = rw[u];
                const int e = k == 0 ? te[0] : (k == 1 ? te[1] : (k == 2 ? te[2] : te[3]));
                const float wgt = (k == 0 ? 1.0f : (k == 1 ? e1 : (k == 2 ? e2 : e3))) * inv;
                const unsigned pos = __hip_atomic_fetch_add(lcnt + e, 1u, __ATOMIC_RELAXED, __HIP_MEMORY_SCOPE_WORKGROUP);
                F.w<int>(WS_RE)[row * 4 + k] = e; F.w<int>(WS_RP)[row * 4 + k] = (int)pos; F.w<float>(WS_RW)[row * 4 + k] = wgt;
            }
        }
    }
    __syncthreads();
    if (F.tid < 32) lcnt[32 + F.tid] = atomicAdd(cnt + F.tid * 32, lcnt[F.tid]);
    __syncthreads();
    for (int row = F.bid * 8 + F.wave; row < nrows; row += nwaves) {
        if (lane < 4) { const int a = row * 4 + lane; F.w<int>(WS_RP)[a] += (int)lcnt[32 + F.w<int>(WS_RE)[a]]; }
    }
}

__device__ __forceinline__ int expert_pad_start(const Frame& F, int l, int& ntiles) {
    const unsigned* cnt = F.w<unsigned>(WS_CTL) + CW_CNT + l * 1024;
    int c = F.lane < 32 ? (int)__hip_atomic_load(cnt + F.lane * 32, __ATOMIC_RELAXED, __HIP_MEMORY_SCOPE_AGENT) : 0;
    int padded = (c + 255) & ~255;
    int incl = padded;
#pragma unroll
    for (int o = 1; o < 32; o <<= 1) { const int v = __shfl_up(incl, o); if ((F.lane & 31) >= o) incl += v; }
    ntiles = __shfl(incl, 31) >> 8;
    return incl - padded;
}

__device__ __forceinline__ void ph_gather(const Frame& F, int l) {
    int ntiles; const int ps = expert_pad_start(F, l, ntiles);
    if (F.bid == 0 && F.wave == 0) {
        int* tab = F.w<int>(WS_CTL) + CW_TILE + l * 320;
        const int nxt = __shfl_down(ps, 1);
        const int endt = (F.lane == 31) ? ntiles : (nxt >> 8);
        if (F.lane < 32) for (int t = ps >> 8; t < endt; ++t) tab[t] = F.lane;
        if (F.lane == 0) F.w<int>(WS_CTL)[CW_NT + l] = ntiles;
    }
    const int nrows = (l == 0) ? T : L;
    for (int a0 = (F.bid * 8 + F.wave) * 64; a0 < nrows * 4; a0 += F.G * 8 * 64) {
        const int a = a0 + F.lane;
        if (a < nrows * 4) {
            const int e = F.w<int>(WS_RE)[a], pos = F.w<int>(WS_RP)[a];
            const int dst = __shfl(ps, e) + pos;
            F.w<int>(WS_SLOT)[a] = dst;
            F.w<int>(WS_ROWTOK)[(size_t)l * MAXROWS + dst] = a >> 2;
        }
    }
}

__device__ __forceinline__ void ph_final(const Frame& F, int l) {
    const int nrows = (l == 0) ? T : L;
    const int nwaves = F.G * 8, lane = F.lane;
    const bf16_t* Y = F.w<bf16_t>(WS_Y) + (size_t)l * MAXROWS * D;
    for (int row = F.bid * 8 + F.wave; row < nrows; row += nwaves) {
        const int which = row >= L;
        const float* ve = vecs_ptr(F, l, which, 5);
        f32x4 f[4];
#pragma unroll
        for (int i = 0; i < 4; ++i) f[i] = (f32x4){0.f, 0.f, 0.f, 0.f};
        int slot[4]; float wgt[4];
#pragma unroll
        for (int k = 0; k < 4; ++k) { slot[k] = F.w<int>(WS_SLOT)[row * 4 + k]; wgt[k] = F.w<float>(WS_RW)[row * 4 + k]; }
#pragma unroll
        for (int k = 0; k < 4; ++k) {
            const bf16_t* yr = Y + (size_t)slot[k] * D;
#pragma unroll
            for (int i = 0; i < 4; ++i) { const u32x2 w = *(const u32x2*)(yr + 4 * lane + 256 * i); f[i][0] += wgt[k] * bflo(w.x); f[i][1] += wgt[k] * bfhi(w.x); f[i][2] += wgt[k] * bflo(w.y); f[i][3] += wgt[k] * bfhi(w.y); }
        }
        const float rs = row_rstd(f);
        f32x4 x[4]; load_row(F.w<float>(WS_XCUR) + (size_t)row * D, lane, x);
#pragma unroll
        for (int i = 0; i < 4; ++i) { const f32x4 a = *(const f32x4*)(ve + 4 * lane + 256 * i); x[i] = x[i] + f[i] * rs * a; }
        float* xo = (l == 1) ? F.out + (size_t)row * D : F.w<float>(WS_XCUR) + (size_t)row * D;
#pragma unroll
        for (int i = 0; i < 4; ++i) *(f32x4*)(xo + 4 * lane + 256 * i) = x[i];
        if (l == 0) {
            const float rstd = row_rstd(x);
            const float* va = vecs_ptr(F, 1, which, 0), *vb = vecs_ptr(F, 1, which, 1);
            bf16_t* orow = F.w<bf16_t>(WS_HB) + (size_t)row * D;
#pragma unroll
            for (int i = 0; i < 4; ++i) {
                const int c = 4 * lane + 256 * i;
                const f32x4 a = *(const f32x4*)(va + c), b = *(const f32x4*)(vb + c);
                u32x2 w; w.x = pk_bf16(x[i][0] * rstd * a[0] + b[0], x[i][1] * rstd * a[1] + b[1]); w.y = pk_bf16(x[i][2] * rstd * a[2] + b[2], x[i][3] * rstd * a[3] + b[3]);
                *(u32x2*)(orow + c) = w;
            }
        }
    }
}

#ifndef CVQ_IN
#define CVQ_IN 5
#define CVQ_OUT 4
#endif
constexpr int PH_PER_LAYER = 10, N_PHASES = 2 + 2 * PH_PER_LAYER;
#ifndef PH_MASK
#define PH_MASK 0xFFFFFFFFu
#endif
#define EN(b) (((PH_MASK) >> (b)) & 1u)
#ifndef DUP_MASK
#define DUP_MASK 0u
#endif
#define REP(b) for (int _rep = 0; _rep < 1 + (int)(((DUP_MASK) >> (b)) & 1u); ++_rep)

__global__ void __launch_bounds__(NTHREADS, 2) mega(Args args) {
    extern __shared__ __attribute__((aligned(16))) unsigned char shm[];
    Frame F0;
    F0.in.kp = (kargp_t)__builtin_amdgcn_kernarg_segment_ptr();
    F0.out = args.out; F0.ws = args.ws; F0.lds = (LAS unsigned char*)shm;
    F0.tid = threadIdx.x; F0.lane = F0.tid & 63; F0.wave = __builtin_amdgcn_readfirstlane(F0.tid >> 6); F0.G = gridDim.x; F0.bid = blockIdx.x;
    volatile LAS unsigned* bst = (volatile LAS unsigned*)(shm + LDS_BYTES - 16);
    XcdBarrier bar; bar.bar = F0.w<unsigned>(WS_CTL) + CW_BAR; bar.x = 0; bar.st = bst;
#if N_LAUNCH_MODE == 1
    if (F0.tid == 0) { bst[0] = 0u; bst[1] = 0u; }
    __syncthreads();
    bar = xcd_barrier_post(F0.w<unsigned>(WS_CTL) + CW_BAR, bst);
#define GRID_BAR() xcd_barrier(bar)
#else
#define GRID_BAR() do {} while (0)
#endif
    const int lo = args.ph_lo, hi = args.ph_hi;
#define IN(k) (lo <= (k) && (k) < hi)
#define SEAM(k) do { if (IN(k) && IN((k) + 1)) GRID_BAR(); } while (0)

    if (IN(0)) { const Frame F = launder(F0); REP(0) ph_convert(F); REP(1) ph_modpart(F); REP(2) ph_filter(F); }
    SEAM(0);
    if (IN(1)) { const Frame F = launder(F0); REP(3) ph_norm1(F, 0); REP(4) ph_fsum(F); ph_vecs(F); }
    SEAM(1);
    for (int l = 0; l < 2; ++l) {
        const int pb = 2 + l * PH_PER_LAYER;
        if (EN(5) && IN(pb + 0)) { const Frame F = launder(F0);
            pg8::Gemm g{F.w<bf16_t>(WS_HB), F.w<bf16_t>(WS_WINT) + (size_t)l * PC * D, D};
            pg8::SchedGrid S{PC / 256, (T / 256) * (PC / 256), F.G, F.vid};
            pg8::EpiBf16 E{F.w<bf16_t>(WS_P), PC, nullptr, 0};
            REP(5) pg8::gemm_phase<pg8::EpiBf16, pg8::SchedGrid>(F.lds, g, S, E, F.tid);
            if (l == 0 && F.G == 256 && F.vid >= 77) cvt_drain(F, 0, (F.vid - 77) * 8 + F.wave, 0, CVQ_IN);
        }
        SEAM(pb + 0);
        if (IN(pb + 1)) { const Frame F = launder(F0); REP(6) ph_ssd_prep(F, l); REP(7) ph_hy_prep(F, l); REP(8) ph_na(F, l, 0); }
        SEAM(pb + 1);
        if (IN(pb + 2)) { const Frame F = launder(F0); REP(9) ph_ssd_scan(F); REP(10) { ph_hy_conv(F, l); if (l == 0) ph_hy_conv_ctx(F, l); } }
        SEAM(pb + 2);
        if (EN(11) && IN(pb + 3)) { const Frame F = launder(F0); REP(11) ph_ssd_out(F, l); REP(18) ph_hy_tr(F); if (l == 0) ph_na(F, l, 1); }
        SEAM(pb + 3);
        if (EN(12) && IN(pb + 4)) { const Frame F = launder(F0);
            pg8::Gemm g{F.w<bf16_t>(WS_MIX), F.w<bf16_t>(WS_WOUTT) + (size_t)l * D * D, D};
            const int nM = (l == 0) ? T / 256 : L / 256;
            pg8::SchedGrid S{4, nM * 4, F.G, F.vid};
            pg8::EpiBf16 E{F.w<bf16_t>(WS_MIXO), D, nullptr, 0};
            REP(12) pg8::gemm_phase<pg8::EpiBf16, pg8::SchedGrid>(F.lds, g, S, E, F.tid);
            if (l == 0 && F.G == 256 && F.vid >= 4) cvt_drain(F, 179 * 8 * CVQ_IN, (F.vid - 4) * 8 + F.wave, 0, CVQ_OUT);
        }
        SEAM(pb + 4);
        if (EN(13) && IN(pb + 5)) { const Frame F = launder(F0); ph_post1(F, l); }
        SEAM(pb + 5);
        if (EN(14) && IN(pb + 6)) { const Frame F = launder(F0); REP(14) ph_gather(F, l); if (l == 1) cvt_drain(F, F.G == 256 ? 179 * 8 * CVQ_IN + 252 * 8 * CVQ_OUT : 0, F.bid * 8 + F.wave, F.G * 8, -1); }
        SEAM(pb + 6);
        if (EN(15) && IN(pb + 7)) { const Frame F = launder(F0);
            const int* tab = F.w<int>(WS_CTL) + CW_TILE + l * 320;
            const int ntiles = __builtin_amdgcn_readfirstlane(F.w<int>(WS_CTL)[CW_NT + l]);
            pg8::Gemm g{F.w<bf16_t>(WS_H2), (const bf16_t*)(F.w<unsigned char>(WS_WGUT) + (size_t)l * NE * 2048 * D), D / 2};
            pg8::SchedMoe S{8, ntiles * 8, F.G, F.vid, tab};
            pg8::EpiAct E{F.w<unsigned char>(WS_HMID) + (size_t)l * MAXROWS * D, F.in[I_BGU] + (size_t)l * NE * 2048};
            LAS int* rowtab = (LAS int*)(F.lds + pg8::STAGE_BYTES);
            __syncthreads();
            {
                int nt_; const int ps = expert_pad_start(F, l, nt_);
                const unsigned* cnt = F.w<unsigned>(WS_CTL) + CW_CNT + l * 1024;
                for (int ui = 0; ui * F.G + F.vid < ntiles * 8 && ui < 12; ++ui) {
                    const int pa = (ui * F.G + F.vid) / 8;
                    const int e = tab[pa];
                    const int pstart = __shfl(ps, e), ce = (int)__hip_atomic_load(cnt + e * 32, __ATOMIC_RELAXED, __HIP_MEMORY_SCOPE_AGENT);
                    if (F.tid < 256) { const int prow = pa * 256 + F.tid; rowtab[ui * 256 + F.tid] = (prow - pstart < ce) ? F.w<int>(WS_ROWTOK)[(size_t)l * MAXROWS + prow] : T; }
                }
            }
            __syncthreads();
            REP(15) pg8::gemm_phase<pg8::EpiAct, pg8::SchedMoe, true, true, true>(F.lds, g, S, E, F.tid, rowtab);
        }
        SEAM(pb + 7);
        if (EN(16) && IN(pb + 8)) { const Frame F = launder(F0);
            const int* tab = F.w<int>(WS_CTL) + CW_TILE + l * 320;
            const int ntiles = __builtin_amdgcn_readfirstlane(F.w<int>(WS_CTL)[CW_NT + l]);
            pg8::Gemm g{(const bf16_t*)(F.w<unsigned char>(WS_HMID) + (size_t)l * MAXROWS * D), (const bf16_t*)(F.w<unsigned char>(WS_WDT) + (size_t)l * NE * D * D), D / 2};
            pg8::SchedMoe S{4, ntiles * 4, F.G, F.vid, tab};
            pg8::EpiBf16 E{F.w<bf16_t>(WS_Y) + (size_t)l * MAXROWS * D, D, F.in[I_BDN] + (size_t)l * NE * D, D};
            REP(16) pg8::gemm_phase<pg8::EpiBf16, pg8::SchedMoe, true, false, true>(F.lds, g, S, E, F.tid);
        }
        SEAM(pb + 8);
        if (EN(17) && IN(pb + 9)) { const Frame F = launder(F0); ph_final(F, l); }
        if (l == 0) SEAM(pb + 9);
    }
#undef IN
#undef SEAM
}

extern "C" void kernel_launch(void* const* d_in, const int* in_sizes, int n_in, void* d_out, int out_size, void* d_ws, size_t ws_size, hipStream_t stream) {
    static int grid = 0;
    if (grid == 0) {
        if (n_in != N_IN || out_size != L * D || ws_size < WS_END) { fprintf(stderr, "kernel_launch: unexpected shapes: n_in %d out %d ws %zu (need %zu)\n", n_in, out_size, ws_size, (size_t)WS_END); grid = -1; return; }
        int dev = 0, cus = 0, per_cu = 0;
        if (hipGetDevice(&dev) != hipSuccess || hipDeviceGetAttribute(&cus, hipDeviceAttributeMultiprocessorCount, dev) != hipSuccess) { grid = -1; return; }
        if (hipFuncSetAttribute((const void*)mega, hipFuncAttributeMaxDynamicSharedMemorySize, LDS_BYTES) != hipSuccess) { fprintf(stderr, "kernel_launch: hipFuncSetAttribute failed\n"); grid = -1; return; }
        if (hipOccupancyMaxActiveBlocksPerMultiprocessor(&per_cu, (const void*)mega, NTHREADS, LDS_BYTES) != hipSuccess || per_cu < 1) { fprintf(stderr, "kernel_launch: occupancy query says %d\n", per_cu); }
        (void)hipGetLastError();
        grid = cus;
    }
    if (grid < 0) return;
    (void)hipMemsetAsync((char*)d_ws + WS_CTL, 0, CTL_BYTES, stream);
    Args a{};
    for (int i = 0; i < N_IN; ++i) a.in[i] = (const float*)d_in[i];
    a.out = (float*)d_out; a.ws = (unsigned char*)d_ws;
#if N_LAUNCH_MODE == 1
    a.ph_lo = 0; a.ph_hi = N_PHASES;
    hipLaunchKernelGGL(mega, dim3(grid), dim3(NTHREADS), LDS_BYTES, stream, a);
#else
    for (int p = 0; p < N_PHASES; ++p) { a.ph_lo = p; a.ph_hi = p + 1; hipLaunchKernelGGL(mega, dim3(grid), dim3(NTHREADS), LDS_BYTES, stream, a); }
#endif
}
```

```cpp
#include <hip/hip_runtime.h>
#include <cstdio>
#include <cstdint>

#define LAS __attribute__((address_space(3)))
typedef unsigned short bf16_t;
typedef short bf16x8 __attribute__((ext_vector_type(8)));
typedef float f32x4 __attribute__((ext_vector_type(4)));
typedef float f32x16 __attribute__((ext_vector_type(16)));
typedef unsigned u32x4 __attribute__((ext_vector_type(4)));
typedef unsigned u32x2 __attribute__((ext_vector_type(2)));
typedef int v4i __attribute__((ext_vector_type(4)));
typedef int v8i __attribute__((ext_vector_type(8)));

#ifndef N_LAUNCH_MODE
#define N_LAUNCH_MODE 1
#endif

constexpr int D = 1024, L = 16384, LC = 256, T = L + LC, NCH = T / 128;
constexpr int PC = 3328;
constexpr int CZ = 0, CXBC = 384, CQ = 1280, CK = 1664, CV = 2048, CHY = 2432, CDT = 3200;
constexpr int NE = 32;
constexpr int MAXT = 292;
constexpr int MAXROWS = MAXT * 256;
constexpr int NTHREADS = 512;
constexpr int LDS_BYTES = 160 * 1024;
constexpr float RMS_EPS = 1e-6f;

enum { I_X = 0, I_C, I_CTX, I_CCTX, I_WMOD, I_BMOD, I_NORMG, I_WIN, I_SCW, I_SCB, I_ALOG, I_DTB, I_SSDD, I_SSDNG, I_RPB, I_HCW, I_HCB,
       I_FW1, I_FB1, I_FW2, I_FB2, I_FW3, I_FREQ, I_HYD, I_WOUT, I_WR, I_BR, I_WGU, I_BGU, I_WDN, I_BDN, N_IN };

constexpr size_t al256(size_t x) { return (x + 255) & ~(size_t)255; }
constexpr size_t WS_CTL   = 0;
constexpr size_t CTL_BYTES = 64 * 1024;
constexpr size_t WS_WINT  = WS_CTL + CTL_BYTES;
constexpr size_t WS_WOUTT = WS_WINT + al256((size_t)2 * PC * D * 2);
constexpr size_t WS_WGUT  = WS_WOUTT + al256((size_t)2 * D * D * 2);
constexpr size_t WS_WDT   = WS_WGUT + al256((size_t)2 * NE * 2048 * D * 2);
constexpr size_t WS_MODP  = WS_WDT + al256((size_t)2 * NE * D * D * 2);
constexpr int KRL = 2 * L + 512;
constexpr size_t WS_KR    = WS_MODP + al256((size_t)2 * 2 * 32 * 6144 * 4);
constexpr size_t WS_KCOMBC= WS_KR + al256((size_t)2 * 256 * KRL * 2);
constexpr size_t WS_FPART = WS_KCOMBC + al256((size_t)2 * LC * 256 * 4);
constexpr size_t WS_FPARTC= WS_FPART + al256((size_t)2 * 256 * 512 * 4);
constexpr size_t WS_FSUM  = WS_FPARTC + al256((size_t)16 * 512 * 4);
constexpr size_t WS_HB    = WS_FSUM + al256((size_t)3 * 256 * 4);
constexpr size_t WS_P     = WS_HB + al256((size_t)T * D * 2);
constexpr size_t WS_XBC   = WS_P + al256((size_t)T * PC * 2);
constexpr size_t WS_DTV   = WS_XBC + al256((size_t)T * 896 * 2);
constexpr size_t WS_ACS   = WS_DTV + al256((size_t)T * 12 * 4);
constexpr size_t WS_ALAST = WS_ACS + al256((size_t)T * 12 * 4);
constexpr size_t WS_STATES= WS_ALAST + al256((size_t)NCH * 12 * 4);
constexpr size_t WS_SSTART= WS_STATES + al256((size_t)2 * NCH * 6 * 128 * 64 * 4);
constexpr size_t WS_U     = WS_SSTART + al256((size_t)2 * NCH * 6 * 128 * 64 * 4);
constexpr size_t WS_UT    = WS_U + al256((size_t)T * 256 * 4);
constexpr size_t WS_UT8   = WS_UT + al256((size_t)256 * L * 2);
constexpr size_t WS_X0T   = WS_UT8 + al256((size_t)256 * L);
constexpr size_t WS_YT    = WS_X0T + al256((size_t)256 * L * 2);
constexpr size_t WS_MIX   = WS_YT + al256((size_t)256 * L * 2);
constexpr size_t WS_MIXO  = WS_MIX + al256((size_t)T * D * 2);
constexpr size_t WS_XCUR  = WS_MIXO + al256((size_t)T * D * 4);
constexpr size_t WS_H2    = WS_XCUR + al256((size_t)T * D * 4);
constexpr size_t WS_RE    = WS_H2 + al256((size_t)(T + 1) * D * 2);
constexpr size_t WS_RP    = WS_RE + al256((size_t)T * 4 * 4);
constexpr size_t WS_RW    = WS_RP + al256((size_t)T * 4 * 4);
constexpr size_t WS_SLOT  = WS_RW + al256((size_t)T * 4 * 4);
constexpr size_t WS_XG    = WS_SLOT + al256((size_t)T * 4 * 4);
constexpr size_t WS_HMID  = WS_XG + 256;
constexpr size_t WS_Y     = WS_HMID + al256((size_t)2 * MAXROWS * D * 2);
constexpr size_t WS_VECS  = WS_Y + al256((size_t)2 * MAXROWS * D * 2);
constexpr size_t WS_ROWTOK= WS_VECS + al256((size_t)2 * 2 * 6 * 1024 * 4);
constexpr size_t WS_END   = WS_ROWTOK + al256((size_t)2 * MAXROWS * 4);

constexpr int CW_BAR = 0;
constexpr int CW_CNT = 8192;
constexpr int CW_NT = 4200;
constexpr int CW_TILE = 4224;

__device__ __forceinline__ float bf2f(unsigned short b) { return __uint_as_float(((unsigned)b) << 16); }
__device__ __forceinline__ unsigned short f2bf(float f) { unsigned u = __float_as_uint(f); u += 0x7FFFu + ((u >> 16) & 1u); return (unsigned short)(u >> 16); }
__device__ __forceinline__ unsigned pk_bf16(float lo, float hi) { return (unsigned)f2bf(lo) | ((unsigned)f2bf(hi) << 16); }
__device__ __forceinline__ float sat8(float x) { return fminf(fmaxf(x, -448.0f), 448.0f); }
__device__ __forceinline__ unsigned pk_fp8x4(float a, float b, float c, float d) { unsigned w = 0; w = __builtin_amdgcn_cvt_pk_fp8_f32(sat8(a), sat8(b), w, false); w = __builtin_amdgcn_cvt_pk_fp8_f32(sat8(c), sat8(d), w, true); return w; }
constexpr float KR_SCALE = 64.0f;
constexpr float W8_SCALE = 32.0f;
constexpr int W8_SCALE_E8M0 = 0x7A7A7A7A, ONE_E8M0 = 0x7F7F7F7F;
__device__ __forceinline__ float bflo(unsigned w) { return __uint_as_float(w << 16); }
__device__ __forceinline__ float bfhi(unsigned w) { return __uint_as_float(w & 0xFFFF0000u); }
__device__ __forceinline__ float silu_f(float x) { return x / (1.0f + __expf(-x)); }
__device__ __forceinline__ float softplus_f(float x) { return x > 20.f ? x : log1pf(__expf(x)); }
__device__ __forceinline__ float wave_sum(float v) {
#pragma unroll
    for (int o = 32; o >= 1; o >>= 1) v += __shfl_xor(v, o);
    return v;
}
__device__ __forceinline__ void lds_fence() { asm volatile("s_waitcnt lgkmcnt(0)" ::: "memory"); }

#define XB_TMO      128
#define XB_XCNT(j)  (256  + 64 * (j))
#define XB_XSUB(j)  (1280 + 64 * (j))
#define XB_XGEN(j)  (2304 + 64 * (j))
#define XB_TOP      3328
#define XB_TOPGEN   3392
#define XCD_BAR_WORDS 3456
#define XB_SPIN_CAP (1u << 18)
__device__ __forceinline__ unsigned xb_ld(unsigned* p)              { return __hip_atomic_load(p, __ATOMIC_RELAXED, __HIP_MEMORY_SCOPE_AGENT); }
__device__ __forceinline__ unsigned xb_add(unsigned* p, unsigned v) { return __hip_atomic_fetch_add(p, v, __ATOMIC_RELAXED, __HIP_MEMORY_SCOPE_AGENT); }
__device__ __forceinline__ unsigned xb_xcc_id() { return (unsigned)__builtin_amdgcn_s_getreg((3 << 11) | 20) & 0xFu; }
#define XB_SPIN(cond, bar) do { unsigned _sp = 0; while (cond) { __builtin_amdgcn_s_sleep(1); \
    if ((++_sp & 255u) == 0u) { if (xb_ld(&(bar)[XB_TMO])) break; if (_sp > XB_SPIN_CAP) { atomicAdd(&(bar)[XB_TMO], 1u); break; } } } } while (0)
struct XcdBarrier { unsigned* bar; unsigned x; volatile LAS unsigned* st; };
__device__ __forceinline__ XcdBarrier xcd_barrier_post(unsigned* bar, volatile LAS unsigned* st) {
    XcdBarrier b; b.bar = bar; b.x = xb_xcc_id(); b.st = st;
    if (threadIdx.x == 0) (void)xb_add(&bar[XB_XCNT(b.x)], 1u);
    return b;
}
__device__ __forceinline__ void xcd_barrier_complete(unsigned* bar, unsigned x, unsigned& nloc, unsigned& nx) {
    const unsigned G = gridDim.x * gridDim.y * gridDim.z;
    unsigned sum, cnt, mine, sp = 0u;
    for (;;) {
        sum = 0u; cnt = 0u; mine = 0u;
#pragma unroll
        for (unsigned j = 0; j < 16; ++j) { const unsigned c = xb_ld(&bar[XB_XCNT(j)]); sum += c; cnt += (c > 0u) ? 1u : 0u; mine = (j == x) ? c : mine; }
        if (sum == G) break;
        __builtin_amdgcn_s_sleep(1);
        if ((++sp & 255u) == 0u) { if (xb_ld(&bar[XB_TMO])) break; if (sp > XB_SPIN_CAP) { atomicAdd(&bar[XB_TMO], 1u); break; } }
    }
    nloc = mine > 0u ? mine : 1u; nx = cnt > 0u ? cnt : 1u;
}
__device__ __forceinline__ void xcd_barrier(const XcdBarrier& b) {
    asm volatile("s_waitcnt vmcnt(0)" ::: "memory");
    __syncthreads();
    if (threadIdx.x == 0) {
        unsigned* bar = b.bar;
        __builtin_amdgcn_s_waitcnt(0);
        unsigned nloc = b.st[0], nx = b.st[1];
        if (nloc == 0u) { xcd_barrier_complete(bar, b.x, nloc, nx); b.st[0] = nloc; b.st[1] = nx; }
        const unsigned old = xb_add(&bar[XB_XSUB(b.x)], 1u);
        const unsigned gen = old / nloc;
        if (old + 1u == (gen + 1u) * nloc) {
            __builtin_amdgcn_fence(__ATOMIC_RELEASE, "agent");
            asm volatile("s_waitcnt vmcnt(0)" ::: "memory");
            const unsigned og = xb_add(&bar[XB_TOP], 1u);
            const unsigned tg = og / nx;
            if (og + 1u == (tg + 1u) * nx) xb_add(&bar[XB_TOPGEN], 1u);
            else XB_SPIN(xb_ld(&bar[XB_TOPGEN]) == tg, bar);
            __builtin_amdgcn_fence(__ATOMIC_ACQUIRE, "agent");
            xb_add(&bar[XB_XGEN(b.x)], 1u);
            asm volatile("s_waitcnt vmcnt(0)" ::: "memory");
        } else {
            XB_SPIN(xb_ld(&bar[XB_XGEN(b.x)]) == gen, bar);
            __builtin_amdgcn_fence(__ATOMIC_ACQUIRE, "agent");
            asm volatile("s_waitcnt vmcnt(0)" ::: "memory");
        }
    }
    __syncthreads();
}

#ifndef GEMM_REP
#define GEMM_REP 1
#endif
namespace pg8 {
constexpr int BM = 256, BK = 64, HALF = 128, HTB = HALF * BK * 2, STAGE_BYTES = 8 * HTB;
__host__ __device__ __forceinline__ int lds_byte(int r, int c) { const int st = (r >> 4) * 2 + (c >> 5), rr = r & 15, cc = c & 31, ob = rr * 64 + cc * 2; return st * 1024 + (ob ^ (((ob >> 9) & 1) << 5)); }
__host__ __device__ __forceinline__ void stage_rc(int b, int& R, int& C) { const int st = b / 1024, sb = b % 1024, swz = sb ^ (((sb >> 9) & 1) << 5); R = (st >> 1) * 16 + swz / 64; C = (st & 1) * 32 + (swz % 64) / 2; }
__host__ __device__ __forceinline__ int perm32(int rho) { const int n = rho >> 4, i = rho & 15; return 8 * (i >> 2) + 4 * n + (i & 3); }

struct Unit { int pa, pb, pn, e; };
struct Gemm { const bf16_t* A; const bf16_t* Bt; int K; };

template <class Epi, class Sched, bool ALIGN_EPI = true, bool GATHER = false, bool FP8 = false>
__device__ __forceinline__ void gemm_phase(LAS unsigned char* lds, const Gemm g, const Sched& S, const Epi& E, const int tid, const LAS int* rowtab = nullptr) {
    const int wid = __builtin_amdgcn_readfirstlane(tid >> 6), lane = tid & 63, wr = wid >> 2, wc = wid & 3, fr = lane & 15, fq = lane >> 4;
    const int K = g.K, nt = K / BK;
    unsigned voffA[2], voffB[2];
    int gR[2], gC[2];
#pragma unroll
    for (int i = 0; i < 2; ++i) { int R, C; stage_rc(tid * 16 + i * 8192, R, C); const int Rb = Epi::PERM ? ((R & ~31) + perm32(R & 31)) : R;
        voffA[i] = (unsigned)(R * K + C) * 2u; voffB[i] = (unsigned)(Rb * K + C) * 2u; gR[i] = R; gC[i] = C * 2; }
    unsigned vC0[2], vC1[2], vN0[2], vN1[2];
#define PG8_GOFFS(dst0, dst1, ui_) do { _Pragma("unroll") for (int _i = 0; _i < 2; ++_i) { \
        dst0[_i] = (unsigned)rowtab[(ui_) * 256 + gR[_i]] * (unsigned)(K * 2) + (unsigned)gC[_i]; dst1[_i] = (unsigned)rowtab[(ui_) * 256 + 128 + gR[_i]] * (unsigned)(K * 2) + (unsigned)gC[_i]; } } while (0)
    const size_t kstep = (size_t)(BK * 2);
    const size_t hstep = (size_t)HALF * K * 2;
    const size_t tstep = 2 * hstep;
    const unsigned ldsw = (unsigned)wid * 1024u;
    const int aoff = lds_byte(wr * 64 + fr, fq * 8), boff = lds_byte(wc * 32 + fr, fq * 8);
#define PG8_SA(b, h) (((b) * 2 + (h)) * HTB)
#define PG8_SB(b, h) ((4 + (b) * 2 + (h)) * HTB)
#define PG8_STAGE(bufoff, gbase, voff) do { _Pragma("unroll") for (int _i = 0; _i < 2; ++_i) \
        __builtin_amdgcn_global_load_lds((const unsigned*)((const char*)(gbase) + (voff)[_i]), (LAS unsigned*)(lds + (bufoff) + ldsw + _i * 8192), 16, 0, 0); } while (0)
#define PG8_LDA(dst, b, h) do { _Pragma("unroll") for (int m = 0; m < 4; ++m) { const v4i _x = *(const LAS v4i*)(lds + PG8_SA(b, h) + aoff + m * 2048), _y = *(const LAS v4i*)(lds + PG8_SA(b, h) + aoff + m * 2048 + 1024); \
        dst[m] = __builtin_shufflevector(_x, _y, 0, 1, 2, 3, 4, 5, 6, 7); } } while (0)
#define PG8_LDB(dst, b, h) do { _Pragma("unroll") for (int n = 0; n < 2; ++n) { const v4i _x = *(const LAS v4i*)(lds + PG8_SB(b, h) + boff + n * 2048), _y = *(const LAS v4i*)(lds + PG8_SB(b, h) + boff + n * 2048 + 1024); \
        dst[n] = __builtin_shufflevector(_x, _y, 0, 1, 2, 3, 4, 5, 6, 7); } } while (0)
#define PG8_HALF0(x) __builtin_bit_cast(bf16x8, __builtin_shufflevector((x), (x), 0, 1, 2, 3))
#define PG8_HALF1(x) __builtin_bit_cast(bf16x8, __builtin_shufflevector((x), (x), 4, 5, 6, 7))
#define PG8_MMA(ai, bj, At, Bt) do { __builtin_amdgcn_s_setprio(1); if constexpr (FP8) { _Pragma("unroll") for (int m = 0; m < 4; ++m) _Pragma("unroll") for (int n = 0; n < 2; ++n) \
        asm volatile("v_mfma_scale_f32_16x16x128_f8f6f4 %0, %1, %2, %0, %3, %4 op_sel_hi:[0,0,0]" : "+v"(acc[ai][bj][m][n]) : "v"(Bt[n]), "v"(At[m]), "v"(sclW), "v"(sclX)); } \
        else { _Pragma("unroll") for (int m = 0; m < 4; ++m) _Pragma("unroll") for (int n = 0; n < 2; ++n) { \
        acc[ai][bj][m][n] = __builtin_amdgcn_mfma_f32_16x16x32_bf16(PG8_HALF0(Bt[n]), PG8_HALF0(At[m]), acc[ai][bj][m][n], 0, 0, 0); \
        acc[ai][bj][m][n] = __builtin_amdgcn_mfma_f32_16x16x32_bf16(PG8_HALF1(Bt[n]), PG8_HALF1(At[m]), acc[ai][bj][m][n], 0, 0, 0); } } __builtin_amdgcn_s_setprio(0); } while (0)
#define PG8_WAIT_V(n) asm volatile("s_waitcnt vmcnt(" #n ")" ::: "memory")
#define PG8_WAIT_L(n) asm volatile("s_waitcnt lgkmcnt(" #n ")" ::: "memory")
#define PG8_BAR __builtin_amdgcn_s_barrier()
#define PG8_SCHED __builtin_amdgcn_sched_barrier(0)
    Unit cur, nxt; int ui = 0;
    if (!S.next(0, cur)) return;
    f32x4 acc[2][2][4][2];
    E.init(acc, cur, wc, fq);
    const int sclW = W8_SCALE_E8M0, sclX = ONE_E8M0;
    v8i At[4], B0[2], B1[2];
    const char* cA = GATHER ? (const char*)g.A : (const char*)g.A + (size_t)cur.pa * tstep; const char* cB = (const char*)g.Bt + (size_t)cur.pb * tstep;
    const size_t hstepA = GATHER ? 0 : hstep;
    if constexpr (GATHER) { PG8_GOFFS(vC0, vC1, 0); } else {
#pragma unroll
        for (int i = 0; i < 2; ++i) { vC0[i] = voffA[i]; vC1[i] = voffA[i]; vN0[i] = voffA[i]; vN1[i] = voffA[i]; } }
    PG8_STAGE(PG8_SB(0, 0), cB, voffB); PG8_STAGE(PG8_SB(0, 1), cB + hstep, voffB); PG8_STAGE(PG8_SA(0, 0), cA, vC0); PG8_STAGE(PG8_SA(0, 1), cA + hstepA, vC1);
    if (wr == 1) PG8_BAR;
    PG8_WAIT_V(2); PG8_BAR;
    PG8_STAGE(PG8_SB(1, 0), cB + kstep, voffB); PG8_STAGE(PG8_SA(1, 0), cA + kstep, vC0); PG8_STAGE(PG8_SB(1, 1), cB + hstep + kstep, voffB);
    PG8_WAIT_V(6); PG8_BAR;
    for (;;) {
        const bool has_next = S.next(ui + 1, nxt);
        const char* nA = GATHER ? (const char*)g.A : (has_next ? (const char*)g.A + (size_t)nxt.pa * tstep : cA); const char* nB = has_next ? (const char*)g.Bt + (size_t)nxt.pb * tstep : cB;
        if constexpr (GATHER) { if (has_next) { PG8_GOFFS(vN0, vN1, ui + 1); } else {
#pragma unroll
            for (int i = 0; i < 2; ++i) { vN0[i] = vC0[i]; vN1[i] = vC1[i]; } } }
#pragma unroll 1
        for (int t = 0; t < nt; t += 2) {
            const bool last = (t == nt - 2);
            unsigned vX0[2], vX1[2];
#pragma unroll
            for (int i = 0; i < 2; ++i) { vX0[i] = (GATHER && last) ? vN0[i] : vC0[i]; vX1[i] = (GATHER && last) ? vN1[i] : vC1[i]; }
            const char* a1 = cA + (size_t)(t + 1) * kstep;
            const char* a2 = last ? nA : cA + (size_t)(t + 2) * kstep; const char* b2 = last ? nB : cB + (size_t)(t + 2) * kstep;
            const char* a3 = a2 + kstep; const char* b3 = b2 + kstep;
            PG8_LDB(B0, 0, 0); PG8_LDB(B1, 0, 1); PG8_SCHED; PG8_LDA(At, 0, 0); PG8_STAGE(PG8_SA(1, 1), a1 + hstepA, vC1);
            PG8_WAIT_V(8); PG8_WAIT_L(0); PG8_BAR; PG8_MMA(0, 0, At, B0); PG8_MMA(0, 1, At, B1); PG8_BAR; PG8_SCHED;
            PG8_LDA(At, 0, 1); PG8_STAGE(PG8_SB(0, 0), b2, voffB); PG8_STAGE(PG8_SB(0, 1), b2 + hstep, voffB); PG8_STAGE(PG8_SA(0, 0), a2, vX0);
            PG8_WAIT_V(8); PG8_WAIT_L(0); PG8_BAR; PG8_MMA(1, 0, At, B0); PG8_MMA(1, 1, At, B1); PG8_BAR; PG8_SCHED;
            PG8_LDB(B0, 1, 0); PG8_LDB(B1, 1, 1); PG8_SCHED; PG8_LDA(At, 1, 0); PG8_STAGE(PG8_SA(0, 1), a2 + hstepA, vX1);
            PG8_WAIT_V(8); PG8_WAIT_L(0); PG8_BAR; PG8_MMA(0, 0, At, B0); PG8_MMA(0, 1, At, B1); PG8_BAR; PG8_SCHED;
            PG8_LDA(At, 1, 1); PG8_STAGE(PG8_SB(1, 0), b3, voffB); PG8_STAGE(PG8_SB(1, 1), b3 + hstep, voffB); PG8_STAGE(PG8_SA(1, 0), a3, vX0);
            PG8_WAIT_V(8); PG8_WAIT_L(0); PG8_BAR; PG8_MMA(1, 0, At, B0); PG8_MMA(1, 1, At, B1); PG8_BAR; PG8_SCHED;
        }
        if constexpr (ALIGN_EPI) { if (wr == 0) PG8_BAR; }
        E(acc, cur, wr, wc, fr, fq);
        if (!has_next) break;
        E.init(acc, nxt, wc, fq);
        cur = nxt; cA = nA; cB = nB; ++ui;
        if constexpr (GATHER) {
#pragma unroll
            for (int i = 0; i < 2; ++i) { vC0[i] = vN0[i]; vC1[i] = vN1[i]; } }
        if constexpr (ALIGN_EPI) { if (wr == 1) PG8_BAR; }
    }
    PG8_WAIT_V(0);
    if constexpr (!ALIGN_EPI) { if (wr == 0) PG8_BAR; }
    PG8_BAR;
#undef PG8_GOFFS
#undef PG8_HALF0
#undef PG8_HALF1
#undef PG8_SA
#undef PG8_SB
#undef PG8_STAGE
#undef PG8_LDA
#undef PG8_LDB
#undef PG8_MMA
#undef PG8_WAIT_V
#undef PG8_WAIT_L
#undef PG8_BAR
#undef PG8_SCHED
}

struct EpiF32 {
    static constexpr bool PERM = false;
    float* C; int ldc;
    __device__ __forceinline__ void operator()(const f32x4 (&acc)[2][2][4][2], const Unit& u, int wr, int wc, int fr, int fq) const {
        const int row0 = u.pa * BM + wr * 64 + fr, col0 = u.pn * BM + wc * 32 + 4 * fq;
#pragma unroll
        for (int ai = 0; ai < 2; ++ai)
#pragma unroll
            for (int m = 0; m < 4; ++m) { float* rowp = C + (size_t)(row0 + ai * HALF + m * 16) * ldc + col0;
#pragma unroll
                for (int bj = 0; bj < 2; ++bj)
#pragma unroll
                    for (int n = 0; n < 2; ++n) *(f32x4*)(rowp + bj * HALF + n * 16) = acc[ai][bj][m][n]; }
    }
};
struct EpiBf16 {
    static constexpr bool PERM = true;
    bf16_t* O; int ldc; const float* bias; int bias_stride;
    __device__ __forceinline__ void init(f32x4 (&acc)[2][2][4][2], const Unit& u, int wc, int fq) const {
        const int col0 = u.pn * BM + wc * 32 + 8 * fq;
#pragma unroll
        for (int bj = 0; bj < 2; ++bj)
#pragma unroll
            for (int n = 0; n < 2; ++n) { const f32x4 bv = bias ? *(const f32x4*)(bias + (size_t)u.e * bias_stride + col0 + bj * HALF + 4 * n) : (f32x4){0.f, 0.f, 0.f, 0.f};
#pragma unroll
                for (int ai = 0; ai < 2; ++ai)
#pragma unroll
                    for (int m = 0; m < 4; ++m) acc[ai][bj][m][n] = bv; }
    }
    __device__ __forceinline__ void operator()(const f32x4 (&acc)[2][2][4][2], const Unit& u, int wr, int wc, int fr, int fq) const {
        const int row0 = u.pa * BM + wr * 64 + fr; const int col0 = u.pn * BM + wc * 32 + 8 * fq;
#pragma unroll
        for (int ai = 0; ai < 2; ++ai)
#pragma unroll
            for (int m = 0; m < 4; ++m) { bf16_t* rowp = O + (size_t)(row0 + ai * HALF + m * 16) * ldc + col0;
#pragma unroll
                for (int bj = 0; bj < 2; ++bj) { const f32x4 v0 = acc[ai][bj][m][0], v1 = acc[ai][bj][m][1];
                    u32x4 w; w.x = pk_bf16(v0[0], v0[1]); w.y = pk_bf16(v0[2], v0[3]); w.z = pk_bf16(v1[0], v1[1]); w.w = pk_bf16(v1[2], v1[3]);
                    *(u32x4*)(rowp + bj * HALF) = w; } }
    }
};
struct EpiAct {
    static constexpr bool PERM = true;
    unsigned char* O; const float* bias;
    __device__ __forceinline__ void init(f32x4 (&acc)[2][2][4][2], const Unit& u, int wc, int fq) const {
        const float* bg = bias + (size_t)u.e * 2048 + u.pn * 128 + wc * 32 + 8 * fq;
#pragma unroll
        for (int bj = 0; bj < 2; ++bj)
#pragma unroll
            for (int n = 0; n < 2; ++n) { const f32x4 bv = *(const f32x4*)(bg + bj * 1024 + 4 * n);
#pragma unroll
                for (int ai = 0; ai < 2; ++ai)
#pragma unroll
                    for (int m = 0; m < 4; ++m) acc[ai][bj][m][n] = bv; }
    }
    __device__ __forceinline__ void operator()(const f32x4 (&acc)[2][2][4][2], const Unit& u, int wr, int wc, int fr, int fq) const {
        const int row0 = u.pa * BM + wr * 64 + fr; const int cc0 = wc * 32 + 8 * fq; const int ocol = u.pn * 128 + cc0;
#pragma unroll
        for (int ai = 0; ai < 2; ++ai)
#pragma unroll
            for (int m = 0; m < 4; ++m) { unsigned char* rowp = O + (size_t)(row0 + ai * HALF + m * 16) * D + ocol;
                float r[8];
#pragma unroll
                for (int n = 0; n < 2; ++n)
#pragma unroll
                    for (int j = 0; j < 4; ++j) { float gt = acc[ai][0][m][n][j], up = acc[ai][1][m][n][j];
                        gt = fminf(gt, 7.0f); up = fminf(fmaxf(up, -7.0f), 7.0f);
                        r[n * 4 + j] = gt / (1.0f + __expf(-1.702f * gt)) * (up + 1.0f); }
                u32x2 w; w.x = pk_fp8x4(r[0], r[1], r[2], r[3]); w.y = pk_fp8x4(r[4], r[5], r[6], r[7]);
                *(u32x2*)rowp = w; }
    }
};
struct SchedGrid {
    int nN, total, G, c;
    __device__ __forceinline__ bool next(int i, Unit& u) const { int Lx = i * G + c; if (Lx >= GEMM_REP * total) return false; if (GEMM_REP > 1) Lx %= total; u.pa = Lx / nN; u.pn = Lx - u.pa * nN; u.pb = u.pn; u.e = 0; return true; }
};
struct SchedMoe {
    int nN, total, G, c; const int* tile_e;
    __device__ __forceinline__ bool next(int i, Unit& u) const { int Lx = i * G + c; if (Lx >= GEMM_REP * total) return false; if (GEMM_REP > 1) Lx %= total; u.pa = Lx / nN; u.pn = Lx - u.pa * nN; u.e = __builtin_amdgcn_readfirstlane((int)tile_e[u.pa]); u.pb = u.e * nN + u.pn; return true; }
};
}

struct Args { const float* in[N_IN]; float* out; unsigned char* ws; int ph_lo, ph_hi; };

typedef const float* __attribute__((address_space(4))) const* kargp_t;
struct InProxy { kargp_t kp; __device__ __forceinline__ const float* operator[](int i) const { return kp[i]; } };
struct Frame {
    InProxy in; float* out; unsigned char* ws;
    LAS unsigned char* lds;
    int tid, lane, wave, G, bid, vid;
    template <class Tp> __device__ __forceinline__ Tp* w(size_t off) const { return (Tp*)(ws + off); }
};

__device__ __forceinline__ Frame launder(const Frame& F) {
    Frame R = F;
    int t = F.tid; asm volatile("" : "+v"(t)); R.tid = t; R.lane = t & 63; R.wave = __builtin_amdgcn_readfirstlane(t >> 6);
    unsigned long long w = (unsigned long long)F.ws; asm volatile("" : "+s"(w)); R.ws = (unsigned char*)w;
    unsigned long long o = (unsigned long long)F.out; asm volatile("" : "+s"(o)); R.out = (float*)o;
    unsigned long long k = (unsigned long long)F.in.kp; asm volatile("" : "+s"(k)); R.in.kp = (kargp_t)k;
    int g = F.G, b = F.bid; asm volatile("" : "+s"(g), "+s"(b)); R.G = g; R.bid = b; R.vid = (g % 8 == 0) ? (b % 8) * (g / 8) + b / 8 : b;
    return R;
}

__device__ __forceinline__ float mod_val(const Frame& F, int l, int which, int j) {
    const float* mp = F.w<float>(WS_MODP) + (size_t)((l * 2 + which) * 32) * 6144 + j;
    float s = F.in[I_BMOD][l * 6144 + j];
#pragma unroll
    for (int k = 0; k < 32; ++k) s += mp[(size_t)k * 6144];
    return s;
}

struct CvtTile { const float* src; bf16_t* dst; int ld, mode, k0, n0; bool f8; };
__device__ __forceinline__ CvtTile cvt_decode(const Frame& F, int t) {
    CvtTile c;
    if (t < 1664) { const int l = t / 832, r = t % 832; c.n0 = (r / 16) * 64; c.k0 = (r % 16) * 64; c.src = F.in[I_WIN] + (size_t)l * 1024 * 3212; c.ld = 3212; c.mode = 1; c.f8 = false; c.dst = F.w<bf16_t>(WS_WINT) + (size_t)l * PC * D; }
    else if (t < 2176) { const int q = t - 1664, l = q / 256, r = q % 256; c.n0 = (r / 16) * 64; c.k0 = (r % 16) * 64; c.src = F.in[I_WOUT] + (size_t)l * D * D; c.ld = 1024; c.mode = 0; c.f8 = false; c.dst = F.w<bf16_t>(WS_WOUTT) + (size_t)l * D * D; }
    else if (t < 34944) { const int q = t - 2176, le = q / 512, r = q % 512; c.n0 = (r / 16) * 64; c.k0 = (r % 16) * 64; c.src = F.in[I_WGU] + (size_t)le * 1024 * 2048; c.ld = 2048; c.mode = 2; c.f8 = true; c.dst = (bf16_t*)(F.w<unsigned char>(WS_WGUT) + (size_t)le * 2048 * D); }
    else { const int q = t - 34944, le = q / 256, r = q % 256; c.n0 = (r / 16) * 64; c.k0 = (r % 16) * 64; c.src = F.in[I_WDN] + (size_t)le * D * D; c.ld = 1024; c.mode = 0; c.f8 = true; c.dst = (bf16_t*)(F.w<unsigned char>(WS_WDT) + (size_t)le * D * D); }
    return c;
}
__device__ __forceinline__ void cvt_load(const CvtTile& c, int lane, f32x4 (&a)[8], f32x4 (&b)[8]) {
    const int i4 = lane & 15, kpl = lane >> 4;
    const int n = c.n0 + 4 * i4;
    int sc; bool valid = true;
    if (c.mode == 0) sc = n;
    else if (c.mode == 1) { if (n < 1280) sc = n; else if (n < 3200) sc = n + 12; else if (n < 3212) sc = n - 3200 + 1280; else { sc = 0; valid = false; } }
    else { const int pn = n >> 8, rr = n & 255; sc = rr < 128 ? pn * 128 + rr : 1024 + pn * 128 + (rr - 128); }
#pragma unroll
    for (int it = 0; it < 8; ++it) {
        const int r0 = c.f8 ? 4 * (kpl + 4 * (it >> 1)) + 2 * (it & 1) : 2 * (kpl + 4 * it);
        a[it] = (f32x4){0.f, 0.f, 0.f, 0.f}; b[it] = a[it];
        if (valid) { a[it] = __builtin_nontemporal_load((const f32x4*)(c.src + (size_t)(c.k0 + r0) * c.ld + sc)); b[it] = __builtin_nontemporal_load((const f32x4*)(c.src + (size_t)(c.k0 + r0 + 1) * c.ld + sc)); }
    }
}
__device__ __forceinline__ void cvt_store(const CvtTile& c, int lane, const f32x4 (&a)[8], const f32x4 (&b)[8], LAS unsigned* lw) {
    const int i4 = lane & 15, kpl = lane >> 4;
    if (c.f8) {
#pragma unroll
        for (int j = 0; j < 4; ++j) {
            const int kq = kpl + 4 * j;
#pragma unroll
            for (int i = 0; i < 4; ++i) lw[kq * 65 + 4 * i4 + i] = pk_fp8x4(W8_SCALE * a[2 * j][i], W8_SCALE * b[2 * j][i], W8_SCALE * a[2 * j + 1][i], W8_SCALE * b[2 * j + 1][i]);
        }
        lds_fence();
        const int g = lane & 3, nl = lane >> 2;
        unsigned char* d8 = (unsigned char*)c.dst;
#pragma unroll
        for (int it = 0; it < 4; ++it) {
            const int nn = nl + 16 * it;
            u32x4 v; v.x = lw[(4 * g + 0) * 65 + nn]; v.y = lw[(4 * g + 1) * 65 + nn]; v.z = lw[(4 * g + 2) * 65 + nn]; v.w = lw[(4 * g + 3) * 65 + nn];
            *(u32x4*)(d8 + (size_t)(c.n0 + nn) * 1024 + c.k0 + 16 * g) = v;
        }
        lds_fence();
        return;
    }
#pragma unroll
    for (int it = 0; it < 8; ++it) {
        const int kp = kpl + 4 * it;
#pragma unroll
        for (int i = 0; i < 4; ++i) lw[kp * 65 + 4 * i4 + i] = pk_bf16(a[it][i], b[it][i]);
    }
    lds_fence();
    const int g = lane & 7, nl = lane >> 3;
#pragma unroll
    for (int it = 0; it < 8; ++it) {
        const int nn = nl + 8 * it;
        u32x4 v; v.x = lw[(4 * g + 0) * 65 + nn]; v.y = lw[(4 * g + 1) * 65 + nn]; v.z = lw[(4 * g + 2) * 65 + nn]; v.w = lw[(4 * g + 3) * 65 + nn];
        *(u32x4*)(c.dst + (size_t)(c.n0 + nn) * 1024 + c.k0 + 8 * g) = v;
    }
    lds_fence();
}

__device__ __forceinline__ void cvt_store8x2(const CvtTile& c, int lane, const f32x4 (&a0)[8], const f32x4 (&b0)[8], const f32x4 (&a1)[8], const f32x4 (&b1)[8], LAS unsigned* lw) {
    const int i4 = lane & 15, kpl = lane >> 4;
#pragma unroll
    for (int j = 0; j < 4; ++j) {
        const int kq = kpl + 4 * j;
#pragma unroll
        for (int i = 0; i < 4; ++i) {
            lw[kq * 65 + 4 * i4 + i] = pk_fp8x4(W8_SCALE * a0[2 * j][i], W8_SCALE * b0[2 * j][i], W8_SCALE * a0[2 * j + 1][i], W8_SCALE * b0[2 * j + 1][i]);
            lw[(16 + kq) * 65 + 4 * i4 + i] = pk_fp8x4(W8_SCALE * a1[2 * j][i], W8_SCALE * b1[2 * j][i], W8_SCALE * a1[2 * j + 1][i], W8_SCALE * b1[2 * j + 1][i]);
        }
    }
    lds_fence();
    const int g = lane & 7, nl = lane >> 3;
    unsigned char* d8 = (unsigned char*)c.dst;
#pragma unroll
    for (int it = 0; it < 8; ++it) {
        const int nn = nl + 8 * it;
        u32x4 v; v.x = lw[(4 * g + 0) * 65 + nn]; v.y = lw[(4 * g + 1) * 65 + nn]; v.z = lw[(4 * g + 2) * 65 + nn]; v.w = lw[(4 * g + 3) * 65 + nn];
        *(u32x4*)(d8 + (size_t)(c.n0 + nn) * 1024 + c.k0 + 16 * g) = v;
    }
    lds_fence();
}
__device__ __forceinline__ void ph_convert(const Frame& F) {
    LAS unsigned* lw = (LAS unsigned*)(F.lds) + F.wave * (32 * 65 + 16);
    const int nwaves = F.G * 8, w0 = F.bid * 8 + F.wave;
    f32x4 a0[8], b0[8], a1[8], b1[8];
    for (int t = w0; t < 2176; t += nwaves) { const CvtTile c = cvt_decode(F, t); cvt_load(c, F.lane, a0, b0); cvt_store(c, F.lane, a0, b0, lw); }
    for (int t = w0; t < 16384 + 8192; t += nwaves) {
        CvtTile c; c.f8 = true;
        if (t < 16384) { const int le = t >> 8, r = t & 255; c.n0 = (r >> 3) * 64; c.k0 = (r & 7) * 128; c.src = F.in[I_WGU] + (size_t)le * 1024 * 2048; c.ld = 2048; c.mode = 2; c.dst = (bf16_t*)(F.w<unsigned char>(WS_WGUT) + (size_t)le * 2048 * D); }
        else { const int q = t - 16384, le = q >> 7, r = q & 127; c.n0 = (r >> 3) * 64; c.k0 = (r & 7) * 128; c.src = F.in[I_WDN] + (size_t)le * D * D; c.ld = 1024; c.mode = 0; c.dst = (bf16_t*)(F.w<unsigned char>(WS_WDT) + (size_t)le * D * D); }
        cvt_load(c, F.lane, a0, b0);
        CvtTile c2 = c; c2.k0 = c.k0 + 64;
        cvt_load(c2, F.lane, a1, b1);
        cvt_store8x2(c, F.lane, a0, b0, a1, b1, lw);
    }
}

__device__ __forceinline__ void ph_modpart(const Frame& F) {
    for (int it = F.bid; it < 768; it += F.G) {
        const int l = it / 384, r = it % 384, cc = r / 32, kc = r % 32;
        const int j = cc * 512 + F.tid;
        const float* wm = F.in[I_WMOD] + (size_t)l * D * 6144 + (size_t)(kc * 32) * 6144 + j;
        float wv[32];
#pragma unroll
        for (int k = 0; k < 32; ++k) wv[k] = wm[(size_t)k * 6144];
        float a0 = 0.f, a1 = 0.f;
#pragma unroll
        for (int k = 0; k < 32; ++k) { a0 += silu_f(F.in[I_C][kc * 32 + k]) * wv[k]; a1 += silu_f(F.in[I_CCTX][kc * 32 + k]) * wv[k]; }
        float* mp = F.w<float>(WS_MODP);
        mp[(size_t)((l * 2 + 0) * 32 + kc) * 6144 + j] = a0;
        mp[(size_t)((l * 2 + 1) * 32 + kc) * 6144 + j] = a1;
    }
}

__device__ __forceinline__ void ph_filter(const Frame& F) {
    LAS float* zs = (LAS float*)F.lds;
    LAS float* h1 = zs + 64 * 33;
    LAS unsigned char* H2b = F.lds + 24832;
    LAS unsigned char* ob = F.lds + 34048;
    const float min_decay = -4.605170185988091f / 1.5f, max_decay = -4.605170185988091f / 0.3f;
    const int wave = F.wave;
    for (int it = F.bid; it < 512 + 16; it += F.G) {
        int tid = F.tid; asm volatile("" : "+v"(tid));
        const int lane = tid & 63;
        const bool isctx = it >= 512;
        const int l = isctx ? 0 : it / 256, grp = isctx ? it - 512 : it % 256;
        const int Lx = isctx ? LC : L, npos = isctx ? 16 : 64;
        const int t0 = grp * npos;
        __syncthreads();
#pragma unroll 1
        for (int q = tid; q < npos * 33; q += NTHREADS) {
            const int pos = q / 33, i = q % 33; const int t = t0 + pos;
            const float tn = (float)t / (float)(Lx - 1);
            const float wv = 6.283185307179586f * (float)t / (float)Lx;
            float v;
            if (i == 0) v = tn;
            else { const int b = (i - 1) & 15; const float f = 1e-4f + (float)b * ((15.0f - 1e-4f) / 15.0f); v = (i <= 16) ? cosf(f * wv) : -sinf(f * wv); }
            zs[q] = v;
        }
        __syncthreads();
        {
            asm volatile("" : "+v"(tid));
            const int o = tid & 63, pg = tid >> 6;
            if (pg * 8 < npos) {
                float acc[8];
                const float bb = F.in[I_FB1][l * 64 + o];
#pragma unroll
                for (int p = 0; p < 8; ++p) acc[p] = bb;
#pragma unroll 3
                for (int i = 0; i < 33; ++i) { const float w = F.in[I_FW1][(size_t)l * 33 * 64 + i * 64 + o];
#pragma unroll
                    for (int p = 0; p < 8; ++p) acc[p] += zs[(pg * 8 + p) * 33 + i] * w; }
                const float fq = F.in[I_FREQ][l * 128 + o];
#pragma unroll
                for (int p = 0; p < 8; ++p) h1[(pg * 8 + p) * 64 + o] = sinf(fq * acc[p]);
            }
        }
        __syncthreads();
        {
            asm volatile("" : "+v"(tid));
            const int o = tid & 63, pg = tid >> 6;
            if (pg * 8 < npos) {
                float acc[8];
                const float bb = F.in[I_FB2][l * 64 + o];
#pragma unroll
                for (int p = 0; p < 8; ++p) acc[p] = bb;
#pragma unroll 4
                for (int i = 0; i < 64; ++i) { const float w = F.in[I_FW2][(size_t)l * 64 * 64 + i * 64 + o];
#pragma unroll
                    for (int p = 0; p < 8; ++p) acc[p] += h1[(pg * 8 + p) * 64 + i] * w; }
                const float fq = F.in[I_FREQ][l * 128 + 64 + o];
#pragma unroll
                for (int p = 0; p < 8; ++p) *(LAS bf16_t*)(H2b + (pg * 8 + p) * 144 + o * 2) = f2bf(sinf(fq * acc[p]));
            }
        }
        __syncthreads();
        {
            int r = lane & 31, hf = lane >> 5;
#pragma unroll
            for (int n = 0; n < 2; ++n) {
                asm volatile("" : "+v"(r), "+v"(hf));
                const int o = 32 * (2 * wave + n) + r, c = o & 255, dir = o >> 8;
                const float* w3 = F.in[I_FW3] + (size_t)l * 64 * 512 + o;
                f32x16 acc[2];
#pragma unroll
                for (int m = 0; m < 2; ++m)
#pragma unroll
                    for (int i = 0; i < 16; ++i) acc[m][i] = 0.f;
#pragma unroll
                for (int ks = 0; ks < 4; ++ks) {
                    float wv[8];
#pragma unroll
                    for (int e = 0; e < 8; ++e) wv[e] = w3[(size_t)(16 * ks + 8 * hf + e) * 512];
                    bf16x8 b;
#pragma unroll
                    for (int e = 0; e < 8; ++e) b[e] = (short)f2bf(wv[e]);
#pragma unroll
                    for (int m = 0; m < 2; ++m) {
                        const bf16x8 a = *(const LAS bf16x8*)(H2b + (32 * m + r) * 144 + (16 * ks + 8 * hf) * 2);
                        acc[m] = __builtin_amdgcn_mfma_f32_32x32x16_bf16(a, b, acc[m], 0, 0, 0);
                    }
                }
                const float delta = fabsf(min_decay + (float)c * ((max_decay - min_decay) / 255.0f));
                const float dstep = delta / (float)(Lx - 1);
                float asum = 0.f;
                if (!isctx) {
#pragma unroll
                    for (int m = 0; m < 2; ++m)
#pragma unroll
                        for (int rg = 0; rg < 16; ++rg) {
                            const int pos = 32 * m + (rg & 3) + 8 * (rg >> 2) + 4 * hf;
                            const float v = acc[m][rg] * __expf(-(float)(t0 + pos) * dstep);
                            asum += fabsf(v);
                            ob[o * 68 + pos] = (unsigned char)(pk_fp8x4(KR_SCALE * v, 0.f, 0.f, 0.f) & 0xFFu);
                        }
                } else {
                    float* kc = F.w<float>(WS_KCOMBC);
#pragma unroll
                    for (int rg = 0; rg < 8; ++rg) {
                        const int pos = (rg & 3) + 8 * (rg >> 2) + 4 * hf, t = t0 + pos;
                        const float v = acc[0][rg] * __expf(-(float)t * dstep);
                        asum += fabsf(v);
                        const int x = dir == 0 ? Lx - 1 + t : Lx - 1 - t;
                        if (dir == 0 || t >= 1) kc[(size_t)x * 256 + c] = v;
                    }
                }
                asum += __shfl_xor(asum, 32);
                if (hf == 0) { if (isctx) F.w<float>(WS_FPARTC)[grp * 512 + o] = asum; else F.w<float>(WS_FPART)[((size_t)l * 256 + grp) * 512 + o] = asum; }
            }
        }
        if (!isctx) {
            __syncthreads();
            unsigned char* KR = F.w<unsigned char>(WS_KR) + (size_t)l * 256 * KRL;
            asm volatile("" : "+v"(tid));
            for (int q = tid; q < 512 * 64; q += NTHREADS) {
                const int o = q >> 6, p = q & 63, c = o & 255, dir = o >> 8;
                if (dir == 0) KR[(size_t)c * KRL + (L - t0 - 63 + p)] = ob[o * 68 + 63 - p];
                else if (t0 + p >= 1) KR[(size_t)c * KRL + (L + t0 + p)] = ob[o * 68 + p];
            }
            if (grp == 0) for (int q = tid; q < 256 * 513; q += NTHREADS) { const int c = q / 513, r = q % 513; KR[(size_t)c * KRL + (r == 512 ? 0 : 2 * L + r)] = 0; }
        }
    }
}

__device__ __forceinline__ void ph_fsum(const Frame& F) {
    const int nwaves = F.G * 8;
    for (int o = F.bid * 8 + F.wave; o < 768; o += nwaves) {
        const int which = o >> 8, c = o & 255;
        float s = 0.f;
        if (which < 2) { const float* fp = F.w<float>(WS_FPART) + (size_t)which * 256 * 512;
            for (int i = F.lane; i < 256; i += 64) s += fp[(size_t)i * 512 + c] + fp[(size_t)i * 512 + 256 + c]; }
        else { const float* fp = F.w<float>(WS_FPARTC); if (F.lane < 16) s = fp[F.lane * 512 + c] + fp[F.lane * 512 + 256 + c]; }
        s = wave_sum(s);
        if (F.lane == 0) F.w<float>(WS_FSUM)[o] = 1.0f / s;
    }
}

__device__ __forceinline__ void ph_vecs(const Frame& F) {
    for (int q = F.bid * NTHREADS + F.tid; q < 2 * 2 * 6 * 1024; q += F.G * NTHREADS) {
        const int j = q & 1023, k = (q >> 10) % 6, which = ((q >> 10) / 6) & 1, l = (q >> 10) / 12;
        const float* ng = F.in[I_NORMG] + (size_t)l * 4 * 1024;
        float v;
        if (k == 0) v = ng[j] * (1.0f + mod_val(F, l, which, 1 * 1024 + j));
        else if (k == 1) v = mod_val(F, l, which, j);
        else if (k == 2) v = ng[1024 + j] * mod_val(F, l, which, 2 * 1024 + j);
        else if (k == 3) v = ng[2048 + j] * (1.0f + mod_val(F, l, which, 4 * 1024 + j));
        else if (k == 4) v = mod_val(F, l, which, 3 * 1024 + j);
        else v = ng[3072 + j] * mod_val(F, l, which, 5 * 1024 + j);
        F.w<float>(WS_VECS)[q] = v;
    }
}
__device__ __forceinline__ const float* vecs_ptr(const Frame& F, int l, int which, int k) { return F.w<float>(WS_VECS) + (size_t)((l * 2 + which) * 6 + k) * 1024; }

__device__ __forceinline__ void load_row(const float* p, int lane, f32x4 (&v)[4]) {
#pragma unroll
    for (int i = 0; i < 4; ++i) v[i] = *(const f32x4*)(p + 4 * lane + 256 * i);
}
__device__ __forceinline__ float row_rstd(const f32x4 (&v)[4]) {
    float s = 0.f;
#pragma unroll
    for (int i = 0; i < 4; ++i) s += v[i][0] * v[i][0] + v[i][1] * v[i][1] + v[i][2] * v[i][2] + v[i][3] * v[i][3];
    s = wave_sum(s);
    return rsqrtf(s * (1.0f / 1024.0f) + RMS_EPS);
}
__device__ __forceinline__ void stage_norm_vecs(const Frame& F, int l, int gain_idx, int sh_seg, int sc_seg, LAS float* dst  ) {
    for (int q = F.tid; q < 2048; q += NTHREADS) {
        const int which = q >> 10, j = q & 1023;
        const float g = F.in[I_NORMG][(l * 4 + gain_idx) * 1024 + j];
        dst[(which * 2 + 0) * 1024 + j] = g * (1.0f + mod_val(F, l, which, sc_seg * 1024 + j));
        dst[(which * 2 + 1) * 1024 + j] = mod_val(F, l, which, sh_seg * 1024 + j);
    }
}
__device__ __forceinline__ void norm_store_bf16(const f32x4 (&v)[4], float rstd, const LAS float* va, const LAS float* vb, bf16_t* orow, int lane) {
#pragma unroll
    for (int i = 0; i < 4; ++i) {
        const int c = 4 * lane + 256 * i;
        const f32x4 a = *(const LAS f32x4*)(va + c), b = *(const LAS f32x4*)(vb + c);
        u32x2 w; w.x = pk_bf16(v[i][0] * rstd * a[0] + b[0], v[i][1] * rstd * a[1] + b[1]); w.y = pk_bf16(v[i][2] * rstd * a[2] + b[2], v[i][3] * rstd * a[3] + b[3]);
        *(u32x2*)(orow + c) = w;
    }
}
__device__ __forceinline__ const float* xrow_ptr(const Frame& F, int l, int row) {
    if (l == 0) return row < L ? F.in[I_X] + (size_t)row * D : F.in[I_CTX] + (size_t)(row - L) * D;
    return F.w<float>(WS_XCUR) + (size_t)row * D;
}
__device__ __forceinline__ void load_xrow(const Frame& F, int l, int row, int lane, f32x4 (&v)[4]) {
    if (l == 0) { load_row(row < L ? F.in[I_X] + (size_t)row * D : F.in[I_CTX] + (size_t)(row - L) * D, lane, v); return; }
    const bf16_t* p = F.w<bf16_t>(WS_XCUR) + (size_t)row * D;
#pragma unroll
    for (int i = 0; i < 4; ++i) { const u32x2 w = *(const u32x2*)(p + 4 * lane + 256 * i); v[i] = (f32x4){bflo(w.x), bfhi(w.x), bflo(w.y), bfhi(w.y)}; }
}
__device__ __forceinline__ void store_xrow_bf16(bf16_t* p, int lane, const f32x4 (&v)[4]) {
#pragma unroll
    for (int i = 0; i < 4; ++i) { u32x2 w; w.x = pk_bf16(v[i][0], v[i][1]); w.y = pk_bf16(v[i][2], v[i][3]); *(u32x2*)(p + 4 * lane + 256 * i) = w; }
}
__device__ __forceinline__ void ph_norm1(const Frame& F, int l) {
    LAS float* vec = (LAS float*)F.lds;
    __syncthreads();
    stage_norm_vecs(F, l, 0, 0, 1, vec);
    __syncthreads();
    const int nwaves = F.G * 8;
    for (int row = F.bid * 8 + F.wave; row < T; row += nwaves) {
        const int which = row >= L;
        f32x4 v[4]; load_row(xrow_ptr(F, l, row), F.lane, v);
        const float rstd = row_rstd(v);
        norm_store_bf16(v, rstd, vec + (which * 2) * 1024, vec + (which * 2 + 1) * 1024, F.w<bf16_t>(WS_HB) + (size_t)row * D, F.lane);
    }
}

constexpr int SROW = 272;
__device__ __forceinline__ bf16x8 lds_frag(const LAS unsigned char* base, int row, int k) { return *(const LAS bf16x8*)(base + row * SROW + k * 2); }
__device__ __forceinline__ void ph_ssd_prep(const Frame& F, int l) {
    LAS unsigned char* BT = F.lds;
    LAS unsigned char* XW = F.lds + 34816;
    LAS float* dts = (LAS float*)(F.lds + 139264);
    LAS float* wj  = dts + 768;
    const bf16_t* P = F.w<bf16_t>(WS_P);
    const int lane = F.lane, wave = F.wave;
    for (int it = F.bid; it < NCH * 2; it += F.G) {
        const int ch = it >> 1, g = it & 1;
        const int row0 = ch * 128;
        const int seq_lo = ch < 128 ? 0 : L, seq_hi = ch < 128 ? L : T;
        int r = lane & 31, hf = lane >> 5; asm volatile("" : "+v"(r), "+v"(hf));
        __syncthreads();
        if (wave < 6) {
            const int hh = wave >> 1, dir = wave & 1, h = g * 3 + hh;
            const float a = -__expf(F.in[I_ALOG][(l * 2 + dir) * 6 + h]), bias = F.in[I_DTB][(l * 2 + dir) * 6 + h];
            const int j0 = 2 * lane;
            const float d0 = softplus_f(bf2f(P[(size_t)(row0 + j0) * PC + CDT + dir * 6 + h]) + bias);
            const float d1 = softplus_f(bf2f(P[(size_t)(row0 + j0 + 1) * PC + CDT + dir * 6 + h]) + bias);
            const float pair = (d0 + d1) * a;
            float incl = pair;
#pragma unroll
            for (int o = 1; o < 64; o <<= 1) {
                const float v = dir == 0 ? __shfl_up(incl, o) : __shfl_down(incl, o);
                const bool okl = dir == 0 ? (lane >= o) : (lane + o < 64);
                if (okl) incl += v;
            }
            const float total = __shfl(incl, dir == 0 ? 63 : 0);
            float acs0, acs1;
            if (dir == 0) { acs1 = incl; acs0 = incl - d1 * a; }
            else { acs0 = incl; acs1 = incl - d0 * a; }
            float* dtv = F.w<float>(WS_DTV) + (size_t)(row0 + j0) * 12 + dir * 6 + h; dtv[0] = d0; dtv[12] = d1;
            float* acv = F.w<float>(WS_ACS) + (size_t)(row0 + j0) * 12 + dir * 6 + h; acv[0] = acs0; acv[12] = acs1;
            if (lane == 0) F.w<float>(WS_ALAST)[ch * 12 + dir * 6 + h] = total;
            dts[wave * 128 + j0] = d0; dts[wave * 128 + j0 + 1] = d1;
            wj[wave * 128 + j0] = __expf(total - acs0) * d0; wj[wave * 128 + j0 + 1] = __expf(total - acs1) * d1;
        }
        __syncthreads();
        if (F.tid < 448) {
            const int pr = F.tid % 224, half = F.tid / 224;
            const int chn = pr < 96 ? g * 192 + 2 * pr : (pr < 160 ? 384 + g * 128 + 2 * (pr - 96) : 640 + g * 128 + 2 * (pr - 160));
            const float* cw = F.in[I_SCW] + (size_t)l * 5 * 896 + chn; const float* cb = F.in[I_SCB] + (size_t)l * 896 + chn;
            float w0[5], w1[5];
#pragma unroll
            for (int k = 0; k < 5; ++k) { w0[k] = cw[k * 896]; w1[k] = cw[k * 896 + 1]; }
            const float b0 = cb[0], b1 = cb[1];
            const int jb = half * 64;
            const bf16_t* src = P + CXBC + chn;
            unsigned win[12];
#pragma unroll
            for (int k = 0; k < 4; ++k) { const int rr = row0 + jb + k - 2; win[k] = (rr >= seq_lo && rr < seq_hi) ? *(const unsigned*)(src + (size_t)rr * PC) : 0u; }
            const int hh = pr / 32;
            const int pch = 2 * (pr & 31);
            for (int jg = 0; jg < 64; jg += 8) {
#pragma unroll
                for (int k = 0; k < 8; ++k) { const int rr = row0 + jb + jg + k + 2; win[4 + k] = (rr >= seq_lo && rr < seq_hi) ? *(const unsigned*)(src + (size_t)rr * PC) : 0u; }
                float s0[8], s1[8];
#pragma unroll
                for (int u = 0; u < 8; ++u) {
                    float a0 = b0, a1 = b1;
#pragma unroll
                    for (int k = 0; k < 5; ++k) { a0 += w0[k] * bflo(win[u + k]); a1 += w1[k] * bfhi(win[u + k]); }
                    s0[u] = silu_f(a0); s1[u] = silu_f(a1);
                    *(unsigned*)(F.w<bf16_t>(WS_XBC) + (size_t)(row0 + jb + jg + u) * 896 + chn) = pk_bf16(s0[u], s1[u]);
                }
#pragma unroll
                for (int k = 0; k < 4; ++k) win[k] = win[8 + k];
#pragma unroll
                for (int u = 0; u < 8; u += 2) {
                    const int j = jb + jg + u;
                    if (pr < 96) {
#pragma unroll
                        for (int dir = 0; dir < 2; ++dir) {
                            const float wa = wj[(hh * 2 + dir) * 128 + j], wb = wj[(hh * 2 + dir) * 128 + j + 1];
                            LAS unsigned char* d = XW + ((hh * 2 + dir) * 64 + pch) * SROW + j * 2;
                            *(LAS unsigned*)d = pk_bf16(s0[u] * wa, s0[u + 1] * wb);
                            *(LAS unsigned*)(d + SROW) = pk_bf16(s1[u] * wa, s1[u + 1] * wb);
                        }
                    } else if (pr < 160) {
                        LAS unsigned char* d = BT + (2 * (pr - 96)) * SROW + j * 2;
                        *(LAS unsigned*)d = pk_bf16(s0[u], s0[u + 1]);
                        *(LAS unsigned*)(d + SROW) = pk_bf16(s1[u], s1[u + 1]);
                    }
                }
            }
        }
        __syncthreads();
        {
            const int nt = wave & 3, pt = wave >> 2;
#pragma unroll 1
            for (int hh = 0; hh < 3; ++hh) {
                const int h = g * 3 + hh;
                f32x16 a0, a1;
#pragma unroll
                for (int i = 0; i < 16; ++i) { a0[i] = 0.f; a1[i] = 0.f; }
                const LAS unsigned char* X0 = XW + (hh * 2) * 64 * SROW;
#pragma unroll
                for (int ks = 0; ks < 8; ++ks) {
                    const bf16x8 a = lds_frag(BT, 32 * nt + r, 16 * ks + 8 * hf);
                    const bf16x8 b0 = lds_frag(X0, 32 * pt + r, 16 * ks + 8 * hf), b1 = lds_frag(X0, 64 + 32 * pt + r, 16 * ks + 8 * hf);
                    a0 = __builtin_amdgcn_mfma_f32_32x32x16_bf16(a, b0, a0, 0, 0, 0);
                    a1 = __builtin_amdgcn_mfma_f32_32x32x16_bf16(a, b1, a1, 0, 0, 0);
                }
                float* s0 = F.w<float>(WS_STATES) + ((size_t)(0 * NCH + ch) * 6 + h) * 8192 + (32 * pt + r) * 128 + 32 * nt + 4 * hf;
                float* s1 = F.w<float>(WS_STATES) + ((size_t)(1 * NCH + ch) * 6 + h) * 8192 + (32 * pt + r) * 128 + 32 * nt + 4 * hf;
#pragma unroll
                for (int gq = 0; gq < 4; ++gq) { *(f32x4*)(s0 + 8 * gq) = (f32x4){a0[4 * gq], a0[4 * gq + 1], a0[4 * gq + 2], a0[4 * gq + 3]};
                                                 *(f32x4*)(s1 + 8 * gq) = (f32x4){a1[4 * gq], a1[4 * gq + 1], a1[4 * gq + 2], a1[4 * gq + 3]}; }
            }
        }
    }
}

__device__ __forceinline__ void ph_ssd_scan(const Frame& F) {
    const int per = (98304 + F.G - 1) / F.G;
    for (int q = F.tid; q < per; q += NTHREADS) {
        const int id = F.bid * per + q;
        if (id >= 98304) break;
        const int dir = id / 49152, rem = id % 49152, h = rem / 8192, e = rem % 8192;
        const float* al = F.w<float>(WS_ALAST) + dir * 6 + h;
        const float* st = F.w<float>(WS_STATES) + ((size_t)(dir * NCH) * 6 + h) * 8192 + e;
        bf16_t* ss = F.w<bf16_t>(WS_SSTART) + ((size_t)(dir * NCH) * 6 + h) * 8192 + e;
        float sacc = 0.f;
        for (int s0 = 0; s0 < NCH; s0 += 26) {
            float sv[26], dv[26]; int cv[26];
#pragma unroll
            for (int u = 0; u < 26; ++u) {
                const int step = s0 + u;
                cv[u] = dir == 0 ? (step < 2 ? 128 + step : step - 2) : 129 - step;
                sv[u] = st[(size_t)cv[u] * 6 * 8192]; dv[u] = al[cv[u] * 12];
            }
#pragma unroll
            for (int u = 0; u < 26; ++u) { ss[(size_t)cv[u] * 6 * 8192] = f2bf(sacc); sacc = sacc * __expf(dv[u]) + sv[u]; }
        }
    }
}

__device__ __forceinline__ void ph_ssd_out(const Frame& F, int l) {
    LAS unsigned char* Cs = F.lds;
    LAS unsigned char* Bs = F.lds + 34816;
    LAS unsigned char* XT = F.lds + 69632;
    LAS float* Yl = (LAS float*)F.lds;
    LAS float* af = (LAS float*)(F.lds + 98816);
    LAS float* ab = af + 384, *dtf = ab + 384, *dtb = dtf + 384;
    LAS float* red = dtb + 384;
    const bf16_t* XBC = F.w<bf16_t>(WS_XBC);
    const bf16_t* P = F.w<bf16_t>(WS_P);
    const int nch = (l == 0) ? NCH : 128;
    const int lane = F.lane, wave = F.wave, r_in = lane & 31, hf_in = lane >> 5;
    const int it_ = wave & 3, jp = wave >> 2;
    for (int it = F.bid; it < nch * 2; it += F.G) {
        const int ch = it >> 1, g = it & 1, row0 = ch * 128;
        int r = r_in, hf = hf_in; asm volatile("" : "+v"(r), "+v"(hf));
        __syncthreads();
        for (int q = F.tid; q < 128 * 16; q += NTHREADS) {
            const int row = q >> 4, piece = q & 15;
            const bf16_t* src = XBC + (size_t)(row0 + row) * 896 + g * 128 + piece * 8;
            *(LAS u32x4*)(Bs + row * SROW + piece * 16) = *(const u32x4*)(src + 384);
            *(LAS u32x4*)(Cs + row * SROW + piece * 16) = *(const u32x4*)(src + 640);
        }
        for (int q = F.tid; q < 768; q += NTHREADS) {
            const int dir = q / 384, rr = q % 384, hh = rr >> 7, j = rr & 127;
            (dir ? ab : af)[hh * 128 + j] = F.w<float>(WS_ACS)[(size_t)(row0 + j) * 12 + dir * 6 + g * 3 + hh];
            (dir ? dtb : dtf)[hh * 128 + j] = F.w<float>(WS_DTV)[(size_t)(row0 + j) * 12 + dir * 6 + g * 3 + hh];
        }
        __syncthreads();
        f32x16 G0, G1;
#pragma unroll
        for (int i = 0; i < 16; ++i) { G0[i] = 0.f; G1[i] = 0.f; }
#pragma unroll
        for (int ks = 0; ks < 8; ++ks) {
            const bf16x8 a = lds_frag(Cs, 32 * it_ + r, 16 * ks + 8 * hf);
            const bf16x8 b0 = lds_frag(Bs, 64 * jp + r, 16 * ks + 8 * hf), b1 = lds_frag(Bs, 64 * jp + 32 + r, 16 * ks + 8 * hf);
            G0 = __builtin_amdgcn_mfma_f32_32x32x16_bf16(a, b0, G0, 0, 0, 0);
            G1 = __builtin_amdgcn_mfma_f32_32x32x16_bf16(a, b1, G1, 0, 0, 0);
        }
        f32x16 yacc[3];
#pragma unroll
        for (int hh = 0; hh < 3; ++hh) {
            const int h = g * 3 + hh;
            asm volatile("" : "+v"(r), "+v"(hf));
            __syncthreads();
#pragma unroll
            for (int tl = 0; tl < 2; ++tl) {
                const int j = 64 * jp + 32 * tl + r;
                const float afj = af[hh * 128 + j], abj = ab[hh * 128 + j], dfj = dtf[hh * 128 + j], dbj = dtb[hh * 128 + j];
#pragma unroll
                for (int rg = 0; rg < 16; ++rg) {
                    const int i = 32 * it_ + (rg & 3) + 8 * (rg >> 2) + 4 * hf;
                    const float mf = fminf(fmaxf((float)(i - j + 1), 0.f), 1.f), mb = fminf(fmaxf((float)(j - i + 1), 0.f), 1.f);
                    const float wf = __expf(fminf(af[hh * 128 + i] - afj, 0.f)) * dfj * mf;
                    const float wb = __expf(fminf(ab[hh * 128 + i] - abj, 0.f)) * dbj * mb;
                    const float gv = tl == 0 ? G0[rg] : G1[rg];
                    *(LAS bf16_t*)(Bs + i * SROW + j * 2) = f2bf(gv * (wf + wb));
                }
            }
            for (int q = F.tid; q < 128 * 8; q += NTHREADS) {
                const int j = q >> 3, pg = q & 7;
                const u32x4 v = *(const u32x4*)(XBC + (size_t)(row0 + j) * 896 + h * 64 + pg * 8);
                LAS unsigned char* d = XT + (pg * 8) * SROW + j * 2;
                *(LAS bf16_t*)(d + 0 * SROW) = (bf16_t)(v.x & 0xFFFF); *(LAS bf16_t*)(d + 1 * SROW) = (bf16_t)(v.x >> 16);
                *(LAS bf16_t*)(d + 2 * SROW) = (bf16_t)(v.y & 0xFFFF); *(LAS bf16_t*)(d + 3 * SROW) = (bf16_t)(v.y >> 16);
                *(LAS bf16_t*)(d + 4 * SROW) = (bf16_t)(v.z & 0xFFFF); *(LAS bf16_t*)(d + 5 * SROW) = (bf16_t)(v.z >> 16);
                *(LAS bf16_t*)(d + 6 * SROW) = (bf16_t)(v.w & 0xFFFF); *(LAS bf16_t*)(d + 7 * SROW) = (bf16_t)(v.w >> 16);
            }
            {
                f32x16 yF, yB;
#pragma unroll
                for (int i = 0; i < 16; ++i) { yF[i] = 0.f; yB[i] = 0.f; }
                const bf16_t* Sf = F.w<bf16_t>(WS_SSTART) + ((size_t)(0 * NCH + ch) * 6 + h) * 8192 + (32 * jp + r) * 128 + 8 * hf;
                const bf16_t* Sb = F.w<bf16_t>(WS_SSTART) + ((size_t)(1 * NCH + ch) * 6 + h) * 8192 + (32 * jp + r) * 128 + 8 * hf;
#pragma unroll 2
                for (int ks = 0; ks < 8; ++ks) {
                    const bf16x8 ac = lds_frag(Cs, 32 * it_ + r, 16 * ks + 8 * hf);
                    const bf16x8 bf_ = *(const bf16x8*)(Sf + 16 * ks), bb_ = *(const bf16x8*)(Sb + 16 * ks);
                    yF = __builtin_amdgcn_mfma_f32_32x32x16_bf16(ac, bf_, yF, 0, 0, 0);
                    yB = __builtin_amdgcn_mfma_f32_32x32x16_bf16(ac, bb_, yB, 0, 0, 0);
                }
#pragma unroll
                for (int rg = 0; rg < 16; ++rg) {
                    const int i = 32 * it_ + (rg & 3) + 8 * (rg >> 2) + 4 * hf;
                    yacc[hh][rg] = __expf(af[hh * 128 + i]) * yF[rg] + __expf(ab[hh * 128 + i]) * yB[rg];
                }
            }
            __syncthreads();
#pragma unroll 2
            for (int ks = 0; ks < 8; ++ks) {
                const bf16x8 aw = lds_frag(Bs, 32 * it_ + r, 16 * ks + 8 * hf), bx = lds_frag(XT, 32 * jp + r, 16 * ks + 8 * hf);
                yacc[hh] = __builtin_amdgcn_mfma_f32_32x32x16_bf16(aw, bx, yacc[hh], 0, 0, 0);
            }
        }
        __syncthreads();
#pragma unroll
        for (int hh = 0; hh < 3; ++hh)
#pragma unroll
            for (int rg = 0; rg < 16; ++rg) { const int i = 32 * it_ + (rg & 3) + 8 * (rg >> 2) + 4 * hf; Yl[i * 193 + hh * 64 + 32 * jp + r] = yacc[hh][rg]; }
        __syncthreads();
        const int i = F.tid & 127, pq = F.tid >> 7;
        float ssq = 0.f;
#pragma unroll 1
        for (int hh = 0; hh < 3; ++hh) {
            const int h = g * 3 + hh; const float dsk = F.in[I_SSDD][l * 6 + h];
            const int chn = h * 64 + pq * 16;
            const u32x4 xa = *(const u32x4*)(XBC + (size_t)(row0 + i) * 896 + chn), xb = *(const u32x4*)(XBC + (size_t)(row0 + i) * 896 + chn + 8);
            const u32x4 za = *(const u32x4*)(P + (size_t)(row0 + i) * PC + CZ + chn), zb = *(const u32x4*)(P + (size_t)(row0 + i) * PC + CZ + chn + 8);
            const unsigned xw_[8] = {xa.x, xa.y, xa.z, xa.w, xb.x, xb.y, xb.z, xb.w}, zw_[8] = {za.x, za.y, za.z, za.w, zb.x, zb.y, zb.z, zb.w};
            LAS float* yr = Yl + i * 193 + hh * 64 + pq * 16;
#pragma unroll
            for (int p2 = 0; p2 < 8; ++p2) {
                const float v0 = (yr[2 * p2] + dsk * bflo(xw_[p2])) * silu_f(bflo(zw_[p2]));
                const float v1 = (yr[2 * p2 + 1] + dsk * bfhi(xw_[p2])) * silu_f(bfhi(zw_[p2]));
                yr[2 * p2] = v0; yr[2 * p2 + 1] = v1; ssq += v0 * v0 + v1 * v1;
            }
        }
        red[pq * 128 + i] = ssq;
        __syncthreads();
        const float tot = red[i] + red[128 + i] + red[256 + i] + red[384 + i];
        const float rstd = rsqrtf(tot * (1.0f / 192.0f) + RMS_EPS);
#pragma unroll 1
        for (int hh = 0; hh < 3; ++hh) {
            const int h = g * 3 + hh;
            bf16_t* o = F.w<bf16_t>(WS_MIX) + (size_t)(row0 + i) * D + h * 64 + pq * 16;
            const float* ng = F.in[I_SSDNG] + l * 384 + h * 64 + pq * 16;
            const LAS float* yr = Yl + i * 193 + hh * 64 + pq * 16;
            unsigned wv[8];
#pragma unroll
            for (int p2 = 0; p2 < 8; ++p2) wv[p2] = pk_bf16(yr[2 * p2] * rstd * ng[2 * p2], yr[2 * p2 + 1] * rstd * ng[2 * p2 + 1]);
            *(u32x4*)o = (u32x4){wv[0], wv[1], wv[2], wv[3]}; *(u32x4*)(o + 8) = (u32x4){wv[4], wv[5], wv[6], wv[7]};
        }
    }
}

__device__ __forceinline__ int na_kv_off(int key, int piece) { return key * 128 + ((piece ^ (key & 7)) << 4); }
__device__ __forceinline__ void na_stage_kv(const Frame& F, const bf16_t* P, LAS unsigned char* Kd, LAS unsigned char* Vd, int h, bool local, int r0, int kc0) {
    for (int q = F.tid; q < 256 * 8; q += NTHREADS) {
        const int key = q >> 3, piece = q & 7;
        const int krow = local ? (r0 + (key >> 5)) * 64 + kc0 + (key & 31) : L + key;
        const bf16_t* src = P + (size_t)krow * PC + h * 64 + piece * 8;
        *(LAS u32x4*)(Kd + na_kv_off(key, piece)) = *(const u32x4*)(src + CK);
        *(LAS u32x4*)(Vd + na_kv_off(key, piece)) = *(const u32x4*)(src + CV);
    }
}
__device__ __forceinline__ void bar_lds() { asm volatile("s_waitcnt lgkmcnt(0)" ::: "memory"); __builtin_amdgcn_s_barrier(); asm volatile("" ::: "memory"); }
struct NaItem { int h, r, cg, r0, kc0, qrow0; bool isctx; };
__device__ __forceinline__ NaItem na_item(int cid, int i_lo, int i_hi, int k) {
    NaItem t; t.isctx = (i_lo + k >= i_hi); t.r = 0; t.r0 = 0; t.kc0 = 0;
    if (!t.isctx) { const int it = i_lo + k; t.h = it >> 10; t.r = (it >> 2) & 255; t.cg = it & 3; t.r0 = min(max(t.r - 4, 0), 248); t.kc0 = min(max(16 * t.cg - 8, 0), 32); t.qrow0 = t.r * 64 + t.cg * 16; }
    else { t.h = cid >> 4; t.cg = cid & 15; t.qrow0 = L + t.cg * 16; }
    return t;
}
__device__ __forceinline__ void ph_na(const Frame& F, int l, int part) {
    LAS unsigned char* Kc = F.lds;
    LAS unsigned char* Vc = F.lds + 32768;
    LAS unsigned char* Kl = F.lds + 65536;
    LAS unsigned char* Vl = F.lds + 98304;
    LAS unsigned char* Qs = F.lds + 131072;
    LAS unsigned char* Pw = F.lds + 133120;
    LAS float* ml = (LAS float*)(F.lds + 151552);
    LAS float* bt = ml + 256;
    const bf16_t* P = F.w<bf16_t>(WS_P);
    const float* rpb = F.in[I_RPB] + (size_t)l * 15 * 31 * 6;
    const int nlat = 6 * 256 * 4;
    const int nB = (l == 0) ? 2520 : 0, nA = nlat - nB;
    const int lane = F.lane, wave = F.wave, c16 = lane & 15, kq = lane >> 4;
    const float scale = 0.125f;
    int cur_h = -1;
    const float ws = part == 0 ? (l == 0 ? 0.45f : 0.67f) : 0.0f;
    const int nP = part == 0 ? nA : nB, base = part == 0 ? 0 : nA;
    const float Wtot = 4.0f * ws + (float)(F.G - 4);
    const float W0 = F.bid < 4 ? F.bid * ws : 4.0f * ws + (float)(F.bid - 4), W1 = F.bid < 3 ? (F.bid + 1) * ws : 4.0f * ws + (float)(F.bid - 3);
    const int i_lo = base + (int)((float)nP * W0 / Wtot + 0.5f), i_hi = (F.bid == F.G - 1) ? base + nP : base + (int)((float)nP * W1 / Wtot + 0.5f);
    const int cid = (l == 0 && part == 0 && F.bid >= 100 && F.bid < 196) ? F.bid - 100 : -1;
    const int n_mine = max(0, i_hi - i_lo) + (cid >= 0 ? 1 : 0);
    u32x4 kreg[4], vreg[4], qreg; float breg = 0.f;
    const int pkey = F.tid >> 3, ppiece = F.tid & 7;
#define NA_PREFETCH(T) do { if (!(T).isctx) { _Pragma("unroll") for (int u = 0; u < 4; ++u) { const int key = pkey + 64 * u; \
            const bf16_t* src = P + (size_t)(((T).r0 + (key >> 5)) * 64 + (T).kc0 + (key & 31)) * PC + (T).h * 64 + ppiece * 8; \
            kreg[u] = *(const u32x4*)(src + CK); vreg[u] = *(const u32x4*)(src + CV); } \
            if (F.tid < 256 && (F.tid & 31) < 31) breg = rpb[(((T).r0 + (F.tid >> 5) - (T).r + 7) * 31 + (F.tid & 31)) * 6 + (T).h]; } \
        if (F.tid < 128) qreg = *(const u32x4*)(P + (size_t)((T).qrow0 + pkey) * PC + CQ + (T).h * 64 + ppiece * 8); } while (0)
    if (n_mine > 0) { const NaItem t0 = na_item(cid, i_lo, i_hi, 0); NA_PREFETCH(t0); }
    for (int k = 0; k < n_mine; ++k) {
        const NaItem t = na_item(cid, i_lo, i_hi, k);
        const bool isctx = t.isctx; const int h = t.h, cg = t.cg, kc0 = t.kc0, qrow0 = t.qrow0;
        if (k == 0) bar_lds();
        if (h != cur_h) { na_stage_kv(F, P, Kc, Vc, h, false, 0, 0); cur_h = h; }
        if (!isctx) {
#pragma unroll
            for (int u = 0; u < 4; ++u) { const int key = pkey + 64 * u; *(LAS u32x4*)(Kl + na_kv_off(key, ppiece)) = kreg[u]; *(LAS u32x4*)(Vl + na_kv_off(key, ppiece)) = vreg[u]; }
            if (F.tid < 256) bt[F.tid] = breg;
        }
        if (F.tid < 128) *(LAS u32x4*)(Qs + na_kv_off(pkey, ppiece)) = qreg;
        if (k + 1 < n_mine) { const NaItem tn = na_item(cid, i_lo, i_hi, k + 1); NA_PREFETCH(tn); }
        bar_lds();
        const bool loc = wave < 4;
        const LAS unsigned char* Kb = loc ? Kl : Kc;
        const LAS unsigned char* Vb = loc ? Vl : Vc;
        const int kbase = (wave & 3) * 64;
        LAS unsigned char* pw = Pw + wave * 2304;
        float mw[4], lw[4];
        if (!(loc && isctx)) {
            f32x4 sacc[4];
#pragma unroll
            for (int nt = 0; nt < 4; ++nt) sacc[nt] = (f32x4){0.f, 0.f, 0.f, 0.f};
#pragma unroll
            for (int ks = 0; ks < 2; ++ks) {
                const bf16x8 a = *(const LAS bf16x8*)(Qs + na_kv_off(c16, 4 * ks + kq));
#pragma unroll
                for (int nt = 0; nt < 4; ++nt) {
                    const bf16x8 b = *(const LAS bf16x8*)(Kb + na_kv_off(kbase + 16 * nt + c16, 4 * ks + kq));
                    sacc[nt] = __builtin_amdgcn_mfma_f32_16x16x32_bf16(a, b, sacc[nt], 0, 0, 0);
                }
            }
#pragma unroll
            for (int rg = 0; rg < 4; ++rg) mw[rg] = -INFINITY;
#pragma unroll
            for (int nt = 0; nt < 4; ++nt) {
                const int kk = kbase + 16 * nt + c16;
#pragma unroll
                for (int rg = 0; rg < 4; ++rg) {
                    float sv = sacc[nt][rg] * scale;
                    if (loc) {
                        const int qi = 4 * kq + rg, qcol = cg * 16 + qi, cstart = min(max(qcol - 8, 0), 48);
                        const int krow = kk >> 5, kcol = kc0 + (kk & 31);
                        const bool ok = (kcol >= cstart) && (kcol < cstart + 16);
                        const int dc = min(max(kcol - qcol + 15, 0), 30);
                        sv = ok ? sv + bt[krow * 32 + dc] : -INFINITY;
                    }
                    sacc[nt][rg] = sv; mw[rg] = fmaxf(mw[rg], sv);
                }
            }
#pragma unroll
            for (int rg = 0; rg < 4; ++rg) {
#pragma unroll
                for (int o = 8; o >= 1; o >>= 1) mw[rg] = fmaxf(mw[rg], __shfl_xor(mw[rg], o));
                lw[rg] = 0.f;
            }
#pragma unroll
            for (int nt = 0; nt < 4; ++nt) {
#pragma unroll
                for (int rg = 0; rg < 4; ++rg) {
                    const float msafe = mw[rg] == -INFINITY ? 0.f : mw[rg];
                    const float pv = __expf(sacc[nt][rg] - msafe);
                    lw[rg] += pv;
                    *(LAS bf16_t*)(pw + (4 * kq + rg) * 144 + (16 * nt + c16) * 2) = f2bf(pv);
                }
            }
#pragma unroll
            for (int rg = 0; rg < 4; ++rg) {
#pragma unroll
                for (int o = 8; o >= 1; o >>= 1) lw[rg] += __shfl_xor(lw[rg], o);
            }
            lds_fence();
            f32x4 oacc[4];
#pragma unroll
            for (int dt = 0; dt < 4; ++dt) oacc[dt] = (f32x4){0.f, 0.f, 0.f, 0.f};
#pragma unroll
            for (int ks = 0; ks < 2; ++ks) {
                const bf16x8 a = *(const LAS bf16x8*)(pw + c16 * 144 + (32 * ks + 8 * kq) * 2);
                const int key0 = kbase + 32 * ks + 8 * kq;
#pragma unroll
                for (int dt = 0; dt < 4; ++dt) {
                    const int d = 16 * dt + c16;
                    bf16x8 b;
#pragma unroll
                    for (int e = 0; e < 8; ++e) b[e] = *(const LAS short*)(Vb + na_kv_off(key0 + e, d >> 3) + (d & 7) * 2);
                    oacc[dt] = __builtin_amdgcn_mfma_f32_16x16x32_bf16(a, b, oacc[dt], 0, 0, 0);
                }
            }
            lds_fence();
#pragma unroll
            for (int dt = 0; dt < 4; ++dt)
#pragma unroll
                for (int rg = 0; rg < 4; ++rg) *(LAS bf16_t*)(pw + (4 * kq + rg) * 144 + (16 * dt + c16) * 2) = f2bf(oacc[dt][rg]);
        } else {
#pragma unroll
            for (int rg = 0; rg < 4; ++rg) { mw[rg] = -INFINITY; lw[rg] = 0.f; }
            for (int q = lane; q < 16 * 36; q += 64) ((LAS unsigned*)pw)[q] = 0u;
        }
        if (c16 == 0) {
#pragma unroll
            for (int rg = 0; rg < 4; ++rg) { ml[(wave * 16 + 4 * kq + rg) * 2] = mw[rg]; ml[(wave * 16 + 4 * kq + rg) * 2 + 1] = lw[rg]; }
        }
        bar_lds();
        {
            const int qi = F.tid >> 5, dp = F.tid & 31;
            float M = -INFINITY;
#pragma unroll
            for (int w = 0; w < 8; ++w) M = fmaxf(M, ml[(w * 16 + qi) * 2]);
            float num0 = 0.f, num1 = 0.f, den = 0.f;
#pragma unroll
            for (int w = 0; w < 8; ++w) {
                const float sc = __expf(ml[(w * 16 + qi) * 2] - M);
                const unsigned ov = *(const LAS unsigned*)(Pw + w * 2304 + qi * 144 + dp * 4);
                num0 += sc * bflo(ov); num1 += sc * bfhi(ov); den += sc * ml[(w * 16 + qi) * 2 + 1];
            }
            const float inv = 1.0f / den;
            *(unsigned*)(F.w<bf16_t>(WS_MIX) + (size_t)(qrow0 + qi) * D + 384 + h * 64 + 2 * dp) = pk_bf16(num0 * inv, num1 * inv);
        }
    }
#undef NA_PREFETCH
}

__device__ __forceinline__ float hy_conv3(const bf16_t* P, const float* cw, const float* cb, int row, int seq_lo, int seq_hi, int col) {
    float s = cb[col];
#pragma unroll
    for (int k = 0; k < 3; ++k) { const int r = row + k - 1; if (r >= seq_lo && r < seq_hi) s += cw[k * 768 + col] * bf2f(P[(size_t)r * PC + CHY + col]); }
    return s;
}
__device__ __forceinline__ void ph_hy_prep(const Frame& F, int l) {
    const bf16_t* P = F.w<bf16_t>(WS_P);
    const float* cw = F.in[I_HCW] + (size_t)l * 3 * 768; const float* cb = F.in[I_HCB] + (size_t)l * 768;
    LAS unsigned* ut = (LAS unsigned*)F.lds;
    LAS unsigned* xt = ut + 256 * 33;
    const int cp = F.tid & 127, rq = F.tid >> 7;
    float w0[3][3], w1[3][3], b0[3], b1[3];
#pragma unroll
    for (int sg = 0; sg < 3; ++sg) { b0[sg] = cb[sg * 256 + 2 * cp]; b1[sg] = cb[sg * 256 + 2 * cp + 1];
#pragma unroll
        for (int k = 0; k < 3; ++k) { w0[sg][k] = cw[k * 768 + sg * 256 + 2 * cp]; w1[sg][k] = cw[k * 768 + sg * 256 + 2 * cp + 1]; } }
    for (int it = F.bid; it < L / 64; it += F.G) {
        const int t0 = it * 64, rb = t0 + rq * 16;
        __syncthreads();
        {
            unsigned win[3][18];
#pragma unroll
            for (int sg = 0; sg < 3; ++sg)
#pragma unroll
                for (int k = 0; k < 18; ++k) { const int rr = rb - 1 + k; win[sg][k] = (rr >= 0 && rr < L) ? *(const unsigned*)(P + (size_t)rr * PC + CHY + sg * 256 + 2 * cp) : 0u; }
#pragma unroll
            for (int jp = 0; jp < 8; ++jp) {
                float u0[2], u1[2], xa[2], xb[2];
#pragma unroll
                for (int q = 0; q < 2; ++q) {
                    const int k = 2 * jp + q;
                    float a0[3], a1[3];
#pragma unroll
                    for (int sg = 0; sg < 3; ++sg) {
                        a0[sg] = b0[sg] + w0[sg][0] * bflo(win[sg][k]) + w0[sg][1] * bflo(win[sg][k + 1]) + w0[sg][2] * bflo(win[sg][k + 2]);
                        a1[sg] = b1[sg] + w1[sg][0] * bfhi(win[sg][k]) + w1[sg][1] * bfhi(win[sg][k + 1]) + w1[sg][2] * bfhi(win[sg][k + 2]);
                    }
                    xa[q] = a0[0]; xb[q] = a1[0]; u0[q] = a0[2] * a0[1]; u1[q] = a1[2] * a1[1];
                }
                const int rp = rq * 8 + jp;
                ut[(2 * cp) * 33 + rp] = pk_bf16(u0[0], u0[1]); ut[(2 * cp + 1) * 33 + rp] = pk_bf16(u1[0], u1[1]);
                xt[(2 * cp) * 33 + rp] = pk_bf16(xa[0], xa[1]); xt[(2 * cp + 1) * 33 + rp] = pk_bf16(xb[0], xb[1]);
            }
        }
        __syncthreads();
        for (int q = F.tid; q < 256 * 8; q += NTHREADS) {
            const int c = q >> 3, g = q & 7;
            u32x4 a, b;
            a.x = ut[c * 33 + 4 * g]; a.y = ut[c * 33 + 4 * g + 1]; a.z = ut[c * 33 + 4 * g + 2]; a.w = ut[c * 33 + 4 * g + 3];
            b.x = xt[c * 33 + 4 * g]; b.y = xt[c * 33 + 4 * g + 1]; b.z = xt[c * 33 + 4 * g + 2]; b.w = xt[c * 33 + 4 * g + 3];
            *(u32x4*)(F.w<bf16_t>(WS_UT) + (size_t)c * L + t0 + 8 * g) = a;
            *(u32x4*)(F.w<bf16_t>(WS_X0T) + (size_t)c * L + t0 + 8 * g) = b;
            u32x2 a8; a8.x = pk_fp8x4(bflo(a.x), bfhi(a.x), bflo(a.y), bfhi(a.y)); a8.y = pk_fp8x4(bflo(a.z), bfhi(a.z), bflo(a.w), bfhi(a.w));
            *(u32x2*)(F.w<unsigned char>(WS_UT8) + (size_t)c * L + t0 + 8 * g) = a8;
        }
    }
    if (l == 0) {
        for (int rp = F.bid; rp < LC / 2; rp += F.G) {
            const int row = L + rp * 2 + (F.tid >> 8), c = F.tid & 255;
            const float x1 = hy_conv3(P, cw, cb, row, L, T, 256 + c), v = hy_conv3(P, cw, cb, row, L, T, 512 + c);
            F.w<float>(WS_U)[(size_t)row * 256 + c] = v * x1;
        }
    }
}
__device__ __forceinline__ void ph_hy_conv_ctx(const Frame& F, int l) {
    const bf16_t* P = F.w<bf16_t>(WS_P);
    const float* cw = F.in[I_HCW] + (size_t)l * 3 * 768; const float* cb = F.in[I_HCB] + (size_t)l * 768;
    for (int it = F.bid; it < 8; it += F.G) {
        const int Lx = LC, rbase = L;
        const int tb = it * 2 + (F.tid >> 8), c = F.tid & 255, t0 = tb * 16;
        const float* U = F.w<float>(WS_U) + (size_t)rbase * 256 + c;
        const float* KC = F.w<float>(WS_KCOMBC) + c;
        float acc[16], wreg[16];
#pragma unroll
        for (int j = 0; j < 16; ++j) { acc[j] = 0.f; wreg[j] = KC[(size_t)(t0 + j + Lx - 1) * 256]; }
        for (int s0 = 0; s0 < Lx; s0 += 16) {
            float ub[16], nb[16];
#pragma unroll
            for (int r = 0; r < 16; ++r) { ub[r] = U[(size_t)(s0 + r) * 256]; const int x = t0 - (s0 + r + 1) + Lx - 1; nb[r] = x >= 0 ? KC[(size_t)x * 256] : 0.f; }
#pragma unroll
            for (int r = 0; r < 16; ++r) {
#pragma unroll
                for (int j = 0; j < 16; ++j) acc[j] += ub[r] * wreg[(j - r) & 15];
                wreg[(15 - r) & 15] = nb[r];
            }
        }
        const float inv = F.w<float>(WS_FSUM)[2 * 256 + c];
        const float db = F.in[I_HYD][l * 256 + c];
#pragma unroll
        for (int j = 0; j < 16; ++j) {
            const int row = rbase + t0 + j;
            const float x0 = hy_conv3(P, cw, cb, row, L, T, c);
            const float u = F.w<float>(WS_U)[(size_t)row * 256 + c];
            F.w<bf16_t>(WS_MIX)[(size_t)row * D + 768 + c] = f2bf(x0 * (acc[j] * inv + u * db));
        }
    }
}

constexpr int HC_UP = 144, HC_UBYTES = 190 * HC_UP;
constexpr int HC_CPOFF = 27392, HC_NG = 83, HC_CPBYTES = 16 * HC_NG * 16;
__device__ __forceinline__ void hc_make_copies(LAS unsigned char* dst, const u32x4 g0, const u32x4 g1, int g) {
    const unsigned w[8] = {g0.x, g0.y, g0.z, g0.w, g1.x, g1.y, g1.z, g1.w};
#pragma unroll
    for (int sh = 0; sh < 16; ++sh) {
        const int b = sh >> 2, r = sh & 3;
        u32x4 o;
        if (r == 0) { o.x = w[b]; o.y = w[b + 1]; o.z = w[b + 2]; o.w = w[b + 3]; }
        else { o.x = __builtin_amdgcn_alignbyte(w[b + 1], w[b], r); o.y = __builtin_amdgcn_alignbyte(w[b + 2], w[b + 1], r);
               o.z = __builtin_amdgcn_alignbyte(w[b + 3], w[b + 2], r); o.w = __builtin_amdgcn_alignbyte(w[b + 4], w[b + 3], r); }
        *(LAS u32x4*)(dst + (sh * HC_NG + g) * 16) = o;
    }
}
__device__ __forceinline__ void ph_hy_conv(const Frame& F, int l) {
    LAS unsigned char* Ul = F.lds;
    LAS unsigned char* Cp = F.lds + HC_CPOFF;
    const int lane = F.lane, wave = F.wave;
    const int nt = wave < 4 ? wave : 7 - wave, par = wave >> 2;
    const int r = lane & 31, h = lane >> 5, sig = r & 15, rho = r >> 4;
    const int sh = (16 - sig) & 15, gofs = 2 * h - rho - (sig ? 1 : 0);
    const int a_lane = (sh * HC_NG + gofs) * 16;
    const int b_lane = r * HC_UP + h * 32;
    const int sclK = 0x79797979, sclU = ONE_E8M0;
    for (int c = F.bid; c < 256; c += F.G) {
        const unsigned char* KRc = F.w<unsigned char>(WS_KR) + ((size_t)l * 256 + c) * KRL;
        const unsigned char* U8c = F.w<unsigned char>(WS_UT8) + (size_t)c * L;
        const bf16_t* UTc = F.w<bf16_t>(WS_UT) + (size_t)c * L;
        __syncthreads();
        for (int q = F.tid; q < 190 * 8; q += NTHREADS) {
            const int blk = q >> 3, piece = q & 7;
            u32x4 v = (u32x4){0u, 0u, 0u, 0u};
            if (blk >= 31 && blk < 159) v = *(const u32x4*)(U8c + (size_t)(blk - 31) * 128 + piece * 16);
            *(LAS u32x4*)(Ul + blk * HC_UP + piece * 16) = v;
        }
        u32x4 g0 = (u32x4){0u, 0u, 0u, 0u}, g1 = g0;
        if (F.tid < HC_NG) { const unsigned char* src = KRc + 31744 + 16 * F.tid; g0 = *(const u32x4*)src; g1 = *(const u32x4*)(src + 16); }
        if (F.tid < HC_NG) hc_make_copies(Cp, g0, g1, F.tid);
        __syncthreads();
        f32x16 acc[4];
#pragma unroll
        for (int m = 0; m < 4; ++m)
#pragma unroll
            for (int i = 0; i < 16; ++i) acc[m][i] = 0.f;
        for (int ci = 0; ci < 32; ++ci) {
            const int Dc = -128 + 8 * ci;
            if (ci + 1 < 32 && F.tid < HC_NG) { const unsigned char* src = KRc + (31744 - 1024 * (ci + 1)) + 16 * F.tid; g0 = *(const u32x4*)src; g1 = *(const u32x4*)(src + 16); }
            const LAS unsigned char* cp = Cp + (ci & 1) * HC_CPBYTES + a_lane;
#pragma unroll 1
            for (int d2 = 0; d2 < 4; ++d2) {
                const int dd = 2 * d2 + par, Dv = Dc + dd;
                if (!((Dv >= 32 * nt - 127) && (Dv <= 32 * nt + 31) && (Dv > -128))) continue;
                const LAS unsigned char* ap = cp + (8 * (8 - dd)) * 16;
                const LAS unsigned char* bp = Ul + b_lane + (32 * nt - Dv + 31) * HC_UP;
                v8i af[6], bfr[2];
#pragma unroll
                for (int e = 0; e < 6; ++e) { const v4i x = *(const LAS v4i*)(ap - 2 * (e - 2) * 16), y = *(const LAS v4i*)(ap - 2 * (e - 2) * 16 + 16); af[e] = __builtin_shufflevector(x, y, 0, 1, 2, 3, 4, 5, 6, 7); }
#pragma unroll
                for (int ks = 0; ks < 2; ++ks) { const v4i x = *(const LAS v4i*)(bp + ks * 64), y = *(const LAS v4i*)(bp + ks * 64 + 16); bfr[ks] = __builtin_shufflevector(x, y, 0, 1, 2, 3, 4, 5, 6, 7); }
#pragma unroll
                for (int ks = 0; ks < 2; ++ks)
#pragma unroll
                    for (int m = 0; m < 4; ++m)
                        asm volatile("v_mfma_scale_f32_32x32x64_f8f6f4 %0, %1, %2, %0, %3, %4 op_sel_hi:[0,0,0]" : "+v"(acc[m]) : "v"(af[m - 2 * ks + 2]), "v"(bfr[ks]), "v"(sclK), "v"(sclU));
            }
            if (ci + 1 < 32 && F.tid < HC_NG) hc_make_copies(Cp + ((ci + 1) & 1) * HC_CPBYTES, g0, g1, F.tid);
            __syncthreads();
        }
        LAS float* Rd = (LAS float*)F.lds;
        if (wave >= 4) {
#pragma unroll
            for (int m = 0; m < 4; ++m)
#pragma unroll
                for (int i = 0; i < 16; ++i) Rd[(nt * 64 + m * 16 + i) * 64 + lane] = acc[m][i];
        }
        __syncthreads();
        if (wave < 4) {
#pragma unroll
            for (int m = 0; m < 4; ++m)
#pragma unroll
                for (int i = 0; i < 16; ++i) acc[m][i] += Rd[(nt * 64 + m * 16 + i) * 64 + lane];
            const float inv = F.w<float>(WS_FSUM)[l * 256 + c];
            const float db = F.in[I_HYD][l * 256 + c];
            const bf16_t* X0c = F.w<bf16_t>(WS_X0T) + (size_t)c * L;
            bf16_t* YTc = F.w<bf16_t>(WS_YT) + (size_t)c * L;
            const int I = 32 * nt + r;
#pragma unroll
            for (int m = 0; m < 4; ++m) {
#pragma unroll
                for (int g = 0; g < 4; ++g) {
                    const int t = 128 * I + 32 * m + 8 * g + 4 * h;
                    const u32x2 xv = *(const u32x2*)(X0c + t), uv = *(const u32x2*)(UTc + t);
                    float y[4];
#pragma unroll
                    for (int e = 0; e < 4; ++e) y[e] = acc[m][4 * g + e] * inv;
                    y[0] = bflo(xv.x) * (y[0] + bflo(uv.x) * db); y[1] = bfhi(xv.x) * (y[1] + bfhi(uv.x) * db);
                    y[2] = bflo(xv.y) * (y[2] + bflo(uv.y) * db); y[3] = bfhi(xv.y) * (y[3] + bfhi(uv.y) * db);
                    u32x2 o; o.x = pk_bf16(y[0], y[1]); o.y = pk_bf16(y[2], y[3]);
                    *(u32x2*)(YTc + t) = o;
                }
            }
        }
    }
}
__device__ __forceinline__ void ph_hy_tr(const Frame& F) {
    LAS unsigned* yt = (LAS unsigned*)F.lds;
    for (int it = F.bid; it < L / 64; it += F.G) {
        const int t0 = it * 64;
        __syncthreads();
        for (int q = F.tid; q < 256 * 8; q += NTHREADS) {
            const int c = q >> 3, g = q & 7;
            const u32x4 a = *(const u32x4*)(F.w<bf16_t>(WS_YT) + (size_t)c * L + t0 + 8 * g);
            yt[c * 33 + 4 * g] = a.x; yt[c * 33 + 4 * g + 1] = a.y; yt[c * 33 + 4 * g + 2] = a.z; yt[c * 33 + 4 * g + 3] = a.w;
        }
        __syncthreads();
        for (int q = F.tid; q < 64 * 32; q += NTHREADS) {
            const int row = q >> 5, cg = q & 31;
            const LAS unsigned short* ys = (const LAS unsigned short*)yt;
            unsigned short v[8];
#pragma unroll
            for (int e = 0; e < 8; ++e) v[e] = ys[((cg * 8 + e) * 33) * 2 + row];
            u32x4 o; o.x = v[0] | ((unsigned)v[1] << 16); o.y = v[2] | ((unsigned)v[3] << 16); o.z = v[4] | ((unsigned)v[5] << 16); o.w = v[6] | ((unsigned)v[7] << 16);
            *(u32x4*)(F.w<bf16_t>(WS_MIX) + (size_t)(t0 + row) * D + 768 + cg * 8) = o;
        }
    }
}

constexpr int WRP = 1028;
__device__ __forceinline__ void ph_post1(const Frame& F, int l) {
    LAS float* wr = (LAS float*)F.lds;
    LAS unsigned* lcnt = (LAS unsigned*)(F.lds + 32 * WRP * 4);
    __syncthreads();
    if (F.tid < 64) lcnt[F.tid] = 0u;
    {
        const f32x4* src = (const f32x4*)(F.in[I_WR] + (size_t)l * 1024 * 32);
        f32x4 v[16];
#pragma unroll
        for (int u = 0; u < 16; ++u) v[u] = src[F.tid + u * NTHREADS];
#pragma unroll
        for (int u = 0; u < 16; ++u) { const int q4 = F.tid + u * NTHREADS, k = q4 >> 3, e0 = (q4 & 7) * 4;
#pragma unroll
            for (int i = 0; i < 4; ++i) wr[(e0 + i) * WRP + k] = v[u][i]; }
    }
    __syncthreads();
    const int nrows = (l == 0) ? T : L;
    const int nwaves = F.G * 8, lane = F.lane;
    unsigned* cnt = F.w<unsigned>(WS_CTL) + CW_CNT + l * 1024;
    if (F.bid == 0) { for (int q = F.tid; q < D / 4; q += NTHREADS) ((unsigned*)(F.w<unsigned char>(WS_H2) + (size_t)T * D))[q] = 0u; }
    const float brl = F.in[I_BR][l * 32 + ((lane >> 1) & 31)];
    const int mye = (lane >> 1) & 31;
    for (int row0 = F.bid * 8 + F.wave; row0 < nrows; row0 += 2 * nwaves) {
        int rw[2]; bool vld[2];
        rw[0] = row0; vld[0] = true; vld[1] = (row0 + nwaves < nrows); rw[1] = vld[1] ? row0 + nwaves : row0;
        f32x4 m[2][4], x[2][4], hv[2][4];
#pragma unroll
        for (int u = 0; u < 2; ++u) { const bf16_t* mr = F.w<bf16_t>(WS_MIXO) + (size_t)rw[u] * D;
#pragma unroll
            for (int i = 0; i < 4; ++i) { const u32x2 w = *(const u32x2*)(mr + 4 * lane + 256 * i); m[u][i] = (f32x4){bflo(w.x), bfhi(w.x), bflo(w.y), bfhi(w.y)}; }
            load_xrow(F, l, rw[u], lane, x[u]); }
#pragma unroll
        for (int u = 0; u < 2; ++u) {
            const int which = rw[u] >= L;
            const float* v0 = vecs_ptr(F, l, which, 2);
            const float rs1 = row_rstd(m[u]);
#pragma unroll
            for (int i = 0; i < 4; ++i) { const f32x4 a = *(const f32x4*)(v0 + 4 * lane + 256 * i); x[u][i] = x[u][i] + m[u][i] * rs1 * a; }
        }
#pragma unroll
        for (int u = 0; u < 2; ++u) {
            if (vld[u]) store_xrow_bf16(F.w<bf16_t>(WS_XCUR) + (size_t)rw[u] * D, lane, x[u]);
        }
#pragma unroll
        for (int u = 0; u < 2; ++u) {
            const int which = rw[u] >= L;
            const float* v1 = vecs_ptr(F, l, which, 3), *v2 = vecs_ptr(F, l, which, 4);
            const float rs2 = row_rstd(x[u]);
#pragma unroll
            for (int i = 0; i < 4; ++i) { const f32x4 a = *(const f32x4*)(v1 + 4 * lane + 256 * i), b = *(const f32x4*)(v2 + 4 * lane + 256 * i); hv[u][i] = x[u][i] * rs2 * a + b; }
            if (vld[u]) { unsigned char* ho = F.w<unsigned char>(WS_H2) + (size_t)rw[u] * D;
#pragma unroll
                for (int i = 0; i < 4; ++i) *(unsigned*)(ho + 4 * lane + 256 * i) = pk_fp8x4(hv[u][i][0], hv[u][i][1], hv[u][i][2], hv[u][i][3]); }
        }
        float part[2][32];
#pragma unroll
        for (int e = 0; e < 32; ++e) {
            float s0 = 0.f, s1 = 0.f;
#pragma unroll
            for (int i = 0; i < 4; ++i) { const f32x4 w = *(const LAS f32x4*)(wr + e * WRP + 4 * lane + 256 * i);
                s0 += hv[0][i][0] * w[0] + hv[0][i][1] * w[1] + hv[0][i][2] * w[2] + hv[0][i][3] * w[3];
                s1 += hv[1][i][0] * w[0] + hv[1][i][1] * w[1] + hv[1][i][2] * w[2] + hv[1][i][3] * w[3]; }
            part[0][e] = s0; part[1][e] = s1;
        }
#pragma unroll
        for (int st = 0; st < 5; ++st) {
            const int o = 32 >> st, n = 32 >> st;
            const bool upper = (lane & o) != 0;
#pragma unroll
            for (int i = 0; i < n / 2; ++i) {
#pragma unroll
                for (int u = 0; u < 2; ++u) {
                    const float send = upper ? part[u][i] : part[u][i + n / 2];
                    const float recv = __shfl_xor(send, o);
                    const float keep = upper ? part[u][i + n / 2] : part[u][i];
                    part[u][i] = keep + recv;
                }
            }
        }
#pragma unroll
        for (int u = 0; u < 2; ++u) {
            float lg = part[u][0] + __shfl_xor(part[u][0], 1);
            lg += brl;
            int rank = 0;
#pragma unroll
            for (int e = 0; e < 32; ++e) { const float ov = __int_as_float(__builtin_amdgcn_readlane(__float_as_int(lg), 2 * e)); rank += (ov > lg || (ov == lg && e < mye)) ? 1 : 0; }
            int te[4]; float tv[4];
#pragma unroll
            for (int k = 0; k < 4; ++k) {
                const unsigned long long msk = __ballot(rank == k && (lane & 1) == 0);
                const int idx = msk ? __builtin_amdgcn_readfirstlane((int)__builtin_ctzll(msk)) : 2 * k;
                te[k] = idx >> 1; tv[k] = __int_as_float(__builtin_amdgcn_readlane(__float_as_int(lg), idx));
            }
            const float e1 = __expf(tv[1] - tv[0]), e2 = __expf(tv[2] - tv[0]), e3 = __expf(tv[3] - tv[0]);
            const float inv = 1.0f / (1.0f + e1 + e2 + e3);
            if (lane < 4 && vld[u]) {
                const int k = lane, row = rw[u];
                const int e = k == 0 ? te[0] : (k == 1 ? te[1] : (k == 2 ? te[2] : te[3]));
                const float wgt = (k == 0 ? 1.0f : (k == 1 ? e1 : (k == 2 ? e2 : e3))) * inv;
                const unsigned pos = __hip_atomic_fetch_add(lcnt + e, 1u, __ATOMIC_RELAXED, __HIP_MEMORY_SCOPE_WORKGROUP);
                F.w<int>(WS_RE)[row * 4 + k] = e; F.w<int>(WS_RP)[row * 4 + k] = (int)pos; F.w<float>(WS_RW)[row * 4 + k] = wgt;
            }
        }
    }
    __syncthreads();
    if (F.tid < 32) lcnt[32 + F.tid] = atomicAdd(cnt + F.tid * 32, lcnt[F.tid]);
    __syncthreads();
    for (int row = F.bid * 8 + F.wave; row < nrows; row += nwaves) {
        if (lane < 4) { const int a = row * 4 + lane; F.w<int>(WS_RP)[a] += (int)lcnt[32 + F.w<int>(WS_RE)[a]]; }
    }
}

__device__ __forceinline__ int expert_pad_start(const Frame& F, int l, int& ntiles) {
    const unsigned* cnt = F.w<unsigned>(WS_CTL) + CW_CNT + l * 1024;
    int c = F.lane < 32 ? (int)__hip_atomic_load(cnt + F.lane * 32, __ATOMIC_RELAXED, __HIP_MEMORY_SCOPE_AGENT) : 0;
    int padded = (c + 255) & ~255;
    int incl = padded;
#pragma unroll
    for (int o = 1; o < 32; o <<= 1) { const int v = __shfl_up(incl, o); if ((F.lane & 31) >= o) incl += v; }
    ntiles = __shfl(incl, 31) >> 8;
    return incl - padded;
}

__device__ __forceinline__ void ph_gather(const Frame& F, int l) {
    int ntiles; const int ps = expert_pad_start(F, l, ntiles);
    if (F.bid == 0 && F.wave == 0) {
        int* tab = F.w<int>(WS_CTL) + CW_TILE + l * 320;
        const int nxt = __shfl_down(ps, 1);
        const int endt = (F.lane == 31) ? ntiles : (nxt >> 8);
        if (F.lane < 32) for (int t = ps >> 8; t < endt; ++t) tab[t] = F.lane;
        if (F.lane == 0) F.w<int>(WS_CTL)[CW_NT + l] = ntiles;
    }
    const int nrows = (l == 0) ? T : L;
    for (int a0 = (F.bid * 8 + F.wave) * 64; a0 < nrows * 4; a0 += F.G * 8 * 64) {
        const int a = a0 + F.lane;
        if (a < nrows * 4) {
            const int e = F.w<int>(WS_RE)[a], pos = F.w<int>(WS_RP)[a];
            const int dst = __shfl(ps, e) + pos;
            F.w<int>(WS_SLOT)[a] = dst;
            F.w<int>(WS_ROWTOK)[(size_t)l * MAXROWS + dst] = a >> 2;
        }
    }
}

__device__ __forceinline__ void ph_final(const Frame& F, int l) {
    const int nrows = (l == 0) ? T : L;
    const int nwaves = F.G * 8, lane = F.lane;
    const bf16_t* Y = F.w<bf16_t>(WS_Y) + (size_t)l * MAXROWS * D;
    int slotn[2][4]; float wgtn[2][4];
#define FN_SLOTS(r0_) do { _Pragma("unroll") for (int u = 0; u < 2; ++u) { const int rr_ = ((r0_) + u * nwaves < nrows) ? (r0_) + u * nwaves : (r0_); \
        _Pragma("unroll") for (int k = 0; k < 4; ++k) { slotn[u][k] = F.w<int>(WS_SLOT)[rr_ * 4 + k]; wgtn[u][k] = F.w<float>(WS_RW)[rr_ * 4 + k]; } } } while (0)
    const int rfirst = F.bid * 8 + F.wave;
    if (rfirst < nrows) FN_SLOTS(rfirst);
    for (int row0 = rfirst; row0 < nrows; row0 += 2 * nwaves) {
        int rw[2]; bool vld[2];
        rw[0] = row0; vld[0] = true; vld[1] = (row0 + nwaves < nrows); rw[1] = vld[1] ? row0 + nwaves : row0;
        int slot[2][4]; float wgt[2][4];
#pragma unroll
        for (int u = 0; u < 2; ++u)
#pragma unroll
            for (int k = 0; k < 4; ++k) { slot[u][k] = slotn[u][k]; wgt[u][k] = wgtn[u][k]; }
        u32x2 yv[2][4][4]; f32x4 x[2][4];
#pragma unroll
        for (int u = 0; u < 2; ++u) {
#pragma unroll
            for (int k = 0; k < 4; ++k) { const bf16_t* yr = Y + (size_t)slot[u][k] * D;
#pragma unroll
                for (int i = 0; i < 4; ++i) yv[u][k][i] = *(const u32x2*)(yr + 4 * lane + 256 * i); }
            load_xrow(F, 1, rw[u], lane, x[u]);
        }
        if (row0 + 2 * nwaves < nrows) FN_SLOTS(row0 + 2 * nwaves);
#pragma unroll
        for (int u = 0; u < 2; ++u) {
            const int which = rw[u] >= L;
            const float* ve = vecs_ptr(F, l, which, 5);
            f32x4 f[4];
#pragma unroll
            for (int i = 0; i < 4; ++i) f[i] = (f32x4){0.f, 0.f, 0.f, 0.f};
#pragma unroll
            for (int k = 0; k < 4; ++k)
#pragma unroll
                for (int i = 0; i < 4; ++i) { const u32x2 w = yv[u][k][i]; f[i][0] += wgt[u][k] * bflo(w.x); f[i][1] += wgt[u][k] * bfhi(w.x); f[i][2] += wgt[u][k] * bflo(w.y); f[i][3] += wgt[u][k] * bfhi(w.y); }
            const float rs = row_rstd(f);
#pragma unroll
            for (int i = 0; i < 4; ++i) { const f32x4 a = *(const f32x4*)(ve + 4 * lane + 256 * i); x[u][i] = x[u][i] + f[i] * rs * a; }
            if (vld[u]) {
                if (l == 1) { float* xo = F.out + (size_t)rw[u] * D;
#pragma unroll
                    for (int i = 0; i < 4; ++i) *(f32x4*)(xo + 4 * lane + 256 * i) = x[u][i]; }
                else store_xrow_bf16(F.w<bf16_t>(WS_XCUR) + (size_t)rw[u] * D, lane, x[u]);
                if (l == 0) {
                    const float rstd = row_rstd(x[u]);
                    const float* va = vecs_ptr(F, 1, which, 0), *vb = vecs_ptr(F, 1, which, 1);
                    bf16_t* orow = F.w<bf16_t>(WS_HB) + (size_t)rw[u] * D;
#pragma unroll
                    for (int i = 0; i < 4; ++i) {
                        const int c = 4 * lane + 256 * i;
                        const f32x4 a = *(const f32x4*)(va + c), b = *(const f32x4*)(vb + c);
                        u32x2 w; w.x = pk_bf16(x[u][i][0] * rstd * a[0] + b[0], x[u][i][1] * rstd * a[1] + b[1]); w.y = pk_bf16(x[u][i][2] * rstd * a[2] + b[2], x[u][i][3] * rstd * a[3] + b[3]);
                        *(u32x2*)(orow + c) = w;
                    }
                }
            }
        }
    }
#undef FN_SLOTS
}

constexpr int PH_PER_LAYER = 10, N_PHASES = 2 + 2 * PH_PER_LAYER;
#ifndef PH_MASK
#define PH_MASK 0xFFFFFFFFu
#endif
#define EN(b) (((PH_MASK) >> (b)) & 1u)
#ifndef DUP_MASK
#define DUP_MASK 0u
#endif
#define REP(b) for (int _rep = 0; _rep < 1 + (int)(((DUP_MASK) >> (b)) & 1u); ++_rep)

__global__ void __launch_bounds__(NTHREADS, 2) mega(Args args) {
    extern __shared__ __attribute__((aligned(16))) unsigned char shm[];
    Frame F0;
    F0.in.kp = (kargp_t)__builtin_amdgcn_kernarg_segment_ptr();
    F0.out = args.out; F0.ws = args.ws; F0.lds = (LAS unsigned char*)shm;
    F0.tid = threadIdx.x; F0.lane = F0.tid & 63; F0.wave = __builtin_amdgcn_readfirstlane(F0.tid >> 6); F0.G = gridDim.x; F0.bid = blockIdx.x;
    volatile LAS unsigned* bst = (volatile LAS unsigned*)(shm + LDS_BYTES - 16);
    XcdBarrier bar; bar.bar = F0.w<unsigned>(WS_CTL) + CW_BAR; bar.x = 0; bar.st = bst;
#if N_LAUNCH_MODE == 1
    if (F0.tid == 0) { bst[0] = 0u; bst[1] = 0u; }
    __syncthreads();
    bar = xcd_barrier_post(F0.w<unsigned>(WS_CTL) + CW_BAR, bst);
#define GRID_BAR() xcd_barrier(bar)
#else
#define GRID_BAR() do {} while (0)
#endif
    const int lo = args.ph_lo, hi = args.ph_hi;
#define IN(k) (lo <= (k) && (k) < hi)
#define SEAM(k) do { if (IN(k) && IN((k) + 1)) GRID_BAR(); } while (0)

    if (IN(0)) { const Frame F = launder(F0); REP(0) ph_convert(F); REP(1) ph_modpart(F); REP(2) ph_filter(F); }
    SEAM(0);
    if (IN(1)) { const Frame F = launder(F0); REP(3) ph_norm1(F, 0); REP(4) ph_fsum(F); ph_vecs(F); }
    SEAM(1);
    for (int l = 0; l < 2; ++l) {
        const int pb = 2 + l * PH_PER_LAYER;
        if (EN(5) && IN(pb + 0)) { const Frame F = launder(F0);
            pg8::Gemm g{F.w<bf16_t>(WS_HB), F.w<bf16_t>(WS_WINT) + (size_t)l * PC * D, D};
            pg8::SchedGrid S{PC / 256, (T / 256) * (PC / 256), F.G, F.vid};
            pg8::EpiBf16 E{F.w<bf16_t>(WS_P), PC, nullptr, 0};
            REP(5) pg8::gemm_phase<pg8::EpiBf16, pg8::SchedGrid>(F.lds, g, S, E, F.tid);
        }
        SEAM(pb + 0);
        if (IN(pb + 1)) { const Frame F = launder(F0); REP(6) ph_ssd_prep(F, l); REP(7) ph_hy_prep(F, l); REP(8) ph_na(F, l, 0); }
        SEAM(pb + 1);
        if (IN(pb + 2)) { const Frame F = launder(F0); REP(9) ph_ssd_scan(F); REP(10) { ph_hy_conv(F, l); if (l == 0) ph_hy_conv_ctx(F, l); } }
        SEAM(pb + 2);
        if (EN(11) && IN(pb + 3)) { const Frame F = launder(F0); REP(11) ph_ssd_out(F, l); REP(18) ph_hy_tr(F); if (l == 0) ph_na(F, l, 1); }
        SEAM(pb + 3);
        if (EN(12) && IN(pb + 4)) { const Frame F = launder(F0);
            pg8::Gemm g{F.w<bf16_t>(WS_MIX), F.w<bf16_t>(WS_WOUTT) + (size_t)l * D * D, D};
            const int nM = (l == 0) ? T / 256 : L / 256;
            pg8::SchedGrid S{4, nM * 4, F.G, F.vid};
            pg8::EpiBf16 E{F.w<bf16_t>(WS_MIXO), D, nullptr, 0};
            REP(12) pg8::gemm_phase<pg8::EpiBf16, pg8::SchedGrid>(F.lds, g, S, E, F.tid);
        }
        SEAM(pb + 4);
        if (EN(13) && IN(pb + 5)) { const Frame F = launder(F0); ph_post1(F, l); }
        SEAM(pb + 5);
        if (EN(14) && IN(pb + 6)) { const Frame F = launder(F0); REP(14) ph_gather(F, l); }
        SEAM(pb + 6);
        if (EN(15) && IN(pb + 7)) { const Frame F = launder(F0);
            const int* tab = F.w<int>(WS_CTL) + CW_TILE + l * 320;
            const int ntiles = __builtin_amdgcn_readfirstlane(F.w<int>(WS_CTL)[CW_NT + l]);
            pg8::Gemm g{F.w<bf16_t>(WS_H2), (const bf16_t*)(F.w<unsigned char>(WS_WGUT) + (size_t)l * NE * 2048 * D), D / 2};
            pg8::SchedMoe S{8, ntiles * 8, F.G, F.vid, tab};
            pg8::EpiAct E{F.w<unsigned char>(WS_HMID) + (size_t)l * MAXROWS * D, F.in[I_BGU] + (size_t)l * NE * 2048};
            LAS int* rowtab = (LAS int*)(F.lds + pg8::STAGE_BYTES);
            __syncthreads();
            {
                int nt_; const int ps = expert_pad_start(F, l, nt_);
                const unsigned* cnt = F.w<unsigned>(WS_CTL) + CW_CNT + l * 1024;
                for (int ui = 0; ui * F.G + F.vid < ntiles * 8 && ui < 12; ++ui) {
                    const int pa = (ui * F.G + F.vid) / 8;
                    const int e = tab[pa];
                    const int pstart = __shfl(ps, e), ce = (int)__hip_atomic_load(cnt + e * 32, __ATOMIC_RELAXED, __HIP_MEMORY_SCOPE_AGENT);
                    if (F.tid < 256) { const int prow = pa * 256 + F.tid; rowtab[ui * 256 + F.tid] = (prow - pstart < ce) ? F.w<int>(WS_ROWTOK)[(size_t)l * MAXROWS + prow] : T; }
                }
            }
            __syncthreads();
            REP(15) pg8::gemm_phase<pg8::EpiAct, pg8::SchedMoe, true, true, true>(F.lds, g, S, E, F.tid, rowtab);
        }
        SEAM(pb + 7);
        if (EN(16) && IN(pb + 8)) { const Frame F = launder(F0);
            const int* tab = F.w<int>(WS_CTL) + CW_TILE + l * 320;
            const int ntiles = __builtin_amdgcn_readfirstlane(F.w<int>(WS_CTL)[CW_NT + l]);
            pg8::Gemm g{(const bf16_t*)(F.w<unsigned char>(WS_HMID) + (size_t)l * MAXROWS * D), (const bf16_t*)(F.w<unsigned char>(WS_WDT) + (size_t)l * NE * D * D), D / 2};
            pg8::SchedMoe S{4, ntiles * 4, F.G, F.vid, tab};
            pg8::EpiBf16 E{F.w<bf16_t>(WS_Y) + (size_t)l * MAXROWS * D, D, F.in[I_BDN] + (size_t)l * NE * D, D};
            REP(16) pg8::gemm_phase<pg8::EpiBf16, pg8::SchedMoe, true, false, true>(F.lds, g, S, E, F.tid);
        }
        SEAM(pb + 8);
        if (EN(17) && IN(pb + 9)) { const Frame F = launder(F0); ph_final(F, l); }
        if (l == 0) SEAM(pb + 9);
    }
#undef IN
#undef SEAM
}

extern "C" void kernel_launch(void* const* d_in, const int* in_sizes, int n_in, void* d_out, int out_size, void* d_ws, size_t ws_size, hipStream_t stream) {
    static int grid = 0;
    if (grid == 0) {
        if (n_in != N_IN || out_size != L * D || ws_size < WS_END) { fprintf(stderr, "kernel_launch: unexpected shapes: n_in %d out %d ws %zu (need %zu)\n", n_in, out_size, ws_size, (size_t)WS_END); grid = -1; return; }
        int dev = 0, cus = 0, per_cu = 0;
        if (hipGetDevice(&dev) != hipSuccess || hipDeviceGetAttribute(&cus, hipDeviceAttributeMultiprocessorCount, dev) != hipSuccess) { grid = -1; return; }
        if (hipFuncSetAttribute((const void*)mega, hipFuncAttributeMaxDynamicSharedMemorySize, LDS_BYTES) != hipSuccess) { fprintf(stderr, "kernel_launch: hipFuncSetAttribute failed\n"); grid = -1; return; }
        if (hipOccupancyMaxActiveBlocksPerMultiprocessor(&per_cu, (const void*)mega, NTHREADS, LDS_BYTES) != hipSuccess || per_cu < 1) { fprintf(stderr, "kernel_launch: occupancy query says %d\n", per_cu); }
        (void)hipGetLastError();
        grid = cus;
    }
    if (grid < 0) return;
    (void)hipMemsetAsync((char*)d_ws + WS_CTL, 0, CTL_BYTES, stream);
    Args a{};
    for (int i = 0; i < N_IN; ++i) a.in[i] = (const float*)d_in[i];
    a.out = (float*)d_out; a.ws = (unsigned char*)d_ws;
#if N_LAUNCH_MODE == 1
    a.ph_lo = 0; a.ph_hi = N_PHASES;
    hipLaunchKernelGGL(mega, dim3(grid), dim3(NTHREADS), LDS_BYTES, stream, a);
#else
    for (int p = 0; p < N_PHASES; ++p) { a.ph_lo = p; a.ph_hi = p + 1; hipLaunchKernelGGL(mega, dim3(grid), dim3(NTHREADS), LDS_BYTES, stream, a); }
#endif
}
```

```cpp
#include <hip/hip_runtime.h>
#include <cstdio>
#include <cstdint>

#define LAS __attribute__((address_space(3)))
typedef unsigned short bf16_t;
typedef short bf16x8 __attribute__((ext_vector_type(8)));
typedef float f32x4 __attribute__((ext_vector_type(4)));
typedef float f32x16 __attribute__((ext_vector_type(16)));
typedef unsigned u32x4 __attribute__((ext_vector_type(4)));
typedef unsigned u32x2 __attribute__((ext_vector_type(2)));
typedef int v4i __attribute__((ext_vector_type(4)));
typedef int v8i __attribute__((ext_vector_type(8)));

#ifndef N_LAUNCH_MODE
#define N_LAUNCH_MODE 1
#endif

constexpr int D = 1024, L = 16384, LC = 256, T = L + LC, NCH = T / 128;
constexpr int PC = 3328;
constexpr int CZ = 0, CXBC = 384, CQ = 1280, CK = 1664, CV = 2048, CHY = 2432, CDT = 3200;
constexpr int NE = 32;
constexpr int MAXT = 292;
constexpr int MAXROWS = MAXT * 256;
constexpr int NTHREADS = 512;
constexpr int LDS_BYTES = 160 * 1024;
constexpr float RMS_EPS = 1e-6f;

enum { I_X = 0, I_C, I_CTX, I_CCTX, I_WMOD, I_BMOD, I_NORMG, I_WIN, I_SCW, I_SCB, I_ALOG, I_DTB, I_SSDD, I_SSDNG, I_RPB, I_HCW, I_HCB,
       I_FW1, I_FB1, I_FW2, I_FB2, I_FW3, I_FREQ, I_HYD, I_WOUT, I_WR, I_BR, I_WGU, I_BGU, I_WDN, I_BDN, N_IN };

constexpr size_t al256(size_t x) { return (x + 255) & ~(size_t)255; }
constexpr size_t WS_CTL   = 0;
constexpr size_t CTL_BYTES = 64 * 1024;
constexpr size_t WS_WINT  = WS_CTL + CTL_BYTES;
constexpr size_t WS_WOUTT = WS_WINT + al256((size_t)2 * PC * D * 2);
constexpr size_t WS_WGUT  = WS_WOUTT + al256((size_t)2 * D * D * 2);
constexpr size_t WS_WDT   = WS_WGUT + al256((size_t)2 * NE * 2048 * D * 2);
constexpr size_t WS_MODP  = WS_WDT + al256((size_t)2 * NE * D * D * 2);
constexpr int KRL = 2 * L + 512;
constexpr size_t WS_KR    = WS_MODP + al256((size_t)2 * 2 * 32 * 6144 * 4);
constexpr size_t WS_KCOMBC= WS_KR + al256((size_t)2 * 256 * KRL * 2);
constexpr size_t WS_FPART = WS_KCOMBC + al256((size_t)2 * LC * 256 * 4);
constexpr size_t WS_FPARTC= WS_FPART + al256((size_t)2 * 256 * 512 * 4);
constexpr size_t WS_FSUM  = WS_FPARTC + al256((size_t)16 * 512 * 4);
constexpr size_t WS_HB    = WS_FSUM + al256((size_t)3 * 256 * 4);
constexpr size_t WS_P     = WS_HB + al256((size_t)T * D * 2);
constexpr size_t WS_XBC   = WS_P + al256((size_t)T * PC * 2);
constexpr size_t WS_DTV   = WS_XBC + al256((size_t)T * 896 * 2);
constexpr size_t WS_ACS   = WS_DTV + al256((size_t)T * 12 * 4);
constexpr size_t WS_ALAST = WS_ACS + al256((size_t)T * 12 * 4);
constexpr size_t WS_STATES= WS_ALAST + al256((size_t)NCH * 12 * 4);
constexpr size_t WS_SSTART= WS_STATES + al256((size_t)2 * NCH * 6 * 128 * 64 * 4);
constexpr size_t WS_U     = WS_SSTART + al256((size_t)2 * NCH * 6 * 128 * 64 * 4);
constexpr size_t WS_UT    = WS_U + al256((size_t)T * 256 * 4);
constexpr size_t WS_UT8   = WS_UT + al256((size_t)256 * L * 2);
constexpr size_t WS_X0T   = WS_UT8 + al256((size_t)256 * L);
constexpr size_t WS_YT    = WS_X0T + al256((size_t)256 * L * 2);
constexpr size_t WS_MIX   = WS_YT + al256((size_t)256 * L * 2);
constexpr size_t WS_MIXO  = WS_MIX + al256((size_t)T * D * 2);
constexpr size_t WS_XCUR  = WS_MIXO + al256((size_t)T * D * 4);
constexpr size_t WS_H2    = WS_XCUR + al256((size_t)T * D * 4);
constexpr size_t WS_RE    = WS_H2 + al256((size_t)(T + 1) * D * 2);
constexpr size_t WS_RP    = WS_RE + al256((size_t)T * 4 * 4);
constexpr size_t WS_RW    = WS_RP + al256((size_t)T * 4 * 4);
constexpr size_t WS_SLOT  = WS_RW + al256((size_t)T * 4 * 4);
constexpr size_t WS_XG    = WS_SLOT + al256((size_t)T * 4 * 4);
constexpr size_t WS_HMID  = WS_XG + 256;
constexpr size_t WS_Y     = WS_HMID + al256((size_t)2 * MAXROWS * D * 2);
constexpr size_t WS_VECS  = WS_Y + al256((size_t)2 * MAXROWS * D * 2);
constexpr size_t WS_ROWTOK= WS_VECS + al256((size_t)2 * 2 * 6 * 1024 * 4);
constexpr size_t WS_END   = WS_ROWTOK + al256((size_t)2 * MAXROWS * 4);

constexpr int CW_BAR = 0;
constexpr int CW_CNT = 8192;
#ifndef PRO_NF
#define PRO_NF 128
#endif
constexpr int CW_CVQ = 4160;
constexpr int CW_NT = 4200;
constexpr int CW_TILE = 4224;

__device__ __forceinline__ float bf2f(unsigned short b) { return __uint_as_float(((unsigned)b) << 16); }
__device__ __forceinline__ unsigned short f2bf(float f) { unsigned u = __float_as_uint(f); u += 0x7FFFu + ((u >> 16) & 1u); return (unsigned short)(u >> 16); }
__device__ __forceinline__ unsigned pk_bf16(float lo, float hi) { return (unsigned)f2bf(lo) | ((unsigned)f2bf(hi) << 16); }
__device__ __forceinline__ float sat8(float x) { return fminf(fmaxf(x, -448.0f), 448.0f); }
__device__ __forceinline__ unsigned pk_fp8x4(float a, float b, float c, float d) { unsigned w = 0; w = __builtin_amdgcn_cvt_pk_fp8_f32(sat8(a), sat8(b), w, false); w = __builtin_amdgcn_cvt_pk_fp8_f32(sat8(c), sat8(d), w, true); return w; }
constexpr float KR_SCALE = 64.0f;
constexpr float W8_SCALE = 32.0f;
constexpr int W8_SCALE_E8M0 = 0x7A7A7A7A, ONE_E8M0 = 0x7F7F7F7F;
__device__ __forceinline__ float bflo(unsigned w) { return __uint_as_float(w << 16); }
__device__ __forceinline__ float bfhi(unsigned w) { return __uint_as_float(w & 0xFFFF0000u); }
__device__ __forceinline__ float silu_f(float x) { return x / (1.0f + __expf(-x)); }
__device__ __forceinline__ float softplus_f(float x) { return x > 20.f ? x : log1pf(__expf(x)); }
__device__ __forceinline__ float wave_sum(float v) {
#pragma unroll
    for (int o = 32; o >= 1; o >>= 1) v += __shfl_xor(v, o);
    return v;
}
__device__ __forceinline__ void lds_fence() { asm volatile("s_waitcnt lgkmcnt(0)" ::: "memory"); }

#define XB_TMO      128
#define XB_XCNT(j)  (256  + 64 * (j))
#define XB_XSUB(j)  (1280 + 64 * (j))
#define XB_XGEN(j)  (2304 + 64 * (j))
#define XB_TOP      3328
#define XB_TOPGEN   3392
#define XCD_BAR_WORDS 3456
#define XB_SPIN_CAP (1u << 18)
__device__ __forceinline__ unsigned xb_ld(unsigned* p)              { return __hip_atomic_load(p, __ATOMIC_RELAXED, __HIP_MEMORY_SCOPE_AGENT); }
__device__ __forceinline__ unsigned xb_add(unsigned* p, unsigned v) { return __hip_atomic_fetch_add(p, v, __ATOMIC_RELAXED, __HIP_MEMORY_SCOPE_AGENT); }
__device__ __forceinline__ unsigned xb_xcc_id() { return (unsigned)__builtin_amdgcn_s_getreg((3 << 11) | 20) & 0xFu; }
#define XB_SPIN(cond, bar) do { unsigned _sp = 0; while (cond) { __builtin_amdgcn_s_sleep(1); \
    if ((++_sp & 255u) == 0u) { if (xb_ld(&(bar)[XB_TMO])) break; if (_sp > XB_SPIN_CAP) { atomicAdd(&(bar)[XB_TMO], 1u); break; } } } } while (0)
struct XcdBarrier { unsigned* bar; unsigned x; volatile LAS unsigned* st; };
__device__ __forceinline__ XcdBarrier xcd_barrier_post(unsigned* bar, volatile LAS unsigned* st) {
    XcdBarrier b; b.bar = bar; b.x = xb_xcc_id(); b.st = st;
    if (threadIdx.x == 0) (void)xb_add(&bar[XB_XCNT(b.x)], 1u);
    return b;
}
__device__ __forceinline__ void xcd_barrier_complete(unsigned* bar, unsigned x, unsigned& nloc, unsigned& nx) {
    const unsigned G = gridDim.x * gridDim.y * gridDim.z;
    unsigned sum, cnt, mine, sp = 0u;
    for (;;) {
        sum = 0u; cnt = 0u; mine = 0u;
#pragma unroll
        for (unsigned j = 0; j < 16; ++j) { const unsigned c = xb_ld(&bar[XB_XCNT(j)]); sum += c; cnt += (c > 0u) ? 1u : 0u; mine = (j == x) ? c : mine; }
        if (sum == G) break;
        __builtin_amdgcn_s_sleep(1);
        if ((++sp & 255u) == 0u) { if (xb_ld(&bar[XB_TMO])) break; if (sp > XB_SPIN_CAP) { atomicAdd(&bar[XB_TMO], 1u); break; } }
    }
    nloc = mine > 0u ? mine : 1u; nx = cnt > 0u ? cnt : 1u;
}
__device__ __forceinline__ void xcd_barrier(const XcdBarrier& b) {
    asm volatile("s_waitcnt vmcnt(0)" ::: "memory");
    __syncthreads();
    if (threadIdx.x == 0) {
        unsigned* bar = b.bar;
        __builtin_amdgcn_s_waitcnt(0);
        unsigned nloc = b.st[0], nx = b.st[1];
        if (nloc == 0u) { xcd_barrier_complete(bar, b.x, nloc, nx); b.st[0] = nloc; b.st[1] = nx; }
        const unsigned old = xb_add(&bar[XB_XSUB(b.x)], 1u);
        const unsigned gen = old / nloc;
        if (old + 1u == (gen + 1u) * nloc) {
            __builtin_amdgcn_fence(__ATOMIC_RELEASE, "agent");
            asm volatile("s_waitcnt vmcnt(0)" ::: "memory");
            const unsigned og = xb_add(&bar[XB_TOP], 1u);
            const unsigned tg = og / nx;
            if (og + 1u == (tg + 1u) * nx) xb_add(&bar[XB_TOPGEN], 1u);
            else XB_SPIN(xb_ld(&bar[XB_TOPGEN]) == tg, bar);
            __builtin_amdgcn_fence(__ATOMIC_ACQUIRE, "agent");
            xb_add(&bar[XB_XGEN(b.x)], 1u);
            asm volatile("s_waitcnt vmcnt(0)" ::: "memory");
        } else {
            XB_SPIN(xb_ld(&bar[XB_XGEN(b.x)]) == gen, bar);
            __builtin_amdgcn_fence(__ATOMIC_ACQUIRE, "agent");
            asm volatile("s_waitcnt vmcnt(0)" ::: "memory");
        }
    }
    __syncthreads();
}

#ifndef GEMM_REP
#define GEMM_REP 1
#endif
namespace pg8 {
constexpr int BM = 256, BK = 64, HALF = 128, HTB = HALF * BK * 2, STAGE_BYTES = 8 * HTB;
__host__ __device__ __forceinline__ int lds_byte(int r, int c) { const int st = (r >> 4) * 2 + (c >> 5), rr = r & 15, cc = c & 31, ob = rr * 64 + cc * 2; return st * 1024 + (ob ^ (((ob >> 9) & 1) << 5)); }
__host__ __device__ __forceinline__ void stage_rc(int b, int& R, int& C) { const int st = b / 1024, sb = b % 1024, swz = sb ^ (((sb >> 9) & 1) << 5); R = (st >> 1) * 16 + swz / 64; C = (st & 1) * 32 + (swz % 64) / 2; }
__host__ __device__ __forceinline__ int perm32(int rho) { const int n = rho >> 4, i = rho & 15; return 8 * (i >> 2) + 4 * n + (i & 3); }

struct Unit { int pa, pb, pn, e; };
struct Gemm { const bf16_t* A; const bf16_t* Bt; int K; };

template <class Epi, class Sched, bool ALIGN_EPI = true, bool GATHER = false, bool FP8 = false>
__device__ __forceinline__ void gemm_phase(LAS unsigned char* lds, const Gemm g, const Sched& S, const Epi& E, const int tid, const LAS int* rowtab = nullptr) {
    const int wid = __builtin_amdgcn_readfirstlane(tid >> 6), lane = tid & 63, wr = wid >> 2, wc = wid & 3, fr = lane & 15, fq = lane >> 4;
    const int K = g.K, nt = K / BK;
    unsigned voffA[2], voffB[2];
    int gR[2], gC[2];
#pragma unroll
    for (int i = 0; i < 2; ++i) { int R, C; stage_rc(tid * 16 + i * 8192, R, C); const int Rb = Epi::PERM ? ((R & ~31) + perm32(R & 31)) : R;
        voffA[i] = (unsigned)(R * K + C) * 2u; voffB[i] = (unsigned)(Rb * K + C) * 2u; gR[i] = R; gC[i] = C * 2; }
    unsigned vC0[2], vC1[2], vN0[2], vN1[2];
#define PG8_GOFFS(dst0, dst1, ui_) do { _Pragma("unroll") for (int _i = 0; _i < 2; ++_i) { \
        dst0[_i] = (unsigned)rowtab[(ui_) * 256 + gR[_i]] * (unsigned)(K * 2) + (unsigned)gC[_i]; dst1[_i] = (unsigned)rowtab[(ui_) * 256 + 128 + gR[_i]] * (unsigned)(K * 2) + (unsigned)gC[_i]; } } while (0)
    const size_t kstep = (size_t)(BK * 2);
    const size_t hstep = (size_t)HALF * K * 2;
    const size_t tstep = 2 * hstep;
    const unsigned ldsw = (unsigned)wid * 1024u;
    const int aoff = lds_byte(wr * 64 + fr, fq * 8), boff = lds_byte(wc * 32 + fr, fq * 8);
#define PG8_SA(b, h) (((b) * 2 + (h)) * HTB)
#define PG8_SB(b, h) ((4 + (b) * 2 + (h)) * HTB)
#define PG8_STAGE(bufoff, gbase, voff) do { _Pragma("unroll") for (int _i = 0; _i < 2; ++_i) \
        __builtin_amdgcn_global_load_lds((const unsigned*)((const char*)(gbase) + (voff)[_i]), (LAS unsigned*)(lds + (bufoff) + ldsw + _i * 8192), 16, 0, 0); } while (0)
#define PG8_LDA(dst, b, h) do { _Pragma("unroll") for (int m = 0; m < 4; ++m) { const v4i _x = *(const LAS v4i*)(lds + PG8_SA(b, h) + aoff + m * 2048), _y = *(const LAS v4i*)(lds + PG8_SA(b, h) + aoff + m * 2048 + 1024); \
        dst[m] = __builtin_shufflevector(_x, _y, 0, 1, 2, 3, 4, 5, 6, 7); } } while (0)
#define PG8_LDB(dst, b, h) do { _Pragma("unroll") for (int n = 0; n < 2; ++n) { const v4i _x = *(const LAS v4i*)(lds + PG8_SB(b, h) + boff + n * 2048), _y = *(const LAS v4i*)(lds + PG8_SB(b, h) + boff + n * 2048 + 1024); \
        dst[n] = __builtin_shufflevector(_x, _y, 0, 1, 2, 3, 4, 5, 6, 7); } } while (0)
#define PG8_HALF0(x) __builtin_bit_cast(bf16x8, __builtin_shufflevector((x), (x), 0, 1, 2, 3))
#define PG8_HALF1(x) __builtin_bit_cast(bf16x8, __builtin_shufflevector((x), (x), 4, 5, 6, 7))
#define PG8_MMA(ai, bj, At, Bt) do { __builtin_amdgcn_s_setprio(1); if constexpr (FP8) { _Pragma("unroll") for (int m = 0; m < 4; ++m) _Pragma("unroll") for (int n = 0; n < 2; ++n) \
        asm volatile("v_mfma_scale_f32_16x16x128_f8f6f4 %0, %1, %2, %0, %3, %4 op_sel_hi:[0,0,0]" : "+v"(acc[ai][bj][m][n]) : "v"(Bt[n]), "v"(At[m]), "v"(sclW), "v"(sclX)); } \
        else { _Pragma("unroll") for (int m = 0; m < 4; ++m) _Pragma("unroll") for (int n = 0; n < 2; ++n) { \
        acc[ai][bj][m][n] = __builtin_amdgcn_mfma_f32_16x16x32_bf16(PG8_HALF0(Bt[n]), PG8_HALF0(At[m]), acc[ai][bj][m][n], 0, 0, 0); \
        acc[ai][bj][m][n] = __builtin_amdgcn_mfma_f32_16x16x32_bf16(PG8_HALF1(Bt[n]), PG8_HALF1(At[m]), acc[ai][bj][m][n], 0, 0, 0); } } __builtin_amdgcn_s_setprio(0); } while (0)
#define PG8_WAIT_V(n) asm volatile("s_waitcnt vmcnt(" #n ")" ::: "memory")
#define PG8_WAIT_L(n) asm volatile("s_waitcnt lgkmcnt(" #n ")" ::: "memory")
#define PG8_BAR __builtin_amdgcn_s_barrier()
#define PG8_SCHED __builtin_amdgcn_sched_barrier(0)
    Unit cur, nxt; int ui = 0;
    if (!S.next(0, cur)) return;
    f32x4 acc[2][2][4][2];
    E.init(acc, cur, wc, fq);
    const int sclW = W8_SCALE_E8M0, sclX = ONE_E8M0;
    v8i At[4], B0[2], B1[2];
    const char* cA = GATHER ? (const char*)g.A : (const char*)g.A + (size_t)cur.pa * tstep; const char* cB = (const char*)g.Bt + (size_t)cur.pb * tstep;
    const size_t hstepA = GATHER ? 0 : hstep;
    if constexpr (GATHER) { PG8_GOFFS(vC0, vC1, 0); } else {
#pragma unroll
        for (int i = 0; i < 2; ++i) { vC0[i] = voffA[i]; vC1[i] = voffA[i]; vN0[i] = voffA[i]; vN1[i] = voffA[i]; } }
    PG8_STAGE(PG8_SB(0, 0), cB, voffB); PG8_STAGE(PG8_SB(0, 1), cB + hstep, voffB); PG8_STAGE(PG8_SA(0, 0), cA, vC0); PG8_STAGE(PG8_SA(0, 1), cA + hstepA, vC1);
    if (wr == 1) PG8_BAR;
    PG8_WAIT_V(2); PG8_BAR;
    PG8_STAGE(PG8_SB(1, 0), cB + kstep, voffB); PG8_STAGE(PG8_SA(1, 0), cA + kstep, vC0); PG8_STAGE(PG8_SB(1, 1), cB + hstep + kstep, voffB);
    PG8_WAIT_V(6); PG8_BAR;
    for (;;) {
        const bool has_next = S.next(ui + 1, nxt);
        const char* nA = GATHER ? (const char*)g.A : (has_next ? (const char*)g.A + (size_t)nxt.pa * tstep : cA); const char* nB = has_next ? (const char*)g.Bt + (size_t)nxt.pb * tstep : cB;
        if constexpr (GATHER) { if (has_next) { PG8_GOFFS(vN0, vN1, ui + 1); } else {
#pragma unroll
            for (int i = 0; i < 2; ++i) { vN0[i] = vC0[i]; vN1[i] = vC1[i]; } } }
#pragma unroll 1
        for (int t = 0; t < nt; t += 2) {
            const bool last = (t == nt - 2);
            unsigned vX0[2], vX1[2];
#pragma unroll
            for (int i = 0; i < 2; ++i) { vX0[i] = (GATHER && last) ? vN0[i] : vC0[i]; vX1[i] = (GATHER && last) ? vN1[i] : vC1[i]; }
            const char* a1 = cA + (size_t)(t + 1) * kstep;
            const char* a2 = last ? nA : cA + (size_t)(t + 2) * kstep; const char* b2 = last ? nB : cB + (size_t)(t + 2) * kstep;
            const char* a3 = a2 + kstep; const char* b3 = b2 + kstep;
            PG8_LDB(B0, 0, 0); PG8_LDB(B1, 0, 1); PG8_SCHED; PG8_LDA(At, 0, 0); PG8_STAGE(PG8_SA(1, 1), a1 + hstepA, vC1);
            PG8_WAIT_V(8); PG8_WAIT_L(0); PG8_BAR; PG8_MMA(0, 0, At, B0); PG8_MMA(0, 1, At, B1); PG8_BAR; PG8_SCHED;
            PG8_LDA(At, 0, 1); PG8_STAGE(PG8_SB(0, 0), b2, voffB); PG8_STAGE(PG8_SB(0, 1), b2 + hstep, voffB); PG8_STAGE(PG8_SA(0, 0), a2, vX0);
            PG8_WAIT_V(8); PG8_WAIT_L(0); PG8_BAR; PG8_MMA(1, 0, At, B0); PG8_MMA(1, 1, At, B1); PG8_BAR; PG8_SCHED;
            PG8_LDB(B0, 1, 0); PG8_LDB(B1, 1, 1); PG8_SCHED; PG8_LDA(At, 1, 0); PG8_STAGE(PG8_SA(0, 1), a2 + hstepA, vX1);
            PG8_WAIT_V(8); PG8_WAIT_L(0); PG8_BAR; PG8_MMA(0, 0, At, B0); PG8_MMA(0, 1, At, B1); PG8_BAR; PG8_SCHED;
            PG8_LDA(At, 1, 1); PG8_STAGE(PG8_SB(1, 0), b3, voffB); PG8_STAGE(PG8_SB(1, 1), b3 + hstep, voffB); PG8_STAGE(PG8_SA(1, 0), a3, vX0);
            PG8_WAIT_V(8); PG8_WAIT_L(0); PG8_BAR; PG8_MMA(1, 0, At, B0); PG8_MMA(1, 1, At, B1); PG8_BAR; PG8_SCHED;
        }
        if constexpr (ALIGN_EPI) { if (wr == 0) PG8_BAR; }
        E(acc, cur, wr, wc, fr, fq);
        if (!has_next) break;
        E.init(acc, nxt, wc, fq);
        cur = nxt; cA = nA; cB = nB; ++ui;
        if constexpr (GATHER) {
#pragma unroll
            for (int i = 0; i < 2; ++i) { vC0[i] = vN0[i]; vC1[i] = vN1[i]; } }
        if constexpr (ALIGN_EPI) { if (wr == 1) PG8_BAR; }
    }
    PG8_WAIT_V(0);
    if constexpr (!ALIGN_EPI) { if (wr == 0) PG8_BAR; }
    PG8_BAR;
#undef PG8_GOFFS
#undef PG8_HALF0
#undef PG8_HALF1
#undef PG8_SA
#undef PG8_SB
#undef PG8_STAGE
#undef PG8_LDA
#undef PG8_LDB
#undef PG8_MMA
#undef PG8_WAIT_V
#undef PG8_WAIT_L
#undef PG8_BAR
#undef PG8_SCHED
}

struct EpiF32 {
    static constexpr bool PERM = false;
    float* C; int ldc;
    __device__ __forceinline__ void operator()(const f32x4 (&acc)[2][2][4][2], const Unit& u, int wr, int wc, int fr, int fq) const {
        const int row0 = u.pa * BM + wr * 64 + fr, col0 = u.pn * BM + wc * 32 + 4 * fq;
#pragma unroll
        for (int ai = 0; ai < 2; ++ai)
#pragma unroll
            for (int m = 0; m < 4; ++m) { float* rowp = C + (size_t)(row0 + ai * HALF + m * 16) * ldc + col0;
#pragma unroll
                for (int bj = 0; bj < 2; ++bj)
#pragma unroll
                    for (int n = 0; n < 2; ++n) *(f32x4*)(rowp + bj * HALF + n * 16) = acc[ai][bj][m][n]; }
    }
};
struct EpiBf16 {
    static constexpr bool PERM = true;
    bf16_t* O; int ldc; const float* bias; int bias_stride;
    __device__ __forceinline__ void init(f32x4 (&acc)[2][2][4][2], const Unit& u, int wc, int fq) const {
        const int col0 = u.pn * BM + wc * 32 + 8 * fq;
#pragma unroll
        for (int bj = 0; bj < 2; ++bj)
#pragma unroll
            for (int n = 0; n < 2; ++n) { const f32x4 bv = bias ? *(const f32x4*)(bias + (size_t)u.e * bias_stride + col0 + bj * HALF + 4 * n) : (f32x4){0.f, 0.f, 0.f, 0.f};
#pragma unroll
                for (int ai = 0; ai < 2; ++ai)
#pragma unroll
                    for (int m = 0; m < 4; ++m) acc[ai][bj][m][n] = bv; }
    }
    __device__ __forceinline__ void operator()(const f32x4 (&acc)[2][2][4][2], const Unit& u, int wr, int wc, int fr, int fq) const {
        const int row0 = u.pa * BM + wr * 64 + fr; const int col0 = u.pn * BM + wc * 32 + 8 * fq;
#pragma unroll
        for (int ai = 0; ai < 2; ++ai)
#pragma unroll
            for (int m = 0; m < 4; ++m) { bf16_t* rowp = O + (size_t)(row0 + ai * HALF + m * 16) * ldc + col0;
#pragma unroll
                for (int bj = 0; bj < 2; ++bj) { const f32x4 v0 = acc[ai][bj][m][0], v1 = acc[ai][bj][m][1];
                    u32x4 w; w.x = pk_bf16(v0[0], v0[1]); w.y = pk_bf16(v0[2], v0[3]); w.z = pk_bf16(v1[0], v1[1]); w.w = pk_bf16(v1[2], v1[3]);
                    *(u32x4*)(rowp + bj * HALF) = w; } }
    }
};
struct EpiAct {
    static constexpr bool PERM = true;
    unsigned char* O; const float* bias;
    __device__ __forceinline__ void init(f32x4 (&acc)[2][2][4][2], const Unit& u, int wc, int fq) const {
        const float* bg = bias + (size_t)u.e * 2048 + u.pn * 128 + wc * 32 + 8 * fq;
#pragma unroll
        for (int bj = 0; bj < 2; ++bj)
#pragma unroll
            for (int n = 0; n < 2; ++n) { const f32x4 bv = *(const f32x4*)(bg + bj * 1024 + 4 * n);
#pragma unroll
                for (int ai = 0; ai < 2; ++ai)
#pragma unroll
                    for (int m = 0; m < 4; ++m) acc[ai][bj][m][n] = bv; }
    }
    __device__ __forceinline__ void operator()(const f32x4 (&acc)[2][2][4][2], const Unit& u, int wr, int wc, int fr, int fq) const {
        const int row0 = u.pa * BM + wr * 64 + fr; const int cc0 = wc * 32 + 8 * fq; const int ocol = u.pn * 128 + cc0;
#pragma unroll
        for (int ai = 0; ai < 2; ++ai)
#pragma unroll
            for (int m = 0; m < 4; ++m) { unsigned char* rowp = O + (size_t)(row0 + ai * HALF + m * 16) * D + ocol;
                float r[8];
#pragma unroll
                for (int n = 0; n < 2; ++n)
#pragma unroll
                    for (int j = 0; j < 4; ++j) { float gt = acc[ai][0][m][n][j], up = acc[ai][1][m][n][j];
                        gt = fminf(gt, 7.0f); up = fminf(fmaxf(up, -7.0f), 7.0f);
                        r[n * 4 + j] = gt / (1.0f + __expf(-1.702f * gt)) * (up + 1.0f); }
                u32x2 w; w.x = pk_fp8x4(r[0], r[1], r[2], r[3]); w.y = pk_fp8x4(r[4], r[5], r[6], r[7]);
                *(u32x2*)rowp = w; }
    }
};
struct SchedGrid {
    int nN, total, G, c;
    __device__ __forceinline__ bool next(int i, Unit& u) const { int Lx = i * G + c; if (Lx >= GEMM_REP * total) return false; if (GEMM_REP > 1) Lx %= total; u.pa = Lx / nN; u.pn = Lx - u.pa * nN; u.pb = u.pn; u.e = 0; return true; }
};
struct SchedMoe {
    int nN, total, G, c; const int* tile_e;
    __device__ __forceinline__ bool next(int i, Unit& u) const { int Lx = i * G + c; if (Lx >= GEMM_REP * total) return false; if (GEMM_REP > 1) Lx %= total; u.pa = Lx / nN; u.pn = Lx - u.pa * nN; u.e = __builtin_amdgcn_readfirstlane((int)tile_e[u.pa]); u.pb = u.e * nN + u.pn; return true; }
};
}

struct Args { const float* in[N_IN]; float* out; unsigned char* ws; int ph_lo, ph_hi; };

typedef const float* __attribute__((address_space(4))) const* kargp_t;
struct InProxy { kargp_t kp; __device__ __forceinline__ const float* operator[](int i) const { return kp[i]; } };
struct Frame {
    InProxy in; float* out; unsigned char* ws;
    LAS unsigned char* lds;
    int tid, lane, wave, G, bid, vid;
    template <class Tp> __device__ __forceinline__ Tp* w(size_t off) const { return (Tp*)(ws + off); }
};

__device__ __forceinline__ Frame launder(const Frame& F) {
    Frame R = F;
    int t = F.tid; asm volatile("" : "+v"(t)); R.tid = t; R.lane = t & 63; R.wave = __builtin_amdgcn_readfirstlane(t >> 6);
    unsigned long long w = (unsigned long long)F.ws; asm volatile("" : "+s"(w)); R.ws = (unsigned char*)w;
    unsigned long long o = (unsigned long long)F.out; asm volatile("" : "+s"(o)); R.out = (float*)o;
    unsigned long long k = (unsigned long long)F.in.kp; asm volatile("" : "+s"(k)); R.in.kp = (kargp_t)k;
    int g = F.G, b = F.bid; asm volatile("" : "+s"(g), "+s"(b)); R.G = g; R.bid = b; R.vid = (g % 8 == 0) ? (b % 8) * (g / 8) + b / 8 : b;
    return R;
}

__device__ __forceinline__ float mod_val(const Frame& F, int l, int which, int j) {
    const float* mp = F.w<float>(WS_MODP) + (size_t)((l * 2 + which) * 32) * 6144 + j;
    float s = F.in[I_BMOD][l * 6144 + j];
#pragma unroll
    for (int k = 0; k < 32; ++k) s += mp[(size_t)k * 6144];
    return s;
}

struct CvtTile { const float* src; bf16_t* dst; int ld, mode, k0, n0; bool f8; };
__device__ __forceinline__ CvtTile cvt_decode(const Frame& F, int t) {
    CvtTile c;
    if (t < 1664) { const int l = t / 832, r = t % 832; c.n0 = (r / 16) * 64; c.k0 = (r % 16) * 64; c.src = F.in[I_WIN] + (size_t)l * 1024 * 3212; c.ld = 3212; c.mode = 1; c.f8 = false; c.dst = F.w<bf16_t>(WS_WINT) + (size_t)l * PC * D; }
    else if (t < 2176) { const int q = t - 1664, l = q / 256, r = q % 256; c.n0 = (r / 16) * 64; c.k0 = (r % 16) * 64; c.src = F.in[I_WOUT] + (size_t)l * D * D; c.ld = 1024; c.mode = 0; c.f8 = false; c.dst = F.w<bf16_t>(WS_WOUTT) + (size_t)l * D * D; }
    else if (t < 34944) { const int q = t - 2176, le = q / 512, r = q % 512; c.n0 = (r / 16) * 64; c.k0 = (r % 16) * 64; c.src = F.in[I_WGU] + (size_t)le * 1024 * 2048; c.ld = 2048; c.mode = 2; c.f8 = true; c.dst = (bf16_t*)(F.w<unsigned char>(WS_WGUT) + (size_t)le * 2048 * D); }
    else { const int q = t - 34944, le = q / 256, r = q % 256; c.n0 = (r / 16) * 64; c.k0 = (r % 16) * 64; c.src = F.in[I_WDN] + (size_t)le * D * D; c.ld = 1024; c.mode = 0; c.f8 = true; c.dst = (bf16_t*)(F.w<unsigned char>(WS_WDT) + (size_t)le * D * D); }
    return c;
}
__device__ __forceinline__ void cvt_load(const CvtTile& c, int lane, f32x4 (&a)[8], f32x4 (&b)[8]) {
    const int i4 = lane & 15, kpl = lane >> 4;
    const int n = c.n0 + 4 * i4;
    int sc; bool valid = true;
    if (c.mode == 0) sc = n;
    else if (c.mode == 1) { if (n < 1280) sc = n; else if (n < 3200) sc = n + 12; else if (n < 3212) sc = n - 3200 + 1280; else { sc = 0; valid = false; } }
    else { const int pn = n >> 8, rr = n & 255; sc = rr < 128 ? pn * 128 + rr : 1024 + pn * 128 + (rr - 128); }
#pragma unroll
    for (int it = 0; it < 8; ++it) {
        const int r0 = c.f8 ? 4 * (kpl + 4 * (it >> 1)) + 2 * (it & 1) : 2 * (kpl + 4 * it);
        a[it] = (f32x4){0.f, 0.f, 0.f, 0.f}; b[it] = a[it];
        if (valid) { a[it] = __builtin_nontemporal_load((const f32x4*)(c.src + (size_t)(c.k0 + r0) * c.ld + sc)); b[it] = __builtin_nontemporal_load((const f32x4*)(c.src + (size_t)(c.k0 + r0 + 1) * c.ld + sc)); }
    }
}
__device__ __forceinline__ void cvt_store(const CvtTile& c, int lane, const f32x4 (&a)[8], const f32x4 (&b)[8], LAS unsigned* lw) {
    const int i4 = lane & 15, kpl = lane >> 4;
    if (c.f8) {
#pragma unroll
        for (int j = 0; j < 4; ++j) {
            const int kq = kpl + 4 * j;
#pragma unroll
            for (int i = 0; i < 4; ++i) lw[kq * 65 + 4 * i4 + i] = pk_fp8x4(W8_SCALE * a[2 * j][i], W8_SCALE * b[2 * j][i], W8_SCALE * a[2 * j + 1][i], W8_SCALE * b[2 * j + 1][i]);
        }
        lds_fence();
        const int g = lane & 3, nl = lane >> 2;
        unsigned char* d8 = (unsigned char*)c.dst;
#pragma unroll
        for (int it = 0; it < 4; ++it) {
            const int nn = nl + 16 * it;
            u32x4 v; v.x = lw[(4 * g + 0) * 65 + nn]; v.y = lw[(4 * g + 1) * 65 + nn]; v.z = lw[(4 * g + 2) * 65 + nn]; v.w = lw[(4 * g + 3) * 65 + nn];
            *(u32x4*)(d8 + (size_t)(c.n0 + nn) * 1024 + c.k0 + 16 * g) = v;
        }
        lds_fence();
        return;
    }
#pragma unroll
    for (int it = 0; it < 8; ++it) {
        const int kp = kpl + 4 * it;
#pragma unroll
        for (int i = 0; i < 4; ++i) lw[kp * 65 + 4 * i4 + i] = pk_bf16(a[it][i], b[it][i]);
    }
    lds_fence();
    const int g = lane & 7, nl = lane >> 3;
#pragma unroll
    for (int it = 0; it < 8; ++it) {
        const int nn = nl + 8 * it;
        u32x4 v; v.x = lw[(4 * g + 0) * 65 + nn]; v.y = lw[(4 * g + 1) * 65 + nn]; v.z = lw[(4 * g + 2) * 65 + nn]; v.w = lw[(4 * g + 3) * 65 + nn];
        *(u32x4*)(c.dst + (size_t)(c.n0 + nn) * 1024 + c.k0 + 8 * g) = v;
    }
    lds_fence();
}

__device__ __forceinline__ void cvt_store8x2(const CvtTile& c, int lane, const f32x4 (&a0)[8], const f32x4 (&b0)[8], const f32x4 (&a1)[8], const f32x4 (&b1)[8], LAS unsigned* lw) {
    const int i4 = lane & 15, kpl = lane >> 4;
#pragma unroll
    for (int j = 0; j < 4; ++j) {
        const int kq = kpl + 4 * j;
#pragma unroll
        for (int i = 0; i < 4; ++i) {
            lw[kq * 65 + 4 * i4 + i] = pk_fp8x4(W8_SCALE * a0[2 * j][i], W8_SCALE * b0[2 * j][i], W8_SCALE * a0[2 * j + 1][i], W8_SCALE * b0[2 * j + 1][i]);
            lw[(16 + kq) * 65 + 4 * i4 + i] = pk_fp8x4(W8_SCALE * a1[2 * j][i], W8_SCALE * b1[2 * j][i], W8_SCALE * a1[2 * j + 1][i], W8_SCALE * b1[2 * j + 1][i]);
        }
    }
    lds_fence();
    const int g = lane & 7, nl = lane >> 3;
    unsigned char* d8 = (unsigned char*)c.dst;
#pragma unroll
    for (int it = 0; it < 8; ++it) {
        const int nn = nl + 8 * it;
        u32x4 v; v.x = lw[(4 * g + 0) * 65 + nn]; v.y = lw[(4 * g + 1) * 65 + nn]; v.z = lw[(4 * g + 2) * 65 + nn]; v.w = lw[(4 * g + 3) * 65 + nn];
        *(u32x4*)(d8 + (size_t)(c.n0 + nn) * 1024 + c.k0 + 16 * g) = v;
    }
    lds_fence();
}
__device__ __forceinline__ void ph_convert(const Frame& F) {
    LAS unsigned* lw = (LAS unsigned*)(F.lds) + F.wave * (32 * 65 + 16);
    const int nwaves = F.G * 8, w0 = F.bid * 8 + F.wave;
    f32x4 a0[8], b0[8], a1[8], b1[8];
    for (int t = w0; t < 2176; t += nwaves) { const CvtTile c = cvt_decode(F, t); cvt_load(c, F.lane, a0, b0); cvt_store(c, F.lane, a0, b0, lw); }
    unsigned* ctr = F.w<unsigned>(WS_CTL) + CW_CVQ;
    for (;;) {
        unsigned tb = 0;
        if (F.lane == 0) tb = atomicAdd(ctr, 4u);
        tb = __builtin_amdgcn_readfirstlane(tb);
        if (tb >= 16384u + 8192u) break;
        for (int t = (int)tb; t < (int)tb + 4; ++t) {
            CvtTile c; c.f8 = true;
            if (t < 16384) { const int le = t >> 8, r = t & 255; c.n0 = (r >> 3) * 64; c.k0 = (r & 7) * 128; c.src = F.in[I_WGU] + (size_t)le * 1024 * 2048; c.ld = 2048; c.mode = 2; c.dst = (bf16_t*)(F.w<unsigned char>(WS_WGUT) + (size_t)le * 2048 * D); }
            else { const int q = t - 16384, le = q >> 7, r = q & 127; c.n0 = (r >> 3) * 64; c.k0 = (r & 7) * 128; c.src = F.in[I_WDN] + (size_t)le * D * D; c.ld = 1024; c.mode = 0; c.dst = (bf16_t*)(F.w<unsigned char>(WS_WDT) + (size_t)le * D * D); }
            cvt_load(c, F.lane, a0, b0);
            CvtTile c2 = c; c2.k0 = c.k0 + 64;
            cvt_load(c2, F.lane, a1, b1);
            cvt_store8x2(c, F.lane, a0, b0, a1, b1, lw);
        }
    }
}

__device__ __forceinline__ void ph_modpart(const Frame& F) {
    if (F.bid >= PRO_NF) return;
    for (int it = F.bid; it < 768; it += PRO_NF) {
        const int l = it / 384, r = it % 384, cc = r / 32, kc = r % 32;
        const int j = cc * 512 + F.tid;
        const float* wm = F.in[I_WMOD] + (size_t)l * D * 6144 + (size_t)(kc * 32) * 6144 + j;
        float wv[32];
#pragma unroll
        for (int k = 0; k < 32; ++k) wv[k] = wm[(size_t)k * 6144];
        float a0 = 0.f, a1 = 0.f;
#pragma unroll
        for (int k = 0; k < 32; ++k) { a0 += silu_f(F.in[I_C][kc * 32 + k]) * wv[k]; a1 += silu_f(F.in[I_CCTX][kc * 32 + k]) * wv[k]; }
        float* mp = F.w<float>(WS_MODP);
        mp[(size_t)((l * 2 + 0) * 32 + kc) * 6144 + j] = a0;
        mp[(size_t)((l * 2 + 1) * 32 + kc) * 6144 + j] = a1;
    }
}

__device__ __forceinline__ void ph_filter(const Frame& F) {
    LAS float* zs = (LAS float*)F.lds;
    LAS float* h1 = zs + 64 * 33;
    LAS unsigned char* H2b = F.lds + 24832;
    LAS unsigned char* ob = F.lds + 34048;
    const float min_decay = -4.605170185988091f / 1.5f, max_decay = -4.605170185988091f / 0.3f;
    const int wave = F.wave;
    if (F.bid >= PRO_NF) return;
    for (int it = F.bid; it < 512 + 16; it += PRO_NF) {
        int tid = F.tid; asm volatile("" : "+v"(tid));
        const int lane = tid & 63;
        const bool isctx = it >= 512;
        const int l = isctx ? 0 : it / 256, grp = isctx ? it - 512 : it % 256;
        const int Lx = isctx ? LC : L, npos = isctx ? 16 : 64;
        const int t0 = grp * npos;
        __syncthreads();
#pragma unroll 1
        for (int q = tid; q < npos * 33; q += NTHREADS) {
            const int pos = q / 33, i = q % 33; const int t = t0 + pos;
            const float tn = (float)t / (float)(Lx - 1);
            const float wv = 6.283185307179586f * (float)t / (float)Lx;
            float v;
            if (i == 0) v = tn;
            else { const int b = (i - 1) & 15; const float f = 1e-4f + (float)b * ((15.0f - 1e-4f) / 15.0f); v = (i <= 16) ? cosf(f * wv) : -sinf(f * wv); }
            zs[q] = v;
        }
        __syncthreads();
        {
            asm volatile("" : "+v"(tid));
            const int o = tid & 63, pg = tid >> 6;
            if (pg * 8 < npos) {
                float acc[8];
                const float bb = F.in[I_FB1][l * 64 + o];
#pragma unroll
                for (int p = 0; p < 8; ++p) acc[p] = bb;
#pragma unroll 3
                for (int i = 0; i < 33; ++i) { const float w = F.in[I_FW1][(size_t)l * 33 * 64 + i * 64 + o];
#pragma unroll
                    for (int p = 0; p < 8; ++p) acc[p] += zs[(pg * 8 + p) * 33 + i] * w; }
                const float fq = F.in[I_FREQ][l * 128 + o];
#pragma unroll
                for (int p = 0; p < 8; ++p) h1[(pg * 8 + p) * 64 + o] = sinf(fq * acc[p]);
            }
        }
        __syncthreads();
        {
            asm volatile("" : "+v"(tid));
            const int o = tid & 63, pg = tid >> 6;
            if (pg * 8 < npos) {
                float acc[8];
                const float bb = F.in[I_FB2][l * 64 + o];
#pragma unroll
                for (int p = 0; p < 8; ++p) acc[p] = bb;
#pragma unroll 4
                for (int i = 0; i < 64; ++i) { const float w = F.in[I_FW2][(size_t)l * 64 * 64 + i * 64 + o];
#pragma unroll
                    for (int p = 0; p < 8; ++p) acc[p] += h1[(pg * 8 + p) * 64 + i] * w; }
                const float fq = F.in[I_FREQ][l * 128 + 64 + o];
#pragma unroll
                for (int p = 0; p < 8; ++p) *(LAS bf16_t*)(H2b + (pg * 8 + p) * 144 + o * 2) = f2bf(sinf(fq * acc[p]));
            }
        }
        __syncthreads();
        {
            int r = lane & 31, hf = lane >> 5;
#pragma unroll
            for (int n = 0; n < 2; ++n) {
                asm volatile("" : "+v"(r), "+v"(hf));
                const int o = 32 * (2 * wave + n) + r, c = o & 255, dir = o >> 8;
                const float* w3 = F.in[I_FW3] + (size_t)l * 64 * 512 + o;
                f32x16 acc[2];
#pragma unroll
                for (int m = 0; m < 2; ++m)
#pragma unroll
                    for (int i = 0; i < 16; ++i) acc[m][i] = 0.f;
#pragma unroll
                for (int ks = 0; ks < 4; ++ks) {
                    float wv[8];
#pragma unroll
                    for (int e = 0; e < 8; ++e) wv[e] = w3[(size_t)(16 * ks + 8 * hf + e) * 512];
                    bf16x8 b;
#pragma unroll
                    for (int e = 0; e < 8; ++e) b[e] = (short)f2bf(wv[e]);
#pragma unroll
                    for (int m = 0; m < 2; ++m) {
                        const bf16x8 a = *(const LAS bf16x8*)(H2b + (32 * m + r) * 144 + (16 * ks + 8 * hf) * 2);
                        acc[m] = __builtin_amdgcn_mfma_f32_32x32x16_bf16(a, b, acc[m], 0, 0, 0);
                    }
                }
                const float delta = fabsf(min_decay + (float)c * ((max_decay - min_decay) / 255.0f));
                const float dstep = delta / (float)(Lx - 1);
                float asum = 0.f;
                if (!isctx) {
#pragma unroll
                    for (int m = 0; m < 2; ++m)
#pragma unroll
                        for (int rg = 0; rg < 16; ++rg) {
                            const int pos = 32 * m + (rg & 3) + 8 * (rg >> 2) + 4 * hf;
                            const float v = acc[m][rg] * __expf(-(float)(t0 + pos) * dstep);
                            asum += fabsf(v);
                            ob[o * 68 + pos] = (unsigned char)(pk_fp8x4(KR_SCALE * v, 0.f, 0.f, 0.f) & 0xFFu);
                        }
                } else {
                    float* kc = F.w<float>(WS_KCOMBC);
#pragma unroll
                    for (int rg = 0; rg < 8; ++rg) {
                        const int pos = (rg & 3) + 8 * (rg >> 2) + 4 * hf, t = t0 + pos;
                        const float v = acc[0][rg] * __expf(-(float)t * dstep);
                        asum += fabsf(v);
                        const int x = dir == 0 ? Lx - 1 + t : Lx - 1 - t;
                        if (dir == 0 || t >= 1) kc[(size_t)x * 256 + c] = v;
                    }
                }
                asum += __shfl_xor(asum, 32);
                if (hf == 0) { if (isctx) F.w<float>(WS_FPARTC)[grp * 512 + o] = asum; else F.w<float>(WS_FPART)[((size_t)l * 256 + grp) * 512 + o] = asum; }
            }
        }
        if (!isctx) {
            __syncthreads();
            unsigned char* KR = F.w<unsigned char>(WS_KR) + (size_t)l * 256 * KRL;
            asm volatile("" : "+v"(tid));
            for (int q = tid; q < 512 * 64; q += NTHREADS) {
                const int o = q >> 6, p = q & 63, c = o & 255, dir = o >> 8;
                if (dir == 0) KR[(size_t)c * KRL + (L - t0 - 63 + p)] = ob[o * 68 + 63 - p];
                else if (t0 + p >= 1) KR[(size_t)c * KRL + (L + t0 + p)] = ob[o * 68 + p];
            }
            if (grp == 0) for (int q = tid; q < 256 * 513; q += NTHREADS) { const int c = q / 513, r = q % 513; KR[(size_t)c * KRL + (r == 512 ? 0 : 2 * L + r)] = 0; }
        }
    }
}

__device__ __forceinline__ void ph_fsum(const Frame& F) {
    const int nwaves = F.G * 8;
    for (int o = F.bid * 8 + F.wave; o < 768; o += nwaves) {
        const int which = o >> 8, c = o & 255;
        float s = 0.f;
        if (which < 2) { const float* fp = F.w<float>(WS_FPART) + (size_t)which * 256 * 512;
            for (int i = F.lane; i < 256; i += 64) s += fp[(size_t)i * 512 + c] + fp[(size_t)i * 512 + 256 + c]; }
        else { const float* fp = F.w<float>(WS_FPARTC); if (F.lane < 16) s = fp[F.lane * 512 + c] + fp[F.lane * 512 + 256 + c]; }
        s = wave_sum(s);
        if (F.lane == 0) F.w<float>(WS_FSUM)[o] = 1.0f / s;
    }
}

__device__ __forceinline__ void ph_vecs(const Frame& F) {
    for (int q = F.bid * NTHREADS + F.tid; q < 2 * 2 * 6 * 1024; q += F.G * NTHREADS) {
        const int j = q & 1023, k = (q >> 10) % 6, which = ((q >> 10) / 6) & 1, l = (q >> 10) / 12;
        const float* ng = F.in[I_NORMG] + (size_t)l * 4 * 1024;
        float v;
        if (k == 0) v = ng[j] * (1.0f + mod_val(F, l, which, 1 * 1024 + j));
        else if (k == 1) v = mod_val(F, l, which, j);
        else if (k == 2) v = ng[1024 + j] * mod_val(F, l, which, 2 * 1024 + j);
        else if (k == 3) v = ng[2048 + j] * (1.0f + mod_val(F, l, which, 4 * 1024 + j));
        else if (k == 4) v = mod_val(F, l, which, 3 * 1024 + j);
        else v = ng[3072 + j] * mod_val(F, l, which, 5 * 1024 + j);
        F.w<float>(WS_VECS)[q] = v;
    }
}
__device__ __forceinline__ const float* vecs_ptr(const Frame& F, int l, int which, int k) { return F.w<float>(WS_VECS) + (size_t)((l * 2 + which) * 6 + k) * 1024; }

__device__ __forceinline__ void load_row(const float* p, int lane, f32x4 (&v)[4]) {
#pragma unroll
    for (int i = 0; i < 4; ++i) v[i] = *(const f32x4*)(p + 4 * lane + 256 * i);
}
__device__ __forceinline__ float row_rstd(const f32x4 (&v)[4]) {
    float s = 0.f;
#pragma unroll
    for (int i = 0; i < 4; ++i) s += v[i][0] * v[i][0] + v[i][1] * v[i][1] + v[i][2] * v[i][2] + v[i][3] * v[i][3];
    s = wave_sum(s);
    return rsqrtf(s * (1.0f / 1024.0f) + RMS_EPS);
}
__device__ __forceinline__ void stage_norm_vecs(const Frame& F, int l, int gain_idx, int sh_seg, int sc_seg, LAS float* dst  ) {
    for (int q = F.tid; q < 2048; q += NTHREADS) {
        const int which = q >> 10, j = q & 1023;
        const float g = F.in[I_NORMG][(l * 4 + gain_idx) * 1024 + j];
        dst[(which * 2 + 0) * 1024 + j] = g * (1.0f + mod_val(F, l, which, sc_seg * 1024 + j));
        dst[(which * 2 + 1) * 1024 + j] = mod_val(F, l, which, sh_seg * 1024 + j);
    }
}
__device__ __forceinline__ void norm_store_bf16(const f32x4 (&v)[4], float rstd, const LAS float* va, const LAS float* vb, bf16_t* orow, int lane) {
#pragma unroll
    for (int i = 0; i < 4; ++i) {
        const int c = 4 * lane + 256 * i;
        const f32x4 a = *(const LAS f32x4*)(va + c), b = *(const LAS f32x4*)(vb + c);
        u32x2 w; w.x = pk_bf16(v[i][0] * rstd * a[0] + b[0], v[i][1] * rstd * a[1] + b[1]); w.y = pk_bf16(v[i][2] * rstd * a[2] + b[2], v[i][3] * rstd * a[3] + b[3]);
        *(u32x2*)(orow + c) = w;
    }
}
__device__ __forceinline__ const float* xrow_ptr(const Frame& F, int l, int row) {
    if (l == 0) return row < L ? F.in[I_X] + (size_t)row * D : F.in[I_CTX] + (size_t)(row - L) * D;
    return F.w<float>(WS_XCUR) + (size_t)row * D;
}
__device__ __forceinline__ void load_xrow(const Frame& F, int l, int row, int lane, f32x4 (&v)[4]) {
    if (l == 0) { load_row(row < L ? F.in[I_X] + (size_t)row * D : F.in[I_CTX] + (size_t)(row - L) * D, lane, v); return; }
    const bf16_t* p = F.w<bf16_t>(WS_XCUR) + (size_t)row * D;
#pragma unroll
    for (int i = 0; i < 4; ++i) { const u32x2 w = *(const u32x2*)(p + 4 * lane + 256 * i); v[i] = (f32x4){bflo(w.x), bfhi(w.x), bflo(w.y), bfhi(w.y)}; }
}
__device__ __forceinline__ void store_xrow_bf16(bf16_t* p, int lane, const f32x4 (&v)[4]) {
#pragma unroll
    for (int i = 0; i < 4; ++i) { u32x2 w; w.x = pk_bf16(v[i][0], v[i][1]); w.y = pk_bf16(v[i][2], v[i][3]); *(u32x2*)(p + 4 * lane + 256 * i) = w; }
}
__device__ __forceinline__ void ph_norm1(const Frame& F, int l) {
    LAS float* vec = (LAS float*)F.lds;
    __syncthreads();
    stage_norm_vecs(F, l, 0, 0, 1, vec);
    __syncthreads();
    const int nwaves = F.G * 8;
    for (int row = F.bid * 8 + F.wave; row < T; row += nwaves) {
        const int which = row >= L;
        f32x4 v[4]; load_row(xrow_ptr(F, l, row), F.lane, v);
        const float rstd = row_rstd(v);
        norm_store_bf16(v, rstd, vec + (which * 2) * 1024, vec + (which * 2 + 1) * 1024, F.w<bf16_t>(WS_HB) + (size_t)row * D, F.lane);
    }
}

constexpr int SROW = 272;
__device__ __forceinline__ bf16x8 lds_frag(const LAS unsigned char* base, int row, int k) { return *(const LAS bf16x8*)(base + row * SROW + k * 2); }
__device__ __forceinline__ void ph_ssd_prep(const Frame& F, int l) {
    LAS unsigned char* BT = F.lds;
    LAS unsigned char* XW = F.lds + 34816;
    LAS float* dts = (LAS float*)(F.lds + 139264);
    LAS float* wj  = dts + 768;
    const bf16_t* P = F.w<bf16_t>(WS_P);
    const int lane = F.lane, wave = F.wave;
    for (int it = F.bid; it < NCH * 2; it += F.G) {
        const int ch = it >> 1, g = it & 1;
        const int row0 = ch * 128;
        const int seq_lo = ch < 128 ? 0 : L, seq_hi = ch < 128 ? L : T;
        int r = lane & 31, hf = lane >> 5; asm volatile("" : "+v"(r), "+v"(hf));
        __syncthreads();
        if (wave < 6) {
            const int hh = wave >> 1, dir = wave & 1, h = g * 3 + hh;
            const float a = -__expf(F.in[I_ALOG][(l * 2 + dir) * 6 + h]), bias = F.in[I_DTB][(l * 2 + dir) * 6 + h];
            const int j0 = 2 * lane;
            const float d0 = softplus_f(bf2f(P[(size_t)(row0 + j0) * PC + CDT + dir * 6 + h]) + bias);
            const float d1 = softplus_f(bf2f(P[(size_t)(row0 + j0 + 1) * PC + CDT + dir * 6 + h]) + bias);
            const float pair = (d0 + d1) * a;
            float incl = pair;
#pragma unroll
            for (int o = 1; o < 64; o <<= 1) {
                const float v = dir == 0 ? __shfl_up(incl, o) : __shfl_down(incl, o);
                const bool okl = dir == 0 ? (lane >= o) : (lane + o < 64);
                if (okl) incl += v;
            }
            const float total = __shfl(incl, dir == 0 ? 63 : 0);
            float acs0, acs1;
            if (dir == 0) { acs1 = incl; acs0 = incl - d1 * a; }
            else { acs0 = incl; acs1 = incl - d0 * a; }
            float* dtv = F.w<float>(WS_DTV) + (size_t)(row0 + j0) * 12 + dir * 6 + h; dtv[0] = d0; dtv[12] = d1;
            float* acv = F.w<float>(WS_ACS) + (size_t)(row0 + j0) * 12 + dir * 6 + h; acv[0] = acs0; acv[12] = acs1;
            if (lane == 0) F.w<float>(WS_ALAST)[ch * 12 + dir * 6 + h] = total;
            dts[wave * 128 + j0] = d0; dts[wave * 128 + j0 + 1] = d1;
            wj[wave * 128 + j0] = __expf(total - acs0) * d0; wj[wave * 128 + j0 + 1] = __expf(total - acs1) * d1;
        }
        __syncthreads();
        if (F.tid < 448) {
            const int pr = F.tid % 224, half = F.tid / 224;
            const int chn = pr < 96 ? g * 192 + 2 * pr : (pr < 160 ? 384 + g * 128 + 2 * (pr - 96) : 640 + g * 128 + 2 * (pr - 160));
            const float* cw = F.in[I_SCW] + (size_t)l * 5 * 896 + chn; const float* cb = F.in[I_SCB] + (size_t)l * 896 + chn;
            float w0[5], w1[5];
#pragma unroll
            for (int k = 0; k < 5; ++k) { w0[k] = cw[k * 896]; w1[k] = cw[k * 896 + 1]; }
            const float b0 = cb[0], b1 = cb[1];
            const int jb = half * 64;
            const bf16_t* src = P + CXBC + chn;
            unsigned win[12];
#pragma unroll
            for (int k = 0; k < 4; ++k) { const int rr = row0 + jb + k - 2; win[k] = (rr >= seq_lo && rr < seq_hi) ? *(const unsigned*)(src + (size_t)rr * PC) : 0u; }
            const int hh = pr / 32;
            const int pch = 2 * (pr & 31);
            for (int jg = 0; jg < 64; jg += 8) {
#pragma unroll
                for (int k = 0; k < 8; ++k) { const int rr = row0 + jb + jg + k + 2; win[4 + k] = (rr >= seq_lo && rr < seq_hi) ? *(const unsigned*)(src + (size_t)rr * PC) : 0u; }
                float s0[8], s1[8];
#pragma unroll
                for (int u = 0; u < 8; ++u) {
                    float a0 = b0, a1 = b1;
#pragma unroll
                    for (int k = 0; k < 5; ++k) { a0 += w0[k] * bflo(win[u + k]); a1 += w1[k] * bfhi(win[u + k]); }
                    s0[u] = silu_f(a0); s1[u] = silu_f(a1);
                    *(unsigned*)(F.w<bf16_t>(WS_XBC) + (size_t)(row0 + jb + jg + u) * 896 + chn) = pk_bf16(s0[u], s1[u]);
                }
#pragma unroll
                for (int k = 0; k < 4; ++k) win[k] = win[8 + k];
#pragma unroll
                for (int u = 0; u < 8; u += 2) {
                    const int j = jb + jg + u;
                    if (pr < 96) {
#pragma unroll
                        for (int dir = 0; dir < 2; ++dir) {
                            const float wa = wj[(hh * 2 + dir) * 128 + j], wb = wj[(hh * 2 + dir) * 128 + j + 1];
                            LAS unsigned char* d = XW + ((hh * 2 + dir) * 64 + pch) * SROW + j * 2;
                            *(LAS unsigned*)d = pk_bf16(s0[u] * wa, s0[u + 1] * wb);
                            *(LAS unsigned*)(d + SROW) = pk_bf16(s1[u] * wa, s1[u + 1] * wb);
                        }
                    } else if (pr < 160) {
                        LAS unsigned char* d = BT + (2 * (pr - 96)) * SROW + j * 2;
                        *(LAS unsigned*)d = pk_bf16(s0[u], s0[u + 1]);
                        *(LAS unsigned*)(d + SROW) = pk_bf16(s1[u], s1[u + 1]);
                    }
                }
            }
        }
        __syncthreads();
        {
            const int nt = wave & 3, pt = wave >> 2;
#pragma unroll 1
            for (int hh = 0; hh < 3; ++hh) {
                const int h = g * 3 + hh;
                f32x16 a0, a1;
#pragma unroll
                for (int i = 0; i < 16; ++i) { a0[i] = 0.f; a1[i] = 0.f; }
                const LAS unsigned char* X0 = XW + (hh * 2) * 64 * SROW;
#pragma unroll
                for (int ks = 0; ks < 8; ++ks) {
                    const bf16x8 a = lds_frag(BT, 32 * nt + r, 16 * ks + 8 * hf);
                    const bf16x8 b0 = lds_frag(X0, 32 * pt + r, 16 * ks + 8 * hf), b1 = lds_frag(X0, 64 + 32 * pt + r, 16 * ks + 8 * hf);
                    a0 = __builtin_amdgcn_mfma_f32_32x32x16_bf16(a, b0, a0, 0, 0, 0);
                    a1 = __builtin_amdgcn_mfma_f32_32x32x16_bf16(a, b1, a1, 0, 0, 0);
                }
                float* s0 = F.w<float>(WS_STATES) + ((size_t)(0 * NCH + ch) * 6 + h) * 8192 + (32 * pt + r) * 128 + 32 * nt + 4 * hf;
                float* s1 = F.w<float>(WS_STATES) + ((size_t)(1 * NCH + ch) * 6 + h) * 8192 + (32 * pt + r) * 128 + 32 * nt + 4 * hf;
#pragma unroll
                for (int gq = 0; gq < 4; ++gq) { *(f32x4*)(s0 + 8 * gq) = (f32x4){a0[4 * gq], a0[4 * gq + 1], a0[4 * gq + 2], a0[4 * gq + 3]};
                                                 *(f32x4*)(s1 + 8 * gq) = (f32x4){a1[4 * gq], a1[4 * gq + 1], a1[4 * gq + 2], a1[4 * gq + 3]}; }
            }
        }
    }
}

__device__ __forceinline__ void ph_ssd_scan(const Frame& F) {
    const int per = (98304 + F.G - 1) / F.G;
    for (int q = F.tid; q < per; q += NTHREADS) {
        const int id = F.bid * per + q;
        if (id >= 98304) break;
        const int dir = id / 49152, rem = id % 49152, h = rem / 8192, e = rem % 8192;
        const float* al = F.w<float>(WS_ALAST) + dir * 6 + h;
        const float* st = F.w<float>(WS_STATES) + ((size_t)(dir * NCH) * 6 + h) * 8192 + e;
        bf16_t* ss = F.w<bf16_t>(WS_SSTART) + ((size_t)(dir * NCH) * 6 + h) * 8192 + e;
        float sacc = 0.f;
        for (int s0 = 0; s0 < NCH; s0 += 26) {
            float sv[26], dv[26]; int cv[26];
#pragma unroll
            for (int u = 0; u < 26; ++u) {
                const int step = s0 + u;
                cv[u] = dir == 0 ? (step < 2 ? 128 + step : step - 2) : 129 - step;
                sv[u] = st[(size_t)cv[u] * 6 * 8192]; dv[u] = al[cv[u] * 12];
            }
#pragma unroll
            for (int u = 0; u < 26; ++u) { ss[(size_t)cv[u] * 6 * 8192] = f2bf(sacc); sacc = sacc * __expf(dv[u]) + sv[u]; }
        }
    }
}

__device__ __forceinline__ void ph_ssd_out(const Frame& F, int l) {
    LAS unsigned char* Cs = F.lds;
    LAS unsigned char* Bs = F.lds + 34816;
    LAS unsigned char* XT = F.lds + 69632;
    LAS float* Yl = (LAS float*)F.lds;
    LAS float* af = (LAS float*)(F.lds + 98816);
    LAS float* ab = af + 384, *dtf = ab + 384, *dtb = dtf + 384;
    LAS float* red = dtb + 384;
    const bf16_t* XBC = F.w<bf16_t>(WS_XBC);
    const bf16_t* P = F.w<bf16_t>(WS_P);
    const int nch = (l == 0) ? NCH : 128;
    const int lane = F.lane, wave = F.wave, r_in = lane & 31, hf_in = lane >> 5;
    const int it_ = wave & 3, jp = wave >> 2;
    for (int it = F.bid; it < nch * 2; it += F.G) {
        const int ch = it >> 1, g = it & 1, row0 = ch * 128;
        int r = r_in, hf = hf_in; asm volatile("" : "+v"(r), "+v"(hf));
        __syncthreads();
        for (int q = F.tid; q < 128 * 16; q += NTHREADS) {
            const int row = q >> 4, piece = q & 15;
            const bf16_t* src = XBC + (size_t)(row0 + row) * 896 + g * 128 + piece * 8;
            *(LAS u32x4*)(Bs + row * SROW + piece * 16) = *(const u32x4*)(src + 384);
            *(LAS u32x4*)(Cs + row * SROW + piece * 16) = *(const u32x4*)(src + 640);
        }
        for (int q = F.tid; q < 768; q += NTHREADS) {
            const int dir = q / 384, rr = q % 384, hh = rr >> 7, j = rr & 127;
            (dir ? ab : af)[hh * 128 + j] = F.w<float>(WS_ACS)[(size_t)(row0 + j) * 12 + dir * 6 + g * 3 + hh];
            (dir ? dtb : dtf)[hh * 128 + j] = F.w<float>(WS_DTV)[(size_t)(row0 + j) * 12 + dir * 6 + g * 3 + hh];
        }
        __syncthreads();
        f32x16 G0, G1;
#pragma unroll
        for (int i = 0; i < 16; ++i) { G0[i] = 0.f; G1[i] = 0.f; }
#pragma unroll
        for (int ks = 0; ks < 8; ++ks) {
            const bf16x8 a = lds_frag(Cs, 32 * it_ + r, 16 * ks + 8 * hf);
            const bf16x8 b0 = lds_frag(Bs, 64 * jp + r, 16 * ks + 8 * hf), b1 = lds_frag(Bs, 64 * jp + 32 + r, 16 * ks + 8 * hf);
            G0 = __builtin_amdgcn_mfma_f32_32x32x16_bf16(a, b0, G0, 0, 0, 0);
            G1 = __builtin_amdgcn_mfma_f32_32x32x16_bf16(a, b1, G1, 0, 0, 0);
        }
        f32x16 yacc[3];
#pragma unroll
        for (int hh = 0; hh < 3; ++hh) {
            const int h = g * 3 + hh;
            asm volatile("" : "+v"(r), "+v"(hf));
            __syncthreads();
#pragma unroll
            for (int tl = 0; tl < 2; ++tl) {
                const int j = 64 * jp + 32 * tl + r;
                const float afj = af[hh * 128 + j], abj = ab[hh * 128 + j], dfj = dtf[hh * 128 + j], dbj = dtb[hh * 128 + j];
#pragma unroll
                for (int rg = 0; rg < 16; ++rg) {
                    const int i = 32 * it_ + (rg & 3) + 8 * (rg >> 2) + 4 * hf;
                    const float mf = fminf(fmaxf((float)(i - j + 1), 0.f), 1.f), mb = fminf(fmaxf((float)(j - i + 1), 0.f), 1.f);
                    const float wf = __expf(fminf(af[hh * 128 + i] - afj, 0.f)) * dfj * mf;
                    const float wb = __expf(fminf(ab[hh * 128 + i] - abj, 0.f)) * dbj * mb;
                    const float gv = tl == 0 ? G0[rg] : G1[rg];
                    *(LAS bf16_t*)(Bs + i * SROW + j * 2) = f2bf(gv * (wf + wb));
                }
            }
            for (int q = F.tid; q < 128 * 8; q += NTHREADS) {
                const int j = q >> 3, pg = q & 7;
                const u32x4 v = *(const u32x4*)(XBC + (size_t)(row0 + j) * 896 + h * 64 + pg * 8);
                LAS unsigned char* d = XT + (pg * 8) * SROW + j * 2;
                *(LAS bf16_t*)(d + 0 * SROW) = (bf16_t)(v.x & 0xFFFF); *(LAS bf16_t*)(d + 1 * SROW) = (bf16_t)(v.x >> 16);
                *(LAS bf16_t*)(d + 2 * SROW) = (bf16_t)(v.y & 0xFFFF); *(LAS bf16_t*)(d + 3 * SROW) = (bf16_t)(v.y >> 16);
                *(LAS bf16_t*)(d + 4 * SROW) = (bf16_t)(v.z & 0xFFFF); *(LAS bf16_t*)(d + 5 * SROW) = (bf16_t)(v.z >> 16);
                *(LAS bf16_t*)(d + 6 * SROW) = (bf16_t)(v.w & 0xFFFF); *(LAS bf16_t*)(d + 7 * SROW) = (bf16_t)(v.w >> 16);
            }
            {
                f32x16 yF, yB;
#pragma unroll
                for (int i = 0; i < 16; ++i) { yF[i] = 0.f; yB[i] = 0.f; }
                const bf16_t* Sf = F.w<bf16_t>(WS_SSTART) + ((size_t)(0 * NCH + ch) * 6 + h) * 8192 + (32 * jp + r) * 128 + 8 * hf;
                const bf16_t* Sb = F.w<bf16_t>(WS_SSTART) + ((size_t)(1 * NCH + ch) * 6 + h) * 8192 + (32 * jp + r) * 128 + 8 * hf;
#pragma unroll 2
                for (int ks = 0; ks < 8; ++ks) {
                    const bf16x8 ac = lds_frag(Cs, 32 * it_ + r, 16 * ks + 8 * hf);
                    const bf16x8 bf_ = *(const bf16x8*)(Sf + 16 * ks), bb_ = *(const bf16x8*)(Sb + 16 * ks);
                    yF = __builtin_amdgcn_mfma_f32_32x32x16_bf16(ac, bf_, yF, 0, 0, 0);
                    yB = __builtin_amdgcn_mfma_f32_32x32x16_bf16(ac, bb_, yB, 0, 0, 0);
                }
#pragma unroll
                for (int rg = 0; rg < 16; ++rg) {
                    const int i = 32 * it_ + (rg & 3) + 8 * (rg >> 2) + 4 * hf;
                    yacc[hh][rg] = __expf(af[hh * 128 + i]) * yF[rg] + __expf(ab[hh * 128 + i]) * yB[rg];
                }
            }
            __syncthreads();
#pragma unroll 2
            for (int ks = 0; ks < 8; ++ks) {
                const bf16x8 aw = lds_frag(Bs, 32 * it_ + r, 16 * ks + 8 * hf), bx = lds_frag(XT, 32 * jp + r, 16 * ks + 8 * hf);
                yacc[hh] = __builtin_amdgcn_mfma_f32_32x32x16_bf16(aw, bx, yacc[hh], 0, 0, 0);
            }
        }
        __syncthreads();
#pragma unroll
        for (int hh = 0; hh < 3; ++hh)
#pragma unroll
            for (int rg = 0; rg < 16; ++rg) { const int i = 32 * it_ + (rg & 3) + 8 * (rg >> 2) + 4 * hf; Yl[i * 193 + hh * 64 + 32 * jp + r] = yacc[hh][rg]; }
        __syncthreads();
        const int i = F.tid & 127, pq = F.tid >> 7;
        float ssq = 0.f;
#pragma unroll 1
        for (int hh = 0; hh < 3; ++hh) {
            const int h = g * 3 + hh; const float dsk = F.in[I_SSDD][l * 6 + h];
            const int chn = h * 64 + pq * 16;
            const u32x4 xa = *(const u32x4*)(XBC + (size_t)(row0 + i) * 896 + chn), xb = *(const u32x4*)(XBC + (size_t)(row0 + i) * 896 + chn + 8);
            const u32x4 za = *(const u32x4*)(P + (size_t)(row0 + i) * PC + CZ + chn), zb = *(const u32x4*)(P + (size_t)(row0 + i) * PC + CZ + chn + 8);
            const unsigned xw_[8] = {xa.x, xa.y, xa.z, xa.w, xb.x, xb.y, xb.z, xb.w}, zw_[8] = {za.x, za.y, za.z, za.w, zb.x, zb.y, zb.z, zb.w};
            LAS float* yr = Yl + i * 193 + hh * 64 + pq * 16;
#pragma unroll
            for (int p2 = 0; p2 < 8; ++p2) {
                const float v0 = (yr[2 * p2] + dsk * bflo(xw_[p2])) * silu_f(bflo(zw_[p2]));
                const float v1 = (yr[2 * p2 + 1] + dsk * bfhi(xw_[p2])) * silu_f(bfhi(zw_[p2]));
                yr[2 * p2] = v0; yr[2 * p2 + 1] = v1; ssq += v0 * v0 + v1 * v1;
            }
        }
        red[pq * 128 + i] = ssq;
        __syncthreads();
        const float tot = red[i] + red[128 + i] + red[256 + i] + red[384 + i];
        const float rstd = rsqrtf(tot * (1.0f / 192.0f) + RMS_EPS);
#pragma unroll 1
        for (int hh = 0; hh < 3; ++hh) {
            const int h = g * 3 + hh;
            bf16_t* o = F.w<bf16_t>(WS_MIX) + (size_t)(row0 + i) * D + h * 64 + pq * 16;
            const float* ng = F.in[I_SSDNG] + l * 384 + h * 64 + pq * 16;
            const LAS float* yr = Yl + i * 193 + hh * 64 + pq * 16;
            unsigned wv[8];
#pragma unroll
            for (int p2 = 0; p2 < 8; ++p2) wv[p2] = pk_bf16(yr[2 * p2] * rstd * ng[2 * p2], yr[2 * p2 + 1] * rstd * ng[2 * p2 + 1]);
            *(u32x4*)o = (u32x4){wv[0], wv[1], wv[2], wv[3]}; *(u32x4*)(o + 8) = (u32x4){wv[4], wv[5], wv[6], wv[7]};
        }
    }
}

__device__ __forceinline__ int na_kv_off(int key, int piece) { return key * 128 + ((piece ^ (key & 7)) << 4); }
constexpr int NA_VP = 144;
__device__ __forceinline__ int na_v_off(int key, int piece) { return key * NA_VP + piece * 16; }
__device__ __forceinline__ void na_stage_kv(const Frame& F, const bf16_t* P, LAS unsigned char* Kd, LAS unsigned char* Vd, int h, bool local, int r0, int kc0) {
    for (int q = F.tid; q < 256 * 8; q += NTHREADS) {
        const int key = q >> 3, piece = q & 7;
        const int krow = local ? (r0 + (key >> 5)) * 64 + kc0 + (key & 31) : L + key;
        const bf16_t* src = P + (size_t)krow * PC + h * 64 + piece * 8;
        *(LAS u32x4*)(Kd + na_kv_off(key, piece)) = *(const u32x4*)(src + CK);
        *(LAS u32x4*)(Vd + na_v_off(key, piece)) = *(const u32x4*)(src + CV);
    }
}
__device__ __forceinline__ void bar_lds() { asm volatile("s_waitcnt lgkmcnt(0)" ::: "memory"); __builtin_amdgcn_s_barrier(); asm volatile("" ::: "memory"); }
struct NaItem { int h, r, cg, r0, kc0, qrow0; bool isctx; };
__device__ __forceinline__ NaItem na_item(int cid, int i_lo, int i_hi, int k) {
    NaItem t; t.isctx = (i_lo + k >= i_hi); t.r = 0; t.r0 = 0; t.kc0 = 0;
    if (!t.isctx) { const int it = i_lo + k; t.h = it >> 10; t.r = (it >> 2) & 255; t.cg = it & 3; t.r0 = min(max(t.r - 4, 0), 248); t.kc0 = min(max(16 * t.cg - 8, 0), 32); t.qrow0 = t.r * 64 + t.cg * 16; }
    else { t.h = cid >> 4; t.cg = cid & 15; t.qrow0 = L + t.cg * 16; }
    return t;
}
__device__ __forceinline__ void ph_na(const Frame& F, int l, int part) {
    LAS unsigned char* Kc = F.lds;
    LAS unsigned char* Vc = F.lds + 32768;
    LAS unsigned char* Kl = F.lds + 69632;
    LAS unsigned char* Vl = F.lds + 102400;
    LAS unsigned char* Qs = F.lds + 139264;
    LAS unsigned char* Pw = F.lds + 141312;
    LAS float* ml = (LAS float*)(F.lds + 159744);
    LAS float* bt = ml + 256;
    const bf16_t* P = F.w<bf16_t>(WS_P);
    const float* rpb = F.in[I_RPB] + (size_t)l * 15 * 31 * 6;
    const int nlat = 6 * 256 * 4;
    const int nB = (l == 0) ? 2520 : 0, nA = nlat - nB;
    const int lane = F.lane, wave = F.wave, c16 = lane & 15, kq = lane >> 4;
    const float scale = 0.125f;
    int cur_h = -1;
    const float ws = part == 0 ? (l == 0 ? 0.45f : 0.67f) : 0.0f;
    const int nP = part == 0 ? nA : nB, base = part == 0 ? 0 : nA;
    const float Wtot = 4.0f * ws + (float)(F.G - 4);
    const float W0 = F.bid < 4 ? F.bid * ws : 4.0f * ws + (float)(F.bid - 4), W1 = F.bid < 3 ? (F.bid + 1) * ws : 4.0f * ws + (float)(F.bid - 3);
    const int i_lo = base + (int)((float)nP * W0 / Wtot + 0.5f), i_hi = (F.bid == F.G - 1) ? base + nP : base + (int)((float)nP * W1 / Wtot + 0.5f);
    const int cid = (l == 0 && part == 0 && F.bid >= 100 && F.bid < 196) ? F.bid - 100 : -1;
    const int n_mine = max(0, i_hi - i_lo) + (cid >= 0 ? 1 : 0);
    u32x4 kreg[4], vreg[4], qreg; float breg = 0.f;
    const int pkey = F.tid >> 3, ppiece = F.tid & 7;
#define NA_PREFETCH(T) do { if (!(T).isctx) { _Pragma("unroll") for (int u = 0; u < 4; ++u) { const int key = pkey + 64 * u; \
            const bf16_t* src = P + (size_t)(((T).r0 + (key >> 5)) * 64 + (T).kc0 + (key & 31)) * PC + (T).h * 64 + ppiece * 8; \
            kreg[u] = *(const u32x4*)(src + CK); vreg[u] = *(const u32x4*)(src + CV); } \
            if (F.tid < 256 && (F.tid & 31) < 31) breg = rpb[(((T).r0 + (F.tid >> 5) - (T).r + 7) * 31 + (F.tid & 31)) * 6 + (T).h]; } \
        if (F.tid < 128) qreg = *(const u32x4*)(P + (size_t)((T).qrow0 + pkey) * PC + CQ + (T).h * 64 + ppiece * 8); } while (0)
    if (n_mine > 0) { const NaItem t0 = na_item(cid, i_lo, i_hi, 0); NA_PREFETCH(t0); }
    for (int k = 0; k < n_mine; ++k) {
        const NaItem t = na_item(cid, i_lo, i_hi, k);
        const bool isctx = t.isctx; const int h = t.h, cg = t.cg, kc0 = t.kc0, qrow0 = t.qrow0;
        if (k == 0) bar_lds();
        if (h != cur_h) { na_stage_kv(F, P, Kc, Vc, h, false, 0, 0); cur_h = h; }
        if (!isctx) {
#pragma unroll
            for (int u = 0; u < 4; ++u) { const int key = pkey + 64 * u; *(LAS u32x4*)(Kl + na_kv_off(key, ppiece)) = kreg[u]; *(LAS u32x4*)(Vl + na_v_off(key, ppiece)) = vreg[u]; }
            if (F.tid < 256) bt[F.tid] = breg;
        }
        if (F.tid < 128) *(LAS u32x4*)(Qs + na_kv_off(pkey, ppiece)) = qreg;
        if (k + 1 < n_mine) { const NaItem tn = na_item(cid, i_lo, i_hi, k + 1); NA_PREFETCH(tn); }
        bar_lds();
        const bool loc = wave < 4;
        const LAS unsigned char* Kb = loc ? Kl : Kc;
        const LAS unsigned char* Vb = loc ? Vl : Vc;
        const int kbase = (wave & 3) * 64;
        LAS unsigned char* pw = Pw + wave * 2304;
        float mw[4], lw[4];
        if (!(loc && isctx)) {
            f32x4 sacc[4];
#pragma unroll
            for (int nt = 0; nt < 4; ++nt) sacc[nt] = (f32x4){0.f, 0.f, 0.f, 0.f};
#pragma unroll
            for (int ks = 0; ks < 2; ++ks) {
                const bf16x8 a = *(const LAS bf16x8*)(Qs + na_kv_off(c16, 4 * ks + kq));
#pragma unroll
                for (int nt = 0; nt < 4; ++nt) {
                    const bf16x8 b = *(const LAS bf16x8*)(Kb + na_kv_off(kbase + 16 * nt + c16, 4 * ks + kq));
                    sacc[nt] = __builtin_amdgcn_mfma_f32_16x16x32_bf16(a, b, sacc[nt], 0, 0, 0);
                }
            }
#pragma unroll
            for (int rg = 0; rg < 4; ++rg) mw[rg] = -INFINITY;
#pragma unroll
            for (int nt = 0; nt < 4; ++nt) {
                const int kk = kbase + 16 * nt + c16;
#pragma unroll
                for (int rg = 0; rg < 4; ++rg) {
                    float sv = sacc[nt][rg] * scale;
                    if (loc) {
                        const int qi = 4 * kq + rg, qcol = cg * 16 + qi, cstart = min(max(qcol - 8, 0), 48);
                        const int krow = kk >> 5, kcol = kc0 + (kk & 31);
                        const bool ok = (kcol >= cstart) && (kcol < cstart + 16);
                        const int dc = min(max(kcol - qcol + 15, 0), 30);
                        sv = ok ? sv + bt[krow * 32 + dc] : -INFINITY;
                    }
                    sacc[nt][rg] = sv; mw[rg] = fmaxf(mw[rg], sv);
                }
            }
#pragma unroll
            for (int rg = 0; rg < 4; ++rg) {
#pragma unroll
                for (int o = 8; o >= 1; o >>= 1) mw[rg] = fmaxf(mw[rg], __shfl_xor(mw[rg], o));
                lw[rg] = 0.f;
            }
#pragma unroll
            for (int nt = 0; nt < 4; ++nt) {
#pragma unroll
                for (int rg = 0; rg < 4; ++rg) {
                    const float msafe = mw[rg] == -INFINITY ? 0.f : mw[rg];
                    const float pv = __expf(sacc[nt][rg] - msafe);
                    lw[rg] += pv;
                    *(LAS bf16_t*)(pw + (4 * kq + rg) * 144 + (16 * nt + c16) * 2) = f2bf(pv);
                }
            }
#pragma unroll
            for (int rg = 0; rg < 4; ++rg) {
#pragma unroll
                for (int o = 8; o >= 1; o >>= 1) lw[rg] += __shfl_xor(lw[rg], o);
            }
            lds_fence();
            f32x4 oacc[4];
#pragma unroll
            for (int dt = 0; dt < 4; ++dt) oacc[dt] = (f32x4){0.f, 0.f, 0.f, 0.f};
            {
                const unsigned vaddr = (unsigned)(unsigned long long)(Vb + (kbase + 8 * kq + (c16 >> 2)) * NA_VP + 8 * (c16 & 3));
                u32x2 t[2][4][2];
                asm volatile(
                    "ds_read_b64_tr_b16 %0, %16 offset:0\n\tds_read_b64_tr_b16 %1, %16 offset:576\n\t"
                    "ds_read_b64_tr_b16 %2, %16 offset:32\n\tds_read_b64_tr_b16 %3, %16 offset:608\n\t"
                    "ds_read_b64_tr_b16 %4, %16 offset:64\n\tds_read_b64_tr_b16 %5, %16 offset:640\n\t"
                    "ds_read_b64_tr_b16 %6, %16 offset:96\n\tds_read_b64_tr_b16 %7, %16 offset:672\n\t"
                    "ds_read_b64_tr_b16 %8, %16 offset:4608\n\tds_read_b64_tr_b16 %9, %16 offset:5184\n\t"
                    "ds_read_b64_tr_b16 %10, %16 offset:4640\n\tds_read_b64_tr_b16 %11, %16 offset:5216\n\t"
                    "ds_read_b64_tr_b16 %12, %16 offset:4672\n\tds_read_b64_tr_b16 %13, %16 offset:5248\n\t"
                    "ds_read_b64_tr_b16 %14, %16 offset:4704\n\tds_read_b64_tr_b16 %15, %16 offset:5280\n\t"
                    "s_waitcnt lgkmcnt(0)"
                    : "=&v"(t[0][0][0]), "=&v"(t[0][0][1]), "=&v"(t[0][1][0]), "=&v"(t[0][1][1]), "=&v"(t[0][2][0]), "=&v"(t[0][2][1]), "=&v"(t[0][3][0]), "=&v"(t[0][3][1]),
                      "=&v"(t[1][0][0]), "=&v"(t[1][0][1]), "=&v"(t[1][1][0]), "=&v"(t[1][1][1]), "=&v"(t[1][2][0]), "=&v"(t[1][2][1]), "=&v"(t[1][3][0]), "=&v"(t[1][3][1])
                    : "v"(vaddr) : "memory");
#pragma unroll
                for (int ks = 0; ks < 2; ++ks) {
                    const bf16x8 a = *(const LAS bf16x8*)(pw + c16 * 144 + (32 * ks + 8 * kq) * 2);
#pragma unroll
                    for (int dt = 0; dt < 4; ++dt) {
                        const u32x4 bw = (u32x4){t[ks][dt][0].x, t[ks][dt][0].y, t[ks][dt][1].x, t[ks][dt][1].y};
                        oacc[dt] = __builtin_amdgcn_mfma_f32_16x16x32_bf16(a, __builtin_bit_cast(bf16x8, bw), oacc[dt], 0, 0, 0);
                    }
                }
            }
            lds_fence();
#pragma unroll
            for (int dt = 0; dt < 4; ++dt)
#pragma unroll
                for (int rg = 0; rg < 4; ++rg) *(LAS bf16_t*)(pw + (4 * kq + rg) * 144 + (16 * dt + c16) * 2) = f2bf(oacc[dt][rg]);
        } else {
#pragma unroll
            for (int rg = 0; rg < 4; ++rg) { mw[rg] = -INFINITY; lw[rg] = 0.f; }
            for (int q = lane; q < 16 * 36; q += 64) ((LAS unsigned*)pw)[q] = 0u;
        }
        if (c16 == 0) {
#pragma unroll
            for (int rg = 0; rg < 4; ++rg) { ml[(wave * 16 + 4 * kq + rg) * 2] = mw[rg]; ml[(wave * 16 + 4 * kq + rg) * 2 + 1] = lw[rg]; }
        }
        bar_lds();
        {
            const int qi = F.tid >> 5, dp = F.tid & 31;
            float M = -INFINITY;
#pragma unroll
            for (int w = 0; w < 8; ++w) M = fmaxf(M, ml[(w * 16 + qi) * 2]);
            float num0 = 0.f, num1 = 0.f, den = 0.f;
#pragma unroll
            for (int w = 0; w < 8; ++w) {
                const float sc = __expf(ml[(w * 16 + qi) * 2] - M);
                const unsigned ov = *(const LAS unsigned*)(Pw + w * 2304 + qi * 144 + dp * 4);
                num0 += sc * bflo(ov); num1 += sc * bfhi(ov); den += sc * ml[(w * 16 + qi) * 2 + 1];
            }
            const float inv = 1.0f / den;
            *(unsigned*)(F.w<bf16_t>(WS_MIX) + (size_t)(qrow0 + qi) * D + 384 + h * 64 + 2 * dp) = pk_bf16(num0 * inv, num1 * inv);
        }
    }
#undef NA_PREFETCH
}

__device__ __forceinline__ float hy_conv3(const bf16_t* P, const float* cw, const float* cb, int row, int seq_lo, int seq_hi, int col) {
    float s = cb[col];
#pragma unroll
    for (int k = 0; k < 3; ++k) { const int r = row + k - 1; if (r >= seq_lo && r < seq_hi) s += cw[k * 768 + col] * bf2f(P[(size_t)r * PC + CHY + col]); }
    return s;
}
__device__ __forceinline__ void ph_hy_prep(const Frame& F, int l) {
    const bf16_t* P = F.w<bf16_t>(WS_P);
    const float* cw = F.in[I_HCW] + (size_t)l * 3 * 768; const float* cb = F.in[I_HCB] + (size_t)l * 768;
    LAS unsigned* ut = (LAS unsigned*)F.lds;
    LAS unsigned* xt = ut + 256 * 33;
    const int cp = F.tid & 127, rq = F.tid >> 7;
    float w0[3][3], w1[3][3], b0[3], b1[3];
#pragma unroll
    for (int sg = 0; sg < 3; ++sg) { b0[sg] = cb[sg * 256 + 2 * cp]; b1[sg] = cb[sg * 256 + 2 * cp + 1];
#pragma unroll
        for (int k = 0; k < 3; ++k) { w0[sg][k] = cw[k * 768 + sg * 256 + 2 * cp]; w1[sg][k] = cw[k * 768 + sg * 256 + 2 * cp + 1]; } }
    for (int it = F.bid; it < L / 64; it += F.G) {
        const int t0 = it * 64, rb = t0 + rq * 16;
        __syncthreads();
        {
            unsigned win[3][18];
#pragma unroll
            for (int sg = 0; sg < 3; ++sg)
#pragma unroll
                for (int k = 0; k < 18; ++k) { const int rr = rb - 1 + k; win[sg][k] = (rr >= 0 && rr < L) ? *(const unsigned*)(P + (size_t)rr * PC + CHY + sg * 256 + 2 * cp) : 0u; }
#pragma unroll
            for (int jp = 0; jp < 8; ++jp) {
                float u0[2], u1[2], xa[2], xb[2];
#pragma unroll
                for (int q = 0; q < 2; ++q) {
                    const int k = 2 * jp + q;
                    float a0[3], a1[3];
#pragma unroll
                    for (int sg = 0; sg < 3; ++sg) {
                        a0[sg] = b0[sg] + w0[sg][0] * bflo(win[sg][k]) + w0[sg][1] * bflo(win[sg][k + 1]) + w0[sg][2] * bflo(win[sg][k + 2]);
                        a1[sg] = b1[sg] + w1[sg][0] * bfhi(win[sg][k]) + w1[sg][1] * bfhi(win[sg][k + 1]) + w1[sg][2] * bfhi(win[sg][k + 2]);
                    }
                    xa[q] = a0[0]; xb[q] = a1[0]; u0[q] = a0[2] * a0[1]; u1[q] = a1[2] * a1[1];
                }
                const int rp = rq * 8 + jp;
                ut[(2 * cp) * 33 + rp] = pk_bf16(u0[0], u0[1]); ut[(2 * cp + 1) * 33 + rp] = pk_bf16(u1[0], u1[1]);
                xt[(2 * cp) * 33 + rp] = pk_bf16(xa[0], xa[1]); xt[(2 * cp + 1) * 33 + rp] = pk_bf16(xb[0], xb[1]);
            }
        }
        __syncthreads();
        for (int q = F.tid; q < 256 * 8; q += NTHREADS) {
            const int c = q >> 3, g = q & 7;
            u32x4 a, b;
            a.x = ut[c * 33 + 4 * g]; a.y = ut[c * 33 + 4 * g + 1]; a.z = ut[c * 33 + 4 * g + 2]; a.w = ut[c * 33 + 4 * g + 3];
            b.x = xt[c * 33 + 4 * g]; b.y = xt[c * 33 + 4 * g + 1]; b.z = xt[c * 33 + 4 * g + 2]; b.w = xt[c * 33 + 4 * g + 3];
            *(u32x4*)(F.w<bf16_t>(WS_UT) + (size_t)c * L + t0 + 8 * g) = a;
            *(u32x4*)(F.w<bf16_t>(WS_X0T) + (size_t)c * L + t0 + 8 * g) = b;
            u32x2 a8; a8.x = pk_fp8x4(bflo(a.x), bfhi(a.x), bflo(a.y), bfhi(a.y)); a8.y = pk_fp8x4(bflo(a.z), bfhi(a.z), bflo(a.w), bfhi(a.w));
            *(u32x2*)(F.w<unsigned char>(WS_UT8) + (size_t)c * L + t0 + 8 * g) = a8;
        }
    }
    if (l == 0) {
        for (int rp = F.bid; rp < LC / 2; rp += F.G) {
            const int row = L + rp * 2 + (F.tid >> 8), c = F.tid & 255;
            const float x1 = hy_conv3(P, cw, cb, row, L, T, 256 + c), v = hy_conv3(P, cw, cb, row, L, T, 512 + c);
            F.w<float>(WS_U)[(size_t)row * 256 + c] = v * x1;
        }
    }
}
__device__ __forceinline__ void ph_hy_conv_ctx(const Frame& F, int l) {
    const bf16_t* P = F.w<bf16_t>(WS_P);
    const float* cw = F.in[I_HCW] + (size_t)l * 3 * 768; const float* cb = F.in[I_HCB] + (size_t)l * 768;
    for (int it = F.bid; it < 8; it += F.G) {
        const int Lx = LC, rbase = L;
        const int tb = it * 2 + (F.tid >> 8), c = F.tid & 255, t0 = tb * 16;
        const float* U = F.w<float>(WS_U) + (size_t)rbase * 256 + c;
        const float* KC = F.w<float>(WS_KCOMBC) + c;
        float acc[16], wreg[16];
#pragma unroll
        for (int j = 0; j < 16; ++j) { acc[j] = 0.f; wreg[j] = KC[(size_t)(t0 + j + Lx - 1) * 256]; }
        for (int s0 = 0; s0 < Lx; s0 += 16) {
            float ub[16], nb[16];
#pragma unroll
            for (int r = 0; r < 16; ++r) { ub[r] = U[(size_t)(s0 + r) * 256]; const int x = t0 - (s0 + r + 1) + Lx - 1; nb[r] = x >= 0 ? KC[(size_t)x * 256] : 0.f; }
#pragma unroll
            for (int r = 0; r < 16; ++r) {
#pragma unroll
                for (int j = 0; j < 16; ++j) acc[j] += ub[r] * wreg[(j - r) & 15];
                wreg[(15 - r) & 15] = nb[r];
            }
        }
        const float inv = F.w<float>(WS_FSUM)[2 * 256 + c];
        const float db = F.in[I_HYD][l * 256 + c];
#pragma unroll
        for (int j = 0; j < 16; ++j) {
            const int row = rbase + t0 + j;
            const float x0 = hy_conv3(P, cw, cb, row, L, T, c);
            const float u = F.w<float>(WS_U)[(size_t)row * 256 + c];
            F.w<bf16_t>(WS_MIX)[(size_t)row * D + 768 + c] = f2bf(x0 * (acc[j] * inv + u * db));
        }
    }
}

constexpr int HC_UP = 144, HC_UBYTES = 190 * HC_UP;
constexpr int HC_CPOFF = 27392, HC_NG = 83, HC_CPBYTES = 16 * HC_NG * 16;
__device__ __forceinline__ void hc_make_copies(LAS unsigned char* dst, const u32x4 g0, const u32x4 g1, int g) {
    const unsigned w[8] = {g0.x, g0.y, g0.z, g0.w, g1.x, g1.y, g1.z, g1.w};
#pragma unroll
    for (int sh = 0; sh < 16; ++sh) {
        const int b = sh >> 2, r = sh & 3;
        u32x4 o;
        if (r == 0) { o.x = w[b]; o.y = w[b + 1]; o.z = w[b + 2]; o.w = w[b + 3]; }
        else { o.x = __builtin_amdgcn_alignbyte(w[b + 1], w[b], r); o.y = __builtin_amdgcn_alignbyte(w[b + 2], w[b + 1], r);
               o.z = __builtin_amdgcn_alignbyte(w[b + 3], w[b + 2], r); o.w = __builtin_amdgcn_alignbyte(w[b + 4], w[b + 3], r); }
        *(LAS u32x4*)(dst + (sh * HC_NG + g) * 16) = o;
    }
}
__device__ __forceinline__ void ph_hy_conv(const Frame& F, int l) {
    LAS unsigned char* Ul = F.lds;
    LAS unsigned char* Cp = F.lds + HC_CPOFF;
    const int lane = F.lane, wave = F.wave;
    const int nt = wave < 4 ? wave : 7 - wave, par = wave >> 2;
    const int r = lane & 31, h = lane >> 5, sig = r & 15, rho = r >> 4;
    const int sh = (16 - sig) & 15, gofs = 2 * h - rho - (sig ? 1 : 0);
    const int a_lane = (sh * HC_NG + gofs) * 16;
    const int b_lane = r * HC_UP + h * 32;
    const int sclK = 0x79797979, sclU = ONE_E8M0;
    for (int c = F.bid; c < 256; c += F.G) {
        const unsigned char* KRc = F.w<unsigned char>(WS_KR) + ((size_t)l * 256 + c) * KRL;
        const unsigned char* U8c = F.w<unsigned char>(WS_UT8) + (size_t)c * L;
        const bf16_t* UTc = F.w<bf16_t>(WS_UT) + (size_t)c * L;
        __syncthreads();
        for (int q = F.tid; q < 190 * 8; q += NTHREADS) {
            const int blk = q >> 3, piece = q & 7;
            u32x4 v = (u32x4){0u, 0u, 0u, 0u};
            if (blk >= 31 && blk < 159) v = *(const u32x4*)(U8c + (size_t)(blk - 31) * 128 + piece * 16);
            *(LAS u32x4*)(Ul + blk * HC_UP + piece * 16) = v;
        }
        u32x4 g0 = (u32x4){0u, 0u, 0u, 0u}, g1 = g0;
        if (F.tid < HC_NG) { const unsigned char* src = KRc + 31744 + 16 * F.tid; g0 = *(const u32x4*)src; g1 = *(const u32x4*)(src + 16); }
        if (F.tid < HC_NG) hc_make_copies(Cp, g0, g1, F.tid);
        __syncthreads();
        f32x16 acc[4];
#pragma unroll
        for (int m = 0; m < 4; ++m)
#pragma unroll
            for (int i = 0; i < 16; ++i) acc[m][i] = 0.f;
        for (int ci = 0; ci < 32; ++ci) {
            const int Dc = -128 + 8 * ci;
            if (ci + 1 < 32 && F.tid < HC_NG) { const unsigned char* src = KRc + (31744 - 1024 * (ci + 1)) + 16 * F.tid; g0 = *(const u32x4*)src; g1 = *(const u32x4*)(src + 16); }
            const LAS unsigned char* cp = Cp + (ci & 1) * HC_CPBYTES + a_lane;
#pragma unroll 1
            for (int d2 = 0; d2 < 4; ++d2) {
                const int dd = 2 * d2 + par, Dv = Dc + dd;
                if (!((Dv >= 32 * nt - 127) && (Dv <= 32 * nt + 31) && (Dv > -128))) continue;
                const LAS unsigned char* ap = cp + (8 * (8 - dd)) * 16;
                const LAS unsigned char* bp = Ul + b_lane + (32 * nt - Dv + 31) * HC_UP;
                v8i af[6], bfr[2];
#pragma unroll
                for (int e = 0; e < 6; ++e) { const v4i x = *(const LAS v4i*)(ap - 2 * (e - 2) * 16), y = *(const LAS v4i*)(ap - 2 * (e - 2) * 16 + 16); af[e] = __builtin_shufflevector(x, y, 0, 1, 2, 3, 4, 5, 6, 7); }
#pragma unroll
                for (int ks = 0; ks < 2; ++ks) { const v4i x = *(const LAS v4i*)(bp + ks * 64), y = *(const LAS v4i*)(bp + ks * 64 + 16); bfr[ks] = __builtin_shufflevector(x, y, 0, 1, 2, 3, 4, 5, 6, 7); }
#pragma unroll
                for (int ks = 0; ks < 2; ++ks)
#pragma unroll
                    for (int m = 0; m < 4; ++m)
                        asm volatile("v_mfma_scale_f32_32x32x64_f8f6f4 %0, %1, %2, %0, %3, %4 op_sel_hi:[0,0,0]" : "+v"(acc[m]) : "v"(af[m - 2 * ks + 2]), "v"(bfr[ks]), "v"(sclK), "v"(sclU));
            }
            if (ci + 1 < 32 && F.tid < HC_NG) hc_make_copies(Cp + ((ci + 1) & 1) * HC_CPBYTES, g0, g1, F.tid);
            __syncthreads();
        }
        LAS float* Rd = (LAS float*)F.lds;
        if (wave >= 4) {
#pragma unroll
            for (int m = 0; m < 4; ++m)
#pragma unroll
                for (int i = 0; i < 16; ++i) Rd[(nt * 64 + m * 16 + i) * 64 + lane] = acc[m][i];
        }
        __syncthreads();
        if (wave < 4) {
#pragma unroll
            for (int m = 0; m < 4; ++m)
#pragma unroll
                for (int i = 0; i < 16; ++i) acc[m][i] += Rd[(nt * 64 + m * 16 + i) * 64 + lane];
            const float inv = F.w<float>(WS_FSUM)[l * 256 + c];
            const float db = F.in[I_HYD][l * 256 + c];
            const bf16_t* X0c = F.w<bf16_t>(WS_X0T) + (size_t)c * L;
            bf16_t* YTc = F.w<bf16_t>(WS_YT) + (size_t)c * L;
            const int I = 32 * nt + r;
#pragma unroll
            for (int m = 0; m < 4; ++m) {
#pragma unroll
                for (int g = 0; g < 4; ++g) {
                    const int t = 128 * I + 32 * m + 8 * g + 4 * h;
                    const u32x2 xv = *(const u32x2*)(X0c + t), uv = *(const u32x2*)(UTc + t);
                    float y[4];
#pragma unroll
                    for (int e = 0; e < 4; ++e) y[e] = acc[m][4 * g + e] * inv;
                    y[0] = bflo(xv.x) * (y[0] + bflo(uv.x) * db); y[1] = bfhi(xv.x) * (y[1] + bfhi(uv.x) * db);
                    y[2] = bflo(xv.y) * (y[2] + bflo(uv.y) * db); y[3] = bfhi(xv.y) * (y[3] + bfhi(uv.y) * db);
                    u32x2 o; o.x = pk_bf16(y[0], y[1]); o.y = pk_bf16(y[2], y[3]);
                    *(u32x2*)(YTc + t) = o;
                }
            }
        }
    }
}
__device__ __forceinline__ void ph_hy_tr(const Frame& F) {
    LAS unsigned* yt = (LAS unsigned*)F.lds;
    for (int it = F.bid; it < L / 64; it += F.G) {
        const int t0 = it * 64;
        __syncthreads();
        for (int q = F.tid; q < 256 * 8; q += NTHREADS) {
            const int c = q >> 3, g = q & 7;
            const u32x4 a = *(const u32x4*)(F.w<bf16_t>(WS_YT) + (size_t)c * L + t0 + 8 * g);
            yt[c * 33 + 4 * g] = a.x; yt[c * 33 + 4 * g + 1] = a.y; yt[c * 33 + 4 * g + 2] = a.z; yt[c * 33 + 4 * g + 3] = a.w;
        }
        __syncthreads();
        for (int q = F.tid; q < 64 * 32; q += NTHREADS) {
            const int row = q >> 5, cg = q & 31;
            const LAS unsigned short* ys = (const LAS unsigned short*)yt;
            unsigned short v[8];
#pragma unroll
            for (int e = 0; e < 8; ++e) v[e] = ys[((cg * 8 + e) * 33) * 2 + row];
            u32x4 o; o.x = v[0] | ((unsigned)v[1] << 16); o.y = v[2] | ((unsigned)v[3] << 16); o.z = v[4] | ((unsigned)v[5] << 16); o.w = v[6] | ((unsigned)v[7] << 16);
            *(u32x4*)(F.w<bf16_t>(WS_MIX) + (size_t)(t0 + row) * D + 768 + cg * 8) = o;
        }
    }
}

constexpr int WRP = 1028;
__device__ __forceinline__ void ph_post1(const Frame& F, int l) {
    LAS float* wr = (LAS float*)F.lds;
    LAS unsigned* lcnt = (LAS unsigned*)(F.lds + 32 * WRP * 4);
    __syncthreads();
    if (F.tid < 64) lcnt[F.tid] = 0u;
    {
        const f32x4* src = (const f32x4*)(F.in[I_WR] + (size_t)l * 1024 * 32);
        f32x4 v[16];
#pragma unroll
        for (int u = 0; u < 16; ++u) v[u] = src[F.tid + u * NTHREADS];
#pragma unroll
        for (int u = 0; u < 16; ++u) { const int q4 = F.tid + u * NTHREADS, k = q4 >> 3, e0 = (q4 & 7) * 4;
#pragma unroll
            for (int i = 0; i < 4; ++i) wr[(e0 + i) * WRP + k] = v[u][i]; }
    }
    __syncthreads();
    const int nrows = (l == 0) ? T : L;
    const int nwaves = F.G * 8, lane = F.lane;
    unsigned* cnt = F.w<unsigned>(WS_CTL) + CW_CNT + l * 1024;
    if (F.bid == 0) { for (int q = F.tid; q < D / 4; q += NTHREADS) ((unsigned*)(F.w<unsigned char>(WS_H2) + (size_t)T * D))[q] = 0u; }
    const float brl = F.in[I_BR][l * 32 + ((lane >> 1) & 31)];
    const int mye = (lane >> 1) & 31;
    for (int row0 = F.bid * 8 + F.wave; row0 < nrows; row0 += 2 * nwaves) {
        int rw[2]; bool vld[2];
        rw[0] = row0; vld[0] = true; vld[1] = (row0 + nwaves < nrows); rw[1] = vld[1] ? row0 + nwaves : row0;
        f32x4 m[2][4], x[2][4], hv[2][4];
#pragma unroll
        for (int u = 0; u < 2; ++u) { const bf16_t* mr = F.w<bf16_t>(WS_MIXO) + (size_t)rw[u] * D;
#pragma unroll
            for (int i = 0; i < 4; ++i) { const u32x2 w = *(const u32x2*)(mr + 4 * lane + 256 * i); m[u][i] = (f32x4){bflo(w.x), bfhi(w.x), bflo(w.y), bfhi(w.y)}; }
            load_xrow(F, l, rw[u], lane, x[u]); }
#pragma unroll
        for (int u = 0; u < 2; ++u) {
            const int which = rw[u] >= L;
            const float* v0 = vecs_ptr(F, l, which, 2);
            const float rs1 = row_rstd(m[u]);
#pragma unroll
            for (int i = 0; i < 4; ++i) { const f32x4 a = *(const f32x4*)(v0 + 4 * lane + 256 * i); x[u][i] = x[u][i] + m[u][i] * rs1 * a; }
        }
#pragma unroll
        for (int u = 0; u < 2; ++u) {
            if (vld[u]) store_xrow_bf16(F.w<bf16_t>(WS_XCUR) + (size_t)rw[u] * D, lane, x[u]);
        }
#pragma unroll
        for (int u = 0; u < 2; ++u) {
            const int which = rw[u] >= L;
            const float* v1 = vecs_ptr(F, l, which, 3), *v2 = vecs_ptr(F, l, which, 4);
            const float rs2 = row_rstd(x[u]);
#pragma unroll
            for (int i = 0; i < 4; ++i) { const f32x4 a = *(const f32x4*)(v1 + 4 * lane + 256 * i), b = *(const f32x4*)(v2 + 4 * lane + 256 * i); hv[u][i] = x[u][i] * rs2 * a + b; }
            if (vld[u]) { unsigned char* ho = F.w<unsigned char>(WS_H2) + (size_t)rw[u] * D;
#pragma unroll
                for (int i = 0; i < 4; ++i) *(unsigned*)(ho + 4 * lane + 256 * i) = pk_fp8x4(hv[u][i][0], hv[u][i][1], hv[u][i][2], hv[u][i][3]); }
        }
        float part[2][32];
#pragma unroll
        for (int e = 0; e < 32; ++e) {
            float s0 = 0.f, s1 = 0.f;
#pragma unroll
            for (int i = 0; i < 4; ++i) { const f32x4 w = *(const LAS f32x4*)(wr + e * WRP + 4 * lane + 256 * i);
                s0 += hv[0][i][0] * w[0] + hv[0][i][1] * w[1] + hv[0][i][2] * w[2] + hv[0][i][3] * w[3];
                s1 += hv[1][i][0] * w[0] + hv[1][i][1] * w[1] + hv[1][i][2] * w[2] + hv[1][i][3] * w[3]; }
            part[0][e] = s0; part[1][e] = s1;
        }
#pragma unroll
        for (int st = 0; st < 5; ++st) {
            const int o = 32 >> st, n = 32 >> st;
            const bool upper = (lane & o) != 0;
#pragma unroll
            for (int i = 0; i < n / 2; ++i) {
#pragma unroll
                for (int u = 0; u < 2; ++u) {
                    const float send = upper ? part[u][i] : part[u][i + n / 2];
                    const float recv = __shfl_xor(send, o);
                    const float keep = upper ? part[u][i + n / 2] : part[u][i];
                    part[u][i] = keep + recv;
                }
            }
        }
#pragma unroll
        for (int u = 0; u < 2; ++u) {
            float lg = part[u][0] + __shfl_xor(part[u][0], 1);
            lg += brl;
            int rank = 0;
#pragma unroll
            for (int e = 0; e < 32; ++e) { const float ov = __int_as_float(__builtin_amdgcn_readlane(__float_as_int(lg), 2 * e)); rank += (ov > lg || (ov == lg && e < mye)) ? 1 : 0; }
            int te[4]; float tv[4];
#pragma unroll
            for (int k = 0; k < 4; ++k) {
                const unsigned long long msk = __ballot(rank == k && (lane & 1) == 0);
                const int idx = msk ? __builtin_amdgcn_readfirstlane((int)__builtin_ctzll(msk)) : 2 * k;
                te[k] = idx >> 1; tv[k] = __int_as_float(__builtin_amdgcn_readlane(__float_as_int(lg), idx));
            }
            const float e1 = __expf(tv[1] - tv[0]), e2 = __expf(tv[2] - tv[0]), e3 = __expf(tv[3] - tv[0]);
            const float inv = 1.0f / (1.0f + e1 + e2 + e3);
            if (lane < 4 && vld[u]) {
                const int k = lane, row = rw[u];
                const int e = k == 0 ? te[0] : (k == 1 ? te[1] : (k == 2 ? te[2] : te[3]));
                const float wgt = (k == 0 ? 1.0f : (k == 1 ? e1 : (k == 2 ? e2 : e3))) * inv;
                const unsigned pos = __hip_atomic_fetch_add(lcnt + e, 1u, __ATOMIC_RELAXED, __HIP_MEMORY_SCOPE_WORKGROUP);
                F.w<int>(WS_RE)[row * 4 + k] = e; F.w<int>(WS_RP)[row * 4 + k] = (int)pos; F.w<float>(WS_RW)[row * 4 + k] = wgt;
            }
        }
    }
    __syncthreads();
    if (F.tid < 32) lcnt[32 + F.tid] = atomicAdd(cnt + F.tid * 32, lcnt[F.tid]);
    __syncthreads();
    for (int row = F.bid * 8 + F.wave; row < nrows; row += nwaves) {
        if (lane < 4) { const int a = row * 4 + lane; F.w<int>(WS_RP)[a] += (int)lcnt[32 + F.w<int>(WS_RE)[a]]; }
    }
}

__device__ __forceinline__ int expert_pad_start(const Frame& F, int l, int& ntiles) {
    const unsigned* cnt = F.w<unsigned>(WS_CTL) + CW_CNT + l * 1024;
    int c = F.lane < 32 ? (int)__hip_atomic_load(cnt + F.lane * 32, __ATOMIC_RELAXED, __HIP_MEMORY_SCOPE_AGENT) : 0;
    int padded = (c + 255) & ~255;
    int incl = padded;
#pragma unroll
    for (int o = 1; o < 32; o <<= 1) { const int v = __shfl_up(incl, o); if ((F.lane & 31) >= o) incl += v; }
    ntiles = __shfl(incl, 31) >> 8;
    return incl - padded;
}

__device__ __forceinline__ void ph_gather(const Frame& F, int l) {
    int ntiles; const int ps = expert_pad_start(F, l, ntiles);
    if (F.bid == 0 && F.wave == 0) {
        int* tab = F.w<int>(WS_CTL) + CW_TILE + l * 320;
        const int nxt = __shfl_down(ps, 1);
        const int endt = (F.lane == 31) ? ntiles : (nxt >> 8);
        if (F.lane < 32) for (int t = ps >> 8; t < endt; ++t) tab[t] = F.lane;
        if (F.lane == 0) F.w<int>(WS_CTL)[CW_NT + l] = ntiles;
    }
    const int nrows = (l == 0) ? T : L;
    for (int a0 = (F.bid * 8 + F.wave) * 64; a0 < nrows * 4; a0 += F.G * 8 * 64) {
        const int a = a0 + F.lane;
        if (a < nrows * 4) {
            const int e = F.w<int>(WS_RE)[a], pos = F.w<int>(WS_RP)[a];
            const int dst = __shfl(ps, e) + pos;
            F.w<int>(WS_SLOT)[a] = dst;
            F.w<int>(WS_ROWTOK)[(size_t)l * MAXROWS + dst] = a >> 2;
        }
    }
}

__device__ __forceinline__ void ph_final(const Frame& F, int l) {
    const int nrows = (l == 0) ? T : L;
    const int nwaves = F.G * 8, lane = F.lane;
    const bf16_t* Y = F.w<bf16_t>(WS_Y) + (size_t)l * MAXROWS * D;
    int slotn[2][4]; float wgtn[2][4];
#define FN_SLOTS(r0_) do { _Pragma("unroll") for (int u = 0; u < 2; ++u) { const int rr_ = ((r0_) + u * nwaves < nrows) ? (r0_) + u * nwaves : (r0_); \
        _Pragma("unroll") for (int k = 0; k < 4; ++k) { slotn[u][k] = F.w<int>(WS_SLOT)[rr_ * 4 + k]; wgtn[u][k] = F.w<float>(WS_RW)[rr_ * 4 + k]; } } } while (0)
    const int rfirst = F.bid * 8 + F.wave;
    if (rfirst < nrows) FN_SLOTS(rfirst);
    for (int row0 = rfirst; row0 < nrows; row0 += 2 * nwaves) {
        int rw[2]; bool vld[2];
        rw[0] = row0; vld[0] = true; vld[1] = (row0 + nwaves < nrows); rw[1] = vld[1] ? row0 + nwaves : row0;
        int slot[2][4]; float wgt[2][4];
#pragma unroll
        for (int u = 0; u < 2; ++u)
#pragma unroll
            for (int k = 0; k < 4; ++k) { slot[u][k] = slotn[u][k]; wgt[u][k] = wgtn[u][k]; }
        u32x2 yv[2][4][4]; f32x4 x[2][4];
#pragma unroll
        for (int u = 0; u < 2; ++u) {
#pragma unroll
            for (int k = 0; k < 4; ++k) { const bf16_t* yr = Y + (size_t)slot[u][k] * D;
#pragma unroll
                for (int i = 0; i < 4; ++i) yv[u][k][i] = *(const u32x2*)(yr + 4 * lane + 256 * i); }
            load_xrow(F, 1, rw[u], lane, x[u]);
        }
        if (row0 + 2 * nwaves < nrows) FN_SLOTS(row0 + 2 * nwaves);
#pragma unroll
        for (int u = 0; u < 2; ++u) {
            const int which = rw[u] >= L;
            const float* ve = vecs_ptr(F, l, which, 5);
            f32x4 f[4];
#pragma unroll
            for (int i = 0; i < 4; ++i) f[i] = (f32x4){0.f, 0.f, 0.f, 0.f};
#pragma unroll
            for (int k = 0; k < 4; ++k)
#pragma unroll
                for (int i = 0; i < 4; ++i) { const u32x2 w = yv[u][k][i]; f[i][0] += wgt[u][k] * bflo(w.x); f[i][1] += wgt[u][k] * bfhi(w.x); f[i][2] += wgt[u][k] * bflo(w.y); f[i][3] += wgt[u][k] * bfhi(w.y); }
            const float rs = row_rstd(f);
#pragma unroll
            for (int i = 0; i < 4; ++i) { const f32x4 a = *(const f32x4*)(ve + 4 * lane + 256 * i); x[u][i] = x[u][i] + f[i] * rs * a; }
            if (vld[u]) {
                if (l == 1) { float* xo = F.out + (size_t)rw[u] * D;
#pragma unroll
                    for (int i = 0; i < 4; ++i) *(f32x4*)(xo + 4 * lane + 256 * i) = x[u][i]; }
                else store_xrow_bf16(F.w<bf16_t>(WS_XCUR) + (size_t)rw[u] * D, lane, x[u]);
                if (l == 0) {
                    const float rstd = row_rstd(x[u]);
                    const float* va = vecs_ptr(F, 1, which, 0), *vb = vecs_ptr(F, 1, which, 1);
                    bf16_t* orow = F.w<bf16_t>(WS_HB) + (size_t)rw[u] * D;
#pragma unroll
                    for (int i = 0; i < 4; ++i) {
                        const int c = 4 * lane + 256 * i;
                        const f32x4 a = *(const f32x4*)(va + c), b = *(const f32x4*)(vb + c);
                        u32x2 w; w.x = pk_bf16(x[u][i][0] * rstd * a[0] + b[0], x[u][i][1] * rstd * a[1] + b[1]); w.y = pk_bf16(x[u][i][2] * rstd * a[2] + b[2], x[u][i][3] * rstd * a[3] + b[3]);
                        *(u32x2*)(orow + c) = w;
                    }
                }
            }
        }
    }
#undef FN_SLOTS
}

constexpr int PH_PER_LAYER = 10, N_PHASES = 2 + 2 * PH_PER_LAYER;
#ifndef PH_MASK
#define PH_MASK 0xFFFFFFFFu
#endif
#define EN(b) (((PH_MASK) >> (b)) & 1u)
#ifndef DUP_MASK
#define DUP_MASK 0u
#endif
#define REP(b) for (int _rep = 0; _rep < 1 + (int)(((DUP_MASK) >> (b)) & 1u); ++_rep)

__global__ void __launch_bounds__(NTHREADS, 2) mega(Args args) {
    extern __shared__ __attribute__((aligned(16))) unsigned char shm[];
    Frame F0;
    F0.in.kp = (kargp_t)__builtin_amdgcn_kernarg_segment_ptr();
    F0.out = args.out; F0.ws = args.ws; F0.lds = (LAS unsigned char*)shm;
    F0.tid = threadIdx.x; F0.lane = F0.tid & 63; F0.wave = __builtin_amdgcn_readfirstlane(F0.tid >> 6); F0.G = gridDim.x; F0.bid = blockIdx.x;
    volatile LAS unsigned* bst = (volatile LAS unsigned*)(shm + LDS_BYTES - 16);
    XcdBarrier bar; bar.bar = F0.w<unsigned>(WS_CTL) + CW_BAR; bar.x = 0; bar.st = bst;
#if N_LAUNCH_MODE == 1
    if (F0.tid == 0) { bst[0] = 0u; bst[1] = 0u; }
    __syncthreads();
    bar = xcd_barrier_post(F0.w<unsigned>(WS_CTL) + CW_BAR, bst);
#define GRID_BAR() xcd_barrier(bar)
#else
#define GRID_BAR() do {} while (0)
#endif
    const int lo = args.ph_lo, hi = args.ph_hi;
#define IN(k) (lo <= (k) && (k) < hi)
#define SEAM(k) do { if (IN(k) && IN((k) + 1)) GRID_BAR(); } while (0)

    if (IN(0)) { const Frame F = launder(F0); REP(1) ph_modpart(F); REP(2) ph_filter(F); __syncthreads(); REP(0) ph_convert(F); }
    SEAM(0);
    if (IN(1)) { const Frame F = launder(F0); REP(3) ph_norm1(F, 0); REP(4) ph_fsum(F); ph_vecs(F); }
    SEAM(1);
    for (int l = 0; l < 2; ++l) {
        const int pb = 2 + l * PH_PER_LAYER;
        if (EN(5) && IN(pb + 0)) { const Frame F = launder(F0);
            pg8::Gemm g{F.w<bf16_t>(WS_HB), F.w<bf16_t>(WS_WINT) + (size_t)l * PC * D, D};
            pg8::SchedGrid S{PC / 256, (T / 256) * (PC / 256), F.G, F.vid};
            pg8::EpiBf16 E{F.w<bf16_t>(WS_P), PC, nullptr, 0};
            REP(5) pg8::gemm_phase<pg8::EpiBf16, pg8::SchedGrid>(F.lds, g, S, E, F.tid);
        }
        SEAM(pb + 0);
        if (IN(pb + 1)) { const Frame F = launder(F0); REP(6) ph_ssd_prep(F, l); REP(7) ph_hy_prep(F, l); REP(8) ph_na(F, l, 0); }
        SEAM(pb + 1);
        if (IN(pb + 2)) { const Frame F = launder(F0); REP(9) ph_ssd_scan(F); REP(10) { ph_hy_conv(F, l); if (l == 0) ph_hy_conv_ctx(F, l); } }
        SEAM(pb + 2);
        if (EN(11) && IN(pb + 3)) { const Frame F = launder(F0); REP(11) ph_ssd_out(F, l); REP(18) ph_hy_tr(F); if (l == 0) ph_na(F, l, 1); }
        SEAM(pb + 3);
        if (EN(12) && IN(pb + 4)) { const Frame F = launder(F0);
            pg8::Gemm g{F.w<bf16_t>(WS_MIX), F.w<bf16_t>(WS_WOUTT) + (size_t)l * D * D, D};
            const int nM = (l == 0) ? T / 256 : L / 256;
            pg8::SchedGrid S{4, nM * 4, F.G, F.vid};
            pg8::EpiBf16 E{F.w<bf16_t>(WS_MIXO), D, nullptr, 0};
            REP(12) pg8::gemm_phase<pg8::EpiBf16, pg8::SchedGrid>(F.lds, g, S, E, F.tid);
        }
        SEAM(pb + 4);
        if (EN(13) && IN(pb + 5)) { const Frame F = launder(F0); ph_post1(F, l); }
        SEAM(pb + 5);
        if (EN(14) && IN(pb + 6)) { const Frame F = launder(F0); REP(14) ph_gather(F, l); }
        SEAM(pb + 6);
        if (EN(15) && IN(pb + 7)) { const Frame F = launder(F0);
            const int* tab = F.w<int>(WS_CTL) + CW_TILE + l * 320;
            const int ntiles = __builtin_amdgcn_readfirstlane(F.w<int>(WS_CTL)[CW_NT + l]);
            pg8::Gemm g{F.w<bf16_t>(WS_H2), (const bf16_t*)(F.w<unsigned char>(WS_WGUT) + (size_t)l * NE * 2048 * D), D / 2};
            pg8::SchedMoe S{8, ntiles * 8, F.G, F.vid, tab};
            pg8::EpiAct E{F.w<unsigned char>(WS_HMID) + (size_t)l * MAXROWS * D, F.in[I_BGU] + (size_t)l * NE * 2048};
            LAS int* rowtab = (LAS int*)(F.lds + pg8::STAGE_BYTES);
            __syncthreads();
            {
                int nt_; const int ps = expert_pad_start(F, l, nt_);
                const unsigned* cnt = F.w<unsigned>(WS_CTL) + CW_CNT + l * 1024;
                for (int ui = 0; ui * F.G + F.vid < ntiles * 8 && ui < 12; ++ui) {
                    const int pa = (ui * F.G + F.vid) / 8;
                    const int e = tab[pa];
                    const int pstart = __shfl(ps, e), ce = (int)__hip_atomic_load(cnt + e * 32, __ATOMIC_RELAXED, __HIP_MEMORY_SCOPE_AGENT);
                    if (F.tid < 256) { const int prow = pa * 256 + F.tid; rowtab[ui * 256 + F.tid] = (prow - pstart < ce) ? F.w<int>(WS_ROWTOK)[(size_t)l * MAXROWS + prow] : T; }
                }
            }
            __syncthreads();
            REP(15) pg8::gemm_phase<pg8::EpiAct, pg8::SchedMoe, true, true, true>(F.lds, g, S, E, F.tid, rowtab);
        }
        SEAM(pb + 7);
        if (EN(16) && IN(pb + 8)) { const Frame F = launder(F0);
            const int* tab = F.w<int>(WS_CTL) + CW_TILE + l * 320;
            const int ntiles = __builtin_amdgcn_readfirstlane(F.w<int>(WS_CTL)[CW_NT + l]);
            pg8::Gemm g{(const bf16_t*)(F.w<unsigned char>(WS_HMID) + (size_t)l * MAXROWS * D), (const bf16_t*)(F.w<unsigned char>(WS_WDT) + (size_t)l * NE * D * D), D / 2};
            pg8::SchedMoe S{4, ntiles * 4, F.G, F.vid, tab};
            pg8::EpiBf16 E{F.w<bf16_t>(WS_Y) + (size_t)l * MAXROWS * D, D, F.in[I_BDN] + (size_t)l * NE * D, D};
            REP(16) pg8::gemm_phase<pg8::EpiBf16, pg8::SchedMoe, true, false, true>(F.lds, g, S, E, F.tid);
        }
        SEAM(pb + 8);
        if (EN(17) && IN(pb + 9)) { const Frame F = launder(F0); ph_final(F, l); }
        if (l == 0) SEAM(pb + 9);
    }
#undef IN
#undef SEAM
}

extern "C" void kernel_launch(void* const* d_in, const int* in_sizes, int n_in, void* d_out, int out_size, void* d_ws, size_t ws_size, hipStream_t stream) {
    static int grid = 0;
    if (grid == 0) {
        if (n_in != N_IN || out_size != L * D || ws_size < WS_END) { fprintf(stderr, "kernel_launch: unexpected shapes: n_in %d out %d ws %zu (need %zu)\n", n_in, out_size, ws_size, (size_t)WS_END); grid = -1; return; }
        int dev = 0, cus = 0, per_cu = 0;
        if (hipGetDevice(&dev) != hipSuccess || hipDeviceGetAttribute(&cus, hipDeviceAttributeMultiprocessorCount, dev) != hipSuccess) { grid = -1; return; }
        if (hipFuncSetAttribute((const void*)mega, hipFuncAttributeMaxDynamicSharedMemorySize, LDS_BYTES) != hipSuccess) { fprintf(stderr, "kernel_launch: hipFuncSetAttribute failed\n"); grid = -1; return; }
        if (hipOccupancyMaxActiveBlocksPerMultiprocessor(&per_cu, (const void*)mega, NTHREADS, LDS_BYTES) != hipSuccess || per_cu < 1) { fprintf(stderr, "kernel_launch: occupancy query says %d\n", per_cu); }
        (void)hipGetLastError();
        grid = cus;
    }
    if (grid < 0) return;
    (void)hipMemsetAsync((char*)d_ws + WS_CTL, 0, CTL_BYTES, stream);
    Args a{};
    for (int i = 0; i < N_IN; ++i) a.in[i] = (const float*)d_in[i];
    a.out = (float*)d_out; a.ws = (unsigned char*)d_ws;
#if N_LAUNCH_MODE == 1
    a.ph_lo = 0; a.ph_hi = N_PHASES;
    hipLaunchKernelGGL(mega, dim3(grid), dim3(NTHREADS), LDS_BYTES, stream, a);
#else
    for (int p = 0; p < N_PHASES; ++p) { a.ph_lo = p; a.ph_hi = p + 1; hipLaunchKernelGGL(mega, dim3(grid), dim3(NTHREADS), LDS_BYTES, stream, a); }
#endif
}
```

```cpp
#include <hip/hip_runtime.h>
#include <cstdio>
#include <cstdint>

#define LAS __attribute__((address_space(3)))
typedef unsigned short bf16_t;
typedef short bf16x8 __attribute__((ext_vector_type(8)));
typedef float f32x4 __attribute__((ext_vector_type(4)));
typedef float f32x16 __attribute__((ext_vector_type(16)));
typedef unsigned u32x4 __attribute__((ext_vector_type(4)));
typedef unsigned u32x2 __attribute__((ext_vector_type(2)));
typedef int v4i __attribute__((ext_vector_type(4)));
typedef int v8i __attribute__((ext_vector_type(8)));

#ifndef N_LAUNCH_MODE
#define N_LAUNCH_MODE 1
#endif

constexpr int D = 1024, L = 16384, LC = 256, T = L + LC, NCH = T / 128;
constexpr int PC = 3328;
constexpr int CZ = 0, CXBC = 384, CQ = 1280, CK = 1664, CV = 2048, CHY = 2432, CDT = 3200;
constexpr int NE = 32;
constexpr int MAXT = 292;
constexpr int MAXROWS = MAXT * 256;
constexpr int NTHREADS = 512;
constexpr int LDS_BYTES = 160 * 1024;
constexpr float RMS_EPS = 1e-6f;

enum { I_X = 0, I_C, I_CTX, I_CCTX, I_WMOD, I_BMOD, I_NORMG, I_WIN, I_SCW, I_SCB, I_ALOG, I_DTB, I_SSDD, I_SSDNG, I_RPB, I_HCW, I_HCB,
       I_FW1, I_FB1, I_FW2, I_FB2, I_FW3, I_FREQ, I_HYD, I_WOUT, I_WR, I_BR, I_WGU, I_BGU, I_WDN, I_BDN, N_IN };

constexpr size_t al256(size_t x) { return (x + 255) & ~(size_t)255; }
constexpr size_t WS_CTL   = 0;
constexpr size_t CTL_BYTES = 64 * 1024;
constexpr size_t WS_WINT  = WS_CTL + CTL_BYTES;
constexpr size_t WS_WOUTT = WS_WINT + al256((size_t)2 * PC * D * 2);
constexpr size_t WS_WGUT  = WS_WOUTT + al256((size_t)2 * D * D * 2);
constexpr size_t WS_WDT   = WS_WGUT + al256((size_t)2 * NE * 2048 * D * 2);
constexpr size_t WS_MODP  = WS_WDT + al256((size_t)2 * NE * D * D * 2);
constexpr int KRL = 2 * L + 512;
constexpr size_t WS_KR    = WS_MODP + al256((size_t)2 * 2 * 32 * 6144 * 4);
constexpr size_t WS_KCOMBC= WS_KR + al256((size_t)2 * 256 * KRL * 2);
constexpr size_t WS_FPART = WS_KCOMBC + al256((size_t)2 * LC * 256 * 4);
constexpr size_t WS_FPARTC= WS_FPART + al256((size_t)2 * 256 * 512 * 4);
constexpr size_t WS_FSUM  = WS_FPARTC + al256((size_t)16 * 512 * 4);
constexpr size_t WS_HB    = WS_FSUM + al256((size_t)3 * 256 * 4);
constexpr size_t WS_P     = WS_HB + al256((size_t)T * D * 2);
constexpr size_t WS_XBC   = WS_P + al256((size_t)T * PC * 2);
constexpr size_t WS_DTV   = WS_XBC + al256((size_t)T * 896 * 2);
constexpr size_t WS_ACS   = WS_DTV + al256((size_t)T * 12 * 4);
constexpr size_t WS_ALAST = WS_ACS + al256((size_t)T * 12 * 4);
constexpr size_t WS_STATES= WS_ALAST + al256((size_t)NCH * 12 * 4);
constexpr size_t WS_SSTART= WS_STATES + al256((size_t)2 * NCH * 6 * 128 * 64 * 4);
constexpr size_t WS_U     = WS_SSTART + al256((size_t)2 * NCH * 6 * 128 * 64 * 4);
constexpr size_t WS_UT    = WS_U + al256((size_t)T * 256 * 4);
constexpr size_t WS_UT8   = WS_UT + al256((size_t)256 * L * 2);
constexpr size_t WS_X0T   = WS_UT8 + al256((size_t)256 * L);
constexpr size_t WS_YT    = WS_X0T + al256((size_t)256 * L * 2);
constexpr size_t WS_MIX   = WS_YT + al256((size_t)256 * L * 2);
constexpr size_t WS_MIXO  = WS_MIX + al256((size_t)T * D * 2);
constexpr size_t WS_XCUR  = WS_MIXO + al256((size_t)T * D * 4);
constexpr size_t WS_H2    = WS_XCUR + al256((size_t)T * D * 4);
constexpr size_t WS_RE    = WS_H2 + al256((size_t)(T + 1) * D * 2);
constexpr size_t WS_RP    = WS_RE + al256((size_t)T * 4 * 4);
constexpr size_t WS_RW    = WS_RP + al256((size_t)T * 4 * 4);
constexpr size_t WS_SLOT  = WS_RW + al256((size_t)T * 4 * 4);
constexpr size_t WS_XG    = WS_SLOT + al256((size_t)T * 4 * 4);
constexpr size_t WS_HMID  = WS_XG + 256;
constexpr size_t WS_Y     = WS_HMID + al256((size_t)2 * MAXROWS * D * 2);
constexpr size_t WS_VECS  = WS_Y + al256((size_t)2 * MAXROWS * D * 2);
constexpr size_t WS_ROWTOK= WS_VECS + al256((size_t)2 * 2 * 6 * 1024 * 4);
constexpr size_t WS_END   = WS_ROWTOK + al256((size_t)2 * MAXROWS * 4);

constexpr int CW_BAR = 0;
constexpr int CW_CNT = 8192;
#ifndef INPROJ_FP8
#define INPROJ_FP8 2
#endif
#define F8IN(l) (((INPROJ_FP8) >> (l)) & 1)
#ifndef PRO_NF
#define PRO_NF 96
#endif
constexpr int CW_CVQ = 4160;
constexpr int CW_NT = 4200;
constexpr int CW_TILE = 4224;

__device__ __forceinline__ float bf2f(unsigned short b) { return __uint_as_float(((unsigned)b) << 16); }
__device__ __forceinline__ unsigned short f2bf(float f) { unsigned u = __float_as_uint(f); u += 0x7FFFu + ((u >> 16) & 1u); return (unsigned short)(u >> 16); }
__device__ __forceinline__ unsigned pk_bf16(float lo, float hi) { return (unsigned)f2bf(lo) | ((unsigned)f2bf(hi) << 16); }
__device__ __forceinline__ float sat8(float x) { return fminf(fmaxf(x, -448.0f), 448.0f); }
__device__ __forceinline__ unsigned pk_fp8x4(float a, float b, float c, float d) { unsigned w = 0; w = __builtin_amdgcn_cvt_pk_fp8_f32(sat8(a), sat8(b), w, false); w = __builtin_amdgcn_cvt_pk_fp8_f32(sat8(c), sat8(d), w, true); return w; }
constexpr float KR_SCALE = 64.0f;
constexpr float W8_SCALE = 32.0f;
constexpr int W8_SCALE_E8M0 = 0x7A7A7A7A, ONE_E8M0 = 0x7F7F7F7F;
__device__ __forceinline__ float bflo(unsigned w) { return __uint_as_float(w << 16); }
__device__ __forceinline__ float bfhi(unsigned w) { return __uint_as_float(w & 0xFFFF0000u); }
__device__ __forceinline__ float silu_f(float x) { return x / (1.0f + __expf(-x)); }
__device__ __forceinline__ float softplus_f(float x) { return x > 20.f ? x : log1pf(__expf(x)); }
__device__ __forceinline__ float wave_sum(float v) {
#pragma unroll
    for (int o = 32; o >= 1; o >>= 1) v += __shfl_xor(v, o);
    return v;
}
__device__ __forceinline__ void lds_fence() { asm volatile("s_waitcnt lgkmcnt(0)" ::: "memory"); }

#define XB_TMO      128
#define XB_XCNT(j)  (256  + 64 * (j))
#define XB_XSUB(j)  (1280 + 64 * (j))
#define XB_XGEN(j)  (2304 + 64 * (j))
#define XB_TOP      3328
#define XB_TOPGEN   3392
#define XCD_BAR_WORDS 3456
#define XB_SPIN_CAP (1u << 18)
__device__ __forceinline__ unsigned xb_ld(unsigned* p)              { return __hip_atomic_load(p, __ATOMIC_RELAXED, __HIP_MEMORY_SCOPE_AGENT); }
__device__ __forceinline__ unsigned xb_add(unsigned* p, unsigned v) { return __hip_atomic_fetch_add(p, v, __ATOMIC_RELAXED, __HIP_MEMORY_SCOPE_AGENT); }
__device__ __forceinline__ unsigned xb_xcc_id() { return (unsigned)__builtin_amdgcn_s_getreg((3 << 11) | 20) & 0xFu; }
#define XB_SPIN(cond, bar) do { unsigned _sp = 0; while (cond) { __builtin_amdgcn_s_sleep(1); \
    if ((++_sp & 255u) == 0u) { if (xb_ld(&(bar)[XB_TMO])) break; if (_sp > XB_SPIN_CAP) { atomicAdd(&(bar)[XB_TMO], 1u); break; } } } } while (0)
struct XcdBarrier { unsigned* bar; unsigned x; volatile LAS unsigned* st; };
__device__ __forceinline__ XcdBarrier xcd_barrier_post(unsigned* bar, volatile LAS unsigned* st) {
    XcdBarrier b; b.bar = bar; b.x = xb_xcc_id(); b.st = st;
    if (threadIdx.x == 0) (void)xb_add(&bar[XB_XCNT(b.x)], 1u);
    return b;
}
__device__ __forceinline__ void xcd_barrier_complete(unsigned* bar, unsigned x, unsigned& nloc, unsigned& nx) {
    const unsigned G = gridDim.x * gridDim.y * gridDim.z;
    unsigned sum, cnt, mine, sp = 0u;
    for (;;) {
        sum = 0u; cnt = 0u; mine = 0u;
#pragma unroll
        for (unsigned j = 0; j < 16; ++j) { const unsigned c = xb_ld(&bar[XB_XCNT(j)]); sum += c; cnt += (c > 0u) ? 1u : 0u; mine = (j == x) ? c : mine; }
        if (sum == G) break;
        __builtin_amdgcn_s_sleep(1);
        if ((++sp & 255u) == 0u) { if (xb_ld(&bar[XB_TMO])) break; if (sp > XB_SPIN_CAP) { atomicAdd(&bar[XB_TMO], 1u); break; } }
    }
    nloc = mine > 0u ? mine : 1u; nx = cnt > 0u ? cnt : 1u;
}
__device__ __forceinline__ void xcd_barrier(const XcdBarrier& b) {
    asm volatile("s_waitcnt vmcnt(0)" ::: "memory");
    __syncthreads();
    if (threadIdx.x == 0) {
        unsigned* bar = b.bar;
        __builtin_amdgcn_s_waitcnt(0);
        unsigned nloc = b.st[0], nx = b.st[1];
        if (nloc == 0u) { xcd_barrier_complete(bar, b.x, nloc, nx); b.st[0] = nloc; b.st[1] = nx; }
        const unsigned old = xb_add(&bar[XB_XSUB(b.x)], 1u);
        const unsigned gen = old / nloc;
        if (old + 1u == (gen + 1u) * nloc) {
            __builtin_amdgcn_fence(__ATOMIC_RELEASE, "agent");
            asm volatile("s_waitcnt vmcnt(0)" ::: "memory");
            const unsigned og = xb_add(&bar[XB_TOP], 1u);
            const unsigned tg = og / nx;
            if (og + 1u == (tg + 1u) * nx) xb_add(&bar[XB_TOPGEN], 1u);
            else XB_SPIN(xb_ld(&bar[XB_TOPGEN]) == tg, bar);
            __builtin_amdgcn_fence(__ATOMIC_ACQUIRE, "agent");
            xb_add(&bar[XB_XGEN(b.x)], 1u);
            asm volatile("s_waitcnt vmcnt(0)" ::: "memory");
        } else {
            XB_SPIN(xb_ld(&bar[XB_XGEN(b.x)]) == gen, bar);
            __builtin_amdgcn_fence(__ATOMIC_ACQUIRE, "agent");
            asm volatile("s_waitcnt vmcnt(0)" ::: "memory");
        }
    }
    __syncthreads();
}

#ifndef GEMM_REP
#define GEMM_REP 1
#endif
namespace pg8 {
constexpr int BM = 256, BK = 64, HALF = 128, HTB = HALF * BK * 2, STAGE_BYTES = 8 * HTB;
__host__ __device__ __forceinline__ int lds_byte(int r, int c) { const int st = (r >> 4) * 2 + (c >> 5), rr = r & 15, cc = c & 31, ob = rr * 64 + cc * 2; return st * 1024 + (ob ^ (((ob >> 9) & 1) << 5)); }
__host__ __device__ __forceinline__ void stage_rc(int b, int& R, int& C) { const int st = b / 1024, sb = b % 1024, swz = sb ^ (((sb >> 9) & 1) << 5); R = (st >> 1) * 16 + swz / 64; C = (st & 1) * 32 + (swz % 64) / 2; }
__host__ __device__ __forceinline__ int perm32(int rho) { const int n = rho >> 4, i = rho & 15; return 8 * (i >> 2) + 4 * n + (i & 3); }

struct Unit { int pa, pb, pn, e; };
struct Gemm { const bf16_t* A; const bf16_t* Bt; int K; };

template <class Epi, class Sched, bool ALIGN_EPI = true, bool GATHER = false, bool FP8 = false>
__device__ __forceinline__ void gemm_phase(LAS unsigned char* lds, const Gemm g, const Sched& S, const Epi& E, const int tid, const LAS int* rowtab = nullptr) {
    const int wid = __builtin_amdgcn_readfirstlane(tid >> 6), lane = tid & 63, wr = wid >> 2, wc = wid & 3, fr = lane & 15, fq = lane >> 4;
    const int K = g.K, nt = K / BK;
    unsigned voffA[2], voffB[2];
    int gR[2], gC[2];
#pragma unroll
    for (int i = 0; i < 2; ++i) { int R, C; stage_rc(tid * 16 + i * 8192, R, C); const int Rb = Epi::PERM ? ((R & ~31) + perm32(R & 31)) : R;
        voffA[i] = (unsigned)(R * K + C) * 2u; voffB[i] = (unsigned)(Rb * K + C) * 2u; gR[i] = R; gC[i] = C * 2; }
    unsigned vC0[2], vC1[2], vN0[2], vN1[2];
#define PG8_GOFFS(dst0, dst1, ui_) do { _Pragma("unroll") for (int _i = 0; _i < 2; ++_i) { \
        dst0[_i] = (unsigned)rowtab[(ui_) * 256 + gR[_i]] * (unsigned)(K * 2) + (unsigned)gC[_i]; dst1[_i] = (unsigned)rowtab[(ui_) * 256 + 128 + gR[_i]] * (unsigned)(K * 2) + (unsigned)gC[_i]; } } while (0)
    const size_t kstep = (size_t)(BK * 2);
    const size_t hstep = (size_t)HALF * K * 2;
    const size_t tstep = 2 * hstep;
    const unsigned ldsw = (unsigned)wid * 1024u;
    const int aoff = lds_byte(wr * 64 + fr, fq * 8), boff = lds_byte(wc * 32 + fr, fq * 8);
#define PG8_SA(b, h) (((b) * 2 + (h)) * HTB)
#define PG8_SB(b, h) ((4 + (b) * 2 + (h)) * HTB)
#define PG8_STAGE(bufoff, gbase, voff) do { _Pragma("unroll") for (int _i = 0; _i < 2; ++_i) \
        __builtin_amdgcn_global_load_lds((const unsigned*)((const char*)(gbase) + (voff)[_i]), (LAS unsigned*)(lds + (bufoff) + ldsw + _i * 8192), 16, 0, 0); } while (0)
#define PG8_LDA(dst, b, h) do { _Pragma("unroll") for (int m = 0; m < 4; ++m) { const v4i _x = *(const LAS v4i*)(lds + PG8_SA(b, h) + aoff + m * 2048), _y = *(const LAS v4i*)(lds + PG8_SA(b, h) + aoff + m * 2048 + 1024); \
        dst[m] = __builtin_shufflevector(_x, _y, 0, 1, 2, 3, 4, 5, 6, 7); } } while (0)
#define PG8_LDB(dst, b, h) do { _Pragma("unroll") for (int n = 0; n < 2; ++n) { const v4i _x = *(const LAS v4i*)(lds + PG8_SB(b, h) + boff + n * 2048), _y = *(const LAS v4i*)(lds + PG8_SB(b, h) + boff + n * 2048 + 1024); \
        dst[n] = __builtin_shufflevector(_x, _y, 0, 1, 2, 3, 4, 5, 6, 7); } } while (0)
#define PG8_HALF0(x) __builtin_bit_cast(bf16x8, __builtin_shufflevector((x), (x), 0, 1, 2, 3))
#define PG8_HALF1(x) __builtin_bit_cast(bf16x8, __builtin_shufflevector((x), (x), 4, 5, 6, 7))
#define PG8_MMA(ai, bj, At, Bt) do { __builtin_amdgcn_s_setprio(1); if constexpr (FP8) { _Pragma("unroll") for (int m = 0; m < 4; ++m) _Pragma("unroll") for (int n = 0; n < 2; ++n) \
        asm volatile("v_mfma_scale_f32_16x16x128_f8f6f4 %0, %1, %2, %0, %3, %4 op_sel_hi:[0,0,0]" : "+v"(acc[ai][bj][m][n]) : "v"(Bt[n]), "v"(At[m]), "v"(sclW), "v"(sclX)); } \
        else { _Pragma("unroll") for (int m = 0; m < 4; ++m) _Pragma("unroll") for (int n = 0; n < 2; ++n) { \
        acc[ai][bj][m][n] = __builtin_amdgcn_mfma_f32_16x16x32_bf16(PG8_HALF0(Bt[n]), PG8_HALF0(At[m]), acc[ai][bj][m][n], 0, 0, 0); \
        acc[ai][bj][m][n] = __builtin_amdgcn_mfma_f32_16x16x32_bf16(PG8_HALF1(Bt[n]), PG8_HALF1(At[m]), acc[ai][bj][m][n], 0, 0, 0); } } __builtin_amdgcn_s_setprio(0); } while (0)
#define PG8_WAIT_V(n) asm volatile("s_waitcnt vmcnt(" #n ")" ::: "memory")
#define PG8_WAIT_L(n) asm volatile("s_waitcnt lgkmcnt(" #n ")" ::: "memory")
#define PG8_BAR __builtin_amdgcn_s_barrier()
#define PG8_SCHED __builtin_amdgcn_sched_barrier(0)
    Unit cur, nxt; int ui = 0;
    if (!S.next(0, cur)) return;
    f32x4 acc[2][2][4][2];
    E.init(acc, cur, wc, fq);
    const int sclW = W8_SCALE_E8M0, sclX = ONE_E8M0;
    v8i At[4], B0[2], B1[2];
    const char* cA = GATHER ? (const char*)g.A : (const char*)g.A + (size_t)cur.pa * tstep; const char* cB = (const char*)g.Bt + (size_t)cur.pb * tstep;
    const size_t hstepA = GATHER ? 0 : hstep;
    if constexpr (GATHER) { PG8_GOFFS(vC0, vC1, 0); } else {
#pragma unroll
        for (int i = 0; i < 2; ++i) { vC0[i] = voffA[i]; vC1[i] = voffA[i]; vN0[i] = voffA[i]; vN1[i] = voffA[i]; } }
    PG8_STAGE(PG8_SB(0, 0), cB, voffB); PG8_STAGE(PG8_SB(0, 1), cB + hstep, voffB); PG8_STAGE(PG8_SA(0, 0), cA, vC0); PG8_STAGE(PG8_SA(0, 1), cA + hstepA, vC1);
    if (wr == 1) PG8_BAR;
    PG8_WAIT_V(2); PG8_BAR;
    PG8_STAGE(PG8_SB(1, 0), cB + kstep, voffB); PG8_STAGE(PG8_SA(1, 0), cA + kstep, vC0); PG8_STAGE(PG8_SB(1, 1), cB + hstep + kstep, voffB);
    PG8_WAIT_V(6); PG8_BAR;
    for (;;) {
        const bool has_next = S.next(ui + 1, nxt);
        const char* nA = GATHER ? (const char*)g.A : (has_next ? (const char*)g.A + (size_t)nxt.pa * tstep : cA); const char* nB = has_next ? (const char*)g.Bt + (size_t)nxt.pb * tstep : cB;
        if constexpr (GATHER) { if (has_next) { PG8_GOFFS(vN0, vN1, ui + 1); } else {
#pragma unroll
            for (int i = 0; i < 2; ++i) { vN0[i] = vC0[i]; vN1[i] = vC1[i]; } } }
#pragma unroll 1
        for (int t = 0; t < nt; t += 2) {
            const bool last = (t == nt - 2);
            unsigned vX0[2], vX1[2];
#pragma unroll
            for (int i = 0; i < 2; ++i) { vX0[i] = (GATHER && last) ? vN0[i] : vC0[i]; vX1[i] = (GATHER && last) ? vN1[i] : vC1[i]; }
            const char* a1 = cA + (size_t)(t + 1) * kstep;
            const char* a2 = last ? nA : cA + (size_t)(t + 2) * kstep; const char* b2 = last ? nB : cB + (size_t)(t + 2) * kstep;
            const char* a3 = a2 + kstep; const char* b3 = b2 + kstep;
            PG8_LDB(B0, 0, 0); PG8_LDB(B1, 0, 1); PG8_SCHED; PG8_LDA(At, 0, 0); PG8_STAGE(PG8_SA(1, 1), a1 + hstepA, vC1);
            PG8_WAIT_V(8); PG8_WAIT_L(0); PG8_BAR; PG8_MMA(0, 0, At, B0); PG8_MMA(0, 1, At, B1); PG8_BAR; PG8_SCHED;
            PG8_LDA(At, 0, 1); PG8_STAGE(PG8_SB(0, 0), b2, voffB); PG8_STAGE(PG8_SB(0, 1), b2 + hstep, voffB); PG8_STAGE(PG8_SA(0, 0), a2, vX0);
            PG8_WAIT_V(8); PG8_WAIT_L(0); PG8_BAR; PG8_MMA(1, 0, At, B0); PG8_MMA(1, 1, At, B1); PG8_BAR; PG8_SCHED;
            PG8_LDB(B0, 1, 0); PG8_LDB(B1, 1, 1); PG8_SCHED; PG8_LDA(At, 1, 0); PG8_STAGE(PG8_SA(0, 1), a2 + hstepA, vX1);
            PG8_WAIT_V(8); PG8_WAIT_L(0); PG8_BAR; PG8_MMA(0, 0, At, B0); PG8_MMA(0, 1, At, B1); PG8_BAR; PG8_SCHED;
            PG8_LDA(At, 1, 1); PG8_STAGE(PG8_SB(1, 0), b3, voffB); PG8_STAGE(PG8_SB(1, 1), b3 + hstep, voffB); PG8_STAGE(PG8_SA(1, 0), a3, vX0);
            PG8_WAIT_V(8); PG8_WAIT_L(0); PG8_BAR; PG8_MMA(1, 0, At, B0); PG8_MMA(1, 1, At, B1); PG8_BAR; PG8_SCHED;
        }
        if constexpr (ALIGN_EPI) { if (wr == 0) PG8_BAR; }
        E(acc, cur, wr, wc, fr, fq);
        if (!has_next) break;
        E.init(acc, nxt, wc, fq);
        cur = nxt; cA = nA; cB = nB; ++ui;
        if constexpr (GATHER) {
#pragma unroll
            for (int i = 0; i < 2; ++i) { vC0[i] = vN0[i]; vC1[i] = vN1[i]; } }
        if constexpr (ALIGN_EPI) { if (wr == 1) PG8_BAR; }
    }
    PG8_WAIT_V(0);
    if constexpr (!ALIGN_EPI) { if (wr == 0) PG8_BAR; }
    PG8_BAR;
#undef PG8_GOFFS
#undef PG8_HALF0
#undef PG8_HALF1
#undef PG8_SA
#undef PG8_SB
#undef PG8_STAGE
#undef PG8_LDA
#undef PG8_LDB
#undef PG8_MMA
#undef PG8_WAIT_V
#undef PG8_WAIT_L
#undef PG8_BAR
#undef PG8_SCHED
}

struct EpiF32 {
    static constexpr bool PERM = false;
    float* C; int ldc;
    __device__ __forceinline__ void operator()(const f32x4 (&acc)[2][2][4][2], const Unit& u, int wr, int wc, int fr, int fq) const {
        const int row0 = u.pa * BM + wr * 64 + fr, col0 = u.pn * BM + wc * 32 + 4 * fq;
#pragma unroll
        for (int ai = 0; ai < 2; ++ai)
#pragma unroll
            for (int m = 0; m < 4; ++m) { float* rowp = C + (size_t)(row0 + ai * HALF + m * 16) * ldc + col0;
#pragma unroll
                for (int bj = 0; bj < 2; ++bj)
#pragma unroll
                    for (int n = 0; n < 2; ++n) *(f32x4*)(rowp + bj * HALF + n * 16) = acc[ai][bj][m][n]; }
    }
};
struct EpiBf16 {
    static constexpr bool PERM = true;
    bf16_t* O; int ldc; const float* bias; int bias_stride;
    __device__ __forceinline__ void init(f32x4 (&acc)[2][2][4][2], const Unit& u, int wc, int fq) const {
        const int col0 = u.pn * BM + wc * 32 + 8 * fq;
#pragma unroll
        for (int bj = 0; bj < 2; ++bj)
#pragma unroll
            for (int n = 0; n < 2; ++n) { const f32x4 bv = bias ? *(const f32x4*)(bias + (size_t)u.e * bias_stride + col0 + bj * HALF + 4 * n) : (f32x4){0.f, 0.f, 0.f, 0.f};
#pragma unroll
                for (int ai = 0; ai < 2; ++ai)
#pragma unroll
                    for (int m = 0; m < 4; ++m) acc[ai][bj][m][n] = bv; }
    }
    __device__ __forceinline__ void operator()(const f32x4 (&acc)[2][2][4][2], const Unit& u, int wr, int wc, int fr, int fq) const {
        const int row0 = u.pa * BM + wr * 64 + fr; const int col0 = u.pn * BM + wc * 32 + 8 * fq;
#pragma unroll
        for (int ai = 0; ai < 2; ++ai)
#pragma unroll
            for (int m = 0; m < 4; ++m) { bf16_t* rowp = O + (size_t)(row0 + ai * HALF + m * 16) * ldc + col0;
#pragma unroll
                for (int bj = 0; bj < 2; ++bj) { const f32x4 v0 = acc[ai][bj][m][0], v1 = acc[ai][bj][m][1];
                    u32x4 w; w.x = pk_bf16(v0[0], v0[1]); w.y = pk_bf16(v0[2], v0[3]); w.z = pk_bf16(v1[0], v1[1]); w.w = pk_bf16(v1[2], v1[3]);
                    *(u32x4*)(rowp + bj * HALF) = w; } }
    }
};
struct EpiAct {
    static constexpr bool PERM = true;
    unsigned char* O; const float* bias;
    __device__ __forceinline__ void init(f32x4 (&acc)[2][2][4][2], const Unit& u, int wc, int fq) const {
        const float* bg = bias + (size_t)u.e * 2048 + u.pn * 128 + wc * 32 + 8 * fq;
#pragma unroll
        for (int bj = 0; bj < 2; ++bj)
#pragma unroll
            for (int n = 0; n < 2; ++n) { const f32x4 bv = *(const f32x4*)(bg + bj * 1024 + 4 * n);
#pragma unroll
                for (int ai = 0; ai < 2; ++ai)
#pragma unroll
                    for (int m = 0; m < 4; ++m) acc[ai][bj][m][n] = bv; }
    }
    __device__ __forceinline__ void operator()(const f32x4 (&acc)[2][2][4][2], const Unit& u, int wr, int wc, int fr, int fq) const {
        const int row0 = u.pa * BM + wr * 64 + fr; const int cc0 = wc * 32 + 8 * fq; const int ocol = u.pn * 128 + cc0;
#pragma unroll
        for (int ai = 0; ai < 2; ++ai)
#pragma unroll
            for (int m = 0; m < 4; ++m) { unsigned char* rowp = O + (size_t)(row0 + ai * HALF + m * 16) * D + ocol;
                float r[8];
#pragma unroll
                for (int n = 0; n < 2; ++n)
#pragma unroll
                    for (int j = 0; j < 4; ++j) { float gt = acc[ai][0][m][n][j], up = acc[ai][1][m][n][j];
                        gt = fminf(gt, 7.0f); up = fminf(fmaxf(up, -7.0f), 7.0f);
                        r[n * 4 + j] = gt / (1.0f + __expf(-1.702f * gt)) * (up + 1.0f); }
                u32x2 w; w.x = pk_fp8x4(r[0], r[1], r[2], r[3]); w.y = pk_fp8x4(r[4], r[5], r[6], r[7]);
                *(u32x2*)rowp = w; }
    }
};
struct SchedGrid {
    int nN, total, G, c;
    __device__ __forceinline__ bool next(int i, Unit& u) const { int Lx = i * G + c; if (Lx >= GEMM_REP * total) return false; if (GEMM_REP > 1) Lx %= total; u.pa = Lx / nN; u.pn = Lx - u.pa * nN; u.pb = u.pn; u.e = 0; return true; }
};
struct SchedMoe {
    int nN, total, G, c; const int* tile_e;
    __device__ __forceinline__ bool next(int i, Unit& u) const { int Lx = i * G + c; if (Lx >= GEMM_REP * total) return false; if (GEMM_REP > 1) Lx %= total; u.pa = Lx / nN; u.pn = Lx - u.pa * nN; u.e = __builtin_amdgcn_readfirstlane((int)tile_e[u.pa]); u.pb = u.e * nN + u.pn; return true; }
};
}

struct Args { const float* in[N_IN]; float* out; unsigned char* ws; int ph_lo, ph_hi; };

typedef const float* __attribute__((address_space(4))) const* kargp_t;
struct InProxy { kargp_t kp; __device__ __forceinline__ const float* operator[](int i) const { return kp[i]; } };
struct Frame {
    InProxy in; float* out; unsigned char* ws;
    LAS unsigned char* lds;
    int tid, lane, wave, G, bid, vid;
    template <class Tp> __device__ __forceinline__ Tp* w(size_t off) const { return (Tp*)(ws + off); }
};

__device__ __forceinline__ Frame launder(const Frame& F) {
    Frame R = F;
    int t = F.tid; asm volatile("" : "+v"(t)); R.tid = t; R.lane = t & 63; R.wave = __builtin_amdgcn_readfirstlane(t >> 6);
    unsigned long long w = (unsigned long long)F.ws; asm volatile("" : "+s"(w)); R.ws = (unsigned char*)w;
    unsigned long long o = (unsigned long long)F.out; asm volatile("" : "+s"(o)); R.out = (float*)o;
    unsigned long long k = (unsigned long long)F.in.kp; asm volatile("" : "+s"(k)); R.in.kp = (kargp_t)k;
    int g = F.G, b = F.bid; asm volatile("" : "+s"(g), "+s"(b)); R.G = g; R.bid = b; R.vid = (g % 8 == 0) ? (b % 8) * (g / 8) + b / 8 : b;
    return R;
}

__device__ __forceinline__ float mod_val(const Frame& F, int l, int which, int j) {
    const float* mp = F.w<float>(WS_MODP) + (size_t)((l * 2 + which) * 32) * 6144 + j;
    float s = F.in[I_BMOD][l * 6144 + j];
#pragma unroll
    for (int k = 0; k < 32; ++k) s += mp[(size_t)k * 6144];
    return s;
}

struct CvtTile { const float* src; bf16_t* dst; int ld, mode, k0, n0; bool f8; };
__device__ __forceinline__ CvtTile cvt_decode(const Frame& F, int t) {
    CvtTile c;
    if (t < 1664) { const int l = t / 832, r = t % 832; c.n0 = (r / 16) * 64; c.k0 = (r % 16) * 64; c.src = F.in[I_WIN] + (size_t)l * 1024 * 3212; c.ld = 3212; c.mode = 1; c.f8 = F8IN(l) != 0; c.dst = F.w<bf16_t>(WS_WINT) + (size_t)l * PC * D; }
    else if (t < 2176) { const int q = t - 1664, l = q / 256, r = q % 256; c.n0 = (r / 16) * 64; c.k0 = (r % 16) * 64; c.src = F.in[I_WOUT] + (size_t)l * D * D; c.ld = 1024; c.mode = 0; c.f8 = false; c.dst = F.w<bf16_t>(WS_WOUTT) + (size_t)l * D * D; }
    else if (t < 34944) { const int q = t - 2176, le = q / 512, r = q % 512; c.n0 = (r / 16) * 64; c.k0 = (r % 16) * 64; c.src = F.in[I_WGU] + (size_t)le * 1024 * 2048; c.ld = 2048; c.mode = 2; c.f8 = true; c.dst = (bf16_t*)(F.w<unsigned char>(WS_WGUT) + (size_t)le * 2048 * D); }
    else { const int q = t - 34944, le = q / 256, r = q % 256; c.n0 = (r / 16) * 64; c.k0 = (r % 16) * 64; c.src = F.in[I_WDN] + (size_t)le * D * D; c.ld = 1024; c.mode = 0; c.f8 = true; c.dst = (bf16_t*)(F.w<unsigned char>(WS_WDT) + (size_t)le * D * D); }
    return c;
}
__device__ __forceinline__ void cvt_load(const CvtTile& c, int lane, f32x4 (&a)[8], f32x4 (&b)[8]) {
    const int i4 = lane & 15, kpl = lane >> 4;
    const int n = c.n0 + 4 * i4;
    int sc; bool valid = true;
    if (c.mode == 0) sc = n;
    else if (c.mode == 1) { if (n < 1280) sc = n; else if (n < 3200) sc = n + 12; else if (n < 3212) sc = n - 3200 + 1280; else { sc = 0; valid = false; } }
    else { const int pn = n >> 8, rr = n & 255; sc = rr < 128 ? pn * 128 + rr : 1024 + pn * 128 + (rr - 128); }
#pragma unroll
    for (int it = 0; it < 8; ++it) {
        const int r0 = c.f8 ? 4 * (kpl + 4 * (it >> 1)) + 2 * (it & 1) : 2 * (kpl + 4 * it);
        a[it] = (f32x4){0.f, 0.f, 0.f, 0.f}; b[it] = a[it];
        if (valid) { a[it] = __builtin_nontemporal_load((const f32x4*)(c.src + (size_t)(c.k0 + r0) * c.ld + sc)); b[it] = __builtin_nontemporal_load((const f32x4*)(c.src + (size_t)(c.k0 + r0 + 1) * c.ld + sc)); }
    }
}
__device__ __forceinline__ void cvt_store(const CvtTile& c, int lane, const f32x4 (&a)[8], const f32x4 (&b)[8], LAS unsigned* lw) {
    const int i4 = lane & 15, kpl = lane >> 4;
    if (c.f8) {
#pragma unroll
        for (int j = 0; j < 4; ++j) {
            const int kq = kpl + 4 * j;
#pragma unroll
            for (int i = 0; i < 4; ++i) lw[kq * 65 + 4 * i4 + i] = pk_fp8x4(W8_SCALE * a[2 * j][i], W8_SCALE * b[2 * j][i], W8_SCALE * a[2 * j + 1][i], W8_SCALE * b[2 * j + 1][i]);
        }
        lds_fence();
        const int g = lane & 3, nl = lane >> 2;
        unsigned char* d8 = (unsigned char*)c.dst;
#pragma unroll
        for (int it = 0; it < 4; ++it) {
            const int nn = nl + 16 * it;
            u32x4 v; v.x = lw[(4 * g + 0) * 65 + nn]; v.y = lw[(4 * g + 1) * 65 + nn]; v.z = lw[(4 * g + 2) * 65 + nn]; v.w = lw[(4 * g + 3) * 65 + nn];
            *(u32x4*)(d8 + (size_t)(c.n0 + nn) * 1024 + c.k0 + 16 * g) = v;
        }
        lds_fence();
        return;
    }
#pragma unroll
    for (int it = 0; it < 8; ++it) {
        const int kp = kpl + 4 * it;
#pragma unroll
        for (int i = 0; i < 4; ++i) lw[kp * 65 + 4 * i4 + i] = pk_bf16(a[it][i], b[it][i]);
    }
    lds_fence();
    const int g = lane & 7, nl = lane >> 3;
#pragma unroll
    for (int it = 0; it < 8; ++it) {
        const int nn = nl + 8 * it;
        u32x4 v; v.x = lw[(4 * g + 0) * 65 + nn]; v.y = lw[(4 * g + 1) * 65 + nn]; v.z = lw[(4 * g + 2) * 65 + nn]; v.w = lw[(4 * g + 3) * 65 + nn];
        *(u32x4*)(c.dst + (size_t)(c.n0 + nn) * 1024 + c.k0 + 8 * g) = v;
    }
    lds_fence();
}

__device__ __forceinline__ void cvt_store8x2(const CvtTile& c, int lane, const f32x4 (&a0)[8], const f32x4 (&b0)[8], const f32x4 (&a1)[8], const f32x4 (&b1)[8], LAS unsigned* lw) {
    const int i4 = lane & 15, kpl = lane >> 4;
#pragma unroll
    for (int j = 0; j < 4; ++j) {
        const int kq = kpl + 4 * j;
#pragma unroll
        for (int i = 0; i < 4; ++i) {
            lw[kq * 65 + 4 * i4 + i] = pk_fp8x4(W8_SCALE * a0[2 * j][i], W8_SCALE * b0[2 * j][i], W8_SCALE * a0[2 * j + 1][i], W8_SCALE * b0[2 * j + 1][i]);
            lw[(16 + kq) * 65 + 4 * i4 + i] = pk_fp8x4(W8_SCALE * a1[2 * j][i], W8_SCALE * b1[2 * j][i], W8_SCALE * a1[2 * j + 1][i], W8_SCALE * b1[2 * j + 1][i]);
        }
    }
    lds_fence();
    const int g = lane & 7, nl = lane >> 3;
    unsigned char* d8 = (unsigned char*)c.dst;
#pragma unroll
    for (int it = 0; it < 8; ++it) {
        const int nn = nl + 8 * it;
        u32x4 v; v.x = lw[(4 * g + 0) * 65 + nn]; v.y = lw[(4 * g + 1) * 65 + nn]; v.z = lw[(4 * g + 2) * 65 + nn]; v.w = lw[(4 * g + 3) * 65 + nn];
        *(u32x4*)(d8 + (size_t)(c.n0 + nn) * 1024 + c.k0 + 16 * g) = v;
    }
    lds_fence();
}
__device__ __forceinline__ void ph_convert(const Frame& F) {
    LAS unsigned* lw = (LAS unsigned*)(F.lds) + F.wave * (32 * 65 + 16);
    const int nwaves = F.G * 8, w0 = F.bid * 8 + F.wave;
    f32x4 a0[8], b0[8], a1[8], b1[8];
    for (int t = w0; t < 2176; t += nwaves) { const CvtTile c = cvt_decode(F, t); cvt_load(c, F.lane, a0, b0); cvt_store(c, F.lane, a0, b0, lw); }
    unsigned* ctr = F.w<unsigned>(WS_CTL) + CW_CVQ;
    for (;;) {
        unsigned tb = 0;
        if (F.lane == 0) tb = atomicAdd(ctr, 4u);
        tb = __builtin_amdgcn_readfirstlane(tb);
        if (tb >= 16384u + 8192u) break;
        for (int t = (int)tb; t < (int)tb + 4; ++t) {
            CvtTile c; c.f8 = true;
            if (t < 16384) { const int le = t >> 8, r = t & 255; c.n0 = (r >> 3) * 64; c.k0 = (r & 7) * 128; c.src = F.in[I_WGU] + (size_t)le * 1024 * 2048; c.ld = 2048; c.mode = 2; c.dst = (bf16_t*)(F.w<unsigned char>(WS_WGUT) + (size_t)le * 2048 * D); }
            else { const int q = t - 16384, le = q >> 7, r = q & 127; c.n0 = (r >> 3) * 64; c.k0 = (r & 7) * 128; c.src = F.in[I_WDN] + (size_t)le * D * D; c.ld = 1024; c.mode = 0; c.dst = (bf16_t*)(F.w<unsigned char>(WS_WDT) + (size_t)le * D * D); }
            cvt_load(c, F.lane, a0, b0);
            CvtTile c2 = c; c2.k0 = c.k0 + 64;
            cvt_load(c2, F.lane, a1, b1);
            cvt_store8x2(c, F.lane, a0, b0, a1, b1, lw);
        }
    }
}

__device__ __forceinline__ void ph_modpart(const Frame& F) {
    for (int it = F.bid; it < 768; it += F.G) {
        const int l = it / 384, r = it % 384, cc = r / 32, kc = r % 32;
        const int j = cc * 512 + F.tid;
        const float* wm = F.in[I_WMOD] + (size_t)l * D * 6144 + (size_t)(kc * 32) * 6144 + j;
        float wv[32];
#pragma unroll
        for (int k = 0; k < 32; ++k) wv[k] = wm[(size_t)k * 6144];
        float a0 = 0.f, a1 = 0.f;
#pragma unroll
        for (int k = 0; k < 32; ++k) { a0 += silu_f(F.in[I_C][kc * 32 + k]) * wv[k]; a1 += silu_f(F.in[I_CCTX][kc * 32 + k]) * wv[k]; }
        float* mp = F.w<float>(WS_MODP);
        mp[(size_t)((l * 2 + 0) * 32 + kc) * 6144 + j] = a0;
        mp[(size_t)((l * 2 + 1) * 32 + kc) * 6144 + j] = a1;
    }
}

__device__ __forceinline__ void ph_filter(const Frame& F) {
    LAS float* zs = (LAS float*)F.lds;
    LAS float* h1 = zs + 64 * 33;
    LAS unsigned char* H2b = F.lds + 24832;
    LAS unsigned char* ob = F.lds + 34048;
    LAS float* w1s = (LAS float*)(F.lds + 68864);
    LAS float* w2s = w1s + 33 * 64;
    const float min_decay = -4.605170185988091f / 1.5f, max_decay = -4.605170185988091f / 0.3f;
    const int wave = F.wave;
    if (F.bid >= PRO_NF) return;
    for (int it = F.bid; it < 512 + 16; it += PRO_NF) {
        int tid = F.tid; asm volatile("" : "+v"(tid));
        const int lane = tid & 63;
        const bool isctx = it >= 512;
        const int l = isctx ? 0 : it / 256, grp = isctx ? it - 512 : it % 256;
        const int Lx = isctx ? LC : L, npos = isctx ? 16 : 64;
        const int t0 = grp * npos;
        __syncthreads();
        for (int q = tid; q < 33 * 64 + 64 * 64; q += NTHREADS) { if (q < 33 * 64) w1s[q] = F.in[I_FW1][(size_t)l * 33 * 64 + q]; else w2s[q - 33 * 64] = F.in[I_FW2][(size_t)l * 64 * 64 + q - 33 * 64]; }
#pragma unroll 1
        for (int q = tid; q < npos * 33; q += NTHREADS) {
            const int pos = q / 33, i = q % 33; const int t = t0 + pos;
            const float tn = (float)t / (float)(Lx - 1);
            const float wv = 6.283185307179586f * (float)t / (float)Lx;
            float v;
            if (i == 0) v = tn;
            else { const int b = (i - 1) & 15; const float f = 1e-4f + (float)b * ((15.0f - 1e-4f) / 15.0f); v = (i <= 16) ? cosf(f * wv) : -sinf(f * wv); }
            zs[q] = v;
        }
        __syncthreads();
        {
            asm volatile("" : "+v"(tid));
            const int o = tid & 63, pg = tid >> 6;
            if (pg * 8 < npos) {
                float acc[8];
                const float bb = F.in[I_FB1][l * 64 + o];
#pragma unroll
                for (int p = 0; p < 8; ++p) acc[p] = bb;
#pragma unroll 3
                for (int i = 0; i < 33; ++i) { const float w = w1s[i * 64 + o];
#pragma unroll
                    for (int p = 0; p < 8; ++p) acc[p] += zs[(pg * 8 + p) * 33 + i] * w; }
                const float fq = F.in[I_FREQ][l * 128 + o];
#pragma unroll
                for (int p = 0; p < 8; ++p) h1[(pg * 8 + p) * 64 + o] = sinf(fq * acc[p]);
            }
        }
        __syncthreads();
        {
            asm volatile("" : "+v"(tid));
            const int o = tid & 63, pg = tid >> 6;
            if (pg * 8 < npos) {
                float acc[8];
                const float bb = F.in[I_FB2][l * 64 + o];
#pragma unroll
                for (int p = 0; p < 8; ++p) acc[p] = bb;
#pragma unroll 4
                for (int i = 0; i < 64; ++i) { const float w = w2s[i * 64 + o];
#pragma unroll
                    for (int p = 0; p < 8; ++p) acc[p] += h1[(pg * 8 + p) * 64 + i] * w; }
                const float fq = F.in[I_FREQ][l * 128 + 64 + o];
#pragma unroll
                for (int p = 0; p < 8; ++p) *(LAS bf16_t*)(H2b + (pg * 8 + p) * 144 + o * 2) = f2bf(sinf(fq * acc[p]));
            }
        }
        __syncthreads();
        {
            int r = lane & 31, hf = lane >> 5;
#pragma unroll
            for (int n = 0; n < 2; ++n) {
                asm volatile("" : "+v"(r), "+v"(hf));
                const int o = 32 * (2 * wave + n) + r, c = o & 255, dir = o >> 8;
                const float* w3 = F.in[I_FW3] + (size_t)l * 64 * 512 + o;
                f32x16 acc[2];
#pragma unroll
                for (int m = 0; m < 2; ++m)
#pragma unroll
                    for (int i = 0; i < 16; ++i) acc[m][i] = 0.f;
                float wv[4][8];
#pragma unroll
                for (int ks = 0; ks < 4; ++ks)
#pragma unroll
                    for (int e = 0; e < 8; ++e) wv[ks][e] = w3[(size_t)(16 * ks + 8 * hf + e) * 512];
#pragma unroll
                for (int ks = 0; ks < 4; ++ks) {
                    bf16x8 b;
#pragma unroll
                    for (int e = 0; e < 8; ++e) b[e] = (short)f2bf(wv[ks][e]);
#pragma unroll
                    for (int m = 0; m < 2; ++m) {
                        const bf16x8 a = *(const LAS bf16x8*)(H2b + (32 * m + r) * 144 + (16 * ks + 8 * hf) * 2);
                        acc[m] = __builtin_amdgcn_mfma_f32_32x32x16_bf16(a, b, acc[m], 0, 0, 0);
                    }
                }
                const float delta = fabsf(min_decay + (float)c * ((max_decay - min_decay) / 255.0f));
                const float dstep = delta / (float)(Lx - 1);
                float asum = 0.f;
                if (!isctx) {
#pragma unroll
                    for (int m = 0; m < 2; ++m)
#pragma unroll
                        for (int rg = 0; rg < 16; ++rg) {
                            const int pos = 32 * m + (rg & 3) + 8 * (rg >> 2) + 4 * hf;
                            const float v = acc[m][rg] * __expf(-(float)(t0 + pos) * dstep);
                            asum += fabsf(v);
                            ob[o * 68 + pos] = (unsigned char)(pk_fp8x4(KR_SCALE * v, 0.f, 0.f, 0.f) & 0xFFu);
                        }
                } else {
                    float* kc = F.w<float>(WS_KCOMBC);
#pragma unroll
                    for (int rg = 0; rg < 8; ++rg) {
                        const int pos = (rg & 3) + 8 * (rg >> 2) + 4 * hf, t = t0 + pos;
                        const float v = acc[0][rg] * __expf(-(float)t * dstep);
                        asum += fabsf(v);
                        const int x = dir == 0 ? Lx - 1 + t : Lx - 1 - t;
                        if (dir == 0 || t >= 1) kc[(size_t)x * 256 + c] = v;
                    }
                }
                asum += __shfl_xor(asum, 32);
                if (hf == 0) { if (isctx) F.w<float>(WS_FPARTC)[grp * 512 + o] = asum; else F.w<float>(WS_FPART)[((size_t)l * 256 + grp) * 512 + o] = asum; }
            }
        }
        if (!isctx) {
            __syncthreads();
            unsigned char* KR = F.w<unsigned char>(WS_KR) + (size_t)l * 256 * KRL;
            asm volatile("" : "+v"(tid));
            for (int q = tid; q < 512 * 64; q += NTHREADS) {
                const int o = q >> 6, p = q & 63, c = o & 255, dir = o >> 8;
                if (dir == 0) KR[(size_t)c * KRL + (L - t0 - 63 + p)] = ob[o * 68 + 63 - p];
                else if (t0 + p >= 1) KR[(size_t)c * KRL + (L + t0 + p)] = ob[o * 68 + p];
            }
            if (grp == 0) for (int q = tid; q < 256 * 513; q += NTHREADS) { const int c = q / 513, r = q % 513; KR[(size_t)c * KRL + (r == 512 ? 0 : 2 * L + r)] = 0; }
        }
    }
}

__device__ __forceinline__ void ph_fsum(const Frame& F) {
    const int nwaves = F.G * 8;
    for (int o = F.bid * 8 + F.wave; o < 768; o += nwaves) {
        const int which = o >> 8, c = o & 255;
        float s = 0.f;
        if (which < 2) { const float* fp = F.w<float>(WS_FPART) + (size_t)which * 256 * 512;
            for (int i = F.lane; i < 256; i += 64) s += fp[(size_t)i * 512 + c] + fp[(size_t)i * 512 + 256 + c]; }
        else { const float* fp = F.w<float>(WS_FPARTC); if (F.lane < 16) s = fp[F.lane * 512 + c] + fp[F.lane * 512 + 256 + c]; }
        s = wave_sum(s);
        if (F.lane == 0) F.w<float>(WS_FSUM)[o] = 1.0f / s;
    }
}

__device__ __forceinline__ void ph_vecs(const Frame& F) {
    for (int q = F.bid * NTHREADS + F.tid; q < 2 * 2 * 6 * 1024; q += F.G * NTHREADS) {
        const int j = q & 1023, k = (q >> 10) % 6, which = ((q >> 10) / 6) & 1, l = (q >> 10) / 12;
        const float* ng = F.in[I_NORMG] + (size_t)l * 4 * 1024;
        float v;
        if (k == 0) v = ng[j] * (1.0f + mod_val(F, l, which, 1 * 1024 + j));
        else if (k == 1) v = mod_val(F, l, which, j);
        else if (k == 2) v = ng[1024 + j] * mod_val(F, l, which, 2 * 1024 + j);
        else if (k == 3) v = ng[2048 + j] * (1.0f + mod_val(F, l, which, 4 * 1024 + j));
        else if (k == 4) v = mod_val(F, l, which, 3 * 1024 + j);
        else v = ng[3072 + j] * mod_val(F, l, which, 5 * 1024 + j);
        F.w<float>(WS_VECS)[q] = v;
    }
}
__device__ __forceinline__ const float* vecs_ptr(const Frame& F, int l, int which, int k) { return F.w<float>(WS_VECS) + (size_t)((l * 2 + which) * 6 + k) * 1024; }

__device__ __forceinline__ void load_row(const float* p, int lane, f32x4 (&v)[4]) {
#pragma unroll
    for (int i = 0; i < 4; ++i) v[i] = *(const f32x4*)(p + 4 * lane + 256 * i);
}
__device__ __forceinline__ float row_rstd(const f32x4 (&v)[4]) {
    float s = 0.f;
#pragma unroll
    for (int i = 0; i < 4; ++i) s += v[i][0] * v[i][0] + v[i][1] * v[i][1] + v[i][2] * v[i][2] + v[i][3] * v[i][3];
    s = wave_sum(s);
    return rsqrtf(s * (1.0f / 1024.0f) + RMS_EPS);
}
__device__ __forceinline__ void stage_norm_vecs(const Frame& F, int l, int gain_idx, int sh_seg, int sc_seg, LAS float* dst  ) {
    for (int q = F.tid; q < 2048; q += NTHREADS) {
        const int which = q >> 10, j = q & 1023;
        const float g = F.in[I_NORMG][(l * 4 + gain_idx) * 1024 + j];
        dst[(which * 2 + 0) * 1024 + j] = g * (1.0f + mod_val(F, l, which, sc_seg * 1024 + j));
        dst[(which * 2 + 1) * 1024 + j] = mod_val(F, l, which, sh_seg * 1024 + j);
    }
}
__device__ __forceinline__ void norm_store_bf16(const f32x4 (&v)[4], float rstd, const LAS float* va, const LAS float* vb, bf16_t* orow, int lane, bool f8 = false) {
#pragma unroll
    for (int i = 0; i < 4; ++i) {
        const int c = 4 * lane + 256 * i;
        const f32x4 a = *(const LAS f32x4*)(va + c), b = *(const LAS f32x4*)(vb + c);
        if (f8) { *(unsigned*)((unsigned char*)orow + c) = pk_fp8x4(v[i][0] * rstd * a[0] + b[0], v[i][1] * rstd * a[1] + b[1], v[i][2] * rstd * a[2] + b[2], v[i][3] * rstd * a[3] + b[3]); }
        else { u32x2 w; w.x = pk_bf16(v[i][0] * rstd * a[0] + b[0], v[i][1] * rstd * a[1] + b[1]); w.y = pk_bf16(v[i][2] * rstd * a[2] + b[2], v[i][3] * rstd * a[3] + b[3]);
        *(u32x2*)(orow + c) = w; }
    }
}
__device__ __forceinline__ const float* xrow_ptr(const Frame& F, int l, int row) {
    if (l == 0) return row < L ? F.in[I_X] + (size_t)row * D : F.in[I_CTX] + (size_t)(row - L) * D;
    return F.w<float>(WS_XCUR) + (size_t)row * D;
}
__device__ __forceinline__ void load_xrow(const Frame& F, int l, int row, int lane, f32x4 (&v)[4]) {
    if (l == 0) { load_row(row < L ? F.in[I_X] + (size_t)row * D : F.in[I_CTX] + (size_t)(row - L) * D, lane, v); return; }
    const bf16_t* p = F.w<bf16_t>(WS_XCUR) + (size_t)row * D;
#pragma unroll
    for (int i = 0; i < 4; ++i) { const u32x2 w = *(const u32x2*)(p + 4 * lane + 256 * i); v[i] = (f32x4){bflo(w.x), bfhi(w.x), bflo(w.y), bfhi(w.y)}; }
}
__device__ __forceinline__ void store_xrow_bf16(bf16_t* p, int lane, const f32x4 (&v)[4]) {
#pragma unroll
    for (int i = 0; i < 4; ++i) { u32x2 w; w.x = pk_bf16(v[i][0], v[i][1]); w.y = pk_bf16(v[i][2], v[i][3]); *(u32x2*)(p + 4 * lane + 256 * i) = w; }
}
__device__ __forceinline__ void ph_norm1(const Frame& F, int l) {
    LAS float* vec = (LAS float*)F.lds;
    __syncthreads();
    stage_norm_vecs(F, l, 0, 0, 1, vec);
    __syncthreads();
    const int nwaves = F.G * 8;
    for (int row = F.bid * 8 + F.wave; row < T; row += nwaves) {
        const int which = row >= L;
        f32x4 v[4]; load_row(xrow_ptr(F, l, row), F.lane, v);
        const float rstd = row_rstd(v);
        norm_store_bf16(v, rstd, vec + (which * 2) * 1024, vec + (which * 2 + 1) * 1024, F8IN(0) ? (bf16_t*)(F.w<unsigned char>(WS_HB) + (size_t)row * D) : F.w<bf16_t>(WS_HB) + (size_t)row * D, F.lane, F8IN(0) != 0);
    }
}

constexpr int SROW = 272;
__device__ __forceinline__ bf16x8 lds_frag(const LAS unsigned char* base, int row, int k) { return *(const LAS bf16x8*)(base + row * SROW + k * 2); }
__device__ __forceinline__ void ph_ssd_prep(const Frame& F, int l) {
    LAS unsigned char* BT = F.lds;
    LAS unsigned char* XW = F.lds + 34816;
    LAS float* dts = (LAS float*)(F.lds + 139264);
    LAS float* wj  = dts + 768;
    const bf16_t* P = F.w<bf16_t>(WS_P);
    const int lane = F.lane, wave = F.wave;
    for (int it = F.bid; it < NCH * 2; it += F.G) {
        const int ch = it >> 1, g = it & 1;
        const int row0 = ch * 128;
        const int seq_lo = ch < 128 ? 0 : L, seq_hi = ch < 128 ? L : T;
        int r = lane & 31, hf = lane >> 5; asm volatile("" : "+v"(r), "+v"(hf));
        __syncthreads();
        if (wave < 6) {
            const int hh = wave >> 1, dir = wave & 1, h = g * 3 + hh;
            const float a = -__expf(F.in[I_ALOG][(l * 2 + dir) * 6 + h]), bias = F.in[I_DTB][(l * 2 + dir) * 6 + h];
            const int j0 = 2 * lane;
            const float d0 = softplus_f(bf2f(P[(size_t)(row0 + j0) * PC + CDT + dir * 6 + h]) + bias);
            const float d1 = softplus_f(bf2f(P[(size_t)(row0 + j0 + 1) * PC + CDT + dir * 6 + h]) + bias);
            const float pair = (d0 + d1) * a;
            float incl = pair;
#pragma unroll
            for (int o = 1; o < 64; o <<= 1) {
                const float v = dir == 0 ? __shfl_up(incl, o) : __shfl_down(incl, o);
                const bool okl = dir == 0 ? (lane >= o) : (lane + o < 64);
                if (okl) incl += v;
            }
            const float total = __shfl(incl, dir == 0 ? 63 : 0);
            float acs0, acs1;
            if (dir == 0) { acs1 = incl; acs0 = incl - d1 * a; }
            else { acs0 = incl; acs1 = incl - d0 * a; }
            float* dtv = F.w<float>(WS_DTV) + (size_t)(row0 + j0) * 12 + dir * 6 + h; dtv[0] = d0; dtv[12] = d1;
            float* acv = F.w<float>(WS_ACS) + (size_t)(row0 + j0) * 12 + dir * 6 + h; acv[0] = acs0; acv[12] = acs1;
            if (lane == 0) F.w<float>(WS_ALAST)[ch * 12 + dir * 6 + h] = total;
            dts[wave * 128 + j0] = d0; dts[wave * 128 + j0 + 1] = d1;
            wj[wave * 128 + j0] = __expf(total - acs0) * d0; wj[wave * 128 + j0 + 1] = __expf(total - acs1) * d1;
        }
        __syncthreads();
        if (F.tid < 448) {
            const int pr = F.tid % 224, half = F.tid / 224;
            const int chn = pr < 96 ? g * 192 + 2 * pr : (pr < 160 ? 384 + g * 128 + 2 * (pr - 96) : 640 + g * 128 + 2 * (pr - 160));
            const float* cw = F.in[I_SCW] + (size_t)l * 5 * 896 + chn; const float* cb = F.in[I_SCB] + (size_t)l * 896 + chn;
            float w0[5], w1[5];
#pragma unroll
            for (int k = 0; k < 5; ++k) { w0[k] = cw[k * 896]; w1[k] = cw[k * 896 + 1]; }
            const float b0 = cb[0], b1 = cb[1];
            const int jb = half * 64;
            const bf16_t* src = P + CXBC + chn;
            unsigned win[12];
#pragma unroll
            for (int k = 0; k < 4; ++k) { const int rr = row0 + jb + k - 2; win[k] = (rr >= seq_lo && rr < seq_hi) ? *(const unsigned*)(src + (size_t)rr * PC) : 0u; }
            const int hh = pr / 32;
            const int pch = 2 * (pr & 31);
            for (int jg = 0; jg < 64; jg += 8) {
#pragma unroll
                for (int k = 0; k < 8; ++k) { const int rr = row0 + jb + jg + k + 2; win[4 + k] = (rr >= seq_lo && rr < seq_hi) ? *(const unsigned*)(src + (size_t)rr * PC) : 0u; }
                float s0[8], s1[8];
#pragma unroll
                for (int u = 0; u < 8; ++u) {
                    float a0 = b0, a1 = b1;
#pragma unroll
                    for (int k = 0; k < 5; ++k) { a0 += w0[k] * bflo(win[u + k]); a1 += w1[k] * bfhi(win[u + k]); }
                    s0[u] = silu_f(a0); s1[u] = silu_f(a1);
                    *(unsigned*)(F.w<bf16_t>(WS_XBC) + (size_t)(row0 + jb + jg + u) * 896 + chn) = pk_bf16(s0[u], s1[u]);
                }
#pragma unroll
                for (int k = 0; k < 4; ++k) win[k] = win[8 + k];
#pragma unroll
                for (int u = 0; u < 8; u += 2) {
                    const int j = jb + jg + u;
                    if (pr < 96) {
#pragma unroll
                        for (int dir = 0; dir < 2; ++dir) {
                            const float wa = wj[(hh * 2 + dir) * 128 + j], wb = wj[(hh * 2 + dir) * 128 + j + 1];
                            LAS unsigned char* d = XW + ((hh * 2 + dir) * 64 + pch) * SROW + j * 2;
                            *(LAS unsigned*)d = pk_bf16(s0[u] * wa, s0[u + 1] * wb);
                            *(LAS unsigned*)(d + SROW) = pk_bf16(s1[u] * wa, s1[u + 1] * wb);
                        }
                    } else if (pr < 160) {
                        LAS unsigned char* d = BT + (2 * (pr - 96)) * SROW + j * 2;
                        *(LAS unsigned*)d = pk_bf16(s0[u], s0[u + 1]);
                        *(LAS unsigned*)(d + SROW) = pk_bf16(s1[u], s1[u + 1]);
                    }
                }
            }
        }
        __syncthreads();
        {
            const int nt = wave & 3, pt = wave >> 2;
#pragma unroll 1
            for (int hh = 0; hh < 3; ++hh) {
                const int h = g * 3 + hh;
                f32x16 a0, a1;
#pragma unroll
                for (int i = 0; i < 16; ++i) { a0[i] = 0.f; a1[i] = 0.f; }
                const LAS unsigned char* X0 = XW + (hh * 2) * 64 * SROW;
#pragma unroll
                for (int ks = 0; ks < 8; ++ks) {
                    const bf16x8 a = lds_frag(BT, 32 * nt + r, 16 * ks + 8 * hf);
                    const bf16x8 b0 = lds_frag(X0, 32 * pt + r, 16 * ks + 8 * hf), b1 = lds_frag(X0, 64 + 32 * pt + r, 16 * ks + 8 * hf);
                    a0 = __builtin_amdgcn_mfma_f32_32x32x16_bf16(a, b0, a0, 0, 0, 0);
                    a1 = __builtin_amdgcn_mfma_f32_32x32x16_bf16(a, b1, a1, 0, 0, 0);
                }
                float* s0 = F.w<float>(WS_STATES) + ((size_t)(0 * NCH + ch) * 6 + h) * 8192 + (32 * pt + r) * 128 + 32 * nt + 4 * hf;
                float* s1 = F.w<float>(WS_STATES) + ((size_t)(1 * NCH + ch) * 6 + h) * 8192 + (32 * pt + r) * 128 + 32 * nt + 4 * hf;
#pragma unroll
                for (int gq = 0; gq < 4; ++gq) { *(f32x4*)(s0 + 8 * gq) = (f32x4){a0[4 * gq], a0[4 * gq + 1], a0[4 * gq + 2], a0[4 * gq + 3]};
                                                 *(f32x4*)(s1 + 8 * gq) = (f32x4){a1[4 * gq], a1[4 * gq + 1], a1[4 * gq + 2], a1[4 * gq + 3]}; }
            }
        }
    }
}

__device__ __forceinline__ void ph_ssd_scan(const Frame& F) {
    const int per = (98304 + F.G - 1) / F.G;
    for (int q = F.tid; q < per; q += NTHREADS) {
        const int id = F.bid * per + q;
        if (id >= 98304) break;
        const int dir = id / 49152, rem = id % 49152, h = rem / 8192, e = rem % 8192;
        const float* al = F.w<float>(WS_ALAST) + dir * 6 + h;
        const float* st = F.w<float>(WS_STATES) + ((size_t)(dir * NCH) * 6 + h) * 8192 + e;
        bf16_t* ss = F.w<bf16_t>(WS_SSTART) + ((size_t)(dir * NCH) * 6 + h) * 8192 + e;
        float sacc = 0.f;
        for (int s0 = 0; s0 < NCH; s0 += 26) {
            float sv[26], dv[26]; int cv[26];
#pragma unroll
            for (int u = 0; u < 26; ++u) {
                const int step = s0 + u;
                cv[u] = dir == 0 ? (step < 2 ? 128 + step : step - 2) : 129 - step;
                sv[u] = st[(size_t)cv[u] * 6 * 8192]; dv[u] = al[cv[u] * 12];
            }
#pragma unroll
            for (int u = 0; u < 26; ++u) { ss[(size_t)cv[u] * 6 * 8192] = f2bf(sacc); sacc = sacc * __expf(dv[u]) + sv[u]; }
        }
    }
}

__device__ __forceinline__ void ph_ssd_out(const Frame& F, int l) {
    LAS unsigned char* Cs = F.lds;
    LAS unsigned char* Bs = F.lds + 34816;
    LAS unsigned char* XT = F.lds + 69632;
    LAS float* Yl = (LAS float*)F.lds;
    LAS float* af = (LAS float*)(F.lds + 98816);
    LAS float* ab = af + 384, *dtf = ab + 384, *dtb = dtf + 384;
    LAS float* red = dtb + 384;
    const bf16_t* XBC = F.w<bf16_t>(WS_XBC);
    const bf16_t* P = F.w<bf16_t>(WS_P);
    const int nch = (l == 0) ? NCH : 128;
    const int lane = F.lane, wave = F.wave, r_in = lane & 31, hf_in = lane >> 5;
    const int it_ = wave & 3, jp = wave >> 2;
    for (int it = F.bid; it < nch * 2; it += F.G) {
        const int ch = it >> 1, g = it & 1, row0 = ch * 128;
        int r = r_in, hf = hf_in; asm volatile("" : "+v"(r), "+v"(hf));
        __syncthreads();
        for (int q = F.tid; q < 128 * 16; q += NTHREADS) {
            const int row = q >> 4, piece = q & 15;
            const bf16_t* src = XBC + (size_t)(row0 + row) * 896 + g * 128 + piece * 8;
            *(LAS u32x4*)(Bs + row * SROW + piece * 16) = *(const u32x4*)(src + 384);
            *(LAS u32x4*)(Cs + row * SROW + piece * 16) = *(const u32x4*)(src + 640);
        }
        for (int q = F.tid; q < 768; q += NTHREADS) {
            const int dir = q / 384, rr = q % 384, hh = rr >> 7, j = rr & 127;
            (dir ? ab : af)[hh * 128 + j] = F.w<float>(WS_ACS)[(size_t)(row0 + j) * 12 + dir * 6 + g * 3 + hh];
            (dir ? dtb : dtf)[hh * 128 + j] = F.w<float>(WS_DTV)[(size_t)(row0 + j) * 12 + dir * 6 + g * 3 + hh];
        }
        __syncthreads();
        f32x16 G0, G1;
#pragma unroll
        for (int i = 0; i < 16; ++i) { G0[i] = 0.f; G1[i] = 0.f; }
#pragma unroll
        for (int ks = 0; ks < 8; ++ks) {
            const bf16x8 a = lds_frag(Cs, 32 * it_ + r, 16 * ks + 8 * hf);
            const bf16x8 b0 = lds_frag(Bs, 64 * jp + r, 16 * ks + 8 * hf), b1 = lds_frag(Bs, 64 * jp + 32 + r, 16 * ks + 8 * hf);
            G0 = __builtin_amdgcn_mfma_f32_32x32x16_bf16(a, b0, G0, 0, 0, 0);
            G1 = __builtin_amdgcn_mfma_f32_32x32x16_bf16(a, b1, G1, 0, 0, 0);
        }
        f32x16 yacc[3];
#pragma unroll
        for (int hh = 0; hh < 3; ++hh) {
            const int h = g * 3 + hh;
            asm volatile("" : "+v"(r), "+v"(hf));
            __syncthreads();
#pragma unroll
            for (int tl = 0; tl < 2; ++tl) {
                const int j = 64 * jp + 32 * tl + r;
                const float afj = af[hh * 128 + j], abj = ab[hh * 128 + j], dfj = dtf[hh * 128 + j], dbj = dtb[hh * 128 + j];
#pragma unroll
                for (int rg = 0; rg < 16; ++rg) {
                    const int i = 32 * it_ + (rg & 3) + 8 * (rg >> 2) + 4 * hf;
                    const float mf = fminf(fmaxf((float)(i - j + 1), 0.f), 1.f), mb = fminf(fmaxf((float)(j - i + 1), 0.f), 1.f);
                    const float wf = __expf(fminf(af[hh * 128 + i] - afj, 0.f)) * dfj * mf;
                    const float wb = __expf(fminf(ab[hh * 128 + i] - abj, 0.f)) * dbj * mb;
                    const float gv = tl == 0 ? G0[rg] : G1[rg];
                    *(LAS bf16_t*)(Bs + i * SROW + j * 2) = f2bf(gv * (wf + wb));
                }
            }
            for (int q = F.tid; q < 128 * 8; q += NTHREADS) {
                const int j = q >> 3, pg = q & 7;
                const u32x4 v = *(const u32x4*)(XBC + (size_t)(row0 + j) * 896 + h * 64 + pg * 8);
                LAS unsigned char* d = XT + (pg * 8) * SROW + j * 2;
                *(LAS bf16_t*)(d + 0 * SROW) = (bf16_t)(v.x & 0xFFFF); *(LAS bf16_t*)(d + 1 * SROW) = (bf16_t)(v.x >> 16);
                *(LAS bf16_t*)(d + 2 * SROW) = (bf16_t)(v.y & 0xFFFF); *(LAS bf16_t*)(d + 3 * SROW) = (bf16_t)(v.y >> 16);
                *(LAS bf16_t*)(d + 4 * SROW) = (bf16_t)(v.z & 0xFFFF); *(LAS bf16_t*)(d + 5 * SROW) = (bf16_t)(v.z >> 16);
                *(LAS bf16_t*)(d + 6 * SROW) = (bf16_t)(v.w & 0xFFFF); *(LAS bf16_t*)(d + 7 * SROW) = (bf16_t)(v.w >> 16);
            }
            {
                f32x16 yF, yB;
#pragma unroll
                for (int i = 0; i < 16; ++i) { yF[i] = 0.f; yB[i] = 0.f; }
                const bf16_t* Sf = F.w<bf16_t>(WS_SSTART) + ((size_t)(0 * NCH + ch) * 6 + h) * 8192 + (32 * jp + r) * 128 + 8 * hf;
                const bf16_t* Sb = F.w<bf16_t>(WS_SSTART) + ((size_t)(1 * NCH + ch) * 6 + h) * 8192 + (32 * jp + r) * 128 + 8 * hf;
#pragma unroll 2
                for (int ks = 0; ks < 8; ++ks) {
                    const bf16x8 ac = lds_frag(Cs, 32 * it_ + r, 16 * ks + 8 * hf);
                    const bf16x8 bf_ = *(const bf16x8*)(Sf + 16 * ks), bb_ = *(const bf16x8*)(Sb + 16 * ks);
                    yF = __builtin_amdgcn_mfma_f32_32x32x16_bf16(ac, bf_, yF, 0, 0, 0);
                    yB = __builtin_amdgcn_mfma_f32_32x32x16_bf16(ac, bb_, yB, 0, 0, 0);
                }
#pragma unroll
                for (int rg = 0; rg < 16; ++rg) {
                    const int i = 32 * it_ + (rg & 3) + 8 * (rg >> 2) + 4 * hf;
                    yacc[hh][rg] = __expf(af[hh * 128 + i]) * yF[rg] + __expf(ab[hh * 128 + i]) * yB[rg];
                }
            }
            __syncthreads();
#pragma unroll 2
            for (int ks = 0; ks < 8; ++ks) {
                const bf16x8 aw = lds_frag(Bs, 32 * it_ + r, 16 * ks + 8 * hf), bx = lds_frag(XT, 32 * jp + r, 16 * ks + 8 * hf);
                yacc[hh] = __builtin_amdgcn_mfma_f32_32x32x16_bf16(aw, bx, yacc[hh], 0, 0, 0);
            }
        }
        __syncthreads();
#pragma unroll
        for (int hh = 0; hh < 3; ++hh)
#pragma unroll
            for (int rg = 0; rg < 16; ++rg) { const int i = 32 * it_ + (rg & 3) + 8 * (rg >> 2) + 4 * hf; Yl[i * 193 + hh * 64 + 32 * jp + r] = yacc[hh][rg]; }
        __syncthreads();
        const int i = F.tid & 127, pq = F.tid >> 7;
        float ssq = 0.f;
#pragma unroll 1
        for (int hh = 0; hh < 3; ++hh) {
            const int h = g * 3 + hh; const float dsk = F.in[I_SSDD][l * 6 + h];
            const int chn = h * 64 + pq * 16;
            const u32x4 xa = *(const u32x4*)(XBC + (size_t)(row0 + i) * 896 + chn), xb = *(const u32x4*)(XBC + (size_t)(row0 + i) * 896 + chn + 8);
            const u32x4 za = *(const u32x4*)(P + (size_t)(row0 + i) * PC + CZ + chn), zb = *(const u32x4*)(P + (size_t)(row0 + i) * PC + CZ + chn + 8);
            const unsigned xw_[8] = {xa.x, xa.y, xa.z, xa.w, xb.x, xb.y, xb.z, xb.w}, zw_[8] = {za.x, za.y, za.z, za.w, zb.x, zb.y, zb.z, zb.w};
            LAS float* yr = Yl + i * 193 + hh * 64 + pq * 16;
#pragma unroll
            for (int p2 = 0; p2 < 8; ++p2) {
                const float v0 = (yr[2 * p2] + dsk * bflo(xw_[p2])) * silu_f(bflo(zw_[p2]));
                const float v1 = (yr[2 * p2 + 1] + dsk * bfhi(xw_[p2])) * silu_f(bfhi(zw_[p2]));
                yr[2 * p2] = v0; yr[2 * p2 + 1] = v1; ssq += v0 * v0 + v1 * v1;
            }
        }
        red[pq * 128 + i] = ssq;
        __syncthreads();
        const float tot = red[i] + red[128 + i] + red[256 + i] + red[384 + i];
        const float rstd = rsqrtf(tot * (1.0f / 192.0f) + RMS_EPS);
#pragma unroll 1
        for (int hh = 0; hh < 3; ++hh) {
            const int h = g * 3 + hh;
            bf16_t* o = F.w<bf16_t>(WS_MIX) + (size_t)(row0 + i) * D + h * 64 + pq * 16;
            const float* ng = F.in[I_SSDNG] + l * 384 + h * 64 + pq * 16;
            const LAS float* yr = Yl + i * 193 + hh * 64 + pq * 16;
            unsigned wv[8];
#pragma unroll
            for (int p2 = 0; p2 < 8; ++p2) wv[p2] = pk_bf16(yr[2 * p2] * rstd * ng[2 * p2], yr[2 * p2 + 1] * rstd * ng[2 * p2 + 1]);
            *(u32x4*)o = (u32x4){wv[0], wv[1], wv[2], wv[3]}; *(u32x4*)(o + 8) = (u32x4){wv[4], wv[5], wv[6], wv[7]};
        }
    }
}

__device__ __forceinline__ int na_kv_off(int key, int piece) { return key * 128 + ((piece ^ (key & 7)) << 4); }
constexpr int NA_VP = 144;
__device__ __forceinline__ int na_v_off(int key, int piece) { return key * NA_VP + piece * 16; }
__device__ __forceinline__ void na_stage_kv(const Frame& F, const bf16_t* P, LAS unsigned char* Kd, LAS unsigned char* Vd, int h, bool local, int r0, int kc0) {
    for (int q = F.tid; q < 256 * 8; q += NTHREADS) {
        const int key = q >> 3, piece = q & 7;
        const int krow = local ? (r0 + (key >> 5)) * 64 + kc0 + (key & 31) : L + key;
        const bf16_t* src = P + (size_t)krow * PC + h * 64 + piece * 8;
        *(LAS u32x4*)(Kd + na_kv_off(key, piece)) = *(const u32x4*)(src + CK);
        *(LAS u32x4*)(Vd + na_v_off(key, piece)) = *(const u32x4*)(src + CV);
    }
}
__device__ __forceinline__ void bar_lds() { asm volatile("s_waitcnt lgkmcnt(0)" ::: "memory"); __builtin_amdgcn_s_barrier(); asm volatile("" ::: "memory"); }
struct NaItem { int h, r, cg, r0, kc0, qrow0; bool isctx; };
__device__ __forceinline__ NaItem na_item(int cid, int i_lo, int i_hi, int k) {
    NaItem t; t.isctx = (i_lo + k >= i_hi); t.r = 0; t.r0 = 0; t.kc0 = 0;
    if (!t.isctx) { const int it = i_lo + k; t.h = it >> 10; t.r = (it >> 2) & 255; t.cg = it & 3; t.r0 = min(max(t.r - 4, 0), 248); t.kc0 = min(max(16 * t.cg - 8, 0), 32); t.qrow0 = t.r * 64 + t.cg * 16; }
    else { t.h = cid >> 4; t.cg = cid & 15; t.qrow0 = L + t.cg * 16; }
    return t;
}
__device__ __forceinline__ void ph_na(const Frame& F, int l, int part) {
    LAS unsigned char* Kc = F.lds;
    LAS unsigned char* Vc = F.lds + 32768;
    LAS unsigned char* Kl = F.lds + 69632;
    LAS unsigned char* Vl = F.lds + 102400;
    LAS unsigned char* Qs = F.lds + 139264;
    LAS unsigned char* Pw = F.lds + 141312;
    LAS float* ml = (LAS float*)(F.lds + 159744);
    LAS float* bt = ml + 256;
    const bf16_t* P = F.w<bf16_t>(WS_P);
    const float* rpb = F.in[I_RPB] + (size_t)l * 15 * 31 * 6;
    const int nlat = 6 * 256 * 4;
    const int nB = (l == 0) ? 2520 : 0, nA = nlat - nB;
    const int lane = F.lane, wave = F.wave, c16 = lane & 15, kq = lane >> 4;
    const float scale = 0.125f;
    int cur_h = -1;
    const float ws = part == 0 ? (l == 0 ? 0.45f : 0.67f) : 0.0f;
    const int nP = part == 0 ? nA : nB, base = part == 0 ? 0 : nA;
    const float Wtot = 4.0f * ws + (float)(F.G - 4);
    const float W0 = F.bid < 4 ? F.bid * ws : 4.0f * ws + (float)(F.bid - 4), W1 = F.bid < 3 ? (F.bid + 1) * ws : 4.0f * ws + (float)(F.bid - 3);
    const int i_lo = base + (int)((float)nP * W0 / Wtot + 0.5f), i_hi = (F.bid == F.G - 1) ? base + nP : base + (int)((float)nP * W1 / Wtot + 0.5f);
    const int cid = (l == 0 && part == 0 && F.bid >= 100 && F.bid < 196) ? F.bid - 100 : -1;
    const int n_mine = max(0, i_hi - i_lo) + (cid >= 0 ? 1 : 0);
    u32x4 kreg[4], vreg[4], qreg; float breg = 0.f;
    const int pkey = F.tid >> 3, ppiece = F.tid & 7;
#define NA_PREFETCH(T) do { if (!(T).isctx) { _Pragma("unroll") for (int u = 0; u < 4; ++u) { const int key = pkey + 64 * u; \
            const bf16_t* src = P + (size_t)(((T).r0 + (key >> 5)) * 64 + (T).kc0 + (key & 31)) * PC + (T).h * 64 + ppiece * 8; \
            kreg[u] = *(const u32x4*)(src + CK); vreg[u] = *(const u32x4*)(src + CV); } \
            if (F.tid < 256 && (F.tid & 31) < 31) breg = rpb[(((T).r0 + (F.tid >> 5) - (T).r + 7) * 31 + (F.tid & 31)) * 6 + (T).h]; } \
        if (F.tid < 128) qreg = *(const u32x4*)(P + (size_t)((T).qrow0 + pkey) * PC + CQ + (T).h * 64 + ppiece * 8); } while (0)
    if (n_mine > 0) { const NaItem t0 = na_item(cid, i_lo, i_hi, 0); NA_PREFETCH(t0); }
    for (int k = 0; k < n_mine; ++k) {
        const NaItem t = na_item(cid, i_lo, i_hi, k);
        const bool isctx = t.isctx; const int h = t.h, cg = t.cg, kc0 = t.kc0, qrow0 = t.qrow0;
        if (k == 0) bar_lds();
        if (h != cur_h) { na_stage_kv(F, P, Kc, Vc, h, false, 0, 0); cur_h = h; }
        if (!isctx) {
#pragma unroll
            for (int u = 0; u < 4; ++u) { const int key = pkey + 64 * u; *(LAS u32x4*)(Kl + na_kv_off(key, ppiece)) = kreg[u]; *(LAS u32x4*)(Vl + na_v_off(key, ppiece)) = vreg[u]; }
            if (F.tid < 256) bt[F.tid] = breg;
        }
        if (F.tid < 128) *(LAS u32x4*)(Qs + na_kv_off(pkey, ppiece)) = qreg;
        if (k + 1 < n_mine) { const NaItem tn = na_item(cid, i_lo, i_hi, k + 1); NA_PREFETCH(tn); }
        bar_lds();
        const bool loc = wave < 4;
        const LAS unsigned char* Kb = loc ? Kl : Kc;
        const LAS unsigned char* Vb = loc ? Vl : Vc;
        const int kbase = (wave & 3) * 64;
        LAS unsigned char* pw = Pw + wave * 2304;
        float mw[4], lw[4];
        if (!(loc && isctx)) {
            f32x4 sacc[4];
#pragma unroll
            for (int nt = 0; nt < 4; ++nt) sacc[nt] = (f32x4){0.f, 0.f, 0.f, 0.f};
#pragma unroll
            for (int ks = 0; ks < 2; ++ks) {
                const bf16x8 a = *(const LAS bf16x8*)(Qs + na_kv_off(c16, 4 * ks + kq));
#pragma unroll
                for (int nt = 0; nt < 4; ++nt) {
                    const bf16x8 b = *(const LAS bf16x8*)(Kb + na_kv_off(kbase + 16 * nt + c16, 4 * ks + kq));
                    sacc[nt] = __builtin_amdgcn_mfma_f32_16x16x32_bf16(a, b, sacc[nt], 0, 0, 0);
                }
            }
#pragma unroll
            for (int rg = 0; rg < 4; ++rg) mw[rg] = -INFINITY;
#pragma unroll
            for (int nt = 0; nt < 4; ++nt) {
                const int kk = kbase + 16 * nt + c16;
#pragma unroll
                for (int rg = 0; rg < 4; ++rg) {
                    float sv = sacc[nt][rg] * scale;
                    if (loc) {
                        const int qi = 4 * kq + rg, qcol = cg * 16 + qi, cstart = min(max(qcol - 8, 0), 48);
                        const int krow = kk >> 5, kcol = kc0 + (kk & 31);
                        const bool ok = (kcol >= cstart) && (kcol < cstart + 16);
                        const int dc = min(max(kcol - qcol + 15, 0), 30);
                        sv = ok ? sv + bt[krow * 32 + dc] : -INFINITY;
                    }
                    sacc[nt][rg] = sv; mw[rg] = fmaxf(mw[rg], sv);
                }
            }
#pragma unroll
            for (int rg = 0; rg < 4; ++rg) {
#pragma unroll
                for (int o = 8; o >= 1; o >>= 1) mw[rg] = fmaxf(mw[rg], __shfl_xor(mw[rg], o));
                lw[rg] = 0.f;
            }
#pragma unroll
            for (int nt = 0; nt < 4; ++nt) {
#pragma unroll
                for (int rg = 0; rg < 4; ++rg) {
                    const float msafe = mw[rg] == -INFINITY ? 0.f : mw[rg];
                    const float pv = __expf(sacc[nt][rg] - msafe);
                    lw[rg] += pv;
                    *(LAS bf16_t*)(pw + (4 * kq + rg) * 144 + (16 * nt + c16) * 2) = f2bf(pv);
                }
            }
#pragma unroll
            for (int rg = 0; rg < 4; ++rg) {
#pragma unroll
                for (int o = 8; o >= 1; o >>= 1) lw[rg] += __shfl_xor(lw[rg], o);
            }
            lds_fence();
            f32x4 oacc[4];
#pragma unroll
            for (int dt = 0; dt < 4; ++dt) oacc[dt] = (f32x4){0.f, 0.f, 0.f, 0.f};
            {
                const unsigned vaddr = (unsigned)(unsigned long long)(Vb + (kbase + 8 * kq + (c16 >> 2)) * NA_VP + 8 * (c16 & 3));
                u32x2 t[2][4][2];
                asm volatile(
                    "ds_read_b64_tr_b16 %0, %16 offset:0\n\tds_read_b64_tr_b16 %1, %16 offset:576\n\t"
                    "ds_read_b64_tr_b16 %2, %16 offset:32\n\tds_read_b64_tr_b16 %3, %16 offset:608\n\t"
                    "ds_read_b64_tr_b16 %4, %16 offset:64\n\tds_read_b64_tr_b16 %5, %16 offset:640\n\t"
                    "ds_read_b64_tr_b16 %6, %16 offset:96\n\tds_read_b64_tr_b16 %7, %16 offset:672\n\t"
                    "ds_read_b64_tr_b16 %8, %16 offset:4608\n\tds_read_b64_tr_b16 %9, %16 offset:5184\n\t"
                    "ds_read_b64_tr_b16 %10, %16 offset:4640\n\tds_read_b64_tr_b16 %11, %16 offset:5216\n\t"
                    "ds_read_b64_tr_b16 %12, %16 offset:4672\n\tds_read_b64_tr_b16 %13, %16 offset:5248\n\t"
                    "ds_read_b64_tr_b16 %14, %16 offset:4704\n\tds_read_b64_tr_b16 %15, %16 offset:5280\n\t"
                    "s_waitcnt lgkmcnt(0)"
                    : "=&v"(t[0][0][0]), "=&v"(t[0][0][1]), "=&v"(t[0][1][0]), "=&v"(t[0][1][1]), "=&v"(t[0][2][0]), "=&v"(t[0][2][1]), "=&v"(t[0][3][0]), "=&v"(t[0][3][1]),
                      "=&v"(t[1][0][0]), "=&v"(t[1][0][1]), "=&v"(t[1][1][0]), "=&v"(t[1][1][1]), "=&v"(t[1][2][0]), "=&v"(t[1][2][1]), "=&v"(t[1][3][0]), "=&v"(t[1][3][1])
                    : "v"(vaddr) : "memory");
#pragma unroll
                for (int ks = 0; ks < 2; ++ks) {
                    const bf16x8 a = *(const LAS bf16x8*)(pw + c16 * 144 + (32 * ks + 8 * kq) * 2);
#pragma unroll
                    for (int dt = 0; dt < 4; ++dt) {
                        const u32x4 bw = (u32x4){t[ks][dt][0].x, t[ks][dt][0].y, t[ks][dt][1].x, t[ks][dt][1].y};
                        oacc[dt] = __builtin_amdgcn_mfma_f32_16x16x32_bf16(a, __builtin_bit_cast(bf16x8, bw), oacc[dt], 0, 0, 0);
                    }
                }
            }
            lds_fence();
#pragma unroll
            for (int dt = 0; dt < 4; ++dt)
#pragma unroll
                for (int rg = 0; rg < 4; ++rg) *(LAS bf16_t*)(pw + (4 * kq + rg) * 144 + (16 * dt + c16) * 2) = f2bf(oacc[dt][rg]);
        } else {
#pragma unroll
            for (int rg = 0; rg < 4; ++rg) { mw[rg] = -INFINITY; lw[rg] = 0.f; }
            for (int q = lane; q < 16 * 36; q += 64) ((LAS unsigned*)pw)[q] = 0u;
        }
        if (c16 == 0) {
#pragma unroll
            for (int rg = 0; rg < 4; ++rg) { ml[(wave * 16 + 4 * kq + rg) * 2] = mw[rg]; ml[(wave * 16 + 4 * kq + rg) * 2 + 1] = lw[rg]; }
        }
        bar_lds();
        {
            const int qi = F.tid >> 5, dp = F.tid & 31;
            float M = -INFINITY;
#pragma unroll
            for (int w = 0; w < 8; ++w) M = fmaxf(M, ml[(w * 16 + qi) * 2]);
            float num0 = 0.f, num1 = 0.f, den = 0.f;
#pragma unroll
            for (int w = 0; w < 8; ++w) {
                const float sc = __expf(ml[(w * 16 + qi) * 2] - M);
                const unsigned ov = *(const LAS unsigned*)(Pw + w * 2304 + qi * 144 + dp * 4);
                num0 += sc * bflo(ov); num1 += sc * bfhi(ov); den += sc * ml[(w * 16 + qi) * 2 + 1];
            }
            const float inv = 1.0f / den;
            *(unsigned*)(F.w<bf16_t>(WS_MIX) + (size_t)(qrow0 + qi) * D + 384 + h * 64 + 2 * dp) = pk_bf16(num0 * inv, num1 * inv);
        }
    }
#undef NA_PREFETCH
}

__device__ __forceinline__ float hy_conv3(const bf16_t* P, const float* cw, const float* cb, int row, int seq_lo, int seq_hi, int col) {
    float s = cb[col];
#pragma unroll
    for (int k = 0; k < 3; ++k) { const int r = row + k - 1; if (r >= seq_lo && r < seq_hi) s += cw[k * 768 + col] * bf2f(P[(size_t)r * PC + CHY + col]); }
    return s;
}
__device__ __forceinline__ void ph_hy_prep(const Frame& F, int l) {
    const bf16_t* P = F.w<bf16_t>(WS_P);
    const float* cw = F.in[I_HCW] + (size_t)l * 3 * 768; const float* cb = F.in[I_HCB] + (size_t)l * 768;
    LAS unsigned* ut = (LAS unsigned*)F.lds;
    LAS unsigned* xt = ut + 256 * 33;
    const int cp = F.tid & 127, rq = F.tid >> 7;
    float w0[3][3], w1[3][3], b0[3], b1[3];
#pragma unroll
    for (int sg = 0; sg < 3; ++sg) { b0[sg] = cb[sg * 256 + 2 * cp]; b1[sg] = cb[sg * 256 + 2 * cp + 1];
#pragma unroll
        for (int k = 0; k < 3; ++k) { w0[sg][k] = cw[k * 768 + sg * 256 + 2 * cp]; w1[sg][k] = cw[k * 768 + sg * 256 + 2 * cp + 1]; } }
    for (int it = F.bid; it < L / 64; it += F.G) {
        const int t0 = it * 64, rb = t0 + rq * 16;
        __syncthreads();
        {
            unsigned win[3][18];
#pragma unroll
            for (int sg = 0; sg < 3; ++sg)
#pragma unroll
                for (int k = 0; k < 18; ++k) { const int rr = rb - 1 + k; win[sg][k] = (rr >= 0 && rr < L) ? *(const unsigned*)(P + (size_t)rr * PC + CHY + sg * 256 + 2 * cp) : 0u; }
#pragma unroll
            for (int jp = 0; jp < 8; ++jp) {
                float u0[2], u1[2], xa[2], xb[2];
#pragma unroll
                for (int q = 0; q < 2; ++q) {
                    const int k = 2 * jp + q;
                    float a0[3], a1[3];
#pragma unroll
                    for (int sg = 0; sg < 3; ++sg) {
                        a0[sg] = b0[sg] + w0[sg][0] * bflo(win[sg][k]) + w0[sg][1] * bflo(win[sg][k + 1]) + w0[sg][2] * bflo(win[sg][k + 2]);
                        a1[sg] = b1[sg] + w1[sg][0] * bfhi(win[sg][k]) + w1[sg][1] * bfhi(win[sg][k + 1]) + w1[sg][2] * bfhi(win[sg][k + 2]);
                    }
                    xa[q] = a0[0]; xb[q] = a1[0]; u0[q] = a0[2] * a0[1]; u1[q] = a1[2] * a1[1];
                }
                const int rp = rq * 8 + jp;
                ut[(2 * cp) * 33 + rp] = pk_bf16(u0[0], u0[1]); ut[(2 * cp + 1) * 33 + rp] = pk_bf16(u1[0], u1[1]);
                xt[(2 * cp) * 33 + rp] = pk_bf16(xa[0], xa[1]); xt[(2 * cp + 1) * 33 + rp] = pk_bf16(xb[0], xb[1]);
            }
        }
        __syncthreads();
        for (int q = F.tid; q < 256 * 8; q += NTHREADS) {
            const int c = q >> 3, g = q & 7;
            u32x4 a, b;
            a.x = ut[c * 33 + 4 * g]; a.y = ut[c * 33 + 4 * g + 1]; a.z = ut[c * 33 + 4 * g + 2]; a.w = ut[c * 33 + 4 * g + 3];
            b.x = xt[c * 33 + 4 * g]; b.y = xt[c * 33 + 4 * g + 1]; b.z = xt[c * 33 + 4 * g + 2]; b.w = xt[c * 33 + 4 * g + 3];
            *(u32x4*)(F.w<bf16_t>(WS_UT) + (size_t)c * L + t0 + 8 * g) = a;
            *(u32x4*)(F.w<bf16_t>(WS_X0T) + (size_t)c * L + t0 + 8 * g) = b;
            u32x2 a8; a8.x = pk_fp8x4(bflo(a.x), bfhi(a.x), bflo(a.y), bfhi(a.y)); a8.y = pk_fp8x4(bflo(a.z), bfhi(a.z), bflo(a.w), bfhi(a.w));
            *(u32x2*)(F.w<unsigned char>(WS_UT8) + (size_t)c * L + t0 + 8 * g) = a8;
        }
    }
    if (l == 0) {
        for (int rp = F.bid; rp < LC / 2; rp += F.G) {
            const int row = L + rp * 2 + (F.tid >> 8), c = F.tid & 255;
            const float x1 = hy_conv3(P, cw, cb, row, L, T, 256 + c), v = hy_conv3(P, cw, cb, row, L, T, 512 + c);
            F.w<float>(WS_U)[(size_t)row * 256 + c] = v * x1;
        }
    }
}
__device__ __forceinline__ void ph_hy_conv_ctx(const Frame& F, int l) {
    const bf16_t* P = F.w<bf16_t>(WS_P);
    const float* cw = F.in[I_HCW] + (size_t)l * 3 * 768; const float* cb = F.in[I_HCB] + (size_t)l * 768;
    for (int it = F.bid; it < 8; it += F.G) {
        const int Lx = LC, rbase = L;
        const int tb = it * 2 + (F.tid >> 8), c = F.tid & 255, t0 = tb * 16;
        const float* U = F.w<float>(WS_U) + (size_t)rbase * 256 + c;
        const float* KC = F.w<float>(WS_KCOMBC) + c;
        float acc[16], wreg[16];
#pragma unroll
        for (int j = 0; j < 16; ++j) { acc[j] = 0.f; wreg[j] = KC[(size_t)(t0 + j + Lx - 1) * 256]; }
        for (int s0 = 0; s0 < Lx; s0 += 16) {
            float ub[16], nb[16];
#pragma unroll
            for (int r = 0; r < 16; ++r) { ub[r] = U[(size_t)(s0 + r) * 256]; const int x = t0 - (s0 + r + 1) + Lx - 1; nb[r] = x >= 0 ? KC[(size_t)x * 256] : 0.f; }
#pragma unroll
            for (int r = 0; r < 16; ++r) {
#pragma unroll
                for (int j = 0; j < 16; ++j) acc[j] += ub[r] * wreg[(j - r) & 15];
                wreg[(15 - r) & 15] = nb[r];
            }
        }
        const float inv = F.w<float>(WS_FSUM)[2 * 256 + c];
        const float db = F.in[I_HYD][l * 256 + c];
#pragma unroll
        for (int j = 0; j < 16; ++j) {
            const int row = rbase + t0 + j;
            const float x0 = hy_conv3(P, cw, cb, row, L, T, c);
            const float u = F.w<float>(WS_U)[(size_t)row * 256 + c];
            F.w<bf16_t>(WS_MIX)[(size_t)row * D + 768 + c] = f2bf(x0 * (acc[j] * inv + u * db));
        }
    }
}

constexpr int HC_UP = 144, HC_UBYTES = 190 * HC_UP;
constexpr int HC_CPOFF = 27392, HC_NG = 83, HC_CPBYTES = 16 * HC_NG * 16;
__device__ __forceinline__ void hc_make_copies(LAS unsigned char* dst, const u32x4 g0, const u32x4 g1, int g) {
    const unsigned w[8] = {g0.x, g0.y, g0.z, g0.w, g1.x, g1.y, g1.z, g1.w};
#pragma unroll
    for (int sh = 0; sh < 16; ++sh) {
        const int b = sh >> 2, r = sh & 3;
        u32x4 o;
        if (r == 0) { o.x = w[b]; o.y = w[b + 1]; o.z = w[b + 2]; o.w = w[b + 3]; }
        else { o.x = __builtin_amdgcn_alignbyte(w[b + 1], w[b], r); o.y = __builtin_amdgcn_alignbyte(w[b + 2], w[b + 1], r);
               o.z = __builtin_amdgcn_alignbyte(w[b + 3], w[b + 2], r); o.w = __builtin_amdgcn_alignbyte(w[b + 4], w[b + 3], r); }
        *(LAS u32x4*)(dst + (sh * HC_NG + g) * 16) = o;
    }
}
__device__ __forceinline__ void ph_hy_conv(const Frame& F, int l) {
    LAS unsigned char* Ul = F.lds;
    LAS unsigned char* Cp = F.lds + HC_CPOFF;
    const int lane = F.lane, wave = F.wave;
    const int nt = wave < 4 ? wave : 7 - wave, par = wave >> 2;
    const int r = lane & 31, h = lane >> 5, sig = r & 15, rho = r >> 4;
    const int sh = (16 - sig) & 15, gofs = 2 * h - rho - (sig ? 1 : 0);
    const int a_lane = (sh * HC_NG + gofs) * 16;
    const int b_lane = r * HC_UP + h * 32;
    const int sclK = 0x79797979, sclU = ONE_E8M0;
    for (int c = F.bid; c < 256; c += F.G) {
        const unsigned char* KRc = F.w<unsigned char>(WS_KR) + ((size_t)l * 256 + c) * KRL;
        const unsigned char* U8c = F.w<unsigned char>(WS_UT8) + (size_t)c * L;
        const bf16_t* UTc = F.w<bf16_t>(WS_UT) + (size_t)c * L;
        __syncthreads();
        for (int q = F.tid; q < 190 * 8; q += NTHREADS) {
            const int blk = q >> 3, piece = q & 7;
            u32x4 v = (u32x4){0u, 0u, 0u, 0u};
            if (blk >= 31 && blk < 159) v = *(const u32x4*)(U8c + (size_t)(blk - 31) * 128 + piece * 16);
            *(LAS u32x4*)(Ul + blk * HC_UP + piece * 16) = v;
        }
        u32x4 g0 = (u32x4){0u, 0u, 0u, 0u}, g1 = g0;
        if (F.tid < HC_NG) { const unsigned char* src = KRc + 31744 + 16 * F.tid; g0 = *(const u32x4*)src; g1 = *(const u32x4*)(src + 16); }
        if (F.tid < HC_NG) hc_make_copies(Cp, g0, g1, F.tid);
        __syncthreads();
        f32x16 acc[4];
#pragma unroll
        for (int m = 0; m < 4; ++m)
#pragma unroll
            for (int i = 0; i < 16; ++i) acc[m][i] = 0.f;
        for (int ci = 0; ci < 32; ++ci) {
            const int Dc = -128 + 8 * ci;
            if (ci + 1 < 32 && F.tid < HC_NG) { const unsigned char* src = KRc + (31744 - 1024 * (ci + 1)) + 16 * F.tid; g0 = *(const u32x4*)src; g1 = *(const u32x4*)(src + 16); }
            const LAS unsigned char* cp = Cp + (ci & 1) * HC_CPBYTES + a_lane;
#pragma unroll 1
            for (int d2 = 0; d2 < 4; ++d2) {
                const int dd = 2 * d2 + par, Dv = Dc + dd;
                if (!((Dv >= 32 * nt - 127) && (Dv <= 32 * nt + 31) && (Dv > -128))) continue;
                const LAS unsigned char* ap = cp + (8 * (8 - dd)) * 16;
                const LAS unsigned char* bp = Ul + b_lane + (32 * nt - Dv + 31) * HC_UP;
                v8i af[6], bfr[2];
#pragma unroll
                for (int e = 0; e < 6; ++e) { const v4i x = *(const LAS v4i*)(ap - 2 * (e - 2) * 16), y = *(const LAS v4i*)(ap - 2 * (e - 2) * 16 + 16); af[e] = __builtin_shufflevector(x, y, 0, 1, 2, 3, 4, 5, 6, 7); }
#pragma unroll
                for (int ks = 0; ks < 2; ++ks) { const v4i x = *(const LAS v4i*)(bp + ks * 64), y = *(const LAS v4i*)(bp + ks * 64 + 16); bfr[ks] = __builtin_shufflevector(x, y, 0, 1, 2, 3, 4, 5, 6, 7); }
#pragma unroll
                for (int ks = 0; ks < 2; ++ks)
#pragma unroll
                    for (int m = 0; m < 4; ++m)
                        asm volatile("v_mfma_scale_f32_32x32x64_f8f6f4 %0, %1, %2, %0, %3, %4 op_sel_hi:[0,0,0]" : "+v"(acc[m]) : "v"(af[m - 2 * ks + 2]), "v"(bfr[ks]), "v"(sclK), "v"(sclU));
            }
            if (ci + 1 < 32 && F.tid < HC_NG) hc_make_copies(Cp + ((ci + 1) & 1) * HC_CPBYTES, g0, g1, F.tid);
            __syncthreads();
        }
        LAS float* Rd = (LAS float*)F.lds;
        if (wave >= 4) {
#pragma unroll
            for (int m = 0; m < 4; ++m)
#pragma unroll
                for (int i = 0; i < 16; ++i) Rd[(nt * 64 + m * 16 + i) * 64 + lane] = acc[m][i];
        }
        __syncthreads();
        if (wave < 4) {
#pragma unroll
            for (int m = 0; m < 4; ++m)
#pragma unroll
                for (int i = 0; i < 16; ++i) acc[m][i] += Rd[(nt * 64 + m * 16 + i) * 64 + lane];
            const float inv = F.w<float>(WS_FSUM)[l * 256 + c];
            const float db = F.in[I_HYD][l * 256 + c];
            const bf16_t* X0c = F.w<bf16_t>(WS_X0T) + (size_t)c * L;
            bf16_t* YTc = F.w<bf16_t>(WS_YT) + (size_t)c * L;
            const int I = 32 * nt + r;
#pragma unroll
            for (int m = 0; m < 4; ++m) {
#pragma unroll
                for (int g = 0; g < 4; ++g) {
                    const int t = 128 * I + 32 * m + 8 * g + 4 * h;
                    const u32x2 xv = *(const u32x2*)(X0c + t), uv = *(const u32x2*)(UTc + t);
                    float y[4];
#pragma unroll
                    for (int e = 0; e < 4; ++e) y[e] = acc[m][4 * g + e] * inv;
                    y[0] = bflo(xv.x) * (y[0] + bflo(uv.x) * db); y[1] = bfhi(xv.x) * (y[1] + bfhi(uv.x) * db);
                    y[2] = bflo(xv.y) * (y[2] + bflo(uv.y) * db); y[3] = bfhi(xv.y) * (y[3] + bfhi(uv.y) * db);
                    u32x2 o; o.x = pk_bf16(y[0], y[1]); o.y = pk_bf16(y[2], y[3]);
                    *(u32x2*)(YTc + t) = o;
                }
            }
        }
    }
}
__device__ __forceinline__ void ph_hy_tr(const Frame& F) {
    LAS unsigned* yt = (LAS unsigned*)F.lds;
    for (int it = F.bid; it < L / 64; it += F.G) {
        const int t0 = it * 64;
        __syncthreads();
        for (int q = F.tid; q < 256 * 8; q += NTHREADS) {
            const int c = q >> 3, g = q & 7;
            const u32x4 a = *(const u32x4*)(F.w<bf16_t>(WS_YT) + (size_t)c * L + t0 + 8 * g);
            yt[c * 33 + 4 * g] = a.x; yt[c * 33 + 4 * g + 1] = a.y; yt[c * 33 + 4 * g + 2] = a.z; yt[c * 33 + 4 * g + 3] = a.w;
        }
        __syncthreads();
        for (int q = F.tid; q < 64 * 32; q += NTHREADS) {
            const int row = q >> 5, cg = q & 31;
            const LAS unsigned short* ys = (const LAS unsigned short*)yt;
            unsigned short v[8];
#pragma unroll
            for (int e = 0; e < 8; ++e) v[e] = ys[((cg * 8 + e) * 33) * 2 + row];
            u32x4 o; o.x = v[0] | ((unsigned)v[1] << 16); o.y = v[2] | ((unsigned)v[3] << 16); o.z = v[4] | ((unsigned)v[5] << 16); o.w = v[6] | ((unsigned)v[7] << 16);
            *(u32x4*)(F.w<bf16_t>(WS_MIX) + (size_t)(t0 + row) * D + 768 + cg * 8) = o;
        }
    }
}

constexpr int WRP = 1028;
__device__ __forceinline__ void ph_post1(const Frame& F, int l) {
    LAS float* wr = (LAS float*)F.lds;
    LAS unsigned* lcnt = (LAS unsigned*)(F.lds + 32 * WRP * 4);
    __syncthreads();
    if (F.tid < 64) lcnt[F.tid] = 0u;
    {
        const f32x4* src = (const f32x4*)(F.in[I_WR] + (size_t)l * 1024 * 32);
        f32x4 v[16];
#pragma unroll
        for (int u = 0; u < 16; ++u) v[u] = src[F.tid + u * NTHREADS];
#pragma unroll
        for (int u = 0; u < 16; ++u) { const int q4 = F.tid + u * NTHREADS, k = q4 >> 3, e0 = (q4 & 7) * 4;
#pragma unroll
            for (int i = 0; i < 4; ++i) wr[(e0 + i) * WRP + k] = v[u][i]; }
    }
    __syncthreads();
    const int nrows = (l == 0) ? T : L;
    const int nwaves = F.G * 8, lane = F.lane;
    unsigned* cnt = F.w<unsigned>(WS_CTL) + CW_CNT + l * 1024;
    if (F.bid == 0) { for (int q = F.tid; q < D / 4; q += NTHREADS) ((unsigned*)(F.w<unsigned char>(WS_H2) + (size_t)T * D))[q] = 0u; }
    const float brl = F.in[I_BR][l * 32 + ((lane >> 1) & 31)];
    const int mye = (lane >> 1) & 31;
    for (int row0 = F.bid * 8 + F.wave; row0 < nrows; row0 += 2 * nwaves) {
        int rw[2]; bool vld[2];
        rw[0] = row0; vld[0] = true; vld[1] = (row0 + nwaves < nrows); rw[1] = vld[1] ? row0 + nwaves : row0;
        f32x4 m[2][4], x[2][4], hv[2][4];
#pragma unroll
        for (int u = 0; u < 2; ++u) { const bf16_t* mr = F.w<bf16_t>(WS_MIXO) + (size_t)rw[u] * D;
#pragma unroll
            for (int i = 0; i < 4; ++i) { const u32x2 w = *(const u32x2*)(mr + 4 * lane + 256 * i); m[u][i] = (f32x4){bflo(w.x), bfhi(w.x), bflo(w.y), bfhi(w.y)}; }
            load_xrow(F, l, rw[u], lane, x[u]); }
#pragma unroll
        for (int u = 0; u < 2; ++u) {
            const int which = rw[u] >= L;
            const float* v0 = vecs_ptr(F, l, which, 2);
            const float rs1 = row_rstd(m[u]);
#pragma unroll
            for (int i = 0; i < 4; ++i) { const f32x4 a = *(const f32x4*)(v0 + 4 * lane + 256 * i); x[u][i] = x[u][i] + m[u][i] * rs1 * a; }
        }
#pragma unroll
        for (int u = 0; u < 2; ++u) {
            if (vld[u]) store_xrow_bf16(F.w<bf16_t>(WS_XCUR) + (size_t)rw[u] * D, lane, x[u]);
        }
#pragma unroll
        for (int u = 0; u < 2; ++u) {
            const int which = rw[u] >= L;
            const float* v1 = vecs_ptr(F, l, which, 3), *v2 = vecs_ptr(F, l, which, 4);
            const float rs2 = row_rstd(x[u]);
#pragma unroll
            for (int i = 0; i < 4; ++i) { const f32x4 a = *(const f32x4*)(v1 + 4 * lane + 256 * i), b = *(const f32x4*)(v2 + 4 * lane + 256 * i); hv[u][i] = x[u][i] * rs2 * a + b; }
            if (vld[u]) { unsigned char* ho = F.w<unsigned char>(WS_H2) + (size_t)rw[u] * D;
#pragma unroll
                for (int i = 0; i < 4; ++i) *(unsigned*)(ho + 4 * lane + 256 * i) = pk_fp8x4(hv[u][i][0], hv[u][i][1], hv[u][i][2], hv[u][i][3]); }
        }
        float part[2][32];
#pragma unroll
        for (int e = 0; e < 32; ++e) {
            float s0 = 0.f, s1 = 0.f;
#pragma unroll
            for (int i = 0; i < 4; ++i) { const f32x4 w = *(const LAS f32x4*)(wr + e * WRP + 4 * lane + 256 * i);
                s0 += hv[0][i][0] * w[0] + hv[0][i][1] * w[1] + hv[0][i][2] * w[2] + hv[0][i][3] * w[3];
                s1 += hv[1][i][0] * w[0] + hv[1][i][1] * w[1] + hv[1][i][2] * w[2] + hv[1][i][3] * w[3]; }
            part[0][e] = s0; part[1][e] = s1;
        }
#pragma unroll
        for (int st = 0; st < 5; ++st) {
            const int o = 32 >> st, n = 32 >> st;
            const bool upper = (lane & o) != 0;
#pragma unroll
            for (int i = 0; i < n / 2; ++i) {
#pragma unroll
                for (int u = 0; u < 2; ++u) {
                    const float send = upper ? part[u][i] : part[u][i + n / 2];
                    const float recv = __shfl_xor(send, o);
                    const float keep = upper ? part[u][i + n / 2] : part[u][i];
                    part[u][i] = keep + recv;
                }
            }
        }
#pragma unroll
        for (int u = 0; u < 2; ++u) {
            float lg = part[u][0] + __shfl_xor(part[u][0], 1);
            lg += brl;
            int rank = 0;
#pragma unroll
            for (int e = 0; e < 32; ++e) { const float ov = __int_as_float(__builtin_amdgcn_readlane(__float_as_int(lg), 2 * e)); rank += (ov > lg || (ov == lg && e < mye)) ? 1 : 0; }
            int te[4]; float tv[4];
#pragma unroll
            for (int k = 0; k < 4; ++k) {
                const unsigned long long msk = __ballot(rank == k && (lane & 1) == 0);
                const int idx = msk ? __builtin_amdgcn_readfirstlane((int)__builtin_ctzll(msk)) : 2 * k;
                te[k] = idx >> 1; tv[k] = __int_as_float(__builtin_amdgcn_readlane(__float_as_int(lg), idx));
            }
            const float e1 = __expf(tv[1] - tv[0]), e2 = __expf(tv[2] - tv[0]), e3 = __expf(tv[3] - tv[0]);
            const float inv = 1.0f / (1.0f + e1 + e2 + e3);
            if (lane < 4 && vld[u]) {
                const int k = lane, row = rw[u];
                const int e = k == 0 ? te[0] : (k == 1 ? te[1] : (k == 2 ? te[2] : te[3]));
                const float wgt = (k == 0 ? 1.0f : (k == 1 ? e1 : (k == 2 ? e2 : e3))) * inv;
                const unsigned pos = __hip_atomic_fetch_add(lcnt + e, 1u, __ATOMIC_RELAXED, __HIP_MEMORY_SCOPE_WORKGROUP);
                F.w<int>(WS_RE)[row * 4 + k] = e; F.w<int>(WS_RP)[row * 4 + k] = (int)pos; F.w<float>(WS_RW)[row * 4 + k] = wgt;
            }
        }
    }
    __syncthreads();
    if (F.tid < 32) lcnt[32 + F.tid] = atomicAdd(cnt + F.tid * 32, lcnt[F.tid]);
    __syncthreads();
    for (int row = F.bid * 8 + F.wave; row < nrows; row += nwaves) {
        if (lane < 4) { const int a = row * 4 + lane; F.w<int>(WS_RP)[a] += (int)lcnt[32 + F.w<int>(WS_RE)[a]]; }
    }
}

__device__ __forceinline__ int expert_pad_start(const Frame& F, int l, int& ntiles) {
    const unsigned* cnt = F.w<unsigned>(WS_CTL) + CW_CNT + l * 1024;
    int c = F.lane < 32 ? (int)__hip_atomic_load(cnt + F.lane * 32, __ATOMIC_RELAXED, __HIP_MEMORY_SCOPE_AGENT) : 0;
    int padded = (c + 255) & ~255;
    int incl = padded;
#pragma unroll
    for (int o = 1; o < 32; o <<= 1) { const int v = __shfl_up(incl, o); if ((F.lane & 31) >= o) incl += v; }
    ntiles = __shfl(incl, 31) >> 8;
    return incl - padded;
}

__device__ __forceinline__ void ph_gather(const Frame& F, int l) {
    int ntiles; const int ps = expert_pad_start(F, l, ntiles);
    if (F.bid == 0 && F.wave == 0) {
        int* tab = F.w<int>(WS_CTL) + CW_TILE + l * 320;
        const int nxt = __shfl_down(ps, 1);
        const int endt = (F.lane == 31) ? ntiles : (nxt >> 8);
        if (F.lane < 32) for (int t = ps >> 8; t < endt; ++t) tab[t] = F.lane;
        if (F.lane == 0) F.w<int>(WS_CTL)[CW_NT + l] = ntiles;
    }
    const int nrows = (l == 0) ? T : L;
    for (int a0 = (F.bid * 8 + F.wave) * 64; a0 < nrows * 4; a0 += F.G * 8 * 64) {
        const int a = a0 + F.lane;
        if (a < nrows * 4) {
            const int e = F.w<int>(WS_RE)[a], pos = F.w<int>(WS_RP)[a];
            const int dst = __shfl(ps, e) + pos;
            F.w<int>(WS_SLOT)[a] = dst;
            F.w<int>(WS_ROWTOK)[(size_t)l * MAXROWS + dst] = a >> 2;
        }
    }
}

__device__ __forceinline__ void ph_final(const Frame& F, int l) {
    const int nrows = (l == 0) ? T : L;
    const int nwaves = F.G * 8, lane = F.lane;
    const bf16_t* Y = F.w<bf16_t>(WS_Y) + (size_t)l * MAXROWS * D;
    int slotn[2][4]; float wgtn[2][4];
#define FN_SLOTS(r0_) do { _Pragma("unroll") for (int u = 0; u < 2; ++u) { const int rr_ = ((r0_) + u * nwaves < nrows) ? (r0_) + u * nwaves : (r0_); \
        _Pragma("unroll") for (int k = 0; k < 4; ++k) { slotn[u][k] = F.w<int>(WS_SLOT)[rr_ * 4 + k]; wgtn[u][k] = F.w<float>(WS_RW)[rr_ * 4 + k]; } } } while (0)
    const int rfirst = F.bid * 8 + F.wave;
    if (rfirst < nrows) FN_SLOTS(rfirst);
    for (int row0 = rfirst; row0 < nrows; row0 += 2 * nwaves) {
        int rw[2]; bool vld[2];
        rw[0] = row0; vld[0] = true; vld[1] = (row0 + nwaves < nrows); rw[1] = vld[1] ? row0 + nwaves : row0;
        int slot[2][4]; float wgt[2][4];
#pragma unroll
        for (int u = 0; u < 2; ++u)
#pragma unroll
            for (int k = 0; k < 4; ++k) { slot[u][k] = slotn[u][k]; wgt[u][k] = wgtn[u][k]; }
        u32x2 yv[2][4][4]; f32x4 x[2][4];
#pragma unroll
        for (int u = 0; u < 2; ++u) {
#pragma unroll
            for (int k = 0; k < 4; ++k) { const bf16_t* yr = Y + (size_t)slot[u][k] * D;
#pragma unroll
                for (int i = 0; i < 4; ++i) yv[u][k][i] = *(const u32x2*)(yr + 4 * lane + 256 * i); }
            load_xrow(F, 1, rw[u], lane, x[u]);
        }
        if (row0 + 2 * nwaves < nrows) FN_SLOTS(row0 + 2 * nwaves);
#pragma unroll
        for (int u = 0; u < 2; ++u) {
            const int which = rw[u] >= L;
            const float* ve = vecs_ptr(F, l, which, 5);
            f32x4 f[4];
#pragma unroll
            for (int i = 0; i < 4; ++i) f[i] = (f32x4){0.f, 0.f, 0.f, 0.f};
#pragma unroll
            for (int k = 0; k < 4; ++k)
#pragma unroll
                for (int i = 0; i < 4; ++i) { const u32x2 w = yv[u][k][i]; f[i][0] += wgt[u][k] * bflo(w.x); f[i][1] += wgt[u][k] * bfhi(w.x); f[i][2] += wgt[u][k] * bflo(w.y); f[i][3] += wgt[u][k] * bfhi(w.y); }
            const float rs = row_rstd(f);
#pragma unroll
            for (int i = 0; i < 4; ++i) { const f32x4 a = *(const f32x4*)(ve + 4 * lane + 256 * i); x[u][i] = x[u][i] + f[i] * rs * a; }
            if (vld[u]) {
                if (l == 1) { float* xo = F.out + (size_t)rw[u] * D;
#pragma unroll
                    for (int i = 0; i < 4; ++i) *(f32x4*)(xo + 4 * lane + 256 * i) = x[u][i]; }
                else store_xrow_bf16(F.w<bf16_t>(WS_XCUR) + (size_t)rw[u] * D, lane, x[u]);
                if (l == 0) {
                    const float rstd = row_rstd(x[u]);
                    const float* va = vecs_ptr(F, 1, which, 0), *vb = vecs_ptr(F, 1, which, 1);
                    bf16_t* orow = F.w<bf16_t>(WS_HB) + (size_t)rw[u] * D;
                    unsigned char* orow8 = F.w<unsigned char>(WS_HB) + (size_t)rw[u] * D;
#pragma unroll
                    for (int i = 0; i < 4; ++i) {
                        const int c = 4 * lane + 256 * i;
                        const f32x4 a = *(const f32x4*)(va + c), b = *(const f32x4*)(vb + c);
                        if (F8IN(1)) *(unsigned*)(orow8 + c) = pk_fp8x4(x[u][i][0] * rstd * a[0] + b[0], x[u][i][1] * rstd * a[1] + b[1], x[u][i][2] * rstd * a[2] + b[2], x[u][i][3] * rstd * a[3] + b[3]);
                        else { u32x2 w; w.x = pk_bf16(x[u][i][0] * rstd * a[0] + b[0], x[u][i][1] * rstd * a[1] + b[1]); w.y = pk_bf16(x[u][i][2] * rstd * a[2] + b[2], x[u][i][3] * rstd * a[3] + b[3]);
                        *(u32x2*)(orow + c) = w; }
                    }
                }
            }
        }
    }
#undef FN_SLOTS
}

constexpr int PH_PER_LAYER = 10, N_PHASES = 2 + 2 * PH_PER_LAYER;
#ifndef PH_MASK
#define PH_MASK 0xFFFFFFFFu
#endif
#define EN(b) (((PH_MASK) >> (b)) & 1u)
#ifndef DUP_MASK
#define DUP_MASK 0u
#endif
#define REP(b) for (int _rep = 0; _rep < 1 + (int)(((DUP_MASK) >> (b)) & 1u); ++_rep)

__global__ void __launch_bounds__(NTHREADS, 2) mega(Args args) {
    extern __shared__ __attribute__((aligned(16))) unsigned char shm[];
    Frame F0;
    F0.in.kp = (kargp_t)__builtin_amdgcn_kernarg_segment_ptr();
    F0.out = args.out; F0.ws = args.ws; F0.lds = (LAS unsigned char*)shm;
    F0.tid = threadIdx.x; F0.lane = F0.tid & 63; F0.wave = __builtin_amdgcn_readfirstlane(F0.tid >> 6); F0.G = gridDim.x; F0.bid = blockIdx.x;
    volatile LAS unsigned* bst = (volatile LAS unsigned*)(shm + LDS_BYTES - 16);
    XcdBarrier bar; bar.bar = F0.w<unsigned>(WS_CTL) + CW_BAR; bar.x = 0; bar.st = bst;
#if N_LAUNCH_MODE == 1
    if (F0.tid == 0) { bst[0] = 0u; bst[1] = 0u; }
    __syncthreads();
    bar = xcd_barrier_post(F0.w<unsigned>(WS_CTL) + CW_BAR, bst);
#define GRID_BAR() xcd_barrier(bar)
#else
#define GRID_BAR() do {} while (0)
#endif
    const int lo = args.ph_lo, hi = args.ph_hi;
#define IN(k) (lo <= (k) && (k) < hi)
#define SEAM(k) do { if (IN(k) && IN((k) + 1)) GRID_BAR(); } while (0)

    if (IN(0)) { const Frame F = launder(F0); REP(1) ph_modpart(F); }
    SEAM(0);
    if (IN(1)) { const Frame F = launder(F0);
        REP(2) ph_filter(F); REP(3) ph_norm1(F, 0); ph_vecs(F); __syncthreads(); REP(0) ph_convert(F); }
    SEAM(1);
    for (int l = 0; l < 2; ++l) {
        const int pb = 2 + l * PH_PER_LAYER;
        if (EN(5) && IN(pb + 0)) { const Frame F = launder(F0);
            const bool f8 = (l == 0) ? (F8IN(0) != 0) : (F8IN(1) != 0);
            pg8::Gemm g{F.w<bf16_t>(WS_HB), F.w<bf16_t>(WS_WINT) + (size_t)l * PC * D, f8 ? D / 2 : D};
            pg8::SchedGrid S{PC / 256, (T / 256) * (PC / 256), F.G, F.vid};
            pg8::EpiBf16 E{F.w<bf16_t>(WS_P), PC, nullptr, 0};
            if (INPROJ_FP8 == 0) pg8::gemm_phase<pg8::EpiBf16, pg8::SchedGrid, true, false, false>(F.lds, g, S, E, F.tid);
            else if (INPROJ_FP8 == 3) pg8::gemm_phase<pg8::EpiBf16, pg8::SchedGrid, true, false, true>(F.lds, g, S, E, F.tid);
            else { if (f8) pg8::gemm_phase<pg8::EpiBf16, pg8::SchedGrid, true, false, true>(F.lds, g, S, E, F.tid); else pg8::gemm_phase<pg8::EpiBf16, pg8::SchedGrid, true, false, false>(F.lds, g, S, E, F.tid); }
        }
        SEAM(pb + 0);
        if (IN(pb + 1)) { const Frame F = launder(F0); if (l == 0) { REP(4) ph_fsum(F); } REP(6) ph_ssd_prep(F, l); REP(7) ph_hy_prep(F, l); REP(8) ph_na(F, l, 0); }
        SEAM(pb + 1);
        if (IN(pb + 2)) { const Frame F = launder(F0); REP(9) ph_ssd_scan(F); REP(10) { ph_hy_conv(F, l); if (l == 0) ph_hy_conv_ctx(F, l); } }
        SEAM(pb + 2);
        if (EN(11) && IN(pb + 3)) { const Frame F = launder(F0); REP(11) ph_ssd_out(F, l); REP(18) ph_hy_tr(F); if (l == 0) ph_na(F, l, 1); }
        SEAM(pb + 3);
        if (EN(12) && IN(pb + 4)) { const Frame F = launder(F0);
            pg8::Gemm g{F.w<bf16_t>(WS_MIX), F.w<bf16_t>(WS_WOUTT) + (size_t)l * D * D, D};
            const int nM = (l == 0) ? T / 256 : L / 256;
            pg8::SchedGrid S{4, nM * 4, F.G, F.vid};
            pg8::EpiBf16 E{F.w<bf16_t>(WS_MIXO), D, nullptr, 0};
            REP(12) pg8::gemm_phase<pg8::EpiBf16, pg8::SchedGrid>(F.lds, g, S, E, F.tid);
        }
        SEAM(pb + 4);
        if (EN(13) && IN(pb + 5)) { const Frame F = launder(F0); ph_post1(F, l); }
        SEAM(pb + 5);
        if (EN(14) && IN(pb + 6)) { const Frame F = launder(F0); REP(14) ph_gather(F, l); }
        SEAM(pb + 6);
        if (EN(15) && IN(pb + 7)) { const Frame F = launder(F0);
            const int* tab = F.w<int>(WS_CTL) + CW_TILE + l * 320;
            const int ntiles = __builtin_amdgcn_readfirstlane(F.w<int>(WS_CTL)[CW_NT + l]);
            pg8::Gemm g{F.w<bf16_t>(WS_H2), (const bf16_t*)(F.w<unsigned char>(WS_WGUT) + (size_t)l * NE * 2048 * D), D / 2};
            pg8::SchedMoe S{8, ntiles * 8, F.G, F.vid, tab};
            pg8::EpiAct E{F.w<unsigned char>(WS_HMID) + (size_t)l * MAXROWS * D, F.in[I_BGU] + (size_t)l * NE * 2048};
            LAS int* rowtab = (LAS int*)(F.lds + pg8::STAGE_BYTES);
            __syncthreads();
            {
                int nt_; const int ps = expert_pad_start(F, l, nt_);
                const unsigned* cnt = F.w<unsigned>(WS_CTL) + CW_CNT + l * 1024;
                for (int ui = 0; ui * F.G + F.vid < ntiles * 8 && ui < 12; ++ui) {
                    const int pa = (ui * F.G + F.vid) / 8;
                    const int e = tab[pa];
                    const int pstart = __shfl(ps, e), ce = (int)__hip_atomic_load(cnt + e * 32, __ATOMIC_RELAXED, __HIP_MEMORY_SCOPE_AGENT);
                    if (F.tid < 256) { const int prow = pa * 256 + F.tid; rowtab[ui * 256 + F.tid] = (prow - pstart < ce) ? F.w<int>(WS_ROWTOK)[(size_t)l * MAXROWS + prow] : T; }
                }
            }
            __syncthreads();
            REP(15) pg8::gemm_phase<pg8::EpiAct, pg8::SchedMoe, true, true, true>(F.lds, g, S, E, F.tid, rowtab);
        }
        SEAM(pb + 7);
        if (EN(16) && IN(pb + 8)) { const Frame F = launder(F0);
            const int* tab = F.w<int>(WS_CTL) + CW_TILE + l * 320;
            const int ntiles = __builtin_amdgcn_readfirstlane(F.w<int>(WS_CTL)[CW_NT + l]);
            pg8::Gemm g{(const bf16_t*)(F.w<unsigned char>(WS_HMID) + (size_t)l * MAXROWS * D), (const bf16_t*)(F.w<unsigned char>(WS_WDT) + (size_t)l * NE * D * D), D / 2};
            pg8::SchedMoe S{4, ntiles * 4, F.G, F.vid, tab};
            pg8::EpiBf16 E{F.w<bf16_t>(WS_Y) + (size_t)l * MAXROWS * D, D, F.in[I_BDN] + (size_t)l * NE * D, D};
            REP(16) pg8::gemm_phase<pg8::EpiBf16, pg8::SchedMoe, true, false, true>(F.lds, g, S, E, F.tid);
        }
        SEAM(pb + 8);
        if (EN(17) && IN(pb + 9)) { const Frame F = launder(F0); ph_final(F, l); }
        if (l == 0) SEAM(pb + 9);
    }
#undef IN
#undef SEAM
}

extern "C" void kernel_launch(void* const* d_in, const int* in_sizes, int n_in, void* d_out, int out_size, void* d_ws, size_t ws_size, hipStream_t stream) {
    static int grid = 0;
    if (grid == 0) {
        if (n_in != N_IN || out_size != L * D || ws_size < WS_END) { fprintf(stderr, "kernel_launch: unexpected shapes: n_in %d out %d ws %zu (need %zu)\n", n_in, out_size, ws_size, (size_t)WS_END); grid = -1; return; }
        int dev = 0, cus = 0, per_cu = 0;
        if (hipGetDevice(&dev) != hipSuccess || hipDeviceGetAttribute(&cus, hipDeviceAttributeMultiprocessorCount, dev) != hipSuccess) { grid = -1; return; }
        if (hipFuncSetAttribute((const void*)mega, hipFuncAttributeMaxDynamicSharedMemorySize, LDS_BYTES) != hipSuccess) { fprintf(stderr, "kernel_launch: hipFuncSetAttribute failed\n"); grid = -1; return; }
        if (hipOccupancyMaxActiveBlocksPerMultiprocessor(&per_cu, (const void*)mega, NTHREADS, LDS_BYTES) != hipSuccess || per_cu < 1) { fprintf(stderr, "kernel_launch: occupancy query says %d\n", per_cu); }
        (void)hipGetLastError();
        grid = cus;
    }
    if (grid < 0) return;
    (void)hipMemsetAsync((char*)d_ws + WS_CTL, 0, CTL_BYTES, stream);
    Args a{};
    for (int i = 0; i < N_IN; ++i) a.in[i] = (const float*)d_in[i];
    a.out = (float*)d_out; a.ws = (unsigned char*)d_ws;
#if N_LAUNCH_MODE == 1
    a.ph_lo = 0; a.ph_hi = N_PHASES;
    hipLaunchKernelGGL(mega, dim3(grid), dim3(NTHREADS), LDS_BYTES, stream, a);
#else
    for (int p = 0; p < N_PHASES; ++p) { a.ph_lo = p; a.ph_hi = p + 1; hipLaunchKernelGGL(mega, dim3(grid), dim3(NTHREADS), LDS_BYTES, stream, a); }
#endif
}
```

```cpp
#include <hip/hip_runtime.h>
#include <cstdio>
#include <cstdint>

#define LAS __attribute__((address_space(3)))
typedef unsigned short bf16_t;
typedef short bf16x8 __attribute__((ext_vector_type(8)));
typedef float f32x4 __attribute__((ext_vector_type(4)));
typedef float f32x16 __attribute__((ext_vector_type(16)));
typedef unsigned u32x4 __attribute__((ext_vector_type(4)));
typedef unsigned u32x2 __attribute__((ext_vector_type(2)));
typedef int v4i __attribute__((ext_vector_type(4)));
typedef int v8i __attribute__((ext_vector_type(8)));

#ifndef N_LAUNCH_MODE
#define N_LAUNCH_MODE 1
#endif

constexpr int D = 1024, L = 16384, LC = 256, T = L + LC, NCH = T / 128;
constexpr int PC = 3328;
constexpr int CZ = 0, CXBC = 384, CQ = 1280, CK = 1664, CV = 2048, CHY = 2432, CDT = 3200;
constexpr int NE = 32;
constexpr int MAXT = 292;
constexpr int MAXROWS = MAXT * 256;
constexpr int NTHREADS = 512;
constexpr int LDS_BYTES = 160 * 1024;
constexpr float RMS_EPS = 1e-6f;

enum { I_X = 0, I_C, I_CTX, I_CCTX, I_WMOD, I_BMOD, I_NORMG, I_WIN, I_SCW, I_SCB, I_ALOG, I_DTB, I_SSDD, I_SSDNG, I_RPB, I_HCW, I_HCB,
       I_FW1, I_FB1, I_FW2, I_FB2, I_FW3, I_FREQ, I_HYD, I_WOUT, I_WR, I_BR, I_WGU, I_BGU, I_WDN, I_BDN, N_IN };

constexpr size_t al256(size_t x) { return (x + 255) & ~(size_t)255; }
constexpr size_t WS_CTL   = 0;
constexpr size_t CTL_BYTES = 64 * 1024;
constexpr size_t WS_WINT  = WS_CTL + CTL_BYTES;
constexpr size_t WS_WOUTT = WS_WINT + al256((size_t)2 * PC * D * 2);
constexpr size_t WS_WGUT  = WS_WOUTT + al256((size_t)2 * D * D * 2);
constexpr size_t WS_WDT   = WS_WGUT + al256((size_t)2 * NE * 2048 * D * 2);
constexpr size_t WS_MODP  = WS_WDT + al256((size_t)2 * NE * D * D * 2);
constexpr int KRL = 2 * L + 512;
constexpr size_t WS_KR    = WS_MODP + al256((size_t)2 * 2 * 32 * 6144 * 4);
constexpr size_t WS_KCOMBC= WS_KR + al256((size_t)2 * 256 * KRL * 2);
constexpr size_t WS_FPART = WS_KCOMBC + al256((size_t)2 * LC * 256 * 4);
constexpr size_t WS_FPARTC= WS_FPART + al256((size_t)2 * 256 * 512 * 4);
constexpr size_t WS_FSUM  = WS_FPARTC + al256((size_t)16 * 512 * 4);
constexpr size_t WS_HB    = WS_FSUM + al256((size_t)3 * 256 * 4);
constexpr size_t WS_P     = WS_HB + al256((size_t)T * D * 2);
constexpr size_t WS_XBC   = WS_P + al256((size_t)T * PC * 2);
constexpr size_t WS_DTV   = WS_XBC + al256((size_t)T * 896 * 2);
constexpr size_t WS_ACS   = WS_DTV + al256((size_t)T * 12 * 4);
constexpr size_t WS_ALAST = WS_ACS + al256((size_t)T * 12 * 4);
constexpr size_t WS_STATES= WS_ALAST + al256((size_t)NCH * 12 * 4);
constexpr size_t WS_SSTART= WS_STATES + al256((size_t)2 * NCH * 6 * 128 * 64 * 4);
constexpr size_t WS_U     = WS_SSTART + al256((size_t)2 * NCH * 6 * 128 * 64 * 4);
constexpr size_t WS_UT    = WS_U + al256((size_t)T * 256 * 4);
constexpr size_t WS_UT8   = WS_UT + al256((size_t)256 * L * 2);
constexpr size_t WS_X0T   = WS_UT8 + al256((size_t)256 * L);
constexpr size_t WS_YT    = WS_X0T + al256((size_t)256 * L * 2);
constexpr size_t WS_MIX   = WS_YT + al256((size_t)256 * L * 2);
constexpr size_t WS_MIXO  = WS_MIX + al256((size_t)T * D * 2);
constexpr size_t WS_XCUR  = WS_MIXO + al256((size_t)T * D * 4);
constexpr size_t WS_H2    = WS_XCUR + al256((size_t)T * D * 4);
constexpr size_t WS_RE    = WS_H2 + al256((size_t)(T + 1) * D * 2);
constexpr size_t WS_RP    = WS_RE + al256((size_t)T * 4 * 4);
constexpr size_t WS_RW    = WS_RP + al256((size_t)T * 4 * 4);
constexpr size_t WS_SLOT  = WS_RW + al256((size_t)T * 4 * 4);
constexpr size_t WS_XG    = WS_SLOT + al256((size_t)T * 4 * 4);
constexpr size_t WS_HMID  = WS_XG + 256;
constexpr size_t WS_Y     = WS_HMID + al256((size_t)2 * MAXROWS * D * 2);
constexpr size_t WS_VECS  = WS_Y + al256((size_t)2 * MAXROWS * D * 2);
constexpr size_t WS_ROWTOK= WS_VECS + al256((size_t)2 * 2 * 6 * 1024 * 4);
constexpr size_t WS_END   = WS_ROWTOK + al256((size_t)2 * MAXROWS * 4);

constexpr int CW_BAR = 0;
constexpr int CW_CNT = 8192;
#ifndef INPROJ_FP8
#define INPROJ_FP8 2
#endif
#define F8IN(l) (((INPROJ_FP8) >> (l)) & 1)
#ifndef PRO_NF
#define PRO_NF 96
#endif
constexpr int CW_CVQ = 4160;
constexpr int CW_NT = 4200;
constexpr int CW_TILE = 4224;

__device__ __forceinline__ float bf2f(unsigned short b) { return __uint_as_float(((unsigned)b) << 16); }
__device__ __forceinline__ unsigned short f2bf(float f) { unsigned u = __float_as_uint(f); u += 0x7FFFu + ((u >> 16) & 1u); return (unsigned short)(u >> 16); }
__device__ __forceinline__ unsigned pk_bf16(float lo, float hi) { return (unsigned)f2bf(lo) | ((unsigned)f2bf(hi) << 16); }
__device__ __forceinline__ float sat8(float x) { return fminf(fmaxf(x, -448.0f), 448.0f); }
__device__ __forceinline__ unsigned pk_fp8x4(float a, float b, float c, float d) { unsigned w = 0; w = __builtin_amdgcn_cvt_pk_fp8_f32(sat8(a), sat8(b), w, false); w = __builtin_amdgcn_cvt_pk_fp8_f32(sat8(c), sat8(d), w, true); return w; }
constexpr float KR_SCALE = 64.0f;
constexpr float W8_SCALE = 32.0f;
constexpr int W8_SCALE_E8M0 = 0x7A7A7A7A, ONE_E8M0 = 0x7F7F7F7F;
__device__ __forceinline__ float bflo(unsigned w) { return __uint_as_float(w << 16); }
__device__ __forceinline__ float bfhi(unsigned w) { return __uint_as_float(w & 0xFFFF0000u); }
__device__ __forceinline__ float silu_f(float x) { return x / (1.0f + __expf(-x)); }
__device__ __forceinline__ float softplus_f(float x) { return x > 20.f ? x : log1pf(__expf(x)); }
__device__ __forceinline__ float row16_ror(float v, int ctrl8421) {
    switch (ctrl8421) {
        case 8: return __int_as_float(__builtin_amdgcn_update_dpp(0, __float_as_int(v), 0x128, 0xF, 0xF, false));
        case 4: return __int_as_float(__builtin_amdgcn_update_dpp(0, __float_as_int(v), 0x124, 0xF, 0xF, false));
        case 2: return __int_as_float(__builtin_amdgcn_update_dpp(0, __float_as_int(v), 0x122, 0xF, 0xF, false));
        default: return __int_as_float(__builtin_amdgcn_update_dpp(0, __float_as_int(v), 0x121, 0xF, 0xF, false));
    }
}
__device__ __forceinline__ float row16_max(float v) { v = fmaxf(v, row16_ror(v, 8)); v = fmaxf(v, row16_ror(v, 4)); v = fmaxf(v, row16_ror(v, 2)); v = fmaxf(v, row16_ror(v, 1)); return v; }
__device__ __forceinline__ float row16_sum(float v) { v += row16_ror(v, 8); v += row16_ror(v, 4); v += row16_ror(v, 2); v += row16_ror(v, 1); return v; }
__device__ __forceinline__ float wave_sum(float v) {
    v = row16_sum(v);
    const int vi = __float_as_int(v);
    return (__int_as_float(__builtin_amdgcn_readlane(vi, 0)) + __int_as_float(__builtin_amdgcn_readlane(vi, 16))) + (__int_as_float(__builtin_amdgcn_readlane(vi, 32)) + __int_as_float(__builtin_amdgcn_readlane(vi, 48)));
}
__device__ __forceinline__ void lds_fence() { asm volatile("s_waitcnt lgkmcnt(0)" ::: "memory"); }

#define XB_TMO      128
#define XB_XCNT(j)  (256  + 64 * (j))
#define XB_XSUB(j)  (1280 + 64 * (j))
#define XB_XGEN(j)  (2304 + 64 * (j))
#define XB_TOP      3328
#define XB_TOPGEN   3392
#define XCD_BAR_WORDS 3456
#define XB_SPIN_CAP (1u << 18)
__device__ __forceinline__ unsigned xb_ld(unsigned* p)              { return __hip_atomic_load(p, __ATOMIC_RELAXED, __HIP_MEMORY_SCOPE_AGENT); }
__device__ __forceinline__ unsigned xb_add(unsigned* p, unsigned v) { return __hip_atomic_fetch_add(p, v, __ATOMIC_RELAXED, __HIP_MEMORY_SCOPE_AGENT); }
__device__ __forceinline__ unsigned xb_xcc_id() { return (unsigned)__builtin_amdgcn_s_getreg((3 << 11) | 20) & 0xFu; }
#define XB_SPIN(cond, bar) do { unsigned _sp = 0; while (cond) { __builtin_amdgcn_s_sleep(1); \
    if ((++_sp & 255u) == 0u) { if (xb_ld(&(bar)[XB_TMO])) break; if (_sp > XB_SPIN_CAP) { atomicAdd(&(bar)[XB_TMO], 1u); break; } } } } while (0)
struct XcdBarrier { unsigned* bar; unsigned x; volatile LAS unsigned* st; };
__device__ __forceinline__ XcdBarrier xcd_barrier_post(unsigned* bar, volatile LAS unsigned* st) {
    XcdBarrier b; b.bar = bar; b.x = xb_xcc_id(); b.st = st;
    if (threadIdx.x == 0) (void)xb_add(&bar[XB_XCNT(b.x)], 1u);
    return b;
}
__device__ __forceinline__ void xcd_barrier_complete(unsigned* bar, unsigned x, unsigned& nloc, unsigned& nx) {
    const unsigned G = gridDim.x * gridDim.y * gridDim.z;
    unsigned sum, cnt, mine, sp = 0u;
    for (;;) {
        sum = 0u; cnt = 0u; mine = 0u;
#pragma unroll
        for (unsigned j = 0; j < 16; ++j) { const unsigned c = xb_ld(&bar[XB_XCNT(j)]); sum += c; cnt += (c > 0u) ? 1u : 0u; mine = (j == x) ? c : mine; }
        if (sum == G) break;
        __builtin_amdgcn_s_sleep(1);
        if ((++sp & 255u) == 0u) { if (xb_ld(&bar[XB_TMO])) break; if (sp > XB_SPIN_CAP) { atomicAdd(&bar[XB_TMO], 1u); break; } }
    }
    nloc = mine > 0u ? mine : 1u; nx = cnt > 0u ? cnt : 1u;
}
__device__ __forceinline__ void xcd_barrier(const XcdBarrier& b) {
    asm volatile("s_waitcnt vmcnt(0)" ::: "memory");
    __syncthreads();
    if (threadIdx.x == 0) {
        unsigned* bar = b.bar;
        __builtin_amdgcn_s_waitcnt(0);
        unsigned nloc = b.st[0], nx = b.st[1];
        if (nloc == 0u) { xcd_barrier_complete(bar, b.x, nloc, nx); b.st[0] = nloc; b.st[1] = nx; }
        const unsigned old = xb_add(&bar[XB_XSUB(b.x)], 1u);
        const unsigned gen = old / nloc;
        if (old + 1u == (gen + 1u) * nloc) {
            __builtin_amdgcn_fence(__ATOMIC_RELEASE, "agent");
            asm volatile("s_waitcnt vmcnt(0)" ::: "memory");
            const unsigned og = xb_add(&bar[XB_TOP], 1u);
            const unsigned tg = og / nx;
            if (og + 1u == (tg + 1u) * nx) xb_add(&bar[XB_TOPGEN], 1u);
            else XB_SPIN(xb_ld(&bar[XB_TOPGEN]) == tg, bar);
            __builtin_amdgcn_fence(__ATOMIC_ACQUIRE, "agent");
            xb_add(&bar[XB_XGEN(b.x)], 1u);
            asm volatile("s_waitcnt vmcnt(0)" ::: "memory");
        } else {
            XB_SPIN(xb_ld(&bar[XB_XGEN(b.x)]) == gen, bar);
            __builtin_amdgcn_fence(__ATOMIC_ACQUIRE, "agent");
            asm volatile("s_waitcnt vmcnt(0)" ::: "memory");
        }
    }
    __syncthreads();
}

#ifndef GEMM_REP
#define GEMM_REP 1
#endif
namespace pg8 {
constexpr int BM = 256, BK = 64, HALF = 128, HTB = HALF * BK * 2, STAGE_BYTES = 8 * HTB;
__host__ __device__ __forceinline__ int lds_byte(int r, int c) { const int st = (r >> 4) * 2 + (c >> 5), rr = r & 15, cc = c & 31, ob = rr * 64 + cc * 2; return st * 1024 + (ob ^ (((ob >> 9) & 1) << 5)); }
__host__ __device__ __forceinline__ void stage_rc(int b, int& R, int& C) { const int st = b / 1024, sb = b % 1024, swz = sb ^ (((sb >> 9) & 1) << 5); R = (st >> 1) * 16 + swz / 64; C = (st & 1) * 32 + (swz % 64) / 2; }
__host__ __device__ __forceinline__ int perm32(int rho) { const int n = rho >> 4, i = rho & 15; return 8 * (i >> 2) + 4 * n + (i & 3); }

struct Unit { int pa, pb, pn, e; };
struct Gemm { const bf16_t* A; const bf16_t* Bt; int K; };

template <class Epi, class Sched, bool ALIGN_EPI = true, bool GATHER = false, bool FP8 = false>
__device__ __forceinline__ void gemm_phase(LAS unsigned char* lds, const Gemm g, const Sched& S, const Epi& E, const int tid, const LAS int* rowtab = nullptr) {
    const int wid = __builtin_amdgcn_readfirstlane(tid >> 6), lane = tid & 63, wr = wid >> 2, wc = wid & 3, fr = lane & 15, fq = lane >> 4;
    const int K = g.K, nt = K / BK;
    unsigned voffA[2], voffB[2];
    int gR[2], gC[2];
#pragma unroll
    for (int i = 0; i < 2; ++i) { int R, C; stage_rc(tid * 16 + i * 8192, R, C); const int Rb = Epi::PERM ? ((R & ~31) + perm32(R & 31)) : R;
        voffA[i] = (unsigned)(R * K + C) * 2u; voffB[i] = (unsigned)(Rb * K + C) * 2u; gR[i] = R; gC[i] = C * 2; }
    unsigned vC0[2], vC1[2], vN0[2], vN1[2];
#define PG8_GOFFS(dst0, dst1, ui_) do { _Pragma("unroll") for (int _i = 0; _i < 2; ++_i) { \
        dst0[_i] = (unsigned)rowtab[(ui_) * 256 + gR[_i]] * (unsigned)(K * 2) + (unsigned)gC[_i]; dst1[_i] = (unsigned)rowtab[(ui_) * 256 + 128 + gR[_i]] * (unsigned)(K * 2) + (unsigned)gC[_i]; } } while (0)
    const size_t kstep = (size_t)(BK * 2);
    const size_t hstep = (size_t)HALF * K * 2;
    const size_t tstep = 2 * hstep;
    const unsigned ldsw = (unsigned)wid * 1024u;
    const int aoff = lds_byte(wr * 64 + fr, fq * 8), boff = lds_byte(wc * 32 + fr, fq * 8);
#define PG8_SA(b, h) (((b) * 2 + (h)) * HTB)
#define PG8_SB(b, h) ((4 + (b) * 2 + (h)) * HTB)
#define PG8_STAGE(bufoff, gbase, voff) do { _Pragma("unroll") for (int _i = 0; _i < 2; ++_i) \
        __builtin_amdgcn_global_load_lds((const unsigned*)((const char*)(gbase) + (voff)[_i]), (LAS unsigned*)(lds + (bufoff) + ldsw + _i * 8192), 16, 0, 0); } while (0)
#define PG8_LDA(dst, b, h) do { _Pragma("unroll") for (int m = 0; m < 4; ++m) { const v4i _x = *(const LAS v4i*)(lds + PG8_SA(b, h) + aoff + m * 2048), _y = *(const LAS v4i*)(lds + PG8_SA(b, h) + aoff + m * 2048 + 1024); \
        dst[m] = __builtin_shufflevector(_x, _y, 0, 1, 2, 3, 4, 5, 6, 7); } } while (0)
#define PG8_LDB(dst, b, h) do { _Pragma("unroll") for (int n = 0; n < 2; ++n) { const v4i _x = *(const LAS v4i*)(lds + PG8_SB(b, h) + boff + n * 2048), _y = *(const LAS v4i*)(lds + PG8_SB(b, h) + boff + n * 2048 + 1024); \
        dst[n] = __builtin_shufflevector(_x, _y, 0, 1, 2, 3, 4, 5, 6, 7); } } while (0)
#define PG8_HALF0(x) __builtin_bit_cast(bf16x8, __builtin_shufflevector((x), (x), 0, 1, 2, 3))
#define PG8_HALF1(x) __builtin_bit_cast(bf16x8, __builtin_shufflevector((x), (x), 4, 5, 6, 7))
#define PG8_MMA(ai, bj, At, Bt) do { __builtin_amdgcn_s_setprio(1); if constexpr (FP8) { _Pragma("unroll") for (int m = 0; m < 4; ++m) _Pragma("unroll") for (int n = 0; n < 2; ++n) \
        asm volatile("v_mfma_scale_f32_16x16x128_f8f6f4 %0, %1, %2, %0, %3, %4 op_sel_hi:[0,0,0]" : "+v"(acc[ai][bj][m][n]) : "v"(Bt[n]), "v"(At[m]), "v"(sclW), "v"(sclX)); } \
        else { _Pragma("unroll") for (int m = 0; m < 4; ++m) _Pragma("unroll") for (int n = 0; n < 2; ++n) { \
        acc[ai][bj][m][n] = __builtin_amdgcn_mfma_f32_16x16x32_bf16(PG8_HALF0(Bt[n]), PG8_HALF0(At[m]), acc[ai][bj][m][n], 0, 0, 0); \
        acc[ai][bj][m][n] = __builtin_amdgcn_mfma_f32_16x16x32_bf16(PG8_HALF1(Bt[n]), PG8_HALF1(At[m]), acc[ai][bj][m][n], 0, 0, 0); } } __builtin_amdgcn_s_setprio(0); } while (0)
#define PG8_WAIT_V(n) asm volatile("s_waitcnt vmcnt(" #n ")" ::: "memory")
#define PG8_WAIT_L(n) asm volatile("s_waitcnt lgkmcnt(" #n ")" ::: "memory")
#define PG8_BAR __builtin_amdgcn_s_barrier()
#define PG8_SCHED __builtin_amdgcn_sched_barrier(0)
    Unit cur, nxt; int ui = 0;
    if (!S.next(0, cur)) return;
    f32x4 acc[2][2][4][2];
    E.init(acc, cur, wc, fq);
    const int sclW = W8_SCALE_E8M0, sclX = ONE_E8M0;
    v8i At[4], B0[2], B1[2];
    const char* cA = GATHER ? (const char*)g.A : (const char*)g.A + (size_t)cur.pa * tstep; const char* cB = (const char*)g.Bt + (size_t)cur.pb * tstep;
    const size_t hstepA = GATHER ? 0 : hstep;
    if constexpr (GATHER) { PG8_GOFFS(vC0, vC1, 0); } else {
#pragma unroll
        for (int i = 0; i < 2; ++i) { vC0[i] = voffA[i]; vC1[i] = voffA[i]; vN0[i] = voffA[i]; vN1[i] = voffA[i]; } }
    PG8_STAGE(PG8_SB(0, 0), cB, voffB); PG8_STAGE(PG8_SB(0, 1), cB + hstep, voffB); PG8_STAGE(PG8_SA(0, 0), cA, vC0); PG8_STAGE(PG8_SA(0, 1), cA + hstepA, vC1);
    if (wr == 1) PG8_BAR;
    PG8_WAIT_V(2); PG8_BAR;
    PG8_STAGE(PG8_SB(1, 0), cB + kstep, voffB); PG8_STAGE(PG8_SA(1, 0), cA + kstep, vC0); PG8_STAGE(PG8_SB(1, 1), cB + hstep + kstep, voffB);
    PG8_WAIT_V(6); PG8_BAR;
    for (;;) {
        const bool has_next = S.next(ui + 1, nxt);
        const char* nA = GATHER ? (const char*)g.A : (has_next ? (const char*)g.A + (size_t)nxt.pa * tstep : cA); const char* nB = has_next ? (const char*)g.Bt + (size_t)nxt.pb * tstep : cB;
        if constexpr (GATHER) { if (has_next) { PG8_GOFFS(vN0, vN1, ui + 1); } else {
#pragma unroll
            for (int i = 0; i < 2; ++i) { vN0[i] = vC0[i]; vN1[i] = vC1[i]; } } }
#pragma unroll 1
        for (int t = 0; t < nt; t += 2) {
            const bool last = (t == nt - 2);
            unsigned vX0[2], vX1[2];
#pragma unroll
            for (int i = 0; i < 2; ++i) { vX0[i] = (GATHER && last) ? vN0[i] : vC0[i]; vX1[i] = (GATHER && last) ? vN1[i] : vC1[i]; }
            const char* a1 = cA + (size_t)(t + 1) * kstep;
            const char* a2 = last ? nA : cA + (size_t)(t + 2) * kstep; const char* b2 = last ? nB : cB + (size_t)(t + 2) * kstep;
            const char* a3 = a2 + kstep; const char* b3 = b2 + kstep;
            PG8_LDB(B0, 0, 0); PG8_LDB(B1, 0, 1); PG8_SCHED; PG8_LDA(At, 0, 0); PG8_STAGE(PG8_SA(1, 1), a1 + hstepA, vC1);
            PG8_WAIT_V(8); PG8_WAIT_L(0); PG8_BAR; PG8_MMA(0, 0, At, B0); PG8_MMA(0, 1, At, B1); PG8_BAR; PG8_SCHED;
            PG8_LDA(At, 0, 1); PG8_STAGE(PG8_SB(0, 0), b2, voffB); PG8_STAGE(PG8_SB(0, 1), b2 + hstep, voffB); PG8_STAGE(PG8_SA(0, 0), a2, vX0);
            PG8_WAIT_V(8); PG8_WAIT_L(0); PG8_BAR; PG8_MMA(1, 0, At, B0); PG8_MMA(1, 1, At, B1); PG8_BAR; PG8_SCHED;
            PG8_LDB(B0, 1, 0); PG8_LDB(B1, 1, 1); PG8_SCHED; PG8_LDA(At, 1, 0); PG8_STAGE(PG8_SA(0, 1), a2 + hstepA, vX1);
            PG8_WAIT_V(8); PG8_WAIT_L(0); PG8_BAR; PG8_MMA(0, 0, At, B0); PG8_MMA(0, 1, At, B1); PG8_BAR; PG8_SCHED;
            PG8_LDA(At, 1, 1); PG8_STAGE(PG8_SB(1, 0), b3, voffB); PG8_STAGE(PG8_SB(1, 1), b3 + hstep, voffB); PG8_STAGE(PG8_SA(1, 0), a3, vX0);
            PG8_WAIT_V(8); PG8_WAIT_L(0); PG8_BAR; PG8_MMA(1, 0, At, B0); PG8_MMA(1, 1, At, B1); PG8_BAR; PG8_SCHED;
        }
        if constexpr (ALIGN_EPI) { if (wr == 0) PG8_BAR; }
        E(acc, cur, wr, wc, fr, fq);
        if (!has_next) break;
        E.init(acc, nxt, wc, fq);
        cur = nxt; cA = nA; cB = nB; ++ui;
        if constexpr (GATHER) {
#pragma unroll
            for (int i = 0; i < 2; ++i) { vC0[i] = vN0[i]; vC1[i] = vN1[i]; } }
        if constexpr (ALIGN_EPI) { if (wr == 1) PG8_BAR; }
    }
    PG8_WAIT_V(0);
    if constexpr (!ALIGN_EPI) { if (wr == 0) PG8_BAR; }
    PG8_BAR;
#undef PG8_GOFFS
#undef PG8_HALF0
#undef PG8_HALF1
#undef PG8_SA
#undef PG8_SB
#undef PG8_STAGE
#undef PG8_LDA
#undef PG8_LDB
#undef PG8_MMA
#undef PG8_WAIT_V
#undef PG8_WAIT_L
#undef PG8_BAR
#undef PG8_SCHED
}

struct EpiF32 {
    static constexpr bool PERM = false;
    float* C; int ldc;
    __device__ __forceinline__ void operator()(const f32x4 (&acc)[2][2][4][2], const Unit& u, int wr, int wc, int fr, int fq) const {
        const int row0 = u.pa * BM + wr * 64 + fr, col0 = u.pn * BM + wc * 32 + 4 * fq;
#pragma unroll
        for (int ai = 0; ai < 2; ++ai)
#pragma unroll
            for (int m = 0; m < 4; ++m) { float* rowp = C + (size_t)(row0 + ai * HALF + m * 16) * ldc + col0;
#pragma unroll
                for (int bj = 0; bj < 2; ++bj)
#pragma unroll
                    for (int n = 0; n < 2; ++n) *(f32x4*)(rowp + bj * HALF + n * 16) = acc[ai][bj][m][n]; }
    }
};
struct EpiBf16 {
    static constexpr bool PERM = true;
    bf16_t* O; int ldc; const float* bias; int bias_stride;
    __device__ __forceinline__ void init(f32x4 (&acc)[2][2][4][2], const Unit& u, int wc, int fq) const {
        const int col0 = u.pn * BM + wc * 32 + 8 * fq;
#pragma unroll
        for (int bj = 0; bj < 2; ++bj)
#pragma unroll
            for (int n = 0; n < 2; ++n) { const f32x4 bv = bias ? *(const f32x4*)(bias + (size_t)u.e * bias_stride + col0 + bj * HALF + 4 * n) : (f32x4){0.f, 0.f, 0.f, 0.f};
#pragma unroll
                for (int ai = 0; ai < 2; ++ai)
#pragma unroll
                    for (int m = 0; m < 4; ++m) acc[ai][bj][m][n] = bv; }
    }
    __device__ __forceinline__ void operator()(const f32x4 (&acc)[2][2][4][2], const Unit& u, int wr, int wc, int fr, int fq) const {
        const int row0 = u.pa * BM + wr * 64 + fr; const int col0 = u.pn * BM + wc * 32 + 8 * fq;
#pragma unroll
        for (int ai = 0; ai < 2; ++ai)
#pragma unroll
            for (int m = 0; m < 4; ++m) { bf16_t* rowp = O + (size_t)(row0 + ai * HALF + m * 16) * ldc + col0;
#pragma unroll
                for (int bj = 0; bj < 2; ++bj) { const f32x4 v0 = acc[ai][bj][m][0], v1 = acc[ai][bj][m][1];
                    u32x4 w; w.x = pk_bf16(v0[0], v0[1]); w.y = pk_bf16(v0[2], v0[3]); w.z = pk_bf16(v1[0], v1[1]); w.w = pk_bf16(v1[2], v1[3]);
                    *(u32x4*)(rowp + bj * HALF) = w; } }
    }
};
struct EpiAct {
    static constexpr bool PERM = true;
    unsigned char* O; const float* bias;
    __device__ __forceinline__ void init(f32x4 (&acc)[2][2][4][2], const Unit& u, int wc, int fq) const {
        const float* bg = bias + (size_t)u.e * 2048 + u.pn * 128 + wc * 32 + 8 * fq;
#pragma unroll
        for (int bj = 0; bj < 2; ++bj)
#pragma unroll
            for (int n = 0; n < 2; ++n) { const f32x4 bv = *(const f32x4*)(bg + bj * 1024 + 4 * n);
#pragma unroll
                for (int ai = 0; ai < 2; ++ai)
#pragma unroll
                    for (int m = 0; m < 4; ++m) acc[ai][bj][m][n] = bv; }
    }
    __device__ __forceinline__ void operator()(const f32x4 (&acc)[2][2][4][2], const Unit& u, int wr, int wc, int fr, int fq) const {
        const int row0 = u.pa * BM + wr * 64 + fr; const int cc0 = wc * 32 + 8 * fq; const int ocol = u.pn * 128 + cc0;
#pragma unroll
        for (int ai = 0; ai < 2; ++ai)
#pragma unroll
            for (int m = 0; m < 4; ++m) { unsigned char* rowp = O + (size_t)(row0 + ai * HALF + m * 16) * D + ocol;
                float r[8];
#pragma unroll
                for (int n = 0; n < 2; ++n)
#pragma unroll
                    for (int j = 0; j < 4; ++j) { float gt = acc[ai][0][m][n][j], up = acc[ai][1][m][n][j];
                        gt = fminf(gt, 7.0f); up = fminf(fmaxf(up, -7.0f), 7.0f);
                        r[n * 4 + j] = gt / (1.0f + __expf(-1.702f * gt)) * (up + 1.0f); }
                u32x2 w; w.x = pk_fp8x4(r[0], r[1], r[2], r[3]); w.y = pk_fp8x4(r[4], r[5], r[6], r[7]);
                *(u32x2*)rowp = w; }
    }
};
struct SchedGrid {
    int nN, total, G, c;
    __device__ __forceinline__ bool next(int i, Unit& u) const { int Lx = i * G + c; if (Lx >= GEMM_REP * total) return false; if (GEMM_REP > 1) Lx %= total; u.pa = Lx / nN; u.pn = Lx - u.pa * nN; u.pb = u.pn; u.e = 0; return true; }
};
struct SchedMoe {
    int nN, total, G, c; const int* tile_e;
    __device__ __forceinline__ bool next(int i, Unit& u) const { int Lx = i * G + c; if (Lx >= GEMM_REP * total) return false; if (GEMM_REP > 1) Lx %= total; u.pa = Lx / nN; u.pn = Lx - u.pa * nN; u.e = __builtin_amdgcn_readfirstlane((int)tile_e[u.pa]); u.pb = u.e * nN + u.pn; return true; }
};
}

struct Args { const float* in[N_IN]; float* out; unsigned char* ws; int ph_lo, ph_hi; };

typedef const float* __attribute__((address_space(4))) const* kargp_t;
struct InProxy { kargp_t kp; __device__ __forceinline__ const float* operator[](int i) const { return kp[i]; } };
struct Frame {
    InProxy in; float* out; unsigned char* ws;
    LAS unsigned char* lds;
    int tid, lane, wave, G, bid, vid;
    template <class Tp> __device__ __forceinline__ Tp* w(size_t off) const { return (Tp*)(ws + off); }
};

__device__ __forceinline__ Frame launder(const Frame& F) {
    Frame R = F;
    int t = F.tid; asm volatile("" : "+v"(t)); R.tid = t; R.lane = t & 63; R.wave = __builtin_amdgcn_readfirstlane(t >> 6);
    unsigned long long w = (unsigned long long)F.ws; asm volatile("" : "+s"(w)); R.ws = (unsigned char*)w;
    unsigned long long o = (unsigned long long)F.out; asm volatile("" : "+s"(o)); R.out = (float*)o;
    unsigned long long k = (unsigned long long)F.in.kp; asm volatile("" : "+s"(k)); R.in.kp = (kargp_t)k;
    int g = F.G, b = F.bid; asm volatile("" : "+s"(g), "+s"(b)); R.G = g; R.bid = b; R.vid = (g % 8 == 0) ? (b % 8) * (g / 8) + b / 8 : b;
    return R;
}

__device__ __forceinline__ float mod_val(const Frame& F, int l, int which, int j) {
    const float* mp = F.w<float>(WS_MODP) + (size_t)((l * 2 + which) * 32) * 6144 + j;
    float s = F.in[I_BMOD][l * 6144 + j];
#pragma unroll
    for (int k = 0; k < 32; ++k) s += mp[(size_t)k * 6144];
    return s;
}

struct CvtTile { const float* src; bf16_t* dst; int ld, mode, k0, n0; bool f8; };
__device__ __forceinline__ CvtTile cvt_decode(const Frame& F, int t) {
    CvtTile c;
    if (t < 1664) { const int l = t / 832, r = t % 832; c.n0 = (r / 16) * 64; c.k0 = (r % 16) * 64; c.src = F.in[I_WIN] + (size_t)l * 1024 * 3212; c.ld = 3212; c.mode = 1; c.f8 = F8IN(l) != 0; c.dst = F.w<bf16_t>(WS_WINT) + (size_t)l * PC * D; }
    else if (t < 2176) { const int q = t - 1664, l = q / 256, r = q % 256; c.n0 = (r / 16) * 64; c.k0 = (r % 16) * 64; c.src = F.in[I_WOUT] + (size_t)l * D * D; c.ld = 1024; c.mode = 0; c.f8 = false; c.dst = F.w<bf16_t>(WS_WOUTT) + (size_t)l * D * D; }
    else if (t < 34944) { const int q = t - 2176, le = q / 512, r = q % 512; c.n0 = (r / 16) * 64; c.k0 = (r % 16) * 64; c.src = F.in[I_WGU] + (size_t)le * 1024 * 2048; c.ld = 2048; c.mode = 2; c.f8 = true; c.dst = (bf16_t*)(F.w<unsigned char>(WS_WGUT) + (size_t)le * 2048 * D); }
    else { const int q = t - 34944, le = q / 256, r = q % 256; c.n0 = (r / 16) * 64; c.k0 = (r % 16) * 64; c.src = F.in[I_WDN] + (size_t)le * D * D; c.ld = 1024; c.mode = 0; c.f8 = true; c.dst = (bf16_t*)(F.w<unsigned char>(WS_WDT) + (size_t)le * D * D); }
    return c;
}
__device__ __forceinline__ void cvt_load(const CvtTile& c, int lane, f32x4 (&a)[8], f32x4 (&b)[8]) {
    const int i4 = lane & 15, kpl = lane >> 4;
    const int n = c.n0 + 4 * i4;
    int sc; bool valid = true;
    if (c.mode == 0) sc = n;
    else if (c.mode == 1) { if (n < 1280) sc = n; else if (n < 3200) sc = n + 12; else if (n < 3212) sc = n - 3200 + 1280; else { sc = 0; valid = false; } }
    else { const int pn = n >> 8, rr = n & 255; sc = rr < 128 ? pn * 128 + rr : 1024 + pn * 128 + (rr - 128); }
#pragma unroll
    for (int it = 0; it < 8; ++it) {
        const int r0 = c.f8 ? 4 * (kpl + 4 * (it >> 1)) + 2 * (it & 1) : 2 * (kpl + 4 * it);
        a[it] = (f32x4){0.f, 0.f, 0.f, 0.f}; b[it] = a[it];
        if (valid) { a[it] = __builtin_nontemporal_load((const f32x4*)(c.src + (size_t)(c.k0 + r0) * c.ld + sc)); b[it] = __builtin_nontemporal_load((const f32x4*)(c.src + (size_t)(c.k0 + r0 + 1) * c.ld + sc)); }
    }
}
__device__ __forceinline__ void cvt_store(const CvtTile& c, int lane, const f32x4 (&a)[8], const f32x4 (&b)[8], LAS unsigned* lw) {
    const int i4 = lane & 15, kpl = lane >> 4;
    if (c.f8) {
#pragma unroll
        for (int j = 0; j < 4; ++j) {
            const int kq = kpl + 4 * j;
#pragma unroll
            for (int i = 0; i < 4; ++i) lw[kq * 65 + 4 * i4 + i] = pk_fp8x4(W8_SCALE * a[2 * j][i], W8_SCALE * b[2 * j][i], W8_SCALE * a[2 * j + 1][i], W8_SCALE * b[2 * j + 1][i]);
        }
        lds_fence();
        const int g = lane & 3, nl = lane >> 2;
        unsigned char* d8 = (unsigned char*)c.dst;
#pragma unroll
        for (int it = 0; it < 4; ++it) {
            const int nn = nl + 16 * it;
            u32x4 v; v.x = lw[(4 * g + 0) * 65 + nn]; v.y = lw[(4 * g + 1) * 65 + nn]; v.z = lw[(4 * g + 2) * 65 + nn]; v.w = lw[(4 * g + 3) * 65 + nn];
            *(u32x4*)(d8 + (size_t)(c.n0 + nn) * 1024 + c.k0 + 16 * g) = v;
        }
        lds_fence();
        return;
    }
#pragma unroll
    for (int it = 0; it < 8; ++it) {
        const int kp = kpl + 4 * it;
#pragma unroll
        for (int i = 0; i < 4; ++i) lw[kp * 65 + 4 * i4 + i] = pk_bf16(a[it][i], b[it][i]);
    }
    lds_fence();
    const int g = lane & 7, nl = lane >> 3;
#pragma unroll
    for (int it = 0; it < 8; ++it) {
        const int nn = nl + 8 * it;
        u32x4 v; v.x = lw[(4 * g + 0) * 65 + nn]; v.y = lw[(4 * g + 1) * 65 + nn]; v.z = lw[(4 * g + 2) * 65 + nn]; v.w = lw[(4 * g + 3) * 65 + nn];
        *(u32x4*)(c.dst + (size_t)(c.n0 + nn) * 1024 + c.k0 + 8 * g) = v;
    }
    lds_fence();
}

__device__ __forceinline__ void cvt_store8x2(const CvtTile& c, int lane, const f32x4 (&a0)[8], const f32x4 (&b0)[8], const f32x4 (&a1)[8], const f32x4 (&b1)[8], LAS unsigned* lw) {
    const int i4 = lane & 15, kpl = lane >> 4;
#pragma unroll
    for (int j = 0; j < 4; ++j) {
        const int kq = kpl + 4 * j;
#pragma unroll
        for (int i = 0; i < 4; ++i) {
            lw[kq * 65 + 4 * i4 + i] = pk_fp8x4(W8_SCALE * a0[2 * j][i], W8_SCALE * b0[2 * j][i], W8_SCALE * a0[2 * j + 1][i], W8_SCALE * b0[2 * j + 1][i]);
            lw[(16 + kq) * 65 + 4 * i4 + i] = pk_fp8x4(W8_SCALE * a1[2 * j][i], W8_SCALE * b1[2 * j][i], W8_SCALE * a1[2 * j + 1][i], W8_SCALE * b1[2 * j + 1][i]);
        }
    }
    lds_fence();
    const int g = lane & 7, nl = lane >> 3;
    unsigned char* d8 = (unsigned char*)c.dst;
#pragma unroll
    for (int it = 0; it < 8; ++it) {
        const int nn = nl + 8 * it;
        u32x4 v; v.x = lw[(4 * g + 0) * 65 + nn]; v.y = lw[(4 * g + 1) * 65 + nn]; v.z = lw[(4 * g + 2) * 65 + nn]; v.w = lw[(4 * g + 3) * 65 + nn];
        *(u32x4*)(d8 + (size_t)(c.n0 + nn) * 1024 + c.k0 + 16 * g) = v;
    }
    lds_fence();
}
__device__ __forceinline__ void ph_convert(const Frame& F) {
    LAS unsigned* lw = (LAS unsigned*)(F.lds) + F.wave * (32 * 65 + 16);
    const int nwaves = F.G * 8, w0 = F.bid * 8 + F.wave;
    f32x4 a0[8], b0[8], a1[8], b1[8];
    for (int t = w0; t < 2176; t += nwaves) { const CvtTile c = cvt_decode(F, t); cvt_load(c, F.lane, a0, b0); cvt_store(c, F.lane, a0, b0, lw); }
    unsigned* ctr = F.w<unsigned>(WS_CTL) + CW_CVQ;
    for (;;) {
        unsigned tb = 0;
        if (F.lane == 0) tb = atomicAdd(ctr, 4u);
        tb = __builtin_amdgcn_readfirstlane(tb);
        if (tb >= 16384u + 8192u) break;
        for (int t = (int)tb; t < (int)tb + 4; ++t) {
            CvtTile c; c.f8 = true;
            if (t < 16384) { const int le = t >> 8, r = t & 255; c.n0 = (r >> 3) * 64; c.k0 = (r & 7) * 128; c.src = F.in[I_WGU] + (size_t)le * 1024 * 2048; c.ld = 2048; c.mode = 2; c.dst = (bf16_t*)(F.w<unsigned char>(WS_WGUT) + (size_t)le * 2048 * D); }
            else { const int q = t - 16384, le = q >> 7, r = q & 127; c.n0 = (r >> 3) * 64; c.k0 = (r & 7) * 128; c.src = F.in[I_WDN] + (size_t)le * D * D; c.ld = 1024; c.mode = 0; c.dst = (bf16_t*)(F.w<unsigned char>(WS_WDT) + (size_t)le * D * D); }
            cvt_load(c, F.lane, a0, b0);
            CvtTile c2 = c; c2.k0 = c.k0 + 64;
            cvt_load(c2, F.lane, a1, b1);
            cvt_store8x2(c, F.lane, a0, b0, a1, b1, lw);
        }
    }
}

__device__ __forceinline__ void ph_modpart(const Frame& F) {
    for (int it = F.bid; it < 768; it += F.G) {
        const int l = it / 384, r = it % 384, cc = r / 32, kc = r % 32;
        const int j = cc * 512 + F.tid;
        const float* wm = F.in[I_WMOD] + (size_t)l * D * 6144 + (size_t)(kc * 32) * 6144 + j;
        float wv[32];
#pragma unroll
        for (int k = 0; k < 32; ++k) wv[k] = wm[(size_t)k * 6144];
        float a0 = 0.f, a1 = 0.f;
#pragma unroll
        for (int k = 0; k < 32; ++k) { a0 += silu_f(F.in[I_C][kc * 32 + k]) * wv[k]; a1 += silu_f(F.in[I_CCTX][kc * 32 + k]) * wv[k]; }
        float* mp = F.w<float>(WS_MODP);
        mp[(size_t)((l * 2 + 0) * 32 + kc) * 6144 + j] = a0;
        mp[(size_t)((l * 2 + 1) * 32 + kc) * 6144 + j] = a1;
    }
}

__device__ __forceinline__ void ph_filter(const Frame& F) {
    LAS float* zs = (LAS float*)F.lds;
    LAS float* h1 = zs + 64 * 33;
    LAS unsigned char* H2b = F.lds + 24832;
    LAS unsigned char* ob = F.lds + 34048;
    LAS float* w1s = (LAS float*)(F.lds + 68864);
    LAS float* w2s = w1s + 33 * 64;
    const float min_decay = -4.605170185988091f / 1.5f, max_decay = -4.605170185988091f / 0.3f;
    const int wave = F.wave;
    if (F.bid >= PRO_NF) return;
    for (int it = F.bid; it < 512 + 16; it += PRO_NF) {
        int tid = F.tid; asm volatile("" : "+v"(tid));
        const int lane = tid & 63;
        const bool isctx = it >= 512;
        const int l = isctx ? 0 : it / 256, grp = isctx ? it - 512 : it % 256;
        const int Lx = isctx ? LC : L, npos = isctx ? 16 : 64;
        const int t0 = grp * npos;
        __syncthreads();
        for (int q = tid; q < 33 * 64 + 64 * 64; q += NTHREADS) { if (q < 33 * 64) w1s[q] = F.in[I_FW1][(size_t)l * 33 * 64 + q]; else w2s[q - 33 * 64] = F.in[I_FW2][(size_t)l * 64 * 64 + q - 33 * 64]; }
#pragma unroll 1
        for (int q = tid; q < npos * 33; q += NTHREADS) {
            const int pos = q / 33, i = q % 33; const int t = t0 + pos;
            const float tn = (float)t / (float)(Lx - 1);
            const float wv = 6.283185307179586f * (float)t / (float)Lx;
            float v;
            if (i == 0) v = tn;
            else { const int b = (i - 1) & 15; const float f = 1e-4f + (float)b * ((15.0f - 1e-4f) / 15.0f); v = (i <= 16) ? cosf(f * wv) : -sinf(f * wv); }
            zs[q] = v;
        }
        __syncthreads();
        {
            asm volatile("" : "+v"(tid));
            const int o = tid & 63, pg = tid >> 6;
            if (pg * 8 < npos) {
                float acc[8];
                const float bb = F.in[I_FB1][l * 64 + o];
#pragma unroll
                for (int p = 0; p < 8; ++p) acc[p] = bb;
#pragma unroll 3
                for (int i = 0; i < 33; ++i) { const float w = w1s[i * 64 + o];
#pragma unroll
                    for (int p = 0; p < 8; ++p) acc[p] += zs[(pg * 8 + p) * 33 + i] * w; }
                const float fq = F.in[I_FREQ][l * 128 + o];
#pragma unroll
                for (int p = 0; p < 8; ++p) h1[(pg * 8 + p) * 64 + o] = sinf(fq * acc[p]);
            }
        }
        __syncthreads();
        {
            asm volatile("" : "+v"(tid));
            const int o = tid & 63, pg = tid >> 6;
            if (pg * 8 < npos) {
                float acc[8];
                const float bb = F.in[I_FB2][l * 64 + o];
#pragma unroll
                for (int p = 0; p < 8; ++p) acc[p] = bb;
#pragma unroll 4
                for (int i = 0; i < 64; ++i) { const float w = w2s[i * 64 + o];
#pragma unroll
                    for (int p = 0; p < 8; ++p) acc[p] += h1[(pg * 8 + p) * 64 + i] * w; }
                const float fq = F.in[I_FREQ][l * 128 + 64 + o];
#pragma unroll
                for (int p = 0; p < 8; ++p) *(LAS bf16_t*)(H2b + (pg * 8 + p) * 144 + o * 2) = f2bf(sinf(fq * acc[p]));
            }
        }
        __syncthreads();
        {
            int r = lane & 31, hf = lane >> 5;
#pragma unroll
            for (int n = 0; n < 2; ++n) {
                asm volatile("" : "+v"(r), "+v"(hf));
                const int o = 32 * (2 * wave + n) + r, c = o & 255, dir = o >> 8;
                const float* w3 = F.in[I_FW3] + (size_t)l * 64 * 512 + o;
                f32x16 acc[2];
#pragma unroll
                for (int m = 0; m < 2; ++m)
#pragma unroll
                    for (int i = 0; i < 16; ++i) acc[m][i] = 0.f;
                float wv[4][8];
#pragma unroll
                for (int ks = 0; ks < 4; ++ks)
#pragma unroll
                    for (int e = 0; e < 8; ++e) wv[ks][e] = w3[(size_t)(16 * ks + 8 * hf + e) * 512];
#pragma unroll
                for (int ks = 0; ks < 4; ++ks) {
                    bf16x8 b;
#pragma unroll
                    for (int e = 0; e < 8; ++e) b[e] = (short)f2bf(wv[ks][e]);
#pragma unroll
                    for (int m = 0; m < 2; ++m) {
                        const bf16x8 a = *(const LAS bf16x8*)(H2b + (32 * m + r) * 144 + (16 * ks + 8 * hf) * 2);
                        acc[m] = __builtin_amdgcn_mfma_f32_32x32x16_bf16(a, b, acc[m], 0, 0, 0);
                    }
                }
                const float delta = fabsf(min_decay + (float)c * ((max_decay - min_decay) / 255.0f));
                const float dstep = delta / (float)(Lx - 1);
                float asum = 0.f;
                if (!isctx) {
#pragma unroll
                    for (int m = 0; m < 2; ++m)
#pragma unroll
                        for (int rg = 0; rg < 16; ++rg) {
                            const int pos = 32 * m + (rg & 3) + 8 * (rg >> 2) + 4 * hf;
                            const float v = acc[m][rg] * __expf(-(float)(t0 + pos) * dstep);
                            asum += fabsf(v);
                            ob[o * 68 + pos] = (unsigned char)(pk_fp8x4(KR_SCALE * v, 0.f, 0.f, 0.f) & 0xFFu);
                        }
                } else {
                    float* kc = F.w<float>(WS_KCOMBC);
#pragma unroll
                    for (int rg = 0; rg < 8; ++rg) {
                        const int pos = (rg & 3) + 8 * (rg >> 2) + 4 * hf, t = t0 + pos;
                        const float v = acc[0][rg] * __expf(-(float)t * dstep);
                        asum += fabsf(v);
                        const int x = dir == 0 ? Lx - 1 + t : Lx - 1 - t;
                        if (dir == 0 || t >= 1) kc[(size_t)x * 256 + c] = v;
                    }
                }
                asum += __shfl_xor(asum, 32);
                if (hf == 0) { if (isctx) F.w<float>(WS_FPARTC)[grp * 512 + o] = asum; else F.w<float>(WS_FPART)[((size_t)l * 256 + grp) * 512 + o] = asum; }
            }
        }
        if (!isctx) {
            __syncthreads();
            unsigned char* KR = F.w<unsigned char>(WS_KR) + (size_t)l * 256 * KRL;
            asm volatile("" : "+v"(tid));
            for (int q = tid; q < 512 * 64; q += NTHREADS) {
                const int o = q >> 6, p = q & 63, c = o & 255, dir = o >> 8;
                if (dir == 0) KR[(size_t)c * KRL + (L - t0 - 63 + p)] = ob[o * 68 + 63 - p];
                else if (t0 + p >= 1) KR[(size_t)c * KRL + (L + t0 + p)] = ob[o * 68 + p];
            }
            if (grp == 0) for (int q = tid; q < 256 * 513; q += NTHREADS) { const int c = q / 513, r = q % 513; KR[(size_t)c * KRL + (r == 512 ? 0 : 2 * L + r)] = 0; }
        }
    }
}

__device__ __forceinline__ void ph_fsum(const Frame& F) {
    const int nwaves = F.G * 8;
    for (int o = F.bid * 8 + F.wave; o < 768; o += nwaves) {
        const int which = o >> 8, c = o & 255;
        float s = 0.f;
        if (which < 2) { const float* fp = F.w<float>(WS_FPART) + (size_t)which * 256 * 512;
            for (int i = F.lane; i < 256; i += 64) s += fp[(size_t)i * 512 + c] + fp[(size_t)i * 512 + 256 + c]; }
        else { const float* fp = F.w<float>(WS_FPARTC); if (F.lane < 16) s = fp[F.lane * 512 + c] + fp[F.lane * 512 + 256 + c]; }
        s = wave_sum(s);
        if (F.lane == 0) F.w<float>(WS_FSUM)[o] = 1.0f / s;
    }
}

__device__ __forceinline__ void ph_vecs(const Frame& F) {
    for (int q = F.bid * NTHREADS + F.tid; q < 2 * 2 * 6 * 1024; q += F.G * NTHREADS) {
        const int j = q & 1023, k = (q >> 10) % 6, which = ((q >> 10) / 6) & 1, l = (q >> 10) / 12;
        const float* ng = F.in[I_NORMG] + (size_t)l * 4 * 1024;
        float v;
        if (k == 0) v = ng[j] * (1.0f + mod_val(F, l, which, 1 * 1024 + j));
        else if (k == 1) v = mod_val(F, l, which, j);
        else if (k == 2) v = ng[1024 + j] * mod_val(F, l, which, 2 * 1024 + j);
        else if (k == 3) v = ng[2048 + j] * (1.0f + mod_val(F, l, which, 4 * 1024 + j));
        else if (k == 4) v = mod_val(F, l, which, 3 * 1024 + j);
        else v = ng[3072 + j] * mod_val(F, l, which, 5 * 1024 + j);
        F.w<float>(WS_VECS)[q] = v;
    }
}
__device__ __forceinline__ const float* vecs_ptr(const Frame& F, int l, int which, int k) { return F.w<float>(WS_VECS) + (size_t)((l * 2 + which) * 6 + k) * 1024; }

__device__ __forceinline__ void load_row(const float* p, int lane, f32x4 (&v)[4]) {
#pragma unroll
    for (int i = 0; i < 4; ++i) v[i] = *(const f32x4*)(p + 4 * lane + 256 * i);
}
__device__ __forceinline__ float row_rstd(const f32x4 (&v)[4]) {
    float s = 0.f;
#pragma unroll
    for (int i = 0; i < 4; ++i) s += v[i][0] * v[i][0] + v[i][1] * v[i][1] + v[i][2] * v[i][2] + v[i][3] * v[i][3];
    s = wave_sum(s);
    return rsqrtf(s * (1.0f / 1024.0f) + RMS_EPS);
}
__device__ __forceinline__ void stage_norm_vecs(const Frame& F, int l, int gain_idx, int sh_seg, int sc_seg, LAS float* dst  ) {
    for (int q = F.tid; q < 2048; q += NTHREADS) {
        const int which = q >> 10, j = q & 1023;
        const float g = F.in[I_NORMG][(l * 4 + gain_idx) * 1024 + j];
        dst[(which * 2 + 0) * 1024 + j] = g * (1.0f + mod_val(F, l, which, sc_seg * 1024 + j));
        dst[(which * 2 + 1) * 1024 + j] = mod_val(F, l, which, sh_seg * 1024 + j);
    }
}
__device__ __forceinline__ void norm_store_bf16(const f32x4 (&v)[4], float rstd, const LAS float* va, const LAS float* vb, bf16_t* orow, int lane, bool f8 = false) {
#pragma unroll
    for (int i = 0; i < 4; ++i) {
        const int c = 4 * lane + 256 * i;
        const f32x4 a = *(const LAS f32x4*)(va + c), b = *(const LAS f32x4*)(vb + c);
        if (f8) { *(unsigned*)((unsigned char*)orow + c) = pk_fp8x4(v[i][0] * rstd * a[0] + b[0], v[i][1] * rstd * a[1] + b[1], v[i][2] * rstd * a[2] + b[2], v[i][3] * rstd * a[3] + b[3]); }
        else { u32x2 w; w.x = pk_bf16(v[i][0] * rstd * a[0] + b[0], v[i][1] * rstd * a[1] + b[1]); w.y = pk_bf16(v[i][2] * rstd * a[2] + b[2], v[i][3] * rstd * a[3] + b[3]);
        *(u32x2*)(orow + c) = w; }
    }
}
__device__ __forceinline__ const float* xrow_ptr(const Frame& F, int l, int row) {
    if (l == 0) return row < L ? F.in[I_X] + (size_t)row * D : F.in[I_CTX] + (size_t)(row - L) * D;
    return F.w<float>(WS_XCUR) + (size_t)row * D;
}
__device__ __forceinline__ void load_xrow(const Frame& F, int l, int row, int lane, f32x4 (&v)[4]) {
    if (l == 0) { load_row(row < L ? F.in[I_X] + (size_t)row * D : F.in[I_CTX] + (size_t)(row - L) * D, lane, v); return; }
    const bf16_t* p = F.w<bf16_t>(WS_XCUR) + (size_t)row * D;
#pragma unroll
    for (int i = 0; i < 4; ++i) { const u32x2 w = *(const u32x2*)(p + 4 * lane + 256 * i); v[i] = (f32x4){bflo(w.x), bfhi(w.x), bflo(w.y), bfhi(w.y)}; }
}
__device__ __forceinline__ void store_xrow_bf16(bf16_t* p, int lane, const f32x4 (&v)[4]) {
#pragma unroll
    for (int i = 0; i < 4; ++i) { u32x2 w; w.x = pk_bf16(v[i][0], v[i][1]); w.y = pk_bf16(v[i][2], v[i][3]); *(u32x2*)(p + 4 * lane + 256 * i) = w; }
}
__device__ __forceinline__ void ph_norm1(const Frame& F, int l) {
    LAS float* vec = (LAS float*)F.lds;
    __syncthreads();
    stage_norm_vecs(F, l, 0, 0, 1, vec);
    __syncthreads();
    const int nwaves = F.G * 8;
    for (int row = F.bid * 8 + F.wave; row < T; row += nwaves) {
        const int which = row >= L;
        f32x4 v[4]; load_row(xrow_ptr(F, l, row), F.lane, v);
        const float rstd = row_rstd(v);
        norm_store_bf16(v, rstd, vec + (which * 2) * 1024, vec + (which * 2 + 1) * 1024, F8IN(0) ? (bf16_t*)(F.w<unsigned char>(WS_HB) + (size_t)row * D) : F.w<bf16_t>(WS_HB) + (size_t)row * D, F.lane, F8IN(0) != 0);
    }
}

constexpr int SROW = 272;
__device__ __forceinline__ bf16x8 lds_frag(const LAS unsigned char* base, int row, int k) { return *(const LAS bf16x8*)(base + row * SROW + k * 2); }
__device__ __forceinline__ void ph_ssd_prep(const Frame& F, int l) {
    LAS unsigned char* BT = F.lds;
    LAS unsigned char* XW = F.lds + 34816;
    LAS float* dts = (LAS float*)(F.lds + 139264);
    LAS float* wj  = dts + 768;
    const bf16_t* P = F.w<bf16_t>(WS_P);
    const int lane = F.lane, wave = F.wave;
    for (int it = F.bid; it < NCH * 2; it += F.G) {
        const int ch = it >> 1, g = it & 1;
        const int row0 = ch * 128;
        const int seq_lo = ch < 128 ? 0 : L, seq_hi = ch < 128 ? L : T;
        int r = lane & 31, hf = lane >> 5; asm volatile("" : "+v"(r), "+v"(hf));
        __syncthreads();
        if (wave < 6) {
            const int hh = wave >> 1, dir = wave & 1, h = g * 3 + hh;
            const float a = -__expf(F.in[I_ALOG][(l * 2 + dir) * 6 + h]), bias = F.in[I_DTB][(l * 2 + dir) * 6 + h];
            const int j0 = 2 * lane;
            const float d0 = softplus_f(bf2f(P[(size_t)(row0 + j0) * PC + CDT + dir * 6 + h]) + bias);
            const float d1 = softplus_f(bf2f(P[(size_t)(row0 + j0 + 1) * PC + CDT + dir * 6 + h]) + bias);
            const float pair = (d0 + d1) * a;
            float incl = pair;
#pragma unroll
            for (int o = 1; o < 64; o <<= 1) {
                const float v = dir == 0 ? __shfl_up(incl, o) : __shfl_down(incl, o);
                const bool okl = dir == 0 ? (lane >= o) : (lane + o < 64);
                if (okl) incl += v;
            }
            const float total = __shfl(incl, dir == 0 ? 63 : 0);
            float acs0, acs1;
            if (dir == 0) { acs1 = incl; acs0 = incl - d1 * a; }
            else { acs0 = incl; acs1 = incl - d0 * a; }
            float* dtv = F.w<float>(WS_DTV) + (size_t)(row0 + j0) * 12 + dir * 6 + h; dtv[0] = d0; dtv[12] = d1;
            float* acv = F.w<float>(WS_ACS) + (size_t)(row0 + j0) * 12 + dir * 6 + h; acv[0] = acs0; acv[12] = acs1;
            if (lane == 0) F.w<float>(WS_ALAST)[ch * 12 + dir * 6 + h] = total;
            dts[wave * 128 + j0] = d0; dts[wave * 128 + j0 + 1] = d1;
            wj[wave * 128 + j0] = __expf(total - acs0) * d0; wj[wave * 128 + j0 + 1] = __expf(total - acs1) * d1;
        }
        __syncthreads();
        if (F.tid < 448) {
            const int pr = F.tid % 224, half = F.tid / 224;
            const int chn = pr < 96 ? g * 192 + 2 * pr : (pr < 160 ? 384 + g * 128 + 2 * (pr - 96) : 640 + g * 128 + 2 * (pr - 160));
            const float* cw = F.in[I_SCW] + (size_t)l * 5 * 896 + chn; const float* cb = F.in[I_SCB] + (size_t)l * 896 + chn;
            float w0[5], w1[5];
#pragma unroll
            for (int k = 0; k < 5; ++k) { w0[k] = cw[k * 896]; w1[k] = cw[k * 896 + 1]; }
            const float b0 = cb[0], b1 = cb[1];
            const int jb = half * 64;
            const bf16_t* src = P + CXBC + chn;
            unsigned win[12];
#pragma unroll
            for (int k = 0; k < 4; ++k) { const int rr = row0 + jb + k - 2; win[k] = (rr >= seq_lo && rr < seq_hi) ? *(const unsigned*)(src + (size_t)rr * PC) : 0u; }
            const int hh = pr / 32;
            const int pch = 2 * (pr & 31);
            for (int jg = 0; jg < 64; jg += 8) {
#pragma unroll
                for (int k = 0; k < 8; ++k) { const int rr = row0 + jb + jg + k + 2; win[4 + k] = (rr >= seq_lo && rr < seq_hi) ? *(const unsigned*)(src + (size_t)rr * PC) : 0u; }
                float s0[8], s1[8];
#pragma unroll
                for (int u = 0; u < 8; ++u) {
                    float a0 = b0, a1 = b1;
#pragma unroll
                    for (int k = 0; k < 5; ++k) { a0 += w0[k] * bflo(win[u + k]); a1 += w1[k] * bfhi(win[u + k]); }
                    s0[u] = silu_f(a0); s1[u] = silu_f(a1);
                    *(unsigned*)(F.w<bf16_t>(WS_XBC) + (size_t)(row0 + jb + jg + u) * 896 + chn) = pk_bf16(s0[u], s1[u]);
                }
#pragma unroll
                for (int k = 0; k < 4; ++k) win[k] = win[8 + k];
#pragma unroll
                for (int u = 0; u < 8; u += 2) {
                    const int j = jb + jg + u;
                    if (pr < 96) {
#pragma unroll
                        for (int dir = 0; dir < 2; ++dir) {
                            const float wa = wj[(hh * 2 + dir) * 128 + j], wb = wj[(hh * 2 + dir) * 128 + j + 1];
                            LAS unsigned char* d = XW + ((hh * 2 + dir) * 64 + pch) * SROW + j * 2;
                            *(LAS unsigned*)d = pk_bf16(s0[u] * wa, s0[u + 1] * wb);
                            *(LAS unsigned*)(d + SROW) = pk_bf16(s1[u] * wa, s1[u + 1] * wb);
                        }
                    } else if (pr < 160) {
                        LAS unsigned char* d = BT + (2 * (pr - 96)) * SROW + j * 2;
                        *(LAS unsigned*)d = pk_bf16(s0[u], s0[u + 1]);
                        *(LAS unsigned*)(d + SROW) = pk_bf16(s1[u], s1[u + 1]);
                    }
                }
            }
        }
        __syncthreads();
        {
            const int nt = wave & 3, pt = wave >> 2;
#pragma unroll 1
            for (int hh = 0; hh < 3; ++hh) {
                const int h = g * 3 + hh;
                f32x16 a0, a1;
#pragma unroll
                for (int i = 0; i < 16; ++i) { a0[i] = 0.f; a1[i] = 0.f; }
                const LAS unsigned char* X0 = XW + (hh * 2) * 64 * SROW;
#pragma unroll
                for (int ks = 0; ks < 8; ++ks) {
                    const bf16x8 a = lds_frag(BT, 32 * nt + r, 16 * ks + 8 * hf);
                    const bf16x8 b0 = lds_frag(X0, 32 * pt + r, 16 * ks + 8 * hf), b1 = lds_frag(X0, 64 + 32 * pt + r, 16 * ks + 8 * hf);
                    a0 = __builtin_amdgcn_mfma_f32_32x32x16_bf16(a, b0, a0, 0, 0, 0);
                    a1 = __builtin_amdgcn_mfma_f32_32x32x16_bf16(a, b1, a1, 0, 0, 0);
                }
                float* s0 = F.w<float>(WS_STATES) + ((size_t)(0 * NCH + ch) * 6 + h) * 8192 + (32 * pt + r) * 128 + 32 * nt + 4 * hf;
                float* s1 = F.w<float>(WS_STATES) + ((size_t)(1 * NCH + ch) * 6 + h) * 8192 + (32 * pt + r) * 128 + 32 * nt + 4 * hf;
#pragma unroll
                for (int gq = 0; gq < 4; ++gq) { *(f32x4*)(s0 + 8 * gq) = (f32x4){a0[4 * gq], a0[4 * gq + 1], a0[4 * gq + 2], a0[4 * gq + 3]};
                                                 *(f32x4*)(s1 + 8 * gq) = (f32x4){a1[4 * gq], a1[4 * gq + 1], a1[4 * gq + 2], a1[4 * gq + 3]}; }
            }
        }
    }
}

__device__ __forceinline__ void ph_ssd_scan(const Frame& F) {
    const int per = (98304 + F.G - 1) / F.G;
    for (int q = F.tid; q < per; q += NTHREADS) {
        const int id = F.bid * per + q;
        if (id >= 98304) break;
        const int dir = id / 49152, rem = id % 49152, h = rem / 8192, e = rem % 8192;
        const float* al = F.w<float>(WS_ALAST) + dir * 6 + h;
        const float* st = F.w<float>(WS_STATES) + ((size_t)(dir * NCH) * 6 + h) * 8192 + e;
        bf16_t* ss = F.w<bf16_t>(WS_SSTART) + ((size_t)(dir * NCH) * 6 + h) * 8192 + e;
        float sacc = 0.f;
        for (int s0 = 0; s0 < NCH; s0 += 26) {
            float sv[26], dv[26]; int cv[26];
#pragma unroll
            for (int u = 0; u < 26; ++u) {
                const int step = s0 + u;
                cv[u] = dir == 0 ? (step < 2 ? 128 + step : step - 2) : 129 - step;
                sv[u] = st[(size_t)cv[u] * 6 * 8192]; dv[u] = al[cv[u] * 12];
            }
#pragma unroll
            for (int u = 0; u < 26; ++u) { ss[(size_t)cv[u] * 6 * 8192] = f2bf(sacc); sacc = sacc * __expf(dv[u]) + sv[u]; }
        }
    }
}

__device__ __forceinline__ void ph_ssd_out(const Frame& F, int l) {
    LAS unsigned char* Cs = F.lds;
    LAS unsigned char* Bs = F.lds + 34816;
    LAS unsigned char* XT = F.lds + 69632;
    LAS float* Yl = (LAS float*)F.lds;
    LAS float* af = (LAS float*)(F.lds + 98816);
    LAS float* ab = af + 384, *dtf = ab + 384, *dtb = dtf + 384;
    LAS float* red = dtb + 384;
    const bf16_t* XBC = F.w<bf16_t>(WS_XBC);
    const bf16_t* P = F.w<bf16_t>(WS_P);
    const int nch = (l == 0) ? NCH : 128;
    const int lane = F.lane, wave = F.wave, r_in = lane & 31, hf_in = lane >> 5;
    const int it_ = wave & 3, jp = wave >> 2;
    for (int it = F.bid; it < nch * 2; it += F.G) {
        const int ch = it >> 1, g = it & 1, row0 = ch * 128;
        int r = r_in, hf = hf_in; asm volatile("" : "+v"(r), "+v"(hf));
        __syncthreads();
        for (int q = F.tid; q < 128 * 16; q += NTHREADS) {
            const int row = q >> 4, piece = q & 15;
            const bf16_t* src = XBC + (size_t)(row0 + row) * 896 + g * 128 + piece * 8;
            *(LAS u32x4*)(Bs + row * SROW + piece * 16) = *(const u32x4*)(src + 384);
            *(LAS u32x4*)(Cs + row * SROW + piece * 16) = *(const u32x4*)(src + 640);
        }
        for (int q = F.tid; q < 768; q += NTHREADS) {
            const int dir = q / 384, rr = q % 384, hh = rr >> 7, j = rr & 127;
            (dir ? ab : af)[hh * 128 + j] = F.w<float>(WS_ACS)[(size_t)(row0 + j) * 12 + dir * 6 + g * 3 + hh];
            (dir ? dtb : dtf)[hh * 128 + j] = F.w<float>(WS_DTV)[(size_t)(row0 + j) * 12 + dir * 6 + g * 3 + hh];
        }
        __syncthreads();
        f32x16 G0, G1;
#pragma unroll
        for (int i = 0; i < 16; ++i) { G0[i] = 0.f; G1[i] = 0.f; }
#pragma unroll
        for (int ks = 0; ks < 8; ++ks) {
            const bf16x8 a = lds_frag(Cs, 32 * it_ + r, 16 * ks + 8 * hf);
            const bf16x8 b0 = lds_frag(Bs, 64 * jp + r, 16 * ks + 8 * hf), b1 = lds_frag(Bs, 64 * jp + 32 + r, 16 * ks + 8 * hf);
            G0 = __builtin_amdgcn_mfma_f32_32x32x16_bf16(a, b0, G0, 0, 0, 0);
            G1 = __builtin_amdgcn_mfma_f32_32x32x16_bf16(a, b1, G1, 0, 0, 0);
        }
        f32x16 yacc[3];
#pragma unroll
        for (int hh = 0; hh < 3; ++hh) {
            const int h = g * 3 + hh;
            asm volatile("" : "+v"(r), "+v"(hf));
            __syncthreads();
#pragma unroll
            for (int tl = 0; tl < 2; ++tl) {
                const int j = 64 * jp + 32 * tl + r;
                const float afj = af[hh * 128 + j], abj = ab[hh * 128 + j], dfj = dtf[hh * 128 + j], dbj = dtb[hh * 128 + j];
#pragma unroll
                for (int rg = 0; rg < 16; ++rg) {
                    const int i = 32 * it_ + (rg & 3) + 8 * (rg >> 2) + 4 * hf;
                    const float mf = fminf(fmaxf((float)(i - j + 1), 0.f), 1.f), mb = fminf(fmaxf((float)(j - i + 1), 0.f), 1.f);
                    const float wf = __expf(fminf(af[hh * 128 + i] - afj, 0.f)) * dfj * mf;
                    const float wb = __expf(fminf(ab[hh * 128 + i] - abj, 0.f)) * dbj * mb;
                    const float gv = tl == 0 ? G0[rg] : G1[rg];
                    *(LAS bf16_t*)(Bs + i * SROW + j * 2) = f2bf(gv * (wf + wb));
                }
            }
            for (int q = F.tid; q < 128 * 8; q += NTHREADS) {
                const int j = q >> 3, pg = q & 7;
                const u32x4 v = *(const u32x4*)(XBC + (size_t)(row0 + j) * 896 + h * 64 + pg * 8);
                LAS unsigned char* d = XT + (pg * 8) * SROW + j * 2;
                *(LAS bf16_t*)(d + 0 * SROW) = (bf16_t)(v.x & 0xFFFF); *(LAS bf16_t*)(d + 1 * SROW) = (bf16_t)(v.x >> 16);
                *(LAS bf16_t*)(d + 2 * SROW) = (bf16_t)(v.y & 0xFFFF); *(LAS bf16_t*)(d + 3 * SROW) = (bf16_t)(v.y >> 16);
                *(LAS bf16_t*)(d + 4 * SROW) = (bf16_t)(v.z & 0xFFFF); *(LAS bf16_t*)(d + 5 * SROW) = (bf16_t)(v.z >> 16);
                *(LAS bf16_t*)(d + 6 * SROW) = (bf16_t)(v.w & 0xFFFF); *(LAS bf16_t*)(d + 7 * SROW) = (bf16_t)(v.w >> 16);
            }
            {
                f32x16 yF, yB;
#pragma unroll
                for (int i = 0; i < 16; ++i) { yF[i] = 0.f; yB[i] = 0.f; }
                const bf16_t* Sf = F.w<bf16_t>(WS_SSTART) + ((size_t)(0 * NCH + ch) * 6 + h) * 8192 + (32 * jp + r) * 128 + 8 * hf;
                const bf16_t* Sb = F.w<bf16_t>(WS_SSTART) + ((size_t)(1 * NCH + ch) * 6 + h) * 8192 + (32 * jp + r) * 128 + 8 * hf;
#pragma unroll 2
                for (int ks = 0; ks < 8; ++ks) {
                    const bf16x8 ac = lds_frag(Cs, 32 * it_ + r, 16 * ks + 8 * hf);
                    const bf16x8 bf_ = *(const bf16x8*)(Sf + 16 * ks), bb_ = *(const bf16x8*)(Sb + 16 * ks);
                    yF = __builtin_amdgcn_mfma_f32_32x32x16_bf16(ac, bf_, yF, 0, 0, 0);
                    yB = __builtin_amdgcn_mfma_f32_32x32x16_bf16(ac, bb_, yB, 0, 0, 0);
                }
#pragma unroll
                for (int rg = 0; rg < 16; ++rg) {
                    const int i = 32 * it_ + (rg & 3) + 8 * (rg >> 2) + 4 * hf;
                    yacc[hh][rg] = __expf(af[hh * 128 + i]) * yF[rg] + __expf(ab[hh * 128 + i]) * yB[rg];
                }
            }
            __syncthreads();
#pragma unroll 2
            for (int ks = 0; ks < 8; ++ks) {
                const bf16x8 aw = lds_frag(Bs, 32 * it_ + r, 16 * ks + 8 * hf), bx = lds_frag(XT, 32 * jp + r, 16 * ks + 8 * hf);
                yacc[hh] = __builtin_amdgcn_mfma_f32_32x32x16_bf16(aw, bx, yacc[hh], 0, 0, 0);
            }
        }
        __syncthreads();
#pragma unroll
        for (int hh = 0; hh < 3; ++hh)
#pragma unroll
            for (int rg = 0; rg < 16; ++rg) { const int i = 32 * it_ + (rg & 3) + 8 * (rg >> 2) + 4 * hf; Yl[i * 193 + hh * 64 + 32 * jp + r] = yacc[hh][rg]; }
        __syncthreads();
        const int i = F.tid & 127, pq = F.tid >> 7;
        float ssq = 0.f;
#pragma unroll 1
        for (int hh = 0; hh < 3; ++hh) {
            const int h = g * 3 + hh; const float dsk = F.in[I_SSDD][l * 6 + h];
            const int chn = h * 64 + pq * 16;
            const u32x4 xa = *(const u32x4*)(XBC + (size_t)(row0 + i) * 896 + chn), xb = *(const u32x4*)(XBC + (size_t)(row0 + i) * 896 + chn + 8);
            const u32x4 za = *(const u32x4*)(P + (size_t)(row0 + i) * PC + CZ + chn), zb = *(const u32x4*)(P + (size_t)(row0 + i) * PC + CZ + chn + 8);
            const unsigned xw_[8] = {xa.x, xa.y, xa.z, xa.w, xb.x, xb.y, xb.z, xb.w}, zw_[8] = {za.x, za.y, za.z, za.w, zb.x, zb.y, zb.z, zb.w};
            LAS float* yr = Yl + i * 193 + hh * 64 + pq * 16;
#pragma unroll
            for (int p2 = 0; p2 < 8; ++p2) {
                const float v0 = (yr[2 * p2] + dsk * bflo(xw_[p2])) * silu_f(bflo(zw_[p2]));
                const float v1 = (yr[2 * p2 + 1] + dsk * bfhi(xw_[p2])) * silu_f(bfhi(zw_[p2]));
                yr[2 * p2] = v0; yr[2 * p2 + 1] = v1; ssq += v0 * v0 + v1 * v1;
            }
        }
        red[pq * 128 + i] = ssq;
        __syncthreads();
        const float tot = red[i] + red[128 + i] + red[256 + i] + red[384 + i];
        const float rstd = rsqrtf(tot * (1.0f / 192.0f) + RMS_EPS);
#pragma unroll 1
        for (int hh = 0; hh < 3; ++hh) {
            const int h = g * 3 + hh;
            bf16_t* o = F.w<bf16_t>(WS_MIX) + (size_t)(row0 + i) * D + h * 64 + pq * 16;
            const float* ng = F.in[I_SSDNG] + l * 384 + h * 64 + pq * 16;
            const LAS float* yr = Yl + i * 193 + hh * 64 + pq * 16;
            unsigned wv[8];
#pragma unroll
            for (int p2 = 0; p2 < 8; ++p2) wv[p2] = pk_bf16(yr[2 * p2] * rstd * ng[2 * p2], yr[2 * p2 + 1] * rstd * ng[2 * p2 + 1]);
            *(u32x4*)o = (u32x4){wv[0], wv[1], wv[2], wv[3]}; *(u32x4*)(o + 8) = (u32x4){wv[4], wv[5], wv[6], wv[7]};
        }
    }
}

__device__ __forceinline__ int na_kv_off(int key, int piece) { return key * 128 + ((piece ^ (key & 7)) << 4); }
constexpr int NA_VP = 144;
__device__ __forceinline__ int na_v_off(int key, int piece) { return key * NA_VP + piece * 16; }
__device__ __forceinline__ void na_stage_kv(const Frame& F, const bf16_t* P, LAS unsigned char* Kd, LAS unsigned char* Vd, int h, bool local, int r0, int kc0) {
    for (int q = F.tid; q < 256 * 8; q += NTHREADS) {
        const int key = q >> 3, piece = q & 7;
        const int krow = local ? (r0 + (key >> 5)) * 64 + kc0 + (key & 31) : L + key;
        const bf16_t* src = P + (size_t)krow * PC + h * 64 + piece * 8;
        *(LAS u32x4*)(Kd + na_kv_off(key, piece)) = *(const u32x4*)(src + CK);
        *(LAS u32x4*)(Vd + na_v_off(key, piece)) = *(const u32x4*)(src + CV);
    }
}
__device__ __forceinline__ void bar_lds() { asm volatile("s_waitcnt lgkmcnt(0)" ::: "memory"); __builtin_amdgcn_s_barrier(); asm volatile("" ::: "memory"); }
struct NaItem { int h, r, cg, r0, kc0, qrow0; bool isctx; };
__device__ __forceinline__ NaItem na_item(int cid, int i_lo, int i_hi, int k) {
    NaItem t; t.isctx = (i_lo + k >= i_hi); t.r = 0; t.r0 = 0; t.kc0 = 0;
    if (!t.isctx) { const int it = i_lo + k; t.h = it >> 10; t.r = (it >> 2) & 255; t.cg = it & 3; t.r0 = min(max(t.r - 4, 0), 248); t.kc0 = min(max(16 * t.cg - 8, 0), 32); t.qrow0 = t.r * 64 + t.cg * 16; }
    else { t.h = cid >> 4; t.cg = cid & 15; t.qrow0 = L + t.cg * 16; }
    return t;
}
__device__ __forceinline__ void ph_na(const Frame& F, int l, int part) {
    LAS unsigned char* Kc = F.lds;
    LAS unsigned char* Vc = F.lds + 32768;
    LAS unsigned char* Kl = F.lds + 69632;
    LAS unsigned char* Vl = F.lds + 102400;
    LAS unsigned char* Qs = F.lds + 139264;
    LAS unsigned char* Pw = F.lds + 141312;
    LAS float* ml = (LAS float*)(F.lds + 159744);
    LAS float* bt = ml + 256;
    const bf16_t* P = F.w<bf16_t>(WS_P);
    const float* rpb = F.in[I_RPB] + (size_t)l * 15 * 31 * 6;
    const int nlat = 6 * 256 * 4;
    const int nB = (l == 0) ? 2520 : 0, nA = nlat - nB;
    const int lane = F.lane, wave = F.wave, c16 = lane & 15, kq = lane >> 4;
    const float scale = 0.125f;
    int cur_h = -1;
    const float ws = part == 0 ? (l == 0 ? 0.45f : 0.67f) : 0.0f;
    const int nP = part == 0 ? nA : nB, base = part == 0 ? 0 : nA;
    const float Wtot = 4.0f * ws + (float)(F.G - 4);
    const float W0 = F.bid < 4 ? F.bid * ws : 4.0f * ws + (float)(F.bid - 4), W1 = F.bid < 3 ? (F.bid + 1) * ws : 4.0f * ws + (float)(F.bid - 3);
    const int i_lo = base + (int)((float)nP * W0 / Wtot + 0.5f), i_hi = (F.bid == F.G - 1) ? base + nP : base + (int)((float)nP * W1 / Wtot + 0.5f);
    const int cid = (l == 0 && part == 0 && F.bid >= 100 && F.bid < 196) ? F.bid - 100 : -1;
    const int n_mine = max(0, i_hi - i_lo) + (cid >= 0 ? 1 : 0);
    u32x4 kreg[4], vreg[4], qreg; float breg = 0.f;
    const int pkey = F.tid >> 3, ppiece = F.tid & 7;
#define NA_PREFETCH(T) do { if (!(T).isctx) { _Pragma("unroll") for (int u = 0; u < 4; ++u) { const int key = pkey + 64 * u; \
            const bf16_t* src = P + (size_t)(((T).r0 + (key >> 5)) * 64 + (T).kc0 + (key & 31)) * PC + (T).h * 64 + ppiece * 8; \
            kreg[u] = *(const u32x4*)(src + CK); vreg[u] = *(const u32x4*)(src + CV); } \
            if (F.tid < 256 && (F.tid & 31) < 31) breg = rpb[(((T).r0 + (F.tid >> 5) - (T).r + 7) * 31 + (F.tid & 31)) * 6 + (T).h]; } \
        if (F.tid < 128) qreg = *(const u32x4*)(P + (size_t)((T).qrow0 + pkey) * PC + CQ + (T).h * 64 + ppiece * 8); } while (0)
    if (n_mine > 0) { const NaItem t0 = na_item(cid, i_lo, i_hi, 0); NA_PREFETCH(t0); }
    for (int k = 0; k < n_mine; ++k) {
        const NaItem t = na_item(cid, i_lo, i_hi, k);
        const bool isctx = t.isctx; const int h = t.h, cg = t.cg, kc0 = t.kc0, qrow0 = t.qrow0;
        if (k == 0) bar_lds();
        if (h != cur_h) { na_stage_kv(F, P, Kc, Vc, h, false, 0, 0); cur_h = h; }
        if (!isctx) {
#pragma unroll
            for (int u = 0; u < 4; ++u) { const int key = pkey + 64 * u; *(LAS u32x4*)(Kl + na_kv_off(key, ppiece)) = kreg[u]; *(LAS u32x4*)(Vl + na_v_off(key, ppiece)) = vreg[u]; }
            if (F.tid < 256) bt[F.tid] = breg;
        }
        if (F.tid < 128) *(LAS u32x4*)(Qs + na_kv_off(pkey, ppiece)) = qreg;
        if (k + 1 < n_mine) { const NaItem tn = na_item(cid, i_lo, i_hi, k + 1); NA_PREFETCH(tn); }
        bar_lds();
        const bool loc = wave < 4;
        const LAS unsigned char* Kb = loc ? Kl : Kc;
        const LAS unsigned char* Vb = loc ? Vl : Vc;
        const int kbase = (wave & 3) * 64;
        LAS unsigned char* pw = Pw + wave * 2304;
        float mw[4], lw[4];
        if (!(loc && isctx)) {
            f32x4 sacc[4];
#pragma unroll
            for (int nt = 0; nt < 4; ++nt) sacc[nt] = (f32x4){0.f, 0.f, 0.f, 0.f};
#pragma unroll
            for (int ks = 0; ks < 2; ++ks) {
                const bf16x8 a = *(const LAS bf16x8*)(Qs + na_kv_off(c16, 4 * ks + kq));
#pragma unroll
                for (int nt = 0; nt < 4; ++nt) {
                    const bf16x8 b = *(const LAS bf16x8*)(Kb + na_kv_off(kbase + 16 * nt + c16, 4 * ks + kq));
                    sacc[nt] = __builtin_amdgcn_mfma_f32_16x16x32_bf16(a, b, sacc[nt], 0, 0, 0);
                }
            }
#pragma unroll
            for (int rg = 0; rg < 4; ++rg) mw[rg] = -INFINITY;
#pragma unroll
            for (int nt = 0; nt < 4; ++nt) {
                const int kk = kbase + 16 * nt + c16;
#pragma unroll
                for (int rg = 0; rg < 4; ++rg) {
                    float sv = sacc[nt][rg] * scale;
                    if (loc) {
                        const int qi = 4 * kq + rg, qcol = cg * 16 + qi, cstart = min(max(qcol - 8, 0), 48);
                        const int krow = kk >> 5, kcol = kc0 + (kk & 31);
                        const bool ok = (kcol >= cstart) && (kcol < cstart + 16);
                        const int dc = min(max(kcol - qcol + 15, 0), 30);
                        sv = ok ? sv + bt[krow * 32 + dc] : -INFINITY;
                    }
                    sacc[nt][rg] = sv; mw[rg] = fmaxf(mw[rg], sv);
                }
            }
#pragma unroll
            for (int rg = 0; rg < 4; ++rg) {
                mw[rg] = row16_max(mw[rg]);
                lw[rg] = 0.f;
            }
#pragma unroll
            for (int nt = 0; nt < 4; ++nt) {
#pragma unroll
                for (int rg = 0; rg < 4; ++rg) {
                    const float msafe = mw[rg] == -INFINITY ? 0.f : mw[rg];
                    const float pv = __expf(sacc[nt][rg] - msafe);
                    lw[rg] += pv;
                    *(LAS bf16_t*)(pw + (4 * kq + rg) * 144 + (16 * nt + c16) * 2) = f2bf(pv);
                }
            }
#pragma unroll
            for (int rg = 0; rg < 4; ++rg) {
                lw[rg] = row16_sum(lw[rg]);
            }
            lds_fence();
            f32x4 oacc[4];
#pragma unroll
            for (int dt = 0; dt < 4; ++dt) oacc[dt] = (f32x4){0.f, 0.f, 0.f, 0.f};
            {
                const unsigned vaddr = (unsigned)(unsigned long long)(Vb + (kbase + 8 * kq + (c16 >> 2)) * NA_VP + 8 * (c16 & 3));
                u32x2 t[2][4][2];
                asm volatile(
                    "ds_read_b64_tr_b16 %0, %16 offset:0\n\tds_read_b64_tr_b16 %1, %16 offset:576\n\t"
                    "ds_read_b64_tr_b16 %2, %16 offset:32\n\tds_read_b64_tr_b16 %3, %16 offset:608\n\t"
                    "ds_read_b64_tr_b16 %4, %16 offset:64\n\tds_read_b64_tr_b16 %5, %16 offset:640\n\t"
                    "ds_read_b64_tr_b16 %6, %16 offset:96\n\tds_read_b64_tr_b16 %7, %16 offset:672\n\t"
                    "ds_read_b64_tr_b16 %8, %16 offset:4608\n\tds_read_b64_tr_b16 %9, %16 offset:5184\n\t"
                    "ds_read_b64_tr_b16 %10, %16 offset:4640\n\tds_read_b64_tr_b16 %11, %16 offset:5216\n\t"
                    "ds_read_b64_tr_b16 %12, %16 offset:4672\n\tds_read_b64_tr_b16 %13, %16 offset:5248\n\t"
                    "ds_read_b64_tr_b16 %14, %16 offset:4704\n\tds_read_b64_tr_b16 %15, %16 offset:5280\n\t"
                    "s_waitcnt lgkmcnt(0)"
                    : "=&v"(t[0][0][0]), "=&v"(t[0][0][1]), "=&v"(t[0][1][0]), "=&v"(t[0][1][1]), "=&v"(t[0][2][0]), "=&v"(t[0][2][1]), "=&v"(t[0][3][0]), "=&v"(t[0][3][1]),
                      "=&v"(t[1][0][0]), "=&v"(t[1][0][1]), "=&v"(t[1][1][0]), "=&v"(t[1][1][1]), "=&v"(t[1][2][0]), "=&v"(t[1][2][1]), "=&v"(t[1][3][0]), "=&v"(t[1][3][1])
                    : "v"(vaddr) : "memory");
#pragma unroll
                for (int ks = 0; ks < 2; ++ks) {
                    const bf16x8 a = *(const LAS bf16x8*)(pw + c16 * 144 + (32 * ks + 8 * kq) * 2);
#pragma unroll
                    for (int dt = 0; dt < 4; ++dt) {
                        const u32x4 bw = (u32x4){t[ks][dt][0].x, t[ks][dt][0].y, t[ks][dt][1].x, t[ks][dt][1].y};
                        oacc[dt] = __builtin_amdgcn_mfma_f32_16x16x32_bf16(a, __builtin_bit_cast(bf16x8, bw), oacc[dt], 0, 0, 0);
                    }
                }
            }
            lds_fence();
#pragma unroll
            for (int dt = 0; dt < 4; ++dt)
#pragma unroll
                for (int rg = 0; rg < 4; ++rg) *(LAS bf16_t*)(pw + (4 * kq + rg) * 144 + (16 * dt + c16) * 2) = f2bf(oacc[dt][rg]);
        } else {
#pragma unroll
            for (int rg = 0; rg < 4; ++rg) { mw[rg] = -INFINITY; lw[rg] = 0.f; }
            for (int q = lane; q < 16 * 36; q += 64) ((LAS unsigned*)pw)[q] = 0u;
        }
        if (c16 == 0) {
#pragma unroll
            for (int rg = 0; rg < 4; ++rg) { ml[(wave * 16 + 4 * kq + rg) * 2] = mw[rg]; ml[(wave * 16 + 4 * kq + rg) * 2 + 1] = lw[rg]; }
        }
        bar_lds();
        {
            const int qi = F.tid >> 5, dp = F.tid & 31;
            float M = -INFINITY;
#pragma unroll
            for (int w = 0; w < 8; ++w) M = fmaxf(M, ml[(w * 16 + qi) * 2]);
            float num0 = 0.f, num1 = 0.f, den = 0.f;
#pragma unroll
            for (int w = 0; w < 8; ++w) {
                const float sc = __expf(ml[(w * 16 + qi) * 2] - M);
                const unsigned ov = *(const LAS unsigned*)(Pw + w * 2304 + qi * 144 + dp * 4);
                num0 += sc * bflo(ov); num1 += sc * bfhi(ov); den += sc * ml[(w * 16 + qi) * 2 + 1];
            }
            const float inv = 1.0f / den;
            *(unsigned*)(F.w<bf16_t>(WS_MIX) + (size_t)(qrow0 + qi) * D + 384 + h * 64 + 2 * dp) = pk_bf16(num0 * inv, num1 * inv);
        }
    }
#undef NA_PREFETCH
}

__device__ __forceinline__ float hy_conv3(const bf16_t* P, const float* cw, const float* cb, int row, int seq_lo, int seq_hi, int col) {
    float s = cb[col];
#pragma unroll
    for (int k = 0; k < 3; ++k) { const int r = row + k - 1; if (r >= seq_lo && r < seq_hi) s += cw[k * 768 + col] * bf2f(P[(size_t)r * PC + CHY + col]); }
    return s;
}
__device__ __forceinline__ void ph_hy_prep(const Frame& F, int l) {
    const bf16_t* P = F.w<bf16_t>(WS_P);
    const float* cw = F.in[I_HCW] + (size_t)l * 3 * 768; const float* cb = F.in[I_HCB] + (size_t)l * 768;
    LAS unsigned* ut = (LAS unsigned*)F.lds;
    LAS unsigned* xt = ut + 256 * 33;
    const int cp = F.tid & 127, rq = F.tid >> 7;
    float w0[3][3], w1[3][3], b0[3], b1[3];
#pragma unroll
    for (int sg = 0; sg < 3; ++sg) { b0[sg] = cb[sg * 256 + 2 * cp]; b1[sg] = cb[sg * 256 + 2 * cp + 1];
#pragma unroll
        for (int k = 0; k < 3; ++k) { w0[sg][k] = cw[k * 768 + sg * 256 + 2 * cp]; w1[sg][k] = cw[k * 768 + sg * 256 + 2 * cp + 1]; } }
    for (int it = F.bid; it < L / 64; it += F.G) {
        const int t0 = it * 64, rb = t0 + rq * 16;
        __syncthreads();
        {
            unsigned win[3][18];
#pragma unroll
            for (int sg = 0; sg < 3; ++sg)
#pragma unroll
                for (int k = 0; k < 18; ++k) { const int rr = rb - 1 + k; win[sg][k] = (rr >= 0 && rr < L) ? *(const unsigned*)(P + (size_t)rr * PC + CHY + sg * 256 + 2 * cp) : 0u; }
#pragma unroll
            for (int jp = 0; jp < 8; ++jp) {
                float u0[2], u1[2], xa[2], xb[2];
#pragma unroll
                for (int q = 0; q < 2; ++q) {
                    const int k = 2 * jp + q;
                    float a0[3], a1[3];
#pragma unroll
                    for (int sg = 0; sg < 3; ++sg) {
                        a0[sg] = b0[sg] + w0[sg][0] * bflo(win[sg][k]) + w0[sg][1] * bflo(win[sg][k + 1]) + w0[sg][2] * bflo(win[sg][k + 2]);
                        a1[sg] = b1[sg] + w1[sg][0] * bfhi(win[sg][k]) + w1[sg][1] * bfhi(win[sg][k + 1]) + w1[sg][2] * bfhi(win[sg][k + 2]);
                    }
                    xa[q] = a0[0]; xb[q] = a1[0]; u0[q] = a0[2] * a0[1]; u1[q] = a1[2] * a1[1];
                }
                const int rp = rq * 8 + jp;
                ut[(2 * cp) * 33 + rp] = pk_bf16(u0[0], u0[1]); ut[(2 * cp + 1) * 33 + rp] = pk_bf16(u1[0], u1[1]);
                xt[(2 * cp) * 33 + rp] = pk_bf16(xa[0], xa[1]); xt[(2 * cp + 1) * 33 + rp] = pk_bf16(xb[0], xb[1]);
            }
        }
        __syncthreads();
        for (int q = F.tid; q < 256 * 8; q += NTHREADS) {
            const int c = q >> 3, g = q & 7;
            u32x4 a, b;
            a.x = ut[c * 33 + 4 * g]; a.y = ut[c * 33 + 4 * g + 1]; a.z = ut[c * 33 + 4 * g + 2]; a.w = ut[c * 33 + 4 * g + 3];
            b.x = xt[c * 33 + 4 * g]; b.y = xt[c * 33 + 4 * g + 1]; b.z = xt[c * 33 + 4 * g + 2]; b.w = xt[c * 33 + 4 * g + 3];
            *(u32x4*)(F.w<bf16_t>(WS_UT) + (size_t)c * L + t0 + 8 * g) = a;
            *(u32x4*)(F.w<bf16_t>(WS_X0T) + (size_t)c * L + t0 + 8 * g) = b;
            u32x2 a8; a8.x = pk_fp8x4(bflo(a.x), bfhi(a.x), bflo(a.y), bfhi(a.y)); a8.y = pk_fp8x4(bflo(a.z), bfhi(a.z), bflo(a.w), bfhi(a.w));
            *(u32x2*)(F.w<unsigned char>(WS_UT8) + (size_t)c * L + t0 + 8 * g) = a8;
        }
    }
    if (l == 0) {
        for (int rp = F.bid; rp < LC / 2; rp += F.G) {
            const int row = L + rp * 2 + (F.tid >> 8), c = F.tid & 255;
            const float x1 = hy_conv3(P, cw, cb, row, L, T, 256 + c), v = hy_conv3(P, cw, cb, row, L, T, 512 + c);
            F.w<float>(WS_U)[(size_t)row * 256 + c] = v * x1;
        }
    }
}
__device__ __forceinline__ void ph_hy_conv_ctx(const Frame& F, int l) {
    const bf16_t* P = F.w<bf16_t>(WS_P);
    const float* cw = F.in[I_HCW] + (size_t)l * 3 * 768; const float* cb = F.in[I_HCB] + (size_t)l * 768;
    for (int it = F.bid; it < 8; it += F.G) {
        const int Lx = LC, rbase = L;
        const int tb = it * 2 + (F.tid >> 8), c = F.tid & 255, t0 = tb * 16;
        const float* U = F.w<float>(WS_U) + (size_t)rbase * 256 + c;
        const float* KC = F.w<float>(WS_KCOMBC) + c;
        float acc[16], wreg[16];
#pragma unroll
        for (int j = 0; j < 16; ++j) { acc[j] = 0.f; wreg[j] = KC[(size_t)(t0 + j + Lx - 1) * 256]; }
        for (int s0 = 0; s0 < Lx; s0 += 16) {
            float ub[16], nb[16];
#pragma unroll
            for (int r = 0; r < 16; ++r) { ub[r] = U[(size_t)(s0 + r) * 256]; const int x = t0 - (s0 + r + 1) + Lx - 1; nb[r] = x >= 0 ? KC[(size_t)x * 256] : 0.f; }
#pragma unroll
            for (int r = 0; r < 16; ++r) {
#pragma unroll
                for (int j = 0; j < 16; ++j) acc[j] += ub[r] * wreg[(j - r) & 15];
                wreg[(15 - r) & 15] = nb[r];
            }
        }
        const float inv = F.w<float>(WS_FSUM)[2 * 256 + c];
        const float db = F.in[I_HYD][l * 256 + c];
#pragma unroll
        for (int j = 0; j < 16; ++j) {
            const int row = rbase + t0 + j;
            const float x0 = hy_conv3(P, cw, cb, row, L, T, c);
            const float u = F.w<float>(WS_U)[(size_t)row * 256 + c];
            F.w<bf16_t>(WS_MIX)[(size_t)row * D + 768 + c] = f2bf(x0 * (acc[j] * inv + u * db));
        }
    }
}

constexpr int HC_UP = 144, HC_UBYTES = 190 * HC_UP;
constexpr int HC_CPOFF = 27392, HC_NG = 83, HC_CPBYTES = 16 * HC_NG * 16;
__device__ __forceinline__ void hc_make_copies(LAS unsigned char* dst, const u32x4 g0, const u32x4 g1, int g) {
    const unsigned w[8] = {g0.x, g0.y, g0.z, g0.w, g1.x, g1.y, g1.z, g1.w};
#pragma unroll
    for (int sh = 0; sh < 16; ++sh) {
        const int b = sh >> 2, r = sh & 3;
        u32x4 o;
        if (r == 0) { o.x = w[b]; o.y = w[b + 1]; o.z = w[b + 2]; o.w = w[b + 3]; }
        else { o.x = __builtin_amdgcn_alignbyte(w[b + 1], w[b], r); o.y = __builtin_amdgcn_alignbyte(w[b + 2], w[b + 1], r);
               o.z = __builtin_amdgcn_alignbyte(w[b + 3], w[b + 2], r); o.w = __builtin_amdgcn_alignbyte(w[b + 4], w[b + 3], r); }
        *(LAS u32x4*)(dst + (sh * HC_NG + g) * 16) = o;
    }
}
__device__ __forceinline__ void ph_hy_conv(const Frame& F, int l) {
    LAS unsigned char* Ul = F.lds;
    LAS unsigned char* Cp = F.lds + HC_CPOFF;
    const int lane = F.lane, wave = F.wave;
    const int nt = wave < 4 ? wave : 7 - wave, par = wave >> 2;
    const int r = lane & 31, h = lane >> 5, sig = r & 15, rho = r >> 4;
    const int sh = (16 - sig) & 15, gofs = 2 * h - rho - (sig ? 1 : 0);
    const int a_lane = (sh * HC_NG + gofs) * 16;
    const int b_lane = r * HC_UP + h * 32;
    const int sclK = 0x79797979, sclU = ONE_E8M0;
    for (int c = F.bid; c < 256; c += F.G) {
        const unsigned char* KRc = F.w<unsigned char>(WS_KR) + ((size_t)l * 256 + c) * KRL;
        const unsigned char* U8c = F.w<unsigned char>(WS_UT8) + (size_t)c * L;
        const bf16_t* UTc = F.w<bf16_t>(WS_UT) + (size_t)c * L;
        __syncthreads();
        for (int q = F.tid; q < 190 * 8; q += NTHREADS) {
            const int blk = q >> 3, piece = q & 7;
            u32x4 v = (u32x4){0u, 0u, 0u, 0u};
            if (blk >= 31 && blk < 159) v = *(const u32x4*)(U8c + (size_t)(blk - 31) * 128 + piece * 16);
            *(LAS u32x4*)(Ul + blk * HC_UP + piece * 16) = v;
        }
        u32x4 g0 = (u32x4){0u, 0u, 0u, 0u}, g1 = g0;
        if (F.tid < HC_NG) { const unsigned char* src = KRc + 31744 + 16 * F.tid; g0 = *(const u32x4*)src; g1 = *(const u32x4*)(src + 16); }
        if (F.tid < HC_NG) hc_make_copies(Cp, g0, g1, F.tid);
        __syncthreads();
        f32x16 acc[4];
#pragma unroll
        for (int m = 0; m < 4; ++m)
#pragma unroll
            for (int i = 0; i < 16; ++i) acc[m][i] = 0.f;
        for (int ci = 0; ci < 32; ++ci) {
            const int Dc = -128 + 8 * ci;
            if (ci + 1 < 32 && F.tid < HC_NG) { const unsigned char* src = KRc + (31744 - 1024 * (ci + 1)) + 16 * F.tid; g0 = *(const u32x4*)src; g1 = *(const u32x4*)(src + 16); }
            const LAS unsigned char* cp = Cp + (ci & 1) * HC_CPBYTES + a_lane;
#pragma unroll 1
            for (int d2 = 0; d2 < 4; ++d2) {
                const int dd = 2 * d2 + par, Dv = Dc + dd;
                if (!((Dv >= 32 * nt - 127) && (Dv <= 32 * nt + 31) && (Dv > -128))) continue;
                const LAS unsigned char* ap = cp + (8 * (8 - dd)) * 16;
                const LAS unsigned char* bp = Ul + b_lane + (32 * nt - Dv + 31) * HC_UP;
                v8i af[6], bfr[2];
#pragma unroll
                for (int e = 0; e < 6; ++e) { const v4i x = *(const LAS v4i*)(ap - 2 * (e - 2) * 16), y = *(const LAS v4i*)(ap - 2 * (e - 2) * 16 + 16); af[e] = __builtin_shufflevector(x, y, 0, 1, 2, 3, 4, 5, 6, 7); }
#pragma unroll
                for (int ks = 0; ks < 2; ++ks) { const v4i x = *(const LAS v4i*)(bp + ks * 64), y = *(const LAS v4i*)(bp + ks * 64 + 16); bfr[ks] = __builtin_shufflevector(x, y, 0, 1, 2, 3, 4, 5, 6, 7); }
#pragma unroll
                for (int ks = 0; ks < 2; ++ks)
#pragma unroll
                    for (int m = 0; m < 4; ++m)
                        asm volatile("v_mfma_scale_f32_32x32x64_f8f6f4 %0, %1, %2, %0, %3, %4 op_sel_hi:[0,0,0]" : "+v"(acc[m]) : "v"(af[m - 2 * ks + 2]), "v"(bfr[ks]), "v"(sclK), "v"(sclU));
            }
            if (ci + 1 < 32 && F.tid < HC_NG) hc_make_copies(Cp + ((ci + 1) & 1) * HC_CPBYTES, g0, g1, F.tid);
            __syncthreads();
        }
        LAS float* Rd = (LAS float*)F.lds;
        if (wave >= 4) {
#pragma unroll
            for (int m = 0; m < 4; ++m)
#pragma unroll
                for (int i = 0; i < 16; ++i) Rd[(nt * 64 + m * 16 + i) * 64 + lane] = acc[m][i];
        }
        __syncthreads();
        if (wave < 4) {
#pragma unroll
            for (int m = 0; m < 4; ++m)
#pragma unroll
                for (int i = 0; i < 16; ++i) acc[m][i] += Rd[(nt * 64 + m * 16 + i) * 64 + lane];
            const float inv = F.w<float>(WS_FSUM)[l * 256 + c];
            const float db = F.in[I_HYD][l * 256 + c];
            const bf16_t* X0c = F.w<bf16_t>(WS_X0T) + (size_t)c * L;
            bf16_t* YTc = F.w<bf16_t>(WS_YT) + (size_t)c * L;
            const int I = 32 * nt + r;
#pragma unroll
            for (int m = 0; m < 4; ++m) {
#pragma unroll
                for (int g = 0; g < 4; ++g) {
                    const int t = 128 * I + 32 * m + 8 * g + 4 * h;
                    const u32x2 xv = *(const u32x2*)(X0c + t), uv = *(const u32x2*)(UTc + t);
                    float y[4];
#pragma unroll
                    for (int e = 0; e < 4; ++e) y[e] = acc[m][4 * g + e] * inv;
                    y[0] = bflo(xv.x) * (y[0] + bflo(uv.x) * db); y[1] = bfhi(xv.x) * (y[1] + bfhi(uv.x) * db);
                    y[2] = bflo(xv.y) * (y[2] + bflo(uv.y) * db); y[3] = bfhi(xv.y) * (y[3] + bfhi(uv.y) * db);
                    u32x2 o; o.x = pk_bf16(y[0], y[1]); o.y = pk_bf16(y[2], y[3]);
                    *(u32x2*)(YTc + t) = o;
                }
            }
        }
    }
}
__device__ __forceinline__ void ph_hy_tr(const Frame& F) {
    LAS unsigned* yt = (LAS unsigned*)F.lds;
    for (int it = F.bid; it < L / 64; it += F.G) {
        const int t0 = it * 64;
        __syncthreads();
        for (int q = F.tid; q < 256 * 8; q += NTHREADS) {
            const int c = q >> 3, g = q & 7;
            const u32x4 a = *(const u32x4*)(F.w<bf16_t>(WS_YT) + (size_t)c * L + t0 + 8 * g);
            yt[c * 33 + 4 * g] = a.x; yt[c * 33 + 4 * g + 1] = a.y; yt[c * 33 + 4 * g + 2] = a.z; yt[c * 33 + 4 * g + 3] = a.w;
        }
        __syncthreads();
        for (int q = F.tid; q < 64 * 32; q += NTHREADS) {
            const int row = q >> 5, cg = q & 31;
            const LAS unsigned short* ys = (const LAS unsigned short*)yt;
            unsigned short v[8];
#pragma unroll
            for (int e = 0; e < 8; ++e) v[e] = ys[((cg * 8 + e) * 33) * 2 + row];
            u32x4 o; o.x = v[0] | ((unsigned)v[1] << 16); o.y = v[2] | ((unsigned)v[3] << 16); o.z = v[4] | ((unsigned)v[5] << 16); o.w = v[6] | ((unsigned)v[7] << 16);
            *(u32x4*)(F.w<bf16_t>(WS_MIX) + (size_t)(t0 + row) * D + 768 + cg * 8) = o;
        }
    }
}

constexpr int WRP = 1028;
__device__ __forceinline__ void ph_post1(const Frame& F, int l) {
    LAS float* wr = (LAS float*)F.lds;
    LAS unsigned* lcnt = (LAS unsigned*)(F.lds + 32 * WRP * 4);
    __syncthreads();
    if (F.tid < 64) lcnt[F.tid] = 0u;
    {
        const f32x4* src = (const f32x4*)(F.in[I_WR] + (size_t)l * 1024 * 32);
        f32x4 v[16];
#pragma unroll
        for (int u = 0; u < 16; ++u) v[u] = src[F.tid + u * NTHREADS];
#pragma unroll
        for (int u = 0; u < 16; ++u) { const int q4 = F.tid + u * NTHREADS, k = q4 >> 3, e0 = (q4 & 7) * 4;
#pragma unroll
            for (int i = 0; i < 4; ++i) wr[(e0 + i) * WRP + k] = v[u][i]; }
    }
    __syncthreads();
    const int nrows = (l == 0) ? T : L;
    const int nwaves = F.G * 8, lane = F.lane;
    unsigned* cnt = F.w<unsigned>(WS_CTL) + CW_CNT + l * 1024;
    if (F.bid == 0) { for (int q = F.tid; q < D / 4; q += NTHREADS) ((unsigned*)(F.w<unsigned char>(WS_H2) + (size_t)T * D))[q] = 0u; }
    const float brl = F.in[I_BR][l * 32 + ((lane >> 1) & 31)];
    const int mye = (lane >> 1) & 31;
    for (int row0 = F.bid * 8 + F.wave; row0 < nrows; row0 += 2 * nwaves) {
        int rw[2]; bool vld[2];
        rw[0] = row0; vld[0] = true; vld[1] = (row0 + nwaves < nrows); rw[1] = vld[1] ? row0 + nwaves : row0;
        f32x4 m[2][4], x[2][4], hv[2][4];
#pragma unroll
        for (int u = 0; u < 2; ++u) { const bf16_t* mr = F.w<bf16_t>(WS_MIXO) + (size_t)rw[u] * D;
#pragma unroll
            for (int i = 0; i < 4; ++i) { const u32x2 w = *(const u32x2*)(mr + 4 * lane + 256 * i); m[u][i] = (f32x4){bflo(w.x), bfhi(w.x), bflo(w.y), bfhi(w.y)}; }
            load_xrow(F, l, rw[u], lane, x[u]); }
#pragma unroll
        for (int u = 0; u < 2; ++u) {
            const int which = rw[u] >= L;
            const float* v0 = vecs_ptr(F, l, which, 2);
            const float rs1 = row_rstd(m[u]);
#pragma unroll
            for (int i = 0; i < 4; ++i) { const f32x4 a = *(const f32x4*)(v0 + 4 * lane + 256 * i); x[u][i] = x[u][i] + m[u][i] * rs1 * a; }
        }
#pragma unroll
        for (int u = 0; u < 2; ++u) {
            if (vld[u]) store_xrow_bf16(F.w<bf16_t>(WS_XCUR) + (size_t)rw[u] * D, lane, x[u]);
        }
#pragma unroll
        for (int u = 0; u < 2; ++u) {
            const int which = rw[u] >= L;
            const float* v1 = vecs_ptr(F, l, which, 3), *v2 = vecs_ptr(F, l, which, 4);
            const float rs2 = row_rstd(x[u]);
#pragma unroll
            for (int i = 0; i < 4; ++i) { const f32x4 a = *(const f32x4*)(v1 + 4 * lane + 256 * i), b = *(const f32x4*)(v2 + 4 * lane + 256 * i); hv[u][i] = x[u][i] * rs2 * a + b; }
            if (vld[u]) { unsigned char* ho = F.w<unsigned char>(WS_H2) + (size_t)rw[u] * D;
#pragma unroll
                for (int i = 0; i < 4; ++i) *(unsigned*)(ho + 4 * lane + 256 * i) = pk_fp8x4(hv[u][i][0], hv[u][i][1], hv[u][i][2], hv[u][i][3]); }
        }
        float part[2][32];
#pragma unroll
        for (int e = 0; e < 32; ++e) {
            float s0 = 0.f, s1 = 0.f;
#pragma unroll
            for (int i = 0; i < 4; ++i) { const f32x4 w = *(const LAS f32x4*)(wr + e * WRP + 4 * lane + 256 * i);
                s0 += hv[0][i][0] * w[0] + hv[0][i][1] * w[1] + hv[0][i][2] * w[2] + hv[0][i][3] * w[3];
                s1 += hv[1][i][0] * w[0] + hv[1][i][1] * w[1] + hv[1][i][2] * w[2] + hv[1][i][3] * w[3]; }
            part[0][e] = s0; part[1][e] = s1;
        }
#pragma unroll
        for (int st = 0; st < 5; ++st) {
            const int o = 32 >> st, n = 32 >> st;
            const bool upper = (lane & o) != 0;
#pragma unroll
            for (int i = 0; i < n / 2; ++i) {
#pragma unroll
                for (int u = 0; u < 2; ++u) {
                    const float send = upper ? part[u][i] : part[u][i + n / 2];
                    const float recv = __shfl_xor(send, o);
                    const float keep = upper ? part[u][i + n / 2] : part[u][i];
                    part[u][i] = keep + recv;
                }
            }
        }
#pragma unroll
        for (int u = 0; u < 2; ++u) {
            float lg = part[u][0] + __shfl_xor(part[u][0], 1);
            lg += brl;
            int rank = 0;
#pragma unroll
            for (int e = 0; e < 32; ++e) { const float ov = __int_as_float(__builtin_amdgcn_readlane(__float_as_int(lg), 2 * e)); rank += (ov > lg || (ov == lg && e < mye)) ? 1 : 0; }
            int te[4]; float tv[4];
#pragma unroll
            for (int k = 0; k < 4; ++k) {
                const unsigned long long msk = __ballot(rank == k && (lane & 1) == 0);
                const int idx = msk ? __builtin_amdgcn_readfirstlane((int)__builtin_ctzll(msk)) : 2 * k;
                te[k] = idx >> 1; tv[k] = __int_as_float(__builtin_amdgcn_readlane(__float_as_int(lg), idx));
            }
            const float e1 = __expf(tv[1] - tv[0]), e2 = __expf(tv[2] - tv[0]), e3 = __expf(tv[3] - tv[0]);
            const float inv = 1.0f / (1.0f + e1 + e2 + e3);
            if (lane < 4 && vld[u]) {
                const int k = lane, row = rw[u];
                const int e = k == 0 ? te[0] : (k == 1 ? te[1] : (k == 2 ? te[2] : te[3]));
                const float wgt = (k == 0 ? 1.0f : (k == 1 ? e1 : (k == 2 ? e2 : e3))) * inv;
                const unsigned pos = __hip_atomic_fetch_add(lcnt + e, 1u, __ATOMIC_RELAXED, __HIP_MEMORY_SCOPE_WORKGROUP);
                F.w<int>(WS_RE)[row * 4 + k] = e; F.w<int>(WS_RP)[row * 4 + k] = (int)pos; F.w<float>(WS_RW)[row * 4 + k] = wgt;
            }
        }
    }
    __syncthreads();
    if (F.tid < 32) lcnt[32 + F.tid] = atomicAdd(cnt + F.tid * 32, lcnt[F.tid]);
    __syncthreads();
    for (int row = F.bid * 8 + F.wave; row < nrows; row += nwaves) {
        if (lane < 4) { const int a = row * 4 + lane; F.w<int>(WS_RP)[a] += (int)lcnt[32 + F.w<int>(WS_RE)[a]]; }
    }
}

__device__ __forceinline__ int expert_pad_start(const Frame& F, int l, int& ntiles) {
    const unsigned* cnt = F.w<unsigned>(WS_CTL) + CW_CNT + l * 1024;
    int c = F.lane < 32 ? (int)__hip_atomic_load(cnt + F.lane * 32, __ATOMIC_RELAXED, __HIP_MEMORY_SCOPE_AGENT) : 0;
    int padded = (c + 255) & ~255;
    int incl = padded;
#pragma unroll
    for (int o = 1; o < 32; o <<= 1) { const int v = __shfl_up(incl, o); if ((F.lane & 31) >= o) incl += v; }
    ntiles = __shfl(incl, 31) >> 8;
    return incl - padded;
}

__device__ __forceinline__ void ph_gather(const Frame& F, int l) {
    int ntiles; const int ps = expert_pad_start(F, l, ntiles);
    if (F.bid == 0 && F.wave == 0) {
        int* tab = F.w<int>(WS_CTL) + CW_TILE + l * 320;
        const int nxt = __shfl_down(ps, 1);
        const int endt = (F.lane == 31) ? ntiles : (nxt >> 8);
        if (F.lane < 32) for (int t = ps >> 8; t < endt; ++t) tab[t] = F.lane;
        if (F.lane == 0) F.w<int>(WS_CTL)[CW_NT + l] = ntiles;
    }
    const int nrows = (l == 0) ? T : L;
    for (int a0 = (F.bid * 8 + F.wave) * 64; a0 < nrows * 4; a0 += F.G * 8 * 64) {
        const int a = a0 + F.lane;
        if (a < nrows * 4) {
            const int e = F.w<int>(WS_RE)[a], pos = F.w<int>(WS_RP)[a];
            const int dst = __shfl(ps, e) + pos;
            F.w<int>(WS_SLOT)[a] = dst;
            F.w<int>(WS_ROWTOK)[(size_t)l * MAXROWS + dst] = a >> 2;
        }
    }
}

__device__ __forceinline__ void ph_final(const Frame& F, int l) {
    const int nrows = (l == 0) ? T : L;
    const int nwaves = F.G * 8, lane = F.lane;
    const bf16_t* Y = F.w<bf16_t>(WS_Y) + (size_t)l * MAXROWS * D;
    int slotn[2][4]; float wgtn[2][4];
#define FN_SLOTS(r0_) do { _Pragma("unroll") for (int u = 0; u < 2; ++u) { const int rr_ = ((r0_) + u * nwaves < nrows) ? (r0_) + u * nwaves : (r0_); \
        _Pragma("unroll") for (int k = 0; k < 4; ++k) { slotn[u][k] = F.w<int>(WS_SLOT)[rr_ * 4 + k]; wgtn[u][k] = F.w<float>(WS_RW)[rr_ * 4 + k]; } } } while (0)
    const int rfirst = F.bid * 8 + F.wave;
    if (rfirst < nrows) FN_SLOTS(rfirst);
    for (int row0 = rfirst; row0 < nrows; row0 += 2 * nwaves) {
        int rw[2]; bool vld[2];
        rw[0] = row0; vld[0] = true; vld[1] = (row0 + nwaves < nrows); rw[1] = vld[1] ? row0 + nwaves : row0;
        int slot[2][4]; float wgt[2][4];
#pragma unroll
        for (int u = 0; u < 2; ++u)
#pragma unroll
            for (int k = 0; k < 4; ++k) { slot[u][k] = slotn[u][k]; wgt[u][k] = wgtn[u][k]; }
        u32x2 yv[2][4][4]; f32x4 x[2][4];
#pragma unroll
        for (int u = 0; u < 2; ++u) {
#pragma unroll
            for (int k = 0; k < 4; ++k) { const bf16_t* yr = Y + (size_t)slot[u][k] * D;
#pragma unroll
                for (int i = 0; i < 4; ++i) yv[u][k][i] = *(const u32x2*)(yr + 4 * lane + 256 * i); }
            load_xrow(F, 1, rw[u], lane, x[u]);
        }
        if (row0 + 2 * nwaves < nrows) FN_SLOTS(row0 + 2 * nwaves);
#pragma unroll
        for (int u = 0; u < 2; ++u) {
            const int which = rw[u] >= L;
            const float* ve = vecs_ptr(F, l, which, 5);
            f32x4 f[4];
#pragma unroll
            for (int i = 0; i < 4; ++i) f[i] = (f32x4){0.f, 0.f, 0.f, 0.f};
#pragma unroll
            for (int k = 0; k < 4; ++k)
#pragma unroll
                for (int i = 0; i < 4; ++i) { const u32x2 w = yv[u][k][i]; f[i][0] += wgt[u][k] * bflo(w.x); f[i][1] += wgt[u][k] * bfhi(w.x); f[i][2] += wgt[u][k] * bflo(w.y); f[i][3] += wgt[u][k] * bfhi(w.y); }
            const float rs = row_rstd(f);
#pragma unroll
            for (int i = 0; i < 4; ++i) { const f32x4 a = *(const f32x4*)(ve + 4 * lane + 256 * i); x[u][i] = x[u][i] + f[i] * rs * a; }
            if (vld[u]) {
                if (l == 1) { float* xo = F.out + (size_t)rw[u] * D;
#pragma unroll
                    for (int i = 0; i < 4; ++i) *(f32x4*)(xo + 4 * lane + 256 * i) = x[u][i]; }
                else store_xrow_bf16(F.w<bf16_t>(WS_XCUR) + (size_t)rw[u] * D, lane, x[u]);
                if (l == 0) {
                    const float rstd = row_rstd(x[u]);
                    const float* va = vecs_ptr(F, 1, which, 0), *vb = vecs_ptr(F, 1, which, 1);
                    bf16_t* orow = F.w<bf16_t>(WS_HB) + (size_t)rw[u] * D;
                    unsigned char* orow8 = F.w<unsigned char>(WS_HB) + (size_t)rw[u] * D;
#pragma unroll
                    for (int i = 0; i < 4; ++i) {
                        const int c = 4 * lane + 256 * i;
                        const f32x4 a = *(const f32x4*)(va + c), b = *(const f32x4*)(vb + c);
                        if (F8IN(1)) *(unsigned*)(orow8 + c) = pk_fp8x4(x[u][i][0] * rstd * a[0] + b[0], x[u][i][1] * rstd * a[1] + b[1], x[u][i][2] * rstd * a[2] + b[2], x[u][i][3] * rstd * a[3] + b[3]);
                        else { u32x2 w; w.x = pk_bf16(x[u][i][0] * rstd * a[0] + b[0], x[u][i][1] * rstd * a[1] + b[1]); w.y = pk_bf16(x[u][i][2] * rstd * a[2] + b[2], x[u][i][3] * rstd * a[3] + b[3]);
                        *(u32x2*)(orow + c) = w; }
                    }
                }
            }
        }
    }
#undef FN_SLOTS
}

constexpr int PH_PER_LAYER = 10, N_PHASES = 2 + 2 * PH_PER_LAYER;
#ifndef PH_MASK
#define PH_MASK 0xFFFFFFFFu
#endif
#define EN(b) (((PH_MASK) >> (b)) & 1u)
#ifndef DUP_MASK
#define DUP_MASK 0u
#endif
#define REP(b) for (int _rep = 0; _rep < 1 + (int)(((DUP_MASK) >> (b)) & 1u); ++_rep)

__global__ void __launch_bounds__(NTHREADS, 2) mega(Args args) {
    extern __shared__ __attribute__((aligned(16))) unsigned char shm[];
    Frame F0;
    F0.in.kp = (kargp_t)__builtin_amdgcn_kernarg_segment_ptr();
    F0.out = args.out; F0.ws = args.ws; F0.lds = (LAS unsigned char*)shm;
    F0.tid = threadIdx.x; F0.lane = F0.tid & 63; F0.wave = __builtin_amdgcn_readfirstlane(F0.tid >> 6); F0.G = gridDim.x; F0.bid = blockIdx.x;
    volatile LAS unsigned* bst = (volatile LAS unsigned*)(shm + LDS_BYTES - 16);
    XcdBarrier bar; bar.bar = F0.w<unsigned>(WS_CTL) + CW_BAR; bar.x = 0; bar.st = bst;
#if N_LAUNCH_MODE == 1
    if (F0.tid == 0) { bst[0] = 0u; bst[1] = 0u; }
    __syncthreads();
    bar = xcd_barrier_post(F0.w<unsigned>(WS_CTL) + CW_BAR, bst);
#define GRID_BAR() xcd_barrier(bar)
#else
#define GRID_BAR() do {} while (0)
#endif
    const int lo = args.ph_lo, hi = args.ph_hi;
#define IN(k) (lo <= (k) && (k) < hi)
#define SEAM(k) do { if (IN(k) && IN((k) + 1)) GRID_BAR(); } while (0)

    if (IN(0)) { const Frame F = launder(F0); REP(1) ph_modpart(F); }
    SEAM(0);
    if (IN(1)) { const Frame F = launder(F0);
        REP(2) ph_filter(F); REP(3) ph_norm1(F, 0); ph_vecs(F); __syncthreads(); REP(0) ph_convert(F); }
    SEAM(1);
    for (int l = 0; l < 2; ++l) {
        const int pb = 2 + l * PH_PER_LAYER;
        if (EN(5) && IN(pb + 0)) { const Frame F = launder(F0);
            const bool f8 = (l == 0) ? (F8IN(0) != 0) : (F8IN(1) != 0);
            pg8::Gemm g{F.w<bf16_t>(WS_HB), F.w<bf16_t>(WS_WINT) + (size_t)l * PC * D, f8 ? D / 2 : D};
            pg8::SchedGrid S{PC / 256, (T / 256) * (PC / 256), F.G, F.vid};
            pg8::EpiBf16 E{F.w<bf16_t>(WS_P), PC, nullptr, 0};
            if (INPROJ_FP8 == 0) pg8::gemm_phase<pg8::EpiBf16, pg8::SchedGrid, true, false, false>(F.lds, g, S, E, F.tid);
            else if (INPROJ_FP8 == 3) pg8::gemm_phase<pg8::EpiBf16, pg8::SchedGrid, true, false, true>(F.lds, g, S, E, F.tid);
            else { if (f8) pg8::gemm_phase<pg8::EpiBf16, pg8::SchedGrid, true, false, true>(F.lds, g, S, E, F.tid); else pg8::gemm_phase<pg8::EpiBf16, pg8::SchedGrid, true, false, false>(F.lds, g, S, E, F.tid); }
        }
        SEAM(pb + 0);
        if (IN(pb + 1)) { const Frame F = launder(F0); if (l == 0) { REP(4) ph_fsum(F); } REP(6) ph_ssd_prep(F, l); REP(7) ph_hy_prep(F, l); REP(8) ph_na(F, l, 0); }
        SEAM(pb + 1);
        if (IN(pb + 2)) { const Frame F = launder(F0); REP(9) ph_ssd_scan(F); REP(10) { ph_hy_conv(F, l); if (l == 0) ph_hy_conv_ctx(F, l); } }
        SEAM(pb + 2);
        if (EN(11) && IN(pb + 3)) { const Frame F = launder(F0); REP(11) ph_ssd_out(F, l); REP(18) ph_hy_tr(F); if (l == 0) ph_na(F, l, 1); }
        SEAM(pb + 3);
        if (EN(12) && IN(pb + 4)) { const Frame F = launder(F0);
            pg8::Gemm g{F.w<bf16_t>(WS_MIX), F.w<bf16_t>(WS_WOUTT) + (size_t)l * D * D, D};
            const int nM = (l == 0) ? T / 256 : L / 256;
            pg8::SchedGrid S{4, nM * 4, F.G, F.vid};
            pg8::EpiBf16 E{F.w<bf16_t>(WS_MIXO), D, nullptr, 0};
            REP(12) pg8::gemm_phase<pg8::EpiBf16, pg8::SchedGrid>(F.lds, g, S, E, F.tid);
        }
        SEAM(pb + 4);
        if (EN(13) && IN(pb + 5)) { const Frame F = launder(F0); ph_post1(F, l); }
        SEAM(pb + 5);
        if (EN(14) && IN(pb + 6)) { const Frame F = launder(F0); REP(14) ph_gather(F, l); }
        SEAM(pb + 6);
        if (EN(15) && IN(pb + 7)) { const Frame F = launder(F0);
            const int* tab = F.w<int>(WS_CTL) + CW_TILE + l * 320;
            const int ntiles = __builtin_amdgcn_readfirstlane(F.w<int>(WS_CTL)[CW_NT + l]);
            pg8::Gemm g{F.w<bf16_t>(WS_H2), (const bf16_t*)(F.w<unsigned char>(WS_WGUT) + (size_t)l * NE * 2048 * D), D / 2};
            pg8::SchedMoe S{8, ntiles * 8, F.G, F.vid, tab};
            pg8::EpiAct E{F.w<unsigned char>(WS_HMID) + (size_t)l * MAXROWS * D, F.in[I_BGU] + (size_t)l * NE * 2048};
            LAS int* rowtab = (LAS int*)(F.lds + pg8::STAGE_BYTES);
            __syncthreads();
            {
                int nt_; const int ps = expert_pad_start(F, l, nt_);
                const unsigned* cnt = F.w<unsigned>(WS_CTL) + CW_CNT + l * 1024;
                for (int ui = 0; ui * F.G + F.vid < ntiles * 8 && ui < 12; ++ui) {
                    const int pa = (ui * F.G + F.vid) / 8;
                    const int e = tab[pa];
                    const int pstart = __shfl(ps, e), ce = (int)__hip_atomic_load(cnt + e * 32, __ATOMIC_RELAXED, __HIP_MEMORY_SCOPE_AGENT);
                    if (F.tid < 256) { const int prow = pa * 256 + F.tid; rowtab[ui * 256 + F.tid] = (prow - pstart < ce) ? F.w<int>(WS_ROWTOK)[(size_t)l * MAXROWS + prow] : T; }
                }
            }
            __syncthreads();
            REP(15) pg8::gemm_phase<pg8::EpiAct, pg8::SchedMoe, true, true, true>(F.lds, g, S, E, F.tid, rowtab);
        }
        SEAM(pb + 7);
        if (EN(16) && IN(pb + 8)) { const Frame F = launder(F0);
            const int* tab = F.w<int>(WS_CTL) + CW_TILE + l * 320;
            const int ntiles = __builtin_amdgcn_readfirstlane(F.w<int>(WS_CTL)[CW_NT + l]);
            pg8::Gemm g{(const bf16_t*)(F.w<unsigned char>(WS_HMID) + (size_t)l * MAXROWS * D), (const bf16_t*)(F.w<unsigned char>(WS_WDT) + (size_t)l * NE * D * D), D / 2};
            pg8::SchedMoe S{4, ntiles * 4, F.G, F.vid, tab};
            pg8::EpiBf16 E{F.w<bf16_t>(WS_Y) + (size_t)l * MAXROWS * D, D, F.in[I_BDN] + (size_t)l * NE * D, D};
            REP(16) pg8::gemm_phase<pg8::EpiBf16, pg8::SchedMoe, true, false, true>(F.lds, g, S, E, F.tid);
        }
        SEAM(pb + 8);
        if (EN(17) && IN(pb + 9)) { const Frame F = launder(F0); ph_final(F, l); }
        if (l == 0) SEAM(pb + 9);
    }
#undef IN
#undef SEAM
}

extern "C" void kernel_launch(void* const* d_in, const int* in_sizes, int n_in, void* d_out, int out_size, void* d_ws, size_t ws_size, hipStream_t stream) {
    static int grid = 0;
    if (grid == 0) {
        if (n_in != N_IN || out_size != L * D || ws_size < WS_END) { fprintf(stderr, "kernel_launch: unexpected shapes: n_in %d out %d ws %zu (need %zu)\n", n_in, out_size, ws_size, (size_t)WS_END); grid = -1; return; }
        int dev = 0, cus = 0, per_cu = 0;
        if (hipGetDevice(&dev) != hipSuccess || hipDeviceGetAttribute(&cus, hipDeviceAttributeMultiprocessorCount, dev) != hipSuccess) { grid = -1; return; }
        if (hipFuncSetAttribute((const void*)mega, hipFuncAttributeMaxDynamicSharedMemorySize, LDS_BYTES) != hipSuccess) { fprintf(stderr, "kernel_launch: hipFuncSetAttribute failed\n"); grid = -1; return; }
        if (hipOccupancyMaxActiveBlocksPerMultiprocessor(&per_cu, (const void*)mega, NTHREADS, LDS_BYTES) != hipSuccess || per_cu < 1) { fprintf(stderr, "kernel_launch: occupancy query says %d\n", per_cu); }
        (void)hipGetLastError();
        grid = cus;
    }
    if (grid < 0) return;
    (void)hipMemsetAsync((char*)d_ws + WS_CTL, 0, CTL_BYTES, stream);
    Args a{};
    for (int i = 0; i < N_IN; ++i) a.in[i] = (const float*)d_in[i];
    a.out = (float*)d_out; a.ws = (unsigned char*)d_ws;
#if N_LAUNCH_MODE == 1
    a.ph_lo = 0; a.ph_hi = N_PHASES;
    hipLaunchKernelGGL(mega, dim3(grid), dim3(NTHREADS), LDS_BYTES, stream, a);
#else
    for (int p = 0; p < N_PHASES; ++p) { a.ph_lo = p; a.ph_hi = p + 1; hipLaunchKernelGGL(mega, dim3(grid), dim3(NTHREADS), LDS_BYTES, stream, a); }
#endif
}
```

```cpp
#include <hip/hip_runtime.h>
#include <cstdio>
#include <cstdint>

#define LAS __attribute__((address_space(3)))
typedef unsigned short bf16_t;
typedef short bf16x8 __attribute__((ext_vector_type(8)));
typedef float f32x4 __attribute__((ext_vector_type(4)));
typedef float f32x16 __attribute__((ext_vector_type(16)));
typedef unsigned u32x4 __attribute__((ext_vector_type(4)));
typedef unsigned u32x2 __attribute__((ext_vector_type(2)));
typedef int v4i __attribute__((ext_vector_type(4)));
typedef int v8i __attribute__((ext_vector_type(8)));

#ifndef N_LAUNCH_MODE
#define N_LAUNCH_MODE 1
#endif

constexpr int D = 1024, L = 16384, LC = 256, T = L + LC, NCH = T / 128;
constexpr int PC = 3328;
constexpr int CZ = 0, CXBC = 384, CQ = 1280, CK = 1664, CV = 2048, CHY = 2432, CDT = 3200;
constexpr int NE = 32;
constexpr int MAXT = 292;
constexpr int MAXROWS = MAXT * 256;
constexpr int NTHREADS = 512;
constexpr int LDS_BYTES = 160 * 1024;
constexpr float RMS_EPS = 1e-6f;

enum { I_X = 0, I_C, I_CTX, I_CCTX, I_WMOD, I_BMOD, I_NORMG, I_WIN, I_SCW, I_SCB, I_ALOG, I_DTB, I_SSDD, I_SSDNG, I_RPB, I_HCW, I_HCB,
       I_FW1, I_FB1, I_FW2, I_FB2, I_FW3, I_FREQ, I_HYD, I_WOUT, I_WR, I_BR, I_WGU, I_BGU, I_WDN, I_BDN, N_IN };

constexpr size_t al256(size_t x) { return (x + 255) & ~(size_t)255; }
constexpr size_t WS_CTL   = 0;
constexpr size_t CTL_BYTES = 64 * 1024;
constexpr size_t WS_WINT  = WS_CTL + CTL_BYTES;
constexpr size_t WS_WOUTT = WS_WINT + al256((size_t)2 * PC * D * 2);
constexpr size_t WS_WGUT  = WS_WOUTT + al256((size_t)2 * D * D * 2);
constexpr size_t WS_WDT   = WS_WGUT + al256((size_t)2 * NE * 2048 * D * 2);
constexpr size_t WS_MODP  = WS_WDT + al256((size_t)2 * NE * D * D * 2);
constexpr int KRL = 2 * L + 512;
constexpr size_t WS_KR    = WS_MODP + al256((size_t)2 * 2 * 32 * 6144 * 4);
constexpr size_t WS_KCOMBC= WS_KR + al256((size_t)2 * 256 * KRL * 2);
constexpr size_t WS_FPART = WS_KCOMBC + al256((size_t)2 * LC * 256 * 4);
constexpr size_t WS_FPARTC= WS_FPART + al256((size_t)2 * 256 * 512 * 4);
constexpr size_t WS_FSUM  = WS_FPARTC + al256((size_t)16 * 512 * 4);
constexpr size_t WS_HB    = WS_FSUM + al256((size_t)3 * 256 * 4);
constexpr size_t WS_P     = WS_HB + al256((size_t)T * D * 2);
constexpr size_t WS_XBC   = WS_P + al256((size_t)T * PC * 2);
constexpr size_t WS_DTV   = WS_XBC + al256((size_t)T * 896 * 2);
constexpr size_t WS_ACS   = WS_DTV + al256((size_t)T * 12 * 4);
constexpr size_t WS_ALAST = WS_ACS + al256((size_t)T * 12 * 4);
constexpr size_t WS_STATES= WS_ALAST + al256((size_t)NCH * 12 * 4);
constexpr size_t WS_SSTART= WS_STATES + al256((size_t)2 * NCH * 6 * 128 * 64 * 4);
constexpr size_t WS_U     = WS_SSTART + al256((size_t)2 * NCH * 6 * 128 * 64 * 4);
constexpr size_t WS_UT    = WS_U + al256((size_t)T * 256 * 4);
constexpr size_t WS_UT8   = WS_UT + al256((size_t)256 * L * 2);
constexpr size_t WS_X0T   = WS_UT8 + al256((size_t)256 * L);
constexpr size_t WS_YT    = WS_X0T + al256((size_t)256 * L * 2);
constexpr size_t WS_MIX   = WS_YT + al256((size_t)256 * L * 2);
constexpr size_t WS_MIXO  = WS_MIX + al256((size_t)T * D * 2);
constexpr size_t WS_XCUR  = WS_MIXO + al256((size_t)T * D * 4);
constexpr size_t WS_H2    = WS_XCUR + al256((size_t)T * D * 4);
constexpr size_t WS_RE    = WS_H2 + al256((size_t)(T + 1) * D * 2);
constexpr size_t WS_RP    = WS_RE + al256((size_t)T * 4 * 4);
constexpr size_t WS_RW    = WS_RP + al256((size_t)T * 4 * 4);
constexpr size_t WS_SLOT  = WS_RW + al256((size_t)T * 4 * 4);
constexpr size_t WS_XG    = WS_SLOT + al256((size_t)T * 4 * 4);
constexpr size_t WS_HMID  = WS_XG + 256;
constexpr size_t WS_Y     = WS_HMID + al256((size_t)2 * MAXROWS * D * 2);
constexpr size_t WS_VECS  = WS_Y + al256((size_t)2 * MAXROWS * D * 2);
constexpr size_t WS_ROWTOK= WS_VECS + al256((size_t)2 * 2 * 6 * 1024 * 4);
constexpr size_t WS_END   = WS_ROWTOK + al256((size_t)2 * MAXROWS * 4);

constexpr int CW_BAR = 0;
constexpr int CW_CNT = 8192;
#ifndef INPROJ_FP8
#define INPROJ_FP8 2
#endif
#define F8IN(l) (((INPROJ_FP8) >> (l)) & 1)
#ifndef PRO_NF
#define PRO_NF 96
#endif
constexpr int CW_CVQ = 4160;
constexpr int CW_NT = 4200;
constexpr int CW_TILE = 4224;

__device__ __forceinline__ float bf2f(unsigned short b) { return __uint_as_float(((unsigned)b) << 16); }
__device__ __forceinline__ unsigned short f2bf(float f) { return __builtin_bit_cast(unsigned short, (__bf16)f); }
typedef __bf16 bf16v2 __attribute__((ext_vector_type(2)));
__device__ __forceinline__ unsigned pk_bf16(float lo, float hi) { const bf16v2 v = {(__bf16)lo, (__bf16)hi}; return __builtin_bit_cast(unsigned, v); }
__device__ __forceinline__ float sat8(float x) { return fminf(fmaxf(x, -448.0f), 448.0f); }
__device__ __forceinline__ unsigned pk_fp8x4(float a, float b, float c, float d) { unsigned w = 0; w = __builtin_amdgcn_cvt_pk_fp8_f32(sat8(a), sat8(b), w, false); w = __builtin_amdgcn_cvt_pk_fp8_f32(sat8(c), sat8(d), w, true); return w; }
constexpr float KR_SCALE = 64.0f;
constexpr float W8_SCALE = 32.0f;
constexpr int W8_SCALE_E8M0 = 0x7A7A7A7A, ONE_E8M0 = 0x7F7F7F7F;
__device__ __forceinline__ float bflo(unsigned w) { return __uint_as_float(w << 16); }
__device__ __forceinline__ float bfhi(unsigned w) { return __uint_as_float(w & 0xFFFF0000u); }
__device__ __forceinline__ float silu_f(float x) { return x / (1.0f + __expf(-x)); }
__device__ __forceinline__ float softplus_f(float x) { return x > 20.f ? x : log1pf(__expf(x)); }
__device__ __forceinline__ float row16_ror(float v, int ctrl8421) {
    switch (ctrl8421) {
        case 8: return __int_as_float(__builtin_amdgcn_update_dpp(0, __float_as_int(v), 0x128, 0xF, 0xF, false));
        case 4: return __int_as_float(__builtin_amdgcn_update_dpp(0, __float_as_int(v), 0x124, 0xF, 0xF, false));
        case 2: return __int_as_float(__builtin_amdgcn_update_dpp(0, __float_as_int(v), 0x122, 0xF, 0xF, false));
        default: return __int_as_float(__builtin_amdgcn_update_dpp(0, __float_as_int(v), 0x121, 0xF, 0xF, false));
    }
}
__device__ __forceinline__ float row16_max(float v) { v = fmaxf(v, row16_ror(v, 8)); v = fmaxf(v, row16_ror(v, 4)); v = fmaxf(v, row16_ror(v, 2)); v = fmaxf(v, row16_ror(v, 1)); return v; }
__device__ __forceinline__ float row16_sum(float v) { v += row16_ror(v, 8); v += row16_ror(v, 4); v += row16_ror(v, 2); v += row16_ror(v, 1); return v; }
__device__ __forceinline__ float wave_sum(float v) {
    v = row16_sum(v);
    const int vi = __float_as_int(v);
    return (__int_as_float(__builtin_amdgcn_readlane(vi, 0)) + __int_as_float(__builtin_amdgcn_readlane(vi, 16))) + (__int_as_float(__builtin_amdgcn_readlane(vi, 32)) + __int_as_float(__builtin_amdgcn_readlane(vi, 48)));
}
__device__ __forceinline__ void lds_fence() { asm volatile("s_waitcnt lgkmcnt(0)" ::: "memory"); }

#define XB_TMO      128
#define XB_XCNT(j)  (256  + 64 * (j))
#define XB_XSUB(j)  (1280 + 64 * (j))
#define XB_XGEN(j)  (2304 + 64 * (j))
#define XB_TOP      3328
#define XB_TOPGEN   3392
#define XCD_BAR_WORDS 3456
#define XB_SPIN_CAP (1u << 18)
__device__ __forceinline__ unsigned xb_ld(unsigned* p)              { return __hip_atomic_load(p, __ATOMIC_RELAXED, __HIP_MEMORY_SCOPE_AGENT); }
__device__ __forceinline__ unsigned xb_add(unsigned* p, unsigned v) { return __hip_atomic_fetch_add(p, v, __ATOMIC_RELAXED, __HIP_MEMORY_SCOPE_AGENT); }
__device__ __forceinline__ unsigned xb_xcc_id() { return (unsigned)__builtin_amdgcn_s_getreg((3 << 11) | 20) & 0xFu; }
#define XB_SPIN(cond, bar) do { unsigned _sp = 0; while (cond) { __builtin_amdgcn_s_sleep(1); \
    if ((++_sp & 255u) == 0u) { if (xb_ld(&(bar)[XB_TMO])) break; if (_sp > XB_SPIN_CAP) { atomicAdd(&(bar)[XB_TMO], 1u); break; } } } } while (0)
struct XcdBarrier { unsigned* bar; unsigned x; volatile LAS unsigned* st; };
__device__ __forceinline__ XcdBarrier xcd_barrier_post(unsigned* bar, volatile LAS unsigned* st) {
    XcdBarrier b; b.bar = bar; b.x = xb_xcc_id(); b.st = st;
    if (threadIdx.x == 0) (void)xb_add(&bar[XB_XCNT(b.x)], 1u);
    return b;
}
__device__ __forceinline__ void xcd_barrier_complete(unsigned* bar, unsigned x, unsigned& nloc, unsigned& nx) {
    const unsigned G = gridDim.x * gridDim.y * gridDim.z;
    unsigned sum, cnt, mine, sp = 0u;
    for (;;) {
        sum = 0u; cnt = 0u; mine = 0u;
#pragma unroll
        for (unsigned j = 0; j < 16; ++j) { const unsigned c = xb_ld(&bar[XB_XCNT(j)]); sum += c; cnt += (c > 0u) ? 1u : 0u; mine = (j == x) ? c : mine; }
        if (sum == G) break;
        __builtin_amdgcn_s_sleep(1);
        if ((++sp & 255u) == 0u) { if (xb_ld(&bar[XB_TMO])) break; if (sp > XB_SPIN_CAP) { atomicAdd(&bar[XB_TMO], 1u); break; } }
    }
    nloc = mine > 0u ? mine : 1u; nx = cnt > 0u ? cnt : 1u;
}
__device__ __forceinline__ void xcd_barrier(const XcdBarrier& b) {
    asm volatile("s_waitcnt vmcnt(0)" ::: "memory");
    __syncthreads();
    if (threadIdx.x == 0) {
        unsigned* bar = b.bar;
        __builtin_amdgcn_s_waitcnt(0);
        unsigned nloc = b.st[0], nx = b.st[1];
        if (nloc == 0u) { xcd_barrier_complete(bar, b.x, nloc, nx); b.st[0] = nloc; b.st[1] = nx; }
        const unsigned old = xb_add(&bar[XB_XSUB(b.x)], 1u);
        const unsigned gen = old / nloc;
        if (old + 1u == (gen + 1u) * nloc) {
            __builtin_amdgcn_fence(__ATOMIC_RELEASE, "agent");
            asm volatile("s_waitcnt vmcnt(0)" ::: "memory");
            const unsigned og = xb_add(&bar[XB_TOP], 1u);
            const unsigned tg = og / nx;
            if (og + 1u == (tg + 1u) * nx) xb_add(&bar[XB_TOPGEN], 1u);
            else XB_SPIN(xb_ld(&bar[XB_TOPGEN]) == tg, bar);
            __builtin_amdgcn_fence(__ATOMIC_ACQUIRE, "agent");
            xb_add(&bar[XB_XGEN(b.x)], 1u);
            asm volatile("s_waitcnt vmcnt(0)" ::: "memory");
        } else {
            XB_SPIN(xb_ld(&bar[XB_XGEN(b.x)]) == gen, bar);
            __builtin_amdgcn_fence(__ATOMIC_ACQUIRE, "agent");
            asm volatile("s_waitcnt vmcnt(0)" ::: "memory");
        }
    }
    __syncthreads();
}

#ifndef GEMM_REP
#define GEMM_REP 1
#endif
namespace pg8 {
constexpr int BM = 256, BK = 64, HALF = 128, HTB = HALF * BK * 2, STAGE_BYTES = 8 * HTB;
__host__ __device__ __forceinline__ int lds_byte(int r, int c) { const int st = (r >> 4) * 2 + (c >> 5), rr = r & 15, cc = c & 31, ob = rr * 64 + cc * 2; return st * 1024 + (ob ^ (((ob >> 9) & 1) << 5)); }
__host__ __device__ __forceinline__ void stage_rc(int b, int& R, int& C) { const int st = b / 1024, sb = b % 1024, swz = sb ^ (((sb >> 9) & 1) << 5); R = (st >> 1) * 16 + swz / 64; C = (st & 1) * 32 + (swz % 64) / 2; }
__host__ __device__ __forceinline__ int perm32(int rho) { const int n = rho >> 4, i = rho & 15; return 8 * (i >> 2) + 4 * n + (i & 3); }

struct Unit { int pa, pb, pn, e; };
struct Gemm { const bf16_t* A; const bf16_t* Bt; int K; };

template <class Epi, class Sched, bool ALIGN_EPI = true, bool GATHER = false, bool FP8 = false>
__device__ __forceinline__ void gemm_phase(LAS unsigned char* lds, const Gemm g, const Sched& S, const Epi& E, const int tid, const LAS int* rowtab = nullptr) {
    const int wid = __builtin_amdgcn_readfirstlane(tid >> 6), lane = tid & 63, wr = wid >> 2, wc = wid & 3, fr = lane & 15, fq = lane >> 4;
    const int K = g.K, nt = K / BK;
    unsigned voffA[2], voffB[2];
    int gR[2], gC[2];
#pragma unroll
    for (int i = 0; i < 2; ++i) { int R, C; stage_rc(tid * 16 + i * 8192, R, C); const int Rb = Epi::PERM ? ((R & ~31) + perm32(R & 31)) : R;
        voffA[i] = (unsigned)(R * K + C) * 2u; voffB[i] = (unsigned)(Rb * K + C) * 2u; gR[i] = R; gC[i] = C * 2; }
    unsigned vC0[2], vC1[2], vN0[2], vN1[2];
#define PG8_GOFFS(dst0, dst1, ui_) do { _Pragma("unroll") for (int _i = 0; _i < 2; ++_i) { \
        dst0[_i] = (unsigned)rowtab[(ui_) * 256 + gR[_i]] * (unsigned)(K * 2) + (unsigned)gC[_i]; dst1[_i] = (unsigned)rowtab[(ui_) * 256 + 128 + gR[_i]] * (unsigned)(K * 2) + (unsigned)gC[_i]; } } while (0)
    const size_t kstep = (size_t)(BK * 2);
    const size_t hstep = (size_t)HALF * K * 2;
    const size_t tstep = 2 * hstep;
    const unsigned ldsw = (unsigned)wid * 1024u;
    const int aoff = lds_byte(wr * 64 + fr, fq * 8), boff = lds_byte(wc * 32 + fr, fq * 8);
#define PG8_SA(b, h) (((b) * 2 + (h)) * HTB)
#define PG8_SB(b, h) ((4 + (b) * 2 + (h)) * HTB)
#define PG8_STAGE(bufoff, gbase, voff) do { _Pragma("unroll") for (int _i = 0; _i < 2; ++_i) \
        __builtin_amdgcn_global_load_lds((const unsigned*)((const char*)(gbase) + (voff)[_i]), (LAS unsigned*)(lds + (bufoff) + ldsw + _i * 8192), 16, 0, 0); } while (0)
#define PG8_LDA(dst, b, h) do { _Pragma("unroll") for (int m = 0; m < 4; ++m) { const v4i _x = *(const LAS v4i*)(lds + PG8_SA(b, h) + aoff + m * 2048), _y = *(const LAS v4i*)(lds + PG8_SA(b, h) + aoff + m * 2048 + 1024); \
        dst[m] = __builtin_shufflevector(_x, _y, 0, 1, 2, 3, 4, 5, 6, 7); } } while (0)
#define PG8_LDB(dst, b, h) do { _Pragma("unroll") for (int n = 0; n < 2; ++n) { const v4i _x = *(const LAS v4i*)(lds + PG8_SB(b, h) + boff + n * 2048), _y = *(const LAS v4i*)(lds + PG8_SB(b, h) + boff + n * 2048 + 1024); \
        dst[n] = __builtin_shufflevector(_x, _y, 0, 1, 2, 3, 4, 5, 6, 7); } } while (0)
#define PG8_HALF0(x) __builtin_bit_cast(bf16x8, __builtin_shufflevector((x), (x), 0, 1, 2, 3))
#define PG8_HALF1(x) __builtin_bit_cast(bf16x8, __builtin_shufflevector((x), (x), 4, 5, 6, 7))
#define PG8_MMA(ai, bj, At, Bt) do { __builtin_amdgcn_s_setprio(1); if constexpr (FP8) { _Pragma("unroll") for (int m = 0; m < 4; ++m) _Pragma("unroll") for (int n = 0; n < 2; ++n) \
        asm volatile("v_mfma_scale_f32_16x16x128_f8f6f4 %0, %1, %2, %0, %3, %4 op_sel_hi:[0,0,0]" : "+v"(acc[ai][bj][m][n]) : "v"(Bt[n]), "v"(At[m]), "v"(sclW), "v"(sclX)); } \
        else { _Pragma("unroll") for (int m = 0; m < 4; ++m) _Pragma("unroll") for (int n = 0; n < 2; ++n) { \
        acc[ai][bj][m][n] = __builtin_amdgcn_mfma_f32_16x16x32_bf16(PG8_HALF0(Bt[n]), PG8_HALF0(At[m]), acc[ai][bj][m][n], 0, 0, 0); \
        acc[ai][bj][m][n] = __builtin_amdgcn_mfma_f32_16x16x32_bf16(PG8_HALF1(Bt[n]), PG8_HALF1(At[m]), acc[ai][bj][m][n], 0, 0, 0); } } __builtin_amdgcn_s_setprio(0); } while (0)
#define PG8_WAIT_V(n) asm volatile("s_waitcnt vmcnt(" #n ")" ::: "memory")
#define PG8_WAIT_L(n) asm volatile("s_waitcnt lgkmcnt(" #n ")" ::: "memory")
#define PG8_BAR __builtin_amdgcn_s_barrier()
#define PG8_SCHED __builtin_amdgcn_sched_barrier(0)
    Unit cur, nxt; int ui = 0;
    if (!S.next(0, cur)) return;
    f32x4 acc[2][2][4][2];
    E.init(acc, cur, wc, fq);
    const int sclW = W8_SCALE_E8M0, sclX = ONE_E8M0;
    v8i At[4], B0[2], B1[2];
    const char* cA = GATHER ? (const char*)g.A : (const char*)g.A + (size_t)cur.pa * tstep; const char* cB = (const char*)g.Bt + (size_t)cur.pb * tstep;
    const size_t hstepA = GATHER ? 0 : hstep;
    if constexpr (GATHER) { PG8_GOFFS(vC0, vC1, 0); } else {
#pragma unroll
        for (int i = 0; i < 2; ++i) { vC0[i] = voffA[i]; vC1[i] = voffA[i]; vN0[i] = voffA[i]; vN1[i] = voffA[i]; } }
    PG8_STAGE(PG8_SB(0, 0), cB, voffB); PG8_STAGE(PG8_SB(0, 1), cB + hstep, voffB); PG8_STAGE(PG8_SA(0, 0), cA, vC0); PG8_STAGE(PG8_SA(0, 1), cA + hstepA, vC1);
    if (wr == 1) PG8_BAR;
    PG8_WAIT_V(2); PG8_BAR;
    PG8_STAGE(PG8_SB(1, 0), cB + kstep, voffB); PG8_STAGE(PG8_SA(1, 0), cA + kstep, vC0); PG8_STAGE(PG8_SB(1, 1), cB + hstep + kstep, voffB);
    PG8_WAIT_V(6); PG8_BAR;
    for (;;) {
        const bool has_next = S.next(ui + 1, nxt);
        const char* nA = GATHER ? (const char*)g.A : (has_next ? (const char*)g.A + (size_t)nxt.pa * tstep : cA); const char* nB = has_next ? (const char*)g.Bt + (size_t)nxt.pb * tstep : cB;
        if constexpr (GATHER) { if (has_next) { PG8_GOFFS(vN0, vN1, ui + 1); } else {
#pragma unroll
            for (int i = 0; i < 2; ++i) { vN0[i] = vC0[i]; vN1[i] = vC1[i]; } } }
#pragma unroll 1
        for (int t = 0; t < nt; t += 2) {
            const bool last = (t == nt - 2);
            unsigned vX0[2], vX1[2];
#pragma unroll
            for (int i = 0; i < 2; ++i) { vX0[i] = (GATHER && last) ? vN0[i] : vC0[i]; vX1[i] = (GATHER && last) ? vN1[i] : vC1[i]; }
            const char* a1 = cA + (size_t)(t + 1) * kstep;
            const char* a2 = last ? nA : cA + (size_t)(t + 2) * kstep; const char* b2 = last ? nB : cB + (size_t)(t + 2) * kstep;
            const char* a3 = a2 + kstep; const char* b3 = b2 + kstep;
            PG8_LDB(B0, 0, 0); PG8_LDB(B1, 0, 1); PG8_SCHED; PG8_LDA(At, 0, 0); PG8_STAGE(PG8_SA(1, 1), a1 + hstepA, vC1);
            PG8_WAIT_V(8); PG8_WAIT_L(0); PG8_BAR; PG8_MMA(0, 0, At, B0); PG8_MMA(0, 1, At, B1); PG8_BAR; PG8_SCHED;
            PG8_LDA(At, 0, 1); PG8_STAGE(PG8_SB(0, 0), b2, voffB); PG8_STAGE(PG8_SB(0, 1), b2 + hstep, voffB); PG8_STAGE(PG8_SA(0, 0), a2, vX0);
            PG8_WAIT_V(8); PG8_WAIT_L(0); PG8_BAR; PG8_MMA(1, 0, At, B0); PG8_MMA(1, 1, At, B1); PG8_BAR; PG8_SCHED;
            PG8_LDB(B0, 1, 0); PG8_LDB(B1, 1, 1); PG8_SCHED; PG8_LDA(At, 1, 0); PG8_STAGE(PG8_SA(0, 1), a2 + hstepA, vX1);
            PG8_WAIT_V(8); PG8_WAIT_L(0); PG8_BAR; PG8_MMA(0, 0, At, B0); PG8_MMA(0, 1, At, B1); PG8_BAR; PG8_SCHED;
            PG8_LDA(At, 1, 1); PG8_STAGE(PG8_SB(1, 0), b3, voffB); PG8_STAGE(PG8_SB(1, 1), b3 + hstep, voffB); PG8_STAGE(PG8_SA(1, 0), a3, vX0);
            PG8_WAIT_V(8); PG8_WAIT_L(0); PG8_BAR; PG8_MMA(1, 0, At, B0); PG8_MMA(1, 1, At, B1); PG8_BAR; PG8_SCHED;
        }
        if constexpr (ALIGN_EPI) { if (wr == 0) PG8_BAR; }
        E(acc, cur, wr, wc, fr, fq);
        if (!has_next) break;
        E.init(acc, nxt, wc, fq);
        cur = nxt; cA = nA; cB = nB; ++ui;
        if constexpr (GATHER) {
#pragma unroll
            for (int i = 0; i < 2; ++i) { vC0[i] = vN0[i]; vC1[i] = vN1[i]; } }
        if constexpr (ALIGN_EPI) { if (wr == 1) PG8_BAR; }
    }
    PG8_WAIT_V(0);
    if constexpr (!ALIGN_EPI) { if (wr == 0) PG8_BAR; }
    PG8_BAR;
#undef PG8_GOFFS
#undef PG8_HALF0
#undef PG8_HALF1
#undef PG8_SA
#undef PG8_SB
#undef PG8_STAGE
#undef PG8_LDA
#undef PG8_LDB
#undef PG8_MMA
#undef PG8_WAIT_V
#undef PG8_WAIT_L
#undef PG8_BAR
#undef PG8_SCHED
}

struct EpiF32 {
    static constexpr bool PERM = false;
    float* C; int ldc;
    __device__ __forceinline__ void operator()(const f32x4 (&acc)[2][2][4][2], const Unit& u, int wr, int wc, int fr, int fq) const {
        const int row0 = u.pa * BM + wr * 64 + fr, col0 = u.pn * BM + wc * 32 + 4 * fq;
#pragma unroll
        for (int ai = 0; ai < 2; ++ai)
#pragma unroll
            for (int m = 0; m < 4; ++m) { float* rowp = C + (size_t)(row0 + ai * HALF + m * 16) * ldc + col0;
#pragma unroll
                for (int bj = 0; bj < 2; ++bj)
#pragma unroll
                    for (int n = 0; n < 2; ++n) *(f32x4*)(rowp + bj * HALF + n * 16) = acc[ai][bj][m][n]; }
    }
};
struct EpiBf16 {
    static constexpr bool PERM = true;
    bf16_t* O; int ldc; const float* bias; int bias_stride;
    __device__ __forceinline__ void init(f32x4 (&acc)[2][2][4][2], const Unit& u, int wc, int fq) const {
        const int col0 = u.pn * BM + wc * 32 + 8 * fq;
#pragma unroll
        for (int bj = 0; bj < 2; ++bj)
#pragma unroll
            for (int n = 0; n < 2; ++n) { const f32x4 bv = bias ? *(const f32x4*)(bias + (size_t)u.e * bias_stride + col0 + bj * HALF + 4 * n) : (f32x4){0.f, 0.f, 0.f, 0.f};
#pragma unroll
                for (int ai = 0; ai < 2; ++ai)
#pragma unroll
                    for (int m = 0; m < 4; ++m) acc[ai][bj][m][n] = bv; }
    }
    __device__ __forceinline__ void operator()(const f32x4 (&acc)[2][2][4][2], const Unit& u, int wr, int wc, int fr, int fq) const {
        const int row0 = u.pa * BM + wr * 64 + fr; const int col0 = u.pn * BM + wc * 32 + 8 * fq;
#pragma unroll
        for (int ai = 0; ai < 2; ++ai)
#pragma unroll
            for (int m = 0; m < 4; ++m) { bf16_t* rowp = O + (size_t)(row0 + ai * HALF + m * 16) * ldc + col0;
#pragma unroll
                for (int bj = 0; bj < 2; ++bj) { const f32x4 v0 = acc[ai][bj][m][0], v1 = acc[ai][bj][m][1];
                    u32x4 w; w.x = pk_bf16(v0[0], v0[1]); w.y = pk_bf16(v0[2], v0[3]); w.z = pk_bf16(v1[0], v1[1]); w.w = pk_bf16(v1[2], v1[3]);
                    *(u32x4*)(rowp + bj * HALF) = w; } }
    }
};
struct EpiAct {
    static constexpr bool PERM = true;
    unsigned char* O; const float* bias;
    __device__ __forceinline__ void init(f32x4 (&acc)[2][2][4][2], const Unit& u, int wc, int fq) const {
        const float* bg = bias + (size_t)u.e * 2048 + u.pn * 128 + wc * 32 + 8 * fq;
#pragma unroll
        for (int bj = 0; bj < 2; ++bj)
#pragma unroll
            for (int n = 0; n < 2; ++n) { const f32x4 bv = *(const f32x4*)(bg + bj * 1024 + 4 * n);
#pragma unroll
                for (int ai = 0; ai < 2; ++ai)
#pragma unroll
                    for (int m = 0; m < 4; ++m) acc[ai][bj][m][n] = bv; }
    }
    __device__ __forceinline__ void operator()(const f32x4 (&acc)[2][2][4][2], const Unit& u, int wr, int wc, int fr, int fq) const {
        const int row0 = u.pa * BM + wr * 64 + fr; const int cc0 = wc * 32 + 8 * fq; const int ocol = u.pn * 128 + cc0;
#pragma unroll
        for (int ai = 0; ai < 2; ++ai)
#pragma unroll
            for (int m = 0; m < 4; ++m) { unsigned char* rowp = O + (size_t)(row0 + ai * HALF + m * 16) * D + ocol;
                float r[8];
#pragma unroll
                for (int n = 0; n < 2; ++n)
#pragma unroll
                    for (int j = 0; j < 4; ++j) { float gt = acc[ai][0][m][n][j], up = acc[ai][1][m][n][j];
                        gt = fminf(gt, 7.0f); up = fminf(fmaxf(up, -7.0f), 7.0f);
                        r[n * 4 + j] = gt / (1.0f + __expf(-1.702f * gt)) * (up + 1.0f); }
                u32x2 w; w.x = pk_fp8x4(r[0], r[1], r[2], r[3]); w.y = pk_fp8x4(r[4], r[5], r[6], r[7]);
                *(u32x2*)rowp = w; }
    }
};
struct SchedGrid {
    int nN, total, G, c;
    __device__ __forceinline__ bool next(int i, Unit& u) const { int Lx = i * G + c; if (Lx >= GEMM_REP * total) return false; if (GEMM_REP > 1) Lx %= total; u.pa = Lx / nN; u.pn = Lx - u.pa * nN; u.pb = u.pn; u.e = 0; return true; }
};
struct SchedMoe {
    int nN, total, G, c; const int* tile_e;
    __device__ __forceinline__ bool next(int i, Unit& u) const { int Lx = i * G + c; if (Lx >= GEMM_REP * total) return false; if (GEMM_REP > 1) Lx %= total; u.pa = Lx / nN; u.pn = Lx - u.pa * nN; u.e = __builtin_amdgcn_readfirstlane((int)tile_e[u.pa]); u.pb = u.e * nN + u.pn; return true; }
};
}

struct Args { const float* in[N_IN]; float* out; unsigned char* ws; int ph_lo, ph_hi; };

typedef const float* __attribute__((address_space(4))) const* kargp_t;
struct InProxy { kargp_t kp; __device__ __forceinline__ const float* operator[](int i) const { return kp[i]; } };
struct Frame {
    InProxy in; float* out; unsigned char* ws;
    LAS unsigned char* lds;
    int tid, lane, wave, G, bid, vid;
    template <class Tp> __device__ __forceinline__ Tp* w(size_t off) const { return (Tp*)(ws + off); }
};

__device__ __forceinline__ Frame launder(const Frame& F) {
    Frame R = F;
    int t = F.tid; asm volatile("" : "+v"(t)); R.tid = t; R.lane = t & 63; R.wave = __builtin_amdgcn_readfirstlane(t >> 6);
    unsigned long long w = (unsigned long long)F.ws; asm volatile("" : "+s"(w)); R.ws = (unsigned char*)w;
    unsigned long long o = (unsigned long long)F.out; asm volatile("" : "+s"(o)); R.out = (float*)o;
    unsigned long long k = (unsigned long long)F.in.kp; asm volatile("" : "+s"(k)); R.in.kp = (kargp_t)k;
    int g = F.G, b = F.bid; asm volatile("" : "+s"(g), "+s"(b)); R.G = g; R.bid = b; R.vid = (g % 8 == 0) ? (b % 8) * (g / 8) + b / 8 : b;
    return R;
}

__device__ __forceinline__ float mod_val(const Frame& F, int l, int which, int j) {
    const float* mp = F.w<float>(WS_MODP) + (size_t)((l * 2 + which) * 32) * 6144 + j;
    float s = F.in[I_BMOD][l * 6144 + j];
#pragma unroll
    for (int k = 0; k < 32; ++k) s += mp[(size_t)k * 6144];
    return s;
}

struct CvtTile { const float* src; bf16_t* dst; int ld, mode, k0, n0; bool f8; };
__device__ __forceinline__ CvtTile cvt_decode(const Frame& F, int t) {
    CvtTile c;
    if (t < 1664) { const int l = t / 832, r = t % 832; c.n0 = (r / 16) * 64; c.k0 = (r % 16) * 64; c.src = F.in[I_WIN] + (size_t)l * 1024 * 3212; c.ld = 3212; c.mode = 1; c.f8 = F8IN(l) != 0; c.dst = F.w<bf16_t>(WS_WINT) + (size_t)l * PC * D; }
    else if (t < 2176) { const int q = t - 1664, l = q / 256, r = q % 256; c.n0 = (r / 16) * 64; c.k0 = (r % 16) * 64; c.src = F.in[I_WOUT] + (size_t)l * D * D; c.ld = 1024; c.mode = 0; c.f8 = false; c.dst = F.w<bf16_t>(WS_WOUTT) + (size_t)l * D * D; }
    else if (t < 34944) { const int q = t - 2176, le = q / 512, r = q % 512; c.n0 = (r / 16) * 64; c.k0 = (r % 16) * 64; c.src = F.in[I_WGU] + (size_t)le * 1024 * 2048; c.ld = 2048; c.mode = 2; c.f8 = true; c.dst = (bf16_t*)(F.w<unsigned char>(WS_WGUT) + (size_t)le * 2048 * D); }
    else { const int q = t - 34944, le = q / 256, r = q % 256; c.n0 = (r / 16) * 64; c.k0 = (r % 16) * 64; c.src = F.in[I_WDN] + (size_t)le * D * D; c.ld = 1024; c.mode = 0; c.f8 = true; c.dst = (bf16_t*)(F.w<unsigned char>(WS_WDT) + (size_t)le * D * D); }
    return c;
}
__device__ __forceinline__ void cvt_load(const CvtTile& c, int lane, f32x4 (&a)[8], f32x4 (&b)[8]) {
    const int i4 = lane & 15, kpl = lane >> 4;
    const int n = c.n0 + 4 * i4;
    int sc; bool valid = true;
    if (c.mode == 0) sc = n;
    else if (c.mode == 1) { if (n < 1280) sc = n; else if (n < 3200) sc = n + 12; else if (n < 3212) sc = n - 3200 + 1280; else { sc = 0; valid = false; } }
    else { const int pn = n >> 8, rr = n & 255; sc = rr < 128 ? pn * 128 + rr : 1024 + pn * 128 + (rr - 128); }
#pragma unroll
    for (int it = 0; it < 8; ++it) {
        const int r0 = c.f8 ? 4 * (kpl + 4 * (it >> 1)) + 2 * (it & 1) : 2 * (kpl + 4 * it);
        a[it] = (f32x4){0.f, 0.f, 0.f, 0.f}; b[it] = a[it];
        if (valid) { a[it] = __builtin_nontemporal_load((const f32x4*)(c.src + (size_t)(c.k0 + r0) * c.ld + sc)); b[it] = __builtin_nontemporal_load((const f32x4*)(c.src + (size_t)(c.k0 + r0 + 1) * c.ld + sc)); }
    }
}
__device__ __forceinline__ void cvt_store(const CvtTile& c, int lane, const f32x4 (&a)[8], const f32x4 (&b)[8], LAS unsigned* lw) {
    const int i4 = lane & 15, kpl = lane >> 4;
    if (c.f8) {
#pragma unroll
        for (int j = 0; j < 4; ++j) {
            const int kq = kpl + 4 * j;
#pragma unroll
            for (int i = 0; i < 4; ++i) lw[kq * 65 + 4 * i4 + i] = pk_fp8x4(W8_SCALE * a[2 * j][i], W8_SCALE * b[2 * j][i], W8_SCALE * a[2 * j + 1][i], W8_SCALE * b[2 * j + 1][i]);
        }
        lds_fence();
        const int g = lane & 3, nl = lane >> 2;
        unsigned char* d8 = (unsigned char*)c.dst;
#pragma unroll
        for (int it = 0; it < 4; ++it) {
            const int nn = nl + 16 * it;
            u32x4 v; v.x = lw[(4 * g + 0) * 65 + nn]; v.y = lw[(4 * g + 1) * 65 + nn]; v.z = lw[(4 * g + 2) * 65 + nn]; v.w = lw[(4 * g + 3) * 65 + nn];
            *(u32x4*)(d8 + (size_t)(c.n0 + nn) * 1024 + c.k0 + 16 * g) = v;
        }
        lds_fence();
        return;
    }
#pragma unroll
    for (int it = 0; it < 8; ++it) {
        const int kp = kpl + 4 * it;
#pragma unroll
        for (int i = 0; i < 4; ++i) lw[kp * 65 + 4 * i4 + i] = pk_bf16(a[it][i], b[it][i]);
    }
    lds_fence();
    const int g = lane & 7, nl = lane >> 3;
#pragma unroll
    for (int it = 0; it < 8; ++it) {
        const int nn = nl + 8 * it;
        u32x4 v; v.x = lw[(4 * g + 0) * 65 + nn]; v.y = lw[(4 * g + 1) * 65 + nn]; v.z = lw[(4 * g + 2) * 65 + nn]; v.w = lw[(4 * g + 3) * 65 + nn];
        *(u32x4*)(c.dst + (size_t)(c.n0 + nn) * 1024 + c.k0 + 8 * g) = v;
    }
    lds_fence();
}

__device__ __forceinline__ void cvt_store8x2(const CvtTile& c, int lane, const f32x4 (&a0)[8], const f32x4 (&b0)[8], const f32x4 (&a1)[8], const f32x4 (&b1)[8], LAS unsigned* lw) {
    const int i4 = lane & 15, kpl = lane >> 4;
#pragma unroll
    for (int j = 0; j < 4; ++j) {
        const int kq = kpl + 4 * j;
#pragma unroll
        for (int i = 0; i < 4; ++i) {
            lw[kq * 65 + 4 * i4 + i] = pk_fp8x4(W8_SCALE * a0[2 * j][i], W8_SCALE * b0[2 * j][i], W8_SCALE * a0[2 * j + 1][i], W8_SCALE * b0[2 * j + 1][i]);
            lw[(16 + kq) * 65 + 4 * i4 + i] = pk_fp8x4(W8_SCALE * a1[2 * j][i], W8_SCALE * b1[2 * j][i], W8_SCALE * a1[2 * j + 1][i], W8_SCALE * b1[2 * j + 1][i]);
        }
    }
    lds_fence();
    const int g = lane & 7, nl = lane >> 3;
    unsigned char* d8 = (unsigned char*)c.dst;
#pragma unroll
    for (int it = 0; it < 8; ++it) {
        const int nn = nl + 8 * it;
        u32x4 v; v.x = lw[(4 * g + 0) * 65 + nn]; v.y = lw[(4 * g + 1) * 65 + nn]; v.z = lw[(4 * g + 2) * 65 + nn]; v.w = lw[(4 * g + 3) * 65 + nn];
        *(u32x4*)(d8 + (size_t)(c.n0 + nn) * 1024 + c.k0 + 16 * g) = v;
    }
    lds_fence();
}
__device__ __forceinline__ void ph_convert(const Frame& F) {
    LAS unsigned* lw = (LAS unsigned*)(F.lds) + F.wave * (32 * 65 + 16);
    const int nwaves = F.G * 8, w0 = F.bid * 8 + F.wave;
    f32x4 a0[8], b0[8], a1[8], b1[8];
    for (int t = w0; t < 2176; t += nwaves) { const CvtTile c = cvt_decode(F, t); cvt_load(c, F.lane, a0, b0); cvt_store(c, F.lane, a0, b0, lw); }
    unsigned* ctr = F.w<unsigned>(WS_CTL) + CW_CVQ;
    for (;;) {
        unsigned tb = 0;
        if (F.lane == 0) tb = atomicAdd(ctr, 4u);
        tb = __builtin_amdgcn_readfirstlane(tb);
        if (tb >= 16384u + 8192u) break;
        for (int t = (int)tb; t < (int)tb + 4; ++t) {
            CvtTile c; c.f8 = true;
            if (t < 16384) { const int le = t >> 8, r = t & 255; c.n0 = (r >> 3) * 64; c.k0 = (r & 7) * 128; c.src = F.in[I_WGU] + (size_t)le * 1024 * 2048; c.ld = 2048; c.mode = 2; c.dst = (bf16_t*)(F.w<unsigned char>(WS_WGUT) + (size_t)le * 2048 * D); }
            else { const int q = t - 16384, le = q >> 7, r = q & 127; c.n0 = (r >> 3) * 64; c.k0 = (r & 7) * 128; c.src = F.in[I_WDN] + (size_t)le * D * D; c.ld = 1024; c.mode = 0; c.dst = (bf16_t*)(F.w<unsigned char>(WS_WDT) + (size_t)le * D * D); }
            cvt_load(c, F.lane, a0, b0);
            CvtTile c2 = c; c2.k0 = c.k0 + 64;
            cvt_load(c2, F.lane, a1, b1);
            cvt_store8x2(c, F.lane, a0, b0, a1, b1, lw);
        }
    }
}

__device__ __forceinline__ void ph_modpart(const Frame& F) {
    for (int it = F.bid; it < 768; it += F.G) {
        const int l = it / 384, r = it % 384, cc = r / 32, kc = r % 32;
        const int j = cc * 512 + F.tid;
        const float* wm = F.in[I_WMOD] + (size_t)l * D * 6144 + (size_t)(kc * 32) * 6144 + j;
        float wv[32];
#pragma unroll
        for (int k = 0; k < 32; ++k) wv[k] = wm[(size_t)k * 6144];
        float a0 = 0.f, a1 = 0.f;
#pragma unroll
        for (int k = 0; k < 32; ++k) { a0 += silu_f(F.in[I_C][kc * 32 + k]) * wv[k]; a1 += silu_f(F.in[I_CCTX][kc * 32 + k]) * wv[k]; }
        float* mp = F.w<float>(WS_MODP);
        mp[(size_t)((l * 2 + 0) * 32 + kc) * 6144 + j] = a0;
        mp[(size_t)((l * 2 + 1) * 32 + kc) * 6144 + j] = a1;
    }
}

__device__ __forceinline__ void ph_filter(const Frame& F) {
    LAS float* zs = (LAS float*)F.lds;
    LAS float* h1 = zs + 64 * 33;
    LAS unsigned char* H2b = F.lds + 24832;
    LAS unsigned char* ob = F.lds + 34048;
    LAS float* w1s = (LAS float*)(F.lds + 68864);
    LAS float* w2s = w1s + 33 * 64;
    const float min_decay = -4.605170185988091f / 1.5f, max_decay = -4.605170185988091f / 0.3f;
    const int wave = F.wave;
    const int nf = F.G < PRO_NF ? F.G : PRO_NF;
    if (F.bid >= nf) return;
    for (int it = F.bid; it < 512 + 16; it += nf) {
        int tid = F.tid; asm volatile("" : "+v"(tid));
        const int lane = tid & 63;
        const bool isctx = it >= 512;
        const int l = isctx ? 0 : it / 256, grp = isctx ? it - 512 : it % 256;
        const int Lx = isctx ? LC : L, npos = isctx ? 16 : 64;
        const int t0 = grp * npos;
        __syncthreads();
        for (int q = tid; q < 33 * 64 + 64 * 64; q += NTHREADS) { if (q < 33 * 64) w1s[q] = F.in[I_FW1][(size_t)l * 33 * 64 + q]; else w2s[q - 33 * 64] = F.in[I_FW2][(size_t)l * 64 * 64 + q - 33 * 64]; }
#pragma unroll 1
        for (int q = tid; q < npos * 33; q += NTHREADS) {
            const int pos = q / 33, i = q % 33; const int t = t0 + pos;
            const float tn = (float)t / (float)(Lx - 1);
            const float wv = 6.283185307179586f * (float)t / (float)Lx;
            float v;
            if (i == 0) v = tn;
            else { const int b = (i - 1) & 15; const float f = 1e-4f + (float)b * ((15.0f - 1e-4f) / 15.0f); v = (i <= 16) ? cosf(f * wv) : -sinf(f * wv); }
            zs[q] = v;
        }
        __syncthreads();
        {
            asm volatile("" : "+v"(tid));
            const int o = tid & 63, pg = tid >> 6;
            if (pg * 8 < npos) {
                float acc[8];
                const float bb = F.in[I_FB1][l * 64 + o];
#pragma unroll
                for (int p = 0; p < 8; ++p) acc[p] = bb;
#pragma unroll 3
                for (int i = 0; i < 33; ++i) { const float w = w1s[i * 64 + o];
#pragma unroll
                    for (int p = 0; p < 8; ++p) acc[p] += zs[(pg * 8 + p) * 33 + i] * w; }
                const float fq = F.in[I_FREQ][l * 128 + o];
#pragma unroll
                for (int p = 0; p < 8; ++p) h1[(pg * 8 + p) * 64 + o] = sinf(fq * acc[p]);
            }
        }
        __syncthreads();
        {
            asm volatile("" : "+v"(tid));
            const int o = tid & 63, pg = tid >> 6;
            if (pg * 8 < npos) {
                float acc[8];
                const float bb = F.in[I_FB2][l * 64 + o];
#pragma unroll
                for (int p = 0; p < 8; ++p) acc[p] = bb;
#pragma unroll 4
                for (int i = 0; i < 64; ++i) { const float w = w2s[i * 64 + o];
#pragma unroll
                    for (int p = 0; p < 8; ++p) acc[p] += h1[(pg * 8 + p) * 64 + i] * w; }
                const float fq = F.in[I_FREQ][l * 128 + 64 + o];
#pragma unroll
                for (int p = 0; p < 8; ++p) *(LAS bf16_t*)(H2b + (pg * 8 + p) * 144 + o * 2) = f2bf(sinf(fq * acc[p]));
            }
        }
        __syncthreads();
        {
            int r = lane & 31, hf = lane >> 5;
#pragma unroll
            for (int n = 0; n < 2; ++n) {
                asm volatile("" : "+v"(r), "+v"(hf));
                const int o = 32 * (2 * wave + n) + r, c = o & 255, dir = o >> 8;
                const float* w3 = F.in[I_FW3] + (size_t)l * 64 * 512 + o;
                f32x16 acc[2];
#pragma unroll
                for (int m = 0; m < 2; ++m)
#pragma unroll
                    for (int i = 0; i < 16; ++i) acc[m][i] = 0.f;
                float wv[4][8];
#pragma unroll
                for (int ks = 0; ks < 4; ++ks)
#pragma unroll
                    for (int e = 0; e < 8; ++e) wv[ks][e] = w3[(size_t)(16 * ks + 8 * hf + e) * 512];
#pragma unroll
                for (int ks = 0; ks < 4; ++ks) {
                    bf16x8 b;
#pragma unroll
                    for (int e = 0; e < 8; ++e) b[e] = (short)f2bf(wv[ks][e]);
#pragma unroll
                    for (int m = 0; m < 2; ++m) {
                        const bf16x8 a = *(const LAS bf16x8*)(H2b + (32 * m + r) * 144 + (16 * ks + 8 * hf) * 2);
                        acc[m] = __builtin_amdgcn_mfma_f32_32x32x16_bf16(a, b, acc[m], 0, 0, 0);
                    }
                }
                const float delta = fabsf(min_decay + (float)c * ((max_decay - min_decay) / 255.0f));
                const float dstep = delta / (float)(Lx - 1);
                float asum = 0.f;
                if (!isctx) {
#pragma unroll
                    for (int m = 0; m < 2; ++m)
#pragma unroll
                        for (int rg = 0; rg < 16; ++rg) {
                            const int pos = 32 * m + (rg & 3) + 8 * (rg >> 2) + 4 * hf;
                            const float v = acc[m][rg] * __expf(-(float)(t0 + pos) * dstep);
                            asum += fabsf(v);
                            ob[o * 68 + pos] = (unsigned char)(pk_fp8x4(KR_SCALE * v, 0.f, 0.f, 0.f) & 0xFFu);
                        }
                } else {
                    float* kc = F.w<float>(WS_KCOMBC);
#pragma unroll
                    for (int rg = 0; rg < 8; ++rg) {
                        const int pos = (rg & 3) + 8 * (rg >> 2) + 4 * hf, t = t0 + pos;
                        const float v = acc[0][rg] * __expf(-(float)t * dstep);
                        asum += fabsf(v);
                        const int x = dir == 0 ? Lx - 1 + t : Lx - 1 - t;
                        if (dir == 0 || t >= 1) kc[(size_t)x * 256 + c] = v;
                    }
                }
                asum += __shfl_xor(asum, 32);
                if (hf == 0) { if (isctx) F.w<float>(WS_FPARTC)[grp * 512 + o] = asum; else F.w<float>(WS_FPART)[((size_t)l * 256 + grp) * 512 + o] = asum; }
            }
        }
        if (!isctx) {
            __syncthreads();
            unsigned char* KR = F.w<unsigned char>(WS_KR) + (size_t)l * 256 * KRL;
            asm volatile("" : "+v"(tid));
            for (int q = tid; q < 512 * 64; q += NTHREADS) {
                const int o = q >> 6, p = q & 63, c = o & 255, dir = o >> 8;
                if (dir == 0) KR[(size_t)c * KRL + (L - t0 - 63 + p)] = ob[o * 68 + 63 - p];
                else if (t0 + p >= 1) KR[(size_t)c * KRL + (L + t0 + p)] = ob[o * 68 + p];
            }
            if (grp == 0) for (int q = tid; q < 256 * 513; q += NTHREADS) { const int c = q / 513, r = q % 513; KR[(size_t)c * KRL + (r == 512 ? 0 : 2 * L + r)] = 0; }
        }
    }
}

__device__ __forceinline__ void ph_fsum(const Frame& F) {
    const int nwaves = F.G * 8;
    for (int o = F.bid * 8 + F.wave; o < 768; o += nwaves) {
        const int which = o >> 8, c = o & 255;
        float s = 0.f;
        if (which < 2) { const float* fp = F.w<float>(WS_FPART) + (size_t)which * 256 * 512;
            for (int i = F.lane; i < 256; i += 64) s += fp[(size_t)i * 512 + c] + fp[(size_t)i * 512 + 256 + c]; }
        else { const float* fp = F.w<float>(WS_FPARTC); if (F.lane < 16) s = fp[F.lane * 512 + c] + fp[F.lane * 512 + 256 + c]; }
        s = wave_sum(s);
        if (F.lane == 0) F.w<float>(WS_FSUM)[o] = 1.0f / s;
    }
}

__device__ __forceinline__ void ph_vecs(const Frame& F) {
    for (int q = F.bid * NTHREADS + F.tid; q < 2 * 2 * 6 * 1024; q += F.G * NTHREADS) {
        const int j = q & 1023, k = (q >> 10) % 6, which = ((q >> 10) / 6) & 1, l = (q >> 10) / 12;
        const float* ng = F.in[I_NORMG] + (size_t)l * 4 * 1024;
        float v;
        if (k == 0) v = ng[j] * (1.0f + mod_val(F, l, which, 1 * 1024 + j));
        else if (k == 1) v = mod_val(F, l, which, j);
        else if (k == 2) v = ng[1024 + j] * mod_val(F, l, which, 2 * 1024 + j);
        else if (k == 3) v = ng[2048 + j] * (1.0f + mod_val(F, l, which, 4 * 1024 + j));
        else if (k == 4) v = mod_val(F, l, which, 3 * 1024 + j);
        else v = ng[3072 + j] * mod_val(F, l, which, 5 * 1024 + j);
        F.w<float>(WS_VECS)[q] = v;
    }
}
__device__ __forceinline__ const float* vecs_ptr(const Frame& F, int l, int which, int k) { return F.w<float>(WS_VECS) + (size_t)((l * 2 + which) * 6 + k) * 1024; }

__device__ __forceinline__ void load_row(const float* p, int lane, f32x4 (&v)[4]) {
#pragma unroll
    for (int i = 0; i < 4; ++i) v[i] = *(const f32x4*)(p + 4 * lane + 256 * i);
}
__device__ __forceinline__ float row_rstd(const f32x4 (&v)[4]) {
    float s = 0.f;
#pragma unroll
    for (int i = 0; i < 4; ++i) s += v[i][0] * v[i][0] + v[i][1] * v[i][1] + v[i][2] * v[i][2] + v[i][3] * v[i][3];
    s = wave_sum(s);
    return rsqrtf(s * (1.0f / 1024.0f) + RMS_EPS);
}
__device__ __forceinline__ void stage_norm_vecs(const Frame& F, int l, int gain_idx, int sh_seg, int sc_seg, LAS float* dst  ) {
    for (int q = F.tid; q < 2048; q += NTHREADS) {
        const int which = q >> 10, j = q & 1023;
        const float g = F.in[I_NORMG][(l * 4 + gain_idx) * 1024 + j];
        dst[(which * 2 + 0) * 1024 + j] = g * (1.0f + mod_val(F, l, which, sc_seg * 1024 + j));
        dst[(which * 2 + 1) * 1024 + j] = mod_val(F, l, which, sh_seg * 1024 + j);
    }
}
__device__ __forceinline__ void norm_store_bf16(const f32x4 (&v)[4], float rstd, const LAS float* va, const LAS float* vb, bf16_t* orow, int lane, bool f8 = false) {
#pragma unroll
    for (int i = 0; i < 4; ++i) {
        const int c = 4 * lane + 256 * i;
        const f32x4 a = *(const LAS f32x4*)(va + c), b = *(const LAS f32x4*)(vb + c);
        if (f8) { *(unsigned*)((unsigned char*)orow + c) = pk_fp8x4(v[i][0] * rstd * a[0] + b[0], v[i][1] * rstd * a[1] + b[1], v[i][2] * rstd * a[2] + b[2], v[i][3] * rstd * a[3] + b[3]); }
        else { u32x2 w; w.x = pk_bf16(v[i][0] * rstd * a[0] + b[0], v[i][1] * rstd * a[1] + b[1]); w.y = pk_bf16(v[i][2] * rstd * a[2] + b[2], v[i][3] * rstd * a[3] + b[3]);
        *(u32x2*)(orow + c) = w; }
    }
}
__device__ __forceinline__ const float* xrow_ptr(const Frame& F, int l, int row) {
    if (l == 0) return row < L ? F.in[I_X] + (size_t)row * D : F.in[I_CTX] + (size_t)(row - L) * D;
    return F.w<float>(WS_XCUR) + (size_t)row * D;
}
__device__ __forceinline__ void load_xrow(const Frame& F, int l, int row, int lane, f32x4 (&v)[4]) {
    if (l == 0) { load_row(row < L ? F.in[I_X] + (size_t)row * D : F.in[I_CTX] + (size_t)(row - L) * D, lane, v); return; }
    const bf16_t* p = F.w<bf16_t>(WS_XCUR) + (size_t)row * D;
#pragma unroll
    for (int i = 0; i < 4; ++i) { const u32x2 w = *(const u32x2*)(p + 4 * lane + 256 * i); v[i] = (f32x4){bflo(w.x), bfhi(w.x), bflo(w.y), bfhi(w.y)}; }
}
__device__ __forceinline__ void store_xrow_bf16(bf16_t* p, int lane, const f32x4 (&v)[4]) {
#pragma unroll
    for (int i = 0; i < 4; ++i) { u32x2 w; w.x = pk_bf16(v[i][0], v[i][1]); w.y = pk_bf16(v[i][2], v[i][3]); *(u32x2*)(p + 4 * lane + 256 * i) = w; }
}
__device__ __forceinline__ void ph_norm1(const Frame& F, int l) {
    LAS float* vec = (LAS float*)F.lds;
    __syncthreads();
    stage_norm_vecs(F, l, 0, 0, 1, vec);
    __syncthreads();
    const int nwaves = F.G * 8;
    for (int row = F.bid * 8 + F.wave; row < T; row += nwaves) {
        const int which = row >= L;
        f32x4 v[4]; load_row(xrow_ptr(F, l, row), F.lane, v);
        const float rstd = row_rstd(v);
        norm_store_bf16(v, rstd, vec + (which * 2) * 1024, vec + (which * 2 + 1) * 1024, F8IN(0) ? (bf16_t*)(F.w<unsigned char>(WS_HB) + (size_t)row * D) : F.w<bf16_t>(WS_HB) + (size_t)row * D, F.lane, F8IN(0) != 0);
    }
}

constexpr int SROW = 272;
__device__ __forceinline__ bf16x8 lds_frag(const LAS unsigned char* base, int row, int k) { return *(const LAS bf16x8*)(base + row * SROW + k * 2); }
__device__ __forceinline__ void ph_ssd_prep(const Frame& F, int l) {
    LAS unsigned char* BT = F.lds;
    LAS unsigned char* XW = F.lds + 34816;
    LAS float* dts = (LAS float*)(F.lds + 139264);
    LAS float* wj  = dts + 768;
    const bf16_t* P = F.w<bf16_t>(WS_P);
    const int lane = F.lane, wave = F.wave;
    for (int it = F.bid; it < NCH * 2; it += F.G) {
        const int ch = it >> 1, g = it & 1;
        const int row0 = ch * 128;
        const int seq_lo = ch < 128 ? 0 : L, seq_hi = ch < 128 ? L : T;
        int r = lane & 31, hf = lane >> 5; asm volatile("" : "+v"(r), "+v"(hf));
        __syncthreads();
        if (wave < 6) {
            const int hh = wave >> 1, dir = wave & 1, h = g * 3 + hh;
            const float a = -__expf(F.in[I_ALOG][(l * 2 + dir) * 6 + h]), bias = F.in[I_DTB][(l * 2 + dir) * 6 + h];
            const int j0 = 2 * lane;
            const float d0 = softplus_f(bf2f(P[(size_t)(row0 + j0) * PC + CDT + dir * 6 + h]) + bias);
            const float d1 = softplus_f(bf2f(P[(size_t)(row0 + j0 + 1) * PC + CDT + dir * 6 + h]) + bias);
            const float pair = (d0 + d1) * a;
            float incl = pair;
#pragma unroll
            for (int o = 1; o < 64; o <<= 1) {
                const float v = dir == 0 ? __shfl_up(incl, o) : __shfl_down(incl, o);
                const bool okl = dir == 0 ? (lane >= o) : (lane + o < 64);
                if (okl) incl += v;
            }
            const float total = __shfl(incl, dir == 0 ? 63 : 0);
            float acs0, acs1;
            if (dir == 0) { acs1 = incl; acs0 = incl - d1 * a; }
            else { acs0 = incl; acs1 = incl - d0 * a; }
            float* dtv = F.w<float>(WS_DTV) + (size_t)(row0 + j0) * 12 + dir * 6 + h; dtv[0] = d0; dtv[12] = d1;
            float* acv = F.w<float>(WS_ACS) + (size_t)(row0 + j0) * 12 + dir * 6 + h; acv[0] = acs0; acv[12] = acs1;
            if (lane == 0) F.w<float>(WS_ALAST)[ch * 12 + dir * 6 + h] = total;
            dts[wave * 128 + j0] = d0; dts[wave * 128 + j0 + 1] = d1;
            wj[wave * 128 + j0] = __expf(total - acs0) * d0; wj[wave * 128 + j0 + 1] = __expf(total - acs1) * d1;
        }
        __syncthreads();
        if (F.tid < 448) {
            const int pr = F.tid % 224, half = F.tid / 224;
            const int chn = pr < 96 ? g * 192 + 2 * pr : (pr < 160 ? 384 + g * 128 + 2 * (pr - 96) : 640 + g * 128 + 2 * (pr - 160));
            const float* cw = F.in[I_SCW] + (size_t)l * 5 * 896 + chn; const float* cb = F.in[I_SCB] + (size_t)l * 896 + chn;
            float w0[5], w1[5];
#pragma unroll
            for (int k = 0; k < 5; ++k) { w0[k] = cw[k * 896]; w1[k] = cw[k * 896 + 1]; }
            const float b0 = cb[0], b1 = cb[1];
            const int jb = half * 64;
            const bf16_t* src = P + CXBC + chn;
            unsigned win[12];
#pragma unroll
            for (int k = 0; k < 4; ++k) { const int rr = row0 + jb + k - 2; win[k] = (rr >= seq_lo && rr < seq_hi) ? *(const unsigned*)(src + (size_t)rr * PC) : 0u; }
            const int hh = pr / 32;
            const int pch = 2 * (pr & 31);
            for (int jg = 0; jg < 64; jg += 8) {
#pragma unroll
                for (int k = 0; k < 8; ++k) { const int rr = row0 + jb + jg + k + 2; win[4 + k] = (rr >= seq_lo && rr < seq_hi) ? *(const unsigned*)(src + (size_t)rr * PC) : 0u; }
                float s0[8], s1[8];
#pragma unroll
                for (int u = 0; u < 8; ++u) {
                    float a0 = b0, a1 = b1;
#pragma unroll
                    for (int k = 0; k < 5; ++k) { a0 += w0[k] * bflo(win[u + k]); a1 += w1[k] * bfhi(win[u + k]); }
                    s0[u] = silu_f(a0); s1[u] = silu_f(a1);
                    *(unsigned*)(F.w<bf16_t>(WS_XBC) + (size_t)(row0 + jb + jg + u) * 896 + chn) = pk_bf16(s0[u], s1[u]);
                }
#pragma unroll
                for (int k = 0; k < 4; ++k) win[k] = win[8 + k];
#pragma unroll
                for (int u = 0; u < 8; u += 2) {
                    const int j = jb + jg + u;
                    if (pr < 96) {
#pragma unroll
                        for (int dir = 0; dir < 2; ++dir) {
                            const float wa = wj[(hh * 2 + dir) * 128 + j], wb = wj[(hh * 2 + dir) * 128 + j + 1];
                            LAS unsigned char* d = XW + ((hh * 2 + dir) * 64 + pch) * SROW + j * 2;
                            *(LAS unsigned*)d = pk_bf16(s0[u] * wa, s0[u + 1] * wb);
                            *(LAS unsigned*)(d + SROW) = pk_bf16(s1[u] * wa, s1[u + 1] * wb);
                        }
                    } else if (pr < 160) {
                        LAS unsigned char* d = BT + (2 * (pr - 96)) * SROW + j * 2;
                        *(LAS unsigned*)d = pk_bf16(s0[u], s0[u + 1]);
                        *(LAS unsigned*)(d + SROW) = pk_bf16(s1[u], s1[u + 1]);
                    }
                }
            }
        }
        __syncthreads();
        {
            const int nt = wave & 3, pt = wave >> 2;
#pragma unroll 1
            for (int hh = 0; hh < 3; ++hh) {
                const int h = g * 3 + hh;
                f32x16 a0, a1;
#pragma unroll
                for (int i = 0; i < 16; ++i) { a0[i] = 0.f; a1[i] = 0.f; }
                const LAS unsigned char* X0 = XW + (hh * 2) * 64 * SROW;
#pragma unroll
                for (int ks = 0; ks < 8; ++ks) {
                    const bf16x8 a = lds_frag(BT, 32 * nt + r, 16 * ks + 8 * hf);
                    const bf16x8 b0 = lds_frag(X0, 32 * pt + r, 16 * ks + 8 * hf), b1 = lds_frag(X0, 64 + 32 * pt + r, 16 * ks + 8 * hf);
                    a0 = __builtin_amdgcn_mfma_f32_32x32x16_bf16(a, b0, a0, 0, 0, 0);
                    a1 = __builtin_amdgcn_mfma_f32_32x32x16_bf16(a, b1, a1, 0, 0, 0);
                }
                float* s0 = F.w<float>(WS_STATES) + ((size_t)(0 * NCH + ch) * 6 + h) * 8192 + (32 * pt + r) * 128 + 32 * nt + 4 * hf;
                float* s1 = F.w<float>(WS_STATES) + ((size_t)(1 * NCH + ch) * 6 + h) * 8192 + (32 * pt + r) * 128 + 32 * nt + 4 * hf;
#pragma unroll
                for (int gq = 0; gq < 4; ++gq) { *(f32x4*)(s0 + 8 * gq) = (f32x4){a0[4 * gq], a0[4 * gq + 1], a0[4 * gq + 2], a0[4 * gq + 3]};
                                                 *(f32x4*)(s1 + 8 * gq) = (f32x4){a1[4 * gq], a1[4 * gq + 1], a1[4 * gq + 2], a1[4 * gq + 3]}; }
            }
        }
    }
}

__device__ __forceinline__ void ph_ssd_scan(const Frame& F) {
    const int per = (98304 + F.G - 1) / F.G;
    for (int q = F.tid; q < per; q += NTHREADS) {
        const int id = F.bid * per + q;
        if (id >= 98304) break;
        const int dir = id / 49152, rem = id % 49152, h = rem / 8192, e = rem % 8192;
        const float* al = F.w<float>(WS_ALAST) + dir * 6 + h;
        const float* st = F.w<float>(WS_STATES) + ((size_t)(dir * NCH) * 6 + h) * 8192 + e;
        bf16_t* ss = F.w<bf16_t>(WS_SSTART) + ((size_t)(dir * NCH) * 6 + h) * 8192 + e;
        float sacc = 0.f;
        for (int s0 = 0; s0 < NCH; s0 += 26) {
            float sv[26], dv[26]; int cv[26];
#pragma unroll
            for (int u = 0; u < 26; ++u) {
                const int step = s0 + u;
                cv[u] = dir == 0 ? (step < 2 ? 128 + step : step - 2) : 129 - step;
                sv[u] = st[(size_t)cv[u] * 6 * 8192]; dv[u] = al[cv[u] * 12];
            }
#pragma unroll
            for (int u = 0; u < 26; ++u) { ss[(size_t)cv[u] * 6 * 8192] = f2bf(sacc); sacc = sacc * __expf(dv[u]) + sv[u]; }
        }
    }
}

__device__ __forceinline__ void ph_ssd_out(const Frame& F, int l) {
    LAS unsigned char* Cs = F.lds;
    LAS unsigned char* Bs = F.lds + 34816;
    LAS unsigned char* XT = F.lds + 69632;
    LAS float* Yl = (LAS float*)F.lds;
    LAS float* af = (LAS float*)(F.lds + 98816);
    LAS float* ab = af + 384, *dtf = ab + 384, *dtb = dtf + 384;
    LAS float* red = dtb + 384;
    const bf16_t* XBC = F.w<bf16_t>(WS_XBC);
    const bf16_t* P = F.w<bf16_t>(WS_P);
    const int nch = (l == 0) ? NCH : 128;
    const int lane = F.lane, wave = F.wave, r_in = lane & 31, hf_in = lane >> 5;
    const int it_ = wave & 3, jp = wave >> 2;
    for (int it = F.bid; it < nch * 2; it += F.G) {
        const int ch = it >> 1, g = it & 1, row0 = ch * 128;
        int r = r_in, hf = hf_in; asm volatile("" : "+v"(r), "+v"(hf));
        __syncthreads();
        for (int q = F.tid; q < 128 * 16; q += NTHREADS) {
            const int row = q >> 4, piece = q & 15;
            const bf16_t* src = XBC + (size_t)(row0 + row) * 896 + g * 128 + piece * 8;
            *(LAS u32x4*)(Bs + row * SROW + piece * 16) = *(const u32x4*)(src + 384);
            *(LAS u32x4*)(Cs + row * SROW + piece * 16) = *(const u32x4*)(src + 640);
        }
        for (int q = F.tid; q < 768; q += NTHREADS) {
            const int dir = q / 384, rr = q % 384, hh = rr >> 7, j = rr & 127;
            (dir ? ab : af)[hh * 128 + j] = F.w<float>(WS_ACS)[(size_t)(row0 + j) * 12 + dir * 6 + g * 3 + hh];
            (dir ? dtb : dtf)[hh * 128 + j] = F.w<float>(WS_DTV)[(size_t)(row0 + j) * 12 + dir * 6 + g * 3 + hh];
        }
        __syncthreads();
        f32x16 G0, G1;
#pragma unroll
        for (int i = 0; i < 16; ++i) { G0[i] = 0.f; G1[i] = 0.f; }
#pragma unroll
        for (int ks = 0; ks < 8; ++ks) {
            const bf16x8 a = lds_frag(Cs, 32 * it_ + r, 16 * ks + 8 * hf);
            const bf16x8 b0 = lds_frag(Bs, 64 * jp + r, 16 * ks + 8 * hf), b1 = lds_frag(Bs, 64 * jp + 32 + r, 16 * ks + 8 * hf);
            G0 = __builtin_amdgcn_mfma_f32_32x32x16_bf16(a, b0, G0, 0, 0, 0);
            G1 = __builtin_amdgcn_mfma_f32_32x32x16_bf16(a, b1, G1, 0, 0, 0);
        }
        f32x16 yacc[3];
#pragma unroll
        for (int hh = 0; hh < 3; ++hh) {
            const int h = g * 3 + hh;
            asm volatile("" : "+v"(r), "+v"(hf));
            __syncthreads();
#pragma unroll
            for (int tl = 0; tl < 2; ++tl) {
                const int j = 64 * jp + 32 * tl + r;
                const float afj = af[hh * 128 + j], abj = ab[hh * 128 + j], dfj = dtf[hh * 128 + j], dbj = dtb[hh * 128 + j];
#pragma unroll
                for (int rg = 0; rg < 16; ++rg) {
                    const int i = 32 * it_ + (rg & 3) + 8 * (rg >> 2) + 4 * hf;
                    const float mf = fminf(fmaxf((float)(i - j + 1), 0.f), 1.f), mb = fminf(fmaxf((float)(j - i + 1), 0.f), 1.f);
                    const float wf = __expf(fminf(af[hh * 128 + i] - afj, 0.f)) * dfj * mf;
                    const float wb = __expf(fminf(ab[hh * 128 + i] - abj, 0.f)) * dbj * mb;
                    const float gv = tl == 0 ? G0[rg] : G1[rg];
                    *(LAS bf16_t*)(Bs + i * SROW + j * 2) = f2bf(gv * (wf + wb));
                }
            }
            for (int q = F.tid; q < 128 * 8; q += NTHREADS) {
                const int j = q >> 3, pg = q & 7;
                const u32x4 v = *(const u32x4*)(XBC + (size_t)(row0 + j) * 896 + h * 64 + pg * 8);
                LAS unsigned char* d = XT + (pg * 8) * SROW + j * 2;
                *(LAS bf16_t*)(d + 0 * SROW) = (bf16_t)(v.x & 0xFFFF); *(LAS bf16_t*)(d + 1 * SROW) = (bf16_t)(v.x >> 16);
                *(LAS bf16_t*)(d + 2 * SROW) = (bf16_t)(v.y & 0xFFFF); *(LAS bf16_t*)(d + 3 * SROW) = (bf16_t)(v.y >> 16);
                *(LAS bf16_t*)(d + 4 * SROW) = (bf16_t)(v.z & 0xFFFF); *(LAS bf16_t*)(d + 5 * SROW) = (bf16_t)(v.z >> 16);
                *(LAS bf16_t*)(d + 6 * SROW) = (bf16_t)(v.w & 0xFFFF); *(LAS bf16_t*)(d + 7 * SROW) = (bf16_t)(v.w >> 16);
            }
            {
                f32x16 yF, yB;
#pragma unroll
                for (int i = 0; i < 16; ++i) { yF[i] = 0.f; yB[i] = 0.f; }
                const bf16_t* Sf = F.w<bf16_t>(WS_SSTART) + ((size_t)(0 * NCH + ch) * 6 + h) * 8192 + (32 * jp + r) * 128 + 8 * hf;
                const bf16_t* Sb = F.w<bf16_t>(WS_SSTART) + ((size_t)(1 * NCH + ch) * 6 + h) * 8192 + (32 * jp + r) * 128 + 8 * hf;
#pragma unroll 2
                for (int ks = 0; ks < 8; ++ks) {
                    const bf16x8 ac = lds_frag(Cs, 32 * it_ + r, 16 * ks + 8 * hf);
                    const bf16x8 bf_ = *(const bf16x8*)(Sf + 16 * ks), bb_ = *(const bf16x8*)(Sb + 16 * ks);
                    yF = __builtin_amdgcn_mfma_f32_32x32x16_bf16(ac, bf_, yF, 0, 0, 0);
                    yB = __builtin_amdgcn_mfma_f32_32x32x16_bf16(ac, bb_, yB, 0, 0, 0);
                }
#pragma unroll
                for (int rg = 0; rg < 16; ++rg) {
                    const int i = 32 * it_ + (rg & 3) + 8 * (rg >> 2) + 4 * hf;
                    yacc[hh][rg] = __expf(af[hh * 128 + i]) * yF[rg] + __expf(ab[hh * 128 + i]) * yB[rg];
                }
            }
            __syncthreads();
#pragma unroll 2
            for (int ks = 0; ks < 8; ++ks) {
                const bf16x8 aw = lds_frag(Bs, 32 * it_ + r, 16 * ks + 8 * hf), bx = lds_frag(XT, 32 * jp + r, 16 * ks + 8 * hf);
                yacc[hh] = __builtin_amdgcn_mfma_f32_32x32x16_bf16(aw, bx, yacc[hh], 0, 0, 0);
            }
        }
        __syncthreads();
#pragma unroll
        for (int hh = 0; hh < 3; ++hh)
#pragma unroll
            for (int rg = 0; rg < 16; ++rg) { const int i = 32 * it_ + (rg & 3) + 8 * (rg >> 2) + 4 * hf; Yl[i * 193 + hh * 64 + 32 * jp + r] = yacc[hh][rg]; }
        __syncthreads();
        const int i = F.tid & 127, pq = F.tid >> 7;
        float ssq = 0.f;
#pragma unroll 1
        for (int hh = 0; hh < 3; ++hh) {
            const int h = g * 3 + hh; const float dsk = F.in[I_SSDD][l * 6 + h];
            const int chn = h * 64 + pq * 16;
            const u32x4 xa = *(const u32x4*)(XBC + (size_t)(row0 + i) * 896 + chn), xb = *(const u32x4*)(XBC + (size_t)(row0 + i) * 896 + chn + 8);
            const u32x4 za = *(const u32x4*)(P + (size_t)(row0 + i) * PC + CZ + chn), zb = *(const u32x4*)(P + (size_t)(row0 + i) * PC + CZ + chn + 8);
            const unsigned xw_[8] = {xa.x, xa.y, xa.z, xa.w, xb.x, xb.y, xb.z, xb.w}, zw_[8] = {za.x, za.y, za.z, za.w, zb.x, zb.y, zb.z, zb.w};
            LAS float* yr = Yl + i * 193 + hh * 64 + pq * 16;
#pragma unroll
            for (int p2 = 0; p2 < 8; ++p2) {
                const float v0 = (yr[2 * p2] + dsk * bflo(xw_[p2])) * silu_f(bflo(zw_[p2]));
                const float v1 = (yr[2 * p2 + 1] + dsk * bfhi(xw_[p2])) * silu_f(bfhi(zw_[p2]));
                yr[2 * p2] = v0; yr[2 * p2 + 1] = v1; ssq += v0 * v0 + v1 * v1;
            }
        }
        red[pq * 128 + i] = ssq;
        __syncthreads();
        const float tot = red[i] + red[128 + i] + red[256 + i] + red[384 + i];
        const float rstd = rsqrtf(tot * (1.0f / 192.0f) + RMS_EPS);
#pragma unroll 1
        for (int hh = 0; hh < 3; ++hh) {
            const int h = g * 3 + hh;
            bf16_t* o = F.w<bf16_t>(WS_MIX) + (size_t)(row0 + i) * D + h * 64 + pq * 16;
            const float* ng = F.in[I_SSDNG] + l * 384 + h * 64 + pq * 16;
            const LAS float* yr = Yl + i * 193 + hh * 64 + pq * 16;
            unsigned wv[8];
#pragma unroll
            for (int p2 = 0; p2 < 8; ++p2) wv[p2] = pk_bf16(yr[2 * p2] * rstd * ng[2 * p2], yr[2 * p2 + 1] * rstd * ng[2 * p2 + 1]);
            *(u32x4*)o = (u32x4){wv[0], wv[1], wv[2], wv[3]}; *(u32x4*)(o + 8) = (u32x4){wv[4], wv[5], wv[6], wv[7]};
        }
    }
}

__device__ __forceinline__ int na_kv_off(int key, int piece) { return key * 128 + ((piece ^ (key & 7)) << 4); }
constexpr int NA_VP = 144;
__device__ __forceinline__ int na_v_off(int key, int piece) { return key * NA_VP + piece * 16; }
__device__ __forceinline__ void na_stage_kv(const Frame& F, const bf16_t* P, LAS unsigned char* Kd, LAS unsigned char* Vd, int h, bool local, int r0, int kc0) {
    for (int q = F.tid; q < 256 * 8; q += NTHREADS) {
        const int key = q >> 3, piece = q & 7;
        const int krow = local ? (r0 + (key >> 5)) * 64 + kc0 + (key & 31) : L + key;
        const bf16_t* src = P + (size_t)krow * PC + h * 64 + piece * 8;
        *(LAS u32x4*)(Kd + na_kv_off(key, piece)) = *(const u32x4*)(src + CK);
        *(LAS u32x4*)(Vd + na_v_off(key, piece)) = *(const u32x4*)(src + CV);
    }
}
__device__ __forceinline__ void bar_lds() { asm volatile("s_waitcnt lgkmcnt(0)" ::: "memory"); __builtin_amdgcn_s_barrier(); asm volatile("" ::: "memory"); }
struct NaItem { int h, r, cg, r0, kc0, qrow0; bool isctx; };
__device__ __forceinline__ NaItem na_item(int cid, int i_lo, int i_hi, int k) {
    NaItem t; t.isctx = (i_lo + k >= i_hi); t.r = 0; t.r0 = 0; t.kc0 = 0;
    if (!t.isctx) { const int it = i_lo + k; t.h = it >> 10; t.cg = (it >> 8) & 3; t.r = it & 255; t.r0 = min(max(t.r - 4, 0), 248); t.kc0 = min(max(16 * t.cg - 8, 0), 32); t.qrow0 = t.r * 64 + t.cg * 16; }
    else { t.h = cid >> 4; t.cg = cid & 15; t.qrow0 = L + t.cg * 16; }
    return t;
}
__device__ __forceinline__ void ph_na(const Frame& F, int l, int part) {
    LAS unsigned char* Kc = F.lds;
    LAS unsigned char* Vc = F.lds + 32768;
    LAS unsigned char* Kl = F.lds + 69632;
    LAS unsigned char* Vl = F.lds + 102400;
    LAS unsigned char* Qs = F.lds + 139264;
    LAS unsigned char* Pw = F.lds + 141312;
    LAS float* ml = (LAS float*)(F.lds + 159744);
    LAS float* bt = ml + 256;
    const bf16_t* P = F.w<bf16_t>(WS_P);
    const float* rpb = F.in[I_RPB] + (size_t)l * 15 * 31 * 6;
    const int nlat = 6 * 256 * 4;
    const int nB = (l == 0) ? 2520 : 0, nA = nlat - nB;
    const int lane = F.lane, wave = F.wave, c16 = lane & 15, kq = lane >> 4;
    const float scale = 0.125f;
    int cur_h = -1;
    const float ws = part == 0 ? (l == 0 ? 0.45f : 0.67f) : 0.0f;
    const int nP = part == 0 ? nA : nB, base = part == 0 ? 0 : nA;
    const float Wtot = 4.0f * ws + (float)(F.G - 4);
    const float W0 = F.bid < 4 ? F.bid * ws : 4.0f * ws + (float)(F.bid - 4), W1 = F.bid < 3 ? (F.bid + 1) * ws : 4.0f * ws + (float)(F.bid - 3);
    const int i_lo = base + (int)((float)nP * W0 / Wtot + 0.5f), i_hi = (F.bid == F.G - 1) ? base + nP : base + (int)((float)nP * W1 / Wtot + 0.5f);
    const int cid = (l == 0 && part == 0 && F.bid >= 100 && F.bid < 196) ? F.bid - 100 : -1;
    const int n_mine = max(0, i_hi - i_lo) + (cid >= 0 ? 1 : 0);
    u32x4 kreg[4], vreg[4], qreg; float breg = 0.f;
    const int pkey = F.tid >> 3, ppiece = F.tid & 7;
#define NA_PREFETCH(T) do { if (!(T).isctx) { _Pragma("unroll") for (int u = 0; u < 4; ++u) { const int key = pkey + 64 * u; \
            const bf16_t* src = P + (size_t)(((T).r0 + (key >> 5)) * 64 + (T).kc0 + (key & 31)) * PC + (T).h * 64 + ppiece * 8; \
            kreg[u] = *(const u32x4*)(src + CK); vreg[u] = *(const u32x4*)(src + CV); } \
            if (F.tid < 256 && (F.tid & 31) < 31) breg = rpb[(((T).r0 + (F.tid >> 5) - (T).r + 7) * 31 + (F.tid & 31)) * 6 + (T).h]; } \
        if (F.tid < 128) qreg = *(const u32x4*)(P + (size_t)((T).qrow0 + pkey) * PC + CQ + (T).h * 64 + ppiece * 8); } while (0)
    if (n_mine > 0) { const NaItem t0 = na_item(cid, i_lo, i_hi, 0); NA_PREFETCH(t0); }
    for (int k = 0; k < n_mine; ++k) {
        const NaItem t = na_item(cid, i_lo, i_hi, k);
        const bool isctx = t.isctx; const int h = t.h, cg = t.cg, kc0 = t.kc0, qrow0 = t.qrow0;
        if (k == 0) bar_lds();
        if (h != cur_h) { na_stage_kv(F, P, Kc, Vc, h, false, 0, 0); cur_h = h; }
        if (!isctx) {
#pragma unroll
            for (int u = 0; u < 4; ++u) { const int key = pkey + 64 * u; *(LAS u32x4*)(Kl + na_kv_off(key, ppiece)) = kreg[u]; *(LAS u32x4*)(Vl + na_v_off(key, ppiece)) = vreg[u]; }
            if (F.tid < 256) bt[F.tid] = breg;
        }
        if (F.tid < 128) *(LAS u32x4*)(Qs + na_kv_off(pkey, ppiece)) = qreg;
        if (k + 1 < n_mine) { const NaItem tn = na_item(cid, i_lo, i_hi, k + 1); NA_PREFETCH(tn); }
        bar_lds();
        const bool loc = wave < 4;
        const LAS unsigned char* Kb = loc ? Kl : Kc;
        const LAS unsigned char* Vb = loc ? Vl : Vc;
        const int kbase = (wave & 3) * 64;
        LAS unsigned char* pw = Pw + wave * 2304;
        float mw[4], lw[4];
        if (!(loc && isctx)) {
            f32x4 sacc[4];
#pragma unroll
            for (int nt = 0; nt < 4; ++nt) sacc[nt] = (f32x4){0.f, 0.f, 0.f, 0.f};
#pragma unroll
            for (int ks = 0; ks < 2; ++ks) {
                const bf16x8 a = *(const LAS bf16x8*)(Qs + na_kv_off(c16, 4 * ks + kq));
#pragma unroll
                for (int nt = 0; nt < 4; ++nt) {
                    const bf16x8 b = *(const LAS bf16x8*)(Kb + na_kv_off(kbase + 16 * nt + c16, 4 * ks + kq));
                    sacc[nt] = __builtin_amdgcn_mfma_f32_16x16x32_bf16(a, b, sacc[nt], 0, 0, 0);
                }
            }
#pragma unroll
            for (int rg = 0; rg < 4; ++rg) mw[rg] = -INFINITY;
#pragma unroll
            for (int nt = 0; nt < 4; ++nt) {
                const int kk = kbase + 16 * nt + c16;
#pragma unroll
                for (int rg = 0; rg < 4; ++rg) {
                    float sv = sacc[nt][rg] * scale;
                    if (loc) {
                        const int qi = 4 * kq + rg, qcol = cg * 16 + qi, cstart = min(max(qcol - 8, 0), 48);
                        const int krow = kk >> 5, kcol = kc0 + (kk & 31);
                        const bool ok = (kcol >= cstart) && (kcol < cstart + 16);
                        const int dc = min(max(kcol - qcol + 15, 0), 30);
                        sv = ok ? sv + bt[krow * 32 + dc] : -INFINITY;
                    }
                    sacc[nt][rg] = sv; mw[rg] = fmaxf(mw[rg], sv);
                }
            }
#pragma unroll
            for (int rg = 0; rg < 4; ++rg) {
                mw[rg] = row16_max(mw[rg]);
                lw[rg] = 0.f;
            }
#pragma unroll
            for (int nt = 0; nt < 4; ++nt) {
#pragma unroll
                for (int rg = 0; rg < 4; ++rg) {
                    const float msafe = mw[rg] == -INFINITY ? 0.f : mw[rg];
                    const float pv = __expf(sacc[nt][rg] - msafe);
                    lw[rg] += pv;
                    *(LAS bf16_t*)(pw + (4 * kq + rg) * 144 + (16 * nt + c16) * 2) = f2bf(pv);
                }
            }
#pragma unroll
            for (int rg = 0; rg < 4; ++rg) {
                lw[rg] = row16_sum(lw[rg]);
            }
            lds_fence();
            f32x4 oacc[4];
#pragma unroll
            for (int dt = 0; dt < 4; ++dt) oacc[dt] = (f32x4){0.f, 0.f, 0.f, 0.f};
            {
                const unsigned vaddr = (unsigned)(unsigned long long)(Vb + (kbase + 8 * kq + (c16 >> 2)) * NA_VP + 8 * (c16 & 3));
                u32x2 t[2][4][2];
                asm volatile(
                    "ds_read_b64_tr_b16 %0, %16 offset:0\n\tds_read_b64_tr_b16 %1, %16 offset:576\n\t"
                    "ds_read_b64_tr_b16 %2, %16 offset:32\n\tds_read_b64_tr_b16 %3, %16 offset:608\n\t"
                    "ds_read_b64_tr_b16 %4, %16 offset:64\n\tds_read_b64_tr_b16 %5, %16 offset:640\n\t"
                    "ds_read_b64_tr_b16 %6, %16 offset:96\n\tds_read_b64_tr_b16 %7, %16 offset:672\n\t"
                    "ds_read_b64_tr_b16 %8, %16 offset:4608\n\tds_read_b64_tr_b16 %9, %16 offset:5184\n\t"
                    "ds_read_b64_tr_b16 %10, %16 offset:4640\n\tds_read_b64_tr_b16 %11, %16 offset:5216\n\t"
                    "ds_read_b64_tr_b16 %12, %16 offset:4672\n\tds_read_b64_tr_b16 %13, %16 offset:5248\n\t"
                    "ds_read_b64_tr_b16 %14, %16 offset:4704\n\tds_read_b64_tr_b16 %15, %16 offset:5280\n\t"
                    "s_waitcnt lgkmcnt(0)"
                    : "=&v"(t[0][0][0]), "=&v"(t[0][0][1]), "=&v"(t[0][1][0]), "=&v"(t[0][1][1]), "=&v"(t[0][2][0]), "=&v"(t[0][2][1]), "=&v"(t[0][3][0]), "=&v"(t[0][3][1]),
                      "=&v"(t[1][0][0]), "=&v"(t[1][0][1]), "=&v"(t[1][1][0]), "=&v"(t[1][1][1]), "=&v"(t[1][2][0]), "=&v"(t[1][2][1]), "=&v"(t[1][3][0]), "=&v"(t[1][3][1])
                    : "v"(vaddr) : "memory");
#pragma unroll
                for (int ks = 0; ks < 2; ++ks) {
                    const bf16x8 a = *(const LAS bf16x8*)(pw + c16 * 144 + (32 * ks + 8 * kq) * 2);
#pragma unroll
                    for (int dt = 0; dt < 4; ++dt) {
                        const u32x4 bw = (u32x4){t[ks][dt][0].x, t[ks][dt][0].y, t[ks][dt][1].x, t[ks][dt][1].y};
                        oacc[dt] = __builtin_amdgcn_mfma_f32_16x16x32_bf16(a, __builtin_bit_cast(bf16x8, bw), oacc[dt], 0, 0, 0);
                    }
                }
            }
            lds_fence();
#pragma unroll
            for (int dt = 0; dt < 4; ++dt)
#pragma unroll
                for (int rg = 0; rg < 4; ++rg) *(LAS bf16_t*)(pw + (4 * kq + rg) * 144 + (16 * dt + c16) * 2) = f2bf(oacc[dt][rg]);
        } else {
#pragma unroll
            for (int rg = 0; rg < 4; ++rg) { mw[rg] = -INFINITY; lw[rg] = 0.f; }
            for (int q = lane; q < 16 * 36; q += 64) ((LAS unsigned*)pw)[q] = 0u;
        }
        if (c16 == 0) {
#pragma unroll
            for (int rg = 0; rg < 4; ++rg) { ml[(wave * 16 + 4 * kq + rg) * 2] = mw[rg]; ml[(wave * 16 + 4 * kq + rg) * 2 + 1] = lw[rg]; }
        }
        bar_lds();
        {
            const int qi = F.tid >> 5, dp = F.tid & 31;
            float M = -INFINITY;
#pragma unroll
            for (int w = 0; w < 8; ++w) M = fmaxf(M, ml[(w * 16 + qi) * 2]);
            float num0 = 0.f, num1 = 0.f, den = 0.f;
#pragma unroll
            for (int w = 0; w < 8; ++w) {
                const float sc = __expf(ml[(w * 16 + qi) * 2] - M);
                const unsigned ov = *(const LAS unsigned*)(Pw + w * 2304 + qi * 144 + dp * 4);
                num0 += sc * bflo(ov); num1 += sc * bfhi(ov); den += sc * ml[(w * 16 + qi) * 2 + 1];
            }
            const float inv = 1.0f / den;
            *(unsigned*)(F.w<bf16_t>(WS_MIX) + (size_t)(qrow0 + qi) * D + 384 + h * 64 + 2 * dp) = pk_bf16(num0 * inv, num1 * inv);
        }
    }
#undef NA_PREFETCH
}

__device__ __forceinline__ float hy_conv3(const bf16_t* P, const float* cw, const float* cb, int row, int seq_lo, int seq_hi, int col) {
    float s = cb[col];
#pragma unroll
    for (int k = 0; k < 3; ++k) { const int r = row + k - 1; if (r >= seq_lo && r < seq_hi) s += cw[k * 768 + col] * bf2f(P[(size_t)r * PC + CHY + col]); }
    return s;
}
__device__ __forceinline__ void ph_hy_prep(const Frame& F, int l) {
    const bf16_t* P = F.w<bf16_t>(WS_P);
    const float* cw = F.in[I_HCW] + (size_t)l * 3 * 768; const float* cb = F.in[I_HCB] + (size_t)l * 768;
    LAS unsigned* ut = (LAS unsigned*)F.lds;
    LAS unsigned* xt = ut + 256 * 33;
    const int cp = F.tid & 127, rq = F.tid >> 7;
    float w0[3][3], w1[3][3], b0[3], b1[3];
#pragma unroll
    for (int sg = 0; sg < 3; ++sg) { b0[sg] = cb[sg * 256 + 2 * cp]; b1[sg] = cb[sg * 256 + 2 * cp + 1];
#pragma unroll
        for (int k = 0; k < 3; ++k) { w0[sg][k] = cw[k * 768 + sg * 256 + 2 * cp]; w1[sg][k] = cw[k * 768 + sg * 256 + 2 * cp + 1]; } }
    for (int it = F.bid; it < L / 64; it += F.G) {
        const int t0 = it * 64, rb = t0 + rq * 16;
        __syncthreads();
        {
            unsigned win[3][18];
#pragma unroll
            for (int sg = 0; sg < 3; ++sg)
#pragma unroll
                for (int k = 0; k < 18; ++k) { const int rr = rb - 1 + k; win[sg][k] = (rr >= 0 && rr < L) ? *(const unsigned*)(P + (size_t)rr * PC + CHY + sg * 256 + 2 * cp) : 0u; }
#pragma unroll
            for (int jp = 0; jp < 8; ++jp) {
                float u0[2], u1[2], xa[2], xb[2];
#pragma unroll
                for (int q = 0; q < 2; ++q) {
                    const int k = 2 * jp + q;
                    float a0[3], a1[3];
#pragma unroll
                    for (int sg = 0; sg < 3; ++sg) {
                        a0[sg] = b0[sg] + w0[sg][0] * bflo(win[sg][k]) + w0[sg][1] * bflo(win[sg][k + 1]) + w0[sg][2] * bflo(win[sg][k + 2]);
                        a1[sg] = b1[sg] + w1[sg][0] * bfhi(win[sg][k]) + w1[sg][1] * bfhi(win[sg][k + 1]) + w1[sg][2] * bfhi(win[sg][k + 2]);
                    }
                    xa[q] = a0[0]; xb[q] = a1[0]; u0[q] = a0[2] * a0[1]; u1[q] = a1[2] * a1[1];
                }
                const int rp = rq * 8 + jp;
                ut[(2 * cp) * 33 + rp] = pk_bf16(u0[0], u0[1]); ut[(2 * cp + 1) * 33 + rp] = pk_bf16(u1[0], u1[1]);
                xt[(2 * cp) * 33 + rp] = pk_bf16(xa[0], xa[1]); xt[(2 * cp + 1) * 33 + rp] = pk_bf16(xb[0], xb[1]);
            }
        }
        __syncthreads();
        for (int q = F.tid; q < 256 * 8; q += NTHREADS) {
            const int c = q >> 3, g = q & 7;
            u32x4 a, b;
            a.x = ut[c * 33 + 4 * g]; a.y = ut[c * 33 + 4 * g + 1]; a.z = ut[c * 33 + 4 * g + 2]; a.w = ut[c * 33 + 4 * g + 3];
            b.x = xt[c * 33 + 4 * g]; b.y = xt[c * 33 + 4 * g + 1]; b.z = xt[c * 33 + 4 * g + 2]; b.w = xt[c * 33 + 4 * g + 3];
            *(u32x4*)(F.w<bf16_t>(WS_UT) + (size_t)c * L + t0 + 8 * g) = a;
            *(u32x4*)(F.w<bf16_t>(WS_X0T) + (size_t)c * L + t0 + 8 * g) = b;
            u32x2 a8; a8.x = pk_fp8x4(bflo(a.x), bfhi(a.x), bflo(a.y), bfhi(a.y)); a8.y = pk_fp8x4(bflo(a.z), bfhi(a.z), bflo(a.w), bfhi(a.w));
            *(u32x2*)(F.w<unsigned char>(WS_UT8) + (size_t)c * L + t0 + 8 * g) = a8;
        }
    }
    if (l == 0) {
        for (int rp = F.bid; rp < LC / 2; rp += F.G) {
            const int row = L + rp * 2 + (F.tid >> 8), c = F.tid & 255;
            const float x1 = hy_conv3(P, cw, cb, row, L, T, 256 + c), v = hy_conv3(P, cw, cb, row, L, T, 512 + c);
            F.w<float>(WS_U)[(size_t)row * 256 + c] = v * x1;
        }
    }
}
__device__ __forceinline__ void ph_hy_conv_ctx(const Frame& F, int l) {
    const bf16_t* P = F.w<bf16_t>(WS_P);
    const float* cw = F.in[I_HCW] + (size_t)l * 3 * 768; const float* cb = F.in[I_HCB] + (size_t)l * 768;
    for (int it = F.bid; it < 8; it += F.G) {
        const int Lx = LC, rbase = L;
        const int tb = it * 2 + (F.tid >> 8), c = F.tid & 255, t0 = tb * 16;
        const float* U = F.w<float>(WS_U) + (size_t)rbase * 256 + c;
        const float* KC = F.w<float>(WS_KCOMBC) + c;
        float acc[16], wreg[16];
#pragma unroll
        for (int j = 0; j < 16; ++j) { acc[j] = 0.f; wreg[j] = KC[(size_t)(t0 + j + Lx - 1) * 256]; }
        for (int s0 = 0; s0 < Lx; s0 += 16) {
            float ub[16], nb[16];
#pragma unroll
            for (int r = 0; r < 16; ++r) { ub[r] = U[(size_t)(s0 + r) * 256]; const int x = t0 - (s0 + r + 1) + Lx - 1; nb[r] = x >= 0 ? KC[(size_t)x * 256] : 0.f; }
#pragma unroll
            for (int r = 0; r < 16; ++r) {
#pragma unroll
                for (int j = 0; j < 16; ++j) acc[j] += ub[r] * wreg[(j - r) & 15];
                wreg[(15 - r) & 15] = nb[r];
            }
        }
        const float inv = F.w<float>(WS_FSUM)[2 * 256 + c];
        const float db = F.in[I_HYD][l * 256 + c];
#pragma unroll
        for (int j = 0; j < 16; ++j) {
            const int row = rbase + t0 + j;
            const float x0 = hy_conv3(P, cw, cb, row, L, T, c);
            const float u = F.w<float>(WS_U)[(size_t)row * 256 + c];
            F.w<bf16_t>(WS_MIX)[(size_t)row * D + 768 + c] = f2bf(x0 * (acc[j] * inv + u * db));
        }
    }
}

constexpr int HC_UP = 144, HC_UBYTES = 190 * HC_UP;
constexpr int HC_CPOFF = 27392, HC_NG = 83, HC_CPBYTES = 16 * HC_NG * 16;
__device__ __forceinline__ void hc_make_copies(LAS unsigned char* dst, const u32x4 g0, const u32x4 g1, int g) {
    const unsigned w[8] = {g0.x, g0.y, g0.z, g0.w, g1.x, g1.y, g1.z, g1.w};
#pragma unroll
    for (int sh = 0; sh < 16; ++sh) {
        const int b = sh >> 2, r = sh & 3;
        u32x4 o;
        if (r == 0) { o.x = w[b]; o.y = w[b + 1]; o.z = w[b + 2]; o.w = w[b + 3]; }
        else { o.x = __builtin_amdgcn_alignbyte(w[b + 1], w[b], r); o.y = __builtin_amdgcn_alignbyte(w[b + 2], w[b + 1], r);
               o.z = __builtin_amdgcn_alignbyte(w[b + 3], w[b + 2], r); o.w = __builtin_amdgcn_alignbyte(w[b + 4], w[b + 3], r); }
        *(LAS u32x4*)(dst + (sh * HC_NG + g) * 16) = o;
    }
}
__device__ __forceinline__ void ph_hy_conv(const Frame& F, int l) {
    LAS unsigned char* Ul = F.lds;
    LAS unsigned char* Cp = F.lds + HC_CPOFF;
    const int lane = F.lane, wave = F.wave;
    const int nt = wave < 4 ? wave : 7 - wave, par = wave >> 2;
    const int r = lane & 31, h = lane >> 5, sig = r & 15, rho = r >> 4;
    const int sh = (16 - sig) & 15, gofs = 2 * h - rho - (sig ? 1 : 0);
    const int a_lane = (sh * HC_NG + gofs) * 16;
    const int b_lane = r * HC_UP + h * 32;
    const int sclK = 0x79797979, sclU = ONE_E8M0;
    for (int c = F.bid; c < 256; c += F.G) {
        const unsigned char* KRc = F.w<unsigned char>(WS_KR) + ((size_t)l * 256 + c) * KRL;
        const unsigned char* U8c = F.w<unsigned char>(WS_UT8) + (size_t)c * L;
        const bf16_t* UTc = F.w<bf16_t>(WS_UT) + (size_t)c * L;
        __syncthreads();
        for (int q = F.tid; q < 190 * 8; q += NTHREADS) {
            const int blk = q >> 3, piece = q & 7;
            u32x4 v = (u32x4){0u, 0u, 0u, 0u};
            if (blk >= 31 && blk < 159) v = *(const u32x4*)(U8c + (size_t)(blk - 31) * 128 + piece * 16);
            *(LAS u32x4*)(Ul + blk * HC_UP + piece * 16) = v;
        }
        u32x4 g0 = (u32x4){0u, 0u, 0u, 0u}, g1 = g0;
        if (F.tid < HC_NG) { const unsigned char* src = KRc + 31744 + 16 * F.tid; g0 = *(const u32x4*)src; g1 = *(const u32x4*)(src + 16); }
        if (F.tid < HC_NG) hc_make_copies(Cp, g0, g1, F.tid);
        __syncthreads();
        f32x16 acc[4];
#pragma unroll
        for (int m = 0; m < 4; ++m)
#pragma unroll
            for (int i = 0; i < 16; ++i) acc[m][i] = 0.f;
        for (int ci = 0; ci < 32; ++ci) {
            const int Dc = -128 + 8 * ci;
            if (ci + 1 < 32 && F.tid < HC_NG) { const unsigned char* src = KRc + (31744 - 1024 * (ci + 1)) + 16 * F.tid; g0 = *(const u32x4*)src; g1 = *(const u32x4*)(src + 16); }
            const LAS unsigned char* cp = Cp + (ci & 1) * HC_CPBYTES + a_lane;
#pragma unroll 1
            for (int d2 = 0; d2 < 4; ++d2) {
                const int dd = 2 * d2 + par, Dv = Dc + dd;
                if (!((Dv >= 32 * nt - 127) && (Dv <= 32 * nt + 31) && (Dv > -128))) continue;
                const LAS unsigned char* ap = cp + (8 * (8 - dd)) * 16;
                const LAS unsigned char* bp = Ul + b_lane + (32 * nt - Dv + 31) * HC_UP;
                v8i af[6], bfr[2];
#pragma unroll
                for (int e = 0; e < 6; ++e) { const v4i x = *(const LAS v4i*)(ap - 2 * (e - 2) * 16), y = *(const LAS v4i*)(ap - 2 * (e - 2) * 16 + 16); af[e] = __builtin_shufflevector(x, y, 0, 1, 2, 3, 4, 5, 6, 7); }
#pragma unroll
                for (int ks = 0; ks < 2; ++ks) { const v4i x = *(const LAS v4i*)(bp + ks * 64), y = *(const LAS v4i*)(bp + ks * 64 + 16); bfr[ks] = __builtin_shufflevector(x, y, 0, 1, 2, 3, 4, 5, 6, 7); }
#pragma unroll
                for (int ks = 0; ks < 2; ++ks)
#pragma unroll
                    for (int m = 0; m < 4; ++m)
                        asm volatile("v_mfma_scale_f32_32x32x64_f8f6f4 %0, %1, %2, %0, %3, %4 op_sel_hi:[0,0,0]" : "+v"(acc[m]) : "v"(af[m - 2 * ks + 2]), "v"(bfr[ks]), "v"(sclK), "v"(sclU));
            }
            if (ci + 1 < 32 && F.tid < HC_NG) hc_make_copies(Cp + ((ci + 1) & 1) * HC_CPBYTES, g0, g1, F.tid);
            __syncthreads();
        }
        LAS float* Rd = (LAS float*)F.lds;
        if (wave >= 4) {
#pragma unroll
            for (int m = 0; m < 4; ++m)
#pragma unroll
                for (int i = 0; i < 16; ++i) Rd[(nt * 64 + m * 16 + i) * 64 + lane] = acc[m][i];
        }
        __syncthreads();
        if (wave < 4) {
#pragma unroll
            for (int m = 0; m < 4; ++m)
#pragma unroll
                for (int i = 0; i < 16; ++i) acc[m][i] += Rd[(nt * 64 + m * 16 + i) * 64 + lane];
            const float inv = F.w<float>(WS_FSUM)[l * 256 + c];
            const float db = F.in[I_HYD][l * 256 + c];
            const bf16_t* X0c = F.w<bf16_t>(WS_X0T) + (size_t)c * L;
            bf16_t* YTc = F.w<bf16_t>(WS_YT) + (size_t)c * L;
            const int I = 32 * nt + r;
#pragma unroll
            for (int m = 0; m < 4; ++m) {
#pragma unroll
                for (int g = 0; g < 4; ++g) {
                    const int t = 128 * I + 32 * m + 8 * g + 4 * h;
                    const u32x2 xv = *(const u32x2*)(X0c + t), uv = *(const u32x2*)(UTc + t);
                    float y[4];
#pragma unroll
                    for (int e = 0; e < 4; ++e) y[e] = acc[m][4 * g + e] * inv;
                    y[0] = bflo(xv.x) * (y[0] + bflo(uv.x) * db); y[1] = bfhi(xv.x) * (y[1] + bfhi(uv.x) * db);
                    y[2] = bflo(xv.y) * (y[2] + bflo(uv.y) * db); y[3] = bfhi(xv.y) * (y[3] + bfhi(uv.y) * db);
                    u32x2 o; o.x = pk_bf16(y[0], y[1]); o.y = pk_bf16(y[2], y[3]);
                    *(u32x2*)(YTc + t) = o;
                }
            }
        }
    }
}
__device__ __forceinline__ void ph_hy_tr(const Frame& F) {
    LAS unsigned* yt = (LAS unsigned*)F.lds;
    for (int it = F.bid; it < L / 64; it += F.G) {
        const int t0 = it * 64;
        __syncthreads();
        for (int q = F.tid; q < 256 * 8; q += NTHREADS) {
            const int c = q >> 3, g = q & 7;
            const u32x4 a = *(const u32x4*)(F.w<bf16_t>(WS_YT) + (size_t)c * L + t0 + 8 * g);
            yt[c * 33 + 4 * g] = a.x; yt[c * 33 + 4 * g + 1] = a.y; yt[c * 33 + 4 * g + 2] = a.z; yt[c * 33 + 4 * g + 3] = a.w;
        }
        __syncthreads();
        for (int q = F.tid; q < 64 * 32; q += NTHREADS) {
            const int row = q >> 5, cg = q & 31;
            const LAS unsigned short* ys = (const LAS unsigned short*)yt;
            unsigned short v[8];
#pragma unroll
            for (int e = 0; e < 8; ++e) v[e] = ys[((cg * 8 + e) * 33) * 2 + row];
            u32x4 o; o.x = v[0] | ((unsigned)v[1] << 16); o.y = v[2] | ((unsigned)v[3] << 16); o.z = v[4] | ((unsigned)v[5] << 16); o.w = v[6] | ((unsigned)v[7] << 16);
            *(u32x4*)(F.w<bf16_t>(WS_MIX) + (size_t)(t0 + row) * D + 768 + cg * 8) = o;
        }
    }
}

constexpr int WRP = 1028;
__device__ __forceinline__ void ph_post1(const Frame& F, int l) {
    LAS float* wr = (LAS float*)F.lds;
    LAS unsigned* lcnt = (LAS unsigned*)(F.lds + 32 * WRP * 4);
    __syncthreads();
    if (F.tid < 64) lcnt[F.tid] = 0u;
    {
        const f32x4* src = (const f32x4*)(F.in[I_WR] + (size_t)l * 1024 * 32);
        f32x4 v[16];
#pragma unroll
        for (int u = 0; u < 16; ++u) v[u] = src[F.tid + u * NTHREADS];
#pragma unroll
        for (int u = 0; u < 16; ++u) { const int q4 = F.tid + u * NTHREADS, k = q4 >> 3, e0 = (q4 & 7) * 4;
#pragma unroll
            for (int i = 0; i < 4; ++i) wr[(e0 + i) * WRP + k] = v[u][i]; }
    }
    __syncthreads();
    const int nrows = (l == 0) ? T : L;
    const int nwaves = F.G * 8, lane = F.lane;
    unsigned* cnt = F.w<unsigned>(WS_CTL) + CW_CNT + l * 1024;
    if (F.bid == 0) { for (int q = F.tid; q < D / 4; q += NTHREADS) ((unsigned*)(F.w<unsigned char>(WS_H2) + (size_t)T * D))[q] = 0u; }
    const float brl = F.in[I_BR][l * 32 + ((lane >> 1) & 31)];
    const int mye = (lane >> 1) & 31;
    for (int row0 = F.bid * 8 + F.wave; row0 < nrows; row0 += 2 * nwaves) {
        int rw[2]; bool vld[2];
        rw[0] = row0; vld[0] = true; vld[1] = (row0 + nwaves < nrows); rw[1] = vld[1] ? row0 + nwaves : row0;
        f32x4 m[2][4], x[2][4], hv[2][4];
#pragma unroll
        for (int u = 0; u < 2; ++u) { const bf16_t* mr = F.w<bf16_t>(WS_MIXO) + (size_t)rw[u] * D;
#pragma unroll
            for (int i = 0; i < 4; ++i) { const u32x2 w = *(const u32x2*)(mr + 4 * lane + 256 * i); m[u][i] = (f32x4){bflo(w.x), bfhi(w.x), bflo(w.y), bfhi(w.y)}; }
            load_xrow(F, l, rw[u], lane, x[u]); }
#pragma unroll
        for (int u = 0; u < 2; ++u) {
            const int which = rw[u] >= L;
            const float* v0 = vecs_ptr(F, l, which, 2);
            const float rs1 = row_rstd(m[u]);
#pragma unroll
            for (int i = 0; i < 4; ++i) { const f32x4 a = *(const f32x4*)(v0 + 4 * lane + 256 * i); x[u][i] = x[u][i] + m[u][i] * rs1 * a; }
        }
#pragma unroll
        for (int u = 0; u < 2; ++u) {
            if (vld[u]) store_xrow_bf16(F.w<bf16_t>(WS_XCUR) + (size_t)rw[u] * D, lane, x[u]);
        }
#pragma unroll
        for (int u = 0; u < 2; ++u) {
            const int which = rw[u] >= L;
            const float* v1 = vecs_ptr(F, l, which, 3), *v2 = vecs_ptr(F, l, which, 4);
            const float rs2 = row_rstd(x[u]);
#pragma unroll
            for (int i = 0; i < 4; ++i) { const f32x4 a = *(const f32x4*)(v1 + 4 * lane + 256 * i), b = *(const f32x4*)(v2 + 4 * lane + 256 * i); hv[u][i] = x[u][i] * rs2 * a + b; }
            if (vld[u]) { unsigned char* ho = F.w<unsigned char>(WS_H2) + (size_t)rw[u] * D;
#pragma unroll
                for (int i = 0; i < 4; ++i) *(unsigned*)(ho + 4 * lane + 256 * i) = pk_fp8x4(hv[u][i][0], hv[u][i][1], hv[u][i][2], hv[u][i][3]); }
        }
        float part[2][32];
#pragma unroll
        for (int e = 0; e < 32; ++e) {
            float s0 = 0.f, s1 = 0.f;
#pragma unroll
            for (int i = 0; i < 4; ++i) { const f32x4 w = *(const LAS f32x4*)(wr + e * WRP + 4 * lane + 256 * i);
                s0 += hv[0][i][0] * w[0] + hv[0][i][1] * w[1] + hv[0][i][2] * w[2] + hv[0][i][3] * w[3];
                s1 += hv[1][i][0] * w[0] + hv[1][i][1] * w[1] + hv[1][i][2] * w[2] + hv[1][i][3] * w[3]; }
            part[0][e] = s0; part[1][e] = s1;
        }
#pragma unroll
        for (int st = 0; st < 5; ++st) {
            const int o = 32 >> st, n = 32 >> st;
            const bool upper = (lane & o) != 0;
#pragma unroll
            for (int i = 0; i < n / 2; ++i) {
#pragma unroll
                for (int u = 0; u < 2; ++u) {
                    const float send = upper ? part[u][i] : part[u][i + n / 2];
                    const float recv = __shfl_xor(send, o);
                    const float keep = upper ? part[u][i + n / 2] : part[u][i];
                    part[u][i] = keep + recv;
                }
            }
        }
#pragma unroll
        for (int u = 0; u < 2; ++u) {
            float lg = part[u][0] + __shfl_xor(part[u][0], 1);
            lg += brl;
            int rank = 0;
#pragma unroll
            for (int e = 0; e < 32; ++e) { const float ov = __int_as_float(__builtin_amdgcn_readlane(__float_as_int(lg), 2 * e)); rank += (ov > lg || (ov == lg && e < mye)) ? 1 : 0; }
            int te[4]; float tv[4];
#pragma unroll
            for (int k = 0; k < 4; ++k) {
                const unsigned long long msk = __ballot(rank == k && (lane & 1) == 0);
                const int idx = msk ? __builtin_amdgcn_readfirstlane((int)__builtin_ctzll(msk)) : 2 * k;
                te[k] = idx >> 1; tv[k] = __int_as_float(__builtin_amdgcn_readlane(__float_as_int(lg), idx));
            }
            const float e1 = __expf(tv[1] - tv[0]), e2 = __expf(tv[2] - tv[0]), e3 = __expf(tv[3] - tv[0]);
            const float inv = 1.0f / (1.0f + e1 + e2 + e3);
            if (lane < 4 && vld[u]) {
                const int k = lane, row = rw[u];
                const int e = k == 0 ? te[0] : (k == 1 ? te[1] : (k == 2 ? te[2] : te[3]));
                const float wgt = (k == 0 ? 1.0f : (k == 1 ? e1 : (k == 2 ? e2 : e3))) * inv;
                const unsigned pos = __hip_atomic_fetch_add(lcnt + e, 1u, __ATOMIC_RELAXED, __HIP_MEMORY_SCOPE_WORKGROUP);
                F.w<int>(WS_RE)[row * 4 + k] = e; F.w<int>(WS_RP)[row * 4 + k] = (int)pos; F.w<float>(WS_RW)[row * 4 + k] = wgt;
            }
        }
    }
    __syncthreads();
    if (F.tid < 32) lcnt[32 + F.tid] = atomicAdd(cnt + F.tid * 32, lcnt[F.tid]);
    __syncthreads();
    for (int row = F.bid * 8 + F.wave; row < nrows; row += nwaves) {
        if (lane < 4) { const int a = row * 4 + lane; F.w<int>(WS_RP)[a] += (int)lcnt[32 + F.w<int>(WS_RE)[a]]; }
    }
}

__device__ __forceinline__ int expert_pad_start(const Frame& F, int l, int& ntiles) {
    const unsigned* cnt = F.w<unsigned>(WS_CTL) + CW_CNT + l * 1024;
    int c = F.lane < 32 ? (int)__hip_atomic_load(cnt + F.lane * 32, __ATOMIC_RELAXED, __HIP_MEMORY_SCOPE_AGENT) : 0;
    int padded = (c + 255) & ~255;
    int incl = padded;
#pragma unroll
    for (int o = 1; o < 32; o <<= 1) { const int v = __shfl_up(incl, o); if ((F.lane & 31) >= o) incl += v; }
    ntiles = __shfl(incl, 31) >> 8;
    return incl - padded;
}

__device__ __forceinline__ void ph_gather(const Frame& F, int l) {
    int ntiles; const int ps = expert_pad_start(F, l, ntiles);
    if (F.bid == 0 && F.wave == 0) {
        int* tab = F.w<int>(WS_CTL) + CW_TILE + l * 320;
        const int nxt = __shfl_down(ps, 1);
        const int endt = (F.lane == 31) ? ntiles : (nxt >> 8);
        if (F.lane < 32) for (int t = ps >> 8; t < endt; ++t) tab[t] = F.lane;
        if (F.lane == 0) F.w<int>(WS_CTL)[CW_NT + l] = ntiles;
    }
    const int nrows = (l == 0) ? T : L;
    for (int a0 = (F.bid * 8 + F.wave) * 64; a0 < nrows * 4; a0 += F.G * 8 * 64) {
        const int a = a0 + F.lane;
        if (a < nrows * 4) {
            const int e = F.w<int>(WS_RE)[a], pos = F.w<int>(WS_RP)[a];
            const int dst = __shfl(ps, e) + pos;
            F.w<int>(WS_SLOT)[a] = dst;
            F.w<int>(WS_ROWTOK)[(size_t)l * MAXROWS + dst] = a >> 2;
        }
    }
}

__device__ __forceinline__ void ph_final(const Frame& F, int l) {
    const int nrows = (l == 0) ? T : L;
    const int nwaves = F.G * 8, lane = F.lane;
    const bf16_t* Y = F.w<bf16_t>(WS_Y) + (size_t)l * MAXROWS * D;
    int slotn[2][4]; float wgtn[2][4];
#define FN_SLOTS(r0_) do { _Pragma("unroll") for (int u = 0; u < 2; ++u) { const int rr_ = ((r0_) + u * nwaves < nrows) ? (r0_) + u * nwaves : (r0_); \
        _Pragma("unroll") for (int k = 0; k < 4; ++k) { slotn[u][k] = F.w<int>(WS_SLOT)[rr_ * 4 + k]; wgtn[u][k] = F.w<float>(WS_RW)[rr_ * 4 + k]; } } } while (0)
    const int rfirst = F.bid * 8 + F.wave;
    if (rfirst < nrows) FN_SLOTS(rfirst);
    for (int row0 = rfirst; row0 < nrows; row0 += 2 * nwaves) {
        int rw[2]; bool vld[2];
        rw[0] = row0; vld[0] = true; vld[1] = (row0 + nwaves < nrows); rw[1] = vld[1] ? row0 + nwaves : row0;
        int slot[2][4]; float wgt[2][4];
#pragma unroll
        for (int u = 0; u < 2; ++u)
#pragma unroll
            for (int k = 0; k < 4; ++k) { slot[u][k] = slotn[u][k]; wgt[u][k] = wgtn[u][k]; }
        u32x2 yv[2][4][4]; f32x4 x[2][4];
#pragma unroll
        for (int u = 0; u < 2; ++u) {
#pragma unroll
            for (int k = 0; k < 4; ++k) { const bf16_t* yr = Y + (size_t)slot[u][k] * D;
#pragma unroll
                for (int i = 0; i < 4; ++i) yv[u][k][i] = *(const u32x2*)(yr + 4 * lane + 256 * i); }
            load_xrow(F, 1, rw[u], lane, x[u]);
        }
        if (row0 + 2 * nwaves < nrows) FN_SLOTS(row0 + 2 * nwaves);
#pragma unroll
        for (int u = 0; u < 2; ++u) {
            const int which = rw[u] >= L;
            const float* ve = vecs_ptr(F, l, which, 5);
            f32x4 f[4];
#pragma unroll
            for (int i = 0; i < 4; ++i) f[i] = (f32x4){0.f, 0.f, 0.f, 0.f};
#pragma unroll
            for (int k = 0; k < 4; ++k)
#pragma unroll
                for (int i = 0; i < 4; ++i) { const u32x2 w = yv[u][k][i]; f[i][0] += wgt[u][k] * bflo(w.x); f[i][1] += wgt[u][k] * bfhi(w.x); f[i][2] += wgt[u][k] * bflo(w.y); f[i][3] += wgt[u][k] * bfhi(w.y); }
            const float rs = row_rstd(f);
#pragma unroll
            for (int i = 0; i < 4; ++i) { const f32x4 a = *(const f32x4*)(ve + 4 * lane + 256 * i); x[u][i] = x[u][i] + f[i] * rs * a; }
            if (vld[u]) {
                if (l == 1) { float* xo = F.out + (size_t)rw[u] * D;
#pragma unroll
                    for (int i = 0; i < 4; ++i) *(f32x4*)(xo + 4 * lane + 256 * i) = x[u][i]; }
                else store_xrow_bf16(F.w<bf16_t>(WS_XCUR) + (size_t)rw[u] * D, lane, x[u]);
                if (l == 0) {
                    const float rstd = row_rstd(x[u]);
                    const float* va = vecs_ptr(F, 1, which, 0), *vb = vecs_ptr(F, 1, which, 1);
                    bf16_t* orow = F.w<bf16_t>(WS_HB) + (size_t)rw[u] * D;
                    unsigned char* orow8 = F.w<unsigned char>(WS_HB) + (size_t)rw[u] * D;
#pragma unroll
                    for (int i = 0; i < 4; ++i) {
                        const int c = 4 * lane + 256 * i;
                        const f32x4 a = *(const f32x4*)(va + c), b = *(const f32x4*)(vb + c);
                        if (F8IN(1)) *(unsigned*)(orow8 + c) = pk_fp8x4(x[u][i][0] * rstd * a[0] + b[0], x[u][i][1] * rstd * a[1] + b[1], x[u][i][2] * rstd * a[2] + b[2], x[u][i][3] * rstd * a[3] + b[3]);
                        else { u32x2 w; w.x = pk_bf16(x[u][i][0] * rstd * a[0] + b[0], x[u][i][1] * rstd * a[1] + b[1]); w.y = pk_bf16(x[u][i][2] * rstd * a[2] + b[2], x[u][i][3] * rstd * a[3] + b[3]);
                        *(u32x2*)(orow + c) = w; }
                    }
                }
            }
        }
    }
#undef FN_SLOTS
}

constexpr int PH_PER_LAYER = 10, N_PHASES = 2 + 2 * PH_PER_LAYER;
#ifndef PH_MASK
#define PH_MASK 0xFFFFFFFFu
#endif
#define EN(b) (((PH_MASK) >> (b)) & 1u)
#ifndef DUP_MASK
#define DUP_MASK 0u
#endif
#define REP(b) for (int _rep = 0; _rep < 1 + (int)(((DUP_MASK) >> (b)) & 1u); ++_rep)

__global__ void __launch_bounds__(NTHREADS, 2) mega(Args args) {
    extern __shared__ __attribute__((aligned(16))) unsigned char shm[];
    Frame F0;
    F0.in.kp = (kargp_t)__builtin_amdgcn_kernarg_segment_ptr();
    F0.out = args.out; F0.ws = args.ws; F0.lds = (LAS unsigned char*)shm;
    F0.tid = threadIdx.x; F0.lane = F0.tid & 63; F0.wave = __builtin_amdgcn_readfirstlane(F0.tid >> 6); F0.G = gridDim.x; F0.bid = blockIdx.x;
    volatile LAS unsigned* bst = (volatile LAS unsigned*)(shm + LDS_BYTES - 16);
    XcdBarrier bar; bar.bar = F0.w<unsigned>(WS_CTL) + CW_BAR; bar.x = 0; bar.st = bst;
#if N_LAUNCH_MODE == 1
    if (F0.tid == 0) { bst[0] = 0u; bst[1] = 0u; }
    __syncthreads();
    bar = xcd_barrier_post(F0.w<unsigned>(WS_CTL) + CW_BAR, bst);
#define GRID_BAR() xcd_barrier(bar)
#else
#define GRID_BAR() do {} while (0)
#endif
    const int lo = args.ph_lo, hi = args.ph_hi;
#define IN(k) (lo <= (k) && (k) < hi)
#define SEAM(k) do { if (IN(k) && IN((k) + 1)) GRID_BAR(); } while (0)

    if (IN(0)) { const Frame F = launder(F0); REP(1) ph_modpart(F); }
    SEAM(0);
    if (IN(1)) { const Frame F = launder(F0);
        REP(2) ph_filter(F); REP(3) ph_norm1(F, 0); ph_vecs(F); __syncthreads(); REP(0) ph_convert(F); }
    SEAM(1);
    for (int l = 0; l < 2; ++l) {
        const int pb = 2 + l * PH_PER_LAYER;
        if (EN(5) && IN(pb + 0)) { const Frame F = launder(F0);
            const bool f8 = (l == 0) ? (F8IN(0) != 0) : (F8IN(1) != 0);
            pg8::Gemm g{F.w<bf16_t>(WS_HB), F.w<bf16_t>(WS_WINT) + (size_t)l * PC * D, f8 ? D / 2 : D};
            pg8::SchedGrid S{PC / 256, (T / 256) * (PC / 256), F.G, F.vid};
            pg8::EpiBf16 E{F.w<bf16_t>(WS_P), PC, nullptr, 0};
            if (INPROJ_FP8 == 0) pg8::gemm_phase<pg8::EpiBf16, pg8::SchedGrid, true, false, false>(F.lds, g, S, E, F.tid);
            else if (INPROJ_FP8 == 3) pg8::gemm_phase<pg8::EpiBf16, pg8::SchedGrid, true, false, true>(F.lds, g, S, E, F.tid);
            else { if (f8) pg8::gemm_phase<pg8::EpiBf16, pg8::SchedGrid, true, false, true>(F.lds, g, S, E, F.tid); else pg8::gemm_phase<pg8::EpiBf16, pg8::SchedGrid, true, false, false>(F.lds, g, S, E, F.tid); }
        }
        SEAM(pb + 0);
        if (IN(pb + 1)) { const Frame F = launder(F0); if (l == 0) { REP(4) ph_fsum(F); } REP(6) ph_ssd_prep(F, l); REP(7) ph_hy_prep(F, l); REP(8) ph_na(F, l, 0); }
        SEAM(pb + 1);
        if (IN(pb + 2)) { const Frame F = launder(F0); REP(9) ph_ssd_scan(F); REP(10) { ph_hy_conv(F, l); if (l == 0) ph_hy_conv_ctx(F, l); } }
        SEAM(pb + 2);
        if (EN(11) && IN(pb + 3)) { const Frame F = launder(F0); REP(11) ph_ssd_out(F, l); REP(18) ph_hy_tr(F); if (l == 0) ph_na(F, l, 1); }
        SEAM(pb + 3);
        if (EN(12) && IN(pb + 4)) { const Frame F = launder(F0);
            pg8::Gemm g{F.w<bf16_t>(WS_MIX), F.w<bf16_t>(WS_WOUTT) + (size_t)l * D * D, D};
            const int nM = (l == 0) ? T / 256 : L / 256;
            pg8::SchedGrid S{4, nM * 4, F.G, F.vid};
            pg8::EpiBf16 E{F.w<bf16_t>(WS_MIXO), D, nullptr, 0};
            REP(12) pg8::gemm_phase<pg8::EpiBf16, pg8::SchedGrid>(F.lds, g, S, E, F.tid);
        }
        SEAM(pb + 4);
        if (EN(13) && IN(pb + 5)) { const Frame F = launder(F0); ph_post1(F, l); }
        SEAM(pb + 5);
        if (EN(14) && IN(pb + 6)) { const Frame F = launder(F0); REP(14) ph_gather(F, l); }
        SEAM(pb + 6);
        if (EN(15) && IN(pb + 7)) { const Frame F = launder(F0);
            const int* tab = F.w<int>(WS_CTL) + CW_TILE + l * 320;
            const int ntiles = __builtin_amdgcn_readfirstlane(F.w<int>(WS_CTL)[CW_NT + l]);
            pg8::Gemm g{F.w<bf16_t>(WS_H2), (const bf16_t*)(F.w<unsigned char>(WS_WGUT) + (size_t)l * NE * 2048 * D), D / 2};
            pg8::SchedMoe S{8, ntiles * 8, F.G, F.vid, tab};
            pg8::EpiAct E{F.w<unsigned char>(WS_HMID) + (size_t)l * MAXROWS * D, F.in[I_BGU] + (size_t)l * NE * 2048};
            LAS int* rowtab = (LAS int*)(F.lds + pg8::STAGE_BYTES);
            __syncthreads();
            {
                int nt_; const int ps = expert_pad_start(F, l, nt_);
                const unsigned* cnt = F.w<unsigned>(WS_CTL) + CW_CNT + l * 1024;
                for (int ui = 0; ui * F.G + F.vid < ntiles * 8 && ui < 12; ++ui) {
                    const int pa = (ui * F.G + F.vid) / 8;
                    const int e = tab[pa];
                    const int pstart = __shfl(ps, e), ce = (int)__hip_atomic_load(cnt + e * 32, __ATOMIC_RELAXED, __HIP_MEMORY_SCOPE_AGENT);
                    if (F.tid < 256) { const int prow = pa * 256 + F.tid; rowtab[ui * 256 + F.tid] = (prow - pstart < ce) ? F.w<int>(WS_ROWTOK)[(size_t)l * MAXROWS + prow] : T; }
                }
            }
            __syncthreads();
            REP(15) pg8::gemm_phase<pg8::EpiAct, pg8::SchedMoe, true, true, true>(F.lds, g, S, E, F.tid, rowtab);
        }
        SEAM(pb + 7);
        if (EN(16) && IN(pb + 8)) { const Frame F = launder(F0);
            const int* tab = F.w<int>(WS_CTL) + CW_TILE + l * 320;
            const int ntiles = __builtin_amdgcn_readfirstlane(F.w<int>(WS_CTL)[CW_NT + l]);
            pg8::Gemm g{(const bf16_t*)(F.w<unsigned char>(WS_HMID) + (size_t)l * MAXROWS * D), (const bf16_t*)(F.w<unsigned char>(WS_WDT) + (size_t)l * NE * D * D), D / 2};
            pg8::SchedMoe S{4, ntiles * 4, F.G, F.vid, tab};
            pg8::EpiBf16 E{F.w<bf16_t>(WS_Y) + (size_t)l * MAXROWS * D, D, F.in[I_BDN] + (size_t)l * NE * D, D};
            REP(16) pg8::gemm_phase<pg8::EpiBf16, pg8::SchedMoe, true, false, true>(F.lds, g, S, E, F.tid);
        }
        SEAM(pb + 8);
        if (EN(17) && IN(pb + 9)) { const Frame F = launder(F0); ph_final(F, l); }
        if (l == 0) SEAM(pb + 9);
    }
#undef IN
#undef SEAM
}

extern "C" void kernel_launch(void* const* d_in, const int* in_sizes, int n_in, void* d_out, int out_size, void* d_ws, size_t ws_size, hipStream_t stream) {
    static int grid = 0;
    if (grid == 0) {
        if (n_in != N_IN || out_size != L * D || ws_size < WS_END) { fprintf(stderr, "kernel_launch: unexpected shapes: n_in %d out %d ws %zu (need %zu)\n", n_in, out_size, ws_size, (size_t)WS_END); grid = -1; return; }
        int dev = 0, cus = 0, per_cu = 0;
        if (hipGetDevice(&dev) != hipSuccess || hipDeviceGetAttribute(&cus, hipDeviceAttributeMultiprocessorCount, dev) != hipSuccess) { grid = -1; return; }
        if (hipFuncSetAttribute((const void*)mega, hipFuncAttributeMaxDynamicSharedMemorySize, LDS_BYTES) != hipSuccess) { fprintf(stderr, "kernel_launch: hipFuncSetAttribute failed\n"); grid = -1; return; }
        if (hipOccupancyMaxActiveBlocksPerMultiprocessor(&per_cu, (const void*)mega, NTHREADS, LDS_BYTES) != hipSuccess || per_cu < 1) { fprintf(stderr, "kernel_launch: occupancy query says %d\n", per_cu); }
        (void)hipGetLastError();
        grid = cus;
    }
    if (grid < 0) return;
    (void)hipMemsetAsync((char*)d_ws + WS_CTL, 0, CTL_BYTES, stream);
    Args a{};
    for (int i = 0; i < N_IN; ++i) a.in[i] = (const float*)d_in[i];
    a.out = (float*)d_out; a.ws = (unsigned char*)d_ws;
#if N_LAUNCH_MODE == 1
    a.ph_lo = 0; a.ph_hi = N_PHASES;
    hipLaunchKernelGGL(mega, dim3(grid), dim3(NTHREADS), LDS_BYTES, stream, a);
#else
    for (int p = 0; p < N_PHASES; ++p) { a.ph_lo = p; a.ph_hi = p + 1; hipLaunchKernelGGL(mega, dim3(grid), dim3(NTHREADS), LDS_BYTES, stream, a); }
#endif
}
```

```cpp
#include <hip/hip_runtime.h>
#include <cstdio>
#include <cstdint>

#define LAS __attribute__((address_space(3)))
typedef unsigned short bf16_t;
typedef short bf16x8 __attribute__((ext_vector_type(8)));
typedef float f32x4 __attribute__((ext_vector_type(4)));
typedef float f32x16 __attribute__((ext_vector_type(16)));
typedef unsigned u32x4 __attribute__((ext_vector_type(4)));
typedef unsigned u32x2 __attribute__((ext_vector_type(2)));
typedef int v4i __attribute__((ext_vector_type(4)));
typedef int v8i __attribute__((ext_vector_type(8)));

#ifndef N_LAUNCH_MODE
#define N_LAUNCH_MODE 1
#endif

constexpr int D = 1024, L = 16384, LC = 256, T = L + LC, NCH = T / 128;
constexpr int PC = 3328;
constexpr int CZ = 0, CXBC = 384, CQ = 1280, CK = 1664, CV = 2048, CHY = 2432, CDT = 3200;
constexpr int NE = 32;
constexpr int MAXT = 292;
constexpr int MAXROWS = MAXT * 256;
constexpr int NTHREADS = 512;
constexpr int LDS_BYTES = 160 * 1024;
constexpr float RMS_EPS = 1e-6f;

enum { I_X = 0, I_C, I_CTX, I_CCTX, I_WMOD, I_BMOD, I_NORMG, I_WIN, I_SCW, I_SCB, I_ALOG, I_DTB, I_SSDD, I_SSDNG, I_RPB, I_HCW, I_HCB,
       I_FW1, I_FB1, I_FW2, I_FB2, I_FW3, I_FREQ, I_HYD, I_WOUT, I_WR, I_BR, I_WGU, I_BGU, I_WDN, I_BDN, N_IN };

constexpr size_t al256(size_t x) { return (x + 255) & ~(size_t)255; }
constexpr size_t WS_CTL   = 0;
constexpr size_t CTL_BYTES = 64 * 1024;
constexpr size_t WS_WINT  = WS_CTL + CTL_BYTES;
constexpr size_t WS_WOUTT = WS_WINT + al256((size_t)2 * PC * D * 2);
constexpr size_t WS_WGUT  = WS_WOUTT + al256((size_t)2 * D * D * 2);
constexpr size_t WS_WDT   = WS_WGUT + al256((size_t)2 * NE * 2048 * D * 2);
constexpr size_t WS_MODP  = WS_WDT + al256((size_t)2 * NE * D * D * 2);
constexpr int KRL = 2 * L + 512;
constexpr size_t WS_KR    = WS_MODP + al256((size_t)2 * 2 * 32 * 6144 * 4);
constexpr size_t WS_KCOMBC= WS_KR + al256((size_t)2 * 256 * KRL * 2);
constexpr size_t WS_FPART = WS_KCOMBC + al256((size_t)2 * LC * 256 * 4);
constexpr size_t WS_FPARTC= WS_FPART + al256((size_t)2 * 256 * 512 * 4);
constexpr size_t WS_FSUM  = WS_FPARTC + al256((size_t)16 * 512 * 4);
constexpr size_t WS_HB    = WS_FSUM + al256((size_t)3 * 256 * 4);
constexpr size_t WS_P     = WS_HB + al256((size_t)T * D * 2);
constexpr size_t WS_XBC   = WS_P + al256((size_t)T * PC * 2);
constexpr size_t WS_DTV   = WS_XBC + al256((size_t)T * 896 * 2);
constexpr size_t WS_ACS   = WS_DTV + al256((size_t)T * 12 * 4);
constexpr size_t WS_ALAST = WS_ACS + al256((size_t)T * 12 * 4);
constexpr size_t WS_STATES= WS_ALAST + al256((size_t)NCH * 12 * 4);
constexpr size_t WS_SSTART= WS_STATES + al256((size_t)2 * NCH * 6 * 128 * 64 * 4);
constexpr size_t WS_U     = WS_SSTART + al256((size_t)2 * NCH * 6 * 128 * 64 * 4);
constexpr size_t WS_UT    = WS_U + al256((size_t)T * 256 * 4);
constexpr size_t WS_UT8   = WS_UT + al256((size_t)256 * L * 2);
constexpr size_t WS_X0T   = WS_UT8 + al256((size_t)256 * L);
constexpr size_t WS_YT    = WS_X0T + al256((size_t)256 * L * 2);
constexpr size_t WS_MIX   = WS_YT + al256((size_t)256 * L * 2);
constexpr size_t WS_MIXO  = WS_MIX + al256((size_t)T * D * 2);
constexpr size_t WS_XCUR  = WS_MIXO + al256((size_t)T * D * 4);
constexpr size_t WS_H2    = WS_XCUR + al256((size_t)T * D * 4);
constexpr size_t WS_RE    = WS_H2 + al256((size_t)(T + 1) * D * 2);
constexpr size_t WS_RP    = WS_RE + al256((size_t)T * 4 * 4);
constexpr size_t WS_RW    = WS_RP + al256((size_t)T * 4 * 4);
constexpr size_t WS_SLOT  = WS_RW + al256((size_t)T * 4 * 4);
constexpr size_t WS_XG    = WS_SLOT + al256((size_t)T * 4 * 4);
constexpr size_t WS_HMID  = WS_XG + 256;
constexpr size_t WS_Y     = WS_HMID + al256((size_t)2 * MAXROWS * D * 2);
constexpr size_t WS_VECS  = WS_Y + al256((size_t)2 * MAXROWS * D * 2);
constexpr size_t WS_ROWTOK= WS_VECS + al256((size_t)2 * 2 * 6 * 1024 * 4);
constexpr size_t WS_END   = WS_ROWTOK + al256((size_t)2 * MAXROWS * 4);

constexpr int CW_BAR = 0;
constexpr int CW_CNT = 8192;
#ifndef INPROJ_FP8
#define INPROJ_FP8 2
#endif
#define F8IN(l) (((INPROJ_FP8) >> (l)) & 1)
#ifndef PRO_NF
#define PRO_NF 96
#endif
constexpr int CW_CVQ = 4160;
constexpr int CW_NT = 4200;
constexpr int CW_TILE = 4224;

__device__ __forceinline__ float bf2f(unsigned short b) { return __uint_as_float(((unsigned)b) << 16); }
__device__ __forceinline__ unsigned short f2bf(float f) { return __builtin_bit_cast(unsigned short, (__bf16)f); }
typedef __bf16 bf16v2 __attribute__((ext_vector_type(2)));
__device__ __forceinline__ unsigned pk_bf16(float lo, float hi) { const bf16v2 v = {(__bf16)lo, (__bf16)hi}; return __builtin_bit_cast(unsigned, v); }
__device__ __forceinline__ float sat8(float x) { return fminf(fmaxf(x, -448.0f), 448.0f); }
__device__ __forceinline__ unsigned pk_fp8x4(float a, float b, float c, float d) { unsigned w = 0; w = __builtin_amdgcn_cvt_pk_fp8_f32(sat8(a), sat8(b), w, false); w = __builtin_amdgcn_cvt_pk_fp8_f32(sat8(c), sat8(d), w, true); return w; }
constexpr float KR_SCALE = 64.0f;
constexpr float W8_SCALE = 32.0f;
constexpr int W8_SCALE_E8M0 = 0x7A7A7A7A, ONE_E8M0 = 0x7F7F7F7F;
__device__ __forceinline__ float bflo(unsigned w) { return __uint_as_float(w << 16); }
__device__ __forceinline__ float bfhi(unsigned w) { return __uint_as_float(w & 0xFFFF0000u); }
__device__ __forceinline__ float silu_f(float x) { return x * __builtin_amdgcn_rcpf(1.0f + __expf(-x)); }
__device__ __forceinline__ float softplus_f(float x) { return x > 20.f ? x : log1pf(__expf(x)); }
__device__ __forceinline__ float row16_ror(float v, int ctrl8421) {
    switch (ctrl8421) {
        case 8: return __int_as_float(__builtin_amdgcn_update_dpp(0, __float_as_int(v), 0x128, 0xF, 0xF, false));
        case 4: return __int_as_float(__builtin_amdgcn_update_dpp(0, __float_as_int(v), 0x124, 0xF, 0xF, false));
        case 2: return __int_as_float(__builtin_amdgcn_update_dpp(0, __float_as_int(v), 0x122, 0xF, 0xF, false));
        default: return __int_as_float(__builtin_amdgcn_update_dpp(0, __float_as_int(v), 0x121, 0xF, 0xF, false));
    }
}
__device__ __forceinline__ float row16_max(float v) { v = fmaxf(v, row16_ror(v, 8)); v = fmaxf(v, row16_ror(v, 4)); v = fmaxf(v, row16_ror(v, 2)); v = fmaxf(v, row16_ror(v, 1)); return v; }
__device__ __forceinline__ float row16_sum(float v) { v += row16_ror(v, 8); v += row16_ror(v, 4); v += row16_ror(v, 2); v += row16_ror(v, 1); return v; }
__device__ __forceinline__ float wave_sum(float v) {
    v = row16_sum(v);
    const int vi = __float_as_int(v);
    return (__int_as_float(__builtin_amdgcn_readlane(vi, 0)) + __int_as_float(__builtin_amdgcn_readlane(vi, 16))) + (__int_as_float(__builtin_amdgcn_readlane(vi, 32)) + __int_as_float(__builtin_amdgcn_readlane(vi, 48)));
}
__device__ __forceinline__ void lds_fence() { asm volatile("s_waitcnt lgkmcnt(0)" ::: "memory"); }

#define XB_TMO      128
#define XB_XCNT(j)  (256  + 64 * (j))
#define XB_XSUB(j)  (1280 + 64 * (j))
#define XB_XGEN(j)  (2304 + 64 * (j))
#define XB_TOP      3328
#define XB_TOPGEN   3392
#define XCD_BAR_WORDS 3456
#define XB_SPIN_CAP (1u << 18)
__device__ __forceinline__ unsigned xb_ld(unsigned* p)              { return __hip_atomic_load(p, __ATOMIC_RELAXED, __HIP_MEMORY_SCOPE_AGENT); }
__device__ __forceinline__ unsigned xb_add(unsigned* p, unsigned v) { return __hip_atomic_fetch_add(p, v, __ATOMIC_RELAXED, __HIP_MEMORY_SCOPE_AGENT); }
__device__ __forceinline__ unsigned xb_xcc_id() { return (unsigned)__builtin_amdgcn_s_getreg((3 << 11) | 20) & 0xFu; }
#define XB_SPIN(cond, bar) do { unsigned _sp = 0; while (cond) { __builtin_amdgcn_s_sleep(1); \
    if ((++_sp & 255u) == 0u) { if (xb_ld(&(bar)[XB_TMO])) break; if (_sp > XB_SPIN_CAP) { atomicAdd(&(bar)[XB_TMO], 1u); break; } } } } while (0)
struct XcdBarrier { unsigned* bar; unsigned x; volatile LAS unsigned* st; };
__device__ __forceinline__ XcdBarrier xcd_barrier_post(unsigned* bar, volatile LAS unsigned* st) {
    XcdBarrier b; b.bar = bar; b.x = xb_xcc_id(); b.st = st;
    if (threadIdx.x == 0) (void)xb_add(&bar[XB_XCNT(b.x)], 1u);
    return b;
}
__device__ __forceinline__ void xcd_barrier_complete(unsigned* bar, unsigned x, unsigned& nloc, unsigned& nx) {
    const unsigned G = gridDim.x * gridDim.y * gridDim.z;
    unsigned sum, cnt, mine, sp = 0u;
    for (;;) {
        sum = 0u; cnt = 0u; mine = 0u;
#pragma unroll
        for (unsigned j = 0; j < 16; ++j) { const unsigned c = xb_ld(&bar[XB_XCNT(j)]); sum += c; cnt += (c > 0u) ? 1u : 0u; mine = (j == x) ? c : mine; }
        if (sum == G) break;
        __builtin_amdgcn_s_sleep(1);
        if ((++sp & 255u) == 0u) { if (xb_ld(&bar[XB_TMO])) break; if (sp > XB_SPIN_CAP) { atomicAdd(&bar[XB_TMO], 1u); break; } }
    }
    nloc = mine > 0u ? mine : 1u; nx = cnt > 0u ? cnt : 1u;
}
__device__ __forceinline__ void xcd_barrier(const XcdBarrier& b) {
    asm volatile("s_waitcnt vmcnt(0)" ::: "memory");
    __syncthreads();
    if (threadIdx.x == 0) {
        unsigned* bar = b.bar;
        __builtin_amdgcn_s_waitcnt(0);
        unsigned nloc = b.st[0], nx = b.st[1];
        if (nloc == 0u) { xcd_barrier_complete(bar, b.x, nloc, nx); b.st[0] = nloc; b.st[1] = nx; }
        const unsigned old = xb_add(&bar[XB_XSUB(b.x)], 1u);
        const unsigned gen = old / nloc;
        if (old + 1u == (gen + 1u) * nloc) {
            __builtin_amdgcn_fence(__ATOMIC_RELEASE, "agent");
            asm volatile("s_waitcnt vmcnt(0)" ::: "memory");
            const unsigned og = xb_add(&bar[XB_TOP], 1u);
            const unsigned tg = og / nx;
            if (og + 1u == (tg + 1u) * nx) xb_add(&bar[XB_TOPGEN], 1u);
            else XB_SPIN(xb_ld(&bar[XB_TOPGEN]) == tg, bar);
            __builtin_amdgcn_fence(__ATOMIC_ACQUIRE, "agent");
            xb_add(&bar[XB_XGEN(b.x)], 1u);
            asm volatile("s_waitcnt vmcnt(0)" ::: "memory");
        } else {
            XB_SPIN(xb_ld(&bar[XB_XGEN(b.x)]) == gen, bar);
            __builtin_amdgcn_fence(__ATOMIC_ACQUIRE, "agent");
            asm volatile("s_waitcnt vmcnt(0)" ::: "memory");
        }
    }
    __syncthreads();
}

#ifndef GEMM_REP
#define GEMM_REP 1
#endif
namespace pg8 {
constexpr int BM = 256, BK = 64, HALF = 128, HTB = HALF * BK * 2, STAGE_BYTES = 8 * HTB;
__host__ __device__ __forceinline__ int lds_byte(int r, int c) { const int st = (r >> 4) * 2 + (c >> 5), rr = r & 15, cc = c & 31, ob = rr * 64 + cc * 2; return st * 1024 + (ob ^ (((ob >> 9) & 1) << 5)); }
__host__ __device__ __forceinline__ void stage_rc(int b, int& R, int& C) { const int st = b / 1024, sb = b % 1024, swz = sb ^ (((sb >> 9) & 1) << 5); R = (st >> 1) * 16 + swz / 64; C = (st & 1) * 32 + (swz % 64) / 2; }
__host__ __device__ __forceinline__ int perm32(int rho) { const int n = rho >> 4, i = rho & 15; return 8 * (i >> 2) + 4 * n + (i & 3); }

struct Unit { int pa, pb, pn, e; };
struct Gemm { const bf16_t* A; const bf16_t* Bt; int K; };

template <class Epi, class Sched, bool ALIGN_EPI = true, bool GATHER = false, bool FP8 = false>
__device__ __forceinline__ void gemm_phase(LAS unsigned char* lds, const Gemm g, const Sched& S, const Epi& E, const int tid, const LAS int* rowtab = nullptr) {
    const int wid = __builtin_amdgcn_readfirstlane(tid >> 6), lane = tid & 63, wr = wid >> 2, wc = wid & 3, fr = lane & 15, fq = lane >> 4;
    const int K = g.K, nt = K / BK;
    unsigned voffA[2], voffB[2];
    int gR[2], gC[2];
#pragma unroll
    for (int i = 0; i < 2; ++i) { int R, C; stage_rc(tid * 16 + i * 8192, R, C); const int Rb = Epi::PERM ? ((R & ~31) + perm32(R & 31)) : R;
        voffA[i] = (unsigned)(R * K + C) * 2u; voffB[i] = (unsigned)(Rb * K + C) * 2u; gR[i] = R; gC[i] = C * 2; }
    unsigned vC0[2], vC1[2], vN0[2], vN1[2];
#define PG8_GOFFS(dst0, dst1, ui_) do { _Pragma("unroll") for (int _i = 0; _i < 2; ++_i) { \
        dst0[_i] = (unsigned)rowtab[(ui_) * 256 + gR[_i]] * (unsigned)(K * 2) + (unsigned)gC[_i]; dst1[_i] = (unsigned)rowtab[(ui_) * 256 + 128 + gR[_i]] * (unsigned)(K * 2) + (unsigned)gC[_i]; } } while (0)
    const size_t kstep = (size_t)(BK * 2);
    const size_t hstep = (size_t)HALF * K * 2;
    const size_t tstep = 2 * hstep;
    const unsigned ldsw = (unsigned)wid * 1024u;
    const int aoff = lds_byte(wr * 64 + fr, fq * 8), boff = lds_byte(wc * 32 + fr, fq * 8);
#define PG8_SA(b, h) (((b) * 2 + (h)) * HTB)
#define PG8_SB(b, h) ((4 + (b) * 2 + (h)) * HTB)
#define PG8_STAGE(bufoff, gbase, voff) do { _Pragma("unroll") for (int _i = 0; _i < 2; ++_i) \
        __builtin_amdgcn_global_load_lds((const unsigned*)((const char*)(gbase) + (voff)[_i]), (LAS unsigned*)(lds + (bufoff) + ldsw + _i * 8192), 16, 0, 0); } while (0)
#define PG8_LDA(dst, b, h) do { _Pragma("unroll") for (int m = 0; m < 4; ++m) { const v4i _x = *(const LAS v4i*)(lds + PG8_SA(b, h) + aoff + m * 2048), _y = *(const LAS v4i*)(lds + PG8_SA(b, h) + aoff + m * 2048 + 1024); \
        dst[m] = __builtin_shufflevector(_x, _y, 0, 1, 2, 3, 4, 5, 6, 7); } } while (0)
#define PG8_LDB(dst, b, h) do { _Pragma("unroll") for (int n = 0; n < 2; ++n) { const v4i _x = *(const LAS v4i*)(lds + PG8_SB(b, h) + boff + n * 2048), _y = *(const LAS v4i*)(lds + PG8_SB(b, h) + boff + n * 2048 + 1024); \
        dst[n] = __builtin_shufflevector(_x, _y, 0, 1, 2, 3, 4, 5, 6, 7); } } while (0)
#define PG8_HALF0(x) __builtin_bit_cast(bf16x8, __builtin_shufflevector((x), (x), 0, 1, 2, 3))
#define PG8_HALF1(x) __builtin_bit_cast(bf16x8, __builtin_shufflevector((x), (x), 4, 5, 6, 7))
#define PG8_MMA(ai, bj, At, Bt) do { __builtin_amdgcn_s_setprio(1); if constexpr (FP8) { _Pragma("unroll") for (int m = 0; m < 4; ++m) _Pragma("unroll") for (int n = 0; n < 2; ++n) \
        asm volatile("v_mfma_scale_f32_16x16x128_f8f6f4 %0, %1, %2, %0, %3, %4 op_sel_hi:[0,0,0]" : "+v"(acc[ai][bj][m][n]) : "v"(Bt[n]), "v"(At[m]), "v"(sclW), "v"(sclX)); } \
        else { _Pragma("unroll") for (int m = 0; m < 4; ++m) _Pragma("unroll") for (int n = 0; n < 2; ++n) { \
        acc[ai][bj][m][n] = __builtin_amdgcn_mfma_f32_16x16x32_bf16(PG8_HALF0(Bt[n]), PG8_HALF0(At[m]), acc[ai][bj][m][n], 0, 0, 0); \
        acc[ai][bj][m][n] = __builtin_amdgcn_mfma_f32_16x16x32_bf16(PG8_HALF1(Bt[n]), PG8_HALF1(At[m]), acc[ai][bj][m][n], 0, 0, 0); } } __builtin_amdgcn_s_setprio(0); } while (0)
#define PG8_WAIT_V(n) asm volatile("s_waitcnt vmcnt(" #n ")" ::: "memory")
#define PG8_WAIT_L(n) asm volatile("s_waitcnt lgkmcnt(" #n ")" ::: "memory")
#define PG8_BAR __builtin_amdgcn_s_barrier()
#define PG8_SCHED __builtin_amdgcn_sched_barrier(0)
    Unit cur, nxt; int ui = 0;
    if (!S.next(0, cur)) return;
    f32x4 acc[2][2][4][2];
    E.init(acc, cur, wc, fq);
    const int sclW = W8_SCALE_E8M0, sclX = ONE_E8M0;
    v8i At[4], B0[2], B1[2];
    const char* cA = GATHER ? (const char*)g.A : (const char*)g.A + (size_t)cur.pa * tstep; const char* cB = (const char*)g.Bt + (size_t)cur.pb * tstep;
    const size_t hstepA = GATHER ? 0 : hstep;
    if constexpr (GATHER) { PG8_GOFFS(vC0, vC1, 0); } else {
#pragma unroll
        for (int i = 0; i < 2; ++i) { vC0[i] = voffA[i]; vC1[i] = voffA[i]; vN0[i] = voffA[i]; vN1[i] = voffA[i]; } }
    PG8_STAGE(PG8_SB(0, 0), cB, voffB); PG8_STAGE(PG8_SB(0, 1), cB + hstep, voffB); PG8_STAGE(PG8_SA(0, 0), cA, vC0); PG8_STAGE(PG8_SA(0, 1), cA + hstepA, vC1);
    if (wr == 1) PG8_BAR;
    PG8_WAIT_V(2); PG8_BAR;
    PG8_STAGE(PG8_SB(1, 0), cB + kstep, voffB); PG8_STAGE(PG8_SA(1, 0), cA + kstep, vC0); PG8_STAGE(PG8_SB(1, 1), cB + hstep + kstep, voffB);
    PG8_WAIT_V(6); PG8_BAR;
    for (;;) {
        const bool has_next = S.next(ui + 1, nxt);
        const char* nA = GATHER ? (const char*)g.A : (has_next ? (const char*)g.A + (size_t)nxt.pa * tstep : cA); const char* nB = has_next ? (const char*)g.Bt + (size_t)nxt.pb * tstep : cB;
        if constexpr (GATHER) { if (has_next) { PG8_GOFFS(vN0, vN1, ui + 1); } else {
#pragma unroll
            for (int i = 0; i < 2; ++i) { vN0[i] = vC0[i]; vN1[i] = vC1[i]; } } }
#pragma unroll 1
        for (int t = 0; t < nt; t += 2) {
            const bool last = (t == nt - 2);
            unsigned vX0[2], vX1[2];
#pragma unroll
            for (int i = 0; i < 2; ++i) { vX0[i] = (GATHER && last) ? vN0[i] : vC0[i]; vX1[i] = (GATHER && last) ? vN1[i] : vC1[i]; }
            const char* a1 = cA + (size_t)(t + 1) * kstep;
            const char* a2 = last ? nA : cA + (size_t)(t + 2) * kstep; const char* b2 = last ? nB : cB + (size_t)(t + 2) * kstep;
            const char* a3 = a2 + kstep; const char* b3 = b2 + kstep;
            PG8_LDB(B0, 0, 0); PG8_LDB(B1, 0, 1); PG8_SCHED; PG8_LDA(At, 0, 0); PG8_STAGE(PG8_SA(1, 1), a1 + hstepA, vC1);
            PG8_WAIT_V(8); PG8_WAIT_L(0); PG8_BAR; PG8_MMA(0, 0, At, B0); PG8_MMA(0, 1, At, B1); PG8_BAR; PG8_SCHED;
            PG8_LDA(At, 0, 1); PG8_STAGE(PG8_SB(0, 0), b2, voffB); PG8_STAGE(PG8_SB(0, 1), b2 + hstep, voffB); PG8_STAGE(PG8_SA(0, 0), a2, vX0);
            PG8_WAIT_V(8); PG8_WAIT_L(0); PG8_BAR; PG8_MMA(1, 0, At, B0); PG8_MMA(1, 1, At, B1); PG8_BAR; PG8_SCHED;
            PG8_LDB(B0, 1, 0); PG8_LDB(B1, 1, 1); PG8_SCHED; PG8_LDA(At, 1, 0); PG8_STAGE(PG8_SA(0, 1), a2 + hstepA, vX1);
            PG8_WAIT_V(8); PG8_WAIT_L(0); PG8_BAR; PG8_MMA(0, 0, At, B0); PG8_MMA(0, 1, At, B1); PG8_BAR; PG8_SCHED;
            PG8_LDA(At, 1, 1); PG8_STAGE(PG8_SB(1, 0), b3, voffB); PG8_STAGE(PG8_SB(1, 1), b3 + hstep, voffB); PG8_STAGE(PG8_SA(1, 0), a3, vX0);
            PG8_WAIT_V(8); PG8_WAIT_L(0); PG8_BAR; PG8_MMA(1, 0, At, B0); PG8_MMA(1, 1, At, B1); PG8_BAR; PG8_SCHED;
        }
        if constexpr (ALIGN_EPI) { if (wr == 0) PG8_BAR; }
        E(acc, cur, wr, wc, fr, fq);
        if (!has_next) break;
        E.init(acc, nxt, wc, fq);
        cur = nxt; cA = nA; cB = nB; ++ui;
        if constexpr (GATHER) {
#pragma unroll
            for (int i = 0; i < 2; ++i) { vC0[i] = vN0[i]; vC1[i] = vN1[i]; } }
        if constexpr (ALIGN_EPI) { if (wr == 1) PG8_BAR; }
    }
    PG8_WAIT_V(0);
    if constexpr (!ALIGN_EPI) { if (wr == 0) PG8_BAR; }
    PG8_BAR;
#undef PG8_GOFFS
#undef PG8_HALF0
#undef PG8_HALF1
#undef PG8_SA
#undef PG8_SB
#undef PG8_STAGE
#undef PG8_LDA
#undef PG8_LDB
#undef PG8_MMA
#undef PG8_WAIT_V
#undef PG8_WAIT_L
#undef PG8_BAR
#undef PG8_SCHED
}

struct EpiF32 {
    static constexpr bool PERM = false;
    float* C; int ldc;
    __device__ __forceinline__ void operator()(const f32x4 (&acc)[2][2][4][2], const Unit& u, int wr, int wc, int fr, int fq) const {
        const int row0 = u.pa * BM + wr * 64 + fr, col0 = u.pn * BM + wc * 32 + 4 * fq;
#pragma unroll
        for (int ai = 0; ai < 2; ++ai)
#pragma unroll
            for (int m = 0; m < 4; ++m) { float* rowp = C + (size_t)(row0 + ai * HALF + m * 16) * ldc + col0;
#pragma unroll
                for (int bj = 0; bj < 2; ++bj)
#pragma unroll
                    for (int n = 0; n < 2; ++n) *(f32x4*)(rowp + bj * HALF + n * 16) = acc[ai][bj][m][n]; }
    }
};
struct EpiBf16 {
    static constexpr bool PERM = true;
    bf16_t* O; int ldc; const float* bias; int bias_stride;
    __device__ __forceinline__ void init(f32x4 (&acc)[2][2][4][2], const Unit& u, int wc, int fq) const {
        const int col0 = u.pn * BM + wc * 32 + 8 * fq;
#pragma unroll
        for (int bj = 0; bj < 2; ++bj)
#pragma unroll
            for (int n = 0; n < 2; ++n) { const f32x4 bv = bias ? *(const f32x4*)(bias + (size_t)u.e * bias_stride + col0 + bj * HALF + 4 * n) : (f32x4){0.f, 0.f, 0.f, 0.f};
#pragma unroll
                for (int ai = 0; ai < 2; ++ai)
#pragma unroll
                    for (int m = 0; m < 4; ++m) acc[ai][bj][m][n] = bv; }
    }
    __device__ __forceinline__ void operator()(const f32x4 (&acc)[2][2][4][2], const Unit& u, int wr, int wc, int fr, int fq) const {
        const int row0 = u.pa * BM + wr * 64 + fr; const int col0 = u.pn * BM + wc * 32 + 8 * fq;
#pragma unroll
        for (int ai = 0; ai < 2; ++ai)
#pragma unroll
            for (int m = 0; m < 4; ++m) { bf16_t* rowp = O + (size_t)(row0 + ai * HALF + m * 16) * ldc + col0;
#pragma unroll
                for (int bj = 0; bj < 2; ++bj) { const f32x4 v0 = acc[ai][bj][m][0], v1 = acc[ai][bj][m][1];
                    u32x4 w; w.x = pk_bf16(v0[0], v0[1]); w.y = pk_bf16(v0[2], v0[3]); w.z = pk_bf16(v1[0], v1[1]); w.w = pk_bf16(v1[2], v1[3]);
                    *(u32x4*)(rowp + bj * HALF) = w; } }
    }
};
struct EpiAct {
    static constexpr bool PERM = true;
    unsigned char* O; const float* bias;
    __device__ __forceinline__ void init(f32x4 (&acc)[2][2][4][2], const Unit& u, int wc, int fq) const {
        const float* bg = bias + (size_t)u.e * 2048 + u.pn * 128 + wc * 32 + 8 * fq;
#pragma unroll
        for (int bj = 0; bj < 2; ++bj)
#pragma unroll
            for (int n = 0; n < 2; ++n) { const f32x4 bv = *(const f32x4*)(bg + bj * 1024 + 4 * n);
#pragma unroll
                for (int ai = 0; ai < 2; ++ai)
#pragma unroll
                    for (int m = 0; m < 4; ++m) acc[ai][bj][m][n] = bv; }
    }
    __device__ __forceinline__ void operator()(const f32x4 (&acc)[2][2][4][2], const Unit& u, int wr, int wc, int fr, int fq) const {
        const int row0 = u.pa * BM + wr * 64 + fr; const int cc0 = wc * 32 + 8 * fq; const int ocol = u.pn * 128 + cc0;
#pragma unroll
        for (int ai = 0; ai < 2; ++ai)
#pragma unroll
            for (int m = 0; m < 4; ++m) { unsigned char* rowp = O + (size_t)(row0 + ai * HALF + m * 16) * D + ocol;
                float r[8];
#pragma unroll
                for (int n = 0; n < 2; ++n)
#pragma unroll
                    for (int j = 0; j < 4; ++j) { float gt = acc[ai][0][m][n][j], up = acc[ai][1][m][n][j];
                        gt = fminf(gt, 7.0f); up = fminf(fmaxf(up, -7.0f), 7.0f);
                        r[n * 4 + j] = gt * __builtin_amdgcn_rcpf(1.0f + __expf(-1.702f * gt)) * (up + 1.0f); }
                u32x2 w; w.x = pk_fp8x4(r[0], r[1], r[2], r[3]); w.y = pk_fp8x4(r[4], r[5], r[6], r[7]);
                *(u32x2*)rowp = w; }
    }
};
struct SchedGrid {
    int nN, total, G, c;
    __device__ __forceinline__ bool next(int i, Unit& u) const { int Lx = i * G + c; if (Lx >= GEMM_REP * total) return false; if (GEMM_REP > 1) Lx %= total; u.pa = Lx / nN; u.pn = Lx - u.pa * nN; u.pb = u.pn; u.e = 0; return true; }
};
struct SchedMoe {
    int nN, total, G, c; const int* tile_e;
    __device__ __forceinline__ bool next(int i, Unit& u) const { int Lx = i * G + c; if (Lx >= GEMM_REP * total) return false; if (GEMM_REP > 1) Lx %= total; u.pa = Lx / nN; u.pn = Lx - u.pa * nN; u.e = __builtin_amdgcn_readfirstlane((int)tile_e[u.pa]); u.pb = u.e * nN + u.pn; return true; }
};
}

struct Args { const float* in[N_IN]; float* out; unsigned char* ws; int ph_lo, ph_hi; };

typedef const float* __attribute__((address_space(4))) const* kargp_t;
struct InProxy { kargp_t kp; __device__ __forceinline__ const float* operator[](int i) const { return kp[i]; } };
struct Frame {
    InProxy in; float* out; unsigned char* ws;
    LAS unsigned char* lds;
    int tid, lane, wave, G, bid, vid;
    template <class Tp> __device__ __forceinline__ Tp* w(size_t off) const { return (Tp*)(ws + off); }
};

__device__ __forceinline__ Frame launder(const Frame& F) {
    Frame R = F;
    int t = F.tid; asm volatile("" : "+v"(t)); R.tid = t; R.lane = t & 63; R.wave = __builtin_amdgcn_readfirstlane(t >> 6);
    unsigned long long w = (unsigned long long)F.ws; asm volatile("" : "+s"(w)); R.ws = (unsigned char*)w;
    unsigned long long o = (unsigned long long)F.out; asm volatile("" : "+s"(o)); R.out = (float*)o;
    unsigned long long k = (unsigned long long)F.in.kp; asm volatile("" : "+s"(k)); R.in.kp = (kargp_t)k;
    int g = F.G, b = F.bid; asm volatile("" : "+s"(g), "+s"(b)); R.G = g; R.bid = b; R.vid = (g % 8 == 0) ? (b % 8) * (g / 8) + b / 8 : b;
    return R;
}

__device__ __forceinline__ float mod_val(const Frame& F, int l, int which, int j) {
    const float* mp = F.w<float>(WS_MODP) + (size_t)((l * 2 + which) * 32) * 6144 + j;
    float s = F.in[I_BMOD][l * 6144 + j];
#pragma unroll
    for (int k = 0; k < 32; ++k) s += mp[(size_t)k * 6144];
    return s;
}

struct CvtTile { const float* src; bf16_t* dst; int ld, mode, k0, n0; bool f8; };
__device__ __forceinline__ CvtTile cvt_decode(const Frame& F, int t) {
    CvtTile c;
    if (t < 1664) { const int l = t / 832, r = t % 832; c.n0 = (r / 16) * 64; c.k0 = (r % 16) * 64; c.src = F.in[I_WIN] + (size_t)l * 1024 * 3212; c.ld = 3212; c.mode = 1; c.f8 = F8IN(l) != 0; c.dst = F.w<bf16_t>(WS_WINT) + (size_t)l * PC * D; }
    else if (t < 2176) { const int q = t - 1664, l = q / 256, r = q % 256; c.n0 = (r / 16) * 64; c.k0 = (r % 16) * 64; c.src = F.in[I_WOUT] + (size_t)l * D * D; c.ld = 1024; c.mode = 0; c.f8 = false; c.dst = F.w<bf16_t>(WS_WOUTT) + (size_t)l * D * D; }
    else if (t < 34944) { const int q = t - 2176, le = q / 512, r = q % 512; c.n0 = (r / 16) * 64; c.k0 = (r % 16) * 64; c.src = F.in[I_WGU] + (size_t)le * 1024 * 2048; c.ld = 2048; c.mode = 2; c.f8 = true; c.dst = (bf16_t*)(F.w<unsigned char>(WS_WGUT) + (size_t)le * 2048 * D); }
    else { const int q = t - 34944, le = q / 256, r = q % 256; c.n0 = (r / 16) * 64; c.k0 = (r % 16) * 64; c.src = F.in[I_WDN] + (size_t)le * D * D; c.ld = 1024; c.mode = 0; c.f8 = true; c.dst = (bf16_t*)(F.w<unsigned char>(WS_WDT) + (size_t)le * D * D); }
    return c;
}
__device__ __forceinline__ void cvt_load(const CvtTile& c, int lane, f32x4 (&a)[8], f32x4 (&b)[8]) {
    const int i4 = lane & 15, kpl = lane >> 4;
    const int n = c.n0 + 4 * i4;
    int sc; bool valid = true;
    if (c.mode == 0) sc = n;
    else if (c.mode == 1) { if (n < 1280) sc = n; else if (n < 3200) sc = n + 12; else if (n < 3212) sc = n - 3200 + 1280; else { sc = 0; valid = false; } }
    else { const int pn = n >> 8, rr = n & 255; sc = rr < 128 ? pn * 128 + rr : 1024 + pn * 128 + (rr - 128); }
#pragma unroll
    for (int it = 0; it < 8; ++it) {
        const int r0 = c.f8 ? 4 * (kpl + 4 * (it >> 1)) + 2 * (it & 1) : 2 * (kpl + 4 * it);
        a[it] = (f32x4){0.f, 0.f, 0.f, 0.f}; b[it] = a[it];
        if (valid) { a[it] = __builtin_nontemporal_load((const f32x4*)(c.src + (size_t)(c.k0 + r0) * c.ld + sc)); b[it] = __builtin_nontemporal_load((const f32x4*)(c.src + (size_t)(c.k0 + r0 + 1) * c.ld + sc)); }
    }
}
__device__ __forceinline__ void cvt_store(const CvtTile& c, int lane, const f32x4 (&a)[8], const f32x4 (&b)[8], LAS unsigned* lw) {
    const int i4 = lane & 15, kpl = lane >> 4;
    if (c.f8) {
#pragma unroll
        for (int j = 0; j < 4; ++j) {
            const int kq = kpl + 4 * j;
#pragma unroll
            for (int i = 0; i < 4; ++i) lw[kq * 65 + 4 * i4 + i] = pk_fp8x4(W8_SCALE * a[2 * j][i], W8_SCALE * b[2 * j][i], W8_SCALE * a[2 * j + 1][i], W8_SCALE * b[2 * j + 1][i]);
        }
        lds_fence();
        const int g = lane & 3, nl = lane >> 2;
        unsigned char* d8 = (unsigned char*)c.dst;
#pragma unroll
        for (int it = 0; it < 4; ++it) {
            const int nn = nl + 16 * it;
            u32x4 v; v.x = lw[(4 * g + 0) * 65 + nn]; v.y = lw[(4 * g + 1) * 65 + nn]; v.z = lw[(4 * g + 2) * 65 + nn]; v.w = lw[(4 * g + 3) * 65 + nn];
            *(u32x4*)(d8 + (size_t)(c.n0 + nn) * 1024 + c.k0 + 16 * g) = v;
        }
        lds_fence();
        return;
    }
#pragma unroll
    for (int it = 0; it < 8; ++it) {
        const int kp = kpl + 4 * it;
#pragma unroll
        for (int i = 0; i < 4; ++i) lw[kp * 65 + 4 * i4 + i] = pk_bf16(a[it][i], b[it][i]);
    }
    lds_fence();
    const int g = lane & 7, nl = lane >> 3;
#pragma unroll
    for (int it = 0; it < 8; ++it) {
        const int nn = nl + 8 * it;
        u32x4 v; v.x = lw[(4 * g + 0) * 65 + nn]; v.y = lw[(4 * g + 1) * 65 + nn]; v.z = lw[(4 * g + 2) * 65 + nn]; v.w = lw[(4 * g + 3) * 65 + nn];
        *(u32x4*)(c.dst + (size_t)(c.n0 + nn) * 1024 + c.k0 + 8 * g) = v;
    }
    lds_fence();
}

__device__ __forceinline__ void cvt_store8x2(const CvtTile& c, int lane, const f32x4 (&a0)[8], const f32x4 (&b0)[8], const f32x4 (&a1)[8], const f32x4 (&b1)[8], LAS unsigned* lw) {
    const int i4 = lane & 15, kpl = lane >> 4;
#pragma unroll
    for (int j = 0; j < 4; ++j) {
        const int kq = kpl + 4 * j;
#pragma unroll
        for (int i = 0; i < 4; ++i) {
            lw[kq * 65 + 4 * i4 + i] = pk_fp8x4(W8_SCALE * a0[2 * j][i], W8_SCALE * b0[2 * j][i], W8_SCALE * a0[2 * j + 1][i], W8_SCALE * b0[2 * j + 1][i]);
            lw[(16 + kq) * 65 + 4 * i4 + i] = pk_fp8x4(W8_SCALE * a1[2 * j][i], W8_SCALE * b1[2 * j][i], W8_SCALE * a1[2 * j + 1][i], W8_SCALE * b1[2 * j + 1][i]);
        }
    }
    lds_fence();
    const int g = lane & 7, nl = lane >> 3;
    unsigned char* d8 = (unsigned char*)c.dst;
#pragma unroll
    for (int it = 0; it < 8; ++it) {
        const int nn = nl + 8 * it;
        u32x4 v; v.x = lw[(4 * g + 0) * 65 + nn]; v.y = lw[(4 * g + 1) * 65 + nn]; v.z = lw[(4 * g + 2) * 65 + nn]; v.w = lw[(4 * g + 3) * 65 + nn];
        *(u32x4*)(d8 + (size_t)(c.n0 + nn) * 1024 + c.k0 + 16 * g) = v;
    }
    lds_fence();
}
__device__ __forceinline__ void ph_convert(const Frame& F) {
    LAS unsigned* lw = (LAS unsigned*)(F.lds) + F.wave * (32 * 65 + 16);
    const int nwaves = F.G * 8, w0 = F.bid * 8 + F.wave;
    f32x4 a0[8], b0[8], a1[8], b1[8];
    for (int t = w0; t < 2176; t += nwaves) { const CvtTile c = cvt_decode(F, t); cvt_load(c, F.lane, a0, b0); cvt_store(c, F.lane, a0, b0, lw); }
    unsigned* ctr = F.w<unsigned>(WS_CTL) + CW_CVQ;
    for (;;) {
        unsigned tb = 0;
        if (F.lane == 0) tb = atomicAdd(ctr, 4u);
        tb = __builtin_amdgcn_readfirstlane(tb);
        if (tb >= 16384u + 8192u) break;
        for (int t = (int)tb; t < (int)tb + 4; ++t) {
            CvtTile c; c.f8 = true;
            if (t < 16384) { const int le = t >> 8, r = t & 255; c.n0 = (r >> 3) * 64; c.k0 = (r & 7) * 128; c.src = F.in[I_WGU] + (size_t)le * 1024 * 2048; c.ld = 2048; c.mode = 2; c.dst = (bf16_t*)(F.w<unsigned char>(WS_WGUT) + (size_t)le * 2048 * D); }
            else { const int q = t - 16384, le = q >> 7, r = q & 127; c.n0 = (r >> 3) * 64; c.k0 = (r & 7) * 128; c.src = F.in[I_WDN] + (size_t)le * D * D; c.ld = 1024; c.mode = 0; c.dst = (bf16_t*)(F.w<unsigned char>(WS_WDT) + (size_t)le * D * D); }
            cvt_load(c, F.lane, a0, b0);
            CvtTile c2 = c; c2.k0 = c.k0 + 64;
            cvt_load(c2, F.lane, a1, b1);
            cvt_store8x2(c, F.lane, a0, b0, a1, b1, lw);
        }
    }
}

__device__ __forceinline__ void ph_modpart(const Frame& F) {
    for (int it = F.bid; it < 768; it += F.G) {
        const int l = it / 384, r = it % 384, cc = r / 32, kc = r % 32;
        const int j = cc * 512 + F.tid;
        const float* wm = F.in[I_WMOD] + (size_t)l * D * 6144 + (size_t)(kc * 32) * 6144 + j;
        float wv[32];
#pragma unroll
        for (int k = 0; k < 32; ++k) wv[k] = wm[(size_t)k * 6144];
        float a0 = 0.f, a1 = 0.f;
#pragma unroll
        for (int k = 0; k < 32; ++k) { a0 += silu_f(F.in[I_C][kc * 32 + k]) * wv[k]; a1 += silu_f(F.in[I_CCTX][kc * 32 + k]) * wv[k]; }
        float* mp = F.w<float>(WS_MODP);
        mp[(size_t)((l * 2 + 0) * 32 + kc) * 6144 + j] = a0;
        mp[(size_t)((l * 2 + 1) * 32 + kc) * 6144 + j] = a1;
    }
}

__device__ __forceinline__ void ph_filter(const Frame& F) {
    LAS float* zs = (LAS float*)F.lds;
    LAS float* h1 = zs + 64 * 33;
    LAS unsigned char* H2b = F.lds + 24832;
    LAS unsigned char* ob = F.lds + 34048;
    LAS float* w1s = (LAS float*)(F.lds + 68864);
    LAS float* w2s = w1s + 33 * 64;
    const float min_decay = -4.605170185988091f / 1.5f, max_decay = -4.605170185988091f / 0.3f;
    const int wave = F.wave;
    const int nf = F.G < PRO_NF ? F.G : PRO_NF;
    if (F.bid >= nf) return;
    for (int it = F.bid; it < 512 + 16; it += nf) {
        int tid = F.tid; asm volatile("" : "+v"(tid));
        const int lane = tid & 63;
        const bool isctx = it >= 512;
        const int l = isctx ? 0 : it / 256, grp = isctx ? it - 512 : it % 256;
        const int Lx = isctx ? LC : L, npos = isctx ? 16 : 64;
        const int t0 = grp * npos;
        __syncthreads();
        for (int q = tid; q < 33 * 64 + 64 * 64; q += NTHREADS) { if (q < 33 * 64) w1s[q] = F.in[I_FW1][(size_t)l * 33 * 64 + q]; else w2s[q - 33 * 64] = F.in[I_FW2][(size_t)l * 64 * 64 + q - 33 * 64]; }
#pragma unroll 1
        for (int q = tid; q < npos * 33; q += NTHREADS) {
            const int pos = q / 33, i = q % 33; const int t = t0 + pos;
            const float tn = (float)t / (float)(Lx - 1);
            const float wv = 6.283185307179586f * (float)t / (float)Lx;
            float v;
            if (i == 0) v = tn;
            else { const int b = (i - 1) & 15; const float f = 1e-4f + (float)b * ((15.0f - 1e-4f) / 15.0f); v = (i <= 16) ? cosf(f * wv) : -sinf(f * wv); }
            zs[q] = v;
        }
        __syncthreads();
        {
            asm volatile("" : "+v"(tid));
            const int o = tid & 63, pg = tid >> 6;
            if (pg * 8 < npos) {
                float acc[8];
                const float bb = F.in[I_FB1][l * 64 + o];
#pragma unroll
                for (int p = 0; p < 8; ++p) acc[p] = bb;
#pragma unroll 3
                for (int i = 0; i < 33; ++i) { const float w = w1s[i * 64 + o];
#pragma unroll
                    for (int p = 0; p < 8; ++p) acc[p] += zs[(pg * 8 + p) * 33 + i] * w; }
                const float fq = F.in[I_FREQ][l * 128 + o];
#pragma unroll
                for (int p = 0; p < 8; ++p) h1[(pg * 8 + p) * 64 + o] = sinf(fq * acc[p]);
            }
        }
        __syncthreads();
        {
            asm volatile("" : "+v"(tid));
            const int o = tid & 63, pg = tid >> 6;
            if (pg * 8 < npos) {
                float acc[8];
                const float bb = F.in[I_FB2][l * 64 + o];
#pragma unroll
                for (int p = 0; p < 8; ++p) acc[p] = bb;
#pragma unroll 4
                for (int i = 0; i < 64; ++i) { const float w = w2s[i * 64 + o];
#pragma unroll
                    for (int p = 0; p < 8; ++p) acc[p] += h1[(pg * 8 + p) * 64 + i] * w; }
                const float fq = F.in[I_FREQ][l * 128 + 64 + o];
#pragma unroll
                for (int p = 0; p < 8; ++p) *(LAS bf16_t*)(H2b + (pg * 8 + p) * 144 + o * 2) = f2bf(sinf(fq * acc[p]));
            }
        }
        __syncthreads();
        {
            int r = lane & 31, hf = lane >> 5;
#pragma unroll
            for (int n = 0; n < 2; ++n) {
                asm volatile("" : "+v"(r), "+v"(hf));
                const int o = 32 * (2 * wave + n) + r, c = o & 255, dir = o >> 8;
                const float* w3 = F.in[I_FW3] + (size_t)l * 64 * 512 + o;
                f32x16 acc[2];
#pragma unroll
                for (int m = 0; m < 2; ++m)
#pragma unroll
                    for (int i = 0; i < 16; ++i) acc[m][i] = 0.f;
                float wv[4][8];
#pragma unroll
                for (int ks = 0; ks < 4; ++ks)
#pragma unroll
                    for (int e = 0; e < 8; ++e) wv[ks][e] = w3[(size_t)(16 * ks + 8 * hf + e) * 512];
#pragma unroll
                for (int ks = 0; ks < 4; ++ks) {
                    bf16x8 b;
#pragma unroll
                    for (int e = 0; e < 8; ++e) b[e] = (short)f2bf(wv[ks][e]);
#pragma unroll
                    for (int m = 0; m < 2; ++m) {
                        const bf16x8 a = *(const LAS bf16x8*)(H2b + (32 * m + r) * 144 + (16 * ks + 8 * hf) * 2);
                        acc[m] = __builtin_amdgcn_mfma_f32_32x32x16_bf16(a, b, acc[m], 0, 0, 0);
                    }
                }
                const float delta = fabsf(min_decay + (float)c * ((max_decay - min_decay) / 255.0f));
                const float dstep = delta / (float)(Lx - 1);
                float asum = 0.f;
                if (!isctx) {
#pragma unroll
                    for (int m = 0; m < 2; ++m)
#pragma unroll
                        for (int rg = 0; rg < 16; ++rg) {
                            const int pos = 32 * m + (rg & 3) + 8 * (rg >> 2) + 4 * hf;
                            const float v = acc[m][rg] * __expf(-(float)(t0 + pos) * dstep);
                            asum += fabsf(v);
                            ob[o * 68 + pos] = (unsigned char)(pk_fp8x4(KR_SCALE * v, 0.f, 0.f, 0.f) & 0xFFu);
                        }
                } else {
                    float* kc = F.w<float>(WS_KCOMBC);
#pragma unroll
                    for (int rg = 0; rg < 8; ++rg) {
                        const int pos = (rg & 3) + 8 * (rg >> 2) + 4 * hf, t = t0 + pos;
                        const float v = acc[0][rg] * __expf(-(float)t * dstep);
                        asum += fabsf(v);
                        const int x = dir == 0 ? Lx - 1 + t : Lx - 1 - t;
                        if (dir == 0 || t >= 1) kc[(size_t)x * 256 + c] = v;
                    }
                }
                asum += __shfl_xor(asum, 32);
                if (hf == 0) { if (isctx) F.w<float>(WS_FPARTC)[grp * 512 + o] = asum; else F.w<float>(WS_FPART)[((size_t)l * 256 + grp) * 512 + o] = asum; }
            }
        }
        if (!isctx) {
            __syncthreads();
            unsigned char* KR = F.w<unsigned char>(WS_KR) + (size_t)l * 256 * KRL;
            asm volatile("" : "+v"(tid));
            for (int q = tid; q < 512 * 64; q += NTHREADS) {
                const int o = q >> 6, p = q & 63, c = o & 255, dir = o >> 8;
                if (dir == 0) KR[(size_t)c * KRL + (L - t0 - 63 + p)] = ob[o * 68 + 63 - p];
                else if (t0 + p >= 1) KR[(size_t)c * KRL + (L + t0 + p)] = ob[o * 68 + p];
            }
            if (grp == 0) for (int q = tid; q < 256 * 513; q += NTHREADS) { const int c = q / 513, r = q % 513; KR[(size_t)c * KRL + (r == 512 ? 0 : 2 * L + r)] = 0; }
        }
    }
}

__device__ __forceinline__ void ph_fsum(const Frame& F) {
    const int nwaves = F.G * 8;
    for (int o = F.bid * 8 + F.wave; o < 768; o += nwaves) {
        const int which = o >> 8, c = o & 255;
        float s = 0.f;
        if (which < 2) { const float* fp = F.w<float>(WS_FPART) + (size_t)which * 256 * 512;
            for (int i = F.lane; i < 256; i += 64) s += fp[(size_t)i * 512 + c] + fp[(size_t)i * 512 + 256 + c]; }
        else { const float* fp = F.w<float>(WS_FPARTC); if (F.lane < 16) s = fp[F.lane * 512 + c] + fp[F.lane * 512 + 256 + c]; }
        s = wave_sum(s);
        if (F.lane == 0) F.w<float>(WS_FSUM)[o] = 1.0f / s;
    }
}

__device__ __forceinline__ void ph_vecs(const Frame& F) {
    for (int q = F.bid * NTHREADS + F.tid; q < 2 * 2 * 6 * 1024; q += F.G * NTHREADS) {
        const int j = q & 1023, k = (q >> 10) % 6, which = ((q >> 10) / 6) & 1, l = (q >> 10) / 12;
        const float* ng = F.in[I_NORMG] + (size_t)l * 4 * 1024;
        float v;
        if (k == 0) v = ng[j] * (1.0f + mod_val(F, l, which, 1 * 1024 + j));
        else if (k == 1) v = mod_val(F, l, which, j);
        else if (k == 2) v = ng[1024 + j] * mod_val(F, l, which, 2 * 1024 + j);
        else if (k == 3) v = ng[2048 + j] * (1.0f + mod_val(F, l, which, 4 * 1024 + j));
        else if (k == 4) v = mod_val(F, l, which, 3 * 1024 + j);
        else v = ng[3072 + j] * mod_val(F, l, which, 5 * 1024 + j);
        F.w<float>(WS_VECS)[q] = v;
    }
}
__device__ __forceinline__ const float* vecs_ptr(const Frame& F, int l, int which, int k) { return F.w<float>(WS_VECS) + (size_t)((l * 2 + which) * 6 + k) * 1024; }

__device__ __forceinline__ void load_row(const float* p, int lane, f32x4 (&v)[4]) {
#pragma unroll
    for (int i = 0; i < 4; ++i) v[i] = *(const f32x4*)(p + 4 * lane + 256 * i);
}
__device__ __forceinline__ float row_rstd(const f32x4 (&v)[4]) {
    float s = 0.f;
#pragma unroll
    for (int i = 0; i < 4; ++i) s += v[i][0] * v[i][0] + v[i][1] * v[i][1] + v[i][2] * v[i][2] + v[i][3] * v[i][3];
    s = wave_sum(s);
    return rsqrtf(s * (1.0f / 1024.0f) + RMS_EPS);
}
__device__ __forceinline__ void stage_norm_vecs(const Frame& F, int l, int gain_idx, int sh_seg, int sc_seg, LAS float* dst  ) {
    for (int q = F.tid; q < 2048; q += NTHREADS) {
        const int which = q >> 10, j = q & 1023;
        const float g = F.in[I_NORMG][(l * 4 + gain_idx) * 1024 + j];
        dst[(which * 2 + 0) * 1024 + j] = g * (1.0f + mod_val(F, l, which, sc_seg * 1024 + j));
        dst[(which * 2 + 1) * 1024 + j] = mod_val(F, l, which, sh_seg * 1024 + j);
    }
}
__device__ __forceinline__ void norm_store_bf16(const f32x4 (&v)[4], float rstd, const LAS float* va, const LAS float* vb, bf16_t* orow, int lane, bool f8 = false) {
#pragma unroll
    for (int i = 0; i < 4; ++i) {
        const int c = 4 * lane + 256 * i;
        const f32x4 a = *(const LAS f32x4*)(va + c), b = *(const LAS f32x4*)(vb + c);
        if (f8) { *(unsigned*)((unsigned char*)orow + c) = pk_fp8x4(v[i][0] * rstd * a[0] + b[0], v[i][1] * rstd * a[1] + b[1], v[i][2] * rstd * a[2] + b[2], v[i][3] * rstd * a[3] + b[3]); }
        else { u32x2 w; w.x = pk_bf16(v[i][0] * rstd * a[0] + b[0], v[i][1] * rstd * a[1] + b[1]); w.y = pk_bf16(v[i][2] * rstd * a[2] + b[2], v[i][3] * rstd * a[3] + b[3]);
        *(u32x2*)(orow + c) = w; }
    }
}
__device__ __forceinline__ const float* xrow_ptr(const Frame& F, int l, int row) {
    if (l == 0) return row < L ? F.in[I_X] + (size_t)row * D : F.in[I_CTX] + (size_t)(row - L) * D;
    return F.w<float>(WS_XCUR) + (size_t)row * D;
}
__device__ __forceinline__ void load_xrow(const Frame& F, int l, int row, int lane, f32x4 (&v)[4]) {
    if (l == 0) { load_row(row < L ? F.in[I_X] + (size_t)row * D : F.in[I_CTX] + (size_t)(row - L) * D, lane, v); return; }
    const bf16_t* p = F.w<bf16_t>(WS_XCUR) + (size_t)row * D;
#pragma unroll
    for (int i = 0; i < 4; ++i) { const u32x2 w = *(const u32x2*)(p + 4 * lane + 256 * i); v[i] = (f32x4){bflo(w.x), bfhi(w.x), bflo(w.y), bfhi(w.y)}; }
}
__device__ __forceinline__ void store_xrow_bf16(bf16_t* p, int lane, const f32x4 (&v)[4]) {
#pragma unroll
    for (int i = 0; i < 4; ++i) { u32x2 w; w.x = pk_bf16(v[i][0], v[i][1]); w.y = pk_bf16(v[i][2], v[i][3]); *(u32x2*)(p + 4 * lane + 256 * i) = w; }
}
__device__ __forceinline__ void ph_norm1(const Frame& F, int l) {
    LAS float* vec = (LAS float*)F.lds;
    __syncthreads();
    stage_norm_vecs(F, l, 0, 0, 1, vec);
    __syncthreads();
    const int nwaves = F.G * 8;
    for (int row = F.bid * 8 + F.wave; row < T; row += nwaves) {
        const int which = row >= L;
        f32x4 v[4]; load_row(xrow_ptr(F, l, row), F.lane, v);
        const float rstd = row_rstd(v);
        norm_store_bf16(v, rstd, vec + (which * 2) * 1024, vec + (which * 2 + 1) * 1024, F8IN(0) ? (bf16_t*)(F.w<unsigned char>(WS_HB) + (size_t)row * D) : F.w<bf16_t>(WS_HB) + (size_t)row * D, F.lane, F8IN(0) != 0);
    }
}

constexpr int SROW = 272;
__device__ __forceinline__ bf16x8 lds_frag(const LAS unsigned char* base, int row, int k) { return *(const LAS bf16x8*)(base + row * SROW + k * 2); }
__device__ __forceinline__ void ph_ssd_prep(const Frame& F, int l) {
    LAS unsigned char* BT = F.lds;
    LAS unsigned char* XW = F.lds + 34816;
    LAS float* dts = (LAS float*)(F.lds + 139264);
    LAS float* wj  = dts + 768;
    const bf16_t* P = F.w<bf16_t>(WS_P);
    const int lane = F.lane, wave = F.wave;
    for (int it = F.bid; it < NCH * 2; it += F.G) {
        const int ch = it >> 1, g = it & 1;
        const int row0 = ch * 128;
        const int seq_lo = ch < 128 ? 0 : L, seq_hi = ch < 128 ? L : T;
        int r = lane & 31, hf = lane >> 5; asm volatile("" : "+v"(r), "+v"(hf));
        __syncthreads();
        if (wave < 6) {
            const int hh = wave >> 1, dir = wave & 1, h = g * 3 + hh;
            const float a = -__expf(F.in[I_ALOG][(l * 2 + dir) * 6 + h]), bias = F.in[I_DTB][(l * 2 + dir) * 6 + h];
            const int j0 = 2 * lane;
            const float d0 = softplus_f(bf2f(P[(size_t)(row0 + j0) * PC + CDT + dir * 6 + h]) + bias);
            const float d1 = softplus_f(bf2f(P[(size_t)(row0 + j0 + 1) * PC + CDT + dir * 6 + h]) + bias);
            const float pair = (d0 + d1) * a;
            float incl = pair;
#pragma unroll
            for (int o = 1; o < 64; o <<= 1) {
                const float v = dir == 0 ? __shfl_up(incl, o) : __shfl_down(incl, o);
                const bool okl = dir == 0 ? (lane >= o) : (lane + o < 64);
                if (okl) incl += v;
            }
            const float total = __shfl(incl, dir == 0 ? 63 : 0);
            float acs0, acs1;
            if (dir == 0) { acs1 = incl; acs0 = incl - d1 * a; }
            else { acs0 = incl; acs1 = incl - d0 * a; }
            float* dtv = F.w<float>(WS_DTV) + (size_t)(row0 + j0) * 12 + dir * 6 + h; dtv[0] = d0; dtv[12] = d1;
            float* acv = F.w<float>(WS_ACS) + (size_t)(row0 + j0) * 12 + dir * 6 + h; acv[0] = acs0; acv[12] = acs1;
            if (lane == 0) F.w<float>(WS_ALAST)[ch * 12 + dir * 6 + h] = total;
            dts[wave * 128 + j0] = d0; dts[wave * 128 + j0 + 1] = d1;
            wj[wave * 128 + j0] = __expf(total - acs0) * d0; wj[wave * 128 + j0 + 1] = __expf(total - acs1) * d1;
        }
        __syncthreads();
        if (F.tid < 448) {
            const int pr = F.tid % 224, half = F.tid / 224;
            const int chn = pr < 96 ? g * 192 + 2 * pr : (pr < 160 ? 384 + g * 128 + 2 * (pr - 96) : 640 + g * 128 + 2 * (pr - 160));
            const float* cw = F.in[I_SCW] + (size_t)l * 5 * 896 + chn; const float* cb = F.in[I_SCB] + (size_t)l * 896 + chn;
            float w0[5], w1[5];
#pragma unroll
            for (int k = 0; k < 5; ++k) { w0[k] = cw[k * 896]; w1[k] = cw[k * 896 + 1]; }
            const float b0 = cb[0], b1 = cb[1];
            const int jb = half * 64;
            const bf16_t* src = P + CXBC + chn;
            unsigned win[12];
#pragma unroll
            for (int k = 0; k < 4; ++k) { const int rr = row0 + jb + k - 2; win[k] = (rr >= seq_lo && rr < seq_hi) ? *(const unsigned*)(src + (size_t)rr * PC) : 0u; }
            const int hh = pr / 32;
            const int pch = 2 * (pr & 31);
            for (int jg = 0; jg < 64; jg += 8) {
#pragma unroll
                for (int k = 0; k < 8; ++k) { const int rr = row0 + jb + jg + k + 2; win[4 + k] = (rr >= seq_lo && rr < seq_hi) ? *(const unsigned*)(src + (size_t)rr * PC) : 0u; }
                float s0[8], s1[8];
#pragma unroll
                for (int u = 0; u < 8; ++u) {
                    float a0 = b0, a1 = b1;
#pragma unroll
                    for (int k = 0; k < 5; ++k) { a0 += w0[k] * bflo(win[u + k]); a1 += w1[k] * bfhi(win[u + k]); }
                    s0[u] = silu_f(a0); s1[u] = silu_f(a1);
                    *(unsigned*)(F.w<bf16_t>(WS_XBC) + (size_t)(row0 + jb + jg + u) * 896 + chn) = pk_bf16(s0[u], s1[u]);
                }
#pragma unroll
                for (int k = 0; k < 4; ++k) win[k] = win[8 + k];
#pragma unroll
                for (int u = 0; u < 8; u += 2) {
                    const int j = jb + jg + u;
                    if (pr < 96) {
#pragma unroll
                        for (int dir = 0; dir < 2; ++dir) {
                            const float wa = wj[(hh * 2 + dir) * 128 + j], wb = wj[(hh * 2 + dir) * 128 + j + 1];
                            LAS unsigned char* d = XW + ((hh * 2 + dir) * 64 + pch) * SROW + j * 2;
                            *(LAS unsigned*)d = pk_bf16(s0[u] * wa, s0[u + 1] * wb);
                            *(LAS unsigned*)(d + SROW) = pk_bf16(s1[u] * wa, s1[u + 1] * wb);
                        }
                    } else if (pr < 160) {
                        LAS unsigned char* d = BT + (2 * (pr - 96)) * SROW + j * 2;
                        *(LAS unsigned*)d = pk_bf16(s0[u], s0[u + 1]);
                        *(LAS unsigned*)(d + SROW) = pk_bf16(s1[u], s1[u + 1]);
                    }
                }
            }
        }
        __syncthreads();
        {
            const int nt = wave & 3, pt = wave >> 2;
#pragma unroll 1
            for (int hh = 0; hh < 3; ++hh) {
                const int h = g * 3 + hh;
                f32x16 a0, a1;
#pragma unroll
                for (int i = 0; i < 16; ++i) { a0[i] = 0.f; a1[i] = 0.f; }
                const LAS unsigned char* X0 = XW + (hh * 2) * 64 * SROW;
#pragma unroll
                for (int ks = 0; ks < 8; ++ks) {
                    const bf16x8 a = lds_frag(BT, 32 * nt + r, 16 * ks + 8 * hf);
                    const bf16x8 b0 = lds_frag(X0, 32 * pt + r, 16 * ks + 8 * hf), b1 = lds_frag(X0, 64 + 32 * pt + r, 16 * ks + 8 * hf);
                    a0 = __builtin_amdgcn_mfma_f32_32x32x16_bf16(a, b0, a0, 0, 0, 0);
                    a1 = __builtin_amdgcn_mfma_f32_32x32x16_bf16(a, b1, a1, 0, 0, 0);
                }
                float* s0 = F.w<float>(WS_STATES) + ((size_t)(0 * NCH + ch) * 6 + h) * 8192 + (32 * pt + r) * 128 + 32 * nt + 4 * hf;
                float* s1 = F.w<float>(WS_STATES) + ((size_t)(1 * NCH + ch) * 6 + h) * 8192 + (32 * pt + r) * 128 + 32 * nt + 4 * hf;
#pragma unroll
                for (int gq = 0; gq < 4; ++gq) { *(f32x4*)(s0 + 8 * gq) = (f32x4){a0[4 * gq], a0[4 * gq + 1], a0[4 * gq + 2], a0[4 * gq + 3]};
                                                 *(f32x4*)(s1 + 8 * gq) = (f32x4){a1[4 * gq], a1[4 * gq + 1], a1[4 * gq + 2], a1[4 * gq + 3]}; }
            }
        }
    }
}

__device__ __forceinline__ void ph_ssd_scan(const Frame& F) {
    const int per = (98304 + F.G - 1) / F.G;
    for (int q = F.tid; q < per; q += NTHREADS) {
        const int id = F.bid * per + q;
        if (id >= 98304) break;
        const int dir = id / 49152, rem = id % 49152, h = rem / 8192, e = rem % 8192;
        const float* al = F.w<float>(WS_ALAST) + dir * 6 + h;
        const float* st = F.w<float>(WS_STATES) + ((size_t)(dir * NCH) * 6 + h) * 8192 + e;
        bf16_t* ss = F.w<bf16_t>(WS_SSTART) + ((size_t)(dir * NCH) * 6 + h) * 8192 + e;
        float sacc = 0.f;
        for (int s0 = 0; s0 < NCH; s0 += 26) {
            float sv[26], dv[26]; int cv[26];
#pragma unroll
            for (int u = 0; u < 26; ++u) {
                const int step = s0 + u;
                cv[u] = dir == 0 ? (step < 2 ? 128 + step : step - 2) : 129 - step;
                sv[u] = st[(size_t)cv[u] * 6 * 8192]; dv[u] = al[cv[u] * 12];
            }
#pragma unroll
            for (int u = 0; u < 26; ++u) { ss[(size_t)cv[u] * 6 * 8192] = f2bf(sacc); sacc = sacc * __expf(dv[u]) + sv[u]; }
        }
    }
}

__device__ __forceinline__ void ph_ssd_out(const Frame& F, int l) {
    LAS unsigned char* Cs = F.lds;
    LAS unsigned char* Bs = F.lds + 34816;
    LAS unsigned char* XT = F.lds + 69632;
    LAS float* Yl = (LAS float*)F.lds;
    LAS float* af = (LAS float*)(F.lds + 98816);
    LAS float* ab = af + 384, *dtf = ab + 384, *dtb = dtf + 384;
    LAS float* red = dtb + 384;
    const bf16_t* XBC = F.w<bf16_t>(WS_XBC);
    const bf16_t* P = F.w<bf16_t>(WS_P);
    const int nch = (l == 0) ? NCH : 128;
    const int lane = F.lane, wave = F.wave, r_in = lane & 31, hf_in = lane >> 5;
    const int it_ = wave & 3, jp = wave >> 2;
    for (int it = F.bid; it < nch * 2; it += F.G) {
        const int ch = it >> 1, g = it & 1, row0 = ch * 128;
        int r = r_in, hf = hf_in; asm volatile("" : "+v"(r), "+v"(hf));
        __syncthreads();
        for (int q = F.tid; q < 128 * 16; q += NTHREADS) {
            const int row = q >> 4, piece = q & 15;
            const bf16_t* src = XBC + (size_t)(row0 + row) * 896 + g * 128 + piece * 8;
            *(LAS u32x4*)(Bs + row * SROW + piece * 16) = *(const u32x4*)(src + 384);
            *(LAS u32x4*)(Cs + row * SROW + piece * 16) = *(const u32x4*)(src + 640);
        }
        for (int q = F.tid; q < 768; q += NTHREADS) {
            const int dir = q / 384, rr = q % 384, hh = rr >> 7, j = rr & 127;
            (dir ? ab : af)[hh * 128 + j] = F.w<float>(WS_ACS)[(size_t)(row0 + j) * 12 + dir * 6 + g * 3 + hh];
            (dir ? dtb : dtf)[hh * 128 + j] = F.w<float>(WS_DTV)[(size_t)(row0 + j) * 12 + dir * 6 + g * 3 + hh];
        }
        __syncthreads();
        f32x16 G0, G1;
#pragma unroll
        for (int i = 0; i < 16; ++i) { G0[i] = 0.f; G1[i] = 0.f; }
#pragma unroll
        for (int ks = 0; ks < 8; ++ks) {
            const bf16x8 a = lds_frag(Cs, 32 * it_ + r, 16 * ks + 8 * hf);
            const bf16x8 b0 = lds_frag(Bs, 64 * jp + r, 16 * ks + 8 * hf), b1 = lds_frag(Bs, 64 * jp + 32 + r, 16 * ks + 8 * hf);
            G0 = __builtin_amdgcn_mfma_f32_32x32x16_bf16(a, b0, G0, 0, 0, 0);
            G1 = __builtin_amdgcn_mfma_f32_32x32x16_bf16(a, b1, G1, 0, 0, 0);
        }
        f32x16 yacc[3];
#pragma unroll
        for (int hh = 0; hh < 3; ++hh) {
            const int h = g * 3 + hh;
            asm volatile("" : "+v"(r), "+v"(hf));
            __syncthreads();
#pragma unroll
            for (int tl = 0; tl < 2; ++tl) {
                const int j = 64 * jp + 32 * tl + r;
                const float afj = af[hh * 128 + j], abj = ab[hh * 128 + j], dfj = dtf[hh * 128 + j], dbj = dtb[hh * 128 + j];
#pragma unroll
                for (int rg = 0; rg < 16; ++rg) {
                    const int i = 32 * it_ + (rg & 3) + 8 * (rg >> 2) + 4 * hf;
                    const float mf = fminf(fmaxf((float)(i - j + 1), 0.f), 1.f), mb = fminf(fmaxf((float)(j - i + 1), 0.f), 1.f);
                    const float wf = __expf(fminf(af[hh * 128 + i] - afj, 0.f)) * dfj * mf;
                    const float wb = __expf(fminf(ab[hh * 128 + i] - abj, 0.f)) * dbj * mb;
                    const float gv = tl == 0 ? G0[rg] : G1[rg];
                    *(LAS bf16_t*)(Bs + i * SROW + j * 2) = f2bf(gv * (wf + wb));
                }
            }
            for (int q = F.tid; q < 128 * 8; q += NTHREADS) {
                const int j = q >> 3, pg = q & 7;
                const u32x4 v = *(const u32x4*)(XBC + (size_t)(row0 + j) * 896 + h * 64 + pg * 8);
                LAS unsigned char* d = XT + (pg * 8) * SROW + j * 2;
                *(LAS bf16_t*)(d + 0 * SROW) = (bf16_t)(v.x & 0xFFFF); *(LAS bf16_t*)(d + 1 * SROW) = (bf16_t)(v.x >> 16);
                *(LAS bf16_t*)(d + 2 * SROW) = (bf16_t)(v.y & 0xFFFF); *(LAS bf16_t*)(d + 3 * SROW) = (bf16_t)(v.y >> 16);
                *(LAS bf16_t*)(d + 4 * SROW) = (bf16_t)(v.z & 0xFFFF); *(LAS bf16_t*)(d + 5 * SROW) = (bf16_t)(v.z >> 16);
                *(LAS bf16_t*)(d + 6 * SROW) = (bf16_t)(v.w & 0xFFFF); *(LAS bf16_t*)(d + 7 * SROW) = (bf16_t)(v.w >> 16);
            }
            {
                f32x16 yF, yB;
#pragma unroll
                for (int i = 0; i < 16; ++i) { yF[i] = 0.f; yB[i] = 0.f; }
                const bf16_t* Sf = F.w<bf16_t>(WS_SSTART) + ((size_t)(0 * NCH + ch) * 6 + h) * 8192 + (32 * jp + r) * 128 + 8 * hf;
                const bf16_t* Sb = F.w<bf16_t>(WS_SSTART) + ((size_t)(1 * NCH + ch) * 6 + h) * 8192 + (32 * jp + r) * 128 + 8 * hf;
#pragma unroll 2
                for (int ks = 0; ks < 8; ++ks) {
                    const bf16x8 ac = lds_frag(Cs, 32 * it_ + r, 16 * ks + 8 * hf);
                    const bf16x8 bf_ = *(const bf16x8*)(Sf + 16 * ks), bb_ = *(const bf16x8*)(Sb + 16 * ks);
                    yF = __builtin_amdgcn_mfma_f32_32x32x16_bf16(ac, bf_, yF, 0, 0, 0);
                    yB = __builtin_amdgcn_mfma_f32_32x32x16_bf16(ac, bb_, yB, 0, 0, 0);
                }
#pragma unroll
                for (int rg = 0; rg < 16; ++rg) {
                    const int i = 32 * it_ + (rg & 3) + 8 * (rg >> 2) + 4 * hf;
                    yacc[hh][rg] = __expf(af[hh * 128 + i]) * yF[rg] + __expf(ab[hh * 128 + i]) * yB[rg];
                }
            }
            __syncthreads();
#pragma unroll 2
            for (int ks = 0; ks < 8; ++ks) {
                const bf16x8 aw = lds_frag(Bs, 32 * it_ + r, 16 * ks + 8 * hf), bx = lds_frag(XT, 32 * jp + r, 16 * ks + 8 * hf);
                yacc[hh] = __builtin_amdgcn_mfma_f32_32x32x16_bf16(aw, bx, yacc[hh], 0, 0, 0);
            }
        }
        __syncthreads();
#pragma unroll
        for (int hh = 0; hh < 3; ++hh)
#pragma unroll
            for (int rg = 0; rg < 16; ++rg) { const int i = 32 * it_ + (rg & 3) + 8 * (rg >> 2) + 4 * hf; Yl[i * 193 + hh * 64 + 32 * jp + r] = yacc[hh][rg]; }
        __syncthreads();
        const int i = F.tid & 127, pq = F.tid >> 7;
        float ssq = 0.f;
#pragma unroll 1
        for (int hh = 0; hh < 3; ++hh) {
            const int h = g * 3 + hh; const float dsk = F.in[I_SSDD][l * 6 + h];
            const int chn = h * 64 + pq * 16;
            const u32x4 xa = *(const u32x4*)(XBC + (size_t)(row0 + i) * 896 + chn), xb = *(const u32x4*)(XBC + (size_t)(row0 + i) * 896 + chn + 8);
            const u32x4 za = *(const u32x4*)(P + (size_t)(row0 + i) * PC + CZ + chn), zb = *(const u32x4*)(P + (size_t)(row0 + i) * PC + CZ + chn + 8);
            const unsigned xw_[8] = {xa.x, xa.y, xa.z, xa.w, xb.x, xb.y, xb.z, xb.w}, zw_[8] = {za.x, za.y, za.z, za.w, zb.x, zb.y, zb.z, zb.w};
            LAS float* yr = Yl + i * 193 + hh * 64 + pq * 16;
#pragma unroll
            for (int p2 = 0; p2 < 8; ++p2) {
                const float v0 = (yr[2 * p2] + dsk * bflo(xw_[p2])) * silu_f(bflo(zw_[p2]));
                const float v1 = (yr[2 * p2 + 1] + dsk * bfhi(xw_[p2])) * silu_f(bfhi(zw_[p2]));
                yr[2 * p2] = v0; yr[2 * p2 + 1] = v1; ssq += v0 * v0 + v1 * v1;
            }
        }
        red[pq * 128 + i] = ssq;
        __syncthreads();
        const float tot = red[i] + red[128 + i] + red[256 + i] + red[384 + i];
        const float rstd = rsqrtf(tot * (1.0f / 192.0f) + RMS_EPS);
#pragma unroll 1
        for (int hh = 0; hh < 3; ++hh) {
            const int h = g * 3 + hh;
            bf16_t* o = F.w<bf16_t>(WS_MIX) + (size_t)(row0 + i) * D + h * 64 + pq * 16;
            const float* ng = F.in[I_SSDNG] + l * 384 + h * 64 + pq * 16;
            const LAS float* yr = Yl + i * 193 + hh * 64 + pq * 16;
            unsigned wv[8];
#pragma unroll
            for (int p2 = 0; p2 < 8; ++p2) wv[p2] = pk_bf16(yr[2 * p2] * rstd * ng[2 * p2], yr[2 * p2 + 1] * rstd * ng[2 * p2 + 1]);
            *(u32x4*)o = (u32x4){wv[0], wv[1], wv[2], wv[3]}; *(u32x4*)(o + 8) = (u32x4){wv[4], wv[5], wv[6], wv[7]};
        }
    }
}

__device__ __forceinline__ int na_kv_off(int key, int piece) { return key * 128 + ((piece ^ (key & 7)) << 4); }
constexpr int NA_VP = 144;
__device__ __forceinline__ int na_v_off(int key, int piece) { return key * NA_VP + piece * 16; }
__device__ __forceinline__ void na_stage_kv(const Frame& F, const bf16_t* P, LAS unsigned char* Kd, LAS unsigned char* Vd, int h, bool local, int r0, int kc0) {
    for (int q = F.tid; q < 256 * 8; q += NTHREADS) {
        const int key = q >> 3, piece = q & 7;
        const int krow = local ? (r0 + (key >> 5)) * 64 + kc0 + (key & 31) : L + key;
        const bf16_t* src = P + (size_t)krow * PC + h * 64 + piece * 8;
        *(LAS u32x4*)(Kd + na_kv_off(key, piece)) = *(const u32x4*)(src + CK);
        *(LAS u32x4*)(Vd + na_v_off(key, piece)) = *(const u32x4*)(src + CV);
    }
}
__device__ __forceinline__ void bar_lds() { asm volatile("s_waitcnt lgkmcnt(0)" ::: "memory"); __builtin_amdgcn_s_barrier(); asm volatile("" ::: "memory"); }
struct NaItem { int h, r, cg, r0, kc0, qrow0; bool isctx; };
__device__ __forceinline__ NaItem na_item(int cid, int i_lo, int i_hi, int k) {
    NaItem t; t.isctx = (i_lo + k >= i_hi); t.r = 0; t.r0 = 0; t.kc0 = 0;
    if (!t.isctx) { const int it = i_lo + k; t.h = it >> 10; t.cg = (it >> 8) & 3; t.r = it & 255; t.r0 = min(max(t.r - 4, 0), 248); t.kc0 = min(max(16 * t.cg - 8, 0), 32); t.qrow0 = t.r * 64 + t.cg * 16; }
    else { t.h = cid >> 4; t.cg = cid & 15; t.qrow0 = L + t.cg * 16; }
    return t;
}
__device__ __forceinline__ void ph_na(const Frame& F, int l, int part) {
    LAS unsigned char* Kc = F.lds;
    LAS unsigned char* Vc = F.lds + 32768;
    LAS unsigned char* Kl = F.lds + 69632;
    LAS unsigned char* Vl = F.lds + 102400;
    LAS unsigned char* Qs = F.lds + 139264;
    LAS unsigned char* Pw = F.lds + 141312;
    LAS float* ml = (LAS float*)(F.lds + 159744);
    LAS float* bt = ml + 256;
    const bf16_t* P = F.w<bf16_t>(WS_P);
    const float* rpb = F.in[I_RPB] + (size_t)l * 15 * 31 * 6;
    const int nlat = 6 * 256 * 4;
    const int nB = (l == 0) ? 2520 : 0, nA = nlat - nB;
    const int lane = F.lane, wave = F.wave, c16 = lane & 15, kq = lane >> 4;
    const float scale = 0.125f;
    int cur_h = -1;
    const float ws = part == 0 ? (l == 0 ? 0.45f : 0.67f) : 0.0f;
    const int nP = part == 0 ? nA : nB, base = part == 0 ? 0 : nA;
    const float Wtot = 4.0f * ws + (float)(F.G - 4);
    const float W0 = F.bid < 4 ? F.bid * ws : 4.0f * ws + (float)(F.bid - 4), W1 = F.bid < 3 ? (F.bid + 1) * ws : 4.0f * ws + (float)(F.bid - 3);
    const int i_lo = base + (int)((float)nP * W0 / Wtot + 0.5f), i_hi = (F.bid == F.G - 1) ? base + nP : base + (int)((float)nP * W1 / Wtot + 0.5f);
    const int cid = (l == 0 && part == 0 && F.bid >= 100 && F.bid < 196) ? F.bid - 100 : -1;
    const int n_mine = max(0, i_hi - i_lo) + (cid >= 0 ? 1 : 0);
    u32x4 kreg[4], vreg[4], qreg; float breg = 0.f;
    const int pkey = F.tid >> 3, ppiece = F.tid & 7;
#define NA_PREFETCH(T) do { if (!(T).isctx) { _Pragma("unroll") for (int u = 0; u < 4; ++u) { const int key = pkey + 64 * u; \
            const bf16_t* src = P + (size_t)(((T).r0 + (key >> 5)) * 64 + (T).kc0 + (key & 31)) * PC + (T).h * 64 + ppiece * 8; \
            kreg[u] = *(const u32x4*)(src + CK); vreg[u] = *(const u32x4*)(src + CV); } \
            if (F.tid < 256 && (F.tid & 31) < 31) breg = rpb[(((T).r0 + (F.tid >> 5) - (T).r + 7) * 31 + (F.tid & 31)) * 6 + (T).h]; } \
        if (F.tid < 128) qreg = *(const u32x4*)(P + (size_t)((T).qrow0 + pkey) * PC + CQ + (T).h * 64 + ppiece * 8); } while (0)
    if (n_mine > 0) { const NaItem t0 = na_item(cid, i_lo, i_hi, 0); NA_PREFETCH(t0); }
    for (int k = 0; k < n_mine; ++k) {
        const NaItem t = na_item(cid, i_lo, i_hi, k);
        const bool isctx = t.isctx; const int h = t.h, cg = t.cg, kc0 = t.kc0, qrow0 = t.qrow0;
        if (k == 0) bar_lds();
        if (h != cur_h) { na_stage_kv(F, P, Kc, Vc, h, false, 0, 0); cur_h = h; }
        if (!isctx) {
#pragma unroll
            for (int u = 0; u < 4; ++u) { const int key = pkey + 64 * u; *(LAS u32x4*)(Kl + na_kv_off(key, ppiece)) = kreg[u]; *(LAS u32x4*)(Vl + na_v_off(key, ppiece)) = vreg[u]; }
            if (F.tid < 256) bt[F.tid] = breg;
        }
        if (F.tid < 128) *(LAS u32x4*)(Qs + na_kv_off(pkey, ppiece)) = qreg;
        if (k + 1 < n_mine) { const NaItem tn = na_item(cid, i_lo, i_hi, k + 1); NA_PREFETCH(tn); }
        bar_lds();
        const bool loc = wave < 4;
        const LAS unsigned char* Kb = loc ? Kl : Kc;
        const LAS unsigned char* Vb = loc ? Vl : Vc;
        const int kbase = (wave & 3) * 64;
        LAS unsigned char* pw = Pw + wave * 2304;
        float mw[4], lw[4];
        if (!(loc && isctx)) {
            f32x4 sacc[4];
#pragma unroll
            for (int nt = 0; nt < 4; ++nt) sacc[nt] = (f32x4){0.f, 0.f, 0.f, 0.f};
#pragma unroll
            for (int ks = 0; ks < 2; ++ks) {
                const bf16x8 a = *(const LAS bf16x8*)(Qs + na_kv_off(c16, 4 * ks + kq));
#pragma unroll
                for (int nt = 0; nt < 4; ++nt) {
                    const bf16x8 b = *(const LAS bf16x8*)(Kb + na_kv_off(kbase + 16 * nt + c16, 4 * ks + kq));
                    sacc[nt] = __builtin_amdgcn_mfma_f32_16x16x32_bf16(a, b, sacc[nt], 0, 0, 0);
                }
            }
#pragma unroll
            for (int rg = 0; rg < 4; ++rg) mw[rg] = -INFINITY;
#pragma unroll
            for (int nt = 0; nt < 4; ++nt) {
                const int kk = kbase + 16 * nt + c16;
#pragma unroll
                for (int rg = 0; rg < 4; ++rg) {
                    float sv = sacc[nt][rg] * scale;
                    if (loc) {
                        const int qi = 4 * kq + rg, qcol = cg * 16 + qi, cstart = min(max(qcol - 8, 0), 48);
                        const int krow = kk >> 5, kcol = kc0 + (kk & 31);
                        const bool ok = (kcol >= cstart) && (kcol < cstart + 16);
                        const int dc = min(max(kcol - qcol + 15, 0), 30);
                        sv = ok ? sv + bt[krow * 32 + dc] : -INFINITY;
                    }
                    sacc[nt][rg] = sv; mw[rg] = fmaxf(mw[rg], sv);
                }
            }
#pragma unroll
            for (int rg = 0; rg < 4; ++rg) {
                mw[rg] = row16_max(mw[rg]);
                lw[rg] = 0.f;
            }
#pragma unroll
            for (int nt = 0; nt < 4; ++nt) {
#pragma unroll
                for (int rg = 0; rg < 4; ++rg) {
                    const float msafe = mw[rg] == -INFINITY ? 0.f : mw[rg];
                    const float pv = __expf(sacc[nt][rg] - msafe);
                    lw[rg] += pv;
                    *(LAS bf16_t*)(pw + (4 * kq + rg) * 144 + (16 * nt + c16) * 2) = f2bf(pv);
                }
            }
#pragma unroll
            for (int rg = 0; rg < 4; ++rg) {
                lw[rg] = row16_sum(lw[rg]);
            }
            lds_fence();
            f32x4 oacc[4];
#pragma unroll
            for (int dt = 0; dt < 4; ++dt) oacc[dt] = (f32x4){0.f, 0.f, 0.f, 0.f};
            {
                const unsigned vaddr = (unsigned)(unsigned long long)(Vb + (kbase + 8 * kq + (c16 >> 2)) * NA_VP + 8 * (c16 & 3));
                u32x2 t[2][4][2];
                asm volatile(
                    "ds_read_b64_tr_b16 %0, %16 offset:0\n\tds_read_b64_tr_b16 %1, %16 offset:576\n\t"
                    "ds_read_b64_tr_b16 %2, %16 offset:32\n\tds_read_b64_tr_b16 %3, %16 offset:608\n\t"
                    "ds_read_b64_tr_b16 %4, %16 offset:64\n\tds_read_b64_tr_b16 %5, %16 offset:640\n\t"
                    "ds_read_b64_tr_b16 %6, %16 offset:96\n\tds_read_b64_tr_b16 %7, %16 offset:672\n\t"
                    "ds_read_b64_tr_b16 %8, %16 offset:4608\n\tds_read_b64_tr_b16 %9, %16 offset:5184\n\t"
                    "ds_read_b64_tr_b16 %10, %16 offset:4640\n\tds_read_b64_tr_b16 %11, %16 offset:5216\n\t"
                    "ds_read_b64_tr_b16 %12, %16 offset:4672\n\tds_read_b64_tr_b16 %13, %16 offset:5248\n\t"
                    "ds_read_b64_tr_b16 %14, %16 offset:4704\n\tds_read_b64_tr_b16 %15, %16 offset:5280\n\t"
                    "s_waitcnt lgkmcnt(0)"
                    : "=&v"(t[0][0][0]), "=&v"(t[0][0][1]), "=&v"(t[0][1][0]), "=&v"(t[0][1][1]), "=&v"(t[0][2][0]), "=&v"(t[0][2][1]), "=&v"(t[0][3][0]), "=&v"(t[0][3][1]),
                      "=&v"(t[1][0][0]), "=&v"(t[1][0][1]), "=&v"(t[1][1][0]), "=&v"(t[1][1][1]), "=&v"(t[1][2][0]), "=&v"(t[1][2][1]), "=&v"(t[1][3][0]), "=&v"(t[1][3][1])
                    : "v"(vaddr) : "memory");
#pragma unroll
                for (int ks = 0; ks < 2; ++ks) {
                    const bf16x8 a = *(const LAS bf16x8*)(pw + c16 * 144 + (32 * ks + 8 * kq) * 2);
#pragma unroll
                    for (int dt = 0; dt < 4; ++dt) {
                        const u32x4 bw = (u32x4){t[ks][dt][0].x, t[ks][dt][0].y, t[ks][dt][1].x, t[ks][dt][1].y};
                        oacc[dt] = __builtin_amdgcn_mfma_f32_16x16x32_bf16(a, __builtin_bit_cast(bf16x8, bw), oacc[dt], 0, 0, 0);
                    }
                }
            }
            lds_fence();
#pragma unroll
            for (int dt = 0; dt < 4; ++dt)
#pragma unroll
                for (int rg = 0; rg < 4; ++rg) *(LAS bf16_t*)(pw + (4 * kq + rg) * 144 + (16 * dt + c16) * 2) = f2bf(oacc[dt][rg]);
        } else {
#pragma unroll
            for (int rg = 0; rg < 4; ++rg) { mw[rg] = -INFINITY; lw[rg] = 0.f; }
            for (int q = lane; q < 16 * 36; q += 64) ((LAS unsigned*)pw)[q] = 0u;
        }
        if (c16 == 0) {
#pragma unroll
            for (int rg = 0; rg < 4; ++rg) { ml[(wave * 16 + 4 * kq + rg) * 2] = mw[rg]; ml[(wave * 16 + 4 * kq + rg) * 2 + 1] = lw[rg]; }
        }
        bar_lds();
        {
            const int qi = F.tid >> 5, dp = F.tid & 31;
            float M = -INFINITY;
#pragma unroll
            for (int w = 0; w < 8; ++w) M = fmaxf(M, ml[(w * 16 + qi) * 2]);
            float num0 = 0.f, num1 = 0.f, den = 0.f;
#pragma unroll
            for (int w = 0; w < 8; ++w) {
                const float sc = __expf(ml[(w * 16 + qi) * 2] - M);
                const unsigned ov = *(const LAS unsigned*)(Pw + w * 2304 + qi * 144 + dp * 4);
                num0 += sc * bflo(ov); num1 += sc * bfhi(ov); den += sc * ml[(w * 16 + qi) * 2 + 1];
            }
            const float inv = __builtin_amdgcn_rcpf(den);
            *(unsigned*)(F.w<bf16_t>(WS_MIX) + (size_t)(qrow0 + qi) * D + 384 + h * 64 + 2 * dp) = pk_bf16(num0 * inv, num1 * inv);
        }
    }
#undef NA_PREFETCH
}

__device__ __forceinline__ float hy_conv3(const bf16_t* P, const float* cw, const float* cb, int row, int seq_lo, int seq_hi, int col) {
    float s = cb[col];
#pragma unroll
    for (int k = 0; k < 3; ++k) { const int r = row + k - 1; if (r >= seq_lo && r < seq_hi) s += cw[k * 768 + col] * bf2f(P[(size_t)r * PC + CHY + col]); }
    return s;
}
__device__ __forceinline__ void ph_hy_prep(const Frame& F, int l) {
    const bf16_t* P = F.w<bf16_t>(WS_P);
    const float* cw = F.in[I_HCW] + (size_t)l * 3 * 768; const float* cb = F.in[I_HCB] + (size_t)l * 768;
    LAS unsigned* ut = (LAS unsigned*)F.lds;
    LAS unsigned* xt = ut + 256 * 33;
    const int cp = F.tid & 127, rq = F.tid >> 7;
    float w0[3][3], w1[3][3], b0[3], b1[3];
#pragma unroll
    for (int sg = 0; sg < 3; ++sg) { b0[sg] = cb[sg * 256 + 2 * cp]; b1[sg] = cb[sg * 256 + 2 * cp + 1];
#pragma unroll
        for (int k = 0; k < 3; ++k) { w0[sg][k] = cw[k * 768 + sg * 256 + 2 * cp]; w1[sg][k] = cw[k * 768 + sg * 256 + 2 * cp + 1]; } }
    for (int it = F.bid; it < L / 64; it += F.G) {
        const int t0 = it * 64, rb = t0 + rq * 16;
        __syncthreads();
        {
            unsigned win[3][18];
#pragma unroll
            for (int sg = 0; sg < 3; ++sg)
#pragma unroll
                for (int k = 0; k < 18; ++k) { const int rr = rb - 1 + k; win[sg][k] = (rr >= 0 && rr < L) ? *(const unsigned*)(P + (size_t)rr * PC + CHY + sg * 256 + 2 * cp) : 0u; }
#pragma unroll
            for (int jp = 0; jp < 8; ++jp) {
                float u0[2], u1[2], xa[2], xb[2];
#pragma unroll
                for (int q = 0; q < 2; ++q) {
                    const int k = 2 * jp + q;
                    float a0[3], a1[3];
#pragma unroll
                    for (int sg = 0; sg < 3; ++sg) {
                        a0[sg] = b0[sg] + w0[sg][0] * bflo(win[sg][k]) + w0[sg][1] * bflo(win[sg][k + 1]) + w0[sg][2] * bflo(win[sg][k + 2]);
                        a1[sg] = b1[sg] + w1[sg][0] * bfhi(win[sg][k]) + w1[sg][1] * bfhi(win[sg][k + 1]) + w1[sg][2] * bfhi(win[sg][k + 2]);
                    }
                    xa[q] = a0[0]; xb[q] = a1[0]; u0[q] = a0[2] * a0[1]; u1[q] = a1[2] * a1[1];
                }
                const int rp = rq * 8 + jp;
                ut[(2 * cp) * 33 + rp] = pk_bf16(u0[0], u0[1]); ut[(2 * cp + 1) * 33 + rp] = pk_bf16(u1[0], u1[1]);
                xt[(2 * cp) * 33 + rp] = pk_bf16(xa[0], xa[1]); xt[(2 * cp + 1) * 33 + rp] = pk_bf16(xb[0], xb[1]);
            }
        }
        __syncthreads();
        for (int q = F.tid; q < 256 * 8; q += NTHREADS) {
            const int c = q >> 3, g = q & 7;
            u32x4 a, b;
            a.x = ut[c * 33 + 4 * g]; a.y = ut[c * 33 + 4 * g + 1]; a.z = ut[c * 33 + 4 * g + 2]; a.w = ut[c * 33 + 4 * g + 3];
            b.x = xt[c * 33 + 4 * g]; b.y = xt[c * 33 + 4 * g + 1]; b.z = xt[c * 33 + 4 * g + 2]; b.w = xt[c * 33 + 4 * g + 3];
            *(u32x4*)(F.w<bf16_t>(WS_UT) + (size_t)c * L + t0 + 8 * g) = a;
            *(u32x4*)(F.w<bf16_t>(WS_X0T) + (size_t)c * L + t0 + 8 * g) = b;
            u32x2 a8; a8.x = pk_fp8x4(bflo(a.x), bfhi(a.x), bflo(a.y), bfhi(a.y)); a8.y = pk_fp8x4(bflo(a.z), bfhi(a.z), bflo(a.w), bfhi(a.w));
            *(u32x2*)(F.w<unsigned char>(WS_UT8) + (size_t)c * L + t0 + 8 * g) = a8;
        }
    }
    if (l == 0) {
        for (int rp = F.bid; rp < LC / 2; rp += F.G) {
            const int row = L + rp * 2 + (F.tid >> 8), c = F.tid & 255;
            const float x1 = hy_conv3(P, cw, cb, row, L, T, 256 + c), v = hy_conv3(P, cw, cb, row, L, T, 512 + c);
            F.w<float>(WS_U)[(size_t)row * 256 + c] = v * x1;
        }
    }
}
__device__ __forceinline__ void ph_hy_conv_ctx(const Frame& F, int l) {
    const bf16_t* P = F.w<bf16_t>(WS_P);
    const float* cw = F.in[I_HCW] + (size_t)l * 3 * 768; const float* cb = F.in[I_HCB] + (size_t)l * 768;
    for (int it = F.bid; it < 8; it += F.G) {
        const int Lx = LC, rbase = L;
        const int tb = it * 2 + (F.tid >> 8), c = F.tid & 255, t0 = tb * 16;
        const float* U = F.w<float>(WS_U) + (size_t)rbase * 256 + c;
        const float* KC = F.w<float>(WS_KCOMBC) + c;
        float acc[16], wreg[16];
#pragma unroll
        for (int j = 0; j < 16; ++j) { acc[j] = 0.f; wreg[j] = KC[(size_t)(t0 + j + Lx - 1) * 256]; }
        for (int s0 = 0; s0 < Lx; s0 += 16) {
            float ub[16], nb[16];
#pragma unroll
            for (int r = 0; r < 16; ++r) { ub[r] = U[(size_t)(s0 + r) * 256]; const int x = t0 - (s0 + r + 1) + Lx - 1; nb[r] = x >= 0 ? KC[(size_t)x * 256] : 0.f; }
#pragma unroll
            for (int r = 0; r < 16; ++r) {
#pragma unroll
                for (int j = 0; j < 16; ++j) acc[j] += ub[r] * wreg[(j - r) & 15];
                wreg[(15 - r) & 15] = nb[r];
            }
        }
        const float inv = F.w<float>(WS_FSUM)[2 * 256 + c];
        const float db = F.in[I_HYD][l * 256 + c];
#pragma unroll
        for (int j = 0; j < 16; ++j) {
            const int row = rbase + t0 + j;
            const float x0 = hy_conv3(P, cw, cb, row, L, T, c);
            const float u = F.w<float>(WS_U)[(size_t)row * 256 + c];
            F.w<bf16_t>(WS_MIX)[(size_t)row * D + 768 + c] = f2bf(x0 * (acc[j] * inv + u * db));
        }
    }
}

constexpr int HC_UP = 144, HC_UBYTES = 190 * HC_UP;
constexpr int HC_CPOFF = 27392, HC_NG = 83, HC_CPBYTES = 16 * HC_NG * 16;
__device__ __forceinline__ void hc_make_copies(LAS unsigned char* dst, const u32x4 g0, const u32x4 g1, int g) {
    const unsigned w[8] = {g0.x, g0.y, g0.z, g0.w, g1.x, g1.y, g1.z, g1.w};
#pragma unroll
    for (int sh = 0; sh < 16; ++sh) {
        const int b = sh >> 2, r = sh & 3;
        u32x4 o;
        if (r == 0) { o.x = w[b]; o.y = w[b + 1]; o.z = w[b + 2]; o.w = w[b + 3]; }
        else { o.x = __builtin_amdgcn_alignbyte(w[b + 1], w[b], r); o.y = __builtin_amdgcn_alignbyte(w[b + 2], w[b + 1], r);
               o.z = __builtin_amdgcn_alignbyte(w[b + 3], w[b + 2], r); o.w = __builtin_amdgcn_alignbyte(w[b + 4], w[b + 3], r); }
        *(LAS u32x4*)(dst + (sh * HC_NG + g) * 16) = o;
    }
}
__device__ __forceinline__ void ph_hy_conv(const Frame& F, int l) {
    LAS unsigned char* Ul = F.lds;
    LAS unsigned char* Cp = F.lds + HC_CPOFF;
    const int lane = F.lane, wave = F.wave;
    const int nt = wave < 4 ? wave : 7 - wave, par = wave >> 2;
    const int r = lane & 31, h = lane >> 5, sig = r & 15, rho = r >> 4;
    const int sh = (16 - sig) & 15, gofs = 2 * h - rho - (sig ? 1 : 0);
    const int a_lane = (sh * HC_NG + gofs) * 16;
    const int b_lane = r * HC_UP + h * 32;
    const int sclK = 0x79797979, sclU = ONE_E8M0;
    for (int c = F.bid; c < 256; c += F.G) {
        const unsigned char* KRc = F.w<unsigned char>(WS_KR) + ((size_t)l * 256 + c) * KRL;
        const unsigned char* U8c = F.w<unsigned char>(WS_UT8) + (size_t)c * L;
        const bf16_t* UTc = F.w<bf16_t>(WS_UT) + (size_t)c * L;
        __syncthreads();
        for (int q = F.tid; q < 190 * 8; q += NTHREADS) {
            const int blk = q >> 3, piece = q & 7;
            u32x4 v = (u32x4){0u, 0u, 0u, 0u};
            if (blk >= 31 && blk < 159) v = *(const u32x4*)(U8c + (size_t)(blk - 31) * 128 + piece * 16);
            *(LAS u32x4*)(Ul + blk * HC_UP + piece * 16) = v;
        }
        u32x4 g0 = (u32x4){0u, 0u, 0u, 0u}, g1 = g0;
        if (F.tid < HC_NG) { const unsigned char* src = KRc + 31744 + 16 * F.tid; g0 = *(const u32x4*)src; g1 = *(const u32x4*)(src + 16); }
        if (F.tid < HC_NG) hc_make_copies(Cp, g0, g1, F.tid);
        __syncthreads();
        f32x16 acc[4];
#pragma unroll
        for (int m = 0; m < 4; ++m)
#pragma unroll
            for (int i = 0; i < 16; ++i) acc[m][i] = 0.f;
        for (int ci = 0; ci < 32; ++ci) {
            const int Dc = -128 + 8 * ci;
            if (ci + 1 < 32 && F.tid < HC_NG) { const unsigned char* src = KRc + (31744 - 1024 * (ci + 1)) + 16 * F.tid; g0 = *(const u32x4*)src; g1 = *(const u32x4*)(src + 16); }
            const LAS unsigned char* cp = Cp + (ci & 1) * HC_CPBYTES + a_lane;
#pragma unroll 1
            for (int d2 = 0; d2 < 4; ++d2) {
                const int dd = 2 * d2 + par, Dv = Dc + dd;
                if (!((Dv >= 32 * nt - 127) && (Dv <= 32 * nt + 31) && (Dv > -128))) continue;
                const LAS unsigned char* ap = cp + (8 * (8 - dd)) * 16;
                const LAS unsigned char* bp = Ul + b_lane + (32 * nt - Dv + 31) * HC_UP;
                v8i af[6], bfr[2];
#pragma unroll
                for (int e = 0; e < 6; ++e) { const v4i x = *(const LAS v4i*)(ap - 2 * (e - 2) * 16), y = *(const LAS v4i*)(ap - 2 * (e - 2) * 16 + 16); af[e] = __builtin_shufflevector(x, y, 0, 1, 2, 3, 4, 5, 6, 7); }
#pragma unroll
                for (int ks = 0; ks < 2; ++ks) { const v4i x = *(const LAS v4i*)(bp + ks * 64), y = *(const LAS v4i*)(bp + ks * 64 + 16); bfr[ks] = __builtin_shufflevector(x, y, 0, 1, 2, 3, 4, 5, 6, 7); }
#pragma unroll
                for (int ks = 0; ks < 2; ++ks)
#pragma unroll
                    for (int m = 0; m < 4; ++m)
                        asm volatile("v_mfma_scale_f32_32x32x64_f8f6f4 %0, %1, %2, %0, %3, %4 op_sel_hi:[0,0,0]" : "+v"(acc[m]) : "v"(af[m - 2 * ks + 2]), "v"(bfr[ks]), "v"(sclK), "v"(sclU));
            }
            if (ci + 1 < 32 && F.tid < HC_NG) hc_make_copies(Cp + ((ci + 1) & 1) * HC_CPBYTES, g0, g1, F.tid);
            __syncthreads();
        }
        LAS float* Rd = (LAS float*)F.lds;
        if (wave >= 4) {
#pragma unroll
            for (int m = 0; m < 4; ++m)
#pragma unroll
                for (int i = 0; i < 16; ++i) Rd[(nt * 64 + m * 16 + i) * 64 + lane] = acc[m][i];
        }
        __syncthreads();
        if (wave < 4) {
#pragma unroll
            for (int m = 0; m < 4; ++m)
#pragma unroll
                for (int i = 0; i < 16; ++i) acc[m][i] += Rd[(nt * 64 + m * 16 + i) * 64 + lane];
            const float inv = F.w<float>(WS_FSUM)[l * 256 + c];
            const float db = F.in[I_HYD][l * 256 + c];
            const bf16_t* X0c = F.w<bf16_t>(WS_X0T) + (size_t)c * L;
            bf16_t* YTc = F.w<bf16_t>(WS_YT) + (size_t)c * L;
            const int I = 32 * nt + r;
#pragma unroll
            for (int m = 0; m < 4; ++m) {
#pragma unroll
                for (int g = 0; g < 4; ++g) {
                    const int t = 128 * I + 32 * m + 8 * g + 4 * h;
                    const u32x2 xv = *(const u32x2*)(X0c + t), uv = *(const u32x2*)(UTc + t);
                    float y[4];
#pragma unroll
                    for (int e = 0; e < 4; ++e) y[e] = acc[m][4 * g + e] * inv;
                    y[0] = bflo(xv.x) * (y[0] + bflo(uv.x) * db); y[1] = bfhi(xv.x) * (y[1] + bfhi(uv.x) * db);
                    y[2] = bflo(xv.y) * (y[2] + bflo(uv.y) * db); y[3] = bfhi(xv.y) * (y[3] + bfhi(uv.y) * db);
                    u32x2 o; o.x = pk_bf16(y[0], y[1]); o.y = pk_bf16(y[2], y[3]);
                    *(u32x2*)(YTc + t) = o;
                }
            }
        }
    }
}
__device__ __forceinline__ void ph_hy_tr(const Frame& F) {
    LAS unsigned* yt = (LAS unsigned*)F.lds;
    for (int it = F.bid; it < L / 64; it += F.G) {
        const int t0 = it * 64;
        __syncthreads();
        for (int q = F.tid; q < 256 * 8; q += NTHREADS) {
            const int c = q >> 3, g = q & 7;
            const u32x4 a = *(const u32x4*)(F.w<bf16_t>(WS_YT) + (size_t)c * L + t0 + 8 * g);
            yt[c * 33 + 4 * g] = a.x; yt[c * 33 + 4 * g + 1] = a.y; yt[c * 33 + 4 * g + 2] = a.z; yt[c * 33 + 4 * g + 3] = a.w;
        }
        __syncthreads();
        for (int q = F.tid; q < 64 * 32; q += NTHREADS) {
            const int row = q >> 5, cg = q & 31;
            const LAS unsigned short* ys = (const LAS unsigned short*)yt;
            unsigned short v[8];
#pragma unroll
            for (int e = 0; e < 8; ++e) v[e] = ys[((cg * 8 + e) * 33) * 2 + row];
            u32x4 o; o.x = v[0] | ((unsigned)v[1] << 16); o.y = v[2] | ((unsigned)v[3] << 16); o.z = v[4] | ((unsigned)v[5] << 16); o.w = v[6] | ((unsigned)v[7] << 16);
            *(u32x4*)(F.w<bf16_t>(WS_MIX) + (size_t)(t0 + row) * D + 768 + cg * 8) = o;
        }
    }
}

constexpr int WRP = 1028;
__device__ __forceinline__ void ph_post1(const Frame& F, int l) {
    LAS float* wr = (LAS float*)F.lds;
    LAS unsigned* lcnt = (LAS unsigned*)(F.lds + 32 * WRP * 4);
    __syncthreads();
    if (F.tid < 64) lcnt[F.tid] = 0u;
    {
        const f32x4* src = (const f32x4*)(F.in[I_WR] + (size_t)l * 1024 * 32);
        f32x4 v[16];
#pragma unroll
        for (int u = 0; u < 16; ++u) v[u] = src[F.tid + u * NTHREADS];
#pragma unroll
        for (int u = 0; u < 16; ++u) { const int q4 = F.tid + u * NTHREADS, k = q4 >> 3, e0 = (q4 & 7) * 4;
#pragma unroll
            for (int i = 0; i < 4; ++i) wr[(e0 + i) * WRP + k] = v[u][i]; }
    }
    __syncthreads();
    const int nrows = (l == 0) ? T : L;
    const int nwaves = F.G * 8, lane = F.lane;
    unsigned* cnt = F.w<unsigned>(WS_CTL) + CW_CNT + l * 1024;
    if (F.bid == 0) { for (int q = F.tid; q < D / 4; q += NTHREADS) ((unsigned*)(F.w<unsigned char>(WS_H2) + (size_t)T * D))[q] = 0u; }
    const float brl = F.in[I_BR][l * 32 + ((lane >> 1) & 31)];
    const int mye = (lane >> 1) & 31;
    for (int row0 = F.bid * 8 + F.wave; row0 < nrows; row0 += 2 * nwaves) {
        int rw[2]; bool vld[2];
        rw[0] = row0; vld[0] = true; vld[1] = (row0 + nwaves < nrows); rw[1] = vld[1] ? row0 + nwaves : row0;
        f32x4 m[2][4], x[2][4], hv[2][4];
#pragma unroll
        for (int u = 0; u < 2; ++u) { const bf16_t* mr = F.w<bf16_t>(WS_MIXO) + (size_t)rw[u] * D;
#pragma unroll
            for (int i = 0; i < 4; ++i) { const u32x2 w = *(const u32x2*)(mr + 4 * lane + 256 * i); m[u][i] = (f32x4){bflo(w.x), bfhi(w.x), bflo(w.y), bfhi(w.y)}; }
            load_xrow(F, l, rw[u], lane, x[u]); }
#pragma unroll
        for (int u = 0; u < 2; ++u) {
            const int which = rw[u] >= L;
            const float* v0 = vecs_ptr(F, l, which, 2);
            const float rs1 = row_rstd(m[u]);
#pragma unroll
            for (int i = 0; i < 4; ++i) { const f32x4 a = *(const f32x4*)(v0 + 4 * lane + 256 * i); x[u][i] = x[u][i] + m[u][i] * rs1 * a; }
        }
#pragma unroll
        for (int u = 0; u < 2; ++u) {
            if (vld[u]) store_xrow_bf16(F.w<bf16_t>(WS_XCUR) + (size_t)rw[u] * D, lane, x[u]);
        }
#pragma unroll
        for (int u = 0; u < 2; ++u) {
            const int which = rw[u] >= L;
            const float* v1 = vecs_ptr(F, l, which, 3), *v2 = vecs_ptr(F, l, which, 4);
            const float rs2 = row_rstd(x[u]);
#pragma unroll
            for (int i = 0; i < 4; ++i) { const f32x4 a = *(const f32x4*)(v1 + 4 * lane + 256 * i), b = *(const f32x4*)(v2 + 4 * lane + 256 * i); hv[u][i] = x[u][i] * rs2 * a + b; }
            if (vld[u]) { unsigned char* ho = F.w<unsigned char>(WS_H2) + (size_t)rw[u] * D;
#pragma unroll
                for (int i = 0; i < 4; ++i) *(unsigned*)(ho + 4 * lane + 256 * i) = pk_fp8x4(hv[u][i][0], hv[u][i][1], hv[u][i][2], hv[u][i][3]); }
        }
        float part[2][32];
#pragma unroll
        for (int e = 0; e < 32; ++e) {
            float s0 = 0.f, s1 = 0.f;
#pragma unroll
            for (int i = 0; i < 4; ++i) { const f32x4 w = *(const LAS f32x4*)(wr + e * WRP + 4 * lane + 256 * i);
                s0 += hv[0][i][0] * w[0] + hv[0][i][1] * w[1] + hv[0][i][2] * w[2] + hv[0][i][3] * w[3];
                s1 += hv[1][i][0] * w[0] + hv[1][i][1] * w[1] + hv[1][i][2] * w[2] + hv[1][i][3] * w[3]; }
            part[0][e] = s0; part[1][e] = s1;
        }
#pragma unroll
        for (int st = 0; st < 5; ++st) {
            const int o = 32 >> st, n = 32 >> st;
            const bool upper = (lane & o) != 0;
#pragma unroll
            for (int i = 0; i < n / 2; ++i) {
#pragma unroll
                for (int u = 0; u < 2; ++u) {
                    const float send = upper ? part[u][i] : part[u][i + n / 2];
                    const float recv = __shfl_xor(send, o);
                    const float keep = upper ? part[u][i + n / 2] : part[u][i];
                    part[u][i] = keep + recv;
                }
            }
        }
#pragma unroll
        for (int u = 0; u < 2; ++u) {
            float lg = part[u][0] + __shfl_xor(part[u][0], 1);
            lg += brl;
            int rank = 0;
#pragma unroll
            for (int e = 0; e < 32; ++e) { const float ov = __int_as_float(__builtin_amdgcn_readlane(__float_as_int(lg), 2 * e)); rank += (ov > lg || (ov == lg && e < mye)) ? 1 : 0; }
            int te[4]; float tv[4];
#pragma unroll
            for (int k = 0; k < 4; ++k) {
                const unsigned long long msk = __ballot(rank == k && (lane & 1) == 0);
                const int idx = msk ? __builtin_amdgcn_readfirstlane((int)__builtin_ctzll(msk)) : 2 * k;
                te[k] = idx >> 1; tv[k] = __int_as_float(__builtin_amdgcn_readlane(__float_as_int(lg), idx));
            }
            const float e1 = __expf(tv[1] - tv[0]), e2 = __expf(tv[2] - tv[0]), e3 = __expf(tv[3] - tv[0]);
            const float inv = 1.0f / (1.0f + e1 + e2 + e3);
            if (lane < 4 && vld[u]) {
                const int k = lane, row = rw[u];
                const int e = k == 0 ? te[0] : (k == 1 ? te[1] : (k == 2 ? te[2] : te[3]));
                const float wgt = (k == 0 ? 1.0f : (k == 1 ? e1 : (k == 2 ? e2 : e3))) * inv;
                const unsigned pos = __hip_atomic_fetch_add(lcnt + e, 1u, __ATOMIC_RELAXED, __HIP_MEMORY_SCOPE_WORKGROUP);
                F.w<int>(WS_RE)[row * 4 + k] = e; F.w<int>(WS_RP)[row * 4 + k] = (int)pos; F.w<float>(WS_RW)[row * 4 + k] = wgt;
            }
        }
    }
    __syncthreads();
    if (F.tid < 32) lcnt[32 + F.tid] = atomicAdd(cnt + F.tid * 32, lcnt[F.tid]);
    __syncthreads();
    for (int row = F.bid * 8 + F.wave; row < nrows; row += nwaves) {
        if (lane < 4) { const int a = row * 4 + lane; F.w<int>(WS_RP)[a] += (int)lcnt[32 + F.w<int>(WS_RE)[a]]; }
    }
}

__device__ __forceinline__ int expert_pad_start(const Frame& F, int l, int& ntiles) {
    const unsigned* cnt = F.w<unsigned>(WS_CTL) + CW_CNT + l * 1024;
    int c = F.lane < 32 ? (int)__hip_atomic_load(cnt + F.lane * 32, __ATOMIC_RELAXED, __HIP_MEMORY_SCOPE_AGENT) : 0;
    int padded = (c + 255) & ~255;
    int incl = padded;
#pragma unroll
    for (int o = 1; o < 32; o <<= 1) { const int v = __shfl_up(incl, o); if ((F.lane & 31) >= o) incl += v; }
    ntiles = __shfl(incl, 31) >> 8;
    return incl - padded;
}

__device__ __forceinline__ void ph_gather(const Frame& F, int l) {
    int ntiles; const int ps = expert_pad_start(F, l, ntiles);
    if (F.bid == 0 && F.wave == 0) {
        int* tab = F.w<int>(WS_CTL) + CW_TILE + l * 320;
        const int nxt = __shfl_down(ps, 1);
        const int endt = (F.lane == 31) ? ntiles : (nxt >> 8);
        if (F.lane < 32) for (int t = ps >> 8; t < endt; ++t) tab[t] = F.lane;
        if (F.lane == 0) F.w<int>(WS_CTL)[CW_NT + l] = ntiles;
    }
    const int nrows = (l == 0) ? T : L;
    for (int a0 = (F.bid * 8 + F.wave) * 64; a0 < nrows * 4; a0 += F.G * 8 * 64) {
        const int a = a0 + F.lane;
        if (a < nrows * 4) {
            const int e = F.w<int>(WS_RE)[a], pos = F.w<int>(WS_RP)[a];
            const int dst = __shfl(ps, e) + pos;
            F.w<int>(WS_SLOT)[a] = dst;
            F.w<int>(WS_ROWTOK)[(size_t)l * MAXROWS + dst] = a >> 2;
        }
    }
}

__device__ __forceinline__ void ph_final(const Frame& F, int l) {
    const int nrows = (l == 0) ? T : L;
    const int nwaves = F.G * 8, lane = F.lane;
    const bf16_t* Y = F.w<bf16_t>(WS_Y) + (size_t)l * MAXROWS * D;
    int slotn[2][4]; float wgtn[2][4];
#define FN_SLOTS(r0_) do { _Pragma("unroll") for (int u = 0; u < 2; ++u) { const int rr_ = ((r0_) + u * nwaves < nrows) ? (r0_) + u * nwaves : (r0_); \
        _Pragma("unroll") for (int k = 0; k < 4; ++k) { slotn[u][k] = F.w<int>(WS_SLOT)[rr_ * 4 + k]; wgtn[u][k] = F.w<float>(WS_RW)[rr_ * 4 + k]; } } } while (0)
    const int rfirst = F.bid * 8 + F.wave;
    if (rfirst < nrows) FN_SLOTS(rfirst);
    for (int row0 = rfirst; row0 < nrows; row0 += 2 * nwaves) {
        int rw[2]; bool vld[2];
        rw[0] = row0; vld[0] = true; vld[1] = (row0 + nwaves < nrows); rw[1] = vld[1] ? row0 + nwaves : row0;
        int slot[2][4]; float wgt[2][4];
#pragma unroll
        for (int u = 0; u < 2; ++u)
#pragma unroll
            for (int k = 0; k < 4; ++k) { slot[u][k] = slotn[u][k]; wgt[u][k] = wgtn[u][k]; }
        u32x2 yv[2][4][4]; f32x4 x[2][4];
#pragma unroll
        for (int u = 0; u < 2; ++u) {
#pragma unroll
            for (int k = 0; k < 4; ++k) { const bf16_t* yr = Y + (size_t)slot[u][k] * D;
#pragma unroll
                for (int i = 0; i < 4; ++i) yv[u][k][i] = *(const u32x2*)(yr + 4 * lane + 256 * i); }
            load_xrow(F, 1, rw[u], lane, x[u]);
        }
        if (row0 + 2 * nwaves < nrows) FN_SLOTS(row0 + 2 * nwaves);
#pragma unroll
        for (int u = 0; u < 2; ++u) {
            const int which = rw[u] >= L;
            const float* ve = vecs_ptr(F, l, which, 5);
            f32x4 f[4];
#pragma unroll
            for (int i = 0; i < 4; ++i) f[i] = (f32x4){0.f, 0.f, 0.f, 0.f};
#pragma unroll
            for (int k = 0; k < 4; ++k)
#pragma unroll
                for (int i = 0; i < 4; ++i) { const u32x2 w = yv[u][k][i]; f[i][0] += wgt[u][k] * bflo(w.x); f[i][1] += wgt[u][k] * bfhi(w.x); f[i][2] += wgt[u][k] * bflo(w.y); f[i][3] += wgt[u][k] * bfhi(w.y); }
            const float rs = row_rstd(f);
#pragma unroll
            for (int i = 0; i < 4; ++i) { const f32x4 a = *(const f32x4*)(ve + 4 * lane + 256 * i); x[u][i] = x[u][i] + f[i] * rs * a; }
            if (vld[u]) {
                if (l == 1) { float* xo = F.out + (size_t)rw[u] * D;
#pragma unroll
                    for (int i = 0; i < 4; ++i) *(f32x4*)(xo + 4 * lane + 256 * i) = x[u][i]; }
                else store_xrow_bf16(F.w<bf16_t>(WS_XCUR) + (size_t)rw[u] * D, lane, x[u]);
                if (l == 0) {
                    const float rstd = row_rstd(x[u]);
                    const float* va = vecs_ptr(F, 1, which, 0), *vb = vecs_ptr(F, 1, which, 1);
                    bf16_t* orow = F.w<bf16_t>(WS_HB) + (size_t)rw[u] * D;
                    unsigned char* orow8 = F.w<unsigned char>(WS_HB) + (size_t)rw[u] * D;
#pragma unroll
                    for (int i = 0; i < 4; ++i) {
                        const int c = 4 * lane + 256 * i;
                        const f32x4 a = *(const f32x4*)(va + c), b = *(const f32x4*)(vb + c);
                        if (F8IN(1)) *(unsigned*)(orow8 + c) = pk_fp8x4(x[u][i][0] * rstd * a[0] + b[0], x[u][i][1] * rstd * a[1] + b[1], x[u][i][2] * rstd * a[2] + b[2], x[u][i][3] * rstd * a[3] + b[3]);
                        else { u32x2 w; w.x = pk_bf16(x[u][i][0] * rstd * a[0] + b[0], x[u][i][1] * rstd * a[1] + b[1]); w.y = pk_bf16(x[u][i][2] * rstd * a[2] + b[2], x[u][i][3] * rstd * a[3] + b[3]);
                        *(u32x2*)(orow + c) = w; }
                    }
                }
            }
        }
    }
#undef FN_SLOTS
}

constexpr int PH_PER_LAYER = 10, N_PHASES = 2 + 2 * PH_PER_LAYER;
#ifndef PH_MASK
#define PH_MASK 0xFFFFFFFFu
#endif
#define EN(b) (((PH_MASK) >> (b)) & 1u)
#ifndef DUP_MASK
#define DUP_MASK 0u
#endif
#define REP(b) for (int _rep = 0; _rep < 1 + (int)(((DUP_MASK) >> (b)) & 1u); ++_rep)

__global__ void __launch_bounds__(NTHREADS, 2) mega(Args args) {
    extern __shared__ __attribute__((aligned(16))) unsigned char shm[];
    Frame F0;
    F0.in.kp = (kargp_t)__builtin_amdgcn_kernarg_segment_ptr();
    F0.out = args.out; F0.ws = args.ws; F0.lds = (LAS unsigned char*)shm;
    F0.tid = threadIdx.x; F0.lane = F0.tid & 63; F0.wave = __builtin_amdgcn_readfirstlane(F0.tid >> 6); F0.G = gridDim.x; F0.bid = blockIdx.x;
    volatile LAS unsigned* bst = (volatile LAS unsigned*)(shm + LDS_BYTES - 16);
    XcdBarrier bar; bar.bar = F0.w<unsigned>(WS_CTL) + CW_BAR; bar.x = 0; bar.st = bst;
#if N_LAUNCH_MODE == 1
    if (F0.tid == 0) { bst[0] = 0u; bst[1] = 0u; }
    __syncthreads();
    bar = xcd_barrier_post(F0.w<unsigned>(WS_CTL) + CW_BAR, bst);
#define GRID_BAR() xcd_barrier(bar)
#else
#define GRID_BAR() do {} while (0)
#endif
    const int lo = args.ph_lo, hi = args.ph_hi;
#define IN(k) (lo <= (k) && (k) < hi)
#define SEAM(k) do { if (IN(k) && IN((k) + 1)) GRID_BAR(); } while (0)

    if (IN(0)) { const Frame F = launder(F0); REP(1) ph_modpart(F); }
    SEAM(0);
    if (IN(1)) { const Frame F = launder(F0);
        REP(2) ph_filter(F); REP(3) ph_norm1(F, 0); ph_vecs(F); __syncthreads(); REP(0) ph_convert(F); }
    SEAM(1);
    for (int l = 0; l < 2; ++l) {
        const int pb = 2 + l * PH_PER_LAYER;
        if (EN(5) && IN(pb + 0)) { const Frame F = launder(F0);
            const bool f8 = (l == 0) ? (F8IN(0) != 0) : (F8IN(1) != 0);
            pg8::Gemm g{F.w<bf16_t>(WS_HB), F.w<bf16_t>(WS_WINT) + (size_t)l * PC * D, f8 ? D / 2 : D};
            pg8::SchedGrid S{PC / 256, (T / 256) * (PC / 256), F.G, F.vid};
            pg8::EpiBf16 E{F.w<bf16_t>(WS_P), PC, nullptr, 0};
            if (INPROJ_FP8 == 0) pg8::gemm_phase<pg8::EpiBf16, pg8::SchedGrid, true, false, false>(F.lds, g, S, E, F.tid);
            else if (INPROJ_FP8 == 3) pg8::gemm_phase<pg8::EpiBf16, pg8::SchedGrid, true, false, true>(F.lds, g, S, E, F.tid);
            else { if (f8) pg8::gemm_phase<pg8::EpiBf16, pg8::SchedGrid, true, false, true>(F.lds, g, S, E, F.tid); else pg8::gemm_phase<pg8::EpiBf16, pg8::SchedGrid, true, false, false>(F.lds, g, S, E, F.tid); }
        }
        SEAM(pb + 0);
        if (IN(pb + 1)) { const Frame F = launder(F0); if (l == 0) { REP(4) ph_fsum(F); } REP(6) ph_ssd_prep(F, l); REP(7) ph_hy_prep(F, l); REP(8) ph_na(F, l, 0); }
        SEAM(pb + 1);
        if (IN(pb + 2)) { const Frame F = launder(F0); REP(9) ph_ssd_scan(F); REP(10) { ph_hy_conv(F, l); if (l == 0) ph_hy_conv_ctx(F, l); } }
        SEAM(pb + 2);
        if (EN(11) && IN(pb + 3)) { const Frame F = launder(F0); REP(11) ph_ssd_out(F, l); REP(18) ph_hy_tr(F); if (l == 0) ph_na(F, l, 1); }
        SEAM(pb + 3);
        if (EN(12) && IN(pb + 4)) { const Frame F = launder(F0);
            pg8::Gemm g{F.w<bf16_t>(WS_MIX), F.w<bf16_t>(WS_WOUTT) + (size_t)l * D * D, D};
            const int nM = (l == 0) ? T / 256 : L / 256;
            pg8::SchedGrid S{4, nM * 4, F.G, F.vid};
            pg8::EpiBf16 E{F.w<bf16_t>(WS_MIXO), D, nullptr, 0};
            REP(12) pg8::gemm_phase<pg8::EpiBf16, pg8::SchedGrid>(F.lds, g, S, E, F.tid);
        }
        SEAM(pb + 4);
        if (EN(13) && IN(pb + 5)) { const Frame F = launder(F0); ph_post1(F, l); }
        SEAM(pb + 5);
        if (EN(14) && IN(pb + 6)) { const Frame F = launder(F0); REP(14) ph_gather(F, l); }
        SEAM(pb + 6);
        if (EN(15) && IN(pb + 7)) { const Frame F = launder(F0);
            const int* tab = F.w<int>(WS_CTL) + CW_TILE + l * 320;
            const int ntiles = __builtin_amdgcn_readfirstlane(F.w<int>(WS_CTL)[CW_NT + l]);
            pg8::Gemm g{F.w<bf16_t>(WS_H2), (const bf16_t*)(F.w<unsigned char>(WS_WGUT) + (size_t)l * NE * 2048 * D), D / 2};
            pg8::SchedMoe S{8, ntiles * 8, F.G, F.vid, tab};
            pg8::EpiAct E{F.w<unsigned char>(WS_HMID) + (size_t)l * MAXROWS * D, F.in[I_BGU] + (size_t)l * NE * 2048};
            LAS int* rowtab = (LAS int*)(F.lds + pg8::STAGE_BYTES);
            __syncthreads();
            {
                int nt_; const int ps = expert_pad_start(F, l, nt_);
                const unsigned* cnt = F.w<unsigned>(WS_CTL) + CW_CNT + l * 1024;
                for (int ui = 0; ui * F.G + F.vid < ntiles * 8 && ui < 12; ++ui) {
                    const int pa = (ui * F.G + F.vid) / 8;
                    const int e = tab[pa];
                    const int pstart = __shfl(ps, e), ce = (int)__hip_atomic_load(cnt + e * 32, __ATOMIC_RELAXED, __HIP_MEMORY_SCOPE_AGENT);
                    if (F.tid < 256) { const int prow = pa * 256 + F.tid; rowtab[ui * 256 + F.tid] = (prow - pstart < ce) ? F.w<int>(WS_ROWTOK)[(size_t)l * MAXROWS + prow] : T; }
                }
            }
            __syncthreads();
            REP(15) pg8::gemm_phase<pg8::EpiAct, pg8::SchedMoe, true, true, true>(F.lds, g, S, E, F.tid, rowtab);
        }
        SEAM(pb + 7);
        if (EN(16) && IN(pb + 8)) { const Frame F = launder(F0);
            const int* tab = F.w<int>(WS_CTL) + CW_TILE + l * 320;
            const int ntiles = __builtin_amdgcn_readfirstlane(F.w<int>(WS_CTL)[CW_NT + l]);
            pg8::Gemm g{(const bf16_t*)(F.w<unsigned char>(WS_HMID) + (size_t)l * MAXROWS * D), (const bf16_t*)(F.w<unsigned char>(WS_WDT) + (size_t)l * NE * D * D), D / 2};
            pg8::SchedMoe S{4, ntiles * 4, F.G, F.vid, tab};
            pg8::EpiBf16 E{F.w<bf16_t>(WS_Y) + (size_t)l * MAXROWS * D, D, F.in[I_BDN] + (size_t)l * NE * D, D};
            REP(16) pg8::gemm_phase<pg8::EpiBf16, pg8::SchedMoe, true, false, true>(F.lds, g, S, E, F.tid);
        }
        SEAM(pb + 8);
        if (EN(17) && IN(pb + 9)) { const Frame F = launder(F0); ph_final(F, l); }
        if (l == 0) SEAM(pb + 9);
    }
#undef IN
#undef SEAM
}

extern "C" void kernel_launch(void* const* d_in, const int* in_sizes, int n_in, void* d_out, int out_size, void* d_ws, size_t ws_size, hipStream_t stream) {
    static int grid = 0;
    if (grid == 0) {
        if (n_in != N_IN || out_size != L * D || ws_size < WS_END) { fprintf(stderr, "kernel_launch: unexpected shapes: n_in %d out %d ws %zu (need %zu)\n", n_in, out_size, ws_size, (size_t)WS_END); grid = -1; return; }
        int dev = 0, cus = 0, per_cu = 0;
        if (hipGetDevice(&dev) != hipSuccess || hipDeviceGetAttribute(&cus, hipDeviceAttributeMultiprocessorCount, dev) != hipSuccess) { grid = -1; return; }
        if (hipFuncSetAttribute((const void*)mega, hipFuncAttributeMaxDynamicSharedMemorySize, LDS_BYTES) != hipSuccess) { fprintf(stderr, "kernel_launch: hipFuncSetAttribute failed\n"); grid = -1; return; }
        if (hipOccupancyMaxActiveBlocksPerMultiprocessor(&per_cu, (const void*)mega, NTHREADS, LDS_BYTES) != hipSuccess || per_cu < 1) { fprintf(stderr, "kernel_launch: occupancy query says %d\n", per_cu); }
        (void)hipGetLastError();
        grid = cus;
    }
    if (grid < 0) return;
    (void)hipMemsetAsync((char*)d_ws + WS_CTL, 0, CTL_BYTES, stream);
    Args a{};
    for (int i = 0; i < N_IN; ++i) a.in[i] = (const float*)d_in[i];
    a.out = (float*)d_out; a.ws = (unsigned char*)d_ws;
#if N_LAUNCH_MODE == 1
    a.ph_lo = 0; a.ph_hi = N_PHASES;
    hipLaunchKernelGGL(mega, dim3(grid), dim3(NTHREADS), LDS_BYTES, stream, a);
#else
    for (int p = 0; p < N_PHASES; ++p) { a.ph_lo = p; a.ph_hi = p + 1; hipLaunchKernelGGL(mega, dim3(grid), dim3(NTHREADS), LDS_BYTES, stream, a); }
#endif
}
```

```cpp
#include <hip/hip_runtime.h>
#include <cstdio>
#include <cstdint>

#define LAS __attribute__((address_space(3)))
typedef unsigned short bf16_t;
typedef short bf16x8 __attribute__((ext_vector_type(8)));
typedef float f32x4 __attribute__((ext_vector_type(4)));
typedef float f32x16 __attribute__((ext_vector_type(16)));
typedef unsigned u32x4 __attribute__((ext_vector_type(4)));
typedef unsigned u32x2 __attribute__((ext_vector_type(2)));
typedef int v4i __attribute__((ext_vector_type(4)));
typedef int v8i __attribute__((ext_vector_type(8)));

#ifndef N_LAUNCH_MODE
#define N_LAUNCH_MODE 1
#endif

constexpr int D = 1024, L = 16384, LC = 256, T = L + LC, NCH = T / 128;
constexpr int PC = 3328;
constexpr int CZ = 0, CXBC = 384, CQ = 1280, CK = 1664, CV = 2048, CHY = 2432, CDT = 3200;
constexpr int NE = 32;
constexpr int MAXT = 292;
constexpr int MAXROWS = MAXT * 256;
constexpr int NTHREADS = 512;
constexpr int LDS_BYTES = 160 * 1024;
constexpr float RMS_EPS = 1e-6f;

enum { I_X = 0, I_C, I_CTX, I_CCTX, I_WMOD, I_BMOD, I_NORMG, I_WIN, I_SCW, I_SCB, I_ALOG, I_DTB, I_SSDD, I_SSDNG, I_RPB, I_HCW, I_HCB,
       I_FW1, I_FB1, I_FW2, I_FB2, I_FW3, I_FREQ, I_HYD, I_WOUT, I_WR, I_BR, I_WGU, I_BGU, I_WDN, I_BDN, N_IN };

constexpr size_t al256(size_t x) { return (x + 255) & ~(size_t)255; }
constexpr size_t WS_CTL   = 0;
constexpr size_t CTL_BYTES = 64 * 1024;
constexpr size_t WS_WINT  = WS_CTL + CTL_BYTES;
constexpr size_t WS_WOUTT = WS_WINT + al256((size_t)2 * PC * D * 2);
constexpr size_t WS_WGUT  = WS_WOUTT + al256((size_t)2 * D * D * 2);
constexpr size_t WS_WDT   = WS_WGUT + al256((size_t)2 * NE * 2048 * D * 2);
constexpr size_t WS_MODP  = WS_WDT + al256((size_t)2 * NE * D * D * 2);
constexpr int KRL = 2 * L + 512;
constexpr size_t WS_KR    = WS_MODP + al256((size_t)2 * 2 * 32 * 6144 * 4);
constexpr size_t WS_KCOMBC= WS_KR + al256((size_t)2 * 256 * KRL * 2);
constexpr size_t WS_FPART = WS_KCOMBC + al256((size_t)2 * LC * 256 * 4);
constexpr size_t WS_FPARTC= WS_FPART + al256((size_t)2 * 256 * 512 * 4);
constexpr size_t WS_FSUM  = WS_FPARTC + al256((size_t)16 * 512 * 4);
constexpr size_t WS_HB    = WS_FSUM + al256((size_t)3 * 256 * 4);
constexpr size_t WS_P     = WS_HB + al256((size_t)T * D * 2);
constexpr size_t WS_XBC   = WS_P + al256((size_t)T * PC * 2);
constexpr size_t WS_DTV   = WS_XBC + al256((size_t)T * 896 * 2);
constexpr size_t WS_ACS   = WS_DTV + al256((size_t)T * 12 * 4);
constexpr size_t WS_ALAST = WS_ACS + al256((size_t)T * 12 * 4);
constexpr size_t WS_STATES= WS_ALAST + al256((size_t)NCH * 12 * 4);
constexpr size_t WS_SSTART= WS_STATES + al256((size_t)2 * NCH * 6 * 128 * 64 * 4);
constexpr size_t WS_U     = WS_SSTART + al256((size_t)2 * NCH * 6 * 128 * 64 * 4);
constexpr size_t WS_UT    = WS_U + al256((size_t)T * 256 * 4);
constexpr size_t WS_UT8   = WS_UT + al256((size_t)256 * L * 2);
constexpr size_t WS_X0T   = WS_UT8 + al256((size_t)256 * L);
constexpr size_t WS_YT    = WS_X0T + al256((size_t)256 * L * 2);
constexpr size_t WS_MIX   = WS_YT + al256((size_t)256 * L * 2);
constexpr size_t WS_MIXO  = WS_MIX + al256((size_t)T * D * 2);
constexpr size_t WS_XCUR  = WS_MIXO + al256((size_t)T * D * 4);
constexpr size_t WS_H2    = WS_XCUR + al256((size_t)T * D * 4);
constexpr size_t WS_RE    = WS_H2 + al256((size_t)(T + 1) * D * 2);
constexpr size_t WS_RP    = WS_RE + al256((size_t)T * 4 * 4);
constexpr size_t WS_RW    = WS_RP + al256((size_t)T * 4 * 4);
constexpr size_t WS_SLOT  = WS_RW + al256((size_t)T * 4 * 4);
constexpr size_t WS_XG    = WS_SLOT + al256((size_t)T * 4 * 4);
constexpr size_t WS_HMID  = WS_XG + 256;
constexpr size_t WS_Y     = WS_HMID + al256((size_t)2 * MAXROWS * D * 2);
constexpr size_t WS_VECS  = WS_Y + al256((size_t)2 * MAXROWS * D * 2);
constexpr size_t WS_ROWTOK= WS_VECS + al256((size_t)2 * 2 * 6 * 1024 * 4);
constexpr size_t WS_END   = WS_ROWTOK + al256((size_t)2 * MAXROWS * 4);

constexpr int CW_BAR = 0;
constexpr int CW_CNT = 8192;
#ifndef INPROJ_FP8
#define INPROJ_FP8 2
#endif
#define F8IN(l) (((INPROJ_FP8) >> (l)) & 1)
#ifndef PRO_NF
#define PRO_NF 96
#endif
constexpr int CW_CVQ = 4160;
constexpr int CW_NT = 4200;
constexpr int CW_TILE = 4224;

__device__ __forceinline__ float bf2f(unsigned short b) { return __uint_as_float(((unsigned)b) << 16); }
__device__ __forceinline__ unsigned short f2bf(float f) { return __builtin_bit_cast(unsigned short, (__bf16)f); }
typedef __bf16 bf16v2 __attribute__((ext_vector_type(2)));
__device__ __forceinline__ unsigned pk_bf16(float lo, float hi) { const bf16v2 v = {(__bf16)lo, (__bf16)hi}; return __builtin_bit_cast(unsigned, v); }
__device__ __forceinline__ float sat8(float x) { return __builtin_amdgcn_fmed3f(x, -448.0f, 448.0f); }
__device__ __forceinline__ unsigned pk_fp8x4_nosat(float a, float b, float c, float d) { unsigned w = 0; w = __builtin_amdgcn_cvt_pk_fp8_f32(a, b, w, false); w = __builtin_amdgcn_cvt_pk_fp8_f32(c, d, w, true); return w; }
__device__ __forceinline__ unsigned pk_fp8x4(float a, float b, float c, float d) { unsigned w = 0; w = __builtin_amdgcn_cvt_pk_fp8_f32(sat8(a), sat8(b), w, false); w = __builtin_amdgcn_cvt_pk_fp8_f32(sat8(c), sat8(d), w, true); return w; }
constexpr float KR_SCALE = 64.0f;
constexpr float W8_SCALE = 32.0f;
constexpr int W8_SCALE_E8M0 = 0x7A7A7A7A, ONE_E8M0 = 0x7F7F7F7F;
__device__ __forceinline__ float bflo(unsigned w) { return __uint_as_float(w << 16); }
__device__ __forceinline__ float bfhi(unsigned w) { return __uint_as_float(w & 0xFFFF0000u); }
__device__ __forceinline__ float silu_f(float x) { return x * __builtin_amdgcn_rcpf(1.0f + __expf(-x)); }
__device__ __forceinline__ float softplus_f(float x) { return x > 20.f ? x : log1pf(__expf(x)); }
__device__ __forceinline__ float row16_ror(float v, int ctrl8421) {
    switch (ctrl8421) {
        case 8: return __int_as_float(__builtin_amdgcn_update_dpp(0, __float_as_int(v), 0x128, 0xF, 0xF, false));
        case 4: return __int_as_float(__builtin_amdgcn_update_dpp(0, __float_as_int(v), 0x124, 0xF, 0xF, false));
        case 2: return __int_as_float(__builtin_amdgcn_update_dpp(0, __float_as_int(v), 0x122, 0xF, 0xF, false));
        default: return __int_as_float(__builtin_amdgcn_update_dpp(0, __float_as_int(v), 0x121, 0xF, 0xF, false));
    }
}
__device__ __forceinline__ float row16_max(float v) { v = fmaxf(v, row16_ror(v, 8)); v = fmaxf(v, row16_ror(v, 4)); v = fmaxf(v, row16_ror(v, 2)); v = fmaxf(v, row16_ror(v, 1)); return v; }
__device__ __forceinline__ float row16_sum(float v) { v += row16_ror(v, 8); v += row16_ror(v, 4); v += row16_ror(v, 2); v += row16_ror(v, 1); return v; }
__device__ __forceinline__ float wave_sum(float v) {
    v = row16_sum(v);
    const int vi = __float_as_int(v);
    return (__int_as_float(__builtin_amdgcn_readlane(vi, 0)) + __int_as_float(__builtin_amdgcn_readlane(vi, 16))) + (__int_as_float(__builtin_amdgcn_readlane(vi, 32)) + __int_as_float(__builtin_amdgcn_readlane(vi, 48)));
}
__device__ __forceinline__ void lds_fence() { asm volatile("s_waitcnt lgkmcnt(0)" ::: "memory"); }

#define XB_TMO      128
#define XB_XCNT(j)  (256  + 64 * (j))
#define XB_XSUB(j)  (1280 + 64 * (j))
#define XB_XGEN(j)  (2304 + 64 * (j))
#define XB_TOP      3328
#define XB_TOPGEN   3392
#define XCD_BAR_WORDS 3456
#define XB_SPIN_CAP (1u << 18)
__device__ __forceinline__ unsigned xb_ld(unsigned* p)              { return __hip_atomic_load(p, __ATOMIC_RELAXED, __HIP_MEMORY_SCOPE_AGENT); }
__device__ __forceinline__ unsigned xb_add(unsigned* p, unsigned v) { return __hip_atomic_fetch_add(p, v, __ATOMIC_RELAXED, __HIP_MEMORY_SCOPE_AGENT); }
__device__ __forceinline__ unsigned xb_xcc_id() { return (unsigned)__builtin_amdgcn_s_getreg((3 << 11) | 20) & 0xFu; }
#define XB_SPIN(cond, bar) do { unsigned _sp = 0; while (cond) { __builtin_amdgcn_s_sleep(1); \
    if ((++_sp & 255u) == 0u) { if (xb_ld(&(bar)[XB_TMO])) break; if (_sp > XB_SPIN_CAP) { atomicAdd(&(bar)[XB_TMO], 1u); break; } } } } while (0)
struct XcdBarrier { unsigned* bar; unsigned x; volatile LAS unsigned* st; };
__device__ __forceinline__ XcdBarrier xcd_barrier_post(unsigned* bar, volatile LAS unsigned* st) {
    XcdBarrier b; b.bar = bar; b.x = xb_xcc_id(); b.st = st;
    if (threadIdx.x == 0) (void)xb_add(&bar[XB_XCNT(b.x)], 1u);
    return b;
}
__device__ __forceinline__ void xcd_barrier_complete(unsigned* bar, unsigned x, unsigned& nloc, unsigned& nx) {
    const unsigned G = gridDim.x * gridDim.y * gridDim.z;
    unsigned sum, cnt, mine, sp = 0u;
    for (;;) {
        sum = 0u; cnt = 0u; mine = 0u;
#pragma unroll
        for (unsigned j = 0; j < 16; ++j) { const unsigned c = xb_ld(&bar[XB_XCNT(j)]); sum += c; cnt += (c > 0u) ? 1u : 0u; mine = (j == x) ? c : mine; }
        if (sum == G) break;
        __builtin_amdgcn_s_sleep(1);
        if ((++sp & 255u) == 0u) { if (xb_ld(&bar[XB_TMO])) break; if (sp > XB_SPIN_CAP) { atomicAdd(&bar[XB_TMO], 1u); break; } }
    }
    nloc = mine > 0u ? mine : 1u; nx = cnt > 0u ? cnt : 1u;
}
__device__ __forceinline__ void xcd_barrier(const XcdBarrier& b) {
    asm volatile("s_waitcnt vmcnt(0)" ::: "memory");
    __syncthreads();
    if (threadIdx.x == 0) {
        unsigned* bar = b.bar;
        __builtin_amdgcn_s_waitcnt(0);
        unsigned nloc = b.st[0], nx = b.st[1];
        if (nloc == 0u) { xcd_barrier_complete(bar, b.x, nloc, nx); b.st[0] = nloc; b.st[1] = nx; }
        const unsigned old = xb_add(&bar[XB_XSUB(b.x)], 1u);
        const unsigned gen = old / nloc;
        if (old + 1u == (gen + 1u) * nloc) {
            __builtin_amdgcn_fence(__ATOMIC_RELEASE, "agent");
            asm volatile("s_waitcnt vmcnt(0)" ::: "memory");
            const unsigned og = xb_add(&bar[XB_TOP], 1u);
            const unsigned tg = og / nx;
            if (og + 1u == (tg + 1u) * nx) xb_add(&bar[XB_TOPGEN], 1u);
            else XB_SPIN(xb_ld(&bar[XB_TOPGEN]) == tg, bar);
            __builtin_amdgcn_fence(__ATOMIC_ACQUIRE, "agent");
            xb_add(&bar[XB_XGEN(b.x)], 1u);
            asm volatile("s_waitcnt vmcnt(0)" ::: "memory");
        } else {
            XB_SPIN(xb_ld(&bar[XB_XGEN(b.x)]) == gen, bar);
            __builtin_amdgcn_fence(__ATOMIC_ACQUIRE, "agent");
            asm volatile("s_waitcnt vmcnt(0)" ::: "memory");
        }
    }
    __syncthreads();
}

#ifndef GEMM_REP
#define GEMM_REP 1
#endif
namespace pg8 {
constexpr int BM = 256, BK = 64, HALF = 128, HTB = HALF * BK * 2, STAGE_BYTES = 8 * HTB;
__host__ __device__ __forceinline__ int lds_byte(int r, int c) { const int st = (r >> 4) * 2 + (c >> 5), rr = r & 15, cc = c & 31, ob = rr * 64 + cc * 2; return st * 1024 + (ob ^ (((ob >> 9) & 1) << 5)); }
__host__ __device__ __forceinline__ void stage_rc(int b, int& R, int& C) { const int st = b / 1024, sb = b % 1024, swz = sb ^ (((sb >> 9) & 1) << 5); R = (st >> 1) * 16 + swz / 64; C = (st & 1) * 32 + (swz % 64) / 2; }
__host__ __device__ __forceinline__ int perm32(int rho) { const int n = rho >> 4, i = rho & 15; return 8 * (i >> 2) + 4 * n + (i & 3); }

struct Unit { int pa, pb, pn, e; };
struct Gemm { const bf16_t* A; const bf16_t* Bt; int K; };

template <class Epi, class Sched, bool ALIGN_EPI = true, bool GATHER = false, bool FP8 = false>
__device__ __forceinline__ void gemm_phase(LAS unsigned char* lds, const Gemm g, const Sched& S, const Epi& E, const int tid, const LAS int* rowtab = nullptr) {
    const int wid = __builtin_amdgcn_readfirstlane(tid >> 6), lane = tid & 63, wr = wid >> 2, wc = wid & 3, fr = lane & 15, fq = lane >> 4;
    const int K = g.K, nt = K / BK;
    unsigned voffA[2], voffB[2];
    int gR[2], gC[2];
#pragma unroll
    for (int i = 0; i < 2; ++i) { int R, C; stage_rc(tid * 16 + i * 8192, R, C); const int Rb = Epi::PERM ? ((R & ~31) + perm32(R & 31)) : R;
        voffA[i] = (unsigned)(R * K + C) * 2u; voffB[i] = (unsigned)(Rb * K + C) * 2u; gR[i] = R; gC[i] = C * 2; }
    unsigned vC0[2], vC1[2], vN0[2], vN1[2];
#define PG8_GOFFS(dst0, dst1, ui_) do { _Pragma("unroll") for (int _i = 0; _i < 2; ++_i) { \
        dst0[_i] = (unsigned)rowtab[(ui_) * 256 + gR[_i]] * (unsigned)(K * 2) + (unsigned)gC[_i]; dst1[_i] = (unsigned)rowtab[(ui_) * 256 + 128 + gR[_i]] * (unsigned)(K * 2) + (unsigned)gC[_i]; } } while (0)
    const size_t kstep = (size_t)(BK * 2);
    const size_t hstep = (size_t)HALF * K * 2;
    const size_t tstep = 2 * hstep;
    const unsigned ldsw = (unsigned)wid * 1024u;
    const int aoff = lds_byte(wr * 64 + fr, fq * 8), boff = lds_byte(wc * 32 + fr, fq * 8);
#define PG8_SA(b, h) (((b) * 2 + (h)) * HTB)
#define PG8_SB(b, h) ((4 + (b) * 2 + (h)) * HTB)
#define PG8_STAGE(bufoff, gbase, voff) do { _Pragma("unroll") for (int _i = 0; _i < 2; ++_i) \
        __builtin_amdgcn_global_load_lds((const unsigned*)((const char*)(gbase) + (voff)[_i]), (LAS unsigned*)(lds + (bufoff) + ldsw + _i * 8192), 16, 0, 0); } while (0)
#define PG8_LDA(dst, b, h) do { _Pragma("unroll") for (int m = 0; m < 4; ++m) { const v4i _x = *(const LAS v4i*)(lds + PG8_SA(b, h) + aoff + m * 2048), _y = *(const LAS v4i*)(lds + PG8_SA(b, h) + aoff + m * 2048 + 1024); \
        dst[m] = __builtin_shufflevector(_x, _y, 0, 1, 2, 3, 4, 5, 6, 7); } } while (0)
#define PG8_LDB(dst, b, h) do { _Pragma("unroll") for (int n = 0; n < 2; ++n) { const v4i _x = *(const LAS v4i*)(lds + PG8_SB(b, h) + boff + n * 2048), _y = *(const LAS v4i*)(lds + PG8_SB(b, h) + boff + n * 2048 + 1024); \
        dst[n] = __builtin_shufflevector(_x, _y, 0, 1, 2, 3, 4, 5, 6, 7); } } while (0)
#define PG8_HALF0(x) __builtin_bit_cast(bf16x8, __builtin_shufflevector((x), (x), 0, 1, 2, 3))
#define PG8_HALF1(x) __builtin_bit_cast(bf16x8, __builtin_shufflevector((x), (x), 4, 5, 6, 7))
#define PG8_MMA(ai, bj, At, Bt) do { __builtin_amdgcn_s_setprio(1); if constexpr (FP8) { _Pragma("unroll") for (int m = 0; m < 4; ++m) _Pragma("unroll") for (int n = 0; n < 2; ++n) \
        asm volatile("v_mfma_scale_f32_16x16x128_f8f6f4 %0, %1, %2, %0, %3, %4 op_sel_hi:[0,0,0]" : "+v"(acc[ai][bj][m][n]) : "v"(Bt[n]), "v"(At[m]), "v"(sclW), "v"(sclX)); } \
        else { _Pragma("unroll") for (int m = 0; m < 4; ++m) _Pragma("unroll") for (int n = 0; n < 2; ++n) { \
        acc[ai][bj][m][n] = __builtin_amdgcn_mfma_f32_16x16x32_bf16(PG8_HALF0(Bt[n]), PG8_HALF0(At[m]), acc[ai][bj][m][n], 0, 0, 0); \
        acc[ai][bj][m][n] = __builtin_amdgcn_mfma_f32_16x16x32_bf16(PG8_HALF1(Bt[n]), PG8_HALF1(At[m]), acc[ai][bj][m][n], 0, 0, 0); } } __builtin_amdgcn_s_setprio(0); } while (0)
#define PG8_WAIT_V(n) asm volatile("s_waitcnt vmcnt(" #n ")" ::: "memory")
#define PG8_WAIT_L(n) asm volatile("s_waitcnt lgkmcnt(" #n ")" ::: "memory")
#define PG8_BAR __builtin_amdgcn_s_barrier()
#define PG8_SCHED __builtin_amdgcn_sched_barrier(0)
    Unit cur, nxt; int ui = 0;
    if (!S.next(0, cur)) return;
    f32x4 acc[2][2][4][2];
    E.init(acc, cur, wc, fq);
    const int sclW = W8_SCALE_E8M0, sclX = ONE_E8M0;
    v8i At[4], B0[2], B1[2];
    const char* cA = GATHER ? (const char*)g.A : (const char*)g.A + (size_t)cur.pa * tstep; const char* cB = (const char*)g.Bt + (size_t)cur.pb * tstep;
    const size_t hstepA = GATHER ? 0 : hstep;
    if constexpr (GATHER) { PG8_GOFFS(vC0, vC1, 0); } else {
#pragma unroll
        for (int i = 0; i < 2; ++i) { vC0[i] = voffA[i]; vC1[i] = voffA[i]; vN0[i] = voffA[i]; vN1[i] = voffA[i]; } }
    PG8_STAGE(PG8_SB(0, 0), cB, voffB); PG8_STAGE(PG8_SB(0, 1), cB + hstep, voffB); PG8_STAGE(PG8_SA(0, 0), cA, vC0); PG8_STAGE(PG8_SA(0, 1), cA + hstepA, vC1);
    if (wr == 1) PG8_BAR;
    PG8_WAIT_V(2); PG8_BAR;
    PG8_STAGE(PG8_SB(1, 0), cB + kstep, voffB); PG8_STAGE(PG8_SA(1, 0), cA + kstep, vC0); PG8_STAGE(PG8_SB(1, 1), cB + hstep + kstep, voffB);
    PG8_WAIT_V(6); PG8_BAR;
    for (;;) {
        const bool has_next = S.next(ui + 1, nxt);
        const char* nA = GATHER ? (const char*)g.A : (has_next ? (const char*)g.A + (size_t)nxt.pa * tstep : cA); const char* nB = has_next ? (const char*)g.Bt + (size_t)nxt.pb * tstep : cB;
        if constexpr (GATHER) { if (has_next) { PG8_GOFFS(vN0, vN1, ui + 1); } else {
#pragma unroll
            for (int i = 0; i < 2; ++i) { vN0[i] = vC0[i]; vN1[i] = vC1[i]; } } }
#pragma unroll 1
        for (int t = 0; t < nt; t += 2) {
            const bool last = (t == nt - 2);
            unsigned vX0[2], vX1[2];
#pragma unroll
            for (int i = 0; i < 2; ++i) { vX0[i] = (GATHER && last) ? vN0[i] : vC0[i]; vX1[i] = (GATHER && last) ? vN1[i] : vC1[i]; }
            const char* a1 = cA + (size_t)(t + 1) * kstep;
            const char* a2 = last ? nA : cA + (size_t)(t + 2) * kstep; const char* b2 = last ? nB : cB + (size_t)(t + 2) * kstep;
            const char* a3 = a2 + kstep; const char* b3 = b2 + kstep;
            PG8_LDB(B0, 0, 0); PG8_LDB(B1, 0, 1); PG8_SCHED; PG8_LDA(At, 0, 0); PG8_STAGE(PG8_SA(1, 1), a1 + hstepA, vC1);
            PG8_WAIT_V(8); PG8_WAIT_L(0); PG8_BAR; PG8_MMA(0, 0, At, B0); PG8_MMA(0, 1, At, B1); PG8_BAR; PG8_SCHED;
            PG8_LDA(At, 0, 1); PG8_STAGE(PG8_SB(0, 0), b2, voffB); PG8_STAGE(PG8_SB(0, 1), b2 + hstep, voffB); PG8_STAGE(PG8_SA(0, 0), a2, vX0);
            PG8_WAIT_V(8); PG8_WAIT_L(0); PG8_BAR; PG8_MMA(1, 0, At, B0); PG8_MMA(1, 1, At, B1); PG8_BAR; PG8_SCHED;
            PG8_LDB(B0, 1, 0); PG8_LDB(B1, 1, 1); PG8_SCHED; PG8_LDA(At, 1, 0); PG8_STAGE(PG8_SA(0, 1), a2 + hstepA, vX1);
            PG8_WAIT_V(8); PG8_WAIT_L(0); PG8_BAR; PG8_MMA(0, 0, At, B0); PG8_MMA(0, 1, At, B1); PG8_BAR; PG8_SCHED;
            PG8_LDA(At, 1, 1); PG8_STAGE(PG8_SB(1, 0), b3, voffB); PG8_STAGE(PG8_SB(1, 1), b3 + hstep, voffB); PG8_STAGE(PG8_SA(1, 0), a3, vX0);
            PG8_WAIT_V(8); PG8_WAIT_L(0); PG8_BAR; PG8_MMA(1, 0, At, B0); PG8_MMA(1, 1, At, B1); PG8_BAR; PG8_SCHED;
        }
        if constexpr (ALIGN_EPI) { if (wr == 0) PG8_BAR; }
        E(acc, cur, wr, wc, fr, fq);
        if (!has_next) break;
        E.init(acc, nxt, wc, fq);
        cur = nxt; cA = nA; cB = nB; ++ui;
        if constexpr (GATHER) {
#pragma unroll
            for (int i = 0; i < 2; ++i) { vC0[i] = vN0[i]; vC1[i] = vN1[i]; } }
        if constexpr (ALIGN_EPI) { if (wr == 1) PG8_BAR; }
    }
    PG8_WAIT_V(0);
    if constexpr (!ALIGN_EPI) { if (wr == 0) PG8_BAR; }
    PG8_BAR;
#undef PG8_GOFFS
#undef PG8_HALF0
#undef PG8_HALF1
#undef PG8_SA
#undef PG8_SB
#undef PG8_STAGE
#undef PG8_LDA
#undef PG8_LDB
#undef PG8_MMA
#undef PG8_WAIT_V
#undef PG8_WAIT_L
#undef PG8_BAR
#undef PG8_SCHED
}

struct EpiF32 {
    static constexpr bool PERM = false;
    float* C; int ldc;
    __device__ __forceinline__ void operator()(const f32x4 (&acc)[2][2][4][2], const Unit& u, int wr, int wc, int fr, int fq) const {
        const int row0 = u.pa * BM + wr * 64 + fr, col0 = u.pn * BM + wc * 32 + 4 * fq;
#pragma unroll
        for (int ai = 0; ai < 2; ++ai)
#pragma unroll
            for (int m = 0; m < 4; ++m) { float* rowp = C + (size_t)(row0 + ai * HALF + m * 16) * ldc + col0;
#pragma unroll
                for (int bj = 0; bj < 2; ++bj)
#pragma unroll
                    for (int n = 0; n < 2; ++n) *(f32x4*)(rowp + bj * HALF + n * 16) = acc[ai][bj][m][n]; }
    }
};
struct EpiBf16 {
    static constexpr bool PERM = true;
    bf16_t* O; int ldc; const float* bias; int bias_stride;
    __device__ __forceinline__ void init(f32x4 (&acc)[2][2][4][2], const Unit& u, int wc, int fq) const {
        const int col0 = u.pn * BM + wc * 32 + 8 * fq;
#pragma unroll
        for (int bj = 0; bj < 2; ++bj)
#pragma unroll
            for (int n = 0; n < 2; ++n) { const f32x4 bv = bias ? *(const f32x4*)(bias + (size_t)u.e * bias_stride + col0 + bj * HALF + 4 * n) : (f32x4){0.f, 0.f, 0.f, 0.f};
#pragma unroll
                for (int ai = 0; ai < 2; ++ai)
#pragma unroll
                    for (int m = 0; m < 4; ++m) acc[ai][bj][m][n] = bv; }
    }
    __device__ __forceinline__ void operator()(const f32x4 (&acc)[2][2][4][2], const Unit& u, int wr, int wc, int fr, int fq) const {
        const int row0 = u.pa * BM + wr * 64 + fr; const int col0 = u.pn * BM + wc * 32 + 8 * fq;
#pragma unroll
        for (int ai = 0; ai < 2; ++ai)
#pragma unroll
            for (int m = 0; m < 4; ++m) { bf16_t* rowp = O + (size_t)(row0 + ai * HALF + m * 16) * ldc + col0;
#pragma unroll
                for (int bj = 0; bj < 2; ++bj) { const f32x4 v0 = acc[ai][bj][m][0], v1 = acc[ai][bj][m][1];
                    u32x4 w; w.x = pk_bf16(v0[0], v0[1]); w.y = pk_bf16(v0[2], v0[3]); w.z = pk_bf16(v1[0], v1[1]); w.w = pk_bf16(v1[2], v1[3]);
                    *(u32x4*)(rowp + bj * HALF) = w; } }
    }
};
struct EpiAct {
    static constexpr bool PERM = true;
    unsigned char* O; const float* bias;
    __device__ __forceinline__ void init(f32x4 (&acc)[2][2][4][2], const Unit& u, int wc, int fq) const {
        const float* bg = bias + (size_t)u.e * 2048 + u.pn * 128 + wc * 32 + 8 * fq;
#pragma unroll
        for (int bj = 0; bj < 2; ++bj)
#pragma unroll
            for (int n = 0; n < 2; ++n) { const f32x4 bv = *(const f32x4*)(bg + bj * 1024 + 4 * n);
#pragma unroll
                for (int ai = 0; ai < 2; ++ai)
#pragma unroll
                    for (int m = 0; m < 4; ++m) acc[ai][bj][m][n] = bv; }
    }
    __device__ __forceinline__ void operator()(const f32x4 (&acc)[2][2][4][2], const Unit& u, int wr, int wc, int fr, int fq) const {
        const int row0 = u.pa * BM + wr * 64 + fr; const int cc0 = wc * 32 + 8 * fq; const int ocol = u.pn * 128 + cc0;
#pragma unroll
        for (int ai = 0; ai < 2; ++ai)
#pragma unroll
            for (int m = 0; m < 4; ++m) { unsigned char* rowp = O + (size_t)(row0 + ai * HALF + m * 16) * D + ocol;
                float r[8];
#pragma unroll
                for (int n = 0; n < 2; ++n)
#pragma unroll
                    for (int j = 0; j < 4; ++j) { float gt = acc[ai][0][m][n][j], up = acc[ai][1][m][n][j];
                        gt = fminf(gt, 7.0f); up = fminf(fmaxf(up, -7.0f), 7.0f);
                        r[n * 4 + j] = gt * __builtin_amdgcn_rcpf(1.0f + __expf(-1.702f * gt)) * (up + 1.0f); }
                u32x2 w; w.x = pk_fp8x4_nosat(r[0], r[1], r[2], r[3]); w.y = pk_fp8x4_nosat(r[4], r[5], r[6], r[7]);
                *(u32x2*)rowp = w; }
    }
};
struct SchedGrid {
    int nN, total, G, c;
    __device__ __forceinline__ bool next(int i, Unit& u) const { int Lx = i * G + c; if (Lx >= GEMM_REP * total) return false; if (GEMM_REP > 1) Lx %= total; u.pa = Lx / nN; u.pn = Lx - u.pa * nN; u.pb = u.pn; u.e = 0; return true; }
};
struct SchedMoe {
    int nN, total, G, c; const int* tile_e;
    __device__ __forceinline__ bool next(int i, Unit& u) const { int Lx = i * G + c; if (Lx >= GEMM_REP * total) return false; if (GEMM_REP > 1) Lx %= total; u.pa = Lx / nN; u.pn = Lx - u.pa * nN; u.e = __builtin_amdgcn_readfirstlane((int)tile_e[u.pa]); u.pb = u.e * nN + u.pn; return true; }
};
}

struct Args { const float* in[N_IN]; float* out; unsigned char* ws; int ph_lo, ph_hi; };

typedef const float* __attribute__((address_space(4))) const* kargp_t;
struct InProxy { kargp_t kp; __device__ __forceinline__ const float* operator[](int i) const { return kp[i]; } };
struct Frame {
    InProxy in; float* out; unsigned char* ws;
    LAS unsigned char* lds;
    int tid, lane, wave, G, bid, vid;
    template <class Tp> __device__ __forceinline__ Tp* w(size_t off) const { return (Tp*)(ws + off); }
};

__device__ __forceinline__ Frame launder(const Frame& F) {
    Frame R = F;
    int t = F.tid; asm volatile("" : "+v"(t)); R.tid = t; R.lane = t & 63; R.wave = __builtin_amdgcn_readfirstlane(t >> 6);
    unsigned long long w = (unsigned long long)F.ws; asm volatile("" : "+s"(w)); R.ws = (unsigned char*)w;
    unsigned long long o = (unsigned long long)F.out; asm volatile("" : "+s"(o)); R.out = (float*)o;
    unsigned long long k = (unsigned long long)F.in.kp; asm volatile("" : "+s"(k)); R.in.kp = (kargp_t)k;
    int g = F.G, b = F.bid; asm volatile("" : "+s"(g), "+s"(b)); R.G = g; R.bid = b; R.vid = (g % 8 == 0) ? (b % 8) * (g / 8) + b / 8 : b;
    return R;
}

__device__ __forceinline__ float mod_val(const Frame& F, int l, int which, int j) {
    const float* mp = F.w<float>(WS_MODP) + (size_t)((l * 2 + which) * 32) * 6144 + j;
    float s = F.in[I_BMOD][l * 6144 + j];
#pragma unroll
    for (int k = 0; k < 32; ++k) s += mp[(size_t)k * 6144];
    return s;
}

struct CvtTile { const float* src; bf16_t* dst; int ld, mode, k0, n0; bool f8; };
__device__ __forceinline__ CvtTile cvt_decode(const Frame& F, int t) {
    CvtTile c;
    if (t < 1664) { const int l = t / 832, r = t % 832; c.n0 = (r / 16) * 64; c.k0 = (r % 16) * 64; c.src = F.in[I_WIN] + (size_t)l * 1024 * 3212; c.ld = 3212; c.mode = 1; c.f8 = F8IN(l) != 0; c.dst = F.w<bf16_t>(WS_WINT) + (size_t)l * PC * D; }
    else if (t < 2176) { const int q = t - 1664, l = q / 256, r = q % 256; c.n0 = (r / 16) * 64; c.k0 = (r % 16) * 64; c.src = F.in[I_WOUT] + (size_t)l * D * D; c.ld = 1024; c.mode = 0; c.f8 = false; c.dst = F.w<bf16_t>(WS_WOUTT) + (size_t)l * D * D; }
    else if (t < 34944) { const int q = t - 2176, le = q / 512, r = q % 512; c.n0 = (r / 16) * 64; c.k0 = (r % 16) * 64; c.src = F.in[I_WGU] + (size_t)le * 1024 * 2048; c.ld = 2048; c.mode = 2; c.f8 = true; c.dst = (bf16_t*)(F.w<unsigned char>(WS_WGUT) + (size_t)le * 2048 * D); }
    else { const int q = t - 34944, le = q / 256, r = q % 256; c.n0 = (r / 16) * 64; c.k0 = (r % 16) * 64; c.src = F.in[I_WDN] + (size_t)le * D * D; c.ld = 1024; c.mode = 0; c.f8 = true; c.dst = (bf16_t*)(F.w<unsigned char>(WS_WDT) + (size_t)le * D * D); }
    return c;
}
__device__ __forceinline__ void cvt_load(const CvtTile& c, int lane, f32x4 (&a)[8], f32x4 (&b)[8]) {
    const int i4 = lane & 15, kpl = lane >> 4;
    const int n = c.n0 + 4 * i4;
    int sc; bool valid = true;
    if (c.mode == 0) sc = n;
    else if (c.mode == 1) { if (n < 1280) sc = n; else if (n < 3200) sc = n + 12; else if (n < 3212) sc = n - 3200 + 1280; else { sc = 0; valid = false; } }
    else { const int pn = n >> 8, rr = n & 255; sc = rr < 128 ? pn * 128 + rr : 1024 + pn * 128 + (rr - 128); }
#pragma unroll
    for (int it = 0; it < 8; ++it) {
        const int r0 = c.f8 ? 4 * (kpl + 4 * (it >> 1)) + 2 * (it & 1) : 2 * (kpl + 4 * it);
        a[it] = (f32x4){0.f, 0.f, 0.f, 0.f}; b[it] = a[it];
        if (valid) { a[it] = __builtin_nontemporal_load((const f32x4*)(c.src + (size_t)(c.k0 + r0) * c.ld + sc)); b[it] = __builtin_nontemporal_load((const f32x4*)(c.src + (size_t)(c.k0 + r0 + 1) * c.ld + sc)); }
    }
}
__device__ __forceinline__ void cvt_store(const CvtTile& c, int lane, const f32x4 (&a)[8], const f32x4 (&b)[8], LAS unsigned* lw) {
    const int i4 = lane & 15, kpl = lane >> 4;
    if (c.f8) {
#pragma unroll
        for (int j = 0; j < 4; ++j) {
            const int kq = kpl + 4 * j;
#pragma unroll
            for (int i = 0; i < 4; ++i) lw[kq * 65 + 4 * i4 + i] = pk_fp8x4(W8_SCALE * a[2 * j][i], W8_SCALE * b[2 * j][i], W8_SCALE * a[2 * j + 1][i], W8_SCALE * b[2 * j + 1][i]);
        }
        lds_fence();
        const int g = lane & 3, nl = lane >> 2;
        unsigned char* d8 = (unsigned char*)c.dst;
#pragma unroll
        for (int it = 0; it < 4; ++it) {
            const int nn = nl + 16 * it;
            u32x4 v; v.x = lw[(4 * g + 0) * 65 + nn]; v.y = lw[(4 * g + 1) * 65 + nn]; v.z = lw[(4 * g + 2) * 65 + nn]; v.w = lw[(4 * g + 3) * 65 + nn];
            *(u32x4*)(d8 + (size_t)(c.n0 + nn) * 1024 + c.k0 + 16 * g) = v;
        }
        lds_fence();
        return;
    }
#pragma unroll
    for (int it = 0; it < 8; ++it) {
        const int kp = kpl + 4 * it;
#pragma unroll
        for (int i = 0; i < 4; ++i) lw[kp * 65 + 4 * i4 + i] = pk_bf16(a[it][i], b[it][i]);
    }
    lds_fence();
    const int g = lane & 7, nl = lane >> 3;
#pragma unroll
    for (int it = 0; it < 8; ++it) {
        const int nn = nl + 8 * it;
        u32x4 v; v.x = lw[(4 * g + 0) * 65 + nn]; v.y = lw[(4 * g + 1) * 65 + nn]; v.z = lw[(4 * g + 2) * 65 + nn]; v.w = lw[(4 * g + 3) * 65 + nn];
        *(u32x4*)(c.dst + (size_t)(c.n0 + nn) * 1024 + c.k0 + 8 * g) = v;
    }
    lds_fence();
}

__device__ __forceinline__ void cvt_store8x2(const CvtTile& c, int lane, const f32x4 (&a0)[8], const f32x4 (&b0)[8], const f32x4 (&a1)[8], const f32x4 (&b1)[8], LAS unsigned* lw) {
    const int i4 = lane & 15, kpl = lane >> 4;
#pragma unroll
    for (int j = 0; j < 4; ++j) {
        const int kq = kpl + 4 * j;
#pragma unroll
        for (int i = 0; i < 4; ++i) {
            lw[kq * 65 + 4 * i4 + i] = pk_fp8x4(W8_SCALE * a0[2 * j][i], W8_SCALE * b0[2 * j][i], W8_SCALE * a0[2 * j + 1][i], W8_SCALE * b0[2 * j + 1][i]);
            lw[(16 + kq) * 65 + 4 * i4 + i] = pk_fp8x4(W8_SCALE * a1[2 * j][i], W8_SCALE * b1[2 * j][i], W8_SCALE * a1[2 * j + 1][i], W8_SCALE * b1[2 * j + 1][i]);
        }
    }
    lds_fence();
    const int g = lane & 7, nl = lane >> 3;
    unsigned char* d8 = (unsigned char*)c.dst;
#pragma unroll
    for (int it = 0; it < 8; ++it) {
        const int nn = nl + 8 * it;
        u32x4 v; v.x = lw[(4 * g + 0) * 65 + nn]; v.y = lw[(4 * g + 1) * 65 + nn]; v.z = lw[(4 * g + 2) * 65 + nn]; v.w = lw[(4 * g + 3) * 65 + nn];
        *(u32x4*)(d8 + (size_t)(c.n0 + nn) * 1024 + c.k0 + 16 * g) = v;
    }
    lds_fence();
}
__device__ __forceinline__ void ph_convert(const Frame& F) {
    LAS unsigned* lw = (LAS unsigned*)(F.lds) + F.wave * (32 * 65 + 16);
    const int nwaves = F.G * 8, w0 = F.bid * 8 + F.wave;
    f32x4 a0[8], b0[8], a1[8], b1[8];
    for (int t = w0; t < 2176; t += nwaves) { const CvtTile c = cvt_decode(F, t); cvt_load(c, F.lane, a0, b0); cvt_store(c, F.lane, a0, b0, lw); }
    unsigned* ctr = F.w<unsigned>(WS_CTL) + CW_CVQ;
    for (;;) {
        unsigned tb = 0;
        if (F.lane == 0) tb = atomicAdd(ctr, 4u);
        tb = __builtin_amdgcn_readfirstlane(tb);
        if (tb >= 16384u + 8192u) break;
        for (int t = (int)tb; t < (int)tb + 4; ++t) {
            CvtTile c; c.f8 = true;
            if (t < 16384) { const int le = t >> 8, r = t & 255; c.n0 = (r >> 3) * 64; c.k0 = (r & 7) * 128; c.src = F.in[I_WGU] + (size_t)le * 1024 * 2048; c.ld = 2048; c.mode = 2; c.dst = (bf16_t*)(F.w<unsigned char>(WS_WGUT) + (size_t)le * 2048 * D); }
            else { const int q = t - 16384, le = q >> 7, r = q & 127; c.n0 = (r >> 3) * 64; c.k0 = (r & 7) * 128; c.src = F.in[I_WDN] + (size_t)le * D * D; c.ld = 1024; c.mode = 0; c.dst = (bf16_t*)(F.w<unsigned char>(WS_WDT) + (size_t)le * D * D); }
            cvt_load(c, F.lane, a0, b0);
            CvtTile c2 = c; c2.k0 = c.k0 + 64;
            cvt_load(c2, F.lane, a1, b1);
            cvt_store8x2(c, F.lane, a0, b0, a1, b1, lw);
        }
    }
}

__device__ __forceinline__ void ph_modpart(const Frame& F) {
    for (int it = F.bid; it < 768; it += F.G) {
        const int l = it / 384, r = it % 384, cc = r / 32, kc = r % 32;
        const int j = cc * 512 + F.tid;
        const float* wm = F.in[I_WMOD] + (size_t)l * D * 6144 + (size_t)(kc * 32) * 6144 + j;
        float wv[32];
#pragma unroll
        for (int k = 0; k < 32; ++k) wv[k] = wm[(size_t)k * 6144];
        float a0 = 0.f, a1 = 0.f;
#pragma unroll
        for (int k = 0; k < 32; ++k) { a0 += silu_f(F.in[I_C][kc * 32 + k]) * wv[k]; a1 += silu_f(F.in[I_CCTX][kc * 32 + k]) * wv[k]; }
        float* mp = F.w<float>(WS_MODP);
        mp[(size_t)((l * 2 + 0) * 32 + kc) * 6144 + j] = a0;
        mp[(size_t)((l * 2 + 1) * 32 + kc) * 6144 + j] = a1;
    }
}

__device__ __forceinline__ void ph_filter(const Frame& F) {
    LAS float* zs = (LAS float*)F.lds;
    LAS float* h1 = zs + 64 * 33;
    LAS unsigned char* H2b = F.lds + 24832;
    LAS unsigned char* ob = F.lds + 34048;
    LAS float* w1s = (LAS float*)(F.lds + 68864);
    LAS float* w2s = w1s + 33 * 64;
    const float min_decay = -4.605170185988091f / 1.5f, max_decay = -4.605170185988091f / 0.3f;
    const int wave = F.wave;
    const int nf = F.G < PRO_NF ? F.G : PRO_NF;
    if (F.bid >= nf) return;
    for (int it = F.bid; it < 512 + 16; it += nf) {
        int tid = F.tid; asm volatile("" : "+v"(tid));
        const int lane = tid & 63;
        const bool isctx = it >= 512;
        const int l = isctx ? 0 : it / 256, grp = isctx ? it - 512 : it % 256;
        const int Lx = isctx ? LC : L, npos = isctx ? 16 : 64;
        const int t0 = grp * npos;
        __syncthreads();
        for (int q = tid; q < 33 * 64 + 64 * 64; q += NTHREADS) { if (q < 33 * 64) w1s[q] = F.in[I_FW1][(size_t)l * 33 * 64 + q]; else w2s[q - 33 * 64] = F.in[I_FW2][(size_t)l * 64 * 64 + q - 33 * 64]; }
#pragma unroll 1
        for (int q = tid; q < npos * 33; q += NTHREADS) {
            const int pos = q / 33, i = q % 33; const int t = t0 + pos;
            const float tn = (float)t / (float)(Lx - 1);
            const float wv = 6.283185307179586f * (float)t / (float)Lx;
            float v;
            if (i == 0) v = tn;
            else { const int b = (i - 1) & 15; const float f = 1e-4f + (float)b * ((15.0f - 1e-4f) / 15.0f); v = (i <= 16) ? cosf(f * wv) : -sinf(f * wv); }
            zs[q] = v;
        }
        __syncthreads();
        {
            asm volatile("" : "+v"(tid));
            const int o = tid & 63, pg = tid >> 6;
            if (pg * 8 < npos) {
                float acc[8];
                const float bb = F.in[I_FB1][l * 64 + o];
#pragma unroll
                for (int p = 0; p < 8; ++p) acc[p] = bb;
#pragma unroll 3
                for (int i = 0; i < 33; ++i) { const float w = w1s[i * 64 + o];
#pragma unroll
                    for (int p = 0; p < 8; ++p) acc[p] += zs[(pg * 8 + p) * 33 + i] * w; }
                const float fq = F.in[I_FREQ][l * 128 + o];
#pragma unroll
                for (int p = 0; p < 8; ++p) h1[(pg * 8 + p) * 64 + o] = sinf(fq * acc[p]);
            }
        }
        __syncthreads();
        {
            asm volatile("" : "+v"(tid));
            const int o = tid & 63, pg = tid >> 6;
            if (pg * 8 < npos) {
                float acc[8];
                const float bb = F.in[I_FB2][l * 64 + o];
#pragma unroll
                for (int p = 0; p < 8; ++p) acc[p] = bb;
#pragma unroll 4
                for (int i = 0; i < 64; ++i) { const float w = w2s[i * 64 + o];
#pragma unroll
                    for (int p = 0; p < 8; ++p) acc[p] += h1[(pg * 8 + p) * 64 + i] * w; }
                const float fq = F.in[I_FREQ][l * 128 + 64 + o];
#pragma unroll
                for (int p = 0; p < 8; ++p) *(LAS bf16_t*)(H2b + (pg * 8 + p) * 144 + o * 2) = f2bf(sinf(fq * acc[p]));
            }
        }
        __syncthreads();
        {
            int r = lane & 31, hf = lane >> 5;
#pragma unroll
            for (int n = 0; n < 2; ++n) {
                asm volatile("" : "+v"(r), "+v"(hf));
                const int o = 32 * (2 * wave + n) + r, c = o & 255, dir = o >> 8;
                const float* w3 = F.in[I_FW3] + (size_t)l * 64 * 512 + o;
                f32x16 acc[2];
#pragma unroll
                for (int m = 0; m < 2; ++m)
#pragma unroll
                    for (int i = 0; i < 16; ++i) acc[m][i] = 0.f;
                float wv[4][8];
#pragma unroll
                for (int ks = 0; ks < 4; ++ks)
#pragma unroll
                    for (int e = 0; e < 8; ++e) wv[ks][e] = w3[(size_t)(16 * ks + 8 * hf + e) * 512];
#pragma unroll
                for (int ks = 0; ks < 4; ++ks) {
                    bf16x8 b;
#pragma unroll
                    for (int e = 0; e < 8; ++e) b[e] = (short)f2bf(wv[ks][e]);
#pragma unroll
                    for (int m = 0; m < 2; ++m) {
                        const bf16x8 a = *(const LAS bf16x8*)(H2b + (32 * m + r) * 144 + (16 * ks + 8 * hf) * 2);
                        acc[m] = __builtin_amdgcn_mfma_f32_32x32x16_bf16(a, b, acc[m], 0, 0, 0);
                    }
                }
                const float delta = fabsf(min_decay + (float)c * ((max_decay - min_decay) / 255.0f));
                const float dstep = delta / (float)(Lx - 1);
                float asum = 0.f;
                if (!isctx) {
#pragma unroll
                    for (int m = 0; m < 2; ++m)
#pragma unroll
                        for (int rg = 0; rg < 16; ++rg) {
                            const int pos = 32 * m + (rg & 3) + 8 * (rg >> 2) + 4 * hf;
                            const float v = acc[m][rg] * __expf(-(float)(t0 + pos) * dstep);
                            asum += fabsf(v);
                            ob[o * 68 + pos] = (unsigned char)(pk_fp8x4(KR_SCALE * v, 0.f, 0.f, 0.f) & 0xFFu);
                        }
                } else {
                    float* kc = F.w<float>(WS_KCOMBC);
#pragma unroll
                    for (int rg = 0; rg < 8; ++rg) {
                        const int pos = (rg & 3) + 8 * (rg >> 2) + 4 * hf, t = t0 + pos;
                        const float v = acc[0][rg] * __expf(-(float)t * dstep);
                        asum += fabsf(v);
                        const int x = dir == 0 ? Lx - 1 + t : Lx - 1 - t;
                        if (dir == 0 || t >= 1) kc[(size_t)x * 256 + c] = v;
                    }
                }
                asum += __shfl_xor(asum, 32);
                if (hf == 0) { if (isctx) F.w<float>(WS_FPARTC)[grp * 512 + o] = asum; else F.w<float>(WS_FPART)[((size_t)l * 256 + grp) * 512 + o] = asum; }
            }
        }
        if (!isctx) {
            __syncthreads();
            unsigned char* KR = F.w<unsigned char>(WS_KR) + (size_t)l * 256 * KRL;
            asm volatile("" : "+v"(tid));
            for (int q = tid; q < 512 * 64; q += NTHREADS) {
                const int o = q >> 6, p = q & 63, c = o & 255, dir = o >> 8;
                if (dir == 0) KR[(size_t)c * KRL + (L - t0 - 63 + p)] = ob[o * 68 + 63 - p];
                else if (t0 + p >= 1) KR[(size_t)c * KRL + (L + t0 + p)] = ob[o * 68 + p];
            }
            if (grp == 0) for (int q = tid; q < 256 * 513; q += NTHREADS) { const int c = q / 513, r = q % 513; KR[(size_t)c * KRL + (r == 512 ? 0 : 2 * L + r)] = 0; }
        }
    }
}

__device__ __forceinline__ void ph_fsum(const Frame& F) {
    const int nwaves = F.G * 8;
    for (int o = F.bid * 8 + F.wave; o < 768; o += nwaves) {
        const int which = o >> 8, c = o & 255;
        float s = 0.f;
        if (which < 2) { const float* fp = F.w<float>(WS_FPART) + (size_t)which * 256 * 512;
            for (int i = F.lane; i < 256; i += 64) s += fp[(size_t)i * 512 + c] + fp[(size_t)i * 512 + 256 + c]; }
        else { const float* fp = F.w<float>(WS_FPARTC); if (F.lane < 16) s = fp[F.lane * 512 + c] + fp[F.lane * 512 + 256 + c]; }
        s = wave_sum(s);
        if (F.lane == 0) F.w<float>(WS_FSUM)[o] = 1.0f / s;
    }
}

__device__ __forceinline__ void ph_vecs(const Frame& F) {
    for (int q = F.bid * NTHREADS + F.tid; q < 2 * 2 * 6 * 1024; q += F.G * NTHREADS) {
        const int j = q & 1023, k = (q >> 10) % 6, which = ((q >> 10) / 6) & 1, l = (q >> 10) / 12;
        const float* ng = F.in[I_NORMG] + (size_t)l * 4 * 1024;
        float v;
        if (k == 0) v = ng[j] * (1.0f + mod_val(F, l, which, 1 * 1024 + j));
        else if (k == 1) v = mod_val(F, l, which, j);
        else if (k == 2) v = ng[1024 + j] * mod_val(F, l, which, 2 * 1024 + j);
        else if (k == 3) v = ng[2048 + j] * (1.0f + mod_val(F, l, which, 4 * 1024 + j));
        else if (k == 4) v = mod_val(F, l, which, 3 * 1024 + j);
        else v = ng[3072 + j] * mod_val(F, l, which, 5 * 1024 + j);
        F.w<float>(WS_VECS)[q] = v;
    }
}
__device__ __forceinline__ const float* vecs_ptr(const Frame& F, int l, int which, int k) { return F.w<float>(WS_VECS) + (size_t)((l * 2 + which) * 6 + k) * 1024; }

__device__ __forceinline__ void load_row(const float* p, int lane, f32x4 (&v)[4]) {
#pragma unroll
    for (int i = 0; i < 4; ++i) v[i] = *(const f32x4*)(p + 4 * lane + 256 * i);
}
__device__ __forceinline__ float row_rstd(const f32x4 (&v)[4]) {
    float s = 0.f;
#pragma unroll
    for (int i = 0; i < 4; ++i) s += v[i][0] * v[i][0] + v[i][1] * v[i][1] + v[i][2] * v[i][2] + v[i][3] * v[i][3];
    s = wave_sum(s);
    return rsqrtf(s * (1.0f / 1024.0f) + RMS_EPS);
}
__device__ __forceinline__ void stage_norm_vecs(const Frame& F, int l, int gain_idx, int sh_seg, int sc_seg, LAS float* dst  ) {
    for (int q = F.tid; q < 2048; q += NTHREADS) {
        const int which = q >> 10, j = q & 1023;
        const float g = F.in[I_NORMG][(l * 4 + gain_idx) * 1024 + j];
        dst[(which * 2 + 0) * 1024 + j] = g * (1.0f + mod_val(F, l, which, sc_seg * 1024 + j));
        dst[(which * 2 + 1) * 1024 + j] = mod_val(F, l, which, sh_seg * 1024 + j);
    }
}
__device__ __forceinline__ void norm_store_bf16(const f32x4 (&v)[4], float rstd, const LAS float* va, const LAS float* vb, bf16_t* orow, int lane, bool f8 = false) {
#pragma unroll
    for (int i = 0; i < 4; ++i) {
        const int c = 4 * lane + 256 * i;
        const f32x4 a = *(const LAS f32x4*)(va + c), b = *(const LAS f32x4*)(vb + c);
        if (f8) { *(unsigned*)((unsigned char*)orow + c) = pk_fp8x4(v[i][0] * rstd * a[0] + b[0], v[i][1] * rstd * a[1] + b[1], v[i][2] * rstd * a[2] + b[2], v[i][3] * rstd * a[3] + b[3]); }
        else { u32x2 w; w.x = pk_bf16(v[i][0] * rstd * a[0] + b[0], v[i][1] * rstd * a[1] + b[1]); w.y = pk_bf16(v[i][2] * rstd * a[2] + b[2], v[i][3] * rstd * a[3] + b[3]);
        *(u32x2*)(orow + c) = w; }
    }
}
__device__ __forceinline__ const float* xrow_ptr(const Frame& F, int l, int row) {
    if (l == 0) return row < L ? F.in[I_X] + (size_t)row * D : F.in[I_CTX] + (size_t)(row - L) * D;
    return F.w<float>(WS_XCUR) + (size_t)row * D;
}
__device__ __forceinline__ void load_xrow(const Frame& F, int l, int row, int lane, f32x4 (&v)[4]) {
    if (l == 0) { load_row(row < L ? F.in[I_X] + (size_t)row * D : F.in[I_CTX] + (size_t)(row - L) * D, lane, v); return; }
    const bf16_t* p = F.w<bf16_t>(WS_XCUR) + (size_t)row * D;
#pragma unroll
    for (int i = 0; i < 4; ++i) { const u32x2 w = *(const u32x2*)(p + 4 * lane + 256 * i); v[i] = (f32x4){bflo(w.x), bfhi(w.x), bflo(w.y), bfhi(w.y)}; }
}
__device__ __forceinline__ void store_xrow_bf16(bf16_t* p, int lane, const f32x4 (&v)[4]) {
#pragma unroll
    for (int i = 0; i < 4; ++i) { u32x2 w; w.x = pk_bf16(v[i][0], v[i][1]); w.y = pk_bf16(v[i][2], v[i][3]); *(u32x2*)(p + 4 * lane + 256 * i) = w; }
}
__device__ __forceinline__ void ph_norm1(const Frame& F, int l) {
    LAS float* vec = (LAS float*)F.lds;
    __syncthreads();
    stage_norm_vecs(F, l, 0, 0, 1, vec);
    __syncthreads();
    const int nwaves = F.G * 8;
    for (int row = F.bid * 8 + F.wave; row < T; row += nwaves) {
        const int which = row >= L;
        f32x4 v[4]; load_row(xrow_ptr(F, l, row), F.lane, v);
        const float rstd = row_rstd(v);
        norm_store_bf16(v, rstd, vec + (which * 2) * 1024, vec + (which * 2 + 1) * 1024, F8IN(0) ? (bf16_t*)(F.w<unsigned char>(WS_HB) + (size_t)row * D) : F.w<bf16_t>(WS_HB) + (size_t)row * D, F.lane, F8IN(0) != 0);
    }
}

constexpr int SROW = 272;
__device__ __forceinline__ bf16x8 lds_frag(const LAS unsigned char* base, int row, int k) { return *(const LAS bf16x8*)(base + row * SROW + k * 2); }
__device__ __forceinline__ void ph_ssd_prep(const Frame& F, int l) {
    LAS unsigned char* BT = F.lds;
    LAS unsigned char* XW = F.lds + 34816;
    LAS float* dts = (LAS float*)(F.lds + 139264);
    LAS float* wj  = dts + 768;
    const bf16_t* P = F.w<bf16_t>(WS_P);
    const int lane = F.lane, wave = F.wave;
    for (int it = F.bid; it < NCH * 2; it += F.G) {
        const int ch = it >> 1, g = it & 1;
        const int row0 = ch * 128;
        const int seq_lo = ch < 128 ? 0 : L, seq_hi = ch < 128 ? L : T;
        int r = lane & 31, hf = lane >> 5; asm volatile("" : "+v"(r), "+v"(hf));
        __syncthreads();
        if (wave < 6) {
            const int hh = wave >> 1, dir = wave & 1, h = g * 3 + hh;
            const float a = -__expf(F.in[I_ALOG][(l * 2 + dir) * 6 + h]), bias = F.in[I_DTB][(l * 2 + dir) * 6 + h];
            const int j0 = 2 * lane;
            const float d0 = softplus_f(bf2f(P[(size_t)(row0 + j0) * PC + CDT + dir * 6 + h]) + bias);
            const float d1 = softplus_f(bf2f(P[(size_t)(row0 + j0 + 1) * PC + CDT + dir * 6 + h]) + bias);
            const float pair = (d0 + d1) * a;
            float incl = pair;
#pragma unroll
            for (int o = 1; o < 64; o <<= 1) {
                const float v = dir == 0 ? __shfl_up(incl, o) : __shfl_down(incl, o);
                const bool okl = dir == 0 ? (lane >= o) : (lane + o < 64);
                if (okl) incl += v;
            }
            const float total = __shfl(incl, dir == 0 ? 63 : 0);
            float acs0, acs1;
            if (dir == 0) { acs1 = incl; acs0 = incl - d1 * a; }
            else { acs0 = incl; acs1 = incl - d0 * a; }
            float* dtv = F.w<float>(WS_DTV) + (size_t)(row0 + j0) * 12 + dir * 6 + h; dtv[0] = d0; dtv[12] = d1;
            float* acv = F.w<float>(WS_ACS) + (size_t)(row0 + j0) * 12 + dir * 6 + h; acv[0] = acs0; acv[12] = acs1;
            if (lane == 0) F.w<float>(WS_ALAST)[ch * 12 + dir * 6 + h] = total;
            dts[wave * 128 + j0] = d0; dts[wave * 128 + j0 + 1] = d1;
            wj[wave * 128 + j0] = __expf(total - acs0) * d0; wj[wave * 128 + j0 + 1] = __expf(total - acs1) * d1;
        }
        __syncthreads();
        if (F.tid < 448) {
            const int pr = F.tid % 224, half = F.tid / 224;
            const int chn = pr < 96 ? g * 192 + 2 * pr : (pr < 160 ? 384 + g * 128 + 2 * (pr - 96) : 640 + g * 128 + 2 * (pr - 160));
            const float* cw = F.in[I_SCW] + (size_t)l * 5 * 896 + chn; const float* cb = F.in[I_SCB] + (size_t)l * 896 + chn;
            float w0[5], w1[5];
#pragma unroll
            for (int k = 0; k < 5; ++k) { w0[k] = cw[k * 896]; w1[k] = cw[k * 896 + 1]; }
            const float b0 = cb[0], b1 = cb[1];
            const int jb = half * 64;
            const bf16_t* src = P + CXBC + chn;
            unsigned win[12];
#pragma unroll
            for (int k = 0; k < 4; ++k) { const int rr = row0 + jb + k - 2; win[k] = (rr >= seq_lo && rr < seq_hi) ? *(const unsigned*)(src + (size_t)rr * PC) : 0u; }
            const int hh = pr / 32;
            const int pch = 2 * (pr & 31);
            for (int jg = 0; jg < 64; jg += 8) {
#pragma unroll
                for (int k = 0; k < 8; ++k) { const int rr = row0 + jb + jg + k + 2; win[4 + k] = (rr >= seq_lo && rr < seq_hi) ? *(const unsigned*)(src + (size_t)rr * PC) : 0u; }
                float s0[8], s1[8];
#pragma unroll
                for (int u = 0; u < 8; ++u) {
                    float a0 = b0, a1 = b1;
#pragma unroll
                    for (int k = 0; k < 5; ++k) { a0 += w0[k] * bflo(win[u + k]); a1 += w1[k] * bfhi(win[u + k]); }
                    s0[u] = silu_f(a0); s1[u] = silu_f(a1);
                    *(unsigned*)(F.w<bf16_t>(WS_XBC) + (size_t)(row0 + jb + jg + u) * 896 + chn) = pk_bf16(s0[u], s1[u]);
                }
#pragma unroll
                for (int k = 0; k < 4; ++k) win[k] = win[8 + k];
#pragma unroll
                for (int u = 0; u < 8; u += 2) {
                    const int j = jb + jg + u;
                    if (pr < 96) {
#pragma unroll
                        for (int dir = 0; dir < 2; ++dir) {
                            const float wa = wj[(hh * 2 + dir) * 128 + j], wb = wj[(hh * 2 + dir) * 128 + j + 1];
                            LAS unsigned char* d = XW + ((hh * 2 + dir) * 64 + pch) * SROW + j * 2;
                            *(LAS unsigned*)d = pk_bf16(s0[u] * wa, s0[u + 1] * wb);
                            *(LAS unsigned*)(d + SROW) = pk_bf16(s1[u] * wa, s1[u + 1] * wb);
                        }
                    } else if (pr < 160) {
                        LAS unsigned char* d = BT + (2 * (pr - 96)) * SROW + j * 2;
                        *(LAS unsigned*)d = pk_bf16(s0[u], s0[u + 1]);
                        *(LAS unsigned*)(d + SROW) = pk_bf16(s1[u], s1[u + 1]);
                    }
                }
            }
        }
        __syncthreads();
        {
            const int nt = wave & 3, pt = wave >> 2;
#pragma unroll 1
            for (int hh = 0; hh < 3; ++hh) {
                const int h = g * 3 + hh;
                f32x16 a0, a1;
#pragma unroll
                for (int i = 0; i < 16; ++i) { a0[i] = 0.f; a1[i] = 0.f; }
                const LAS unsigned char* X0 = XW + (hh * 2) * 64 * SROW;
#pragma unroll
                for (int ks = 0; ks < 8; ++ks) {
                    const bf16x8 a = lds_frag(BT, 32 * nt + r, 16 * ks + 8 * hf);
                    const bf16x8 b0 = lds_frag(X0, 32 * pt + r, 16 * ks + 8 * hf), b1 = lds_frag(X0, 64 + 32 * pt + r, 16 * ks + 8 * hf);
                    a0 = __builtin_amdgcn_mfma_f32_32x32x16_bf16(a, b0, a0, 0, 0, 0);
                    a1 = __builtin_amdgcn_mfma_f32_32x32x16_bf16(a, b1, a1, 0, 0, 0);
                }
                float* s0 = F.w<float>(WS_STATES) + ((size_t)(0 * NCH + ch) * 6 + h) * 8192 + (32 * pt + r) * 128 + 32 * nt + 4 * hf;
                float* s1 = F.w<float>(WS_STATES) + ((size_t)(1 * NCH + ch) * 6 + h) * 8192 + (32 * pt + r) * 128 + 32 * nt + 4 * hf;
#pragma unroll
                for (int gq = 0; gq < 4; ++gq) { *(f32x4*)(s0 + 8 * gq) = (f32x4){a0[4 * gq], a0[4 * gq + 1], a0[4 * gq + 2], a0[4 * gq + 3]};
                                                 *(f32x4*)(s1 + 8 * gq) = (f32x4){a1[4 * gq], a1[4 * gq + 1], a1[4 * gq + 2], a1[4 * gq + 3]}; }
            }
        }
    }
}

__device__ __forceinline__ void ph_ssd_scan(const Frame& F) {
    const int per = (98304 + F.G - 1) / F.G;
    for (int q = F.tid; q < per; q += NTHREADS) {
        const int id = F.bid * per + q;
        if (id >= 98304) break;
        const int dir = id / 49152, rem = id % 49152, h = rem / 8192, e = rem % 8192;
        const float* al = F.w<float>(WS_ALAST) + dir * 6 + h;
        const float* st = F.w<float>(WS_STATES) + ((size_t)(dir * NCH) * 6 + h) * 8192 + e;
        bf16_t* ss = F.w<bf16_t>(WS_SSTART) + ((size_t)(dir * NCH) * 6 + h) * 8192 + e;
        float sacc = 0.f;
        for (int s0 = 0; s0 < NCH; s0 += 26) {
            float sv[26], dv[26]; int cv[26];
#pragma unroll
            for (int u = 0; u < 26; ++u) {
                const int step = s0 + u;
                cv[u] = dir == 0 ? (step < 2 ? 128 + step : step - 2) : 129 - step;
                sv[u] = st[(size_t)cv[u] * 6 * 8192]; dv[u] = al[cv[u] * 12];
            }
#pragma unroll
            for (int u = 0; u < 26; ++u) { ss[(size_t)cv[u] * 6 * 8192] = f2bf(sacc); sacc = sacc * __expf(dv[u]) + sv[u]; }
        }
    }
}

__device__ __forceinline__ void ph_ssd_out(const Frame& F, int l) {
    LAS unsigned char* Cs = F.lds;
    LAS unsigned char* Bs = F.lds + 34816;
    LAS unsigned char* XT = F.lds + 69632;
    LAS float* Yl = (LAS float*)F.lds;
    LAS float* af = (LAS float*)(F.lds + 98816);
    LAS float* ab = af + 384, *dtf = ab + 384, *dtb = dtf + 384;
    LAS float* red = dtb + 384;
    const bf16_t* XBC = F.w<bf16_t>(WS_XBC);
    const bf16_t* P = F.w<bf16_t>(WS_P);
    const int nch = (l == 0) ? NCH : 128;
    const int lane = F.lane, wave = F.wave, r_in = lane & 31, hf_in = lane >> 5;
    const int it_ = wave & 3, jp = wave >> 2;
    for (int it = F.bid; it < nch * 2; it += F.G) {
        const int ch = it >> 1, g = it & 1, row0 = ch * 128;
        int r = r_in, hf = hf_in; asm volatile("" : "+v"(r), "+v"(hf));
        __syncthreads();
        for (int q = F.tid; q < 128 * 16; q += NTHREADS) {
            const int row = q >> 4, piece = q & 15;
            const bf16_t* src = XBC + (size_t)(row0 + row) * 896 + g * 128 + piece * 8;
            *(LAS u32x4*)(Bs + row * SROW + piece * 16) = *(const u32x4*)(src + 384);
            *(LAS u32x4*)(Cs + row * SROW + piece * 16) = *(const u32x4*)(src + 640);
        }
        for (int q = F.tid; q < 768; q += NTHREADS) {
            const int dir = q / 384, rr = q % 384, hh = rr >> 7, j = rr & 127;
            (dir ? ab : af)[hh * 128 + j] = F.w<float>(WS_ACS)[(size_t)(row0 + j) * 12 + dir * 6 + g * 3 + hh];
            (dir ? dtb : dtf)[hh * 128 + j] = F.w<float>(WS_DTV)[(size_t)(row0 + j) * 12 + dir * 6 + g * 3 + hh];
        }
        __syncthreads();
        f32x16 G0, G1;
#pragma unroll
        for (int i = 0; i < 16; ++i) { G0[i] = 0.f; G1[i] = 0.f; }
#pragma unroll
        for (int ks = 0; ks < 8; ++ks) {
            const bf16x8 a = lds_frag(Cs, 32 * it_ + r, 16 * ks + 8 * hf);
            const bf16x8 b0 = lds_frag(Bs, 64 * jp + r, 16 * ks + 8 * hf), b1 = lds_frag(Bs, 64 * jp + 32 + r, 16 * ks + 8 * hf);
            G0 = __builtin_amdgcn_mfma_f32_32x32x16_bf16(a, b0, G0, 0, 0, 0);
            G1 = __builtin_amdgcn_mfma_f32_32x32x16_bf16(a, b1, G1, 0, 0, 0);
        }
        f32x16 yacc[3];
#pragma unroll
        for (int hh = 0; hh < 3; ++hh) {
            const int h = g * 3 + hh;
            asm volatile("" : "+v"(r), "+v"(hf));
            __syncthreads();
#pragma unroll
            for (int tl = 0; tl < 2; ++tl) {
                const int j = 64 * jp + 32 * tl + r;
                const float afj = af[hh * 128 + j], abj = ab[hh * 128 + j], dfj = dtf[hh * 128 + j], dbj = dtb[hh * 128 + j];
#pragma unroll
                for (int rg = 0; rg < 16; ++rg) {
                    const int i = 32 * it_ + (rg & 3) + 8 * (rg >> 2) + 4 * hf;
                    const float mf = fminf(fmaxf((float)(i - j + 1), 0.f), 1.f), mb = fminf(fmaxf((float)(j - i + 1), 0.f), 1.f);
                    const float wf = __expf(fminf(af[hh * 128 + i] - afj, 0.f)) * dfj * mf;
                    const float wb = __expf(fminf(ab[hh * 128 + i] - abj, 0.f)) * dbj * mb;
                    const float gv = tl == 0 ? G0[rg] : G1[rg];
                    *(LAS bf16_t*)(Bs + i * SROW + j * 2) = f2bf(gv * (wf + wb));
                }
            }
            for (int q = F.tid; q < 128 * 8; q += NTHREADS) {
                const int j = q >> 3, pg = q & 7;
                const u32x4 v = *(const u32x4*)(XBC + (size_t)(row0 + j) * 896 + h * 64 + pg * 8);
                LAS unsigned char* d = XT + (pg * 8) * SROW + j * 2;
                *(LAS bf16_t*)(d + 0 * SROW) = (bf16_t)(v.x & 0xFFFF); *(LAS bf16_t*)(d + 1 * SROW) = (bf16_t)(v.x >> 16);
                *(LAS bf16_t*)(d + 2 * SROW) = (bf16_t)(v.y & 0xFFFF); *(LAS bf16_t*)(d + 3 * SROW) = (bf16_t)(v.y >> 16);
                *(LAS bf16_t*)(d + 4 * SROW) = (bf16_t)(v.z & 0xFFFF); *(LAS bf16_t*)(d + 5 * SROW) = (bf16_t)(v.z >> 16);
                *(LAS bf16_t*)(d + 6 * SROW) = (bf16_t)(v.w & 0xFFFF); *(LAS bf16_t*)(d + 7 * SROW) = (bf16_t)(v.w >> 16);
            }
            {
                f32x16 yF, yB;
#pragma unroll
                for (int i = 0; i < 16; ++i) { yF[i] = 0.f; yB[i] = 0.f; }
                const bf16_t* Sf = F.w<bf16_t>(WS_SSTART) + ((size_t)(0 * NCH + ch) * 6 + h) * 8192 + (32 * jp + r) * 128 + 8 * hf;
                const bf16_t* Sb = F.w<bf16_t>(WS_SSTART) + ((size_t)(1 * NCH + ch) * 6 + h) * 8192 + (32 * jp + r) * 128 + 8 * hf;
#pragma unroll 2
                for (int ks = 0; ks < 8; ++ks) {
                    const bf16x8 ac = lds_frag(Cs, 32 * it_ + r, 16 * ks + 8 * hf);
                    const bf16x8 bf_ = *(const bf16x8*)(Sf + 16 * ks), bb_ = *(const bf16x8*)(Sb + 16 * ks);
                    yF = __builtin_amdgcn_mfma_f32_32x32x16_bf16(ac, bf_, yF, 0, 0, 0);
                    yB = __builtin_amdgcn_mfma_f32_32x32x16_bf16(ac, bb_, yB, 0, 0, 0);
                }
#pragma unroll
                for (int rg = 0; rg < 16; ++rg) {
                    const int i = 32 * it_ + (rg & 3) + 8 * (rg >> 2) + 4 * hf;
                    yacc[hh][rg] = __expf(af[hh * 128 + i]) * yF[rg] + __expf(ab[hh * 128 + i]) * yB[rg];
                }
            }
            __syncthreads();
#pragma unroll 2
            for (int ks = 0; ks < 8; ++ks) {
                const bf16x8 aw = lds_frag(Bs, 32 * it_ + r, 16 * ks + 8 * hf), bx = lds_frag(XT, 32 * jp + r, 16 * ks + 8 * hf);
                yacc[hh] = __builtin_amdgcn_mfma_f32_32x32x16_bf16(aw, bx, yacc[hh], 0, 0, 0);
            }
        }
        __syncthreads();
#pragma unroll
        for (int hh = 0; hh < 3; ++hh)
#pragma unroll
            for (int rg = 0; rg < 16; ++rg) { const int i = 32 * it_ + (rg & 3) + 8 * (rg >> 2) + 4 * hf; Yl[i * 193 + hh * 64 + 32 * jp + r] = yacc[hh][rg]; }
        __syncthreads();
        const int i = F.tid & 127, pq = F.tid >> 7;
        float ssq = 0.f;
#pragma unroll 1
        for (int hh = 0; hh < 3; ++hh) {
            const int h = g * 3 + hh; const float dsk = F.in[I_SSDD][l * 6 + h];
            const int chn = h * 64 + pq * 16;
            const u32x4 xa = *(const u32x4*)(XBC + (size_t)(row0 + i) * 896 + chn), xb = *(const u32x4*)(XBC + (size_t)(row0 + i) * 896 + chn + 8);
            const u32x4 za = *(const u32x4*)(P + (size_t)(row0 + i) * PC + CZ + chn), zb = *(const u32x4*)(P + (size_t)(row0 + i) * PC + CZ + chn + 8);
            const unsigned xw_[8] = {xa.x, xa.y, xa.z, xa.w, xb.x, xb.y, xb.z, xb.w}, zw_[8] = {za.x, za.y, za.z, za.w, zb.x, zb.y, zb.z, zb.w};
            LAS float* yr = Yl + i * 193 + hh * 64 + pq * 16;
#pragma unroll
            for (int p2 = 0; p2 < 8; ++p2) {
                const float v0 = (yr[2 * p2] + dsk * bflo(xw_[p2])) * silu_f(bflo(zw_[p2]));
                const float v1 = (yr[2 * p2 + 1] + dsk * bfhi(xw_[p2])) * silu_f(bfhi(zw_[p2]));
                yr[2 * p2] = v0; yr[2 * p2 + 1] = v1; ssq += v0 * v0 + v1 * v1;
            }
        }
        red[pq * 128 + i] = ssq;
        __syncthreads();
        const float tot = red[i] + red[128 + i] + red[256 + i] + red[384 + i];
        const float rstd = rsqrtf(tot * (1.0f / 192.0f) + RMS_EPS);
#pragma unroll 1
        for (int hh = 0; hh < 3; ++hh) {
            const int h = g * 3 + hh;
            bf16_t* o = F.w<bf16_t>(WS_MIX) + (size_t)(row0 + i) * D + h * 64 + pq * 16;
            const float* ng = F.in[I_SSDNG] + l * 384 + h * 64 + pq * 16;
            const LAS float* yr = Yl + i * 193 + hh * 64 + pq * 16;
            unsigned wv[8];
#pragma unroll
            for (int p2 = 0; p2 < 8; ++p2) wv[p2] = pk_bf16(yr[2 * p2] * rstd * ng[2 * p2], yr[2 * p2 + 1] * rstd * ng[2 * p2 + 1]);
            *(u32x4*)o = (u32x4){wv[0], wv[1], wv[2], wv[3]}; *(u32x4*)(o + 8) = (u32x4){wv[4], wv[5], wv[6], wv[7]};
        }
    }
}

__device__ __forceinline__ int na_kv_off(int key, int piece) { return key * 128 + ((piece ^ (key & 7)) << 4); }
constexpr int NA_VP = 144;
__device__ __forceinline__ int na_v_off(int key, int piece) { return key * NA_VP + piece * 16; }
__device__ __forceinline__ void na_stage_kv(const Frame& F, const bf16_t* P, LAS unsigned char* Kd, LAS unsigned char* Vd, int h, bool local, int r0, int kc0) {
    for (int q = F.tid; q < 256 * 8; q += NTHREADS) {
        const int key = q >> 3, piece = q & 7;
        const int krow = local ? (r0 + (key >> 5)) * 64 + kc0 + (key & 31) : L + key;
        const bf16_t* src = P + (size_t)krow * PC + h * 64 + piece * 8;
        *(LAS u32x4*)(Kd + na_kv_off(key, piece)) = *(const u32x4*)(src + CK);
        *(LAS u32x4*)(Vd + na_v_off(key, piece)) = *(const u32x4*)(src + CV);
    }
}
__device__ __forceinline__ void bar_lds() { asm volatile("s_waitcnt lgkmcnt(0)" ::: "memory"); __builtin_amdgcn_s_barrier(); asm volatile("" ::: "memory"); }
struct NaItem { int h, r, cg, r0, kc0, qrow0; bool isctx; };
__device__ __forceinline__ NaItem na_item(int cid, int i_lo, int i_hi, int k) {
    NaItem t; t.isctx = (i_lo + k >= i_hi); t.r = 0; t.r0 = 0; t.kc0 = 0;
    if (!t.isctx) { const int it = i_lo + k; t.h = it >> 10; t.cg = (it >> 8) & 3; t.r = it & 255; t.r0 = min(max(t.r - 4, 0), 248); t.kc0 = min(max(16 * t.cg - 8, 0), 32); t.qrow0 = t.r * 64 + t.cg * 16; }
    else { t.h = cid >> 4; t.cg = cid & 15; t.qrow0 = L + t.cg * 16; }
    return t;
}
__device__ __forceinline__ void ph_na(const Frame& F, int l, int part) {
    LAS unsigned char* Kc = F.lds;
    LAS unsigned char* Vc = F.lds + 32768;
    LAS unsigned char* Kl = F.lds + 69632;
    LAS unsigned char* Vl = F.lds + 102400;
    LAS unsigned char* Qs = F.lds + 139264;
    LAS unsigned char* Pw = F.lds + 141312;
    LAS float* ml = (LAS float*)(F.lds + 159744);
    LAS float* bt = ml + 256;
    const bf16_t* P = F.w<bf16_t>(WS_P);
    const float* rpb = F.in[I_RPB] + (size_t)l * 15 * 31 * 6;
    const int nlat = 6 * 256 * 4;
    const int nB = (l == 0) ? 2520 : 0, nA = nlat - nB;
    const int lane = F.lane, wave = F.wave, c16 = lane & 15, kq = lane >> 4;
    const float scale = 0.125f;
    int cur_h = -1;
    const float ws = part == 0 ? (l == 0 ? 0.45f : 0.67f) : 0.0f;
    const int nP = part == 0 ? nA : nB, base = part == 0 ? 0 : nA;
    const float Wtot = 4.0f * ws + (float)(F.G - 4);
    const float W0 = F.bid < 4 ? F.bid * ws : 4.0f * ws + (float)(F.bid - 4), W1 = F.bid < 3 ? (F.bid + 1) * ws : 4.0f * ws + (float)(F.bid - 3);
    const int i_lo = base + (int)((float)nP * W0 / Wtot + 0.5f), i_hi = (F.bid == F.G - 1) ? base + nP : base + (int)((float)nP * W1 / Wtot + 0.5f);
    const int cid = (l == 0 && part == 0 && F.bid >= 100 && F.bid < 196) ? F.bid - 100 : -1;
    const int n_mine = max(0, i_hi - i_lo) + (cid >= 0 ? 1 : 0);
    u32x4 kreg[4], vreg[4], qreg; float breg = 0.f;
    const int pkey = F.tid >> 3, ppiece = F.tid & 7;
#define NA_PREFETCH(T) do { if (!(T).isctx) { _Pragma("unroll") for (int u = 0; u < 4; ++u) { const int key = pkey + 64 * u; \
            const bf16_t* src = P + (size_t)(((T).r0 + (key >> 5)) * 64 + (T).kc0 + (key & 31)) * PC + (T).h * 64 + ppiece * 8; \
            kreg[u] = *(const u32x4*)(src + CK); vreg[u] = *(const u32x4*)(src + CV); } \
            if (F.tid < 256 && (F.tid & 31) < 31) breg = rpb[(((T).r0 + (F.tid >> 5) - (T).r + 7) * 31 + (F.tid & 31)) * 6 + (T).h]; } \
        if (F.tid < 128) qreg = *(const u32x4*)(P + (size_t)((T).qrow0 + pkey) * PC + CQ + (T).h * 64 + ppiece * 8); } while (0)
    if (n_mine > 0) { const NaItem t0 = na_item(cid, i_lo, i_hi, 0); NA_PREFETCH(t0); }
    for (int k = 0; k < n_mine; ++k) {
        const NaItem t = na_item(cid, i_lo, i_hi, k);
        const bool isctx = t.isctx; const int h = t.h, cg = t.cg, kc0 = t.kc0, qrow0 = t.qrow0;
        if (k == 0) bar_lds();
        if (h != cur_h) { na_stage_kv(F, P, Kc, Vc, h, false, 0, 0); cur_h = h; }
        if (!isctx) {
#pragma unroll
            for (int u = 0; u < 4; ++u) { const int key = pkey + 64 * u; *(LAS u32x4*)(Kl + na_kv_off(key, ppiece)) = kreg[u]; *(LAS u32x4*)(Vl + na_v_off(key, ppiece)) = vreg[u]; }
            if (F.tid < 256) bt[F.tid] = breg;
        }
        if (F.tid < 128) *(LAS u32x4*)(Qs + na_kv_off(pkey, ppiece)) = qreg;
        if (k + 1 < n_mine) { const NaItem tn = na_item(cid, i_lo, i_hi, k + 1); NA_PREFETCH(tn); }
        bar_lds();
        const bool loc = wave < 4;
        const LAS unsigned char* Kb = loc ? Kl : Kc;
        const LAS unsigned char* Vb = loc ? Vl : Vc;
        const int kbase = (wave & 3) * 64;
        LAS unsigned char* pw = Pw + wave * 2304;
        float mw[4], lw[4];
        if (!(loc && isctx)) {
            f32x4 sacc[4];
#pragma unroll
            for (int nt = 0; nt < 4; ++nt) sacc[nt] = (f32x4){0.f, 0.f, 0.f, 0.f};
#pragma unroll
            for (int ks = 0; ks < 2; ++ks) {
                const bf16x8 a = *(const LAS bf16x8*)(Qs + na_kv_off(c16, 4 * ks + kq));
#pragma unroll
                for (int nt = 0; nt < 4; ++nt) {
                    const bf16x8 b = *(const LAS bf16x8*)(Kb + na_kv_off(kbase + 16 * nt + c16, 4 * ks + kq));
                    sacc[nt] = __builtin_amdgcn_mfma_f32_16x16x32_bf16(a, b, sacc[nt], 0, 0, 0);
                }
            }
#pragma unroll
            for (int rg = 0; rg < 4; ++rg) mw[rg] = -INFINITY;
#pragma unroll
            for (int nt = 0; nt < 4; ++nt) {
                const int kk = kbase + 16 * nt + c16;
#pragma unroll
                for (int rg = 0; rg < 4; ++rg) {
                    float sv = sacc[nt][rg] * scale;
                    if (loc) {
                        const int qi = 4 * kq + rg, qcol = cg * 16 + qi, cstart = min(max(qcol - 8, 0), 48);
                        const int krow = kk >> 5, kcol = kc0 + (kk & 31);
                        const bool ok = (kcol >= cstart) && (kcol < cstart + 16);
                        const int dc = min(max(kcol - qcol + 15, 0), 30);
                        sv = ok ? sv + bt[krow * 32 + dc] : -INFINITY;
                    }
                    sacc[nt][rg] = sv; mw[rg] = fmaxf(mw[rg], sv);
                }
            }
#pragma unroll
            for (int rg = 0; rg < 4; ++rg) {
                mw[rg] = row16_max(mw[rg]);
                lw[rg] = 0.f;
            }
#pragma unroll
            for (int nt = 0; nt < 4; ++nt) {
#pragma unroll
                for (int rg = 0; rg < 4; ++rg) {
                    const float msafe = mw[rg] == -INFINITY ? 0.f : mw[rg];
                    const float pv = __expf(sacc[nt][rg] - msafe);
                    lw[rg] += pv;
                    *(LAS bf16_t*)(pw + (4 * kq + rg) * 144 + (16 * nt + c16) * 2) = f2bf(pv);
                }
            }
#pragma unroll
            for (int rg = 0; rg < 4; ++rg) {
                lw[rg] = row16_sum(lw[rg]);
            }
            lds_fence();
            f32x4 oacc[4];
#pragma unroll
            for (int dt = 0; dt < 4; ++dt) oacc[dt] = (f32x4){0.f, 0.f, 0.f, 0.f};
            {
                const unsigned vaddr = (unsigned)(unsigned long long)(Vb + (kbase + 8 * kq + (c16 >> 2)) * NA_VP + 8 * (c16 & 3));
                u32x2 t[2][4][2];
                asm volatile(
                    "ds_read_b64_tr_b16 %0, %16 offset:0\n\tds_read_b64_tr_b16 %1, %16 offset:576\n\t"
                    "ds_read_b64_tr_b16 %2, %16 offset:32\n\tds_read_b64_tr_b16 %3, %16 offset:608\n\t"
                    "ds_read_b64_tr_b16 %4, %16 offset:64\n\tds_read_b64_tr_b16 %5, %16 offset:640\n\t"
                    "ds_read_b64_tr_b16 %6, %16 offset:96\n\tds_read_b64_tr_b16 %7, %16 offset:672\n\t"
                    "ds_read_b64_tr_b16 %8, %16 offset:4608\n\tds_read_b64_tr_b16 %9, %16 offset:5184\n\t"
                    "ds_read_b64_tr_b16 %10, %16 offset:4640\n\tds_read_b64_tr_b16 %11, %16 offset:5216\n\t"
                    "ds_read_b64_tr_b16 %12, %16 offset:4672\n\tds_read_b64_tr_b16 %13, %16 offset:5248\n\t"
                    "ds_read_b64_tr_b16 %14, %16 offset:4704\n\tds_read_b64_tr_b16 %15, %16 offset:5280\n\t"
                    "s_waitcnt lgkmcnt(0)"
                    : "=&v"(t[0][0][0]), "=&v"(t[0][0][1]), "=&v"(t[0][1][0]), "=&v"(t[0][1][1]), "=&v"(t[0][2][0]), "=&v"(t[0][2][1]), "=&v"(t[0][3][0]), "=&v"(t[0][3][1]),
                      "=&v"(t[1][0][0]), "=&v"(t[1][0][1]), "=&v"(t[1][1][0]), "=&v"(t[1][1][1]), "=&v"(t[1][2][0]), "=&v"(t[1][2][1]), "=&v"(t[1][3][0]), "=&v"(t[1][3][1])
                    : "v"(vaddr) : "memory");
#pragma unroll
                for (int ks = 0; ks < 2; ++ks) {
                    const bf16x8 a = *(const LAS bf16x8*)(pw + c16 * 144 + (32 * ks + 8 * kq) * 2);
#pragma unroll
                    for (int dt = 0; dt < 4; ++dt) {
                        const u32x4 bw = (u32x4){t[ks][dt][0].x, t[ks][dt][0].y, t[ks][dt][1].x, t[ks][dt][1].y};
                        oacc[dt] = __builtin_amdgcn_mfma_f32_16x16x32_bf16(a, __builtin_bit_cast(bf16x8, bw), oacc[dt], 0, 0, 0);
                    }
                }
            }
            lds_fence();
#pragma unroll
            for (int dt = 0; dt < 4; ++dt)
#pragma unroll
                for (int rg = 0; rg < 4; ++rg) *(LAS bf16_t*)(pw + (4 * kq + rg) * 144 + (16 * dt + c16) * 2) = f2bf(oacc[dt][rg]);
        } else {
#pragma unroll
            for (int rg = 0; rg < 4; ++rg) { mw[rg] = -INFINITY; lw[rg] = 0.f; }
            for (int q = lane; q < 16 * 36; q += 64) ((LAS unsigned*)pw)[q] = 0u;
        }
        if (c16 == 0) {
#pragma unroll
            for (int rg = 0; rg < 4; ++rg) { ml[(wave * 16 + 4 * kq + rg) * 2] = mw[rg]; ml[(wave * 16 + 4 * kq + rg) * 2 + 1] = lw[rg]; }
        }
        bar_lds();
        {
            const int qi = F.tid >> 5, dp = F.tid & 31;
            float M = -INFINITY;
#pragma unroll
            for (int w = 0; w < 8; ++w) M = fmaxf(M, ml[(w * 16 + qi) * 2]);
            float num0 = 0.f, num1 = 0.f, den = 0.f;
#pragma unroll
            for (int w = 0; w < 8; ++w) {
                const float sc = __expf(ml[(w * 16 + qi) * 2] - M);
                const unsigned ov = *(const LAS unsigned*)(Pw + w * 2304 + qi * 144 + dp * 4);
                num0 += sc * bflo(ov); num1 += sc * bfhi(ov); den += sc * ml[(w * 16 + qi) * 2 + 1];
            }
            const float inv = __builtin_amdgcn_rcpf(den);
            *(unsigned*)(F.w<bf16_t>(WS_MIX) + (size_t)(qrow0 + qi) * D + 384 + h * 64 + 2 * dp) = pk_bf16(num0 * inv, num1 * inv);
        }
    }
#undef NA_PREFETCH
}

__device__ __forceinline__ float hy_conv3(const bf16_t* P, const float* cw, const float* cb, int row, int seq_lo, int seq_hi, int col) {
    float s = cb[col];
#pragma unroll
    for (int k = 0; k < 3; ++k) { const int r = row + k - 1; if (r >= seq_lo && r < seq_hi) s += cw[k * 768 + col] * bf2f(P[(size_t)r * PC + CHY + col]); }
    return s;
}
__device__ __forceinline__ void ph_hy_prep(const Frame& F, int l) {
    const bf16_t* P = F.w<bf16_t>(WS_P);
    const float* cw = F.in[I_HCW] + (size_t)l * 3 * 768; const float* cb = F.in[I_HCB] + (size_t)l * 768;
    LAS unsigned* ut = (LAS unsigned*)F.lds;
    LAS unsigned* xt = ut + 256 * 33;
    const int cp = F.tid & 127, rq = F.tid >> 7;
    float w0[3][3], w1[3][3], b0[3], b1[3];
#pragma unroll
    for (int sg = 0; sg < 3; ++sg) { b0[sg] = cb[sg * 256 + 2 * cp]; b1[sg] = cb[sg * 256 + 2 * cp + 1];
#pragma unroll
        for (int k = 0; k < 3; ++k) { w0[sg][k] = cw[k * 768 + sg * 256 + 2 * cp]; w1[sg][k] = cw[k * 768 + sg * 256 + 2 * cp + 1]; } }
    for (int it = F.bid; it < L / 64; it += F.G) {
        const int t0 = it * 64, rb = t0 + rq * 16;
        __syncthreads();
        {
            unsigned win[3][18];
#pragma unroll
            for (int sg = 0; sg < 3; ++sg)
#pragma unroll
                for (int k = 0; k < 18; ++k) { const int rr = rb - 1 + k; win[sg][k] = (rr >= 0 && rr < L) ? *(const unsigned*)(P + (size_t)rr * PC + CHY + sg * 256 + 2 * cp) : 0u; }
#pragma unroll
            for (int jp = 0; jp < 8; ++jp) {
                float u0[2], u1[2], xa[2], xb[2];
#pragma unroll
                for (int q = 0; q < 2; ++q) {
                    const int k = 2 * jp + q;
                    float a0[3], a1[3];
#pragma unroll
                    for (int sg = 0; sg < 3; ++sg) {
                        a0[sg] = b0[sg] + w0[sg][0] * bflo(win[sg][k]) + w0[sg][1] * bflo(win[sg][k + 1]) + w0[sg][2] * bflo(win[sg][k + 2]);
                        a1[sg] = b1[sg] + w1[sg][0] * bfhi(win[sg][k]) + w1[sg][1] * bfhi(win[sg][k + 1]) + w1[sg][2] * bfhi(win[sg][k + 2]);
                    }
                    xa[q] = a0[0]; xb[q] = a1[0]; u0[q] = a0[2] * a0[1]; u1[q] = a1[2] * a1[1];
                }
                const int rp = rq * 8 + jp;
                ut[(2 * cp) * 33 + rp] = pk_bf16(u0[0], u0[1]); ut[(2 * cp + 1) * 33 + rp] = pk_bf16(u1[0], u1[1]);
                xt[(2 * cp) * 33 + rp] = pk_bf16(xa[0], xa[1]); xt[(2 * cp + 1) * 33 + rp] = pk_bf16(xb[0], xb[1]);
            }
        }
        __syncthreads();
        for (int q = F.tid; q < 256 * 8; q += NTHREADS) {
            const int c = q >> 3, g = q & 7;
            u32x4 a, b;
            a.x = ut[c * 33 + 4 * g]; a.y = ut[c * 33 + 4 * g + 1]; a.z = ut[c * 33 + 4 * g + 2]; a.w = ut[c * 33 + 4 * g + 3];
            b.x = xt[c * 33 + 4 * g]; b.y = xt[c * 33 + 4 * g + 1]; b.z = xt[c * 33 + 4 * g + 2]; b.w = xt[c * 33 + 4 * g + 3];
            *(u32x4*)(F.w<bf16_t>(WS_UT) + (size_t)c * L + t0 + 8 * g) = a;
            *(u32x4*)(F.w<bf16_t>(WS_X0T) + (size_t)c * L + t0 + 8 * g) = b;
            u32x2 a8; a8.x = pk_fp8x4(bflo(a.x), bfhi(a.x), bflo(a.y), bfhi(a.y)); a8.y = pk_fp8x4(bflo(a.z), bfhi(a.z), bflo(a.w), bfhi(a.w));
            *(u32x2*)(F.w<unsigned char>(WS_UT8) + (size_t)c * L + t0 + 8 * g) = a8;
        }
    }
    if (l == 0) {
        for (int rp = F.bid; rp < LC / 2; rp += F.G) {
            const int row = L + rp * 2 + (F.tid >> 8), c = F.tid & 255;
            const float x1 = hy_conv3(P, cw, cb, row, L, T, 256 + c), v = hy_conv3(P, cw, cb, row, L, T, 512 + c);
            F.w<float>(WS_U)[(size_t)row * 256 + c] = v * x1;
        }
    }
}
__device__ __forceinline__ void ph_hy_conv_ctx(const Frame& F, int l) {
    const bf16_t* P = F.w<bf16_t>(WS_P);
    const float* cw = F.in[I_HCW] + (size_t)l * 3 * 768; const float* cb = F.in[I_HCB] + (size_t)l * 768;
    for (int it = F.bid; it < 8; it += F.G) {
        const int Lx = LC, rbase = L;
        const int tb = it * 2 + (F.tid >> 8), c = F.tid & 255, t0 = tb * 16;
        const float* U = F.w<float>(WS_U) + (size_t)rbase * 256 + c;
        const float* KC = F.w<float>(WS_KCOMBC) + c;
        float acc[16], wreg[16];
#pragma unroll
        for (int j = 0; j < 16; ++j) { acc[j] = 0.f; wreg[j] = KC[(size_t)(t0 + j + Lx - 1) * 256]; }
        for (int s0 = 0; s0 < Lx; s0 += 16) {
            float ub[16], nb[16];
#pragma unroll
            for (int r = 0; r < 16; ++r) { ub[r] = U[(size_t)(s0 + r) * 256]; const int x = t0 - (s0 + r + 1) + Lx - 1; nb[r] = x >= 0 ? KC[(size_t)x * 256] : 0.f; }
#pragma unroll
            for (int r = 0; r < 16; ++r) {
#pragma unroll
                for (int j = 0; j < 16; ++j) acc[j] += ub[r] * wreg[(j - r) & 15];
                wreg[(15 - r) & 15] = nb[r];
            }
        }
        const float inv = F.w<float>(WS_FSUM)[2 * 256 + c];
        const float db = F.in[I_HYD][l * 256 + c];
#pragma unroll
        for (int j = 0; j < 16; ++j) {
            const int row = rbase + t0 + j;
            const float x0 = hy_conv3(P, cw, cb, row, L, T, c);
            const float u = F.w<float>(WS_U)[(size_t)row * 256 + c];
            F.w<bf16_t>(WS_MIX)[(size_t)row * D + 768 + c] = f2bf(x0 * (acc[j] * inv + u * db));
        }
    }
}

constexpr int HC_UP = 144, HC_UBYTES = 190 * HC_UP;
constexpr int HC_CPOFF = 27392, HC_NG = 83, HC_CPBYTES = 16 * HC_NG * 16;
__device__ __forceinline__ void hc_make_copies(LAS unsigned char* dst, const u32x4 g0, const u32x4 g1, int g) {
    const unsigned w[8] = {g0.x, g0.y, g0.z, g0.w, g1.x, g1.y, g1.z, g1.w};
#pragma unroll
    for (int sh = 0; sh < 16; ++sh) {
        const int b = sh >> 2, r = sh & 3;
        u32x4 o;
        if (r == 0) { o.x = w[b]; o.y = w[b + 1]; o.z = w[b + 2]; o.w = w[b + 3]; }
        else { o.x = __builtin_amdgcn_alignbyte(w[b + 1], w[b], r); o.y = __builtin_amdgcn_alignbyte(w[b + 2], w[b + 1], r);
               o.z = __builtin_amdgcn_alignbyte(w[b + 3], w[b + 2], r); o.w = __builtin_amdgcn_alignbyte(w[b + 4], w[b + 3], r); }
        *(LAS u32x4*)(dst + (sh * HC_NG + g) * 16) = o;
    }
}
__device__ __forceinline__ void ph_hy_conv(const Frame& F, int l) {
    LAS unsigned char* Ul = F.lds;
    LAS unsigned char* Cp = F.lds + HC_CPOFF;
    const int lane = F.lane, wave = F.wave;
    const int nt = wave < 4 ? wave : 7 - wave, par = wave >> 2;
    const int r = lane & 31, h = lane >> 5, sig = r & 15, rho = r >> 4;
    const int sh = (16 - sig) & 15, gofs = 2 * h - rho - (sig ? 1 : 0);
    const int a_lane = (sh * HC_NG + gofs) * 16;
    const int b_lane = r * HC_UP + h * 32;
    const int sclK = 0x79797979, sclU = ONE_E8M0;
    for (int c = F.bid; c < 256; c += F.G) {
        const unsigned char* KRc = F.w<unsigned char>(WS_KR) + ((size_t)l * 256 + c) * KRL;
        const unsigned char* U8c = F.w<unsigned char>(WS_UT8) + (size_t)c * L;
        const bf16_t* UTc = F.w<bf16_t>(WS_UT) + (size_t)c * L;
        __syncthreads();
        for (int q = F.tid; q < 190 * 8; q += NTHREADS) {
            const int blk = q >> 3, piece = q & 7;
            u32x4 v = (u32x4){0u, 0u, 0u, 0u};
            if (blk >= 31 && blk < 159) v = *(const u32x4*)(U8c + (size_t)(blk - 31) * 128 + piece * 16);
            *(LAS u32x4*)(Ul + blk * HC_UP + piece * 16) = v;
        }
        u32x4 g0 = (u32x4){0u, 0u, 0u, 0u}, g1 = g0;
        if (F.tid < HC_NG) { const unsigned char* src = KRc + 31744 + 16 * F.tid; g0 = *(const u32x4*)src; g1 = *(const u32x4*)(src + 16); }
        if (F.tid < HC_NG) hc_make_copies(Cp, g0, g1, F.tid);
        __syncthreads();
        f32x16 acc[4];
#pragma unroll
        for (int m = 0; m < 4; ++m)
#pragma unroll
            for (int i = 0; i < 16; ++i) acc[m][i] = 0.f;
        for (int ci = 0; ci < 32; ++ci) {
            const int Dc = -128 + 8 * ci;
            if (ci + 1 < 32 && F.tid < HC_NG) { const unsigned char* src = KRc + (31744 - 1024 * (ci + 1)) + 16 * F.tid; g0 = *(const u32x4*)src; g1 = *(const u32x4*)(src + 16); }
            const LAS unsigned char* cp = Cp + (ci & 1) * HC_CPBYTES + a_lane;
#pragma unroll 1
            for (int d2 = 0; d2 < 4; ++d2) {
                const int dd = 2 * d2 + par, Dv = Dc + dd;
                if (!((Dv >= 32 * nt - 127) && (Dv <= 32 * nt + 31) && (Dv > -128))) continue;
                const LAS unsigned char* ap = cp + (8 * (8 - dd)) * 16;
                const LAS unsigned char* bp = Ul + b_lane + (32 * nt - Dv + 31) * HC_UP;
                v8i af[6], bfr[2];
#pragma unroll
                for (int e = 0; e < 6; ++e) { const v4i x = *(const LAS v4i*)(ap - 2 * (e - 2) * 16), y = *(const LAS v4i*)(ap - 2 * (e - 2) * 16 + 16); af[e] = __builtin_shufflevector(x, y, 0, 1, 2, 3, 4, 5, 6, 7); }
#pragma unroll
                for (int ks = 0; ks < 2; ++ks) { const v4i x = *(const LAS v4i*)(bp + ks * 64), y = *(const LAS v4i*)(bp + ks * 64 + 16); bfr[ks] = __builtin_shufflevector(x, y, 0, 1, 2, 3, 4, 5, 6, 7); }
#pragma unroll
                for (int ks = 0; ks < 2; ++ks)
#pragma unroll
                    for (int m = 0; m < 4; ++m)
                        asm volatile("v_mfma_scale_f32_32x32x64_f8f6f4 %0, %1, %2, %0, %3, %4 op_sel_hi:[0,0,0]" : "+v"(acc[m]) : "v"(af[m - 2 * ks + 2]), "v"(bfr[ks]), "v"(sclK), "v"(sclU));
            }
            if (ci + 1 < 32 && F.tid < HC_NG) hc_make_copies(Cp + ((ci + 1) & 1) * HC_CPBYTES, g0, g1, F.tid);
            __syncthreads();
        }
        LAS float* Rd = (LAS float*)F.lds;
        if (wave >= 4) {
#pragma unroll
            for (int m = 0; m < 4; ++m)
#pragma unroll
                for (int i = 0; i < 16; ++i) Rd[(nt * 64 + m * 16 + i) * 64 + lane] = acc[m][i];
        }
        __syncthreads();
        if (wave < 4) {
#pragma unroll
            for (int m = 0; m < 4; ++m)
#pragma unroll
                for (int i = 0; i < 16; ++i) acc[m][i] += Rd[(nt * 64 + m * 16 + i) * 64 + lane];
            const float inv = F.w<float>(WS_FSUM)[l * 256 + c];
            const float db = F.in[I_HYD][l * 256 + c];
            const bf16_t* X0c = F.w<bf16_t>(WS_X0T) + (size_t)c * L;
            bf16_t* YTc = F.w<bf16_t>(WS_YT) + (size_t)c * L;
            const int I = 32 * nt + r;
#pragma unroll
            for (int m = 0; m < 4; ++m) {
#pragma unroll
                for (int g = 0; g < 4; ++g) {
                    const int t = 128 * I + 32 * m + 8 * g + 4 * h;
                    const u32x2 xv = *(const u32x2*)(X0c + t), uv = *(const u32x2*)(UTc + t);
                    float y[4];
#pragma unroll
                    for (int e = 0; e < 4; ++e) y[e] = acc[m][4 * g + e] * inv;
                    y[0] = bflo(xv.x) * (y[0] + bflo(uv.x) * db); y[1] = bfhi(xv.x) * (y[1] + bfhi(uv.x) * db);
                    y[2] = bflo(xv.y) * (y[2] + bflo(uv.y) * db); y[3] = bfhi(xv.y) * (y[3] + bfhi(uv.y) * db);
                    u32x2 o; o.x = pk_bf16(y[0], y[1]); o.y = pk_bf16(y[2], y[3]);
                    *(u32x2*)(YTc + t) = o;
                }
            }
        }
    }
}
__device__ __forceinline__ void ph_hy_tr(const Frame& F) {
    LAS unsigned* yt = (LAS unsigned*)F.lds;
    for (int it = F.bid; it < L / 64; it += F.G) {
        const int t0 = it * 64;
        __syncthreads();
        for (int q = F.tid; q < 256 * 8; q += NTHREADS) {
            const int c = q >> 3, g = q & 7;
            const u32x4 a = *(const u32x4*)(F.w<bf16_t>(WS_YT) + (size_t)c * L + t0 + 8 * g);
            yt[c * 33 + 4 * g] = a.x; yt[c * 33 + 4 * g + 1] = a.y; yt[c * 33 + 4 * g + 2] = a.z; yt[c * 33 + 4 * g + 3] = a.w;
        }
        __syncthreads();
        for (int q = F.tid; q < 64 * 32; q += NTHREADS) {
            const int row = q >> 5, cg = q & 31;
            const LAS unsigned short* ys = (const LAS unsigned short*)yt;
            unsigned short v[8];
#pragma unroll
            for (int e = 0; e < 8; ++e) v[e] = ys[((cg * 8 + e) * 33) * 2 + row];
            u32x4 o; o.x = v[0] | ((unsigned)v[1] << 16); o.y = v[2] | ((unsigned)v[3] << 16); o.z = v[4] | ((unsigned)v[5] << 16); o.w = v[6] | ((unsigned)v[7] << 16);
            *(u32x4*)(F.w<bf16_t>(WS_MIX) + (size_t)(t0 + row) * D + 768 + cg * 8) = o;
        }
    }
}

constexpr int WRP = 1028;
__device__ __forceinline__ void ph_post1(const Frame& F, int l) {
    LAS float* wr = (LAS float*)F.lds;
    LAS unsigned* lcnt = (LAS unsigned*)(F.lds + 32 * WRP * 4);
    __syncthreads();
    if (F.tid < 64) lcnt[F.tid] = 0u;
    {
        const f32x4* src = (const f32x4*)(F.in[I_WR] + (size_t)l * 1024 * 32);
        f32x4 v[16];
#pragma unroll
        for (int u = 0; u < 16; ++u) v[u] = src[F.tid + u * NTHREADS];
#pragma unroll
        for (int u = 0; u < 16; ++u) { const int q4 = F.tid + u * NTHREADS, k = q4 >> 3, e0 = (q4 & 7) * 4;
#pragma unroll
            for (int i = 0; i < 4; ++i) wr[(e0 + i) * WRP + k] = v[u][i]; }
    }
    __syncthreads();
    const int nrows = (l == 0) ? T : L;
    const int nwaves = F.G * 8, lane = F.lane;
    unsigned* cnt = F.w<unsigned>(WS_CTL) + CW_CNT + l * 1024;
    if (F.bid == 0) { for (int q = F.tid; q < D / 4; q += NTHREADS) ((unsigned*)(F.w<unsigned char>(WS_H2) + (size_t)T * D))[q] = 0u; }
    const float brl = F.in[I_BR][l * 32 + ((lane >> 1) & 31)];
    const int mye = (lane >> 1) & 31;
    for (int row0 = F.bid * 8 + F.wave; row0 < nrows; row0 += 2 * nwaves) {
        int rw[2]; bool vld[2];
        rw[0] = row0; vld[0] = true; vld[1] = (row0 + nwaves < nrows); rw[1] = vld[1] ? row0 + nwaves : row0;
        f32x4 m[2][4], x[2][4], hv[2][4];
#pragma unroll
        for (int u = 0; u < 2; ++u) { const bf16_t* mr = F.w<bf16_t>(WS_MIXO) + (size_t)rw[u] * D;
#pragma unroll
            for (int i = 0; i < 4; ++i) { const u32x2 w = *(const u32x2*)(mr + 4 * lane + 256 * i); m[u][i] = (f32x4){bflo(w.x), bfhi(w.x), bflo(w.y), bfhi(w.y)}; }
            load_xrow(F, l, rw[u], lane, x[u]); }
#pragma unroll
        for (int u = 0; u < 2; ++u) {
            const int which = rw[u] >= L;
            const float* v0 = vecs_ptr(F, l, which, 2);
            const float rs1 = row_rstd(m[u]);
#pragma unroll
            for (int i = 0; i < 4; ++i) { const f32x4 a = *(const f32x4*)(v0 + 4 * lane + 256 * i); x[u][i] = x[u][i] + m[u][i] * rs1 * a; }
        }
#pragma unroll
        for (int u = 0; u < 2; ++u) {
            if (vld[u]) store_xrow_bf16(F.w<bf16_t>(WS_XCUR) + (size_t)rw[u] * D, lane, x[u]);
        }
#pragma unroll
        for (int u = 0; u < 2; ++u) {
            const int which = rw[u] >= L;
            const float* v1 = vecs_ptr(F, l, which, 3), *v2 = vecs_ptr(F, l, which, 4);
            const float rs2 = row_rstd(x[u]);
#pragma unroll
            for (int i = 0; i < 4; ++i) { const f32x4 a = *(const f32x4*)(v1 + 4 * lane + 256 * i), b = *(const f32x4*)(v2 + 4 * lane + 256 * i); hv[u][i] = x[u][i] * rs2 * a + b; }
            if (vld[u]) { unsigned char* ho = F.w<unsigned char>(WS_H2) + (size_t)rw[u] * D;
#pragma unroll
                for (int i = 0; i < 4; ++i) *(unsigned*)(ho + 4 * lane + 256 * i) = pk_fp8x4(hv[u][i][0], hv[u][i][1], hv[u][i][2], hv[u][i][3]); }
        }
        float part[2][32];
#pragma unroll
        for (int e = 0; e < 32; ++e) {
            float s0 = 0.f, s1 = 0.f;
#pragma unroll
            for (int i = 0; i < 4; ++i) { const f32x4 w = *(const LAS f32x4*)(wr + e * WRP + 4 * lane + 256 * i);
                s0 += hv[0][i][0] * w[0] + hv[0][i][1] * w[1] + hv[0][i][2] * w[2] + hv[0][i][3] * w[3];
                s1 += hv[1][i][0] * w[0] + hv[1][i][1] * w[1] + hv[1][i][2] * w[2] + hv[1][i][3] * w[3]; }
            part[0][e] = s0; part[1][e] = s1;
        }
#pragma unroll
        for (int st = 0; st < 5; ++st) {
            const int o = 32 >> st, n = 32 >> st;
            const bool upper = (lane & o) != 0;
#pragma unroll
            for (int i = 0; i < n / 2; ++i) {
#pragma unroll
                for (int u = 0; u < 2; ++u) {
                    const float send = upper ? part[u][i] : part[u][i + n / 2];
                    const float recv = __shfl_xor(send, o);
                    const float keep = upper ? part[u][i + n / 2] : part[u][i];
                    part[u][i] = keep + recv;
                }
            }
        }
#pragma unroll
        for (int u = 0; u < 2; ++u) {
            float lg = part[u][0] + __shfl_xor(part[u][0], 1);
            lg += brl;
            int rank = 0;
#pragma unroll
            for (int e = 0; e < 32; ++e) { const float ov = __int_as_float(__builtin_amdgcn_readlane(__float_as_int(lg), 2 * e)); rank += (ov > lg || (ov == lg && e < mye)) ? 1 : 0; }
            int te[4]; float tv[4];
#pragma unroll
            for (int k = 0; k < 4; ++k) {
                const unsigned long long msk = __ballot(rank == k && (lane & 1) == 0);
                const int idx = msk ? __builtin_amdgcn_readfirstlane((int)__builtin_ctzll(msk)) : 2 * k;
                te[k] = idx >> 1; tv[k] = __int_as_float(__builtin_amdgcn_readlane(__float_as_int(lg), idx));
            }
            const float e1 = __expf(tv[1] - tv[0]), e2 = __expf(tv[2] - tv[0]), e3 = __expf(tv[3] - tv[0]);
            const float inv = 1.0f / (1.0f + e1 + e2 + e3);
            if (lane < 4 && vld[u]) {
                const int k = lane, row = rw[u];
                const int e = k == 0 ? te[0] : (k == 1 ? te[1] : (k == 2 ? te[2] : te[3]));
                const float wgt = (k == 0 ? 1.0f : (k == 1 ? e1 : (k == 2 ? e2 : e3))) * inv;
                const unsigned pos = __hip_atomic_fetch_add(lcnt + e, 1u, __ATOMIC_RELAXED, __HIP_MEMORY_SCOPE_WORKGROUP);
                F.w<int>(WS_RE)[row * 4 + k] = e; F.w<int>(WS_RP)[row * 4 + k] = (int)pos; F.w<float>(WS_RW)[row * 4 + k] = wgt;
            }
        }
    }
    __syncthreads();
    if (F.tid < 32) lcnt[32 + F.tid] = atomicAdd(cnt + F.tid * 32, lcnt[F.tid]);
    __syncthreads();
    for (int row = F.bid * 8 + F.wave; row < nrows; row += nwaves) {
        if (lane < 4) { const int a = row * 4 + lane; F.w<int>(WS_RP)[a] += (int)lcnt[32 + F.w<int>(WS_RE)[a]]; }
    }
}

__device__ __forceinline__ int expert_pad_start(const Frame& F, int l, int& ntiles) {
    const unsigned* cnt = F.w<unsigned>(WS_CTL) + CW_CNT + l * 1024;
    int c = F.lane < 32 ? (int)__hip_atomic_load(cnt + F.lane * 32, __ATOMIC_RELAXED, __HIP_MEMORY_SCOPE_AGENT) : 0;
    int padded = (c + 255) & ~255;
    int incl = padded;
#pragma unroll
    for (int o = 1; o < 32; o <<= 1) { const int v = __shfl_up(incl, o); if ((F.lane & 31) >= o) incl += v; }
    ntiles = __shfl(incl, 31) >> 8;
    return incl - padded;
}

__device__ __forceinline__ void ph_gather(const Frame& F, int l) {
    int ntiles; const int ps = expert_pad_start(F, l, ntiles);
    if (F.bid == 0 && F.wave == 0) {
        int* tab = F.w<int>(WS_CTL) + CW_TILE + l * 320;
        const int nxt = __shfl_down(ps, 1);
        const int endt = (F.lane == 31) ? ntiles : (nxt >> 8);
        if (F.lane < 32) for (int t = ps >> 8; t < endt; ++t) tab[t] = F.lane;
        if (F.lane == 0) F.w<int>(WS_CTL)[CW_NT + l] = ntiles;
    }
    const int nrows = (l == 0) ? T : L;
    for (int a0 = (F.bid * 8 + F.wave) * 64; a0 < nrows * 4; a0 += F.G * 8 * 64) {
        const int a = a0 + F.lane;
        if (a < nrows * 4) {
            const int e = F.w<int>(WS_RE)[a], pos = F.w<int>(WS_RP)[a];
            const int dst = __shfl(ps, e) + pos;
            F.w<int>(WS_SLOT)[a] = dst;
            F.w<int>(WS_ROWTOK)[(size_t)l * MAXROWS + dst] = a >> 2;
        }
    }
}

__device__ __forceinline__ void ph_final(const Frame& F, int l) {
    const int nrows = (l == 0) ? T : L;
    const int nwaves = F.G * 8, lane = F.lane;
    const bf16_t* Y = F.w<bf16_t>(WS_Y) + (size_t)l * MAXROWS * D;
    int slotn[2][4]; float wgtn[2][4];
#define FN_SLOTS(r0_) do { _Pragma("unroll") for (int u = 0; u < 2; ++u) { const int rr_ = ((r0_) + u * nwaves < nrows) ? (r0_) + u * nwaves : (r0_); \
        _Pragma("unroll") for (int k = 0; k < 4; ++k) { slotn[u][k] = F.w<int>(WS_SLOT)[rr_ * 4 + k]; wgtn[u][k] = F.w<float>(WS_RW)[rr_ * 4 + k]; } } } while (0)
    const int rfirst = F.bid * 8 + F.wave;
    if (rfirst < nrows) FN_SLOTS(rfirst);
    for (int row0 = rfirst; row0 < nrows; row0 += 2 * nwaves) {
        int rw[2]; bool vld[2];
        rw[0] = row0; vld[0] = true; vld[1] = (row0 + nwaves < nrows); rw[1] = vld[1] ? row0 + nwaves : row0;
        int slot[2][4]; float wgt[2][4];
#pragma unroll
        for (int u = 0; u < 2; ++u)
#pragma unroll
            for (int k = 0; k < 4; ++k) { slot[u][k] = slotn[u][k]; wgt[u][k] = wgtn[u][k]; }
        u32x2 yv[2][4][4]; f32x4 x[2][4];
#pragma unroll
        for (int u = 0; u < 2; ++u) {
#pragma unroll
            for (int k = 0; k < 4; ++k) { const bf16_t* yr = Y + (size_t)slot[u][k] * D;
#pragma unroll
                for (int i = 0; i < 4; ++i) yv[u][k][i] = *(const u32x2*)(yr + 4 * lane + 256 * i); }
            load_xrow(F, 1, rw[u], lane, x[u]);
        }
        if (row0 + 2 * nwaves < nrows) FN_SLOTS(row0 + 2 * nwaves);
#pragma unroll
        for (int u = 0; u < 2; ++u) {
            const int which = rw[u] >= L;
            const float* ve = vecs_ptr(F, l, which, 5);
            f32x4 f[4];
#pragma unroll
            for (int i = 0; i < 4; ++i) f[i] = (f32x4){0.f, 0.f, 0.f, 0.f};
#pragma unroll
            for (int k = 0; k < 4; ++k)
#pragma unroll
                for (int i = 0; i < 4; ++i) { const u32x2 w = yv[u][k][i]; f[i][0] += wgt[u][k] * bflo(w.x); f[i][1] += wgt[u][k] * bfhi(w.x); f[i][2] += wgt[u][k] * bflo(w.y); f[i][3] += wgt[u][k] * bfhi(w.y); }
            const float rs = row_rstd(f);
#pragma unroll
            for (int i = 0; i < 4; ++i) { const f32x4 a = *(const f32x4*)(ve + 4 * lane + 256 * i); x[u][i] = x[u][i] + f[i] * rs * a; }
            if (vld[u]) {
                if (l == 1) { float* xo = F.out + (size_t)rw[u] * D;
#pragma unroll
                    for (int i = 0; i < 4; ++i) *(f32x4*)(xo + 4 * lane + 256 * i) = x[u][i]; }
                else store_xrow_bf16(F.w<bf16_t>(WS_XCUR) + (size_t)rw[u] * D, lane, x[u]);
                if (l == 0) {
                    const float rstd = row_rstd(x[u]);
                    const float* va = vecs_ptr(F, 1, which, 0), *vb = vecs_ptr(F, 1, which, 1);
                    bf16_t* orow = F.w<bf16_t>(WS_HB) + (size_t)rw[u] * D;
                    unsigned char* orow8 = F.w<unsigned char>(WS_HB) + (size_t)rw[u] * D;
#pragma unroll
                    for (int i = 0; i < 4; ++i) {
                        const int c = 4 * lane + 256 * i;
                        const f32x4 a = *(const f32x4*)(va + c), b = *(const f32x4*)(vb + c);
                        if (F8IN(1)) *(unsigned*)(orow8 + c) = pk_fp8x4(x[u][i][0] * rstd * a[0] + b[0], x[u][i][1] * rstd * a[1] + b[1], x[u][i][2] * rstd * a[2] + b[2], x[u][i][3] * rstd * a[3] + b[3]);
                        else { u32x2 w; w.x = pk_bf16(x[u][i][0] * rstd * a[0] + b[0], x[u][i][1] * rstd * a[1] + b[1]); w.y = pk_bf16(x[u][i][2] * rstd * a[2] + b[2], x[u][i][3] * rstd * a[3] + b[3]);
                        *(u32x2*)(orow + c) = w; }
                    }
                }
            }
        }
    }
#undef FN_SLOTS
}

constexpr int PH_PER_LAYER = 10, N_PHASES = 2 + 2 * PH_PER_LAYER;
#ifndef PH_MASK
#define PH_MASK 0xFFFFFFFFu
#endif
#define EN(b) (((PH_MASK) >> (b)) & 1u)
#ifndef DUP_MASK
#define DUP_MASK 0u
#endif
#define REP(b) for (int _rep = 0; _rep < 1 + (int)(((DUP_MASK) >> (b)) & 1u); ++_rep)

__global__ void __launch_bounds__(NTHREADS, 2) mega(Args args) {
    extern __shared__ __attribute__((aligned(16))) unsigned char shm[];
    Frame F0;
    F0.in.kp = (kargp_t)__builtin_amdgcn_kernarg_segment_ptr();
    F0.out = args.out; F0.ws = args.ws; F0.lds = (LAS unsigned char*)shm;
    F0.tid = threadIdx.x; F0.lane = F0.tid & 63; F0.wave = __builtin_amdgcn_readfirstlane(F0.tid >> 6); F0.G = gridDim.x; F0.bid = blockIdx.x;
    volatile LAS unsigned* bst = (volatile LAS unsigned*)(shm + LDS_BYTES - 16);
    XcdBarrier bar; bar.bar = F0.w<unsigned>(WS_CTL) + CW_BAR; bar.x = 0; bar.st = bst;
#if N_LAUNCH_MODE == 1
    if (F0.tid == 0) { bst[0] = 0u; bst[1] = 0u; }
    __syncthreads();
    bar = xcd_barrier_post(F0.w<unsigned>(WS_CTL) + CW_BAR, bst);
#define GRID_BAR() xcd_barrier(bar)
#else
#define GRID_BAR() do {} while (0)
#endif
    const int lo = args.ph_lo, hi = args.ph_hi;
#define IN(k) (lo <= (k) && (k) < hi)
#define SEAM(k) do { if (IN(k) && IN((k) + 1)) GRID_BAR(); } while (0)

    if (IN(0)) { const Frame F = launder(F0); REP(1) ph_modpart(F); }
    SEAM(0);
    if (IN(1)) { const Frame F = launder(F0);
        REP(2) ph_filter(F); REP(3) ph_norm1(F, 0); ph_vecs(F); __syncthreads(); REP(0) ph_convert(F); }
    SEAM(1);
    for (int l = 0; l < 2; ++l) {
        const int pb = 2 + l * PH_PER_LAYER;
        if (EN(5) && IN(pb + 0)) { const Frame F = launder(F0);
            const bool f8 = (l == 0) ? (F8IN(0) != 0) : (F8IN(1) != 0);
            pg8::Gemm g{F.w<bf16_t>(WS_HB), F.w<bf16_t>(WS_WINT) + (size_t)l * PC * D, f8 ? D / 2 : D};
            pg8::SchedGrid S{PC / 256, (T / 256) * (PC / 256), F.G, F.vid};
            pg8::EpiBf16 E{F.w<bf16_t>(WS_P), PC, nullptr, 0};
            if (INPROJ_FP8 == 0) pg8::gemm_phase<pg8::EpiBf16, pg8::SchedGrid, true, false, false>(F.lds, g, S, E, F.tid);
            else if (INPROJ_FP8 == 3) pg8::gemm_phase<pg8::EpiBf16, pg8::SchedGrid, true, false, true>(F.lds, g, S, E, F.tid);
            else { if (f8) pg8::gemm_phase<pg8::EpiBf16, pg8::SchedGrid, true, false, true>(F.lds, g, S, E, F.tid); else pg8::gemm_phase<pg8::EpiBf16, pg8::SchedGrid, true, false, false>(F.lds, g, S, E, F.tid); }
        }
        SEAM(pb + 0);
        if (IN(pb + 1)) { const Frame F = launder(F0); if (l == 0) { REP(4) ph_fsum(F); } REP(6) ph_ssd_prep(F, l); REP(7) ph_hy_prep(F, l); REP(8) ph_na(F, l, 0); }
        SEAM(pb + 1);
        if (IN(pb + 2)) { const Frame F = launder(F0); REP(9) ph_ssd_scan(F); REP(10) { ph_hy_conv(F, l); if (l == 0) ph_hy_conv_ctx(F, l); } }
        SEAM(pb + 2);
        if (EN(11) && IN(pb + 3)) { const Frame F = launder(F0); REP(11) ph_ssd_out(F, l); REP(18) ph_hy_tr(F); if (l == 0) ph_na(F, l, 1); }
        SEAM(pb + 3);
        if (EN(12) && IN(pb + 4)) { const Frame F = launder(F0);
            pg8::Gemm g{F.w<bf16_t>(WS_MIX), F.w<bf16_t>(WS_WOUTT) + (size_t)l * D * D, D};
            const int nM = (l == 0) ? T / 256 : L / 256;
            pg8::SchedGrid S{4, nM * 4, F.G, F.vid};
            pg8::EpiBf16 E{F.w<bf16_t>(WS_MIXO), D, nullptr, 0};
            REP(12) pg8::gemm_phase<pg8::EpiBf16, pg8::SchedGrid>(F.lds, g, S, E, F.tid);
        }
        SEAM(pb + 4);
        if (EN(13) && IN(pb + 5)) { const Frame F = launder(F0); ph_post1(F, l); }
        SEAM(pb + 5);
        if (EN(14) && IN(pb + 6)) { const Frame F = launder(F0); REP(14) ph_gather(F, l); }
        SEAM(pb + 6);
        if (EN(15) && IN(pb + 7)) { const Frame F = launder(F0);
            const int* tab = F.w<int>(WS_CTL) + CW_TILE + l * 320;
            const int ntiles = __builtin_amdgcn_readfirstlane(F.w<int>(WS_CTL)[CW_NT + l]);
            pg8::Gemm g{F.w<bf16_t>(WS_H2), (const bf16_t*)(F.w<unsigned char>(WS_WGUT) + (size_t)l * NE * 2048 * D), D / 2};
            pg8::SchedMoe S{8, ntiles * 8, F.G, F.vid, tab};
            pg8::EpiAct E{F.w<unsigned char>(WS_HMID) + (size_t)l * MAXROWS * D, F.in[I_BGU] + (size_t)l * NE * 2048};
            LAS int* rowtab = (LAS int*)(F.lds + pg8::STAGE_BYTES);
            __syncthreads();
            {
                int nt_; const int ps = expert_pad_start(F, l, nt_);
                const unsigned* cnt = F.w<unsigned>(WS_CTL) + CW_CNT + l * 1024;
                for (int ui = 0; ui * F.G + F.vid < ntiles * 8 && ui < 12; ++ui) {
                    const int pa = (ui * F.G + F.vid) / 8;
                    const int e = tab[pa];
                    const int pstart = __shfl(ps, e), ce = (int)__hip_atomic_load(cnt + e * 32, __ATOMIC_RELAXED, __HIP_MEMORY_SCOPE_AGENT);
                    if (F.tid < 256) { const int prow = pa * 256 + F.tid; rowtab[ui * 256 + F.tid] = (prow - pstart < ce) ? F.w<int>(WS_ROWTOK)[(size_t)l * MAXROWS + prow] : T; }
                }
            }
            __syncthreads();
            REP(15) pg8::gemm_phase<pg8::EpiAct, pg8::SchedMoe, true, true, true>(F.lds, g, S, E, F.tid, rowtab);
        }
        SEAM(pb + 7);
        if (EN(16) && IN(pb + 8)) { const Frame F = launder(F0);
            const int* tab = F.w<int>(WS_CTL) + CW_TILE + l * 320;
            const int ntiles = __builtin_amdgcn_readfirstlane(F.w<int>(WS_CTL)[CW_NT + l]);
            pg8::Gemm g{(const bf16_t*)(F.w<unsigned char>(WS_HMID) + (size_t)l * MAXROWS * D), (const bf16_t*)(F.w<unsigned char>(WS_WDT) + (size_t)l * NE * D * D), D / 2};
            pg8::SchedMoe S{4, ntiles * 4, F.G, F.vid, tab};
            pg8::EpiBf16 E{F.w<bf16_t>(WS_Y) + (size_t)l * MAXROWS * D, D, F.in[I_BDN] + (size_t)l * NE * D, D};
            REP(16) pg8::gemm_phase<pg8::EpiBf16, pg8::SchedMoe, true, false, true>(F.lds, g, S, E, F.tid);
        }
        SEAM(pb + 8);
        if (EN(17) && IN(pb + 9)) { const Frame F = launder(F0); ph_final(F, l); }
        if (l == 0) SEAM(pb + 9);
    }
#undef IN
#undef SEAM
}

extern "C" void kernel_launch(void* const* d_in, const int* in_sizes, int n_in, void* d_out, int out_size, void* d_ws, size_t ws_size, hipStream_t stream) {
    static int grid = 0;
    if (grid == 0) {
        if (n_in != N_IN || out_size != L * D || ws_size < WS_END) { fprintf(stderr, "kernel_launch: unexpected shapes: n_in %d out %d ws %zu (need %zu)\n", n_in, out_size, ws_size, (size_t)WS_END); grid = -1; return; }
        int dev = 0, cus = 0, per_cu = 0;
        if (hipGetDevice(&dev) != hipSuccess || hipDeviceGetAttribute(&cus, hipDeviceAttributeMultiprocessorCount, dev) != hipSuccess) { grid = -1; return; }
        if (hipFuncSetAttribute((const void*)mega, hipFuncAttributeMaxDynamicSharedMemorySize, LDS_BYTES) != hipSuccess) { fprintf(stderr, "kernel_launch: hipFuncSetAttribute failed\n"); grid = -1; return; }
        if (hipOccupancyMaxActiveBlocksPerMultiprocessor(&per_cu, (const void*)mega, NTHREADS, LDS_BYTES) != hipSuccess || per_cu < 1) { fprintf(stderr, "kernel_launch: occupancy query says %d\n", per_cu); }
        (void)hipGetLastError();
        grid = cus;
    }
    if (grid < 0) return;
    (void)hipMemsetAsync((char*)d_ws + WS_CTL, 0, CTL_BYTES, stream);
    Args a{};
    for (int i = 0; i < N_IN; ++i) a.in[i] = (const float*)d_in[i];
    a.out = (float*)d_out; a.ws = (unsigned char*)d_ws;
#if N_LAUNCH_MODE == 1
    a.ph_lo = 0; a.ph_hi = N_PHASES;
    hipLaunchKernelGGL(mega, dim3(grid), dim3(NTHREADS), LDS_BYTES, stream, a);
#else
    for (int p = 0; p < N_PHASES; ++p) { a.ph_lo = p; a.ph_hi = p + 1; hipLaunchKernelGGL(mega, dim3(grid), dim3(NTHREADS), LDS_BYTES, stream, a); }
#endif
}
```

```cpp
#include <hip/hip_runtime.h>
#include <cstdio>
#include <cstdint>

#define LAS __attribute__((address_space(3)))
typedef unsigned short bf16_t;
typedef short bf16x8 __attribute__((ext_vector_type(8)));
typedef float f32x4 __attribute__((ext_vector_type(4)));
typedef float f32x16 __attribute__((ext_vector_type(16)));
typedef unsigned u32x4 __attribute__((ext_vector_type(4)));
typedef unsigned u32x2 __attribute__((ext_vector_type(2)));
typedef float f32x2v __attribute__((ext_vector_type(2)));
typedef int v4i __attribute__((ext_vector_type(4)));
typedef int v8i __attribute__((ext_vector_type(8)));

#ifndef N_LAUNCH_MODE
#define N_LAUNCH_MODE 1
#endif

constexpr int D = 1024, L = 16384, LC = 256, T = L + LC, NCH = T / 128;
constexpr int PC = 3328;
constexpr int CZ = 0, CXBC = 384, CQ = 1280, CK = 1664, CV = 2048, CHY = 2432, CDT = 3200;
constexpr int NE = 32;
constexpr int MAXT = 292;
constexpr int MAXROWS = MAXT * 256;
constexpr int NTHREADS = 512;
constexpr int LDS_BYTES = 160 * 1024;
constexpr float RMS_EPS = 1e-6f;

enum { I_X = 0, I_C, I_CTX, I_CCTX, I_WMOD, I_BMOD, I_NORMG, I_WIN, I_SCW, I_SCB, I_ALOG, I_DTB, I_SSDD, I_SSDNG, I_RPB, I_HCW, I_HCB,
       I_FW1, I_FB1, I_FW2, I_FB2, I_FW3, I_FREQ, I_HYD, I_WOUT, I_WR, I_BR, I_WGU, I_BGU, I_WDN, I_BDN, N_IN };

constexpr size_t al256(size_t x) { return (x + 255) & ~(size_t)255; }
constexpr size_t WS_CTL   = 0;
constexpr size_t CTL_BYTES = 64 * 1024;
constexpr size_t WS_WINT  = WS_CTL + CTL_BYTES;
constexpr size_t WS_WOUTT = WS_WINT + al256((size_t)2 * PC * D * 2);
constexpr size_t WS_WGUT  = WS_WOUTT + al256((size_t)2 * D * D * 2);
constexpr size_t WS_WDT   = WS_WGUT + al256((size_t)2 * NE * 2048 * D * 2);
constexpr size_t WS_MODP  = WS_WDT + al256((size_t)2 * NE * D * D * 2);
constexpr int KRL = 2 * L + 512;
constexpr size_t WS_KR    = WS_MODP + al256((size_t)2 * 2 * 32 * 6144 * 4);
constexpr size_t WS_KCOMBC= WS_KR + al256((size_t)2 * 256 * KRL * 2);
constexpr size_t WS_FPART = WS_KCOMBC + al256((size_t)2 * LC * 256 * 4);
constexpr size_t WS_FPARTC= WS_FPART + al256((size_t)2 * 256 * 512 * 4);
constexpr size_t WS_FSUM  = WS_FPARTC + al256((size_t)16 * 512 * 4);
constexpr size_t WS_HB    = WS_FSUM + al256((size_t)3 * 256 * 4);
constexpr size_t WS_P     = WS_HB + al256((size_t)T * D * 2);
constexpr size_t WS_XBC   = WS_P + al256((size_t)T * PC * 2);
constexpr size_t WS_DTV   = WS_XBC + al256((size_t)T * 896 * 2);
constexpr size_t WS_ACS   = WS_DTV + al256((size_t)T * 12 * 4);
constexpr size_t WS_ALAST = WS_ACS + al256((size_t)T * 12 * 4);
constexpr size_t WS_STATES= WS_ALAST + al256((size_t)NCH * 12 * 4);
constexpr size_t WS_SSTART= WS_STATES + al256((size_t)2 * NCH * 6 * 128 * 64 * 4);
constexpr size_t WS_U     = WS_SSTART + al256((size_t)2 * NCH * 6 * 128 * 64 * 4);
constexpr size_t WS_UT    = WS_U + al256((size_t)T * 256 * 4);
constexpr size_t WS_UT8   = WS_UT + al256((size_t)256 * L * 2);
constexpr size_t WS_X0T   = WS_UT8 + al256((size_t)256 * L);
constexpr size_t WS_YT    = WS_X0T + al256((size_t)256 * L * 2);
constexpr size_t WS_MIX   = WS_YT + al256((size_t)256 * L * 2);
constexpr size_t WS_MIXO  = WS_MIX + al256((size_t)T * D * 2);
constexpr size_t WS_XCUR  = WS_MIXO + al256((size_t)T * D * 4);
constexpr size_t WS_H2    = WS_XCUR + al256((size_t)T * D * 4);
constexpr size_t WS_RE    = WS_H2 + al256((size_t)(T + 1) * D * 2);
constexpr size_t WS_RP    = WS_RE + al256((size_t)T * 4 * 4);
constexpr size_t WS_RW    = WS_RP + al256((size_t)T * 4 * 4);
constexpr size_t WS_SLOT  = WS_RW + al256((size_t)T * 4 * 4);
constexpr size_t WS_XG    = WS_SLOT + al256((size_t)T * 4 * 4);
constexpr size_t WS_HMID  = WS_XG + 256;
constexpr size_t WS_Y     = WS_HMID + al256((size_t)2 * MAXROWS * D * 2);
constexpr size_t WS_VECS  = WS_Y + al256((size_t)2 * MAXROWS * D * 2);
constexpr size_t WS_ROWTOK= WS_VECS + al256((size_t)2 * 2 * 6 * 1024 * 4);
constexpr int MIXP_BF = 38;
constexpr size_t WS_HB8   = WS_ROWTOK + al256((size_t)2 * MAXROWS * 4);
constexpr size_t WS_WIN8  = WS_HB8 + al256((size_t)(64 - MIXP_BF) * 256 * D);
constexpr size_t WS_END   = WS_WIN8 + al256((size_t)PC * D);

constexpr int CW_BAR = 0;
constexpr int CW_CNT = 8192;
#ifndef INPROJ_FP8
#define INPROJ_FP8 3
#endif
#define F8IN(l) (((INPROJ_FP8) >> (l)) & 1)
#ifndef PRO_NF
#define PRO_NF 96
#endif
constexpr int CW_CVQ = 4160;
constexpr int CW_NT = 4200;
constexpr int CW_TILE = 4224;

__device__ __forceinline__ float bf2f(unsigned short b) { return __uint_as_float(((unsigned)b) << 16); }
__device__ __forceinline__ unsigned short f2bf(float f) { return __builtin_bit_cast(unsigned short, (__bf16)f); }
typedef __bf16 bf16v2 __attribute__((ext_vector_type(2)));
__device__ __forceinline__ unsigned pk_bf16(float lo, float hi) { const bf16v2 v = {(__bf16)lo, (__bf16)hi}; return __builtin_bit_cast(unsigned, v); }
__device__ __forceinline__ float sat8(float x) { return __builtin_amdgcn_fmed3f(x, -448.0f, 448.0f); }
__device__ __forceinline__ unsigned pk_fp8x4_nosat(float a, float b, float c, float d) { unsigned w = 0; w = __builtin_amdgcn_cvt_pk_fp8_f32(a, b, w, false); w = __builtin_amdgcn_cvt_pk_fp8_f32(c, d, w, true); return w; }
__device__ __forceinline__ unsigned pk_fp8x4(float a, float b, float c, float d) { unsigned w = 0; w = __builtin_amdgcn_cvt_pk_fp8_f32(sat8(a), sat8(b), w, false); w = __builtin_amdgcn_cvt_pk_fp8_f32(sat8(c), sat8(d), w, true); return w; }
constexpr float KR_SCALE = 64.0f;
constexpr float W8_SCALE = 32.0f;
constexpr int W8_SCALE_E8M0 = 0x7A7A7A7A, ONE_E8M0 = 0x7F7F7F7F;
__device__ __forceinline__ float bflo(unsigned w) { return __uint_as_float(w << 16); }
__device__ __forceinline__ float bfhi(unsigned w) { return __uint_as_float(w & 0xFFFF0000u); }
__device__ __forceinline__ float silu_f(float x) { return x * __builtin_amdgcn_rcpf(1.0f + __expf(-x)); }
__device__ __forceinline__ float softplus_f(float x) { return x > 20.f ? x : log1pf(__expf(x)); }
__device__ __forceinline__ float row16_ror(float v, int ctrl8421) {
    switch (ctrl8421) {
        case 8: return __int_as_float(__builtin_amdgcn_update_dpp(0, __float_as_int(v), 0x128, 0xF, 0xF, false));
        case 4: return __int_as_float(__builtin_amdgcn_update_dpp(0, __float_as_int(v), 0x124, 0xF, 0xF, false));
        case 2: return __int_as_float(__builtin_amdgcn_update_dpp(0, __float_as_int(v), 0x122, 0xF, 0xF, false));
        default: return __int_as_float(__builtin_amdgcn_update_dpp(0, __float_as_int(v), 0x121, 0xF, 0xF, false));
    }
}
__device__ __forceinline__ float row16_max(float v) { v = fmaxf(v, row16_ror(v, 8)); v = fmaxf(v, row16_ror(v, 4)); v = fmaxf(v, row16_ror(v, 2)); v = fmaxf(v, row16_ror(v, 1)); return v; }
__device__ __forceinline__ float row16_sum(float v) { v += row16_ror(v, 8); v += row16_ror(v, 4); v += row16_ror(v, 2); v += row16_ror(v, 1); return v; }
__device__ __forceinline__ float wave_sum(float v) {
    v = row16_sum(v);
    const int vi = __float_as_int(v);
    return (__int_as_float(__builtin_amdgcn_readlane(vi, 0)) + __int_as_float(__builtin_amdgcn_readlane(vi, 16))) + (__int_as_float(__builtin_amdgcn_readlane(vi, 32)) + __int_as_float(__builtin_amdgcn_readlane(vi, 48)));
}
__device__ __forceinline__ void lds_fence() { asm volatile("s_waitcnt lgkmcnt(0)" ::: "memory"); }
__device__ __forceinline__ void bar_lds() { asm volatile("s_waitcnt lgkmcnt(0)" ::: "memory"); __builtin_amdgcn_s_barrier(); asm volatile("" ::: "memory"); }

#define XB_TMO      128
#define XB_XCNT(j)  (256  + 64 * (j))
#define XB_XSUB(j)  (1280 + 64 * (j))
#define XB_XGEN(j)  (2304 + 64 * (j))
#define XB_TOP      3328
#define XB_TOPGEN   3392
#define XCD_BAR_WORDS 3456
#define XB_SPIN_CAP (1u << 18)
__device__ __forceinline__ unsigned xb_ld(unsigned* p)              { return __hip_atomic_load(p, __ATOMIC_RELAXED, __HIP_MEMORY_SCOPE_AGENT); }
__device__ __forceinline__ unsigned xb_add(unsigned* p, unsigned v) { return __hip_atomic_fetch_add(p, v, __ATOMIC_RELAXED, __HIP_MEMORY_SCOPE_AGENT); }
__device__ __forceinline__ unsigned xb_xcc_id() { return (unsigned)__builtin_amdgcn_s_getreg((3 << 11) | 20) & 0xFu; }
#define XB_SPIN(cond, bar) do { unsigned _sp = 0; while (cond) { __builtin_amdgcn_s_sleep(1); \
    if ((++_sp & 255u) == 0u) { if (xb_ld(&(bar)[XB_TMO])) break; if (_sp > XB_SPIN_CAP) { atomicAdd(&(bar)[XB_TMO], 1u); break; } } } } while (0)
struct XcdBarrier { unsigned* bar; unsigned x; volatile LAS unsigned* st; };
__device__ __forceinline__ XcdBarrier xcd_barrier_post(unsigned* bar, volatile LAS unsigned* st) {
    XcdBarrier b; b.bar = bar; b.x = xb_xcc_id(); b.st = st;
    if (threadIdx.x == 0) (void)xb_add(&bar[XB_XCNT(b.x)], 1u);
    return b;
}
__device__ __forceinline__ void xcd_barrier_complete(unsigned* bar, unsigned x, unsigned& nloc, unsigned& nx) {
    const unsigned G = gridDim.x * gridDim.y * gridDim.z;
    unsigned sum, cnt, mine, sp = 0u;
    for (;;) {
        sum = 0u; cnt = 0u; mine = 0u;
#pragma unroll
        for (unsigned j = 0; j < 16; ++j) { const unsigned c = xb_ld(&bar[XB_XCNT(j)]); sum += c; cnt += (c > 0u) ? 1u : 0u; mine = (j == x) ? c : mine; }
        if (sum == G) break;
        __builtin_amdgcn_s_sleep(1);
        if ((++sp & 255u) == 0u) { if (xb_ld(&bar[XB_TMO])) break; if (sp > XB_SPIN_CAP) { atomicAdd(&bar[XB_TMO], 1u); break; } }
    }
    nloc = mine > 0u ? mine : 1u; nx = cnt > 0u ? cnt : 1u;
}
__device__ __forceinline__ void xcd_barrier(const XcdBarrier& b) {
    asm volatile("s_waitcnt vmcnt(0)" ::: "memory");
    __syncthreads();
    if (threadIdx.x == 0) {
        unsigned* bar = b.bar;
        __builtin_amdgcn_s_waitcnt(0);
        unsigned nloc = b.st[0], nx = b.st[1];
        if (nloc == 0u) { xcd_barrier_complete(bar, b.x, nloc, nx); b.st[0] = nloc; b.st[1] = nx; }
        const unsigned old = xb_add(&bar[XB_XSUB(b.x)], 1u);
        const unsigned gen = old / nloc;
        if (old + 1u == (gen + 1u) * nloc) {
            __builtin_amdgcn_fence(__ATOMIC_RELEASE, "agent");
            asm volatile("s_waitcnt vmcnt(0)" ::: "memory");
            const unsigned og = xb_add(&bar[XB_TOP], 1u);
            const unsigned tg = og / nx;
            if (og + 1u == (tg + 1u) * nx) xb_add(&bar[XB_TOPGEN], 1u);
            else XB_SPIN(xb_ld(&bar[XB_TOPGEN]) == tg, bar);
            __builtin_amdgcn_fence(__ATOMIC_ACQUIRE, "agent");
            xb_add(&bar[XB_XGEN(b.x)], 1u);
            asm volatile("s_waitcnt vmcnt(0)" ::: "memory");
        } else {
            XB_SPIN(xb_ld(&bar[XB_XGEN(b.x)]) == gen, bar);
            __builtin_amdgcn_fence(__ATOMIC_ACQUIRE, "agent");
            asm volatile("s_waitcnt vmcnt(0)" ::: "memory");
        }
    }
    __syncthreads();
}

#ifndef GEMM_REP
#define GEMM_REP 1
#endif
namespace pg8 {
constexpr int BM = 256, BK = 64, HALF = 128, HTB = HALF * BK * 2, STAGE_BYTES = 8 * HTB;
__host__ __device__ __forceinline__ int lds_byte(int r, int c) { const int st = (r >> 4) * 2 + (c >> 5), rr = r & 15, cc = c & 31, ob = rr * 64 + cc * 2; return st * 1024 + (ob ^ (((ob >> 9) & 1) << 5)); }
__host__ __device__ __forceinline__ void stage_rc(int b, int& R, int& C) { const int st = b / 1024, sb = b % 1024, swz = sb ^ (((sb >> 9) & 1) << 5); R = (st >> 1) * 16 + swz / 64; C = (st & 1) * 32 + (swz % 64) / 2; }
__host__ __device__ __forceinline__ int perm32(int rho) { const int n = rho >> 4, i = rho & 15; return 8 * (i >> 2) + 4 * n + (i & 3); }

struct Unit { int pa, pb, pn, e; };
struct Gemm { const bf16_t* A; const bf16_t* Bt; int K; };

template <class Epi, class Sched, bool ALIGN_EPI = true, bool GATHER = false, bool FP8 = false>
__device__ __forceinline__ void gemm_phase(LAS unsigned char* lds, const Gemm g, const Sched& S, const Epi& E, const int tid, const LAS int* rowtab = nullptr) {
    const int wid = __builtin_amdgcn_readfirstlane(tid >> 6), lane = tid & 63, wr = wid >> 2, wc = wid & 3, fr = lane & 15, fq = lane >> 4;
    const int K = g.K, nt = K / BK;
    unsigned voffA[2], voffB[2];
    int gR[2], gC[2];
#pragma unroll
    for (int i = 0; i < 2; ++i) { int R, C; stage_rc(tid * 16 + i * 8192, R, C); const int Rb = Epi::PERM ? ((R & ~31) + perm32(R & 31)) : R;
        voffA[i] = (unsigned)(R * K + C) * 2u; voffB[i] = (unsigned)(Rb * K + C) * 2u; gR[i] = R; gC[i] = C * 2; }
    unsigned vC0[2], vC1[2], vN0[2], vN1[2];
#define PG8_GOFFS(dst0, dst1, ui_) do { _Pragma("unroll") for (int _i = 0; _i < 2; ++_i) { \
        dst0[_i] = (unsigned)rowtab[(ui_) * 256 + gR[_i]] * (unsigned)(K * 2) + (unsigned)gC[_i]; dst1[_i] = (unsigned)rowtab[(ui_) * 256 + 128 + gR[_i]] * (unsigned)(K * 2) + (unsigned)gC[_i]; } } while (0)
    const size_t kstep = (size_t)(BK * 2);
    const size_t hstep = (size_t)HALF * K * 2;
    const size_t tstep = 2 * hstep;
    const unsigned ldsw = (unsigned)wid * 1024u;
    const int aoff = lds_byte(wr * 64 + fr, fq * 8), boff = lds_byte(wc * 32 + fr, fq * 8);
#define PG8_SA(b, h) (((b) * 2 + (h)) * HTB)
#define PG8_SB(b, h) ((4 + (b) * 2 + (h)) * HTB)
#define PG8_STAGE(bufoff, gbase, voff) do { _Pragma("unroll") for (int _i = 0; _i < 2; ++_i) \
        __builtin_amdgcn_global_load_lds((const unsigned*)((const char*)(gbase) + (voff)[_i]), (LAS unsigned*)(lds + (bufoff) + ldsw + _i * 8192), 16, 0, 0); } while (0)
#define PG8_LDA(dst, b, h) do { _Pragma("unroll") for (int m = 0; m < 4; ++m) { const v4i _x = *(const LAS v4i*)(lds + PG8_SA(b, h) + aoff + m * 2048), _y = *(const LAS v4i*)(lds + PG8_SA(b, h) + aoff + m * 2048 + 1024); \
        dst[m] = __builtin_shufflevector(_x, _y, 0, 1, 2, 3, 4, 5, 6, 7); } } while (0)
#define PG8_LDB(dst, b, h) do { _Pragma("unroll") for (int n = 0; n < 2; ++n) { const v4i _x = *(const LAS v4i*)(lds + PG8_SB(b, h) + boff + n * 2048), _y = *(const LAS v4i*)(lds + PG8_SB(b, h) + boff + n * 2048 + 1024); \
        dst[n] = __builtin_shufflevector(_x, _y, 0, 1, 2, 3, 4, 5, 6, 7); } } while (0)
#define PG8_HALF0(x) __builtin_bit_cast(bf16x8, __builtin_shufflevector((x), (x), 0, 1, 2, 3))
#define PG8_HALF1(x) __builtin_bit_cast(bf16x8, __builtin_shufflevector((x), (x), 4, 5, 6, 7))
#define PG8_MMA(ai, bj, At, Bt) do { __builtin_amdgcn_s_setprio(1); if constexpr (FP8) { _Pragma("unroll") for (int m = 0; m < 4; ++m) _Pragma("unroll") for (int n = 0; n < 2; ++n) \
        asm volatile("v_mfma_scale_f32_16x16x128_f8f6f4 %0, %1, %2, %0, %3, %4 op_sel_hi:[0,0,0]" : "+v"(acc[ai][bj][m][n]) : "v"(Bt[n]), "v"(At[m]), "v"(sclW), "v"(sclX)); } \
        else { _Pragma("unroll") for (int m = 0; m < 4; ++m) _Pragma("unroll") for (int n = 0; n < 2; ++n) { \
        acc[ai][bj][m][n] = __builtin_amdgcn_mfma_f32_16x16x32_bf16(PG8_HALF0(Bt[n]), PG8_HALF0(At[m]), acc[ai][bj][m][n], 0, 0, 0); \
        acc[ai][bj][m][n] = __builtin_amdgcn_mfma_f32_16x16x32_bf16(PG8_HALF1(Bt[n]), PG8_HALF1(At[m]), acc[ai][bj][m][n], 0, 0, 0); } } __builtin_amdgcn_s_setprio(0); } while (0)
#define PG8_WAIT_V(n) asm volatile("s_waitcnt vmcnt(" #n ")" ::: "memory")
#define PG8_WAIT_L(n) asm volatile("s_waitcnt lgkmcnt(" #n ")" ::: "memory")
#define PG8_BAR __builtin_amdgcn_s_barrier()
#define PG8_SCHED __builtin_amdgcn_sched_barrier(0)
    Unit cur, nxt; int ui = 0;
    if (!S.next(0, cur)) return;
    f32x4 acc[2][2][4][2];
    E.init(acc, cur, wc, fq);
    const int sclW = W8_SCALE_E8M0, sclX = ONE_E8M0;
    v8i At[4], B0[2], B1[2];
    const char* cA = GATHER ? (const char*)g.A : (const char*)g.A + (size_t)cur.pa * tstep; const char* cB = (const char*)g.Bt + (size_t)cur.pb * tstep;
    const size_t hstepA = GATHER ? 0 : hstep;
    if constexpr (GATHER) { PG8_GOFFS(vC0, vC1, 0); } else {
#pragma unroll
        for (int i = 0; i < 2; ++i) { vC0[i] = voffA[i]; vC1[i] = voffA[i]; vN0[i] = voffA[i]; vN1[i] = voffA[i]; } }
    PG8_STAGE(PG8_SB(0, 0), cB, voffB); PG8_STAGE(PG8_SB(0, 1), cB + hstep, voffB); PG8_STAGE(PG8_SA(0, 0), cA, vC0); PG8_STAGE(PG8_SA(0, 1), cA + hstepA, vC1);
    if (wr == 1) PG8_BAR;
    PG8_WAIT_V(2); PG8_BAR;
    PG8_STAGE(PG8_SB(1, 0), cB + kstep, voffB); PG8_STAGE(PG8_SA(1, 0), cA + kstep, vC0); PG8_STAGE(PG8_SB(1, 1), cB + hstep + kstep, voffB);
    PG8_WAIT_V(6); PG8_BAR;
    for (;;) {
        const bool has_next = S.next(ui + 1, nxt);
        const char* nA = GATHER ? (const char*)g.A : (has_next ? (const char*)g.A + (size_t)nxt.pa * tstep : cA); const char* nB = has_next ? (const char*)g.Bt + (size_t)nxt.pb * tstep : cB;
        if constexpr (GATHER) { if (has_next) { PG8_GOFFS(vN0, vN1, ui + 1); } else {
#pragma unroll
            for (int i = 0; i < 2; ++i) { vN0[i] = vC0[i]; vN1[i] = vC1[i]; } } }
#pragma unroll 1
        for (int t = 0; t < nt; t += 2) {
            const bool last = (t == nt - 2);
            unsigned vX0[2], vX1[2];
#pragma unroll
            for (int i = 0; i < 2; ++i) { vX0[i] = (GATHER && last) ? vN0[i] : vC0[i]; vX1[i] = (GATHER && last) ? vN1[i] : vC1[i]; }
            const char* a1 = cA + (size_t)(t + 1) * kstep;
            const char* a2 = last ? nA : cA + (size_t)(t + 2) * kstep; const char* b2 = last ? nB : cB + (size_t)(t + 2) * kstep;
            const char* a3 = a2 + kstep; const char* b3 = b2 + kstep;
            PG8_LDB(B0, 0, 0); PG8_LDB(B1, 0, 1); PG8_SCHED; PG8_LDA(At, 0, 0); PG8_STAGE(PG8_SA(1, 1), a1 + hstepA, vC1);
            PG8_WAIT_V(8); PG8_WAIT_L(0); PG8_BAR; PG8_MMA(0, 0, At, B0); PG8_MMA(0, 1, At, B1); PG8_BAR; PG8_SCHED;
            PG8_LDA(At, 0, 1); PG8_STAGE(PG8_SB(0, 0), b2, voffB); PG8_STAGE(PG8_SB(0, 1), b2 + hstep, voffB); PG8_STAGE(PG8_SA(0, 0), a2, vX0);
            PG8_WAIT_V(8); PG8_WAIT_L(0); PG8_BAR; PG8_MMA(1, 0, At, B0); PG8_MMA(1, 1, At, B1); PG8_BAR; PG8_SCHED;
            PG8_LDB(B0, 1, 0); PG8_LDB(B1, 1, 1); PG8_SCHED; PG8_LDA(At, 1, 0); PG8_STAGE(PG8_SA(0, 1), a2 + hstepA, vX1);
            PG8_WAIT_V(8); PG8_WAIT_L(0); PG8_BAR; PG8_MMA(0, 0, At, B0); PG8_MMA(0, 1, At, B1); PG8_BAR; PG8_SCHED;
            PG8_LDA(At, 1, 1); PG8_STAGE(PG8_SB(1, 0), b3, voffB); PG8_STAGE(PG8_SB(1, 1), b3 + hstep, voffB); PG8_STAGE(PG8_SA(1, 0), a3, vX0);
            PG8_WAIT_V(8); PG8_WAIT_L(0); PG8_BAR; PG8_MMA(1, 0, At, B0); PG8_MMA(1, 1, At, B1); PG8_BAR; PG8_SCHED;
        }
        if constexpr (ALIGN_EPI) { if (wr == 0) PG8_BAR; }
        E(acc, cur, wr, wc, fr, fq);
        if (!has_next) break;
        E.init(acc, nxt, wc, fq);
        cur = nxt; cA = nA; cB = nB; ++ui;
        if constexpr (GATHER) {
#pragma unroll
            for (int i = 0; i < 2; ++i) { vC0[i] = vN0[i]; vC1[i] = vN1[i]; } }
        if constexpr (ALIGN_EPI) { if (wr == 1) PG8_BAR; }
    }
    PG8_WAIT_V(0);
    if constexpr (!ALIGN_EPI) { if (wr == 0) PG8_BAR; }
    PG8_BAR;
#undef PG8_GOFFS
#undef PG8_HALF0
#undef PG8_HALF1
#undef PG8_SA
#undef PG8_SB
#undef PG8_STAGE
#undef PG8_LDA
#undef PG8_LDB
#undef PG8_MMA
#undef PG8_WAIT_V
#undef PG8_WAIT_L
#undef PG8_BAR
#undef PG8_SCHED
}

struct EpiF32 {
    static constexpr bool PERM = false;
    float* C; int ldc;
    __device__ __forceinline__ void operator()(const f32x4 (&acc)[2][2][4][2], const Unit& u, int wr, int wc, int fr, int fq) const {
        const int row0 = u.pa * BM + wr * 64 + fr, col0 = u.pn * BM + wc * 32 + 4 * fq;
#pragma unroll
        for (int ai = 0; ai < 2; ++ai)
#pragma unroll
            for (int m = 0; m < 4; ++m) { float* rowp = C + (size_t)(row0 + ai * HALF + m * 16) * ldc + col0;
#pragma unroll
                for (int bj = 0; bj < 2; ++bj)
#pragma unroll
                    for (int n = 0; n < 2; ++n) *(f32x4*)(rowp + bj * HALF + n * 16) = acc[ai][bj][m][n]; }
    }
};
struct EpiBf16 {
    static constexpr bool PERM = true;
    bf16_t* O; int ldc; const float* bias; int bias_stride;
    __device__ __forceinline__ void init(f32x4 (&acc)[2][2][4][2], const Unit& u, int wc, int fq) const {
        const int col0 = u.pn * BM + wc * 32 + 8 * fq;
#pragma unroll
        for (int bj = 0; bj < 2; ++bj)
#pragma unroll
            for (int n = 0; n < 2; ++n) { const f32x4 bv = bias ? *(const f32x4*)(bias + (size_t)u.e * bias_stride + col0 + bj * HALF + 4 * n) : (f32x4){0.f, 0.f, 0.f, 0.f};
#pragma unroll
                for (int ai = 0; ai < 2; ++ai)
#pragma unroll
                    for (int m = 0; m < 4; ++m) acc[ai][bj][m][n] = bv; }
    }
    __device__ __forceinline__ void operator()(const f32x4 (&acc)[2][2][4][2], const Unit& u, int wr, int wc, int fr, int fq) const {
        const int row0 = u.pa * BM + wr * 64 + fr; const int col0 = u.pn * BM + wc * 32 + 8 * fq;
#pragma unroll
        for (int ai = 0; ai < 2; ++ai)
#pragma unroll
            for (int m = 0; m < 4; ++m) { bf16_t* rowp = O + (size_t)(row0 + ai * HALF + m * 16) * ldc + col0;
#pragma unroll
                for (int bj = 0; bj < 2; ++bj) { const f32x4 v0 = acc[ai][bj][m][0], v1 = acc[ai][bj][m][1];
                    u32x4 w; w.x = pk_bf16(v0[0], v0[1]); w.y = pk_bf16(v0[2], v0[3]); w.z = pk_bf16(v1[0], v1[1]); w.w = pk_bf16(v1[2], v1[3]);
                    *(u32x4*)(rowp + bj * HALF) = w; } }
    }
};
struct EpiFp8 {
    static constexpr bool PERM = true;
    unsigned char* O; int ldc; const float* bias; int bias_stride;
    __device__ __forceinline__ void init(f32x4 (&acc)[2][2][4][2], const Unit& u, int wc, int fq) const {
        const int col0 = u.pn * BM + wc * 32 + 8 * fq;
#pragma unroll
        for (int bj = 0; bj < 2; ++bj)
#pragma unroll
            for (int n = 0; n < 2; ++n) { const f32x4 bv = *(const f32x4*)(bias + (size_t)u.e * bias_stride + col0 + bj * HALF + 4 * n);
#pragma unroll
                for (int ai = 0; ai < 2; ++ai)
#pragma unroll
                    for (int m = 0; m < 4; ++m) acc[ai][bj][m][n] = bv; }
    }
    __device__ __forceinline__ void operator()(const f32x4 (&acc)[2][2][4][2], const Unit& u, int wr, int wc, int fr, int fq) const {
        const int row0 = u.pa * BM + wr * 64 + fr; const int col0 = u.pn * BM + wc * 32 + 8 * fq;
#pragma unroll
        for (int ai = 0; ai < 2; ++ai)
#pragma unroll
            for (int m = 0; m < 4; ++m) { unsigned char* rowp = O + (size_t)(row0 + ai * HALF + m * 16) * ldc + col0;
#pragma unroll
                for (int bj = 0; bj < 2; ++bj) { const f32x4 v0 = acc[ai][bj][m][0], v1 = acc[ai][bj][m][1];
                    u32x2 w; w.x = pk_fp8x4(v0[0], v0[1], v0[2], v0[3]); w.y = pk_fp8x4(v1[0], v1[1], v1[2], v1[3]);
                    *(u32x2*)(rowp + bj * HALF) = w; } }
    }
};
struct EpiAct {
    static constexpr bool PERM = true;
    unsigned char* O; const float* bias;
    __device__ __forceinline__ void init(f32x4 (&acc)[2][2][4][2], const Unit& u, int wc, int fq) const {
        const float* bg = bias + (size_t)u.e * 2048 + u.pn * 128 + wc * 32 + 8 * fq;
#pragma unroll
        for (int bj = 0; bj < 2; ++bj)
#pragma unroll
            for (int n = 0; n < 2; ++n) { const f32x4 bv = *(const f32x4*)(bg + bj * 1024 + 4 * n);
#pragma unroll
                for (int ai = 0; ai < 2; ++ai)
#pragma unroll
                    for (int m = 0; m < 4; ++m) acc[ai][bj][m][n] = bv; }
    }
    __device__ __forceinline__ void operator()(const f32x4 (&acc)[2][2][4][2], const Unit& u, int wr, int wc, int fr, int fq) const {
        const int row0 = u.pa * BM + wr * 64 + fr; const int cc0 = wc * 32 + 8 * fq; const int ocol = u.pn * 128 + cc0;
#pragma unroll
        for (int ai = 0; ai < 2; ++ai)
#pragma unroll
            for (int m = 0; m < 4; ++m) { unsigned char* rowp = O + (size_t)(row0 + ai * HALF + m * 16) * D + ocol;
                float r[8];
#pragma unroll
                for (int n = 0; n < 2; ++n)
#pragma unroll
                    for (int j = 0; j < 4; ++j) { float gt = acc[ai][0][m][n][j], up = acc[ai][1][m][n][j];
                        gt = fminf(gt, 7.0f); up = fminf(fmaxf(up, -7.0f), 7.0f);
                        r[n * 4 + j] = gt * __builtin_amdgcn_rcpf(1.0f + __expf(-1.702f * gt)) * (up + 1.0f); }
                u32x2 w; w.x = pk_fp8x4_nosat(r[0], r[1], r[2], r[3]); w.y = pk_fp8x4_nosat(r[4], r[5], r[6], r[7]);
                *(u32x2*)rowp = w; }
    }
};
struct SchedGrid {
    int nN, total, G, c;
    __device__ __forceinline__ bool next(int i, Unit& u) const { int Lx = i * G + c; if (Lx >= GEMM_REP * total) return false; if (GEMM_REP > 1) Lx %= total; u.pa = Lx / nN; u.pn = Lx - u.pa * nN; u.pb = u.pn; u.e = 0; return true; }
};
struct SchedPanels {
    int nN, total, G, c, nlat, last;
    __device__ __forceinline__ bool next(int i, Unit& u) const { int Lx = i * G + c; if (Lx >= total) return false; const int pi = Lx / nN; u.pa = pi < nlat ? pi : last; u.pn = Lx - pi * nN; u.pb = u.pn; u.e = 0; return true; }
};
struct SchedMoe {
    int nN, total, G, c; const int* tile_e;
    int e_l;
    __device__ __forceinline__ void preload(int lane) { const int Lx = lane * G + c; e_l = (lane < 64 && Lx < total) ? tile_e[Lx / nN] : 0; }
    __device__ __forceinline__ bool next(int i, Unit& u) const { int Lx = i * G + c; if (Lx >= GEMM_REP * total) return false; if (GEMM_REP > 1) Lx %= total; u.pa = Lx / nN; u.pn = Lx - u.pa * nN;
        u.e = (GEMM_REP > 1) ? __builtin_amdgcn_readfirstlane((int)tile_e[u.pa]) : __builtin_amdgcn_readlane(e_l, i); u.pb = u.e * nN + u.pn; return true; }
};
}

struct Args { const float* in[N_IN]; float* out; unsigned char* ws; int ph_lo, ph_hi; };

typedef const float* __attribute__((address_space(4))) const* kargp_t;
struct InProxy { kargp_t kp; __device__ __forceinline__ const float* operator[](int i) const { return kp[i]; } };
struct Frame {
    InProxy in; float* out; unsigned char* ws;
    LAS unsigned char* lds;
    int tid, lane, wave, G, bid, vid;
    template <class Tp> __device__ __forceinline__ Tp* w(size_t off) const { return (Tp*)((__attribute__((address_space(1))) unsigned char*)ws + off); }
    __device__ __forceinline__ float* o() const { return (float*)((__attribute__((address_space(1))) float*)out); }
};

__device__ __forceinline__ Frame launder(const Frame& F) {
    Frame R = F;
    int t = F.tid; asm volatile("" : "+v"(t)); R.tid = t; R.lane = t & 63; R.wave = __builtin_amdgcn_readfirstlane(t >> 6);
    unsigned long long w = (unsigned long long)F.ws; asm volatile("" : "+s"(w)); R.ws = (unsigned char*)w;
    unsigned long long o = (unsigned long long)F.out; asm volatile("" : "+s"(o)); R.out = (float*)o;
    unsigned long long k = (unsigned long long)F.in.kp; asm volatile("" : "+s"(k)); R.in.kp = (kargp_t)k;
    int g = F.G, b = F.bid; asm volatile("" : "+s"(g), "+s"(b)); R.G = g; R.bid = b; R.vid = (g % 8 == 0) ? (b % 8) * (g / 8) + b / 8 : b;
    return R;
}

__device__ __forceinline__ float mod_val(const Frame& F, int l, int which, int j) {
    const float* mp = F.w<float>(WS_MODP) + (size_t)((l * 2 + which) * 32) * 6144 + j;
    float s = F.in[I_BMOD][l * 6144 + j];
#pragma unroll
    for (int k = 0; k < 32; ++k) s += mp[(size_t)k * 6144];
    return s;
}

struct CvtTile { const float* src; bf16_t* dst; int ld, mode, k0, n0; bool f8; };
__device__ __forceinline__ CvtTile cvt_decode(const Frame& F, int t) {
    CvtTile c;
    if (t < 1664) { const int l = t / 832, r = t % 832; c.n0 = (r / 16) * 64; c.k0 = (r % 16) * 64; c.src = F.in[I_WIN] + (size_t)l * 1024 * 3212; c.ld = 3212; c.mode = 1; c.f8 = F8IN(l) != 0; c.dst = F.w<bf16_t>(WS_WINT) + (size_t)l * PC * D; }
    else if (t < 2176) { const int q = t - 1664, l = q / 256, r = q % 256; c.n0 = (r / 16) * 64; c.k0 = (r % 16) * 64; c.src = F.in[I_WOUT] + (size_t)l * D * D; c.ld = 1024; c.mode = 0; c.f8 = false; c.dst = F.w<bf16_t>(WS_WOUTT) + (size_t)l * D * D; }
    else if (t < 2176 + 832) { const int r = t - 2176; c.n0 = (r / 16) * 64; c.k0 = (r % 16) * 64; c.src = F.in[I_WIN]; c.ld = 3212; c.mode = 1; c.f8 = true; c.dst = (bf16_t*)F.w<unsigned char>(WS_WIN8); }
    else if (t < 34944) { const int q = t - 2176, le = q / 512, r = q % 512; c.n0 = (r / 16) * 64; c.k0 = (r % 16) * 64; c.src = F.in[I_WGU] + (size_t)le * 1024 * 2048; c.ld = 2048; c.mode = 2; c.f8 = true; c.dst = (bf16_t*)(F.w<unsigned char>(WS_WGUT) + (size_t)le * 2048 * D); }
    else { const int q = t - 34944, le = q / 256, r = q % 256; c.n0 = (r / 16) * 64; c.k0 = (r % 16) * 64; c.src = F.in[I_WDN] + (size_t)le * D * D; c.ld = 1024; c.mode = 0; c.f8 = true; c.dst = (bf16_t*)(F.w<unsigned char>(WS_WDT) + (size_t)le * D * D); }
    return c;
}
__device__ __forceinline__ void cvt_load(const CvtTile& c, int lane, f32x4 (&a)[8], f32x4 (&b)[8]) {
    const int i4 = lane & 15, kpl = lane >> 4;
    const int n = c.n0 + 4 * i4;
    int sc; bool valid = true;
    if (c.mode == 0) sc = n;
    else if (c.mode == 1) { if (n < 1280) sc = n; else if (n < 3200) sc = n + 12; else if (n < 3212) sc = n - 3200 + 1280; else { sc = 0; valid = false; } }
    else { const int pn = n >> 8, rr = n & 255; sc = rr < 128 ? pn * 128 + rr : 1024 + pn * 128 + (rr - 128); }
#pragma unroll
    for (int it = 0; it < 8; ++it) {
        const int r0 = c.f8 ? 4 * (kpl + 4 * (it >> 1)) + 2 * (it & 1) : 2 * (kpl + 4 * it);
        a[it] = (f32x4){0.f, 0.f, 0.f, 0.f}; b[it] = a[it];
        if (valid) { a[it] = __builtin_nontemporal_load((const f32x4*)(c.src + (size_t)(c.k0 + r0) * c.ld + sc)); b[it] = __builtin_nontemporal_load((const f32x4*)(c.src + (size_t)(c.k0 + r0 + 1) * c.ld + sc)); }
    }
}
__device__ __forceinline__ void cvt_store(const CvtTile& c, int lane, const f32x4 (&a)[8], const f32x4 (&b)[8], LAS unsigned* lw) {
    const int i4 = lane & 15, kpl = lane >> 4;
    if (c.f8) {
#pragma unroll
        for (int j = 0; j < 4; ++j) {
            const int kq = kpl + 4 * j;
#pragma unroll
            for (int i = 0; i < 4; ++i) lw[kq * 65 + 4 * i4 + i] = pk_fp8x4(W8_SCALE * a[2 * j][i], W8_SCALE * b[2 * j][i], W8_SCALE * a[2 * j + 1][i], W8_SCALE * b[2 * j + 1][i]);
        }
        lds_fence();
        const int g = lane & 3, nl = lane >> 2;
        unsigned char* d8 = (unsigned char*)c.dst;
#pragma unroll
        for (int it = 0; it < 4; ++it) {
            const int nn = nl + 16 * it;
            u32x4 v; v.x = lw[(4 * g + 0) * 65 + nn]; v.y = lw[(4 * g + 1) * 65 + nn]; v.z = lw[(4 * g + 2) * 65 + nn]; v.w = lw[(4 * g + 3) * 65 + nn];
            *(u32x4*)(d8 + (size_t)(c.n0 + nn) * 1024 + c.k0 + 16 * g) = v;
        }
        lds_fence();
        return;
    }
#pragma unroll
    for (int it = 0; it < 8; ++it) {
        const int kp = kpl + 4 * it;
#pragma unroll
        for (int i = 0; i < 4; ++i) lw[kp * 65 + 4 * i4 + i] = pk_bf16(a[it][i], b[it][i]);
    }
    lds_fence();
    const int g = lane & 7, nl = lane >> 3;
#pragma unroll
    for (int it = 0; it < 8; ++it) {
        const int nn = nl + 8 * it;
        u32x4 v; v.x = lw[(4 * g + 0) * 65 + nn]; v.y = lw[(4 * g + 1) * 65 + nn]; v.z = lw[(4 * g + 2) * 65 + nn]; v.w = lw[(4 * g + 3) * 65 + nn];
        *(u32x4*)(c.dst + (size_t)(c.n0 + nn) * 1024 + c.k0 + 8 * g) = v;
    }
    lds_fence();
}

__device__ __forceinline__ void cvt_store8x2(const CvtTile& c, int lane, const f32x4 (&a0)[8], const f32x4 (&b0)[8], const f32x4 (&a1)[8], const f32x4 (&b1)[8], LAS unsigned* lw) {
    const int i4 = lane & 15, kpl = lane >> 4;
#pragma unroll
    for (int j = 0; j < 4; ++j) {
        const int kq = kpl + 4 * j;
#pragma unroll
        for (int i = 0; i < 4; ++i) {
            lw[kq * 65 + 4 * i4 + i] = pk_fp8x4(W8_SCALE * a0[2 * j][i], W8_SCALE * b0[2 * j][i], W8_SCALE * a0[2 * j + 1][i], W8_SCALE * b0[2 * j + 1][i]);
            lw[(16 + kq) * 65 + 4 * i4 + i] = pk_fp8x4(W8_SCALE * a1[2 * j][i], W8_SCALE * b1[2 * j][i], W8_SCALE * a1[2 * j + 1][i], W8_SCALE * b1[2 * j + 1][i]);
        }
    }
    lds_fence();
    const int g = lane & 7, nl = lane >> 3;
    unsigned char* d8 = (unsigned char*)c.dst;
#pragma unroll
    for (int it = 0; it < 8; ++it) {
        const int nn = nl + 8 * it;
        u32x4 v; v.x = lw[(4 * g + 0) * 65 + nn]; v.y = lw[(4 * g + 1) * 65 + nn]; v.z = lw[(4 * g + 2) * 65 + nn]; v.w = lw[(4 * g + 3) * 65 + nn];
        *(u32x4*)(d8 + (size_t)(c.n0 + nn) * 1024 + c.k0 + 16 * g) = v;
    }
    lds_fence();
}
__device__ __forceinline__ void ph_convert(const Frame& F) {
    LAS unsigned* lw = (LAS unsigned*)(F.lds) + F.wave * (32 * 65 + 16);
    const int nwaves = F.G * 8, w0 = F.bid * 8 + F.wave;
    f32x4 a0[8], b0[8], a1[8], b1[8];
    for (int t = w0; t < 2176 + 832; t += nwaves) { const CvtTile c = cvt_decode(F, t); cvt_load(c, F.lane, a0, b0); cvt_store(c, F.lane, a0, b0, lw); }
    unsigned* ctr = F.w<unsigned>(WS_CTL) + CW_CVQ;
    unsigned tb = 0;
    if (F.lane == 0) tb = atomicAdd(ctr, 2u);
    tb = __builtin_amdgcn_readfirstlane(tb);
    for (;;) {
        if (tb >= 16384u + 8192u) break;
        unsigned tbn = 0;
        if (F.lane == 0) tbn = atomicAdd(ctr, 2u);
        for (int t = (int)tb; t < (int)tb + 2; ++t) {
            CvtTile c; c.f8 = true;
            if (t < 16384) { const int le = t >> 8, r = t & 255; c.n0 = (r >> 3) * 64; c.k0 = (r & 7) * 128; c.src = F.in[I_WGU] + (size_t)le * 1024 * 2048; c.ld = 2048; c.mode = 2; c.dst = (bf16_t*)(F.w<unsigned char>(WS_WGUT) + (size_t)le * 2048 * D); }
            else { const int q = t - 16384, le = q >> 7, r = q & 127; c.n0 = (r >> 3) * 64; c.k0 = (r & 7) * 128; c.src = F.in[I_WDN] + (size_t)le * D * D; c.ld = 1024; c.mode = 0; c.dst = (bf16_t*)(F.w<unsigned char>(WS_WDT) + (size_t)le * D * D); }
            cvt_load(c, F.lane, a0, b0);
            CvtTile c2 = c; c2.k0 = c.k0 + 64;
            cvt_load(c2, F.lane, a1, b1);
            cvt_store8x2(c, F.lane, a0, b0, a1, b1, lw);
        }
        tb = __builtin_amdgcn_readfirstlane(tbn);
    }
}

__device__ __forceinline__ void ph_modpart(const Frame& F) {
    LAS float* sc = (LAS float*)F.lds;
    __syncthreads();
    for (int q = F.tid; q < 2048; q += NTHREADS) sc[q] = silu_f(q < 1024 ? F.in[I_C][q] : F.in[I_CCTX][q - 1024]);
    __syncthreads();
    for (int it0 = F.bid; it0 < 768; it0 += 3 * F.G) {
        float wv[3][32];
#pragma unroll
        for (int u = 0; u < 3; ++u) {
            const int it = min(it0 + u * F.G, 767), l = it / 384, r = it % 384, cc = r / 32, kc = r % 32;
            const float* wm = F.in[I_WMOD] + (size_t)l * D * 6144 + (size_t)(kc * 32) * 6144 + cc * 512 + F.tid;
#pragma unroll
            for (int k = 0; k < 32; ++k) wv[u][k] = wm[(size_t)k * 6144];
        }
#pragma unroll
        for (int u = 0; u < 3; ++u) {
            const int it = it0 + u * F.G;
            if (it < 768) {
                const int l = it / 384, r = it % 384, cc = r / 32, kc = r % 32, j = cc * 512 + F.tid;
                float a0 = 0.f, a1 = 0.f;
#pragma unroll
                for (int k = 0; k < 32; ++k) { a0 += sc[kc * 32 + k] * wv[u][k]; a1 += sc[1024 + kc * 32 + k] * wv[u][k]; }
                float* mp = F.w<float>(WS_MODP);
                mp[(size_t)((l * 2 + 0) * 32 + kc) * 6144 + j] = a0;
                mp[(size_t)((l * 2 + 1) * 32 + kc) * 6144 + j] = a1;
            }
        }
    }
}

__device__ __forceinline__ void ph_filter(const Frame& F) {
    LAS float* zs = (LAS float*)(F.lds + 93696);
    LAS float* h1 = (LAS float*)(F.lds + 8448);
    LAS unsigned char* H2b = F.lds + 24832;
    LAS unsigned char* ob = F.lds + 34048;
    LAS float* w1s = (LAS float*)(F.lds + 68864);
    LAS float* w2s = w1s + 33 * 64;
    const float min_decay = -4.605170185988091f / 1.5f, max_decay = -4.605170185988091f / 0.3f;
    const int wave = F.wave;
    const int nf = F.G < PRO_NF ? F.G : PRO_NF;
    if (F.bid >= nf) return;
    int cur_l = -1;
    for (int it = F.bid; it < 512 + 16; it += nf) {
        int tid = F.tid; asm volatile("" : "+v"(tid));
        const int lane = tid & 63;
        const bool isctx = it >= 512;
        const int l = isctx ? 0 : it / 256, grp = isctx ? it - 512 : it % 256;
        const int Lx = isctx ? LC : L, npos = isctx ? 16 : 64;
        const int t0 = grp * npos;
        const float inv_lm1 = 1.0f / (float)(Lx - 1), inv_l = 1.0f / (float)Lx;
        float wv3[2][4][8];
        {
            const int r3 = lane & 31, hf3 = lane >> 5;
#pragma unroll
            for (int n = 0; n < 2; ++n) { const float* w3 = F.in[I_FW3] + (size_t)l * 64 * 512 + 32 * (2 * wave + n) + r3;
#pragma unroll
                for (int ks = 0; ks < 4; ++ks)
#pragma unroll
                    for (int e = 0; e < 8; ++e) wv3[n][ks][e] = w3[(size_t)(16 * ks + 8 * hf3 + e) * 512]; }
        }
        __syncthreads();
        if (l != cur_l) {
            for (int q = tid; q < 33 * 64 + 64 * 64; q += NTHREADS) { if (q < 33 * 64) w1s[q] = F.in[I_FW1][(size_t)l * 33 * 64 + q]; else w2s[q - 33 * 64] = F.in[I_FW2][(size_t)l * 64 * 64 + q - 33 * 64]; }
            cur_l = l;
        }
#pragma unroll 1
        for (int q = tid; q < npos * 33; q += NTHREADS) {
            const int pos = q / 33, i = q % 33; const int t = t0 + pos;
            const float tn = (float)t * inv_lm1;
            const float rv = (float)t * inv_l;
            float v;
            if (i == 0) v = tn;
            else { const int b = (i - 1) & 15; const float f = 1e-4f + (float)b * ((15.0f - 1e-4f) / 15.0f); v = (i <= 16) ? __builtin_amdgcn_cosf(f * rv) : -__builtin_amdgcn_sinf(f * rv); }
            zs[pos * 36 + i] = v;
        }
        __syncthreads();
        {
            asm volatile("" : "+v"(tid));
            const int o = tid & 63, pg = tid >> 6;
            if (pg * 8 < npos) {
                float acc[8];
                const float bb = F.in[I_FB1][l * 64 + o];
#pragma unroll
                for (int p = 0; p < 8; ++p) acc[p] = bb;
#pragma unroll 2
                for (int i4 = 0; i4 < 8; ++i4) {
                    f32x4 zz[8];
#pragma unroll
                    for (int p = 0; p < 8; ++p) zz[p] = *(const LAS f32x4*)(zs + (pg * 8 + p) * 36 + 4 * i4);
#pragma unroll
                    for (int e = 0; e < 4; ++e) { const float w = w1s[(4 * i4 + e) * 64 + o];
#pragma unroll
                        for (int p = 0; p < 8; ++p) acc[p] += zz[p][e] * w; }
                }
                { const float w = w1s[32 * 64 + o];
#pragma unroll
                    for (int p = 0; p < 8; ++p) acc[p] += zs[(pg * 8 + p) * 36 + 32] * w; }
                const float fq = F.in[I_FREQ][l * 128 + o];
#pragma unroll
                for (int p = 0; p < 8; ++p) h1[(pg * 8 + p) * 64 + o] = __builtin_amdgcn_sinf(fq * acc[p] * 0.15915494309189535f);
            }
        }
        __syncthreads();
        {
            asm volatile("" : "+v"(tid));
            const int o = tid & 63, pg = tid >> 6;
            if (pg * 8 < npos) {
                float acc[8];
                const float bb = F.in[I_FB2][l * 64 + o];
#pragma unroll
                for (int p = 0; p < 8; ++p) acc[p] = bb;
#pragma unroll 2
                for (int i4 = 0; i4 < 16; ++i4) {
                    f32x4 hh[8];
#pragma unroll
                    for (int p = 0; p < 8; ++p) hh[p] = *(const LAS f32x4*)(h1 + (pg * 8 + p) * 64 + 4 * i4);
#pragma unroll
                    for (int e = 0; e < 4; ++e) { const float w = w2s[(4 * i4 + e) * 64 + o];
#pragma unroll
                        for (int p = 0; p < 8; ++p) acc[p] += hh[p][e] * w; }
                }
                const float fq = F.in[I_FREQ][l * 128 + 64 + o];
#pragma unroll
                for (int p = 0; p < 8; ++p) *(LAS bf16_t*)(H2b + (pg * 8 + p) * 144 + o * 2) = f2bf(__builtin_amdgcn_sinf(fq * acc[p] * 0.15915494309189535f));
            }
        }
        __syncthreads();
        {
            int r = lane & 31, hf = lane >> 5;
#pragma unroll
            for (int n = 0; n < 2; ++n) {
                asm volatile("" : "+v"(r), "+v"(hf));
                const int o = 32 * (2 * wave + n) + r, c = o & 255, dir = o >> 8;
                f32x16 acc[2];
#pragma unroll
                for (int m = 0; m < 2; ++m)
#pragma unroll
                    for (int i = 0; i < 16; ++i) acc[m][i] = 0.f;
                float wv[4][8];
#pragma unroll
                for (int ks = 0; ks < 4; ++ks)
#pragma unroll
                    for (int e = 0; e < 8; ++e) wv[ks][e] = wv3[n][ks][e];
#pragma unroll
                for (int ks = 0; ks < 4; ++ks) {
                    bf16x8 b;
#pragma unroll
                    for (int e = 0; e < 8; ++e) b[e] = (short)f2bf(wv[ks][e]);
#pragma unroll
                    for (int m = 0; m < 2; ++m) {
                        const bf16x8 a = *(const LAS bf16x8*)(H2b + (32 * m + r) * 144 + (16 * ks + 8 * hf) * 2);
                        acc[m] = __builtin_amdgcn_mfma_f32_32x32x16_bf16(a, b, acc[m], 0, 0, 0);
                    }
                }
                const float delta = fabsf(min_decay + (float)c * ((max_decay - min_decay) / 255.0f));
                const float dstep = delta / (float)(Lx - 1);
                float asum = 0.f;
                if (!isctx) {
#pragma unroll
                    for (int m = 0; m < 2; ++m)
#pragma unroll
                        for (int rg = 0; rg < 16; ++rg) {
                            const int pos = 32 * m + (rg & 3) + 8 * (rg >> 2) + 4 * hf;
                            const float v = acc[m][rg] * __expf(-(float)(t0 + pos) * dstep);
                            asum += fabsf(v);
                            ob[o * 68 + pos] = (unsigned char)(pk_fp8x4(KR_SCALE * v, 0.f, 0.f, 0.f) & 0xFFu);
                        }
                } else {
                    float* kc = F.w<float>(WS_KCOMBC);
#pragma unroll
                    for (int rg = 0; rg < 8; ++rg) {
                        const int pos = (rg & 3) + 8 * (rg >> 2) + 4 * hf, t = t0 + pos;
                        const float v = acc[0][rg] * __expf(-(float)t * dstep);
                        asum += fabsf(v);
                        const int x = dir == 0 ? Lx - 1 + t : Lx - 1 - t;
                        if (dir == 0 || t >= 1) kc[(size_t)x * 256 + c] = v;
                    }
                }
                asum += __shfl_xor(asum, 32);
                if (hf == 0) { if (isctx) F.w<float>(WS_FPARTC)[grp * 512 + o] = asum; else F.w<float>(WS_FPART)[((size_t)l * 256 + grp) * 512 + o] = asum; }
            }
        }
        if (!isctx) {
            __syncthreads();
            unsigned char* KR = F.w<unsigned char>(WS_KR) + (size_t)l * 256 * KRL;
            asm volatile("" : "+v"(tid));
            for (int q = tid; q < 512 * 16; q += NTHREADS) {
                const int o = q >> 4, k = q & 15, c = o & 255, dir = o >> 8;
                const LAS unsigned* ow = (const LAS unsigned*)(ob + o * 68);
                unsigned char* row = KR + (size_t)c * KRL;
                if (dir == 1) {
                    const unsigned w = ow[k];
                    if (t0 + 4 * k >= 1) *(unsigned*)(row + L + t0 + 4 * k) = w;
                    else { row[L + 1] = (unsigned char)(w >> 8); row[L + 2] = (unsigned char)(w >> 16); row[L + 3] = (unsigned char)(w >> 24); }
                } else {
                    const int yb = L - t0 - 64;
                    if (k >= 1) {
                        const unsigned X = ow[15 - k], Y = ow[16 - k];
                        *(unsigned*)(row + yb + 4 * k) = (Y & 0xFFu) | ((X >> 24) << 8) | (((X >> 16) & 0xFFu) << 16) | (((X >> 8) & 0xFFu) << 24);
                    } else {
                        const unsigned X = ow[15], Z = ow[0];
                        row[yb + 1] = (unsigned char)(X >> 24); row[yb + 2] = (unsigned char)(X >> 16); row[yb + 3] = (unsigned char)(X >> 8); row[yb + 64] = (unsigned char)Z;
                    }
                }
            }
            if (grp == 0) for (int q = tid; q < 256 * 513; q += NTHREADS) { const int c = q / 513, r = q % 513; KR[(size_t)c * KRL + (r == 512 ? 0 : 2 * L + r)] = 0; }
        }
    }
}

__device__ __forceinline__ void ph_fsum(const Frame& F) {
    const int nwaves = F.G * 8;
    for (int o = F.bid * 8 + F.wave; o < 768; o += nwaves) {
        const int which = o >> 8, c = o & 255;
        float s = 0.f;
        if (which < 2) { const float* fp = F.w<float>(WS_FPART) + (size_t)which * 256 * 512;
            for (int i = F.lane; i < 256; i += 64) s += fp[(size_t)i * 512 + c] + fp[(size_t)i * 512 + 256 + c]; }
        else { const float* fp = F.w<float>(WS_FPARTC); if (F.lane < 16) s = fp[F.lane * 512 + c] + fp[F.lane * 512 + 256 + c]; }
        s = wave_sum(s);
        if (F.lane == 0) F.w<float>(WS_FSUM)[o] = 1.0f / s;
    }
}

__device__ __forceinline__ void ph_vecs(const Frame& F) {
    for (int q = F.bid * NTHREADS + F.tid; q < 2 * 2 * 6 * 1024; q += F.G * NTHREADS) {
        const int j = q & 1023, k = (q >> 10) % 6, which = ((q >> 10) / 6) & 1, l = (q >> 10) / 12;
        const float* ng = F.in[I_NORMG] + (size_t)l * 4 * 1024;
        float v;
        if (k == 0) v = ng[j] * (1.0f + mod_val(F, l, which, 1 * 1024 + j));
        else if (k == 1) v = mod_val(F, l, which, j);
        else if (k == 2) v = ng[1024 + j] * mod_val(F, l, which, 2 * 1024 + j);
        else if (k == 3) v = ng[2048 + j] * (1.0f + mod_val(F, l, which, 4 * 1024 + j));
        else if (k == 4) v = mod_val(F, l, which, 3 * 1024 + j);
        else v = ng[3072 + j] * mod_val(F, l, which, 5 * 1024 + j);
        F.w<float>(WS_VECS)[q] = v;
    }
}
__device__ __forceinline__ const float* vecs_ptr(const Frame& F, int l, int which, int k) { return F.w<float>(WS_VECS) + (size_t)((l * 2 + which) * 6 + k) * 1024; }

__device__ __forceinline__ void load_row(const float* p, int lane, f32x4 (&v)[4]) {
#pragma unroll
    for (int i = 0; i < 4; ++i) v[i] = *(const f32x4*)(p + 4 * lane + 256 * i);
}
__device__ __forceinline__ float row_rstd(const f32x4 (&v)[4]) {
    float s = 0.f;
#pragma unroll
    for (int i = 0; i < 4; ++i) s += v[i][0] * v[i][0] + v[i][1] * v[i][1] + v[i][2] * v[i][2] + v[i][3] * v[i][3];
    s = wave_sum(s);
    return rsqrtf(s * (1.0f / 1024.0f) + RMS_EPS);
}
__device__ __forceinline__ void stage_norm_vecs(const Frame& F, int l, int gain_idx, int sh_seg, int sc_seg, LAS float* dst  ) {
    for (int q = F.tid; q < 2048; q += NTHREADS) {
        const int which = q >> 10, j = q & 1023;
        const float g = F.in[I_NORMG][(l * 4 + gain_idx) * 1024 + j];
        dst[(which * 2 + 0) * 1024 + j] = g * (1.0f + mod_val(F, l, which, sc_seg * 1024 + j));
        dst[(which * 2 + 1) * 1024 + j] = mod_val(F, l, which, sh_seg * 1024 + j);
    }
}
__device__ __forceinline__ void norm_store_bf16(const f32x4 (&v)[4], float rstd, const LAS float* va, const LAS float* vb, bf16_t* orow, int lane, bool f8 = false) {
#pragma unroll
    for (int i = 0; i < 4; ++i) {
        const int c = 4 * lane + 256 * i;
        const f32x4 a = *(const LAS f32x4*)(va + c), b = *(const LAS f32x4*)(vb + c);
        if (f8) { *(unsigned*)((unsigned char*)orow + c) = pk_fp8x4(v[i][0] * rstd * a[0] + b[0], v[i][1] * rstd * a[1] + b[1], v[i][2] * rstd * a[2] + b[2], v[i][3] * rstd * a[3] + b[3]); }
        else { u32x2 w; w.x = pk_bf16(v[i][0] * rstd * a[0] + b[0], v[i][1] * rstd * a[1] + b[1]); w.y = pk_bf16(v[i][2] * rstd * a[2] + b[2], v[i][3] * rstd * a[3] + b[3]);
        *(u32x2*)(orow + c) = w; }
    }
}
__device__ __forceinline__ const float* xrow_ptr(const Frame& F, int l, int row) {
    if (l == 0) return row < L ? F.in[I_X] + (size_t)row * D : F.in[I_CTX] + (size_t)(row - L) * D;
    return F.w<float>(WS_XCUR) + (size_t)row * D;
}
__device__ __forceinline__ void load_xrow(const Frame& F, int l, int row, int lane, f32x4 (&v)[4]) {
    if (l == 0) { load_row(row < L ? F.in[I_X] + (size_t)row * D : F.in[I_CTX] + (size_t)(row - L) * D, lane, v); return; }
    const bf16_t* p = F.w<bf16_t>(WS_XCUR) + (size_t)row * D;
#pragma unroll
    for (int i = 0; i < 4; ++i) { const u32x2 w = *(const u32x2*)(p + 4 * lane + 256 * i); v[i] = (f32x4){bflo(w.x), bfhi(w.x), bflo(w.y), bfhi(w.y)}; }
}
__device__ __forceinline__ void store_xrow_bf16(bf16_t* p, int lane, const f32x4 (&v)[4]) {
#pragma unroll
    for (int i = 0; i < 4; ++i) { u32x2 w; w.x = pk_bf16(v[i][0], v[i][1]); w.y = pk_bf16(v[i][2], v[i][3]); *(u32x2*)(p + 4 * lane + 256 * i) = w; }
}
__device__ __forceinline__ void ph_norm1(const Frame& F, int l) {
    LAS float* vec = (LAS float*)F.lds;
    __syncthreads();
    stage_norm_vecs(F, l, 0, 0, 1, vec);
    __syncthreads();
    const int nwaves = F.G * 8;
    for (int row = F.bid * 8 + F.wave; row < T; row += nwaves) {
        const int which = row >= L;
        f32x4 v[4]; load_row(xrow_ptr(F, l, row), F.lane, v);
        const float rstd = row_rstd(v);
        const bool r8 = (l == 0) && !F8IN(0) && row >= MIXP_BF * 256 && row < L;
        if (r8) norm_store_bf16(v, rstd, vec + (which * 2) * 1024, vec + (which * 2 + 1) * 1024, (bf16_t*)(F.w<unsigned char>(WS_HB8) + (size_t)(row - MIXP_BF * 256) * D), F.lane, true);
        else norm_store_bf16(v, rstd, vec + (which * 2) * 1024, vec + (which * 2 + 1) * 1024, F8IN(0) ? (bf16_t*)(F.w<unsigned char>(WS_HB) + (size_t)row * D) : F.w<bf16_t>(WS_HB) + (size_t)row * D, F.lane, F8IN(0) != 0);
    }
}

constexpr int SROW = 272;
__device__ __forceinline__ bf16x8 lds_frag(const LAS unsigned char* base, int row, int k) { return *(const LAS bf16x8*)(base + row * SROW + k * 2); }
__device__ __forceinline__ void ph_ssd_prep(const Frame& F, int l) {
    LAS unsigned char* BT = F.lds;
    LAS unsigned char* XW = F.lds + 34816;
    LAS float* dts = (LAS float*)(F.lds + 139264);
    LAS float* wj  = dts + 768;
    const bf16_t* P = F.w<bf16_t>(WS_P);
    const int lane = F.lane, wave = F.wave;
    for (int it = F.bid; it < NCH * 2; it += F.G) {
        const int ch = it >> 1, g = it & 1;
        const int row0 = ch * 128;
        const int seq_lo = ch < 128 ? 0 : L, seq_hi = ch < 128 ? L : T;
        int r = lane & 31, hf = lane >> 5; asm volatile("" : "+v"(r), "+v"(hf));
        __syncthreads();
        if (wave < 6) {
            const int hh = wave >> 1, dir = wave & 1, h = g * 3 + hh;
            const float a = -__expf(F.in[I_ALOG][(l * 2 + dir) * 6 + h]), bias = F.in[I_DTB][(l * 2 + dir) * 6 + h];
            const int j0 = 2 * lane;
            const float d0 = softplus_f(bf2f(P[(size_t)(row0 + j0) * PC + CDT + dir * 6 + h]) + bias);
            const float d1 = softplus_f(bf2f(P[(size_t)(row0 + j0 + 1) * PC + CDT + dir * 6 + h]) + bias);
            const float pair = (d0 + d1) * a;
            float incl = pair;
#pragma unroll
            for (int o = 1; o < 64; o <<= 1) {
                const float v = dir == 0 ? __shfl_up(incl, o) : __shfl_down(incl, o);
                const bool okl = dir == 0 ? (lane >= o) : (lane + o < 64);
                if (okl) incl += v;
            }
            const float total = __shfl(incl, dir == 0 ? 63 : 0);
            float acs0, acs1;
            if (dir == 0) { acs1 = incl; acs0 = incl - d1 * a; }
            else { acs0 = incl; acs1 = incl - d0 * a; }
            float* dtv = F.w<float>(WS_DTV) + (size_t)(row0 + j0) * 12 + dir * 6 + h; dtv[0] = d0; dtv[12] = d1;
            float* acv = F.w<float>(WS_ACS) + (size_t)(row0 + j0) * 12 + dir * 6 + h; acv[0] = acs0; acv[12] = acs1;
            if (lane == 0) F.w<float>(WS_ALAST)[ch * 12 + dir * 6 + h] = total;
            dts[wave * 128 + j0] = d0; dts[wave * 128 + j0 + 1] = d1;
            wj[wave * 128 + j0] = __expf(total - acs0) * d0; wj[wave * 128 + j0 + 1] = __expf(total - acs1) * d1;
        }
        __syncthreads();
        if (F.tid < 448) {
            const int pr = F.tid % 224, half = F.tid / 224;
            const int chn = pr < 96 ? g * 192 + 2 * pr : (pr < 160 ? 384 + g * 128 + 2 * (pr - 96) : 640 + g * 128 + 2 * (pr - 160));
            const float* cw = F.in[I_SCW] + (size_t)l * 5 * 896 + chn; const float* cb = F.in[I_SCB] + (size_t)l * 896 + chn;
            float w0[5], w1[5];
#pragma unroll
            for (int k = 0; k < 5; ++k) { w0[k] = cw[k * 896]; w1[k] = cw[k * 896 + 1]; }
            const float b0 = cb[0], b1 = cb[1];
            const int jb = half * 64;
            const bf16_t* src = P + CXBC + chn;
            unsigned win[12];
#pragma unroll
            for (int k = 0; k < 4; ++k) { const int rr = row0 + jb + k - 2; win[k] = (rr >= seq_lo && rr < seq_hi) ? *(const unsigned*)(src + (size_t)rr * PC) : 0u; }
            const int hh = pr / 32;
            const int pch = 2 * (pr & 31);
            for (int jg = 0; jg < 64; jg += 8) {
#pragma unroll
                for (int k = 0; k < 8; ++k) { const int rr = row0 + jb + jg + k + 2; win[4 + k] = (rr >= seq_lo && rr < seq_hi) ? *(const unsigned*)(src + (size_t)rr * PC) : 0u; }
                float s0[8], s1[8];
#pragma unroll
                for (int u = 0; u < 8; ++u) {
                    float a0 = b0, a1 = b1;
#pragma unroll
                    for (int k = 0; k < 5; ++k) { a0 += w0[k] * bflo(win[u + k]); a1 += w1[k] * bfhi(win[u + k]); }
                    s0[u] = silu_f(a0); s1[u] = silu_f(a1);
                    *(unsigned*)(F.w<bf16_t>(WS_XBC) + (size_t)(row0 + jb + jg + u) * 896 + chn) = pk_bf16(s0[u], s1[u]);
                }
#pragma unroll
                for (int k = 0; k < 4; ++k) win[k] = win[8 + k];
                {
                    const int j0 = jb + jg;
                    if (pr < 96) {
#pragma unroll
                        for (int dir = 0; dir < 2; ++dir) {
                            const f32x4 wlo = *(const LAS f32x4*)(wj + (hh * 2 + dir) * 128 + j0), whi = *(const LAS f32x4*)(wj + (hh * 2 + dir) * 128 + j0 + 4);
                            u32x4 a, b;
                            a.x = pk_bf16(s0[0] * wlo[0], s0[1] * wlo[1]); a.y = pk_bf16(s0[2] * wlo[2], s0[3] * wlo[3]); a.z = pk_bf16(s0[4] * whi[0], s0[5] * whi[1]); a.w = pk_bf16(s0[6] * whi[2], s0[7] * whi[3]);
                            b.x = pk_bf16(s1[0] * wlo[0], s1[1] * wlo[1]); b.y = pk_bf16(s1[2] * wlo[2], s1[3] * wlo[3]); b.z = pk_bf16(s1[4] * whi[0], s1[5] * whi[1]); b.w = pk_bf16(s1[6] * whi[2], s1[7] * whi[3]);
                            LAS unsigned char* d = XW + ((hh * 2 + dir) * 64 + pch) * SROW + j0 * 2;
                            *(LAS u32x4*)d = a; *(LAS u32x4*)(d + SROW) = b;
                        }
                    } else if (pr < 160) {
                        u32x4 a, b;
                        a.x = pk_bf16(s0[0], s0[1]); a.y = pk_bf16(s0[2], s0[3]); a.z = pk_bf16(s0[4], s0[5]); a.w = pk_bf16(s0[6], s0[7]);
                        b.x = pk_bf16(s1[0], s1[1]); b.y = pk_bf16(s1[2], s1[3]); b.z = pk_bf16(s1[4], s1[5]); b.w = pk_bf16(s1[6], s1[7]);
                        LAS unsigned char* d = BT + (2 * (pr - 96)) * SROW + j0 * 2;
                        *(LAS u32x4*)d = a; *(LAS u32x4*)(d + SROW) = b;
                    }
                }
            }
        }
        __syncthreads();
        {
            const int nt = wave & 3, pt = wave >> 2;
#pragma unroll 1
            for (int hh = 0; hh < 3; ++hh) {
                const int h = g * 3 + hh;
                f32x16 a0, a1;
#pragma unroll
                for (int i = 0; i < 16; ++i) { a0[i] = 0.f; a1[i] = 0.f; }
                const LAS unsigned char* X0 = XW + (hh * 2) * 64 * SROW;
#pragma unroll
                for (int ks = 0; ks < 8; ++ks) {
                    const bf16x8 a = lds_frag(BT, 32 * nt + r, 16 * ks + 8 * hf);
                    const bf16x8 b0 = lds_frag(X0, 32 * pt + r, 16 * ks + 8 * hf), b1 = lds_frag(X0, 64 + 32 * pt + r, 16 * ks + 8 * hf);
                    a0 = __builtin_amdgcn_mfma_f32_32x32x16_bf16(a, b0, a0, 0, 0, 0);
                    a1 = __builtin_amdgcn_mfma_f32_32x32x16_bf16(a, b1, a1, 0, 0, 0);
                }
                float* s0 = F.w<float>(WS_STATES) + ((size_t)(0 * NCH + ch) * 6 + h) * 8192 + (32 * pt + r) * 128 + 32 * nt + 4 * hf;
                float* s1 = F.w<float>(WS_STATES) + ((size_t)(1 * NCH + ch) * 6 + h) * 8192 + (32 * pt + r) * 128 + 32 * nt + 4 * hf;
#pragma unroll
                for (int gq = 0; gq < 4; ++gq) { *(f32x4*)(s0 + 8 * gq) = (f32x4){a0[4 * gq], a0[4 * gq + 1], a0[4 * gq + 2], a0[4 * gq + 3]};
                                                 *(f32x4*)(s1 + 8 * gq) = (f32x4){a1[4 * gq], a1[4 * gq + 1], a1[4 * gq + 2], a1[4 * gq + 3]}; }
            }
        }
    }
}

__device__ __forceinline__ void ph_ssd_scan(const Frame& F) {
    const int per = (98304 + F.G - 1) / F.G;
    for (int q = F.tid; q < per; q += NTHREADS) {
        const int id = F.bid * per + q;
        if (id >= 98304) break;
        const int dir = id / 49152, rem = id % 49152, h = rem / 8192, e = rem % 8192;
        const float* al = F.w<float>(WS_ALAST) + dir * 6 + h;
        const float* st = F.w<float>(WS_STATES) + ((size_t)(dir * NCH) * 6 + h) * 8192 + e;
        bf16_t* ss = F.w<bf16_t>(WS_SSTART) + ((size_t)(dir * NCH) * 6 + h) * 8192 + e;
        float sacc = 0.f;
        for (int s0 = 0; s0 < NCH; s0 += 26) {
            float sv[26], dv[26]; int cv[26];
#pragma unroll
            for (int u = 0; u < 26; ++u) {
                const int step = s0 + u;
                cv[u] = dir == 0 ? (step < 2 ? 128 + step : step - 2) : 129 - step;
                sv[u] = st[(size_t)cv[u] * 6 * 8192]; dv[u] = al[cv[u] * 12];
            }
#pragma unroll
            for (int u = 0; u < 26; ++u) { ss[(size_t)cv[u] * 6 * 8192] = f2bf(sacc); sacc = sacc * __expf(dv[u]) + sv[u]; }
        }
    }
}

__device__ __forceinline__ void ph_ssd_out(const Frame& F, int l) {
    LAS unsigned char* Cs = F.lds;
    LAS unsigned char* Bs = F.lds + 34816;
    LAS unsigned char* XT = F.lds + 69632;
    LAS float* Yl = (LAS float*)F.lds;
    LAS float* af = (LAS float*)(F.lds + 98816);
    LAS float* ab = af + 384, *dtf = ab + 384, *dtb = dtf + 384;
    LAS float* red = dtb + 384;
    LAS float* eaf = red + 512, *eab = eaf + 384;
    const bf16_t* XBC = F.w<bf16_t>(WS_XBC);
    const bf16_t* P = F.w<bf16_t>(WS_P);
    const int nch = (l == 0) ? NCH : 128;
    const int lane = F.lane, wave = F.wave, r_in = lane & 31, hf_in = lane >> 5;
    const int it_ = wave & 3, jp = wave >> 2;
    for (int it = F.bid; it < nch * 2; it += F.G) {
        const int ch = it >> 1, g = it & 1, row0 = ch * 128;
        int r = r_in, hf = hf_in; asm volatile("" : "+v"(r), "+v"(hf));
        __syncthreads();
        {
            u32x4 bq[4], cq[4]; float avq[2], dvq[2];
#pragma unroll
            for (int u = 0; u < 4; ++u) { const int q = F.tid + u * NTHREADS, row = q >> 4, piece = q & 15;
                const bf16_t* src = XBC + (size_t)(row0 + row) * 896 + g * 128 + piece * 8; bq[u] = *(const u32x4*)(src + 384); cq[u] = *(const u32x4*)(src + 640); }
#pragma unroll
            for (int u = 0; u < 2; ++u) { const int q = min(F.tid + u * NTHREADS, 767), dir = q / 384, rr = q % 384, hh = rr >> 7, j = rr & 127;
                avq[u] = F.w<float>(WS_ACS)[(size_t)(row0 + j) * 12 + dir * 6 + g * 3 + hh]; dvq[u] = F.w<float>(WS_DTV)[(size_t)(row0 + j) * 12 + dir * 6 + g * 3 + hh]; }
#pragma unroll
            for (int u = 0; u < 4; ++u) { const int q = F.tid + u * NTHREADS, row = q >> 4, piece = q & 15;
                *(LAS u32x4*)(Bs + row * SROW + piece * 16) = bq[u]; *(LAS u32x4*)(Cs + row * SROW + piece * 16) = cq[u]; }
#pragma unroll
            for (int u = 0; u < 2; ++u) { const int q = F.tid + u * NTHREADS;
                if (q < 768) { const int dir = q / 384, rr = q % 384, hh = rr >> 7, j = rr & 127;
                    (dir ? ab : af)[hh * 128 + j] = avq[u]; (dir ? eab : eaf)[hh * 128 + j] = __expf(avq[u]); (dir ? dtb : dtf)[hh * 128 + j] = dvq[u]; } }
        }
        __syncthreads();
        f32x16 G0, G1;
#pragma unroll
        for (int i = 0; i < 16; ++i) { G0[i] = 0.f; G1[i] = 0.f; }
#pragma unroll
        for (int ks = 0; ks < 8; ++ks) {
            const bf16x8 a = lds_frag(Cs, 32 * it_ + r, 16 * ks + 8 * hf);
            const bf16x8 b0 = lds_frag(Bs, 64 * jp + r, 16 * ks + 8 * hf), b1 = lds_frag(Bs, 64 * jp + 32 + r, 16 * ks + 8 * hf);
            G0 = __builtin_amdgcn_mfma_f32_32x32x16_bf16(a, b0, G0, 0, 0, 0);
            G1 = __builtin_amdgcn_mfma_f32_32x32x16_bf16(a, b1, G1, 0, 0, 0);
        }
        f32x16 yacc[3];
#pragma unroll
        for (int hh = 0; hh < 3; ++hh) {
            const int h = g * 3 + hh;
            asm volatile("" : "+v"(r), "+v"(hf));
            bf16x8 sfr[8], sbr[8]; u32x4 xv[2];
            {
                const bf16_t* Sf = F.w<bf16_t>(WS_SSTART) + ((size_t)(0 * NCH + ch) * 6 + h) * 8192 + (32 * jp + r) * 128 + 8 * hf;
                const bf16_t* Sb = F.w<bf16_t>(WS_SSTART) + ((size_t)(1 * NCH + ch) * 6 + h) * 8192 + (32 * jp + r) * 128 + 8 * hf;
#pragma unroll
                for (int ks = 0; ks < 8; ++ks) { sfr[ks] = *(const bf16x8*)(Sf + 16 * ks); sbr[ks] = *(const bf16x8*)(Sb + 16 * ks); }
#pragma unroll
                for (int u = 0; u < 2; ++u) { const int jp_ = F.tid & 63, pg = F.tid >> 6; xv[u] = *(const u32x4*)(XBC + (size_t)(row0 + 2 * jp_ + u) * 896 + h * 64 + pg * 8); }
            }
            bar_lds();
#pragma unroll
            for (int tl = 0; tl < 2; ++tl) {
                const int j = 64 * jp + 32 * tl + r;
                const float afj = af[hh * 128 + j], abj = ab[hh * 128 + j], dfj = dtf[hh * 128 + j], dbj = dtb[hh * 128 + j];
                const int jt = 2 * jp + tl;
                if (jt < it_) {
#pragma unroll
                    for (int rg = 0; rg < 16; ++rg) {
                        const int i = 32 * it_ + (rg & 3) + 8 * (rg >> 2) + 4 * hf;
                        const float wf = __expf(fminf(af[hh * 128 + i] - afj, 0.f)) * dfj;
                        const float gv = tl == 0 ? G0[rg] : G1[rg];
                        *(LAS bf16_t*)(Bs + i * SROW + j * 2) = f2bf(gv * wf);
                    }
                } else if (jt > it_) {
#pragma unroll
                    for (int rg = 0; rg < 16; ++rg) {
                        const int i = 32 * it_ + (rg & 3) + 8 * (rg >> 2) + 4 * hf;
                        const float wb = __expf(fminf(ab[hh * 128 + i] - abj, 0.f)) * dbj;
                        const float gv = tl == 0 ? G0[rg] : G1[rg];
                        *(LAS bf16_t*)(Bs + i * SROW + j * 2) = f2bf(gv * wb);
                    }
                } else {
#pragma unroll
                    for (int rg = 0; rg < 16; ++rg) {
                        const int i = 32 * it_ + (rg & 3) + 8 * (rg >> 2) + 4 * hf;
                        const float mf = fminf(fmaxf((float)(i - j + 1), 0.f), 1.f), mb = fminf(fmaxf((float)(j - i + 1), 0.f), 1.f);
                        const float wf = __expf(fminf(af[hh * 128 + i] - afj, 0.f)) * dfj * mf;
                        const float wb = __expf(fminf(ab[hh * 128 + i] - abj, 0.f)) * dbj * mb;
                        const float gv = tl == 0 ? G0[rg] : G1[rg];
                        *(LAS bf16_t*)(Bs + i * SROW + j * 2) = f2bf(gv * (wf + wb));
                    }
                }
            }
            {
                const int jp_ = F.tid & 63, pg = F.tid >> 6;
                const u32x4 v0 = xv[0], v1 = xv[1];
                LAS unsigned char* d = XT + (pg * 8) * SROW + jp_ * 4;
                *(LAS unsigned*)(d + 0 * SROW) = (v0.x & 0xFFFFu) | (v1.x << 16); *(LAS unsigned*)(d + 1 * SROW) = (v0.x >> 16) | (v1.x & 0xFFFF0000u);
                *(LAS unsigned*)(d + 2 * SROW) = (v0.y & 0xFFFFu) | (v1.y << 16); *(LAS unsigned*)(d + 3 * SROW) = (v0.y >> 16) | (v1.y & 0xFFFF0000u);
                *(LAS unsigned*)(d + 4 * SROW) = (v0.z & 0xFFFFu) | (v1.z << 16); *(LAS unsigned*)(d + 5 * SROW) = (v0.z >> 16) | (v1.z & 0xFFFF0000u);
                *(LAS unsigned*)(d + 6 * SROW) = (v0.w & 0xFFFFu) | (v1.w << 16); *(LAS unsigned*)(d + 7 * SROW) = (v0.w >> 16) | (v1.w & 0xFFFF0000u);
            }
            {
                f32x16 yF, yB;
#pragma unroll
                for (int i = 0; i < 16; ++i) { yF[i] = 0.f; yB[i] = 0.f; }
#pragma unroll
                for (int ks = 0; ks < 8; ++ks) {
                    const bf16x8 ac = lds_frag(Cs, 32 * it_ + r, 16 * ks + 8 * hf);
                    yF = __builtin_amdgcn_mfma_f32_32x32x16_bf16(ac, sfr[ks], yF, 0, 0, 0);
                    yB = __builtin_amdgcn_mfma_f32_32x32x16_bf16(ac, sbr[ks], yB, 0, 0, 0);
                }
#pragma unroll
                for (int rg = 0; rg < 16; ++rg) {
                    const int i = 32 * it_ + (rg & 3) + 8 * (rg >> 2) + 4 * hf;
                    yacc[hh][rg] = eaf[hh * 128 + i] * yF[rg] + eab[hh * 128 + i] * yB[rg];
                }
            }
            bar_lds();
#pragma unroll 2
            for (int ks = 0; ks < 8; ++ks) {
                const bf16x8 aw = lds_frag(Bs, 32 * it_ + r, 16 * ks + 8 * hf), bx = lds_frag(XT, 32 * jp + r, 16 * ks + 8 * hf);
                yacc[hh] = __builtin_amdgcn_mfma_f32_32x32x16_bf16(aw, bx, yacc[hh], 0, 0, 0);
            }
        }
        const int i = F.tid & 127, pq = F.tid >> 7;
        u32x4 xz[3][4];
#pragma unroll
        for (int hh = 0; hh < 3; ++hh) { const int chn = (g * 3 + hh) * 64 + pq * 16;
            xz[hh][0] = *(const u32x4*)(XBC + (size_t)(row0 + i) * 896 + chn); xz[hh][1] = *(const u32x4*)(XBC + (size_t)(row0 + i) * 896 + chn + 8);
            xz[hh][2] = *(const u32x4*)(P + (size_t)(row0 + i) * PC + CZ + chn); xz[hh][3] = *(const u32x4*)(P + (size_t)(row0 + i) * PC + CZ + chn + 8); }
        bar_lds();
#pragma unroll
        for (int hh = 0; hh < 3; ++hh)
#pragma unroll
            for (int rg = 0; rg < 16; ++rg) { const int i2 = 32 * it_ + (rg & 3) + 8 * (rg >> 2) + 4 * hf; Yl[i2 * 193 + hh * 64 + 32 * jp + r] = yacc[hh][rg]; }
        bar_lds();
        float ssq = 0.f;
#pragma unroll
        for (int hh = 0; hh < 3; ++hh) {
            const int h = g * 3 + hh; const float dsk = F.in[I_SSDD][l * 6 + h];
            const u32x4 xa = xz[hh][0], xb = xz[hh][1], za = xz[hh][2], zb = xz[hh][3];
            const unsigned xw_[8] = {xa.x, xa.y, xa.z, xa.w, xb.x, xb.y, xb.z, xb.w}, zw_[8] = {za.x, za.y, za.z, za.w, zb.x, zb.y, zb.z, zb.w};
            LAS float* yr = Yl + i * 193 + hh * 64 + pq * 16;
#pragma unroll
            for (int p2 = 0; p2 < 8; ++p2) {
                const float v0 = (yr[2 * p2] + dsk * bflo(xw_[p2])) * silu_f(bflo(zw_[p2]));
                const float v1 = (yr[2 * p2 + 1] + dsk * bfhi(xw_[p2])) * silu_f(bfhi(zw_[p2]));
                yr[2 * p2] = v0; yr[2 * p2 + 1] = v1; ssq += v0 * v0 + v1 * v1;
            }
        }
        red[pq * 128 + i] = ssq;
        __syncthreads();
        const float tot = red[i] + red[128 + i] + red[256 + i] + red[384 + i];
        const float rstd = rsqrtf(tot * (1.0f / 192.0f) + RMS_EPS);
#pragma unroll
        for (int hh = 0; hh < 3; ++hh) {
            const int h = g * 3 + hh;
            bf16_t* o = F.w<bf16_t>(WS_MIX) + (size_t)(row0 + i) * D + h * 64 + pq * 16;
            const float* ng = F.in[I_SSDNG] + l * 384 + h * 64 + pq * 16;
            const LAS float* yr = Yl + i * 193 + hh * 64 + pq * 16;
            unsigned wv[8];
#pragma unroll
            for (int p2 = 0; p2 < 8; ++p2) wv[p2] = pk_bf16(yr[2 * p2] * rstd * ng[2 * p2], yr[2 * p2 + 1] * rstd * ng[2 * p2 + 1]);
            *(u32x4*)o = (u32x4){wv[0], wv[1], wv[2], wv[3]}; *(u32x4*)(o + 8) = (u32x4){wv[4], wv[5], wv[6], wv[7]};
        }
    }
}

__device__ __forceinline__ int na_kv_off(int key, int piece) { return key * 128 + ((piece ^ (key & 7)) << 4); }
constexpr int NA_VP = 144;
__device__ __forceinline__ int na_v_off(int key, int piece) { return key * NA_VP + piece * 16; }
__device__ __forceinline__ void na_stage_kv(const Frame& F, const bf16_t* P, LAS unsigned char* Kd, LAS unsigned char* Vd, int h, bool local, int r0, int kc0) {
    for (int q = F.tid; q < 256 * 8; q += NTHREADS) {
        const int key = q >> 3, piece = q & 7;
        const int krow = local ? (r0 + (key >> 5)) * 64 + kc0 + (key & 31) : L + key;
        const bf16_t* src = P + (size_t)krow * PC + h * 64 + piece * 8;
        *(LAS u32x4*)(Kd + na_kv_off(key, piece)) = *(const u32x4*)(src + CK);
        *(LAS u32x4*)(Vd + na_v_off(key, piece)) = *(const u32x4*)(src + CV);
    }
}
struct NaItem { int h, r, cg, r0, kc0, qrow0; bool isctx; };
__device__ __forceinline__ NaItem na_item(int cid, int i_lo, int i_hi, int k) {
    NaItem t; t.isctx = (i_lo + k >= i_hi); t.r = 0; t.r0 = 0; t.kc0 = 0;
    if (!t.isctx) { const int it = i_lo + k; t.h = it >> 10; t.cg = (it >> 8) & 3; t.r = it & 255; t.r0 = min(max(t.r - 4, 0), 248); t.kc0 = min(max(16 * t.cg - 8, 0), 32); t.qrow0 = t.r * 64 + t.cg * 16; }
    else { t.h = cid >> 4; t.cg = cid & 15; t.qrow0 = L + t.cg * 16; }
    return t;
}
__device__ __forceinline__ void ph_na(const Frame& F, int l, int part) {
    LAS unsigned char* Kc = F.lds;
    LAS unsigned char* Vc = F.lds + 32768;
    LAS unsigned char* Kl = F.lds + 69632;
    LAS unsigned char* Vl = F.lds + 102400;
    LAS unsigned char* Qs = F.lds + 139264;
    LAS unsigned char* Pw = F.lds + 141312;
    LAS float* ml = (LAS float*)(F.lds + 159744);
    LAS float* bt = ml + 256;
    const bf16_t* P = F.w<bf16_t>(WS_P);
    const float* rpb = F.in[I_RPB] + (size_t)l * 15 * 31 * 6;
    const int nlat = 6 * 256 * 4;
    const int nB = (l == 0) ? 2520 : 0, nA = nlat - nB;
    const int lane = F.lane, wave = F.wave, c16 = lane & 15, kq = lane >> 4;
    const float scale = 0.125f;
    int cur_h = -1;
    const float ws = part == 0 ? (l == 0 ? 0.45f : 0.67f) : 0.0f, wc = part == 0 ? 1.0f : 0.15f;
    const int nP = part == 0 ? nA : nB, base = part == 0 ? 0 : nA;
    const int b0_ = F.bid, b1_ = F.bid + 1;
    const float W0 = b0_ <= 4 ? b0_ * ws : (b0_ <= 12 ? 4.0f * ws + (b0_ - 4) * wc : 4.0f * ws + 8.0f * wc + (float)(b0_ - 12));
    const float W1 = b1_ <= 4 ? b1_ * ws : (b1_ <= 12 ? 4.0f * ws + (b1_ - 4) * wc : 4.0f * ws + 8.0f * wc + (float)(b1_ - 12));
    const float Wtot = 4.0f * ws + 8.0f * wc + (float)(F.G - 12);
    const int i_lo = base + (int)((float)nP * W0 / Wtot + 0.5f), i_hi = (F.bid == F.G - 1) ? base + nP : base + (int)((float)nP * W1 / Wtot + 0.5f);
    const int cid = (l == 0 && part == 0 && F.bid >= 100 && F.bid < 196) ? F.bid - 100 : -1;
    const int n_mine = max(0, i_hi - i_lo) + (cid >= 0 ? 1 : 0);
    u32x4 kreg[4], vreg[4], qreg; float breg = 0.f;
    const int pkey = F.tid >> 3, ppiece = F.tid & 7;
#define NA_PREFETCH(T) do { if (!(T).isctx) { _Pragma("unroll") for (int u = 0; u < 4; ++u) { const int key = pkey + 64 * u; \
            const bf16_t* src = P + (size_t)(((T).r0 + (key >> 5)) * 64 + (T).kc0 + (key & 31)) * PC + (T).h * 64 + ppiece * 8; \
            kreg[u] = *(const u32x4*)(src + CK); vreg[u] = *(const u32x4*)(src + CV); } \
            if (F.tid < 256 && (F.tid & 31) < 31) breg = rpb[(((T).r0 + (F.tid >> 5) - (T).r + 7) * 31 + (F.tid & 31)) * 6 + (T).h]; } \
        if (F.tid < 128) qreg = *(const u32x4*)(P + (size_t)((T).qrow0 + pkey) * PC + CQ + (T).h * 64 + ppiece * 8); } while (0)
    if (n_mine > 0) { const NaItem t0 = na_item(cid, i_lo, i_hi, 0); NA_PREFETCH(t0); }
    for (int k = 0; k < n_mine; ++k) {
        const NaItem t = na_item(cid, i_lo, i_hi, k);
        const bool isctx = t.isctx; const int h = t.h, cg = t.cg, kc0 = t.kc0, qrow0 = t.qrow0;
        if (k == 0) bar_lds();
        if (h != cur_h) { na_stage_kv(F, P, Kc, Vc, h, false, 0, 0); cur_h = h; }
        if (!isctx) {
#pragma unroll
            for (int u = 0; u < 4; ++u) { const int key = pkey + 64 * u; *(LAS u32x4*)(Kl + na_kv_off(key, ppiece)) = kreg[u]; *(LAS u32x4*)(Vl + na_v_off(key, ppiece)) = vreg[u]; }
            if (F.tid < 256) bt[F.tid] = breg;
        }
        if (F.tid < 128) *(LAS u32x4*)(Qs + na_kv_off(pkey, ppiece)) = qreg;
        if (k + 1 < n_mine) { const NaItem tn = na_item(cid, i_lo, i_hi, k + 1); NA_PREFETCH(tn); }
        bar_lds();
        const bool loc = wave < 4;
        const LAS unsigned char* Kb = loc ? Kl : Kc;
        const LAS unsigned char* Vb = loc ? Vl : Vc;
        const int kbase = (wave & 3) * 64;
        LAS unsigned char* pw = Pw + wave * 2304;
        float mq = -INFINITY, lq = 0.f;
        if (!(loc && isctx)) {
            f32x4 sacc[4];
#pragma unroll
            for (int nt = 0; nt < 4; ++nt) sacc[nt] = (f32x4){0.f, 0.f, 0.f, 0.f};
#pragma unroll
            for (int ks = 0; ks < 2; ++ks) {
                const bf16x8 qf = *(const LAS bf16x8*)(Qs + na_kv_off(c16, 4 * ks + kq));
#pragma unroll
                for (int nt = 0; nt < 4; ++nt) {
                    const bf16x8 kf = *(const LAS bf16x8*)(Kb + na_kv_off(kbase + 16 * nt + c16, 4 * ks + kq));
                    sacc[nt] = __builtin_amdgcn_mfma_f32_16x16x32_bf16(kf, qf, sacc[nt], 0, 0, 0);
                }
            }
            if (loc) {
                const int qcol = cg * 16 + c16, cstart = min(max(qcol - 8, 0), 48);
                float bv[4][4];
#pragma unroll
                for (int nt = 0; nt < 4; ++nt)
#pragma unroll
                    for (int rg = 0; rg < 4; ++rg) { const int kk = kbase + 16 * nt + 4 * kq + rg, krow = kk >> 5, kcol = kc0 + (kk & 31); bv[nt][rg] = bt[krow * 32 + min(max(kcol - qcol + 15, 0), 30)]; }
                asm volatile("" ::: "memory");
#pragma unroll
                for (int nt = 0; nt < 4; ++nt)
#pragma unroll
                    for (int rg = 0; rg < 4; ++rg) {
                        const int kk = kbase + 16 * nt + 4 * kq + rg, kcol = kc0 + (kk & 31);
                        const bool ok = (kcol >= cstart) && (kcol < cstart + 16);
                        const float sv = ok ? sacc[nt][rg] * scale + bv[nt][rg] : -INFINITY;
                        sacc[nt][rg] = sv; mq = fmaxf(mq, sv);
                    }
            } else {
#pragma unroll
                for (int nt = 0; nt < 4; ++nt)
#pragma unroll
                    for (int rg = 0; rg < 4; ++rg) { const float sv = sacc[nt][rg] * scale; sacc[nt][rg] = sv; mq = fmaxf(mq, sv); }
            }
            mq = fmaxf(mq, __shfl_xor(mq, 16)); mq = fmaxf(mq, __shfl_xor(mq, 32));
            const float msafe = mq == -INFINITY ? 0.f : mq;
            unsigned pk[4][2];
#pragma unroll
            for (int nt = 0; nt < 4; ++nt) {
                float pv[4];
#pragma unroll
                for (int rg = 0; rg < 4; ++rg) { pv[rg] = __expf(sacc[nt][rg] - msafe); lq += pv[rg]; }
                pk[nt][0] = pk_bf16(pv[0], pv[1]); pk[nt][1] = pk_bf16(pv[2], pv[3]);
            }
            lq += __shfl_xor(lq, 16); lq += __shfl_xor(lq, 32);
            f32x4 oacc[4];
#pragma unroll
            for (int dt = 0; dt < 4; ++dt) oacc[dt] = (f32x4){0.f, 0.f, 0.f, 0.f};
            {
                const unsigned vaddr = (unsigned)(unsigned long long)(Vb + (kbase + 4 * kq + (c16 >> 2)) * NA_VP + 8 * (c16 & 3));
                u32x2 t[2][4][2];
                asm volatile(
                    "ds_read_b64_tr_b16 %0, %16 offset:0\n\tds_read_b64_tr_b16 %1, %16 offset:2304\n\t"
                    "ds_read_b64_tr_b16 %2, %16 offset:32\n\tds_read_b64_tr_b16 %3, %16 offset:2336\n\t"
                    "ds_read_b64_tr_b16 %4, %16 offset:64\n\tds_read_b64_tr_b16 %5, %16 offset:2368\n\t"
                    "ds_read_b64_tr_b16 %6, %16 offset:96\n\tds_read_b64_tr_b16 %7, %16 offset:2400\n\t"
                    "ds_read_b64_tr_b16 %8, %16 offset:4608\n\tds_read_b64_tr_b16 %9, %16 offset:6912\n\t"
                    "ds_read_b64_tr_b16 %10, %16 offset:4640\n\tds_read_b64_tr_b16 %11, %16 offset:6944\n\t"
                    "ds_read_b64_tr_b16 %12, %16 offset:4672\n\tds_read_b64_tr_b16 %13, %16 offset:6976\n\t"
                    "ds_read_b64_tr_b16 %14, %16 offset:4704\n\tds_read_b64_tr_b16 %15, %16 offset:7008\n\t"
                    "s_waitcnt lgkmcnt(0)"
                    : "=&v"(t[0][0][0]), "=&v"(t[0][0][1]), "=&v"(t[0][1][0]), "=&v"(t[0][1][1]), "=&v"(t[0][2][0]), "=&v"(t[0][2][1]), "=&v"(t[0][3][0]), "=&v"(t[0][3][1]),
                      "=&v"(t[1][0][0]), "=&v"(t[1][0][1]), "=&v"(t[1][1][0]), "=&v"(t[1][1][1]), "=&v"(t[1][2][0]), "=&v"(t[1][2][1]), "=&v"(t[1][3][0]), "=&v"(t[1][3][1])
                    : "v"(vaddr) : "memory");
#pragma unroll
                for (int m = 0; m < 2; ++m) {
                    const u32x4 aw = (u32x4){pk[2 * m][0], pk[2 * m][1], pk[2 * m + 1][0], pk[2 * m + 1][1]};
                    const bf16x8 a = __builtin_bit_cast(bf16x8, aw);
#pragma unroll
                    for (int dt = 0; dt < 4; ++dt) {
                        const u32x4 bw = (u32x4){t[m][dt][0].x, t[m][dt][0].y, t[m][dt][1].x, t[m][dt][1].y};
                        oacc[dt] = __builtin_amdgcn_mfma_f32_16x16x32_bf16(a, __builtin_bit_cast(bf16x8, bw), oacc[dt], 0, 0, 0);
                    }
                }
            }
#pragma unroll
            for (int dt = 0; dt < 4; ++dt)
#pragma unroll
                for (int rg = 0; rg < 4; ++rg) *(LAS bf16_t*)(pw + (4 * kq + rg) * 144 + (16 * dt + c16) * 2) = f2bf(oacc[dt][rg]);
        } else {
            for (int q = lane; q < 16 * 36; q += 64) ((LAS unsigned*)pw)[q] = 0u;
        }
        if (kq == 0) { ml[(wave * 16 + c16) * 2] = mq; ml[(wave * 16 + c16) * 2 + 1] = lq; }
        bar_lds();
        {
            const int qi = F.tid >> 5, dp = F.tid & 31;
            float M = -INFINITY;
#pragma unroll
            for (int w = 0; w < 8; ++w) M = fmaxf(M, ml[(w * 16 + qi) * 2]);
            float num0 = 0.f, num1 = 0.f, den = 0.f;
#pragma unroll
            for (int w = 0; w < 8; ++w) {
                const float sc = __expf(ml[(w * 16 + qi) * 2] - M);
                const unsigned ov = *(const LAS unsigned*)(Pw + w * 2304 + qi * 144 + dp * 4);
                num0 += sc * bflo(ov); num1 += sc * bfhi(ov); den += sc * ml[(w * 16 + qi) * 2 + 1];
            }
            const float inv = __builtin_amdgcn_rcpf(den);
            *(unsigned*)(F.w<bf16_t>(WS_MIX) + (size_t)(qrow0 + qi) * D + 384 + h * 64 + 2 * dp) = pk_bf16(num0 * inv, num1 * inv);
        }
    }
#undef NA_PREFETCH
}

__device__ __forceinline__ float hy_conv3(const bf16_t* P, const float* cw, const float* cb, int row, int seq_lo, int seq_hi, int col) {
    float s = cb[col];
    float pv[3];
#pragma unroll
    for (int k = 0; k < 3; ++k) { const int r = row + k - 1, rc = min(max(r, seq_lo), seq_hi - 1); pv[k] = bf2f(P[(size_t)rc * PC + CHY + col]); }
#pragma unroll
    for (int k = 0; k < 3; ++k) { const int r = row + k - 1; s += (r >= seq_lo && r < seq_hi) ? cw[k * 768 + col] * pv[k] : 0.f; }
    return s;
}
__device__ __forceinline__ void ph_hy_prep(const Frame& F, int l) {
    const bf16_t* P = F.w<bf16_t>(WS_P);
    const float* cw = F.in[I_HCW] + (size_t)l * 3 * 768; const float* cb = F.in[I_HCB] + (size_t)l * 768;
    LAS unsigned* ut = (LAS unsigned*)F.lds;
    LAS unsigned* xt = ut + 256 * 33;
    const int cp = F.tid & 127, rq = F.tid >> 7;
    float w0[3][3], w1[3][3], b0[3], b1[3];
#pragma unroll
    for (int sg = 0; sg < 3; ++sg) { b0[sg] = cb[sg * 256 + 2 * cp]; b1[sg] = cb[sg * 256 + 2 * cp + 1];
#pragma unroll
        for (int k = 0; k < 3; ++k) { w0[sg][k] = cw[k * 768 + sg * 256 + 2 * cp]; w1[sg][k] = cw[k * 768 + sg * 256 + 2 * cp + 1]; } }
    for (int it = F.bid; it < L / 64; it += F.G) {
        const int t0 = it * 64, rb = t0 + rq * 16;
        __syncthreads();
        {
            unsigned win[3][18];
#pragma unroll
            for (int sg = 0; sg < 3; ++sg)
#pragma unroll
                for (int k = 0; k < 18; ++k) { const int rr = rb - 1 + k; win[sg][k] = (rr >= 0 && rr < L) ? *(const unsigned*)(P + (size_t)rr * PC + CHY + sg * 256 + 2 * cp) : 0u; }
#pragma unroll
            for (int jp = 0; jp < 8; ++jp) {
                float u0[2], u1[2], xa[2], xb[2];
#pragma unroll
                for (int q = 0; q < 2; ++q) {
                    const int k = 2 * jp + q;
                    float a0[3], a1[3];
#pragma unroll
                    for (int sg = 0; sg < 3; ++sg) {
                        a0[sg] = b0[sg] + w0[sg][0] * bflo(win[sg][k]) + w0[sg][1] * bflo(win[sg][k + 1]) + w0[sg][2] * bflo(win[sg][k + 2]);
                        a1[sg] = b1[sg] + w1[sg][0] * bfhi(win[sg][k]) + w1[sg][1] * bfhi(win[sg][k + 1]) + w1[sg][2] * bfhi(win[sg][k + 2]);
                    }
                    xa[q] = a0[0]; xb[q] = a1[0]; u0[q] = a0[2] * a0[1]; u1[q] = a1[2] * a1[1];
                }
                const int rp = rq * 8 + jp;
                ut[(2 * cp) * 33 + rp] = pk_bf16(u0[0], u0[1]); ut[(2 * cp + 1) * 33 + rp] = pk_bf16(u1[0], u1[1]);
                xt[(2 * cp) * 33 + rp] = pk_bf16(xa[0], xa[1]); xt[(2 * cp + 1) * 33 + rp] = pk_bf16(xb[0], xb[1]);
            }
        }
        __syncthreads();
        for (int q = F.tid; q < 256 * 8; q += NTHREADS) {
            const int c = q >> 3, g = q & 7;
            u32x4 a, b;
            a.x = ut[c * 33 + 4 * g]; a.y = ut[c * 33 + 4 * g + 1]; a.z = ut[c * 33 + 4 * g + 2]; a.w = ut[c * 33 + 4 * g + 3];
            b.x = xt[c * 33 + 4 * g]; b.y = xt[c * 33 + 4 * g + 1]; b.z = xt[c * 33 + 4 * g + 2]; b.w = xt[c * 33 + 4 * g + 3];
            *(u32x4*)(F.w<bf16_t>(WS_UT) + (size_t)c * L + t0 + 8 * g) = a;
            *(u32x4*)(F.w<bf16_t>(WS_X0T) + (size_t)c * L + t0 + 8 * g) = b;
            u32x2 a8; a8.x = pk_fp8x4(bflo(a.x), bfhi(a.x), bflo(a.y), bfhi(a.y)); a8.y = pk_fp8x4(bflo(a.z), bfhi(a.z), bflo(a.w), bfhi(a.w));
            *(u32x2*)(F.w<unsigned char>(WS_UT8) + (size_t)c * L + t0 + 8 * g) = a8;
        }
    }
    if (l == 0) {
        for (int rp = F.bid; rp < LC / 2; rp += F.G) {
            const int row = L + rp * 2 + (F.tid >> 8), c = F.tid & 255;
            const float x1 = hy_conv3(P, cw, cb, row, L, T, 256 + c), v = hy_conv3(P, cw, cb, row, L, T, 512 + c);
            F.w<float>(WS_U)[(size_t)row * 256 + c] = v * x1;
        }
    }
}
__device__ __forceinline__ void ph_hy_conv_ctx(const Frame& F, int l) {
    const bf16_t* P = F.w<bf16_t>(WS_P);
    const float* cw = F.in[I_HCW] + (size_t)l * 3 * 768; const float* cb = F.in[I_HCB] + (size_t)l * 768;
    for (int it = F.bid - 4; it >= 0 && it < 8; it += F.G) {
        const int Lx = LC, rbase = L;
        const int tb = it * 2 + (F.tid >> 8), c = F.tid & 255, t0 = tb * 16;
        const float* U = F.w<float>(WS_U) + (size_t)rbase * 256 + c;
        const float* KC = F.w<float>(WS_KCOMBC) + c;
        float acc[16], wreg[16];
#pragma unroll
        for (int j = 0; j < 16; ++j) { acc[j] = 0.f; wreg[j] = KC[(size_t)(t0 + j + Lx - 1) * 256]; }
        float ub[16], nb[16], ubn[16], nbn[16];
#define HCC_FETCH(UB, NB, s0_) do { _Pragma("unroll") for (int r = 0; r < 16; ++r) { UB[r] = U[(size_t)((s0_) + r) * 256]; const int x = t0 - ((s0_) + r + 1) + Lx - 1; NB[r] = KC[(size_t)(x < 0 ? 0 : x) * 256]; } } while (0)
#define HCC_STEP(UB, NB, s0_) do { _Pragma("unroll") for (int r = 0; r < 16; ++r) { \
            _Pragma("unroll") for (int j = 0; j < 16; ++j) acc[j] += UB[r] * wreg[(j - r) & 15]; \
            const int x = t0 - ((s0_) + r + 1) + Lx - 1; wreg[(15 - r) & 15] = x >= 0 ? NB[r] : 0.f; } } while (0)
        HCC_FETCH(ub, nb, 0);
#pragma unroll 1
        for (int s0 = 0; s0 < Lx; s0 += 32) {
            HCC_FETCH(ubn, nbn, s0 + 16);
            HCC_STEP(ub, nb, s0);
            if (s0 + 32 < Lx) HCC_FETCH(ub, nb, s0 + 32);
            HCC_STEP(ubn, nbn, s0 + 16);
        }
#undef HCC_FETCH
#undef HCC_STEP
        const float inv = F.w<float>(WS_FSUM)[2 * 256 + c];
        const float db = F.in[I_HYD][l * 256 + c];
        const float w0 = cw[c], w1 = cw[768 + c], w2 = cw[1536 + c], bb = cb[c];
        float pvw[18], uu[16];
#pragma unroll
        for (int k = 0; k < 18; ++k) { const int r = rbase + t0 - 1 + k, rc = min(max(r, L), T - 1); pvw[k] = bf2f(P[(size_t)rc * PC + CHY + c]); }
#pragma unroll
        for (int j = 0; j < 16; ++j) uu[j] = F.w<float>(WS_U)[(size_t)(rbase + t0 + j) * 256 + c];
#pragma unroll
        for (int k = 0; k < 18; ++k) { const int r = rbase + t0 - 1 + k; pvw[k] = (r >= L && r < T) ? pvw[k] : 0.f; }
#pragma unroll
        for (int j = 0; j < 16; ++j) {
            const int row = rbase + t0 + j;
            const float x0 = bb + w0 * pvw[j] + w1 * pvw[j + 1] + w2 * pvw[j + 2];
            F.w<bf16_t>(WS_MIX)[(size_t)row * D + 768 + c] = f2bf(x0 * (acc[j] * inv + uu[j] * db));
        }
    }
}

constexpr int HC_UP = 144, HC_UBYTES = 190 * HC_UP;
constexpr int HC_CPOFF = 27392, HC_NG = 83, HC_CPBYTES = 16 * HC_NG * 16;
__device__ __forceinline__ void hc_make_copies(LAS unsigned char* dst, const u32x4 g0, const u32x4 g1, int g) {
    const unsigned w[8] = {g0.x, g0.y, g0.z, g0.w, g1.x, g1.y, g1.z, g1.w};
#pragma unroll
    for (int sh = 0; sh < 16; ++sh) {
        const int b = sh >> 2, r = sh & 3;
        u32x4 o;
        if (r == 0) { o.x = w[b]; o.y = w[b + 1]; o.z = w[b + 2]; o.w = w[b + 3]; }
        else { o.x = __builtin_amdgcn_alignbyte(w[b + 1], w[b], r); o.y = __builtin_amdgcn_alignbyte(w[b + 2], w[b + 1], r);
               o.z = __builtin_amdgcn_alignbyte(w[b + 3], w[b + 2], r); o.w = __builtin_amdgcn_alignbyte(w[b + 4], w[b + 3], r); }
        *(LAS u32x4*)(dst + (sh * HC_NG + g) * 16) = o;
    }
}
__device__ __forceinline__ void ph_hy_conv(const Frame& F, int l) {
    LAS unsigned char* Ul = F.lds;
    LAS unsigned char* Cp = F.lds + HC_CPOFF;
    const int lane = F.lane, wave = F.wave;
    const int nt = wave < 4 ? wave : 7 - wave, par = wave >> 2;
    const int r = lane & 31, h = lane >> 5, sig = r & 15, rho = r >> 4;
    const int sh = (16 - sig) & 15, gofs = 2 * h - rho - (sig ? 1 : 0);
    const int a_lane = (sh * HC_NG + gofs) * 16;
    const int b_lane = r * HC_UP + h * 32;
    const int sclK = 0x79797979, sclU = ONE_E8M0;
    for (int c = F.bid; c < 256; c += F.G) {
        const unsigned char* KRc = F.w<unsigned char>(WS_KR) + ((size_t)l * 256 + c) * KRL;
        const unsigned char* U8c = F.w<unsigned char>(WS_UT8) + (size_t)c * L;
        const bf16_t* UTc = F.w<bf16_t>(WS_UT) + (size_t)c * L;
        __syncthreads();
        {
            u32x4 uq[3];
#pragma unroll
            for (int u = 0; u < 3; ++u) { const int q = F.tid + u * NTHREADS, blk = q >> 3, piece = q & 7, bc = min(max(blk - 31, 0), 127); uq[u] = *(const u32x4*)(U8c + (size_t)bc * 128 + piece * 16); }
#pragma unroll
            for (int u = 0; u < 3; ++u) { const int q = F.tid + u * NTHREADS, blk = q >> 3, piece = q & 7;
                if (q < 190 * 8) *(LAS u32x4*)(Ul + blk * HC_UP + piece * 16) = (blk >= 31 && blk < 159) ? uq[u] : (u32x4){0u, 0u, 0u, 0u}; }
        }
        u32x4 g0 = (u32x4){0u, 0u, 0u, 0u}, g1 = g0;
        if (F.tid < HC_NG) { const unsigned char* src = KRc + 31744 + 16 * F.tid; g0 = *(const u32x4*)src; g1 = *(const u32x4*)(src + 16); }
        if (F.tid < HC_NG) hc_make_copies(Cp, g0, g1, F.tid);
        __syncthreads();
        f32x16 acc[4];
#pragma unroll
        for (int m = 0; m < 4; ++m)
#pragma unroll
            for (int i = 0; i < 16; ++i) acc[m][i] = 0.f;
        for (int ci = 0; ci < 32; ++ci) {
            const int Dc = -128 + 8 * ci;
            if (ci + 1 < 32 && F.tid < HC_NG) { const unsigned char* src = KRc + (31744 - 1024 * (ci + 1)) + 16 * F.tid; g0 = *(const u32x4*)src; g1 = *(const u32x4*)(src + 16); }
            const LAS unsigned char* cp = Cp + (ci & 1) * HC_CPBYTES + a_lane;
#pragma unroll 1
            for (int d2 = 0; d2 < 4; ++d2) {
                const int dd = 2 * d2 + par, Dv = Dc + dd;
                if (!((Dv >= 32 * nt - 127) && (Dv <= 32 * nt + 31) && (Dv > -128))) continue;
                const LAS unsigned char* ap = cp + (8 * (8 - dd)) * 16;
                const LAS unsigned char* bp = Ul + b_lane + (32 * nt - Dv + 31) * HC_UP;
                v8i af[6], bfr[2];
#pragma unroll
                for (int e = 0; e < 6; ++e) { const v4i x = *(const LAS v4i*)(ap - 2 * (e - 2) * 16), y = *(const LAS v4i*)(ap - 2 * (e - 2) * 16 + 16); af[e] = __builtin_shufflevector(x, y, 0, 1, 2, 3, 4, 5, 6, 7); }
#pragma unroll
                for (int ks = 0; ks < 2; ++ks) { const v4i x = *(const LAS v4i*)(bp + ks * 64), y = *(const LAS v4i*)(bp + ks * 64 + 16); bfr[ks] = __builtin_shufflevector(x, y, 0, 1, 2, 3, 4, 5, 6, 7); }
#pragma unroll
                for (int ks = 0; ks < 2; ++ks)
#pragma unroll
                    for (int m = 0; m < 4; ++m)
                        asm volatile("v_mfma_scale_f32_32x32x64_f8f6f4 %0, %1, %2, %0, %3, %4 op_sel_hi:[0,0,0]" : "+v"(acc[m]) : "v"(af[m - 2 * ks + 2]), "v"(bfr[ks]), "v"(sclK), "v"(sclU));
            }
            if (ci + 1 < 32 && F.tid < HC_NG) hc_make_copies(Cp + ((ci + 1) & 1) * HC_CPBYTES, g0, g1, F.tid);
            __syncthreads();
        }
        LAS float* Rd = (LAS float*)F.lds;
        if (wave >= 4) {
#pragma unroll
            for (int m = 0; m < 4; ++m)
#pragma unroll
                for (int i = 0; i < 16; ++i) Rd[(nt * 64 + m * 16 + i) * 64 + lane] = acc[m][i];
        }
        __syncthreads();
        if (wave < 4) {
#pragma unroll
            for (int m = 0; m < 4; ++m)
#pragma unroll
                for (int i = 0; i < 16; ++i) acc[m][i] += Rd[(nt * 64 + m * 16 + i) * 64 + lane];
            const float inv = F.w<float>(WS_FSUM)[l * 256 + c];
            const float db = F.in[I_HYD][l * 256 + c];
            const bf16_t* X0c = F.w<bf16_t>(WS_X0T) + (size_t)c * L;
            bf16_t* YTc = F.w<bf16_t>(WS_YT) + (size_t)c * L;
            const int I = 32 * nt + r;
#pragma unroll
            for (int m = 0; m < 4; ++m) {
#pragma unroll
                for (int g = 0; g < 4; ++g) {
                    const int t = 128 * I + 32 * m + 8 * g + 4 * h;
                    const u32x2 xv = *(const u32x2*)(X0c + t), uv = *(const u32x2*)(UTc + t);
                    float y[4];
#pragma unroll
                    for (int e = 0; e < 4; ++e) y[e] = acc[m][4 * g + e] * inv;
                    y[0] = bflo(xv.x) * (y[0] + bflo(uv.x) * db); y[1] = bfhi(xv.x) * (y[1] + bfhi(uv.x) * db);
                    y[2] = bflo(xv.y) * (y[2] + bflo(uv.y) * db); y[3] = bfhi(xv.y) * (y[3] + bfhi(uv.y) * db);
                    u32x2 o; o.x = pk_bf16(y[0], y[1]); o.y = pk_bf16(y[2], y[3]);
                    *(u32x2*)(YTc + t) = o;
                }
            }
        }
    }
}
__device__ __forceinline__ void ph_hy_tr(const Frame& F) {
    LAS unsigned* yt = (LAS unsigned*)F.lds;
    for (int it = F.bid; it < L / 64; it += F.G) {
        const int t0 = it * 64;
        __syncthreads();
        {
            u32x4 aq[4];
#pragma unroll
            for (int u = 0; u < 4; ++u) { const int q = F.tid + u * NTHREADS, c = q >> 3, g = q & 7; aq[u] = *(const u32x4*)(F.w<bf16_t>(WS_YT) + (size_t)c * L + t0 + 8 * g); }
#pragma unroll
            for (int u = 0; u < 4; ++u) { const int q = F.tid + u * NTHREADS, c = q >> 3, g = q & 7;
                yt[c * 33 + 4 * g] = aq[u].x; yt[c * 33 + 4 * g + 1] = aq[u].y; yt[c * 33 + 4 * g + 2] = aq[u].z; yt[c * 33 + 4 * g + 3] = aq[u].w; }
        }
        __syncthreads();
        for (int q = F.tid; q < 64 * 32; q += NTHREADS) {
            const int row = q >> 5, cg = q & 31;
            const LAS unsigned short* ys = (const LAS unsigned short*)yt;
            unsigned short v[8];
#pragma unroll
            for (int e = 0; e < 8; ++e) v[e] = ys[((cg * 8 + e) * 33) * 2 + row];
            u32x4 o; o.x = v[0] | ((unsigned)v[1] << 16); o.y = v[2] | ((unsigned)v[3] << 16); o.z = v[4] | ((unsigned)v[5] << 16); o.w = v[6] | ((unsigned)v[7] << 16);
            *(u32x4*)(F.w<bf16_t>(WS_MIX) + (size_t)(t0 + row) * D + 768 + cg * 8) = o;
        }
    }
}

__device__ __forceinline__ void ph_post1(const Frame& F, int l) {
    constexpr int HVP = 1032;
    LAS float* hvb = (LAS float*)F.lds;
    LAS float* pl = (LAS float*)(F.lds + 16 * HVP * 4);
    LAS unsigned* lcnt = (LAS unsigned*)(F.lds + 16 * HVP * 4 + 16384);
    LAS unsigned* lpos = lcnt + 64;
    LAS float* pv = (LAS float*)(lpos + 512);
    __syncthreads();
    if (F.tid < 64) lcnt[F.tid] = 0u;
    {
        f32x4 pq[3];
#pragma unroll
        for (int u = 0; u < 3; ++u) { const int q = F.tid + u * NTHREADS, which = q / 768, r = q % 768, kk = r >> 8, c4 = r & 255; pq[u] = *(const f32x4*)(vecs_ptr(F, l, which, 2 + kk) + 4 * c4); }
#pragma unroll
        for (int u = 0; u < 3; ++u) { const int q = F.tid + u * NTHREADS, which = q / 768, r = q % 768, kk = r >> 8, c4 = r & 255; *(LAS f32x4*)(pv + (which * 3 + kk) * 1024 + 4 * c4) = pq[u]; }
    }
    const int c16 = F.lane & 15, kq = F.lane >> 4;
    float wb[8][4][2];
    {
        const float* wrg = F.in[I_WR] + (size_t)l * 1024 * 32 + (size_t)(F.wave * 128 + 4 * kq) * 32 + c16;
#pragma unroll
        for (int j = 0; j < 8; ++j)
#pragma unroll
            for (int s_ = 0; s_ < 4; ++s_)
#pragma unroll
                for (int nf = 0; nf < 2; ++nf) wb[j][s_][nf] = wrg[(16 * j + s_) * 32 + 16 * nf];
    }
    __syncthreads();
    const int nrows = (l == 0) ? T : L;
    const int nwaves = F.G * 8, lane = F.lane;
    unsigned* cnt = F.w<unsigned>(WS_CTL) + CW_CNT + l * 1024;
    if (F.bid == 0) { for (int q = F.tid; q < D / 4; q += NTHREADS) ((unsigned*)(F.w<unsigned char>(WS_H2) + (size_t)T * D))[q] = 0u; }
    const float brl = F.in[I_BR][l * 32 + ((lane >> 1) & 31)];
    const int mye = (lane >> 1) & 31;
    u32x2 mraw[2][4]; u32x4 xraw[2][4];
#define POST1_ISSUE(rbv) do { _Pragma("unroll") for (int u = 0; u < 2; ++u) { const int r0_ = (rbv) + F.wave, r_ = (u == 1 && r0_ + nwaves < nrows) ? r0_ + nwaves : r0_; \
        const bf16_t* mr_ = F.w<bf16_t>(WS_MIXO) + (size_t)r_ * D; \
        _Pragma("unroll") for (int i = 0; i < 4; ++i) mraw[u][i] = *(const u32x2*)(mr_ + 4 * lane + 256 * i); \
        if (l == 0) { const float* xp_ = r_ < L ? F.in[I_X] + (size_t)r_ * D : F.in[I_CTX] + (size_t)(r_ - L) * D; \
            _Pragma("unroll") for (int i = 0; i < 4; ++i) xraw[u][i] = *(const u32x4*)(xp_ + 4 * lane + 256 * i); } \
        else { const bf16_t* xp_ = F.w<bf16_t>(WS_XCUR) + (size_t)r_ * D; \
            _Pragma("unroll") for (int i = 0; i < 4; ++i) { const u32x2 w_ = *(const u32x2*)(xp_ + 4 * lane + 256 * i); xraw[u][i].x = w_.x; xraw[u][i].y = w_.y; } } } } while (0)
    if (F.bid * 8 < nrows) POST1_ISSUE(F.bid * 8);
    int trip = 0;
    for (int rb = F.bid * 8; rb < nrows; rb += 2 * nwaves, ++trip) {
        const int row0 = rb + F.wave;
        int rw[2]; bool vld[2];
        rw[0] = row0; vld[0] = true; vld[1] = (row0 + nwaves < nrows); rw[1] = vld[1] ? row0 + nwaves : row0;
        f32x4 m[2][4], x[2][4], hv[2][4];
#pragma unroll
        for (int u = 0; u < 2; ++u) {
#pragma unroll
            for (int i = 0; i < 4; ++i) { const u32x2 w = mraw[u][i]; m[u][i] = (f32x4){bflo(w.x), bfhi(w.x), bflo(w.y), bfhi(w.y)};
                const u32x4 xw = xraw[u][i];
                if (l == 0) x[u][i] = __builtin_bit_cast(f32x4, xw); else x[u][i] = (f32x4){bflo(xw.x), bfhi(xw.x), bflo(xw.y), bfhi(xw.y)}; } }
#pragma unroll
        for (int u = 0; u < 2; ++u) {
            const int which = rw[u] >= L;
            const LAS float* v0 = pv + (which * 3) * 1024;
            const float rs1 = row_rstd(m[u]);
#pragma unroll
            for (int i = 0; i < 4; ++i) { const f32x4 a = *(const LAS f32x4*)(v0 + 4 * lane + 256 * i); x[u][i] = x[u][i] + m[u][i] * rs1 * a; }
        }
#pragma unroll
        for (int u = 0; u < 2; ++u) {
            if (vld[u]) store_xrow_bf16(F.w<bf16_t>(WS_XCUR) + (size_t)rw[u] * D, lane, x[u]);
        }
#pragma unroll
        for (int u = 0; u < 2; ++u) {
            const int which = rw[u] >= L;
            const LAS float* v1 = pv + (which * 3 + 1) * 1024, *v2 = pv + (which * 3 + 2) * 1024;
            const float rs2 = row_rstd(x[u]);
#pragma unroll
            for (int i = 0; i < 4; ++i) { const f32x4 a = *(const LAS f32x4*)(v1 + 4 * lane + 256 * i), b = *(const LAS f32x4*)(v2 + 4 * lane + 256 * i); hv[u][i] = x[u][i] * rs2 * a + b; }
            if (vld[u]) { unsigned char* ho = F.w<unsigned char>(WS_H2) + (size_t)rw[u] * D;
#pragma unroll
                for (int i = 0; i < 4; ++i) *(unsigned*)(ho + 4 * lane + 256 * i) = pk_fp8x4(hv[u][i][0], hv[u][i][1], hv[u][i][2], hv[u][i][3]); }
        }
#pragma unroll
        for (int u = 0; u < 2; ++u)
#pragma unroll
            for (int i = 0; i < 4; ++i) *(LAS f32x4*)(hvb + (2 * F.wave + u) * HVP + 4 * lane + 256 * i) = hv[u][i];
        if (rb + 2 * nwaves < nrows) POST1_ISSUE(rb + 2 * nwaves);
        bar_lds();
        {
            f32x4 acc0 = (f32x4){0.f, 0.f, 0.f, 0.f}, acc1 = acc0;
#pragma unroll
            for (int j = 0; j < 8; ++j) {
                const f32x4 a = *(const LAS f32x4*)(hvb + c16 * HVP + F.wave * 128 + 16 * j + 4 * kq);
#pragma unroll
                for (int s_ = 0; s_ < 4; ++s_) {
                    acc0 = __builtin_amdgcn_mfma_f32_16x16x4f32(a[s_], wb[j][s_][0], acc0, 0, 0, 0);
                    acc1 = __builtin_amdgcn_mfma_f32_16x16x4f32(a[s_], wb[j][s_][1], acc1, 0, 0, 0);
                }
            }
#pragma unroll
            for (int r = 0; r < 4; ++r) { pl[(F.wave * 16 + 4 * kq + r) * 32 + c16] = acc0[r]; pl[(F.wave * 16 + 4 * kq + r) * 32 + 16 + c16] = acc1[r]; }
        }
        bar_lds();
#pragma unroll
        for (int u = 0; u < 2; ++u) {
            float ps = 0.f;
#pragma unroll
            for (int w4 = 0; w4 < 4; ++w4) ps += pl[(((lane & 1) * 4 + w4) * 16 + 2 * F.wave + u) * 32 + (lane >> 1)];
            float lg = ps + __shfl_xor(ps, 1);
            lg += brl;
            int rank = 0;
#pragma unroll
            for (int e = 0; e < 32; ++e) { const float ov = __int_as_float(__builtin_amdgcn_readlane(__float_as_int(lg), 2 * e)); rank += (ov > lg || (ov == lg && e < mye)) ? 1 : 0; }
            int te[4]; float tv[4];
#pragma unroll
            for (int k = 0; k < 4; ++k) {
                const unsigned long long msk = __ballot(rank == k && (lane & 1) == 0);
                const int idx = msk ? __builtin_amdgcn_readfirstlane((int)__builtin_ctzll(msk)) : 2 * k;
                te[k] = idx >> 1; tv[k] = __int_as_float(__builtin_amdgcn_readlane(__float_as_int(lg), idx));
            }
            const float e1 = __expf(tv[1] - tv[0]), e2 = __expf(tv[2] - tv[0]), e3 = __expf(tv[3] - tv[0]);
            const float inv = __builtin_amdgcn_rcpf(1.0f + e1 + e2 + e3);
            if (lane < 4 && vld[u]) {
                const int k = lane, row = rw[u];
                const int e = k == 0 ? te[0] : (k == 1 ? te[1] : (k == 2 ? te[2] : te[3]));
                const float wgt = (k == 0 ? 1.0f : (k == 1 ? e1 : (k == 2 ? e2 : e3))) * inv;
                const unsigned pos = __hip_atomic_fetch_add(lcnt + e, 1u, __ATOMIC_RELAXED, __HIP_MEMORY_SCOPE_WORKGROUP);
                F.w<int>(WS_RE)[row * 4 + k] = e; F.w<float>(WS_RW)[row * 4 + k] = wgt;
                lpos[((F.wave * 8 + trip) * 2 + u) * 4 + k] = pos | ((unsigned)e << 16);
            }
        }
    }
    __syncthreads();
    if (F.tid < 32) lcnt[32 + F.tid] = atomicAdd(cnt + F.tid * 32, lcnt[F.tid]);
    __syncthreads();
    {
        const int sl = lane >> 2, k = lane & 3, row = F.bid * 8 + F.wave + (sl >> 1) * 2 * nwaves + (sl & 1) * nwaves;
        if (row < nrows) { const unsigned pe = lpos[(F.wave * 16 + sl) * 4 + k]; F.w<int>(WS_RP)[row * 4 + k] = (int)((pe & 0xFFFFu) + lcnt[32 + (pe >> 16)]); }
    }
#undef POST1_ISSUE
}

__device__ __forceinline__ int expert_pad_start(const Frame& F, int l, int& ntiles) {
    const unsigned* cnt = F.w<unsigned>(WS_CTL) + CW_CNT + l * 1024;
    int c = F.lane < 32 ? (int)__hip_atomic_load(cnt + F.lane * 32, __ATOMIC_RELAXED, __HIP_MEMORY_SCOPE_AGENT) : 0;
    int padded = (c + 255) & ~255;
    int incl = padded;
#pragma unroll
    for (int o = 1; o < 32; o <<= 1) { const int v = __shfl_up(incl, o); if ((F.lane & 31) >= o) incl += v; }
    ntiles = __shfl(incl, 31) >> 8;
    return incl - padded;
}

__device__ __forceinline__ void ph_gather(const Frame& F, int l) {
    int ntiles; const int ps = expert_pad_start(F, l, ntiles);
    if (F.bid == 0 && F.wave == 0) {
        int* tab = F.w<int>(WS_CTL) + CW_TILE + l * 320;
        const int nxt = __shfl_down(ps, 1);
        const int endt = (F.lane == 31) ? ntiles : (nxt >> 8);
        if (F.lane < 32) for (int t = ps >> 8; t < endt; ++t) tab[t] = F.lane;
        if (F.lane == 0) F.w<int>(WS_CTL)[CW_NT + l] = ntiles;
    }
    const int nrows = (l == 0) ? T : L;
    for (int a0 = (F.bid * 8 + F.wave) * 64; a0 < nrows * 4; a0 += F.G * 8 * 64) {
        const int a = a0 + F.lane;
        if (a < nrows * 4) {
            const int e = F.w<int>(WS_RE)[a], pos = F.w<int>(WS_RP)[a];
            const int dst = __shfl(ps, e) + pos;
            F.w<int>(WS_SLOT)[a] = dst;
            F.w<int>(WS_ROWTOK)[(size_t)l * MAXROWS + dst] = a >> 2;
        }
    }
}

__device__ __forceinline__ void ph_final(const Frame& F, int l) {
    const int nrows = (l == 0) ? T : L;
    const int nwaves = F.G * 8, lane = F.lane;
    const unsigned char* Y = F.w<unsigned char>(WS_Y) + (size_t)l * MAXROWS * D;
    LAS float* fv = (LAS float*)F.lds;
    __syncthreads();
    {
        f32x4 pq[3];
#pragma unroll
        for (int u = 0; u < 3; ++u) { const int q = F.tid + u * NTHREADS, which = q / 768, r = q % 768, kk = r >> 8, c4 = r & 255;
            const float* vp = kk == 0 ? vecs_ptr(F, l, which, 5) : vecs_ptr(F, 1, which, kk - 1); pq[u] = *(const f32x4*)(vp + 4 * c4); }
#pragma unroll
        for (int u = 0; u < 3; ++u) { const int q = F.tid + u * NTHREADS, which = q / 768, r = q % 768, kk = r >> 8, c4 = r & 255; *(LAS f32x4*)(fv + (which * 3 + kk) * 1024 + 4 * c4) = pq[u]; }
    }
    __syncthreads();
    int slotn[2][4]; float wgtn[2][4];
#define FN_SLOTS(r0_) do { _Pragma("unroll") for (int u = 0; u < 2; ++u) { const int rr_ = ((r0_) + u * nwaves < nrows) ? (r0_) + u * nwaves : (r0_); \
        _Pragma("unroll") for (int k = 0; k < 4; ++k) { slotn[u][k] = F.w<int>(WS_SLOT)[rr_ * 4 + k]; wgtn[u][k] = F.w<float>(WS_RW)[rr_ * 4 + k]; } } } while (0)
    const int rfirst = F.bid * 8 + F.wave;
    if (rfirst < nrows) FN_SLOTS(rfirst);
    for (int row0 = rfirst; row0 < nrows; row0 += 2 * nwaves) {
        int rw[2]; bool vld[2];
        rw[0] = row0; vld[0] = true; vld[1] = (row0 + nwaves < nrows); rw[1] = vld[1] ? row0 + nwaves : row0;
        int slot[2][4]; float wgt[2][4];
#pragma unroll
        for (int u = 0; u < 2; ++u)
#pragma unroll
            for (int k = 0; k < 4; ++k) { slot[u][k] = slotn[u][k]; wgt[u][k] = wgtn[u][k]; }
        unsigned yv[2][4][4]; f32x4 x[2][4];
#pragma unroll
        for (int u = 0; u < 2; ++u) {
#pragma unroll
            for (int k = 0; k < 4; ++k) { const unsigned char* yr = Y + (size_t)slot[u][k] * D;
#pragma unroll
                for (int i = 0; i < 4; ++i) yv[u][k][i] = *(const unsigned*)(yr + 4 * lane + 256 * i); }
            load_xrow(F, 1, rw[u], lane, x[u]);
        }
        if (row0 + 2 * nwaves < nrows) FN_SLOTS(row0 + 2 * nwaves);
#pragma unroll
        for (int u = 0; u < 2; ++u) {
            const int which = rw[u] >= L;
            const LAS float* ve = fv + (which * 3) * 1024;
            f32x4 f[4];
#pragma unroll
            for (int i = 0; i < 4; ++i) f[i] = (f32x4){0.f, 0.f, 0.f, 0.f};
#pragma unroll
            for (int k = 0; k < 4; ++k)
#pragma unroll
                for (int i = 0; i < 4; ++i) { const unsigned w = yv[u][k][i]; const f32x2v lo = __builtin_amdgcn_cvt_pk_f32_fp8(w, false), hi = __builtin_amdgcn_cvt_pk_f32_fp8(w, true);
                    f[i][0] += wgt[u][k] * lo.x; f[i][1] += wgt[u][k] * lo.y; f[i][2] += wgt[u][k] * hi.x; f[i][3] += wgt[u][k] * hi.y; }
            const float rs = row_rstd(f);
#pragma unroll
            for (int i = 0; i < 4; ++i) { const f32x4 a = *(const LAS f32x4*)(ve + 4 * lane + 256 * i); x[u][i] = x[u][i] + f[i] * rs * a; }
            if (vld[u]) {
                if (l == 1) { float* xo = F.o() + (size_t)rw[u] * D;
#pragma unroll
                    for (int i = 0; i < 4; ++i) *(f32x4*)(xo + 4 * lane + 256 * i) = x[u][i]; }
                else store_xrow_bf16(F.w<bf16_t>(WS_XCUR) + (size_t)rw[u] * D, lane, x[u]);
                if (l == 0) {
                    const float rstd = row_rstd(x[u]);
                    const LAS float* va = fv + (which * 3 + 1) * 1024, *vb = fv + (which * 3 + 2) * 1024;
                    bf16_t* orow = F.w<bf16_t>(WS_HB) + (size_t)rw[u] * D;
                    unsigned char* orow8 = F.w<unsigned char>(WS_HB) + (size_t)rw[u] * D;
#pragma unroll
                    for (int i = 0; i < 4; ++i) {
                        const int c = 4 * lane + 256 * i;
                        const f32x4 a = *(const LAS f32x4*)(va + c), b = *(const LAS f32x4*)(vb + c);
                        if (F8IN(1)) *(unsigned*)(orow8 + c) = pk_fp8x4(x[u][i][0] * rstd * a[0] + b[0], x[u][i][1] * rstd * a[1] + b[1], x[u][i][2] * rstd * a[2] + b[2], x[u][i][3] * rstd * a[3] + b[3]);
                        else { u32x2 w; w.x = pk_bf16(x[u][i][0] * rstd * a[0] + b[0], x[u][i][1] * rstd * a[1] + b[1]); w.y = pk_bf16(x[u][i][2] * rstd * a[2] + b[2], x[u][i][3] * rstd * a[3] + b[3]);
                        *(u32x2*)(orow + c) = w; }
                    }
                }
            }
        }
    }
#undef FN_SLOTS
}

__device__ __forceinline__ void ph_outproj_ctx(const Frame& F, int l) {
    LAS float* red = (LAS float*)(F.lds + pg8::STAGE_BYTES);
    const int fr = F.lane & 15, fq = F.lane >> 4;
    for (int p = F.vid; p < 256; p += F.G) {
        const int r0 = L + (p >> 4) * 16, n0 = (p & 15) * 64;
        const bf16_t* ap = F.w<bf16_t>(WS_MIX) + (size_t)(r0 + fr) * D + F.wave * 128 + fq * 8;
        const bf16_t* bp = F.w<bf16_t>(WS_WOUTT) + (size_t)l * D * D + (size_t)(n0 + fr) * D + F.wave * 128 + fq * 8;
        bf16x8 a[4], b[4][4];
#pragma unroll
        for (int ks = 0; ks < 4; ++ks) a[ks] = *(const bf16x8*)(ap + ks * 32);
#pragma unroll
        for (int nf = 0; nf < 4; ++nf)
#pragma unroll
            for (int ks = 0; ks < 4; ++ks) b[nf][ks] = *(const bf16x8*)(bp + (size_t)nf * 16 * D + ks * 32);
        f32x4 acc[4];
#pragma unroll
        for (int nf = 0; nf < 4; ++nf) { acc[nf] = (f32x4){0.f, 0.f, 0.f, 0.f};
#pragma unroll
            for (int ks = 0; ks < 4; ++ks) acc[nf] = __builtin_amdgcn_mfma_f32_16x16x32_bf16(a[ks], b[nf][ks], acc[nf], 0, 0, 0); }
        if (F.wave > 0) {
#pragma unroll
            for (int nf = 0; nf < 4; ++nf)
#pragma unroll
                for (int j = 0; j < 4; ++j) red[((F.wave - 1) * 16 + nf * 4 + j) * 64 + F.lane] = acc[nf][j];
        }
        __syncthreads();
        if (F.wave == 0) {
#pragma unroll
            for (int nf = 0; nf < 4; ++nf)
#pragma unroll
                for (int j = 0; j < 4; ++j) { float s = acc[nf][j];
#pragma unroll
                    for (int w = 0; w < 7; ++w) s += red[(w * 16 + nf * 4 + j) * 64 + F.lane];
                    F.w<bf16_t>(WS_MIXO)[(size_t)(r0 + 4 * fq + j) * D + n0 + nf * 16 + fr] = f2bf(s); }
        }
        __syncthreads();
    }
}

constexpr int PH_PER_LAYER = 10, N_PHASES = 2 + 2 * PH_PER_LAYER;
#ifndef PH_MASK
#define PH_MASK 0xFFFFFFFFu
#endif
#define EN(b) (((PH_MASK) >> (b)) & 1u)
#ifndef DUP_MASK
#define DUP_MASK 0u
#endif
#define REP(b) for (int _rep = 0; _rep < 1 + (int)(((DUP_MASK) >> (b)) & 1u); ++_rep)

__global__ void __launch_bounds__(NTHREADS, 2) mega(Args args) {
    extern __shared__ __attribute__((aligned(16))) unsigned char shm[];
    Frame F0;
    F0.in.kp = (kargp_t)__builtin_amdgcn_kernarg_segment_ptr();
    F0.out = args.out; F0.ws = args.ws; F0.lds = (LAS unsigned char*)shm;
    F0.tid = threadIdx.x; F0.lane = F0.tid & 63; F0.wave = __builtin_amdgcn_readfirstlane(F0.tid >> 6); F0.G = gridDim.x; F0.bid = blockIdx.x;
    volatile LAS unsigned* bst = (volatile LAS unsigned*)(shm + LDS_BYTES - 16);
    XcdBarrier bar; bar.bar = F0.w<unsigned>(WS_CTL) + CW_BAR; bar.x = 0; bar.st = bst;
#if N_LAUNCH_MODE == 1
    if (F0.tid == 0) { bst[0] = 0u; bst[1] = 0u; }
    __syncthreads();
    bar = xcd_barrier_post(F0.w<unsigned>(WS_CTL) + CW_BAR, bst);
#define GRID_BAR() xcd_barrier(bar)
#else
#define GRID_BAR() do {} while (0)
#endif
    const int lo = args.ph_lo, hi = args.ph_hi;
#define IN(k) (lo <= (k) && (k) < hi)
#define SEAM(k) do { if (IN(k) && IN((k) + 1)) GRID_BAR(); } while (0)

    if (IN(0)) { const Frame F = launder(F0); REP(1) ph_modpart(F); }
    SEAM(0);
    if (IN(1)) { const Frame F = launder(F0);
        REP(2) ph_filter(F); REP(3) ph_norm1(F, 0); ph_vecs(F); __syncthreads(); REP(0) ph_convert(F); }
    SEAM(1);
    for (int l = 0; l < 2; ++l) {
        const int pb = 2 + l * PH_PER_LAYER;
        if (EN(5) && IN(pb + 0)) { const Frame F = launder(F0);
            const bool f8 = (l == 0) ? (F8IN(0) != 0) : (F8IN(1) != 0);
            pg8::Gemm g{F.w<bf16_t>(WS_HB), F.w<bf16_t>(WS_WINT) + (size_t)l * PC * D, f8 ? D / 2 : D};
            pg8::SchedGrid S{PC / 256, (T / 256) * (PC / 256), F.G, F.vid};
            pg8::EpiBf16 E{F.w<bf16_t>(WS_P), PC, nullptr, 0};
            if (l == 0 && INPROJ_FP8 == 2) {
                pg8::SchedPanels S1{PC / 256, (MIXP_BF + 1) * (PC / 256), F.G, F.vid, MIXP_BF, 64};
                pg8::gemm_phase<pg8::EpiBf16, pg8::SchedPanels, true, false, false>(F.lds, g, S1, E, F.tid);
                pg8::Gemm g2{(const bf16_t*)F.w<unsigned char>(WS_HB8), (const bf16_t*)F.w<unsigned char>(WS_WIN8), D / 2};
                pg8::SchedGrid S2{PC / 256, (64 - MIXP_BF) * (PC / 256), F.G, F.vid};
                pg8::EpiBf16 E2{F.w<bf16_t>(WS_P) + (size_t)MIXP_BF * 256 * PC, PC, nullptr, 0};
                pg8::gemm_phase<pg8::EpiBf16, pg8::SchedGrid, true, false, true>(F.lds, g2, S2, E2, F.tid);
            }
            else if (INPROJ_FP8 == 0) pg8::gemm_phase<pg8::EpiBf16, pg8::SchedGrid, true, false, false>(F.lds, g, S, E, F.tid);
            else if (INPROJ_FP8 == 3) pg8::gemm_phase<pg8::EpiBf16, pg8::SchedGrid, true, false, true>(F.lds, g, S, E, F.tid);
            else { if (f8) pg8::gemm_phase<pg8::EpiBf16, pg8::SchedGrid, true, false, true>(F.lds, g, S, E, F.tid); else pg8::gemm_phase<pg8::EpiBf16, pg8::SchedGrid, true, false, false>(F.lds, g, S, E, F.tid); }
        }
        SEAM(pb + 0);
        if (IN(pb + 1)) { const Frame F = launder(F0); if (l == 0) { REP(4) ph_fsum(F); } REP(6) ph_ssd_prep(F, l); REP(7) ph_hy_prep(F, l); REP(8) ph_na(F, l, 0); }
        SEAM(pb + 1);
        if (IN(pb + 2)) { const Frame F = launder(F0); REP(9) ph_ssd_scan(F); REP(10) { ph_hy_conv(F, l); } }
        SEAM(pb + 2);
        if (EN(11) && IN(pb + 3)) { const Frame F = launder(F0); REP(11) ph_ssd_out(F, l); REP(18) ph_hy_tr(F); if (l == 0) { ph_hy_conv_ctx(F, l); ph_na(F, l, 1); } }
        SEAM(pb + 3);
        if (EN(12) && IN(pb + 4)) { const Frame F = launder(F0);
            pg8::Gemm g{F.w<bf16_t>(WS_MIX), F.w<bf16_t>(WS_WOUTT) + (size_t)l * D * D, D};
            pg8::SchedGrid S{4, (L / 256) * 4, F.G, F.vid};
            pg8::EpiBf16 E{F.w<bf16_t>(WS_MIXO), D, nullptr, 0};
            REP(12) pg8::gemm_phase<pg8::EpiBf16, pg8::SchedGrid>(F.lds, g, S, E, F.tid);
            if (l == 0) ph_outproj_ctx(F, l);
        }
        SEAM(pb + 4);
        if (EN(13) && IN(pb + 5)) { const Frame F = launder(F0); ph_post1(F, l); }
        SEAM(pb + 5);
        if (EN(14) && IN(pb + 6)) { const Frame F = launder(F0); REP(14) ph_gather(F, l); }
        SEAM(pb + 6);
        if (EN(15) && IN(pb + 7)) { const Frame F = launder(F0);
            const int* tab = F.w<int>(WS_CTL) + CW_TILE + l * 320;
            const int ntiles = __builtin_amdgcn_readfirstlane(F.w<int>(WS_CTL)[CW_NT + l]);
            pg8::Gemm g{F.w<bf16_t>(WS_H2), (const bf16_t*)(F.w<unsigned char>(WS_WGUT) + (size_t)l * NE * 2048 * D), D / 2};
            pg8::SchedMoe S{8, ntiles * 8, F.G, F.vid, tab, 0}; S.preload(F.lane);
            pg8::EpiAct E{F.w<unsigned char>(WS_HMID) + (size_t)l * MAXROWS * D, F.in[I_BGU] + (size_t)l * NE * 2048};
            LAS int* rowtab = (LAS int*)(F.lds + pg8::STAGE_BYTES);
            __syncthreads();
            {
                int nt_; const int ps = expert_pad_start(F, l, nt_);
                const unsigned* cnt = F.w<unsigned>(WS_CTL) + CW_CNT + l * 1024;
                const int total_ = ntiles * 8, Lx_ = F.lane * F.G + F.vid;
                const bool val_ = F.lane < 12 && Lx_ < total_;
                const int pa_l = val_ ? Lx_ / 8 : 0;
                const int e_l = val_ ? tab[pa_l] : 0;
                const int pst_l = __shfl(ps, e_l);
                const int ce_l = (int)__hip_atomic_load(cnt + e_l * 32, __ATOMIC_RELAXED, __HIP_MEMORY_SCOPE_AGENT);
                const int nu_ = F.vid < total_ ? min((total_ - F.vid + F.G - 1) / F.G, 12) : 0;
                if (F.wave < 4) {
                    int rv[12];
#pragma unroll
                    for (int ui = 0; ui < 12; ++ui) {
                        const int pa = __builtin_amdgcn_readlane(pa_l, ui), pst = __builtin_amdgcn_readlane(pst_l, ui), ce = __builtin_amdgcn_readlane(ce_l, ui);
                        const int prow = pa * 256 + F.tid;
                        const int t_ = F.w<int>(WS_ROWTOK)[(size_t)l * MAXROWS + prow];
                        rv[ui] = (prow - pst < ce) ? t_ : T;
                    }
#pragma unroll
                    for (int ui = 0; ui < 12; ++ui) if (ui < nu_) rowtab[ui * 256 + F.tid] = rv[ui];
                }
            }
            __syncthreads();
            REP(15) pg8::gemm_phase<pg8::EpiAct, pg8::SchedMoe, true, true, true>(F.lds, g, S, E, F.tid, rowtab);
        }
        SEAM(pb + 7);
        if (EN(16) && IN(pb + 8)) { const Frame F = launder(F0);
            const int* tab = F.w<int>(WS_CTL) + CW_TILE + l * 320;
            const int ntiles = __builtin_amdgcn_readfirstlane(F.w<int>(WS_CTL)[CW_NT + l]);
            pg8::Gemm g{(const bf16_t*)(F.w<unsigned char>(WS_HMID) + (size_t)l * MAXROWS * D), (const bf16_t*)(F.w<unsigned char>(WS_WDT) + (size_t)l * NE * D * D), D / 2};
            pg8::SchedMoe S{4, ntiles * 4, F.G, F.vid, tab, 0}; S.preload(F.lane);
            pg8::EpiFp8 E{F.w<unsigned char>(WS_Y) + (size_t)l * MAXROWS * D, D, F.in[I_BDN] + (size_t)l * NE * D, D};
            REP(16) pg8::gemm_phase<pg8::EpiFp8, pg8::SchedMoe, true, false, true>(F.lds, g, S, E, F.tid);
        }
        SEAM(pb + 8);
        if (EN(17) && IN(pb + 9)) { const Frame F = launder(F0); ph_final(F, l); }
        if (l == 0) SEAM(pb + 9);
    }
#undef IN
#undef SEAM
}

extern "C" void kernel_launch(void* const* d_in, const int* in_sizes, int n_in, void* d_out, int out_size, void* d_ws, size_t ws_size, hipStream_t stream) {
    static int grid = 0;
    if (grid == 0) {
        if (n_in != N_IN || out_size != L * D || ws_size < WS_END) { fprintf(stderr, "kernel_launch: unexpected shapes: n_in %d out %d ws %zu (need %zu)\n", n_in, out_size, ws_size, (size_t)WS_END); grid = -1; return; }
        int dev = 0, cus = 0, per_cu = 0;
        if (hipGetDevice(&dev) != hipSuccess || hipDeviceGetAttribute(&cus, hipDeviceAttributeMultiprocessorCount, dev) != hipSuccess) { grid = -1; return; }
        if (hipFuncSetAttribute((const void*)mega, hipFuncAttributeMaxDynamicSharedMemorySize, LDS_BYTES) != hipSuccess) { fprintf(stderr, "kernel_launch: hipFuncSetAttribute failed\n"); grid = -1; return; }
        if (hipOccupancyMaxActiveBlocksPerMultiprocessor(&per_cu, (const void*)mega, NTHREADS, LDS_BYTES) != hipSuccess || per_cu < 1) { fprintf(stderr, "kernel_launch: occupancy query says %d\n", per_cu); }
        (void)hipGetLastError();
        grid = cus;
    }
    if (grid < 0) return;
    (void)hipMemsetAsync((char*)d_ws + WS_CTL, 0, CTL_BYTES, stream);
    Args a{};
    for (int i = 0; i < N_IN; ++i) a.in[i] = (const float*)d_in[i];
    a.out = (float*)d_out; a.ws = (unsigned char*)d_ws;
#if N_LAUNCH_MODE == 1
    a.ph_lo = 0; a.ph_hi = N_PHASES;
    hipLaunchKernelGGL(mega, dim3(grid), dim3(NTHREADS), LDS_BYTES, stream, a);
#else
    for (int p = 0; p < N_PHASES; ++p) { a.ph_lo = p; a.ph_hi = p + 1; hipLaunchKernelGGL(mega, dim3(grid), dim3(NTHREADS), LDS_BYTES, stream, a); }
#endif
}
```
